# Optimizing an MI355X kernel written in HIP

```python
import math
import jax
import jax.numpy as jnp
from jax import lax
import numpy as np

D_MODEL = 1024
BATCH = 1
SEQ = 16384
DEPTH = 2

GRID_W = 64
CTX_LEN = 256
NORM_EPS = 1e-6

S5_GROUP = 16
S5_GROUPS = 32
S5_WIDTH = S5_GROUP * S5_GROUPS
S5_STATE = 64
S5_DT_MIN = 1e-3
S5_DT_MAX = 1e-1
S5_LAMBDA_RE_MAX = -1e-4
NA_HEADS = 8
NA_HEAD_DIM = 64
NA_WIDTH = NA_HEADS * NA_HEAD_DIM
NA_KH_MAX = 8
NA_KW = 16
IN_WIDTH = S5_WIDTH + 3 * NA_WIDTH
MIX_WIDTH = S5_WIDTH + NA_WIDTH
FOURIER_GROUPS = 4
N_EXPERTS = 64
N_EXPERT_GROUPS = 8
TOPK_GROUPS = 4
TOP_K = 8
EXPERT_FF = 256
SHARED_FF = 256
ROUTED_SCALE = 2.5
EXPERT_BLOCK = 128

kernel_name = 'hybrid_s5_natten_fnet_moe_dit'


def rms_norm(x):
    xf = x.astype(jnp.float32)
    return (xf * lax.rsqrt(jnp.mean(xf * xf, axis=-1, keepdims=True) + NORM_EPS)).astype(x.dtype)


def modulate(h, shift, scale):
    return rms_norm(h) * (1 + scale) + shift


def adaln(cond, w, b):
    return jnp.split(jax.nn.silu(cond) @ w + b, 6, axis=-1)


def _linear_recurrence(left, right):
    a_l, b_l = left
    a_r, b_r = right
    return a_l * a_r, a_r * b_l + b_r


def s5_discretize(lam_re, lam_im, log_dt, b_re, b_im):
    f32 = jnp.float32
    lam = lax.complex(jnp.minimum(lam_re.astype(f32), S5_LAMBDA_RE_MAX), lam_im.astype(f32))
    dt = jnp.exp(log_dt.astype(f32))[:, None]
    lam_bar = jnp.exp(lam * dt)
    b_bar = ((lam_bar - 1.0) / lam)[..., None] * lax.complex(b_re.astype(f32), b_im.astype(f32))
    return lam_bar, b_bar


def s5_scan(u, lam_bar, b_bar, init, reverse):
    bu = jnp.einsum('btgc,gpc->btgp', u.astype(jnp.complex64), b_bar)
    entry = -1 if reverse else 0
    bu = bu.at[:, entry].add(lam_bar * init)
    a = jnp.broadcast_to(lam_bar, bu.shape)
    _, states = lax.associative_scan(_linear_recurrence, (a, bu), reverse=reverse, axis=1)
    return states


def s5_readout(st_f, st_b, c_f, c_b, d, u, w_glu, b_glu, out_dtype):
    y = (jnp.real(jnp.einsum('btgp,gcp->btgc', st_f, c_f))
         + jnp.real(jnp.einsum('btgp,gcp->btgc', st_b, c_b)) + d * u)
    g = jax.nn.gelu(y.reshape(u.shape[0], u.shape[1], S5_WIDTH).astype(out_dtype))
    return g * jax.nn.sigmoid(g @ w_glu + b_glu)


def neighbourhood_attention(q, k, v, k_ctx, v_ctx, rpb, rows):
    bsz = q.shape[0]
    kh = min(NA_KH_MAX, rows)
    n_local = kh * NA_KW
    scale = NA_HEAD_DIM ** -0.5
    q_col = np.arange(GRID_W)
    col_start = np.clip(q_col - NA_KW // 2, 0, GRID_W - NA_KW)
    key_cols = col_start[:, None] + np.arange(NA_KW)
    rpb_col = rpb[:, :, key_cols - q_col[:, None] + NA_KW - 1]

    def one_row(r):
        r0 = jnp.clip(r - kh // 2, 0, rows - kh)
        key_rows = r0 + jnp.arange(kh)
        idx = (key_rows[None, :, None] * GRID_W + key_cols[:, None, :]).reshape(GRID_W, n_local)
        q_r = lax.dynamic_slice_in_dim(q, r * GRID_W, GRID_W, axis=1)
        k_r = k[:, idx]
        v_r = v[:, idx]
        bias = rpb_col[:, key_rows - r + NA_KH_MAX - 1]
        bias = jnp.transpose(bias, (0, 2, 1, 3)).reshape(NA_HEADS, GRID_W, n_local)
        s_loc = jnp.einsum('bqhd,bqkhd->bhqk', q_r, k_r).astype(jnp.float32) * scale + bias
        s_ctx = jnp.einsum('bqhd,bkhd->bhqk', q_r, k_ctx).astype(jnp.float32) * scale
        p = jax.nn.softmax(jnp.concatenate([s_loc, s_ctx], axis=-1), axis=-1).astype(v.dtype)
        o = jnp.einsum('bhqk,bqkhd->bqhd', p[..., :n_local], v_r)
        return o + jnp.einsum('bhqk,bkhd->bqhd', p[..., n_local:], v_ctx)

    out = lax.map(one_row, jnp.arange(rows))
    return jnp.moveaxis(out, 0, 1).reshape(bsz, rows * GRID_W, NA_WIDTH)


def context_attention(q, k, v):
    s = jnp.einsum('bqhd,bkhd->bhqk', q, k).astype(jnp.float32) * NA_HEAD_DIM ** -0.5
    p = jax.nn.softmax(s, axis=-1).astype(v.dtype)
    o = jnp.einsum('bhqk,bkhd->bqhd', p, v)
    return o.reshape(q.shape[0], q.shape[1], NA_WIDTH)


def even_mixer(a_c, a_l, rows, w_in, lam_re, lam_im, log_dt, b_re, b_im, c_re, c_im, s5_d,
               w_glu, b_glu, q_gain, k_gain, rpb, w_out, need_ctx):
    def project(a):
        bsz, t = a.shape[:2]
        z = a @ w_in
        u = z[..., :S5_WIDTH].astype(jnp.float32).reshape(bsz, t, S5_GROUPS, S5_GROUP)
        qkv = z[..., S5_WIDTH:].reshape(bsz, t, 3, NA_HEADS, NA_HEAD_DIM)
        return u, qkv[:, :, 0], rms_norm(qkv[:, :, 1]) * k_gain, qkv[:, :, 2]

    u_c, qr_c, k_c, v_c = project(a_c)
    u_l, qr_l, k_l, v_l = project(a_l)

    f32 = jnp.float32
    lam_f, bb_f = s5_discretize(lam_re[0], lam_im[0], log_dt[0], b_re[0], b_im[0])
    lam_b, bb_b = s5_discretize(lam_re[1], lam_im[1], log_dt[1], b_re[1], b_im[1])
    cc_f = lax.complex(c_re[0].astype(f32), c_im[0].astype(f32))
    cc_b = lax.complex(c_re[1].astype(f32), c_im[1].astype(f32))
    d32 = s5_d.astype(f32)
    zero = jnp.zeros((u_c.shape[0], S5_GROUPS, S5_STATE), jnp.complex64)
    st_cf = s5_scan(u_c, lam_f, bb_f, zero, False)
    st_cb = s5_scan(u_c, lam_b, bb_b, zero, True)
    st_lf = s5_scan(u_l, lam_f, bb_f, st_cf[:, -1], False)
    st_lb = s5_scan(u_l, lam_b, bb_b, st_cb[:, 0], True)
    s5_l = s5_readout(st_lf, st_lb, cc_f, cc_b, d32, u_l, w_glu, b_glu, a_l.dtype)
    na_l = neighbourhood_attention(rms_norm(qr_l) * q_gain, k_l, v_l, k_c, v_c, rpb, rows)
    y_l = jnp.concatenate([s5_l, na_l], axis=-1) @ w_out
    if not need_ctx:
        return None, y_l
    s5_c = s5_readout(st_cf, st_cb, cc_f, cc_b, d32, u_c, w_glu, b_glu, a_c.dtype)
    na_c = context_attention(rms_norm(qr_c) * q_gain, k_c, v_c)
    y_c = jnp.concatenate([s5_c, na_c], axis=-1) @ w_out
    return y_c, y_l


def fourier_mixer(a, w, b):
    bsz, t, d = a.shape
    hg = a.astype(jnp.float32).reshape(bsz, t, FOURIER_GROUPS, d // FOURIER_GROUPS)
    f = jnp.real(jnp.fft.fft2(hg, axes=(1, 3), norm='ortho'))
    return f.reshape(bsz, t, d).astype(a.dtype) @ w + b


def routed_experts(h, e_idx, e_w, w_gate, w_up, w_down):
    n, d = h.shape
    n_exp = w_gate.shape[0]
    nk = n * TOP_K
    flat_e = e_idx.reshape(-1)
    flat_tok = jnp.repeat(jnp.arange(n, dtype=jnp.int32), TOP_K)
    flat_w = e_w.reshape(-1)
    order = jnp.argsort(flat_e)
    se, st, sw = flat_e[order], flat_tok[order], flat_w[order]
    counts = jnp.bincount(flat_e, length=n_exp)
    padded = (counts + EXPERT_BLOCK - 1) // EXPERT_BLOCK * EXPERT_BLOCK
    pad_end = jnp.cumsum(padded)
    pad_start = pad_end - padded
    start = jnp.cumsum(counts) - counts
    dest = pad_start[se] + (jnp.arange(nk) - start[se])
    n_blocks = (nk + n_exp * (EXPERT_BLOCK - 1) + EXPERT_BLOCK - 1) // EXPERT_BLOCK
    cap = n_blocks * EXPERT_BLOCK
    buf_tok = jnp.full((cap,), n, jnp.int32).at[dest].set(st)
    buf_w = jnp.zeros((cap,), h.dtype).at[dest].set(sw)
    blk_e = jnp.minimum(jnp.searchsorted(pad_end, jnp.arange(n_blocks) * EXPERT_BLOCK, side='right'),
                        n_exp - 1)
    h_pad = jnp.concatenate([h, jnp.zeros((1, d), h.dtype)], axis=0)

    def one_block(args):
        tok, wgt, e = args
        xb = h_pad[tok]
        hid = jax.nn.silu(xb @ w_gate[e]) * (xb @ w_up[e])
        return (hid @ w_down[e]) * wgt[:, None]

    y = lax.map(one_block, (buf_tok.reshape(n_blocks, EXPERT_BLOCK),
                            buf_w.reshape(n_blocks, EXPERT_BLOCK), blk_e))
    out = jnp.zeros((n + 1, d), h.dtype).at[buf_tok].add(y.reshape(cap, d))
    return out[:n]


def moe_ffn(h, w_router, router_bias, w_eg, w_eu, w_ed, w_sg, w_su, w_sd):
    n = h.shape[0]
    scores = jax.nn.sigmoid((h @ w_router).astype(jnp.float32))
    sel = scores + router_bias.astype(jnp.float32)
    grp = sel.reshape(n, N_EXPERT_GROUPS, N_EXPERTS // N_EXPERT_GROUPS)
    grp_score = jnp.sum(lax.top_k(grp, 2)[0], axis=-1)
    _, top_grp = lax.top_k(grp_score, TOPK_GROUPS)
    grp_keep = jnp.any(top_grp[:, :, None] == jnp.arange(N_EXPERT_GROUPS), axis=1)
    keep = jnp.repeat(grp_keep, N_EXPERTS // N_EXPERT_GROUPS, axis=1)
    _, idx = lax.top_k(jnp.where(keep, sel, -jnp.inf), TOP_K)
    gate = jnp.take_along_axis(scores, idx, axis=1)
    gate = ROUTED_SCALE * gate / jnp.sum(gate, axis=-1, keepdims=True)
    routed = routed_experts(h, idx, gate.astype(h.dtype), w_eg, w_eu, w_ed)
    shared = (jax.nn.silu(h @ w_sg) * (h @ w_su)) @ w_sd
    return routed + shared


def setup_inputs(seed: int = 0) -> dict:
    key = jax.random.key(seed)
    keys = iter(jax.random.split(key, 40))
    f32 = jnp.float32
    d = D_MODEL
    n_even = (DEPTH + 1) // 2
    n_odd = DEPTH // 2

    def nrm(shape, scale):
        return jax.random.normal(next(keys), shape, f32) * scale

    s5_shape = (n_even, 2, S5_GROUPS, S5_STATE)
    c_scale = S5_STATE ** -0.25
    return {
        'x': nrm((BATCH, SEQ, d), 1.0),
        'c': nrm((BATCH, d), 1.0),
        'ctx': nrm((BATCH, CTX_LEN, d), 1.0),
        'c_ctx': nrm((d,), 1.0),
        'w_ada': nrm((DEPTH, d, 6 * d), 0.5 * d ** -0.5),
        'b_ada': nrm((DEPTH, 6 * d), 0.02),
        'w_in': nrm((n_even, d, IN_WIDTH), d ** -0.5),
        's5_lam_re': -0.5 + nrm(s5_shape, 0.01),
        's5_lam_im': jnp.pi * jnp.arange(S5_STATE, dtype=f32) + nrm(s5_shape, 0.01),
        's5_log_dt': jax.random.uniform(next(keys), (n_even, 2, S5_GROUPS), f32,
                                        math.log(S5_DT_MIN), math.log(S5_DT_MAX)),
        's5_b_re': nrm((n_even, 2, S5_GROUPS, S5_STATE, S5_GROUP), (2 * S5_GROUP) ** -0.5),
        's5_b_im': nrm((n_even, 2, S5_GROUPS, S5_STATE, S5_GROUP), (2 * S5_GROUP) ** -0.5),
        's5_c_re': nrm((n_even, 2, S5_GROUPS, S5_GROUP, S5_STATE), c_scale),
        's5_c_im': nrm((n_even, 2, S5_GROUPS, S5_GROUP, S5_STATE), c_scale),
        's5_d': nrm((n_even, S5_GROUPS, S5_GROUP), 1.0),
        's5_w_glu': nrm((n_even, S5_WIDTH, S5_WIDTH), S5_WIDTH ** -0.5),
        's5_b_glu': nrm((n_even, S5_WIDTH), 0.01),
        'na_q_gain': 1.0 + nrm((n_even, NA_HEAD_DIM), 0.01),
        'na_k_gain': 1.0 + nrm((n_even, NA_HEAD_DIM), 0.01),
        'na_rpb': nrm((n_even, NA_HEADS, 2 * NA_KH_MAX - 1, 2 * NA_KW - 1), 0.1),
        'w_mix_out': nrm((n_even, MIX_WIDTH, d), MIX_WIDTH ** -0.5),
        'w_fourier_out': nrm((n_odd, d, d), d ** -0.5),
        'b_fourier_out': nrm((n_odd, d), 0.01),
        'w_router': nrm((DEPTH, d, N_EXPERTS), d ** -0.5),
        'router_bias': nrm((DEPTH, N_EXPERTS), 0.01),
        'w_exp_gate': nrm((DEPTH, N_EXPERTS, d, EXPERT_FF), d ** -0.5),
        'w_exp_up': nrm((DEPTH, N_EXPERTS, d, EXPERT_FF), d ** -0.5),
        'w_exp_down': nrm((DEPTH, N_EXPERTS, EXPERT_FF, d), EXPERT_FF ** -0.5),
        'w_sh_gate': nrm((DEPTH, d, SHARED_FF), d ** -0.5),
        'w_sh_up': nrm((DEPTH, d, SHARED_FF), d ** -0.5),
        'w_sh_down': nrm((DEPTH, SHARED_FF, d), SHARED_FF ** -0.5),
    }


def reference(x, c, ctx, c_ctx, w_ada, b_ada, w_in, s5_lam_re, s5_lam_im, s5_log_dt,
              s5_b_re, s5_b_im, s5_c_re, s5_c_im, s5_d, s5_w_glu, s5_b_glu, na_q_gain,
              na_k_gain, na_rpb, w_mix_out, w_fourier_out, b_fourier_out, w_router,
              router_bias, w_exp_gate, w_exp_up, w_exp_down, w_sh_gate, w_sh_up, w_sh_down):
    d = x.shape[-1]
    rows = x.shape[1] // GRID_W
    h_l, h_c = x, ctx
    for i in range(DEPTH):
        need_ctx = any(j % 2 == 0 for j in range(i + 1, DEPTH))
        ml = [m[:, None, :] for m in adaln(c, w_ada[i], b_ada[i])]
        a_l = modulate(h_l, ml[0], ml[1])
        if i % 2 == 0 or need_ctx:
            mc = adaln(c_ctx, w_ada[i], b_ada[i])
        if i % 2 == 0:
            e = i // 2
            y_c, y_l = even_mixer(modulate(h_c, mc[0], mc[1]), a_l, rows, w_in[e],
                                  s5_lam_re[e], s5_lam_im[e], s5_log_dt[e], s5_b_re[e],
                                  s5_b_im[e], s5_c_re[e], s5_c_im[e], s5_d[e], s5_w_glu[e],
                                  s5_b_glu[e], na_q_gain[e], na_k_gain[e], na_rpb[e],
                                  w_mix_out[e], need_ctx)
        else:
            o = i // 2
            y_l = fourier_mixer(a_l, w_fourier_out[o], b_fourier_out[o])
            y_c = (fourier_mixer(modulate(h_c, mc[0], mc[1]), w_fourier_out[o], b_fourier_out[o])
                   if need_ctx else None)
        h_l = h_l + ml[2] * y_l
        f_l = modulate(h_l, ml[3], ml[4]).reshape(-1, d)
        moe_w = (w_router[i], router_bias[i], w_exp_gate[i], w_exp_up[i], w_exp_down[i],
                 w_sh_gate[i], w_sh_up[i], w_sh_down[i])
        if need_ctx:
            h_c = h_c + mc[2] * y_c
            f_c = modulate(h_c, mc[3], mc[4]).reshape(-1, d)
            n_c = f_c.shape[0]
            ffn = moe_ffn(jnp.concatenate([f_c, f_l], axis=0), *moe_w)
            h_c = h_c + mc[5] * ffn[:n_c].reshape(h_c.shape)
            h_l = h_l + ml[5] * ffn[n_c:].reshape(h_l.shape)
        else:
            h_l = h_l + ml[5] * moe_ffn(f_l, *moe_w).reshape(h_l.shape)
    return h_l
```

```cpp
#include <hip/hip_runtime.h>
#include <cstdio>
#include <cstdint>
#include <cmath>
namespace ref {
constexpr int TOK = 16384, CTXN = 256, NROW = TOK + CTXN, DM = 1024;

__device__ __forceinline__ float wave_sum(float v) {
#pragma unroll
  for (int o = 32; o >= 1; o >>= 1) v += __shfl_xor(v, o);
  return v;
}
__device__ __forceinline__ float wave_max(float v) {
#pragma unroll
  for (int o = 32; o >= 1; o >>= 1) v = fmaxf(v, __shfl_xor(v, o));
  return v;
}

__global__ void k_adaln(const float* cond, const float* w, const float* b, float* out) {
  int j = blockIdx.x * 256 + threadIdx.x;
  float acc = b[j];
  for (int k = 0; k < 1024; ++k) { float c = cond[k]; float s = c / (1.f + expf(-c)); acc += s * w[(size_t)k * 6144 + j]; }
  out[j] = acc;
}

__global__ void k_modulate(const float* h, const float* shift, const float* scale, float* out) {
  int row = blockIdx.x; const float* hr = h + (size_t)row * 1024; float* orow = out + (size_t)row * 1024;
  float v[4]; float ss = 0.f;
#pragma unroll
  for (int i = 0; i < 4; ++i) { v[i] = hr[threadIdx.x + 256 * i]; ss += v[i] * v[i]; }
  ss = wave_sum(ss);
  __shared__ float red[4];
  if ((threadIdx.x & 63) == 0) red[threadIdx.x >> 6] = ss;
  __syncthreads();
  float tot = red[0] + red[1] + red[2] + red[3];
  float r = rsqrtf(tot * (1.f / 1024.f) + 1e-6f);
#pragma unroll
  for (int i = 0; i < 4; ++i) { int c = threadIdx.x + 256 * i; orow[c] = v[i] * r * (1.f + scale[c]) + shift[c]; }
}

__global__ void __launch_bounds__(256) k_gemm(const float* A, int lda, const int* rows, const int* mcnt, const float* B, int ldb,
                                              float* C, int ldc, int M, int N, int K, const int* srow, const float* sw) {
  if (mcnt) { int mc = *mcnt; M = mc < M ? mc : M; }
  int m0 = blockIdx.y * 64, n0 = blockIdx.x * 64;
  if (m0 >= M) return;
  __shared__ float As[16][65];
  __shared__ float Bs[16][64];
  int tx = threadIdx.x & 15, ty = threadIdx.x >> 4;
  float acc[4][4];
#pragma unroll
  for (int i = 0; i < 4; ++i)
#pragma unroll
    for (int j = 0; j < 4; ++j) acc[i][j] = 0.f;
  for (int k0 = 0; k0 < K; k0 += 16) {
#pragma unroll
    for (int i = 0; i < 4; ++i) {
      int e = threadIdx.x + 256 * i; int r = e >> 4, c = e & 15; int gr = m0 + r; float v = 0.f;
      if (gr < M) { int ar = rows ? rows[gr] : gr; v = A[(size_t)ar * lda + k0 + c]; }
      As[c][r] = v;
    }
#pragma unroll
    for (int i = 0; i < 4; ++i) { int e = threadIdx.x + 256 * i; int r = e >> 6, c = e & 63; Bs[r][c] = B[(size_t)(k0 + r) * ldb + n0 + c]; }
    __syncthreads();
#pragma unroll
    for (int kk = 0; kk < 16; ++kk) {
      float a[4], b[4];
#pragma unroll
      for (int i = 0; i < 4; ++i) a[i] = As[kk][ty * 4 + i];
#pragma unroll
      for (int j = 0; j < 4; ++j) b[j] = Bs[kk][tx * 4 + j];
#pragma unroll
      for (int i = 0; i < 4; ++i)
#pragma unroll
        for (int j = 0; j < 4; ++j) acc[i][j] += a[i] * b[j];
    }
    __syncthreads();
  }
#pragma unroll
  for (int i = 0; i < 4; ++i) {
    int gr = m0 + ty * 4 + i;
    if (gr < M) {
      if (srow) {
        float* cp = C + (size_t)srow[gr] * ldc + n0 + tx * 4; float s = sw[gr];
#pragma unroll
        for (int j = 0; j < 4; ++j) cp[j] += s * acc[i][j];
      } else {
        float* cp = C + (size_t)gr * ldc + n0 + tx * 4;
#pragma unroll
        for (int j = 0; j < 4; ++j) cp[j] = acc[i][j];
      }
    }
  }
}

__global__ void k_headnorm(float* z, const float* gain, int coloff, int nrows) {
  int idx = blockIdx.x * 256 + threadIdx.x; if (idx >= nrows * 8) return;
  int row = idx >> 3, h = idx & 7; float* p = z + (size_t)row * 2048 + coloff + h * 64;
  float ss = 0.f; for (int d = 0; d < 64; ++d) ss += p[d] * p[d];
  float r = rsqrtf(ss * (1.f / 64.f) + 1e-6f);
  for (int d = 0; d < 64; ++d) p[d] = p[d] * r * gain[d];
}

__global__ void k_s5prep(const float* lam_re, const float* lam_im, const float* log_dt, const float* b_re, const float* b_im,
                         float2* lamb, float2* bbar) {
  int idx = blockIdx.x * 256 + threadIdx.x; if (idx >= 4096) return;
  int dg = idx >> 6;
  float lr = fminf(lam_re[idx], -1e-4f), li = lam_im[idx]; float dt = expf(log_dt[dg]);
  float er = expf(lr * dt); float sn, cs; sincosf(li * dt, &sn, &cs); float br = er * cs, bi = er * sn;
  float nr = br - 1.f, ni = bi; float den = lr * lr + li * li; float cr = (nr * lr + ni * li) / den, ci = (ni * lr - nr * li) / den;
  lamb[idx] = make_float2(br, bi);
  for (int c = 0; c < 16; ++c) { float xr = b_re[idx * 16 + c], xi = b_im[idx * 16 + c]; bbar[idx * 16 + c] = make_float2(cr * xr - ci * xi, cr * xi + ci * xr); }
}

__global__ void __launch_bounds__(64) k_s5scan(const float* z, const float2* lamb, const float2* bbar, const float* c_re, const float* c_im,
                                               const float* dvec, float* y) {
  int g = blockIdx.x; int lane = threadIdx.x;
  __shared__ float2 xs[64];
  int c = lane & 15, q = lane >> 4;
  for (int dir = 0; dir < 2; ++dir) {
    int ci = (dir * 32 + g) * 64 + lane;
    float2 lam = lamb[ci]; float2 bb[16];
#pragma unroll
    for (int cc = 0; cc < 16; ++cc) bb[cc] = bbar[ci * 16 + cc];
    float cre[16], cim[16];
#pragma unroll
    for (int j = 0; j < 16; ++j) { cre[j] = c_re[((dir * 32 + g) * 16 + c) * 64 + q * 16 + j]; cim[j] = c_im[((dir * 32 + g) * 16 + c) * 64 + q * 16 + j]; }
    float dd = dvec[g * 16 + c];
    float xr = 0.f, xi = 0.f;
    for (int j = 0; j < NROW; ++j) {
      int row = dir == 0 ? (j < 256 ? TOK + j : j - 256) : (j < 256 ? TOK + 255 - j : TOK - 1 - (j - 256));
      const float* up = z + (size_t)row * 2048 + g * 16;
      float4 u0 = *(const float4*)(up), u1 = *(const float4*)(up + 4), u2 = *(const float4*)(up + 8), u3 = *(const float4*)(up + 12);
      float u[16] = {u0.x, u0.y, u0.z, u0.w, u1.x, u1.y, u1.z, u1.w, u2.x, u2.y, u2.z, u2.w, u3.x, u3.y, u3.z, u3.w};
      float br = 0.f, bi = 0.f;
#pragma unroll
      for (int cc = 0; cc < 16; ++cc) { br += bb[cc].x * u[cc]; bi += bb[cc].y * u[cc]; }
      float nr = lam.x * xr - lam.y * xi + br, ni = lam.x * xi + lam.y * xr + bi; xr = nr; xi = ni;
      if (j >= 256) {
        xs[lane] = make_float2(xr, xi); __syncthreads();
        float part = 0.f;
#pragma unroll
        for (int jj = 0; jj < 16; ++jj) { float2 v = xs[q * 16 + jj]; part += cre[jj] * v.x - cim[jj] * v.y; }
        part += __shfl_xor(part, 16); part += __shfl_xor(part, 32);
        if (q == 0) { float uc = up[c]; float* yp = y + (size_t)row * 512 + g * 16 + c; if (dir == 0) *yp = part + dd * uc; else *yp += part; }
        __syncthreads();
      }
    }
  }
}

__device__ __forceinline__ float gelu_tanh(float x) { return 0.5f * x * (1.f + tanhf(0.7978845608028654f * (x + 0.044715f * x * x * x))); }
__global__ void k_gelu(const float* y, float* g, int n) { int i = blockIdx.x * 256 + threadIdx.x; if (i < n) g[i] = gelu_tanh(y[i]); }
__global__ void k_glu(const float* g, const float* t, const float* b, float* concat) {
  int i = blockIdx.x * 256 + threadIdx.x; int row = i >> 9, col = i & 511;
  float v = t[i] + b[col]; concat[(size_t)row * 1024 + col] = g[i] / (1.f + expf(-v));
}

__global__ void __launch_bounds__(512) k_na(const float* z, const float* rpb, float* concat) {
  int t = blockIdx.x; int r = t >> 6, cc = t & 63;
  int r0 = min(max(r - 4, 0), 248); int cs = min(max(cc - 8, 0), 48);
  __shared__ float qs[512]; __shared__ float sc[8][384]; __shared__ float ssum[8];
  int tid = threadIdx.x;
  qs[tid] = z[(size_t)t * 2048 + 512 + tid]; __syncthreads();
  for (int e = tid; e < 3072; e += 512) {
    int h = e / 384, kk = e % 384; int row; float bias = 0.f;
    if (kk < 128) { int kr = r0 + (kk >> 4), kc = cs + (kk & 15); row = kr * 64 + kc; bias = rpb[(h * 15 + (kr - r + 7)) * 31 + (kc - cc + 15)]; }
    else row = TOK + kk - 128;
    const float* kp = z + (size_t)row * 2048 + 1024 + h * 64; float s = 0.f;
    for (int d = 0; d < 64; ++d) s += qs[h * 64 + d] * kp[d];
    sc[h][kk] = s * 0.125f + bias;
  }
  __syncthreads();
  int h = tid >> 6, lane = tid & 63;
  float m = -1e30f; for (int kk = lane; kk < 384; kk += 64) m = fmaxf(m, sc[h][kk]);
  m = wave_max(m);
  float sum = 0.f; for (int kk = lane; kk < 384; kk += 64) { float p = expf(sc[h][kk] - m); sc[h][kk] = p; sum += p; }
  sum = wave_sum(sum);
  if (lane == 0) ssum[h] = sum;
  __syncthreads();
  float o = 0.f;
  for (int kk = 0; kk < 384; ++kk) {
    int row; if (kk < 128) { int kr = r0 + (kk >> 4), kc = cs + (kk & 15); row = kr * 64 + kc; } else row = TOK + kk - 128;
    o += sc[h][kk] * z[(size_t)row * 2048 + 1536 + h * 64 + lane];
  }
  concat[(size_t)t * 1024 + 512 + h * 64 + lane] = o / ssum[h];
}

__global__ void k_resid(const float* hin, const float* gate, const float* y, const float* bias, float* hout) {
  size_t i = (size_t)blockIdx.x * 256 + threadIdx.x; int col = (int)(i & 1023);
  float v = y[i]; if (bias) v += bias[col]; hout[i] = hin[i] + gate[col] * v;
}

__global__ void __launch_bounds__(64) k_route(const float* logits, const float* rbias, int* cnt, int* ltok, float* lw) {
  __shared__ float s_sc[64][64]; __shared__ float s_sel[64][64];
  int tid = threadIdx.x; int t = blockIdx.x * 64 + tid;
  for (int e = 0; e < 64; ++e) { float l = logits[(size_t)t * 64 + e]; float s = 1.f / (1.f + expf(-l)); s_sc[e][tid] = s; s_sel[e][tid] = s + rbias[e]; }
  float gs[8];
#pragma unroll
  for (int g = 0; g < 8; ++g) { float m1 = -INFINITY, m2 = -INFINITY;
#pragma unroll
    for (int j = 0; j < 8; ++j) { float v = s_sel[g * 8 + j][tid]; if (v > m1) { m2 = m1; m1 = v; } else if (v > m2) m2 = v; }
    gs[g] = m1 + m2; }
  unsigned keep = 0u;
#pragma unroll
  for (int it = 0; it < 4; ++it) { float best = -INFINITY; int bi = 0;
#pragma unroll
    for (int g = 0; g < 8; ++g) { if (!((keep >> g) & 1u) && gs[g] > best) { best = gs[g]; bi = g; } }
    keep |= 1u << bi; }
  unsigned long long taken = 0ull; int idx[8]; float gt[8]; float gsum = 0.f;
#pragma unroll
  for (int it = 0; it < 8; ++it) { float best = -INFINITY; int bi = 0;
    for (int e = 0; e < 64; ++e) { if (((keep >> (e >> 3)) & 1u) && !((taken >> e) & 1ull)) { float v = s_sel[e][tid]; if (v > best) { best = v; bi = e; } } }
    taken |= 1ull << bi; idx[it] = bi; gt[it] = s_sc[bi][tid]; gsum += gt[it]; }
#pragma unroll
  for (int it = 0; it < 8; ++it) { int e = idx[it]; float w = 2.5f * gt[it] / gsum; int slot = atomicAdd(&cnt[e], 1); ltok[(size_t)e * TOK + slot] = t; lw[(size_t)e * TOK + slot] = w; }
}

__global__ void k_swiglu(const float* hg, const float* hu, float* hid, const int* mcnt, int cap) {
  int i = blockIdx.x * 256 + threadIdx.x; int row = i >> 8; int mc = mcnt ? *mcnt : cap; if (row >= mc) return;
  float g = hg[i]; hid[i] = g / (1.f + expf(-g)) * hu[i];
}

__global__ void k_twiddle(float2* tw) { int n = blockIdx.x * 256 + threadIdx.x; float s, c; sincospif((float)n / 8192.f, &s, &c); tw[n] = make_float2(c, -s); }
__global__ void k_dftmat(const float2* tw, float* Dm) { int i = blockIdx.x * 256 + threadIdx.x; int c = i >> 9, col = i & 511; int m = col & 255; float2 w = tw[(c * m * 64) & 16383]; Dm[i] = col < 256 ? w.x : w.y; }
__global__ void k_fft1(const float* Z, const float2* tw, float* Yr, float* Yi) {
  size_t idx = (size_t)blockIdx.x * 256 + threadIdx.x; int ch = (int)(idx & 1023); int t2 = (int)((idx >> 10) & 127); int k1 = (int)(idx >> 17);
  int g = ch >> 8, m = ch & 255; float ar = 0.f, ai = 0.f;
  for (int t1 = 0; t1 < 128; ++t1) { int t = 128 * t1 + t2; const float* zp = Z + ((size_t)t * 4 + g) * 512 + m; float zr = zp[0], zi = zp[256];
    float2 w = tw[(k1 * t1 * 128) & 16383]; ar += w.x * zr - w.y * zi; ai += w.x * zi + w.y * zr; }
  float2 w = tw[(k1 * t2) & 16383]; Yr[idx] = ar * w.x - ai * w.y; Yi[idx] = ar * w.y + ai * w.x;
}
__global__ void k_fft2(const float* Yr, const float* Yi, const float2* tw, float* F) {
  size_t idx = (size_t)blockIdx.x * 256 + threadIdx.x; int ch = (int)(idx & 1023); int k1 = (int)((idx >> 10) & 127); int k2 = (int)(idx >> 17);
  float acc = 0.f;
  for (int t2 = 0; t2 < 128; ++t2) { size_t yi = (((size_t)k1 * 128 + t2) << 10) + ch; float2 w = tw[(k2 * t2 * 128) & 16383]; acc += w.x * Yr[yi] - w.y * Yi[yi]; }
  F[((size_t)(k1 + 128 * k2) << 10) + ch] = acc * (1.f / 2048.f);
}

__global__ void k_iota(int* l, float* w) { int i = blockIdx.x * 256 + threadIdx.x; l[i] = i; w[i] = 1.f; }

struct In {
  const float *x, *c, *ctx, *c_ctx, *w_ada, *b_ada, *w_in, *lam_re, *lam_im, *log_dt, *b_re, *b_im, *c_re, *c_im, *s5_d, *w_glu, *b_glu, *q_gain,
      *k_gain, *rpb, *w_mix, *w_four, *b_four, *w_router, *r_bias, *w_eg, *w_eu, *w_ed, *w_sg, *w_su, *w_sd;
};

static void gemm(hipStream_t s, const float* A, int lda, const int* rows, const int* mcnt, const float* B, int ldb, float* C, int ldc, int M, int N, int K,
                 const int* srow = nullptr, const float* sw = nullptr) {
  dim3 grid(N / 64, (M + 63) / 64);
  hipLaunchKernelGGL(k_gemm, grid, dim3(256), 0, s, A, lda, rows, mcnt, B, ldb, C, ldc, M, N, K, srow, sw);
}

static void moe(hipStream_t s, const In& in, int layer, const float* f, float* acc, char* arena) {
  float* logits = (float*)arena; arena += (size_t)TOK * 64 * 4;
  int* cnt = (int*)arena; arena += 4096;
  int* ltok = (int*)arena; arena += (size_t)64 * TOK * 4;
  float* lw = (float*)arena; arena += (size_t)64 * TOK * 4;
  float* hg = (float*)arena; arena += (size_t)TOK * 256 * 4;
  float* hu = (float*)arena; arena += (size_t)TOK * 256 * 4;
  hipMemsetAsync(cnt, 0, 4096, s);
  hipMemsetAsync(acc, 0, (size_t)TOK * 1024 * 4, s);
  gemm(s, f, 1024, nullptr, nullptr, in.w_router + (size_t)layer * 1024 * 64, 64, logits, 64, TOK, 64, 1024);
  hipLaunchKernelGGL(k_route, dim3(TOK / 64), dim3(64), 0, s, logits, in.r_bias + layer * 64, cnt, ltok, lw);
  for (int e = 0; e < 64; ++e) {
    const float* wg = in.w_eg + ((size_t)layer * 64 + e) * 1024 * 256; const float* wu = in.w_eu + ((size_t)layer * 64 + e) * 1024 * 256;
    const float* wd = in.w_ed + ((size_t)layer * 64 + e) * 256 * 1024;
    gemm(s, f, 1024, ltok + (size_t)e * TOK, cnt + e, wg, 256, hg, 256, TOK, 256, 1024);
    gemm(s, f, 1024, ltok + (size_t)e * TOK, cnt + e, wu, 256, hu, 256, TOK, 256, 1024);
    hipLaunchKernelGGL(k_swiglu, dim3(TOK), dim3(256), 0, s, hg, hu, hg, cnt + e, TOK);
    gemm(s, hg, 256, nullptr, cnt + e, wd, 1024, acc, 1024, TOK, 1024, 256, ltok + (size_t)e * TOK, lw + (size_t)e * TOK);
  }
  {
    int* idl = (int*)arena; arena += (size_t)TOK * 4; float* idw = (float*)arena; arena += (size_t)TOK * 4;
    hipLaunchKernelGGL(k_iota, dim3(TOK / 256), dim3(256), 0, s, idl, idw);
    const float* wg = in.w_sg + (size_t)layer * 1024 * 256; const float* wu = in.w_su + (size_t)layer * 1024 * 256; const float* wd = in.w_sd + (size_t)layer * 256 * 1024;
    gemm(s, f, 1024, nullptr, nullptr, wg, 256, hg, 256, TOK, 256, 1024);
    gemm(s, f, 1024, nullptr, nullptr, wu, 256, hu, 256, TOK, 256, 1024);
    hipLaunchKernelGGL(k_swiglu, dim3(TOK), dim3(256), 0, s, hg, hu, hg, (const int*)nullptr, TOK);
    gemm(s, hg, 256, nullptr, nullptr, wd, 1024, acc, 1024, TOK, 1024, 256, idl, idw);
  }
}

static void forward(hipStream_t s, const In& in, float* out, char* ws) {
  char* small = ws;
  float* mod = (float*)small;
  float2* lamb = (float2*)(small + 131072);
  float2* bbar = (float2*)(small + 262144);
  float2* tw = (float2*)(small + 1048576);
  float* Dm = (float*)(small + 2097152);
  char* arena = ws + (4u << 20);
  hipLaunchKernelGGL(k_adaln, dim3(24), dim3(256), 0, s, in.c, in.w_ada, in.b_ada, mod);
  hipLaunchKernelGGL(k_adaln, dim3(24), dim3(256), 0, s, in.c_ctx, in.w_ada, in.b_ada, mod + 6144);
  hipLaunchKernelGGL(k_adaln, dim3(24), dim3(256), 0, s, in.c, in.w_ada + (size_t)1024 * 6144, in.b_ada + 6144, mod + 2 * 6144);
  const float* ml0 = mod; const float* mc0 = mod + 6144; const float* ml1 = mod + 2 * 6144;
  {
    char* a = arena;
    float* a0 = (float*)a; a += (size_t)NROW * 1024 * 4;
    float* z = (float*)a; a += (size_t)NROW * 2048 * 4;
    float* ys5 = (float*)a; a += (size_t)TOK * 512 * 4;
    float* gbuf = (float*)a; a += (size_t)TOK * 512 * 4;
    float* tbuf = (float*)a; a += (size_t)TOK * 512 * 4;
    float* concat = (float*)a; a += (size_t)TOK * 1024 * 4;
    float* ymix = (float*)a; a += (size_t)TOK * 1024 * 4;
    hipLaunchKernelGGL(k_modulate, dim3(TOK), dim3(256), 0, s, in.x, ml0, ml0 + 1024, a0);
    hipLaunchKernelGGL(k_modulate, dim3(CTXN), dim3(256), 0, s, in.ctx, mc0, mc0 + 1024, a0 + (size_t)TOK * 1024);
    gemm(s, a0, 1024, nullptr, nullptr, in.w_in, 2048, z, 2048, NROW, 2048, 1024);
    hipLaunchKernelGGL(k_headnorm, dim3(NROW * 8 / 256), dim3(256), 0, s, z, in.q_gain, 512, NROW);
    hipLaunchKernelGGL(k_headnorm, dim3(NROW * 8 / 256), dim3(256), 0, s, z, in.k_gain, 1024, NROW);
    hipLaunchKernelGGL(k_s5prep, dim3(16), dim3(256), 0, s, in.lam_re, in.lam_im, in.log_dt, in.b_re, in.b_im, lamb, bbar);
    hipLaunchKernelGGL(k_s5scan, dim3(32), dim3(64), 0, s, z, lamb, bbar, in.c_re, in.c_im, in.s5_d, ys5);
    hipLaunchKernelGGL(k_gelu, dim3(TOK * 512 / 256), dim3(256), 0, s, ys5, gbuf, TOK * 512);
    gemm(s, gbuf, 512, nullptr, nullptr, in.w_glu, 512, tbuf, 512, TOK, 512, 512);
    hipLaunchKernelGGL(k_glu, dim3(TOK * 512 / 256), dim3(256), 0, s, gbuf, tbuf, in.b_glu, concat);
    hipLaunchKernelGGL(k_na, dim3(TOK), dim3(512), 0, s, z, in.rpb, concat);
    gemm(s, concat, 1024, nullptr, nullptr, in.w_mix, 1024, ymix, 1024, TOK, 1024, 1024);
    hipLaunchKernelGGL(k_resid, dim3(TOK * 1024 / 256), dim3(256), 0, s, in.x, ml0 + 2048, ymix, (const float*)nullptr, out);
  }
  {
    char* a = arena;
    float* f = (float*)a; a += (size_t)TOK * 1024 * 4;
    float* acc = (float*)a; a += (size_t)TOK * 1024 * 4;
    hipLaunchKernelGGL(k_modulate, dim3(TOK), dim3(256), 0, s, out, ml0 + 3072, ml0 + 4096, f);
    moe(s, in, 0, f, acc, a);
    hipLaunchKernelGGL(k_resid, dim3(TOK * 1024 / 256), dim3(256), 0, s, out, ml0 + 5120, acc, (const float*)nullptr, out);
  }
  {
    char* a = arena;
    float* a1 = (float*)a; a += (size_t)TOK * 1024 * 4;
    float* Z = (float*)a; a += (size_t)TOK * 4 * 512 * 4;
    float* Yr = (float*)a; a += (size_t)TOK * 1024 * 4;
    float* Yi = (float*)a; a += (size_t)TOK * 1024 * 4;
    float* F = (float*)a; a += (size_t)TOK * 1024 * 4;
    hipLaunchKernelGGL(k_twiddle, dim3(64), dim3(256), 0, s, tw);
    hipLaunchKernelGGL(k_dftmat, dim3(512), dim3(256), 0, s, tw, Dm);
    hipLaunchKernelGGL(k_modulate, dim3(TOK), dim3(256), 0, s, out, ml1, ml1 + 1024, a1);
    gemm(s, a1, 256, nullptr, nullptr, Dm, 512, Z, 512, TOK * 4, 512, 256);
    hipLaunchKernelGGL(k_fft1, dim3(TOK * 1024 / 256), dim3(256), 0, s, Z, tw, Yr, Yi);
    hipLaunchKernelGGL(k_fft2, dim3(TOK * 1024 / 256), dim3(256), 0, s, Yr, Yi, tw, F);
    float* yf = Z;
    gemm(s, F, 1024, nullptr, nullptr, in.w_four, 1024, yf, 1024, TOK, 1024, 1024);
    hipLaunchKernelGGL(k_resid, dim3(TOK * 1024 / 256), dim3(256), 0, s, out, ml1 + 2048, yf, in.b_four, out);
  }
  {
    char* a = arena;
    float* f = (float*)a; a += (size_t)TOK * 1024 * 4;
    float* acc = (float*)a; a += (size_t)TOK * 1024 * 4;
    hipLaunchKernelGGL(k_modulate, dim3(TOK), dim3(256), 0, s, out, ml1 + 3072, ml1 + 4096, f);
    moe(s, in, 1, f, acc, a);
    hipLaunchKernelGGL(k_resid, dim3(TOK * 1024 / 256), dim3(256), 0, s, out, ml1 + 5120, acc, (const float*)nullptr, out);
  }
}
}

extern "C" void kernel_launch(void* const* d_in, const int* in_sizes, int n_in, void* d_out, int out_size, void* d_ws, size_t ws_size, hipStream_t stream) {
  if (n_in != 31 || out_size != 16384 * 1024 || ws_size < (size_t)520 * 1000 * 1000) { fprintf(stderr, "kernel_launch: unexpected n_in %d out %d ws %zu\n", n_in, out_size, ws_size); return; }
  ref::In in;
  const float** p = (const float**)&in;
  for (int i = 0; i < 31; ++i) p[i] = (const float*)d_in[i];
  ref::forward(stream, in, (float*)d_out, (char*)d_ws);
}
```

```cpp
#define CHECK 0
#define MK_N_LAUNCHES 27
#define MK_SP2 true
#include <hip/hip_runtime.h>
#include <cstdio>
#include <cstdint>
#include <cmath>
namespace mk {
#define LAS __attribute__((address_space(3)))
typedef unsigned short bf16_t;
typedef short bf16x8 __attribute__((ext_vector_type(8)));
typedef float f32x4 __attribute__((ext_vector_type(4)));
typedef float f32x2 __attribute__((ext_vector_type(2)));
typedef unsigned u32x4 __attribute__((ext_vector_type(4)));
typedef unsigned u32x2 __attribute__((ext_vector_type(2)));

constexpr int TOK = 16384, CTXN = 256, NROW = TOK + CTXN;
constexpr int NWAVES = 8, NTHR = 512;
constexpr int LDS_STAGE = 131072, LDS_BYTES = 155648, LDS_MISC_OFF = LDS_BYTES - 4096;

__device__ __forceinline__ unsigned cvt_pk_bf16(float lo, float hi) { unsigned r; asm volatile("v_cvt_pk_bf16_f32 %0, %1, %2" : "=v"(r) : "v"(lo), "v"(hi)); return r; }
__device__ __forceinline__ float bf_lo(unsigned w) { return __uint_as_float(w << 16); }
__device__ __forceinline__ float bf_hi(unsigned w) { return __uint_as_float(w & 0xffff0000u); }
__device__ __forceinline__ float bf2f(bf16_t b) { return __uint_as_float(((unsigned)b) << 16); }
__device__ __forceinline__ bf16_t f2bf(float f) { unsigned u = __float_as_uint(f); return (bf16_t)((u + 0x7fffu + ((u >> 16) & 1u)) >> 16); }
__device__ __forceinline__ float sx(float v, int o) { int l = __builtin_amdgcn_mbcnt_hi(~0u, __builtin_amdgcn_mbcnt_lo(~0u, 0u)); asm volatile("" : "+v"(l)); return __int_as_float(__builtin_amdgcn_ds_bpermute((l ^ o) << 2, __float_as_int(v))); }
__device__ __forceinline__ float wave_sum(float v) {
#pragma unroll
  for (int o = 1; o < 64; o <<= 1) v += sx(v, o);
  return v;
}
__device__ __forceinline__ float fast_sigmoid(float x) { return __builtin_amdgcn_rcpf(1.f + __expf(-x)); }
__device__ __forceinline__ float fast_tanh(float x) { float e = __expf(2.f * x); return 1.f - 2.f * __builtin_amdgcn_rcpf(e + 1.f); }
__device__ __forceinline__ float gelu_tanh(float x) { return 0.5f * x * (1.f + fast_tanh(0.7978845608028654f * (x + 0.044715f * x * x * x))); }

#define XB_TMO      128
#define XB_XCNT(j)  (256  + 64 * (j))
#define XB_XSUB(j)  (1280 + 64 * (j))
#define XB_XGEN(j)  (2304 + 64 * (j))
#define XB_TOP      3328
#define XB_TOPGEN   3392
#define XCD_BAR_WORDS 3456
#define XB_SPIN_CAP (1u << 20)
__device__ __forceinline__ unsigned xb_ld(unsigned* p) { return __hip_atomic_load(p, __ATOMIC_RELAXED, __HIP_MEMORY_SCOPE_AGENT); }
__device__ __forceinline__ unsigned xb_add(unsigned* p, unsigned v) { return __hip_atomic_fetch_add(p, v, __ATOMIC_RELAXED, __HIP_MEMORY_SCOPE_AGENT); }
__device__ __forceinline__ unsigned xb_xcc_id() { return (unsigned)__builtin_amdgcn_s_getreg((3 << 11) | 20) & 0xFu; }
#define XB_SPIN(cond, bar) do { unsigned _sp = 0; while (cond) { __builtin_amdgcn_s_sleep(1); \
    if ((++_sp & 255u) == 0u) { if (xb_ld(&(bar)[XB_TMO])) break; if (_sp > XB_SPIN_CAP) { atomicAdd(&(bar)[XB_TMO], 1u); break; } } } } while (0)
struct XcdBarrier { unsigned* bar; unsigned x; volatile LAS unsigned* st; };
__device__ __forceinline__ XcdBarrier xcd_barrier_post(unsigned* bar, volatile LAS unsigned* st, int tid) {
  XcdBarrier b; b.bar = bar; b.x = xb_xcc_id(); b.st = st;
  if (tid == 0) (void)xb_add(&bar[XB_XCNT(b.x)], 1u);
  return b;
}
__device__ __forceinline__ void xcd_barrier_complete(unsigned* bar, unsigned x, unsigned& nloc, unsigned& nx) {
  const unsigned G = gridDim.x * gridDim.y * gridDim.z;
  unsigned sum, cnt, mine, sp = 0u;
  for (;;) {
    sum = 0u; cnt = 0u; mine = 0u;
#pragma unroll
    for (unsigned j = 0; j < 16; ++j) { const unsigned c = xb_ld(&bar[XB_XCNT(j)]); sum += c; cnt += (c > 0u) ? 1u : 0u; mine = (j == x) ? c : mine; }
    if (sum == G) break;
    __builtin_amdgcn_s_sleep(1);
    if ((++sp & 255u) == 0u) { if (xb_ld(&bar[XB_TMO])) break; if (sp > XB_SPIN_CAP) { atomicAdd(&bar[XB_TMO], 1u); break; } }
  }
  nloc = mine > 0u ? mine : 1u; nx = cnt > 0u ? cnt : 1u;
}
__device__ __forceinline__ void xcd_barrier(const XcdBarrier& b, int tid) {
  asm volatile("s_waitcnt vmcnt(0)" ::: "memory");
  __syncthreads();
  if (tid == 0) {
    unsigned* bar = b.bar;
    __builtin_amdgcn_s_waitcnt(0);
    unsigned nloc = b.st[0], nx = b.st[1];
    if (nloc == 0u) { xcd_barrier_complete(bar, b.x, nloc, nx); b.st[0] = nloc; b.st[1] = nx; }
    const unsigned old = xb_add(&bar[XB_XSUB(b.x)], 1u);
    const unsigned gen = old / nloc;
    if (old + 1u == (gen + 1u) * nloc) {
      __builtin_amdgcn_fence(__ATOMIC_RELEASE, "agent");
      asm volatile("s_waitcnt vmcnt(0)" ::: "memory");
      const unsigned og = xb_add(&bar[XB_TOP], 1u);
      const unsigned tg = og / nx;
      if (og + 1u == (tg + 1u) * nx) xb_add(&bar[XB_TOPGEN], 1u);
      else XB_SPIN(xb_ld(&bar[XB_TOPGEN]) == tg, bar);
      __builtin_amdgcn_fence(__ATOMIC_ACQUIRE, "agent");
      xb_add(&bar[XB_XGEN(b.x)], 1u);
      asm volatile("s_waitcnt vmcnt(0)" ::: "memory");
    } else {
      XB_SPIN(xb_ld(&bar[XB_XGEN(b.x)]) == gen, bar);
      __builtin_amdgcn_fence(__ATOMIC_ACQUIRE, "agent");
      asm volatile("s_waitcnt vmcnt(0)" ::: "memory");
    }
  }
  __syncthreads();
}

constexpr int BM = 256, BK = 64, HALF = 128, HTB = HALF * BK * 2, NXCD = 8;
__device__ __forceinline__ int lds_byte(int r, int c) { const int st = (r >> 4) * 2 + (c >> 5), rr = r & 15, cc = c & 31, ob = rr * 64 + cc * 2; return st * 1024 + (ob ^ (((ob >> 9) & 1) << 5)); }
__device__ __forceinline__ void stage_rc(int b, int& R, int& C) { const int st = b / 1024, sb = b % 1024, swz = sb ^ (((sb >> 9) & 1) << 5); R = (st >> 1) * 16 + swz / 64; C = (st & 1) * 32 + (swz % 64) / 2; }
__device__ __forceinline__ int perm32(int rho) { const int n = rho >> 4, i = rho & 15; return 8 * (i >> 2) + 4 * n + (i & 3); }

struct Unit { int pm, pn, a, b; };
typedef f32x4 Acc[2][2][4][2];
template <class P, bool SP2>
__device__ __forceinline__ void gemm_phase(LAS unsigned char* lds, const P& p, int G, int c, int tid_in) {
  const int tid = tid_in, wid = __builtin_amdgcn_readfirstlane(tid >> 6), lane = tid & 63, wr = wid >> 2, wc = wid & 3, fr = lane & 15, fq = lane >> 4;
  const int K = p.K, nt = K / BK;
  const int nunits = p.nunits;
  int sR[2], sRb[2], sC[2];
#pragma unroll
  for (int i = 0; i < 2; ++i) { int R, C; stage_rc(tid * 16 + i * 8192, R, C); sR[i] = R; sRb[i] = P::PERM ? ((R & ~31) + perm32(R & 31)) : R; sC[i] = C * 2; }
  const size_t kstep = (size_t)(BK * 2);
  const unsigned ldsw = (unsigned)wid * 1024u;
  const int aoff = lds_byte(wr * 64 + fr, fq * 8), boff = lds_byte(wc * 32 + fr, fq * 8);
#define PG8_SA(b, h) (((b) * 2 + (h)) * HTB)
#define PG8_SB(b, h) ((4 + (b) * 2 + (h)) * HTB)
#define PG8_STAGE(bufoff, gbase, voff) do { _Pragma("unroll") for (int _i = 0; _i < 2; ++_i) \
        __builtin_amdgcn_global_load_lds((const unsigned*)((const char*)(gbase) + (voff)[_i]), (LAS unsigned*)(lds + (bufoff) + ldsw + _i * 8192), 16, 0, 0); } while (0)
#define PG8_LDA(dst, b, h) do { _Pragma("unroll") for (int m = 0; m < 4; ++m) _Pragma("unroll") for (int k = 0; k < 2; ++k) dst[m][k] = *(const LAS bf16x8*)(lds + PG8_SA(b, h) + aoff + m * 2048 + k * 1024); } while (0)
#define PG8_LDB(dst, b, h) do { _Pragma("unroll") for (int n = 0; n < 2; ++n) _Pragma("unroll") for (int k = 0; k < 2; ++k) dst[n][k] = *(const LAS bf16x8*)(lds + PG8_SB(b, h) + boff + n * 2048 + k * 1024); } while (0)
#define PG8_MMA(ai, bj, At, Bt) do { __builtin_amdgcn_s_setprio(1); _Pragma("unroll") for (int m = 0; m < 4; ++m) _Pragma("unroll") for (int n = 0; n < 2; ++n) _Pragma("unroll") for (int k = 0; k < 2; ++k) \
        acc[ai][bj][m][n] = __builtin_amdgcn_mfma_f32_16x16x32_bf16(Bt[n][k], At[m][k], acc[ai][bj][m][n], 0, 0, 0); __builtin_amdgcn_s_setprio(0); } while (0)
#define PG8_WAIT_V(n) asm volatile("s_waitcnt vmcnt(" #n ")" ::: "memory")
#define PG8_WAIT_L(n) asm volatile("s_waitcnt lgkmcnt(" #n ")" ::: "memory")
#define PG8_BAR __builtin_amdgcn_s_barrier()
#define PG8_SCHED __builtin_amdgcn_sched_barrier(0)
#define PG8_DECODE(i, u) do { int _w = (i) * G + c; { const int q = nunits / NXCD, r = nunits % NXCD, xcd = _w % NXCD, off = _w / NXCD; _w = (xcd < r ? xcd * (q + 1) : r * (q + 1) + (xcd - r) * q) + off; } p.decode(_w, u); } while (0)
#define PG8_OFFS(u, vA, vB) do { _Pragma("unroll") for (int _h = 0; _h < 2; ++_h) _Pragma("unroll") for (int _i = 0; _i < 2; ++_i) { \
        if (_h == 0 || !P::LINA) vA[_h][_i] = p.rowA(u, _h * HALF + sR[_i]) + (unsigned)sC[_i]; if (_h == 0 || !P::LINB) vB[_h][_i] = p.rowB(u, _h * HALF + sRb[_i]) + (unsigned)sC[_i]; } } while (0)
  if (c >= nunits) return;
  Unit cur, nxt; int ui = 0;
  PG8_DECODE(0, cur);
  Acc acc;
#pragma unroll
  for (int a = 0; a < 2; ++a)
#pragma unroll
    for (int b = 0; b < 2; ++b)
#pragma unroll
      for (int m = 0; m < 4; ++m)
#pragma unroll
        for (int n = 0; n < 2; ++n) acc[a][b][m][n] = (f32x4){0.f, 0.f, 0.f, 0.f};
  bf16x8 At[4][2], B0[2][2], B1[2][2];
  unsigned vA[2][2], vB[2][2];
  PG8_OFFS(cur, vA, vB);
  const char* cA = p.baseA(cur); const char* cB = p.baseB(cur);
  const size_t hA = P::LINA ? p.halfA() : 0, hB = P::LINB ? p.halfB() : 0;
  if constexpr (SP2) {
    PG8_STAGE(PG8_SB(0, 0), cB, vB[0]); PG8_STAGE(PG8_SB(0, 1), (cB) + (P::LINB ? hB : 0), vB[P::LINB ? 0 : 1]); PG8_STAGE(PG8_SA(0, 0), cA, vA[0]); PG8_STAGE(PG8_SA(0, 1), (cA) + (P::LINA ? hA : 0), vA[P::LINA ? 0 : 1]);
    if (wr == 1) PG8_BAR;
    PG8_WAIT_V(2); PG8_BAR;
    PG8_STAGE(PG8_SB(1, 0), cB + kstep, vB[0]); PG8_STAGE(PG8_SA(1, 0), cA + kstep, vA[0]); PG8_STAGE(PG8_SB(1, 1), (cB + kstep) + (P::LINB ? hB : 0), vB[P::LINB ? 0 : 1]);
    PG8_WAIT_V(6); PG8_BAR;
  } else {
    PG8_STAGE(PG8_SB(0, 0), cB, vB[0]); PG8_STAGE(PG8_SA(0, 0), cA, vA[0]); PG8_STAGE(PG8_SB(0, 1), (cB) + (P::LINB ? hB : 0), vB[P::LINB ? 0 : 1]); PG8_STAGE(PG8_SA(0, 1), (cA) + (P::LINA ? hA : 0), vA[P::LINA ? 0 : 1]);
    if (wr == 1) PG8_BAR;
    PG8_WAIT_V(4); PG8_BAR;
    PG8_STAGE(PG8_SB(1, 0), cB + kstep, vB[0]); PG8_STAGE(PG8_SA(1, 0), cA + kstep, vA[0]); PG8_STAGE(PG8_SB(1, 1), (cB + kstep) + (P::LINB ? hB : 0), vB[P::LINB ? 0 : 1]);
    PG8_WAIT_V(6); PG8_BAR;
  }
  for (;;) {
    const bool has_next = ((ui + 1) * G + c) < nunits;
    if (has_next) PG8_DECODE(ui + 1, nxt);
    const char* nA = has_next ? p.baseA(nxt) : cA; const char* nB = has_next ? p.baseB(nxt) : cB;
    for (int t = 0; t < nt; t += 2) {
      const bool last = (t == nt - 2);
      const char* a1 = cA + (size_t)(t + 1) * kstep;
      const char* a2 = last ? nA : cA + (size_t)(t + 2) * kstep; const char* b2 = last ? nB : cB + (size_t)(t + 2) * kstep;
      const char* a3 = a2 + kstep; const char* b3 = b2 + kstep;
      if constexpr (SP2) {
        PG8_LDB(B0, 0, 0); PG8_LDB(B1, 0, 1); PG8_SCHED; PG8_LDA(At, 0, 0); PG8_STAGE(PG8_SA(1, 1), (a1) + (P::LINA ? hA : 0), vA[P::LINA ? 0 : 1]);
        PG8_WAIT_V(8); PG8_WAIT_L(0); PG8_BAR; PG8_MMA(0, 0, At, B0); PG8_MMA(0, 1, At, B1); PG8_BAR; PG8_SCHED;
        if (last && has_next) { PG8_OFFS(nxt, vA, vB); }
        PG8_LDA(At, 0, 1); PG8_STAGE(PG8_SB(0, 0), b2, vB[0]); PG8_STAGE(PG8_SB(0, 1), (b2) + (P::LINB ? hB : 0), vB[P::LINB ? 0 : 1]); PG8_STAGE(PG8_SA(0, 0), a2, vA[0]);
        PG8_WAIT_V(8); PG8_WAIT_L(0); PG8_BAR; PG8_MMA(1, 0, At, B0); PG8_MMA(1, 1, At, B1); PG8_BAR; PG8_SCHED;
        PG8_LDB(B0, 1, 0); PG8_LDB(B1, 1, 1); PG8_SCHED; PG8_LDA(At, 1, 0); PG8_STAGE(PG8_SA(0, 1), (a2) + (P::LINA ? hA : 0), vA[P::LINA ? 0 : 1]);
        PG8_WAIT_V(8); PG8_WAIT_L(0); PG8_BAR; PG8_MMA(0, 0, At, B0); PG8_MMA(0, 1, At, B1); PG8_BAR; PG8_SCHED;
        PG8_LDA(At, 1, 1); PG8_STAGE(PG8_SB(1, 0), b3, vB[0]); PG8_STAGE(PG8_SB(1, 1), (b3) + (P::LINB ? hB : 0), vB[P::LINB ? 0 : 1]); PG8_STAGE(PG8_SA(1, 0), a3, vA[0]);
        PG8_WAIT_V(8); PG8_WAIT_L(0); PG8_BAR; PG8_MMA(1, 0, At, B0); PG8_MMA(1, 1, At, B1); PG8_BAR; PG8_SCHED;
      } else {
        PG8_LDB(B0, 0, 0); PG8_SCHED; PG8_LDA(At, 0, 0); PG8_STAGE(PG8_SA(1, 1), (a1) + (P::LINA ? hA : 0), vA[P::LINA ? 0 : 1]);
        PG8_WAIT_L(8); PG8_BAR; PG8_WAIT_L(0); PG8_MMA(0, 0, At, B0); PG8_BAR; PG8_SCHED;
        if (last && has_next) { PG8_OFFS(nxt, vA, vB); }
        PG8_LDB(B1, 0, 1); PG8_STAGE(PG8_SB(0, 0), b2, vB[0]);
        PG8_BAR; PG8_WAIT_L(0); PG8_MMA(0, 1, At, B1); PG8_BAR;
        PG8_LDA(At, 0, 1); PG8_STAGE(PG8_SA(0, 0), a2, vA[0]);
        PG8_BAR; PG8_WAIT_L(0); PG8_MMA(1, 0, At, B0); PG8_BAR; PG8_SCHED;
        PG8_STAGE(PG8_SB(0, 1), (b2) + (P::LINB ? hB : 0), vB[P::LINB ? 0 : 1]);
        PG8_WAIT_V(6); PG8_BAR; PG8_MMA(1, 1, At, B1); PG8_BAR;
        PG8_LDB(B0, 1, 0); PG8_SCHED; PG8_LDA(At, 1, 0); PG8_STAGE(PG8_SA(0, 1), (a2) + (P::LINA ? hA : 0), vA[P::LINA ? 0 : 1]);
        PG8_WAIT_L(8); PG8_BAR; PG8_WAIT_L(0); PG8_MMA(0, 0, At, B0); PG8_BAR; PG8_SCHED;
        PG8_LDB(B1, 1, 1); PG8_STAGE(PG8_SB(1, 0), b3, vB[0]);
        PG8_BAR; PG8_WAIT_L(0); PG8_MMA(0, 1, At, B1); PG8_BAR;
        PG8_LDA(At, 1, 1); PG8_STAGE(PG8_SA(1, 0), a3, vA[0]);
        PG8_BAR; PG8_WAIT_L(0); PG8_MMA(1, 0, At, B0); PG8_BAR; PG8_SCHED;
        PG8_STAGE(PG8_SB(1, 1), (b3) + (P::LINB ? hB : 0), vB[P::LINB ? 0 : 1]);
        PG8_WAIT_V(6); PG8_BAR; PG8_MMA(1, 1, At, B1); PG8_BAR;
      }
    }
    if (wr == 0) PG8_BAR;
    { int fr_e = fr, fq_e = fq; asm volatile("" : "+v"(fr_e), "+v"(fq_e)); p.epi(acc, cur, wr, wc, fr_e, fq_e); }
    if (!has_next) break;
#pragma unroll
    for (int a = 0; a < 2; ++a)
#pragma unroll
      for (int b = 0; b < 2; ++b)
#pragma unroll
        for (int m = 0; m < 4; ++m)
#pragma unroll
          for (int n = 0; n < 2; ++n) acc[a][b][m][n] = (f32x4){0.f, 0.f, 0.f, 0.f};
    cur = nxt; cA = nA; cB = nB; ++ui;
    if (wr == 1) PG8_BAR;
  }
  PG8_WAIT_V(0);
  PG8_BAR;
#undef PG8_SA
#undef PG8_SB
#undef PG8_STAGE
#undef PG8_LDA
#undef PG8_LDB
#undef PG8_MMA
#undef PG8_WAIT_V
#undef PG8_WAIT_L
#undef PG8_BAR
#undef PG8_SCHED
#undef PG8_DECODE
#undef PG8_OFFS
}
}
namespace mk {
constexpr size_t MiB = 1u << 20;
constexpr size_t WS_CTL = 0, CTL_ZERO_BYTES = 65536;
constexpr size_t WS_MOD = 65536;
constexpr size_t WS_LAML = 262144;
constexpr size_t WS_WIN_T = 1 * MiB, WS_WGLU_T = 5 * MiB, WS_WMIX_T = 6 * MiB, WS_WFOUR_T = 8 * MiB, WS_WROUT_T = 10 * MiB;
constexpr size_t WS_DMT = 10 * MiB + 512 * 1024, WS_W1 = 10 * MiB + 768 * 1024, WS_W2 = 10 * MiB + 896 * 1024;
constexpr size_t WS_WEXP = 12 * MiB, EXP_STRIDE = 3 * MiB / 2, EXP_DOFF = 1 * MiB;
constexpr size_t WS_R = 110 * MiB;
constexpr size_t WS_WS = WS_R, WS_TT = WS_R + 8 * MiB, WS_A0 = WS_R + 34 * MiB, WS_AS5 = WS_R + 67 * MiB, WS_Q = WS_R + 103 * MiB, WS_K = WS_R + 119 * MiB,
                 WS_VT = WS_R + 136 * MiB, WS_SST = WS_R + 153 * MiB, WS_GB = WS_R + 177 * MiB, WS_CONCAT = WS_R + 193 * MiB;
constexpr size_t WS_F = WS_R, WS_LTOK = WS_R + 32 * MiB, WS_LW = WS_R + 36 * MiB, WS_ASG = WS_R + 40 * MiB, WS_HID = WS_R + 42 * MiB, WS_YAS = WS_R + 86 * MiB,
                 WS_A1 = WS_R + 262 * MiB;
constexpr size_t WS_X1 = WS_R, WS_X2 = WS_R + 64 * MiB, WS_FB = WS_R + 128 * MiB;
constexpr size_t WS_HOPT = WS_R + 294 * MiB;
constexpr size_t WS_NEED = WS_R + 294 * MiB;
constexpr int HALF_CAP_ROWS = 90112;
constexpr int CW_BAR = 4096, CW_CNT = 8192  , CW_DQ0 = 12288, CW_DQ1 = 12352;

struct Args { const float* in[31]; float* h; unsigned char* ws; int ph_lo, ph_hi, flags, pad; };
enum { IN_X = 0, IN_C, IN_CTX, IN_CCTX, IN_WADA, IN_BADA, IN_WIN, IN_LRE, IN_LIM, IN_LDT, IN_BRE, IN_BIM, IN_CRE, IN_CIM, IN_S5D, IN_WGLU, IN_BGLU, IN_QG, IN_KG,
       IN_RPB, IN_WMIX, IN_WFOUR, IN_BFOUR, IN_WROUT, IN_RBIAS, IN_WEG, IN_WEU, IN_WED, IN_WSG, IN_WSU, IN_WSD };
constexpr int FLAG_SKIP_EXPERTS = 1;

struct Ctx {
  LAS unsigned char* lds; const Args* a; unsigned char* ws; int tid, lane, wave, G, c;
};

__device__ __forceinline__ int rowmap(int code, int n) {
  if (code == 1) { if (n < 512 || n >= 1536) return n; const int blk = n & ~255, c = n & 255; return blk + 128 * ((c >> 5) & 1) + 32 * (c >> 6) + (c & 31); }
  if (code == 2) return 256 * (n >> 7) + (n & 127);
  if (code == 3) return 256 * (n >> 7) + 128 + (n & 127);
  return n;
}
__device__ __forceinline__ void transpose_item(const float* W, int K, int N, bf16_t* WT, int code, LAS float* scr, int item, int lane) {
  const int nblk = N / 32, kb = item / nblk, nb = item % nblk, k0 = 64 * kb, n0 = 32 * nb;
#pragma unroll 8
  for (int i = 0; i < 32; ++i) { const int kk = 2 * i + (lane >> 5); scr[kk * 33 + (lane & 31)] = W[(size_t)(k0 + kk) * N + n0 + (lane & 31)]; }
  asm volatile("s_waitcnt lgkmcnt(0)" ::: "memory");
  const int cch = lane & 7;
#pragma unroll
  for (int j = 0; j < 4; ++j) { const int n = (lane >> 3) + 8 * j; const LAS float* s = scr + (8 * cch) * 33 + n;
    u32x4 o; o.x = cvt_pk_bf16(s[0 * 33], s[1 * 33]); o.y = cvt_pk_bf16(s[2 * 33], s[3 * 33]); o.z = cvt_pk_bf16(s[4 * 33], s[5 * 33]); o.w = cvt_pk_bf16(s[6 * 33], s[7 * 33]);
    *(u32x4*)(WT + (size_t)rowmap(code, n0 + n) * K + k0 + 8 * cch) = o; }
  asm volatile("s_waitcnt lgkmcnt(0)" ::: "memory");
}
constexpr int IT_WIN = 1024, IT_GLU = 128, IT_MIX = 512, IT_FOUR = 512, IT_ROUT = 64, IT_SMALL = IT_WIN + IT_GLU + IT_MIX + IT_FOUR + IT_ROUT, IT_EXP = 384;
__device__ __forceinline__ void small_item(const Ctx& X, LAS float* scr, int it) {
  const Args& a = *X.a; unsigned char* ws = X.ws;
  if (it < IT_WIN) { transpose_item(a.in[IN_WIN], 1024, 2048, (bf16_t*)(ws + WS_WIN_T), 1, scr, it, X.lane); return; } it -= IT_WIN;
  if (it < IT_GLU) { transpose_item(a.in[IN_WGLU], 512, 512, (bf16_t*)(ws + WS_WGLU_T), 0, scr, it, X.lane); return; } it -= IT_GLU;
  if (it < IT_MIX) { transpose_item(a.in[IN_WMIX], 1024, 1024, (bf16_t*)(ws + WS_WMIX_T), 0, scr, it, X.lane); return; } it -= IT_MIX;
  if (it < IT_FOUR) { transpose_item(a.in[IN_WFOUR], 1024, 1024, (bf16_t*)(ws + WS_WFOUR_T), 0, scr, it, X.lane); return; } it -= IT_FOUR;
  { const int l = it >> 5; transpose_item(a.in[IN_WROUT] + (size_t)l * 1024 * 64, 1024, 64, (bf16_t*)(ws + WS_WROUT_T) + (size_t)l * 64 * 1024, 0, scr, it & 31, X.lane); }
}
__device__ __forceinline__ void expert_item(const Ctx& X, LAS float* scr, int layer, int it) {
  const Args& a = *X.a; const int e = it / IT_EXP, r = it % IT_EXP;
  bf16_t* gu = (bf16_t*)(X.ws + WS_WEXP + (size_t)e * EXP_STRIDE); bf16_t* dt = (bf16_t*)(X.ws + WS_WEXP + (size_t)e * EXP_STRIDE + EXP_DOFF);
  const float *wg, *wu, *wd;
  if (e < 64) { const size_t o = ((size_t)layer * 64 + e) * 262144; wg = a.in[IN_WEG] + o; wu = a.in[IN_WEU] + o; wd = a.in[IN_WED] + o; }
  else { const size_t o = (size_t)layer * 262144; wg = a.in[IN_WSG] + o; wu = a.in[IN_WSU] + o; wd = a.in[IN_WSD] + o; }
  if (r < 128) transpose_item(wg, 1024, 256, gu, 2, scr, r, X.lane);
  else if (r < 256) transpose_item(wu, 1024, 256, gu, 3, scr, r - 128, X.lane);
  else transpose_item(wd, 256, 1024, dt, 0, scr, r - 256, X.lane);
}
__device__ __forceinline__ void transpose_work(const Ctx& X, unsigned* ctr, int first_small, int n_small, int layer, int n_exp_items) {
  LAS float* scr = (LAS float*)(X.lds + X.wave * 8704);
  const int total = n_small + n_exp_items;
  for (;;) {
    int base = 0; if (X.lane == 0) base = (int)atomicAdd(ctr, 8u);
    base = __builtin_amdgcn_readfirstlane(base);
    if (base >= total) break;
    for (int k = 0; k < 8; ++k) { const int it = base + k; if (it >= total) break;
      if (it < n_small) small_item(X, scr, first_small + it); else expert_item(X, scr, layer, it - n_small); }
  }
}

__device__ __forceinline__ void p0_adaln(const Ctx& X, int it) {
  const Args& a = *X.a; const int layer = it / 96, ct = it % 96, col = ct * 64 + X.lane;
  LAS float* sl = (LAS float*)X.lds;
  for (int i = X.tid; i < 2048; i += NTHR) { const float v = i < 1024 ? a.in[IN_C][i] : a.in[IN_CCTX][i - 1024]; sl[i] = v / (1.f + __expf(-v)); }
  __syncthreads();
  const float* W = a.in[IN_WADA] + (size_t)layer * 1024 * 6144 + col;
  float a0 = 0.f, a1 = 0.f; const int k0 = X.wave * 128;
#pragma unroll 8
  for (int k = 0; k < 128; ++k) { const float w = W[(size_t)(k0 + k) * 6144]; a0 += sl[k0 + k] * w; a1 += sl[1024 + k0 + k] * w; }
  LAS float* red = sl + 2048;
  red[(X.wave * 64 + X.lane) * 2] = a0; red[(X.wave * 64 + X.lane) * 2 + 1] = a1;
  __syncthreads();
  if (X.tid < 128) { const int l = X.tid & 63, v = X.tid >> 6; float s = 0.f;
#pragma unroll
    for (int w = 0; w < 8; ++w) s += red[(w * 64 + l) * 2 + v];
    s += a.in[IN_BADA][layer * 6144 + ct * 64 + l];
    float* mod = (float*)(X.ws + WS_MOD);
    if (layer == 0) mod[v * 6144 + ct * 64 + l] = s; else if (v == 0) mod[2 * 6144 + ct * 64 + l] = s; }
  __syncthreads();
}

__device__ __forceinline__ void p0_s5tables(const Ctx& X, int g) {
  const Args& a = *X.a;
  LAS f32x2* POW = (LAS f32x2*)X.lds;
  LAS f32x2* BB = (LAS f32x2*)(X.lds + 33792);
  LAS f32x2* CC = (LAS f32x2*)(X.lds + 33792 + 16384);
  LAS float* KK = (LAS float*)(X.lds + 33792 + 32768);
  LAS float* DD = (LAS float*)(X.lds + 33792 + 32768 + 65536);
  const int tid = X.tid;
  if (tid < 128) {
    const int dir = tid >> 6, p = tid & 63, idx = (dir * 32 + g) * 64 + p;
    const float lr = fminf(a.in[IN_LRE][idx], -1e-4f), li = a.in[IN_LIM][idx], dt = expf(a.in[IN_LDT][dir * 32 + g]);
    for (int tau = 0; tau <= 32; ++tau) { const float mg = expf(lr * dt * (float)tau); float sn, cs; sincosf(li * dt * (float)tau, &sn, &cs); POW[(dir * 33 + tau) * 64 + p] = (f32x2){mg * cs, mg * sn}; }
    const f32x2 l1 = POW[(dir * 33 + 1) * 64 + p], l32 = POW[(dir * 33 + 32) * 64 + p];
    ((float2*)(X.ws + WS_LAML))[idx] = make_float2(l32.x, l32.y);
    const float nr = l1.x - 1.f, ni = l1.y, den = lr * lr + li * li, cr = (nr * lr + ni * li) / den, ci = (ni * lr - nr * li) / den;
    for (int c = 0; c < 16; ++c) { const float xr = a.in[IN_BRE][idx * 16 + c], xi = a.in[IN_BIM][idx * 16 + c]; BB[(dir * 64 + p) * 16 + c] = (f32x2){cr * xr - ci * xi, cr * xi + ci * xr}; }
  }
  for (int i = tid; i < 2048; i += NTHR) { const int dir = i >> 10, c = (i >> 6) & 15, p = i & 63; const int gi = ((dir * 32 + g) * 16 + c) * 64 + p; CC[i] = (f32x2){a.in[IN_CRE][gi], a.in[IN_CIM][gi]}; }
  if (tid < 16) DD[tid] = a.in[IN_S5D][g * 16 + tid];
  __syncthreads();
  for (int combo = tid; combo < 1024; combo += NTHR) {
    const int dir = combo >> 9, tau = (combo >> 4) & 31, c = combo & 15;
    float accv[16];
#pragma unroll
    for (int j = 0; j < 16; ++j) accv[j] = 0.f;
    for (int p = 0; p < 64; ++p) {
      const f32x2 cc = CC[(dir * 16 + c) * 64 + p], pw = POW[(dir * 33 + tau) * 64 + p];
      const float zr = cc.x * pw.x - cc.y * pw.y, zi = cc.x * pw.y + cc.y * pw.x;
#pragma unroll
      for (int j = 0; j < 16; ++j) { const f32x2 b = BB[(dir * 64 + p) * 16 + j]; accv[j] += zr * b.x - zi * b.y; }
    }
#pragma unroll
    for (int j = 0; j < 16; ++j) KK[((dir * 32 + tau) * 16 + c) * 16 + j] = accv[j];
  }
  __syncthreads();
  bf16_t* TT = (bf16_t*)(X.ws + WS_TT) + (size_t)g * 512 * 768;
  for (int q = tid; q < 512 * 96; q += NTHR) {
    const int row = q / 96, cc8 = q % 96, i = row >> 4, c = row & 15; float v[8];
    if (cc8 < 64) {
      const int s = cc8 >> 1, c0 = (cc8 & 1) * 8;
#pragma unroll
      for (int j = 0; j < 8; ++j) { const int cp = c0 + j; float x;
        if (s < i) x = KK[((0 * 32 + (i - s)) * 16 + c) * 16 + cp];
        else if (s > i) x = KK[((1 * 32 + (s - i)) * 16 + c) * 16 + cp];
        else x = KK[((0 * 32 + 0) * 16 + c) * 16 + cp] + KK[((1 * 32 + 0) * 16 + c) * 16 + cp] + (cp == c ? DD[c] : 0.f);
        v[j] = x; }
    } else {
      const int kk = (cc8 - 64) * 8, dir = kk >> 7, ri = (kk >> 6) & 1, p0 = kk & 63, tau = dir == 0 ? i + 1 : 32 - i;
#pragma unroll
      for (int j = 0; j < 8; ++j) { const int p = p0 + j; const f32x2 cc = CC[(dir * 16 + c) * 64 + p], pw = POW[(dir * 33 + tau) * 64 + p];
        v[j] = ri == 0 ? (cc.x * pw.x - cc.y * pw.y) : -(cc.x * pw.y + cc.y * pw.x); }
    }
    u32x4 o; o.x = cvt_pk_bf16(v[0], v[1]); o.y = cvt_pk_bf16(v[2], v[3]); o.z = cvt_pk_bf16(v[4], v[5]); o.w = cvt_pk_bf16(v[6], v[7]);
    *(u32x4*)(TT + (size_t)row * 768 + cc8 * 8) = o;
  }
  bf16_t* WSm = (bf16_t*)(X.ws + WS_WS) + (size_t)g * 256 * 512;
  for (int q = tid; q < 256 * 64; q += NTHR) {
    const int n = q >> 6, cc8 = q & 63, dir = n >> 7, ri = (n >> 6) & 1, p = n & 63, s = cc8 >> 1, c0 = (cc8 & 1) * 8, tau = dir == 0 ? 31 - s : s;
    const f32x2 pw = POW[(dir * 33 + tau) * 64 + p]; float v[8];
#pragma unroll
    for (int j = 0; j < 8; ++j) { const f32x2 b = BB[(dir * 64 + p) * 16 + c0 + j]; v[j] = ri == 0 ? (pw.x * b.x - pw.y * b.y) : (pw.x * b.y + pw.y * b.x); }
    u32x4 o; o.x = cvt_pk_bf16(v[0], v[1]); o.y = cvt_pk_bf16(v[2], v[3]); o.z = cvt_pk_bf16(v[4], v[5]); o.w = cvt_pk_bf16(v[6], v[7]);
    *(u32x4*)(WSm + (size_t)n * 512 + cc8 * 8) = o;
  }
  __syncthreads();
}

__device__ __forceinline__ void p0_dftconst(const Ctx& X, int idx) {
  for (int q = idx * NTHR + X.tid; q < 32768; q += 32 * NTHR) {
    float v[8]; bf16_t* dst;
    if (q < 16384) {
      const int R = q >> 5, c0 = (q & 31) * 8, ri = R >> 8, m = R & 255; dst = (bf16_t*)(X.ws + WS_DMT) + (size_t)R * 256 + c0;
#pragma unroll
      for (int j = 0; j < 8; ++j) { float s, c; sincospif((float)(((c0 + j) * m) & 255) * (1.f / 128.f), &s, &c); v[j] = ri == 0 ? c : -s; }
    } else if (q < 24576) {
      const int q2 = q - 16384, R = q2 >> 5, c0 = (q2 & 31) * 8, rip = R >> 7, ka = R & 127; dst = (bf16_t*)(X.ws + WS_W1) + (size_t)R * 256 + c0;
#pragma unroll
      for (int j = 0; j < 8; ++j) { const int C = c0 + j, ri = C >> 7, ta = C & 127; float s, c; sincospif((float)((ka * ta) & 127) * (1.f / 64.f), &s, &c);
        v[j] = (rip == ri) ? c : (rip == 0 ? s : -s); }
    } else {
      const int q2 = q - 24576, R = q2 >> 5, c0 = (q2 & 31) * 8; dst = (bf16_t*)(X.ws + WS_W2) + (size_t)R * 256 + c0;
#pragma unroll
      for (int j = 0; j < 8; ++j) { const int C = c0 + j, rip = C >> 7, tb = C & 127; float s, c; sincospif((float)((R * tb) & 127) * (1.f / 64.f), &s, &c);
        v[j] = R < 128 ? (rip == 0 ? c : s) * (1.f / 2048.f) : 0.f; }
    }
    u32x4 o; o.x = cvt_pk_bf16(v[0], v[1]); o.y = cvt_pk_bf16(v[2], v[3]); o.z = cvt_pk_bf16(v[4], v[5]); o.w = cvt_pk_bf16(v[6], v[7]);
    *(u32x4*)dst = o;
  }
}

__device__ __forceinline__ void phase_prep(const Ctx& X) {
  const int c = X.c;
  if (c < 192) p0_adaln(X, c);
  else if (c < 224) p0_s5tables(X, c - 192);
  else p0_dftconst(X, c - 224);
  __syncthreads();
  unsigned* ctl = (unsigned*)(X.ws + WS_CTL);
  transpose_work(X, ctl + CW_DQ0, 0, IT_SMALL, (X.a->flags & 2) ? 1 : 0, (X.a->flags & FLAG_SKIP_EXPERTS) ? 0 : 65 * IT_EXP);
}

__device__ __forceinline__ void modulate_row(const float* hrow, const float* shift, const float* scale, bf16_t* orow, int lane) {
  const f32x4* xr = (const f32x4*)hrow + lane; f32x4 v[4]; float ss = 0.f;
#pragma unroll
  for (int j = 0; j < 4; ++j) { v[j] = xr[64 * j]; ss += (v[j].x * v[j].x + v[j].y * v[j].y) + (v[j].z * v[j].z + v[j].w * v[j].w); }
  const float r = rsqrtf(wave_sum(ss) * (1.f / 1024.f) + 1e-6f);
  u32x2* o8 = (u32x2*)orow + lane;
#pragma unroll
  for (int j = 0; j < 4; ++j) { const f32x4 sh = ((const f32x4*)shift)[lane + 64 * j], sc = ((const f32x4*)scale)[lane + 64 * j];
    u32x2 w; w.x = cvt_pk_bf16(v[j].x * r * (1.f + sc.x) + sh.x, v[j].y * r * (1.f + sc.y) + sh.y); w.y = cvt_pk_bf16(v[j].z * r * (1.f + sc.z) + sh.z, v[j].w * r * (1.f + sc.w) + sh.w);
    o8[64 * j] = w; }
}
__device__ __forceinline__ void phase_mod0(const Ctx& X) {
  const Args& a = *X.a; const float* mod = (const float*)(X.ws + WS_MOD); bf16_t* A0 = (bf16_t*)(X.ws + WS_A0);
  const int gw = X.c * NWAVES + X.wave, NGW = X.G * NWAVES;
  for (int r = gw; r < NROW; r += NGW) {
    if (r < TOK) modulate_row(a.in[IN_X] + (size_t)r * 1024, mod, mod + 1024, A0 + (size_t)r * 1024, X.lane);
    else modulate_row(a.in[IN_CTX] + (size_t)(r - TOK) * 1024, mod + 6144, mod + 6144 + 1024, A0 + (size_t)r * 1024, X.lane);
  }
}

__device__ __forceinline__ u32x4 pack8(const f32x4& v0, const f32x4& v1) { u32x4 w; w.x = cvt_pk_bf16(v0[0], v0[1]); w.y = cvt_pk_bf16(v0[2], v0[3]); w.z = cvt_pk_bf16(v1[0], v1[1]); w.w = cvt_pk_bf16(v1[2], v1[3]); return w; }

struct G1 {
  static constexpr bool PERM = true; static constexpr bool LINA = true, LINB = true; __device__ __forceinline__ size_t halfA() const { return 128u * 2048u; } __device__ __forceinline__ size_t halfB() const { return 128u * 2048u; } int K, nunits; unsigned char* ws; const float* qg; const float* kg;
  __device__ __forceinline__ void decode(int w, Unit& u) const { if (w < 390) { u.a = 0; u.pm = w / 6; u.pn = w % 6; } else { const int w2 = w - 390; u.a = 1; u.pm = w2 & 1; u.pn = w2 >> 1; } u.b = 0; }
  __device__ __forceinline__ const char* baseA(const Unit& u) const { return (const char*)ws + (u.a == 0 ? WS_A0 : WS_WIN_T + (size_t)1536 * 2048); }
  __device__ __forceinline__ const char* baseB(const Unit& u) const { return (const char*)ws + (u.a == 0 ? WS_WIN_T : WS_A0); }
  __device__ __forceinline__ unsigned rowA(const Unit& u, int r) const { return (unsigned)(u.pm * 256 + r) * 2048u; }
  __device__ __forceinline__ unsigned rowB(const Unit& u, int r) const { return (unsigned)(u.pn * 256 + r) * 2048u; }
  __device__ __forceinline__ void epi(const Acc& acc, const Unit& u, int wr, int wc, int fr, int fq) const {
    if (u.a == 1) {
      bf16_t* VT = (bf16_t*)(ws + WS_VT);
#pragma unroll
      for (int ai = 0; ai < 2; ++ai)
#pragma unroll
        for (int m = 0; m < 4; ++m) { const int d = u.pm * 256 + ai * 128 + wr * 64 + m * 16 + fr;
#pragma unroll
          for (int bj = 0; bj < 2; ++bj) { const int t0 = u.pn * 256 + bj * 128 + wc * 32 + 8 * fq; *(u32x4*)(VT + (size_t)d * NROW + t0) = pack8(acc[ai][bj][m][0], acc[ai][bj][m][1]); } }
      return;
    }
    if (u.pn < 2) {
      bf16_t* AS5 = (bf16_t*)(ws + WS_AS5);
#pragma unroll
      for (int ai = 0; ai < 2; ++ai)
#pragma unroll
        for (int m = 0; m < 4; ++m) { const int row = u.pm * 256 + ai * 128 + wr * 64 + m * 16 + fr; int crow, s;
          if (row < TOK) { crow = row >> 5; s = row & 31; } else { const int j = row - TOK; crow = 512 + (j >> 5); s = j & 31; }
#pragma unroll
          for (int bj = 0; bj < 2; ++bj) { const int g = 16 * u.pn + 8 * bj + 2 * wc + (fq >> 1), c0 = 8 * (fq & 1);
            *(u32x4*)(AS5 + ((size_t)(g * 768 + crow) * 768 + s * 16 + c0)) = pack8(acc[ai][bj][m][0], acc[ai][bj][m][1]); } }
      return;
    }
    const bool isq = u.pn < 4;
    if (isq && u.pm == 64) return;
    const int head = 4 * ((u.pn - 2) & 1) + wc; const float* gain = isq ? qg : kg;
    bf16_t* dst = isq ? (bf16_t*)(ws + WS_Q) : (bf16_t*)(ws + WS_K);
    f32x4 gv[2][2];
#pragma unroll
    for (int bj = 0; bj < 2; ++bj) { gv[bj][0] = *(const f32x4*)(gain + 32 * bj + 8 * fq); gv[bj][1] = *(const f32x4*)(gain + 32 * bj + 8 * fq + 4); }
#pragma unroll
    for (int ai = 0; ai < 2; ++ai)
#pragma unroll
      for (int m = 0; m < 4; ++m) { const int row = u.pm * 256 + ai * 128 + wr * 64 + m * 16 + fr; float ss = 0.f;
#pragma unroll
        for (int bj = 0; bj < 2; ++bj)
#pragma unroll
          for (int n = 0; n < 2; ++n) { const f32x4 x = acc[ai][bj][m][n]; ss += (x[0] * x[0] + x[1] * x[1]) + (x[2] * x[2] + x[3] * x[3]); }
        ss += sx(ss, 16); ss += sx(ss, 32);
        const float rinv = rsqrtf(ss * (1.f / 64.f) + 1e-6f);
#pragma unroll
        for (int bj = 0; bj < 2; ++bj) { const f32x4 v0 = acc[ai][bj][m][0] * rinv * gv[bj][0], v1 = acc[ai][bj][m][1] * rinv * gv[bj][1];
          *(u32x4*)(dst + (size_t)row * 512 + head * 64 + 32 * bj + 8 * fq) = pack8(v0, v1); } }
  }
};

struct G2 {
  static constexpr bool PERM = true; static constexpr bool LINA = true, LINB = true; __device__ __forceinline__ size_t halfA() const { return 128u * 1536u; } __device__ __forceinline__ size_t halfB() const { return 128u * 1024u; } int K, nunits; unsigned char* ws;
  __device__ __forceinline__ void decode(int w, Unit& u) const { u.a = w / 3; u.pm = w % 3; u.pn = 0; u.b = 0; }
  __device__ __forceinline__ const char* baseA(const Unit& u) const { return (const char*)ws + WS_AS5 + (size_t)u.a * 768 * 768 * 2; }
  __device__ __forceinline__ const char* baseB(const Unit& u) const { return (const char*)ws + WS_WS + (size_t)u.a * 256 * 512 * 2; }
  __device__ __forceinline__ unsigned rowA(const Unit& u, int r) const { return (unsigned)(u.pm * 256 + r) * 1536u; }
  __device__ __forceinline__ unsigned rowB(const Unit& u, int r) const { return (unsigned)r * 1024u; }
  __device__ __forceinline__ void epi(const Acc& acc, const Unit& u, int wr, int wc, int fr, int fq) const {
    float* SST = (float*)(ws + WS_SST) + (size_t)u.a * 768 * 256;
#pragma unroll
    for (int ai = 0; ai < 2; ++ai)
#pragma unroll
      for (int m = 0; m < 4; ++m) { const int crow = u.pm * 256 + ai * 128 + wr * 64 + m * 16 + fr; if (crow >= 520) continue;
#pragma unroll
        for (int bj = 0; bj < 2; ++bj) { float* p = SST + (size_t)crow * 256 + bj * 128 + wc * 32 + 8 * fq; *(f32x4*)p = acc[ai][bj][m][0]; *(f32x4*)(p + 4) = acc[ai][bj][m][1]; } }
  }
};

struct G3 {
  static constexpr bool PERM = true; static constexpr bool LINA = true, LINB = true; __device__ __forceinline__ size_t halfA() const { return 128u * 1536u; } __device__ __forceinline__ size_t halfB() const { return 128u * 1536u; } int K, nunits; unsigned char* ws;
  __device__ __forceinline__ void decode(int w, Unit& u) const { u.a = w >> 2; u.pm = (w >> 1) & 1; u.pn = w & 1; u.b = 0; }
  __device__ __forceinline__ const char* baseA(const Unit& u) const { return (const char*)ws + WS_AS5 + (size_t)u.a * 768 * 768 * 2; }
  __device__ __forceinline__ const char* baseB(const Unit& u) const { return (const char*)ws + WS_TT + (size_t)u.a * 512 * 768 * 2; }
  __device__ __forceinline__ unsigned rowA(const Unit& u, int r) const { return (unsigned)(u.pm * 256 + r) * 1536u; }
  __device__ __forceinline__ unsigned rowB(const Unit& u, int r) const { return (unsigned)(u.pn * 256 + r) * 1536u; }
  __device__ __forceinline__ void epi(const Acc& acc, const Unit& u, int wr, int wc, int fr, int fq) const {
    bf16_t* GB = (bf16_t*)(ws + WS_GB);
#pragma unroll
    for (int ai = 0; ai < 2; ++ai)
#pragma unroll
      for (int m = 0; m < 4; ++m) { const int crow = u.pm * 256 + ai * 128 + wr * 64 + m * 16 + fr;
#pragma unroll
        for (int bj = 0; bj < 2; ++bj) { const int pp = u.pn * 256 + bj * 128 + wc * 32 + 8 * fq, i = pp >> 4, c0 = pp & 15; f32x4 v0 = acc[ai][bj][m][0], v1 = acc[ai][bj][m][1];
#pragma unroll
          for (int j = 0; j < 4; ++j) { v0[j] = gelu_tanh(v0[j]); v1[j] = gelu_tanh(v1[j]); }
          *(u32x4*)(GB + (size_t)(crow * 32 + i) * 512 + u.a * 16 + c0) = pack8(v0, v1); } }
  }
};

struct G4 {
  static constexpr bool PERM = true; static constexpr bool LINA = true, LINB = true; __device__ __forceinline__ size_t halfA() const { return 128u * 1024u; } __device__ __forceinline__ size_t halfB() const { return 128u * 1024u; } int K, nunits; unsigned char* ws; const float* bglu;
  __device__ __forceinline__ void decode(int w, Unit& u) const { u.pm = w >> 1; u.pn = w & 1; u.a = 0; u.b = 0; }
  __device__ __forceinline__ const char* baseA(const Unit&) const { return (const char*)ws + WS_GB; }
  __device__ __forceinline__ const char* baseB(const Unit&) const { return (const char*)ws + WS_WGLU_T; }
  __device__ __forceinline__ unsigned rowA(const Unit& u, int r) const { return (unsigned)(u.pm * 256 + r) * 1024u; }
  __device__ __forceinline__ unsigned rowB(const Unit& u, int r) const { return (unsigned)(u.pn * 256 + r) * 1024u; }
  __device__ __forceinline__ void epi(const Acc& acc, const Unit& u, int wr, int wc, int fr, int fq) const {
    const bf16_t* GB = (const bf16_t*)(ws + WS_GB); bf16_t* CC = (bf16_t*)(ws + WS_CONCAT);
#pragma unroll
    for (int bj = 0; bj < 2; ++bj) { const int col0 = u.pn * 256 + bj * 128 + wc * 32 + 8 * fq; const f32x4 b0 = *(const f32x4*)(bglu + col0), b1 = *(const f32x4*)(bglu + col0 + 4);
#pragma unroll
      for (int ai = 0; ai < 2; ++ai)
#pragma unroll
        for (int m = 0; m < 4; ++m) { const int row = u.pm * 256 + ai * 128 + wr * 64 + m * 16 + fr; const u32x4 gw = *(const u32x4*)(GB + (size_t)row * 512 + col0);
          f32x4 v0 = acc[ai][bj][m][0] + b0, v1 = acc[ai][bj][m][1] + b1;
          v0[0] = bf_lo(gw.x) * fast_sigmoid(v0[0]); v0[1] = bf_hi(gw.x) * fast_sigmoid(v0[1]); v0[2] = bf_lo(gw.y) * fast_sigmoid(v0[2]); v0[3] = bf_hi(gw.y) * fast_sigmoid(v0[3]);
          v1[0] = bf_lo(gw.z) * fast_sigmoid(v1[0]); v1[1] = bf_hi(gw.z) * fast_sigmoid(v1[1]); v1[2] = bf_lo(gw.w) * fast_sigmoid(v1[2]); v1[3] = bf_hi(gw.w) * fast_sigmoid(v1[3]);
          *(u32x4*)(CC + (size_t)row * 1024 + col0) = pack8(v0, v1); } }
  }
};

struct GRes {
  static constexpr bool PERM = false; static constexpr bool LINA = true, LINB = true; __device__ __forceinline__ size_t halfA() const { return 128u * 2048u; } __device__ __forceinline__ size_t halfB() const { return 128u * 2048u; } int K, nunits; const char* A; const char* Bt; const float* hin; float* hout; const float* gate; const float* bias;
  __device__ __forceinline__ void decode(int w, Unit& u) const { u.pm = w >> 2; u.pn = w & 3; u.a = 0; u.b = 0; }
  __device__ __forceinline__ const char* baseA(const Unit&) const { return A; }
  __device__ __forceinline__ const char* baseB(const Unit&) const { return Bt; }
  __device__ __forceinline__ unsigned rowA(const Unit& u, int r) const { return (unsigned)(u.pm * 256 + r) * 2048u; }
  __device__ __forceinline__ unsigned rowB(const Unit& u, int r) const { return (unsigned)(u.pn * 256 + r) * 2048u; }
  __device__ __forceinline__ void epi(const Acc& acc, const Unit& u, int wr, int wc, int fr, int fq) const {
#pragma unroll
    for (int bj = 0; bj < 2; ++bj)
#pragma unroll
      for (int n = 0; n < 2; ++n) { const int col0 = u.pn * 256 + bj * 128 + wc * 32 + 16 * n + 4 * fq; const f32x4 gt = *(const f32x4*)(gate + col0);
        f32x4 bs = (f32x4){0.f, 0.f, 0.f, 0.f}; if (bias) bs = *(const f32x4*)(bias + col0);
#pragma unroll
        for (int ai = 0; ai < 2; ++ai)
#pragma unroll
          for (int m = 0; m < 4; ++m) { const size_t off = (size_t)(u.pm * 256 + ai * 128 + wr * 64 + m * 16 + fr) * 1024 + col0;
            const f32x4 hv = *(const f32x4*)(hin + off); *(f32x4*)(hout + off) = hv + gt * (acc[ai][bj][m][n] + bs); } }
  }
};

struct MoeTab { const LAS int* toff; const LAS int* cnt; };
__device__ __forceinline__ void build_moetab(const Ctx& X, int layer, int half, LAS int* toff, LAS int* cntl) {
  const unsigned* cnt = (const unsigned*)(X.ws + WS_CTL) + CW_CNT + (layer * 2 + half) * 64;
  if (X.tid < 64) cntl[X.tid] = (int)__hip_atomic_load(cnt + X.tid, __ATOMIC_RELAXED, __HIP_MEMORY_SCOPE_AGENT);
  __syncthreads();
  if (X.tid == 0) { int s = 0; for (int e = 0; e < 64; ++e) { toff[e] = s; s += (cntl[e] + 255) >> 8; } toff[64] = s; toff[65] = s + 32; }
  __syncthreads();
}
__device__ __forceinline__ int find_expert(const LAS int* toff, int ti) { int e = 0;
#pragma unroll 8
  for (int j = 1; j <= 64; ++j) e += (ti >= toff[j]) ? 1 : 0; return e; }

struct G6 {
  static constexpr bool PERM = true; static constexpr bool LINA = false, LINB = true; __device__ __forceinline__ size_t halfA() const { return 0; } __device__ __forceinline__ size_t halfB() const { return 128u * 2048u; } int K, nunits; unsigned char* ws; MoeTab tab; int half;
  __device__ __forceinline__ void decode(int w, Unit& u) const { const int ti = w >> 1; u.pn = w & 1; u.a = find_expert(tab.toff, ti); u.pm = ti - tab.toff[u.a]; u.b = ti; }
  __device__ __forceinline__ const char* baseA(const Unit&) const { return (const char*)ws + WS_F; }
  __device__ __forceinline__ const char* baseB(const Unit& u) const { return (const char*)ws + WS_WEXP + (size_t)u.a * EXP_STRIDE; }
  __device__ __forceinline__ unsigned rowA(const Unit& u, int r) const { const int idx = u.pm * 256 + r; int tok;
    if (u.a == 64) tok = half * 8192 + idx; else { tok = half * 8192; if (idx < tab.cnt[u.a]) tok = ((const int*)(ws + WS_LTOK))[(half * 64 + u.a) * 8192 + idx]; }
    return (unsigned)tok * 2048u; }
  __device__ __forceinline__ unsigned rowB(const Unit& u, int r) const { return (unsigned)(u.pn * 256 + r) * 2048u; }
  __device__ __forceinline__ void epi(const Acc& acc, const Unit& u, int wr, int wc, int fr, int fq) const {
    bf16_t* HID = (bf16_t*)(ws + WS_HID);
#pragma unroll
    for (int ai = 0; ai < 2; ++ai)
#pragma unroll
      for (int m = 0; m < 4; ++m) { const size_t hrow = (size_t)u.b * 256 + ai * 128 + wr * 64 + m * 16 + fr; f32x4 v0, v1;
#pragma unroll
        for (int j = 0; j < 4; ++j) { const float g0 = acc[ai][0][m][0][j], g1 = acc[ai][0][m][1][j]; v0[j] = g0 * fast_sigmoid(g0) * acc[ai][1][m][0][j]; v1[j] = g1 * fast_sigmoid(g1) * acc[ai][1][m][1][j]; }
        *(u32x4*)(HID + hrow * 256 + u.pn * 128 + wc * 32 + 8 * fq) = pack8(v0, v1); }
  }
};
struct G7 {
  static constexpr bool PERM = true; static constexpr bool LINA = true, LINB = true; __device__ __forceinline__ size_t halfA() const { return 128u * 512u; } __device__ __forceinline__ size_t halfB() const { return 128u * 512u; } int K, nunits; unsigned char* ws; MoeTab tab; int half;
  __device__ __forceinline__ void decode(int w, Unit& u) const { const int ti = w >> 2; u.pn = w & 3; u.a = find_expert(tab.toff, ti); u.pm = ti - tab.toff[u.a]; u.b = ti; }
  __device__ __forceinline__ const char* baseA(const Unit&) const { return (const char*)ws + WS_HID; }
  __device__ __forceinline__ const char* baseB(const Unit& u) const { return (const char*)ws + WS_WEXP + (size_t)u.a * EXP_STRIDE + EXP_DOFF; }
  __device__ __forceinline__ unsigned rowA(const Unit& u, int r) const { return (unsigned)(u.b * 256 + r) * 512u; }
  __device__ __forceinline__ unsigned rowB(const Unit& u, int r) const { return (unsigned)(u.pn * 256 + r) * 512u; }
  __device__ __forceinline__ void epi(const Acc& acc, const Unit& u, int wr, int wc, int fr, int fq) const {
    bf16_t* YAS = (bf16_t*)(ws + WS_YAS); const float* lw = (const float*)(ws + WS_LW) + (size_t)(half * 64 + (u.a & 63)) * 8192;
#pragma unroll
    for (int ai = 0; ai < 2; ++ai)
#pragma unroll
      for (int m = 0; m < 4; ++m) { const int tr = ai * 128 + wr * 64 + m * 16 + fr, idx = u.pm * 256 + tr; float wgt = 1.f;
        if (u.a < 64) { wgt = 0.f; if (idx < tab.cnt[u.a]) wgt = lw[idx]; }
        const size_t yrow = (size_t)u.b * 256 + tr;
#pragma unroll
        for (int bj = 0; bj < 2; ++bj) *(u32x4*)(YAS + yrow * 1024 + u.pn * 256 + bj * 128 + wc * 32 + 8 * fq) = pack8(acc[ai][bj][m][0] * wgt, acc[ai][bj][m][1] * wgt); }
  }
};

struct G8 {
  static constexpr bool PERM = true; static constexpr bool LINA = true, LINB = false; __device__ __forceinline__ size_t halfA() const { return 128u * 512u; } __device__ __forceinline__ size_t halfB() const { return 0; } int K, nunits; unsigned char* ws;
  __device__ __forceinline__ void decode(int w, Unit& u) const { u.a = w >> 7; const int r = w & 127; u.pm = r & 1; u.pn = r >> 1; u.b = 0; }
  __device__ __forceinline__ const char* baseA(const Unit&) const { return (const char*)ws + WS_DMT; }
  __device__ __forceinline__ const char* baseB(const Unit& u) const { return (const char*)ws + WS_A1 + (size_t)u.a * 512; }
  __device__ __forceinline__ unsigned rowA(const Unit& u, int r) const { return (unsigned)(u.pm * 256 + r) * 512u; }
  __device__ __forceinline__ unsigned rowB(const Unit& u, int r) const { const int n = u.pn * 256 + r; return (unsigned)(128 * (n & 127) + (n >> 7)) * 2048u; }
  __device__ __forceinline__ void epi(const Acc& acc, const Unit& u, int wr, int wc, int fr, int fq) const {
    bf16_t* X1 = (bf16_t*)(ws + WS_X1);
#pragma unroll
    for (int ai = 0; ai < 2; ++ai)
#pragma unroll
      for (int m = 0; m < 4; ++m) { const int mm = ai * 128 + wr * 64 + m * 16 + fr;
#pragma unroll
        for (int bj = 0; bj < 2; ++bj) { const int n0 = u.pn * 256 + bj * 128 + wc * 32 + 8 * fq, tb = n0 >> 7, ta0 = n0 & 127;
          *(u32x4*)(X1 + ((((size_t)(u.a * 256 + mm) * 128 + tb) * 2 + u.pm) * 128 + ta0)) = pack8(acc[ai][bj][m][0], acc[ai][bj][m][1]); } }
  }
};
struct G9 {
  static constexpr bool PERM = true; static constexpr bool LINA = true, LINB = true; __device__ __forceinline__ size_t halfA() const { return 128u * 512u; } __device__ __forceinline__ size_t halfB() const { return 128u * 512u; } int K, nunits; unsigned char* ws;
  __device__ __forceinline__ void decode(int w, Unit& u) const { u.pm = 0; u.pn = w; u.a = 0; u.b = 0; }
  __device__ __forceinline__ const char* baseA(const Unit&) const { return (const char*)ws + WS_W1; }
  __device__ __forceinline__ const char* baseB(const Unit&) const { return (const char*)ws + WS_X1; }
  __device__ __forceinline__ unsigned rowA(const Unit&, int r) const { return (unsigned)r * 512u; }
  __device__ __forceinline__ unsigned rowB(const Unit& u, int r) const { return (unsigned)(u.pn * 256 + r) * 512u; }
  __device__ __forceinline__ void epi(const Acc& acc, const Unit& u, int wr, int wc, int fr, int fq) const {
    bf16_t* X2 = (bf16_t*)(ws + WS_X2);
#pragma unroll
    for (int m = 0; m < 4; ++m) { const int ka = wr * 64 + m * 16 + fr;
#pragma unroll
      for (int bj = 0; bj < 2; ++bj) { const int n0 = u.pn * 256 + bj * 128 + wc * 32 + 8 * fq, gm = n0 >> 7, tb0 = n0 & 127; f32x4 r0, r1, i0, i1;
#pragma unroll
        for (int j = 0; j < 4; ++j) {
          { const float ang = (float)((ka * (tb0 + j)) & 16383) * (1.f / 16384.f), cs = __builtin_amdgcn_cosf(ang), sn = __builtin_amdgcn_sinf(ang); const float yr = acc[0][bj][m][0][j], yi = acc[1][bj][m][0][j]; r0[j] = yr * cs + yi * sn; i0[j] = yi * cs - yr * sn; }
          { const float ang = (float)((ka * (tb0 + 4 + j)) & 16383) * (1.f / 16384.f), cs = __builtin_amdgcn_cosf(ang), sn = __builtin_amdgcn_sinf(ang); const float yr = acc[0][bj][m][1][j], yi = acc[1][bj][m][1][j]; r1[j] = yr * cs + yi * sn; i1[j] = yi * cs - yr * sn; } }
        bf16_t* p = X2 + (((size_t)(gm * 128 + ka) * 2) * 128 + tb0); *(u32x4*)p = pack8(r0, r1); *(u32x4*)(p + 128) = pack8(i0, i1); } }
  }
};
struct G10 {
  static constexpr bool PERM = true; static constexpr bool LINA = true, LINB = false; __device__ __forceinline__ size_t halfA() const { return 128u * 512u; } __device__ __forceinline__ size_t halfB() const { return 0; } int K, nunits; unsigned char* ws;
  __device__ __forceinline__ void decode(int w, Unit& u) const { u.pm = 0; u.pn = w; u.a = 0; u.b = 0; }
  __device__ __forceinline__ const char* baseA(const Unit&) const { return (const char*)ws + WS_W2; }
  __device__ __forceinline__ const char* baseB(const Unit&) const { return (const char*)ws + WS_X2; }
  __device__ __forceinline__ unsigned rowA(const Unit&, int r) const { return (unsigned)r * 512u; }
  __device__ __forceinline__ unsigned rowB(const Unit& u, int r) const { const int n = u.pn * 256 + r, ka = n >> 10, gm = n & 1023; return (unsigned)(gm * 128 + ka) * 512u; }
  __device__ __forceinline__ void epi(const Acc& acc, const Unit& u, int wr, int wc, int fr, int fq) const {
    bf16_t* FB = (bf16_t*)(ws + WS_FB); const int ka = u.pn >> 2;
#pragma unroll
    for (int m = 0; m < 4; ++m) { const int kb = wr * 64 + m * 16 + fr; const size_t k = (size_t)ka + 128 * kb;
#pragma unroll
      for (int bj = 0; bj < 2; ++bj) { const int d0 = (u.pn & 3) * 256 + bj * 128 + wc * 32 + 8 * fq; *(u32x4*)(FB + k * 1024 + d0) = pack8(acc[0][bj][m][0], acc[0][bj][m][1]); } }
  }
};
}
namespace mk {
typedef float f32x16 __attribute__((ext_vector_type(16)));

__device__ __forceinline__ void phase_scan(const Ctx& X) {
  const int gt = X.c * NTHR + X.tid; if (gt >= 4096) return;
  const int g = gt >> 7, dir = (gt >> 6) & 1, p = gt & 63;
  const float2 lam = ((const float2*)(X.ws + WS_LAML))[(dir * 32 + g) * 64 + p];
  const float* S = (const float*)(X.ws + WS_SST) + (size_t)g * 768 * 256 + dir * 128 + p;
  bf16_t* XP = (bf16_t*)(X.ws + WS_AS5) + (size_t)g * 768 * 768 + 512 + dir * 128 + p;
  float xr = 0.f, xi = 0.f;
  for (int j = 0; j < 520; ++j) {
    const int row = dir == 0 ? (j < 8 ? 512 + j : j - 8) : (j < 8 ? 519 - j : 519 - j);
    const float sr = S[(size_t)row * 256], si = S[(size_t)row * 256 + 64];
    XP[(size_t)row * 768] = f2bf(xr); XP[(size_t)row * 768 + 64] = f2bf(xi);
    const float nr = lam.x * xr - lam.y * xi + sr, ni = lam.x * xi + lam.y * xr + si; xr = nr; xi = ni;
  }
}

#define MFMA32(a, b, c) __builtin_amdgcn_mfma_f32_32x32x16_bf16((a), (b), (c), 0, 0, 0)
__device__ __forceinline__ void attn_unit(const Ctx& X, const LAS float* rpbl, int head, int tile) {
  const bf16_t* Q = (const bf16_t*)(X.ws + WS_Q); const bf16_t* Kb = (const bf16_t*)(X.ws + WS_K); const bf16_t* VT = (const bf16_t*)(X.ws + WS_VT);
  bf16_t* CCt = (bf16_t*)(X.ws + WS_CONCAT);
  const int lane = X.lane, ql = lane & 31, hh = lane >> 5;
  const int rp = tile >> 2, mt = tile & 3;
  const int r = 2 * rp + (ql >> 4), cq = 16 * mt + (ql & 15), tq = r * 64 + cq;
  const int r0q = min(max(r - 4, 0), 248), csq = min(max(cq - 8, 0), 48);
  const int rlo = min(max(2 * rp - 4, 0), 248), rhi = min(max(2 * rp - 3, 0), 248) + 7;
  const int csb = min(max(16 * mt - 8, 0), 32);
  const int nloc = rhi - rlo + 1;
  bf16x8 qf[4];
#pragma unroll
  for (int ks = 0; ks < 4; ++ks) qf[ks] = *(const bf16x8*)(Q + (size_t)tq * 512 + head * 64 + 16 * ks + 8 * hh);
  const int kperm = (ql & ~12) | ((ql & 4) << 1) | ((ql & 8) >> 1);
  f32x16 o0, o1;
#pragma unroll
  for (int i = 0; i < 16; ++i) { o0[i] = 0.f; o1[i] = 0.f; }
  float lsum = 0.f;
  const float c1 = 0.125f * 1.44269504f, c2 = 8.f * 1.44269504f;
  const float* rp_h = nullptr; (void)rp_h;
  for (int b = 0; b < nloc + 8; ++b) {
    const bool loc = b < nloc;
    const int kr = rlo + b;
    const int tokbase = loc ? kr * 64 + csb : TOK + 32 * (b - nloc);
    bf16x8 kf[4], vf[2][2];
    { const bf16_t* kp = Kb + (size_t)(tokbase + kperm) * 512 + head * 64 + 8 * hh;
#pragma unroll
      for (int ks = 0; ks < 4; ++ks) kf[ks] = *(const bf16x8*)(kp + 16 * ks); }
#pragma unroll
    for (int db = 0; db < 2; ++db)
#pragma unroll
      for (int s = 0; s < 2; ++s) vf[db][s] = *(const bf16x8*)(VT + (size_t)(head * 64 + 32 * db + ql) * NROW + tokbase + 16 * s + 8 * hh);
    f32x16 sacc;
#pragma unroll
    for (int i = 0; i < 16; ++i) sacc[i] = 0.f;
#pragma unroll
    for (int ks = 0; ks < 4; ++ks) sacc = MFMA32(kf[ks], qf[ks], sacc);
    float pv[16];
    if (loc) {
      const bool rowok = (kr >= r0q) && (kr <= r0q + 7);
      const LAS float* bp = rpbl + (head * 15 + (kr - r + 7)) * 31 + (csb - cq + 15);
#pragma unroll
      for (int i = 0; i < 16; ++i) { const int kidx = 16 * (i >> 3) + 8 * hh + (i & 7); const int kc = csb + kidx;
        const bool ok = rowok && (kc >= csq) && (kc <= csq + 15);
        float bias = 0.f; if (ok) bias = bp[kidx];
        const float e = __builtin_amdgcn_exp2f(sacc[i] * c1 + bias * 1.44269504f - c2); pv[i] = ok ? e : 0.f; }
    } else {
#pragma unroll
      for (int i = 0; i < 16; ++i) pv[i] = __builtin_amdgcn_exp2f(sacc[i] * c1 - c2);
    }
    u32x4 p0, p1;
    p0.x = cvt_pk_bf16(pv[0], pv[1]); p0.y = cvt_pk_bf16(pv[2], pv[3]); p0.z = cvt_pk_bf16(pv[4], pv[5]); p0.w = cvt_pk_bf16(pv[6], pv[7]);
    p1.x = cvt_pk_bf16(pv[8], pv[9]); p1.y = cvt_pk_bf16(pv[10], pv[11]); p1.z = cvt_pk_bf16(pv[12], pv[13]); p1.w = cvt_pk_bf16(pv[14], pv[15]);
    lsum += (bf_lo(p0.x) + bf_hi(p0.x)) + (bf_lo(p0.y) + bf_hi(p0.y)) + (bf_lo(p0.z) + bf_hi(p0.z)) + (bf_lo(p0.w) + bf_hi(p0.w))
          + (bf_lo(p1.x) + bf_hi(p1.x)) + (bf_lo(p1.y) + bf_hi(p1.y)) + (bf_lo(p1.z) + bf_hi(p1.z)) + (bf_lo(p1.w) + bf_hi(p1.w));
    const bf16x8 pb0 = __builtin_bit_cast(bf16x8, p0), pb1 = __builtin_bit_cast(bf16x8, p1);
    o0 = MFMA32(vf[0][0], pb0, o0); o0 = MFMA32(vf[0][1], pb1, o0);
    o1 = MFMA32(vf[1][0], pb0, o1); o1 = MFMA32(vf[1][1], pb1, o1);
  }
  lsum += sx(lsum, 32);
  const float inv = 1.f / lsum;
  bf16_t* op = CCt + (size_t)tq * 1024 + 512 + head * 64 + 4 * hh;
#pragma unroll
  for (int gq = 0; gq < 4; ++gq) {
    u32x2 w0, w1;
    w0.x = cvt_pk_bf16(o0[4 * gq] * inv, o0[4 * gq + 1] * inv); w0.y = cvt_pk_bf16(o0[4 * gq + 2] * inv, o0[4 * gq + 3] * inv);
    w1.x = cvt_pk_bf16(o1[4 * gq] * inv, o1[4 * gq + 1] * inv); w1.y = cvt_pk_bf16(o1[4 * gq + 2] * inv, o1[4 * gq + 3] * inv);
    *(u32x2*)(op + 8 * gq) = w0; *(u32x2*)(op + 32 + 8 * gq) = w1;
  }
}
__device__ __forceinline__ void phase_attn(const Ctx& X) {
  LAS float* rpbl = (LAS float*)X.lds;
  for (int i = X.tid; i < 8 * 15 * 31; i += NTHR) rpbl[i] = X.a->in[IN_RPB][i];
  __syncthreads();
  const int gw = X.c * NWAVES + X.wave, NGW = X.G * NWAVES;
  for (int U = gw; U < 4096; U += NGW) attn_unit(X, rpbl, U >> 9, U & 511);
}

__device__ __forceinline__ void phase_router(const Ctx& X, int layer) {
  const float* mod = (const float*)(X.ws + WS_MOD) + (layer == 0 ? 0 : 2 * 6144);
  const float* shift = mod + 3072; const float* scale = mod + 4096;
  const float* h = X.a->h; bf16_t* F = (bf16_t*)(X.ws + WS_F);
  unsigned* cntg = (unsigned*)(X.ws + WS_CTL) + CW_CNT + layer * 128;
  int* ltok = (int*)(X.ws + WS_LTOK); float* lw = (float*)(X.ws + WS_LW); int* asg = (int*)(X.ws + WS_ASG);
  const bf16_t* WR = (const bf16_t*)(X.ws + WS_WROUT_T) + (size_t)layer * 64 * 1024;
  const float* rbias = X.a->in[IN_RBIAS] + layer * 64;
  constexpr int FROW = 2064;
  const int lane = X.lane, wave = X.wave, tid = X.tid;
  for (int tile = X.c; tile < TOK / 64; tile += X.G) {
    const int t0 = tile * 64;
    for (int rr = 0; rr < 8; ++rr) {
      const int lr = wave * 8 + rr, t = t0 + lr;
      const f32x4* xr = (const f32x4*)(h + (size_t)t * 1024) + lane; f32x4 v[4]; float ss = 0.f;
#pragma unroll
      for (int j = 0; j < 4; ++j) { v[j] = xr[64 * j]; ss += (v[j].x * v[j].x + v[j].y * v[j].y) + (v[j].z * v[j].z + v[j].w * v[j].w); }
      const float r = rsqrtf(wave_sum(ss) * (1.f / 1024.f) + 1e-6f);
#pragma unroll
      for (int j = 0; j < 4; ++j) { const f32x4 sh = ((const f32x4*)shift)[lane + 64 * j], sc = ((const f32x4*)scale)[lane + 64 * j];
        u32x2 w; w.x = cvt_pk_bf16(v[j].x * r * (1.f + sc.x) + sh.x, v[j].y * r * (1.f + sc.y) + sh.y); w.y = cvt_pk_bf16(v[j].z * r * (1.f + sc.z) + sh.z, v[j].w * r * (1.f + sc.w) + sh.w);
        ((u32x2*)(F + (size_t)t * 1024))[lane + 64 * j] = w;
        *(LAS u32x2*)(X.lds + lr * FROW + (lane + 64 * j) * 8) = w; }
    }
    __syncthreads();
    f32x4 lg[2];
    { const int rb = wave & 3, fr = lane & 15, fq = lane >> 4;
      lg[0] = (f32x4){0.f, 0.f, 0.f, 0.f}; lg[1] = lg[0];
      const LAS unsigned char* ap = X.lds + (rb * 16 + fr) * FROW + fq * 16;
      const bf16_t* bp0 = WR + (size_t)((2 * (wave >> 2)) * 16 + fr) * 1024 + fq * 8; const bf16_t* bp1 = bp0 + 16 * 1024;
#pragma unroll 4
      for (int ks = 0; ks < 32; ++ks) { const bf16x8 af = *(const LAS bf16x8*)(ap + ks * 64); const bf16x8 b0 = *(const bf16x8*)(bp0 + ks * 32), b1 = *(const bf16x8*)(bp1 + ks * 32);
        lg[0] = __builtin_amdgcn_mfma_f32_16x16x32_bf16(af, b0, lg[0], 0, 0, 0); lg[1] = __builtin_amdgcn_mfma_f32_16x16x32_bf16(af, b1, lg[1], 0, 0, 0); }
    }
    __syncthreads();
    LAS float* LG = (LAS float*)X.lds;
    LAS float* GS = LG + 64 * 65;
    LAS float* SELV = GS + 512;
    LAS int* OUTE = (LAS int*)(SELV + 4096);
    LAS float* OUTS = (LAS float*)(OUTE + 512);
    LAS int* HIST = (LAS int*)(OUTS + 512);
    LAS int* BASE = HIST + 64;
    { const int rb = wave & 3, fr = lane & 15, fq = lane >> 4;
#pragma unroll
      for (int eb = 0; eb < 2; ++eb)
#pragma unroll
        for (int j = 0; j < 4; ++j) LG[(rb * 16 + 4 * fq + j) * 65 + (2 * (wave >> 2) + eb) * 16 + fr] = lg[eb][j];
      if (tid < 64) HIST[tid] = 0; }
    __syncthreads();
    const int tl = tid >> 3, grp = tid & 7;
    float v[8], sc[8];
    { float m1 = -INFINITY, m2 = -INFINITY;
#pragma unroll
      for (int j = 0; j < 8; ++j) { const float s = 1.f / (1.f + __expf(-LG[tl * 65 + grp * 8 + j])); sc[j] = s; v[j] = s + rbias[grp * 8 + j];
        if (v[j] > m1) { m2 = m1; m1 = v[j]; } else if (v[j] > m2) m2 = v[j]; }
      GS[tl * 8 + grp] = m1 + m2; }
    __syncthreads();
    bool keep;
    { const float mine = GS[tl * 8 + grp]; int rank = 0;
#pragma unroll
      for (int g2 = 0; g2 < 8; ++g2) { const float o = GS[tl * 8 + g2]; rank += (o > mine || (o == mine && g2 < grp)) ? 1 : 0; }
      keep = rank < 4;
#pragma unroll
      for (int j = 0; j < 8; ++j) SELV[tl * 64 + grp * 8 + j] = keep ? v[j] : -INFINITY; }
    __syncthreads();
    if (keep) {
      int rk[8];
#pragma unroll
      for (int j = 0; j < 8; ++j) rk[j] = 0;
      for (int e2 = 0; e2 < 64; ++e2) { const float o = SELV[tl * 64 + e2];
#pragma unroll
        for (int j = 0; j < 8; ++j) rk[j] += (o > v[j] || (o == v[j] && e2 < grp * 8 + j)) ? 1 : 0; }
#pragma unroll
      for (int j = 0; j < 8; ++j) if (rk[j] < 8) { OUTE[tl * 8 + rk[j]] = grp * 8 + j; OUTS[tl * 8 + rk[j]] = sc[j]; }
    }
    __syncthreads();
    { const int jj = tid & 7, e = OUTE[tl * 8 + jj]; const float s = OUTS[tl * 8 + jj];
      float sum = s; sum += sx(sum, 1); sum += sx(sum, 2); sum += sx(sum, 4);
      const float w = 2.5f * s / sum;
      const int sl = atomicAdd((int*)&HIST[e], 1);
      __syncthreads();
      const int t = t0 + tl, half = t >> 13;
      if (tid < 64) { const int n = HIST[tid]; BASE[tid] = n ? (int)atomicAdd(cntg + half * 64 + tid, (unsigned)n) : 0; }
      __syncthreads();
      const int slot = BASE[e] + sl;
      ltok[(size_t)(half * 64 + e) * 8192 + slot] = t; lw[(size_t)(half * 64 + e) * 8192 + slot] = w; asg[t * 8 + jj] = (e << 16) | slot; }
    __syncthreads();
  }
}

__device__ __forceinline__ void phase_combine(const Ctx& X, int layer, int half, const LAS int* toff) {
  const float* mod = (const float*)(X.ws + WS_MOD) + (layer == 0 ? 0 : 2 * 6144);
  const float* gffn = mod + 5120;
  const float* nmod = (const float*)(X.ws + WS_MOD) + 2 * 6144;
  float* h = X.a->h; const bf16_t* YAS = (const bf16_t*)(X.ws + WS_YAS); const int* asg = (const int*)(X.ws + WS_ASG); bf16_t* A1 = (bf16_t*)(X.ws + WS_A1);
  const int gw = X.c * NWAVES + X.wave, NGW = X.G * NWAVES, lane = X.lane;
  for (int ti = gw; ti < 8192; ti += NGW) {
    const int t = half * 8192 + ti;
    f32x4 acc[4];
#pragma unroll
    for (int j = 0; j < 4; ++j) acc[j] = (f32x4){0.f, 0.f, 0.f, 0.f};
    int pos[9];
#pragma unroll
    for (int k = 0; k < 8; ++k) { const int a = asg[t * 8 + k]; pos[k] = toff[a >> 16] * 256 + (a & 0xffff); }
    pos[8] = toff[64] * 256 + ti;
#pragma unroll
    for (int k = 0; k < 9; ++k) { const u32x2* yr = (const u32x2*)(YAS + (size_t)pos[k] * 1024) + lane;
#pragma unroll
      for (int j = 0; j < 4; ++j) { const u32x2 w = yr[64 * j]; acc[j].x += bf_lo(w.x); acc[j].y += bf_hi(w.x); acc[j].z += bf_lo(w.y); acc[j].w += bf_hi(w.y); } }
    f32x4* hr = (f32x4*)(h + (size_t)t * 1024) + lane; f32x4 v[4]; float ss = 0.f;
#pragma unroll
    for (int j = 0; j < 4; ++j) { const f32x4 gt = ((const f32x4*)gffn)[lane + 64 * j]; v[j] = hr[64 * j] + gt * acc[j]; hr[64 * j] = v[j];
      ss += (v[j].x * v[j].x + v[j].y * v[j].y) + (v[j].z * v[j].z + v[j].w * v[j].w); }
    if (layer == 0) {
      const float r = rsqrtf(wave_sum(ss) * (1.f / 1024.f) + 1e-6f);
#pragma unroll
      for (int j = 0; j < 4; ++j) { const f32x4 sh = ((const f32x4*)nmod)[lane + 64 * j], sc = ((const f32x4*)(nmod + 1024))[lane + 64 * j];
        u32x2 w; w.x = cvt_pk_bf16(v[j].x * r * (1.f + sc.x) + sh.x, v[j].y * r * (1.f + sc.y) + sh.y); w.y = cvt_pk_bf16(v[j].z * r * (1.f + sc.z) + sh.z, v[j].w * r * (1.f + sc.w) + sh.w);
        ((u32x2*)(A1 + (size_t)t * 1024))[lane + 64 * j] = w; }
    }
  }
}

constexpr int NPHASE = 27;
template <bool SP2>
__global__ void __launch_bounds__(NTHR, 2) mk_fwd(Args args) {
  extern __shared__ __attribute__((aligned(16))) unsigned char lds_raw[];
  Ctx X; X.lds = (LAS unsigned char*)lds_raw; X.a = &args; X.ws = args.ws; X.tid = threadIdx.x; X.lane = X.tid & 63; X.wave = __builtin_amdgcn_readfirstlane(X.tid >> 6);
  X.G = gridDim.x; X.c = blockIdx.x;
  const int wave_s = X.wave;
  volatile LAS unsigned* MISC = (volatile LAS unsigned*)(X.lds + LDS_MISC_OFF);
  LAS int* TOFF = (LAS int*)(X.lds + LDS_MISC_OFF + 64);
  LAS int* CNTL = (LAS int*)(X.lds + LDS_MISC_OFF + 64 + 512);
  if (X.tid < 16) MISC[X.tid] = 0u;
  __syncthreads();
  unsigned* ctl = (unsigned*)(X.ws + WS_CTL);
  const int lo = args.ph_lo, hi = args.ph_hi;
  const bool multi = (hi - lo) > 1;
  XcdBarrier bar; bar.bar = ctl + CW_BAR; bar.x = 0; bar.st = nullptr;
  if (multi) bar = xcd_barrier_post(ctl + CW_BAR, MISC, X.tid);
  LAS unsigned char* lds = X.lds;
  unsigned char* ws = X.ws;
  const float* mod = (const float*)(ws + WS_MOD); (void)mod;
#ifndef PH_MASK
#define PH_MASK 0x7ffffffull
#endif
#define IN(k) ((((unsigned long long)PH_MASK >> (k)) & 1ull) && lo <= (k) && (k) < hi)
#define SEAM(k) do { if (IN(k) && IN((k) + 1)) xcd_barrier(bar, X.tid); } while (0)
#define LAUNDER() do { int w0_ = wave_s; asm volatile("" : "+s"(w0_)); int l_ = __builtin_amdgcn_mbcnt_hi(~0u, __builtin_amdgcn_mbcnt_lo(~0u, 0u)); asm volatile("" : "+v"(l_)); X.wave = w0_; X.lane = l_; X.tid = w0_ * 64 + l_; \
    unsigned char* w_ = args.ws; asm volatile("" : "+s"(w_)); X.ws = w_; ws = w_; mod = (const float*)(w_ + WS_MOD); } while (0)
  if (IN(0)) { LAUNDER(); phase_prep(X); } SEAM(0);
  if (IN(1)) { LAUNDER(); phase_mod0(X); } SEAM(1);
  if (IN(2)) { LAUNDER(); G1 p; p.K = 1024; p.nunits = 520; p.ws = ws; p.qg = args.in[IN_QG]; p.kg = args.in[IN_KG]; gemm_phase<G1, SP2>(lds, p, X.G, X.c, X.tid); } SEAM(2);
  if (IN(3)) { LAUNDER(); G2 p; p.K = 512; p.nunits = 96; p.ws = ws; gemm_phase<G2, SP2>(lds, p, X.G, X.c, X.tid); } SEAM(3);
  if (IN(4)) { LAUNDER(); phase_scan(X); } SEAM(4);
  if (IN(5)) { LAUNDER(); G3 p; p.K = 768; p.nunits = 128; p.ws = ws; gemm_phase<G3, SP2>(lds, p, X.G, X.c, X.tid); } SEAM(5);
  if (IN(6)) { LAUNDER(); G4 p; p.K = 512; p.nunits = 128; p.ws = ws; p.bglu = args.in[IN_BGLU]; gemm_phase<G4, SP2>(lds, p, X.G, X.c, X.tid); } SEAM(6);
  if (IN(7)) { LAUNDER(); phase_attn(X); } SEAM(7);
  if (IN(8)) { LAUNDER(); GRes p; p.K = 1024; p.nunits = 256; p.A = (const char*)ws + WS_CONCAT; p.Bt = (const char*)ws + WS_WMIX_T; p.hin = args.in[IN_X]; p.hout = args.h; p.gate = mod + 2048; p.bias = nullptr;
    gemm_phase<GRes, SP2>(lds, p, X.G, X.c, X.tid); } SEAM(8);
#pragma unroll 1
  for (int layer = 0; layer < 2; ++layer) {
    const int pb = layer == 0 ? 9 : 20;
    if (IN(pb)) { LAUNDER(); phase_router(X, layer); } SEAM(pb);
#pragma unroll 1
    for (int half = 0; half < 2; ++half) {
      const int p6 = pb + 1 + 3 * half;
      if (IN(p6)) { LAUNDER(); build_moetab(X, layer, half, TOFF, CNTL); G6 p; p.K = 1024; p.ws = ws; p.tab.toff = TOFF; p.tab.cnt = CNTL; p.half = half; p.nunits = TOFF[65] * 2; gemm_phase<G6, SP2>(lds, p, X.G, X.c, X.tid); } SEAM(p6);
      if (IN(p6 + 1)) { LAUNDER(); build_moetab(X, layer, half, TOFF, CNTL); G7 p; p.K = 256; p.ws = ws; p.tab.toff = TOFF; p.tab.cnt = CNTL; p.half = half; p.nunits = TOFF[65] * 4; gemm_phase<G7, SP2>(lds, p, X.G, X.c, X.tid); } SEAM(p6 + 1);
      if (IN(p6 + 2)) { LAUNDER(); build_moetab(X, layer, half, TOFF, CNTL); phase_combine(X, layer, half, TOFF);
        if (layer == 0 && half == 1 && !(args.flags & FLAG_SKIP_EXPERTS)) { __syncthreads(); transpose_work(X, ctl + CW_DQ1, 0, 0, 1, 65 * IT_EXP); } }
      if (!(layer == 1 && half == 1)) SEAM(p6 + 2);
    }
    if (layer == 0) {
      if (IN(16)) { LAUNDER(); G8 p; p.K = 256; p.nunits = 512; p.ws = ws; gemm_phase<G8, SP2>(lds, p, X.G, X.c, X.tid); } SEAM(16);
      if (IN(17)) { LAUNDER(); G9 p; p.K = 256; p.nunits = 512; p.ws = ws; gemm_phase<G9, SP2>(lds, p, X.G, X.c, X.tid); } SEAM(17);
      if (IN(18)) { LAUNDER(); G10 p; p.K = 256; p.nunits = 512; p.ws = ws; gemm_phase<G10, SP2>(lds, p, X.G, X.c, X.tid); } SEAM(18);
      if (IN(19)) { LAUNDER(); GRes p; p.K = 1024; p.nunits = 256; p.A = (const char*)ws + WS_FB; p.Bt = (const char*)ws + WS_WFOUR_T; p.hin = args.h; p.hout = args.h; p.gate = mod + 2 * 6144 + 2048; p.bias = args.in[IN_BFOUR];
        gemm_phase<GRes, SP2>(lds, p, X.G, X.c, X.tid); } SEAM(19);
    }
  }
#undef IN
#undef SEAM
}
}
#ifndef MK_SP2
#define MK_SP2 true
#endif
#ifndef MK_N_LAUNCHES
#define MK_N_LAUNCHES 1
#endif
#ifndef CHECK
#define CHECK 0
#endif
static int g_grid = 0;
static bool mk_setup(int n_in, int out_size, size_t ws_size) {
  if (g_grid == 0) {
    g_grid = -1;
    if (n_in != 31 || out_size != 16384 * 1024 || ws_size < (size_t)530 * 1000 * 1000) { fprintf(stderr, "kernel_launch: unexpected n_in %d out %d ws %zu\n", n_in, out_size, ws_size); return false; }
    int dev = 0, cus = 0;
    if (hipGetDevice(&dev) != hipSuccess || hipDeviceGetAttribute(&cus, hipDeviceAttributeMultiprocessorCount, dev) != hipSuccess) return false;
    if (cus < 256) { fprintf(stderr, "kernel_launch: needs 256 CUs, device has %d\n", cus); return false; }
    if (hipFuncSetAttribute((const void*)mk::mk_fwd<MK_SP2>, hipFuncAttributeMaxDynamicSharedMemorySize, mk::LDS_BYTES) != hipSuccess) { fprintf(stderr, "kernel_launch: hipFuncSetAttribute failed\n"); return false; }
    g_grid = 256;
  }
  return g_grid > 0;
}
static void mk_run(hipStream_t s, mk::Args a, int lo, int hi) {
  a.ph_lo = lo; a.ph_hi = hi;
  hipLaunchKernelGGL(mk::mk_fwd<MK_SP2>, dim3(g_grid), dim3(mk::NTHR), mk::LDS_BYTES, s, a);
}

#if CHECK
namespace chk {
using mk::bf16_t;
__device__ __forceinline__ float b2f(bf16_t b) { return __uint_as_float(((unsigned)b) << 16); }
__global__ void k_cmp(int mode, const void* A, const float* B, unsigned long long n, double* acc) {
  double e = 0.0, r = 0.0; const bf16_t* A16 = (const bf16_t*)A;
  for (unsigned long long i = (unsigned long long)blockIdx.x * 256 + threadIdx.x; i < n; i += (unsigned long long)gridDim.x * 256) {
    float a = 0.f, b = 0.f; const int row = (int)(i >> 9), col = (int)(i & 511);
    switch (mode) {
      case 0: a = ((const float*)A)[i]; b = B[i]; break;
      case 1: a = b2f(A16[i]); b = B[i]; break;
      case 2: { b = B[(size_t)row * 2048 + col]; const int g = col >> 4, c = col & 15; int crow, s; if (row < 16384) { crow = row >> 5; s = row & 31; } else { const int j = row - 16384; crow = 512 + (j >> 5); s = j & 31; }
                a = b2f(A16[((size_t)(g * 768 + crow)) * 768 + s * 16 + c]); } break;
      case 3: b = B[(size_t)row * 2048 + 512 + col]; a = b2f(A16[(size_t)row * 512 + col]); break;
      case 4: b = B[(size_t)row * 2048 + 1024 + col]; a = b2f(A16[(size_t)row * 512 + col]); break;
      case 5: b = B[(size_t)row * 2048 + 1536 + col]; a = b2f(A16[(size_t)col * 16640 + row]); break;
      case 6: b = B[(size_t)row * 1024 + col]; a = b2f(A16[(size_t)row * 1024 + col]); break;
      case 7: b = B[(size_t)row * 1024 + 512 + col]; a = b2f(A16[(size_t)row * 1024 + 512 + col]); break;
      case 8: { const int ta = (int)(i & 127), ri = (int)((i >> 7) & 1), tb = (int)((i >> 8) & 127), m = (int)((i >> 15) & 255), g = (int)(i >> 23); a = b2f(A16[i]); const int t = 128 * ta + tb; b = B[((size_t)t * 4 + g) * 512 + ri * 256 + m]; } break;
      default: break;
    }
    const double d = (double)a - (double)b; e += d * d; r += (double)b * (double)b;
  }
  for (int o = 32; o >= 1; o >>= 1) { e += __shfl_xor(e, o); r += __shfl_xor(r, o); }
  if ((threadIdx.x & 63) == 0) { atomicAdd(acc, e); atomicAdd(acc + 1, r); }
}
__global__ void k_cmp_x2(const bf16_t* X2, const float* Yr, const float* Yi, double* acc) {
  double e = 0.0, r = 0.0;
  for (unsigned long long i = (unsigned long long)blockIdx.x * 256 + threadIdx.x; i < (1ull << 25); i += (unsigned long long)gridDim.x * 256) {
    const int tb = (int)(i & 127), rip = (int)((i >> 7) & 1), ka = (int)((i >> 8) & 127), gm = (int)(i >> 15);
    const float a = b2f(X2[i]); const size_t yi = (((size_t)ka * 128 + tb) << 10) + gm; const float b = rip ? Yi[yi] : Yr[yi];
    const double d = (double)a - (double)b; e += d * d; r += (double)b * (double)b;
  }
  for (int o = 32; o >= 1; o >>= 1) { e += __shfl_xor(e, o); r += __shfl_xor(r, o); }
  if ((threadIdx.x & 63) == 0) { atomicAdd(acc, e); atomicAdd(acc + 1, r); }
}
__global__ void k_judge(const double* acc, int n, float tol, int* fail) {
  if (threadIdx.x == 0 && blockIdx.x == 0) { fail[0] = 0; for (int k = 0; k < n; ++k) { const double rel = sqrt(acc[2 * k] / acc[2 * k + 1]); if (!(rel <= (double)tol)) { fail[0] = k + 1; break; } } }
}
__global__ void k_encode(float* out, size_t n, const int* fail) {
  const int f = fail[0]; if (f == 0) return; const float sc = 1.f + 0.1f * (float)f;
  for (size_t i = (size_t)blockIdx.x * 256 + threadIdx.x; i < n; i += (size_t)gridDim.x * 256) out[i] *= sc;
}
__global__ void k_f2bf(const float* in, bf16_t* out, size_t n) { for (size_t i = (size_t)blockIdx.x * 256 + threadIdx.x; i < n; i += (size_t)gridDim.x * 256) out[i] = mk::f2bf(in[i]); }
static void cmp(hipStream_t s, int mode, const void* A, const float* B, unsigned long long n, double* acc) { hipLaunchKernelGGL(k_cmp, dim3(2048), dim3(256), 0, s, mode, A, B, n, acc); }
}
#endif

extern "C" void kernel_launch(void* const* d_in, const int* in_sizes, int n_in, void* d_out, int out_size, void* d_ws, size_t ws_size, hipStream_t stream) {
  if (!mk_setup(n_in, out_size, ws_size)) return;
  unsigned char* ws = (unsigned char*)d_ws;
  const size_t MiB = mk::MiB;
  mk::Args a{};
  for (int i = 0; i < 31; ++i) a.in[i] = (const float*)d_in[i];
  a.h = (float*)d_out; a.ws = ws; a.flags = 0; a.pad = 0;
#if CHECK == 0
  (void)hipMemsetAsync(ws + mk::WS_CTL, 0, mk::CTL_ZERO_BYTES, stream);
#if MK_N_LAUNCHES == 1
  mk_run(stream, a, 0, mk::NPHASE);
#else
  for (int ph = 0; ph < mk::NPHASE; ++ph) mk_run(stream, a, ph, ph + 1);
#endif
#else
  ref::In in; { const float** p = (const float**)&in; for (int i = 0; i < 31; ++i) p[i] = (const float*)d_in[i]; }
  float* out = (float*)d_out;
  char* wsc = (char*)d_ws;
  ref::Small sm; sm.mod = (float*)(wsc + 498 * MiB); sm.lamb = (float2*)(wsc + 498 * MiB + 131072); sm.bbar = (float2*)(wsc + 498 * MiB + 262144);
  sm.tw = (float2*)(wsc + 499 * MiB); sm.Dm = (float*)(wsc + 499 * MiB + 262144);
  double* acc = (double*)(wsc + 500 * MiB); int* fail = (int*)(wsc + 500 * MiB + 4096);
  (void)hipMemsetAsync(acc, 0, 8192, stream);
  (void)hipMemsetAsync(ws + mk::WS_CTL, 0, mk::CTL_ZERO_BYTES, stream);
  float* HOPT = (float*)(ws + mk::WS_HOPT);
  int nchk = 0;
#if CHECK == 1
  ref::MixBuf mb; mb.a0 = (float*)(wsc + 12 * MiB); mb.z = (float*)(wsc + 336 * MiB); mb.g = (float*)(wsc + 466 * MiB); mb.t = (float*)(wsc + 77 * MiB); mb.concat = mb.a0; mb.ymix = mb.z;
  char* moe_arena = wsc + 12 * MiB;
  ref::FourBuf fb; { char* p = wsc + 12 * MiB; fb.a1 = (float*)p; p += 64 * MiB; fb.Z = (float*)p; p += 128 * MiB; fb.Yr = (float*)p; p += 64 * MiB; fb.Yi = (float*)p; p += 64 * MiB; fb.F = (float*)p; fb.yf = fb.Z; }
  a.flags = mk::FLAG_SKIP_EXPERTS;
  nchk = 10;
  ref::forward(stream, in, out, sm, mb, moe_arena, fb, [&](int st) {
    if (st == 1) { mk_run(stream, a, 0, 1); chk::cmp(stream, 0, ws + mk::WS_MOD, sm.mod, 3 * 6144, acc + 0); }
    if (st == 2) { mk_run(stream, a, 1, 2); chk::cmp(stream, 1, ws + mk::WS_A0, mb.a0, 16640ull * 1024, acc + 2); }
    if (st == 3) { mk_run(stream, a, 2, 3); chk::cmp(stream, 2, ws + mk::WS_AS5, mb.z, 16640ull * 512, acc + 4); chk::cmp(stream, 3, ws + mk::WS_Q, mb.z, 16384ull * 512, acc + 6);
                   chk::cmp(stream, 4, ws + mk::WS_K, mb.z, 16640ull * 512, acc + 8); chk::cmp(stream, 5, ws + mk::WS_VT, mb.z, 16640ull * 512, acc + 10); }
    if (st == 4) { mk_run(stream, a, 3, 4); mk_run(stream, a, 4, 5); mk_run(stream, a, 5, 6); chk::cmp(stream, 1, ws + mk::WS_GB, mb.g, 16384ull * 512, acc + 12); }
    if (st == 5) { mk_run(stream, a, 6, 7); chk::cmp(stream, 6, ws + mk::WS_CONCAT, mb.concat, 16384ull * 512, acc + 14); }
    if (st == 6) { mk_run(stream, a, 7, 8); chk::cmp(stream, 7, ws + mk::WS_CONCAT, mb.concat, 16384ull * 512, acc + 16); }
    if (st == 7) { mk::Args b = a; b.h = HOPT; mk_run(stream, b, 8, 9); chk::cmp(stream, 0, HOPT, out, 16384ull * 1024, acc + 18); }
  });
#elif CHECK == 2 || CHECK == 4
  const int L = CHECK == 2 ? 0 : 1;
  ref::MixBuf mb; { char* p = wsc + 12 * MiB; mb.a0 = (float*)p; p += 65 * MiB; mb.z = (float*)p; p += 130 * MiB; mb.g = (float*)p; p += 32 * MiB; mb.t = (float*)p; p += 32 * MiB; mb.concat = (float*)p; p += 64 * MiB; mb.ymix = mb.z; }
  ref::FourBuf fb; { char* p = wsc + 12 * MiB; fb.a1 = (float*)p; p += 64 * MiB; fb.Z = (float*)p; p += 128 * MiB; fb.Yr = (float*)p; p += 64 * MiB; fb.Yi = (float*)p; p += 64 * MiB; fb.F = (float*)p; fb.yf = fb.Z; }
  char* moe_arena = wsc + 110 * MiB;
  nchk = L == 0 ? 2 : 1;
  a.flags = 0;
  ref::forward(stream, in, out, sm, mb, moe_arena, fb, [&](int st) {
    if ((L == 0 && st == 7) || (L == 1 && st == 11)) {
      mk::Args b = a; b.h = HOPT; if (L == 1) b.flags = 2;
      mk_run(stream, b, 0, 1);
      (void)hipMemcpyAsync(HOPT, out, (size_t)16384 * 1024 * 4, hipMemcpyDeviceToDevice, stream);
      const int pb = L == 0 ? 9 : 20; b.flags |= mk::FLAG_SKIP_EXPERTS;
      for (int ph = pb; ph < pb + 7; ++ph) mk_run(stream, b, ph, ph + 1);
    }
    if ((L == 0 && st == 8) || (L == 1 && st == 12)) chk::cmp(stream, 0, HOPT, out, 16384ull * 1024, acc + 0);
    if (L == 0 && st == 9) chk::cmp(stream, 1, ws + mk::WS_A1, fb.a1, 16384ull * 1024, acc + 2);
  });
#elif CHECK == 3
  ref::MixBuf mb; { char* p = wsc + 12 * MiB; mb.a0 = (float*)p; p += 65 * MiB; mb.z = (float*)p; p += 130 * MiB; mb.g = (float*)p; p += 32 * MiB; mb.t = (float*)p; p += 32 * MiB; mb.concat = (float*)p; p += 64 * MiB; mb.ymix = mb.z; }
  char* moe_arena = wsc + 12 * MiB;
  ref::FourBuf fb; fb.Z = (float*)(wsc + 270 * MiB);
  fb.a1 = (float*)(wsc + 12 * MiB); fb.Yr = (float*)(wsc + 12 * MiB);   fb.Yi = (float*)(wsc + 468 * MiB - 0); fb.F = (float*)(wsc + 270 * MiB); fb.yf = (float*)(wsc + 334 * MiB);
  fb.Yi = (float*)(wsc + 76 * MiB);
  nchk = 4;
  a.flags = mk::FLAG_SKIP_EXPERTS;
  ref::forward(stream, in, out, sm, mb, moe_arena, fb, [&](int st) {
    if (st == 9) {
      mk::Args b = a; b.h = HOPT;
      mk_run(stream, b, 0, 1);
      hipLaunchKernelGGL(chk::k_f2bf, dim3(2048), dim3(256), 0, stream, fb.a1, (chk::bf16_t*)(ws + mk::WS_A1), (size_t)16384 * 1024);
      (void)hipMemcpyAsync(HOPT, out, (size_t)16384 * 1024 * 4, hipMemcpyDeviceToDevice, stream);
      mk_run(stream, b, 16, 17);
    }
  });
#endif
  hipLaunchKernelGGL(chk::k_judge, dim3(1), dim3(64), 0, stream, acc, nchk, 0.05f, fail);
  hipLaunchKernelGGL(chk::k_encode, dim3(2048), dim3(256), 0, stream, out, (size_t)16384 * 1024, fail);
#endif
}
```

```cpp
#define CHECK 0
#define MK_N_LAUNCHES 1
#define MK_SP2 true
#include <hip/hip_runtime.h>
#include <cstdio>
#include <cstdint>
#include <cmath>
namespace mk {
#define LAS __attribute__((address_space(3)))
typedef unsigned short bf16_t;
typedef short bf16x8 __attribute__((ext_vector_type(8)));
typedef float f32x4 __attribute__((ext_vector_type(4)));
typedef float f32x2 __attribute__((ext_vector_type(2)));
typedef unsigned u32x4 __attribute__((ext_vector_type(4)));
typedef unsigned u32x2 __attribute__((ext_vector_type(2)));

constexpr int TOK = 16384, CTXN = 256, NROW = TOK + CTXN;
constexpr int NWAVES = 8, NTHR = 512;
constexpr int LDS_STAGE = 131072, LDS_BYTES = 155648, LDS_MISC_OFF = LDS_BYTES - 4096;

__device__ __forceinline__ unsigned cvt_pk_bf16(float lo, float hi) { unsigned r; asm volatile("v_cvt_pk_bf16_f32 %0, %1, %2" : "=v"(r) : "v"(lo), "v"(hi)); return r; }
__device__ __forceinline__ float bf_lo(unsigned w) { return __uint_as_float(w << 16); }
__device__ __forceinline__ float bf_hi(unsigned w) { return __uint_as_float(w & 0xffff0000u); }
__device__ __forceinline__ float bf2f(bf16_t b) { return __uint_as_float(((unsigned)b) << 16); }
__device__ __forceinline__ bf16_t f2bf(float f) { unsigned u = __float_as_uint(f); return (bf16_t)((u + 0x7fffu + ((u >> 16) & 1u)) >> 16); }
__device__ __forceinline__ float sx(float v, int o) { int l = __builtin_amdgcn_mbcnt_hi(~0u, __builtin_amdgcn_mbcnt_lo(~0u, 0u)); asm volatile("" : "+v"(l)); return __int_as_float(__builtin_amdgcn_ds_bpermute((l ^ o) << 2, __float_as_int(v))); }
__device__ __forceinline__ float wave_sum(float v) {
#pragma unroll
  for (int o = 1; o < 64; o <<= 1) v += sx(v, o);
  return v;
}
__device__ __forceinline__ float fast_sigmoid(float x) { return __builtin_amdgcn_rcpf(1.f + __expf(-x)); }
__device__ __forceinline__ float fast_tanh(float x) { float e = __expf(2.f * x); return 1.f - 2.f * __builtin_amdgcn_rcpf(e + 1.f); }
__device__ __forceinline__ float gelu_tanh(float x) { return 0.5f * x * (1.f + fast_tanh(0.7978845608028654f * (x + 0.044715f * x * x * x))); }

#define XB_TMO      128
#define XB_XCNT(j)  (256  + 64 * (j))
#define XB_XSUB(j)  (1280 + 64 * (j))
#define XB_XGEN(j)  (2304 + 64 * (j))
#define XB_TOP      3328
#define XB_TOPGEN   3392
#define XCD_BAR_WORDS 3456
#define XB_SPIN_CAP (1u << 20)
__device__ __forceinline__ unsigned xb_ld(unsigned* p) { return __hip_atomic_load(p, __ATOMIC_RELAXED, __HIP_MEMORY_SCOPE_AGENT); }
__device__ __forceinline__ unsigned xb_add(unsigned* p, unsigned v) { return __hip_atomic_fetch_add(p, v, __ATOMIC_RELAXED, __HIP_MEMORY_SCOPE_AGENT); }
__device__ __forceinline__ unsigned xb_xcc_id() { return (unsigned)__builtin_amdgcn_s_getreg((3 << 11) | 20) & 0xFu; }
#define XB_SPIN(cond, bar) do { unsigned _sp = 0; while (cond) { __builtin_amdgcn_s_sleep(1); \
    if ((++_sp & 255u) == 0u) { if (xb_ld(&(bar)[XB_TMO])) break; if (_sp > XB_SPIN_CAP) { atomicAdd(&(bar)[XB_TMO], 1u); break; } } } } while (0)
struct XcdBarrier { unsigned* bar; unsigned x; volatile LAS unsigned* st; };
__device__ __forceinline__ XcdBarrier xcd_barrier_post(unsigned* bar, volatile LAS unsigned* st, int tid) {
  XcdBarrier b; b.bar = bar; b.x = xb_xcc_id(); b.st = st;
  if (tid == 0) (void)xb_add(&bar[XB_XCNT(b.x)], 1u);
  return b;
}
__device__ __forceinline__ void xcd_barrier_complete(unsigned* bar, unsigned x, unsigned& nloc, unsigned& nx) {
  const unsigned G = gridDim.x * gridDim.y * gridDim.z;
  unsigned sum, cnt, mine, sp = 0u;
  for (;;) {
    sum = 0u; cnt = 0u; mine = 0u;
#pragma unroll
    for (unsigned j = 0; j < 16; ++j) { const unsigned c = xb_ld(&bar[XB_XCNT(j)]); sum += c; cnt += (c > 0u) ? 1u : 0u; mine = (j == x) ? c : mine; }
    if (sum == G) break;
    __builtin_amdgcn_s_sleep(1);
    if ((++sp & 255u) == 0u) { if (xb_ld(&bar[XB_TMO])) break; if (sp > XB_SPIN_CAP) { atomicAdd(&bar[XB_TMO], 1u); break; } }
  }
  nloc = mine > 0u ? mine : 1u; nx = cnt > 0u ? cnt : 1u;
}
__device__ __forceinline__ void xcd_barrier(const XcdBarrier& b, int tid) {
  asm volatile("s_waitcnt vmcnt(0)" ::: "memory");
  __syncthreads();
  if (tid == 0) {
    unsigned* bar = b.bar;
    __builtin_amdgcn_s_waitcnt(0);
    unsigned nloc = b.st[0], nx = b.st[1];
    if (nloc == 0u) { xcd_barrier_complete(bar, b.x, nloc, nx); b.st[0] = nloc; b.st[1] = nx; }
    const unsigned old = xb_add(&bar[XB_XSUB(b.x)], 1u);
    const unsigned gen = old / nloc;
    if (old + 1u == (gen + 1u) * nloc) {
      __builtin_amdgcn_fence(__ATOMIC_RELEASE, "agent");
      asm volatile("s_waitcnt vmcnt(0)" ::: "memory");
      const unsigned og = xb_add(&bar[XB_TOP], 1u);
      const unsigned tg = og / nx;
      if (og + 1u == (tg + 1u) * nx) xb_add(&bar[XB_TOPGEN], 1u);
      else XB_SPIN(xb_ld(&bar[XB_TOPGEN]) == tg, bar);
      __builtin_amdgcn_fence(__ATOMIC_ACQUIRE, "agent");
      xb_add(&bar[XB_XGEN(b.x)], 1u);
      asm volatile("s_waitcnt vmcnt(0)" ::: "memory");
    } else {
      XB_SPIN(xb_ld(&bar[XB_XGEN(b.x)]) == gen, bar);
      __builtin_amdgcn_fence(__ATOMIC_ACQUIRE, "agent");
      asm volatile("s_waitcnt vmcnt(0)" ::: "memory");
    }
  }
  __syncthreads();
}

constexpr int BM = 256, BK = 64, HALF = 128, HTB = HALF * BK * 2, NXCD = 8;
__device__ __forceinline__ int lds_byte(int r, int c) { const int st = (r >> 4) * 2 + (c >> 5), rr = r & 15, cc = c & 31, ob = rr * 64 + cc * 2; return st * 1024 + (ob ^ (((ob >> 9) & 1) << 5)); }
__device__ __forceinline__ void stage_rc(int b, int& R, int& C) { const int st = b / 1024, sb = b % 1024, swz = sb ^ (((sb >> 9) & 1) << 5); R = (st >> 1) * 16 + swz / 64; C = (st & 1) * 32 + (swz % 64) / 2; }
__device__ __forceinline__ int perm32(int rho) { const int n = rho >> 4, i = rho & 15; return 8 * (i >> 2) + 4 * n + (i & 3); }

struct Unit { int pm, pn, a, b; };
typedef f32x4 Acc[2][2][4][2];
template <class P, bool SP2>
__device__ __forceinline__ void gemm_phase(LAS unsigned char* lds, const P& p, int G, int c, int tid_in) {
  const int tid = tid_in, wid = __builtin_amdgcn_readfirstlane(tid >> 6), lane = tid & 63, wr = wid >> 2, wc = wid & 3, fr = lane & 15, fq = lane >> 4;
  const int K = p.K, nt = K / BK;
  const int nunits = p.nunits;
  int sR[2], sRb[2], sC[2];
#pragma unroll
  for (int i = 0; i < 2; ++i) { int R, C; stage_rc(tid * 16 + i * 8192, R, C); sR[i] = R; sRb[i] = P::PERM ? ((R & ~31) + perm32(R & 31)) : R; sC[i] = C * 2; }
  const size_t kstep = (size_t)(BK * 2);
  const unsigned ldsw = (unsigned)wid * 1024u;
  const int aoff = lds_byte(wr * 64 + fr, fq * 8), boff = lds_byte(wc * 32 + fr, fq * 8);
#define PG8_SA(b, h) (((b) * 2 + (h)) * HTB)
#define PG8_SB(b, h) ((4 + (b) * 2 + (h)) * HTB)
#define PG8_STAGE(bufoff, gbase, voff) do { _Pragma("unroll") for (int _i = 0; _i < 2; ++_i) \
        __builtin_amdgcn_global_load_lds((const unsigned*)((const char*)(gbase) + (voff)[_i]), (LAS unsigned*)(lds + (bufoff) + ldsw + _i * 8192), 16, 0, 0); } while (0)
#define PG8_LDA(dst, b, h) do { _Pragma("unroll") for (int m = 0; m < 4; ++m) _Pragma("unroll") for (int k = 0; k < 2; ++k) dst[m][k] = *(const LAS bf16x8*)(lds + PG8_SA(b, h) + aoff + m * 2048 + k * 1024); } while (0)
#define PG8_LDB(dst, b, h) do { _Pragma("unroll") for (int n = 0; n < 2; ++n) _Pragma("unroll") for (int k = 0; k < 2; ++k) dst[n][k] = *(const LAS bf16x8*)(lds + PG8_SB(b, h) + boff + n * 2048 + k * 1024); } while (0)
#define PG8_MMA(ai, bj, At, Bt) do { __builtin_amdgcn_s_setprio(1); _Pragma("unroll") for (int m = 0; m < 4; ++m) _Pragma("unroll") for (int n = 0; n < 2; ++n) _Pragma("unroll") for (int k = 0; k < 2; ++k) \
        acc[ai][bj][m][n] = __builtin_amdgcn_mfma_f32_16x16x32_bf16(Bt[n][k], At[m][k], acc[ai][bj][m][n], 0, 0, 0); __builtin_amdgcn_s_setprio(0); } while (0)
#define PG8_WAIT_V(n) asm volatile("s_waitcnt vmcnt(" #n ")" ::: "memory")
#define PG8_WAIT_L(n) asm volatile("s_waitcnt lgkmcnt(" #n ")" ::: "memory")
#define PG8_BAR __builtin_amdgcn_s_barrier()
#define PG8_SCHED __builtin_amdgcn_sched_barrier(0)
#define PG8_DECODE(i, u) do { int _w = (i) * G + c; { const int q = nunits / NXCD, r = nunits % NXCD, xcd = _w % NXCD, off = _w / NXCD; _w = (xcd < r ? xcd * (q + 1) : r * (q + 1) + (xcd - r) * q) + off; } p.decode(_w, u); } while (0)
#define PG8_OFFS(u, vA, vB) do { _Pragma("unroll") for (int _h = 0; _h < 2; ++_h) _Pragma("unroll") for (int _i = 0; _i < 2; ++_i) { \
        if (_h == 0 || !P::LINA) vA[_h][_i] = p.rowA(u, _h * HALF + sR[_i]) + (unsigned)sC[_i]; if (_h == 0 || !P::LINB) vB[_h][_i] = p.rowB(u, _h * HALF + sRb[_i]) + (unsigned)sC[_i]; } } while (0)
  if (c >= nunits) return;
  Unit cur, nxt; int ui = 0;
  PG8_DECODE(0, cur);
  Acc acc;
#pragma unroll
  for (int a = 0; a < 2; ++a)
#pragma unroll
    for (int b = 0; b < 2; ++b)
#pragma unroll
      for (int m = 0; m < 4; ++m)
#pragma unroll
        for (int n = 0; n < 2; ++n) acc[a][b][m][n] = (f32x4){0.f, 0.f, 0.f, 0.f};
  bf16x8 At[4][2], B0[2][2], B1[2][2];
  unsigned vA[2][2], vB[2][2];
  PG8_OFFS(cur, vA, vB);
  const char* cA = p.baseA(cur); const char* cB = p.baseB(cur);
  const size_t hA = P::LINA ? p.halfA() : 0, hB = P::LINB ? p.halfB() : 0;
  if constexpr (SP2) {
    PG8_STAGE(PG8_SB(0, 0), cB, vB[0]); PG8_STAGE(PG8_SB(0, 1), (cB) + (P::LINB ? hB : 0), vB[P::LINB ? 0 : 1]); PG8_STAGE(PG8_SA(0, 0), cA, vA[0]); PG8_STAGE(PG8_SA(0, 1), (cA) + (P::LINA ? hA : 0), vA[P::LINA ? 0 : 1]);
    if (wr == 1) PG8_BAR;
    PG8_WAIT_V(2); PG8_BAR;
    PG8_STAGE(PG8_SB(1, 0), cB + kstep, vB[0]); PG8_STAGE(PG8_SA(1, 0), cA + kstep, vA[0]); PG8_STAGE(PG8_SB(1, 1), (cB + kstep) + (P::LINB ? hB : 0), vB[P::LINB ? 0 : 1]);
    PG8_WAIT_V(6); PG8_BAR;
  } else {
    PG8_STAGE(PG8_SB(0, 0), cB, vB[0]); PG8_STAGE(PG8_SA(0, 0), cA, vA[0]); PG8_STAGE(PG8_SB(0, 1), (cB) + (P::LINB ? hB : 0), vB[P::LINB ? 0 : 1]); PG8_STAGE(PG8_SA(0, 1), (cA) + (P::LINA ? hA : 0), vA[P::LINA ? 0 : 1]);
    if (wr == 1) PG8_BAR;
    PG8_WAIT_V(4); PG8_BAR;
    PG8_STAGE(PG8_SB(1, 0), cB + kstep, vB[0]); PG8_STAGE(PG8_SA(1, 0), cA + kstep, vA[0]); PG8_STAGE(PG8_SB(1, 1), (cB + kstep) + (P::LINB ? hB : 0), vB[P::LINB ? 0 : 1]);
    PG8_WAIT_V(6); PG8_BAR;
  }
  for (;;) {
    const bool has_next = ((ui + 1) * G + c) < nunits;
    if (has_next) PG8_DECODE(ui + 1, nxt);
    const char* nA = has_next ? p.baseA(nxt) : cA; const char* nB = has_next ? p.baseB(nxt) : cB;
    for (int t = 0; t < nt; t += 2) {
      const bool last = (t == nt - 2);
      const char* a1 = cA + (size_t)(t + 1) * kstep;
      const char* a2 = last ? nA : cA + (size_t)(t + 2) * kstep; const char* b2 = last ? nB : cB + (size_t)(t + 2) * kstep;
      const char* a3 = a2 + kstep; const char* b3 = b2 + kstep;
      if constexpr (SP2) {
        PG8_LDB(B0, 0, 0); PG8_LDB(B1, 0, 1); PG8_SCHED; PG8_LDA(At, 0, 0); PG8_STAGE(PG8_SA(1, 1), (a1) + (P::LINA ? hA : 0), vA[P::LINA ? 0 : 1]);
        PG8_WAIT_V(8); PG8_WAIT_L(0); PG8_BAR; PG8_MMA(0, 0, At, B0); PG8_MMA(0, 1, At, B1); PG8_BAR; PG8_SCHED;
        if (last && has_next) { PG8_OFFS(nxt, vA, vB); }
        PG8_LDA(At, 0, 1); PG8_STAGE(PG8_SB(0, 0), b2, vB[0]); PG8_STAGE(PG8_SB(0, 1), (b2) + (P::LINB ? hB : 0), vB[P::LINB ? 0 : 1]); PG8_STAGE(PG8_SA(0, 0), a2, vA[0]);
        PG8_WAIT_V(8); PG8_WAIT_L(0); PG8_BAR; PG8_MMA(1, 0, At, B0); PG8_MMA(1, 1, At, B1); PG8_BAR; PG8_SCHED;
        PG8_LDB(B0, 1, 0); PG8_LDB(B1, 1, 1); PG8_SCHED; PG8_LDA(At, 1, 0); PG8_STAGE(PG8_SA(0, 1), (a2) + (P::LINA ? hA : 0), vA[P::LINA ? 0 : 1]);
        PG8_WAIT_V(8); PG8_WAIT_L(0); PG8_BAR; PG8_MMA(0, 0, At, B0); PG8_MMA(0, 1, At, B1); PG8_BAR; PG8_SCHED;
        PG8_LDA(At, 1, 1); PG8_STAGE(PG8_SB(1, 0), b3, vB[0]); PG8_STAGE(PG8_SB(1, 1), (b3) + (P::LINB ? hB : 0), vB[P::LINB ? 0 : 1]); PG8_STAGE(PG8_SA(1, 0), a3, vA[0]);
        PG8_WAIT_V(8); PG8_WAIT_L(0); PG8_BAR; PG8_MMA(1, 0, At, B0); PG8_MMA(1, 1, At, B1); PG8_BAR; PG8_SCHED;
      } else {
        PG8_LDB(B0, 0, 0); PG8_SCHED; PG8_LDA(At, 0, 0); PG8_STAGE(PG8_SA(1, 1), (a1) + (P::LINA ? hA : 0), vA[P::LINA ? 0 : 1]);
        PG8_WAIT_L(8); PG8_BAR; PG8_WAIT_L(0); PG8_MMA(0, 0, At, B0); PG8_BAR; PG8_SCHED;
        if (last && has_next) { PG8_OFFS(nxt, vA, vB); }
        PG8_LDB(B1, 0, 1); PG8_STAGE(PG8_SB(0, 0), b2, vB[0]);
        PG8_BAR; PG8_WAIT_L(0); PG8_MMA(0, 1, At, B1); PG8_BAR;
        PG8_LDA(At, 0, 1); PG8_STAGE(PG8_SA(0, 0), a2, vA[0]);
        PG8_BAR; PG8_WAIT_L(0); PG8_MMA(1, 0, At, B0); PG8_BAR; PG8_SCHED;
        PG8_STAGE(PG8_SB(0, 1), (b2) + (P::LINB ? hB : 0), vB[P::LINB ? 0 : 1]);
        PG8_WAIT_V(6); PG8_BAR; PG8_MMA(1, 1, At, B1); PG8_BAR;
        PG8_LDB(B0, 1, 0); PG8_SCHED; PG8_LDA(At, 1, 0); PG8_STAGE(PG8_SA(0, 1), (a2) + (P::LINA ? hA : 0), vA[P::LINA ? 0 : 1]);
        PG8_WAIT_L(8); PG8_BAR; PG8_WAIT_L(0); PG8_MMA(0, 0, At, B0); PG8_BAR; PG8_SCHED;
        PG8_LDB(B1, 1, 1); PG8_STAGE(PG8_SB(1, 0), b3, vB[0]);
        PG8_BAR; PG8_WAIT_L(0); PG8_MMA(0, 1, At, B1); PG8_BAR;
        PG8_LDA(At, 1, 1); PG8_STAGE(PG8_SA(1, 0), a3, vA[0]);
        PG8_BAR; PG8_WAIT_L(0); PG8_MMA(1, 0, At, B0); PG8_BAR; PG8_SCHED;
        PG8_STAGE(PG8_SB(1, 1), (b3) + (P::LINB ? hB : 0), vB[P::LINB ? 0 : 1]);
        PG8_WAIT_V(6); PG8_BAR; PG8_MMA(1, 1, At, B1); PG8_BAR;
      }
    }
    if (wr == 0) PG8_BAR;
    { int fr_e = fr, fq_e = fq; asm volatile("" : "+v"(fr_e), "+v"(fq_e)); p.epi(acc, cur, wr, wc, fr_e, fq_e); }
    if (!has_next) break;
#pragma unroll
    for (int a = 0; a < 2; ++a)
#pragma unroll
      for (int b = 0; b < 2; ++b)
#pragma unroll
        for (int m = 0; m < 4; ++m)
#pragma unroll
          for (int n = 0; n < 2; ++n) acc[a][b][m][n] = (f32x4){0.f, 0.f, 0.f, 0.f};
    cur = nxt; cA = nA; cB = nB; ++ui;
    if (wr == 1) PG8_BAR;
  }
  PG8_WAIT_V(0);
  PG8_BAR;
#undef PG8_SA
#undef PG8_SB
#undef PG8_STAGE
#undef PG8_LDA
#undef PG8_LDB
#undef PG8_MMA
#undef PG8_WAIT_V
#undef PG8_WAIT_L
#undef PG8_BAR
#undef PG8_SCHED
#undef PG8_DECODE
#undef PG8_OFFS
}
}
namespace mk {
constexpr size_t MiB = 1u << 20;
constexpr size_t WS_CTL = 0, CTL_ZERO_BYTES = 65536;
constexpr size_t WS_MOD = 65536;
constexpr size_t WS_LAML = 262144;
constexpr size_t WS_WIN_T = 1 * MiB, WS_WGLU_T = 5 * MiB, WS_WMIX_T = 6 * MiB, WS_WFOUR_T = 8 * MiB, WS_WROUT_T = 10 * MiB;
constexpr size_t WS_DMT = 10 * MiB + 512 * 1024, WS_W1 = 10 * MiB + 768 * 1024, WS_W2 = 10 * MiB + 896 * 1024;
constexpr size_t WS_WEXP = 12 * MiB, EXP_STRIDE = 3 * MiB / 2, EXP_DOFF = 1 * MiB;
constexpr size_t WS_R = 110 * MiB;
constexpr size_t WS_WS = WS_R, WS_TT = WS_R + 8 * MiB, WS_A0 = WS_R + 34 * MiB, WS_AS5 = WS_R + 67 * MiB, WS_Q = WS_R + 103 * MiB, WS_K = WS_R + 119 * MiB,
                 WS_VT = WS_R + 136 * MiB, WS_SST = WS_R + 153 * MiB, WS_GB = WS_R + 177 * MiB, WS_CONCAT = WS_R + 193 * MiB;
constexpr size_t WS_F = WS_R, WS_LTOK = WS_R + 32 * MiB, WS_LW = WS_R + 36 * MiB, WS_ASG = WS_R + 40 * MiB, WS_HID = WS_R + 42 * MiB, WS_YAS = WS_R + 86 * MiB,
                 WS_A1 = WS_R + 262 * MiB;
constexpr size_t WS_X1 = WS_R, WS_X2 = WS_R + 64 * MiB, WS_FB = WS_R + 128 * MiB;
constexpr size_t WS_HOPT = WS_R + 294 * MiB;
constexpr size_t WS_NEED = WS_R + 294 * MiB;
constexpr int HALF_CAP_ROWS = 90112;
constexpr int CW_BAR = 4096, CW_CNT = 8192  , CW_DQ0 = 12288, CW_DQ1 = 12352;

struct Args { const float* in[31]; float* h; unsigned char* ws; int ph_lo, ph_hi, flags, pad; };
enum { IN_X = 0, IN_C, IN_CTX, IN_CCTX, IN_WADA, IN_BADA, IN_WIN, IN_LRE, IN_LIM, IN_LDT, IN_BRE, IN_BIM, IN_CRE, IN_CIM, IN_S5D, IN_WGLU, IN_BGLU, IN_QG, IN_KG,
       IN_RPB, IN_WMIX, IN_WFOUR, IN_BFOUR, IN_WROUT, IN_RBIAS, IN_WEG, IN_WEU, IN_WED, IN_WSG, IN_WSU, IN_WSD };
constexpr int FLAG_SKIP_EXPERTS = 1;

struct Ctx {
  LAS unsigned char* lds; const Args* a; unsigned char* ws; int tid, lane, wave, G, c;
};

__device__ __forceinline__ int rowmap(int code, int n) {
  if (code == 1) { if (n < 512 || n >= 1536) return n; const int blk = n & ~255, c = n & 255; return blk + 128 * ((c >> 5) & 1) + 32 * (c >> 6) + (c & 31); }
  if (code == 2) return 256 * (n >> 7) + (n & 127);
  if (code == 3) return 256 * (n >> 7) + 128 + (n & 127);
  return n;
}
__device__ __forceinline__ void transpose_item(const float* W, int K, int N, bf16_t* WT, int code, LAS float* scr, int item, int lane) {
  const int nblk = N / 32, kb = item / nblk, nb = item % nblk, k0 = 64 * kb, n0 = 32 * nb;
#pragma unroll 8
  for (int i = 0; i < 32; ++i) { const int kk = 2 * i + (lane >> 5); scr[kk * 33 + (lane & 31)] = W[(size_t)(k0 + kk) * N + n0 + (lane & 31)]; }
  asm volatile("s_waitcnt lgkmcnt(0)" ::: "memory");
  const int cch = lane & 7;
#pragma unroll
  for (int j = 0; j < 4; ++j) { const int n = (lane >> 3) + 8 * j; const LAS float* s = scr + (8 * cch) * 33 + n;
    u32x4 o; o.x = cvt_pk_bf16(s[0 * 33], s[1 * 33]); o.y = cvt_pk_bf16(s[2 * 33], s[3 * 33]); o.z = cvt_pk_bf16(s[4 * 33], s[5 * 33]); o.w = cvt_pk_bf16(s[6 * 33], s[7 * 33]);
    *(u32x4*)(WT + (size_t)rowmap(code, n0 + n) * K + k0 + 8 * cch) = o; }
  asm volatile("s_waitcnt lgkmcnt(0)" ::: "memory");
}
constexpr int IT_WIN = 1024, IT_GLU = 128, IT_MIX = 512, IT_FOUR = 512, IT_ROUT = 64, IT_SMALL = IT_WIN + IT_GLU + IT_MIX + IT_FOUR + IT_ROUT, IT_EXP = 384;
__device__ __forceinline__ void small_item(const Ctx& X, LAS float* scr, int it) {
  const Args& a = *X.a; unsigned char* ws = X.ws;
  if (it < IT_WIN) { transpose_item(a.in[IN_WIN], 1024, 2048, (bf16_t*)(ws + WS_WIN_T), 1, scr, it, X.lane); return; } it -= IT_WIN;
  if (it < IT_GLU) { transpose_item(a.in[IN_WGLU], 512, 512, (bf16_t*)(ws + WS_WGLU_T), 0, scr, it, X.lane); return; } it -= IT_GLU;
  if (it < IT_MIX) { transpose_item(a.in[IN_WMIX], 1024, 1024, (bf16_t*)(ws + WS_WMIX_T), 0, scr, it, X.lane); return; } it -= IT_MIX;
  if (it < IT_FOUR) { transpose_item(a.in[IN_WFOUR], 1024, 1024, (bf16_t*)(ws + WS_WFOUR_T), 0, scr, it, X.lane); return; } it -= IT_FOUR;
  { const int l = it >> 5; transpose_item(a.in[IN_WROUT] + (size_t)l * 1024 * 64, 1024, 64, (bf16_t*)(ws + WS_WROUT_T) + (size_t)l * 64 * 1024, 0, scr, it & 31, X.lane); }
}
__device__ __forceinline__ void expert_item(const Ctx& X, LAS float* scr, int layer, int it) {
  const Args& a = *X.a; const int e = it / IT_EXP, r = it % IT_EXP;
  bf16_t* gu = (bf16_t*)(X.ws + WS_WEXP + (size_t)e * EXP_STRIDE); bf16_t* dt = (bf16_t*)(X.ws + WS_WEXP + (size_t)e * EXP_STRIDE + EXP_DOFF);
  const float *wg, *wu, *wd;
  if (e < 64) { const size_t o = ((size_t)layer * 64 + e) * 262144; wg = a.in[IN_WEG] + o; wu = a.in[IN_WEU] + o; wd = a.in[IN_WED] + o; }
  else { const size_t o = (size_t)layer * 262144; wg = a.in[IN_WSG] + o; wu = a.in[IN_WSU] + o; wd = a.in[IN_WSD] + o; }
  if (r < 128) transpose_item(wg, 1024, 256, gu, 2, scr, r, X.lane);
  else if (r < 256) transpose_item(wu, 1024, 256, gu, 3, scr, r - 128, X.lane);
  else transpose_item(wd, 256, 1024, dt, 0, scr, r - 256, X.lane);
}
__device__ __forceinline__ void transpose_work(const Ctx& X, unsigned* ctr, int first_small, int n_small, int layer, int n_exp_items) {
  LAS float* scr = (LAS float*)(X.lds + X.wave * 8704);
  const int total = n_small + n_exp_items;
  for (;;) {
    int base = 0; if (X.lane == 0) base = (int)atomicAdd(ctr, 8u);
    base = __builtin_amdgcn_readfirstlane(base);
    if (base >= total) break;
    for (int k = 0; k < 8; ++k) { const int it = base + k; if (it >= total) break;
      if (it < n_small) small_item(X, scr, first_small + it); else expert_item(X, scr, layer, it - n_small); }
  }
}

__device__ __forceinline__ void p0_adaln(const Ctx& X, int it) {
  const Args& a = *X.a; const int layer = it / 96, ct = it % 96, col = ct * 64 + X.lane;
  LAS float* sl = (LAS float*)X.lds;
  for (int i = X.tid; i < 2048; i += NTHR) { const float v = i < 1024 ? a.in[IN_C][i] : a.in[IN_CCTX][i - 1024]; sl[i] = v / (1.f + __expf(-v)); }
  __syncthreads();
  const float* W = a.in[IN_WADA] + (size_t)layer * 1024 * 6144 + col;
  float a0 = 0.f, a1 = 0.f; const int k0 = X.wave * 128;
#pragma unroll 8
  for (int k = 0; k < 128; ++k) { const float w = W[(size_t)(k0 + k) * 6144]; a0 += sl[k0 + k] * w; a1 += sl[1024 + k0 + k] * w; }
  LAS float* red = sl + 2048;
  red[(X.wave * 64 + X.lane) * 2] = a0; red[(X.wave * 64 + X.lane) * 2 + 1] = a1;
  __syncthreads();
  if (X.tid < 128) { const int l = X.tid & 63, v = X.tid >> 6; float s = 0.f;
#pragma unroll
    for (int w = 0; w < 8; ++w) s += red[(w * 64 + l) * 2 + v];
    s += a.in[IN_BADA][layer * 6144 + ct * 64 + l];
    float* mod = (float*)(X.ws + WS_MOD);
    if (layer == 0) mod[v * 6144 + ct * 64 + l] = s; else if (v == 0) mod[2 * 6144 + ct * 64 + l] = s; }
  __syncthreads();
}

__device__ __forceinline__ void p0_s5tables(const Ctx& X, int g) {
  const Args& a = *X.a;
  LAS f32x2* POW = (LAS f32x2*)X.lds;
  LAS f32x2* BB = (LAS f32x2*)(X.lds + 33792);
  LAS f32x2* CC = (LAS f32x2*)(X.lds + 33792 + 16384);
  LAS float* KK = (LAS float*)(X.lds + 33792 + 32768);
  LAS float* DD = (LAS float*)(X.lds + 33792 + 32768 + 65536);
  const int tid = X.tid;
  if (tid < 128) {
    const int dir = tid >> 6, p = tid & 63, idx = (dir * 32 + g) * 64 + p;
    const float lr = fminf(a.in[IN_LRE][idx], -1e-4f), li = a.in[IN_LIM][idx], dt = expf(a.in[IN_LDT][dir * 32 + g]);
    for (int tau = 0; tau <= 32; ++tau) { const float mg = expf(lr * dt * (float)tau); float sn, cs; sincosf(li * dt * (float)tau, &sn, &cs); POW[(dir * 33 + tau) * 64 + p] = (f32x2){mg * cs, mg * sn}; }
    const f32x2 l1 = POW[(dir * 33 + 1) * 64 + p], l32 = POW[(dir * 33 + 32) * 64 + p];
    ((float2*)(X.ws + WS_LAML))[idx] = make_float2(l32.x, l32.y);
    const float nr = l1.x - 1.f, ni = l1.y, den = lr * lr + li * li, cr = (nr * lr + ni * li) / den, ci = (ni * lr - nr * li) / den;
    for (int c = 0; c < 16; ++c) { const float xr = a.in[IN_BRE][idx * 16 + c], xi = a.in[IN_BIM][idx * 16 + c]; BB[(dir * 64 + p) * 16 + c] = (f32x2){cr * xr - ci * xi, cr * xi + ci * xr}; }
  }
  for (int i = tid; i < 2048; i += NTHR) { const int dir = i >> 10, c = (i >> 6) & 15, p = i & 63; const int gi = ((dir * 32 + g) * 16 + c) * 64 + p; CC[i] = (f32x2){a.in[IN_CRE][gi], a.in[IN_CIM][gi]}; }
  if (tid < 16) DD[tid] = a.in[IN_S5D][g * 16 + tid];
  __syncthreads();
  for (int combo = tid; combo < 1024; combo += NTHR) {
    const int dir = combo >> 9, tau = (combo >> 4) & 31, c = combo & 15;
    float accv[16];
#pragma unroll
    for (int j = 0; j < 16; ++j) accv[j] = 0.f;
    for (int p = 0; p < 64; ++p) {
      const f32x2 cc = CC[(dir * 16 + c) * 64 + p], pw = POW[(dir * 33 + tau) * 64 + p];
      const float zr = cc.x * pw.x - cc.y * pw.y, zi = cc.x * pw.y + cc.y * pw.x;
#pragma unroll
      for (int j = 0; j < 16; ++j) { const f32x2 b = BB[(dir * 64 + p) * 16 + j]; accv[j] += zr * b.x - zi * b.y; }
    }
#pragma unroll
    for (int j = 0; j < 16; ++j) KK[((dir * 32 + tau) * 16 + c) * 16 + j] = accv[j];
  }
  __syncthreads();
  bf16_t* TT = (bf16_t*)(X.ws + WS_TT) + (size_t)g * 512 * 768;
  for (int q = tid; q < 512 * 96; q += NTHR) {
    const int row = q / 96, cc8 = q % 96, i = row >> 4, c = row & 15; float v[8];
    if (cc8 < 64) {
      const int s = cc8 >> 1, c0 = (cc8 & 1) * 8;
#pragma unroll
      for (int j = 0; j < 8; ++j) { const int cp = c0 + j; float x;
        if (s < i) x = KK[((0 * 32 + (i - s)) * 16 + c) * 16 + cp];
        else if (s > i) x = KK[((1 * 32 + (s - i)) * 16 + c) * 16 + cp];
        else x = KK[((0 * 32 + 0) * 16 + c) * 16 + cp] + KK[((1 * 32 + 0) * 16 + c) * 16 + cp] + (cp == c ? DD[c] : 0.f);
        v[j] = x; }
    } else {
      const int kk = (cc8 - 64) * 8, dir = kk >> 7, ri = (kk >> 6) & 1, p0 = kk & 63, tau = dir == 0 ? i + 1 : 32 - i;
#pragma unroll
      for (int j = 0; j < 8; ++j) { const int p = p0 + j; const f32x2 cc = CC[(dir * 16 + c) * 64 + p], pw = POW[(dir * 33 + tau) * 64 + p];
        v[j] = ri == 0 ? (cc.x * pw.x - cc.y * pw.y) : -(cc.x * pw.y + cc.y * pw.x); }
    }
    u32x4 o; o.x = cvt_pk_bf16(v[0], v[1]); o.y = cvt_pk_bf16(v[2], v[3]); o.z = cvt_pk_bf16(v[4], v[5]); o.w = cvt_pk_bf16(v[6], v[7]);
    *(u32x4*)(TT + (size_t)row * 768 + cc8 * 8) = o;
  }
  bf16_t* WSm = (bf16_t*)(X.ws + WS_WS) + (size_t)g * 256 * 512;
  for (int q = tid; q < 256 * 64; q += NTHR) {
    const int n = q >> 6, cc8 = q & 63, dir = n >> 7, ri = (n >> 6) & 1, p = n & 63, s = cc8 >> 1, c0 = (cc8 & 1) * 8, tau = dir == 0 ? 31 - s : s;
    const f32x2 pw = POW[(dir * 33 + tau) * 64 + p]; float v[8];
#pragma unroll
    for (int j = 0; j < 8; ++j) { const f32x2 b = BB[(dir * 64 + p) * 16 + c0 + j]; v[j] = ri == 0 ? (pw.x * b.x - pw.y * b.y) : (pw.x * b.y + pw.y * b.x); }
    u32x4 o; o.x = cvt_pk_bf16(v[0], v[1]); o.y = cvt_pk_bf16(v[2], v[3]); o.z = cvt_pk_bf16(v[4], v[5]); o.w = cvt_pk_bf16(v[6], v[7]);
    *(u32x4*)(WSm + (size_t)n * 512 + cc8 * 8) = o;
  }
  __syncthreads();
}

__device__ __forceinline__ void p0_dftconst(const Ctx& X, int idx) {
  for (int q = idx * NTHR + X.tid; q < 32768; q += 32 * NTHR) {
    float v[8]; bf16_t* dst;
    if (q < 16384) {
      const int R = q >> 5, c0 = (q & 31) * 8, ri = R >> 8, m = R & 255; dst = (bf16_t*)(X.ws + WS_DMT) + (size_t)R * 256 + c0;
#pragma unroll
      for (int j = 0; j < 8; ++j) { float s, c; sincospif((float)(((c0 + j) * m) & 255) * (1.f / 128.f), &s, &c); v[j] = ri == 0 ? c : -s; }
    } else if (q < 24576) {
      const int q2 = q - 16384, R = q2 >> 5, c0 = (q2 & 31) * 8, rip = R >> 7, ka = R & 127; dst = (bf16_t*)(X.ws + WS_W1) + (size_t)R * 256 + c0;
#pragma unroll
      for (int j = 0; j < 8; ++j) { const int C = c0 + j, ri = C >> 7, ta = C & 127; float s, c; sincospif((float)((ka * ta) & 127) * (1.f / 64.f), &s, &c);
        v[j] = (rip == ri) ? c : (rip == 0 ? s : -s); }
    } else {
      const int q2 = q - 24576, R = q2 >> 5, c0 = (q2 & 31) * 8; dst = (bf16_t*)(X.ws + WS_W2) + (size_t)R * 256 + c0;
#pragma unroll
      for (int j = 0; j < 8; ++j) { const int C = c0 + j, rip = C >> 7, tb = C & 127; float s, c; sincospif((float)((R * tb) & 127) * (1.f / 64.f), &s, &c);
        v[j] = R < 128 ? (rip == 0 ? c : s) * (1.f / 2048.f) : 0.f; }
    }
    u32x4 o; o.x = cvt_pk_bf16(v[0], v[1]); o.y = cvt_pk_bf16(v[2], v[3]); o.z = cvt_pk_bf16(v[4], v[5]); o.w = cvt_pk_bf16(v[6], v[7]);
    *(u32x4*)dst = o;
  }
}

__device__ __forceinline__ void phase_prep(const Ctx& X) {
  const int c = X.c;
  if (c < 192) p0_adaln(X, c);
  else if (c < 224) p0_s5tables(X, c - 192);
  else p0_dftconst(X, c - 224);
  __syncthreads();
  unsigned* ctl = (unsigned*)(X.ws + WS_CTL);
  transpose_work(X, ctl + CW_DQ0, 0, IT_SMALL, (X.a->flags & 2) ? 1 : 0, (X.a->flags & FLAG_SKIP_EXPERTS) ? 0 : 65 * IT_EXP);
}

__device__ __forceinline__ void modulate_row(const float* hrow, const float* shift, const float* scale, bf16_t* orow, int lane) {
  const f32x4* xr = (const f32x4*)hrow + lane; f32x4 v[4]; float ss = 0.f;
#pragma unroll
  for (int j = 0; j < 4; ++j) { v[j] = xr[64 * j]; ss += (v[j].x * v[j].x + v[j].y * v[j].y) + (v[j].z * v[j].z + v[j].w * v[j].w); }
  const float r = rsqrtf(wave_sum(ss) * (1.f / 1024.f) + 1e-6f);
  u32x2* o8 = (u32x2*)orow + lane;
#pragma unroll
  for (int j = 0; j < 4; ++j) { const f32x4 sh = ((const f32x4*)shift)[lane + 64 * j], sc = ((const f32x4*)scale)[lane + 64 * j];
    u32x2 w; w.x = cvt_pk_bf16(v[j].x * r * (1.f + sc.x) + sh.x, v[j].y * r * (1.f + sc.y) + sh.y); w.y = cvt_pk_bf16(v[j].z * r * (1.f + sc.z) + sh.z, v[j].w * r * (1.f + sc.w) + sh.w);
    o8[64 * j] = w; }
}
__device__ __forceinline__ void phase_mod0(const Ctx& X) {
  const Args& a = *X.a; const float* mod = (const float*)(X.ws + WS_MOD); bf16_t* A0 = (bf16_t*)(X.ws + WS_A0);
  const int gw = X.c * NWAVES + X.wave, NGW = X.G * NWAVES;
  for (int r = gw; r < NROW; r += NGW) {
    if (r < TOK) modulate_row(a.in[IN_X] + (size_t)r * 1024, mod, mod + 1024, A0 + (size_t)r * 1024, X.lane);
    else modulate_row(a.in[IN_CTX] + (size_t)(r - TOK) * 1024, mod + 6144, mod + 6144 + 1024, A0 + (size_t)r * 1024, X.lane);
  }
}

__device__ __forceinline__ u32x4 pack8(const f32x4& v0, const f32x4& v1) { u32x4 w; w.x = cvt_pk_bf16(v0[0], v0[1]); w.y = cvt_pk_bf16(v0[2], v0[3]); w.z = cvt_pk_bf16(v1[0], v1[1]); w.w = cvt_pk_bf16(v1[2], v1[3]); return w; }

struct G1 {
  static constexpr bool PERM = true; static constexpr bool LINA = true, LINB = true; __device__ __forceinline__ size_t halfA() const { return 128u * 2048u; } __device__ __forceinline__ size_t halfB() const { return 128u * 2048u; } int K, nunits; unsigned char* ws; const float* qg; const float* kg;
  __device__ __forceinline__ void decode(int w, Unit& u) const { if (w < 390) { u.a = 0; u.pm = w / 6; u.pn = w % 6; } else { const int w2 = w - 390; u.a = 1; u.pm = w2 & 1; u.pn = w2 >> 1; } u.b = 0; }
  __device__ __forceinline__ const char* baseA(const Unit& u) const { return (const char*)ws + (u.a == 0 ? WS_A0 : WS_WIN_T + (size_t)1536 * 2048); }
  __device__ __forceinline__ const char* baseB(const Unit& u) const { return (const char*)ws + (u.a == 0 ? WS_WIN_T : WS_A0); }
  __device__ __forceinline__ unsigned rowA(const Unit& u, int r) const { return (unsigned)(u.pm * 256 + r) * 2048u; }
  __device__ __forceinline__ unsigned rowB(const Unit& u, int r) const { return (unsigned)(u.pn * 256 + r) * 2048u; }
  __device__ __forceinline__ void epi(const Acc& acc, const Unit& u, int wr, int wc, int fr, int fq) const {
    if (u.a == 1) {
      bf16_t* VT = (bf16_t*)(ws + WS_VT);
#pragma unroll
      for (int ai = 0; ai < 2; ++ai)
#pragma unroll
        for (int m = 0; m < 4; ++m) { const int d = u.pm * 256 + ai * 128 + wr * 64 + m * 16 + fr;
#pragma unroll
          for (int bj = 0; bj < 2; ++bj) { const int t0 = u.pn * 256 + bj * 128 + wc * 32 + 8 * fq; *(u32x4*)(VT + (size_t)d * NROW + t0) = pack8(acc[ai][bj][m][0], acc[ai][bj][m][1]); } }
      return;
    }
    if (u.pn < 2) {
      bf16_t* AS5 = (bf16_t*)(ws + WS_AS5);
#pragma unroll
      for (int ai = 0; ai < 2; ++ai)
#pragma unroll
        for (int m = 0; m < 4; ++m) { const int row = u.pm * 256 + ai * 128 + wr * 64 + m * 16 + fr; int crow, s;
          if (row < TOK) { crow = row >> 5; s = row & 31; } else { const int j = row - TOK; crow = 512 + (j >> 5); s = j & 31; }
#pragma unroll
          for (int bj = 0; bj < 2; ++bj) { const int g = 16 * u.pn + 8 * bj + 2 * wc + (fq >> 1), c0 = 8 * (fq & 1);
            *(u32x4*)(AS5 + ((size_t)(g * 768 + crow) * 768 + s * 16 + c0)) = pack8(acc[ai][bj][m][0], acc[ai][bj][m][1]); } }
      return;
    }
    const bool isq = u.pn < 4;
    if (isq && u.pm == 64) return;
    const int head = 4 * ((u.pn - 2) & 1) + wc; const float* gain = isq ? qg : kg;
    bf16_t* dst = isq ? (bf16_t*)(ws + WS_Q) : (bf16_t*)(ws + WS_K);
    f32x4 gv[2][2];
#pragma unroll
    for (int bj = 0; bj < 2; ++bj) { gv[bj][0] = *(const f32x4*)(gain + 32 * bj + 8 * fq); gv[bj][1] = *(const f32x4*)(gain + 32 * bj + 8 * fq + 4); }
#pragma unroll
    for (int ai = 0; ai < 2; ++ai)
#pragma unroll
      for (int m = 0; m < 4; ++m) { const int row = u.pm * 256 + ai * 128 + wr * 64 + m * 16 + fr; float ss = 0.f;
#pragma unroll
        for (int bj = 0; bj < 2; ++bj)
#pragma unroll
          for (int n = 0; n < 2; ++n) { const f32x4 x = acc[ai][bj][m][n]; ss += (x[0] * x[0] + x[1] * x[1]) + (x[2] * x[2] + x[3] * x[3]); }
        ss += sx(ss, 16); ss += sx(ss, 32);
        const float rinv = rsqrtf(ss * (1.f / 64.f) + 1e-6f);
#pragma unroll
        for (int bj = 0; bj < 2; ++bj) { const f32x4 v0 = acc[ai][bj][m][0] * rinv * gv[bj][0], v1 = acc[ai][bj][m][1] * rinv * gv[bj][1];
          *(u32x4*)(dst + (size_t)row * 512 + head * 64 + 32 * bj + 8 * fq) = pack8(v0, v1); } }
  }
};

struct G2 {
  static constexpr bool PERM = true; static constexpr bool LINA = true, LINB = true; __device__ __forceinline__ size_t halfA() const { return 128u * 1536u; } __device__ __forceinline__ size_t halfB() const { return 128u * 1024u; } int K, nunits; unsigned char* ws;
  __device__ __forceinline__ void decode(int w, Unit& u) const { u.a = w / 3; u.pm = w % 3; u.pn = 0; u.b = 0; }
  __device__ __forceinline__ const char* baseA(const Unit& u) const { return (const char*)ws + WS_AS5 + (size_t)u.a * 768 * 768 * 2; }
  __device__ __forceinline__ const char* baseB(const Unit& u) const { return (const char*)ws + WS_WS + (size_t)u.a * 256 * 512 * 2; }
  __device__ __forceinline__ unsigned rowA(const Unit& u, int r) const { return (unsigned)(u.pm * 256 + r) * 1536u; }
  __device__ __forceinline__ unsigned rowB(const Unit& u, int r) const { return (unsigned)r * 1024u; }
  __device__ __forceinline__ void epi(const Acc& acc, const Unit& u, int wr, int wc, int fr, int fq) const {
    float* SST = (float*)(ws + WS_SST) + (size_t)u.a * 768 * 256;
#pragma unroll
    for (int ai = 0; ai < 2; ++ai)
#pragma unroll
      for (int m = 0; m < 4; ++m) { const int crow = u.pm * 256 + ai * 128 + wr * 64 + m * 16 + fr; if (crow >= 520) continue;
#pragma unroll
        for (int bj = 0; bj < 2; ++bj) { float* p = SST + (size_t)crow * 256 + bj * 128 + wc * 32 + 8 * fq; *(f32x4*)p = acc[ai][bj][m][0]; *(f32x4*)(p + 4) = acc[ai][bj][m][1]; } }
  }
};

struct G3 {
  static constexpr bool PERM = true; static constexpr bool LINA = true, LINB = true; __device__ __forceinline__ size_t halfA() const { return 128u * 1536u; } __device__ __forceinline__ size_t halfB() const { return 128u * 1536u; } int K, nunits; unsigned char* ws;
  __device__ __forceinline__ void decode(int w, Unit& u) const { u.a = w >> 2; u.pm = (w >> 1) & 1; u.pn = w & 1; u.b = 0; }
  __device__ __forceinline__ const char* baseA(const Unit& u) const { return (const char*)ws + WS_AS5 + (size_t)u.a * 768 * 768 * 2; }
  __device__ __forceinline__ const char* baseB(const Unit& u) const { return (const char*)ws + WS_TT + (size_t)u.a * 512 * 768 * 2; }
  __device__ __forceinline__ unsigned rowA(const Unit& u, int r) const { return (unsigned)(u.pm * 256 + r) * 1536u; }
  __device__ __forceinline__ unsigned rowB(const Unit& u, int r) const { return (unsigned)(u.pn * 256 + r) * 1536u; }
  __device__ __forceinline__ void epi(const Acc& acc, const Unit& u, int wr, int wc, int fr, int fq) const {
    bf16_t* GB = (bf16_t*)(ws + WS_GB);
#pragma unroll
    for (int ai = 0; ai < 2; ++ai)
#pragma unroll
      for (int m = 0; m < 4; ++m) { const int crow = u.pm * 256 + ai * 128 + wr * 64 + m * 16 + fr;
#pragma unroll
        for (int bj = 0; bj < 2; ++bj) { const int pp = u.pn * 256 + bj * 128 + wc * 32 + 8 * fq, i = pp >> 4, c0 = pp & 15; f32x4 v0 = acc[ai][bj][m][0], v1 = acc[ai][bj][m][1];
#pragma unroll
          for (int j = 0; j < 4; ++j) { v0[j] = gelu_tanh(v0[j]); v1[j] = gelu_tanh(v1[j]); }
          *(u32x4*)(GB + (size_t)(crow * 32 + i) * 512 + u.a * 16 + c0) = pack8(v0, v1); } }
  }
};

struct G4 {
  static constexpr bool PERM = true; static constexpr bool LINA = true, LINB = true; __device__ __forceinline__ size_t halfA() const { return 128u * 1024u; } __device__ __forceinline__ size_t halfB() const { return 128u * 1024u; } int K, nunits; unsigned char* ws; const float* bglu;
  __device__ __forceinline__ void decode(int w, Unit& u) const { u.pm = w >> 1; u.pn = w & 1; u.a = 0; u.b = 0; }
  __device__ __forceinline__ const char* baseA(const Unit&) const { return (const char*)ws + WS_GB; }
  __device__ __forceinline__ const char* baseB(const Unit&) const { return (const char*)ws + WS_WGLU_T; }
  __device__ __forceinline__ unsigned rowA(const Unit& u, int r) const { return (unsigned)(u.pm * 256 + r) * 1024u; }
  __device__ __forceinline__ unsigned rowB(const Unit& u, int r) const { return (unsigned)(u.pn * 256 + r) * 1024u; }
  __device__ __forceinline__ void epi(const Acc& acc, const Unit& u, int wr, int wc, int fr, int fq) const {
    const bf16_t* GB = (const bf16_t*)(ws + WS_GB); bf16_t* CC = (bf16_t*)(ws + WS_CONCAT);
#pragma unroll
    for (int bj = 0; bj < 2; ++bj) { const int col0 = u.pn * 256 + bj * 128 + wc * 32 + 8 * fq; const f32x4 b0 = *(const f32x4*)(bglu + col0), b1 = *(const f32x4*)(bglu + col0 + 4);
#pragma unroll
      for (int ai = 0; ai < 2; ++ai)
#pragma unroll
        for (int m = 0; m < 4; ++m) { const int row = u.pm * 256 + ai * 128 + wr * 64 + m * 16 + fr; const u32x4 gw = *(const u32x4*)(GB + (size_t)row * 512 + col0);
          f32x4 v0 = acc[ai][bj][m][0] + b0, v1 = acc[ai][bj][m][1] + b1;
          v0[0] = bf_lo(gw.x) * fast_sigmoid(v0[0]); v0[1] = bf_hi(gw.x) * fast_sigmoid(v0[1]); v0[2] = bf_lo(gw.y) * fast_sigmoid(v0[2]); v0[3] = bf_hi(gw.y) * fast_sigmoid(v0[3]);
          v1[0] = bf_lo(gw.z) * fast_sigmoid(v1[0]); v1[1] = bf_hi(gw.z) * fast_sigmoid(v1[1]); v1[2] = bf_lo(gw.w) * fast_sigmoid(v1[2]); v1[3] = bf_hi(gw.w) * fast_sigmoid(v1[3]);
          *(u32x4*)(CC + (size_t)row * 1024 + col0) = pack8(v0, v1); } }
  }
};

struct GRes {
  static constexpr bool PERM = false; static constexpr bool LINA = true, LINB = true; __device__ __forceinline__ size_t halfA() const { return 128u * 2048u; } __device__ __forceinline__ size_t halfB() const { return 128u * 2048u; } int K, nunits; const char* A; const char* Bt; const float* hin; float* hout; const float* gate; const float* bias;
  __device__ __forceinline__ void decode(int w, Unit& u) const { u.pm = w >> 2; u.pn = w & 3; u.a = 0; u.b = 0; }
  __device__ __forceinline__ const char* baseA(const Unit&) const { return A; }
  __device__ __forceinline__ const char* baseB(const Unit&) const { return Bt; }
  __device__ __forceinline__ unsigned rowA(const Unit& u, int r) const { return (unsigned)(u.pm * 256 + r) * 2048u; }
  __device__ __forceinline__ unsigned rowB(const Unit& u, int r) const { return (unsigned)(u.pn * 256 + r) * 2048u; }
  __device__ __forceinline__ void epi(const Acc& acc, const Unit& u, int wr, int wc, int fr, int fq) const {
#pragma unroll
    for (int bj = 0; bj < 2; ++bj)
#pragma unroll
      for (int n = 0; n < 2; ++n) { const int col0 = u.pn * 256 + bj * 128 + wc * 32 + 16 * n + 4 * fq; const f32x4 gt = *(const f32x4*)(gate + col0);
        f32x4 bs = (f32x4){0.f, 0.f, 0.f, 0.f}; if (bias) bs = *(const f32x4*)(bias + col0);
#pragma unroll
        for (int ai = 0; ai < 2; ++ai)
#pragma unroll
          for (int m = 0; m < 4; ++m) { const size_t off = (size_t)(u.pm * 256 + ai * 128 + wr * 64 + m * 16 + fr) * 1024 + col0;
            const f32x4 hv = *(const f32x4*)(hin + off); *(f32x4*)(hout + off) = hv + gt * (acc[ai][bj][m][n] + bs); } }
  }
};

struct MoeTab { const LAS int* toff; const LAS int* cnt; };
__device__ __forceinline__ void build_moetab(const Ctx& X, int layer, int half, LAS int* toff, LAS int* cntl) {
  const unsigned* cnt = (const unsigned*)(X.ws + WS_CTL) + CW_CNT + (layer * 2 + half) * 64;
  if (X.tid < 64) cntl[X.tid] = (int)__hip_atomic_load(cnt + X.tid, __ATOMIC_RELAXED, __HIP_MEMORY_SCOPE_AGENT);
  __syncthreads();
  if (X.tid == 0) { int s = 0; for (int e = 0; e < 64; ++e) { toff[e] = s; s += (cntl[e] + 255) >> 8; } toff[64] = s; toff[65] = s + 32; }
  __syncthreads();
}
__device__ __forceinline__ int find_expert(const LAS int* toff, int ti) { int e = 0;
#pragma unroll 8
  for (int j = 1; j <= 64; ++j) e += (ti >= toff[j]) ? 1 : 0; return e; }

struct G6 {
  static constexpr bool PERM = true; static constexpr bool LINA = false, LINB = true; __device__ __forceinline__ size_t halfA() const { return 0; } __device__ __forceinline__ size_t halfB() const { return 128u * 2048u; } int K, nunits; unsigned char* ws; MoeTab tab; int half;
  __device__ __forceinline__ void decode(int w, Unit& u) const { const int ti = w >> 1; u.pn = w & 1; u.a = find_expert(tab.toff, ti); u.pm = ti - tab.toff[u.a]; u.b = ti; }
  __device__ __forceinline__ const char* baseA(const Unit&) const { return (const char*)ws + WS_F; }
  __device__ __forceinline__ const char* baseB(const Unit& u) const { return (const char*)ws + WS_WEXP + (size_t)u.a * EXP_STRIDE; }
  __device__ __forceinline__ unsigned rowA(const Unit& u, int r) const { const int idx = u.pm * 256 + r; int tok;
    if (u.a == 64) tok = half * 8192 + idx; else { tok = half * 8192; if (idx < tab.cnt[u.a]) tok = ((const int*)(ws + WS_LTOK))[(half * 64 + u.a) * 8192 + idx]; }
    return (unsigned)tok * 2048u; }
  __device__ __forceinline__ unsigned rowB(const Unit& u, int r) const { return (unsigned)(u.pn * 256 + r) * 2048u; }
  __device__ __forceinline__ void epi(const Acc& acc, const Unit& u, int wr, int wc, int fr, int fq) const {
    bf16_t* HID = (bf16_t*)(ws + WS_HID);
#pragma unroll
    for (int ai = 0; ai < 2; ++ai)
#pragma unroll
      for (int m = 0; m < 4; ++m) { const size_t hrow = (size_t)u.b * 256 + ai * 128 + wr * 64 + m * 16 + fr; f32x4 v0, v1;
#pragma unroll
        for (int j = 0; j < 4; ++j) { const float g0 = acc[ai][0][m][0][j], g1 = acc[ai][0][m][1][j]; v0[j] = g0 * fast_sigmoid(g0) * acc[ai][1][m][0][j]; v1[j] = g1 * fast_sigmoid(g1) * acc[ai][1][m][1][j]; }
        *(u32x4*)(HID + hrow * 256 + u.pn * 128 + wc * 32 + 8 * fq) = pack8(v0, v1); }
  }
};
struct G7 {
  static constexpr bool PERM = true; static constexpr bool LINA = true, LINB = true; __device__ __forceinline__ size_t halfA() const { return 128u * 512u; } __device__ __forceinline__ size_t halfB() const { return 128u * 512u; } int K, nunits; unsigned char* ws; MoeTab tab; int half;
  __device__ __forceinline__ void decode(int w, Unit& u) const { const int ti = w >> 2; u.pn = w & 3; u.a = find_expert(tab.toff, ti); u.pm = ti - tab.toff[u.a]; u.b = ti; }
  __device__ __forceinline__ const char* baseA(const Unit&) const { return (const char*)ws + WS_HID; }
  __device__ __forceinline__ const char* baseB(const Unit& u) const { return (const char*)ws + WS_WEXP + (size_t)u.a * EXP_STRIDE + EXP_DOFF; }
  __device__ __forceinline__ unsigned rowA(const Unit& u, int r) const { return (unsigned)(u.b * 256 + r) * 512u; }
  __device__ __forceinline__ unsigned rowB(const Unit& u, int r) const { return (unsigned)(u.pn * 256 + r) * 512u; }
  __device__ __forceinline__ void epi(const Acc& acc, const Unit& u, int wr, int wc, int fr, int fq) const {
    bf16_t* YAS = (bf16_t*)(ws + WS_YAS); const float* lw = (const float*)(ws + WS_LW) + (size_t)(half * 64 + (u.a & 63)) * 8192;
#pragma unroll
    for (int ai = 0; ai < 2; ++ai)
#pragma unroll
      for (int m = 0; m < 4; ++m) { const int tr = ai * 128 + wr * 64 + m * 16 + fr, idx = u.pm * 256 + tr; float wgt = 1.f;
        if (u.a < 64) { wgt = 0.f; if (idx < tab.cnt[u.a]) wgt = lw[idx]; }
        const size_t yrow = (size_t)u.b * 256 + tr;
#pragma unroll
        for (int bj = 0; bj < 2; ++bj) *(u32x4*)(YAS + yrow * 1024 + u.pn * 256 + bj * 128 + wc * 32 + 8 * fq) = pack8(acc[ai][bj][m][0] * wgt, acc[ai][bj][m][1] * wgt); }
  }
};

struct G8 {
  static constexpr bool PERM = true; static constexpr bool LINA = true, LINB = false; __device__ __forceinline__ size_t halfA() const { return 128u * 512u; } __device__ __forceinline__ size_t halfB() const { return 0; } int K, nunits; unsigned char* ws;
  __device__ __forceinline__ void decode(int w, Unit& u) const { u.a = w >> 7; const int r = w & 127; u.pm = r & 1; u.pn = r >> 1; u.b = 0; }
  __device__ __forceinline__ const char* baseA(const Unit&) const { return (const char*)ws + WS_DMT; }
  __device__ __forceinline__ const char* baseB(const Unit& u) const { return (const char*)ws + WS_A1 + (size_t)u.a * 512; }
  __device__ __forceinline__ unsigned rowA(const Unit& u, int r) const { return (unsigned)(u.pm * 256 + r) * 512u; }
  __device__ __forceinline__ unsigned rowB(const Unit& u, int r) const { const int n = u.pn * 256 + r; return (unsigned)(128 * (n & 127) + (n >> 7)) * 2048u; }
  __device__ __forceinline__ void epi(const Acc& acc, const Unit& u, int wr, int wc, int fr, int fq) const {
    bf16_t* X1 = (bf16_t*)(ws + WS_X1);
#pragma unroll
    for (int ai = 0; ai < 2; ++ai)
#pragma unroll
      for (int m = 0; m < 4; ++m) { const int mm = ai * 128 + wr * 64 + m * 16 + fr;
#pragma unroll
        for (int bj = 0; bj < 2; ++bj) { const int n0 = u.pn * 256 + bj * 128 + wc * 32 + 8 * fq, tb = n0 >> 7, ta0 = n0 & 127;
          *(u32x4*)(X1 + ((((size_t)(u.a * 256 + mm) * 128 + tb) * 2 + u.pm) * 128 + ta0)) = pack8(acc[ai][bj][m][0], acc[ai][bj][m][1]); } }
  }
};
struct G9 {
  static constexpr bool PERM = true; static constexpr bool LINA = true, LINB = true; __device__ __forceinline__ size_t halfA() const { return 128u * 512u; } __device__ __forceinline__ size_t halfB() const { return 128u * 512u; } int K, nunits; unsigned char* ws;
  __device__ __forceinline__ void decode(int w, Unit& u) const { u.pm = 0; u.pn = w; u.a = 0; u.b = 0; }
  __device__ __forceinline__ const char* baseA(const Unit&) const { return (const char*)ws + WS_W1; }
  __device__ __forceinline__ const char* baseB(const Unit&) const { return (const char*)ws + WS_X1; }
  __device__ __forceinline__ unsigned rowA(const Unit&, int r) const { return (unsigned)r * 512u; }
  __device__ __forceinline__ unsigned rowB(const Unit& u, int r) const { return (unsigned)(u.pn * 256 + r) * 512u; }
  __device__ __forceinline__ void epi(const Acc& acc, const Unit& u, int wr, int wc, int fr, int fq) const {
    bf16_t* X2 = (bf16_t*)(ws + WS_X2);
#pragma unroll
    for (int m = 0; m < 4; ++m) { const int ka = wr * 64 + m * 16 + fr;
#pragma unroll
      for (int bj = 0; bj < 2; ++bj) { const int n0 = u.pn * 256 + bj * 128 + wc * 32 + 8 * fq, gm = n0 >> 7, tb0 = n0 & 127; f32x4 r0, r1, i0, i1;
#pragma unroll
        for (int j = 0; j < 4; ++j) {
          { const float ang = (float)((ka * (tb0 + j)) & 16383) * (1.f / 16384.f), cs = __builtin_amdgcn_cosf(ang), sn = __builtin_amdgcn_sinf(ang); const float yr = acc[0][bj][m][0][j], yi = acc[1][bj][m][0][j]; r0[j] = yr * cs + yi * sn; i0[j] = yi * cs - yr * sn; }
          { const float ang = (float)((ka * (tb0 + 4 + j)) & 16383) * (1.f / 16384.f), cs = __builtin_amdgcn_cosf(ang), sn = __builtin_amdgcn_sinf(ang); const float yr = acc[0][bj][m][1][j], yi = acc[1][bj][m][1][j]; r1[j] = yr * cs + yi * sn; i1[j] = yi * cs - yr * sn; } }
        bf16_t* p = X2 + (((size_t)(gm * 128 + ka) * 2) * 128 + tb0); *(u32x4*)p = pack8(r0, r1); *(u32x4*)(p + 128) = pack8(i0, i1); } }
  }
};
struct G10 {
  static constexpr bool PERM = true; static constexpr bool LINA = true, LINB = false; __device__ __forceinline__ size_t halfA() const { return 128u * 512u; } __device__ __forceinline__ size_t halfB() const { return 0; } int K, nunits; unsigned char* ws;
  __device__ __forceinline__ void decode(int w, Unit& u) const { u.pm = 0; u.pn = w; u.a = 0; u.b = 0; }
  __device__ __forceinline__ const char* baseA(const Unit&) const { return (const char*)ws + WS_W2; }
  __device__ __forceinline__ const char* baseB(const Unit&) const { return (const char*)ws + WS_X2; }
  __device__ __forceinline__ unsigned rowA(const Unit&, int r) const { return (unsigned)r * 512u; }
  __device__ __forceinline__ unsigned rowB(const Unit& u, int r) const { const int n = u.pn * 256 + r, ka = n >> 10, gm = n & 1023; return (unsigned)(gm * 128 + ka) * 512u; }
  __device__ __forceinline__ void epi(const Acc& acc, const Unit& u, int wr, int wc, int fr, int fq) const {
    bf16_t* FB = (bf16_t*)(ws + WS_FB); const int ka = u.pn >> 2;
#pragma unroll
    for (int m = 0; m < 4; ++m) { const int kb = wr * 64 + m * 16 + fr; const size_t k = (size_t)ka + 128 * kb;
#pragma unroll
      for (int bj = 0; bj < 2; ++bj) { const int d0 = (u.pn & 3) * 256 + bj * 128 + wc * 32 + 8 * fq; *(u32x4*)(FB + k * 1024 + d0) = pack8(acc[0][bj][m][0], acc[0][bj][m][1]); } }
  }
};
}
namespace mk {
typedef float f32x16 __attribute__((ext_vector_type(16)));

__device__ __forceinline__ void phase_scan(const Ctx& X) {
  const int gt = X.c * NTHR + X.tid; if (gt >= 4096) return;
  const int g = gt >> 7, dir = (gt >> 6) & 1, p = gt & 63;
  const float2 lam = ((const float2*)(X.ws + WS_LAML))[(dir * 32 + g) * 64 + p];
  const float* S = (const float*)(X.ws + WS_SST) + (size_t)g * 768 * 256 + dir * 128 + p;
  bf16_t* XP = (bf16_t*)(X.ws + WS_AS5) + (size_t)g * 768 * 768 + 512 + dir * 128 + p;
  float xr = 0.f, xi = 0.f;
  for (int j = 0; j < 520; ++j) {
    const int row = dir == 0 ? (j < 8 ? 512 + j : j - 8) : (j < 8 ? 519 - j : 519 - j);
    const float sr = S[(size_t)row * 256], si = S[(size_t)row * 256 + 64];
    XP[(size_t)row * 768] = f2bf(xr); XP[(size_t)row * 768 + 64] = f2bf(xi);
    const float nr = lam.x * xr - lam.y * xi + sr, ni = lam.x * xi + lam.y * xr + si; xr = nr; xi = ni;
  }
}

#define MFMA32(a, b, c) __builtin_amdgcn_mfma_f32_32x32x16_bf16((a), (b), (c), 0, 0, 0)
__device__ __forceinline__ void attn_unit(const Ctx& X, const LAS float* rpbl, int head, int tile) {
  const bf16_t* Q = (const bf16_t*)(X.ws + WS_Q); const bf16_t* Kb = (const bf16_t*)(X.ws + WS_K); const bf16_t* VT = (const bf16_t*)(X.ws + WS_VT);
  bf16_t* CCt = (bf16_t*)(X.ws + WS_CONCAT);
  const int lane = X.lane, ql = lane & 31, hh = lane >> 5;
  const int rp = tile >> 2, mt = tile & 3;
  const int r = 2 * rp + (ql >> 4), cq = 16 * mt + (ql & 15), tq = r * 64 + cq;
  const int r0q = min(max(r - 4, 0), 248), csq = min(max(cq - 8, 0), 48);
  const int rlo = min(max(2 * rp - 4, 0), 248), rhi = min(max(2 * rp - 3, 0), 248) + 7;
  const int csb = min(max(16 * mt - 8, 0), 32);
  const int nloc = rhi - rlo + 1;
  bf16x8 qf[4];
#pragma unroll
  for (int ks = 0; ks < 4; ++ks) qf[ks] = *(const bf16x8*)(Q + (size_t)tq * 512 + head * 64 + 16 * ks + 8 * hh);
  const int kperm = (ql & ~12) | ((ql & 4) << 1) | ((ql & 8) >> 1);
  f32x16 o0, o1;
#pragma unroll
  for (int i = 0; i < 16; ++i) { o0[i] = 0.f; o1[i] = 0.f; }
  float lsum = 0.f;
  const float c1 = 0.125f * 1.44269504f, c2 = 8.f * 1.44269504f;
  const float* rp_h = nullptr; (void)rp_h;
  for (int b = 0; b < nloc + 8; ++b) {
    const bool loc = b < nloc;
    const int kr = rlo + b;
    const int tokbase = loc ? kr * 64 + csb : TOK + 32 * (b - nloc);
    bf16x8 kf[4], vf[2][2];
    { const bf16_t* kp = Kb + (size_t)(tokbase + kperm) * 512 + head * 64 + 8 * hh;
#pragma unroll
      for (int ks = 0; ks < 4; ++ks) kf[ks] = *(const bf16x8*)(kp + 16 * ks); }
#pragma unroll
    for (int db = 0; db < 2; ++db)
#pragma unroll
      for (int s = 0; s < 2; ++s) vf[db][s] = *(const bf16x8*)(VT + (size_t)(head * 64 + 32 * db + ql) * NROW + tokbase + 16 * s + 8 * hh);
    f32x16 sacc;
#pragma unroll
    for (int i = 0; i < 16; ++i) sacc[i] = 0.f;
#pragma unroll
    for (int ks = 0; ks < 4; ++ks) sacc = MFMA32(kf[ks], qf[ks], sacc);
    float pv[16];
    if (loc) {
      const bool rowok = (kr >= r0q) && (kr <= r0q + 7);
      const LAS float* bp = rpbl + (head * 15 + (kr - r + 7)) * 31 + (csb - cq + 15);
#pragma unroll
      for (int i = 0; i < 16; ++i) { const int kidx = 16 * (i >> 3) + 8 * hh + (i & 7); const int kc = csb + kidx;
        const bool ok = rowok && (kc >= csq) && (kc <= csq + 15);
        float bias = 0.f; if (ok) bias = bp[kidx];
        const float e = __builtin_amdgcn_exp2f(sacc[i] * c1 + bias * 1.44269504f - c2); pv[i] = ok ? e : 0.f; }
    } else {
#pragma unroll
      for (int i = 0; i < 16; ++i) pv[i] = __builtin_amdgcn_exp2f(sacc[i] * c1 - c2);
    }
    u32x4 p0, p1;
    p0.x = cvt_pk_bf16(pv[0], pv[1]); p0.y = cvt_pk_bf16(pv[2], pv[3]); p0.z = cvt_pk_bf16(pv[4], pv[5]); p0.w = cvt_pk_bf16(pv[6], pv[7]);
    p1.x = cvt_pk_bf16(pv[8], pv[9]); p1.y = cvt_pk_bf16(pv[10], pv[11]); p1.z = cvt_pk_bf16(pv[12], pv[13]); p1.w = cvt_pk_bf16(pv[14], pv[15]);
    lsum += (bf_lo(p0.x) + bf_hi(p0.x)) + (bf_lo(p0.y) + bf_hi(p0.y)) + (bf_lo(p0.z) + bf_hi(p0.z)) + (bf_lo(p0.w) + bf_hi(p0.w))
          + (bf_lo(p1.x) + bf_hi(p1.x)) + (bf_lo(p1.y) + bf_hi(p1.y)) + (bf_lo(p1.z) + bf_hi(p1.z)) + (bf_lo(p1.w) + bf_hi(p1.w));
    const bf16x8 pb0 = __builtin_bit_cast(bf16x8, p0), pb1 = __builtin_bit_cast(bf16x8, p1);
    o0 = MFMA32(vf[0][0], pb0, o0); o0 = MFMA32(vf[0][1], pb1, o0);
    o1 = MFMA32(vf[1][0], pb0, o1); o1 = MFMA32(vf[1][1], pb1, o1);
  }
  lsum += sx(lsum, 32);
  const float inv = 1.f / lsum;
  bf16_t* op = CCt + (size_t)tq * 1024 + 512 + head * 64 + 4 * hh;
#pragma unroll
  for (int gq = 0; gq < 4; ++gq) {
    u32x2 w0, w1;
    w0.x = cvt_pk_bf16(o0[4 * gq] * inv, o0[4 * gq + 1] * inv); w0.y = cvt_pk_bf16(o0[4 * gq + 2] * inv, o0[4 * gq + 3] * inv);
    w1.x = cvt_pk_bf16(o1[4 * gq] * inv, o1[4 * gq + 1] * inv); w1.y = cvt_pk_bf16(o1[4 * gq + 2] * inv, o1[4 * gq + 3] * inv);
    *(u32x2*)(op + 8 * gq) = w0; *(u32x2*)(op + 32 + 8 * gq) = w1;
  }
}
__device__ __forceinline__ void phase_attn(const Ctx& X) {
  LAS float* rpbl = (LAS float*)X.lds;
  for (int i = X.tid; i < 8 * 15 * 31; i += NTHR) rpbl[i] = X.a->in[IN_RPB][i];
  __syncthreads();
  const int gw = X.c * NWAVES + X.wave, NGW = X.G * NWAVES;
  for (int U = gw; U < 4096; U += NGW) attn_unit(X, rpbl, U >> 9, U & 511);
}

__device__ __forceinline__ void phase_router(const Ctx& X, int layer) {
  const float* mod = (const float*)(X.ws + WS_MOD) + (layer == 0 ? 0 : 2 * 6144);
  const float* shift = mod + 3072; const float* scale = mod + 4096;
  const float* h = X.a->h; bf16_t* F = (bf16_t*)(X.ws + WS_F);
  unsigned* cntg = (unsigned*)(X.ws + WS_CTL) + CW_CNT + layer * 128;
  int* ltok = (int*)(X.ws + WS_LTOK); float* lw = (float*)(X.ws + WS_LW); int* asg = (int*)(X.ws + WS_ASG);
  const bf16_t* WR = (const bf16_t*)(X.ws + WS_WROUT_T) + (size_t)layer * 64 * 1024;
  const float* rbias = X.a->in[IN_RBIAS] + layer * 64;
  constexpr int FROW = 2064;
  const int lane = X.lane, wave = X.wave, tid = X.tid;
  for (int tile = X.c; tile < TOK / 64; tile += X.G) {
    const int t0 = tile * 64;
    for (int rr = 0; rr < 8; ++rr) {
      const int lr = wave * 8 + rr, t = t0 + lr;
      const f32x4* xr = (const f32x4*)(h + (size_t)t * 1024) + lane; f32x4 v[4]; float ss = 0.f;
#pragma unroll
      for (int j = 0; j < 4; ++j) { v[j] = xr[64 * j]; ss += (v[j].x * v[j].x + v[j].y * v[j].y) + (v[j].z * v[j].z + v[j].w * v[j].w); }
      const float r = rsqrtf(wave_sum(ss) * (1.f / 1024.f) + 1e-6f);
#pragma unroll
      for (int j = 0; j < 4; ++j) { const f32x4 sh = ((const f32x4*)shift)[lane + 64 * j], sc = ((const f32x4*)scale)[lane + 64 * j];
        u32x2 w; w.x = cvt_pk_bf16(v[j].x * r * (1.f + sc.x) + sh.x, v[j].y * r * (1.f + sc.y) + sh.y); w.y = cvt_pk_bf16(v[j].z * r * (1.f + sc.z) + sh.z, v[j].w * r * (1.f + sc.w) + sh.w);
        ((u32x2*)(F + (size_t)t * 1024))[lane + 64 * j] = w;
        *(LAS u32x2*)(X.lds + lr * FROW + (lane + 64 * j) * 8) = w; }
    }
    __syncthreads();
    f32x4 lg[2];
    { const int rb = wave & 3, fr = lane & 15, fq = lane >> 4;
      lg[0] = (f32x4){0.f, 0.f, 0.f, 0.f}; lg[1] = lg[0];
      const LAS unsigned char* ap = X.lds + (rb * 16 + fr) * FROW + fq * 16;
      const bf16_t* bp0 = WR + (size_t)((2 * (wave >> 2)) * 16 + fr) * 1024 + fq * 8; const bf16_t* bp1 = bp0 + 16 * 1024;
#pragma unroll 4
      for (int ks = 0; ks < 32; ++ks) { const bf16x8 af = *(const LAS bf16x8*)(ap + ks * 64); const bf16x8 b0 = *(const bf16x8*)(bp0 + ks * 32), b1 = *(const bf16x8*)(bp1 + ks * 32);
        lg[0] = __builtin_amdgcn_mfma_f32_16x16x32_bf16(af, b0, lg[0], 0, 0, 0); lg[1] = __builtin_amdgcn_mfma_f32_16x16x32_bf16(af, b1, lg[1], 0, 0, 0); }
    }
    __syncthreads();
    LAS float* LG = (LAS float*)X.lds;
    LAS float* GS = LG + 64 * 65;
    LAS float* SELV = GS + 512;
    LAS int* OUTE = (LAS int*)(SELV + 4096);
    LAS float* OUTS = (LAS float*)(OUTE + 512);
    LAS int* HIST = (LAS int*)(OUTS + 512);
    LAS int* BASE = HIST + 64;
    { const int rb = wave & 3, fr = lane & 15, fq = lane >> 4;
#pragma unroll
      for (int eb = 0; eb < 2; ++eb)
#pragma unroll
        for (int j = 0; j < 4; ++j) LG[(rb * 16 + 4 * fq + j) * 65 + (2 * (wave >> 2) + eb) * 16 + fr] = lg[eb][j];
      if (tid < 64) HIST[tid] = 0; }
    __syncthreads();
    const int tl = tid >> 3, grp = tid & 7;
    float v[8], sc[8];
    { float m1 = -INFINITY, m2 = -INFINITY;
#pragma unroll
      for (int j = 0; j < 8; ++j) { const float s = 1.f / (1.f + __expf(-LG[tl * 65 + grp * 8 + j])); sc[j] = s; v[j] = s + rbias[grp * 8 + j];
        if (v[j] > m1) { m2 = m1; m1 = v[j]; } else if (v[j] > m2) m2 = v[j]; }
      GS[tl * 8 + grp] = m1 + m2; }
    __syncthreads();
    bool keep;
    { const float mine = GS[tl * 8 + grp]; int rank = 0;
#pragma unroll
      for (int g2 = 0; g2 < 8; ++g2) { const float o = GS[tl * 8 + g2]; rank += (o > mine || (o == mine && g2 < grp)) ? 1 : 0; }
      keep = rank < 4;
#pragma unroll
      for (int j = 0; j < 8; ++j) SELV[tl * 64 + grp * 8 + j] = keep ? v[j] : -INFINITY; }
    __syncthreads();
    if (keep) {
      int rk[8];
#pragma unroll
      for (int j = 0; j < 8; ++j) rk[j] = 0;
      for (int e2 = 0; e2 < 64; ++e2) { const float o = SELV[tl * 64 + e2];
#pragma unroll
        for (int j = 0; j < 8; ++j) rk[j] += (o > v[j] || (o == v[j] && e2 < grp * 8 + j)) ? 1 : 0; }
#pragma unroll
      for (int j = 0; j < 8; ++j) if (rk[j] < 8) { OUTE[tl * 8 + rk[j]] = grp * 8 + j; OUTS[tl * 8 + rk[j]] = sc[j]; }
    }
    __syncthreads();
    { const int jj = tid & 7, e = OUTE[tl * 8 + jj]; const float s = OUTS[tl * 8 + jj];
      float sum = s; sum += sx(sum, 1); sum += sx(sum, 2); sum += sx(sum, 4);
      const float w = 2.5f * s / sum;
      const int sl = atomicAdd((int*)&HIST[e], 1);
      __syncthreads();
      const int t = t0 + tl, half = t >> 13;
      if (tid < 64) { const int n = HIST[tid]; BASE[tid] = n ? (int)atomicAdd(cntg + half * 64 + tid, (unsigned)n) : 0; }
      __syncthreads();
      const int slot = BASE[e] + sl;
      ltok[(size_t)(half * 64 + e) * 8192 + slot] = t; lw[(size_t)(half * 64 + e) * 8192 + slot] = w; asg[t * 8 + jj] = (e << 16) | slot; }
    __syncthreads();
  }
}

__device__ __forceinline__ void phase_combine(const Ctx& X, int layer, int half, const LAS int* toff) {
  const float* mod = (const float*)(X.ws + WS_MOD) + (layer == 0 ? 0 : 2 * 6144);
  const float* gffn = mod + 5120;
  const float* nmod = (const float*)(X.ws + WS_MOD) + 2 * 6144;
  float* h = X.a->h; const bf16_t* YAS = (const bf16_t*)(X.ws + WS_YAS); const int* asg = (const int*)(X.ws + WS_ASG); bf16_t* A1 = (bf16_t*)(X.ws + WS_A1);
  const int gw = X.c * NWAVES + X.wave, NGW = X.G * NWAVES, lane = X.lane;
  for (int ti = gw; ti < 8192; ti += NGW) {
    const int t = half * 8192 + ti;
    f32x4 acc[4];
#pragma unroll
    for (int j = 0; j < 4; ++j) acc[j] = (f32x4){0.f, 0.f, 0.f, 0.f};
    int pos[9];
#pragma unroll
    for (int k = 0; k < 8; ++k) { const int a = asg[t * 8 + k]; pos[k] = toff[a >> 16] * 256 + (a & 0xffff); }
    pos[8] = toff[64] * 256 + ti;
#pragma unroll
    for (int k = 0; k < 9; ++k) { const u32x2* yr = (const u32x2*)(YAS + (size_t)pos[k] * 1024) + lane;
#pragma unroll
      for (int j = 0; j < 4; ++j) { const u32x2 w = yr[64 * j]; acc[j].x += bf_lo(w.x); acc[j].y += bf_hi(w.x); acc[j].z += bf_lo(w.y); acc[j].w += bf_hi(w.y); } }
    f32x4* hr = (f32x4*)(h + (size_t)t * 1024) + lane; f32x4 v[4]; float ss = 0.f;
#pragma unroll
    for (int j = 0; j < 4; ++j) { const f32x4 gt = ((const f32x4*)gffn)[lane + 64 * j]; v[j] = hr[64 * j] + gt * acc[j]; hr[64 * j] = v[j];
      ss += (v[j].x * v[j].x + v[j].y * v[j].y) + (v[j].z * v[j].z + v[j].w * v[j].w); }
    if (layer == 0) {
      const float r = rsqrtf(wave_sum(ss) * (1.f / 1024.f) + 1e-6f);
#pragma unroll
      for (int j = 0; j < 4; ++j) { const f32x4 sh = ((const f32x4*)nmod)[lane + 64 * j], sc = ((const f32x4*)(nmod + 1024))[lane + 64 * j];
        u32x2 w; w.x = cvt_pk_bf16(v[j].x * r * (1.f + sc.x) + sh.x, v[j].y * r * (1.f + sc.y) + sh.y); w.y = cvt_pk_bf16(v[j].z * r * (1.f + sc.z) + sh.z, v[j].w * r * (1.f + sc.w) + sh.w);
        ((u32x2*)(A1 + (size_t)t * 1024))[lane + 64 * j] = w; }
    }
  }
}

constexpr int NPHASE = 27;
template <bool SP2>
__global__ void __launch_bounds__(NTHR, 2) mk_fwd(Args args) {
  extern __shared__ __attribute__((aligned(16))) unsigned char lds_raw[];
  Ctx X; X.lds = (LAS unsigned char*)lds_raw; X.a = &args; X.ws = args.ws; X.tid = threadIdx.x; X.lane = X.tid & 63; X.wave = __builtin_amdgcn_readfirstlane(X.tid >> 6);
  X.G = gridDim.x; X.c = blockIdx.x;
  const int wave_s = X.wave;
  volatile LAS unsigned* MISC = (volatile LAS unsigned*)(X.lds + LDS_MISC_OFF);
  LAS int* TOFF = (LAS int*)(X.lds + LDS_MISC_OFF + 64);
  LAS int* CNTL = (LAS int*)(X.lds + LDS_MISC_OFF + 64 + 512);
  if (X.tid < 16) MISC[X.tid] = 0u;
  __syncthreads();
  unsigned* ctl = (unsigned*)(X.ws + WS_CTL);
  const int lo = args.ph_lo, hi = args.ph_hi;
  const bool multi = (hi - lo) > 1;
  XcdBarrier bar; bar.bar = ctl + CW_BAR; bar.x = 0; bar.st = nullptr;
  if (multi) bar = xcd_barrier_post(ctl + CW_BAR, MISC, X.tid);
  LAS unsigned char* lds = X.lds;
  unsigned char* ws = X.ws;
  const float* mod = (const float*)(ws + WS_MOD); (void)mod;
#ifndef PH_MASK
#define PH_MASK 0x7ffffffull
#endif
#define IN(k) ((((unsigned long long)PH_MASK >> (k)) & 1ull) && lo <= (k) && (k) < hi)
#define SEAM(k) do { if (IN(k) && IN((k) + 1)) xcd_barrier(bar, X.tid); } while (0)
#define LAUNDER() do { int w0_ = wave_s; asm volatile("" : "+s"(w0_)); int l_ = __builtin_amdgcn_mbcnt_hi(~0u, __builtin_amdgcn_mbcnt_lo(~0u, 0u)); asm volatile("" : "+v"(l_)); X.wave = w0_; X.lane = l_; X.tid = w0_ * 64 + l_; \
    unsigned char* w_ = args.ws; asm volatile("" : "+s"(w_)); X.ws = w_; ws = w_; mod = (const float*)(w_ + WS_MOD); } while (0)
  if (IN(0)) { LAUNDER(); phase_prep(X); } SEAM(0);
  if (IN(1)) { LAUNDER(); phase_mod0(X); } SEAM(1);
  if (IN(2)) { LAUNDER(); G1 p; p.K = 1024; p.nunits = 520; p.ws = ws; p.qg = args.in[IN_QG]; p.kg = args.in[IN_KG]; gemm_phase<G1, SP2>(lds, p, X.G, X.c, X.tid); } SEAM(2);
  if (IN(3)) { LAUNDER(); G2 p; p.K = 512; p.nunits = 96; p.ws = ws; gemm_phase<G2, SP2>(lds, p, X.G, X.c, X.tid); } SEAM(3);
  if (IN(4)) { LAUNDER(); phase_scan(X); } SEAM(4);
  if (IN(5)) { LAUNDER(); G3 p; p.K = 768; p.nunits = 128; p.ws = ws; gemm_phase<G3, SP2>(lds, p, X.G, X.c, X.tid); } SEAM(5);
  if (IN(6)) { LAUNDER(); G4 p; p.K = 512; p.nunits = 128; p.ws = ws; p.bglu = args.in[IN_BGLU]; gemm_phase<G4, SP2>(lds, p, X.G, X.c, X.tid); } SEAM(6);
  if (IN(7)) { LAUNDER(); phase_attn(X); } SEAM(7);
  if (IN(8)) { LAUNDER(); GRes p; p.K = 1024; p.nunits = 256; p.A = (const char*)ws + WS_CONCAT; p.Bt = (const char*)ws + WS_WMIX_T; p.hin = args.in[IN_X]; p.hout = args.h; p.gate = mod + 2048; p.bias = nullptr;
    gemm_phase<GRes, SP2>(lds, p, X.G, X.c, X.tid); } SEAM(8);
#pragma unroll 1
  for (int layer = 0; layer < 2; ++layer) {
    const int pb = layer == 0 ? 9 : 20;
    if (IN(pb)) { LAUNDER(); phase_router(X, layer); } SEAM(pb);
#pragma unroll 1
    for (int half = 0; half < 2; ++half) {
      const int p6 = pb + 1 + 3 * half;
      if (IN(p6)) { LAUNDER(); build_moetab(X, layer, half, TOFF, CNTL); G6 p; p.K = 1024; p.ws = ws; p.tab.toff = TOFF; p.tab.cnt = CNTL; p.half = half; p.nunits = TOFF[65] * 2; gemm_phase<G6, SP2>(lds, p, X.G, X.c, X.tid); } SEAM(p6);
      if (IN(p6 + 1)) { LAUNDER(); build_moetab(X, layer, half, TOFF, CNTL); G7 p; p.K = 256; p.ws = ws; p.tab.toff = TOFF; p.tab.cnt = CNTL; p.half = half; p.nunits = TOFF[65] * 4; gemm_phase<G7, SP2>(lds, p, X.G, X.c, X.tid); } SEAM(p6 + 1);
      if (IN(p6 + 2)) { LAUNDER(); build_moetab(X, layer, half, TOFF, CNTL); phase_combine(X, layer, half, TOFF);
        if (layer == 0 && half == 1 && !(args.flags & FLAG_SKIP_EXPERTS)) { __syncthreads(); transpose_work(X, ctl + CW_DQ1, 0, 0, 1, 65 * IT_EXP); } }
      if (!(layer == 1 && half == 1)) SEAM(p6 + 2);
    }
    if (layer == 0) {
      if (IN(16)) { LAUNDER(); G8 p; p.K = 256; p.nunits = 512; p.ws = ws; gemm_phase<G8, SP2>(lds, p, X.G, X.c, X.tid); } SEAM(16);
      if (IN(17)) { LAUNDER(); G9 p; p.K = 256; p.nunits = 512; p.ws = ws; gemm_phase<G9, SP2>(lds, p, X.G, X.c, X.tid); } SEAM(17);
      if (IN(18)) { LAUNDER(); G10 p; p.K = 256; p.nunits = 512; p.ws = ws; gemm_phase<G10, SP2>(lds, p, X.G, X.c, X.tid); } SEAM(18);
      if (IN(19)) { LAUNDER(); GRes p; p.K = 1024; p.nunits = 256; p.A = (const char*)ws + WS_FB; p.Bt = (const char*)ws + WS_WFOUR_T; p.hin = args.h; p.hout = args.h; p.gate = mod + 2 * 6144 + 2048; p.bias = args.in[IN_BFOUR];
        gemm_phase<GRes, SP2>(lds, p, X.G, X.c, X.tid); } SEAM(19);
    }
  }
#undef IN
#undef SEAM
}
}
#ifndef MK_SP2
#define MK_SP2 true
#endif
#ifndef MK_N_LAUNCHES
#define MK_N_LAUNCHES 1
#endif
#ifndef CHECK
#define CHECK 0
#endif
static int g_grid = 0;
static bool mk_setup(int n_in, int out_size, size_t ws_size) {
  if (g_grid == 0) {
    g_grid = -1;
    if (n_in != 31 || out_size != 16384 * 1024 || ws_size < (size_t)530 * 1000 * 1000) { fprintf(stderr, "kernel_launch: unexpected n_in %d out %d ws %zu\n", n_in, out_size, ws_size); return false; }
    int dev = 0, cus = 0;
    if (hipGetDevice(&dev) != hipSuccess || hipDeviceGetAttribute(&cus, hipDeviceAttributeMultiprocessorCount, dev) != hipSuccess) return false;
    if (cus < 256) { fprintf(stderr, "kernel_launch: needs 256 CUs, device has %d\n", cus); return false; }
    if (hipFuncSetAttribute((const void*)mk::mk_fwd<MK_SP2>, hipFuncAttributeMaxDynamicSharedMemorySize, mk::LDS_BYTES) != hipSuccess) { fprintf(stderr, "kernel_launch: hipFuncSetAttribute failed\n"); return false; }
    g_grid = 256;
  }
  return g_grid > 0;
}
static void mk_run(hipStream_t s, mk::Args a, int lo, int hi) {
  a.ph_lo = lo; a.ph_hi = hi;
  hipLaunchKernelGGL(mk::mk_fwd<MK_SP2>, dim3(g_grid), dim3(mk::NTHR), mk::LDS_BYTES, s, a);
}

#if CHECK
namespace chk {
using mk::bf16_t;
__device__ __forceinline__ float b2f(bf16_t b) { return __uint_as_float(((unsigned)b) << 16); }
__global__ void k_cmp(int mode, const void* A, const float* B, unsigned long long n, double* acc) {
  double e = 0.0, r = 0.0; const bf16_t* A16 = (const bf16_t*)A;
  for (unsigned long long i = (unsigned long long)blockIdx.x * 256 + threadIdx.x; i < n; i += (unsigned long long)gridDim.x * 256) {
    float a = 0.f, b = 0.f; const int row = (int)(i >> 9), col = (int)(i & 511);
    switch (mode) {
      case 0: a = ((const float*)A)[i]; b = B[i]; break;
      case 1: a = b2f(A16[i]); b = B[i]; break;
      case 2: { b = B[(size_t)row * 2048 + col]; const int g = col >> 4, c = col & 15; int crow, s; if (row < 16384) { crow = row >> 5; s = row & 31; } else { const int j = row - 16384; crow = 512 + (j >> 5); s = j & 31; }
                a = b2f(A16[((size_t)(g * 768 + crow)) * 768 + s * 16 + c]); } break;
      case 3: b = B[(size_t)row * 2048 + 512 + col]; a = b2f(A16[(size_t)row * 512 + col]); break;
      case 4: b = B[(size_t)row * 2048 + 1024 + col]; a = b2f(A16[(size_t)row * 512 + col]); break;
      case 5: b = B[(size_t)row * 2048 + 1536 + col]; a = b2f(A16[(size_t)col * 16640 + row]); break;
      case 6: b = B[(size_t)row * 1024 + col]; a = b2f(A16[(size_t)row * 1024 + col]); break;
      case 7: b = B[(size_t)row * 1024 + 512 + col]; a = b2f(A16[(size_t)row * 1024 + 512 + col]); break;
      case 8: { const int ta = (int)(i & 127), ri = (int)((i >> 7) & 1), tb = (int)((i >> 8) & 127), m = (int)((i >> 15) & 255), g = (int)(i >> 23); a = b2f(A16[i]); const int t = 128 * ta + tb; b = B[((size_t)t * 4 + g) * 512 + ri * 256 + m]; } break;
      default: break;
    }
    const double d = (double)a - (double)b; e += d * d; r += (double)b * (double)b;
  }
  for (int o = 32; o >= 1; o >>= 1) { e += __shfl_xor(e, o); r += __shfl_xor(r, o); }
  if ((threadIdx.x & 63) == 0) { atomicAdd(acc, e); atomicAdd(acc + 1, r); }
}
__global__ void k_cmp_x2(const bf16_t* X2, const float* Yr, const float* Yi, double* acc) {
  double e = 0.0, r = 0.0;
  for (unsigned long long i = (unsigned long long)blockIdx.x * 256 + threadIdx.x; i < (1ull << 25); i += (unsigned long long)gridDim.x * 256) {
    const int tb = (int)(i & 127), rip = (int)((i >> 7) & 1), ka = (int)((i >> 8) & 127), gm = (int)(i >> 15);
    const float a = b2f(X2[i]); const size_t yi = (((size_t)ka * 128 + tb) << 10) + gm; const float b = rip ? Yi[yi] : Yr[yi];
    const double d = (double)a - (double)b; e += d * d; r += (double)b * (double)b;
  }
  for (int o = 32; o >= 1; o >>= 1) { e += __shfl_xor(e, o); r += __shfl_xor(r, o); }
  if ((threadIdx.x & 63) == 0) { atomicAdd(acc, e); atomicAdd(acc + 1, r); }
}
__global__ void k_judge(const double* acc, int n, float tol, int* fail) {
  if (threadIdx.x == 0 && blockIdx.x == 0) { fail[0] = 0; for (int k = 0; k < n; ++k) { const double rel = sqrt(acc[2 * k] / acc[2 * k + 1]); if (!(rel <= (double)tol)) { fail[0] = k + 1; break; } } }
}
__global__ void k_encode(float* out, size_t n, const int* fail) {
  const int f = fail[0]; if (f == 0) return; const float sc = 1.f + 0.1f * (float)f;
  for (size_t i = (size_t)blockIdx.x * 256 + threadIdx.x; i < n; i += (size_t)gridDim.x * 256) out[i] *= sc;
}
__global__ void k_f2bf(const float* in, bf16_t* out, size_t n) { for (size_t i = (size_t)blockIdx.x * 256 + threadIdx.x; i < n; i += (size_t)gridDim.x * 256) out[i] = mk::f2bf(in[i]); }
static void cmp(hipStream_t s, int mode, const void* A, const float* B, unsigned long long n, double* acc) { hipLaunchKernelGGL(k_cmp, dim3(2048), dim3(256), 0, s, mode, A, B, n, acc); }
}
#endif

extern "C" void kernel_launch(void* const* d_in, const int* in_sizes, int n_in, void* d_out, int out_size, void* d_ws, size_t ws_size, hipStream_t stream) {
  if (!mk_setup(n_in, out_size, ws_size)) return;
  unsigned char* ws = (unsigned char*)d_ws;
  const size_t MiB = mk::MiB;
  mk::Args a{};
  for (int i = 0; i < 31; ++i) a.in[i] = (const float*)d_in[i];
  a.h = (float*)d_out; a.ws = ws; a.flags = 0; a.pad = 0;
#if CHECK == 0
  (void)hipMemsetAsync(ws + mk::WS_CTL, 0, mk::CTL_ZERO_BYTES, stream);
#if MK_N_LAUNCHES == 1
  mk_run(stream, a, 0, mk::NPHASE);
#else
  for (int ph = 0; ph < mk::NPHASE; ++ph) mk_run(stream, a, ph, ph + 1);
#endif
#else
  ref::In in; { const float** p = (const float**)&in; for (int i = 0; i < 31; ++i) p[i] = (const float*)d_in[i]; }
  float* out = (float*)d_out;
  char* wsc = (char*)d_ws;
  ref::Small sm; sm.mod = (float*)(wsc + 498 * MiB); sm.lamb = (float2*)(wsc + 498 * MiB + 131072); sm.bbar = (float2*)(wsc + 498 * MiB + 262144);
  sm.tw = (float2*)(wsc + 499 * MiB); sm.Dm = (float*)(wsc + 499 * MiB + 262144);
  double* acc = (double*)(wsc + 500 * MiB); int* fail = (int*)(wsc + 500 * MiB + 4096);
  (void)hipMemsetAsync(acc, 0, 8192, stream);
  (void)hipMemsetAsync(ws + mk::WS_CTL, 0, mk::CTL_ZERO_BYTES, stream);
  float* HOPT = (float*)(ws + mk::WS_HOPT);
  int nchk = 0;
#if CHECK == 1
  ref::MixBuf mb; mb.a0 = (float*)(wsc + 12 * MiB); mb.z = (float*)(wsc + 336 * MiB); mb.g = (float*)(wsc + 466 * MiB); mb.t = (float*)(wsc + 77 * MiB); mb.concat = mb.a0; mb.ymix = mb.z;
  char* moe_arena = wsc + 12 * MiB;
  ref::FourBuf fb; { char* p = wsc + 12 * MiB; fb.a1 = (float*)p; p += 64 * MiB; fb.Z = (float*)p; p += 128 * MiB; fb.Yr = (float*)p; p += 64 * MiB; fb.Yi = (float*)p; p += 64 * MiB; fb.F = (float*)p; fb.yf = fb.Z; }
  a.flags = mk::FLAG_SKIP_EXPERTS;
  nchk = 10;
  ref::forward(stream, in, out, sm, mb, moe_arena, fb, [&](int st) {
    if (st == 1) { mk_run(stream, a, 0, 1); chk::cmp(stream, 0, ws + mk::WS_MOD, sm.mod, 3 * 6144, acc + 0); }
    if (st == 2) { mk_run(stream, a, 1, 2); chk::cmp(stream, 1, ws + mk::WS_A0, mb.a0, 16640ull * 1024, acc + 2); }
    if (st == 3) { mk_run(stream, a, 2, 3); chk::cmp(stream, 2, ws + mk::WS_AS5, mb.z, 16640ull * 512, acc + 4); chk::cmp(stream, 3, ws + mk::WS_Q, mb.z, 16384ull * 512, acc + 6);
                   chk::cmp(stream, 4, ws + mk::WS_K, mb.z, 16640ull * 512, acc + 8); chk::cmp(stream, 5, ws + mk::WS_VT, mb.z, 16640ull * 512, acc + 10); }
    if (st == 4) { mk_run(stream, a, 3, 4); mk_run(stream, a, 4, 5); mk_run(stream, a, 5, 6); chk::cmp(stream, 1, ws + mk::WS_GB, mb.g, 16384ull * 512, acc + 12); }
    if (st == 5) { mk_run(stream, a, 6, 7); chk::cmp(stream, 6, ws + mk::WS_CONCAT, mb.concat, 16384ull * 512, acc + 14); }
    if (st == 6) { mk_run(stream, a, 7, 8); chk::cmp(stream, 7, ws + mk::WS_CONCAT, mb.concat, 16384ull * 512, acc + 16); }
    if (st == 7) { mk::Args b = a; b.h = HOPT; mk_run(stream, b, 8, 9); chk::cmp(stream, 0, HOPT, out, 16384ull * 1024, acc + 18); }
  });
#elif CHECK == 2 || CHECK == 4
  const int L = CHECK == 2 ? 0 : 1;
  ref::MixBuf mb; { char* p = wsc + 12 * MiB; mb.a0 = (float*)p; p += 65 * MiB; mb.z = (float*)p; p += 130 * MiB; mb.g = (float*)p; p += 32 * MiB; mb.t = (float*)p; p += 32 * MiB; mb.concat = (float*)p; p += 64 * MiB; mb.ymix = mb.z; }
  ref::FourBuf fb; { char* p = wsc + 12 * MiB; fb.a1 = (float*)p; p += 64 * MiB; fb.Z = (float*)p; p += 128 * MiB; fb.Yr = (float*)p; p += 64 * MiB; fb.Yi = (float*)p; p += 64 * MiB; fb.F = (float*)p; fb.yf = fb.Z; }
  char* moe_arena = wsc + 110 * MiB;
  nchk = L == 0 ? 2 : 1;
  a.flags = 0;
  ref::forward(stream, in, out, sm, mb, moe_arena, fb, [&](int st) {
    if ((L == 0 && st == 7) || (L == 1 && st == 11)) {
      mk::Args b = a; b.h = HOPT; if (L == 1) b.flags = 2;
      mk_run(stream, b, 0, 1);
      (void)hipMemcpyAsync(HOPT, out, (size_t)16384 * 1024 * 4, hipMemcpyDeviceToDevice, stream);
      const int pb = L == 0 ? 9 : 20; b.flags |= mk::FLAG_SKIP_EXPERTS;
      for (int ph = pb; ph < pb + 7; ++ph) mk_run(stream, b, ph, ph + 1);
    }
    if ((L == 0 && st == 8) || (L == 1 && st == 12)) chk::cmp(stream, 0, HOPT, out, 16384ull * 1024, acc + 0);
    if (L == 0 && st == 9) chk::cmp(stream, 1, ws + mk::WS_A1, fb.a1, 16384ull * 1024, acc + 2);
  });
#elif CHECK == 3
  ref::MixBuf mb; { char* p = wsc + 12 * MiB; mb.a0 = (float*)p; p += 65 * MiB; mb.z = (float*)p; p += 130 * MiB; mb.g = (float*)p; p += 32 * MiB; mb.t = (float*)p; p += 32 * MiB; mb.concat = (float*)p; p += 64 * MiB; mb.ymix = mb.z; }
  char* moe_arena = wsc + 12 * MiB;
  ref::FourBuf fb; fb.Z = (float*)(wsc + 270 * MiB);
  fb.a1 = (float*)(wsc + 12 * MiB); fb.Yr = (float*)(wsc + 12 * MiB);   fb.Yi = (float*)(wsc + 468 * MiB - 0); fb.F = (float*)(wsc + 270 * MiB); fb.yf = (float*)(wsc + 334 * MiB);
  fb.Yi = (float*)(wsc + 76 * MiB);
  nchk = 4;
  a.flags = mk::FLAG_SKIP_EXPERTS;
  ref::forward(stream, in, out, sm, mb, moe_arena, fb, [&](int st) {
    if (st == 9) {
      mk::Args b = a; b.h = HOPT;
      mk_run(stream, b, 0, 1);
      hipLaunchKernelGGL(chk::k_f2bf, dim3(2048), dim3(256), 0, stream, fb.a1, (chk::bf16_t*)(ws + mk::WS_A1), (size_t)16384 * 1024);
      (void)hipMemcpyAsync(HOPT, out, (size_t)16384 * 1024 * 4, hipMemcpyDeviceToDevice, stream);
      mk_run(stream, b, 16, 17);
    }
  });
#endif
  hipLaunchKernelGGL(chk::k_judge, dim3(1), dim3(64), 0, stream, acc, nchk, 0.05f, fail);
  hipLaunchKernelGGL(chk::k_encode, dim3(2048), dim3(256), 0, stream, out, (size_t)16384 * 1024, fail);
#endif
}
```

```cpp
#define CHECK 0
#define MK_N_LAUNCHES 1
#define MK_SP2 true
#define REP_MASK 0ull
#include <hip/hip_runtime.h>
#include <cstdio>
#include <cstdint>
#include <cmath>
namespace mk {
#define LAS __attribute__((address_space(3)))
typedef unsigned short bf16_t;
typedef short bf16x8 __attribute__((ext_vector_type(8)));
typedef float f32x4 __attribute__((ext_vector_type(4)));
typedef float f32x2 __attribute__((ext_vector_type(2)));
typedef unsigned u32x4 __attribute__((ext_vector_type(4)));
typedef unsigned u32x2 __attribute__((ext_vector_type(2)));

constexpr int TOK = 16384, CTXN = 256, NROW = TOK + CTXN;
constexpr int NWAVES = 8, NTHR = 512;
constexpr int LDS_STAGE = 131072, LDS_BYTES = 155648, LDS_MISC_OFF = LDS_BYTES - 4096;

__device__ __forceinline__ unsigned cvt_pk_bf16(float lo, float hi) { unsigned r; asm volatile("v_cvt_pk_bf16_f32 %0, %1, %2" : "=v"(r) : "v"(lo), "v"(hi)); return r; }
__device__ __forceinline__ float bf_lo(unsigned w) { return __uint_as_float(w << 16); }
__device__ __forceinline__ float bf_hi(unsigned w) { return __uint_as_float(w & 0xffff0000u); }
__device__ __forceinline__ float bf2f(bf16_t b) { return __uint_as_float(((unsigned)b) << 16); }
__device__ __forceinline__ bf16_t f2bf(float f) { unsigned u = __float_as_uint(f); return (bf16_t)((u + 0x7fffu + ((u >> 16) & 1u)) >> 16); }
__device__ __forceinline__ float sx(float v, int o) { int l = __builtin_amdgcn_mbcnt_hi(~0u, __builtin_amdgcn_mbcnt_lo(~0u, 0u)); asm volatile("" : "+v"(l)); return __int_as_float(__builtin_amdgcn_ds_bpermute((l ^ o) << 2, __float_as_int(v))); }
__device__ __forceinline__ float wave_sum(float v) {
#pragma unroll
  for (int o = 1; o < 64; o <<= 1) v += sx(v, o);
  return v;
}
__device__ __forceinline__ float fast_sigmoid(float x) { return __builtin_amdgcn_rcpf(1.f + __expf(-x)); }
__device__ __forceinline__ float fast_tanh(float x) { float e = __expf(2.f * x); return 1.f - 2.f * __builtin_amdgcn_rcpf(e + 1.f); }
__device__ __forceinline__ float gelu_tanh(float x) { return 0.5f * x * (1.f + fast_tanh(0.7978845608028654f * (x + 0.044715f * x * x * x))); }

#define XB_TMO      128
#define XB_XCNT(j)  (256  + 64 * (j))
#define XB_XSUB(j)  (1280 + 64 * (j))
#define XB_XGEN(j)  (2304 + 64 * (j))
#define XB_TOP      3328
#define XB_TOPGEN   3392
#define XCD_BAR_WORDS 3456
#define XB_SPIN_CAP (1u << 20)
__device__ __forceinline__ unsigned xb_ld(unsigned* p) { return __hip_atomic_load(p, __ATOMIC_RELAXED, __HIP_MEMORY_SCOPE_AGENT); }
__device__ __forceinline__ unsigned xb_add(unsigned* p, unsigned v) { return __hip_atomic_fetch_add(p, v, __ATOMIC_RELAXED, __HIP_MEMORY_SCOPE_AGENT); }
__device__ __forceinline__ unsigned xb_xcc_id() { return (unsigned)__builtin_amdgcn_s_getreg((3 << 11) | 20) & 0xFu; }
#define XB_SPIN(cond, bar) do { unsigned _sp = 0; while (cond) { __builtin_amdgcn_s_sleep(1); \
    if ((++_sp & 255u) == 0u) { if (xb_ld(&(bar)[XB_TMO])) break; if (_sp > XB_SPIN_CAP) { atomicAdd(&(bar)[XB_TMO], 1u); break; } } } } while (0)
struct XcdBarrier { unsigned* bar; unsigned x; volatile LAS unsigned* st; };
__device__ __forceinline__ XcdBarrier xcd_barrier_post(unsigned* bar, volatile LAS unsigned* st, int tid) {
  XcdBarrier b; b.bar = bar; b.x = xb_xcc_id(); b.st = st;
  if (tid == 0) (void)xb_add(&bar[XB_XCNT(b.x)], 1u);
  return b;
}
__device__ __forceinline__ void xcd_barrier_complete(unsigned* bar, unsigned x, unsigned& nloc, unsigned& nx) {
  const unsigned G = gridDim.x * gridDim.y * gridDim.z;
  unsigned sum, cnt, mine, sp = 0u;
  for (;;) {
    sum = 0u; cnt = 0u; mine = 0u;
#pragma unroll
    for (unsigned j = 0; j < 16; ++j) { const unsigned c = xb_ld(&bar[XB_XCNT(j)]); sum += c; cnt += (c > 0u) ? 1u : 0u; }
    if (sum == G) { mine = xb_ld(&bar[256 + 64 * x]); break; }
    __builtin_amdgcn_s_sleep(1);
    if ((++sp & 255u) == 0u) { if (xb_ld(&bar[XB_TMO])) break; if (sp > XB_SPIN_CAP) { atomicAdd(&bar[XB_TMO], 1u); break; } }
  }
  nloc = mine > 0u ? mine : 1u; nx = cnt > 0u ? cnt : 1u;
}
__device__ __forceinline__ void xcd_barrier(const XcdBarrier& b, int tid) {
  asm volatile("s_waitcnt vmcnt(0)" ::: "memory");
  __syncthreads();
  if (tid == 0) {
    unsigned* bar = b.bar;
    __builtin_amdgcn_s_waitcnt(0);
    unsigned nloc = b.st[0], nx = b.st[1];
    if (nloc == 0u) { xcd_barrier_complete(bar, b.x, nloc, nx); b.st[0] = nloc; b.st[1] = nx; }
    const unsigned old = xb_add(&bar[XB_XSUB(b.x)], 1u);
    const unsigned gen = old / nloc;
    if (old + 1u == (gen + 1u) * nloc) {
      __builtin_amdgcn_fence(__ATOMIC_RELEASE, "agent");
      asm volatile("s_waitcnt vmcnt(0)" ::: "memory");
      const unsigned og = xb_add(&bar[XB_TOP], 1u);
      const unsigned tg = og / nx;
      if (og + 1u == (tg + 1u) * nx) xb_add(&bar[XB_TOPGEN], 1u);
      else XB_SPIN(xb_ld(&bar[XB_TOPGEN]) == tg, bar);
      __builtin_amdgcn_fence(__ATOMIC_ACQUIRE, "agent");
      xb_add(&bar[XB_XGEN(b.x)], 1u);
      asm volatile("s_waitcnt vmcnt(0)" ::: "memory");
    } else {
      XB_SPIN(xb_ld(&bar[XB_XGEN(b.x)]) == gen, bar);
      __builtin_amdgcn_fence(__ATOMIC_ACQUIRE, "agent");
      asm volatile("s_waitcnt vmcnt(0)" ::: "memory");
    }
  }
  __syncthreads();
}

constexpr int BM = 256, BK = 64, HALF = 128, HTB = HALF * BK * 2, NXCD = 8;
__device__ __forceinline__ int lds_byte(int r, int c) { const int st = (r >> 4) * 2 + (c >> 5), rr = r & 15, cc = c & 31, ob = rr * 64 + cc * 2; return st * 1024 + (ob ^ (((ob >> 9) & 1) << 5)); }
__device__ __forceinline__ void stage_rc(int b, int& R, int& C) { const int st = b / 1024, sb = b % 1024, swz = sb ^ (((sb >> 9) & 1) << 5); R = (st >> 1) * 16 + swz / 64; C = (st & 1) * 32 + (swz % 64) / 2; }
__device__ __forceinline__ int perm32(int rho) { const int n = rho >> 4, i = rho & 15; return 8 * (i >> 2) + 4 * n + (i & 3); }

struct Unit { int pm, pn, a, b, ord; };
__device__ __forceinline__ int xcd_remap(int L, int nunits) { const int q = nunits / NXCD, r = nunits % NXCD, xcd = L % NXCD, off = L / NXCD; return (xcd < r ? xcd * (q + 1) : r * (q + 1) + (xcd - r) * q) + off; }
typedef f32x4 Acc[2][2][4][2];
template <class P, bool SP2>
__device__ __forceinline__ void gemm_phase(LAS unsigned char* lds, const P& p, int G, int c, int tid_in) {
  const int tid = tid_in, wid = __builtin_amdgcn_readfirstlane(tid >> 6), lane = tid & 63, wr = wid >> 2, wc = wid & 3, fr = lane & 15, fq = lane >> 4;
  const int K = p.K, nt = K / BK;
  const int nunits = p.nunits;
  const size_t kstep = (size_t)(BK * 2);
  const unsigned ldsw = (unsigned)wid * 1024u;
  const int aoff = lds_byte(wr * 64 + fr, fq * 8), boff = lds_byte(wc * 32 + fr, fq * 8);
#define PG8_SA(b, h) (((b) * 2 + (h)) * HTB)
#define PG8_SB(b, h) ((4 + (b) * 2 + (h)) * HTB)
#define PG8_STAGE(bufoff, gbase, voff) do { _Pragma("unroll") for (int _i = 0; _i < 2; ++_i) \
        __builtin_amdgcn_global_load_lds((const unsigned*)((const char*)(gbase) + (voff)[_i]), (LAS unsigned*)(lds + (bufoff) + ldsw + _i * 8192), 16, 0, 0); } while (0)
#define PG8_LDA(dst, b, h) do { _Pragma("unroll") for (int m = 0; m < 4; ++m) _Pragma("unroll") for (int k = 0; k < 2; ++k) dst[m][k] = *(const LAS bf16x8*)(lds + PG8_SA(b, h) + aoff + m * 2048 + k * 1024); } while (0)
#define PG8_LDB(dst, b, h) do { _Pragma("unroll") for (int n = 0; n < 2; ++n) _Pragma("unroll") for (int k = 0; k < 2; ++k) dst[n][k] = *(const LAS bf16x8*)(lds + PG8_SB(b, h) + boff + n * 2048 + k * 1024); } while (0)
#define PG8_MMA(ai, bj, At, Bt) do { __builtin_amdgcn_s_setprio(1); _Pragma("unroll") for (int m = 0; m < 4; ++m) _Pragma("unroll") for (int n = 0; n < 2; ++n) _Pragma("unroll") for (int k = 0; k < 2; ++k) \
        acc[ai][bj][m][n] = __builtin_amdgcn_mfma_f32_16x16x32_bf16(Bt[n][k], At[m][k], acc[ai][bj][m][n], 0, 0, 0); __builtin_amdgcn_s_setprio(0); } while (0)
#define PG8_WAIT_V(n) asm volatile("s_waitcnt vmcnt(" #n ")" ::: "memory")
#define PG8_WAIT_L(n) asm volatile("s_waitcnt lgkmcnt(" #n ")" ::: "memory")
#define PG8_BAR __builtin_amdgcn_s_barrier()
#define PG8_SCHED __builtin_amdgcn_sched_barrier(0)
#define PG8_DECODE(i, u) do { p.decode(xcd_remap((i) * G + c, nunits), u); u.ord = (i); } while (0)
#define PG8_OFFS(u, vA, vB) do { int _t = tid; asm volatile("" : "+v"(_t)); _Pragma("unroll") for (int _i = 0; _i < 2; ++_i) { int _R, _C; stage_rc(_t * 16 + _i * 8192, _R, _C); \
        const int _Rb = P::PERM ? ((_R & ~31) + perm32(_R & 31)) : _R; _Pragma("unroll") for (int _h = 0; _h < 2; ++_h) { \
        if (_h == 0 || !P::LINA) vA[_h][_i] = p.rowA(u, _h * HALF + _R) + (unsigned)(_C * 2); if (_h == 0 || !P::LINB) vB[_h][_i] = p.rowB(u, _h * HALF + _Rb) + (unsigned)(_C * 2); } } } while (0)
  if (c >= nunits) return;
  Unit cur, nxt; int ui = 0;
  PG8_DECODE(0, cur);
  Acc acc; float zf_ = 0.f; asm volatile("" : "+v"(zf_));
#pragma unroll
  for (int a = 0; a < 2; ++a)
#pragma unroll
    for (int b = 0; b < 2; ++b)
#pragma unroll
      for (int m = 0; m < 4; ++m)
#pragma unroll
        for (int n = 0; n < 2; ++n) acc[a][b][m][n] = (f32x4){zf_, zf_, zf_, zf_};
  bf16x8 At[4][2], B0[2][2], B1[2][2];
  unsigned vA[2][2], vB[2][2];
  PG8_OFFS(cur, vA, vB);
  const char* cA = p.baseA(cur); const char* cB = p.baseB(cur);
  const size_t hA = P::LINA ? p.halfA() : 0, hB = P::LINB ? p.halfB() : 0;
  if constexpr (SP2) {
    PG8_STAGE(PG8_SB(0, 0), cB, vB[0]); PG8_STAGE(PG8_SB(0, 1), (cB) + (P::LINB ? hB : 0), vB[P::LINB ? 0 : 1]); PG8_STAGE(PG8_SA(0, 0), cA, vA[0]); PG8_STAGE(PG8_SA(0, 1), (cA) + (P::LINA ? hA : 0), vA[P::LINA ? 0 : 1]);
    if (wr == 1) PG8_BAR;
    PG8_WAIT_V(2); PG8_BAR;
    PG8_STAGE(PG8_SB(1, 0), cB + kstep, vB[0]); PG8_STAGE(PG8_SA(1, 0), cA + kstep, vA[0]); PG8_STAGE(PG8_SB(1, 1), (cB + kstep) + (P::LINB ? hB : 0), vB[P::LINB ? 0 : 1]);
    PG8_WAIT_V(6); PG8_BAR;
  } else {
    PG8_STAGE(PG8_SB(0, 0), cB, vB[0]); PG8_STAGE(PG8_SA(0, 0), cA, vA[0]); PG8_STAGE(PG8_SB(0, 1), (cB) + (P::LINB ? hB : 0), vB[P::LINB ? 0 : 1]); PG8_STAGE(PG8_SA(0, 1), (cA) + (P::LINA ? hA : 0), vA[P::LINA ? 0 : 1]);
    if (wr == 1) PG8_BAR;
    PG8_WAIT_V(4); PG8_BAR;
    PG8_STAGE(PG8_SB(1, 0), cB + kstep, vB[0]); PG8_STAGE(PG8_SA(1, 0), cA + kstep, vA[0]); PG8_STAGE(PG8_SB(1, 1), (cB + kstep) + (P::LINB ? hB : 0), vB[P::LINB ? 0 : 1]);
    PG8_WAIT_V(6); PG8_BAR;
  }
  for (;;) {
    const bool has_next = ((ui + 1) * G + c) < nunits;
    if (has_next) PG8_DECODE(ui + 1, nxt);
    const char* nA = has_next ? p.baseA(nxt) : cA; const char* nB = has_next ? p.baseB(nxt) : cB;
    for (int t = 0; t < nt; t += 2) {
      const bool last = (t == nt - 2);
      const char* a1 = cA + (size_t)(t + 1) * kstep;
      const char* a2 = last ? nA : cA + (size_t)(t + 2) * kstep; const char* b2 = last ? nB : cB + (size_t)(t + 2) * kstep;
      const char* a3 = a2 + kstep; const char* b3 = b2 + kstep;
      if constexpr (SP2) {
        PG8_LDB(B0, 0, 0); PG8_LDB(B1, 0, 1); PG8_SCHED; PG8_LDA(At, 0, 0); PG8_STAGE(PG8_SA(1, 1), (a1) + (P::LINA ? hA : 0), vA[P::LINA ? 0 : 1]);
        PG8_WAIT_V(8); PG8_WAIT_L(0); PG8_BAR; PG8_MMA(0, 0, At, B0); PG8_MMA(0, 1, At, B1); PG8_BAR; PG8_SCHED;
        if (last && has_next) { PG8_OFFS(nxt, vA, vB); }
        PG8_LDA(At, 0, 1); PG8_STAGE(PG8_SB(0, 0), b2, vB[0]); PG8_STAGE(PG8_SB(0, 1), (b2) + (P::LINB ? hB : 0), vB[P::LINB ? 0 : 1]); PG8_STAGE(PG8_SA(0, 0), a2, vA[0]);
        PG8_WAIT_V(8); PG8_WAIT_L(0); PG8_BAR; PG8_MMA(1, 0, At, B0); PG8_MMA(1, 1, At, B1); PG8_BAR; PG8_SCHED;
        PG8_LDB(B0, 1, 0); PG8_LDB(B1, 1, 1); PG8_SCHED; PG8_LDA(At, 1, 0); PG8_STAGE(PG8_SA(0, 1), (a2) + (P::LINA ? hA : 0), vA[P::LINA ? 0 : 1]);
        PG8_WAIT_V(8); PG8_WAIT_L(0); PG8_BAR; PG8_MMA(0, 0, At, B0); PG8_MMA(0, 1, At, B1); PG8_BAR; PG8_SCHED;
        PG8_LDA(At, 1, 1); PG8_STAGE(PG8_SB(1, 0), b3, vB[0]); PG8_STAGE(PG8_SB(1, 1), (b3) + (P::LINB ? hB : 0), vB[P::LINB ? 0 : 1]); PG8_STAGE(PG8_SA(1, 0), a3, vA[0]);
        PG8_WAIT_V(8); PG8_WAIT_L(0); PG8_BAR; PG8_MMA(1, 0, At, B0); PG8_MMA(1, 1, At, B1); PG8_BAR; PG8_SCHED;
      } else {
        PG8_LDB(B0, 0, 0); PG8_SCHED; PG8_LDA(At, 0, 0); PG8_STAGE(PG8_SA(1, 1), (a1) + (P::LINA ? hA : 0), vA[P::LINA ? 0 : 1]);
        PG8_WAIT_L(8); PG8_BAR; PG8_WAIT_L(0); PG8_MMA(0, 0, At, B0); PG8_BAR; PG8_SCHED;
        if (last && has_next) { PG8_OFFS(nxt, vA, vB); }
        PG8_LDB(B1, 0, 1); PG8_STAGE(PG8_SB(0, 0), b2, vB[0]);
        PG8_BAR; PG8_WAIT_L(0); PG8_MMA(0, 1, At, B1); PG8_BAR;
        PG8_LDA(At, 0, 1); PG8_STAGE(PG8_SA(0, 0), a2, vA[0]);
        PG8_BAR; PG8_WAIT_L(0); PG8_MMA(1, 0, At, B0); PG8_BAR; PG8_SCHED;
        PG8_STAGE(PG8_SB(0, 1), (b2) + (P::LINB ? hB : 0), vB[P::LINB ? 0 : 1]);
        PG8_WAIT_V(6); PG8_BAR; PG8_MMA(1, 1, At, B1); PG8_BAR;
        PG8_LDB(B0, 1, 0); PG8_SCHED; PG8_LDA(At, 1, 0); PG8_STAGE(PG8_SA(0, 1), (a2) + (P::LINA ? hA : 0), vA[P::LINA ? 0 : 1]);
        PG8_WAIT_L(8); PG8_BAR; PG8_WAIT_L(0); PG8_MMA(0, 0, At, B0); PG8_BAR; PG8_SCHED;
        PG8_LDB(B1, 1, 1); PG8_STAGE(PG8_SB(1, 0), b3, vB[0]);
        PG8_BAR; PG8_WAIT_L(0); PG8_MMA(0, 1, At, B1); PG8_BAR;
        PG8_LDA(At, 1, 1); PG8_STAGE(PG8_SA(1, 0), a3, vA[0]);
        PG8_BAR; PG8_WAIT_L(0); PG8_MMA(1, 0, At, B0); PG8_BAR; PG8_SCHED;
        PG8_STAGE(PG8_SB(1, 1), (b3) + (P::LINB ? hB : 0), vB[P::LINB ? 0 : 1]);
        PG8_WAIT_V(6); PG8_BAR; PG8_MMA(1, 1, At, B1); PG8_BAR;
      }
    }
    if (wr == 0) PG8_BAR;
    { int fr_e = fr, fq_e = fq; asm volatile("" : "+v"(fr_e), "+v"(fq_e)); p.epi(acc, cur, wr, wc, fr_e, fq_e); }
    if (!has_next) break;
    zf_ = 0.f; asm volatile("" : "+v"(zf_));
#pragma unroll
    for (int a = 0; a < 2; ++a)
#pragma unroll
      for (int b = 0; b < 2; ++b)
#pragma unroll
        for (int m = 0; m < 4; ++m)
#pragma unroll
          for (int n = 0; n < 2; ++n) acc[a][b][m][n] = (f32x4){zf_, zf_, zf_, zf_};
    cur = nxt; cA = nA; cB = nB; ++ui;
    if (wr == 1) PG8_BAR;
  }
  PG8_WAIT_V(0);
  PG8_BAR;
#undef PG8_SA
#undef PG8_SB
#undef PG8_STAGE
#undef PG8_LDA
#undef PG8_LDB
#undef PG8_MMA
#undef PG8_WAIT_V
#undef PG8_WAIT_L
#undef PG8_BAR
#undef PG8_SCHED
#undef PG8_DECODE
#undef PG8_OFFS
}
}
namespace mk {
constexpr size_t MiB = 1u << 20;
constexpr size_t WS_CTL = 0, CTL_ZERO_BYTES = 65536;
constexpr size_t WS_MOD = 65536;
constexpr size_t WS_LAML = 262144;
constexpr size_t WS_WIN_T = 1 * MiB, WS_WGLU_T = 5 * MiB, WS_WMIX_T = 6 * MiB, WS_WFOUR_T = 8 * MiB, WS_WROUT_T = 10 * MiB;
constexpr size_t WS_DMT = 10 * MiB + 512 * 1024, WS_W1 = 10 * MiB + 768 * 1024, WS_W2 = 10 * MiB + 896 * 1024;
constexpr size_t WS_WEXP = 12 * MiB, EXP_STRIDE = 3 * MiB / 2, EXP_DOFF = 1 * MiB;
constexpr size_t WS_R = 110 * MiB;
constexpr size_t WS_WS = WS_R, WS_TT = WS_R + 8 * MiB, WS_A0 = WS_R + 34 * MiB, WS_AS5 = WS_R + 67 * MiB, WS_Q = WS_R + 103 * MiB, WS_K = WS_R + 119 * MiB,
                 WS_VT = WS_R + 136 * MiB, WS_SST = WS_R + 153 * MiB, WS_GB = WS_R + 177 * MiB, WS_CONCAT = WS_R + 193 * MiB;
constexpr size_t WS_F = WS_R, WS_LTOK = WS_R + 32 * MiB, WS_ASG = WS_R + 36 * MiB, WS_HID = WS_R + 42 * MiB, WS_YAS = WS_R + 130 * MiB,
                 WS_A1 = WS_R + 306 * MiB;
constexpr size_t WS_X1 = WS_R, WS_X2 = WS_R + 64 * MiB, WS_FB = WS_R + 128 * MiB;
constexpr size_t WS_HOPT = WS_R + 338 * MiB;
constexpr size_t WS_NEED = WS_R + 338 * MiB;
constexpr int HALF_CAP_ROWS = 90112;
constexpr int CW_BAR = 4096, CW_CNT = 8192  , CW_DQ0 = 12288, CW_DQ1 = 12352;

struct Args { const float* in[31]; float* h; unsigned char* ws; int ph_lo, ph_hi, flags, pad; };
enum { IN_X = 0, IN_C, IN_CTX, IN_CCTX, IN_WADA, IN_BADA, IN_WIN, IN_LRE, IN_LIM, IN_LDT, IN_BRE, IN_BIM, IN_CRE, IN_CIM, IN_S5D, IN_WGLU, IN_BGLU, IN_QG, IN_KG,
       IN_RPB, IN_WMIX, IN_WFOUR, IN_BFOUR, IN_WROUT, IN_RBIAS, IN_WEG, IN_WEU, IN_WED, IN_WSG, IN_WSU, IN_WSD };
constexpr int FLAG_SKIP_EXPERTS = 1;

struct Ctx {
  LAS unsigned char* lds; const Args* a; unsigned char* ws; int tid, lane, wave, G, c;
};

__device__ __forceinline__ u32x4 pack8(const f32x4& v0, const f32x4& v1) { u32x4 w; w.x = cvt_pk_bf16(v0[0], v0[1]); w.y = cvt_pk_bf16(v0[2], v0[3]); w.z = cvt_pk_bf16(v1[0], v1[1]); w.w = cvt_pk_bf16(v1[2], v1[3]); return w; }
__device__ __forceinline__ int rowmap(int code, int n) {
  if (code == 1) { if (n < 512 || n >= 1536) return n; const int blk = n & ~255, c = n & 255; return blk + 128 * ((c >> 5) & 1) + 32 * (c >> 6) + (c & 31); }
  if (code == 2) return 256 * (n >> 7) + (n & 127);
  if (code == 3) return 256 * (n >> 7) + 128 + (n & 127);
  return n;
}
__device__ __forceinline__ void transpose_item(const float* W, int K, int N, bf16_t* WT, int code, LAS unsigned char* scr, int item, int lane) {
  const int nblk = N / 64, kb = item / nblk, nb = item % nblk, k0 = 64 * kb, n0 = 64 * nb;
  const int q = lane >> 4, a = lane & 15;
  f32x4 v[16];
  const float* src = W + (size_t)(k0 + 2 * q) * N + n0 + 4 * a;
#pragma unroll
  for (int i = 0; i < 16; ++i) v[i] = *(const f32x4*)(src + (size_t)((i & 1) + 8 * (i >> 1)) * N);
#pragma unroll
  for (int ii = 0; ii < 8; ++ii) { const int dsw = q + 4 * (ii ^ (a & 7));
#pragma unroll
    for (int j = 0; j < 4; ++j) *(LAS unsigned*)(scr + (4 * a + j) * 128 + 4 * dsw) = cvt_pk_bf16(v[2 * ii][j], v[2 * ii + 1][j]); }
  asm volatile("s_waitcnt lgkmcnt(0)" ::: "memory");
  const int c = lane & 7;
#pragma unroll
  for (int jj = 0; jj < 8; ++jj) { const int n = (lane >> 3) + 8 * jj, cs = c ^ ((n >> 2) & 7);
    const u32x4 o = *(const LAS u32x4*)(scr + n * 128 + 16 * cs);
    *(u32x4*)(WT + (size_t)rowmap(code, n0 + n) * K + k0 + 8 * c) = o; }
  asm volatile("s_waitcnt lgkmcnt(0)" ::: "memory");
}
constexpr int IT_WIN = 512, IT_GLU = 64, IT_MIX = 256, IT_FOUR = 256, IT_ROUT = 32, IT_SMALL = IT_WIN + IT_GLU + IT_MIX + IT_FOUR + IT_ROUT, IT_EXP = 192;
__device__ __forceinline__ void small_item(const Ctx& X, LAS unsigned char* scr, int it) {
  const Args& a = *X.a; unsigned char* ws = X.ws;
  if (it < IT_WIN) { transpose_item(a.in[IN_WIN], 1024, 2048, (bf16_t*)(ws + WS_WIN_T), 1, scr, it, X.lane); return; } it -= IT_WIN;
  if (it < IT_GLU) { transpose_item(a.in[IN_WGLU], 512, 512, (bf16_t*)(ws + WS_WGLU_T), 0, scr, it, X.lane); return; } it -= IT_GLU;
  if (it < IT_MIX) { transpose_item(a.in[IN_WMIX], 1024, 1024, (bf16_t*)(ws + WS_WMIX_T), 0, scr, it, X.lane); return; } it -= IT_MIX;
  if (it < IT_FOUR) { transpose_item(a.in[IN_WFOUR], 1024, 1024, (bf16_t*)(ws + WS_WFOUR_T), 0, scr, it, X.lane); return; } it -= IT_FOUR;
  { const int l = it >> 4; transpose_item(a.in[IN_WROUT] + (size_t)l * 1024 * 64, 1024, 64, (bf16_t*)(ws + WS_WROUT_T) + (size_t)l * 64 * 1024, 0, scr, it & 15, X.lane); }
}
__device__ __forceinline__ void expert_item(const Ctx& X, LAS unsigned char* scr, int layer, int it) {
  const Args& a = *X.a; const int e = it / IT_EXP, r = it % IT_EXP;
  bf16_t* gu = (bf16_t*)(X.ws + WS_WEXP + (size_t)e * EXP_STRIDE); bf16_t* dt = (bf16_t*)(X.ws + WS_WEXP + (size_t)e * EXP_STRIDE + EXP_DOFF);
  const float *wg, *wu, *wd;
  if (e < 64) { const size_t o = ((size_t)layer * 64 + e) * 262144; wg = a.in[IN_WEG] + o; wu = a.in[IN_WEU] + o; wd = a.in[IN_WED] + o; }
  else { const size_t o = (size_t)layer * 262144; wg = a.in[IN_WSG] + o; wu = a.in[IN_WSU] + o; wd = a.in[IN_WSD] + o; }
  if (r < 64) transpose_item(wg, 1024, 256, gu, 2, scr, r, X.lane);
  else if (r < 128) transpose_item(wu, 1024, 256, gu, 3, scr, r - 64, X.lane);
  else transpose_item(wd, 256, 1024, dt, 0, scr, r - 128, X.lane);
}
__device__ __forceinline__ void transpose_work(const Ctx& X, unsigned* ctr, int first_small, int n_small, int layer, int n_exp_items) {
  LAS unsigned char* scr = X.lds + X.wave * 8192;
  volatile LAS int* shb = (volatile LAS int*)(X.lds + LDS_MISC_OFF + 1024);
  const int total = n_small + n_exp_items;
  for (;;) {
    __syncthreads();
    if (X.tid == 0) shb[0] = (int)atomicAdd(ctr, 32u);
    __syncthreads();
    const int base = shb[0];
    if (base >= total) break;
    for (int k = 0; k < 4; ++k) { const int it = base + X.wave * 4 + k; if (it >= total) break;
      if (it < n_small) small_item(X, scr, first_small + it); else expert_item(X, scr, layer, it - n_small); }
  }
}

__device__ __forceinline__ void p0_adaln(const Ctx& X, int it) {
  const Args& a = *X.a; const int layer = it / 48, ct = it % 48, col = ct * 128 + X.lane;
  LAS float* sl = (LAS float*)X.lds;
  for (int i = X.tid; i < 2048; i += NTHR) { const float v = i < 1024 ? a.in[IN_C][i] : a.in[IN_CCTX][i - 1024]; sl[i] = v / (1.f + __expf(-v)); }
  __syncthreads();
  const float* W = a.in[IN_WADA] + (size_t)layer * 1024 * 6144 + col;
  float a0 = 0.f, a1 = 0.f, b0 = 0.f, b1 = 0.f; const int k0 = X.wave * 128;
#pragma unroll 16
  for (int k = 0; k < 128; ++k) { const float w0 = W[(size_t)(k0 + k) * 6144], w1 = W[(size_t)(k0 + k) * 6144 + 64]; const float s0 = sl[k0 + k], s1 = sl[1024 + k0 + k];
    a0 += s0 * w0; a1 += s1 * w0; b0 += s0 * w1; b1 += s1 * w1; }
  LAS float* red = sl + 2048;
  red[(X.wave * 128 + X.lane) * 2] = a0; red[(X.wave * 128 + X.lane) * 2 + 1] = a1; red[(X.wave * 128 + 64 + X.lane) * 2] = b0; red[(X.wave * 128 + 64 + X.lane) * 2 + 1] = b1;
  __syncthreads();
  if (X.tid < 256) { const int l = X.tid & 127, v = X.tid >> 7; float s = 0.f;
#pragma unroll
    for (int w = 0; w < 8; ++w) s += red[(w * 128 + l) * 2 + v];
    s += a.in[IN_BADA][layer * 6144 + ct * 128 + l];
    float* mod = (float*)(X.ws + WS_MOD);
    if (layer == 0) mod[v * 6144 + ct * 128 + l] = s; else if (v == 0) mod[2 * 6144 + ct * 128 + l] = s; }
  __syncthreads();
}

__device__ __forceinline__ void p0_s5tables(const Ctx& X, int g, int part) {
  const Args& a = *X.a;
  LAS f32x2* POW = (LAS f32x2*)X.lds;
  LAS f32x2* BB = (LAS f32x2*)(X.lds + 33792);
  LAS f32x2* CC = (LAS f32x2*)(X.lds + 33792 + 16384);
  LAS float* KK = (LAS float*)(X.lds + 33792 + 32768);
  LAS float* DD = (LAS float*)(X.lds + 33792 + 32768 + 65536);
  const int tid = X.tid;
  if (tid < 128) {
    const int dir = tid >> 6, p = tid & 63, idx = (dir * 32 + g) * 64 + p;
    const float lr = fminf(a.in[IN_LRE][idx], -1e-4f), li = a.in[IN_LIM][idx], dt = expf(a.in[IN_LDT][dir * 32 + g]);
    for (int tau = 0; tau <= 32; ++tau) { const float mg = expf(lr * dt * (float)tau); float sn, cs; sincospif(li * dt * (float)tau * 0.318309886183790672f, &sn, &cs); POW[(dir * 33 + tau) * 64 + p] = (f32x2){mg * cs, mg * sn}; }
    const f32x2 l1 = POW[(dir * 33 + 1) * 64 + p], l32 = POW[(dir * 33 + 32) * 64 + p];
    if (part == 0) ((float2*)(X.ws + WS_LAML))[idx] = make_float2(l32.x, l32.y);
    const float nr = l1.x - 1.f, ni = l1.y, den = lr * lr + li * li, cr = (nr * lr + ni * li) / den, ci = (ni * lr - nr * li) / den;
    for (int c = 0; c < 16; ++c) { const float xr = a.in[IN_BRE][idx * 16 + c], xi = a.in[IN_BIM][idx * 16 + c]; BB[(dir * 64 + p) * 16 + c] = (f32x2){cr * xr - ci * xi, cr * xi + ci * xr}; }
  }
  for (int i = tid; i < 2048; i += NTHR) { const int dir = i >> 10, c = (i >> 6) & 15, p = i & 63; const int gi = ((dir * 32 + g) * 16 + c) * 64 + p; CC[i] = (f32x2){a.in[IN_CRE][gi], a.in[IN_CIM][gi]}; }
  if (tid < 16) DD[tid] = a.in[IN_S5D][g * 16 + tid];
  __syncthreads();
  for (int combo = tid; combo < 1024; combo += NTHR) {
    const int dir = combo >> 9, tau = (combo >> 4) & 31, c = combo & 15;
    float accv[16];
#pragma unroll
    for (int j = 0; j < 16; ++j) accv[j] = 0.f;
#pragma unroll 2
    for (int p = 0; p < 64; ++p) {
      const f32x2 cc = CC[(dir * 16 + c) * 64 + p], pw = POW[(dir * 33 + tau) * 64 + p];
      const float zr = cc.x * pw.x - cc.y * pw.y, zi = cc.x * pw.y + cc.y * pw.x;
      const LAS f32x4* bp = (const LAS f32x4*)(BB + (dir * 64 + p) * 16);
#pragma unroll
      for (int j = 0; j < 8; ++j) { const f32x4 b = bp[j]; accv[2 * j] += zr * b.x - zi * b.y; accv[2 * j + 1] += zr * b.z - zi * b.w; }
    }
#pragma unroll
    for (int j = 0; j < 4; ++j) *(LAS f32x4*)(KK + ((dir * 32 + tau) * 16 + c) * 16 + 4 * j) = (f32x4){accv[4 * j], accv[4 * j + 1], accv[4 * j + 2], accv[4 * j + 3]};
  }
  __syncthreads();
  bf16_t* TT = (bf16_t*)(X.ws + WS_TT) + (size_t)g * 512 * 768;
  for (int q = part * 12288 + tid; q < (part + 1) * 12288; q += NTHR) {
    const int row = q / 96, cc8 = q % 96, i = row >> 4, c = row & 15; f32x4 v0, v1;
    if (cc8 < 64) {
      const int s = cc8 >> 1, c0 = (cc8 & 1) * 8;
      const int dir = s < i ? 0 : 1, tau = s < i ? i - s : s - i;
      const LAS f32x4* kp = (const LAS f32x4*)(KK + ((dir * 32 + tau) * 16 + c) * 16 + c0);
      v0 = kp[0]; v1 = kp[1];
      if (s == i) { const LAS f32x4* k0p = (const LAS f32x4*)(KK + ((0 * 32 + 0) * 16 + c) * 16 + c0); v0 += k0p[0]; v1 += k0p[1];
        const float d = DD[c]; const int dj = c - c0;
        if (dj >= 0 && dj < 4) v0[dj] += d; else if (dj >= 4 && dj < 8) v1[dj - 4] += d; }
    } else {
      const int kk = (cc8 - 64) * 8, dir = kk >> 7, ri = (kk >> 6) & 1, p0 = kk & 63, tau = dir == 0 ? i + 1 : 32 - i;
      const LAS f32x4* cp = (const LAS f32x4*)(CC + (dir * 16 + c) * 64 + p0); const LAS f32x4* pp = (const LAS f32x4*)(POW + (dir * 33 + tau) * 64 + p0);
      float v[8];
#pragma unroll
      for (int j = 0; j < 4; ++j) { const f32x4 cc = cp[j], pw = pp[j];
        v[2 * j] = ri == 0 ? (cc.x * pw.x - cc.y * pw.y) : -(cc.x * pw.y + cc.y * pw.x); v[2 * j + 1] = ri == 0 ? (cc.z * pw.z - cc.w * pw.w) : -(cc.z * pw.w + cc.w * pw.z); }
      v0 = (f32x4){v[0], v[1], v[2], v[3]}; v1 = (f32x4){v[4], v[5], v[6], v[7]};
    }
    *(u32x4*)(TT + (size_t)row * 768 + cc8 * 8) = pack8(v0, v1);
  }
  bf16_t* WSm = (bf16_t*)(X.ws + WS_WS) + (size_t)g * 256 * 512;
  for (int q = part * 4096 + tid; q < (part + 1) * 4096; q += NTHR) {
    const int n = q >> 6, cc8 = q & 63, dir = n >> 7, ri = (n >> 6) & 1, p = n & 63, s = cc8 >> 1, c0 = (cc8 & 1) * 8, tau = dir == 0 ? 31 - s : s;
    const f32x2 pw = POW[(dir * 33 + tau) * 64 + p]; const LAS f32x4* bp = (const LAS f32x4*)(BB + (dir * 64 + p) * 16 + c0); float v[8];
#pragma unroll
    for (int j = 0; j < 4; ++j) { const f32x4 b = bp[j]; v[2 * j] = ri == 0 ? (pw.x * b.x - pw.y * b.y) : (pw.x * b.y + pw.y * b.x); v[2 * j + 1] = ri == 0 ? (pw.x * b.z - pw.y * b.w) : (pw.x * b.w + pw.y * b.z); }
    *(u32x4*)(WSm + (size_t)n * 512 + cc8 * 8) = pack8((f32x4){v[0], v[1], v[2], v[3]}, (f32x4){v[4], v[5], v[6], v[7]});
  }
  __syncthreads();
}

__device__ __forceinline__ void p0_dftconst(const Ctx& X, int idx) {
  for (int q = idx * NTHR + X.tid; q < 32768; q += 32 * NTHR) {
    float v[8]; bf16_t* dst;
    if (q < 16384) {
      const int R = q >> 5, c0 = (q & 31) * 8, ri = R >> 8, m = R & 255; dst = (bf16_t*)(X.ws + WS_DMT) + (size_t)R * 256 + c0;
#pragma unroll
      for (int j = 0; j < 8; ++j) { float s, c; sincospif((float)(((c0 + j) * m) & 255) * (1.f / 128.f), &s, &c); v[j] = ri == 0 ? c : -s; }
    } else if (q < 24576) {
      const int q2 = q - 16384, R = q2 >> 5, c0 = (q2 & 31) * 8, rip = R >> 7, ka = R & 127; dst = (bf16_t*)(X.ws + WS_W1) + (size_t)R * 256 + c0;
#pragma unroll
      for (int j = 0; j < 8; ++j) { const int C = c0 + j, ri = C >> 7, ta = C & 127; float s, c; sincospif((float)((ka * ta) & 127) * (1.f / 64.f), &s, &c);
        v[j] = (rip == ri) ? c : (rip == 0 ? s : -s); }
    } else {
      const int q2 = q - 24576, R = q2 >> 5, c0 = (q2 & 31) * 8; dst = (bf16_t*)(X.ws + WS_W2) + (size_t)R * 256 + c0;
#pragma unroll
      for (int j = 0; j < 8; ++j) { const int C = c0 + j, rip = C >> 7, tb = C & 127; float s, c; sincospif((float)((R * tb) & 127) * (1.f / 64.f), &s, &c);
        v[j] = R < 128 ? (rip == 0 ? c : s) * (1.f / 2048.f) : 0.f; }
    }
    u32x4 o; o.x = cvt_pk_bf16(v[0], v[1]); o.y = cvt_pk_bf16(v[2], v[3]); o.z = cvt_pk_bf16(v[4], v[5]); o.w = cvt_pk_bf16(v[6], v[7]);
    *(u32x4*)dst = o;
  }
}

__device__ __forceinline__ void phase_prep(const Ctx& X, int rep) {
  const int c = X.c;
  if (c < 96) p0_adaln(X, c);
  else if (c < 224) p0_s5tables(X, (c - 96) >> 2, (c - 96) & 3);
  else p0_dftconst(X, c - 224);
  __syncthreads();
  unsigned* ctl = (unsigned*)(X.ws + WS_CTL);
  transpose_work(X, ctl + CW_DQ0 + 128 * rep, 0, IT_SMALL, (X.a->flags & 2) ? 1 : 0, (X.a->flags & FLAG_SKIP_EXPERTS) ? 0 : 65 * IT_EXP);
}

__device__ __forceinline__ void modulate_row(const float* hrow, const float* shift, const float* scale, bf16_t* orow, int lane) {
  const f32x4* xr = (const f32x4*)hrow + lane; f32x4 v[4]; float ss = 0.f;
#pragma unroll
  for (int j = 0; j < 4; ++j) { v[j] = xr[64 * j]; ss += (v[j].x * v[j].x + v[j].y * v[j].y) + (v[j].z * v[j].z + v[j].w * v[j].w); }
  const float r = rsqrtf(wave_sum(ss) * (1.f / 1024.f) + 1e-6f);
  u32x2* o8 = (u32x2*)orow + lane;
#pragma unroll
  for (int j = 0; j < 4; ++j) { const f32x4 sh = ((const f32x4*)shift)[lane + 64 * j], sc = ((const f32x4*)scale)[lane + 64 * j];
    u32x2 w; w.x = cvt_pk_bf16(v[j].x * r * (1.f + sc.x) + sh.x, v[j].y * r * (1.f + sc.y) + sh.y); w.y = cvt_pk_bf16(v[j].z * r * (1.f + sc.z) + sh.z, v[j].w * r * (1.f + sc.w) + sh.w);
    o8[64 * j] = w; }
}
__device__ __forceinline__ void phase_mod0(const Ctx& X) {
  const Args& a = *X.a; const float* mod = (const float*)(X.ws + WS_MOD); bf16_t* A0 = (bf16_t*)(X.ws + WS_A0);
  const int gw = X.c * NWAVES + X.wave, NGW = X.G * NWAVES;
  for (int r = gw; r < NROW; r += NGW) {
    if (r < TOK) modulate_row(a.in[IN_X] + (size_t)r * 1024, mod, mod + 1024, A0 + (size_t)r * 1024, X.lane);
    else modulate_row(a.in[IN_CTX] + (size_t)(r - TOK) * 1024, mod + 6144, mod + 6144 + 1024, A0 + (size_t)r * 1024, X.lane);
  }
}


struct G1 {
  static constexpr bool PERM = true; static constexpr bool LINA = true, LINB = true; __device__ __forceinline__ size_t halfA() const { return 128u * 2048u; } __device__ __forceinline__ size_t halfB() const { return 128u * 2048u; } int K, nunits; unsigned char* ws; const float* qg; const float* kg;
  __device__ __forceinline__ void decode(int w, Unit& u) const { if (w < 390) { u.a = 0; u.pm = w / 6; u.pn = w % 6; } else { const int w2 = w - 390; u.a = 1; u.pm = w2 & 1; u.pn = w2 >> 1; } u.b = 0; }
  __device__ __forceinline__ const char* baseA(const Unit& u) const { return (const char*)ws + (u.a == 0 ? WS_A0 : WS_WIN_T + (size_t)1536 * 2048); }
  __device__ __forceinline__ const char* baseB(const Unit& u) const { return (const char*)ws + (u.a == 0 ? WS_WIN_T : WS_A0); }
  __device__ __forceinline__ unsigned rowA(const Unit& u, int r) const { return (unsigned)(u.pm * 256 + r) * 2048u; }
  __device__ __forceinline__ unsigned rowB(const Unit& u, int r) const { return (unsigned)(u.pn * 256 + r) * 2048u; }
  __device__ __forceinline__ void epi(const Acc& acc, const Unit& u, int wr, int wc, int fr, int fq) const {
    if (u.a == 1) {
      bf16_t* VT = (bf16_t*)(ws + WS_VT);
#pragma unroll
      for (int ai = 0; ai < 2; ++ai)
#pragma unroll
        for (int m = 0; m < 4; ++m) { const int d = u.pm * 256 + ai * 128 + wr * 64 + m * 16 + fr;
#pragma unroll
          for (int bj = 0; bj < 2; ++bj) { const int t0 = u.pn * 256 + bj * 128 + wc * 32 + 8 * fq; *(u32x4*)(VT + (size_t)d * NROW + t0) = pack8(acc[ai][bj][m][0], acc[ai][bj][m][1]); } }
      return;
    }
    if (u.pn < 2) {
      bf16_t* AS5 = (bf16_t*)(ws + WS_AS5);
#pragma unroll
      for (int ai = 0; ai < 2; ++ai)
#pragma unroll
        for (int m = 0; m < 4; ++m) { const int row = u.pm * 256 + ai * 128 + wr * 64 + m * 16 + fr; int crow, s;
          if (row < TOK) { crow = row >> 5; s = row & 31; } else { const int j = row - TOK; crow = 512 + (j >> 5); s = j & 31; }
#pragma unroll
          for (int bj = 0; bj < 2; ++bj) { const int g = 16 * u.pn + 8 * bj + 2 * wc + (fq >> 1), c0 = 8 * (fq & 1);
            *(u32x4*)(AS5 + ((size_t)(g * 768 + crow) * 768 + s * 16 + c0)) = pack8(acc[ai][bj][m][0], acc[ai][bj][m][1]); } }
      return;
    }
    const bool isq = u.pn < 4;
    if (isq && u.pm == 64) return;
    const int head = 4 * ((u.pn - 2) & 1) + wc; const float* gain = isq ? qg : kg;
    bf16_t* dst = isq ? (bf16_t*)(ws + WS_Q) : (bf16_t*)(ws + WS_K);
    f32x4 gv[2][2];
#pragma unroll
    for (int bj = 0; bj < 2; ++bj) { gv[bj][0] = *(const f32x4*)(gain + 32 * bj + 8 * fq); gv[bj][1] = *(const f32x4*)(gain + 32 * bj + 8 * fq + 4); }
#pragma unroll
    for (int ai = 0; ai < 2; ++ai)
#pragma unroll
      for (int m = 0; m < 4; ++m) { const int row = u.pm * 256 + ai * 128 + wr * 64 + m * 16 + fr; float ss = 0.f;
#pragma unroll
        for (int bj = 0; bj < 2; ++bj)
#pragma unroll
          for (int n = 0; n < 2; ++n) { const f32x4 x = acc[ai][bj][m][n]; ss += (x[0] * x[0] + x[1] * x[1]) + (x[2] * x[2] + x[3] * x[3]); }
        ss += sx(ss, 16); ss += sx(ss, 32);
        const float rinv = rsqrtf(ss * (1.f / 64.f) + 1e-6f);
#pragma unroll
        for (int bj = 0; bj < 2; ++bj) { const f32x4 v0 = acc[ai][bj][m][0] * rinv * gv[bj][0], v1 = acc[ai][bj][m][1] * rinv * gv[bj][1];
          *(u32x4*)(dst + (size_t)row * 512 + head * 64 + 32 * bj + 8 * fq) = pack8(v0, v1); } }
  }
};

struct G2 {
  static constexpr bool PERM = true; static constexpr bool LINA = true, LINB = true; __device__ __forceinline__ size_t halfA() const { return 128u * 1536u; } __device__ __forceinline__ size_t halfB() const { return 128u * 1024u; } int K, nunits; unsigned char* ws;
  __device__ __forceinline__ void decode(int w, Unit& u) const { u.a = w / 3; u.pm = w % 3; u.pn = 0; u.b = 0; }
  __device__ __forceinline__ const char* baseA(const Unit& u) const { return (const char*)ws + WS_AS5 + (size_t)u.a * 768 * 768 * 2; }
  __device__ __forceinline__ const char* baseB(const Unit& u) const { return (const char*)ws + WS_WS + (size_t)u.a * 256 * 512 * 2; }
  __device__ __forceinline__ unsigned rowA(const Unit& u, int r) const { return (unsigned)(u.pm * 256 + r) * 1536u; }
  __device__ __forceinline__ unsigned rowB(const Unit& u, int r) const { return (unsigned)r * 1024u; }
  __device__ __forceinline__ void epi(const Acc& acc, const Unit& u, int wr, int wc, int fr, int fq) const {
    float* SST = (float*)(ws + WS_SST) + (size_t)u.a * 768 * 256;
#pragma unroll
    for (int ai = 0; ai < 2; ++ai)
#pragma unroll
      for (int m = 0; m < 4; ++m) { const int crow = u.pm * 256 + ai * 128 + wr * 64 + m * 16 + fr; if (crow >= 520) continue;
#pragma unroll
        for (int bj = 0; bj < 2; ++bj) { float* p = SST + (size_t)crow * 256 + bj * 128 + wc * 32 + 8 * fq; *(f32x4*)p = acc[ai][bj][m][0]; *(f32x4*)(p + 4) = acc[ai][bj][m][1]; } }
  }
};

struct G3 {
  static constexpr bool PERM = true; static constexpr bool LINA = true, LINB = true; __device__ __forceinline__ size_t halfA() const { return 128u * 1536u; } __device__ __forceinline__ size_t halfB() const { return 128u * 1536u; } int K, nunits; unsigned char* ws;
  __device__ __forceinline__ void decode(int w, Unit& u) const { u.a = w >> 2; u.pm = (w >> 1) & 1; u.pn = w & 1; u.b = 0; }
  __device__ __forceinline__ const char* baseA(const Unit& u) const { return (const char*)ws + WS_AS5 + (size_t)u.a * 768 * 768 * 2; }
  __device__ __forceinline__ const char* baseB(const Unit& u) const { return (const char*)ws + WS_TT + (size_t)u.a * 512 * 768 * 2; }
  __device__ __forceinline__ unsigned rowA(const Unit& u, int r) const { return (unsigned)(u.pm * 256 + r) * 1536u; }
  __device__ __forceinline__ unsigned rowB(const Unit& u, int r) const { return (unsigned)(u.pn * 256 + r) * 1536u; }
  __device__ __forceinline__ void epi(const Acc& acc, const Unit& u, int wr, int wc, int fr, int fq) const {
    bf16_t* GB = (bf16_t*)(ws + WS_GB);
#pragma unroll
    for (int ai = 0; ai < 2; ++ai)
#pragma unroll
      for (int m = 0; m < 4; ++m) { const int crow = u.pm * 256 + ai * 128 + wr * 64 + m * 16 + fr;
#pragma unroll
        for (int bj = 0; bj < 2; ++bj) { const int pp = u.pn * 256 + bj * 128 + wc * 32 + 8 * fq, i = pp >> 4, c0 = pp & 15; f32x4 v0 = acc[ai][bj][m][0], v1 = acc[ai][bj][m][1];
#pragma unroll
          for (int j = 0; j < 4; ++j) { v0[j] = gelu_tanh(v0[j]); v1[j] = gelu_tanh(v1[j]); }
          *(u32x4*)(GB + (size_t)(crow * 32 + i) * 512 + u.a * 16 + c0) = pack8(v0, v1); } }
  }
};

struct G4 {
  static constexpr bool PERM = true; static constexpr bool LINA = true, LINB = true; __device__ __forceinline__ size_t halfA() const { return 128u * 1024u; } __device__ __forceinline__ size_t halfB() const { return 128u * 1024u; } int K, nunits; unsigned char* ws; const float* bglu;
  __device__ __forceinline__ void decode(int w, Unit& u) const { u.pm = w >> 1; u.pn = w & 1; u.a = 0; u.b = 0; }
  __device__ __forceinline__ const char* baseA(const Unit&) const { return (const char*)ws + WS_GB; }
  __device__ __forceinline__ const char* baseB(const Unit&) const { return (const char*)ws + WS_WGLU_T; }
  __device__ __forceinline__ unsigned rowA(const Unit& u, int r) const { return (unsigned)(u.pm * 256 + r) * 1024u; }
  __device__ __forceinline__ unsigned rowB(const Unit& u, int r) const { return (unsigned)(u.pn * 256 + r) * 1024u; }
  __device__ __forceinline__ void epi(const Acc& acc, const Unit& u, int wr, int wc, int fr, int fq) const {
    const bf16_t* GB = (const bf16_t*)(ws + WS_GB); bf16_t* CC = (bf16_t*)(ws + WS_CONCAT);
#pragma unroll
    for (int bj = 0; bj < 2; ++bj) { const int col0 = u.pn * 256 + bj * 128 + wc * 32 + 8 * fq; const f32x4 b0 = *(const f32x4*)(bglu + col0), b1 = *(const f32x4*)(bglu + col0 + 4);
#pragma unroll
      for (int ai = 0; ai < 2; ++ai)
#pragma unroll
        for (int m = 0; m < 4; ++m) { const int row = u.pm * 256 + ai * 128 + wr * 64 + m * 16 + fr; const u32x4 gw = *(const u32x4*)(GB + (size_t)row * 512 + col0);
          f32x4 v0 = acc[ai][bj][m][0] + b0, v1 = acc[ai][bj][m][1] + b1;
          v0[0] = bf_lo(gw.x) * fast_sigmoid(v0[0]); v0[1] = bf_hi(gw.x) * fast_sigmoid(v0[1]); v0[2] = bf_lo(gw.y) * fast_sigmoid(v0[2]); v0[3] = bf_hi(gw.y) * fast_sigmoid(v0[3]);
          v1[0] = bf_lo(gw.z) * fast_sigmoid(v1[0]); v1[1] = bf_hi(gw.z) * fast_sigmoid(v1[1]); v1[2] = bf_lo(gw.w) * fast_sigmoid(v1[2]); v1[3] = bf_hi(gw.w) * fast_sigmoid(v1[3]);
          *(u32x4*)(CC + (size_t)row * 1024 + col0) = pack8(v0, v1); } }
  }
};

struct GRes {
  static constexpr bool PERM = false; static constexpr bool LINA = true, LINB = true; __device__ __forceinline__ size_t halfA() const { return 128u * 2048u; } __device__ __forceinline__ size_t halfB() const { return 128u * 2048u; } int K, nunits; const char* A; const char* Bt; const float* hin; float* hout; const float* gate; const float* bias;
  __device__ __forceinline__ void decode(int w, Unit& u) const { u.pm = w >> 2; u.pn = w & 3; u.a = 0; u.b = 0; }
  __device__ __forceinline__ const char* baseA(const Unit&) const { return A; }
  __device__ __forceinline__ const char* baseB(const Unit&) const { return Bt; }
  __device__ __forceinline__ unsigned rowA(const Unit& u, int r) const { return (unsigned)(u.pm * 256 + r) * 2048u; }
  __device__ __forceinline__ unsigned rowB(const Unit& u, int r) const { return (unsigned)(u.pn * 256 + r) * 2048u; }
  __device__ __forceinline__ void epi(const Acc& acc, const Unit& u, int wr, int wc, int fr, int fq) const {
#pragma unroll
    for (int bj = 0; bj < 2; ++bj)
#pragma unroll
      for (int n = 0; n < 2; ++n) { const int col0 = u.pn * 256 + bj * 128 + wc * 32 + 16 * n + 4 * fq; const f32x4 gt = *(const f32x4*)(gate + col0);
        f32x4 bs = (f32x4){0.f, 0.f, 0.f, 0.f}; if (bias) bs = *(const f32x4*)(bias + col0);
#pragma unroll
        for (int ai = 0; ai < 2; ++ai)
#pragma unroll
          for (int m = 0; m < 4; ++m) { const size_t off = (size_t)(u.pm * 256 + ai * 128 + wr * 64 + m * 16 + fr) * 1024 + col0;
            const f32x4 hv = *(const f32x4*)(hin + off); *(f32x4*)(hout + off) = hv + gt * (acc[ai][bj][m][n] + bs); } }
  }
};

__device__ __forceinline__ void build_moetab(const Ctx& X, int layer, LAS int* toff) {
  const unsigned* cnt = (const unsigned*)(X.ws + WS_CTL) + CW_CNT + layer * 128;
  LAS int* texp = toff + 256;
  LAS int* ntile = toff + 132;
  __syncthreads();
  if (X.tid < 128) ntile[X.tid] = ((int)__hip_atomic_load(cnt + X.tid, __ATOMIC_RELAXED, __HIP_MEMORY_SCOPE_AGENT) + 255) >> 8;
  __syncthreads();
  if (X.tid < 2) { const int half = X.tid; int s = 0; for (int e = 0; e < 64; ++e) { toff[half * 66 + e] = s; s += ntile[half * 64 + e]; } toff[half * 66 + 64] = s; toff[half * 66 + 65] = s + 32; }
  __syncthreads();
  if (X.tid < 130) { const int half = X.tid / 65, e = X.tid % 65; const int lo = toff[half * 66 + e], hi = toff[half * 66 + e + 1]; for (int t = lo; t < hi && t < 352; ++t) texp[half * 352 + t] = e; }
  __syncthreads();
}
__device__ __forceinline__ int find_expert(const LAS int* toff, int half, int ti) { return toff[256 + half * 352 + ti]; }

struct G6 {
  static constexpr bool PERM = true; static constexpr bool LINA = false, LINB = true; __device__ __forceinline__ size_t halfA() const { return 0; } __device__ __forceinline__ size_t halfB() const { return 128u * 2048u; }
  int K, nunits; unsigned char* ws; const LAS int* toff; const LAS unsigned* tokt;
  __device__ __forceinline__ void decode(int w, Unit& u) const { const int gt = w >> 1, t0 = toff[65]; const int half = gt >= t0 ? 1 : 0, ti = gt - half * t0; u.pn = w & 1; const int e = find_expert(toff, half, ti);
    u.a = e | (half << 8); u.pm = ti - toff[66 * half + e]; u.b = gt; }
  __device__ __forceinline__ const char* baseA(const Unit&) const { return (const char*)ws + WS_F; }
  __device__ __forceinline__ const char* baseB(const Unit& u) const { return (const char*)ws + WS_WEXP + (size_t)(u.a & 255) * EXP_STRIDE; }
  __device__ __forceinline__ unsigned rowA(const Unit& u, int r) const { return tokt[u.ord * 256 + r]; }
  __device__ __forceinline__ void build_tokt(const Ctx& X, LAS unsigned* tk) const {
    for (int i = 0; i * X.G + X.c < nunits; ++i) { Unit u; decode(xcd_remap(i * X.G + X.c, nunits), u);
      if (X.tid < 256) { const int idx = u.pm * 256 + X.tid, half = u.a >> 8, e = u.a & 255; int tok = half * 8192 + idx;
        if (e < 64) tok = ((const int*)(ws + WS_LTOK))[(half * 64 + e) * 8192 + idx];
        tk[i * 256 + X.tid] = (unsigned)tok * 2048u; } }
    __syncthreads();
  }
  __device__ __forceinline__ unsigned rowB(const Unit& u, int r) const { return (unsigned)(u.pn * 256 + r) * 2048u; }
  __device__ __forceinline__ void epi(const Acc& acc, const Unit& u, int wr, int wc, int fr, int fq) const {
    bf16_t* HID = (bf16_t*)(ws + WS_HID);
#pragma unroll
    for (int ai = 0; ai < 2; ++ai)
#pragma unroll
      for (int m = 0; m < 4; ++m) { const size_t hrow = (size_t)u.b * 256 + ai * 128 + wr * 64 + m * 16 + fr; f32x4 v0, v1;
#pragma unroll
        for (int j = 0; j < 4; ++j) { const float g0 = acc[ai][0][m][0][j], g1 = acc[ai][0][m][1][j]; v0[j] = g0 * fast_sigmoid(g0) * acc[ai][1][m][0][j]; v1[j] = g1 * fast_sigmoid(g1) * acc[ai][1][m][1][j]; }
        *(u32x4*)(HID + hrow * 256 + u.pn * 128 + wc * 32 + 8 * fq) = pack8(v0, v1); }
  }
};
struct G7 {
  static constexpr bool PERM = true; static constexpr bool LINA = true, LINB = true; __device__ __forceinline__ size_t halfA() const { return 128u * 512u; } __device__ __forceinline__ size_t halfB() const { return 128u * 512u; }
  int K, nunits; unsigned char* ws; const LAS int* toff; int hidbase; int dry; int half;
  __device__ __forceinline__ void decode(int w, Unit& u) const { const int ti = w >> 2; u.pn = w & 3; u.a = find_expert(toff, half, ti); u.pm = ti - toff[66 * half + u.a]; u.b = ti; }
  __device__ __forceinline__ const char* baseA(const Unit&) const { return (const char*)ws + WS_HID + (size_t)hidbase * 256 * 512; }
  __device__ __forceinline__ const char* baseB(const Unit& u) const { return (const char*)ws + WS_WEXP + (size_t)u.a * EXP_STRIDE + EXP_DOFF; }
  __device__ __forceinline__ unsigned rowA(const Unit& u, int r) const { return (unsigned)(u.b * 256 + r) * 512u; }
  __device__ __forceinline__ unsigned rowB(const Unit& u, int r) const { return (unsigned)(u.pn * 256 + r) * 512u; }
  __device__ __forceinline__ void epi(const Acc& acc, const Unit& u, int wr, int wc, int fr, int fq) const {
    bf16_t* YAS = (bf16_t*)(ws + WS_YAS);
#pragma unroll
    for (int ai = 0; ai < 2; ++ai)
#pragma unroll
      for (int m = 0; m < 4; ++m) { const size_t yrow = (size_t)u.b * 256 + ai * 128 + wr * 64 + m * 16 + fr;
#pragma unroll
        for (int bj = 0; bj < 2; ++bj) { const u32x4 pk = pack8(acc[ai][bj][m][0], acc[ai][bj][m][1]); if (!dry || pk.x == 0x12345678u) *(u32x4*)(YAS + yrow * 1024 + u.pn * 256 + bj * 128 + wc * 32 + 8 * fq) = pk; } }
  }
};

struct G8 {
  static constexpr bool PERM = true; static constexpr bool LINA = true, LINB = false; __device__ __forceinline__ size_t halfA() const { return 128u * 512u; } __device__ __forceinline__ size_t halfB() const { return 0; } int K, nunits; unsigned char* ws;
  __device__ __forceinline__ void decode(int w, Unit& u) const { u.pm = w >> 8; u.a = (w >> 6) & 3; u.pn = w & 63; u.b = 0; }
  __device__ __forceinline__ const char* baseA(const Unit&) const { return (const char*)ws + WS_DMT; }
  __device__ __forceinline__ const char* baseB(const Unit& u) const { return (const char*)ws + WS_A1 + (size_t)u.a * 512; }
  __device__ __forceinline__ unsigned rowA(const Unit& u, int r) const { return (unsigned)(u.pm * 256 + r) * 512u; }
  __device__ __forceinline__ unsigned rowB(const Unit& u, int r) const { const int n = u.pn * 256 + r; return (unsigned)(128 * (n & 127) + (n >> 7)) * 2048u; }
  __device__ __forceinline__ void epi(const Acc& acc, const Unit& u, int wr, int wc, int fr, int fq) const {
    bf16_t* X1 = (bf16_t*)(ws + WS_X1);
#pragma unroll
    for (int ai = 0; ai < 2; ++ai)
#pragma unroll
      for (int m = 0; m < 4; ++m) { const int mm = ai * 128 + wr * 64 + m * 16 + fr;
#pragma unroll
        for (int bj = 0; bj < 2; ++bj) { const int n0 = u.pn * 256 + bj * 128 + wc * 32 + 8 * fq, tb = n0 >> 7, ta0 = n0 & 127;
          *(u32x4*)(X1 + ((((size_t)(u.a * 256 + mm) * 128 + tb) * 2 + u.pm) * 128 + ta0)) = pack8(acc[ai][bj][m][0], acc[ai][bj][m][1]); } }
  }
};
struct G9 {
  static constexpr bool PERM = true; static constexpr bool LINA = true, LINB = true; __device__ __forceinline__ size_t halfA() const { return 128u * 512u; } __device__ __forceinline__ size_t halfB() const { return 128u * 512u; } int K, nunits; unsigned char* ws;
  __device__ __forceinline__ void decode(int w, Unit& u) const { u.pm = 0; u.pn = w; u.a = 0; u.b = 0; }
  __device__ __forceinline__ const char* baseA(const Unit&) const { return (const char*)ws + WS_W1; }
  __device__ __forceinline__ const char* baseB(const Unit&) const { return (const char*)ws + WS_X1; }
  __device__ __forceinline__ unsigned rowA(const Unit&, int r) const { return (unsigned)r * 512u; }
  __device__ __forceinline__ unsigned rowB(const Unit& u, int r) const { return (unsigned)(u.pn * 256 + r) * 512u; }
  __device__ __forceinline__ void epi(const Acc& acc, const Unit& u, int wr, int wc, int fr, int fq) const {
    bf16_t* X2 = (bf16_t*)(ws + WS_X2);
#pragma unroll
    for (int m = 0; m < 4; ++m) { const int ka = wr * 64 + m * 16 + fr;
#pragma unroll
      for (int bj = 0; bj < 2; ++bj) { const int n0 = u.pn * 256 + bj * 128 + wc * 32 + 8 * fq, gm = n0 >> 7, tb0 = n0 & 127; f32x4 r0, r1, i0, i1;
#pragma unroll
        for (int j = 0; j < 4; ++j) {
          { const float ang = (float)((ka * (tb0 + j)) & 16383) * (1.f / 16384.f), cs = __builtin_amdgcn_cosf(ang), sn = __builtin_amdgcn_sinf(ang); const float yr = acc[0][bj][m][0][j], yi = acc[1][bj][m][0][j]; r0[j] = yr * cs + yi * sn; i0[j] = yi * cs - yr * sn; }
          { const float ang = (float)((ka * (tb0 + 4 + j)) & 16383) * (1.f / 16384.f), cs = __builtin_amdgcn_cosf(ang), sn = __builtin_amdgcn_sinf(ang); const float yr = acc[0][bj][m][1][j], yi = acc[1][bj][m][1][j]; r1[j] = yr * cs + yi * sn; i1[j] = yi * cs - yr * sn; } }
        bf16_t* p = X2 + (((size_t)(gm * 128 + ka) * 2) * 128 + tb0); *(u32x4*)p = pack8(r0, r1); *(u32x4*)(p + 128) = pack8(i0, i1); } }
  }
};
struct G10 {
  static constexpr bool PERM = true; static constexpr bool LINA = true, LINB = false; __device__ __forceinline__ size_t halfA() const { return 128u * 512u; } __device__ __forceinline__ size_t halfB() const { return 0; } int K, nunits; unsigned char* ws;
  __device__ __forceinline__ void decode(int w, Unit& u) const { u.pm = 0; u.pn = w; u.a = 0; u.b = 0; }
  __device__ __forceinline__ const char* baseA(const Unit&) const { return (const char*)ws + WS_W2; }
  __device__ __forceinline__ const char* baseB(const Unit&) const { return (const char*)ws + WS_X2; }
  __device__ __forceinline__ unsigned rowA(const Unit&, int r) const { return (unsigned)r * 512u; }
  __device__ __forceinline__ unsigned rowB(const Unit& u, int r) const { const int n = u.pn * 256 + r, ka = n >> 10, gm = n & 1023; return (unsigned)(gm * 128 + ka) * 512u; }
  __device__ __forceinline__ void epi(const Acc& acc, const Unit& u, int wr, int wc, int fr, int fq) const {
    bf16_t* FB = (bf16_t*)(ws + WS_FB); const int ka = u.pn >> 2;
#pragma unroll
    for (int m = 0; m < 4; ++m) { const int kb = wr * 64 + m * 16 + fr; const size_t k = (size_t)ka + 128 * kb;
#pragma unroll
      for (int bj = 0; bj < 2; ++bj) { const int d0 = (u.pn & 3) * 256 + bj * 128 + wc * 32 + 8 * fq; *(u32x4*)(FB + k * 1024 + d0) = pack8(acc[0][bj][m][0], acc[0][bj][m][1]); } }
  }
};
}
namespace mk {
typedef float f32x16 __attribute__((ext_vector_type(16)));

__device__ __forceinline__ void phase_scan(const Ctx& X) {
  const int gt = X.c * NTHR + X.tid; if (gt >= 4096) return;
  const int g = gt >> 7, dir = (gt >> 6) & 1, p = gt & 63;
  const float2 lam = ((const float2*)(X.ws + WS_LAML))[(dir * 32 + g) * 64 + p];
  const float* S = (const float*)(X.ws + WS_SST) + (size_t)g * 768 * 256 + dir * 128 + p;
  bf16_t* XP = (bf16_t*)(X.ws + WS_AS5) + (size_t)g * 768 * 768 + 512 + dir * 128 + p;
  float xr = 0.f, xi = 0.f;
  for (int j0 = 0; j0 < 520; j0 += 8) {
    float sr[8], si[8];
#pragma unroll
    for (int k = 0; k < 8; ++k) { const int j = j0 + k; const int row = dir == 0 ? (j < 8 ? 512 + j : j - 8) : 519 - j; sr[k] = S[(size_t)row * 256]; si[k] = S[(size_t)row * 256 + 64]; }
#pragma unroll
    for (int k = 0; k < 8; ++k) { const int j = j0 + k; const int row = dir == 0 ? (j < 8 ? 512 + j : j - 8) : 519 - j;
      XP[(size_t)row * 768] = f2bf(xr); XP[(size_t)row * 768 + 64] = f2bf(xi);
      const float nr = lam.x * xr - lam.y * xi + sr[k], ni = lam.x * xi + lam.y * xr + si[k]; xr = nr; xi = ni; }
  }
}

__device__ __forceinline__ void zero_lists(const Ctx& X) {
  u32x4* z = (u32x4*)(X.ws + WS_LTOK); unsigned zu_ = 0u; asm volatile("" : "+v"(zu_)); const u32x4 zero = (u32x4){zu_, zu_, zu_, zu_};
  for (int i = X.c * NTHR + X.tid; i < (int)(4 * MiB / 16); i += X.G * NTHR) z[i] = zero;
}
#define MFMA32(a, b, c) __builtin_amdgcn_mfma_f32_32x32x16_bf16((a), (b), (c), 0, 0, 0)
__device__ __forceinline__ void attn_unit(const Ctx& X, const LAS float* rpbl, int head, int tile) {
  const bf16_t* Q = (const bf16_t*)(X.ws + WS_Q); const bf16_t* Kb = (const bf16_t*)(X.ws + WS_K); const bf16_t* VT = (const bf16_t*)(X.ws + WS_VT);
  bf16_t* CCt = (bf16_t*)(X.ws + WS_CONCAT);
  const int lane = X.lane, ql = lane & 31, hh = lane >> 5;
  const int rp = tile >> 2, mt = tile & 3;
  const int r = 2 * rp + (ql >> 4), cq = 16 * mt + (ql & 15), tq = r * 64 + cq;
  const int r0q = min(max(r - 4, 0), 248), csq = min(max(cq - 8, 0), 48);
  const int rlo = min(max(2 * rp - 4, 0), 248), rhi = min(max(2 * rp - 3, 0), 248) + 7;
  const int csb = min(max(16 * mt - 8, 0), 32);
  const int nloc = rhi - rlo + 1;
  bf16x8 qf[4];
#pragma unroll
  for (int ks = 0; ks < 4; ++ks) qf[ks] = *(const bf16x8*)(Q + (size_t)tq * 512 + head * 64 + 16 * ks + 8 * hh);
  const int kperm = (ql & ~12) | ((ql & 4) << 1) | ((ql & 8) >> 1);
  f32x16 o0, o1;
#pragma unroll
  for (int i = 0; i < 16; ++i) { o0[i] = 0.f; o1[i] = 0.f; }
  float lsum = 0.f;
  const float c1 = 0.125f * 1.44269504f, c2 = 8.f * 1.44269504f;
  const float* rp_h = nullptr; (void)rp_h;
  bf16x8 kf[4], vf[2][2];
  { const int tb0 = rlo * 64 + csb; const bf16_t* kp = Kb + (size_t)(tb0 + kperm) * 512 + head * 64 + 8 * hh;
#pragma unroll
    for (int ks = 0; ks < 4; ++ks) kf[ks] = *(const bf16x8*)(kp + 16 * ks);
#pragma unroll
    for (int db = 0; db < 2; ++db)
#pragma unroll
      for (int s2 = 0; s2 < 2; ++s2) vf[db][s2] = *(const bf16x8*)(VT + (size_t)(head * 64 + 32 * db + ql) * NROW + tb0 + 16 * s2 + 8 * hh); }
  for (int b = 0; b < nloc + 8; ++b) {
    const bool loc = b < nloc;
    const int kr = rlo + b;
    bf16x8 kc[4], vc[2][2];
#pragma unroll
    for (int ks = 0; ks < 4; ++ks) kc[ks] = kf[ks];
#pragma unroll
    for (int db = 0; db < 2; ++db)
#pragma unroll
      for (int s2 = 0; s2 < 2; ++s2) vc[db][s2] = vf[db][s2];
    if (b + 1 < nloc + 8) { const int bn = b + 1; const int tbn = bn < nloc ? (rlo + bn) * 64 + csb : TOK + 32 * (bn - nloc);
      const bf16_t* kp = Kb + (size_t)(tbn + kperm) * 512 + head * 64 + 8 * hh;
#pragma unroll
      for (int ks = 0; ks < 4; ++ks) kf[ks] = *(const bf16x8*)(kp + 16 * ks);
#pragma unroll
      for (int db = 0; db < 2; ++db)
#pragma unroll
        for (int s2 = 0; s2 < 2; ++s2) vf[db][s2] = *(const bf16x8*)(VT + (size_t)(head * 64 + 32 * db + ql) * NROW + tbn + 16 * s2 + 8 * hh); }
    f32x16 sacc;
#pragma unroll
    for (int i = 0; i < 16; ++i) sacc[i] = 0.f;
#pragma unroll
    for (int ks = 0; ks < 4; ++ks) sacc = MFMA32(kc[ks], qf[ks], sacc);
    float pv[16];
    if (loc) {
      const bool rowok = (kr >= r0q) && (kr <= r0q + 7);
      const LAS float* bp = rpbl + (head * 15 + (kr - r + 7)) * 31 + (csb - cq + 15);
#pragma unroll
      for (int i = 0; i < 16; ++i) { const int kidx = 16 * (i >> 3) + 8 * hh + (i & 7); const int kc = csb + kidx;
        const bool ok = rowok && (kc >= csq) && (kc <= csq + 15);
        float bias = 0.f; if (ok) bias = bp[kidx];
        const float e = __builtin_amdgcn_exp2f(sacc[i] * c1 + bias * 1.44269504f - c2); pv[i] = ok ? e : 0.f; }
    } else {
#pragma unroll
      for (int i = 0; i < 16; ++i) pv[i] = __builtin_amdgcn_exp2f(sacc[i] * c1 - c2);
    }
    u32x4 p0, p1;
    p0.x = cvt_pk_bf16(pv[0], pv[1]); p0.y = cvt_pk_bf16(pv[2], pv[3]); p0.z = cvt_pk_bf16(pv[4], pv[5]); p0.w = cvt_pk_bf16(pv[6], pv[7]);
    p1.x = cvt_pk_bf16(pv[8], pv[9]); p1.y = cvt_pk_bf16(pv[10], pv[11]); p1.z = cvt_pk_bf16(pv[12], pv[13]); p1.w = cvt_pk_bf16(pv[14], pv[15]);
    lsum += (bf_lo(p0.x) + bf_hi(p0.x)) + (bf_lo(p0.y) + bf_hi(p0.y)) + (bf_lo(p0.z) + bf_hi(p0.z)) + (bf_lo(p0.w) + bf_hi(p0.w))
          + (bf_lo(p1.x) + bf_hi(p1.x)) + (bf_lo(p1.y) + bf_hi(p1.y)) + (bf_lo(p1.z) + bf_hi(p1.z)) + (bf_lo(p1.w) + bf_hi(p1.w));
    const bf16x8 pb0 = __builtin_bit_cast(bf16x8, p0), pb1 = __builtin_bit_cast(bf16x8, p1);
    o0 = MFMA32(vc[0][0], pb0, o0); o0 = MFMA32(vc[0][1], pb1, o0);
    o1 = MFMA32(vc[1][0], pb0, o1); o1 = MFMA32(vc[1][1], pb1, o1);
  }
  lsum += sx(lsum, 32);
  const float inv = 1.f / lsum;
  bf16_t* op = CCt + (size_t)tq * 1024 + 512 + head * 64 + 4 * hh;
#pragma unroll
  for (int gq = 0; gq < 4; ++gq) {
    u32x2 w0, w1;
    w0.x = cvt_pk_bf16(o0[4 * gq] * inv, o0[4 * gq + 1] * inv); w0.y = cvt_pk_bf16(o0[4 * gq + 2] * inv, o0[4 * gq + 3] * inv);
    w1.x = cvt_pk_bf16(o1[4 * gq] * inv, o1[4 * gq + 1] * inv); w1.y = cvt_pk_bf16(o1[4 * gq + 2] * inv, o1[4 * gq + 3] * inv);
    *(u32x2*)(op + 8 * gq) = w0; *(u32x2*)(op + 32 + 8 * gq) = w1;
  }
}
__device__ __forceinline__ void phase_attn(const Ctx& X) {
  LAS float* rpbl = (LAS float*)X.lds;
  zero_lists(X);
  for (int i = X.tid; i < 8 * 15 * 31; i += NTHR) rpbl[i] = X.a->in[IN_RPB][i];
  __syncthreads();
  const int gw = X.c * NWAVES + X.wave, NGW = X.G * NWAVES;
  for (int U = gw; U < 4096; U += NGW) attn_unit(X, rpbl, U >> 9, U & 511);
}

__device__ __forceinline__ void phase_router(const Ctx& X, int layer, int dry) {
  const float* mod = (const float*)(X.ws + WS_MOD) + (layer == 0 ? 0 : 2 * 6144);
  const float* shift = mod + 3072; const float* scale = mod + 4096;
  const float* h = X.a->h; bf16_t* F = (bf16_t*)(X.ws + WS_F);
  unsigned* cntg = (unsigned*)(X.ws + WS_CTL) + CW_CNT + layer * 128;
  int* ltok = (int*)(X.ws + WS_LTOK); int* asg = (int*)(X.ws + WS_ASG);
  const bf16_t* WR = (const bf16_t*)(X.ws + WS_WROUT_T) + (size_t)layer * 64 * 1024;
  const float* rbias = X.a->in[IN_RBIAS] + layer * 64;
  constexpr int FROW = 2064;
  const int lane = X.lane, wave = X.wave, tid = X.tid;
  for (int tile = X.c; tile < TOK / 64; tile += X.G) {
    const int t0 = tile * 64;
    for (int rb4 = 0; rb4 < 2; ++rb4) {
      f32x4 v[4][4];
#pragma unroll
      for (int rr = 0; rr < 4; ++rr) { const f32x4* xr = (const f32x4*)(h + (size_t)(t0 + wave * 8 + rb4 * 4 + rr) * 1024) + lane;
#pragma unroll
        for (int j = 0; j < 4; ++j) v[rr][j] = xr[64 * j]; }
#pragma unroll
      for (int rr = 0; rr < 4; ++rr) {
        const int lr = wave * 8 + rb4 * 4 + rr, t = t0 + lr; float ss = 0.f;
#pragma unroll
        for (int j = 0; j < 4; ++j) ss += (v[rr][j].x * v[rr][j].x + v[rr][j].y * v[rr][j].y) + (v[rr][j].z * v[rr][j].z + v[rr][j].w * v[rr][j].w);
        const float r = rsqrtf(wave_sum(ss) * (1.f / 1024.f) + 1e-6f);
#pragma unroll
        for (int j = 0; j < 4; ++j) { const f32x4 sh = ((const f32x4*)shift)[lane + 64 * j], sc = ((const f32x4*)scale)[lane + 64 * j];
          u32x2 w; w.x = cvt_pk_bf16(v[rr][j].x * r * (1.f + sc.x) + sh.x, v[rr][j].y * r * (1.f + sc.y) + sh.y); w.y = cvt_pk_bf16(v[rr][j].z * r * (1.f + sc.z) + sh.z, v[rr][j].w * r * (1.f + sc.w) + sh.w);
          if (!dry) ((u32x2*)(F + (size_t)t * 1024))[lane + 64 * j] = w;
          *(LAS u32x2*)(X.lds + lr * FROW + (lane + 64 * j) * 8) = w; }
      }
    }
    __syncthreads();
    f32x4 lg[2];
    { const int rb = wave & 3, fr = lane & 15, fq = lane >> 4;
      lg[0] = (f32x4){0.f, 0.f, 0.f, 0.f}; lg[1] = lg[0];
      const LAS unsigned char* ap = X.lds + (rb * 16 + fr) * FROW + fq * 16;
      const bf16_t* bp0 = WR + (size_t)((2 * (wave >> 2)) * 16 + fr) * 1024 + fq * 8; const bf16_t* bp1 = bp0 + 16 * 1024;
#pragma unroll 16
      for (int ks = 0; ks < 32; ++ks) { const bf16x8 af = *(const LAS bf16x8*)(ap + ks * 64); const bf16x8 b0 = *(const bf16x8*)(bp0 + ks * 32), b1 = *(const bf16x8*)(bp1 + ks * 32);
        lg[0] = __builtin_amdgcn_mfma_f32_16x16x32_bf16(af, b0, lg[0], 0, 0, 0); lg[1] = __builtin_amdgcn_mfma_f32_16x16x32_bf16(af, b1, lg[1], 0, 0, 0); }
    }
    __syncthreads();
    LAS float* LG = (LAS float*)X.lds;
    LAS float* GS = LG + 64 * 65;
    LAS float* SELV = GS + 512;
    LAS int* OUTE = (LAS int*)(SELV + 4096);
    LAS float* OUTS = (LAS float*)(OUTE + 512);
    LAS int* HIST = (LAS int*)(OUTS + 512);
    LAS int* BASE = HIST + 64;
    { const int rb = wave & 3, fr = lane & 15, fq = lane >> 4;
#pragma unroll
      for (int eb = 0; eb < 2; ++eb)
#pragma unroll
        for (int j = 0; j < 4; ++j) LG[(rb * 16 + 4 * fq + j) * 65 + (2 * (wave >> 2) + eb) * 16 + fr] = lg[eb][j];
      if (tid < 64) HIST[tid] = 0; }
    __syncthreads();
    const int tl = tid >> 3, grp = tid & 7;
    float v[8], sc[8];
    { float m1 = -INFINITY, m2 = -INFINITY;
#pragma unroll
      for (int j = 0; j < 8; ++j) { const float s = 1.f / (1.f + __expf(-LG[tl * 65 + grp * 8 + j])); sc[j] = s; v[j] = s + rbias[grp * 8 + j];
        if (v[j] > m1) { m2 = m1; m1 = v[j]; } else if (v[j] > m2) m2 = v[j]; }
      GS[tl * 8 + grp] = m1 + m2; }
    __syncthreads();
    bool keep;
    { const float mine = GS[tl * 8 + grp]; int rank = 0;
#pragma unroll
      for (int g2 = 0; g2 < 8; ++g2) { const float o = GS[tl * 8 + g2]; rank += (o > mine || (o == mine && g2 < grp)) ? 1 : 0; }
      keep = rank < 4;
#pragma unroll
      for (int j = 0; j < 8; ++j) SELV[tl * 64 + grp * 8 + j] = keep ? v[j] : -INFINITY; }
    __syncthreads();
    if (keep) {
      int rk[8];
#pragma unroll
      for (int j = 0; j < 8; ++j) rk[j] = 0;
      for (int e2 = 0; e2 < 64; ++e2) { const float o = SELV[tl * 64 + e2];
#pragma unroll
        for (int j = 0; j < 8; ++j) rk[j] += (o > v[j] || (o == v[j] && e2 < grp * 8 + j)) ? 1 : 0; }
#pragma unroll
      for (int j = 0; j < 8; ++j) if (rk[j] < 8) { OUTE[tl * 8 + rk[j]] = grp * 8 + j; OUTS[tl * 8 + rk[j]] = sc[j]; }
    }
    __syncthreads();
    { const int jj = tid & 7, e = OUTE[tl * 8 + jj]; const float s = OUTS[tl * 8 + jj];
      float sum = s; sum += sx(sum, 1); sum += sx(sum, 2); sum += sx(sum, 4);
      const float w = 2.5f * s / sum;
      const int sl = atomicAdd((int*)&HIST[e], 1);
      __syncthreads();
      const int t = t0 + tl, half = t >> 13;
      if (tid < 64) { const int n = HIST[tid]; BASE[tid] = (n && !dry) ? (int)atomicAdd(cntg + half * 64 + tid, (unsigned)n) : 0; }
      __syncthreads();
      const int slot = BASE[e] + sl;
      if (!dry) { ltok[(size_t)(half * 64 + e) * 8192 + slot] = t; } if (!dry) ((int2*)asg)[t * 8 + jj] = make_int2((e << 16) | slot, __float_as_int(w)); }
    __syncthreads();
  }
}

__device__ __forceinline__ void phase_combine(const Ctx& X, int layer, int half, const LAS int* toff, int dry) {
  const float* mod = (const float*)(X.ws + WS_MOD) + (layer == 0 ? 0 : 2 * 6144);
  const float* gffn = mod + 5120;
  const float* nmod = (const float*)(X.ws + WS_MOD) + 2 * 6144;
  float* h = X.a->h; const bf16_t* YAS = (const bf16_t*)(X.ws + WS_YAS); const int* asg = (const int*)(X.ws + WS_ASG); bf16_t* A1 = (bf16_t*)(X.ws + WS_A1);
  const int gw = X.c * NWAVES + X.wave, NGW = X.G * NWAVES, lane = X.lane;
  int2 an[8];
#pragma unroll
  for (int k = 0; k < 8; ++k) an[k] = ((const int2*)asg)[(half * 8192 + gw) * 8 + k];
  for (int ti = gw; ti < 8192; ti += NGW) {
    const int t = half * 8192 + ti;
    f32x4 acc[4];
#pragma unroll
    for (int j = 0; j < 4; ++j) acc[j] = (f32x4){0.f, 0.f, 0.f, 0.f};
    int pos[9]; float wgt[9];
#pragma unroll
    for (int k = 0; k < 8; ++k) { pos[k] = toff[an[k].x >> 16] * 256 + (an[k].x & 0xffff); wgt[k] = __int_as_float(an[k].y); }
    if (ti + NGW < 8192) {
#pragma unroll
      for (int k = 0; k < 8; ++k) an[k] = ((const int2*)asg)[(t + NGW) * 8 + k]; }
    pos[8] = toff[64] * 256 + ti; wgt[8] = 1.f;
#pragma unroll
    for (int k = 0; k < 9; ++k) { const u32x2* yr = (const u32x2*)(YAS + (size_t)pos[k] * 1024) + lane; const float wk = wgt[k];
#pragma unroll
      for (int j = 0; j < 4; ++j) { const u32x2 w = yr[64 * j]; acc[j].x += wk * bf_lo(w.x); acc[j].y += wk * bf_hi(w.x); acc[j].z += wk * bf_lo(w.y); acc[j].w += wk * bf_hi(w.y); } }
    f32x4* hr = (f32x4*)(h + (size_t)t * 1024) + lane; f32x4 v[4]; float ss = 0.f;
#pragma unroll
    for (int j = 0; j < 4; ++j) { const f32x4 gt = ((const f32x4*)gffn)[lane + 64 * j]; v[j] = hr[64 * j] + gt * acc[j]; if (!dry) hr[64 * j] = v[j];
      ss += (v[j].x * v[j].x + v[j].y * v[j].y) + (v[j].z * v[j].z + v[j].w * v[j].w); }
    if (layer == 0) {
      const float r = rsqrtf(wave_sum(ss) * (1.f / 1024.f) + 1e-6f);
#pragma unroll
      for (int j = 0; j < 4; ++j) { const f32x4 sh = ((const f32x4*)nmod)[lane + 64 * j], sc = ((const f32x4*)(nmod + 1024))[lane + 64 * j];
        u32x2 w; w.x = cvt_pk_bf16(v[j].x * r * (1.f + sc.x) + sh.x, v[j].y * r * (1.f + sc.y) + sh.y); w.y = cvt_pk_bf16(v[j].z * r * (1.f + sc.z) + sh.z, v[j].w * r * (1.f + sc.w) + sh.w);
        if (!dry) ((u32x2*)(A1 + (size_t)t * 1024))[lane + 64 * j] = w; }
    }
  }
}

constexpr int NPHASE = 25;
template <bool SP2>
__global__ void __launch_bounds__(NTHR, 2) mk_fwd(Args args) {
  extern __shared__ __attribute__((aligned(16))) unsigned char lds_raw[];
  Ctx X; X.lds = (LAS unsigned char*)lds_raw; X.a = &args; X.ws = args.ws; X.tid = threadIdx.x; X.lane = X.tid & 63; X.wave = __builtin_amdgcn_readfirstlane(X.tid >> 6);
  X.G = gridDim.x; X.c = blockIdx.x;
  const int wave_s = X.wave;
  volatile LAS unsigned* MISC = (volatile LAS unsigned*)(X.lds + LDS_MISC_OFF);
  LAS int* TOFF = (LAS int*)(X.lds + LDS_MISC_OFF + 64);
  if (X.tid < 16) MISC[X.tid] = 0u;
  __syncthreads();
  unsigned* ctl = (unsigned*)(X.ws + WS_CTL);
  const int lo = args.ph_lo, hi = args.ph_hi;
  const bool multi = (hi - lo) > 1;
  XcdBarrier bar; bar.bar = ctl + CW_BAR; bar.x = 0; bar.st = nullptr;
  if (multi) bar = xcd_barrier_post(ctl + CW_BAR, MISC, X.tid);
  LAS unsigned char* lds = X.lds;
  unsigned char* ws = X.ws;
  const float* mod = (const float*)(ws + WS_MOD); (void)mod;
#ifndef PH_MASK
#define PH_MASK 0x1ffffffull
#endif
#define IN(k) ((((unsigned long long)PH_MASK >> (k)) & 1ull) && lo <= (k) && (k) < hi)
#define SEAM(k) do { if (IN(k) && IN((k) + 1)) xcd_barrier(bar, X.tid); } while (0)
#ifndef REP_MASK
#define REP_MASK 0ull
#endif
#define REPS(k) ((int)(((unsigned long long)REP_MASK >> (k)) & 1ull))
#define LAUNDER() do { int w0_ = wave_s; asm volatile("" : "+s"(w0_)); int l_ = __builtin_amdgcn_mbcnt_hi(~0u, __builtin_amdgcn_mbcnt_lo(~0u, 0u)); asm volatile("" : "+v"(l_)); X.wave = w0_; X.lane = l_; X.tid = w0_ * 64 + l_; \
    unsigned char* w_ = args.ws; asm volatile("" : "+s"(w_)); X.ws = w_; ws = w_; mod = (const float*)(w_ + WS_MOD); } while (0)
  if (IN(0)) for (int rep_ = 0; rep_ <= REPS(0); ++rep_) { if (rep_) xcd_barrier(bar, X.tid); LAUNDER(); phase_prep(X, rep_); } SEAM(0);
#ifdef EXTRA_BARS
  if (multi) for (int eb_ = 0; eb_ < EXTRA_BARS; ++eb_) xcd_barrier(bar, X.tid);
#endif
  if (IN(1)) for (int rep_ = 0; rep_ <= REPS(1); ++rep_) { if (rep_) xcd_barrier(bar, X.tid); LAUNDER(); phase_mod0(X); } SEAM(1);
  if (IN(2)) for (int rep_ = 0; rep_ <= REPS(2); ++rep_) { if (rep_) xcd_barrier(bar, X.tid); LAUNDER(); G1 p; p.K = 1024; p.nunits = 520; p.ws = ws; p.qg = args.in[IN_QG]; p.kg = args.in[IN_KG]; gemm_phase<G1, SP2>(lds, p, X.G, X.c, X.tid); } SEAM(2);
  if (IN(3)) for (int rep_ = 0; rep_ <= REPS(3); ++rep_) { if (rep_) xcd_barrier(bar, X.tid); LAUNDER(); G2 p; p.K = 512; p.nunits = 96; p.ws = ws; gemm_phase<G2, SP2>(lds, p, X.G, X.c, X.tid); } SEAM(3);
  if (IN(4)) for (int rep_ = 0; rep_ <= REPS(4); ++rep_) { if (rep_) xcd_barrier(bar, X.tid); LAUNDER(); phase_scan(X); } SEAM(4);
  if (IN(5)) for (int rep_ = 0; rep_ <= REPS(5); ++rep_) { if (rep_) xcd_barrier(bar, X.tid); LAUNDER(); G3 p; p.K = 768; p.nunits = 128; p.ws = ws; gemm_phase<G3, SP2>(lds, p, X.G, X.c, X.tid); } SEAM(5);
  if (IN(6)) for (int rep_ = 0; rep_ <= REPS(6); ++rep_) { if (rep_) xcd_barrier(bar, X.tid); LAUNDER(); G4 p; p.K = 512; p.nunits = 128; p.ws = ws; p.bglu = args.in[IN_BGLU]; gemm_phase<G4, SP2>(lds, p, X.G, X.c, X.tid); } SEAM(6);
  if (IN(7)) for (int rep_ = 0; rep_ <= REPS(7); ++rep_) { if (rep_) xcd_barrier(bar, X.tid); LAUNDER(); phase_attn(X); } SEAM(7);
  if (IN(8)) for (int rep_ = 0; rep_ <= REPS(8); ++rep_) { if (rep_) xcd_barrier(bar, X.tid); LAUNDER(); GRes p; p.K = 1024; p.nunits = 256; p.A = (const char*)ws + WS_CONCAT; p.Bt = (const char*)ws + WS_WMIX_T; p.hin = args.in[IN_X]; p.hout = args.h; p.gate = mod + 2048; p.bias = nullptr;
    gemm_phase<GRes, SP2>(lds, p, X.G, X.c, X.tid); } SEAM(8);
#pragma unroll 1
  for (int layer = 0; layer < 2; ++layer) {
    const int pb = layer == 0 ? 9 : 19;
    if (IN(pb)) for (int rep_ = 0; rep_ <= REPS(pb); ++rep_) { if (rep_) xcd_barrier(bar, X.tid); LAUNDER(); phase_router(X, layer, rep_); } SEAM(pb);
    if (IN(pb + 1)) for (int rep_ = 0; rep_ <= REPS(pb + 1); ++rep_) { if (rep_) xcd_barrier(bar, X.tid); LAUNDER(); build_moetab(X, layer, TOFF); G6 p; p.K = 1024; p.ws = ws; p.toff = TOFF; p.nunits = (TOFF[65] + TOFF[66 + 65]) * 2; { LAS unsigned* tk = (LAS unsigned*)(X.lds + LDS_STAGE); p.tokt = tk; p.build_tokt(X, tk); } gemm_phase<G6, SP2>(lds, p, X.G, X.c, X.tid); } SEAM(pb + 1);
#pragma unroll 1
    for (int half = 0; half < 2; ++half) {
      const int p7 = pb + 2 + 2 * half;
      if (IN(p7)) for (int rep_ = 0; rep_ <= REPS(p7); ++rep_) { if (rep_) xcd_barrier(bar, X.tid); LAUNDER(); build_moetab(X, layer, TOFF); G7 p; p.K = 256; p.ws = ws; p.toff = TOFF; p.half = half; p.hidbase = half ? TOFF[65] : 0; p.dry = rep_; p.nunits = TOFF[66 * half + 65] * 4; gemm_phase<G7, SP2>(lds, p, X.G, X.c, X.tid); } SEAM(p7);
      if (IN(p7 + 1)) for (int rep_ = REPS(p7 + 1); rep_ >= 0; --rep_) { if (rep_ == 0 && REPS(p7 + 1)) xcd_barrier(bar, X.tid); LAUNDER(); build_moetab(X, layer, TOFF); phase_combine(X, layer, half, TOFF + 66 * half, rep_);
        if (layer == 0 && half == 1 && !(args.flags & FLAG_SKIP_EXPERTS)) { __syncthreads(); transpose_work(X, ctl + CW_DQ1, 0, 0, 1, 65 * IT_EXP); } }
      if (!(layer == 1 && half == 1)) SEAM(p7 + 1);
    }
    if (layer == 0) {
      if (IN(15)) for (int rep_ = 0; rep_ <= REPS(15); ++rep_) { if (rep_) xcd_barrier(bar, X.tid); LAUNDER(); G8 p; p.K = 256; p.nunits = 512; p.ws = ws; gemm_phase<G8, SP2>(lds, p, X.G, X.c, X.tid); } SEAM(15);
      if (IN(16)) for (int rep_ = 0; rep_ <= REPS(16); ++rep_) { if (rep_) xcd_barrier(bar, X.tid); LAUNDER(); G9 p; p.K = 256; p.nunits = 512; p.ws = ws; gemm_phase<G9, SP2>(lds, p, X.G, X.c, X.tid); } SEAM(16);
      if (IN(17)) for (int rep_ = 0; rep_ <= REPS(17); ++rep_) { if (rep_) xcd_barrier(bar, X.tid); LAUNDER(); G10 p; p.K = 256; p.nunits = 512; p.ws = ws; gemm_phase<G10, SP2>(lds, p, X.G, X.c, X.tid); } SEAM(17);
      if (IN(18)) { LAUNDER(); zero_lists(X); GRes p; p.K = 1024; p.nunits = 256; p.A = (const char*)ws + WS_FB; p.Bt = (const char*)ws + WS_WFOUR_T; p.hin = args.h; p.hout = args.h; p.gate = mod + 2 * 6144 + 2048; p.bias = args.in[IN_BFOUR];
        gemm_phase<GRes, SP2>(lds, p, X.G, X.c, X.tid); } SEAM(18);
    }
  }
#undef IN
#undef SEAM
}
}
#ifndef MK_SP2
#define MK_SP2 true
#endif
#ifndef MK_N_LAUNCHES
#define MK_N_LAUNCHES 1
#endif
#ifndef CHECK
#define CHECK 0
#endif
static int g_grid = 0;
static bool mk_setup(int n_in, int out_size, size_t ws_size) {
  if (g_grid == 0) {
    g_grid = -1;
    if (n_in != 31 || out_size != 16384 * 1024 || ws_size < (size_t)530 * 1000 * 1000) { fprintf(stderr, "kernel_launch: unexpected n_in %d out %d ws %zu\n", n_in, out_size, ws_size); return false; }
    int dev = 0, cus = 0;
    if (hipGetDevice(&dev) != hipSuccess || hipDeviceGetAttribute(&cus, hipDeviceAttributeMultiprocessorCount, dev) != hipSuccess) return false;
    if (cus < 256) { fprintf(stderr, "kernel_launch: needs 256 CUs, device has %d\n", cus); return false; }
    if (hipFuncSetAttribute((const void*)mk::mk_fwd<MK_SP2>, hipFuncAttributeMaxDynamicSharedMemorySize, mk::LDS_BYTES) != hipSuccess) { fprintf(stderr, "kernel_launch: hipFuncSetAttribute failed\n"); return false; }
    g_grid = 256;
  }
  return g_grid > 0;
}
static void mk_run(hipStream_t s, mk::Args a, int lo, int hi) {
  a.ph_lo = lo; a.ph_hi = hi;
  hipLaunchKernelGGL(mk::mk_fwd<MK_SP2>, dim3(g_grid), dim3(mk::NTHR), mk::LDS_BYTES, s, a);
}

#if CHECK
namespace chk {
using mk::bf16_t;
__device__ __forceinline__ float b2f(bf16_t b) { return __uint_as_float(((unsigned)b) << 16); }
__global__ void k_cmp(int mode, const void* A, const float* B, unsigned long long n, double* acc) {
  double e = 0.0, r = 0.0; const bf16_t* A16 = (const bf16_t*)A;
  for (unsigned long long i = (unsigned long long)blockIdx.x * 256 + threadIdx.x; i < n; i += (unsigned long long)gridDim.x * 256) {
    float a = 0.f, b = 0.f; const int row = (int)(i >> 9), col = (int)(i & 511);
    switch (mode) {
      case 0: a = ((const float*)A)[i]; b = B[i]; break;
      case 1: a = b2f(A16[i]); b = B[i]; break;
      case 2: { b = B[(size_t)row * 2048 + col]; const int g = col >> 4, c = col & 15; int crow, s; if (row < 16384) { crow = row >> 5; s = row & 31; } else { const int j = row - 16384; crow = 512 + (j >> 5); s = j & 31; }
                a = b2f(A16[((size_t)(g * 768 + crow)) * 768 + s * 16 + c]); } break;
      case 3: b = B[(size_t)row * 2048 + 512 + col]; a = b2f(A16[(size_t)row * 512 + col]); break;
      case 4: b = B[(size_t)row * 2048 + 1024 + col]; a = b2f(A16[(size_t)row * 512 + col]); break;
      case 5: b = B[(size_t)row * 2048 + 1536 + col]; a = b2f(A16[(size_t)col * 16640 + row]); break;
      case 6: b = B[(size_t)row * 1024 + col]; a = b2f(A16[(size_t)row * 1024 + col]); break;
      case 7: b = B[(size_t)row * 1024 + 512 + col]; a = b2f(A16[(size_t)row * 1024 + 512 + col]); break;
      case 8: { const int ta = (int)(i & 127), ri = (int)((i >> 7) & 1), tb = (int)((i >> 8) & 127), m = (int)((i >> 15) & 255), g = (int)(i >> 23); a = b2f(A16[i]); const int t = 128 * ta + tb; b = B[((size_t)t * 4 + g) * 512 + ri * 256 + m]; } break;
      default: break;
    }
    const double d = (double)a - (double)b; e += d * d; r += (double)b * (double)b;
  }
  for (int o = 32; o >= 1; o >>= 1) { e += __shfl_xor(e, o); r += __shfl_xor(r, o); }
  if ((threadIdx.x & 63) == 0) { atomicAdd(acc, e); atomicAdd(acc + 1, r); }
}
__global__ void k_cmp_x2(const bf16_t* X2, const float* Yr, const float* Yi, double* acc) {
  double e = 0.0, r = 0.0;
  for (unsigned long long i = (unsigned long long)blockIdx.x * 256 + threadIdx.x; i < (1ull << 25); i += (unsigned long long)gridDim.x * 256) {
    const int tb = (int)(i & 127), rip = (int)((i >> 7) & 1), ka = (int)((i >> 8) & 127), gm = (int)(i >> 15);
    const float a = b2f(X2[i]); const size_t yi = (((size_t)ka * 128 + tb) << 10) + gm; const float b = rip ? Yi[yi] : Yr[yi];
    const double d = (double)a - (double)b; e += d * d; r += (double)b * (double)b;
  }
  for (int o = 32; o >= 1; o >>= 1) { e += __shfl_xor(e, o); r += __shfl_xor(r, o); }
  if ((threadIdx.x & 63) == 0) { atomicAdd(acc, e); atomicAdd(acc + 1, r); }
}
__global__ void k_judge(const double* acc, int n, float tol, int* fail) {
  if (threadIdx.x == 0 && blockIdx.x == 0) { fail[0] = 0; for (int k = 0; k < n; ++k) { const double rel = sqrt(acc[2 * k] / acc[2 * k + 1]); if (!(rel <= (double)tol)) { fail[0] = k + 1; break; } } }
}
__global__ void k_encode(float* out, size_t n, const int* fail) {
  const int f = fail[0]; if (f == 0) return; const float sc = 1.f + 0.1f * (float)f;
  for (size_t i = (size_t)blockIdx.x * 256 + threadIdx.x; i < n; i += (size_t)gridDim.x * 256) out[i] *= sc;
}
__global__ void k_f2bf(const float* in, bf16_t* out, size_t n) { for (size_t i = (size_t)blockIdx.x * 256 + threadIdx.x; i < n; i += (size_t)gridDim.x * 256) out[i] = mk::f2bf(in[i]); }
static void cmp(hipStream_t s, int mode, const void* A, const float* B, unsigned long long n, double* acc) { hipLaunchKernelGGL(k_cmp, dim3(2048), dim3(256), 0, s, mode, A, B, n, acc); }
}
#endif

extern "C" void kernel_launch(void* const* d_in, const int* in_sizes, int n_in, void* d_out, int out_size, void* d_ws, size_t ws_size, hipStream_t stream) {
  if (!mk_setup(n_in, out_size, ws_size)) return;
  unsigned char* ws = (unsigned char*)d_ws;
  const size_t MiB = mk::MiB;
  mk::Args a{};
  for (int i = 0; i < 31; ++i) a.in[i] = (const float*)d_in[i];
  a.h = (float*)d_out; a.ws = ws; a.flags = 0; a.pad = 0;
#if CHECK == 0
  (void)hipMemsetAsync(ws + mk::WS_CTL, 0, mk::CTL_ZERO_BYTES, stream);
#if MK_N_LAUNCHES == 1
  mk_run(stream, a, 0, mk::NPHASE);
#else
  for (int ph = 0; ph < mk::NPHASE; ++ph) mk_run(stream, a, ph, ph + 1);
#endif
#else
  ref::In in; { const float** p = (const float**)&in; for (int i = 0; i < 31; ++i) p[i] = (const float*)d_in[i]; }
  float* out = (float*)d_out;
  char* wsc = (char*)d_ws;
  ref::Small sm; sm.mod = (float*)(wsc + 498 * MiB); sm.lamb = (float2*)(wsc + 498 * MiB + 131072); sm.bbar = (float2*)(wsc + 498 * MiB + 262144);
  sm.tw = (float2*)(wsc + 499 * MiB); sm.Dm = (float*)(wsc + 499 * MiB + 262144);
  double* acc = (double*)(wsc + 500 * MiB); int* fail = (int*)(wsc + 500 * MiB + 4096);
  (void)hipMemsetAsync(acc, 0, 8192, stream);
  (void)hipMemsetAsync(ws + mk::WS_CTL, 0, mk::CTL_ZERO_BYTES, stream);
  float* HOPT = (float*)(ws + mk::WS_HOPT);
  int nchk = 0;
#if CHECK == 1
  ref::MixBuf mb; mb.a0 = (float*)(wsc + 12 * MiB); mb.z = (float*)(wsc + 336 * MiB); mb.g = (float*)(wsc + 466 * MiB); mb.t = (float*)(wsc + 77 * MiB); mb.concat = mb.a0; mb.ymix = mb.z;
  char* moe_arena = wsc + 12 * MiB;
  ref::FourBuf fb; { char* p = wsc + 12 * MiB; fb.a1 = (float*)p; p += 64 * MiB; fb.Z = (float*)p; p += 128 * MiB; fb.Yr = (float*)p; p += 64 * MiB; fb.Yi = (float*)p; p += 64 * MiB; fb.F = (float*)p; fb.yf = fb.Z; }
  a.flags = mk::FLAG_SKIP_EXPERTS;
  nchk = 10;
  ref::forward(stream, in, out, sm, mb, moe_arena, fb, [&](int st) {
    if (st == 1) { mk_run(stream, a, 0, 1); chk::cmp(stream, 0, ws + mk::WS_MOD, sm.mod, 3 * 6144, acc + 0); }
    if (st == 2) { mk_run(stream, a, 1, 2); chk::cmp(stream, 1, ws + mk::WS_A0, mb.a0, 16640ull * 1024, acc + 2); }
    if (st == 3) { mk_run(stream, a, 2, 3); chk::cmp(stream, 2, ws + mk::WS_AS5, mb.z, 16640ull * 512, acc + 4); chk::cmp(stream, 3, ws + mk::WS_Q, mb.z, 16384ull * 512, acc + 6);
                   chk::cmp(stream, 4, ws + mk::WS_K, mb.z, 16640ull * 512, acc + 8); chk::cmp(stream, 5, ws + mk::WS_VT, mb.z, 16640ull * 512, acc + 10); }
    if (st == 4) { mk_run(stream, a, 3, 4); mk_run(stream, a, 4, 5); mk_run(stream, a, 5, 6); chk::cmp(stream, 1, ws + mk::WS_GB, mb.g, 16384ull * 512, acc + 12); }
    if (st == 5) { mk_run(stream, a, 6, 7); chk::cmp(stream, 6, ws + mk::WS_CONCAT, mb.concat, 16384ull * 512, acc + 14); }
    if (st == 6) { mk_run(stream, a, 7, 8); chk::cmp(stream, 7, ws + mk::WS_CONCAT, mb.concat, 16384ull * 512, acc + 16); }
    if (st == 7) { mk::Args b = a; b.h = HOPT; mk_run(stream, b, 8, 9); chk::cmp(stream, 0, HOPT, out, 16384ull * 1024, acc + 18); }
  });
#elif CHECK == 2 || CHECK == 4
  const int L = CHECK == 2 ? 0 : 1;
  ref::MixBuf mb; { char* p = wsc + 12 * MiB; mb.a0 = (float*)p; p += 65 * MiB; mb.z = (float*)p; p += 130 * MiB; mb.g = (float*)p; p += 32 * MiB; mb.t = (float*)p; p += 32 * MiB; mb.concat = (float*)p; p += 64 * MiB; mb.ymix = mb.z; }
  ref::FourBuf fb; { char* p = wsc + 12 * MiB; fb.a1 = (float*)p; p += 64 * MiB; fb.Z = (float*)p; p += 128 * MiB; fb.Yr = (float*)p; p += 64 * MiB; fb.Yi = (float*)p; p += 64 * MiB; fb.F = (float*)p; fb.yf = fb.Z; }
  char* moe_arena = wsc + 110 * MiB;
  nchk = L == 0 ? 2 : 1;
  a.flags = 0;
  ref::forward(stream, in, out, sm, mb, moe_arena, fb, [&](int st) {
    if ((L == 0 && st == 7) || (L == 1 && st == 11)) {
      mk::Args b = a; b.h = HOPT; if (L == 1) b.flags = 2;
      mk_run(stream, b, 0, 1);
      (void)hipMemcpyAsync(HOPT, out, (size_t)16384 * 1024 * 4, hipMemcpyDeviceToDevice, stream);
      const int pb = L == 0 ? 9 : 20; b.flags |= mk::FLAG_SKIP_EXPERTS;
      for (int ph = pb; ph < pb + 7; ++ph) mk_run(stream, b, ph, ph + 1);
    }
    if ((L == 0 && st == 8) || (L == 1 && st == 12)) chk::cmp(stream, 0, HOPT, out, 16384ull * 1024, acc + 0);
    if (L == 0 && st == 9) chk::cmp(stream, 1, ws + mk::WS_A1, fb.a1, 16384ull * 1024, acc + 2);
  });
#elif CHECK == 3
  ref::MixBuf mb; { char* p = wsc + 12 * MiB; mb.a0 = (float*)p; p += 65 * MiB; mb.z = (float*)p; p += 130 * MiB; mb.g = (float*)p; p += 32 * MiB; mb.t = (float*)p; p += 32 * MiB; mb.concat = (float*)p; p += 64 * MiB; mb.ymix = mb.z; }
  char* moe_arena = wsc + 12 * MiB;
  ref::FourBuf fb; fb.Z = (float*)(wsc + 270 * MiB);
  fb.a1 = (float*)(wsc + 12 * MiB); fb.Yr = (float*)(wsc + 12 * MiB);   fb.Yi = (float*)(wsc + 468 * MiB - 0); fb.F = (float*)(wsc + 270 * MiB); fb.yf = (float*)(wsc + 334 * MiB);
  fb.Yi = (float*)(wsc + 76 * MiB);
  nchk = 4;
  a.flags = mk::FLAG_SKIP_EXPERTS;
  ref::forward(stream, in, out, sm, mb, moe_arena, fb, [&](int st) {
    if (st == 9) {
      mk::Args b = a; b.h = HOPT;
      mk_run(stream, b, 0, 1);
      hipLaunchKernelGGL(chk::k_f2bf, dim3(2048), dim3(256), 0, stream, fb.a1, (chk::bf16_t*)(ws + mk::WS_A1), (size_t)16384 * 1024);
      (void)hipMemcpyAsync(HOPT, out, (size_t)16384 * 1024 * 4, hipMemcpyDeviceToDevice, stream);
      mk_run(stream, b, 16, 17);
    }
  });
#endif
  hipLaunchKernelGGL(chk::k_judge, dim3(1), dim3(64), 0, stream, acc, nchk, 0.05f, fail);
  hipLaunchKernelGGL(chk::k_encode, dim3(2048), dim3(256), 0, stream, out, (size_t)16384 * 1024, fail);
#endif
}
```

```cpp
#define CHECK 0
#define MK_N_LAUNCHES 1
#define MK_SP2 true
#define REP_MASK 0ull
#include <hip/hip_runtime.h>
#include <cstdio>
#include <cstdint>
#include <cmath>
namespace mk {
#define LAS __attribute__((address_space(3)))
typedef unsigned short bf16_t;
typedef short bf16x8 __attribute__((ext_vector_type(8)));
typedef float f32x4 __attribute__((ext_vector_type(4)));
typedef float f32x2 __attribute__((ext_vector_type(2)));
typedef unsigned u32x4 __attribute__((ext_vector_type(4)));
typedef unsigned u32x2 __attribute__((ext_vector_type(2)));
typedef int i32x8 __attribute__((ext_vector_type(8)));
typedef int i32x4 __attribute__((ext_vector_type(4)));

constexpr int TOK = 16384, CTXN = 256, NROW = TOK + CTXN;
constexpr int NWAVES = 8, NTHR = 512;
constexpr int LDS_STAGE = 131072, LDS_BYTES = 155648, LDS_MISC_OFF = LDS_BYTES - 4096;

__device__ __forceinline__ unsigned cvt_pk_bf16(float lo, float hi) { unsigned r; asm volatile("v_cvt_pk_bf16_f32 %0, %1, %2" : "=v"(r) : "v"(lo), "v"(hi)); return r; }
__device__ __forceinline__ float bf_lo(unsigned w) { return __uint_as_float(w << 16); }
__device__ __forceinline__ float bf_hi(unsigned w) { return __uint_as_float(w & 0xffff0000u); }
__device__ __forceinline__ float bf2f(bf16_t b) { return __uint_as_float(((unsigned)b) << 16); }
__device__ __forceinline__ bf16_t f2bf(float f) { unsigned u = __float_as_uint(f); return (bf16_t)((u + 0x7fffu + ((u >> 16) & 1u)) >> 16); }
__device__ __forceinline__ float sx(float v, int o) { int l = __builtin_amdgcn_mbcnt_hi(~0u, __builtin_amdgcn_mbcnt_lo(~0u, 0u)); asm volatile("" : "+v"(l)); return __int_as_float(__builtin_amdgcn_ds_bpermute((l ^ o) << 2, __float_as_int(v))); }
__device__ __forceinline__ float wave_sum(float v) {
#pragma unroll
  for (int o = 1; o < 64; o <<= 1) v += sx(v, o);
  return v;
}
__device__ __forceinline__ float fast_sigmoid(float x) { return __builtin_amdgcn_rcpf(1.f + __expf(-x)); }
__device__ __forceinline__ float fast_tanh(float x) { float e = __expf(2.f * x); return 1.f - 2.f * __builtin_amdgcn_rcpf(e + 1.f); }
__device__ __forceinline__ float gelu_tanh(float x) { return 0.5f * x * (1.f + fast_tanh(0.7978845608028654f * (x + 0.044715f * x * x * x))); }

#define XB_TMO      128
#define XB_XCNT(j)  (256  + 64 * (j))
#define XB_XSUB(j)  (1280 + 64 * (j))
#define XB_XGEN(j)  (2304 + 64 * (j))
#define XB_TOP      3328
#define XB_TOPGEN   3392
#define XCD_BAR_WORDS 3456
#define XB_SPIN_CAP (1u << 20)
__device__ __forceinline__ unsigned xb_ld(unsigned* p) { return __hip_atomic_load(p, __ATOMIC_RELAXED, __HIP_MEMORY_SCOPE_AGENT); }
__device__ __forceinline__ unsigned xb_add(unsigned* p, unsigned v) { return __hip_atomic_fetch_add(p, v, __ATOMIC_RELAXED, __HIP_MEMORY_SCOPE_AGENT); }
__device__ __forceinline__ unsigned xb_xcc_id() { return (unsigned)__builtin_amdgcn_s_getreg((3 << 11) | 20) & 0xFu; }
#define XB_SPIN(cond, bar) do { unsigned _sp = 0; while (cond) { __builtin_amdgcn_s_sleep(1); \
    if ((++_sp & 255u) == 0u) { if (xb_ld(&(bar)[XB_TMO])) break; if (_sp > XB_SPIN_CAP) { atomicAdd(&(bar)[XB_TMO], 1u); break; } } } } while (0)
struct XcdBarrier { unsigned* bar; unsigned x; volatile LAS unsigned* st; };
__device__ __forceinline__ XcdBarrier xcd_barrier_post(unsigned* bar, volatile LAS unsigned* st, int tid) {
  XcdBarrier b; b.bar = bar; b.x = xb_xcc_id(); b.st = st;
  if (tid == 0) (void)xb_add(&bar[XB_XCNT(b.x)], 1u);
  return b;
}
__device__ __forceinline__ void xcd_barrier_complete(unsigned* bar, unsigned x, unsigned& nloc, unsigned& nx) {
  const unsigned G = gridDim.x * gridDim.y * gridDim.z;
  unsigned sum, cnt, mine, sp = 0u;
  for (;;) {
    sum = 0u; cnt = 0u; mine = 0u;
#pragma unroll
    for (unsigned j = 0; j < 16; ++j) { const unsigned c = xb_ld(&bar[XB_XCNT(j)]); sum += c; cnt += (c > 0u) ? 1u : 0u; }
    if (sum == G) { mine = xb_ld(&bar[256 + 64 * x]); break; }
    __builtin_amdgcn_s_sleep(1);
    if ((++sp & 255u) == 0u) { if (xb_ld(&bar[XB_TMO])) break; if (sp > XB_SPIN_CAP) { atomicAdd(&bar[XB_TMO], 1u); break; } }
  }
  nloc = mine > 0u ? mine : 1u; nx = cnt > 0u ? cnt : 1u;
}
__device__ __forceinline__ void xcd_barrier(const XcdBarrier& b, int tid) {
  asm volatile("s_waitcnt vmcnt(0)" ::: "memory");
  __syncthreads();
  if (tid == 0) {
    unsigned* bar = b.bar;
    __builtin_amdgcn_s_waitcnt(0);
    unsigned nloc = b.st[0], nx = b.st[1];
    if (nloc == 0u) { xcd_barrier_complete(bar, b.x, nloc, nx); b.st[0] = nloc; b.st[1] = nx; }
    const unsigned old = xb_add(&bar[XB_XSUB(b.x)], 1u);
    const unsigned gen = old / nloc;
    if (old + 1u == (gen + 1u) * nloc) {
      __builtin_amdgcn_fence(__ATOMIC_RELEASE, "agent");
      asm volatile("s_waitcnt vmcnt(0)" ::: "memory");
      const unsigned og = xb_add(&bar[XB_TOP], 1u);
      const unsigned tg = og / nx;
      if (og + 1u == (tg + 1u) * nx) xb_add(&bar[XB_TOPGEN], 1u);
      else XB_SPIN(xb_ld(&bar[XB_TOPGEN]) == tg, bar);
      __builtin_amdgcn_fence(__ATOMIC_ACQUIRE, "agent");
      xb_add(&bar[XB_XGEN(b.x)], 1u);
      asm volatile("s_waitcnt vmcnt(0)" ::: "memory");
    } else {
      XB_SPIN(xb_ld(&bar[XB_XGEN(b.x)]) == gen, bar);
      __builtin_amdgcn_fence(__ATOMIC_ACQUIRE, "agent");
      asm volatile("s_waitcnt vmcnt(0)" ::: "memory");
    }
  }
  __syncthreads();
}

constexpr int BM = 256, BK = 64, HALF = 128, HTB = HALF * BK * 2, NXCD = 8;
__device__ __forceinline__ int lds_byte(int r, int c) { const int st = (r >> 4) * 2 + (c >> 5), rr = r & 15, cc = c & 31, ob = rr * 64 + cc * 2; return st * 1024 + (ob ^ (((ob >> 9) & 1) << 5)); }
__device__ __forceinline__ void stage_rc(int b, int& R, int& C) { const int st = b / 1024, sb = b % 1024, swz = sb ^ (((sb >> 9) & 1) << 5); R = (st >> 1) * 16 + swz / 64; C = (st & 1) * 32 + (swz % 64) / 2; }
__device__ __forceinline__ int perm32(int rho) { const int n = rho >> 4, i = rho & 15; return 8 * (i >> 2) + 4 * n + (i & 3); }

struct Unit { int pm, pn, a, b, ord; };
__device__ __forceinline__ int xcd_remap(int L, int nunits) { const int q = nunits / NXCD, r = nunits % NXCD, xcd = L % NXCD, off = L / NXCD; return (xcd < r ? xcd * (q + 1) : r * (q + 1) + (xcd - r) * q) + off; }
typedef f32x4 Acc[2][2][4][2];
template <class P, bool SP2>
__device__ __forceinline__ void gemm_phase(LAS unsigned char* lds, const P& p, int G, int c, int tid_in) {
  const int tid = tid_in, wid = __builtin_amdgcn_readfirstlane(tid >> 6), lane = tid & 63, wr = wid >> 2, wc = wid & 3, fr = lane & 15, fq = lane >> 4;
  const int K = p.K, nt = K / BK;
  const int nunits = p.nunits;
  const size_t kstep = (size_t)(BK * 2);
  const unsigned ldsw = (unsigned)wid * 1024u;
  const int aoff = lds_byte(wr * 64 + fr, P::F8 ? fq * 16 : fq * 8), boff = lds_byte(wc * 32 + fr, P::F8 ? fq * 16 : fq * 8);
#define PG8_SA(b, h) (((b) * 2 + (h)) * HTB)
#define PG8_SB(b, h) ((4 + (b) * 2 + (h)) * HTB)
#define PG8_STAGE(bufoff, gbase, voff) do { _Pragma("unroll") for (int _i = 0; _i < 2; ++_i) \
        __builtin_amdgcn_global_load_lds((const unsigned*)((const char*)(gbase) + (voff)[_i]), (LAS unsigned*)(lds + (bufoff) + ldsw + _i * 8192), 16, 0, 0); } while (0)
#define PG8_RD32(p_) __builtin_shufflevector(*(const LAS i32x4*)(p_), *(const LAS i32x4*)((p_) + 16), 0, 1, 2, 3, 4, 5, 6, 7)
#define PG8_LDA(dst, b, h) do { if constexpr (P::F8) { _Pragma("unroll") for (int m = 0; m < 4; ++m) dst##8[m] = PG8_RD32(lds + PG8_SA(b, h) + aoff + m * 2048); } \
        else { _Pragma("unroll") for (int m = 0; m < 4; ++m) _Pragma("unroll") for (int k = 0; k < 2; ++k) dst[m][k] = *(const LAS bf16x8*)(lds + PG8_SA(b, h) + aoff + m * 2048 + k * 1024); } } while (0)
#define PG8_LDB(dst, b, h) do { if constexpr (P::F8) { _Pragma("unroll") for (int n = 0; n < 2; ++n) dst##8[n] = PG8_RD32(lds + PG8_SB(b, h) + boff + n * 2048); } \
        else { _Pragma("unroll") for (int n = 0; n < 2; ++n) _Pragma("unroll") for (int k = 0; k < 2; ++k) dst[n][k] = *(const LAS bf16x8*)(lds + PG8_SB(b, h) + boff + n * 2048 + k * 1024); } } while (0)
#define PG8_MMA(ai, bj, At, Bt) do { __builtin_amdgcn_s_setprio(1); if constexpr (P::F8) { _Pragma("unroll") for (int m = 0; m < 4; ++m) _Pragma("unroll") for (int n = 0; n < 2; ++n) \
        acc[ai][bj][m][n] = __builtin_amdgcn_mfma_scale_f32_16x16x128_f8f6f4(Bt##8[n], At##8[m], acc[ai][bj][m][n], 0, 0, 0, P::SCALE_B, 0, 0x7F7F7F7F); } \
        else { _Pragma("unroll") for (int m = 0; m < 4; ++m) _Pragma("unroll") for (int n = 0; n < 2; ++n) _Pragma("unroll") for (int k = 0; k < 2; ++k) \
        acc[ai][bj][m][n] = __builtin_amdgcn_mfma_f32_16x16x32_bf16(Bt[n][k], At[m][k], acc[ai][bj][m][n], 0, 0, 0); } __builtin_amdgcn_s_setprio(0); } while (0)
#define PG8_WAIT_V(n) asm volatile("s_waitcnt vmcnt(" #n ")" ::: "memory")
#define PG8_WAIT_L(n) asm volatile("s_waitcnt lgkmcnt(" #n ")" ::: "memory")
#define PG8_BAR __builtin_amdgcn_s_barrier()
#define PG8_SCHED __builtin_amdgcn_sched_barrier(0)
#define PG8_DECODE(i, u) do { p.decode(P::CONTIG ? (u_lo + (i)) : xcd_remap((i) * G + c, nunits), u); u.ord = (i); } while (0)
#define PG8_HAS(i) (P::CONTIG ? (u_lo + (i) < u_hi) : ((i) * G + c < nunits))
#define PG8_OFFS(u, vA, vB) do { int _t = tid; asm volatile("" : "+v"(_t)); _Pragma("unroll") for (int _i = 0; _i < 2; ++_i) { int _R, _C; stage_rc(_t * 16 + _i * 8192, _R, _C); \
        const int _Rb = P::PERM ? ((_R & ~31) + perm32(_R & 31)) : _R; _Pragma("unroll") for (int _h = 0; _h < 2; ++_h) { \
        if (_h == 0 || !P::LINA) vA[_h][_i] = p.rowA(u, _h * HALF + _R) + (unsigned)(_C * 2); if (_h == 0 || !P::LINB) vB[_h][_i] = p.rowB(u, _h * HALF + _Rb) + (unsigned)(_C * 2); } } } while (0)
  const int vc_ = (G % 8 == 0) ? (c % 8) * (G / 8) + c / 8 : c;
  const int u_lo = (int)(((long)vc_ * nunits) / G), u_hi = (int)(((long)(vc_ + 1) * nunits) / G);
  if (!PG8_HAS(0)) return;
  Unit cur, nxt; int ui = 0;
  PG8_DECODE(0, cur);
  Acc acc; float zf_ = 0.f; asm volatile("" : "+v"(zf_));
#pragma unroll
  for (int a = 0; a < 2; ++a)
#pragma unroll
    for (int b = 0; b < 2; ++b)
#pragma unroll
      for (int m = 0; m < 4; ++m)
#pragma unroll
        for (int n = 0; n < 2; ++n) acc[a][b][m][n] = (f32x4){zf_, zf_, zf_, zf_};
  bf16x8 At[4][2], B0[2][2], B1[2][2]; i32x8 At8[4], B08[2], B18[2];
  unsigned vA[2][2], vB[2][2];
  PG8_OFFS(cur, vA, vB);
  const char* cA = p.baseA(cur); const char* cB = p.baseB(cur);
  const size_t hA = P::LINA ? p.halfA() : 0, hB = P::LINB ? p.halfB() : 0;
  if constexpr (SP2) {
    PG8_STAGE(PG8_SB(0, 0), cB, vB[0]); PG8_STAGE(PG8_SB(0, 1), (cB) + (P::LINB ? hB : 0), vB[P::LINB ? 0 : 1]); PG8_STAGE(PG8_SA(0, 0), cA, vA[0]); PG8_STAGE(PG8_SA(0, 1), (cA) + (P::LINA ? hA : 0), vA[P::LINA ? 0 : 1]);
    if (wr == 1) PG8_BAR;
    PG8_WAIT_V(2); PG8_BAR;
    PG8_STAGE(PG8_SB(1, 0), cB + kstep, vB[0]); PG8_STAGE(PG8_SA(1, 0), cA + kstep, vA[0]); PG8_STAGE(PG8_SB(1, 1), (cB + kstep) + (P::LINB ? hB : 0), vB[P::LINB ? 0 : 1]);
    PG8_WAIT_V(6); PG8_BAR;
  } else {
    PG8_STAGE(PG8_SB(0, 0), cB, vB[0]); PG8_STAGE(PG8_SA(0, 0), cA, vA[0]); PG8_STAGE(PG8_SB(0, 1), (cB) + (P::LINB ? hB : 0), vB[P::LINB ? 0 : 1]); PG8_STAGE(PG8_SA(0, 1), (cA) + (P::LINA ? hA : 0), vA[P::LINA ? 0 : 1]);
    if (wr == 1) PG8_BAR;
    PG8_WAIT_V(4); PG8_BAR;
    PG8_STAGE(PG8_SB(1, 0), cB + kstep, vB[0]); PG8_STAGE(PG8_SA(1, 0), cA + kstep, vA[0]); PG8_STAGE(PG8_SB(1, 1), (cB + kstep) + (P::LINB ? hB : 0), vB[P::LINB ? 0 : 1]);
    PG8_WAIT_V(6); PG8_BAR;
  }
  for (;;) {
    const bool has_next = PG8_HAS(ui + 1);
    if (has_next) PG8_DECODE(ui + 1, nxt);
    const char* nA = has_next ? p.baseA(nxt) : cA; const char* nB = has_next ? p.baseB(nxt) : cB;
    for (int t = 0; t < nt; t += 2) {
      const bool last = (t == nt - 2);
      const char* a1 = cA + (size_t)(t + 1) * kstep;
      const char* a2 = last ? nA : cA + (size_t)(t + 2) * kstep; const char* b2 = last ? nB : cB + (size_t)(t + 2) * kstep;
      const char* a3 = a2 + kstep; const char* b3 = b2 + kstep;
      if constexpr (SP2) {
        PG8_LDB(B0, 0, 0); PG8_LDB(B1, 0, 1); PG8_SCHED; PG8_LDA(At, 0, 0); PG8_STAGE(PG8_SA(1, 1), (a1) + (P::LINA ? hA : 0), vA[P::LINA ? 0 : 1]);
        PG8_WAIT_V(8); PG8_WAIT_L(0); PG8_BAR; PG8_MMA(0, 0, At, B0); PG8_MMA(0, 1, At, B1); PG8_BAR; PG8_SCHED;
        if (last && has_next) { PG8_OFFS(nxt, vA, vB); }
        PG8_LDA(At, 0, 1); PG8_STAGE(PG8_SB(0, 0), b2, vB[0]); PG8_STAGE(PG8_SB(0, 1), (b2) + (P::LINB ? hB : 0), vB[P::LINB ? 0 : 1]); PG8_STAGE(PG8_SA(0, 0), a2, vA[0]);
        PG8_WAIT_V(8); PG8_WAIT_L(0); PG8_BAR; PG8_MMA(1, 0, At, B0); PG8_MMA(1, 1, At, B1); PG8_BAR; PG8_SCHED;
        PG8_LDB(B0, 1, 0); PG8_LDB(B1, 1, 1); PG8_SCHED; PG8_LDA(At, 1, 0); PG8_STAGE(PG8_SA(0, 1), (a2) + (P::LINA ? hA : 0), vA[P::LINA ? 0 : 1]);
        PG8_WAIT_V(8); PG8_WAIT_L(0); PG8_BAR; PG8_MMA(0, 0, At, B0); PG8_MMA(0, 1, At, B1); PG8_BAR; PG8_SCHED;
        PG8_LDA(At, 1, 1); PG8_STAGE(PG8_SB(1, 0), b3, vB[0]); PG8_STAGE(PG8_SB(1, 1), (b3) + (P::LINB ? hB : 0), vB[P::LINB ? 0 : 1]); PG8_STAGE(PG8_SA(1, 0), a3, vA[0]);
        PG8_WAIT_V(8); PG8_WAIT_L(0); PG8_BAR; PG8_MMA(1, 0, At, B0); PG8_MMA(1, 1, At, B1); PG8_BAR; PG8_SCHED;
      } else {
        PG8_LDB(B0, 0, 0); PG8_SCHED; PG8_LDA(At, 0, 0); PG8_STAGE(PG8_SA(1, 1), (a1) + (P::LINA ? hA : 0), vA[P::LINA ? 0 : 1]);
        PG8_WAIT_L(8); PG8_BAR; PG8_WAIT_L(0); PG8_MMA(0, 0, At, B0); PG8_BAR; PG8_SCHED;
        if (last && has_next) { PG8_OFFS(nxt, vA, vB); }
        PG8_LDB(B1, 0, 1); PG8_STAGE(PG8_SB(0, 0), b2, vB[0]);
        PG8_BAR; PG8_WAIT_L(0); PG8_MMA(0, 1, At, B1); PG8_BAR;
        PG8_LDA(At, 0, 1); PG8_STAGE(PG8_SA(0, 0), a2, vA[0]);
        PG8_BAR; PG8_WAIT_L(0); PG8_MMA(1, 0, At, B0); PG8_BAR; PG8_SCHED;
        PG8_STAGE(PG8_SB(0, 1), (b2) + (P::LINB ? hB : 0), vB[P::LINB ? 0 : 1]);
        PG8_WAIT_V(6); PG8_BAR; PG8_MMA(1, 1, At, B1); PG8_BAR;
        PG8_LDB(B0, 1, 0); PG8_SCHED; PG8_LDA(At, 1, 0); PG8_STAGE(PG8_SA(0, 1), (a2) + (P::LINA ? hA : 0), vA[P::LINA ? 0 : 1]);
        PG8_WAIT_L(8); PG8_BAR; PG8_WAIT_L(0); PG8_MMA(0, 0, At, B0); PG8_BAR; PG8_SCHED;
        PG8_LDB(B1, 1, 1); PG8_STAGE(PG8_SB(1, 0), b3, vB[0]);
        PG8_BAR; PG8_WAIT_L(0); PG8_MMA(0, 1, At, B1); PG8_BAR;
        PG8_LDA(At, 1, 1); PG8_STAGE(PG8_SA(1, 0), a3, vA[0]);
        PG8_BAR; PG8_WAIT_L(0); PG8_MMA(1, 0, At, B0); PG8_BAR; PG8_SCHED;
        PG8_STAGE(PG8_SB(1, 1), (b3) + (P::LINB ? hB : 0), vB[P::LINB ? 0 : 1]);
        PG8_WAIT_V(6); PG8_BAR; PG8_MMA(1, 1, At, B1); PG8_BAR;
      }
    }
    if constexpr (P::ALIGN) { if (wr == 0) PG8_BAR; }
    { int fr_e = fr, fq_e = fq; asm volatile("" : "+v"(fr_e), "+v"(fq_e)); p.epi(acc, cur, wr, wc, fr_e, fq_e); }
    if (!has_next) break;
    zf_ = 0.f; asm volatile("" : "+v"(zf_));
#pragma unroll
    for (int a = 0; a < 2; ++a)
#pragma unroll
      for (int b = 0; b < 2; ++b)
#pragma unroll
        for (int m = 0; m < 4; ++m)
#pragma unroll
          for (int n = 0; n < 2; ++n) acc[a][b][m][n] = (f32x4){zf_, zf_, zf_, zf_};
    cur = nxt; cA = nA; cB = nB; ++ui;
    if constexpr (P::ALIGN) { if (wr == 1) PG8_BAR; }
  }
  PG8_WAIT_V(0);
  if constexpr (!P::ALIGN) { if (wr == 0) PG8_BAR; }
  PG8_BAR;
#undef PG8_SA
#undef PG8_SB
#undef PG8_STAGE
#undef PG8_RD32
#undef PG8_LDA
#undef PG8_LDB
#undef PG8_MMA
#undef PG8_WAIT_V
#undef PG8_WAIT_L
#undef PG8_BAR
#undef PG8_SCHED
#undef PG8_DECODE
#undef PG8_HAS
#undef PG8_OFFS
}
}
namespace mk {
constexpr size_t MiB = 1u << 20;
constexpr size_t WS_CTL = 0, CTL_ZERO_BYTES = 65536;
constexpr size_t WS_MOD = 65536;
constexpr size_t WS_LAML = 262144;
constexpr size_t WS_WIN_T = 1 * MiB, WS_WGLU_T = 5 * MiB, WS_WMIX_T = 6 * MiB, WS_WFOUR_T = 8 * MiB, WS_WROUT_T = 10 * MiB;
constexpr size_t WS_DMT = 10 * MiB + 512 * 1024, WS_W1 = 10 * MiB + 768 * 1024, WS_W2 = 10 * MiB + 896 * 1024;
constexpr size_t WS_WEXP = 12 * MiB, EXP_STRIDE = 3 * MiB / 2, EXP_DOFF = 1 * MiB;
constexpr size_t WS_R = 110 * MiB;
constexpr size_t WS_WS = WS_R, WS_TT = WS_R + 8 * MiB, WS_A0 = WS_R + 34 * MiB, WS_AS5 = WS_R + 67 * MiB, WS_Q = WS_R + 103 * MiB, WS_K = WS_R + 119 * MiB,
                 WS_VT = WS_R + 136 * MiB, WS_SST = WS_R + 153 * MiB, WS_GB = WS_R + 177 * MiB, WS_CONCAT = WS_R + 193 * MiB;
constexpr size_t WS_F = WS_R, WS_LTOK = WS_R + 32 * MiB, WS_ASG = WS_R + 36 * MiB, WS_HID = WS_R + 42 * MiB, WS_YAS = WS_R + 130 * MiB,
                 WS_A1 = WS_R + 306 * MiB;
constexpr size_t WS_X1 = WS_R, WS_X2 = WS_R + 64 * MiB, WS_FB = WS_R + 128 * MiB;
constexpr size_t WS_HOPT = WS_R + 338 * MiB;
constexpr size_t WS_NEED = WS_R + 338 * MiB;
constexpr int HALF_CAP_ROWS = 90112;
constexpr int CW_BAR = 4096, CW_CNT = 8192  , CW_DQ0 = 12288, CW_DQ1 = 12352;

struct Args { const float* in[31]; float* h; unsigned char* ws; int ph_lo, ph_hi, flags, pad; };
enum { IN_X = 0, IN_C, IN_CTX, IN_CCTX, IN_WADA, IN_BADA, IN_WIN, IN_LRE, IN_LIM, IN_LDT, IN_BRE, IN_BIM, IN_CRE, IN_CIM, IN_S5D, IN_WGLU, IN_BGLU, IN_QG, IN_KG,
       IN_RPB, IN_WMIX, IN_WFOUR, IN_BFOUR, IN_WROUT, IN_RBIAS, IN_WEG, IN_WEU, IN_WED, IN_WSG, IN_WSU, IN_WSD };
constexpr int FLAG_SKIP_EXPERTS = 1;

struct Ctx {
  LAS unsigned char* lds; const Args* a; unsigned char* ws; int tid, lane, wave, G, c;
};

__device__ __forceinline__ u32x4 pack8(const f32x4& v0, const f32x4& v1) { u32x4 w; w.x = cvt_pk_bf16(v0[0], v0[1]); w.y = cvt_pk_bf16(v0[2], v0[3]); w.z = cvt_pk_bf16(v1[0], v1[1]); w.w = cvt_pk_bf16(v1[2], v1[3]); return w; }
__device__ __forceinline__ int rowmap(int code, int n) {
  if (code == 1) { if (n < 512 || n >= 1536) return n; const int blk = n & ~255, c = n & 255; return blk + 128 * ((c >> 5) & 1) + 32 * (c >> 6) + (c & 31); }
  if (code == 2) return 256 * (n >> 7) + (n & 127);
  if (code == 3) return 256 * (n >> 7) + 128 + (n & 127);
  return n;
}
__device__ __forceinline__ void transpose_item(const float* W, int K, int N, bf16_t* WT, int code, LAS unsigned char* scr, int item, int lane) {
  const int nblk = N / 64, kb = item / nblk, nb = item % nblk, k0 = 64 * kb, n0 = 64 * nb;
  const int q = lane >> 4, a = lane & 15;
  f32x4 v[16];
  const float* src = W + (size_t)(k0 + 2 * q) * N + n0 + 4 * a;
#pragma unroll
  for (int i = 0; i < 16; ++i) v[i] = *(const f32x4*)(src + (size_t)((i & 1) + 8 * (i >> 1)) * N);
#pragma unroll
  for (int ii = 0; ii < 8; ++ii) { const int dsw = q + 4 * (ii ^ (a & 7));
#pragma unroll
    for (int j = 0; j < 4; ++j) *(LAS unsigned*)(scr + (4 * a + j) * 128 + 4 * dsw) = cvt_pk_bf16(v[2 * ii][j], v[2 * ii + 1][j]); }
  asm volatile("s_waitcnt lgkmcnt(0)" ::: "memory");
  const int c = lane & 7;
#pragma unroll
  for (int jj = 0; jj < 8; ++jj) { const int n = (lane >> 3) + 8 * jj, cs = c ^ ((n >> 2) & 7);
    const u32x4 o = *(const LAS u32x4*)(scr + n * 128 + 16 * cs);
    *(u32x4*)(WT + (size_t)rowmap(code, n0 + n) * K + k0 + 8 * c) = o; }
  asm volatile("s_waitcnt lgkmcnt(0)" ::: "memory");
}
__device__ __forceinline__ void transpose_item8(const float* W, int K, int N, unsigned char* WT, int code, float scale, LAS unsigned char* scr, int item, int lane) {
  const int nblk = N / 64, kb = item / nblk, nb = item % nblk, k0 = 64 * kb, n0 = 64 * nb;
  const int q = lane >> 4, a = lane & 15;
  f32x4 v[16];
  const float* src = W + (size_t)(k0 + 4 * q) * N + n0 + 4 * a;
#pragma unroll
  for (int i = 0; i < 16; ++i) v[i] = *(const f32x4*)(src + (size_t)((i & 3) + 16 * (i >> 2)) * N);
#pragma unroll
  for (int ib = 0; ib < 4; ++ib) { const int dsw = q + 4 * (ib ^ (a & 3));
#pragma unroll
    for (int j = 0; j < 4; ++j) { int w = 0; w = __builtin_amdgcn_cvt_pk_fp8_f32(v[4 * ib][j] * scale, v[4 * ib + 1][j] * scale, w, false); w = __builtin_amdgcn_cvt_pk_fp8_f32(v[4 * ib + 2][j] * scale, v[4 * ib + 3][j] * scale, w, true);
      *(LAS int*)(scr + (4 * a + j) * 64 + 4 * dsw) = w; } }
  asm volatile("s_waitcnt lgkmcnt(0)" ::: "memory");
  const int c = lane & 3;
#pragma unroll
  for (int jj = 0; jj < 4; ++jj) { const int n = (lane >> 2) + 16 * jj, cs = c ^ ((n >> 2) & 3);
    const u32x4 o = *(const LAS u32x4*)(scr + n * 64 + 16 * cs);
    *(u32x4*)(WT + (size_t)rowmap(code, n0 + n) * K + k0 + 16 * c) = o; }
  asm volatile("s_waitcnt lgkmcnt(0)" ::: "memory");
}
constexpr int IT_WIN = 512, IT_GLU = 64, IT_MIX = 256, IT_FOUR = 256, IT_ROUT = 32, IT_SMALL = IT_WIN + IT_GLU + IT_MIX + IT_FOUR + IT_ROUT, IT_EXP = 192;
__device__ __forceinline__ void small_item(const Ctx& X, LAS unsigned char* scr, int it) {
  const Args& a = *X.a; unsigned char* ws = X.ws;
  if (it < IT_WIN) { transpose_item(a.in[IN_WIN], 1024, 2048, (bf16_t*)(ws + WS_WIN_T), 1, scr, it, X.lane); return; } it -= IT_WIN;
  if (it < IT_GLU) { transpose_item(a.in[IN_WGLU], 512, 512, (bf16_t*)(ws + WS_WGLU_T), 0, scr, it, X.lane); return; } it -= IT_GLU;
  if (it < IT_MIX) { transpose_item(a.in[IN_WMIX], 1024, 1024, (bf16_t*)(ws + WS_WMIX_T), 0, scr, it, X.lane); return; } it -= IT_MIX;
  if (it < IT_FOUR) { transpose_item(a.in[IN_WFOUR], 1024, 1024, (bf16_t*)(ws + WS_WFOUR_T), 0, scr, it, X.lane); return; } it -= IT_FOUR;
  { const int l = it >> 4; transpose_item(a.in[IN_WROUT] + (size_t)l * 1024 * 64, 1024, 64, (bf16_t*)(ws + WS_WROUT_T) + (size_t)l * 64 * 1024, 0, scr, it & 15, X.lane); }
}
__device__ __forceinline__ void expert_item(const Ctx& X, LAS unsigned char* scr, int layer, int it) {
  const Args& a = *X.a; const int e = it / IT_EXP, r = it % IT_EXP;
  bf16_t* gu = (bf16_t*)(X.ws + WS_WEXP + (size_t)e * EXP_STRIDE); bf16_t* dt = (bf16_t*)(X.ws + WS_WEXP + (size_t)e * EXP_STRIDE + EXP_DOFF);
  const float *wg, *wu, *wd;
  if (e < 64) { const size_t o = ((size_t)layer * 64 + e) * 262144; wg = a.in[IN_WEG] + o; wu = a.in[IN_WEU] + o; wd = a.in[IN_WED] + o; }
  else { const size_t o = (size_t)layer * 262144; wg = a.in[IN_WSG] + o; wu = a.in[IN_WSU] + o; wd = a.in[IN_WSD] + o; }
  if (r < 64) transpose_item8(wg, 1024, 256, (unsigned char*)gu, 2, 32.f, scr, r, X.lane);
  else if (r < 128) transpose_item8(wu, 1024, 256, (unsigned char*)gu, 3, 32.f, scr, r - 64, X.lane);
  else transpose_item(wd, 256, 1024, dt, 0, scr, r - 128, X.lane);
}
__device__ __forceinline__ void transpose_work(const Ctx& X, unsigned* ctr, int first_small, int n_small, int layer, int n_exp_items) {
  LAS unsigned char* scr = X.lds + X.wave * 8192;
  volatile LAS int* shb = (volatile LAS int*)(X.lds + LDS_MISC_OFF + 1024);
  const int total = n_small + n_exp_items;
  for (;;) {
    __syncthreads();
    if (X.tid == 0) shb[0] = (int)atomicAdd(ctr, 32u);
    __syncthreads();
    const int base = shb[0];
    if (base >= total) break;
    for (int k = 0; k < 4; ++k) { const int it = base + X.wave * 4 + k; if (it >= total) break;
      if (it < n_small) small_item(X, scr, first_small + it); else expert_item(X, scr, layer, it - n_small); }
  }
}

__device__ __forceinline__ void p0_adaln(const Ctx& X, int it) {
  const Args& a = *X.a; const int layer = it / 48, ct = it % 48, col = ct * 128 + X.lane;
  LAS float* sl = (LAS float*)X.lds;
  for (int i = X.tid; i < 2048; i += NTHR) { const float v = i < 1024 ? a.in[IN_C][i] : a.in[IN_CCTX][i - 1024]; sl[i] = v / (1.f + __expf(-v)); }
  __syncthreads();
  const float* W = a.in[IN_WADA] + (size_t)layer * 1024 * 6144 + col;
  float a0 = 0.f, a1 = 0.f, b0 = 0.f, b1 = 0.f; const int k0 = X.wave * 128;
#pragma unroll 16
  for (int k = 0; k < 128; ++k) { const float w0 = W[(size_t)(k0 + k) * 6144], w1 = W[(size_t)(k0 + k) * 6144 + 64]; const float s0 = sl[k0 + k], s1 = sl[1024 + k0 + k];
    a0 += s0 * w0; a1 += s1 * w0; b0 += s0 * w1; b1 += s1 * w1; }
  LAS float* red = sl + 2048;
  red[(X.wave * 128 + X.lane) * 2] = a0; red[(X.wave * 128 + X.lane) * 2 + 1] = a1; red[(X.wave * 128 + 64 + X.lane) * 2] = b0; red[(X.wave * 128 + 64 + X.lane) * 2 + 1] = b1;
  __syncthreads();
  if (X.tid < 256) { const int l = X.tid & 127, v = X.tid >> 7; float s = 0.f;
#pragma unroll
    for (int w = 0; w < 8; ++w) s += red[(w * 128 + l) * 2 + v];
    s += a.in[IN_BADA][layer * 6144 + ct * 128 + l];
    float* mod = (float*)(X.ws + WS_MOD);
    if (layer == 0) mod[v * 6144 + ct * 128 + l] = s; else if (v == 0) mod[2 * 6144 + ct * 128 + l] = s; }
  __syncthreads();
}

__device__ __forceinline__ void p0_s5tables(const Ctx& X, int g, int part) {
  const Args& a = *X.a;
  LAS f32x2* POW = (LAS f32x2*)X.lds;
  LAS f32x2* BB = (LAS f32x2*)(X.lds + 33792);
  LAS f32x2* CC = (LAS f32x2*)(X.lds + 33792 + 16384);
  LAS float* KK = (LAS float*)(X.lds + 33792 + 32768);
  LAS float* DD = (LAS float*)(X.lds + 33792 + 32768 + 65536);
  const int tid = X.tid;
  if (tid < 128) {
    const int dir = tid >> 6, p = tid & 63, idx = (dir * 32 + g) * 64 + p;
    const float lr = fminf(a.in[IN_LRE][idx], -1e-4f), li = a.in[IN_LIM][idx], dt = expf(a.in[IN_LDT][dir * 32 + g]);
    for (int tau = 0; tau <= 32; ++tau) { const float mg = expf(lr * dt * (float)tau); float sn, cs; sincospif(li * dt * (float)tau * 0.318309886183790672f, &sn, &cs); POW[(dir * 33 + tau) * 64 + p] = (f32x2){mg * cs, mg * sn}; }
    const f32x2 l1 = POW[(dir * 33 + 1) * 64 + p], l32 = POW[(dir * 33 + 32) * 64 + p];
    if (part == 0) ((float2*)(X.ws + WS_LAML))[idx] = make_float2(l32.x, l32.y);
    const float nr = l1.x - 1.f, ni = l1.y, den = lr * lr + li * li, cr = (nr * lr + ni * li) / den, ci = (ni * lr - nr * li) / den;
    for (int c = 0; c < 16; ++c) { const float xr = a.in[IN_BRE][idx * 16 + c], xi = a.in[IN_BIM][idx * 16 + c]; BB[(dir * 64 + p) * 16 + c] = (f32x2){cr * xr - ci * xi, cr * xi + ci * xr}; }
  }
  for (int i = tid; i < 2048; i += NTHR) { const int dir = i >> 10, c = (i >> 6) & 15, p = i & 63; const int gi = ((dir * 32 + g) * 16 + c) * 64 + p; CC[i] = (f32x2){a.in[IN_CRE][gi], a.in[IN_CIM][gi]}; }
  if (tid < 16) DD[tid] = a.in[IN_S5D][g * 16 + tid];
  __syncthreads();
  for (int combo = tid; combo < 1024; combo += NTHR) {
    const int dir = combo >> 9, tau = (combo >> 4) & 31, c = combo & 15;
    float accv[16];
#pragma unroll
    for (int j = 0; j < 16; ++j) accv[j] = 0.f;
#pragma unroll 2
    for (int p = 0; p < 64; ++p) {
      const f32x2 cc = CC[(dir * 16 + c) * 64 + p], pw = POW[(dir * 33 + tau) * 64 + p];
      const float zr = cc.x * pw.x - cc.y * pw.y, zi = cc.x * pw.y + cc.y * pw.x;
      const LAS f32x4* bp = (const LAS f32x4*)(BB + (dir * 64 + p) * 16);
#pragma unroll
      for (int j = 0; j < 8; ++j) { const f32x4 b = bp[j]; accv[2 * j] += zr * b.x - zi * b.y; accv[2 * j + 1] += zr * b.z - zi * b.w; }
    }
#pragma unroll
    for (int j = 0; j < 4; ++j) *(LAS f32x4*)(KK + ((dir * 32 + tau) * 16 + c) * 16 + 4 * j) = (f32x4){accv[4 * j], accv[4 * j + 1], accv[4 * j + 2], accv[4 * j + 3]};
  }
  __syncthreads();
  bf16_t* TT = (bf16_t*)(X.ws + WS_TT) + (size_t)g * 512 * 768;
  for (int q = part * 12288 + tid; q < (part + 1) * 12288; q += NTHR) {
    const int row = q / 96, cc8 = q % 96, i = row >> 4, c = row & 15; f32x4 v0, v1;
    if (cc8 < 64) {
      const int s = cc8 >> 1, c0 = (cc8 & 1) * 8;
      const int dir = s < i ? 0 : 1, tau = s < i ? i - s : s - i;
      const LAS f32x4* kp = (const LAS f32x4*)(KK + ((dir * 32 + tau) * 16 + c) * 16 + c0);
      v0 = kp[0]; v1 = kp[1];
      if (s == i) { const LAS f32x4* k0p = (const LAS f32x4*)(KK + ((0 * 32 + 0) * 16 + c) * 16 + c0); v0 += k0p[0]; v1 += k0p[1];
        const float d = DD[c]; const int dj = c - c0;
        if (dj >= 0 && dj < 4) v0[dj] += d; else if (dj >= 4 && dj < 8) v1[dj - 4] += d; }
    } else {
      const int kk = (cc8 - 64) * 8, dir = kk >> 7, ri = (kk >> 6) & 1, p0 = kk & 63, tau = dir == 0 ? i + 1 : 32 - i;
      const LAS f32x4* cp = (const LAS f32x4*)(CC + (dir * 16 + c) * 64 + p0); const LAS f32x4* pp = (const LAS f32x4*)(POW + (dir * 33 + tau) * 64 + p0);
      float v[8];
#pragma unroll
      for (int j = 0; j < 4; ++j) { const f32x4 cc = cp[j], pw = pp[j];
        v[2 * j] = ri == 0 ? (cc.x * pw.x - cc.y * pw.y) : -(cc.x * pw.y + cc.y * pw.x); v[2 * j + 1] = ri == 0 ? (cc.z * pw.z - cc.w * pw.w) : -(cc.z * pw.w + cc.w * pw.z); }
      v0 = (f32x4){v[0], v[1], v[2], v[3]}; v1 = (f32x4){v[4], v[5], v[6], v[7]};
    }
    *(u32x4*)(TT + (size_t)row * 768 + cc8 * 8) = pack8(v0, v1);
  }
  bf16_t* WSm = (bf16_t*)(X.ws + WS_WS) + (size_t)g * 256 * 512;
  for (int q = part * 4096 + tid; q < (part + 1) * 4096; q += NTHR) {
    const int n = q >> 6, cc8 = q & 63, dir = n >> 7, ri = (n >> 6) & 1, p = n & 63, s = cc8 >> 1, c0 = (cc8 & 1) * 8, tau = dir == 0 ? 31 - s : s;
    const f32x2 pw = POW[(dir * 33 + tau) * 64 + p]; const LAS f32x4* bp = (const LAS f32x4*)(BB + (dir * 64 + p) * 16 + c0); float v[8];
#pragma unroll
    for (int j = 0; j < 4; ++j) { const f32x4 b = bp[j]; v[2 * j] = ri == 0 ? (pw.x * b.x - pw.y * b.y) : (pw.x * b.y + pw.y * b.x); v[2 * j + 1] = ri == 0 ? (pw.x * b.z - pw.y * b.w) : (pw.x * b.w + pw.y * b.z); }
    *(u32x4*)(WSm + (size_t)n * 512 + cc8 * 8) = pack8((f32x4){v[0], v[1], v[2], v[3]}, (f32x4){v[4], v[5], v[6], v[7]});
  }
  __syncthreads();
}

__device__ __forceinline__ void p0_dftconst(const Ctx& X, int idx) {
  for (int q = idx * NTHR + X.tid; q < 32768; q += 32 * NTHR) {
    float v[8]; bf16_t* dst;
    if (q < 16384) {
      const int R = q >> 5, c0 = (q & 31) * 8, ri = R >> 8, m = R & 255; dst = (bf16_t*)(X.ws + WS_DMT) + (size_t)R * 256 + c0;
#pragma unroll
      for (int j = 0; j < 8; ++j) { float s, c; sincospif((float)(((c0 + j) * m) & 255) * (1.f / 128.f), &s, &c); v[j] = ri == 0 ? c : -s; }
    } else if (q < 24576) {
      const int q2 = q - 16384, R = q2 >> 5, c0 = (q2 & 31) * 8, rip = R >> 7, ka = R & 127; dst = (bf16_t*)(X.ws + WS_W1) + (size_t)R * 256 + c0;
#pragma unroll
      for (int j = 0; j < 8; ++j) { const int C = c0 + j, ri = C >> 7, ta = C & 127; float s, c; sincospif((float)((ka * ta) & 127) * (1.f / 64.f), &s, &c);
        v[j] = (rip == ri) ? c : (rip == 0 ? s : -s); }
    } else {
      const int q2 = q - 24576, R = q2 >> 5, c0 = (q2 & 31) * 8; dst = (bf16_t*)(X.ws + WS_W2) + (size_t)R * 256 + c0;
#pragma unroll
      for (int j = 0; j < 8; ++j) { const int C = c0 + j, rip = C >> 7, tb = C & 127; float s, c; sincospif((float)((R * tb) & 127) * (1.f / 64.f), &s, &c);
        v[j] = R < 128 ? (rip == 0 ? c : s) * (1.f / 2048.f) : 0.f; }
    }
    u32x4 o; o.x = cvt_pk_bf16(v[0], v[1]); o.y = cvt_pk_bf16(v[2], v[3]); o.z = cvt_pk_bf16(v[4], v[5]); o.w = cvt_pk_bf16(v[6], v[7]);
    *(u32x4*)dst = o;
  }
}

__device__ __forceinline__ void phase_prep(const Ctx& X, int rep) {
  const int c = X.c;
  if (c < 96) p0_adaln(X, c);
  else if (c < 224) p0_s5tables(X, (c - 96) >> 2, (c - 96) & 3);
  else p0_dftconst(X, c - 224);
  __syncthreads();
  unsigned* ctl = (unsigned*)(X.ws + WS_CTL);
  transpose_work(X, ctl + CW_DQ0 + 128 * rep, 0, IT_SMALL, (X.a->flags & 2) ? 1 : 0, (X.a->flags & FLAG_SKIP_EXPERTS) ? 0 : 65 * IT_EXP);
}

__device__ __forceinline__ void modulate_row(const float* hrow, const float* shift, const float* scale, bf16_t* orow, int lane) {
  const f32x4* xr = (const f32x4*)hrow + lane; f32x4 v[4]; float ss = 0.f;
#pragma unroll
  for (int j = 0; j < 4; ++j) { v[j] = xr[64 * j]; ss += (v[j].x * v[j].x + v[j].y * v[j].y) + (v[j].z * v[j].z + v[j].w * v[j].w); }
  const float r = rsqrtf(wave_sum(ss) * (1.f / 1024.f) + 1e-6f);
  u32x2* o8 = (u32x2*)orow + lane;
#pragma unroll
  for (int j = 0; j < 4; ++j) { const f32x4 sh = ((const f32x4*)shift)[lane + 64 * j], sc = ((const f32x4*)scale)[lane + 64 * j];
    u32x2 w; w.x = cvt_pk_bf16(v[j].x * r * (1.f + sc.x) + sh.x, v[j].y * r * (1.f + sc.y) + sh.y); w.y = cvt_pk_bf16(v[j].z * r * (1.f + sc.z) + sh.z, v[j].w * r * (1.f + sc.w) + sh.w);
    o8[64 * j] = w; }
}
__device__ __forceinline__ void phase_mod0(const Ctx& X) {
  const Args& a = *X.a; const float* mod = (const float*)(X.ws + WS_MOD); bf16_t* A0 = (bf16_t*)(X.ws + WS_A0);
  const int gw = X.c * NWAVES + X.wave, NGW = X.G * NWAVES;
  for (int r = gw; r < NROW; r += NGW) {
    if (r < TOK) modulate_row(a.in[IN_X] + (size_t)r * 1024, mod, mod + 1024, A0 + (size_t)r * 1024, X.lane);
    else modulate_row(a.in[IN_CTX] + (size_t)(r - TOK) * 1024, mod + 6144, mod + 6144 + 1024, A0 + (size_t)r * 1024, X.lane);
  }
}


struct G1 {
  static constexpr bool PERM = true; static constexpr bool F8 = false; static constexpr int SCALE_B = 0x7A7A7A7A; static constexpr bool CONTIG = false; static constexpr bool ALIGN = true; static constexpr bool LINA = true, LINB = true; __device__ __forceinline__ size_t halfA() const { return 128u * 2048u; } __device__ __forceinline__ size_t halfB() const { return 128u * 2048u; } int K, nunits; unsigned char* ws; const float* qg; const float* kg;
  __device__ __forceinline__ void decode(int w, Unit& u) const { if (w < 390) { u.a = 0; u.pm = w / 6; u.pn = w % 6; } else { const int w2 = w - 390; u.a = 1; u.pm = w2 & 1; u.pn = w2 >> 1; } u.b = 0; }
  __device__ __forceinline__ const char* baseA(const Unit& u) const { return (const char*)ws + (u.a == 0 ? WS_A0 : WS_WIN_T + (size_t)1536 * 2048); }
  __device__ __forceinline__ const char* baseB(const Unit& u) const { return (const char*)ws + (u.a == 0 ? WS_WIN_T : WS_A0); }
  __device__ __forceinline__ unsigned rowA(const Unit& u, int r) const { return (unsigned)(u.pm * 256 + r) * 2048u; }
  __device__ __forceinline__ unsigned rowB(const Unit& u, int r) const { return (unsigned)(u.pn * 256 + r) * 2048u; }
  __device__ __forceinline__ void epi(const Acc& acc, const Unit& u, int wr, int wc, int fr, int fq) const {
    if (u.a == 1) {
      bf16_t* VT = (bf16_t*)(ws + WS_VT);
#pragma unroll
      for (int ai = 0; ai < 2; ++ai)
#pragma unroll
        for (int m = 0; m < 4; ++m) { const int d = u.pm * 256 + ai * 128 + wr * 64 + m * 16 + fr;
#pragma unroll
          for (int bj = 0; bj < 2; ++bj) { const int t0 = u.pn * 256 + bj * 128 + wc * 32 + 8 * fq; *(u32x4*)(VT + (size_t)d * NROW + t0) = pack8(acc[ai][bj][m][0], acc[ai][bj][m][1]); } }
      return;
    }
    if (u.pn < 2) {
      bf16_t* AS5 = (bf16_t*)(ws + WS_AS5);
#pragma unroll
      for (int ai = 0; ai < 2; ++ai)
#pragma unroll
        for (int m = 0; m < 4; ++m) { const int row = u.pm * 256 + ai * 128 + wr * 64 + m * 16 + fr; int crow, s;
          if (row < TOK) { crow = row >> 5; s = row & 31; } else { const int j = row - TOK; crow = 512 + (j >> 5); s = j & 31; }
#pragma unroll
          for (int bj = 0; bj < 2; ++bj) { const int g = 16 * u.pn + 8 * bj + 2 * wc + (fq >> 1), c0 = 8 * (fq & 1);
            *(u32x4*)(AS5 + ((size_t)(g * 768 + crow) * 768 + s * 16 + c0)) = pack8(acc[ai][bj][m][0], acc[ai][bj][m][1]); } }
      return;
    }
    const bool isq = u.pn < 4;
    if (isq && u.pm == 64) return;
    const int head = 4 * ((u.pn - 2) & 1) + wc; const float* gain = isq ? qg : kg;
    bf16_t* dst = isq ? (bf16_t*)(ws + WS_Q) : (bf16_t*)(ws + WS_K);
    f32x4 gv[2][2];
#pragma unroll
    for (int bj = 0; bj < 2; ++bj) { gv[bj][0] = *(const f32x4*)(gain + 32 * bj + 8 * fq); gv[bj][1] = *(const f32x4*)(gain + 32 * bj + 8 * fq + 4); }
#pragma unroll
    for (int ai = 0; ai < 2; ++ai)
#pragma unroll
      for (int m = 0; m < 4; ++m) { const int row = u.pm * 256 + ai * 128 + wr * 64 + m * 16 + fr; float ss = 0.f;
#pragma unroll
        for (int bj = 0; bj < 2; ++bj)
#pragma unroll
          for (int n = 0; n < 2; ++n) { const f32x4 x = acc[ai][bj][m][n]; ss += (x[0] * x[0] + x[1] * x[1]) + (x[2] * x[2] + x[3] * x[3]); }
        ss += sx(ss, 16); ss += sx(ss, 32);
        const float rinv = rsqrtf(ss * (1.f / 64.f) + 1e-6f);
#pragma unroll
        for (int bj = 0; bj < 2; ++bj) { const f32x4 v0 = acc[ai][bj][m][0] * rinv * gv[bj][0], v1 = acc[ai][bj][m][1] * rinv * gv[bj][1];
          *(u32x4*)(dst + (size_t)row * 512 + head * 64 + 32 * bj + 8 * fq) = pack8(v0, v1); } }
  }
};

struct G2 {
  static constexpr bool PERM = true; static constexpr bool F8 = false; static constexpr int SCALE_B = 0x7A7A7A7A; static constexpr bool CONTIG = false; static constexpr bool ALIGN = true; static constexpr bool LINA = true, LINB = true; __device__ __forceinline__ size_t halfA() const { return 128u * 1536u; } __device__ __forceinline__ size_t halfB() const { return 128u * 1024u; } int K, nunits; unsigned char* ws;
  __device__ __forceinline__ void decode(int w, Unit& u) const { u.a = w / 3; u.pm = w % 3; u.pn = 0; u.b = 0; }
  __device__ __forceinline__ const char* baseA(const Unit& u) const { return (const char*)ws + WS_AS5 + (size_t)u.a * 768 * 768 * 2; }
  __device__ __forceinline__ const char* baseB(const Unit& u) const { return (const char*)ws + WS_WS + (size_t)u.a * 256 * 512 * 2; }
  __device__ __forceinline__ unsigned rowA(const Unit& u, int r) const { return (unsigned)(u.pm * 256 + r) * 1536u; }
  __device__ __forceinline__ unsigned rowB(const Unit& u, int r) const { return (unsigned)r * 1024u; }
  __device__ __forceinline__ void epi(const Acc& acc, const Unit& u, int wr, int wc, int fr, int fq) const {
    float* SST = (float*)(ws + WS_SST) + (size_t)u.a * 768 * 256;
#pragma unroll
    for (int ai = 0; ai < 2; ++ai)
#pragma unroll
      for (int m = 0; m < 4; ++m) { const int crow = u.pm * 256 + ai * 128 + wr * 64 + m * 16 + fr; if (crow >= 520) continue;
#pragma unroll
        for (int bj = 0; bj < 2; ++bj) { float* p = SST + (size_t)crow * 256 + bj * 128 + wc * 32 + 8 * fq; *(f32x4*)p = acc[ai][bj][m][0]; *(f32x4*)(p + 4) = acc[ai][bj][m][1]; } }
  }
};

struct G3 {
  static constexpr bool PERM = true; static constexpr bool F8 = false; static constexpr int SCALE_B = 0x7A7A7A7A; static constexpr bool CONTIG = false; static constexpr bool ALIGN = true; static constexpr bool LINA = true, LINB = true; __device__ __forceinline__ size_t halfA() const { return 128u * 1536u; } __device__ __forceinline__ size_t halfB() const { return 128u * 1536u; } int K, nunits; unsigned char* ws;
  __device__ __forceinline__ void decode(int w, Unit& u) const { u.a = w >> 2; u.pm = (w >> 1) & 1; u.pn = w & 1; u.b = 0; }
  __device__ __forceinline__ const char* baseA(const Unit& u) const { return (const char*)ws + WS_AS5 + (size_t)u.a * 768 * 768 * 2; }
  __device__ __forceinline__ const char* baseB(const Unit& u) const { return (const char*)ws + WS_TT + (size_t)u.a * 512 * 768 * 2; }
  __device__ __forceinline__ unsigned rowA(const Unit& u, int r) const { return (unsigned)(u.pm * 256 + r) * 1536u; }
  __device__ __forceinline__ unsigned rowB(const Unit& u, int r) const { return (unsigned)(u.pn * 256 + r) * 1536u; }
  __device__ __forceinline__ void epi(const Acc& acc, const Unit& u, int wr, int wc, int fr, int fq) const {
    bf16_t* GB = (bf16_t*)(ws + WS_GB);
#pragma unroll
    for (int ai = 0; ai < 2; ++ai)
#pragma unroll
      for (int m = 0; m < 4; ++m) { const int crow = u.pm * 256 + ai * 128 + wr * 64 + m * 16 + fr;
#pragma unroll
        for (int bj = 0; bj < 2; ++bj) { const int pp = u.pn * 256 + bj * 128 + wc * 32 + 8 * fq, i = pp >> 4, c0 = pp & 15; f32x4 v0 = acc[ai][bj][m][0], v1 = acc[ai][bj][m][1];
#pragma unroll
          for (int j = 0; j < 4; ++j) { v0[j] = gelu_tanh(v0[j]); v1[j] = gelu_tanh(v1[j]); }
          *(u32x4*)(GB + (size_t)(crow * 32 + i) * 512 + u.a * 16 + c0) = pack8(v0, v1); } }
  }
};

struct G4 {
  static constexpr bool PERM = true; static constexpr bool F8 = false; static constexpr int SCALE_B = 0x7A7A7A7A; static constexpr bool CONTIG = false; static constexpr bool ALIGN = true; static constexpr bool LINA = true, LINB = true; __device__ __forceinline__ size_t halfA() const { return 128u * 1024u; } __device__ __forceinline__ size_t halfB() const { return 128u * 1024u; } int K, nunits; unsigned char* ws; const float* bglu;
  __device__ __forceinline__ void decode(int w, Unit& u) const { u.pm = w >> 1; u.pn = w & 1; u.a = 0; u.b = 0; }
  __device__ __forceinline__ const char* baseA(const Unit&) const { return (const char*)ws + WS_GB; }
  __device__ __forceinline__ const char* baseB(const Unit&) const { return (const char*)ws + WS_WGLU_T; }
  __device__ __forceinline__ unsigned rowA(const Unit& u, int r) const { return (unsigned)(u.pm * 256 + r) * 1024u; }
  __device__ __forceinline__ unsigned rowB(const Unit& u, int r) const { return (unsigned)(u.pn * 256 + r) * 1024u; }
  __device__ __forceinline__ void epi(const Acc& acc, const Unit& u, int wr, int wc, int fr, int fq) const {
    const bf16_t* GB = (const bf16_t*)(ws + WS_GB); bf16_t* CC = (bf16_t*)(ws + WS_CONCAT);
#pragma unroll
    for (int bj = 0; bj < 2; ++bj) { const int col0 = u.pn * 256 + bj * 128 + wc * 32 + 8 * fq; const f32x4 b0 = *(const f32x4*)(bglu + col0), b1 = *(const f32x4*)(bglu + col0 + 4);
#pragma unroll
      for (int ai = 0; ai < 2; ++ai)
#pragma unroll
        for (int m = 0; m < 4; ++m) { const int row = u.pm * 256 + ai * 128 + wr * 64 + m * 16 + fr; const u32x4 gw = *(const u32x4*)(GB + (size_t)row * 512 + col0);
          f32x4 v0 = acc[ai][bj][m][0] + b0, v1 = acc[ai][bj][m][1] + b1;
          v0[0] = bf_lo(gw.x) * fast_sigmoid(v0[0]); v0[1] = bf_hi(gw.x) * fast_sigmoid(v0[1]); v0[2] = bf_lo(gw.y) * fast_sigmoid(v0[2]); v0[3] = bf_hi(gw.y) * fast_sigmoid(v0[3]);
          v1[0] = bf_lo(gw.z) * fast_sigmoid(v1[0]); v1[1] = bf_hi(gw.z) * fast_sigmoid(v1[1]); v1[2] = bf_lo(gw.w) * fast_sigmoid(v1[2]); v1[3] = bf_hi(gw.w) * fast_sigmoid(v1[3]);
          *(u32x4*)(CC + (size_t)row * 1024 + col0) = pack8(v0, v1); } }
  }
};

struct GRes {
  static constexpr bool PERM = false; static constexpr bool F8 = false; static constexpr int SCALE_B = 0x7A7A7A7A; static constexpr bool CONTIG = false; static constexpr bool ALIGN = true; static constexpr bool LINA = true, LINB = true; __device__ __forceinline__ size_t halfA() const { return 128u * 2048u; } __device__ __forceinline__ size_t halfB() const { return 128u * 2048u; } int K, nunits; const char* A; const char* Bt; const float* hin; float* hout; const float* gate; const float* bias;
  __device__ __forceinline__ void decode(int w, Unit& u) const { u.pm = w >> 2; u.pn = w & 3; u.a = 0; u.b = 0; }
  __device__ __forceinline__ const char* baseA(const Unit&) const { return A; }
  __device__ __forceinline__ const char* baseB(const Unit&) const { return Bt; }
  __device__ __forceinline__ unsigned rowA(const Unit& u, int r) const { return (unsigned)(u.pm * 256 + r) * 2048u; }
  __device__ __forceinline__ unsigned rowB(const Unit& u, int r) const { return (unsigned)(u.pn * 256 + r) * 2048u; }
  __device__ __forceinline__ void epi(const Acc& acc, const Unit& u, int wr, int wc, int fr, int fq) const {
#pragma unroll
    for (int bj = 0; bj < 2; ++bj)
#pragma unroll
      for (int n = 0; n < 2; ++n) { const int col0 = u.pn * 256 + bj * 128 + wc * 32 + 16 * n + 4 * fq; const f32x4 gt = *(const f32x4*)(gate + col0);
        f32x4 bs = (f32x4){0.f, 0.f, 0.f, 0.f}; if (bias) bs = *(const f32x4*)(bias + col0);
#pragma unroll
        for (int ai = 0; ai < 2; ++ai)
#pragma unroll
          for (int m = 0; m < 4; ++m) { const size_t off = (size_t)(u.pm * 256 + ai * 128 + wr * 64 + m * 16 + fr) * 1024 + col0;
            const f32x4 hv = *(const f32x4*)(hin + off); *(f32x4*)(hout + off) = hv + gt * (acc[ai][bj][m][n] + bs); } }
  }
};

__device__ __forceinline__ void build_moetab(const Ctx& X, int layer, LAS int* toff) {
  const unsigned* cnt = (const unsigned*)(X.ws + WS_CTL) + CW_CNT + layer * 128;
  LAS int* texp = toff + 256;
  LAS int* ntile = toff + 132;
  __syncthreads();
  if (X.tid < 128) ntile[X.tid] = ((int)__hip_atomic_load(cnt + X.tid, __ATOMIC_RELAXED, __HIP_MEMORY_SCOPE_AGENT) + 255) >> 8;
  __syncthreads();
  if (X.tid < 2) { const int half = X.tid; int s = 0; for (int e = 0; e < 64; ++e) { toff[half * 66 + e] = s; s += ntile[half * 64 + e]; } toff[half * 66 + 64] = s; toff[half * 66 + 65] = s + 32; }
  __syncthreads();
  if (X.tid < 130) { const int half = X.tid / 65, e = X.tid % 65; const int lo = toff[half * 66 + e], hi = toff[half * 66 + e + 1]; for (int t = lo; t < hi && t < 352; ++t) texp[half * 352 + t] = e; }
  __syncthreads();
}
__device__ __forceinline__ int find_expert(const LAS int* toff, int half, int ti) { return toff[256 + half * 352 + ti]; }

struct G6 {
  static constexpr bool PERM = true; static constexpr bool F8 = true; static constexpr int SCALE_B = 0x7A7A7A7A; static constexpr bool CONTIG = false; static constexpr bool ALIGN = true; static constexpr bool LINA = false, LINB = true; __device__ __forceinline__ size_t halfA() const { return 0; } __device__ __forceinline__ size_t halfB() const { return 128u * 1024u; }
  int K, nunits; unsigned char* ws; const LAS int* toff; const LAS unsigned* tokt; const LAS int* tord;
  __device__ __forceinline__ void decode(int w, Unit& u) const { const int rec = tord[w >> 1]; const int e = rec & 255, half = (rec >> 8) & 1, pm = rec >> 16; u.pn = w & 1;
    u.a = e | (half << 8); u.pm = pm; u.b = half * toff[65] + toff[66 * half + e] + pm; }
  __device__ __forceinline__ const char* baseA(const Unit&) const { return (const char*)ws + WS_F; }
  __device__ __forceinline__ const char* baseB(const Unit& u) const { return (const char*)ws + WS_WEXP + (size_t)(u.a & 255) * EXP_STRIDE; }
  __device__ __forceinline__ unsigned rowA(const Unit& u, int r) const { return tokt[u.ord * 256 + r]; }
  __device__ __forceinline__ void build_tord(const Ctx& X, LAS int* td) const {
    if (X.tid < 65) { const int e = X.tid; int base = 0; for (int e2 = 0; e2 < e; ++e2) base += (toff[e2 + 1] - toff[e2]) + (toff[66 + e2 + 1] - toff[66 + e2]);
      const int n0 = toff[e + 1] - toff[e], n1 = toff[66 + e + 1] - toff[66 + e];
      for (int i = 0; i < n0; ++i) td[base + i] = e | (i << 16);
      for (int i = 0; i < n1; ++i) td[base + n0 + i] = e | (1 << 8) | (i << 16); }
    __syncthreads();
  }
  __device__ __forceinline__ void build_tokt(const Ctx& X, LAS unsigned* tk) const {
    const int vc_ = (X.c % 8) * (X.G / 8) + X.c / 8; const int u_lo = (int)(((long)vc_ * nunits) / X.G), u_hi = (int)(((long)(vc_ + 1) * nunits) / X.G);
    for (int i = 0; CONTIG ? (u_lo + i < u_hi) : (i * X.G + X.c < nunits); ++i) { Unit u; decode(CONTIG ? u_lo + i : xcd_remap(i * X.G + X.c, nunits), u);
      if (X.tid < 256) { const int idx = u.pm * 256 + X.tid, half = u.a >> 8, e = u.a & 255; int tok = half * 8192 + idx;
        if (e < 64) tok = ((const int*)(ws + WS_LTOK))[(half * 64 + e) * 8192 + idx];
        tk[i * 256 + X.tid] = (unsigned)tok * 1024u; } }
    __syncthreads();
  }
  __device__ __forceinline__ unsigned rowB(const Unit& u, int r) const { return (unsigned)(u.pn * 256 + r) * 1024u; }
  __device__ __forceinline__ void epi(const Acc& acc, const Unit& u, int wr, int wc, int fr, int fq) const {
    bf16_t* HID = (bf16_t*)(ws + WS_HID);
#pragma unroll
    for (int ai = 0; ai < 2; ++ai)
#pragma unroll
      for (int m = 0; m < 4; ++m) { const size_t hrow = (size_t)u.b * 256 + ai * 128 + wr * 64 + m * 16 + fr; f32x4 v0, v1;
#pragma unroll
        for (int j = 0; j < 4; ++j) { const float g0 = acc[ai][0][m][0][j], g1 = acc[ai][0][m][1][j]; v0[j] = g0 * fast_sigmoid(g0) * acc[ai][1][m][0][j]; v1[j] = g1 * fast_sigmoid(g1) * acc[ai][1][m][1][j]; }
        *(u32x4*)(HID + hrow * 256 + u.pn * 128 + wc * 32 + 8 * fq) = pack8(v0, v1); }
  }
};
struct G7 {
  static constexpr bool PERM = true; static constexpr bool F8 = false; static constexpr int SCALE_B = 0x7A7A7A7A; static constexpr bool CONTIG = false; static constexpr bool ALIGN = true; static constexpr bool LINA = true, LINB = true; __device__ __forceinline__ size_t halfA() const { return 128u * 512u; } __device__ __forceinline__ size_t halfB() const { return 128u * 512u; }
  int K, nunits; unsigned char* ws; const LAS int* toff; int hidbase; int dry; int half;
  __device__ __forceinline__ void decode(int w, Unit& u) const { const int ti = w >> 2; u.pn = w & 3; u.a = find_expert(toff, half, ti); u.pm = ti - toff[66 * half + u.a]; u.b = ti; }
  __device__ __forceinline__ const char* baseA(const Unit&) const { return (const char*)ws + WS_HID + (size_t)hidbase * 256 * 512; }
  __device__ __forceinline__ const char* baseB(const Unit& u) const { return (const char*)ws + WS_WEXP + (size_t)u.a * EXP_STRIDE + EXP_DOFF; }
  __device__ __forceinline__ unsigned rowA(const Unit& u, int r) const { return (unsigned)(u.b * 256 + r) * 512u; }
  __device__ __forceinline__ unsigned rowB(const Unit& u, int r) const { return (unsigned)(u.pn * 256 + r) * 512u; }
  __device__ __forceinline__ void epi(const Acc& acc, const Unit& u, int wr, int wc, int fr, int fq) const {
    bf16_t* YAS = (bf16_t*)(ws + WS_YAS);
#pragma unroll
    for (int ai = 0; ai < 2; ++ai)
#pragma unroll
      for (int m = 0; m < 4; ++m) { const size_t yrow = (size_t)u.b * 256 + ai * 128 + wr * 64 + m * 16 + fr;
#pragma unroll
        for (int bj = 0; bj < 2; ++bj) { const u32x4 pk = pack8(acc[ai][bj][m][0], acc[ai][bj][m][1]); if (!dry || pk.x == 0x12345678u) *(u32x4*)(YAS + yrow * 1024 + u.pn * 256 + bj * 128 + wc * 32 + 8 * fq) = pk; } }
  }
};

struct G8 {
  static constexpr bool PERM = true; static constexpr bool F8 = false; static constexpr int SCALE_B = 0x7A7A7A7A; static constexpr bool CONTIG = false; static constexpr bool ALIGN = true; static constexpr bool LINA = true, LINB = false; __device__ __forceinline__ size_t halfA() const { return 128u * 512u; } __device__ __forceinline__ size_t halfB() const { return 0; } int K, nunits; unsigned char* ws;
  __device__ __forceinline__ void decode(int w, Unit& u) const { u.pm = w >> 8; u.a = (w >> 6) & 3; u.pn = w & 63; u.b = 0; }
  __device__ __forceinline__ const char* baseA(const Unit&) const { return (const char*)ws + WS_DMT; }
  __device__ __forceinline__ const char* baseB(const Unit& u) const { return (const char*)ws + WS_A1 + (size_t)u.a * 512; }
  __device__ __forceinline__ unsigned rowA(const Unit& u, int r) const { return (unsigned)(u.pm * 256 + r) * 512u; }
  __device__ __forceinline__ unsigned rowB(const Unit& u, int r) const { const int n = u.pn * 256 + r; return (unsigned)(128 * (n & 127) + (n >> 7)) * 2048u; }
  __device__ __forceinline__ void epi(const Acc& acc, const Unit& u, int wr, int wc, int fr, int fq) const {
    bf16_t* X1 = (bf16_t*)(ws + WS_X1);
#pragma unroll
    for (int ai = 0; ai < 2; ++ai)
#pragma unroll
      for (int m = 0; m < 4; ++m) { const int mm = ai * 128 + wr * 64 + m * 16 + fr;
#pragma unroll
        for (int bj = 0; bj < 2; ++bj) { const int n0 = u.pn * 256 + bj * 128 + wc * 32 + 8 * fq, tb = n0 >> 7, ta0 = n0 & 127;
          *(u32x4*)(X1 + ((((size_t)(u.a * 256 + mm) * 128 + tb) * 2 + u.pm) * 128 + ta0)) = pack8(acc[ai][bj][m][0], acc[ai][bj][m][1]); } }
  }
};
struct G9 {
  static constexpr bool PERM = true; static constexpr bool F8 = false; static constexpr int SCALE_B = 0x7A7A7A7A; static constexpr bool CONTIG = false; static constexpr bool ALIGN = true; static constexpr bool LINA = true, LINB = true; __device__ __forceinline__ size_t halfA() const { return 128u * 512u; } __device__ __forceinline__ size_t halfB() const { return 128u * 512u; } int K, nunits; unsigned char* ws;
  __device__ __forceinline__ void decode(int w, Unit& u) const { u.pm = 0; u.pn = w; u.a = 0; u.b = 0; }
  __device__ __forceinline__ const char* baseA(const Unit&) const { return (const char*)ws + WS_W1; }
  __device__ __forceinline__ const char* baseB(const Unit&) const { return (const char*)ws + WS_X1; }
  __device__ __forceinline__ unsigned rowA(const Unit&, int r) const { return (unsigned)r * 512u; }
  __device__ __forceinline__ unsigned rowB(const Unit& u, int r) const { return (unsigned)(u.pn * 256 + r) * 512u; }
  __device__ __forceinline__ void epi(const Acc& acc, const Unit& u, int wr, int wc, int fr, int fq) const {
    bf16_t* X2 = (bf16_t*)(ws + WS_X2);
#pragma unroll
    for (int m = 0; m < 4; ++m) { const int ka = wr * 64 + m * 16 + fr;
#pragma unroll
      for (int bj = 0; bj < 2; ++bj) { const int n0 = u.pn * 256 + bj * 128 + wc * 32 + 8 * fq, gm = n0 >> 7, tb0 = n0 & 127; f32x4 r0, r1, i0, i1;
#pragma unroll
        for (int j = 0; j < 4; ++j) {
          { const float ang = (float)((ka * (tb0 + j)) & 16383) * (1.f / 16384.f), cs = __builtin_amdgcn_cosf(ang), sn = __builtin_amdgcn_sinf(ang); const float yr = acc[0][bj][m][0][j], yi = acc[1][bj][m][0][j]; r0[j] = yr * cs + yi * sn; i0[j] = yi * cs - yr * sn; }
          { const float ang = (float)((ka * (tb0 + 4 + j)) & 16383) * (1.f / 16384.f), cs = __builtin_amdgcn_cosf(ang), sn = __builtin_amdgcn_sinf(ang); const float yr = acc[0][bj][m][1][j], yi = acc[1][bj][m][1][j]; r1[j] = yr * cs + yi * sn; i1[j] = yi * cs - yr * sn; } }
        bf16_t* p = X2 + (((size_t)(gm * 128 + ka) * 2) * 128 + tb0); *(u32x4*)p = pack8(r0, r1); *(u32x4*)(p + 128) = pack8(i0, i1); } }
  }
};
struct G10 {
  static constexpr bool PERM = true; static constexpr bool F8 = false; static constexpr int SCALE_B = 0x7A7A7A7A; static constexpr bool CONTIG = false; static constexpr bool ALIGN = true; static constexpr bool LINA = true, LINB = false; __device__ __forceinline__ size_t halfA() const { return 128u * 512u; } __device__ __forceinline__ size_t halfB() const { return 0; } int K, nunits; unsigned char* ws;
  __device__ __forceinline__ void decode(int w, Unit& u) const { u.pm = 0; u.pn = w; u.a = 0; u.b = 0; }
  __device__ __forceinline__ const char* baseA(const Unit&) const { return (const char*)ws + WS_W2; }
  __device__ __forceinline__ const char* baseB(const Unit&) const { return (const char*)ws + WS_X2; }
  __device__ __forceinline__ unsigned rowA(const Unit&, int r) const { return (unsigned)r * 512u; }
  __device__ __forceinline__ unsigned rowB(const Unit& u, int r) const { const int n = u.pn * 256 + r, ka = n >> 10, gm = n & 1023; return (unsigned)(gm * 128 + ka) * 512u; }
  __device__ __forceinline__ void epi(const Acc& acc, const Unit& u, int wr, int wc, int fr, int fq) const {
    bf16_t* FB = (bf16_t*)(ws + WS_FB); const int ka = u.pn >> 2;
#pragma unroll
    for (int m = 0; m < 4; ++m) { const int kb = wr * 64 + m * 16 + fr; const size_t k = (size_t)ka + 128 * kb;
#pragma unroll
      for (int bj = 0; bj < 2; ++bj) { const int d0 = (u.pn & 3) * 256 + bj * 128 + wc * 32 + 8 * fq; *(u32x4*)(FB + k * 1024 + d0) = pack8(acc[0][bj][m][0], acc[0][bj][m][1]); } }
  }
};
}
namespace mk {
typedef float f32x16 __attribute__((ext_vector_type(16)));

__device__ __forceinline__ void phase_scan(const Ctx& X) {
  if (X.c >= 64) return;
  const int ch = X.c * 64 + (X.tid & 63), seg = X.tid >> 6;
  const int g = ch >> 7, dir = (ch >> 6) & 1, p = ch & 63;
  const float2 lam = ((const float2*)(X.ws + WS_LAML))[(dir * 32 + g) * 64 + p];
  const float* S = (const float*)(X.ws + WS_SST) + (size_t)g * 768 * 256 + dir * 128 + p;
  bf16_t* XP = (bf16_t*)(X.ws + WS_AS5) + (size_t)g * 768 * 768 + 512 + dir * 128 + p;
  LAS float* EX = (LAS float*)X.lds;
  const int j0 = seg * 65;
  float xr = 0.f, xi = 0.f;
  for (int b = 0; b < 65; b += 13) {
    float sr[13], si[13];
#pragma unroll
    for (int k = 0; k < 13; ++k) { const int j = j0 + b + k; const int row = dir == 0 ? (j < 8 ? 512 + j : j - 8) : 519 - j; sr[k] = S[(size_t)row * 256]; si[k] = S[(size_t)row * 256 + 64]; }
#pragma unroll
    for (int k = 0; k < 13; ++k) { const float nr = lam.x * xr - lam.y * xi + sr[k], ni = lam.x * xi + lam.y * xr + si[k]; xr = nr; xi = ni; }
  }
  EX[(seg * 64 + (X.tid & 63)) * 2] = xr; EX[(seg * 64 + (X.tid & 63)) * 2 + 1] = xi;
  float pr = 1.f, pi = 0.f;
  for (int k = 0; k < 65; ++k) { const float nr = pr * lam.x - pi * lam.y, ni = pr * lam.y + pi * lam.x; pr = nr; pi = ni; }
  __syncthreads();
  float cr = 0.f, ci = 0.f;
  for (int s2 = 0; s2 < seg; ++s2) { const float er = EX[(s2 * 64 + (X.tid & 63)) * 2], ei = EX[(s2 * 64 + (X.tid & 63)) * 2 + 1];
    const float nr = pr * cr - pi * ci + er, ni = pr * ci + pi * cr + ei; cr = nr; ci = ni; }
  xr = cr; xi = ci;
  for (int b = 0; b < 65; b += 13) {
    float sr[13], si[13];
#pragma unroll
    for (int k = 0; k < 13; ++k) { const int j = j0 + b + k; const int row = dir == 0 ? (j < 8 ? 512 + j : j - 8) : 519 - j; sr[k] = S[(size_t)row * 256]; si[k] = S[(size_t)row * 256 + 64]; }
#pragma unroll
    for (int k = 0; k < 13; ++k) { const int j = j0 + b + k; const int row = dir == 0 ? (j < 8 ? 512 + j : j - 8) : 519 - j;
      XP[(size_t)row * 768] = f2bf(xr); XP[(size_t)row * 768 + 64] = f2bf(xi);
      const float nr = lam.x * xr - lam.y * xi + sr[k], ni = lam.x * xi + lam.y * xr + si[k]; xr = nr; xi = ni; }
  }
  __syncthreads();
}

__device__ __forceinline__ void zero_lists(const Ctx& X) {
  u32x4* z = (u32x4*)(X.ws + WS_LTOK); unsigned zu_ = 0u; asm volatile("" : "+v"(zu_)); const u32x4 zero = (u32x4){zu_, zu_, zu_, zu_};
  for (int i = X.c * NTHR + X.tid; i < (int)(4 * MiB / 16); i += X.G * NTHR) z[i] = zero;
}
#define MFMA32(a, b, c) __builtin_amdgcn_mfma_f32_32x32x16_bf16((a), (b), (c), 0, 0, 0)
__device__ __forceinline__ void attn_unit(const Ctx& X, const LAS float* rpbl, int head, int tile) {
  const bf16_t* Q = (const bf16_t*)(X.ws + WS_Q); const bf16_t* Kb = (const bf16_t*)(X.ws + WS_K); const bf16_t* VT = (const bf16_t*)(X.ws + WS_VT);
  bf16_t* CCt = (bf16_t*)(X.ws + WS_CONCAT);
  const int lane = X.lane, ql = lane & 31, hh = lane >> 5;
  const int rp = tile >> 2, mt = tile & 3;
  const int r = 2 * rp + (ql >> 4), cq = 16 * mt + (ql & 15), tq = r * 64 + cq;
  const int r0q = min(max(r - 4, 0), 248), csq = min(max(cq - 8, 0), 48);
  const int rlo = min(max(2 * rp - 4, 0), 248), rhi = min(max(2 * rp - 3, 0), 248) + 7;
  const int csb = min(max(16 * mt - 8, 0), 32);
  const int nloc = rhi - rlo + 1;
  unsigned cmask = 0u;
#pragma unroll
  for (int k = 0; k < 32; ++k) cmask |= ((csb + k >= csq) && (csb + k <= csq + 15)) ? (1u << k) : 0u;
  bf16x8 qf[4];
#pragma unroll
  for (int ks = 0; ks < 4; ++ks) qf[ks] = *(const bf16x8*)(Q + (size_t)tq * 512 + head * 64 + 16 * ks + 8 * hh);
  const int kperm = (ql & ~12) | ((ql & 4) << 1) | ((ql & 8) >> 1);
  f32x16 o0, o1;
#pragma unroll
  for (int i = 0; i < 16; ++i) { o0[i] = 0.f; o1[i] = 0.f; }
  float lsum = 0.f;
  const float c1 = 0.125f * 1.44269504f, c2 = 8.f * 1.44269504f;
  const float* rp_h = nullptr; (void)rp_h;
  bf16x8 kf[4], vf[2][2];
  { const int tb0 = rlo * 64 + csb; const bf16_t* kp = Kb + (size_t)(tb0 + kperm) * 512 + head * 64 + 8 * hh;
#pragma unroll
    for (int ks = 0; ks < 4; ++ks) kf[ks] = *(const bf16x8*)(kp + 16 * ks);
#pragma unroll
    for (int db = 0; db < 2; ++db)
#pragma unroll
      for (int s2 = 0; s2 < 2; ++s2) vf[db][s2] = *(const bf16x8*)(VT + (size_t)(head * 64 + 32 * db + ql) * NROW + tb0 + 16 * s2 + 8 * hh); }
  for (int b = 0; b < nloc + 8; ++b) {
    const bool loc = b < nloc;
    const int kr = rlo + b;
    bf16x8 kc[4], vc[2][2];
#pragma unroll
    for (int ks = 0; ks < 4; ++ks) kc[ks] = kf[ks];
#pragma unroll
    for (int db = 0; db < 2; ++db)
#pragma unroll
      for (int s2 = 0; s2 < 2; ++s2) vc[db][s2] = vf[db][s2];
    if (b + 1 < nloc + 8) { const int bn = b + 1; const int tbn = bn < nloc ? (rlo + bn) * 64 + csb : TOK + 32 * (bn - nloc);
      const bf16_t* kp = Kb + (size_t)(tbn + kperm) * 512 + head * 64 + 8 * hh;
#pragma unroll
      for (int ks = 0; ks < 4; ++ks) kf[ks] = *(const bf16x8*)(kp + 16 * ks);
#pragma unroll
      for (int db = 0; db < 2; ++db)
#pragma unroll
        for (int s2 = 0; s2 < 2; ++s2) vf[db][s2] = *(const bf16x8*)(VT + (size_t)(head * 64 + 32 * db + ql) * NROW + tbn + 16 * s2 + 8 * hh); }
    f32x16 sacc;
#pragma unroll
    for (int i = 0; i < 16; ++i) sacc[i] = 0.f;
#pragma unroll
    for (int ks = 0; ks < 4; ++ks) sacc = MFMA32(kc[ks], qf[ks], sacc);
    float pv[16];
    if (loc) {
      const bool rowok = (kr >= r0q) && (kr <= r0q + 7);
      const int dr = min(max(kr - r + 7, 0), 14);
      const LAS float* bp = rpbl + (head * 15 + dr) * 31;
      const int dc0 = csb - cq + 15;
#pragma unroll
      for (int i = 0; i < 16; ++i) { const int kidx = 16 * (i >> 3) + 8 * hh + (i & 7);
        const bool ok = rowok && ((cmask >> kidx) & 1u);
        const float bias = bp[min(max(dc0 + kidx, 0), 30)];
        const float e = __builtin_amdgcn_exp2f(sacc[i] * c1 + bias * 1.44269504f - c2); pv[i] = ok ? e : 0.f; }
    } else {
#pragma unroll
      for (int i = 0; i < 16; ++i) pv[i] = __builtin_amdgcn_exp2f(sacc[i] * c1 - c2);
    }
    u32x4 p0, p1;
    p0.x = cvt_pk_bf16(pv[0], pv[1]); p0.y = cvt_pk_bf16(pv[2], pv[3]); p0.z = cvt_pk_bf16(pv[4], pv[5]); p0.w = cvt_pk_bf16(pv[6], pv[7]);
    p1.x = cvt_pk_bf16(pv[8], pv[9]); p1.y = cvt_pk_bf16(pv[10], pv[11]); p1.z = cvt_pk_bf16(pv[12], pv[13]); p1.w = cvt_pk_bf16(pv[14], pv[15]);
    lsum += (bf_lo(p0.x) + bf_hi(p0.x)) + (bf_lo(p0.y) + bf_hi(p0.y)) + (bf_lo(p0.z) + bf_hi(p0.z)) + (bf_lo(p0.w) + bf_hi(p0.w))
          + (bf_lo(p1.x) + bf_hi(p1.x)) + (bf_lo(p1.y) + bf_hi(p1.y)) + (bf_lo(p1.z) + bf_hi(p1.z)) + (bf_lo(p1.w) + bf_hi(p1.w));
    const bf16x8 pb0 = __builtin_bit_cast(bf16x8, p0), pb1 = __builtin_bit_cast(bf16x8, p1);
    o0 = MFMA32(vc[0][0], pb0, o0); o0 = MFMA32(vc[0][1], pb1, o0);
    o1 = MFMA32(vc[1][0], pb0, o1); o1 = MFMA32(vc[1][1], pb1, o1);
  }
  lsum += sx(lsum, 32);
  const float inv = 1.f / lsum;
  bf16_t* op = CCt + (size_t)tq * 1024 + 512 + head * 64 + 4 * hh;
#pragma unroll
  for (int gq = 0; gq < 4; ++gq) {
    u32x2 w0, w1;
    w0.x = cvt_pk_bf16(o0[4 * gq] * inv, o0[4 * gq + 1] * inv); w0.y = cvt_pk_bf16(o0[4 * gq + 2] * inv, o0[4 * gq + 3] * inv);
    w1.x = cvt_pk_bf16(o1[4 * gq] * inv, o1[4 * gq + 1] * inv); w1.y = cvt_pk_bf16(o1[4 * gq + 2] * inv, o1[4 * gq + 3] * inv);
    *(u32x2*)(op + 8 * gq) = w0; *(u32x2*)(op + 32 + 8 * gq) = w1;
  }
}
__device__ __forceinline__ void phase_attn(const Ctx& X) {
  LAS float* rpbl = (LAS float*)X.lds;
  zero_lists(X);
  for (int i = X.tid; i < 8 * 15 * 31; i += NTHR) rpbl[i] = X.a->in[IN_RPB][i];
  __syncthreads();
  const int gw = X.c * NWAVES + X.wave, NGW = X.G * NWAVES;
  for (int U = gw; U < 4096; U += NGW) attn_unit(X, rpbl, U >> 9, U & 511);
}

__device__ __forceinline__ void phase_router(const Ctx& X, int layer, int dry) {
  const float* mod = (const float*)(X.ws + WS_MOD) + (layer == 0 ? 0 : 2 * 6144);
  const float* shift = mod + 3072; const float* scale = mod + 4096;
  const float* h = X.a->h; bf16_t* F = (bf16_t*)(X.ws + WS_F);
  unsigned* cntg = (unsigned*)(X.ws + WS_CTL) + CW_CNT + layer * 128;
  int* ltok = (int*)(X.ws + WS_LTOK); int* asg = (int*)(X.ws + WS_ASG);
  const bf16_t* WR = (const bf16_t*)(X.ws + WS_WROUT_T) + (size_t)layer * 64 * 1024;
  const float* rbias = X.a->in[IN_RBIAS] + layer * 64;
  constexpr int FROW = 2064;
  const int lane = X.lane, wave = X.wave, tid = X.tid;
  for (int tile = X.c; tile < TOK / 64; tile += X.G) {
    const int t0 = tile * 64;
    for (int rb4 = 0; rb4 < 2; ++rb4) {
      f32x4 v[4][4];
#pragma unroll
      for (int rr = 0; rr < 4; ++rr) { const f32x4* xr = (const f32x4*)(h + (size_t)(t0 + wave * 8 + rb4 * 4 + rr) * 1024) + lane;
#pragma unroll
        for (int j = 0; j < 4; ++j) v[rr][j] = xr[64 * j]; }
#pragma unroll
      for (int rr = 0; rr < 4; ++rr) {
        const int lr = wave * 8 + rb4 * 4 + rr, t = t0 + lr; float ss = 0.f;
#pragma unroll
        for (int j = 0; j < 4; ++j) ss += (v[rr][j].x * v[rr][j].x + v[rr][j].y * v[rr][j].y) + (v[rr][j].z * v[rr][j].z + v[rr][j].w * v[rr][j].w);
        const float r = rsqrtf(wave_sum(ss) * (1.f / 1024.f) + 1e-6f);
#pragma unroll
        for (int j = 0; j < 4; ++j) { const f32x4 sh = ((const f32x4*)shift)[lane + 64 * j], sc = ((const f32x4*)scale)[lane + 64 * j];
          u32x2 w; w.x = cvt_pk_bf16(v[rr][j].x * r * (1.f + sc.x) + sh.x, v[rr][j].y * r * (1.f + sc.y) + sh.y); w.y = cvt_pk_bf16(v[rr][j].z * r * (1.f + sc.z) + sh.z, v[rr][j].w * r * (1.f + sc.w) + sh.w);
          if (!dry) { int w8 = 0; w8 = __builtin_amdgcn_cvt_pk_fp8_f32(v[rr][j].x * r * (1.f + sc.x) + sh.x, v[rr][j].y * r * (1.f + sc.y) + sh.y, w8, false);
            w8 = __builtin_amdgcn_cvt_pk_fp8_f32(v[rr][j].z * r * (1.f + sc.z) + sh.z, v[rr][j].w * r * (1.f + sc.w) + sh.w, w8, true);
            ((int*)((unsigned char*)F + (size_t)t * 1024))[lane + 64 * j] = w8; }
          *(LAS u32x2*)(X.lds + lr * FROW + (lane + 64 * j) * 8) = w; }
      }
    }
    __syncthreads();
    f32x4 lg[2];
    { const int rb = wave & 3, fr = lane & 15, fq = lane >> 4;
      lg[0] = (f32x4){0.f, 0.f, 0.f, 0.f}; lg[1] = lg[0];
      const LAS unsigned char* ap = X.lds + (rb * 16 + fr) * FROW + fq * 16;
      const bf16_t* bp0 = WR + (size_t)((2 * (wave >> 2)) * 16 + fr) * 1024 + fq * 8; const bf16_t* bp1 = bp0 + 16 * 1024;
#pragma unroll 16
      for (int ks = 0; ks < 32; ++ks) { const bf16x8 af = *(const LAS bf16x8*)(ap + ks * 64); const bf16x8 b0 = *(const bf16x8*)(bp0 + ks * 32), b1 = *(const bf16x8*)(bp1 + ks * 32);
        lg[0] = __builtin_amdgcn_mfma_f32_16x16x32_bf16(af, b0, lg[0], 0, 0, 0); lg[1] = __builtin_amdgcn_mfma_f32_16x16x32_bf16(af, b1, lg[1], 0, 0, 0); }
    }
    __syncthreads();
    LAS float* LG = (LAS float*)X.lds;
    LAS float* GS = LG + 64 * 65;
    LAS float* SELV = GS + 512;
    LAS int* OUTE = (LAS int*)(SELV + 4096);
    LAS float* OUTS = (LAS float*)(OUTE + 512);
    LAS int* HIST = (LAS int*)(OUTS + 512);
    LAS int* BASE = HIST + 64;
    { const int rb = wave & 3, fr = lane & 15, fq = lane >> 4;
#pragma unroll
      for (int eb = 0; eb < 2; ++eb)
#pragma unroll
        for (int j = 0; j < 4; ++j) LG[(rb * 16 + 4 * fq + j) * 65 + (2 * (wave >> 2) + eb) * 16 + fr] = lg[eb][j];
      if (tid < 64) HIST[tid] = 0; }
    __syncthreads();
    const int tl = tid >> 3, grp = tid & 7;
    float v[8], sc[8];
    { float m1 = -INFINITY, m2 = -INFINITY;
#pragma unroll
      for (int j = 0; j < 8; ++j) { const float s = 1.f / (1.f + __expf(-LG[tl * 65 + grp * 8 + j])); sc[j] = s; v[j] = s + rbias[grp * 8 + j];
        if (v[j] > m1) { m2 = m1; m1 = v[j]; } else if (v[j] > m2) m2 = v[j]; }
      GS[tl * 8 + grp] = m1 + m2; }
    __syncthreads();
    bool keep;
    { const float mine = GS[tl * 8 + grp]; int rank = 0;
#pragma unroll
      for (int g2 = 0; g2 < 8; ++g2) { const float o = GS[tl * 8 + g2]; rank += (o > mine || (o == mine && g2 < grp)) ? 1 : 0; }
      keep = rank < 4;
#pragma unroll
      for (int j = 0; j < 8; ++j) SELV[tl * 64 + grp * 8 + j] = keep ? v[j] : -INFINITY; }
    __syncthreads();
    if (keep) {
      int rk[8];
#pragma unroll
      for (int j = 0; j < 8; ++j) rk[j] = 0;
      for (int e2 = 0; e2 < 64; ++e2) { const float o = SELV[tl * 64 + e2];
#pragma unroll
        for (int j = 0; j < 8; ++j) rk[j] += (o > v[j] || (o == v[j] && e2 < grp * 8 + j)) ? 1 : 0; }
#pragma unroll
      for (int j = 0; j < 8; ++j) if (rk[j] < 8) { OUTE[tl * 8 + rk[j]] = grp * 8 + j; OUTS[tl * 8 + rk[j]] = sc[j]; }
    }
    __syncthreads();
    { const int jj = tid & 7, e = OUTE[tl * 8 + jj]; const float s = OUTS[tl * 8 + jj];
      float sum = s; sum += sx(sum, 1); sum += sx(sum, 2); sum += sx(sum, 4);
      const float w = 2.5f * s / sum;
      const int sl = atomicAdd((int*)&HIST[e], 1);
      __syncthreads();
      const int t = t0 + tl, half = t >> 13;
      if (tid < 64) { const int n = HIST[tid]; BASE[tid] = (n && !dry) ? (int)atomicAdd(cntg + half * 64 + tid, (unsigned)n) : 0; }
      __syncthreads();
      const int slot = BASE[e] + sl;
      if (!dry) { ltok[(size_t)(half * 64 + e) * 8192 + slot] = t; } if (!dry) ((int2*)asg)[t * 8 + jj] = make_int2((e << 16) | slot, __float_as_int(w)); }
    __syncthreads();
  }
}

__device__ __forceinline__ void phase_combine(const Ctx& X, int layer, int half, const LAS int* toff, int dry) {
  const float* mod = (const float*)(X.ws + WS_MOD) + (layer == 0 ? 0 : 2 * 6144);
  const float* gffn = mod + 5120;
  const float* nmod = (const float*)(X.ws + WS_MOD) + 2 * 6144;
  float* h = X.a->h; const bf16_t* YAS = (const bf16_t*)(X.ws + WS_YAS); const int* asg = (const int*)(X.ws + WS_ASG); bf16_t* A1 = (bf16_t*)(X.ws + WS_A1);
  const int gw = X.c * NWAVES + X.wave, NGW = X.G * NWAVES, lane = X.lane;
  int2 an[8];
#pragma unroll
  for (int k = 0; k < 8; ++k) an[k] = ((const int2*)asg)[(half * 8192 + gw) * 8 + k];
  for (int ti = gw; ti < 8192; ti += NGW) {
    const int t = half * 8192 + ti;
    f32x4 acc[4];
#pragma unroll
    for (int j = 0; j < 4; ++j) acc[j] = (f32x4){0.f, 0.f, 0.f, 0.f};
    int pos[9]; float wgt[9];
#pragma unroll
    for (int k = 0; k < 8; ++k) { pos[k] = toff[an[k].x >> 16] * 256 + (an[k].x & 0xffff); wgt[k] = __int_as_float(an[k].y); }
    if (ti + NGW < 8192) {
#pragma unroll
      for (int k = 0; k < 8; ++k) an[k] = ((const int2*)asg)[(t + NGW) * 8 + k]; }
    pos[8] = toff[64] * 256 + ti; wgt[8] = 1.f;
#pragma unroll
    for (int k = 0; k < 9; ++k) { const u32x2* yr = (const u32x2*)(YAS + (size_t)pos[k] * 1024) + lane; const float wk = wgt[k];
#pragma unroll
      for (int j = 0; j < 4; ++j) { const u32x2 w = yr[64 * j]; acc[j].x += wk * bf_lo(w.x); acc[j].y += wk * bf_hi(w.x); acc[j].z += wk * bf_lo(w.y); acc[j].w += wk * bf_hi(w.y); } }
    f32x4* hr = (f32x4*)(h + (size_t)t * 1024) + lane; f32x4 v[4]; float ss = 0.f;
#pragma unroll
    for (int j = 0; j < 4; ++j) { const f32x4 gt = ((const f32x4*)gffn)[lane + 64 * j]; v[j] = hr[64 * j] + gt * acc[j]; if (!dry) hr[64 * j] = v[j];
      ss += (v[j].x * v[j].x + v[j].y * v[j].y) + (v[j].z * v[j].z + v[j].w * v[j].w); }
    if (layer == 0) {
      const float r = rsqrtf(wave_sum(ss) * (1.f / 1024.f) + 1e-6f);
#pragma unroll
      for (int j = 0; j < 4; ++j) { const f32x4 sh = ((const f32x4*)nmod)[lane + 64 * j], sc = ((const f32x4*)(nmod + 1024))[lane + 64 * j];
        u32x2 w; w.x = cvt_pk_bf16(v[j].x * r * (1.f + sc.x) + sh.x, v[j].y * r * (1.f + sc.y) + sh.y); w.y = cvt_pk_bf16(v[j].z * r * (1.f + sc.z) + sh.z, v[j].w * r * (1.f + sc.w) + sh.w);
        if (!dry) ((u32x2*)(A1 + (size_t)t * 1024))[lane + 64 * j] = w; }
    }
  }
}

constexpr int NPHASE = 25;
template <bool SP2>
__global__ void __launch_bounds__(NTHR, 2) mk_fwd(Args args) {
  extern __shared__ __attribute__((aligned(16))) unsigned char lds_raw[];
  Ctx X; X.lds = (LAS unsigned char*)lds_raw; X.a = &args; X.ws = args.ws; X.tid = threadIdx.x; X.lane = X.tid & 63; X.wave = __builtin_amdgcn_readfirstlane(X.tid >> 6);
  X.G = gridDim.x; X.c = blockIdx.x;
  const int wave_s = X.wave;
  volatile LAS unsigned* MISC = (volatile LAS unsigned*)(X.lds + LDS_MISC_OFF);
  LAS int* TOFF = (LAS int*)(X.lds + LDS_MISC_OFF + 64);
  if (X.tid < 16) MISC[X.tid] = 0u;
  __syncthreads();
  unsigned* ctl = (unsigned*)(X.ws + WS_CTL);
  const int lo = args.ph_lo, hi = args.ph_hi;
  const bool multi = (hi - lo) > 1;
  XcdBarrier bar; bar.bar = ctl + CW_BAR; bar.x = 0; bar.st = nullptr;
  if (multi) bar = xcd_barrier_post(ctl + CW_BAR, MISC, X.tid);
  LAS unsigned char* lds = X.lds;
  unsigned char* ws = X.ws;
  const float* mod = (const float*)(ws + WS_MOD); (void)mod;
#ifndef PH_MASK
#define PH_MASK 0x1ffffffull
#endif
#define IN(k) ((((unsigned long long)PH_MASK >> (k)) & 1ull) && lo <= (k) && (k) < hi)
#define SEAM(k) do { if (IN(k) && IN((k) + 1)) xcd_barrier(bar, X.tid); } while (0)
#ifndef REP_MASK
#define REP_MASK 0ull
#endif
#define REPS(k) ((int)(((unsigned long long)REP_MASK >> (k)) & 1ull))
#define LAUNDER() do { int w0_ = wave_s; asm volatile("" : "+s"(w0_)); int l_ = __builtin_amdgcn_mbcnt_hi(~0u, __builtin_amdgcn_mbcnt_lo(~0u, 0u)); asm volatile("" : "+v"(l_)); X.wave = w0_; X.lane = l_; X.tid = w0_ * 64 + l_; \
    size_t z0_ = 0; asm volatile("" : "+s"(z0_)); unsigned char* w_ = args.ws + z0_; X.ws = w_; ws = w_; mod = (const float*)(w_ + WS_MOD); } while (0)
  if (IN(0)) for (int rep_ = 0; rep_ <= REPS(0); ++rep_) { if (rep_) xcd_barrier(bar, X.tid); LAUNDER(); phase_prep(X, rep_); } SEAM(0);
#ifdef EXTRA_BARS
  if (multi) for (int eb_ = 0; eb_ < EXTRA_BARS; ++eb_) xcd_barrier(bar, X.tid);
#endif
  if (IN(1)) for (int rep_ = 0; rep_ <= REPS(1); ++rep_) { if (rep_) xcd_barrier(bar, X.tid); LAUNDER(); phase_mod0(X); } SEAM(1);
  if (IN(2)) for (int rep_ = 0; rep_ <= REPS(2); ++rep_) { if (rep_) xcd_barrier(bar, X.tid); LAUNDER(); G1 p; p.K = 1024; p.nunits = 520; p.ws = ws; p.qg = args.in[IN_QG]; p.kg = args.in[IN_KG]; gemm_phase<G1, SP2>(lds, p, X.G, X.c, X.tid); } SEAM(2);
  if (IN(3)) for (int rep_ = 0; rep_ <= REPS(3); ++rep_) { if (rep_) xcd_barrier(bar, X.tid); LAUNDER(); G2 p; p.K = 512; p.nunits = 96; p.ws = ws; gemm_phase<G2, SP2>(lds, p, X.G, X.c, X.tid); } SEAM(3);
  if (IN(4)) for (int rep_ = 0; rep_ <= REPS(4); ++rep_) { if (rep_) xcd_barrier(bar, X.tid); LAUNDER(); phase_scan(X); } SEAM(4);
  if (IN(5)) for (int rep_ = 0; rep_ <= REPS(5); ++rep_) { if (rep_) xcd_barrier(bar, X.tid); LAUNDER(); G3 p; p.K = 768; p.nunits = 128; p.ws = ws; gemm_phase<G3, SP2>(lds, p, X.G, X.c, X.tid); } SEAM(5);
  if (IN(6)) for (int rep_ = 0; rep_ <= REPS(6); ++rep_) { if (rep_) xcd_barrier(bar, X.tid); LAUNDER(); G4 p; p.K = 512; p.nunits = 128; p.ws = ws; p.bglu = args.in[IN_BGLU]; gemm_phase<G4, SP2>(lds, p, X.G, X.c, X.tid); } SEAM(6);
  if (IN(7)) for (int rep_ = 0; rep_ <= REPS(7); ++rep_) { if (rep_) xcd_barrier(bar, X.tid); LAUNDER(); phase_attn(X); } SEAM(7);
  if (IN(8)) for (int rep_ = 0; rep_ <= REPS(8); ++rep_) { if (rep_) xcd_barrier(bar, X.tid); LAUNDER(); GRes p; p.K = 1024; p.nunits = 256; p.A = (const char*)ws + WS_CONCAT; p.Bt = (const char*)ws + WS_WMIX_T; p.hin = args.in[IN_X]; p.hout = args.h; p.gate = mod + 2048; p.bias = nullptr;
    gemm_phase<GRes, SP2>(lds, p, X.G, X.c, X.tid); } SEAM(8);
#pragma unroll 1
  for (int layer = 0; layer < 2; ++layer) {
    const int pb = layer == 0 ? 9 : 19;
    if (IN(pb)) for (int rep_ = 0; rep_ <= REPS(pb); ++rep_) { if (rep_) xcd_barrier(bar, X.tid); LAUNDER(); phase_router(X, layer, rep_); } SEAM(pb);
    if (IN(pb + 1)) for (int rep_ = 0; rep_ <= REPS(pb + 1); ++rep_) { if (rep_) xcd_barrier(bar, X.tid); LAUNDER(); build_moetab(X, layer, TOFF); G6 p; p.K = 512; p.ws = ws; p.toff = TOFF; p.nunits = (TOFF[65] + TOFF[66 + 65]) * 2; { LAS unsigned* tk = (LAS unsigned*)(X.lds + LDS_STAGE); LAS int* td = (LAS int*)(X.lds + LDS_STAGE + 8192); p.tokt = tk; p.tord = td; p.build_tord(X, td); p.build_tokt(X, tk); } gemm_phase<G6, SP2>(lds, p, X.G, X.c, X.tid); } SEAM(pb + 1);
#pragma unroll 1
    for (int half = 0; half < 2; ++half) {
      const int p7 = pb + 2 + 2 * half;
      if (IN(p7)) for (int rep_ = 0; rep_ <= REPS(p7); ++rep_) { if (rep_) xcd_barrier(bar, X.tid); LAUNDER(); build_moetab(X, layer, TOFF); G7 p; p.K = 256; p.ws = ws; p.toff = TOFF; p.half = half; p.hidbase = half ? TOFF[65] : 0; p.dry = rep_; p.nunits = TOFF[66 * half + 65] * 4; gemm_phase<G7, SP2>(lds, p, X.G, X.c, X.tid); } SEAM(p7);
      if (IN(p7 + 1)) for (int rep_ = REPS(p7 + 1); rep_ >= 0; --rep_) { if (rep_ == 0 && REPS(p7 + 1)) xcd_barrier(bar, X.tid); LAUNDER(); build_moetab(X, layer, TOFF); phase_combine(X, layer, half, TOFF + 66 * half, rep_);
        if (layer == 0 && half == 1 && !(args.flags & FLAG_SKIP_EXPERTS)) { __syncthreads(); transpose_work(X, ctl + CW_DQ1, 0, 0, 1, 65 * IT_EXP); } }
      if (!(layer == 1 && half == 1)) SEAM(p7 + 1);
    }
    if (layer == 0) {
      if (IN(15)) for (int rep_ = 0; rep_ <= REPS(15); ++rep_) { if (rep_) xcd_barrier(bar, X.tid); LAUNDER(); G8 p; p.K = 256; p.nunits = 512; p.ws = ws; gemm_phase<G8, SP2>(lds, p, X.G, X.c, X.tid); } SEAM(15);
      if (IN(16)) for (int rep_ = 0; rep_ <= REPS(16); ++rep_) { if (rep_) xcd_barrier(bar, X.tid); LAUNDER(); G9 p; p.K = 256; p.nunits = 512; p.ws = ws; gemm_phase<G9, SP2>(lds, p, X.G, X.c, X.tid); } SEAM(16);
      if (IN(17)) for (int rep_ = 0; rep_ <= REPS(17); ++rep_) { if (rep_) xcd_barrier(bar, X.tid); LAUNDER(); G10 p; p.K = 256; p.nunits = 512; p.ws = ws; gemm_phase<G10, SP2>(lds, p, X.G, X.c, X.tid); } SEAM(17);
      if (IN(18)) { LAUNDER(); zero_lists(X); GRes p; p.K = 1024; p.nunits = 256; p.A = (const char*)ws + WS_FB; p.Bt = (const char*)ws + WS_WFOUR_T; p.hin = args.h; p.hout = args.h; p.gate = mod + 2 * 6144 + 2048; p.bias = args.in[IN_BFOUR];
        gemm_phase<GRes, SP2>(lds, p, X.G, X.c, X.tid); } SEAM(18);
    }
  }
#undef IN
#undef SEAM
}
}
#ifndef MK_SP2
#define MK_SP2 true
#endif
#ifndef MK_N_LAUNCHES
#define MK_N_LAUNCHES 1
#endif
#ifndef CHECK
#define CHECK 0
#endif
static int g_grid = 0;
static bool mk_setup(int n_in, int out_size, size_t ws_size) {
  if (g_grid == 0) {
    g_grid = -1;
    if (n_in != 31 || out_size != 16384 * 1024 || ws_size < (size_t)530 * 1000 * 1000) { fprintf(stderr, "kernel_launch: unexpected n_in %d out %d ws %zu\n", n_in, out_size, ws_size); return false; }
    int dev = 0, cus = 0;
    if (hipGetDevice(&dev) != hipSuccess || hipDeviceGetAttribute(&cus, hipDeviceAttributeMultiprocessorCount, dev) != hipSuccess) return false;
    if (cus < 256) { fprintf(stderr, "kernel_launch: needs 256 CUs, device has %d\n", cus); return false; }
    if (hipFuncSetAttribute((const void*)mk::mk_fwd<MK_SP2>, hipFuncAttributeMaxDynamicSharedMemorySize, mk::LDS_BYTES) != hipSuccess) { fprintf(stderr, "kernel_launch: hipFuncSetAttribute failed\n"); return false; }
    g_grid = 256;
  }
  return g_grid > 0;
}
static void mk_run(hipStream_t s, mk::Args a, int lo, int hi) {
  a.ph_lo = lo; a.ph_hi = hi;
  hipLaunchKernelGGL(mk::mk_fwd<MK_SP2>, dim3(g_grid), dim3(mk::NTHR), mk::LDS_BYTES, s, a);
}

#if CHECK
namespace chk {
using mk::bf16_t;
__device__ __forceinline__ float b2f(bf16_t b) { return __uint_as_float(((unsigned)b) << 16); }
__global__ void k_cmp(int mode, const void* A, const float* B, unsigned long long n, double* acc) {
  double e = 0.0, r = 0.0; const bf16_t* A16 = (const bf16_t*)A;
  for (unsigned long long i = (unsigned long long)blockIdx.x * 256 + threadIdx.x; i < n; i += (unsigned long long)gridDim.x * 256) {
    float a = 0.f, b = 0.f; const int row = (int)(i >> 9), col = (int)(i & 511);
    switch (mode) {
      case 0: a = ((const float*)A)[i]; b = B[i]; break;
      case 1: a = b2f(A16[i]); b = B[i]; break;
      case 2: { b = B[(size_t)row * 2048 + col]; const int g = col >> 4, c = col & 15; int crow, s; if (row < 16384) { crow = row >> 5; s = row & 31; } else { const int j = row - 16384; crow = 512 + (j >> 5); s = j & 31; }
                a = b2f(A16[((size_t)(g * 768 + crow)) * 768 + s * 16 + c]); } break;
      case 3: b = B[(size_t)row * 2048 + 512 + col]; a = b2f(A16[(size_t)row * 512 + col]); break;
      case 4: b = B[(size_t)row * 2048 + 1024 + col]; a = b2f(A16[(size_t)row * 512 + col]); break;
      case 5: b = B[(size_t)row * 2048 + 1536 + col]; a = b2f(A16[(size_t)col * 16640 + row]); break;
      case 6: b = B[(size_t)row * 1024 + col]; a = b2f(A16[(size_t)row * 1024 + col]); break;
      case 7: b = B[(size_t)row * 1024 + 512 + col]; a = b2f(A16[(size_t)row * 1024 + 512 + col]); break;
      case 8: { const int ta = (int)(i & 127), ri = (int)((i >> 7) & 1), tb = (int)((i >> 8) & 127), m = (int)((i >> 15) & 255), g = (int)(i >> 23); a = b2f(A16[i]); const int t = 128 * ta + tb; b = B[((size_t)t * 4 + g) * 512 + ri * 256 + m]; } break;
      default: break;
    }
    const double d = (double)a - (double)b; e += d * d; r += (double)b * (double)b;
  }
  for (int o = 32; o >= 1; o >>= 1) { e += __shfl_xor(e, o); r += __shfl_xor(r, o); }
  if ((threadIdx.x & 63) == 0) { atomicAdd(acc, e); atomicAdd(acc + 1, r); }
}
__global__ void k_cmp_x2(const bf16_t* X2, const float* Yr, const float* Yi, double* acc) {
  double e = 0.0, r = 0.0;
  for (unsigned long long i = (unsigned long long)blockIdx.x * 256 + threadIdx.x; i < (1ull << 25); i += (unsigned long long)gridDim.x * 256) {
    const int tb = (int)(i & 127), rip = (int)((i >> 7) & 1), ka = (int)((i >> 8) & 127), gm = (int)(i >> 15);
    const float a = b2f(X2[i]); const size_t yi = (((size_t)ka * 128 + tb) << 10) + gm; const float b = rip ? Yi[yi] : Yr[yi];
    const double d = (double)a - (double)b; e += d * d; r += (double)b * (double)b;
  }
  for (int o = 32; o >= 1; o >>= 1) { e += __shfl_xor(e, o); r += __shfl_xor(r, o); }
  if ((threadIdx.x & 63) == 0) { atomicAdd(acc, e); atomicAdd(acc + 1, r); }
}
__global__ void k_judge(const double* acc, int n, float tol, int* fail) {
  if (threadIdx.x == 0 && blockIdx.x == 0) { fail[0] = 0; for (int k = 0; k < n; ++k) { const double rel = sqrt(acc[2 * k] / acc[2 * k + 1]); if (!(rel <= (double)tol)) { fail[0] = k + 1; break; } } }
}
__global__ void k_encode(float* out, size_t n, const int* fail) {
  const int f = fail[0]; if (f == 0) return; const float sc = 1.f + 0.1f * (float)f;
  for (size_t i = (size_t)blockIdx.x * 256 + threadIdx.x; i < n; i += (size_t)gridDim.x * 256) out[i] *= sc;
}
__global__ void k_f2bf(const float* in, bf16_t* out, size_t n) { for (size_t i = (size_t)blockIdx.x * 256 + threadIdx.x; i < n; i += (size_t)gridDim.x * 256) out[i] = mk::f2bf(in[i]); }
static void cmp(hipStream_t s, int mode, const void* A, const float* B, unsigned long long n, double* acc) { hipLaunchKernelGGL(k_cmp, dim3(2048), dim3(256), 0, s, mode, A, B, n, acc); }
}
#endif

extern "C" void kernel_launch(void* const* d_in, const int* in_sizes, int n_in, void* d_out, int out_size, void* d_ws, size_t ws_size, hipStream_t stream) {
  if (!mk_setup(n_in, out_size, ws_size)) return;
  unsigned char* ws = (unsigned char*)d_ws;
  const size_t MiB = mk::MiB;
  mk::Args a{};
  for (int i = 0; i < 31; ++i) a.in[i] = (const float*)d_in[i];
  a.h = (float*)d_out; a.ws = ws; a.flags = 0; a.pad = 0;
#if CHECK == 0
  (void)hipMemsetAsync(ws + mk::WS_CTL, 0, mk::CTL_ZERO_BYTES, stream);
#if MK_N_LAUNCHES == 1
  mk_run(stream, a, 0, mk::NPHASE);
#else
  for (int ph = 0; ph < mk::NPHASE; ++ph) mk_run(stream, a, ph, ph + 1);
#endif
#else
  ref::In in; { const float** p = (const float**)&in; for (int i = 0; i < 31; ++i) p[i] = (const float*)d_in[i]; }
  float* out = (float*)d_out;
  char* wsc = (char*)d_ws;
  ref::Small sm; sm.mod = (float*)(wsc + 498 * MiB); sm.lamb = (float2*)(wsc + 498 * MiB + 131072); sm.bbar = (float2*)(wsc + 498 * MiB + 262144);
  sm.tw = (float2*)(wsc + 499 * MiB); sm.Dm = (float*)(wsc + 499 * MiB + 262144);
  double* acc = (double*)(wsc + 500 * MiB); int* fail = (int*)(wsc + 500 * MiB + 4096);
  (void)hipMemsetAsync(acc, 0, 8192, stream);
  (void)hipMemsetAsync(ws + mk::WS_CTL, 0, mk::CTL_ZERO_BYTES, stream);
  float* HOPT = (float*)(ws + mk::WS_HOPT);
  int nchk = 0;
#if CHECK == 1
  ref::MixBuf mb; mb.a0 = (float*)(wsc + 12 * MiB); mb.z = (float*)(wsc + 336 * MiB); mb.g = (float*)(wsc + 466 * MiB); mb.t = (float*)(wsc + 77 * MiB); mb.concat = mb.a0; mb.ymix = mb.z;
  char* moe_arena = wsc + 12 * MiB;
  ref::FourBuf fb; { char* p = wsc + 12 * MiB; fb.a1 = (float*)p; p += 64 * MiB; fb.Z = (float*)p; p += 128 * MiB; fb.Yr = (float*)p; p += 64 * MiB; fb.Yi = (float*)p; p += 64 * MiB; fb.F = (float*)p; fb.yf = fb.Z; }
  a.flags = mk::FLAG_SKIP_EXPERTS;
  nchk = 10;
  ref::forward(stream, in, out, sm, mb, moe_arena, fb, [&](int st) {
    if (st == 1) { mk_run(stream, a, 0, 1); chk::cmp(stream, 0, ws + mk::WS_MOD, sm.mod, 3 * 6144, acc + 0); }
    if (st == 2) { mk_run(stream, a, 1, 2); chk::cmp(stream, 1, ws + mk::WS_A0, mb.a0, 16640ull * 1024, acc + 2); }
    if (st == 3) { mk_run(stream, a, 2, 3); chk::cmp(stream, 2, ws + mk::WS_AS5, mb.z, 16640ull * 512, acc + 4); chk::cmp(stream, 3, ws + mk::WS_Q, mb.z, 16384ull * 512, acc + 6);
                   chk::cmp(stream, 4, ws + mk::WS_K, mb.z, 16640ull * 512, acc + 8); chk::cmp(stream, 5, ws + mk::WS_VT, mb.z, 16640ull * 512, acc + 10); }
    if (st == 4) { mk_run(stream, a, 3, 4); mk_run(stream, a, 4, 5); mk_run(stream, a, 5, 6); chk::cmp(stream, 1, ws + mk::WS_GB, mb.g, 16384ull * 512, acc + 12); }
    if (st == 5) { mk_run(stream, a, 6, 7); chk::cmp(stream, 6, ws + mk::WS_CONCAT, mb.concat, 16384ull * 512, acc + 14); }
    if (st == 6) { mk_run(stream, a, 7, 8); chk::cmp(stream, 7, ws + mk::WS_CONCAT, mb.concat, 16384ull * 512, acc + 16); }
    if (st == 7) { mk::Args b = a; b.h = HOPT; mk_run(stream, b, 8, 9); chk::cmp(stream, 0, HOPT, out, 16384ull * 1024, acc + 18); }
  });
#elif CHECK == 2 || CHECK == 4
  const int L = CHECK == 2 ? 0 : 1;
  ref::MixBuf mb; { char* p = wsc + 12 * MiB; mb.a0 = (float*)p; p += 65 * MiB; mb.z = (float*)p; p += 130 * MiB; mb.g = (float*)p; p += 32 * MiB; mb.t = (float*)p; p += 32 * MiB; mb.concat = (float*)p; p += 64 * MiB; mb.ymix = mb.z; }
  ref::FourBuf fb; { char* p = wsc + 12 * MiB; fb.a1 = (float*)p; p += 64 * MiB; fb.Z = (float*)p; p += 128 * MiB; fb.Yr = (float*)p; p += 64 * MiB; fb.Yi = (float*)p; p += 64 * MiB; fb.F = (float*)p; fb.yf = fb.Z; }
  char* moe_arena = wsc + 110 * MiB;
  nchk = L == 0 ? 2 : 1;
  a.flags = 0;
  ref::forward(stream, in, out, sm, mb, moe_arena, fb, [&](int st) {
    if ((L == 0 && st == 7) || (L == 1 && st == 11)) {
      mk::Args b = a; b.h = HOPT; if (L == 1) b.flags = 2;
      mk_run(stream, b, 0, 1);
      (void)hipMemcpyAsync(HOPT, out, (size_t)16384 * 1024 * 4, hipMemcpyDeviceToDevice, stream);
      const int pb = L == 0 ? 9 : 20; b.flags |= mk::FLAG_SKIP_EXPERTS;
      for (int ph = pb; ph < pb + 7; ++ph) mk_run(stream, b, ph, ph + 1);
    }
    if ((L == 0 && st == 8) || (L == 1 && st == 12)) chk::cmp(stream, 0, HOPT, out, 16384ull * 1024, acc + 0);
    if (L == 0 && st == 9) chk::cmp(stream, 1, ws + mk::WS_A1, fb.a1, 16384ull * 1024, acc + 2);
  });
#elif CHECK == 3
  ref::MixBuf mb; { char* p = wsc + 12 * MiB; mb.a0 = (float*)p; p += 65 * MiB; mb.z = (float*)p; p += 130 * MiB; mb.g = (float*)p; p += 32 * MiB; mb.t = (float*)p; p += 32 * MiB; mb.concat = (float*)p; p += 64 * MiB; mb.ymix = mb.z; }
  char* moe_arena = wsc + 12 * MiB;
  ref::FourBuf fb; fb.Z = (float*)(wsc + 270 * MiB);
  fb.a1 = (float*)(wsc + 12 * MiB); fb.Yr = (float*)(wsc + 12 * MiB);   fb.Yi = (float*)(wsc + 468 * MiB - 0); fb.F = (float*)(wsc + 270 * MiB); fb.yf = (float*)(wsc + 334 * MiB);
  fb.Yi = (float*)(wsc + 76 * MiB);
  nchk = 4;
  a.flags = mk::FLAG_SKIP_EXPERTS;
  ref::forward(stream, in, out, sm, mb, moe_arena, fb, [&](int st) {
    if (st == 9) {
      mk::Args b = a; b.h = HOPT;
      mk_run(stream, b, 0, 1);
      hipLaunchKernelGGL(chk::k_f2bf, dim3(2048), dim3(256), 0, stream, fb.a1, (chk::bf16_t*)(ws + mk::WS_A1), (size_t)16384 * 1024);
      (void)hipMemcpyAsync(HOPT, out, (size_t)16384 * 1024 * 4, hipMemcpyDeviceToDevice, stream);
      mk_run(stream, b, 16, 17);
    }
  });
#endif
  hipLaunchKernelGGL(chk::k_judge, dim3(1), dim3(64), 0, stream, acc, nchk, 0.05f, fail);
  hipLaunchKernelGGL(chk::k_encode, dim3(2048), dim3(256), 0, stream, out, (size_t)16384 * 1024, fail);
#endif
}
```

```cpp
#define CHECK 0
#define MK_N_LAUNCHES 1
#define MK_SP2 true
#define REP_MASK 0ull
#include <hip/hip_runtime.h>
#include <cstdio>
#include <cstdint>
#include <cmath>
namespace mk {
#define LAS __attribute__((address_space(3)))
typedef unsigned short bf16_t;
typedef short bf16x8 __attribute__((ext_vector_type(8)));
typedef float f32x4 __attribute__((ext_vector_type(4)));
typedef float f32x2 __attribute__((ext_vector_type(2)));
typedef unsigned u32x4 __attribute__((ext_vector_type(4)));
typedef unsigned u32x2 __attribute__((ext_vector_type(2)));
typedef int i32x8 __attribute__((ext_vector_type(8)));
typedef int i32x4 __attribute__((ext_vector_type(4)));

constexpr int TOK = 16384, CTXN = 256, NROW = TOK + CTXN;
constexpr int NWAVES = 8, NTHR = 512;
constexpr int LDS_STAGE = 131072, LDS_BYTES = 155648, LDS_MISC_OFF = LDS_BYTES - 4096;

__device__ __forceinline__ unsigned cvt_pk_bf16(float lo, float hi) { unsigned r; asm volatile("v_cvt_pk_bf16_f32 %0, %1, %2" : "=v"(r) : "v"(lo), "v"(hi)); return r; }
__device__ __forceinline__ float bf_lo(unsigned w) { return __uint_as_float(w << 16); }
__device__ __forceinline__ float bf_hi(unsigned w) { return __uint_as_float(w & 0xffff0000u); }
__device__ __forceinline__ float bf2f(bf16_t b) { return __uint_as_float(((unsigned)b) << 16); }
__device__ __forceinline__ bf16_t f2bf(float f) { unsigned u = __float_as_uint(f); return (bf16_t)((u + 0x7fffu + ((u >> 16) & 1u)) >> 16); }
__device__ __forceinline__ float sx(float v, int o) { int l = __builtin_amdgcn_mbcnt_hi(~0u, __builtin_amdgcn_mbcnt_lo(~0u, 0u)); asm volatile("" : "+v"(l)); return __int_as_float(__builtin_amdgcn_ds_bpermute((l ^ o) << 2, __float_as_int(v))); }
__device__ __forceinline__ float wave_sum(float v) {
#pragma unroll
  for (int o = 1; o < 64; o <<= 1) v += sx(v, o);
  return v;
}
__device__ __forceinline__ float fast_sigmoid(float x) { return __builtin_amdgcn_rcpf(1.f + __expf(-x)); }
__device__ __forceinline__ float fast_tanh(float x) { float e = __expf(2.f * x); return 1.f - 2.f * __builtin_amdgcn_rcpf(e + 1.f); }
__device__ __forceinline__ float gelu_tanh(float x) { return 0.5f * x * (1.f + fast_tanh(0.7978845608028654f * (x + 0.044715f * x * x * x))); }

#define XB_TMO      128
#define XB_XCNT(j)  (256  + 64 * (j))
#define XB_XSUB(j)  (1280 + 64 * (j))
#define XB_XGEN(j)  (2304 + 64 * (j))
#define XB_TOP      3328
#define XB_TOPGEN   3392
#define XCD_BAR_WORDS 3456
#define XB_SPIN_CAP (1u << 20)
__device__ __forceinline__ unsigned xb_ld(unsigned* p) { return __hip_atomic_load(p, __ATOMIC_RELAXED, __HIP_MEMORY_SCOPE_AGENT); }
__device__ __forceinline__ unsigned xb_add(unsigned* p, unsigned v) { return __hip_atomic_fetch_add(p, v, __ATOMIC_RELAXED, __HIP_MEMORY_SCOPE_AGENT); }
__device__ __forceinline__ unsigned xb_xcc_id() { return (unsigned)__builtin_amdgcn_s_getreg((3 << 11) | 20) & 0xFu; }
#define XB_SPIN(cond, bar) do { unsigned _sp = 0; while (cond) { __builtin_amdgcn_s_sleep(1); \
    if ((++_sp & 255u) == 0u) { if (xb_ld(&(bar)[XB_TMO])) break; if (_sp > XB_SPIN_CAP) { atomicAdd(&(bar)[XB_TMO], 1u); break; } } } } while (0)
struct XcdBarrier { unsigned* bar; unsigned x; volatile LAS unsigned* st; };
__device__ __forceinline__ XcdBarrier xcd_barrier_post(unsigned* bar, volatile LAS unsigned* st, int tid) {
  XcdBarrier b; b.bar = bar; b.x = xb_xcc_id(); b.st = st;
  if (tid == 0) (void)xb_add(&bar[XB_XCNT(b.x)], 1u);
  return b;
}
__device__ __forceinline__ void xcd_barrier_complete(unsigned* bar, unsigned x, unsigned& nloc, unsigned& nx) {
  const unsigned G = gridDim.x * gridDim.y * gridDim.z;
  unsigned sum, cnt, mine, sp = 0u;
  for (;;) {
    sum = 0u; cnt = 0u; mine = 0u;
#pragma unroll
    for (unsigned j = 0; j < 16; ++j) { const unsigned c = xb_ld(&bar[XB_XCNT(j)]); sum += c; cnt += (c > 0u) ? 1u : 0u; }
    if (sum == G) { mine = xb_ld(&bar[256 + 64 * x]); break; }
    __builtin_amdgcn_s_sleep(1);
    if ((++sp & 255u) == 0u) { if (xb_ld(&bar[XB_TMO])) break; if (sp > XB_SPIN_CAP) { atomicAdd(&bar[XB_TMO], 1u); break; } }
  }
  nloc = mine > 0u ? mine : 1u; nx = cnt > 0u ? cnt : 1u;
}
__device__ __forceinline__ void xcd_barrier(const XcdBarrier& b, int tid) {
  asm volatile("s_waitcnt vmcnt(0)" ::: "memory");
  __syncthreads();
  if (tid == 0) {
    unsigned* bar = b.bar;
    __builtin_amdgcn_s_waitcnt(0);
    unsigned nloc = b.st[0], nx = b.st[1];
    if (nloc == 0u) { xcd_barrier_complete(bar, b.x, nloc, nx); b.st[0] = nloc; b.st[1] = nx; }
    const unsigned old = xb_add(&bar[XB_XSUB(b.x)], 1u);
    const unsigned gen = old / nloc;
    if (old + 1u == (gen + 1u) * nloc) {
      __builtin_amdgcn_fence(__ATOMIC_RELEASE, "agent");
      asm volatile("s_waitcnt vmcnt(0)" ::: "memory");
      const unsigned og = xb_add(&bar[XB_TOP], 1u);
      const unsigned tg = og / nx;
      if (og + 1u == (tg + 1u) * nx) xb_add(&bar[XB_TOPGEN], 1u);
      else XB_SPIN(xb_ld(&bar[XB_TOPGEN]) == tg, bar);
      __builtin_amdgcn_fence(__ATOMIC_ACQUIRE, "agent");
      xb_add(&bar[XB_XGEN(b.x)], 1u);
      asm volatile("s_waitcnt vmcnt(0)" ::: "memory");
    } else {
      XB_SPIN(xb_ld(&bar[XB_XGEN(b.x)]) == gen, bar);
      __builtin_amdgcn_fence(__ATOMIC_ACQUIRE, "agent");
      asm volatile("s_waitcnt vmcnt(0)" ::: "memory");
    }
  }
  __syncthreads();
}

constexpr int BM = 256, BK = 64, HALF = 128, HTB = HALF * BK * 2, NXCD = 8;
__device__ __forceinline__ int lds_byte(int r, int c) { const int st = (r >> 4) * 2 + (c >> 5), rr = r & 15, cc = c & 31, ob = rr * 64 + cc * 2; return st * 1024 + (ob ^ (((ob >> 9) & 1) << 5)); }
__device__ __forceinline__ void stage_rc(int b, int& R, int& C) { const int st = b / 1024, sb = b % 1024, swz = sb ^ (((sb >> 9) & 1) << 5); R = (st >> 1) * 16 + swz / 64; C = (st & 1) * 32 + (swz % 64) / 2; }
__device__ __forceinline__ int perm32(int rho) { const int n = rho >> 4, i = rho & 15; return 8 * (i >> 2) + 4 * n + (i & 3); }

struct Unit { int pm, pn, a, b, ord; };
__device__ __forceinline__ int xcd_remap(int L, int nunits) { const int q = nunits / NXCD, r = nunits % NXCD, xcd = L % NXCD, off = L / NXCD; return (xcd < r ? xcd * (q + 1) : r * (q + 1) + (xcd - r) * q) + off; }
typedef f32x4 Acc[2][2][4][2];
template <class P, bool SP2>
__device__ __forceinline__ void gemm_phase(LAS unsigned char* lds, const P& p, int G, int c, int tid_in) {
  const int tid = tid_in, wid = __builtin_amdgcn_readfirstlane(tid >> 6), lane = tid & 63, wr = wid >> 2, wc = wid & 3, fr = lane & 15, fq = lane >> 4;
  const int K = p.K, nt = K / BK;
  const int nunits = p.nunits;
  const size_t kstep = (size_t)(BK * 2);
  const unsigned ldsw = (unsigned)wid * 1024u;
  const int aoff = lds_byte(wr * 64 + fr, P::F8 ? fq * 16 : fq * 8), boff = lds_byte(wc * 32 + fr, P::F8 ? fq * 16 : fq * 8);
#define PG8_SA(b, h) (((b) * 2 + (h)) * HTB)
#define PG8_SB(b, h) ((4 + (b) * 2 + (h)) * HTB)
#define PG8_STAGE(bufoff, gbase, voff) do { _Pragma("unroll") for (int _i = 0; _i < 2; ++_i) \
        __builtin_amdgcn_global_load_lds((const unsigned*)((const char*)(gbase) + (voff)[_i]), (LAS unsigned*)(lds + (bufoff) + ldsw + _i * 8192), 16, 0, 0); } while (0)
#define PG8_RD32(p_) __builtin_shufflevector(*(const LAS i32x4*)(p_), *(const LAS i32x4*)((p_) + 16), 0, 1, 2, 3, 4, 5, 6, 7)
#define PG8_LDA(dst, b, h) do { if constexpr (P::F8) { _Pragma("unroll") for (int m = 0; m < 4; ++m) dst##8[m] = PG8_RD32(lds + PG8_SA(b, h) + aoff + m * 2048); } \
        else { _Pragma("unroll") for (int m = 0; m < 4; ++m) _Pragma("unroll") for (int k = 0; k < 2; ++k) dst[m][k] = *(const LAS bf16x8*)(lds + PG8_SA(b, h) + aoff + m * 2048 + k * 1024); } } while (0)
#define PG8_LDB(dst, b, h) do { if constexpr (P::F8) { _Pragma("unroll") for (int n = 0; n < 2; ++n) dst##8[n] = PG8_RD32(lds + PG8_SB(b, h) + boff + n * 2048); } \
        else { _Pragma("unroll") for (int n = 0; n < 2; ++n) _Pragma("unroll") for (int k = 0; k < 2; ++k) dst[n][k] = *(const LAS bf16x8*)(lds + PG8_SB(b, h) + boff + n * 2048 + k * 1024); } } while (0)
#define PG8_MMA(ai, bj, At, Bt) do { __builtin_amdgcn_s_setprio(1); if constexpr (P::F8) { _Pragma("unroll") for (int m = 0; m < 4; ++m) _Pragma("unroll") for (int n = 0; n < 2; ++n) \
        acc[ai][bj][m][n] = __builtin_amdgcn_mfma_scale_f32_16x16x128_f8f6f4(Bt##8[n], At##8[m], acc[ai][bj][m][n], 0, 0, 0, P::SCALE_B, 0, 0x7F7F7F7F); } \
        else { _Pragma("unroll") for (int m = 0; m < 4; ++m) _Pragma("unroll") for (int n = 0; n < 2; ++n) _Pragma("unroll") for (int k = 0; k < 2; ++k) \
        acc[ai][bj][m][n] = __builtin_amdgcn_mfma_f32_16x16x32_bf16(Bt[n][k], At[m][k], acc[ai][bj][m][n], 0, 0, 0); } __builtin_amdgcn_s_setprio(0); } while (0)
#define PG8_WAIT_V(n) asm volatile("s_waitcnt vmcnt(" #n ")" ::: "memory")
#define PG8_WAIT_L(n) asm volatile("s_waitcnt lgkmcnt(" #n ")" ::: "memory")
#define PG8_BAR __builtin_amdgcn_s_barrier()
#define PG8_SCHED __builtin_amdgcn_sched_barrier(0)
#define PG8_DECODE(i, u) do { p.decode(P::CONTIG ? (u_lo + (i)) : xcd_remap((i) * G + c, nunits), u); u.ord = (i); } while (0)
#define PG8_HAS(i) (P::CONTIG ? (u_lo + (i) < u_hi) : ((i) * G + c < nunits))
#define PG8_OFFS(u, vA, vB) do { int _t = tid; asm volatile("" : "+v"(_t)); _Pragma("unroll") for (int _i = 0; _i < 2; ++_i) { int _R, _C; stage_rc(_t * 16 + _i * 8192, _R, _C); \
        const int _Rb = P::PERM ? ((_R & ~31) + perm32(_R & 31)) : _R; _Pragma("unroll") for (int _h = 0; _h < 2; ++_h) { \
        if (_h == 0 || !P::LINA) vA[_h][_i] = p.rowA(u, _h * HALF + _R) + (unsigned)(_C * 2); if (_h == 0 || !P::LINB) vB[_h][_i] = p.rowB(u, _h * HALF + _Rb) + (unsigned)(_C * 2); } } } while (0)
  const int vc_ = (G % 8 == 0) ? (c % 8) * (G / 8) + c / 8 : c;
  const int u_lo = (int)(((long)vc_ * nunits) / G), u_hi = (int)(((long)(vc_ + 1) * nunits) / G);
  if (!PG8_HAS(0)) return;
  Unit cur, nxt; int ui = 0;
  PG8_DECODE(0, cur);
  Acc acc; float zf_ = 0.f; asm volatile("" : "+v"(zf_));
#pragma unroll
  for (int a = 0; a < 2; ++a)
#pragma unroll
    for (int b = 0; b < 2; ++b)
#pragma unroll
      for (int m = 0; m < 4; ++m)
#pragma unroll
        for (int n = 0; n < 2; ++n) acc[a][b][m][n] = (f32x4){zf_, zf_, zf_, zf_};
  bf16x8 At[4][2], B0[2][2], B1[2][2]; i32x8 At8[4], B08[2], B18[2];
  unsigned vA[2][2], vB[2][2];
  PG8_OFFS(cur, vA, vB);
  const char* cA = p.baseA(cur); const char* cB = p.baseB(cur);
  const size_t hA = P::LINA ? p.halfA() : 0, hB = P::LINB ? p.halfB() : 0;
  if constexpr (SP2) {
    PG8_STAGE(PG8_SB(0, 0), cB, vB[0]); PG8_STAGE(PG8_SB(0, 1), (cB) + (P::LINB ? hB : 0), vB[P::LINB ? 0 : 1]); PG8_STAGE(PG8_SA(0, 0), cA, vA[0]); PG8_STAGE(PG8_SA(0, 1), (cA) + (P::LINA ? hA : 0), vA[P::LINA ? 0 : 1]);
    if (wr == 1) PG8_BAR;
    PG8_WAIT_V(2); PG8_BAR;
    PG8_STAGE(PG8_SB(1, 0), cB + kstep, vB[0]); PG8_STAGE(PG8_SA(1, 0), cA + kstep, vA[0]); PG8_STAGE(PG8_SB(1, 1), (cB + kstep) + (P::LINB ? hB : 0), vB[P::LINB ? 0 : 1]);
    PG8_WAIT_V(6); PG8_BAR;
  } else {
    PG8_STAGE(PG8_SB(0, 0), cB, vB[0]); PG8_STAGE(PG8_SA(0, 0), cA, vA[0]); PG8_STAGE(PG8_SB(0, 1), (cB) + (P::LINB ? hB : 0), vB[P::LINB ? 0 : 1]); PG8_STAGE(PG8_SA(0, 1), (cA) + (P::LINA ? hA : 0), vA[P::LINA ? 0 : 1]);
    if (wr == 1) PG8_BAR;
    PG8_WAIT_V(4); PG8_BAR;
    PG8_STAGE(PG8_SB(1, 0), cB + kstep, vB[0]); PG8_STAGE(PG8_SA(1, 0), cA + kstep, vA[0]); PG8_STAGE(PG8_SB(1, 1), (cB + kstep) + (P::LINB ? hB : 0), vB[P::LINB ? 0 : 1]);
    PG8_WAIT_V(6); PG8_BAR;
  }
  for (;;) {
    const bool has_next = PG8_HAS(ui + 1);
    if (has_next) PG8_DECODE(ui + 1, nxt);
    const char* nA = has_next ? p.baseA(nxt) : cA; const char* nB = has_next ? p.baseB(nxt) : cB;
    for (int t = 0; t < nt; t += 2) {
      const bool last = (t == nt - 2);
      const char* a1 = cA + (size_t)(t + 1) * kstep;
      const char* a2 = last ? nA : cA + (size_t)(t + 2) * kstep; const char* b2 = last ? nB : cB + (size_t)(t + 2) * kstep;
      const char* a3 = a2 + kstep; const char* b3 = b2 + kstep;
      if constexpr (SP2) {
        PG8_LDB(B0, 0, 0); PG8_LDB(B1, 0, 1); PG8_SCHED; PG8_LDA(At, 0, 0); PG8_STAGE(PG8_SA(1, 1), (a1) + (P::LINA ? hA : 0), vA[P::LINA ? 0 : 1]);
        PG8_WAIT_V(8); PG8_WAIT_L(0); PG8_BAR; PG8_MMA(0, 0, At, B0); PG8_MMA(0, 1, At, B1); PG8_BAR; PG8_SCHED;
        if (last && has_next) { PG8_OFFS(nxt, vA, vB); }
        PG8_LDA(At, 0, 1); PG8_STAGE(PG8_SB(0, 0), b2, vB[0]); PG8_STAGE(PG8_SB(0, 1), (b2) + (P::LINB ? hB : 0), vB[P::LINB ? 0 : 1]); PG8_STAGE(PG8_SA(0, 0), a2, vA[0]);
        PG8_WAIT_V(8); PG8_WAIT_L(0); PG8_BAR; PG8_MMA(1, 0, At, B0); PG8_MMA(1, 1, At, B1); PG8_BAR; PG8_SCHED;
        PG8_LDB(B0, 1, 0); PG8_LDB(B1, 1, 1); PG8_SCHED; PG8_LDA(At, 1, 0); PG8_STAGE(PG8_SA(0, 1), (a2) + (P::LINA ? hA : 0), vA[P::LINA ? 0 : 1]);
        PG8_WAIT_V(8); PG8_WAIT_L(0); PG8_BAR; PG8_MMA(0, 0, At, B0); PG8_MMA(0, 1, At, B1); PG8_BAR; PG8_SCHED;
        PG8_LDA(At, 1, 1); PG8_STAGE(PG8_SB(1, 0), b3, vB[0]); PG8_STAGE(PG8_SB(1, 1), (b3) + (P::LINB ? hB : 0), vB[P::LINB ? 0 : 1]); PG8_STAGE(PG8_SA(1, 0), a3, vA[0]);
        PG8_WAIT_V(8); PG8_WAIT_L(0); PG8_BAR; PG8_MMA(1, 0, At, B0); PG8_MMA(1, 1, At, B1); PG8_BAR; PG8_SCHED;
      } else {
        PG8_LDB(B0, 0, 0); PG8_SCHED; PG8_LDA(At, 0, 0); PG8_STAGE(PG8_SA(1, 1), (a1) + (P::LINA ? hA : 0), vA[P::LINA ? 0 : 1]);
        PG8_WAIT_L(8); PG8_BAR; PG8_WAIT_L(0); PG8_MMA(0, 0, At, B0); PG8_BAR; PG8_SCHED;
        if (last && has_next) { PG8_OFFS(nxt, vA, vB); }
        PG8_LDB(B1, 0, 1); PG8_STAGE(PG8_SB(0, 0), b2, vB[0]);
        PG8_BAR; PG8_WAIT_L(0); PG8_MMA(0, 1, At, B1); PG8_BAR;
        PG8_LDA(At, 0, 1); PG8_STAGE(PG8_SA(0, 0), a2, vA[0]);
        PG8_BAR; PG8_WAIT_L(0); PG8_MMA(1, 0, At, B0); PG8_BAR; PG8_SCHED;
        PG8_STAGE(PG8_SB(0, 1), (b2) + (P::LINB ? hB : 0), vB[P::LINB ? 0 : 1]);
        PG8_WAIT_V(6); PG8_BAR; PG8_MMA(1, 1, At, B1); PG8_BAR;
        PG8_LDB(B0, 1, 0); PG8_SCHED; PG8_LDA(At, 1, 0); PG8_STAGE(PG8_SA(0, 1), (a2) + (P::LINA ? hA : 0), vA[P::LINA ? 0 : 1]);
        PG8_WAIT_L(8); PG8_BAR; PG8_WAIT_L(0); PG8_MMA(0, 0, At, B0); PG8_BAR; PG8_SCHED;
        PG8_LDB(B1, 1, 1); PG8_STAGE(PG8_SB(1, 0), b3, vB[0]);
        PG8_BAR; PG8_WAIT_L(0); PG8_MMA(0, 1, At, B1); PG8_BAR;
        PG8_LDA(At, 1, 1); PG8_STAGE(PG8_SA(1, 0), a3, vA[0]);
        PG8_BAR; PG8_WAIT_L(0); PG8_MMA(1, 0, At, B0); PG8_BAR; PG8_SCHED;
        PG8_STAGE(PG8_SB(1, 1), (b3) + (P::LINB ? hB : 0), vB[P::LINB ? 0 : 1]);
        PG8_WAIT_V(6); PG8_BAR; PG8_MMA(1, 1, At, B1); PG8_BAR;
      }
    }
    if constexpr (P::ALIGN) { if (wr == 0) PG8_BAR; }
    { int fr_e = fr, fq_e = fq; asm volatile("" : "+v"(fr_e), "+v"(fq_e)); p.epi(acc, cur, wr, wc, fr_e, fq_e); }
    if (!has_next) break;
    zf_ = 0.f; asm volatile("" : "+v"(zf_));
#pragma unroll
    for (int a = 0; a < 2; ++a)
#pragma unroll
      for (int b = 0; b < 2; ++b)
#pragma unroll
        for (int m = 0; m < 4; ++m)
#pragma unroll
          for (int n = 0; n < 2; ++n) acc[a][b][m][n] = (f32x4){zf_, zf_, zf_, zf_};
    cur = nxt; cA = nA; cB = nB; ++ui;
    if constexpr (P::ALIGN) { if (wr == 1) PG8_BAR; }
  }
  PG8_WAIT_V(0);
  if constexpr (!P::ALIGN) { if (wr == 0) PG8_BAR; }
  PG8_BAR;
#undef PG8_SA
#undef PG8_SB
#undef PG8_STAGE
#undef PG8_RD32
#undef PG8_LDA
#undef PG8_LDB
#undef PG8_MMA
#undef PG8_WAIT_V
#undef PG8_WAIT_L
#undef PG8_BAR
#undef PG8_SCHED
#undef PG8_DECODE
#undef PG8_HAS
#undef PG8_OFFS
}
}
namespace mk {
constexpr size_t MiB = 1u << 20;
constexpr size_t WS_CTL = 0, CTL_ZERO_BYTES = 65536;
constexpr size_t WS_MOD = 65536;
constexpr size_t WS_LAML = 262144;
constexpr size_t WS_WIN_T = 1 * MiB, WS_WGLU_T = 5 * MiB, WS_WMIX_T = 6 * MiB, WS_WFOUR_T = 8 * MiB, WS_WROUT_T = 10 * MiB;
constexpr size_t WS_DMT = 10 * MiB + 512 * 1024, WS_W1 = 10 * MiB + 768 * 1024, WS_W2 = 10 * MiB + 896 * 1024;
constexpr size_t WS_WEXP = 12 * MiB, EXP_STRIDE = 3 * MiB / 2, EXP_DOFF = 1 * MiB;
constexpr size_t WS_R = 110 * MiB;
constexpr size_t WS_WS = WS_R, WS_TT = WS_R + 8 * MiB, WS_A0 = WS_R + 34 * MiB, WS_AS5 = WS_R + 67 * MiB, WS_Q = WS_R + 103 * MiB, WS_K = WS_R + 119 * MiB,
                 WS_VT = WS_R + 136 * MiB, WS_SST = WS_R + 153 * MiB, WS_GB = WS_R + 177 * MiB, WS_CONCAT = WS_R + 193 * MiB;
constexpr size_t WS_F = WS_R, WS_LTOK = WS_R + 32 * MiB, WS_ASG = WS_R + 36 * MiB, WS_HID = WS_R + 42 * MiB, WS_YAS = WS_R + 130 * MiB,
                 WS_A1 = WS_R + 306 * MiB;
constexpr size_t WS_X1 = WS_R, WS_X2 = WS_R + 64 * MiB, WS_FB = WS_R + 128 * MiB;
constexpr size_t WS_HOPT = WS_R + 338 * MiB;
constexpr size_t WS_NEED = WS_R + 338 * MiB;
constexpr int HALF_CAP_ROWS = 90112;
constexpr int CW_BAR = 4096, CW_CNT = 8192  , CW_DQ0 = 12288, CW_DQ1 = 12352;

struct Args { const float* in[31]; float* h; unsigned char* ws; int ph_lo, ph_hi, flags, pad; };
enum { IN_X = 0, IN_C, IN_CTX, IN_CCTX, IN_WADA, IN_BADA, IN_WIN, IN_LRE, IN_LIM, IN_LDT, IN_BRE, IN_BIM, IN_CRE, IN_CIM, IN_S5D, IN_WGLU, IN_BGLU, IN_QG, IN_KG,
       IN_RPB, IN_WMIX, IN_WFOUR, IN_BFOUR, IN_WROUT, IN_RBIAS, IN_WEG, IN_WEU, IN_WED, IN_WSG, IN_WSU, IN_WSD };
constexpr int FLAG_SKIP_EXPERTS = 1;

struct Ctx {
  LAS unsigned char* lds; const Args* a; unsigned char* ws; int tid, lane, wave, G, c;
};

__device__ __forceinline__ u32x4 pack8(const f32x4& v0, const f32x4& v1) { u32x4 w; w.x = cvt_pk_bf16(v0[0], v0[1]); w.y = cvt_pk_bf16(v0[2], v0[3]); w.z = cvt_pk_bf16(v1[0], v1[1]); w.w = cvt_pk_bf16(v1[2], v1[3]); return w; }
__device__ __forceinline__ int rowmap(int code, int n) {
  if (code == 1) { if (n < 512 || n >= 1536) return n; const int blk = n & ~255, c = n & 255; return blk + 128 * ((c >> 5) & 1) + 32 * (c >> 6) + (c & 31); }
  if (code == 2) return 256 * (n >> 7) + (n & 127);
  if (code == 3) return 256 * (n >> 7) + 128 + (n & 127);
  return n;
}
__device__ __forceinline__ void transpose_item(const float* W, int K, int N, bf16_t* WT, int code, LAS unsigned char* scr, int item, int lane) {
  const int nblk = N / 64, kb = item / nblk, nb = item % nblk, k0 = 64 * kb, n0 = 64 * nb;
  const int q = lane >> 4, a = lane & 15;
  f32x4 v[16];
  const float* src = W + (size_t)(k0 + 2 * q) * N + n0 + 4 * a;
#pragma unroll
  for (int i = 0; i < 16; ++i) v[i] = *(const f32x4*)(src + (size_t)((i & 1) + 8 * (i >> 1)) * N);
#pragma unroll
  for (int ii = 0; ii < 8; ++ii) { const int dsw = q + 4 * (ii ^ (a & 7));
#pragma unroll
    for (int j = 0; j < 4; ++j) *(LAS unsigned*)(scr + (4 * a + j) * 128 + 4 * dsw) = cvt_pk_bf16(v[2 * ii][j], v[2 * ii + 1][j]); }
  asm volatile("s_waitcnt lgkmcnt(0)" ::: "memory");
  const int c = lane & 7;
#pragma unroll
  for (int jj = 0; jj < 8; ++jj) { const int n = (lane >> 3) + 8 * jj, cs = c ^ ((n >> 2) & 7);
    const u32x4 o = *(const LAS u32x4*)(scr + n * 128 + 16 * cs);
    *(u32x4*)(WT + (size_t)rowmap(code, n0 + n) * K + k0 + 8 * c) = o; }
  asm volatile("s_waitcnt lgkmcnt(0)" ::: "memory");
}
__device__ __forceinline__ void transpose_item8(const float* W, int K, int N, unsigned char* WT, int code, float scale, LAS unsigned char* scr, int item, int lane) {
  const int nblk = N / 64, kb = item / nblk, nb = item % nblk, k0 = 64 * kb, n0 = 64 * nb;
  const int q = lane >> 4, a = lane & 15;
  f32x4 v[16];
  const float* src = W + (size_t)(k0 + 4 * q) * N + n0 + 4 * a;
#pragma unroll
  for (int i = 0; i < 16; ++i) v[i] = *(const f32x4*)(src + (size_t)((i & 3) + 16 * (i >> 2)) * N);
#pragma unroll
  for (int ib = 0; ib < 4; ++ib) { const int dsw = q + 4 * (ib ^ (a & 3));
#pragma unroll
    for (int j = 0; j < 4; ++j) { int w = 0; w = __builtin_amdgcn_cvt_pk_fp8_f32(v[4 * ib][j] * scale, v[4 * ib + 1][j] * scale, w, false); w = __builtin_amdgcn_cvt_pk_fp8_f32(v[4 * ib + 2][j] * scale, v[4 * ib + 3][j] * scale, w, true);
      *(LAS int*)(scr + (4 * a + j) * 64 + 4 * dsw) = w; } }
  asm volatile("s_waitcnt lgkmcnt(0)" ::: "memory");
  const int c = lane & 3;
#pragma unroll
  for (int jj = 0; jj < 4; ++jj) { const int n = (lane >> 2) + 16 * jj, cs = c ^ ((n >> 2) & 3);
    const u32x4 o = *(const LAS u32x4*)(scr + n * 64 + 16 * cs);
    *(u32x4*)(WT + (size_t)rowmap(code, n0 + n) * K + k0 + 16 * c) = o; }
  asm volatile("s_waitcnt lgkmcnt(0)" ::: "memory");
}
constexpr int IT_WIN = 512, IT_GLU = 64, IT_MIX = 256, IT_FOUR = 256, IT_ROUT = 32, IT_SMALL = IT_WIN + IT_GLU + IT_MIX + IT_FOUR + IT_ROUT, IT_EXP = 192;
__device__ __forceinline__ void small_item(const Ctx& X, LAS unsigned char* scr, int it) {
  const Args& a = *X.a; unsigned char* ws = X.ws;
  if (it < IT_WIN) { transpose_item(a.in[IN_WIN], 1024, 2048, (bf16_t*)(ws + WS_WIN_T), 1, scr, it, X.lane); return; } it -= IT_WIN;
  if (it < IT_GLU) { transpose_item(a.in[IN_WGLU], 512, 512, (bf16_t*)(ws + WS_WGLU_T), 0, scr, it, X.lane); return; } it -= IT_GLU;
  if (it < IT_MIX) { transpose_item(a.in[IN_WMIX], 1024, 1024, (bf16_t*)(ws + WS_WMIX_T), 0, scr, it, X.lane); return; } it -= IT_MIX;
  if (it < IT_FOUR) { transpose_item(a.in[IN_WFOUR], 1024, 1024, (bf16_t*)(ws + WS_WFOUR_T), 0, scr, it, X.lane); return; } it -= IT_FOUR;
  { const int l = it >> 4; transpose_item(a.in[IN_WROUT] + (size_t)l * 1024 * 64, 1024, 64, (bf16_t*)(ws + WS_WROUT_T) + (size_t)l * 64 * 1024, 0, scr, it & 15, X.lane); }
}
__device__ __forceinline__ void expert_item(const Ctx& X, LAS unsigned char* scr, int layer, int it) {
  const Args& a = *X.a; const int e = it / IT_EXP, r = it % IT_EXP;
  bf16_t* gu = (bf16_t*)(X.ws + WS_WEXP + (size_t)e * EXP_STRIDE); bf16_t* dt = (bf16_t*)(X.ws + WS_WEXP + (size_t)e * EXP_STRIDE + EXP_DOFF);
  const float *wg, *wu, *wd;
  if (e < 64) { const size_t o = ((size_t)layer * 64 + e) * 262144; wg = a.in[IN_WEG] + o; wu = a.in[IN_WEU] + o; wd = a.in[IN_WED] + o; }
  else { const size_t o = (size_t)layer * 262144; wg = a.in[IN_WSG] + o; wu = a.in[IN_WSU] + o; wd = a.in[IN_WSD] + o; }
  if (r < 64) transpose_item8(wg, 1024, 256, (unsigned char*)gu, 2, 32.f, scr, r, X.lane);
  else if (r < 128) transpose_item8(wu, 1024, 256, (unsigned char*)gu, 3, 32.f, scr, r - 64, X.lane);
  else transpose_item(wd, 256, 1024, dt, 0, scr, r - 128, X.lane);
}
__device__ __forceinline__ void transpose_work(const Ctx& X, unsigned* ctr, int first_small, int n_small, int layer, int n_exp_items) {
  LAS unsigned char* scr = X.lds + X.wave * 8192;
  volatile LAS int* shb = (volatile LAS int*)(X.lds + LDS_MISC_OFF + 1024);
  const int total = n_small + n_exp_items;
  for (;;) {
    __syncthreads();
    if (X.tid == 0) shb[0] = (int)atomicAdd(ctr, 32u);
    __syncthreads();
    const int base = shb[0];
    if (base >= total) break;
    for (int k = 0; k < 4; ++k) { const int it = base + X.wave * 4 + k; if (it >= total) break;
      if (it < n_small) small_item(X, scr, first_small + it); else expert_item(X, scr, layer, it - n_small); }
  }
}

__device__ __forceinline__ void p0_adaln(const Ctx& X, int it) {
  const Args& a = *X.a; const int layer = it / 48, ct = it % 48, col = ct * 128 + X.lane;
  LAS float* sl = (LAS float*)X.lds;
  for (int i = X.tid; i < 2048; i += NTHR) { const float v = i < 1024 ? a.in[IN_C][i] : a.in[IN_CCTX][i - 1024]; sl[i] = v / (1.f + __expf(-v)); }
  __syncthreads();
  const float* W = a.in[IN_WADA] + (size_t)layer * 1024 * 6144 + col;
  float a0 = 0.f, a1 = 0.f, b0 = 0.f, b1 = 0.f; const int k0 = X.wave * 128;
#pragma unroll 16
  for (int k = 0; k < 128; ++k) { const float w0 = W[(size_t)(k0 + k) * 6144], w1 = W[(size_t)(k0 + k) * 6144 + 64]; const float s0 = sl[k0 + k], s1 = sl[1024 + k0 + k];
    a0 += s0 * w0; a1 += s1 * w0; b0 += s0 * w1; b1 += s1 * w1; }
  LAS float* red = sl + 2048;
  red[(X.wave * 128 + X.lane) * 2] = a0; red[(X.wave * 128 + X.lane) * 2 + 1] = a1; red[(X.wave * 128 + 64 + X.lane) * 2] = b0; red[(X.wave * 128 + 64 + X.lane) * 2 + 1] = b1;
  __syncthreads();
  if (X.tid < 256) { const int l = X.tid & 127, v = X.tid >> 7; float s = 0.f;
#pragma unroll
    for (int w = 0; w < 8; ++w) s += red[(w * 128 + l) * 2 + v];
    s += a.in[IN_BADA][layer * 6144 + ct * 128 + l];
    float* mod = (float*)(X.ws + WS_MOD);
    if (layer == 0) mod[v * 6144 + ct * 128 + l] = s; else if (v == 0) mod[2 * 6144 + ct * 128 + l] = s; }
  __syncthreads();
}

__device__ __forceinline__ void p0_s5tables(const Ctx& X, int g, int part) {
  const Args& a = *X.a;
  LAS f32x2* POW = (LAS f32x2*)X.lds;
  LAS f32x2* BB = (LAS f32x2*)(X.lds + 33792);
  LAS f32x2* CC = (LAS f32x2*)(X.lds + 33792 + 16384);
  LAS float* KK = (LAS float*)(X.lds + 33792 + 32768);
  LAS float* DD = (LAS float*)(X.lds + 33792 + 32768 + 65536);
  const int tid = X.tid;
  if (tid < 128) {
    const int dir = tid >> 6, p = tid & 63, idx = (dir * 32 + g) * 64 + p;
    const float lr = fminf(a.in[IN_LRE][idx], -1e-4f), li = a.in[IN_LIM][idx], dt = expf(a.in[IN_LDT][dir * 32 + g]);
    for (int tau = 0; tau <= 32; ++tau) { const float mg = expf(lr * dt * (float)tau); float sn, cs; sincospif(li * dt * (float)tau * 0.318309886183790672f, &sn, &cs); POW[(dir * 33 + tau) * 64 + p] = (f32x2){mg * cs, mg * sn}; }
    const f32x2 l1 = POW[(dir * 33 + 1) * 64 + p], l32 = POW[(dir * 33 + 32) * 64 + p];
    if (part == 0) ((float2*)(X.ws + WS_LAML))[idx] = make_float2(l32.x, l32.y);
    const float nr = l1.x - 1.f, ni = l1.y, den = lr * lr + li * li, cr = (nr * lr + ni * li) / den, ci = (ni * lr - nr * li) / den;
    for (int c = 0; c < 16; ++c) { const float xr = a.in[IN_BRE][idx * 16 + c], xi = a.in[IN_BIM][idx * 16 + c]; BB[(dir * 64 + p) * 16 + c] = (f32x2){cr * xr - ci * xi, cr * xi + ci * xr}; }
  }
  for (int i = tid; i < 2048; i += NTHR) { const int dir = i >> 10, c = (i >> 6) & 15, p = i & 63; const int gi = ((dir * 32 + g) * 16 + c) * 64 + p; CC[i] = (f32x2){a.in[IN_CRE][gi], a.in[IN_CIM][gi]}; }
  if (tid < 16) DD[tid] = a.in[IN_S5D][g * 16 + tid];
  __syncthreads();
  for (int combo = tid; combo < 1024; combo += NTHR) {
    const int dir = combo >> 9, tau = (combo >> 4) & 31, c = combo & 15;
    float accv[16];
#pragma unroll
    for (int j = 0; j < 16; ++j) accv[j] = 0.f;
#pragma unroll 2
    for (int p = 0; p < 64; ++p) {
      const f32x2 cc = CC[(dir * 16 + c) * 64 + p], pw = POW[(dir * 33 + tau) * 64 + p];
      const float zr = cc.x * pw.x - cc.y * pw.y, zi = cc.x * pw.y + cc.y * pw.x;
      const LAS f32x4* bp = (const LAS f32x4*)(BB + (dir * 64 + p) * 16);
#pragma unroll
      for (int j = 0; j < 8; ++j) { const f32x4 b = bp[j]; accv[2 * j] += zr * b.x - zi * b.y; accv[2 * j + 1] += zr * b.z - zi * b.w; }
    }
#pragma unroll
    for (int j = 0; j < 4; ++j) *(LAS f32x4*)(KK + ((dir * 32 + tau) * 16 + c) * 16 + 4 * j) = (f32x4){accv[4 * j], accv[4 * j + 1], accv[4 * j + 2], accv[4 * j + 3]};
  }
  __syncthreads();
  bf16_t* TT = (bf16_t*)(X.ws + WS_TT) + (size_t)g * 512 * 768;
  for (int q = part * 12288 + tid; q < (part + 1) * 12288; q += NTHR) {
    const int row = q / 96, cc8 = q % 96, i = row >> 4, c = row & 15; f32x4 v0, v1;
    if (cc8 < 64) {
      const int s = cc8 >> 1, c0 = (cc8 & 1) * 8;
      const int dir = s < i ? 0 : 1, tau = s < i ? i - s : s - i;
      const LAS f32x4* kp = (const LAS f32x4*)(KK + ((dir * 32 + tau) * 16 + c) * 16 + c0);
      v0 = kp[0]; v1 = kp[1];
      if (s == i) { const LAS f32x4* k0p = (const LAS f32x4*)(KK + ((0 * 32 + 0) * 16 + c) * 16 + c0); v0 += k0p[0]; v1 += k0p[1];
        const float d = DD[c]; const int dj = c - c0;
        if (dj >= 0 && dj < 4) v0[dj] += d; else if (dj >= 4 && dj < 8) v1[dj - 4] += d; }
    } else {
      const int kk = (cc8 - 64) * 8, dir = kk >> 7, ri = (kk >> 6) & 1, p0 = kk & 63, tau = dir == 0 ? i + 1 : 32 - i;
      const LAS f32x4* cp = (const LAS f32x4*)(CC + (dir * 16 + c) * 64 + p0); const LAS f32x4* pp = (const LAS f32x4*)(POW + (dir * 33 + tau) * 64 + p0);
      float v[8];
#pragma unroll
      for (int j = 0; j < 4; ++j) { const f32x4 cc = cp[j], pw = pp[j];
        v[2 * j] = ri == 0 ? (cc.x * pw.x - cc.y * pw.y) : -(cc.x * pw.y + cc.y * pw.x); v[2 * j + 1] = ri == 0 ? (cc.z * pw.z - cc.w * pw.w) : -(cc.z * pw.w + cc.w * pw.z); }
      v0 = (f32x4){v[0], v[1], v[2], v[3]}; v1 = (f32x4){v[4], v[5], v[6], v[7]};
    }
    *(u32x4*)(TT + (size_t)row * 768 + cc8 * 8) = pack8(v0, v1);
  }
  bf16_t* WSm = (bf16_t*)(X.ws + WS_WS) + (size_t)g * 256 * 512;
  for (int q = part * 4096 + tid; q < (part + 1) * 4096; q += NTHR) {
    const int n = q >> 6, cc8 = q & 63, dir = n >> 7, ri = (n >> 6) & 1, p = n & 63, s = cc8 >> 1, c0 = (cc8 & 1) * 8, tau = dir == 0 ? 31 - s : s;
    const f32x2 pw = POW[(dir * 33 + tau) * 64 + p]; const LAS f32x4* bp = (const LAS f32x4*)(BB + (dir * 64 + p) * 16 + c0); float v[8];
#pragma unroll
    for (int j = 0; j < 4; ++j) { const f32x4 b = bp[j]; v[2 * j] = ri == 0 ? (pw.x * b.x - pw.y * b.y) : (pw.x * b.y + pw.y * b.x); v[2 * j + 1] = ri == 0 ? (pw.x * b.z - pw.y * b.w) : (pw.x * b.w + pw.y * b.z); }
    *(u32x4*)(WSm + (size_t)n * 512 + cc8 * 8) = pack8((f32x4){v[0], v[1], v[2], v[3]}, (f32x4){v[4], v[5], v[6], v[7]});
  }
  __syncthreads();
}

__device__ __forceinline__ void p0_dftconst(const Ctx& X, int idx) {
  for (int q = idx * NTHR + X.tid; q < 32768; q += 32 * NTHR) {
    float v[8]; bf16_t* dst;
    if (q < 16384) {
      const int R = q >> 5, c0 = (q & 31) * 8, ri = R >> 8, m = R & 255; dst = (bf16_t*)(X.ws + WS_DMT) + (size_t)R * 256 + c0;
#pragma unroll
      for (int j = 0; j < 8; ++j) { float s, c; sincospif((float)(((c0 + j) * m) & 255) * (1.f / 128.f), &s, &c); v[j] = ri == 0 ? c : -s; }
    } else if (q < 24576) {
      const int q2 = q - 16384, R = q2 >> 5, c0 = (q2 & 31) * 8, rip = R >> 7, ka = R & 127; dst = (bf16_t*)(X.ws + WS_W1) + (size_t)R * 256 + c0;
#pragma unroll
      for (int j = 0; j < 8; ++j) { const int C = c0 + j, ri = C >> 7, ta = C & 127; float s, c; sincospif((float)((ka * ta) & 127) * (1.f / 64.f), &s, &c);
        v[j] = (rip == ri) ? c : (rip == 0 ? s : -s); }
    } else {
      const int q2 = q - 24576, R = q2 >> 5, c0 = (q2 & 31) * 8; dst = (bf16_t*)(X.ws + WS_W2) + (size_t)R * 256 + c0;
#pragma unroll
      for (int j = 0; j < 8; ++j) { const int C = c0 + j, rip = C >> 7, tb = C & 127; float s, c; sincospif((float)((R * tb) & 127) * (1.f / 64.f), &s, &c);
        v[j] = R < 128 ? (rip == 0 ? c : s) * (1.f / 2048.f) : 0.f; }
    }
    u32x4 o; o.x = cvt_pk_bf16(v[0], v[1]); o.y = cvt_pk_bf16(v[2], v[3]); o.z = cvt_pk_bf16(v[4], v[5]); o.w = cvt_pk_bf16(v[6], v[7]);
    *(u32x4*)dst = o;
  }
}

__device__ __forceinline__ void phase_prep(const Ctx& X, int rep) {
  const int c = X.c;
  if (c < 96) p0_adaln(X, c);
  else if (c < 224) p0_s5tables(X, (c - 96) >> 2, (c - 96) & 3);
  else p0_dftconst(X, c - 224);
  __syncthreads();
  unsigned* ctl = (unsigned*)(X.ws + WS_CTL);
  transpose_work(X, ctl + CW_DQ0 + 128 * rep, 0, IT_SMALL, (X.a->flags & 2) ? 1 : 0, (X.a->flags & FLAG_SKIP_EXPERTS) ? 0 : 65 * IT_EXP);
}

__device__ __forceinline__ void modulate_row(const float* hrow, const float* shift, const float* scale, bf16_t* orow, int lane) {
  const f32x4* xr = (const f32x4*)hrow + lane; f32x4 v[4]; float ss = 0.f;
#pragma unroll
  for (int j = 0; j < 4; ++j) { v[j] = xr[64 * j]; ss += (v[j].x * v[j].x + v[j].y * v[j].y) + (v[j].z * v[j].z + v[j].w * v[j].w); }
  const float r = rsqrtf(wave_sum(ss) * (1.f / 1024.f) + 1e-6f);
  u32x2* o8 = (u32x2*)orow + lane;
#pragma unroll
  for (int j = 0; j < 4; ++j) { const f32x4 sh = ((const f32x4*)shift)[lane + 64 * j], sc = ((const f32x4*)scale)[lane + 64 * j];
    u32x2 w; w.x = cvt_pk_bf16(v[j].x * r * (1.f + sc.x) + sh.x, v[j].y * r * (1.f + sc.y) + sh.y); w.y = cvt_pk_bf16(v[j].z * r * (1.f + sc.z) + sh.z, v[j].w * r * (1.f + sc.w) + sh.w);
    o8[64 * j] = w; }
}
__device__ __forceinline__ void phase_mod0(const Ctx& X) {
  const Args& a = *X.a; const float* mod = (const float*)(X.ws + WS_MOD); bf16_t* A0 = (bf16_t*)(X.ws + WS_A0);
  const int gw = X.c * NWAVES + X.wave, NGW = X.G * NWAVES;
  for (int r = gw; r < NROW; r += NGW) {
    if (r < TOK) modulate_row(a.in[IN_X] + (size_t)r * 1024, mod, mod + 1024, A0 + (size_t)r * 1024, X.lane);
    else modulate_row(a.in[IN_CTX] + (size_t)(r - TOK) * 1024, mod + 6144, mod + 6144 + 1024, A0 + (size_t)r * 1024, X.lane);
  }
}


struct G1 {
  static constexpr bool PERM = true; static constexpr bool F8 = false; static constexpr int SCALE_B = 0x7A7A7A7A; static constexpr bool CONTIG = false; static constexpr bool ALIGN = true; static constexpr bool LINA = true, LINB = true; __device__ __forceinline__ size_t halfA() const { return 128u * 2048u; } __device__ __forceinline__ size_t halfB() const { return 128u * 2048u; } int K, nunits; unsigned char* ws; const float* qg; const float* kg;
  __device__ __forceinline__ void decode(int w, Unit& u) const { if (w < 390) { u.a = 0; u.pm = w / 6; u.pn = w % 6; } else { const int w2 = w - 390; u.a = 1; u.pm = w2 & 1; u.pn = w2 >> 1; } u.b = 0; }
  __device__ __forceinline__ const char* baseA(const Unit& u) const { return (const char*)ws + (u.a == 0 ? WS_A0 : WS_WIN_T + (size_t)1536 * 2048); }
  __device__ __forceinline__ const char* baseB(const Unit& u) const { return (const char*)ws + (u.a == 0 ? WS_WIN_T : WS_A0); }
  __device__ __forceinline__ unsigned rowA(const Unit& u, int r) const { return (unsigned)(u.pm * 256 + r) * 2048u; }
  __device__ __forceinline__ unsigned rowB(const Unit& u, int r) const { return (unsigned)(u.pn * 256 + r) * 2048u; }
  __device__ __forceinline__ void epi(const Acc& acc, const Unit& u, int wr, int wc, int fr, int fq) const {
    if (u.a == 1) {
      bf16_t* VT = (bf16_t*)(ws + WS_VT);
#pragma unroll
      for (int ai = 0; ai < 2; ++ai)
#pragma unroll
        for (int m = 0; m < 4; ++m) { const int d = u.pm * 256 + ai * 128 + wr * 64 + m * 16 + fr;
#pragma unroll
          for (int bj = 0; bj < 2; ++bj) { const int t0 = u.pn * 256 + bj * 128 + wc * 32 + 8 * fq; *(u32x4*)(VT + (size_t)d * NROW + t0) = pack8(acc[ai][bj][m][0], acc[ai][bj][m][1]); } }
      return;
    }
    if (u.pn < 2) {
      bf16_t* AS5 = (bf16_t*)(ws + WS_AS5);
#pragma unroll
      for (int ai = 0; ai < 2; ++ai)
#pragma unroll
        for (int m = 0; m < 4; ++m) { const int row = u.pm * 256 + ai * 128 + wr * 64 + m * 16 + fr; int crow, s;
          if (row < TOK) { crow = row >> 5; s = row & 31; } else { const int j = row - TOK; crow = 512 + (j >> 5); s = j & 31; }
#pragma unroll
          for (int bj = 0; bj < 2; ++bj) { const int g = 16 * u.pn + 8 * bj + 2 * wc + (fq >> 1), c0 = 8 * (fq & 1);
            *(u32x4*)(AS5 + ((size_t)(g * 768 + crow) * 768 + s * 16 + c0)) = pack8(acc[ai][bj][m][0], acc[ai][bj][m][1]); } }
      return;
    }
    const bool isq = u.pn < 4;
    if (isq && u.pm == 64) return;
    const int head = 4 * ((u.pn - 2) & 1) + wc; const float* gain = isq ? qg : kg;
    bf16_t* dst = isq ? (bf16_t*)(ws + WS_Q) : (bf16_t*)(ws + WS_K);
    f32x4 gv[2][2];
#pragma unroll
    for (int bj = 0; bj < 2; ++bj) { gv[bj][0] = *(const f32x4*)(gain + 32 * bj + 8 * fq); gv[bj][1] = *(const f32x4*)(gain + 32 * bj + 8 * fq + 4); }
#pragma unroll
    for (int ai = 0; ai < 2; ++ai)
#pragma unroll
      for (int m = 0; m < 4; ++m) { const int row = u.pm * 256 + ai * 128 + wr * 64 + m * 16 + fr; float ss = 0.f;
#pragma unroll
        for (int bj = 0; bj < 2; ++bj)
#pragma unroll
          for (int n = 0; n < 2; ++n) { const f32x4 x = acc[ai][bj][m][n]; ss += (x[0] * x[0] + x[1] * x[1]) + (x[2] * x[2] + x[3] * x[3]); }
        ss += sx(ss, 16); ss += sx(ss, 32);
        const float rinv = rsqrtf(ss * (1.f / 64.f) + 1e-6f);
#pragma unroll
        for (int bj = 0; bj < 2; ++bj) { const f32x4 v0 = acc[ai][bj][m][0] * rinv * gv[bj][0], v1 = acc[ai][bj][m][1] * rinv * gv[bj][1];
          *(u32x4*)(dst + (size_t)row * 512 + head * 64 + 32 * bj + 8 * fq) = pack8(v0, v1); } }
  }
};

struct G2 {
  static constexpr bool PERM = true; static constexpr bool F8 = false; static constexpr int SCALE_B = 0x7A7A7A7A; static constexpr bool CONTIG = false; static constexpr bool ALIGN = true; static constexpr bool LINA = true, LINB = true; __device__ __forceinline__ size_t halfA() const { return 128u * 1536u; } __device__ __forceinline__ size_t halfB() const { return 128u * 1024u; } int K, nunits; unsigned char* ws;
  __device__ __forceinline__ void decode(int w, Unit& u) const { u.a = w / 3; u.pm = w % 3; u.pn = 0; u.b = 0; }
  __device__ __forceinline__ const char* baseA(const Unit& u) const { return (const char*)ws + WS_AS5 + (size_t)u.a * 768 * 768 * 2; }
  __device__ __forceinline__ const char* baseB(const Unit& u) const { return (const char*)ws + WS_WS + (size_t)u.a * 256 * 512 * 2; }
  __device__ __forceinline__ unsigned rowA(const Unit& u, int r) const { return (unsigned)(u.pm * 256 + r) * 1536u; }
  __device__ __forceinline__ unsigned rowB(const Unit& u, int r) const { return (unsigned)r * 1024u; }
  __device__ __forceinline__ void epi(const Acc& acc, const Unit& u, int wr, int wc, int fr, int fq) const {
    float* SST = (float*)(ws + WS_SST) + (size_t)u.a * 768 * 256;
#pragma unroll
    for (int ai = 0; ai < 2; ++ai)
#pragma unroll
      for (int m = 0; m < 4; ++m) { const int crow = u.pm * 256 + ai * 128 + wr * 64 + m * 16 + fr; if (crow >= 520) continue;
#pragma unroll
        for (int bj = 0; bj < 2; ++bj) { float* p = SST + (size_t)crow * 256 + bj * 128 + wc * 32 + 8 * fq; *(f32x4*)p = acc[ai][bj][m][0]; *(f32x4*)(p + 4) = acc[ai][bj][m][1]; } }
  }
};

struct G3 {
  static constexpr bool PERM = true; static constexpr bool F8 = false; static constexpr int SCALE_B = 0x7A7A7A7A; static constexpr bool CONTIG = false; static constexpr bool ALIGN = true; static constexpr bool LINA = true, LINB = true; __device__ __forceinline__ size_t halfA() const { return 128u * 1536u; } __device__ __forceinline__ size_t halfB() const { return 128u * 1536u; } int K, nunits; unsigned char* ws;
  __device__ __forceinline__ void decode(int w, Unit& u) const { u.a = w >> 2; u.pm = (w >> 1) & 1; u.pn = w & 1; u.b = 0; }
  __device__ __forceinline__ const char* baseA(const Unit& u) const { return (const char*)ws + WS_AS5 + (size_t)u.a * 768 * 768 * 2; }
  __device__ __forceinline__ const char* baseB(const Unit& u) const { return (const char*)ws + WS_TT + (size_t)u.a * 512 * 768 * 2; }
  __device__ __forceinline__ unsigned rowA(const Unit& u, int r) const { return (unsigned)(u.pm * 256 + r) * 1536u; }
  __device__ __forceinline__ unsigned rowB(const Unit& u, int r) const { return (unsigned)(u.pn * 256 + r) * 1536u; }
  __device__ __forceinline__ void epi(const Acc& acc, const Unit& u, int wr, int wc, int fr, int fq) const {
    bf16_t* GB = (bf16_t*)(ws + WS_GB);
#pragma unroll
    for (int ai = 0; ai < 2; ++ai)
#pragma unroll
      for (int m = 0; m < 4; ++m) { const int crow = u.pm * 256 + ai * 128 + wr * 64 + m * 16 + fr;
#pragma unroll
        for (int bj = 0; bj < 2; ++bj) { const int pp = u.pn * 256 + bj * 128 + wc * 32 + 8 * fq, i = pp >> 4, c0 = pp & 15; f32x4 v0 = acc[ai][bj][m][0], v1 = acc[ai][bj][m][1];
#pragma unroll
          for (int j = 0; j < 4; ++j) { v0[j] = gelu_tanh(v0[j]); v1[j] = gelu_tanh(v1[j]); }
          *(u32x4*)(GB + (size_t)(crow * 32 + i) * 512 + u.a * 16 + c0) = pack8(v0, v1); } }
  }
};

struct G4 {
  static constexpr bool PERM = true; static constexpr bool F8 = false; static constexpr int SCALE_B = 0x7A7A7A7A; static constexpr bool CONTIG = false; static constexpr bool ALIGN = true; static constexpr bool LINA = true, LINB = true; __device__ __forceinline__ size_t halfA() const { return 128u * 1024u; } __device__ __forceinline__ size_t halfB() const { return 128u * 1024u; } int K, nunits; unsigned char* ws; const float* bglu;
  __device__ __forceinline__ void decode(int w, Unit& u) const { u.pm = w >> 1; u.pn = w & 1; u.a = 0; u.b = 0; }
  __device__ __forceinline__ const char* baseA(const Unit&) const { return (const char*)ws + WS_GB; }
  __device__ __forceinline__ const char* baseB(const Unit&) const { return (const char*)ws + WS_WGLU_T; }
  __device__ __forceinline__ unsigned rowA(const Unit& u, int r) const { return (unsigned)(u.pm * 256 + r) * 1024u; }
  __device__ __forceinline__ unsigned rowB(const Unit& u, int r) const { return (unsigned)(u.pn * 256 + r) * 1024u; }
  __device__ __forceinline__ void epi(const Acc& acc, const Unit& u, int wr, int wc, int fr, int fq) const {
    const bf16_t* GB = (const bf16_t*)(ws + WS_GB); bf16_t* CC = (bf16_t*)(ws + WS_CONCAT);
#pragma unroll
    for (int bj = 0; bj < 2; ++bj) { const int col0 = u.pn * 256 + bj * 128 + wc * 32 + 8 * fq; const f32x4 b0 = *(const f32x4*)(bglu + col0), b1 = *(const f32x4*)(bglu + col0 + 4);
#pragma unroll
      for (int ai = 0; ai < 2; ++ai)
#pragma unroll
        for (int m = 0; m < 4; ++m) { const int row = u.pm * 256 + ai * 128 + wr * 64 + m * 16 + fr; const u32x4 gw = *(const u32x4*)(GB + (size_t)row * 512 + col0);
          f32x4 v0 = acc[ai][bj][m][0] + b0, v1 = acc[ai][bj][m][1] + b1;
          v0[0] = bf_lo(gw.x) * fast_sigmoid(v0[0]); v0[1] = bf_hi(gw.x) * fast_sigmoid(v0[1]); v0[2] = bf_lo(gw.y) * fast_sigmoid(v0[2]); v0[3] = bf_hi(gw.y) * fast_sigmoid(v0[3]);
          v1[0] = bf_lo(gw.z) * fast_sigmoid(v1[0]); v1[1] = bf_hi(gw.z) * fast_sigmoid(v1[1]); v1[2] = bf_lo(gw.w) * fast_sigmoid(v1[2]); v1[3] = bf_hi(gw.w) * fast_sigmoid(v1[3]);
          *(u32x4*)(CC + (size_t)row * 1024 + col0) = pack8(v0, v1); } }
  }
};

struct GRes {
  static constexpr bool PERM = false; static constexpr bool F8 = false; static constexpr int SCALE_B = 0x7A7A7A7A; static constexpr bool CONTIG = false; static constexpr bool ALIGN = true; static constexpr bool LINA = true, LINB = true; __device__ __forceinline__ size_t halfA() const { return 128u * 2048u; } __device__ __forceinline__ size_t halfB() const { return 128u * 2048u; } int K, nunits; const char* A; const char* Bt; const float* hin; float* hout; const float* gate; const float* bias;
  __device__ __forceinline__ void decode(int w, Unit& u) const { u.pm = w >> 2; u.pn = w & 3; u.a = 0; u.b = 0; }
  __device__ __forceinline__ const char* baseA(const Unit&) const { return A; }
  __device__ __forceinline__ const char* baseB(const Unit&) const { return Bt; }
  __device__ __forceinline__ unsigned rowA(const Unit& u, int r) const { return (unsigned)(u.pm * 256 + r) * 2048u; }
  __device__ __forceinline__ unsigned rowB(const Unit& u, int r) const { return (unsigned)(u.pn * 256 + r) * 2048u; }
  __device__ __forceinline__ void epi(const Acc& acc, const Unit& u, int wr, int wc, int fr, int fq) const {
#pragma unroll
    for (int bj = 0; bj < 2; ++bj)
#pragma unroll
      for (int n = 0; n < 2; ++n) { const int col0 = u.pn * 256 + bj * 128 + wc * 32 + 16 * n + 4 * fq; const f32x4 gt = *(const f32x4*)(gate + col0);
        f32x4 bs = (f32x4){0.f, 0.f, 0.f, 0.f}; if (bias) bs = *(const f32x4*)(bias + col0);
#pragma unroll
        for (int ai = 0; ai < 2; ++ai)
#pragma unroll
          for (int m = 0; m < 4; ++m) { const size_t off = (size_t)(u.pm * 256 + ai * 128 + wr * 64 + m * 16 + fr) * 1024 + col0;
            const f32x4 hv = *(const f32x4*)(hin + off); *(f32x4*)(hout + off) = hv + gt * (acc[ai][bj][m][n] + bs); } }
  }
};

__device__ __forceinline__ void build_moetab(const Ctx& X, int layer, LAS int* toff) {
  const unsigned* cnt = (const unsigned*)(X.ws + WS_CTL) + CW_CNT + layer * 128;
  LAS int* texp = toff + 256;
  LAS int* ntile = toff + 132;
  __syncthreads();
  if (X.tid < 64) ntile[X.tid] = ((int)__hip_atomic_load(cnt + X.tid, __ATOMIC_RELAXED, __HIP_MEMORY_SCOPE_AGENT) + 255) >> 8;
  __syncthreads();
  if (X.tid == 0) { int s = 0; for (int e = 0; e < 64; ++e) { toff[e] = s; s += ntile[e]; } toff[64] = s; toff[65] = s + 64; }
  __syncthreads();
  if (X.tid < 65) { const int e = X.tid; const int lo = toff[e], hi = toff[e + 1]; for (int t = lo; t < hi && t < 704; ++t) texp[t] = e; }
  __syncthreads();
}
__device__ __forceinline__ int find_expert(const LAS int* toff, int ti) { return toff[256 + ti]; }

struct G6 {
  static constexpr bool PERM = true; static constexpr bool F8 = true; static constexpr int SCALE_B = 0x7A7A7A7A; static constexpr bool CONTIG = false; static constexpr bool ALIGN = true; static constexpr bool LINA = false, LINB = true;
  __device__ __forceinline__ size_t halfA() const { return 0; } __device__ __forceinline__ size_t halfB() const { return 128u * 1024u; }
  int K, nunits; unsigned char* ws; const LAS int* toff; const LAS unsigned* tokt;
  __device__ __forceinline__ void decode(int w, Unit& u) const { const int ti = w >> 1; u.pn = w & 1; u.a = find_expert(toff, ti); u.pm = ti - toff[u.a]; u.b = ti; }
  __device__ __forceinline__ const char* baseA(const Unit&) const { return (const char*)ws + WS_F; }
  __device__ __forceinline__ const char* baseB(const Unit& u) const { return (const char*)ws + WS_WEXP + (size_t)u.a * EXP_STRIDE; }
  __device__ __forceinline__ unsigned rowA(const Unit& u, int r) const { return tokt[u.ord * 256 + r]; }
  __device__ __forceinline__ void build_tokt(const Ctx& X, LAS unsigned* tk) const {
    for (int i = 0; i * X.G + X.c < nunits; ++i) { Unit u; decode(xcd_remap(i * X.G + X.c, nunits), u);
      if (X.tid < 256) { const int idx = u.pm * 256 + X.tid; int tok = idx;
        if (u.a < 64) tok = ((const int*)(ws + WS_LTOK))[u.a * 16384 + idx];
        tk[i * 256 + X.tid] = (unsigned)tok * 1024u; } }
    __syncthreads();
  }
  __device__ __forceinline__ unsigned rowB(const Unit& u, int r) const { return (unsigned)(u.pn * 256 + r) * 1024u; }
  __device__ __forceinline__ void epi(const Acc& acc, const Unit& u, int wr, int wc, int fr, int fq) const {
    bf16_t* HID = (bf16_t*)(ws + WS_HID);
#pragma unroll
    for (int ai = 0; ai < 2; ++ai)
#pragma unroll
      for (int m = 0; m < 4; ++m) { const size_t hrow = (size_t)u.b * 256 + ai * 128 + wr * 64 + m * 16 + fr; f32x4 v0, v1;
#pragma unroll
        for (int j = 0; j < 4; ++j) { const float g0 = acc[ai][0][m][0][j], g1 = acc[ai][0][m][1][j]; v0[j] = g0 * fast_sigmoid(g0) * acc[ai][1][m][0][j]; v1[j] = g1 * fast_sigmoid(g1) * acc[ai][1][m][1][j]; }
        *(u32x4*)(HID + hrow * 256 + u.pn * 128 + wc * 32 + 8 * fq) = pack8(v0, v1); }
  }
};
struct G7 {
  static constexpr bool PERM = true; static constexpr bool F8 = false; static constexpr int SCALE_B = 0x7A7A7A7A; static constexpr bool CONTIG = false; static constexpr bool ALIGN = true; static constexpr bool LINA = true, LINB = true;
  __device__ __forceinline__ size_t halfA() const { return 128u * 512u; } __device__ __forceinline__ size_t halfB() const { return 128u * 512u; }
  int K, nunits; unsigned char* ws; const LAS int* toff; int dry;
  __device__ __forceinline__ void decode(int w, Unit& u) const { const int ti = w >> 2; u.pn = w & 3; u.a = find_expert(toff, ti); u.pm = ti - toff[u.a]; u.b = ti; }
  __device__ __forceinline__ const char* baseA(const Unit&) const { return (const char*)ws + WS_HID; }
  __device__ __forceinline__ const char* baseB(const Unit& u) const { return (const char*)ws + WS_WEXP + (size_t)u.a * EXP_STRIDE + EXP_DOFF; }
  __device__ __forceinline__ unsigned rowA(const Unit& u, int r) const { return (unsigned)(u.b * 256 + r) * 512u; }
  __device__ __forceinline__ unsigned rowB(const Unit& u, int r) const { return (unsigned)(u.pn * 256 + r) * 512u; }
  __device__ __forceinline__ void epi(const Acc& acc, const Unit& u, int wr, int wc, int fr, int fq) const {
    unsigned char* YAS = ws + WS_YAS;
#pragma unroll
    for (int ai = 0; ai < 2; ++ai)
#pragma unroll
      for (int m = 0; m < 4; ++m) { const size_t yrow = (size_t)u.b * 256 + ai * 128 + wr * 64 + m * 16 + fr;
#pragma unroll
        for (int bj = 0; bj < 2; ++bj) { const f32x4 v0 = acc[ai][bj][m][0], v1 = acc[ai][bj][m][1]; int w0 = 0, w1 = 0;
          w0 = __builtin_amdgcn_cvt_pk_fp8_f32(v0[0], v0[1], w0, false); w0 = __builtin_amdgcn_cvt_pk_fp8_f32(v0[2], v0[3], w0, true);
          w1 = __builtin_amdgcn_cvt_pk_fp8_f32(v1[0], v1[1], w1, false); w1 = __builtin_amdgcn_cvt_pk_fp8_f32(v1[2], v1[3], w1, true);
          if (!dry || w0 == 0x12345678) *(u32x2*)(YAS + yrow * 1024 + u.pn * 256 + bj * 128 + wc * 32 + 8 * fq) = (u32x2){(unsigned)w0, (unsigned)w1}; } }
  }
};

struct G8 {
  static constexpr bool PERM = true; static constexpr bool F8 = false; static constexpr int SCALE_B = 0x7A7A7A7A; static constexpr bool CONTIG = false; static constexpr bool ALIGN = true; static constexpr bool LINA = true, LINB = false; __device__ __forceinline__ size_t halfA() const { return 128u * 512u; } __device__ __forceinline__ size_t halfB() const { return 0; } int K, nunits; unsigned char* ws;
  __device__ __forceinline__ void decode(int w, Unit& u) const { u.pm = w >> 8; u.a = (w >> 6) & 3; u.pn = w & 63; u.b = 0; }
  __device__ __forceinline__ const char* baseA(const Unit&) const { return (const char*)ws + WS_DMT; }
  __device__ __forceinline__ const char* baseB(const Unit& u) const { return (const char*)ws + WS_A1 + (size_t)u.a * 512; }
  __device__ __forceinline__ unsigned rowA(const Unit& u, int r) const { return (unsigned)(u.pm * 256 + r) * 512u; }
  __device__ __forceinline__ unsigned rowB(const Unit& u, int r) const { const int n = u.pn * 256 + r; return (unsigned)(128 * (n & 127) + (n >> 7)) * 2048u; }
  __device__ __forceinline__ void epi(const Acc& acc, const Unit& u, int wr, int wc, int fr, int fq) const {
    bf16_t* X1 = (bf16_t*)(ws + WS_X1);
#pragma unroll
    for (int ai = 0; ai < 2; ++ai)
#pragma unroll
      for (int m = 0; m < 4; ++m) { const int mm = ai * 128 + wr * 64 + m * 16 + fr;
#pragma unroll
        for (int bj = 0; bj < 2; ++bj) { const int n0 = u.pn * 256 + bj * 128 + wc * 32 + 8 * fq, tb = n0 >> 7, ta0 = n0 & 127;
          *(u32x4*)(X1 + ((((size_t)(u.a * 256 + mm) * 128 + tb) * 2 + u.pm) * 128 + ta0)) = pack8(acc[ai][bj][m][0], acc[ai][bj][m][1]); } }
  }
};
struct G9 {
  static constexpr bool PERM = true; static constexpr bool F8 = false; static constexpr int SCALE_B = 0x7A7A7A7A; static constexpr bool CONTIG = false; static constexpr bool ALIGN = true; static constexpr bool LINA = true, LINB = true; __device__ __forceinline__ size_t halfA() const { return 128u * 512u; } __device__ __forceinline__ size_t halfB() const { return 128u * 512u; } int K, nunits; unsigned char* ws;
  __device__ __forceinline__ void decode(int w, Unit& u) const { u.pm = 0; u.pn = w; u.a = 0; u.b = 0; }
  __device__ __forceinline__ const char* baseA(const Unit&) const { return (const char*)ws + WS_W1; }
  __device__ __forceinline__ const char* baseB(const Unit&) const { return (const char*)ws + WS_X1; }
  __device__ __forceinline__ unsigned rowA(const Unit&, int r) const { return (unsigned)r * 512u; }
  __device__ __forceinline__ unsigned rowB(const Unit& u, int r) const { return (unsigned)(u.pn * 256 + r) * 512u; }
  __device__ __forceinline__ void epi(const Acc& acc, const Unit& u, int wr, int wc, int fr, int fq) const {
    bf16_t* X2 = (bf16_t*)(ws + WS_X2);
#pragma unroll
    for (int m = 0; m < 4; ++m) { const int ka = wr * 64 + m * 16 + fr;
#pragma unroll
      for (int bj = 0; bj < 2; ++bj) { const int n0 = u.pn * 256 + bj * 128 + wc * 32 + 8 * fq, gm = n0 >> 7, tb0 = n0 & 127; f32x4 r0, r1, i0, i1;
#pragma unroll
        for (int j = 0; j < 4; ++j) {
          { const float ang = (float)((ka * (tb0 + j)) & 16383) * (1.f / 16384.f), cs = __builtin_amdgcn_cosf(ang), sn = __builtin_amdgcn_sinf(ang); const float yr = acc[0][bj][m][0][j], yi = acc[1][bj][m][0][j]; r0[j] = yr * cs + yi * sn; i0[j] = yi * cs - yr * sn; }
          { const float ang = (float)((ka * (tb0 + 4 + j)) & 16383) * (1.f / 16384.f), cs = __builtin_amdgcn_cosf(ang), sn = __builtin_amdgcn_sinf(ang); const float yr = acc[0][bj][m][1][j], yi = acc[1][bj][m][1][j]; r1[j] = yr * cs + yi * sn; i1[j] = yi * cs - yr * sn; } }
        bf16_t* p = X2 + (((size_t)(gm * 128 + ka) * 2) * 128 + tb0); *(u32x4*)p = pack8(r0, r1); *(u32x4*)(p + 128) = pack8(i0, i1); } }
  }
};
struct G10 {
  static constexpr bool PERM = true; static constexpr bool F8 = false; static constexpr int SCALE_B = 0x7A7A7A7A; static constexpr bool CONTIG = false; static constexpr bool ALIGN = true; static constexpr bool LINA = true, LINB = false; __device__ __forceinline__ size_t halfA() const { return 128u * 512u; } __device__ __forceinline__ size_t halfB() const { return 0; } int K, nunits; unsigned char* ws;
  __device__ __forceinline__ void decode(int w, Unit& u) const { u.pm = 0; u.pn = w; u.a = 0; u.b = 0; }
  __device__ __forceinline__ const char* baseA(const Unit&) const { return (const char*)ws + WS_W2; }
  __device__ __forceinline__ const char* baseB(const Unit&) const { return (const char*)ws + WS_X2; }
  __device__ __forceinline__ unsigned rowA(const Unit&, int r) const { return (unsigned)r * 512u; }
  __device__ __forceinline__ unsigned rowB(const Unit& u, int r) const { const int n = u.pn * 256 + r, ka = n >> 10, gm = n & 1023; return (unsigned)(gm * 128 + ka) * 512u; }
  __device__ __forceinline__ void epi(const Acc& acc, const Unit& u, int wr, int wc, int fr, int fq) const {
    bf16_t* FB = (bf16_t*)(ws + WS_FB); const int ka = u.pn >> 2;
#pragma unroll
    for (int m = 0; m < 4; ++m) { const int kb = wr * 64 + m * 16 + fr; const size_t k = (size_t)ka + 128 * kb;
#pragma unroll
      for (int bj = 0; bj < 2; ++bj) { const int d0 = (u.pn & 3) * 256 + bj * 128 + wc * 32 + 8 * fq; *(u32x4*)(FB + k * 1024 + d0) = pack8(acc[0][bj][m][0], acc[0][bj][m][1]); } }
  }
};
}
namespace mk {
typedef float f32x16 __attribute__((ext_vector_type(16)));

__device__ __forceinline__ void phase_scan(const Ctx& X) {
  if (X.c >= 64) return;
  const int ch = X.c * 64 + (X.tid & 63), seg = X.tid >> 6;
  const int g = ch >> 7, dir = (ch >> 6) & 1, p = ch & 63;
  const float2 lam = ((const float2*)(X.ws + WS_LAML))[(dir * 32 + g) * 64 + p];
  const float* S = (const float*)(X.ws + WS_SST) + (size_t)g * 768 * 256 + dir * 128 + p;
  bf16_t* XP = (bf16_t*)(X.ws + WS_AS5) + (size_t)g * 768 * 768 + 512 + dir * 128 + p;
  LAS float* EX = (LAS float*)X.lds;
  const int j0 = seg * 65;
  float xr = 0.f, xi = 0.f;
  for (int b = 0; b < 65; b += 13) {
    float sr[13], si[13];
#pragma unroll
    for (int k = 0; k < 13; ++k) { const int j = j0 + b + k; const int row = dir == 0 ? (j < 8 ? 512 + j : j - 8) : 519 - j; sr[k] = S[(size_t)row * 256]; si[k] = S[(size_t)row * 256 + 64]; }
#pragma unroll
    for (int k = 0; k < 13; ++k) { const float nr = lam.x * xr - lam.y * xi + sr[k], ni = lam.x * xi + lam.y * xr + si[k]; xr = nr; xi = ni; }
  }
  EX[(seg * 64 + (X.tid & 63)) * 2] = xr; EX[(seg * 64 + (X.tid & 63)) * 2 + 1] = xi;
  float pr = 1.f, pi = 0.f;
  for (int k = 0; k < 65; ++k) { const float nr = pr * lam.x - pi * lam.y, ni = pr * lam.y + pi * lam.x; pr = nr; pi = ni; }
  __syncthreads();
  float cr = 0.f, ci = 0.f;
  for (int s2 = 0; s2 < seg; ++s2) { const float er = EX[(s2 * 64 + (X.tid & 63)) * 2], ei = EX[(s2 * 64 + (X.tid & 63)) * 2 + 1];
    const float nr = pr * cr - pi * ci + er, ni = pr * ci + pi * cr + ei; cr = nr; ci = ni; }
  xr = cr; xi = ci;
  for (int b = 0; b < 65; b += 13) {
    float sr[13], si[13];
#pragma unroll
    for (int k = 0; k < 13; ++k) { const int j = j0 + b + k; const int row = dir == 0 ? (j < 8 ? 512 + j : j - 8) : 519 - j; sr[k] = S[(size_t)row * 256]; si[k] = S[(size_t)row * 256 + 64]; }
#pragma unroll
    for (int k = 0; k < 13; ++k) { const int j = j0 + b + k; const int row = dir == 0 ? (j < 8 ? 512 + j : j - 8) : 519 - j;
      XP[(size_t)row * 768] = f2bf(xr); XP[(size_t)row * 768 + 64] = f2bf(xi);
      const float nr = lam.x * xr - lam.y * xi + sr[k], ni = lam.x * xi + lam.y * xr + si[k]; xr = nr; xi = ni; }
  }
  __syncthreads();
}

__device__ __forceinline__ void zero_lists(const Ctx& X) {
  u32x4* z = (u32x4*)(X.ws + WS_LTOK); unsigned zu_ = 0u; asm volatile("" : "+v"(zu_)); const u32x4 zero = (u32x4){zu_, zu_, zu_, zu_};
  for (int i = X.c * NTHR + X.tid; i < (int)(4 * MiB / 16); i += X.G * NTHR) z[i] = zero;
}
#define MFMA32(a, b, c) __builtin_amdgcn_mfma_f32_32x32x16_bf16((a), (b), (c), 0, 0, 0)
__device__ __forceinline__ void attn_unit(const Ctx& X, const LAS float* rpbl, int head, int tile) {
  const bf16_t* Q = (const bf16_t*)(X.ws + WS_Q); const bf16_t* Kb = (const bf16_t*)(X.ws + WS_K); const bf16_t* VT = (const bf16_t*)(X.ws + WS_VT);
  bf16_t* CCt = (bf16_t*)(X.ws + WS_CONCAT);
  const int lane = X.lane, ql = lane & 31, hh = lane >> 5;
  const int rp = tile >> 2, mt = tile & 3;
  const int r = 2 * rp + (ql >> 4), cq = 16 * mt + (ql & 15), tq = r * 64 + cq;
  const int r0q = min(max(r - 4, 0), 248), csq = min(max(cq - 8, 0), 48);
  const int rlo = min(max(2 * rp - 4, 0), 248), rhi = min(max(2 * rp - 3, 0), 248) + 7;
  const int csb = min(max(16 * mt - 8, 0), 32);
  const int nloc = rhi - rlo + 1;
  unsigned cmask = 0u;
#pragma unroll
  for (int k = 0; k < 32; ++k) cmask |= ((csb + k >= csq) && (csb + k <= csq + 15)) ? (1u << k) : 0u;
  bf16x8 qf[4];
#pragma unroll
  for (int ks = 0; ks < 4; ++ks) qf[ks] = *(const bf16x8*)(Q + (size_t)tq * 512 + head * 64 + 16 * ks + 8 * hh);
  const int kperm = (ql & ~12) | ((ql & 4) << 1) | ((ql & 8) >> 1);
  f32x16 o0, o1;
#pragma unroll
  for (int i = 0; i < 16; ++i) { o0[i] = 0.f; o1[i] = 0.f; }
  float lsum = 0.f;
  const float c1 = 0.125f * 1.44269504f, c2 = 8.f * 1.44269504f;
  const float* rp_h = nullptr; (void)rp_h;
  bf16x8 kf[4], vf[2][2];
  { const int tb0 = rlo * 64 + csb; const bf16_t* kp = Kb + (size_t)(tb0 + kperm) * 512 + head * 64 + 8 * hh;
#pragma unroll
    for (int ks = 0; ks < 4; ++ks) kf[ks] = *(const bf16x8*)(kp + 16 * ks);
#pragma unroll
    for (int db = 0; db < 2; ++db)
#pragma unroll
      for (int s2 = 0; s2 < 2; ++s2) vf[db][s2] = *(const bf16x8*)(VT + (size_t)(head * 64 + 32 * db + ql) * NROW + tb0 + 16 * s2 + 8 * hh); }
  for (int b = 0; b < nloc + 8; ++b) {
    const bool loc = b < nloc;
    const int kr = rlo + b;
    bf16x8 kc[4], vc[2][2];
#pragma unroll
    for (int ks = 0; ks < 4; ++ks) kc[ks] = kf[ks];
#pragma unroll
    for (int db = 0; db < 2; ++db)
#pragma unroll
      for (int s2 = 0; s2 < 2; ++s2) vc[db][s2] = vf[db][s2];
    if (b + 1 < nloc + 8) { const int bn = b + 1; const int tbn = bn < nloc ? (rlo + bn) * 64 + csb : TOK + 32 * (bn - nloc);
      const bf16_t* kp = Kb + (size_t)(tbn + kperm) * 512 + head * 64 + 8 * hh;
#pragma unroll
      for (int ks = 0; ks < 4; ++ks) kf[ks] = *(const bf16x8*)(kp + 16 * ks);
#pragma unroll
      for (int db = 0; db < 2; ++db)
#pragma unroll
        for (int s2 = 0; s2 < 2; ++s2) vf[db][s2] = *(const bf16x8*)(VT + (size_t)(head * 64 + 32 * db + ql) * NROW + tbn + 16 * s2 + 8 * hh); }
    f32x16 sacc;
#pragma unroll
    for (int i = 0; i < 16; ++i) sacc[i] = 0.f;
#pragma unroll
    for (int ks = 0; ks < 4; ++ks) sacc = MFMA32(kc[ks], qf[ks], sacc);
    float pv[16];
    if (loc) {
      const bool rowok = (kr >= r0q) && (kr <= r0q + 7);
      const int dr = min(max(kr - r + 7, 0), 14);
      const LAS float* bp = rpbl + (head * 15 + dr) * 31;
      const int dc0 = csb - cq + 15;
#pragma unroll
      for (int i = 0; i < 16; ++i) { const int kidx = 16 * (i >> 3) + 8 * hh + (i & 7);
        const bool ok = rowok && ((cmask >> kidx) & 1u);
        const float bias = bp[min(max(dc0 + kidx, 0), 30)];
        const float e = __builtin_amdgcn_exp2f(sacc[i] * c1 + bias * 1.44269504f - c2); pv[i] = ok ? e : 0.f; }
    } else {
#pragma unroll
      for (int i = 0; i < 16; ++i) pv[i] = __builtin_amdgcn_exp2f(sacc[i] * c1 - c2);
    }
    u32x4 p0, p1;
    p0.x = cvt_pk_bf16(pv[0], pv[1]); p0.y = cvt_pk_bf16(pv[2], pv[3]); p0.z = cvt_pk_bf16(pv[4], pv[5]); p0.w = cvt_pk_bf16(pv[6], pv[7]);
    p1.x = cvt_pk_bf16(pv[8], pv[9]); p1.y = cvt_pk_bf16(pv[10], pv[11]); p1.z = cvt_pk_bf16(pv[12], pv[13]); p1.w = cvt_pk_bf16(pv[14], pv[15]);
    lsum += (bf_lo(p0.x) + bf_hi(p0.x)) + (bf_lo(p0.y) + bf_hi(p0.y)) + (bf_lo(p0.z) + bf_hi(p0.z)) + (bf_lo(p0.w) + bf_hi(p0.w))
          + (bf_lo(p1.x) + bf_hi(p1.x)) + (bf_lo(p1.y) + bf_hi(p1.y)) + (bf_lo(p1.z) + bf_hi(p1.z)) + (bf_lo(p1.w) + bf_hi(p1.w));
    const bf16x8 pb0 = __builtin_bit_cast(bf16x8, p0), pb1 = __builtin_bit_cast(bf16x8, p1);
    o0 = MFMA32(vc[0][0], pb0, o0); o0 = MFMA32(vc[0][1], pb1, o0);
    o1 = MFMA32(vc[1][0], pb0, o1); o1 = MFMA32(vc[1][1], pb1, o1);
  }
  lsum += sx(lsum, 32);
  const float inv = 1.f / lsum;
  bf16_t* op = CCt + (size_t)tq * 1024 + 512 + head * 64 + 4 * hh;
#pragma unroll
  for (int gq = 0; gq < 4; ++gq) {
    u32x2 w0, w1;
    w0.x = cvt_pk_bf16(o0[4 * gq] * inv, o0[4 * gq + 1] * inv); w0.y = cvt_pk_bf16(o0[4 * gq + 2] * inv, o0[4 * gq + 3] * inv);
    w1.x = cvt_pk_bf16(o1[4 * gq] * inv, o1[4 * gq + 1] * inv); w1.y = cvt_pk_bf16(o1[4 * gq + 2] * inv, o1[4 * gq + 3] * inv);
    *(u32x2*)(op + 8 * gq) = w0; *(u32x2*)(op + 32 + 8 * gq) = w1;
  }
}
__device__ __forceinline__ void phase_attn(const Ctx& X) {
  LAS float* rpbl = (LAS float*)X.lds;
  zero_lists(X);
  for (int i = X.tid; i < 8 * 15 * 31; i += NTHR) rpbl[i] = X.a->in[IN_RPB][i];
  __syncthreads();
  const int gw = X.c * NWAVES + X.wave, NGW = X.G * NWAVES;
  for (int U = gw; U < 4096; U += NGW) attn_unit(X, rpbl, U >> 9, U & 511);
}

__device__ __forceinline__ void phase_router(const Ctx& X, int layer, int dry) {
  const float* mod = (const float*)(X.ws + WS_MOD) + (layer == 0 ? 0 : 2 * 6144);
  const float* shift = mod + 3072; const float* scale = mod + 4096;
  const float* h = X.a->h; bf16_t* F = (bf16_t*)(X.ws + WS_F);
  unsigned* cntg = (unsigned*)(X.ws + WS_CTL) + CW_CNT + layer * 128;
  int* ltok = (int*)(X.ws + WS_LTOK); int* asg = (int*)(X.ws + WS_ASG);
  const bf16_t* WR = (const bf16_t*)(X.ws + WS_WROUT_T) + (size_t)layer * 64 * 1024;
  const float* rbias = X.a->in[IN_RBIAS] + layer * 64;
  constexpr int FROW = 2064;
  const int lane = X.lane, wave = X.wave, tid = X.tid;
  for (int tile = X.c; tile < TOK / 64; tile += X.G) {
    const int t0 = tile * 64;
    for (int rb4 = 0; rb4 < 2; ++rb4) {
      f32x4 v[4][4];
#pragma unroll
      for (int rr = 0; rr < 4; ++rr) { const f32x4* xr = (const f32x4*)(h + (size_t)(t0 + wave * 8 + rb4 * 4 + rr) * 1024) + lane;
#pragma unroll
        for (int j = 0; j < 4; ++j) v[rr][j] = xr[64 * j]; }
#pragma unroll
      for (int rr = 0; rr < 4; ++rr) {
        const int lr = wave * 8 + rb4 * 4 + rr, t = t0 + lr; float ss = 0.f;
#pragma unroll
        for (int j = 0; j < 4; ++j) ss += (v[rr][j].x * v[rr][j].x + v[rr][j].y * v[rr][j].y) + (v[rr][j].z * v[rr][j].z + v[rr][j].w * v[rr][j].w);
        const float r = rsqrtf(wave_sum(ss) * (1.f / 1024.f) + 1e-6f);
#pragma unroll
        for (int j = 0; j < 4; ++j) { const f32x4 sh = ((const f32x4*)shift)[lane + 64 * j], sc = ((const f32x4*)scale)[lane + 64 * j];
          u32x2 w; w.x = cvt_pk_bf16(v[rr][j].x * r * (1.f + sc.x) + sh.x, v[rr][j].y * r * (1.f + sc.y) + sh.y); w.y = cvt_pk_bf16(v[rr][j].z * r * (1.f + sc.z) + sh.z, v[rr][j].w * r * (1.f + sc.w) + sh.w);
          if (!dry) { int w8 = 0; w8 = __builtin_amdgcn_cvt_pk_fp8_f32(v[rr][j].x * r * (1.f + sc.x) + sh.x, v[rr][j].y * r * (1.f + sc.y) + sh.y, w8, false);
            w8 = __builtin_amdgcn_cvt_pk_fp8_f32(v[rr][j].z * r * (1.f + sc.z) + sh.z, v[rr][j].w * r * (1.f + sc.w) + sh.w, w8, true);
            ((int*)((unsigned char*)F + (size_t)t * 1024))[lane + 64 * j] = w8; }
          *(LAS u32x2*)(X.lds + lr * FROW + (lane + 64 * j) * 8) = w; }
      }
    }
    __syncthreads();
    f32x4 lg[2];
    { const int rb = wave & 3, fr = lane & 15, fq = lane >> 4;
      lg[0] = (f32x4){0.f, 0.f, 0.f, 0.f}; lg[1] = lg[0];
      const LAS unsigned char* ap = X.lds + (rb * 16 + fr) * FROW + fq * 16;
      const bf16_t* bp0 = WR + (size_t)((2 * (wave >> 2)) * 16 + fr) * 1024 + fq * 8; const bf16_t* bp1 = bp0 + 16 * 1024;
#pragma unroll 16
      for (int ks = 0; ks < 32; ++ks) { const bf16x8 af = *(const LAS bf16x8*)(ap + ks * 64); const bf16x8 b0 = *(const bf16x8*)(bp0 + ks * 32), b1 = *(const bf16x8*)(bp1 + ks * 32);
        lg[0] = __builtin_amdgcn_mfma_f32_16x16x32_bf16(af, b0, lg[0], 0, 0, 0); lg[1] = __builtin_amdgcn_mfma_f32_16x16x32_bf16(af, b1, lg[1], 0, 0, 0); }
    }
    __syncthreads();
    LAS float* LG = (LAS float*)X.lds;
    LAS float* GS = LG + 64 * 65;
    LAS float* SELV = GS + 512;
    LAS int* OUTE = (LAS int*)(SELV + 4096);
    LAS float* OUTS = (LAS float*)(OUTE + 512);
    LAS int* HIST = (LAS int*)(OUTS + 512);
    LAS int* BASE = HIST + 64;
    { const int rb = wave & 3, fr = lane & 15, fq = lane >> 4;
#pragma unroll
      for (int eb = 0; eb < 2; ++eb)
#pragma unroll
        for (int j = 0; j < 4; ++j) LG[(rb * 16 + 4 * fq + j) * 65 + (2 * (wave >> 2) + eb) * 16 + fr] = lg[eb][j];
      if (tid < 64) HIST[tid] = 0; }
    __syncthreads();
    const int tl = tid >> 3, grp = tid & 7;
    float v[8], sc[8];
    { float m1 = -INFINITY, m2 = -INFINITY;
#pragma unroll
      for (int j = 0; j < 8; ++j) { const float s = 1.f / (1.f + __expf(-LG[tl * 65 + grp * 8 + j])); sc[j] = s; v[j] = s + rbias[grp * 8 + j];
        if (v[j] > m1) { m2 = m1; m1 = v[j]; } else if (v[j] > m2) m2 = v[j]; }
      GS[tl * 8 + grp] = m1 + m2; }
    __syncthreads();
    bool keep;
    { const float mine = GS[tl * 8 + grp]; int rank = 0;
#pragma unroll
      for (int g2 = 0; g2 < 8; ++g2) { const float o = GS[tl * 8 + g2]; rank += (o > mine || (o == mine && g2 < grp)) ? 1 : 0; }
      keep = rank < 4;
#pragma unroll
      for (int j = 0; j < 8; ++j) SELV[tl * 64 + grp * 8 + j] = keep ? v[j] : -INFINITY; }
    __syncthreads();
    if (keep) {
      int rk[8];
#pragma unroll
      for (int j = 0; j < 8; ++j) rk[j] = 0;
      for (int e2 = 0; e2 < 64; ++e2) { const float o = SELV[tl * 64 + e2];
#pragma unroll
        for (int j = 0; j < 8; ++j) rk[j] += (o > v[j] || (o == v[j] && e2 < grp * 8 + j)) ? 1 : 0; }
#pragma unroll
      for (int j = 0; j < 8; ++j) if (rk[j] < 8) { OUTE[tl * 8 + rk[j]] = grp * 8 + j; OUTS[tl * 8 + rk[j]] = sc[j]; }
    }
    __syncthreads();
    { const int jj = tid & 7, e = OUTE[tl * 8 + jj]; const float s = OUTS[tl * 8 + jj];
      float sum = s; sum += sx(sum, 1); sum += sx(sum, 2); sum += sx(sum, 4);
      const float w = 2.5f * s / sum;
      const int sl = atomicAdd((int*)&HIST[e], 1);
      __syncthreads();
      const int t = t0 + tl;
      if (tid < 64) { const int n = HIST[tid]; BASE[tid] = (n && !dry) ? (int)atomicAdd(cntg + tid, (unsigned)n) : 0; }
      __syncthreads();
      const int slot = BASE[e] + sl;
      if (!dry) { ltok[(size_t)e * 16384 + slot] = t; } if (!dry) ((int2*)asg)[t * 8 + jj] = make_int2((e << 16) | slot, __float_as_int(w)); }
    __syncthreads();
  }
}

__device__ __forceinline__ void phase_combine(const Ctx& X, int layer, const LAS int* toff, int dry) {
  const float* mod = (const float*)(X.ws + WS_MOD) + (layer == 0 ? 0 : 2 * 6144);
  const float* gffn = mod + 5120;
  const float* nmod = (const float*)(X.ws + WS_MOD) + 2 * 6144;
  float* h = X.a->h; const unsigned char* YAS = X.ws + WS_YAS; const int* asg = (const int*)(X.ws + WS_ASG); bf16_t* A1 = (bf16_t*)(X.ws + WS_A1);
  const int gw = X.c * NWAVES + X.wave, NGW = X.G * NWAVES, lane = X.lane;
  int2 an[8];
#pragma unroll
  for (int k = 0; k < 8; ++k) an[k] = ((const int2*)asg)[gw * 8 + k];
  for (int ti = gw; ti < TOK; ti += NGW) {
    const int t = ti;
    f32x4 acc[4];
#pragma unroll
    for (int j = 0; j < 4; ++j) acc[j] = (f32x4){0.f, 0.f, 0.f, 0.f};
    int pos[9]; float wgt[9];
#pragma unroll
    for (int k = 0; k < 8; ++k) { pos[k] = toff[an[k].x >> 16] * 256 + (an[k].x & 0xffff); wgt[k] = __int_as_float(an[k].y); }
    if (ti + NGW < TOK) {
#pragma unroll
      for (int k = 0; k < 8; ++k) an[k] = ((const int2*)asg)[(t + NGW) * 8 + k]; }
    pos[8] = toff[64] * 256 + ti; wgt[8] = 1.f;
#pragma unroll
    for (int k = 0; k < 9; ++k) { const int* yr = (const int*)(YAS + (size_t)pos[k] * 1024) + lane; const float wk = wgt[k];
#pragma unroll
      for (int j = 0; j < 4; ++j) { const int w = yr[64 * j];
        acc[j].x += wk * __builtin_amdgcn_cvt_f32_fp8(w, 0); acc[j].y += wk * __builtin_amdgcn_cvt_f32_fp8(w, 1); acc[j].z += wk * __builtin_amdgcn_cvt_f32_fp8(w, 2); acc[j].w += wk * __builtin_amdgcn_cvt_f32_fp8(w, 3); } }
    f32x4* hr = (f32x4*)(h + (size_t)t * 1024) + lane; f32x4 v[4]; float ss = 0.f;
#pragma unroll
    for (int j = 0; j < 4; ++j) { const f32x4 gt = ((const f32x4*)gffn)[lane + 64 * j]; v[j] = hr[64 * j] + gt * acc[j]; if (!dry) hr[64 * j] = v[j];
      ss += (v[j].x * v[j].x + v[j].y * v[j].y) + (v[j].z * v[j].z + v[j].w * v[j].w); }
    if (layer == 0) {
      const float r = rsqrtf(wave_sum(ss) * (1.f / 1024.f) + 1e-6f);
#pragma unroll
      for (int j = 0; j < 4; ++j) { const f32x4 sh = ((const f32x4*)nmod)[lane + 64 * j], sc = ((const f32x4*)(nmod + 1024))[lane + 64 * j];
        u32x2 w; w.x = cvt_pk_bf16(v[j].x * r * (1.f + sc.x) + sh.x, v[j].y * r * (1.f + sc.y) + sh.y); w.y = cvt_pk_bf16(v[j].z * r * (1.f + sc.z) + sh.z, v[j].w * r * (1.f + sc.w) + sh.w);
        if (!dry) ((u32x2*)(A1 + (size_t)t * 1024))[lane + 64 * j] = w; }
    }
  }
}

constexpr int NPHASE = 21;
template <bool SP2>
__global__ void __launch_bounds__(NTHR, 2) mk_fwd(Args args) {
  extern __shared__ __attribute__((aligned(16))) unsigned char lds_raw[];
  Ctx X; X.lds = (LAS unsigned char*)lds_raw; X.a = &args; X.ws = args.ws; X.tid = threadIdx.x; X.lane = X.tid & 63; X.wave = __builtin_amdgcn_readfirstlane(X.tid >> 6);
  X.G = gridDim.x; X.c = blockIdx.x;
  const int wave_s = X.wave;
  volatile LAS unsigned* MISC = (volatile LAS unsigned*)(X.lds + LDS_MISC_OFF);
  LAS int* TOFF = (LAS int*)(X.lds + LDS_MISC_OFF + 64);
  if (X.tid < 16) MISC[X.tid] = 0u;
  __syncthreads();
  unsigned* ctl = (unsigned*)(X.ws + WS_CTL);
  const int lo = args.ph_lo, hi = args.ph_hi;
  const bool multi = (hi - lo) > 1;
  XcdBarrier bar; bar.bar = ctl + CW_BAR; bar.x = 0; bar.st = nullptr;
  if (multi) bar = xcd_barrier_post(ctl + CW_BAR, MISC, X.tid);
  LAS unsigned char* lds = X.lds;
  unsigned char* ws = X.ws;
  const float* mod = (const float*)(ws + WS_MOD); (void)mod;
#ifndef PH_MASK
#define PH_MASK 0x1fffffull
#endif
#define IN(k) ((((unsigned long long)PH_MASK >> (k)) & 1ull) && lo <= (k) && (k) < hi)
#define SEAM(k) do { if (IN(k) && IN((k) + 1)) xcd_barrier(bar, X.tid); } while (0)
#ifndef REP_MASK
#define REP_MASK 0ull
#endif
#define REPS(k) ((int)(((unsigned long long)REP_MASK >> (k)) & 1ull))
#define LAUNDER() do { int w0_ = wave_s; asm volatile("" : "+s"(w0_)); int l_ = __builtin_amdgcn_mbcnt_hi(~0u, __builtin_amdgcn_mbcnt_lo(~0u, 0u)); asm volatile("" : "+v"(l_)); X.wave = w0_; X.lane = l_; X.tid = w0_ * 64 + l_; \
    size_t z0_ = 0; asm volatile("" : "+s"(z0_)); unsigned char* w_ = args.ws + z0_; X.ws = w_; ws = w_; mod = (const float*)(w_ + WS_MOD); } while (0)
  if (IN(0)) for (int rep_ = 0; rep_ <= REPS(0); ++rep_) { if (rep_) xcd_barrier(bar, X.tid); LAUNDER(); phase_prep(X, rep_); } SEAM(0);
#ifdef EXTRA_BARS
  if (multi) for (int eb_ = 0; eb_ < EXTRA_BARS; ++eb_) xcd_barrier(bar, X.tid);
#endif
  if (IN(1)) for (int rep_ = 0; rep_ <= REPS(1); ++rep_) { if (rep_) xcd_barrier(bar, X.tid); LAUNDER(); phase_mod0(X); } SEAM(1);
  if (IN(2)) for (int rep_ = 0; rep_ <= REPS(2); ++rep_) { if (rep_) xcd_barrier(bar, X.tid); LAUNDER(); G1 p; p.K = 1024; p.nunits = 520; p.ws = ws; p.qg = args.in[IN_QG]; p.kg = args.in[IN_KG]; gemm_phase<G1, SP2>(lds, p, X.G, X.c, X.tid); } SEAM(2);
  if (IN(3)) for (int rep_ = 0; rep_ <= REPS(3); ++rep_) { if (rep_) xcd_barrier(bar, X.tid); LAUNDER(); G2 p; p.K = 512; p.nunits = 96; p.ws = ws; gemm_phase<G2, SP2>(lds, p, X.G, X.c, X.tid); } SEAM(3);
  if (IN(4)) for (int rep_ = 0; rep_ <= REPS(4); ++rep_) { if (rep_) xcd_barrier(bar, X.tid); LAUNDER(); phase_scan(X); } SEAM(4);
  if (IN(5)) for (int rep_ = 0; rep_ <= REPS(5); ++rep_) { if (rep_) xcd_barrier(bar, X.tid); LAUNDER(); G3 p; p.K = 768; p.nunits = 128; p.ws = ws; gemm_phase<G3, SP2>(lds, p, X.G, X.c, X.tid); } SEAM(5);
  if (IN(6)) for (int rep_ = 0; rep_ <= REPS(6); ++rep_) { if (rep_) xcd_barrier(bar, X.tid); LAUNDER(); G4 p; p.K = 512; p.nunits = 128; p.ws = ws; p.bglu = args.in[IN_BGLU]; gemm_phase<G4, SP2>(lds, p, X.G, X.c, X.tid); } SEAM(6);
  if (IN(7)) for (int rep_ = 0; rep_ <= REPS(7); ++rep_) { if (rep_) xcd_barrier(bar, X.tid); LAUNDER(); phase_attn(X); } SEAM(7);
  if (IN(8)) for (int rep_ = 0; rep_ <= REPS(8); ++rep_) { if (rep_) xcd_barrier(bar, X.tid); LAUNDER(); GRes p; p.K = 1024; p.nunits = 256; p.A = (const char*)ws + WS_CONCAT; p.Bt = (const char*)ws + WS_WMIX_T; p.hin = args.in[IN_X]; p.hout = args.h; p.gate = mod + 2048; p.bias = nullptr;
    gemm_phase<GRes, SP2>(lds, p, X.G, X.c, X.tid); } SEAM(8);
#pragma unroll 1
  for (int layer = 0; layer < 2; ++layer) {
    const int pb = layer == 0 ? 9 : 17;
    if (IN(pb)) for (int rep_ = 0; rep_ <= REPS(pb); ++rep_) { if (rep_) xcd_barrier(bar, X.tid); LAUNDER(); phase_router(X, layer, rep_); } SEAM(pb);
    if (IN(pb + 1)) for (int rep_ = 0; rep_ <= REPS(pb + 1); ++rep_) { if (rep_) xcd_barrier(bar, X.tid); LAUNDER(); build_moetab(X, layer, TOFF); G6 p; p.K = 512; p.ws = ws; p.toff = TOFF; p.nunits = TOFF[65] * 2;
      { LAS unsigned* tk = (LAS unsigned*)(X.lds + LDS_STAGE); p.tokt = tk; p.build_tokt(X, tk); } gemm_phase<G6, SP2>(lds, p, X.G, X.c, X.tid); } SEAM(pb + 1);
    if (IN(pb + 2)) for (int rep_ = 0; rep_ <= REPS(pb + 2); ++rep_) { if (rep_) xcd_barrier(bar, X.tid); LAUNDER(); build_moetab(X, layer, TOFF); G7 p; p.K = 256; p.ws = ws; p.toff = TOFF; p.dry = rep_; p.nunits = TOFF[65] * 4; gemm_phase<G7, SP2>(lds, p, X.G, X.c, X.tid); } SEAM(pb + 2);
    if (IN(pb + 3)) for (int rep_ = REPS(pb + 3); rep_ >= 0; --rep_) { if (rep_ == 0 && REPS(pb + 3)) xcd_barrier(bar, X.tid); LAUNDER(); build_moetab(X, layer, TOFF); phase_combine(X, layer, TOFF, rep_);
      if (layer == 0 && rep_ == 0 && !(args.flags & FLAG_SKIP_EXPERTS)) { __syncthreads(); transpose_work(X, ctl + CW_DQ1, 0, 0, 1, 65 * IT_EXP); } }
    if (layer == 0) {
      SEAM(12);
      if (IN(13)) for (int rep_ = 0; rep_ <= REPS(13); ++rep_) { if (rep_) xcd_barrier(bar, X.tid); LAUNDER(); G8 p; p.K = 256; p.nunits = 512; p.ws = ws; gemm_phase<G8, SP2>(lds, p, X.G, X.c, X.tid); } SEAM(13);
      if (IN(14)) for (int rep_ = 0; rep_ <= REPS(14); ++rep_) { if (rep_) xcd_barrier(bar, X.tid); LAUNDER(); G9 p; p.K = 256; p.nunits = 512; p.ws = ws; gemm_phase<G9, SP2>(lds, p, X.G, X.c, X.tid); } SEAM(14);
      if (IN(15)) for (int rep_ = 0; rep_ <= REPS(15); ++rep_) { if (rep_) xcd_barrier(bar, X.tid); LAUNDER(); G10 p; p.K = 256; p.nunits = 512; p.ws = ws; gemm_phase<G10, SP2>(lds, p, X.G, X.c, X.tid); } SEAM(15);
      if (IN(16)) { LAUNDER(); zero_lists(X); GRes p; p.K = 1024; p.nunits = 256; p.A = (const char*)ws + WS_FB; p.Bt = (const char*)ws + WS_WFOUR_T; p.hin = args.h; p.hout = args.h; p.gate = mod + 2 * 6144 + 2048; p.bias = args.in[IN_BFOUR];
        gemm_phase<GRes, SP2>(lds, p, X.G, X.c, X.tid); } SEAM(16);
    }
  }
#undef IN
#undef SEAM
}
}
#ifndef MK_SP2
#define MK_SP2 true
#endif
#ifndef MK_N_LAUNCHES
#define MK_N_LAUNCHES 1
#endif
#ifndef CHECK
#define CHECK 0
#endif
static int g_grid = 0;
static bool mk_setup(int n_in, int out_size, size_t ws_size) {
  if (g_grid == 0) {
    g_grid = -1;
    if (n_in != 31 || out_size != 16384 * 1024 || ws_size < (size_t)530 * 1000 * 1000) { fprintf(stderr, "kernel_launch: unexpected n_in %d out %d ws %zu\n", n_in, out_size, ws_size); return false; }
    int dev = 0, cus = 0;
    if (hipGetDevice(&dev) != hipSuccess || hipDeviceGetAttribute(&cus, hipDeviceAttributeMultiprocessorCount, dev) != hipSuccess) return false;
    if (cus < 256) { fprintf(stderr, "kernel_launch: needs 256 CUs, device has %d\n", cus); return false; }
    if (hipFuncSetAttribute((const void*)mk::mk_fwd<MK_SP2>, hipFuncAttributeMaxDynamicSharedMemorySize, mk::LDS_BYTES) != hipSuccess) { fprintf(stderr, "kernel_launch: hipFuncSetAttribute failed\n"); return false; }
    g_grid = 256;
  }
  return g_grid > 0;
}
static void mk_run(hipStream_t s, mk::Args a, int lo, int hi) {
  a.ph_lo = lo; a.ph_hi = hi;
  hipLaunchKernelGGL(mk::mk_fwd<MK_SP2>, dim3(g_grid), dim3(mk::NTHR), mk::LDS_BYTES, s, a);
}

#if CHECK
namespace chk {
using mk::bf16_t;
__device__ __forceinline__ float b2f(bf16_t b) { return __uint_as_float(((unsigned)b) << 16); }
__global__ void k_cmp(int mode, const void* A, const float* B, unsigned long long n, double* acc) {
  double e = 0.0, r = 0.0; const bf16_t* A16 = (const bf16_t*)A;
  for (unsigned long long i = (unsigned long long)blockIdx.x * 256 + threadIdx.x; i < n; i += (unsigned long long)gridDim.x * 256) {
    float a = 0.f, b = 0.f; const int row = (int)(i >> 9), col = (int)(i & 511);
    switch (mode) {
      case 0: a = ((const float*)A)[i]; b = B[i]; break;
      case 1: a = b2f(A16[i]); b = B[i]; break;
      case 2: { b = B[(size_t)row * 2048 + col]; const int g = col >> 4, c = col & 15; int crow, s; if (row < 16384) { crow = row >> 5; s = row & 31; } else { const int j = row - 16384; crow = 512 + (j >> 5); s = j & 31; }
                a = b2f(A16[((size_t)(g * 768 + crow)) * 768 + s * 16 + c]); } break;
      case 3: b = B[(size_t)row * 2048 + 512 + col]; a = b2f(A16[(size_t)row * 512 + col]); break;
      case 4: b = B[(size_t)row * 2048 + 1024 + col]; a = b2f(A16[(size_t)row * 512 + col]); break;
      case 5: b = B[(size_t)row * 2048 + 1536 + col]; a = b2f(A16[(size_t)col * 16640 + row]); break;
      case 6: b = B[(size_t)row * 1024 + col]; a = b2f(A16[(size_t)row * 1024 + col]); break;
      case 7: b = B[(size_t)row * 1024 + 512 + col]; a = b2f(A16[(size_t)row * 1024 + 512 + col]); break;
      case 8: { const int ta = (int)(i & 127), ri = (int)((i >> 7) & 1), tb = (int)((i >> 8) & 127), m = (int)((i >> 15) & 255), g = (int)(i >> 23); a = b2f(A16[i]); const int t = 128 * ta + tb; b = B[((size_t)t * 4 + g) * 512 + ri * 256 + m]; } break;
      default: break;
    }
    const double d = (double)a - (double)b; e += d * d; r += (double)b * (double)b;
  }
  for (int o = 32; o >= 1; o >>= 1) { e += __shfl_xor(e, o); r += __shfl_xor(r, o); }
  if ((threadIdx.x & 63) == 0) { atomicAdd(acc, e); atomicAdd(acc + 1, r); }
}
__global__ void k_cmp_x2(const bf16_t* X2, const float* Yr, const float* Yi, double* acc) {
  double e = 0.0, r = 0.0;
  for (unsigned long long i = (unsigned long long)blockIdx.x * 256 + threadIdx.x; i < (1ull << 25); i += (unsigned long long)gridDim.x * 256) {
    const int tb = (int)(i & 127), rip = (int)((i >> 7) & 1), ka = (int)((i >> 8) & 127), gm = (int)(i >> 15);
    const float a = b2f(X2[i]); const size_t yi = (((size_t)ka * 128 + tb) << 10) + gm; const float b = rip ? Yi[yi] : Yr[yi];
    const double d = (double)a - (double)b; e += d * d; r += (double)b * (double)b;
  }
  for (int o = 32; o >= 1; o >>= 1) { e += __shfl_xor(e, o); r += __shfl_xor(r, o); }
  if ((threadIdx.x & 63) == 0) { atomicAdd(acc, e); atomicAdd(acc + 1, r); }
}
__global__ void k_judge(const double* acc, int n, float tol, int* fail) {
  if (threadIdx.x == 0 && blockIdx.x == 0) { fail[0] = 0; for (int k = 0; k < n; ++k) { const double rel = sqrt(acc[2 * k] / acc[2 * k + 1]); if (!(rel <= (double)tol)) { fail[0] = k + 1; break; } } }
}
__global__ void k_encode(float* out, size_t n, const int* fail) {
  const int f = fail[0]; if (f == 0) return; const float sc = 1.f + 0.1f * (float)f;
  for (size_t i = (size_t)blockIdx.x * 256 + threadIdx.x; i < n; i += (size_t)gridDim.x * 256) out[i] *= sc;
}
__global__ void k_f2bf(const float* in, bf16_t* out, size_t n) { for (size_t i = (size_t)blockIdx.x * 256 + threadIdx.x; i < n; i += (size_t)gridDim.x * 256) out[i] = mk::f2bf(in[i]); }
static void cmp(hipStream_t s, int mode, const void* A, const float* B, unsigned long long n, double* acc) { hipLaunchKernelGGL(k_cmp, dim3(2048), dim3(256), 0, s, mode, A, B, n, acc); }
}
#endif

extern "C" void kernel_launch(void* const* d_in, const int* in_sizes, int n_in, void* d_out, int out_size, void* d_ws, size_t ws_size, hipStream_t stream) {
  if (!mk_setup(n_in, out_size, ws_size)) return;
  unsigned char* ws = (unsigned char*)d_ws;
  const size_t MiB = mk::MiB;
  mk::Args a{};
  for (int i = 0; i < 31; ++i) a.in[i] = (const float*)d_in[i];
  a.h = (float*)d_out; a.ws = ws; a.flags = 0; a.pad = 0;
#if CHECK == 0
  (void)hipMemsetAsync(ws + mk::WS_CTL, 0, mk::CTL_ZERO_BYTES, stream);
#if MK_N_LAUNCHES == 1
  mk_run(stream, a, 0, mk::NPHASE);
#else
  for (int ph = 0; ph < mk::NPHASE; ++ph) mk_run(stream, a, ph, ph + 1);
#endif
#else
  ref::In in; { const float** p = (const float**)&in; for (int i = 0; i < 31; ++i) p[i] = (const float*)d_in[i]; }
  float* out = (float*)d_out;
  char* wsc = (char*)d_ws;
  ref::Small sm; sm.mod = (float*)(wsc + 498 * MiB); sm.lamb = (float2*)(wsc + 498 * MiB + 131072); sm.bbar = (float2*)(wsc + 498 * MiB + 262144);
  sm.tw = (float2*)(wsc + 499 * MiB); sm.Dm = (float*)(wsc + 499 * MiB + 262144);
  double* acc = (double*)(wsc + 500 * MiB); int* fail = (int*)(wsc + 500 * MiB + 4096);
  (void)hipMemsetAsync(acc, 0, 8192, stream);
  (void)hipMemsetAsync(ws + mk::WS_CTL, 0, mk::CTL_ZERO_BYTES, stream);
  float* HOPT = (float*)(ws + mk::WS_HOPT);
  int nchk = 0;
#if CHECK == 1
  ref::MixBuf mb; mb.a0 = (float*)(wsc + 12 * MiB); mb.z = (float*)(wsc + 336 * MiB); mb.g = (float*)(wsc + 466 * MiB); mb.t = (float*)(wsc + 77 * MiB); mb.concat = mb.a0; mb.ymix = mb.z;
  char* moe_arena = wsc + 12 * MiB;
  ref::FourBuf fb; { char* p = wsc + 12 * MiB; fb.a1 = (float*)p; p += 64 * MiB; fb.Z = (float*)p; p += 128 * MiB; fb.Yr = (float*)p; p += 64 * MiB; fb.Yi = (float*)p; p += 64 * MiB; fb.F = (float*)p; fb.yf = fb.Z; }
  a.flags = mk::FLAG_SKIP_EXPERTS;
  nchk = 10;
  ref::forward(stream, in, out, sm, mb, moe_arena, fb, [&](int st) {
    if (st == 1) { mk_run(stream, a, 0, 1); chk::cmp(stream, 0, ws + mk::WS_MOD, sm.mod, 3 * 6144, acc + 0); }
    if (st == 2) { mk_run(stream, a, 1, 2); chk::cmp(stream, 1, ws + mk::WS_A0, mb.a0, 16640ull * 1024, acc + 2); }
    if (st == 3) { mk_run(stream, a, 2, 3); chk::cmp(stream, 2, ws + mk::WS_AS5, mb.z, 16640ull * 512, acc + 4); chk::cmp(stream, 3, ws + mk::WS_Q, mb.z, 16384ull * 512, acc + 6);
                   chk::cmp(stream, 4, ws + mk::WS_K, mb.z, 16640ull * 512, acc + 8); chk::cmp(stream, 5, ws + mk::WS_VT, mb.z, 16640ull * 512, acc + 10); }
    if (st == 4) { mk_run(stream, a, 3, 4); mk_run(stream, a, 4, 5); mk_run(stream, a, 5, 6); chk::cmp(stream, 1, ws + mk::WS_GB, mb.g, 16384ull * 512, acc + 12); }
    if (st == 5) { mk_run(stream, a, 6, 7); chk::cmp(stream, 6, ws + mk::WS_CONCAT, mb.concat, 16384ull * 512, acc + 14); }
    if (st == 6) { mk_run(stream, a, 7, 8); chk::cmp(stream, 7, ws + mk::WS_CONCAT, mb.concat, 16384ull * 512, acc + 16); }
    if (st == 7) { mk::Args b = a; b.h = HOPT; mk_run(stream, b, 8, 9); chk::cmp(stream, 0, HOPT, out, 16384ull * 1024, acc + 18); }
  });
#elif CHECK == 2 || CHECK == 4
  const int L = CHECK == 2 ? 0 : 1;
  ref::MixBuf mb; { char* p = wsc + 12 * MiB; mb.a0 = (float*)p; p += 65 * MiB; mb.z = (float*)p; p += 130 * MiB; mb.g = (float*)p; p += 32 * MiB; mb.t = (float*)p; p += 32 * MiB; mb.concat = (float*)p; p += 64 * MiB; mb.ymix = mb.z; }
  ref::FourBuf fb; { char* p = wsc + 12 * MiB; fb.a1 = (float*)p; p += 64 * MiB; fb.Z = (float*)p; p += 128 * MiB; fb.Yr = (float*)p; p += 64 * MiB; fb.Yi = (float*)p; p += 64 * MiB; fb.F = (float*)p; fb.yf = fb.Z; }
  char* moe_arena = wsc + 110 * MiB;
  nchk = L == 0 ? 2 : 1;
  a.flags = 0;
  ref::forward(stream, in, out, sm, mb, moe_arena, fb, [&](int st) {
    if ((L == 0 && st == 7) || (L == 1 && st == 11)) {
      mk::Args b = a; b.h = HOPT; if (L == 1) b.flags = 2;
      mk_run(stream, b, 0, 1);
      (void)hipMemcpyAsync(HOPT, out, (size_t)16384 * 1024 * 4, hipMemcpyDeviceToDevice, stream);
      const int pb = L == 0 ? 9 : 20; b.flags |= mk::FLAG_SKIP_EXPERTS;
      for (int ph = pb; ph < pb + 7; ++ph) mk_run(stream, b, ph, ph + 1);
    }
    if ((L == 0 && st == 8) || (L == 1 && st == 12)) chk::cmp(stream, 0, HOPT, out, 16384ull * 1024, acc + 0);
    if (L == 0 && st == 9) chk::cmp(stream, 1, ws + mk::WS_A1, fb.a1, 16384ull * 1024, acc + 2);
  });
#elif CHECK == 3
  ref::MixBuf mb; { char* p = wsc + 12 * MiB; mb.a0 = (float*)p; p += 65 * MiB; mb.z = (float*)p; p += 130 * MiB; mb.g = (float*)p; p += 32 * MiB; mb.t = (float*)p; p += 32 * MiB; mb.concat = (float*)p; p += 64 * MiB; mb.ymix = mb.z; }
  char* moe_arena = wsc + 12 * MiB;
  ref::FourBuf fb; fb.Z = (float*)(wsc + 270 * MiB);
  fb.a1 = (float*)(wsc + 12 * MiB); fb.Yr = (float*)(wsc + 12 * MiB);   fb.Yi = (float*)(wsc + 468 * MiB - 0); fb.F = (float*)(wsc + 270 * MiB); fb.yf = (float*)(wsc + 334 * MiB);
  fb.Yi = (float*)(wsc + 76 * MiB);
  nchk = 4;
  a.flags = mk::FLAG_SKIP_EXPERTS;
  ref::forward(stream, in, out, sm, mb, moe_arena, fb, [&](int st) {
    if (st == 9) {
      mk::Args b = a; b.h = HOPT;
      mk_run(stream, b, 0, 1);
      hipLaunchKernelGGL(chk::k_f2bf, dim3(2048), dim3(256), 0, stream, fb.a1, (chk::bf16_t*)(ws + mk::WS_A1), (size_t)16384 * 1024);
      (void)hipMemcpyAsync(HOPT, out, (size_t)16384 * 1024 * 4, hipMemcpyDeviceToDevice, stream);
      mk_run(stream, b, 16, 17);
    }
  });
#endif
  hipLaunchKernelGGL(chk::k_judge, dim3(1), dim3(64), 0, stream, acc, nchk, 0.05f, fail);
  hipLaunchKernelGGL(chk::k_encode, dim3(2048), dim3(256), 0, stream, out, (size_t)16384 * 1024, fail);
#endif
}
```

```cpp
#define CHECK 0
#define MK_N_LAUNCHES 1
#define MK_SP2 true
#define REP_MASK 0ull
#include <hip/hip_runtime.h>
#include <cstdio>
#include <cstdint>
#include <cmath>
namespace mk {
#define LAS __attribute__((address_space(3)))
typedef unsigned short bf16_t;
typedef short bf16x8 __attribute__((ext_vector_type(8)));
typedef float f32x4 __attribute__((ext_vector_type(4)));
typedef float f32x2 __attribute__((ext_vector_type(2)));
typedef unsigned u32x4 __attribute__((ext_vector_type(4)));
typedef unsigned u32x2 __attribute__((ext_vector_type(2)));
typedef int i32x8 __attribute__((ext_vector_type(8)));
typedef int i32x4 __attribute__((ext_vector_type(4)));

constexpr int TOK = 16384, CTXN = 256, NROW = TOK + CTXN;
constexpr int NWAVES = 8, NTHR = 512;
constexpr int LDS_STAGE = 131072, LDS_BYTES = 155648, LDS_MISC_OFF = LDS_BYTES - 4096;

__device__ __forceinline__ unsigned cvt_pk_bf16(float lo, float hi) { unsigned r; asm volatile("v_cvt_pk_bf16_f32 %0, %1, %2" : "=v"(r) : "v"(lo), "v"(hi)); return r; }
__device__ __forceinline__ float bf_lo(unsigned w) { return __uint_as_float(w << 16); }
__device__ __forceinline__ float bf_hi(unsigned w) { return __uint_as_float(w & 0xffff0000u); }
__device__ __forceinline__ float bf2f(bf16_t b) { return __uint_as_float(((unsigned)b) << 16); }
__device__ __forceinline__ bf16_t f2bf(float f) { unsigned u = __float_as_uint(f); return (bf16_t)((u + 0x7fffu + ((u >> 16) & 1u)) >> 16); }
__device__ __forceinline__ float sx(float v, int o) { int l = __builtin_amdgcn_mbcnt_hi(~0u, __builtin_amdgcn_mbcnt_lo(~0u, 0u)); asm volatile("" : "+v"(l)); return __int_as_float(__builtin_amdgcn_ds_bpermute((l ^ o) << 2, __float_as_int(v))); }
__device__ __forceinline__ float wave_sum(float v) {
#pragma unroll
  for (int o = 1; o < 64; o <<= 1) v += sx(v, o);
  return v;
}
__device__ __forceinline__ float fast_sigmoid(float x) { return __builtin_amdgcn_rcpf(1.f + __expf(-x)); }
__device__ __forceinline__ float fast_tanh(float x) { float e = __expf(2.f * x); return 1.f - 2.f * __builtin_amdgcn_rcpf(e + 1.f); }
__device__ __forceinline__ float gelu_tanh(float x) { return 0.5f * x * (1.f + fast_tanh(0.7978845608028654f * (x + 0.044715f * x * x * x))); }

#define XB_TMO      128
#define XB_XCNT(j)  (256  + 64 * (j))
#define XB_XSUB(j)  (1280 + 64 * (j))
#define XB_XGEN(j)  (2304 + 64 * (j))
#define XB_TOP      3328
#define XB_TOPGEN   3392
#define XCD_BAR_WORDS 3456
#define XB_SPIN_CAP (1u << 20)
__device__ __forceinline__ unsigned xb_ld(unsigned* p) { return __hip_atomic_load(p, __ATOMIC_RELAXED, __HIP_MEMORY_SCOPE_AGENT); }
__device__ __forceinline__ unsigned xb_add(unsigned* p, unsigned v) { return __hip_atomic_fetch_add(p, v, __ATOMIC_RELAXED, __HIP_MEMORY_SCOPE_AGENT); }
__device__ __forceinline__ unsigned xb_xcc_id() { return (unsigned)__builtin_amdgcn_s_getreg((3 << 11) | 20) & 0xFu; }
#define XB_SPIN(cond, bar) do { unsigned _sp = 0; while (cond) { __builtin_amdgcn_s_sleep(1); \
    if ((++_sp & 255u) == 0u) { if (xb_ld(&(bar)[XB_TMO])) break; if (_sp > XB_SPIN_CAP) { atomicAdd(&(bar)[XB_TMO], 1u); break; } } } } while (0)
struct XcdBarrier { unsigned* bar; unsigned x; volatile LAS unsigned* st; };
__device__ __forceinline__ XcdBarrier xcd_barrier_post(unsigned* bar, volatile LAS unsigned* st, int tid) {
  XcdBarrier b; b.bar = bar; b.x = xb_xcc_id(); b.st = st;
  if (tid == 0) (void)xb_add(&bar[XB_XCNT(b.x)], 1u);
  return b;
}
__device__ __forceinline__ void xcd_barrier_complete(unsigned* bar, unsigned x, unsigned& nloc, unsigned& nx) {
  const unsigned G = gridDim.x * gridDim.y * gridDim.z;
  unsigned sum, cnt, mine, sp = 0u;
  for (;;) {
    sum = 0u; cnt = 0u; mine = 0u;
#pragma unroll
    for (unsigned j = 0; j < 16; ++j) { const unsigned c = xb_ld(&bar[XB_XCNT(j)]); sum += c; cnt += (c > 0u) ? 1u : 0u; }
    if (sum == G) { mine = xb_ld(&bar[256 + 64 * x]); break; }
    __builtin_amdgcn_s_sleep(1);
    if ((++sp & 255u) == 0u) { if (xb_ld(&bar[XB_TMO])) break; if (sp > XB_SPIN_CAP) { atomicAdd(&bar[XB_TMO], 1u); break; } }
  }
  nloc = mine > 0u ? mine : 1u; nx = cnt > 0u ? cnt : 1u;
}
__device__ __forceinline__ void xcd_barrier(const XcdBarrier& b, int tid) {
  asm volatile("s_waitcnt vmcnt(0)" ::: "memory");
  __syncthreads();
  if (tid == 0) {
    unsigned* bar = b.bar;
    __builtin_amdgcn_s_waitcnt(0);
    unsigned nloc = b.st[0], nx = b.st[1];
    if (nloc == 0u) { xcd_barrier_complete(bar, b.x, nloc, nx); b.st[0] = nloc; b.st[1] = nx; }
    const unsigned old = xb_add(&bar[XB_XSUB(b.x)], 1u);
    const unsigned gen = old / nloc;
    if (old + 1u == (gen + 1u) * nloc) {
      __builtin_amdgcn_fence(__ATOMIC_RELEASE, "agent");
      asm volatile("s_waitcnt vmcnt(0)" ::: "memory");
      const unsigned og = xb_add(&bar[XB_TOP], 1u);
      const unsigned tg = og / nx;
      if (og + 1u == (tg + 1u) * nx) xb_add(&bar[XB_TOPGEN], 1u);
      else XB_SPIN(xb_ld(&bar[XB_TOPGEN]) == tg, bar);
      __builtin_amdgcn_fence(__ATOMIC_ACQUIRE, "agent");
      xb_add(&bar[XB_XGEN(b.x)], 1u);
      asm volatile("s_waitcnt vmcnt(0)" ::: "memory");
    } else {
      XB_SPIN(xb_ld(&bar[XB_XGEN(b.x)]) == gen, bar);
      __builtin_amdgcn_fence(__ATOMIC_ACQUIRE, "agent");
      asm volatile("s_waitcnt vmcnt(0)" ::: "memory");
    }
  }
  __syncthreads();
}

constexpr int BM = 256, BK = 64, HALF = 128, HTB = HALF * BK * 2, NXCD = 8;
__device__ __forceinline__ int lds_byte(int r, int c) { const int st = (r >> 4) * 2 + (c >> 5), rr = r & 15, cc = c & 31, ob = rr * 64 + cc * 2; return st * 1024 + (ob ^ (((ob >> 9) & 1) << 5)); }
__device__ __forceinline__ void stage_rc(int b, int& R, int& C) { const int st = b / 1024, sb = b % 1024, swz = sb ^ (((sb >> 9) & 1) << 5); R = (st >> 1) * 16 + swz / 64; C = (st & 1) * 32 + (swz % 64) / 2; }
__device__ __forceinline__ int perm32(int rho) { const int n = rho >> 4, i = rho & 15; return 8 * (i >> 2) + 4 * n + (i & 3); }

struct Unit { int pm, pn, a, b, ord; };
__device__ __forceinline__ int xcd_remap(int L, int nunits) { const int q = nunits / NXCD, r = nunits % NXCD, xcd = L % NXCD, off = L / NXCD; return (xcd < r ? xcd * (q + 1) : r * (q + 1) + (xcd - r) * q) + off; }
typedef f32x4 Acc[2][2][4][2];
template <class P, bool SP2>
__device__ __forceinline__ void gemm_phase(LAS unsigned char* lds, const P& p, int G, int c, int tid_in) {
  const int tid = tid_in, wid = __builtin_amdgcn_readfirstlane(tid >> 6), lane = tid & 63, wr = wid >> 2, wc = wid & 3, fr = lane & 15, fq = lane >> 4;
  const int K = p.K, nt = K / BK;
  const int nunits = p.nunits;
  const size_t kstep = (size_t)(BK * 2);
  const unsigned ldsw = (unsigned)wid * 1024u;
  const int aoff = lds_byte(wr * 64 + fr, P::F8 ? fq * 16 : fq * 8), boff = lds_byte(wc * 32 + fr, P::F8 ? fq * 16 : fq * 8);
#define PG8_SA(b, h) (((b) * 2 + (h)) * HTB)
#define PG8_SB(b, h) ((4 + (b) * 2 + (h)) * HTB)
#define PG8_STAGE(bufoff, gbase, voff) do { _Pragma("unroll") for (int _i = 0; _i < 2; ++_i) \
        __builtin_amdgcn_global_load_lds((const unsigned*)((const char*)(gbase) + (voff)[_i]), (LAS unsigned*)(lds + (bufoff) + ldsw + _i * 8192), 16, 0, 0); } while (0)
#define PG8_RD32(p_) __builtin_shufflevector(*(const LAS i32x4*)(p_), *(const LAS i32x4*)((p_) + 16), 0, 1, 2, 3, 4, 5, 6, 7)
#define PG8_LDA(dst, b, h) do { if constexpr (P::F8) { _Pragma("unroll") for (int m = 0; m < 4; ++m) dst##8[m] = PG8_RD32(lds + PG8_SA(b, h) + aoff + m * 2048); } \
        else { _Pragma("unroll") for (int m = 0; m < 4; ++m) _Pragma("unroll") for (int k = 0; k < 2; ++k) dst[m][k] = *(const LAS bf16x8*)(lds + PG8_SA(b, h) + aoff + m * 2048 + k * 1024); } } while (0)
#define PG8_LDB(dst, b, h) do { if constexpr (P::F8) { _Pragma("unroll") for (int n = 0; n < 2; ++n) dst##8[n] = PG8_RD32(lds + PG8_SB(b, h) + boff + n * 2048); } \
        else { _Pragma("unroll") for (int n = 0; n < 2; ++n) _Pragma("unroll") for (int k = 0; k < 2; ++k) dst[n][k] = *(const LAS bf16x8*)(lds + PG8_SB(b, h) + boff + n * 2048 + k * 1024); } } while (0)
#define PG8_MMA(ai, bj, At, Bt) do { __builtin_amdgcn_s_setprio(1); if constexpr (P::F8) { _Pragma("unroll") for (int m = 0; m < 4; ++m) _Pragma("unroll") for (int n = 0; n < 2; ++n) \
        acc[ai][bj][m][n] = __builtin_amdgcn_mfma_scale_f32_16x16x128_f8f6f4(Bt##8[n], At##8[m], acc[ai][bj][m][n], 0, 0, 0, P::SCALE_B, 0, 0x7F7F7F7F); } \
        else { _Pragma("unroll") for (int m = 0; m < 4; ++m) _Pragma("unroll") for (int n = 0; n < 2; ++n) _Pragma("unroll") for (int k = 0; k < 2; ++k) \
        acc[ai][bj][m][n] = __builtin_amdgcn_mfma_f32_16x16x32_bf16(Bt[n][k], At[m][k], acc[ai][bj][m][n], 0, 0, 0); } __builtin_amdgcn_s_setprio(0); } while (0)
#define PG8_WAIT_V(n) asm volatile("s_waitcnt vmcnt(" #n ")" ::: "memory")
#define PG8_WAIT_L(n) asm volatile("s_waitcnt lgkmcnt(" #n ")" ::: "memory")
#define PG8_BAR __builtin_amdgcn_s_barrier()
#define PG8_SCHED __builtin_amdgcn_sched_barrier(0)
#define PG8_DECODE(i, u) do { p.decode(P::CONTIG ? (u_lo + (i)) : xcd_remap((i) * G + c, nunits), u); u.ord = (i); } while (0)
#define PG8_HAS(i) (P::CONTIG ? (u_lo + (i) < u_hi) : ((i) * G + c < nunits))
#define PG8_OFFS(u, vA, vB) do { int _t = tid; asm volatile("" : "+v"(_t)); _Pragma("unroll") for (int _i = 0; _i < 2; ++_i) { int _R, _C; stage_rc(_t * 16 + _i * 8192, _R, _C); \
        const int _Rb = P::PERM ? ((_R & ~31) + perm32(_R & 31)) : _R; _Pragma("unroll") for (int _h = 0; _h < 2; ++_h) { \
        if (_h == 0 || !P::LINA) vA[_h][_i] = p.rowA(u, _h * HALF + _R) + (unsigned)(_C * 2); if (_h == 0 || !P::LINB) vB[_h][_i] = p.rowB(u, _h * HALF + _Rb) + (unsigned)(_C * 2); } } } while (0)
  const int vc_ = (G % 8 == 0) ? (c % 8) * (G / 8) + c / 8 : c;
  const int u_lo = (int)(((long)vc_ * nunits) / G), u_hi = (int)(((long)(vc_ + 1) * nunits) / G);
  if (!PG8_HAS(0)) return;
  Unit cur, nxt; int ui = 0;
  PG8_DECODE(0, cur);
  Acc acc; float zf_ = 0.f; asm volatile("" : "+v"(zf_));
#pragma unroll
  for (int a = 0; a < 2; ++a)
#pragma unroll
    for (int b = 0; b < 2; ++b)
#pragma unroll
      for (int m = 0; m < 4; ++m)
#pragma unroll
        for (int n = 0; n < 2; ++n) acc[a][b][m][n] = (f32x4){zf_, zf_, zf_, zf_};
  bf16x8 At[4][2], B0[2][2], B1[2][2]; i32x8 At8[4], B08[2], B18[2];
  unsigned vA[2][2], vB[2][2];
  PG8_OFFS(cur, vA, vB);
  const char* cA = p.baseA(cur); const char* cB = p.baseB(cur);
  const size_t hA = P::LINA ? p.halfA() : 0, hB = P::LINB ? p.halfB() : 0;
  if constexpr (SP2) {
    PG8_STAGE(PG8_SB(0, 0), cB, vB[0]); PG8_STAGE(PG8_SB(0, 1), (cB) + (P::LINB ? hB : 0), vB[P::LINB ? 0 : 1]); PG8_STAGE(PG8_SA(0, 0), cA, vA[0]); PG8_STAGE(PG8_SA(0, 1), (cA) + (P::LINA ? hA : 0), vA[P::LINA ? 0 : 1]);
    if (wr == 1) PG8_BAR;
    PG8_WAIT_V(2); PG8_BAR;
    PG8_STAGE(PG8_SB(1, 0), cB + kstep, vB[0]); PG8_STAGE(PG8_SA(1, 0), cA + kstep, vA[0]); PG8_STAGE(PG8_SB(1, 1), (cB + kstep) + (P::LINB ? hB : 0), vB[P::LINB ? 0 : 1]);
    PG8_WAIT_V(6); PG8_BAR;
  } else {
    PG8_STAGE(PG8_SB(0, 0), cB, vB[0]); PG8_STAGE(PG8_SA(0, 0), cA, vA[0]); PG8_STAGE(PG8_SB(0, 1), (cB) + (P::LINB ? hB : 0), vB[P::LINB ? 0 : 1]); PG8_STAGE(PG8_SA(0, 1), (cA) + (P::LINA ? hA : 0), vA[P::LINA ? 0 : 1]);
    if (wr == 1) PG8_BAR;
    PG8_WAIT_V(4); PG8_BAR;
    PG8_STAGE(PG8_SB(1, 0), cB + kstep, vB[0]); PG8_STAGE(PG8_SA(1, 0), cA + kstep, vA[0]); PG8_STAGE(PG8_SB(1, 1), (cB + kstep) + (P::LINB ? hB : 0), vB[P::LINB ? 0 : 1]);
    PG8_WAIT_V(6); PG8_BAR;
  }
  for (;;) {
    const bool has_next = PG8_HAS(ui + 1);
    if (has_next) PG8_DECODE(ui + 1, nxt);
    const char* nA = has_next ? p.baseA(nxt) : cA; const char* nB = has_next ? p.baseB(nxt) : cB;
    for (int t = 0; t < nt; t += 2) {
      const bool last = (t == nt - 2);
      const char* a1 = cA + (size_t)(t + 1) * kstep;
      const char* a2 = last ? nA : cA + (size_t)(t + 2) * kstep; const char* b2 = last ? nB : cB + (size_t)(t + 2) * kstep;
      const char* a3 = a2 + kstep; const char* b3 = b2 + kstep;
      if constexpr (SP2) {
        PG8_LDB(B0, 0, 0); PG8_LDB(B1, 0, 1); PG8_SCHED; PG8_LDA(At, 0, 0); PG8_STAGE(PG8_SA(1, 1), (a1) + (P::LINA ? hA : 0), vA[P::LINA ? 0 : 1]);
        PG8_WAIT_V(8); PG8_WAIT_L(0); PG8_BAR; PG8_MMA(0, 0, At, B0); PG8_MMA(0, 1, At, B1); PG8_BAR; PG8_SCHED;
        if (last && has_next) { PG8_OFFS(nxt, vA, vB); }
        PG8_LDA(At, 0, 1); PG8_STAGE(PG8_SB(0, 0), b2, vB[0]); PG8_STAGE(PG8_SB(0, 1), (b2) + (P::LINB ? hB : 0), vB[P::LINB ? 0 : 1]); PG8_STAGE(PG8_SA(0, 0), a2, vA[0]);
        PG8_WAIT_V(8); PG8_WAIT_L(0); PG8_BAR; PG8_MMA(1, 0, At, B0); PG8_MMA(1, 1, At, B1); PG8_BAR; PG8_SCHED;
        PG8_LDB(B0, 1, 0); PG8_LDB(B1, 1, 1); PG8_SCHED; PG8_LDA(At, 1, 0); PG8_STAGE(PG8_SA(0, 1), (a2) + (P::LINA ? hA : 0), vA[P::LINA ? 0 : 1]);
        PG8_WAIT_V(8); PG8_WAIT_L(0); PG8_BAR; PG8_MMA(0, 0, At, B0); PG8_MMA(0, 1, At, B1); PG8_BAR; PG8_SCHED;
        PG8_LDA(At, 1, 1); PG8_STAGE(PG8_SB(1, 0), b3, vB[0]); PG8_STAGE(PG8_SB(1, 1), (b3) + (P::LINB ? hB : 0), vB[P::LINB ? 0 : 1]); PG8_STAGE(PG8_SA(1, 0), a3, vA[0]);
        PG8_WAIT_V(8); PG8_WAIT_L(0); PG8_BAR; PG8_MMA(1, 0, At, B0); PG8_MMA(1, 1, At, B1); PG8_BAR; PG8_SCHED;
      } else {
        PG8_LDB(B0, 0, 0); PG8_SCHED; PG8_LDA(At, 0, 0); PG8_STAGE(PG8_SA(1, 1), (a1) + (P::LINA ? hA : 0), vA[P::LINA ? 0 : 1]);
        PG8_WAIT_L(8); PG8_BAR; PG8_WAIT_L(0); PG8_MMA(0, 0, At, B0); PG8_BAR; PG8_SCHED;
        if (last && has_next) { PG8_OFFS(nxt, vA, vB); }
        PG8_LDB(B1, 0, 1); PG8_STAGE(PG8_SB(0, 0), b2, vB[0]);
        PG8_BAR; PG8_WAIT_L(0); PG8_MMA(0, 1, At, B1); PG8_BAR;
        PG8_LDA(At, 0, 1); PG8_STAGE(PG8_SA(0, 0), a2, vA[0]);
        PG8_BAR; PG8_WAIT_L(0); PG8_MMA(1, 0, At, B0); PG8_BAR; PG8_SCHED;
        PG8_STAGE(PG8_SB(0, 1), (b2) + (P::LINB ? hB : 0), vB[P::LINB ? 0 : 1]);
        PG8_WAIT_V(6); PG8_BAR; PG8_MMA(1, 1, At, B1); PG8_BAR;
        PG8_LDB(B0, 1, 0); PG8_SCHED; PG8_LDA(At, 1, 0); PG8_STAGE(PG8_SA(0, 1), (a2) + (P::LINA ? hA : 0), vA[P::LINA ? 0 : 1]);
        PG8_WAIT_L(8); PG8_BAR; PG8_WAIT_L(0); PG8_MMA(0, 0, At, B0); PG8_BAR; PG8_SCHED;
        PG8_LDB(B1, 1, 1); PG8_STAGE(PG8_SB(1, 0), b3, vB[0]);
        PG8_BAR; PG8_WAIT_L(0); PG8_MMA(0, 1, At, B1); PG8_BAR;
        PG8_LDA(At, 1, 1); PG8_STAGE(PG8_SA(1, 0), a3, vA[0]);
        PG8_BAR; PG8_WAIT_L(0); PG8_MMA(1, 0, At, B0); PG8_BAR; PG8_SCHED;
        PG8_STAGE(PG8_SB(1, 1), (b3) + (P::LINB ? hB : 0), vB[P::LINB ? 0 : 1]);
        PG8_WAIT_V(6); PG8_BAR; PG8_MMA(1, 1, At, B1); PG8_BAR;
      }
    }
    if constexpr (P::ALIGN) { if (wr == 0) PG8_BAR; }
    { int fr_e = fr, fq_e = fq; asm volatile("" : "+v"(fr_e), "+v"(fq_e)); p.epi(acc, cur, wr, wc, fr_e, fq_e); }
    if (!has_next) break;
    zf_ = 0.f; asm volatile("" : "+v"(zf_));
#pragma unroll
    for (int a = 0; a < 2; ++a)
#pragma unroll
      for (int b = 0; b < 2; ++b)
#pragma unroll
        for (int m = 0; m < 4; ++m)
#pragma unroll
          for (int n = 0; n < 2; ++n) acc[a][b][m][n] = (f32x4){zf_, zf_, zf_, zf_};
    cur = nxt; cA = nA; cB = nB; ++ui;
    if constexpr (P::ALIGN) { if (wr == 1) PG8_BAR; }
  }
  PG8_WAIT_V(0);
  if constexpr (!P::ALIGN) { if (wr == 0) PG8_BAR; }
  PG8_BAR;
#undef PG8_SA
#undef PG8_SB
#undef PG8_STAGE
#undef PG8_RD32
#undef PG8_LDA
#undef PG8_LDB
#undef PG8_MMA
#undef PG8_WAIT_V
#undef PG8_WAIT_L
#undef PG8_BAR
#undef PG8_SCHED
#undef PG8_DECODE
#undef PG8_HAS
#undef PG8_OFFS
}
}
namespace mk {
constexpr size_t MiB = 1u << 20;
constexpr size_t WS_CTL = 0, CTL_ZERO_BYTES = 65536;
constexpr size_t WS_MOD = 65536;
constexpr size_t WS_LAML = 262144;
constexpr size_t WS_WIN_T = 1 * MiB, WS_WGLU_T = 5 * MiB, WS_WMIX_T = 6 * MiB, WS_WFOUR_T = 8 * MiB, WS_WROUT_T = 10 * MiB;
constexpr size_t WS_DMT = 10 * MiB + 512 * 1024, WS_W1 = 10 * MiB + 768 * 1024, WS_W2 = 10 * MiB + 896 * 1024;
constexpr size_t WS_WEXP = 12 * MiB, EXP_STRIDE = 3 * MiB / 2, EXP_DOFF = 1 * MiB;
constexpr size_t WS_R = 110 * MiB;
constexpr size_t WS_WS = WS_R, WS_TT = WS_R + 8 * MiB, WS_A0 = WS_R + 34 * MiB, WS_AS5 = WS_R + 67 * MiB, WS_Q = WS_R + 103 * MiB, WS_K = WS_R + 119 * MiB,
                 WS_VT = WS_R + 136 * MiB, WS_SST = WS_R + 153 * MiB, WS_GB = WS_R + 177 * MiB, WS_CONCAT = WS_R + 193 * MiB;
constexpr size_t WS_F = WS_R, WS_LTOK = WS_R + 32 * MiB, WS_ASG = WS_R + 36 * MiB, WS_HID = WS_R + 42 * MiB, WS_YAS = WS_R + 130 * MiB,
                 WS_A1 = WS_R + 306 * MiB;
constexpr size_t WS_X1 = WS_R, WS_X2 = WS_R + 64 * MiB, WS_FB = WS_R + 128 * MiB;
constexpr size_t WS_HOPT = WS_R + 338 * MiB;
constexpr size_t WS_WEXP1 = WS_R + 338 * MiB;
constexpr size_t EXP1_STRIDE = 1 * MiB, EXP1_DOFF = 512 * 1024;
constexpr size_t WS_NEED = WS_R + 403 * MiB;
constexpr int HALF_CAP_ROWS = 90112;
constexpr int CW_BAR = 4096, CW_CNT = 8192  , CW_DQ0 = 12288, CW_DQ1 = 12352, CW_DONE = 13312  ;

struct Args { const float* in[31]; float* h; unsigned char* ws; int ph_lo, ph_hi, flags, pad; };
enum { IN_X = 0, IN_C, IN_CTX, IN_CCTX, IN_WADA, IN_BADA, IN_WIN, IN_LRE, IN_LIM, IN_LDT, IN_BRE, IN_BIM, IN_CRE, IN_CIM, IN_S5D, IN_WGLU, IN_BGLU, IN_QG, IN_KG,
       IN_RPB, IN_WMIX, IN_WFOUR, IN_BFOUR, IN_WROUT, IN_RBIAS, IN_WEG, IN_WEU, IN_WED, IN_WSG, IN_WSU, IN_WSD };
constexpr int FLAG_SKIP_EXPERTS = 1;

struct Ctx {
  LAS unsigned char* lds; const Args* a; unsigned char* ws; int tid, lane, wave, G, c;
};

__device__ __forceinline__ u32x4 pack8(const f32x4& v0, const f32x4& v1) { u32x4 w; w.x = cvt_pk_bf16(v0[0], v0[1]); w.y = cvt_pk_bf16(v0[2], v0[3]); w.z = cvt_pk_bf16(v1[0], v1[1]); w.w = cvt_pk_bf16(v1[2], v1[3]); return w; }
__device__ __forceinline__ int rowmap(int code, int n) {
  if (code == 1) { if (n < 512 || n >= 1536) return n; const int blk = n & ~255, c = n & 255; return blk + 128 * ((c >> 5) & 1) + 32 * (c >> 6) + (c & 31); }
  if (code == 2) return 256 * (n >> 7) + (n & 127);
  if (code == 3) return 256 * (n >> 7) + 128 + (n & 127);
  return n;
}
__device__ __forceinline__ void transpose_item(const float* W, int K, int N, bf16_t* WT, int code, LAS unsigned char* scr, int item, int lane) {
  const int nblk = N / 64, kb = item / nblk, nb = item % nblk, k0 = 64 * kb, n0 = 64 * nb;
  const int q = lane >> 4, a = lane & 15;
  f32x4 v[16];
  const float* src = W + (size_t)(k0 + 2 * q) * N + n0 + 4 * a;
#pragma unroll
  for (int i = 0; i < 16; ++i) v[i] = *(const f32x4*)(src + (size_t)((i & 1) + 8 * (i >> 1)) * N);
#pragma unroll
  for (int ii = 0; ii < 8; ++ii) { const int dsw = q + 4 * (ii ^ (a & 7));
#pragma unroll
    for (int j = 0; j < 4; ++j) *(LAS unsigned*)(scr + (4 * a + j) * 128 + 4 * dsw) = cvt_pk_bf16(v[2 * ii][j], v[2 * ii + 1][j]); }
  asm volatile("s_waitcnt lgkmcnt(0)" ::: "memory");
  const int c = lane & 7;
#pragma unroll
  for (int jj = 0; jj < 8; ++jj) { const int n = (lane >> 3) + 8 * jj, cs = c ^ ((n >> 2) & 7);
    const u32x4 o = *(const LAS u32x4*)(scr + n * 128 + 16 * cs);
    *(u32x4*)(WT + (size_t)rowmap(code, n0 + n) * K + k0 + 8 * c) = o; }
  asm volatile("s_waitcnt lgkmcnt(0)" ::: "memory");
}
__device__ __forceinline__ void transpose_item8(const float* W, int K, int N, unsigned char* WT, int code, float scale, LAS unsigned char* scr, int item, int lane) {
  const int nblk = N / 64, kb = item / nblk, nb = item % nblk, k0 = 64 * kb, n0 = 64 * nb;
  const int q = lane >> 4, a = lane & 15;
  f32x4 v[16];
  const float* src = W + (size_t)(k0 + 4 * q) * N + n0 + 4 * a;
#pragma unroll
  for (int i = 0; i < 16; ++i) v[i] = *(const f32x4*)(src + (size_t)((i & 3) + 16 * (i >> 2)) * N);
#pragma unroll
  for (int ib = 0; ib < 4; ++ib) { const int dsw = q + 4 * (ib ^ (a & 3));
#pragma unroll
    for (int j = 0; j < 4; ++j) { int w = 0; w = __builtin_amdgcn_cvt_pk_fp8_f32(v[4 * ib][j] * scale, v[4 * ib + 1][j] * scale, w, false); w = __builtin_amdgcn_cvt_pk_fp8_f32(v[4 * ib + 2][j] * scale, v[4 * ib + 3][j] * scale, w, true);
      *(LAS int*)(scr + (4 * a + j) * 64 + 4 * dsw) = w; } }
  asm volatile("s_waitcnt lgkmcnt(0)" ::: "memory");
  const int c = lane & 3;
#pragma unroll
  for (int jj = 0; jj < 4; ++jj) { const int n = (lane >> 2) + 16 * jj, cs = c ^ ((n >> 2) & 3);
    const u32x4 o = *(const LAS u32x4*)(scr + n * 64 + 16 * cs);
    *(u32x4*)(WT + (size_t)rowmap(code, n0 + n) * K + k0 + 16 * c) = o; }
  asm volatile("s_waitcnt lgkmcnt(0)" ::: "memory");
}
constexpr int IT_WIN = 512, IT_GLU = 64, IT_MIX = 256, IT_FOUR = 256, IT_ROUT = 32, IT_SMALL = IT_WIN + IT_GLU + IT_MIX + IT_FOUR + IT_ROUT, IT_EXP = 192;
__device__ __forceinline__ void small_item(const Ctx& X, LAS unsigned char* scr, int it) {
  const Args& a = *X.a; unsigned char* ws = X.ws;
  if (it < IT_WIN) { transpose_item(a.in[IN_WIN], 1024, 2048, (bf16_t*)(ws + WS_WIN_T), 1, scr, it, X.lane); return; } it -= IT_WIN;
  if (it < IT_GLU) { transpose_item(a.in[IN_WGLU], 512, 512, (bf16_t*)(ws + WS_WGLU_T), 0, scr, it, X.lane); return; } it -= IT_GLU;
  if (it < IT_MIX) { transpose_item(a.in[IN_WMIX], 1024, 1024, (bf16_t*)(ws + WS_WMIX_T), 0, scr, it, X.lane); return; } it -= IT_MIX;
  if (it < IT_FOUR) { transpose_item(a.in[IN_WFOUR], 1024, 1024, (bf16_t*)(ws + WS_WFOUR_T), 0, scr, it, X.lane); return; } it -= IT_FOUR;
  { const int l = it >> 4; transpose_item(a.in[IN_WROUT] + (size_t)l * 1024 * 64, 1024, 64, (bf16_t*)(ws + WS_WROUT_T) + (size_t)l * 64 * 1024, 0, scr, it & 15, X.lane); }
}
__device__ __forceinline__ void expert_item(const Ctx& X, LAS unsigned char* scr, int layer, int it) {
  const Args& a = *X.a; const int e = it / IT_EXP, r = it % IT_EXP;
  bf16_t* gu = (bf16_t*)(X.ws + (layer == 0 ? WS_WEXP + (size_t)e * EXP_STRIDE : WS_WEXP1 + (size_t)e * EXP1_STRIDE));
  bf16_t* dt = (bf16_t*)(X.ws + (layer == 0 ? WS_WEXP + (size_t)e * EXP_STRIDE + EXP_DOFF : WS_WEXP1 + (size_t)e * EXP1_STRIDE + EXP1_DOFF));
  const float *wg, *wu, *wd;
  if (e < 64) { const size_t o = ((size_t)layer * 64 + e) * 262144; wg = a.in[IN_WEG] + o; wu = a.in[IN_WEU] + o; wd = a.in[IN_WED] + o; }
  else { const size_t o = (size_t)layer * 262144; wg = a.in[IN_WSG] + o; wu = a.in[IN_WSU] + o; wd = a.in[IN_WSD] + o; }
  if (r < 64) transpose_item8(wg, 1024, 256, (unsigned char*)gu, 2, 32.f, scr, r, X.lane);
  else if (r < 128) transpose_item8(wu, 1024, 256, (unsigned char*)gu, 3, 32.f, scr, r - 64, X.lane);
  else transpose_item(wd, 256, 1024, dt, 0, scr, r - 128, X.lane);
}
__device__ __forceinline__ void transpose_work(const Ctx& X, unsigned* ctr, int first_small, int n_small, int layer, int n_exp_items, unsigned* done = nullptr, unsigned need = 0u) {
  LAS unsigned char* scr = X.lds + X.wave * 8192;
  volatile LAS int* shb = (volatile LAS int*)(X.lds + LDS_MISC_OFF + 1024);
  const int total = n_small + n_exp_items;
  const int per = done ? 1 : 4;
  for (;;) {
    __syncthreads();
    if (X.tid == 0) { int b = total; if (!done || __hip_atomic_load(done, __ATOMIC_RELAXED, __HIP_MEMORY_SCOPE_AGENT) < need) b = (int)atomicAdd(ctr, (unsigned)(8 * per)); shb[0] = b; }
    __syncthreads();
    const int base = shb[0];
    if (base >= total) break;
    for (int k = 0; k < per; ++k) { const int it = base + X.wave * per + k; if (it >= total) break;
      if (it < n_small) small_item(X, scr, first_small + it); else expert_item(X, scr, layer, it - n_small); }
  }
}

__device__ __forceinline__ void p0_adaln(const Ctx& X, int it) {
  const Args& a = *X.a; const int layer = it / 48, ct = it % 48, col = ct * 128 + X.lane;
  LAS float* sl = (LAS float*)X.lds;
  for (int i = X.tid; i < 2048; i += NTHR) { const float v = i < 1024 ? a.in[IN_C][i] : a.in[IN_CCTX][i - 1024]; sl[i] = v / (1.f + __expf(-v)); }
  __syncthreads();
  const float* W = a.in[IN_WADA] + (size_t)layer * 1024 * 6144 + col;
  float a0 = 0.f, a1 = 0.f, b0 = 0.f, b1 = 0.f; const int k0 = X.wave * 128;
#pragma unroll 16
  for (int k = 0; k < 128; ++k) { const float w0 = W[(size_t)(k0 + k) * 6144], w1 = W[(size_t)(k0 + k) * 6144 + 64]; const float s0 = sl[k0 + k], s1 = sl[1024 + k0 + k];
    a0 += s0 * w0; a1 += s1 * w0; b0 += s0 * w1; b1 += s1 * w1; }
  LAS float* red = sl + 2048;
  red[(X.wave * 128 + X.lane) * 2] = a0; red[(X.wave * 128 + X.lane) * 2 + 1] = a1; red[(X.wave * 128 + 64 + X.lane) * 2] = b0; red[(X.wave * 128 + 64 + X.lane) * 2 + 1] = b1;
  __syncthreads();
  if (X.tid < 256) { const int l = X.tid & 127, v = X.tid >> 7; float s = 0.f;
#pragma unroll
    for (int w = 0; w < 8; ++w) s += red[(w * 128 + l) * 2 + v];
    s += a.in[IN_BADA][layer * 6144 + ct * 128 + l];
    float* mod = (float*)(X.ws + WS_MOD);
    if (layer == 0) mod[v * 6144 + ct * 128 + l] = s; else if (v == 0) mod[2 * 6144 + ct * 128 + l] = s; }
  __syncthreads();
}

__device__ __forceinline__ void p0_s5tables(const Ctx& X, int g, int part) {
  const Args& a = *X.a;
  LAS f32x2* POW = (LAS f32x2*)X.lds;
  LAS f32x2* BB = (LAS f32x2*)(X.lds + 33792);
  LAS f32x2* CC = (LAS f32x2*)(X.lds + 33792 + 16384);
  LAS float* KK = (LAS float*)(X.lds + 33792 + 32768);
  LAS float* DD = (LAS float*)(X.lds + 33792 + 32768 + 65536);
  const int tid = X.tid;
  if (tid < 128) {
    const int dir = tid >> 6, p = tid & 63, idx = (dir * 32 + g) * 64 + p;
    const float lr = fminf(a.in[IN_LRE][idx], -1e-4f), li = a.in[IN_LIM][idx], dt = expf(a.in[IN_LDT][dir * 32 + g]);
    for (int tau = 0; tau <= 32; ++tau) { const float mg = expf(lr * dt * (float)tau); float sn, cs; sincospif(li * dt * (float)tau * 0.318309886183790672f, &sn, &cs); POW[(dir * 33 + tau) * 64 + p] = (f32x2){mg * cs, mg * sn}; }
    const f32x2 l1 = POW[(dir * 33 + 1) * 64 + p], l32 = POW[(dir * 33 + 32) * 64 + p];
    if (part == 0) ((float2*)(X.ws + WS_LAML))[idx] = make_float2(l32.x, l32.y);
    const float nr = l1.x - 1.f, ni = l1.y, den = lr * lr + li * li, cr = (nr * lr + ni * li) / den, ci = (ni * lr - nr * li) / den;
    for (int c = 0; c < 16; ++c) { const float xr = a.in[IN_BRE][idx * 16 + c], xi = a.in[IN_BIM][idx * 16 + c]; BB[(dir * 64 + p) * 16 + c] = (f32x2){cr * xr - ci * xi, cr * xi + ci * xr}; }
  }
  for (int i = tid; i < 2048; i += NTHR) { const int dir = i >> 10, c = (i >> 6) & 15, p = i & 63; const int gi = ((dir * 32 + g) * 16 + c) * 64 + p; CC[i] = (f32x2){a.in[IN_CRE][gi], a.in[IN_CIM][gi]}; }
  if (tid < 16) DD[tid] = a.in[IN_S5D][g * 16 + tid];
  __syncthreads();
  for (int combo = tid; combo < 1024; combo += NTHR) {
    const int dir = combo >> 9, tau = (combo >> 4) & 31, c = combo & 15;
    float accv[16];
#pragma unroll
    for (int j = 0; j < 16; ++j) accv[j] = 0.f;
#pragma unroll 2
    for (int p = 0; p < 64; ++p) {
      const f32x2 cc = CC[(dir * 16 + c) * 64 + p], pw = POW[(dir * 33 + tau) * 64 + p];
      const float zr = cc.x * pw.x - cc.y * pw.y, zi = cc.x * pw.y + cc.y * pw.x;
      const LAS f32x4* bp = (const LAS f32x4*)(BB + (dir * 64 + p) * 16);
#pragma unroll
      for (int j = 0; j < 8; ++j) { const f32x4 b = bp[j]; accv[2 * j] += zr * b.x - zi * b.y; accv[2 * j + 1] += zr * b.z - zi * b.w; }
    }
#pragma unroll
    for (int j = 0; j < 4; ++j) *(LAS f32x4*)(KK + ((dir * 32 + tau) * 16 + c) * 16 + 4 * j) = (f32x4){accv[4 * j], accv[4 * j + 1], accv[4 * j + 2], accv[4 * j + 3]};
  }
  __syncthreads();
  bf16_t* TT = (bf16_t*)(X.ws + WS_TT) + (size_t)g * 512 * 768;
  for (int q = part * 12288 + tid; q < (part + 1) * 12288; q += NTHR) {
    const int row = q / 96, cc8 = q % 96, i = row >> 4, c = row & 15; f32x4 v0, v1;
    if (cc8 < 64) {
      const int s = cc8 >> 1, c0 = (cc8 & 1) * 8;
      const int dir = s < i ? 0 : 1, tau = s < i ? i - s : s - i;
      const LAS f32x4* kp = (const LAS f32x4*)(KK + ((dir * 32 + tau) * 16 + c) * 16 + c0);
      v0 = kp[0]; v1 = kp[1];
      if (s == i) { const LAS f32x4* k0p = (const LAS f32x4*)(KK + ((0 * 32 + 0) * 16 + c) * 16 + c0); v0 += k0p[0]; v1 += k0p[1];
        const float d = DD[c]; const int dj = c - c0;
        if (dj >= 0 && dj < 4) v0[dj] += d; else if (dj >= 4 && dj < 8) v1[dj - 4] += d; }
    } else {
      const int kk = (cc8 - 64) * 8, dir = kk >> 7, ri = (kk >> 6) & 1, p0 = kk & 63, tau = dir == 0 ? i + 1 : 32 - i;
      const LAS f32x4* cp = (const LAS f32x4*)(CC + (dir * 16 + c) * 64 + p0); const LAS f32x4* pp = (const LAS f32x4*)(POW + (dir * 33 + tau) * 64 + p0);
      float v[8];
#pragma unroll
      for (int j = 0; j < 4; ++j) { const f32x4 cc = cp[j], pw = pp[j];
        v[2 * j] = ri == 0 ? (cc.x * pw.x - cc.y * pw.y) : -(cc.x * pw.y + cc.y * pw.x); v[2 * j + 1] = ri == 0 ? (cc.z * pw.z - cc.w * pw.w) : -(cc.z * pw.w + cc.w * pw.z); }
      v0 = (f32x4){v[0], v[1], v[2], v[3]}; v1 = (f32x4){v[4], v[5], v[6], v[7]};
    }
    *(u32x4*)(TT + (size_t)row * 768 + cc8 * 8) = pack8(v0, v1);
  }
  bf16_t* WSm = (bf16_t*)(X.ws + WS_WS) + (size_t)g * 256 * 512;
  for (int q = part * 4096 + tid; q < (part + 1) * 4096; q += NTHR) {
    const int n = q >> 6, cc8 = q & 63, dir = n >> 7, ri = (n >> 6) & 1, p = n & 63, s = cc8 >> 1, c0 = (cc8 & 1) * 8, tau = dir == 0 ? 31 - s : s;
    const f32x2 pw = POW[(dir * 33 + tau) * 64 + p]; const LAS f32x4* bp = (const LAS f32x4*)(BB + (dir * 64 + p) * 16 + c0); float v[8];
#pragma unroll
    for (int j = 0; j < 4; ++j) { const f32x4 b = bp[j]; v[2 * j] = ri == 0 ? (pw.x * b.x - pw.y * b.y) : (pw.x * b.y + pw.y * b.x); v[2 * j + 1] = ri == 0 ? (pw.x * b.z - pw.y * b.w) : (pw.x * b.w + pw.y * b.z); }
    *(u32x4*)(WSm + (size_t)n * 512 + cc8 * 8) = pack8((f32x4){v[0], v[1], v[2], v[3]}, (f32x4){v[4], v[5], v[6], v[7]});
  }
  __syncthreads();
}

__device__ __forceinline__ void p0_dftconst(const Ctx& X, int idx) {
  for (int q = idx * NTHR + X.tid; q < 32768; q += 32 * NTHR) {
    float v[8]; bf16_t* dst;
    if (q < 16384) {
      const int R = q >> 5, c0 = (q & 31) * 8, ri = R >> 8, m = R & 255; dst = (bf16_t*)(X.ws + WS_DMT) + (size_t)R * 256 + c0;
#pragma unroll
      for (int j = 0; j < 8; ++j) { float s, c; sincospif((float)(((c0 + j) * m) & 255) * (1.f / 128.f), &s, &c); v[j] = ri == 0 ? c : -s; }
    } else if (q < 24576) {
      const int q2 = q - 16384, R = q2 >> 5, c0 = (q2 & 31) * 8, rip = R >> 7, ka = R & 127; dst = (bf16_t*)(X.ws + WS_W1) + (size_t)R * 256 + c0;
#pragma unroll
      for (int j = 0; j < 8; ++j) { const int C = c0 + j, ri = C >> 7, ta = C & 127; float s, c; sincospif((float)((ka * ta) & 127) * (1.f / 64.f), &s, &c);
        v[j] = (rip == ri) ? c : (rip == 0 ? s : -s); }
    } else {
      const int q2 = q - 24576, R = q2 >> 5, c0 = (q2 & 31) * 8; dst = (bf16_t*)(X.ws + WS_W2) + (size_t)R * 256 + c0;
#pragma unroll
      for (int j = 0; j < 8; ++j) { const int C = c0 + j, rip = C >> 7, tb = C & 127; float s, c; sincospif((float)((R * tb) & 127) * (1.f / 64.f), &s, &c);
        v[j] = R < 128 ? (rip == 0 ? c : s) * (1.f / 2048.f) : 0.f; }
    }
    u32x4 o; o.x = cvt_pk_bf16(v[0], v[1]); o.y = cvt_pk_bf16(v[2], v[3]); o.z = cvt_pk_bf16(v[4], v[5]); o.w = cvt_pk_bf16(v[6], v[7]);
    *(u32x4*)dst = o;
  }
}

__device__ __forceinline__ void phase_prep(const Ctx& X, int rep) {
  const int c = X.c;
  if (c < 96) p0_adaln(X, c);
  else if (c < 224) p0_s5tables(X, (c - 96) >> 2, (c - 96) & 3);
  else p0_dftconst(X, c - 224);
  __syncthreads();
  unsigned* ctl = (unsigned*)(X.ws + WS_CTL);
  transpose_work(X, ctl + CW_DQ0 + 128 * rep, 0, IT_SMALL, (X.a->flags & 2) ? 1 : 0, (X.a->flags & FLAG_SKIP_EXPERTS) ? 0 : 65 * IT_EXP);
}

__device__ __forceinline__ void modulate_row(const float* hrow, const float* shift, const float* scale, bf16_t* orow, int lane) {
  const f32x4* xr = (const f32x4*)hrow + lane; f32x4 v[4]; float ss = 0.f;
#pragma unroll
  for (int j = 0; j < 4; ++j) { v[j] = xr[64 * j]; ss += (v[j].x * v[j].x + v[j].y * v[j].y) + (v[j].z * v[j].z + v[j].w * v[j].w); }
  const float r = rsqrtf(wave_sum(ss) * (1.f / 1024.f) + 1e-6f);
  u32x2* o8 = (u32x2*)orow + lane;
#pragma unroll
  for (int j = 0; j < 4; ++j) { const f32x4 sh = ((const f32x4*)shift)[lane + 64 * j], sc = ((const f32x4*)scale)[lane + 64 * j];
    u32x2 w; w.x = cvt_pk_bf16(v[j].x * r * (1.f + sc.x) + sh.x, v[j].y * r * (1.f + sc.y) + sh.y); w.y = cvt_pk_bf16(v[j].z * r * (1.f + sc.z) + sh.z, v[j].w * r * (1.f + sc.w) + sh.w);
    o8[64 * j] = w; }
}
__device__ __forceinline__ void phase_mod0(const Ctx& X) {
  const Args& a = *X.a; const float* mod = (const float*)(X.ws + WS_MOD); bf16_t* A0 = (bf16_t*)(X.ws + WS_A0);
  const int gw = X.c * NWAVES + X.wave, NGW = X.G * NWAVES;
  for (int r = gw; r < NROW; r += NGW) {
    if (r < TOK) modulate_row(a.in[IN_X] + (size_t)r * 1024, mod, mod + 1024, A0 + (size_t)r * 1024, X.lane);
    else modulate_row(a.in[IN_CTX] + (size_t)(r - TOK) * 1024, mod + 6144, mod + 6144 + 1024, A0 + (size_t)r * 1024, X.lane);
  }
}


struct G1 {
  static constexpr bool PERM = true; static constexpr bool F8 = false; static constexpr int SCALE_B = 0x7A7A7A7A; static constexpr bool CONTIG = false; static constexpr bool ALIGN = true; static constexpr bool LINA = true, LINB = true; __device__ __forceinline__ size_t halfA() const { return 128u * 2048u; } __device__ __forceinline__ size_t halfB() const { return 128u * 2048u; } int K, nunits; unsigned char* ws; const float* qg; const float* kg;
  __device__ __forceinline__ void decode(int w, Unit& u) const { if (w < 390) { u.a = 0; u.pm = w / 6; u.pn = w % 6; } else { const int w2 = w - 390; u.a = 1; u.pm = w2 & 1; u.pn = w2 >> 1; } u.b = 0; }
  __device__ __forceinline__ const char* baseA(const Unit& u) const { return (const char*)ws + (u.a == 0 ? WS_A0 : WS_WIN_T + (size_t)1536 * 2048); }
  __device__ __forceinline__ const char* baseB(const Unit& u) const { return (const char*)ws + (u.a == 0 ? WS_WIN_T : WS_A0); }
  __device__ __forceinline__ unsigned rowA(const Unit& u, int r) const { return (unsigned)(u.pm * 256 + r) * 2048u; }
  __device__ __forceinline__ unsigned rowB(const Unit& u, int r) const { return (unsigned)(u.pn * 256 + r) * 2048u; }
  __device__ __forceinline__ void epi(const Acc& acc, const Unit& u, int wr, int wc, int fr, int fq) const {
    if (u.a == 1) {
      bf16_t* VT = (bf16_t*)(ws + WS_VT);
#pragma unroll
      for (int ai = 0; ai < 2; ++ai)
#pragma unroll
        for (int m = 0; m < 4; ++m) { const int dd = u.pm * 256 + ai * 128 + wr * 64 + m * 16 + fr, head = dd >> 6, d = dd & 63;
#pragma unroll
          for (int bj = 0; bj < 2; ++bj) { const int t0 = u.pn * 256 + bj * 128 + wc * 32 + 8 * fq, kr = t0 >> 6, cg = (t0 >> 3) & 7;
            *(u32x4*)(VT + ((((size_t)(head * 260 + kr) * 8 + cg) * 64 + d) * 8)) = pack8(acc[ai][bj][m][0], acc[ai][bj][m][1]); } }
      return;
    }
    if (u.pn < 2) {
      bf16_t* AS5 = (bf16_t*)(ws + WS_AS5);
#pragma unroll
      for (int ai = 0; ai < 2; ++ai)
#pragma unroll
        for (int m = 0; m < 4; ++m) { const int row = u.pm * 256 + ai * 128 + wr * 64 + m * 16 + fr; int crow, s;
          if (row < TOK) { crow = row >> 5; s = row & 31; } else { const int j = row - TOK; crow = 512 + (j >> 5); s = j & 31; }
#pragma unroll
          for (int bj = 0; bj < 2; ++bj) { const int g = 16 * u.pn + 8 * bj + 2 * wc + (fq >> 1), c0 = 8 * (fq & 1);
            *(u32x4*)(AS5 + ((size_t)(g * 768 + crow) * 768 + s * 16 + c0)) = pack8(acc[ai][bj][m][0], acc[ai][bj][m][1]); } }
      return;
    }
    const bool isq = u.pn < 4;
    if (isq && u.pm == 64) return;
    const int head = 4 * ((u.pn - 2) & 1) + wc; const float* gain = isq ? qg : kg;
    bf16_t* dst = isq ? (bf16_t*)(ws + WS_Q) : (bf16_t*)(ws + WS_K);
    f32x4 gv[2][2];
#pragma unroll
    for (int bj = 0; bj < 2; ++bj) { gv[bj][0] = *(const f32x4*)(gain + 32 * bj + 8 * fq); gv[bj][1] = *(const f32x4*)(gain + 32 * bj + 8 * fq + 4); }
#pragma unroll
    for (int ai = 0; ai < 2; ++ai)
#pragma unroll
      for (int m = 0; m < 4; ++m) { const int row = u.pm * 256 + ai * 128 + wr * 64 + m * 16 + fr; float ss = 0.f;
#pragma unroll
        for (int bj = 0; bj < 2; ++bj)
#pragma unroll
          for (int n = 0; n < 2; ++n) { const f32x4 x = acc[ai][bj][m][n]; ss += (x[0] * x[0] + x[1] * x[1]) + (x[2] * x[2] + x[3] * x[3]); }
        ss += sx(ss, 16); ss += sx(ss, 32);
        const float rinv = rsqrtf(ss * (1.f / 64.f) + 1e-6f);
#pragma unroll
        for (int bj = 0; bj < 2; ++bj) { const f32x4 v0 = acc[ai][bj][m][0] * rinv * gv[bj][0], v1 = acc[ai][bj][m][1] * rinv * gv[bj][1];
          if (isq) *(u32x4*)(dst + (size_t)row * 512 + head * 64 + 32 * bj + 8 * fq) = pack8(v0, v1);
          else { const int kr = row >> 6, cg = (row >> 3) & 7, k8 = row & 7, ks = 2 * bj + (fq >> 1), hh2 = fq & 1;
            *(u32x4*)(dst + (((((size_t)(head * 260 + kr) * 8 + cg) * 4 + ks) * 8 + k8) * 2 + hh2) * 8) = pack8(v0, v1); } } }
  }
};

struct G2 {
  static constexpr bool PERM = true; static constexpr bool F8 = false; static constexpr int SCALE_B = 0x7A7A7A7A; static constexpr bool CONTIG = false; static constexpr bool ALIGN = true; static constexpr bool LINA = true, LINB = true; __device__ __forceinline__ size_t halfA() const { return 128u * 1536u; } __device__ __forceinline__ size_t halfB() const { return 128u * 1024u; } int K, nunits; unsigned char* ws;
  __device__ __forceinline__ void decode(int w, Unit& u) const { u.a = w / 3; u.pm = w % 3; u.pn = 0; u.b = 0; }
  __device__ __forceinline__ const char* baseA(const Unit& u) const { return (const char*)ws + WS_AS5 + (size_t)u.a * 768 * 768 * 2; }
  __device__ __forceinline__ const char* baseB(const Unit& u) const { return (const char*)ws + WS_WS + (size_t)u.a * 256 * 512 * 2; }
  __device__ __forceinline__ unsigned rowA(const Unit& u, int r) const { return (unsigned)(u.pm * 256 + r) * 1536u; }
  __device__ __forceinline__ unsigned rowB(const Unit& u, int r) const { return (unsigned)r * 1024u; }
  __device__ __forceinline__ void epi(const Acc& acc, const Unit& u, int wr, int wc, int fr, int fq) const {
    float* SST = (float*)(ws + WS_SST) + (size_t)u.a * 768 * 256;
#pragma unroll
    for (int ai = 0; ai < 2; ++ai)
#pragma unroll
      for (int m = 0; m < 4; ++m) { const int crow = u.pm * 256 + ai * 128 + wr * 64 + m * 16 + fr; if (crow >= 520) continue;
#pragma unroll
        for (int bj = 0; bj < 2; ++bj) { float* p = SST + (size_t)crow * 256 + bj * 128 + wc * 32 + 8 * fq; *(f32x4*)p = acc[ai][bj][m][0]; *(f32x4*)(p + 4) = acc[ai][bj][m][1]; } }
  }
};

struct G3 {
  static constexpr bool PERM = true; static constexpr bool F8 = false; static constexpr int SCALE_B = 0x7A7A7A7A; static constexpr bool CONTIG = false; static constexpr bool ALIGN = true; static constexpr bool LINA = true, LINB = true; __device__ __forceinline__ size_t halfA() const { return 128u * 1536u; } __device__ __forceinline__ size_t halfB() const { return 128u * 1536u; } int K, nunits; unsigned char* ws;
  __device__ __forceinline__ void decode(int w, Unit& u) const { u.a = w >> 2; u.pm = (w >> 1) & 1; u.pn = w & 1; u.b = 0; }
  __device__ __forceinline__ const char* baseA(const Unit& u) const { return (const char*)ws + WS_AS5 + (size_t)u.a * 768 * 768 * 2; }
  __device__ __forceinline__ const char* baseB(const Unit& u) const { return (const char*)ws + WS_TT + (size_t)u.a * 512 * 768 * 2; }
  __device__ __forceinline__ unsigned rowA(const Unit& u, int r) const { return (unsigned)(u.pm * 256 + r) * 1536u; }
  __device__ __forceinline__ unsigned rowB(const Unit& u, int r) const { return (unsigned)(u.pn * 256 + r) * 1536u; }
  __device__ __forceinline__ void epi(const Acc& acc, const Unit& u, int wr, int wc, int fr, int fq) const {
    bf16_t* GB = (bf16_t*)(ws + WS_GB);
#pragma unroll
    for (int ai = 0; ai < 2; ++ai)
#pragma unroll
      for (int m = 0; m < 4; ++m) { const int crow = u.pm * 256 + ai * 128 + wr * 64 + m * 16 + fr;
#pragma unroll
        for (int bj = 0; bj < 2; ++bj) { const int pp = u.pn * 256 + bj * 128 + wc * 32 + 8 * fq, i = pp >> 4, c0 = pp & 15; f32x4 v0 = acc[ai][bj][m][0], v1 = acc[ai][bj][m][1];
#pragma unroll
          for (int j = 0; j < 4; ++j) { v0[j] = gelu_tanh(v0[j]); v1[j] = gelu_tanh(v1[j]); }
          *(u32x4*)(GB + (size_t)(crow * 32 + i) * 512 + u.a * 16 + c0) = pack8(v0, v1); } }
  }
};

struct G4 {
  static constexpr bool PERM = true; static constexpr bool F8 = false; static constexpr int SCALE_B = 0x7A7A7A7A; static constexpr bool CONTIG = false; static constexpr bool ALIGN = true; static constexpr bool LINA = true, LINB = true; __device__ __forceinline__ size_t halfA() const { return 128u * 1024u; } __device__ __forceinline__ size_t halfB() const { return 128u * 1024u; } int K, nunits; unsigned char* ws; const float* bglu;
  __device__ __forceinline__ void decode(int w, Unit& u) const { u.pm = w >> 1; u.pn = w & 1; u.a = 0; u.b = 0; }
  __device__ __forceinline__ const char* baseA(const Unit&) const { return (const char*)ws + WS_GB; }
  __device__ __forceinline__ const char* baseB(const Unit&) const { return (const char*)ws + WS_WGLU_T; }
  __device__ __forceinline__ unsigned rowA(const Unit& u, int r) const { return (unsigned)(u.pm * 256 + r) * 1024u; }
  __device__ __forceinline__ unsigned rowB(const Unit& u, int r) const { return (unsigned)(u.pn * 256 + r) * 1024u; }
  __device__ __forceinline__ void epi(const Acc& acc, const Unit& u, int wr, int wc, int fr, int fq) const {
    const bf16_t* GB = (const bf16_t*)(ws + WS_GB); bf16_t* CC = (bf16_t*)(ws + WS_CONCAT);
#pragma unroll
    for (int bj = 0; bj < 2; ++bj) { const int col0 = u.pn * 256 + bj * 128 + wc * 32 + 8 * fq; const f32x4 b0 = *(const f32x4*)(bglu + col0), b1 = *(const f32x4*)(bglu + col0 + 4);
#pragma unroll
      for (int ai = 0; ai < 2; ++ai)
#pragma unroll
        for (int m = 0; m < 4; ++m) { const int row = u.pm * 256 + ai * 128 + wr * 64 + m * 16 + fr; const u32x4 gw = *(const u32x4*)(GB + (size_t)row * 512 + col0);
          f32x4 v0 = acc[ai][bj][m][0] + b0, v1 = acc[ai][bj][m][1] + b1;
          v0[0] = bf_lo(gw.x) * fast_sigmoid(v0[0]); v0[1] = bf_hi(gw.x) * fast_sigmoid(v0[1]); v0[2] = bf_lo(gw.y) * fast_sigmoid(v0[2]); v0[3] = bf_hi(gw.y) * fast_sigmoid(v0[3]);
          v1[0] = bf_lo(gw.z) * fast_sigmoid(v1[0]); v1[1] = bf_hi(gw.z) * fast_sigmoid(v1[1]); v1[2] = bf_lo(gw.w) * fast_sigmoid(v1[2]); v1[3] = bf_hi(gw.w) * fast_sigmoid(v1[3]);
          *(u32x4*)(CC + (size_t)row * 1024 + col0) = pack8(v0, v1); } }
  }
};

struct GRes {
  static constexpr bool PERM = false; static constexpr bool F8 = false; static constexpr int SCALE_B = 0x7A7A7A7A; static constexpr bool CONTIG = false; static constexpr bool ALIGN = true; static constexpr bool LINA = true, LINB = true; __device__ __forceinline__ size_t halfA() const { return 128u * 2048u; } __device__ __forceinline__ size_t halfB() const { return 128u * 2048u; } int K, nunits; const char* A; const char* Bt; const float* hin; float* hout; const float* gate; const float* bias;
  __device__ __forceinline__ void decode(int w, Unit& u) const { u.pm = w >> 2; u.pn = w & 3; u.a = 0; u.b = 0; }
  __device__ __forceinline__ const char* baseA(const Unit&) const { return A; }
  __device__ __forceinline__ const char* baseB(const Unit&) const { return Bt; }
  __device__ __forceinline__ unsigned rowA(const Unit& u, int r) const { return (unsigned)(u.pm * 256 + r) * 2048u; }
  __device__ __forceinline__ unsigned rowB(const Unit& u, int r) const { return (unsigned)(u.pn * 256 + r) * 2048u; }
  __device__ __forceinline__ void epi(const Acc& acc, const Unit& u, int wr, int wc, int fr, int fq) const {
#pragma unroll
    for (int bj = 0; bj < 2; ++bj)
#pragma unroll
      for (int n = 0; n < 2; ++n) { const int col0 = u.pn * 256 + bj * 128 + wc * 32 + 16 * n + 4 * fq; const f32x4 gt = *(const f32x4*)(gate + col0);
        f32x4 bs = (f32x4){0.f, 0.f, 0.f, 0.f}; if (bias) bs = *(const f32x4*)(bias + col0);
#pragma unroll
        for (int ai = 0; ai < 2; ++ai)
#pragma unroll
          for (int m = 0; m < 4; ++m) { const size_t off = (size_t)(u.pm * 256 + ai * 128 + wr * 64 + m * 16 + fr) * 1024 + col0;
            const f32x4 hv = *(const f32x4*)(hin + off); *(f32x4*)(hout + off) = hv + gt * (acc[ai][bj][m][n] + bs); } }
  }
};

__device__ __forceinline__ void build_moetab(const Ctx& X, int layer, LAS int* toff) {
  const unsigned* cnt = (const unsigned*)(X.ws + WS_CTL) + CW_CNT + layer * 128;
  LAS int* texp = toff + 256;
  LAS int* ntile = toff + 132;
  __syncthreads();
  if (X.tid < 64) ntile[X.tid] = ((int)__hip_atomic_load(cnt + X.tid, __ATOMIC_RELAXED, __HIP_MEMORY_SCOPE_AGENT) + 255) >> 8;
  __syncthreads();
  if (X.tid == 0) { int s = 0; for (int e = 0; e < 64; ++e) { toff[e] = s; s += ntile[e]; } toff[64] = s; toff[65] = s + 64; }
  __syncthreads();
  if (X.tid < 65) { const int e = X.tid; const int lo = toff[e], hi = toff[e + 1]; for (int t = lo; t < hi && t < 704; ++t) texp[t] = e; }
  __syncthreads();
}
__device__ __forceinline__ int find_expert(const LAS int* toff, int ti) { return toff[256 + ti]; }

struct G6 {
  static constexpr bool PERM = true; static constexpr bool F8 = true; static constexpr int SCALE_B = 0x7A7A7A7A; static constexpr bool CONTIG = false; static constexpr bool ALIGN = true; static constexpr bool LINA = false, LINB = true;
  __device__ __forceinline__ size_t halfA() const { return 0; } __device__ __forceinline__ size_t halfB() const { return 128u * 1024u; }
  int K, nunits; unsigned char* ws; const LAS int* toff; const LAS unsigned* tokt; const char* wbase; size_t wstride;
  __device__ __forceinline__ void decode(int w, Unit& u) const { const int ti = w >> 1; u.pn = w & 1; u.a = find_expert(toff, ti); u.pm = ti - toff[u.a]; u.b = ti; }
  __device__ __forceinline__ const char* baseA(const Unit&) const { return (const char*)ws + WS_F; }
  __device__ __forceinline__ const char* baseB(const Unit& u) const { return wbase + (size_t)u.a * wstride; }
  __device__ __forceinline__ unsigned rowA(const Unit& u, int r) const { return tokt[u.ord * 256 + r]; }
  __device__ __forceinline__ void build_tokt(const Ctx& X, LAS unsigned* tk) const {
    for (int i = 0; i * X.G + X.c < nunits; ++i) { Unit u; decode(xcd_remap(i * X.G + X.c, nunits), u);
      if (X.tid < 256) { const int idx = u.pm * 256 + X.tid; int tok = idx;
        if (u.a < 64) tok = ((const int*)(ws + WS_LTOK))[u.a * 16384 + idx];
        tk[i * 256 + X.tid] = (unsigned)tok * 1024u; } }
    __syncthreads();
  }
  __device__ __forceinline__ unsigned rowB(const Unit& u, int r) const { return (unsigned)(u.pn * 256 + r) * 1024u; }
  __device__ __forceinline__ void epi(const Acc& acc, const Unit& u, int wr, int wc, int fr, int fq) const {
    bf16_t* HID = (bf16_t*)(ws + WS_HID);
#pragma unroll
    for (int ai = 0; ai < 2; ++ai)
#pragma unroll
      for (int m = 0; m < 4; ++m) { const size_t hrow = (size_t)u.b * 256 + ai * 128 + wr * 64 + m * 16 + fr; f32x4 v0, v1;
#pragma unroll
        for (int j = 0; j < 4; ++j) { const float g0 = acc[ai][0][m][0][j], g1 = acc[ai][0][m][1][j]; v0[j] = g0 * fast_sigmoid(g0) * acc[ai][1][m][0][j]; v1[j] = g1 * fast_sigmoid(g1) * acc[ai][1][m][1][j]; }
        *(u32x4*)(HID + hrow * 256 + u.pn * 128 + wc * 32 + 8 * fq) = pack8(v0, v1); }
  }
};
struct G7 {
  static constexpr bool PERM = true; static constexpr bool F8 = false; static constexpr int SCALE_B = 0x7A7A7A7A; static constexpr bool CONTIG = false; static constexpr bool ALIGN = true; static constexpr bool LINA = true, LINB = true;
  __device__ __forceinline__ size_t halfA() const { return 128u * 512u; } __device__ __forceinline__ size_t halfB() const { return 128u * 512u; }
  int K, nunits; unsigned char* ws; const LAS int* toff; int dry; const char* wbase; size_t wstride;
  __device__ __forceinline__ void decode(int w, Unit& u) const { const int ti = w >> 2; u.pn = w & 3; u.a = find_expert(toff, ti); u.pm = ti - toff[u.a]; u.b = ti; }
  __device__ __forceinline__ const char* baseA(const Unit&) const { return (const char*)ws + WS_HID; }
  __device__ __forceinline__ const char* baseB(const Unit& u) const { return wbase + (size_t)u.a * wstride; }
  __device__ __forceinline__ unsigned rowA(const Unit& u, int r) const { return (unsigned)(u.b * 256 + r) * 512u; }
  __device__ __forceinline__ unsigned rowB(const Unit& u, int r) const { return (unsigned)(u.pn * 256 + r) * 512u; }
  __device__ __forceinline__ void epi(const Acc& acc, const Unit& u, int wr, int wc, int fr, int fq) const {
    unsigned char* YAS = ws + WS_YAS;
#pragma unroll
    for (int ai = 0; ai < 2; ++ai)
#pragma unroll
      for (int m = 0; m < 4; ++m) { const size_t yrow = (size_t)u.b * 256 + ai * 128 + wr * 64 + m * 16 + fr;
#pragma unroll
        for (int bj = 0; bj < 2; ++bj) { const f32x4 v0 = acc[ai][bj][m][0], v1 = acc[ai][bj][m][1]; int w0 = 0, w1 = 0;
          w0 = __builtin_amdgcn_cvt_pk_fp8_f32(v0[0], v0[1], w0, false); w0 = __builtin_amdgcn_cvt_pk_fp8_f32(v0[2], v0[3], w0, true);
          w1 = __builtin_amdgcn_cvt_pk_fp8_f32(v1[0], v1[1], w1, false); w1 = __builtin_amdgcn_cvt_pk_fp8_f32(v1[2], v1[3], w1, true);
          if (!dry || w0 == 0x12345678) *(u32x2*)(YAS + yrow * 1024 + u.pn * 256 + bj * 128 + wc * 32 + 8 * fq) = (u32x2){(unsigned)w0, (unsigned)w1}; } }
  }
};

struct G8 {
  static constexpr bool PERM = true; static constexpr bool F8 = false; static constexpr int SCALE_B = 0x7A7A7A7A; static constexpr bool CONTIG = false; static constexpr bool ALIGN = true; static constexpr bool LINA = true, LINB = false; __device__ __forceinline__ size_t halfA() const { return 128u * 512u; } __device__ __forceinline__ size_t halfB() const { return 0; } int K, nunits; unsigned char* ws;
  __device__ __forceinline__ void decode(int w, Unit& u) const { u.pm = w >> 8; u.a = (w >> 6) & 3; u.pn = w & 63; u.b = 0; }
  __device__ __forceinline__ const char* baseA(const Unit&) const { return (const char*)ws + WS_DMT; }
  __device__ __forceinline__ const char* baseB(const Unit& u) const { return (const char*)ws + WS_A1 + (size_t)u.a * 512; }
  __device__ __forceinline__ unsigned rowA(const Unit& u, int r) const { return (unsigned)(u.pm * 256 + r) * 512u; }
  __device__ __forceinline__ unsigned rowB(const Unit& u, int r) const { const int n = u.pn * 256 + r; return (unsigned)(128 * (n & 127) + (n >> 7)) * 2048u; }
  __device__ __forceinline__ void epi(const Acc& acc, const Unit& u, int wr, int wc, int fr, int fq) const {
    bf16_t* X1 = (bf16_t*)(ws + WS_X1);
#pragma unroll
    for (int ai = 0; ai < 2; ++ai)
#pragma unroll
      for (int m = 0; m < 4; ++m) { const int mm = ai * 128 + wr * 64 + m * 16 + fr;
#pragma unroll
        for (int bj = 0; bj < 2; ++bj) { const int n0 = u.pn * 256 + bj * 128 + wc * 32 + 8 * fq, tb = n0 >> 7, ta0 = n0 & 127;
          *(u32x4*)(X1 + ((((size_t)(u.a * 256 + mm) * 128 + tb) * 2 + u.pm) * 128 + ta0)) = pack8(acc[ai][bj][m][0], acc[ai][bj][m][1]); } }
  }
};
struct G9 {
  static constexpr bool PERM = true; static constexpr bool F8 = false; static constexpr int SCALE_B = 0x7A7A7A7A; static constexpr bool CONTIG = false; static constexpr bool ALIGN = true; static constexpr bool LINA = true, LINB = true; __device__ __forceinline__ size_t halfA() const { return 128u * 512u; } __device__ __forceinline__ size_t halfB() const { return 128u * 512u; } int K, nunits; unsigned char* ws;
  __device__ __forceinline__ void decode(int w, Unit& u) const { u.pm = 0; u.pn = w; u.a = 0; u.b = 0; }
  __device__ __forceinline__ const char* baseA(const Unit&) const { return (const char*)ws + WS_W1; }
  __device__ __forceinline__ const char* baseB(const Unit&) const { return (const char*)ws + WS_X1; }
  __device__ __forceinline__ unsigned rowA(const Unit&, int r) const { return (unsigned)r * 512u; }
  __device__ __forceinline__ unsigned rowB(const Unit& u, int r) const { return (unsigned)(u.pn * 256 + r) * 512u; }
  __device__ __forceinline__ void epi(const Acc& acc, const Unit& u, int wr, int wc, int fr, int fq) const {
    bf16_t* X2 = (bf16_t*)(ws + WS_X2);
#pragma unroll
    for (int m = 0; m < 4; ++m) { const int ka = wr * 64 + m * 16 + fr;
#pragma unroll
      for (int bj = 0; bj < 2; ++bj) { const int n0 = u.pn * 256 + bj * 128 + wc * 32 + 8 * fq, gm = n0 >> 7, tb0 = n0 & 127; f32x4 r0, r1, i0, i1;
#pragma unroll
        for (int j = 0; j < 4; ++j) {
          { const float ang = (float)((ka * (tb0 + j)) & 16383) * (1.f / 16384.f), cs = __builtin_amdgcn_cosf(ang), sn = __builtin_amdgcn_sinf(ang); const float yr = acc[0][bj][m][0][j], yi = acc[1][bj][m][0][j]; r0[j] = yr * cs + yi * sn; i0[j] = yi * cs - yr * sn; }
          { const float ang = (float)((ka * (tb0 + 4 + j)) & 16383) * (1.f / 16384.f), cs = __builtin_amdgcn_cosf(ang), sn = __builtin_amdgcn_sinf(ang); const float yr = acc[0][bj][m][1][j], yi = acc[1][bj][m][1][j]; r1[j] = yr * cs + yi * sn; i1[j] = yi * cs - yr * sn; } }
        bf16_t* p = X2 + (((size_t)(gm * 128 + ka) * 2) * 128 + tb0); *(u32x4*)p = pack8(r0, r1); *(u32x4*)(p + 128) = pack8(i0, i1); } }
  }
};
struct G10 {
  static constexpr bool PERM = true; static constexpr bool F8 = false; static constexpr int SCALE_B = 0x7A7A7A7A; static constexpr bool CONTIG = false; static constexpr bool ALIGN = true; static constexpr bool LINA = true, LINB = false; __device__ __forceinline__ size_t halfA() const { return 128u * 512u; } __device__ __forceinline__ size_t halfB() const { return 0; } int K, nunits; unsigned char* ws;
  __device__ __forceinline__ void decode(int w, Unit& u) const { u.pm = 0; u.pn = w; u.a = 0; u.b = 0; }
  __device__ __forceinline__ const char* baseA(const Unit&) const { return (const char*)ws + WS_W2; }
  __device__ __forceinline__ const char* baseB(const Unit&) const { return (const char*)ws + WS_X2; }
  __device__ __forceinline__ unsigned rowA(const Unit&, int r) const { return (unsigned)r * 512u; }
  __device__ __forceinline__ unsigned rowB(const Unit& u, int r) const { const int n = u.pn * 256 + r, ka = n >> 10, gm = n & 1023; return (unsigned)(gm * 128 + ka) * 512u; }
  __device__ __forceinline__ void epi(const Acc& acc, const Unit& u, int wr, int wc, int fr, int fq) const {
    bf16_t* FB = (bf16_t*)(ws + WS_FB); const int ka = u.pn >> 2;
#pragma unroll
    for (int m = 0; m < 4; ++m) { const int kb = wr * 64 + m * 16 + fr; const size_t k = (size_t)ka + 128 * kb;
#pragma unroll
      for (int bj = 0; bj < 2; ++bj) { const int d0 = (u.pn & 3) * 256 + bj * 128 + wc * 32 + 8 * fq; *(u32x4*)(FB + k * 1024 + d0) = pack8(acc[0][bj][m][0], acc[0][bj][m][1]); } }
  }
};
}
namespace mk {
typedef float f32x16 __attribute__((ext_vector_type(16)));

__device__ __forceinline__ void phase_scan(const Ctx& X) {
  if (X.c >= 64) return;
  const int ch = X.c * 64 + (X.tid & 63), seg = X.tid >> 6;
  const int g = ch >> 7, dir = (ch >> 6) & 1, p = ch & 63;
  const float2 lam = ((const float2*)(X.ws + WS_LAML))[(dir * 32 + g) * 64 + p];
  const float* S = (const float*)(X.ws + WS_SST) + (size_t)g * 768 * 256 + dir * 128 + p;
  bf16_t* XP = (bf16_t*)(X.ws + WS_AS5) + (size_t)g * 768 * 768 + 512 + dir * 128 + p;
  LAS float* EX = (LAS float*)X.lds;
  const int j0 = seg * 65;
  float xr = 0.f, xi = 0.f;
  for (int b = 0; b < 65; b += 13) {
    float sr[13], si[13];
#pragma unroll
    for (int k = 0; k < 13; ++k) { const int j = j0 + b + k; const int row = dir == 0 ? (j < 8 ? 512 + j : j - 8) : 519 - j; sr[k] = S[(size_t)row * 256]; si[k] = S[(size_t)row * 256 + 64]; }
#pragma unroll
    for (int k = 0; k < 13; ++k) { const float nr = lam.x * xr - lam.y * xi + sr[k], ni = lam.x * xi + lam.y * xr + si[k]; xr = nr; xi = ni; }
  }
  EX[(seg * 64 + (X.tid & 63)) * 2] = xr; EX[(seg * 64 + (X.tid & 63)) * 2 + 1] = xi;
  float pr = 1.f, pi = 0.f;
  for (int k = 0; k < 65; ++k) { const float nr = pr * lam.x - pi * lam.y, ni = pr * lam.y + pi * lam.x; pr = nr; pi = ni; }
  __syncthreads();
  float cr = 0.f, ci = 0.f;
  for (int s2 = 0; s2 < seg; ++s2) { const float er = EX[(s2 * 64 + (X.tid & 63)) * 2], ei = EX[(s2 * 64 + (X.tid & 63)) * 2 + 1];
    const float nr = pr * cr - pi * ci + er, ni = pr * ci + pi * cr + ei; cr = nr; ci = ni; }
  xr = cr; xi = ci;
  for (int b = 0; b < 65; b += 13) {
    float sr[13], si[13];
#pragma unroll
    for (int k = 0; k < 13; ++k) { const int j = j0 + b + k; const int row = dir == 0 ? (j < 8 ? 512 + j : j - 8) : 519 - j; sr[k] = S[(size_t)row * 256]; si[k] = S[(size_t)row * 256 + 64]; }
#pragma unroll
    for (int k = 0; k < 13; ++k) { const int j = j0 + b + k; const int row = dir == 0 ? (j < 8 ? 512 + j : j - 8) : 519 - j;
      XP[(size_t)row * 768] = f2bf(xr); XP[(size_t)row * 768 + 64] = f2bf(xi);
      const float nr = lam.x * xr - lam.y * xi + sr[k], ni = lam.x * xi + lam.y * xr + si[k]; xr = nr; xi = ni; }
  }
  __syncthreads();
}

__device__ __forceinline__ void zero_lists(const Ctx& X) {
  u32x4* z = (u32x4*)(X.ws + WS_LTOK); unsigned zu_ = 0u; asm volatile("" : "+v"(zu_)); const u32x4 zero = (u32x4){zu_, zu_, zu_, zu_};
  for (int i = X.c * NTHR + X.tid; i < (int)(4 * MiB / 16); i += X.G * NTHR) z[i] = zero;
}
#define MFMA32(a, b, c) __builtin_amdgcn_mfma_f32_32x32x16_bf16((a), (b), (c), 0, 0, 0)
__device__ __forceinline__ void attn_unit(const Ctx& X, const LAS float* rpbl, int head, int tile) {
  const bf16_t* Q = (const bf16_t*)(X.ws + WS_Q); const bf16_t* Kb = (const bf16_t*)(X.ws + WS_K); const bf16_t* VT = (const bf16_t*)(X.ws + WS_VT);
  bf16_t* CCt = (bf16_t*)(X.ws + WS_CONCAT);
  const int lane = X.lane, ql = lane & 31, hh = lane >> 5;
  const int rp = tile >> 2, mt = tile & 3;
  const int r = 2 * rp + (ql >> 4), cq = 16 * mt + (ql & 15), tq = r * 64 + cq;
  const int r0q = min(max(r - 4, 0), 248), csq = min(max(cq - 8, 0), 48);
  const int rlo = min(max(2 * rp - 4, 0), 248), rhi = min(max(2 * rp - 3, 0), 248) + 7;
  const int csb = min(max(16 * mt - 8, 0), 32);
  const int nloc = rhi - rlo + 1;
  unsigned cmask = 0u;
#pragma unroll
  for (int k = 0; k < 32; ++k) cmask |= ((csb + k >= csq) && (csb + k <= csq + 15)) ? (1u << k) : 0u;
  bf16x8 qf[4];
#pragma unroll
  for (int ks = 0; ks < 4; ++ks) qf[ks] = *(const bf16x8*)(Q + (size_t)tq * 512 + head * 64 + 16 * ks + 8 * hh);
  const int kperm = (ql & ~12) | ((ql & 4) << 1) | ((ql & 8) >> 1);
  f32x16 o0, o1;
#pragma unroll
  for (int i = 0; i < 16; ++i) { o0[i] = 0.f; o1[i] = 0.f; }
  float lsum = 0.f;
  const float c1 = 0.125f * 1.44269504f, c2 = 8.f * 1.44269504f;
  const float* rp_h = nullptr; (void)rp_h;
  const size_t koff_lane = (size_t)(((kperm >> 3) * 4 * 8 + (kperm & 7)) * 2 + hh) * 8;
  const size_t voff_lane = (size_t)(hh * 64 + ql) * 8;
  bf16x8 kf[4], vf[2][2];
  { const int kr0 = rlo, cg0 = csb >> 3;
    const bf16_t* kp = Kb + ((size_t)(head * 260 + kr0) * 8 + cg0) * 512 + koff_lane; const bf16_t* vp = VT + ((size_t)(head * 260 + kr0) * 8 + cg0) * 512 + voff_lane;
#pragma unroll
    for (int ks = 0; ks < 4; ++ks) kf[ks] = *(const bf16x8*)(kp + ks * 128);
#pragma unroll
    for (int db = 0; db < 2; ++db)
#pragma unroll
      for (int s2 = 0; s2 < 2; ++s2) vf[db][s2] = *(const bf16x8*)(vp + db * 256 + s2 * 1024); }
  for (int b = 0; b < nloc + 8; ++b) {
    const bool loc = b < nloc;
    const int kr = rlo + b;
    bf16x8 kc[4], vc[2][2];
#pragma unroll
    for (int ks = 0; ks < 4; ++ks) kc[ks] = kf[ks];
#pragma unroll
    for (int db = 0; db < 2; ++db)
#pragma unroll
      for (int s2 = 0; s2 < 2; ++s2) vc[db][s2] = vf[db][s2];
    if (b + 1 < nloc + 8) { const int bn = b + 1; const int krn = bn < nloc ? rlo + bn : 256 + ((bn - nloc) >> 1), cgn = bn < nloc ? (csb >> 3) : 4 * ((bn - nloc) & 1);
      const bf16_t* kp = Kb + ((size_t)(head * 260 + krn) * 8 + cgn) * 512 + koff_lane; const bf16_t* vp = VT + ((size_t)(head * 260 + krn) * 8 + cgn) * 512 + voff_lane;
#pragma unroll
      for (int ks = 0; ks < 4; ++ks) kf[ks] = *(const bf16x8*)(kp + ks * 128);
#pragma unroll
      for (int db = 0; db < 2; ++db)
#pragma unroll
        for (int s2 = 0; s2 < 2; ++s2) vf[db][s2] = *(const bf16x8*)(vp + db * 256 + s2 * 1024); }
    f32x16 sacc;
#pragma unroll
    for (int i = 0; i < 16; ++i) sacc[i] = 0.f;
#pragma unroll
    for (int ks = 0; ks < 4; ++ks) sacc = MFMA32(kc[ks], qf[ks], sacc);
    float pv[16];
    if (loc) {
      const bool rowok = (kr >= r0q) && (kr <= r0q + 7);
      const int dr = min(max(kr - r + 7, 0), 14);
      const LAS float* bp = rpbl + (head * 15 + dr) * 31;
      const int dc0 = csb - cq + 15;
#pragma unroll
      for (int i = 0; i < 16; ++i) { const int kidx = 16 * (i >> 3) + 8 * hh + (i & 7);
        const bool ok = rowok && ((cmask >> kidx) & 1u);
        const float bias = bp[min(max(dc0 + kidx, 0), 30)];
        const float e = __builtin_amdgcn_exp2f(sacc[i] * c1 + bias * 1.44269504f - c2); pv[i] = ok ? e : 0.f; }
    } else {
#pragma unroll
      for (int i = 0; i < 16; ++i) pv[i] = __builtin_amdgcn_exp2f(sacc[i] * c1 - c2);
    }
    u32x4 p0, p1;
    p0.x = cvt_pk_bf16(pv[0], pv[1]); p0.y = cvt_pk_bf16(pv[2], pv[3]); p0.z = cvt_pk_bf16(pv[4], pv[5]); p0.w = cvt_pk_bf16(pv[6], pv[7]);
    p1.x = cvt_pk_bf16(pv[8], pv[9]); p1.y = cvt_pk_bf16(pv[10], pv[11]); p1.z = cvt_pk_bf16(pv[12], pv[13]); p1.w = cvt_pk_bf16(pv[14], pv[15]);
    lsum += (bf_lo(p0.x) + bf_hi(p0.x)) + (bf_lo(p0.y) + bf_hi(p0.y)) + (bf_lo(p0.z) + bf_hi(p0.z)) + (bf_lo(p0.w) + bf_hi(p0.w))
          + (bf_lo(p1.x) + bf_hi(p1.x)) + (bf_lo(p1.y) + bf_hi(p1.y)) + (bf_lo(p1.z) + bf_hi(p1.z)) + (bf_lo(p1.w) + bf_hi(p1.w));
    const bf16x8 pb0 = __builtin_bit_cast(bf16x8, p0), pb1 = __builtin_bit_cast(bf16x8, p1);
    o0 = MFMA32(vc[0][0], pb0, o0); o0 = MFMA32(vc[0][1], pb1, o0);
    o1 = MFMA32(vc[1][0], pb0, o1); o1 = MFMA32(vc[1][1], pb1, o1);
  }
  lsum += sx(lsum, 32);
  const float inv = 1.f / lsum;
  bf16_t* op = CCt + (size_t)tq * 1024 + 512 + head * 64 + 4 * hh;
#pragma unroll
  for (int gq = 0; gq < 4; ++gq) {
    u32x2 w0, w1;
    w0.x = cvt_pk_bf16(o0[4 * gq] * inv, o0[4 * gq + 1] * inv); w0.y = cvt_pk_bf16(o0[4 * gq + 2] * inv, o0[4 * gq + 3] * inv);
    w1.x = cvt_pk_bf16(o1[4 * gq] * inv, o1[4 * gq + 1] * inv); w1.y = cvt_pk_bf16(o1[4 * gq + 2] * inv, o1[4 * gq + 3] * inv);
    *(u32x2*)(op + 8 * gq) = w0; *(u32x2*)(op + 32 + 8 * gq) = w1;
  }
}
__device__ __forceinline__ void phase_attn(const Ctx& X) {
  LAS float* rpbl = (LAS float*)X.lds;
  zero_lists(X);
  for (int i = X.tid; i < 8 * 15 * 31; i += NTHR) rpbl[i] = X.a->in[IN_RPB][i];
  __syncthreads();
  const int gw = X.c * NWAVES + X.wave, NGW = X.G * NWAVES;
  for (int U = gw; U < 4096; U += NGW) attn_unit(X, rpbl, U >> 9, U & 511);
}

__device__ __forceinline__ void phase_router(const Ctx& X, int layer, int dry) {
  const float* mod = (const float*)(X.ws + WS_MOD) + (layer == 0 ? 0 : 2 * 6144);
  const float* shift = mod + 3072; const float* scale = mod + 4096;
  const float* h = X.a->h; bf16_t* F = (bf16_t*)(X.ws + WS_F);
  unsigned* cntg = (unsigned*)(X.ws + WS_CTL) + CW_CNT + layer * 128;
  int* ltok = (int*)(X.ws + WS_LTOK); int* asg = (int*)(X.ws + WS_ASG);
  const bf16_t* WR = (const bf16_t*)(X.ws + WS_WROUT_T) + (size_t)layer * 64 * 1024;
  const float* rbias = X.a->in[IN_RBIAS] + layer * 64;
  constexpr int FROW = 2064;
  const int lane = X.lane, wave = X.wave, tid = X.tid;
  for (int tile = X.c; tile < TOK / 64; tile += X.G) {
    const int t0 = tile * 64;
    for (int rb4 = 0; rb4 < 2; ++rb4) {
      f32x4 v[4][4];
#pragma unroll
      for (int rr = 0; rr < 4; ++rr) { const f32x4* xr = (const f32x4*)(h + (size_t)(t0 + wave * 8 + rb4 * 4 + rr) * 1024) + lane;
#pragma unroll
        for (int j = 0; j < 4; ++j) v[rr][j] = xr[64 * j]; }
#pragma unroll
      for (int rr = 0; rr < 4; ++rr) {
        const int lr = wave * 8 + rb4 * 4 + rr, t = t0 + lr; float ss = 0.f;
#pragma unroll
        for (int j = 0; j < 4; ++j) ss += (v[rr][j].x * v[rr][j].x + v[rr][j].y * v[rr][j].y) + (v[rr][j].z * v[rr][j].z + v[rr][j].w * v[rr][j].w);
        const float r = rsqrtf(wave_sum(ss) * (1.f / 1024.f) + 1e-6f);
#pragma unroll
        for (int j = 0; j < 4; ++j) { const f32x4 sh = ((const f32x4*)shift)[lane + 64 * j], sc = ((const f32x4*)scale)[lane + 64 * j];
          u32x2 w; w.x = cvt_pk_bf16(v[rr][j].x * r * (1.f + sc.x) + sh.x, v[rr][j].y * r * (1.f + sc.y) + sh.y); w.y = cvt_pk_bf16(v[rr][j].z * r * (1.f + sc.z) + sh.z, v[rr][j].w * r * (1.f + sc.w) + sh.w);
          if (!dry) { int w8 = 0; w8 = __builtin_amdgcn_cvt_pk_fp8_f32(v[rr][j].x * r * (1.f + sc.x) + sh.x, v[rr][j].y * r * (1.f + sc.y) + sh.y, w8, false);
            w8 = __builtin_amdgcn_cvt_pk_fp8_f32(v[rr][j].z * r * (1.f + sc.z) + sh.z, v[rr][j].w * r * (1.f + sc.w) + sh.w, w8, true);
            ((int*)((unsigned char*)F + (size_t)t * 1024))[lane + 64 * j] = w8; }
          *(LAS u32x2*)(X.lds + lr * FROW + (lane + 64 * j) * 8) = w; }
      }
    }
    __syncthreads();
    f32x4 lg[2];
    { const int rb = wave & 3, fr = lane & 15, fq = lane >> 4;
      lg[0] = (f32x4){0.f, 0.f, 0.f, 0.f}; lg[1] = lg[0];
      const LAS unsigned char* ap = X.lds + (rb * 16 + fr) * FROW + fq * 16;
      const bf16_t* bp0 = WR + (size_t)((2 * (wave >> 2)) * 16 + fr) * 1024 + fq * 8; const bf16_t* bp1 = bp0 + 16 * 1024;
#pragma unroll 16
      for (int ks = 0; ks < 32; ++ks) { const bf16x8 af = *(const LAS bf16x8*)(ap + ks * 64); const bf16x8 b0 = *(const bf16x8*)(bp0 + ks * 32), b1 = *(const bf16x8*)(bp1 + ks * 32);
        lg[0] = __builtin_amdgcn_mfma_f32_16x16x32_bf16(af, b0, lg[0], 0, 0, 0); lg[1] = __builtin_amdgcn_mfma_f32_16x16x32_bf16(af, b1, lg[1], 0, 0, 0); }
    }
    __syncthreads();
    LAS float* LG = (LAS float*)X.lds;
    LAS float* GS = LG + 64 * 65;
    LAS float* SELV = GS + 512;
    LAS int* OUTE = (LAS int*)(SELV + 4096);
    LAS float* OUTS = (LAS float*)(OUTE + 512);
    LAS int* HIST = (LAS int*)(OUTS + 512);
    LAS int* BASE = HIST + 64;
    { const int rb = wave & 3, fr = lane & 15, fq = lane >> 4;
#pragma unroll
      for (int eb = 0; eb < 2; ++eb)
#pragma unroll
        for (int j = 0; j < 4; ++j) LG[(rb * 16 + 4 * fq + j) * 65 + (2 * (wave >> 2) + eb) * 16 + fr] = lg[eb][j];
      if (tid < 64) HIST[tid] = 0; }
    __syncthreads();
    const int tl = tid >> 3, grp = tid & 7;
    float v[8], sc[8];
    { float m1 = -INFINITY, m2 = -INFINITY;
#pragma unroll
      for (int j = 0; j < 8; ++j) { const float s = 1.f / (1.f + __expf(-LG[tl * 65 + grp * 8 + j])); sc[j] = s; v[j] = s + rbias[grp * 8 + j];
        if (v[j] > m1) { m2 = m1; m1 = v[j]; } else if (v[j] > m2) m2 = v[j]; }
      GS[tl * 8 + grp] = m1 + m2; }
    __syncthreads();
    bool keep;
    { const float mine = GS[tl * 8 + grp]; int rank = 0;
#pragma unroll
      for (int g2 = 0; g2 < 8; ++g2) { const float o = GS[tl * 8 + g2]; rank += (o > mine || (o == mine && g2 < grp)) ? 1 : 0; }
      keep = rank < 4;
#pragma unroll
      for (int j = 0; j < 8; ++j) SELV[tl * 64 + grp * 8 + j] = keep ? v[j] : -INFINITY; }
    __syncthreads();
    if (keep) {
      int rk[8];
#pragma unroll
      for (int j = 0; j < 8; ++j) rk[j] = 0;
      for (int e2 = 0; e2 < 64; ++e2) { const float o = SELV[tl * 64 + e2];
#pragma unroll
        for (int j = 0; j < 8; ++j) rk[j] += (o > v[j] || (o == v[j] && e2 < grp * 8 + j)) ? 1 : 0; }
#pragma unroll
      for (int j = 0; j < 8; ++j) if (rk[j] < 8) { OUTE[tl * 8 + rk[j]] = grp * 8 + j; OUTS[tl * 8 + rk[j]] = sc[j]; }
    }
    __syncthreads();
    { const int jj = tid & 7, e = OUTE[tl * 8 + jj]; const float s = OUTS[tl * 8 + jj];
      float sum = s; sum += sx(sum, 1); sum += sx(sum, 2); sum += sx(sum, 4);
      const float w = 2.5f * s / sum;
      const int sl = atomicAdd((int*)&HIST[e], 1);
      __syncthreads();
      const int t = t0 + tl;
      if (tid < 64) { const int n = HIST[tid]; BASE[tid] = (n && !dry) ? (int)atomicAdd(cntg + tid, (unsigned)n) : 0; }
      __syncthreads();
      const int slot = BASE[e] + sl;
      if (!dry) { ltok[(size_t)e * 16384 + slot] = t; } if (!dry) ((int2*)asg)[t * 8 + jj] = make_int2((e << 16) | slot, __float_as_int(w)); }
    __syncthreads();
  }
}

__device__ __forceinline__ void phase_combine(const Ctx& X, int layer, const LAS int* toff, int dry) {
  const float* mod = (const float*)(X.ws + WS_MOD) + (layer == 0 ? 0 : 2 * 6144);
  const float* gffn = mod + 5120;
  const float* nmod = (const float*)(X.ws + WS_MOD) + 2 * 6144;
  float* h = X.a->h; const unsigned char* YAS = X.ws + WS_YAS; const int* asg = (const int*)(X.ws + WS_ASG); bf16_t* A1 = (bf16_t*)(X.ws + WS_A1);
  const int gw = X.c * NWAVES + X.wave, NGW = X.G * NWAVES, lane = X.lane;
  for (int t0 = gw; t0 < TOK; t0 += 2 * NGW) {
    int yw[2][9][4]; f32x4 hv[2][4]; float wgt[2][8];
#pragma unroll
    for (int u = 0; u < 2; ++u) { const int t = t0 + u * NGW;
      int pos[9];
#pragma unroll
      for (int k = 0; k < 8; ++k) { const int2 a = ((const int2*)asg)[t * 8 + k]; pos[k] = toff[a.x >> 16] * 256 + (a.x & 0xffff); wgt[u][k] = __int_as_float(a.y); }
      pos[8] = toff[64] * 256 + t;
#pragma unroll
      for (int k = 0; k < 9; ++k) { const int* yr = (const int*)(YAS + (size_t)pos[k] * 1024) + lane;
#pragma unroll
        for (int j = 0; j < 4; ++j) yw[u][k][j] = yr[64 * j]; }
      const f32x4* hr = (const f32x4*)(h + (size_t)t * 1024) + lane;
#pragma unroll
      for (int j = 0; j < 4; ++j) hv[u][j] = hr[64 * j]; }
#pragma unroll
    for (int u = 0; u < 2; ++u) { const int t = t0 + u * NGW;
      f32x4 acc[4];
#pragma unroll
      for (int j = 0; j < 4; ++j) acc[j] = (f32x4){0.f, 0.f, 0.f, 0.f};
#pragma unroll
      for (int k = 0; k < 9; ++k) { const float wk = k < 8 ? wgt[u][k] : 1.f;
#pragma unroll
        for (int j = 0; j < 4; ++j) { const int w = yw[u][k][j];
          acc[j].x += wk * __builtin_amdgcn_cvt_f32_fp8(w, 0); acc[j].y += wk * __builtin_amdgcn_cvt_f32_fp8(w, 1); acc[j].z += wk * __builtin_amdgcn_cvt_f32_fp8(w, 2); acc[j].w += wk * __builtin_amdgcn_cvt_f32_fp8(w, 3); } }
      f32x4* hr = (f32x4*)(h + (size_t)t * 1024) + lane; f32x4 v[4]; float ss = 0.f;
#pragma unroll
      for (int j = 0; j < 4; ++j) { const f32x4 gt = ((const f32x4*)gffn)[lane + 64 * j]; v[j] = hv[u][j] + gt * acc[j]; if (!dry) hr[64 * j] = v[j];
        ss += (v[j].x * v[j].x + v[j].y * v[j].y) + (v[j].z * v[j].z + v[j].w * v[j].w); }
      if (layer == 0) {
        const float r = rsqrtf(wave_sum(ss) * (1.f / 1024.f) + 1e-6f);
#pragma unroll
        for (int j = 0; j < 4; ++j) { const f32x4 sh = ((const f32x4*)nmod)[lane + 64 * j], sc = ((const f32x4*)(nmod + 1024))[lane + 64 * j];
          u32x2 w; w.x = cvt_pk_bf16(v[j].x * r * (1.f + sc.x) + sh.x, v[j].y * r * (1.f + sc.y) + sh.y); w.y = cvt_pk_bf16(v[j].z * r * (1.f + sc.z) + sh.z, v[j].w * r * (1.f + sc.w) + sh.w);
          if (!dry) ((u32x2*)(A1 + (size_t)t * 1024))[lane + 64 * j] = w; }
      }
    }
  }
}

constexpr int NPHASE = 21;
template <bool SP2>
__global__ void __launch_bounds__(NTHR, 2) mk_fwd(Args args) {
  extern __shared__ __attribute__((aligned(16))) unsigned char lds_raw[];
  Ctx X; X.lds = (LAS unsigned char*)lds_raw; X.a = &args; X.ws = args.ws; X.tid = threadIdx.x; X.lane = X.tid & 63; X.wave = __builtin_amdgcn_readfirstlane(X.tid >> 6);
  X.G = gridDim.x; X.c = blockIdx.x;
  const int wave_s = X.wave;
  volatile LAS unsigned* MISC = (volatile LAS unsigned*)(X.lds + LDS_MISC_OFF);
  LAS int* TOFF = (LAS int*)(X.lds + LDS_MISC_OFF + 64);
  if (X.tid < 16) MISC[X.tid] = 0u;
  __syncthreads();
  unsigned* ctl = (unsigned*)(X.ws + WS_CTL);
  const int lo = args.ph_lo, hi = args.ph_hi;
  const bool multi = (hi - lo) > 1;
  XcdBarrier bar; bar.bar = ctl + CW_BAR; bar.x = 0; bar.st = nullptr;
  if (multi) bar = xcd_barrier_post(ctl + CW_BAR, MISC, X.tid);
  LAS unsigned char* lds = X.lds;
  unsigned char* ws = X.ws;
  const float* mod = (const float*)(ws + WS_MOD); (void)mod;
#ifndef PH_MASK
#define PH_MASK 0x1fffffull
#endif
#define IN(k) ((((unsigned long long)PH_MASK >> (k)) & 1ull) && lo <= (k) && (k) < hi)
#define SEAM(k) do { if (IN(k) && IN((k) + 1)) xcd_barrier(bar, X.tid); } while (0)
#ifndef REP_MASK
#define REP_MASK 0ull
#endif
#define REPS(k) ((int)(((unsigned long long)REP_MASK >> (k)) & 1ull))
#define FILL(ph, nb) do { if (!(args.flags & FLAG_SKIP_EXPERTS) && multi) { if (X.c < (nb)) { __syncthreads(); if (X.tid == 0) atomicAdd(ctl + CW_DONE + 64 * (ph), 1u); } \
    else transpose_work(X, ctl + CW_DQ1, 0, 0, 1, 65 * IT_EXP, ctl + CW_DONE + 64 * (ph), (unsigned)(nb)); } } while (0)
#define LAUNDER() do { int w0_ = wave_s; asm volatile("" : "+s"(w0_)); int l_ = __builtin_amdgcn_mbcnt_hi(~0u, __builtin_amdgcn_mbcnt_lo(~0u, 0u)); asm volatile("" : "+v"(l_)); X.wave = w0_; X.lane = l_; X.tid = w0_ * 64 + l_; \
    size_t z0_ = 0; asm volatile("" : "+s"(z0_)); unsigned char* w_ = args.ws + z0_; X.ws = w_; ws = w_; mod = (const float*)(w_ + WS_MOD); } while (0)
  if (IN(0)) for (int rep_ = 0; rep_ <= REPS(0); ++rep_) { if (rep_) xcd_barrier(bar, X.tid); LAUNDER(); phase_prep(X, rep_); } SEAM(0);
#ifdef EXTRA_BARS
  if (multi) for (int eb_ = 0; eb_ < EXTRA_BARS; ++eb_) xcd_barrier(bar, X.tid);
#endif
  if (IN(1)) for (int rep_ = 0; rep_ <= REPS(1); ++rep_) { if (rep_) xcd_barrier(bar, X.tid); LAUNDER(); phase_mod0(X); } SEAM(1);
  if (IN(2)) for (int rep_ = 0; rep_ <= REPS(2); ++rep_) { if (rep_) xcd_barrier(bar, X.tid); LAUNDER(); G1 p; p.K = 1024; p.nunits = 520; p.ws = ws; p.qg = args.in[IN_QG]; p.kg = args.in[IN_KG]; gemm_phase<G1, SP2>(lds, p, X.G, X.c, X.tid); FILL(2, 8); } SEAM(2);
  if (IN(3)) for (int rep_ = 0; rep_ <= REPS(3); ++rep_) { if (rep_) xcd_barrier(bar, X.tid); LAUNDER(); G2 p; p.K = 512; p.nunits = 96; p.ws = ws; gemm_phase<G2, SP2>(lds, p, X.G, X.c, X.tid); FILL(3, 96); } SEAM(3);
  if (IN(4)) for (int rep_ = 0; rep_ <= REPS(4); ++rep_) { if (rep_) xcd_barrier(bar, X.tid); LAUNDER(); phase_scan(X); FILL(4, 64); } SEAM(4);
  if (IN(5)) for (int rep_ = 0; rep_ <= REPS(5); ++rep_) { if (rep_) xcd_barrier(bar, X.tid); LAUNDER(); G3 p; p.K = 768; p.nunits = 128; p.ws = ws; gemm_phase<G3, SP2>(lds, p, X.G, X.c, X.tid); FILL(5, 128); } SEAM(5);
  if (IN(6)) for (int rep_ = 0; rep_ <= REPS(6); ++rep_) { if (rep_) xcd_barrier(bar, X.tid); LAUNDER(); G4 p; p.K = 512; p.nunits = 128; p.ws = ws; p.bglu = args.in[IN_BGLU]; gemm_phase<G4, SP2>(lds, p, X.G, X.c, X.tid); FILL(6, 128); } SEAM(6);
  if (IN(7)) for (int rep_ = 0; rep_ <= REPS(7); ++rep_) { if (rep_) xcd_barrier(bar, X.tid); LAUNDER(); phase_attn(X); } SEAM(7);
  if (IN(8)) for (int rep_ = 0; rep_ <= REPS(8); ++rep_) { if (rep_) xcd_barrier(bar, X.tid); LAUNDER(); GRes p; p.K = 1024; p.nunits = 256; p.A = (const char*)ws + WS_CONCAT; p.Bt = (const char*)ws + WS_WMIX_T; p.hin = args.in[IN_X]; p.hout = args.h; p.gate = mod + 2048; p.bias = nullptr;
    gemm_phase<GRes, SP2>(lds, p, X.G, X.c, X.tid); } SEAM(8);
#pragma unroll 1
  for (int layer = 0; layer < 2; ++layer) {
    const int pb = layer == 0 ? 9 : 17;
    if (IN(pb)) for (int rep_ = 0; rep_ <= REPS(pb); ++rep_) { if (rep_) xcd_barrier(bar, X.tid); LAUNDER(); phase_router(X, layer, rep_); } SEAM(pb);
    if (IN(pb + 1)) for (int rep_ = 0; rep_ <= REPS(pb + 1); ++rep_) { if (rep_) xcd_barrier(bar, X.tid); LAUNDER(); build_moetab(X, layer, TOFF); G6 p; p.K = 512; p.ws = ws; p.toff = TOFF; p.nunits = TOFF[65] * 2; p.wbase = (const char*)ws + (layer == 0 ? WS_WEXP : WS_WEXP1); p.wstride = layer == 0 ? EXP_STRIDE : EXP1_STRIDE;
      { LAS unsigned* tk = (LAS unsigned*)(X.lds + LDS_STAGE); p.tokt = tk; p.build_tokt(X, tk); } gemm_phase<G6, SP2>(lds, p, X.G, X.c, X.tid); } SEAM(pb + 1);
    if (IN(pb + 2)) for (int rep_ = 0; rep_ <= REPS(pb + 2); ++rep_) { if (rep_) xcd_barrier(bar, X.tid); LAUNDER(); build_moetab(X, layer, TOFF); G7 p; p.K = 256; p.ws = ws; p.toff = TOFF; p.dry = rep_; p.nunits = TOFF[65] * 4; p.wbase = (const char*)ws + (layer == 0 ? WS_WEXP + EXP_DOFF : WS_WEXP1 + EXP1_DOFF); p.wstride = layer == 0 ? EXP_STRIDE : EXP1_STRIDE; gemm_phase<G7, SP2>(lds, p, X.G, X.c, X.tid); } SEAM(pb + 2);
    if (IN(pb + 3)) for (int rep_ = REPS(pb + 3); rep_ >= 0; --rep_) { if (rep_ == 0 && REPS(pb + 3)) xcd_barrier(bar, X.tid); LAUNDER(); build_moetab(X, layer, TOFF); phase_combine(X, layer, TOFF, rep_);
      if (layer == 0 && rep_ == 0 && !(args.flags & FLAG_SKIP_EXPERTS)) { __syncthreads(); transpose_work(X, ctl + CW_DQ1, 0, 0, 1, 65 * IT_EXP); } }
    if (layer == 0) {
      SEAM(12);
      if (IN(13)) for (int rep_ = 0; rep_ <= REPS(13); ++rep_) { if (rep_) xcd_barrier(bar, X.tid); LAUNDER(); G8 p; p.K = 256; p.nunits = 512; p.ws = ws; gemm_phase<G8, SP2>(lds, p, X.G, X.c, X.tid); } SEAM(13);
      if (IN(14)) for (int rep_ = 0; rep_ <= REPS(14); ++rep_) { if (rep_) xcd_barrier(bar, X.tid); LAUNDER(); G9 p; p.K = 256; p.nunits = 512; p.ws = ws; gemm_phase<G9, SP2>(lds, p, X.G, X.c, X.tid); } SEAM(14);
      if (IN(15)) for (int rep_ = 0; rep_ <= REPS(15); ++rep_) { if (rep_) xcd_barrier(bar, X.tid); LAUNDER(); G10 p; p.K = 256; p.nunits = 512; p.ws = ws; gemm_phase<G10, SP2>(lds, p, X.G, X.c, X.tid); } SEAM(15);
      if (IN(16)) { LAUNDER(); zero_lists(X); GRes p; p.K = 1024; p.nunits = 256; p.A = (const char*)ws + WS_FB; p.Bt = (const char*)ws + WS_WFOUR_T; p.hin = args.h; p.hout = args.h; p.gate = mod + 2 * 6144 + 2048; p.bias = args.in[IN_BFOUR];
        gemm_phase<GRes, SP2>(lds, p, X.G, X.c, X.tid); } SEAM(16);
    }
  }
#undef IN
#undef SEAM
}
}
#ifndef MK_SP2
#define MK_SP2 true
#endif
#ifndef MK_N_LAUNCHES
#define MK_N_LAUNCHES 1
#endif
#ifndef CHECK
#define CHECK 0
#endif
static int g_grid = 0;
static bool mk_setup(int n_in, int out_size, size_t ws_size) {
  if (g_grid == 0) {
    g_grid = -1;
    if (n_in != 31 || out_size != 16384 * 1024 || ws_size < mk::WS_NEED) { fprintf(stderr, "kernel_launch: unexpected n_in %d out %d ws %zu\n", n_in, out_size, ws_size); return false; }
    int dev = 0, cus = 0;
    if (hipGetDevice(&dev) != hipSuccess || hipDeviceGetAttribute(&cus, hipDeviceAttributeMultiprocessorCount, dev) != hipSuccess) return false;
    if (cus < 256) { fprintf(stderr, "kernel_launch: needs 256 CUs, device has %d\n", cus); return false; }
    if (hipFuncSetAttribute((const void*)mk::mk_fwd<MK_SP2>, hipFuncAttributeMaxDynamicSharedMemorySize, mk::LDS_BYTES) != hipSuccess) { fprintf(stderr, "kernel_launch: hipFuncSetAttribute failed\n"); return false; }
    g_grid = 256;
  }
  return g_grid > 0;
}
static void mk_run(hipStream_t s, mk::Args a, int lo, int hi) {
  a.ph_lo = lo; a.ph_hi = hi;
  hipLaunchKernelGGL(mk::mk_fwd<MK_SP2>, dim3(g_grid), dim3(mk::NTHR), mk::LDS_BYTES, s, a);
}

#if CHECK
namespace chk {
using mk::bf16_t;
__device__ __forceinline__ float b2f(bf16_t b) { return __uint_as_float(((unsigned)b) << 16); }
__global__ void k_cmp(int mode, const void* A, const float* B, unsigned long long n, double* acc) {
  double e = 0.0, r = 0.0; const bf16_t* A16 = (const bf16_t*)A;
  for (unsigned long long i = (unsigned long long)blockIdx.x * 256 + threadIdx.x; i < n; i += (unsigned long long)gridDim.x * 256) {
    float a = 0.f, b = 0.f; const int row = (int)(i >> 9), col = (int)(i & 511);
    switch (mode) {
      case 0: a = ((const float*)A)[i]; b = B[i]; break;
      case 1: a = b2f(A16[i]); b = B[i]; break;
      case 2: { b = B[(size_t)row * 2048 + col]; const int g = col >> 4, c = col & 15; int crow, s; if (row < 16384) { crow = row >> 5; s = row & 31; } else { const int j = row - 16384; crow = 512 + (j >> 5); s = j & 31; }
                a = b2f(A16[((size_t)(g * 768 + crow)) * 768 + s * 16 + c]); } break;
      case 3: b = B[(size_t)row * 2048 + 512 + col]; a = b2f(A16[(size_t)row * 512 + col]); break;
      case 4: b = B[(size_t)row * 2048 + 1024 + col]; a = b2f(A16[(size_t)row * 512 + col]); break;
      case 5: b = B[(size_t)row * 2048 + 1536 + col]; a = b2f(A16[(size_t)col * 16640 + row]); break;
      case 6: b = B[(size_t)row * 1024 + col]; a = b2f(A16[(size_t)row * 1024 + col]); break;
      case 7: b = B[(size_t)row * 1024 + 512 + col]; a = b2f(A16[(size_t)row * 1024 + 512 + col]); break;
      case 8: { const int ta = (int)(i & 127), ri = (int)((i >> 7) & 1), tb = (int)((i >> 8) & 127), m = (int)((i >> 15) & 255), g = (int)(i >> 23); a = b2f(A16[i]); const int t = 128 * ta + tb; b = B[((size_t)t * 4 + g) * 512 + ri * 256 + m]; } break;
      default: break;
    }
    const double d = (double)a - (double)b; e += d * d; r += (double)b * (double)b;
  }
  for (int o = 32; o >= 1; o >>= 1) { e += __shfl_xor(e, o); r += __shfl_xor(r, o); }
  if ((threadIdx.x & 63) == 0) { atomicAdd(acc, e); atomicAdd(acc + 1, r); }
}
__global__ void k_cmp_x2(const bf16_t* X2, const float* Yr, const float* Yi, double* acc) {
  double e = 0.0, r = 0.0;
  for (unsigned long long i = (unsigned long long)blockIdx.x * 256 + threadIdx.x; i < (1ull << 25); i += (unsigned long long)gridDim.x * 256) {
    const int tb = (int)(i & 127), rip = (int)((i >> 7) & 1), ka = (int)((i >> 8) & 127), gm = (int)(i >> 15);
    const float a = b2f(X2[i]); const size_t yi = (((size_t)ka * 128 + tb) << 10) + gm; const float b = rip ? Yi[yi] : Yr[yi];
    const double d = (double)a - (double)b; e += d * d; r += (double)b * (double)b;
  }
  for (int o = 32; o >= 1; o >>= 1) { e += __shfl_xor(e, o); r += __shfl_xor(r, o); }
  if ((threadIdx.x & 63) == 0) { atomicAdd(acc, e); atomicAdd(acc + 1, r); }
}
__global__ void k_judge(const double* acc, int n, float tol, int* fail) {
  if (threadIdx.x == 0 && blockIdx.x == 0) { fail[0] = 0; for (int k = 0; k < n; ++k) { const double rel = sqrt(acc[2 * k] / acc[2 * k + 1]); if (!(rel <= (double)tol)) { fail[0] = k + 1; break; } } }
}
__global__ void k_encode(float* out, size_t n, const int* fail) {
  const int f = fail[0]; if (f == 0) return; const float sc = 1.f + 0.1f * (float)f;
  for (size_t i = (size_t)blockIdx.x * 256 + threadIdx.x; i < n; i += (size_t)gridDim.x * 256) out[i] *= sc;
}
__global__ void k_f2bf(const float* in, bf16_t* out, size_t n) { for (size_t i = (size_t)blockIdx.x * 256 + threadIdx.x; i < n; i += (size_t)gridDim.x * 256) out[i] = mk::f2bf(in[i]); }
static void cmp(hipStream_t s, int mode, const void* A, const float* B, unsigned long long n, double* acc) { hipLaunchKernelGGL(k_cmp, dim3(2048), dim3(256), 0, s, mode, A, B, n, acc); }
}
#endif

extern "C" void kernel_launch(void* const* d_in, const int* in_sizes, int n_in, void* d_out, int out_size, void* d_ws, size_t ws_size, hipStream_t stream) {
  if (!mk_setup(n_in, out_size, ws_size)) return;
  unsigned char* ws = (unsigned char*)d_ws;
  const size_t MiB = mk::MiB;
  mk::Args a{};
  for (int i = 0; i < 31; ++i) a.in[i] = (const float*)d_in[i];
  a.h = (float*)d_out; a.ws = ws; a.flags = 0; a.pad = 0;
#if CHECK == 0
  (void)hipMemsetAsync(ws + mk::WS_CTL, 0, mk::CTL_ZERO_BYTES, stream);
#if MK_N_LAUNCHES == 1
  mk_run(stream, a, 0, mk::NPHASE);
#else
  for (int ph = 0; ph < mk::NPHASE; ++ph) mk_run(stream, a, ph, ph + 1);
#endif
#else
  ref::In in; { const float** p = (const float**)&in; for (int i = 0; i < 31; ++i) p[i] = (const float*)d_in[i]; }
  float* out = (float*)d_out;
  char* wsc = (char*)d_ws;
  ref::Small sm; sm.mod = (float*)(wsc + 498 * MiB); sm.lamb = (float2*)(wsc + 498 * MiB + 131072); sm.bbar = (float2*)(wsc + 498 * MiB + 262144);
  sm.tw = (float2*)(wsc + 499 * MiB); sm.Dm = (float*)(wsc + 499 * MiB + 262144);
  double* acc = (double*)(wsc + 500 * MiB); int* fail = (int*)(wsc + 500 * MiB + 4096);
  (void)hipMemsetAsync(acc, 0, 8192, stream);
  (void)hipMemsetAsync(ws + mk::WS_CTL, 0, mk::CTL_ZERO_BYTES, stream);
  float* HOPT = (float*)(ws + mk::WS_HOPT);
  int nchk = 0;
#if CHECK == 1
  ref::MixBuf mb; mb.a0 = (float*)(wsc + 12 * MiB); mb.z = (float*)(wsc + 336 * MiB); mb.g = (float*)(wsc + 466 * MiB); mb.t = (float*)(wsc + 77 * MiB); mb.concat = mb.a0; mb.ymix = mb.z;
  char* moe_arena = wsc + 12 * MiB;
  ref::FourBuf fb; { char* p = wsc + 12 * MiB; fb.a1 = (float*)p; p += 64 * MiB; fb.Z = (float*)p; p += 128 * MiB; fb.Yr = (float*)p; p += 64 * MiB; fb.Yi = (float*)p; p += 64 * MiB; fb.F = (float*)p; fb.yf = fb.Z; }
  a.flags = mk::FLAG_SKIP_EXPERTS;
  nchk = 10;
  ref::forward(stream, in, out, sm, mb, moe_arena, fb, [&](int st) {
    if (st == 1) { mk_run(stream, a, 0, 1); chk::cmp(stream, 0, ws + mk::WS_MOD, sm.mod, 3 * 6144, acc + 0); }
    if (st == 2) { mk_run(stream, a, 1, 2); chk::cmp(stream, 1, ws + mk::WS_A0, mb.a0, 16640ull * 1024, acc + 2); }
    if (st == 3) { mk_run(stream, a, 2, 3); chk::cmp(stream, 2, ws + mk::WS_AS5, mb.z, 16640ull * 512, acc + 4); chk::cmp(stream, 3, ws + mk::WS_Q, mb.z, 16384ull * 512, acc + 6);
                   chk::cmp(stream, 4, ws + mk::WS_K, mb.z, 16640ull * 512, acc + 8); chk::cmp(stream, 5, ws + mk::WS_VT, mb.z, 16640ull * 512, acc + 10); }
    if (st == 4) { mk_run(stream, a, 3, 4); mk_run(stream, a, 4, 5); mk_run(stream, a, 5, 6); chk::cmp(stream, 1, ws + mk::WS_GB, mb.g, 16384ull * 512, acc + 12); }
    if (st == 5) { mk_run(stream, a, 6, 7); chk::cmp(stream, 6, ws + mk::WS_CONCAT, mb.concat, 16384ull * 512, acc + 14); }
    if (st == 6) { mk_run(stream, a, 7, 8); chk::cmp(stream, 7, ws + mk::WS_CONCAT, mb.concat, 16384ull * 512, acc + 16); }
    if (st == 7) { mk::Args b = a; b.h = HOPT; mk_run(stream, b, 8, 9); chk::cmp(stream, 0, HOPT, out, 16384ull * 1024, acc + 18); }
  });
#elif CHECK == 2 || CHECK == 4
  const int L = CHECK == 2 ? 0 : 1;
  ref::MixBuf mb; { char* p = wsc + 12 * MiB; mb.a0 = (float*)p; p += 65 * MiB; mb.z = (float*)p; p += 130 * MiB; mb.g = (float*)p; p += 32 * MiB; mb.t = (float*)p; p += 32 * MiB; mb.concat = (float*)p; p += 64 * MiB; mb.ymix = mb.z; }
  ref::FourBuf fb; { char* p = wsc + 12 * MiB; fb.a1 = (float*)p; p += 64 * MiB; fb.Z = (float*)p; p += 128 * MiB; fb.Yr = (float*)p; p += 64 * MiB; fb.Yi = (float*)p; p += 64 * MiB; fb.F = (float*)p; fb.yf = fb.Z; }
  char* moe_arena = wsc + 110 * MiB;
  nchk = L == 0 ? 2 : 1;
  a.flags = 0;
  ref::forward(stream, in, out, sm, mb, moe_arena, fb, [&](int st) {
    if ((L == 0 && st == 7) || (L == 1 && st == 11)) {
      mk::Args b = a; b.h = HOPT; if (L == 1) b.flags = 2;
      mk_run(stream, b, 0, 1);
      (void)hipMemcpyAsync(HOPT, out, (size_t)16384 * 1024 * 4, hipMemcpyDeviceToDevice, stream);
      const int pb = L == 0 ? 9 : 20; b.flags |= mk::FLAG_SKIP_EXPERTS;
      for (int ph = pb; ph < pb + 7; ++ph) mk_run(stream, b, ph, ph + 1);
    }
    if ((L == 0 && st == 8) || (L == 1 && st == 12)) chk::cmp(stream, 0, HOPT, out, 16384ull * 1024, acc + 0);
    if (L == 0 && st == 9) chk::cmp(stream, 1, ws + mk::WS_A1, fb.a1, 16384ull * 1024, acc + 2);
  });
#elif CHECK == 3
  ref::MixBuf mb; { char* p = wsc + 12 * MiB; mb.a0 = (float*)p; p += 65 * MiB; mb.z = (float*)p; p += 130 * MiB; mb.g = (float*)p; p += 32 * MiB; mb.t = (float*)p; p += 32 * MiB; mb.concat = (float*)p; p += 64 * MiB; mb.ymix = mb.z; }
  char* moe_arena = wsc + 12 * MiB;
  ref::FourBuf fb; fb.Z = (float*)(wsc + 270 * MiB);
  fb.a1 = (float*)(wsc + 12 * MiB); fb.Yr = (float*)(wsc + 12 * MiB);   fb.Yi = (float*)(wsc + 468 * MiB - 0); fb.F = (float*)(wsc + 270 * MiB); fb.yf = (float*)(wsc + 334 * MiB);
  fb.Yi = (float*)(wsc + 76 * MiB);
  nchk = 4;
  a.flags = mk::FLAG_SKIP_EXPERTS;
  ref::forward(stream, in, out, sm, mb, moe_arena, fb, [&](int st) {
    if (st == 9) {
      mk::Args b = a; b.h = HOPT;
      mk_run(stream, b, 0, 1);
      hipLaunchKernelGGL(chk::k_f2bf, dim3(2048), dim3(256), 0, stream, fb.a1, (chk::bf16_t*)(ws + mk::WS_A1), (size_t)16384 * 1024);
      (void)hipMemcpyAsync(HOPT, out, (size_t)16384 * 1024 * 4, hipMemcpyDeviceToDevice, stream);
      mk_run(stream, b, 16, 17);
    }
  });
#endif
  hipLaunchKernelGGL(chk::k_judge, dim3(1), dim3(64), 0, stream, acc, nchk, 0.05f, fail);
  hipLaunchKernelGGL(chk::k_encode, dim3(2048), dim3(256), 0, stream, out, (size_t)16384 * 1024, fail);
#endif
}
```

```cpp
#define CHECK 0
#define MK_N_LAUNCHES 1
#define MK_SP2 true
#define REP_MASK 0ull
#define ROUTER_VARIANT 1
#include <hip/hip_runtime.h>
#include <cstdio>
#include <cstdint>
#include <cmath>
namespace mk {
#define LAS __attribute__((address_space(3)))
typedef unsigned short bf16_t;
typedef short bf16x8 __attribute__((ext_vector_type(8)));
typedef float f32x4 __attribute__((ext_vector_type(4)));
typedef float f32x2 __attribute__((ext_vector_type(2)));
typedef unsigned u32x4 __attribute__((ext_vector_type(4)));
typedef unsigned u32x2 __attribute__((ext_vector_type(2)));
typedef int i32x8 __attribute__((ext_vector_type(8)));
typedef int i32x4 __attribute__((ext_vector_type(4)));

constexpr int TOK = 16384, CTXN = 256, NROW = TOK + CTXN;
constexpr int NWAVES = 8, NTHR = 512;
constexpr int LDS_STAGE = 131072, LDS_BYTES = 155648, LDS_MISC_OFF = LDS_BYTES - 4096;

__device__ __forceinline__ unsigned cvt_pk_bf16(float lo, float hi) { unsigned r; asm volatile("v_cvt_pk_bf16_f32 %0, %1, %2" : "=v"(r) : "v"(lo), "v"(hi)); return r; }
__device__ __forceinline__ float bf_lo(unsigned w) { return __uint_as_float(w << 16); }
__device__ __forceinline__ float bf_hi(unsigned w) { return __uint_as_float(w & 0xffff0000u); }
__device__ __forceinline__ float bf2f(bf16_t b) { return __uint_as_float(((unsigned)b) << 16); }
__device__ __forceinline__ bf16_t f2bf(float f) { unsigned u = __float_as_uint(f); return (bf16_t)((u + 0x7fffu + ((u >> 16) & 1u)) >> 16); }
__device__ __forceinline__ float sx(float v, int o) { int l = __builtin_amdgcn_mbcnt_hi(~0u, __builtin_amdgcn_mbcnt_lo(~0u, 0u)); asm volatile("" : "+v"(l)); return __int_as_float(__builtin_amdgcn_ds_bpermute((l ^ o) << 2, __float_as_int(v))); }
__device__ __forceinline__ float wave_sum(float v) {
#pragma unroll
  for (int o = 1; o < 64; o <<= 1) v += sx(v, o);
  return v;
}
__device__ __forceinline__ float fast_sigmoid(float x) { return __builtin_amdgcn_rcpf(1.f + __expf(-x)); }
__device__ __forceinline__ float fast_tanh(float x) { float e = __expf(2.f * x); return 1.f - 2.f * __builtin_amdgcn_rcpf(e + 1.f); }
__device__ __forceinline__ float gelu_tanh(float x) { return 0.5f * x * (1.f + fast_tanh(0.7978845608028654f * (x + 0.044715f * x * x * x))); }

#define XB_TMO      128
#define XB_XCNT(j)  (256  + 64 * (j))
#define XB_XSUB(j)  (1280 + 64 * (j))
#define XB_XGEN(j)  (2304 + 64 * (j))
#define XB_TOP      3328
#define XB_TOPGEN   3392
#define XCD_BAR_WORDS 3456
#define XB_SPIN_CAP (1u << 20)
__device__ __forceinline__ unsigned xb_ld(unsigned* p) { return __hip_atomic_load(p, __ATOMIC_RELAXED, __HIP_MEMORY_SCOPE_AGENT); }
__device__ __forceinline__ unsigned xb_add(unsigned* p, unsigned v) { return __hip_atomic_fetch_add(p, v, __ATOMIC_RELAXED, __HIP_MEMORY_SCOPE_AGENT); }
__device__ __forceinline__ unsigned xb_xcc_id() { return (unsigned)__builtin_amdgcn_s_getreg((3 << 11) | 20) & 0xFu; }
#define XB_SPIN(cond, bar) do { unsigned _sp = 0; while (cond) { __builtin_amdgcn_s_sleep(1); \
    if ((++_sp & 255u) == 0u) { if (xb_ld(&(bar)[XB_TMO])) break; if (_sp > XB_SPIN_CAP) { atomicAdd(&(bar)[XB_TMO], 1u); break; } } } } while (0)
struct XcdBarrier { unsigned* bar; unsigned x; volatile LAS unsigned* st; };
__device__ __forceinline__ XcdBarrier xcd_barrier_post(unsigned* bar, volatile LAS unsigned* st, int tid) {
  XcdBarrier b; b.bar = bar; b.x = xb_xcc_id(); b.st = st;
  if (tid == 0) (void)xb_add(&bar[XB_XCNT(b.x)], 1u);
  return b;
}
__device__ __forceinline__ void xcd_barrier_complete(unsigned* bar, unsigned x, unsigned& nloc, unsigned& nx) {
  const unsigned G = gridDim.x * gridDim.y * gridDim.z;
  unsigned sum, cnt, mine, sp = 0u;
  for (;;) {
    sum = 0u; cnt = 0u; mine = 0u;
#pragma unroll
    for (unsigned j = 0; j < 16; ++j) { const unsigned c = xb_ld(&bar[XB_XCNT(j)]); sum += c; cnt += (c > 0u) ? 1u : 0u; }
    if (sum == G) { mine = xb_ld(&bar[256 + 64 * x]); break; }
    __builtin_amdgcn_s_sleep(1);
    if ((++sp & 255u) == 0u) { if (xb_ld(&bar[XB_TMO])) break; if (sp > XB_SPIN_CAP) { atomicAdd(&bar[XB_TMO], 1u); break; } }
  }
  nloc = mine > 0u ? mine : 1u; nx = cnt > 0u ? cnt : 1u;
}
__device__ __forceinline__ void xcd_barrier(const XcdBarrier& b, int tid) {
  asm volatile("s_waitcnt vmcnt(0)" ::: "memory");
  __syncthreads();
  if (tid == 0) {
    unsigned* bar = b.bar;
    __builtin_amdgcn_s_waitcnt(0);
    unsigned nloc = b.st[0], nx = b.st[1];
    if (nloc == 0u) { xcd_barrier_complete(bar, b.x, nloc, nx); b.st[0] = nloc; b.st[1] = nx; }
    const unsigned old = xb_add(&bar[XB_XSUB(b.x)], 1u);
    const unsigned gen = old / nloc;
    if (old + 1u == (gen + 1u) * nloc) {
      __builtin_amdgcn_fence(__ATOMIC_RELEASE, "agent");
      asm volatile("s_waitcnt vmcnt(0)" ::: "memory");
      const unsigned og = xb_add(&bar[XB_TOP], 1u);
      const unsigned tg = og / nx;
      if (og + 1u == (tg + 1u) * nx) xb_add(&bar[XB_TOPGEN], 1u);
      else XB_SPIN(xb_ld(&bar[XB_TOPGEN]) == tg, bar);
      __builtin_amdgcn_fence(__ATOMIC_ACQUIRE, "agent");
      xb_add(&bar[XB_XGEN(b.x)], 1u);
      asm volatile("s_waitcnt vmcnt(0)" ::: "memory");
    } else {
      XB_SPIN(xb_ld(&bar[XB_XGEN(b.x)]) == gen, bar);
      __builtin_amdgcn_fence(__ATOMIC_ACQUIRE, "agent");
      asm volatile("s_waitcnt vmcnt(0)" ::: "memory");
    }
  }
  __syncthreads();
}

constexpr int BM = 256, BK = 64, HALF = 128, HTB = HALF * BK * 2, NXCD = 8;
__device__ __forceinline__ int lds_byte(int r, int c) { const int st = (r >> 4) * 2 + (c >> 5), rr = r & 15, cc = c & 31, ob = rr * 64 + cc * 2; return st * 1024 + (ob ^ (((ob >> 9) & 1) << 5)); }
__device__ __forceinline__ void stage_rc(int b, int& R, int& C) { const int st = b / 1024, sb = b % 1024, swz = sb ^ (((sb >> 9) & 1) << 5); R = (st >> 1) * 16 + swz / 64; C = (st & 1) * 32 + (swz % 64) / 2; }
__device__ __forceinline__ int perm32(int rho) { const int n = rho >> 4, i = rho & 15; return 8 * (i >> 2) + 4 * n + (i & 3); }

struct Unit { int pm, pn, a, b, ord; };
__device__ __forceinline__ int xcd_remap(int L, int nunits) { const int q = nunits / NXCD, r = nunits % NXCD, xcd = L % NXCD, off = L / NXCD; return (xcd < r ? xcd * (q + 1) : r * (q + 1) + (xcd - r) * q) + off; }
typedef f32x4 Acc[2][2][4][2];
template <class P, bool SP2>
__device__ __forceinline__ void gemm_phase(LAS unsigned char* lds, const P& p, int G, int c, int tid_in) {
  const int tid = tid_in, wid = __builtin_amdgcn_readfirstlane(tid >> 6), lane = tid & 63, wr = wid >> 2, wc = wid & 3, fr = lane & 15, fq = lane >> 4;
  const int K = p.K, nt = K / BK;
  const int nunits = p.nunits;
  const size_t kstep = (size_t)(BK * 2);
  const unsigned ldsw = (unsigned)wid * 1024u;
  const int aoff = lds_byte(wr * 64 + fr, P::F8 ? fq * 16 : fq * 8), boff = lds_byte(wc * 32 + fr, P::F8 ? fq * 16 : fq * 8);
#define PG8_SA(b, h) (((b) * 2 + (h)) * HTB)
#define PG8_SB(b, h) ((4 + (b) * 2 + (h)) * HTB)
#define PG8_STAGE(bufoff, gbase, voff) do { _Pragma("unroll") for (int _i = 0; _i < 2; ++_i) \
        __builtin_amdgcn_global_load_lds((const unsigned*)((const char*)(gbase) + (voff)[_i]), (LAS unsigned*)(lds + (bufoff) + ldsw + _i * 8192), 16, 0, 0); } while (0)
#define PG8_RD32(p_) __builtin_shufflevector(*(const LAS i32x4*)(p_), *(const LAS i32x4*)((p_) + 16), 0, 1, 2, 3, 4, 5, 6, 7)
#define PG8_LDA(dst, b, h) do { if constexpr (P::F8) { _Pragma("unroll") for (int m = 0; m < 4; ++m) dst##8[m] = PG8_RD32(lds + PG8_SA(b, h) + aoff + m * 2048); } \
        else { _Pragma("unroll") for (int m = 0; m < 4; ++m) _Pragma("unroll") for (int k = 0; k < 2; ++k) dst[m][k] = *(const LAS bf16x8*)(lds + PG8_SA(b, h) + aoff + m * 2048 + k * 1024); } } while (0)
#define PG8_LDB(dst, b, h) do { if constexpr (P::F8) { _Pragma("unroll") for (int n = 0; n < 2; ++n) dst##8[n] = PG8_RD32(lds + PG8_SB(b, h) + boff + n * 2048); } \
        else { _Pragma("unroll") for (int n = 0; n < 2; ++n) _Pragma("unroll") for (int k = 0; k < 2; ++k) dst[n][k] = *(const LAS bf16x8*)(lds + PG8_SB(b, h) + boff + n * 2048 + k * 1024); } } while (0)
#define PG8_MMA(ai, bj, At, Bt) do { __builtin_amdgcn_s_setprio(1); if constexpr (P::F8) { _Pragma("unroll") for (int m = 0; m < 4; ++m) _Pragma("unroll") for (int n = 0; n < 2; ++n) \
        acc[ai][bj][m][n] = __builtin_amdgcn_mfma_scale_f32_16x16x128_f8f6f4(Bt##8[n], At##8[m], acc[ai][bj][m][n], 0, 0, 0, P::SCALE_B, 0, 0x7F7F7F7F); } \
        else { _Pragma("unroll") for (int m = 0; m < 4; ++m) _Pragma("unroll") for (int n = 0; n < 2; ++n) _Pragma("unroll") for (int k = 0; k < 2; ++k) \
        acc[ai][bj][m][n] = __builtin_amdgcn_mfma_f32_16x16x32_bf16(Bt[n][k], At[m][k], acc[ai][bj][m][n], 0, 0, 0); } __builtin_amdgcn_s_setprio(0); } while (0)
#define PG8_WAIT_V(n) asm volatile("s_waitcnt vmcnt(" #n ")" ::: "memory")
#define PG8_WAIT_L(n) asm volatile("s_waitcnt lgkmcnt(" #n ")" ::: "memory")
#define PG8_BAR __builtin_amdgcn_s_barrier()
#define PG8_SCHED __builtin_amdgcn_sched_barrier(0)
#define PG8_DECODE(i, u) do { p.decode(P::CONTIG ? (u_lo + (i)) : xcd_remap((i) * G + c, nunits), u); u.ord = (i); } while (0)
#define PG8_HAS(i) (P::CONTIG ? (u_lo + (i) < u_hi) : ((i) * G + c < nunits))
#define PG8_OFFS(u, vA, vB) do { int _t = tid; asm volatile("" : "+v"(_t)); _Pragma("unroll") for (int _i = 0; _i < 2; ++_i) { int _R, _C; stage_rc(_t * 16 + _i * 8192, _R, _C); \
        const int _Rb = P::PERM ? ((_R & ~31) + perm32(_R & 31)) : _R; _Pragma("unroll") for (int _h = 0; _h < 2; ++_h) { \
        if (_h == 0 || !P::LINA) vA[_h][_i] = p.rowA(u, _h * HALF + _R) + (unsigned)(_C * 2); if (_h == 0 || !P::LINB) vB[_h][_i] = p.rowB(u, _h * HALF + _Rb) + (unsigned)(_C * 2); } } } while (0)
  const int vc_ = (G % 8 == 0) ? (c % 8) * (G / 8) + c / 8 : c;
  const int u_lo = (int)(((long)vc_ * nunits) / G), u_hi = (int)(((long)(vc_ + 1) * nunits) / G);
  if (!PG8_HAS(0)) return;
  Unit cur, nxt; int ui = 0;
  PG8_DECODE(0, cur);
  Acc acc; float zf_ = 0.f; asm volatile("" : "+v"(zf_));
#pragma unroll
  for (int a = 0; a < 2; ++a)
#pragma unroll
    for (int b = 0; b < 2; ++b)
#pragma unroll
      for (int m = 0; m < 4; ++m)
#pragma unroll
        for (int n = 0; n < 2; ++n) acc[a][b][m][n] = (f32x4){zf_, zf_, zf_, zf_};
  bf16x8 At[4][2], B0[2][2], B1[2][2]; i32x8 At8[4], B08[2], B18[2];
  unsigned vA[2][2], vB[2][2];
  PG8_OFFS(cur, vA, vB);
  const char* cA = p.baseA(cur); const char* cB = p.baseB(cur);
  const size_t hA = P::LINA ? p.halfA() : 0, hB = P::LINB ? p.halfB() : 0;
  if constexpr (SP2) {
    PG8_STAGE(PG8_SB(0, 0), cB, vB[0]); PG8_STAGE(PG8_SB(0, 1), (cB) + (P::LINB ? hB : 0), vB[P::LINB ? 0 : 1]); PG8_STAGE(PG8_SA(0, 0), cA, vA[0]); PG8_STAGE(PG8_SA(0, 1), (cA) + (P::LINA ? hA : 0), vA[P::LINA ? 0 : 1]);
    if (wr == 1) PG8_BAR;
    PG8_WAIT_V(2); PG8_BAR;
    PG8_STAGE(PG8_SB(1, 0), cB + kstep, vB[0]); PG8_STAGE(PG8_SA(1, 0), cA + kstep, vA[0]); PG8_STAGE(PG8_SB(1, 1), (cB + kstep) + (P::LINB ? hB : 0), vB[P::LINB ? 0 : 1]);
    PG8_WAIT_V(6); PG8_BAR;
  } else {
    PG8_STAGE(PG8_SB(0, 0), cB, vB[0]); PG8_STAGE(PG8_SA(0, 0), cA, vA[0]); PG8_STAGE(PG8_SB(0, 1), (cB) + (P::LINB ? hB : 0), vB[P::LINB ? 0 : 1]); PG8_STAGE(PG8_SA(0, 1), (cA) + (P::LINA ? hA : 0), vA[P::LINA ? 0 : 1]);
    if (wr == 1) PG8_BAR;
    PG8_WAIT_V(4); PG8_BAR;
    PG8_STAGE(PG8_SB(1, 0), cB + kstep, vB[0]); PG8_STAGE(PG8_SA(1, 0), cA + kstep, vA[0]); PG8_STAGE(PG8_SB(1, 1), (cB + kstep) + (P::LINB ? hB : 0), vB[P::LINB ? 0 : 1]);
    PG8_WAIT_V(6); PG8_BAR;
  }
  for (;;) {
    const bool has_next = PG8_HAS(ui + 1);
    if (has_next) PG8_DECODE(ui + 1, nxt);
    const char* nA = has_next ? p.baseA(nxt) : cA; const char* nB = has_next ? p.baseB(nxt) : cB;
    for (int t = 0; t < nt; t += 2) {
      const bool last = (t == nt - 2);
      const char* a1 = cA + (size_t)(t + 1) * kstep;
      const char* a2 = last ? nA : cA + (size_t)(t + 2) * kstep; const char* b2 = last ? nB : cB + (size_t)(t + 2) * kstep;
      const char* a3 = a2 + kstep; const char* b3 = b2 + kstep;
      if constexpr (SP2) {
        PG8_LDB(B0, 0, 0); PG8_LDB(B1, 0, 1); PG8_SCHED; PG8_LDA(At, 0, 0); PG8_STAGE(PG8_SA(1, 1), (a1) + (P::LINA ? hA : 0), vA[P::LINA ? 0 : 1]);
        PG8_WAIT_V(8); PG8_WAIT_L(0); PG8_BAR; PG8_MMA(0, 0, At, B0); PG8_MMA(0, 1, At, B1); PG8_BAR; PG8_SCHED;
        if (last && has_next) { PG8_OFFS(nxt, vA, vB); }
        PG8_LDA(At, 0, 1); PG8_STAGE(PG8_SB(0, 0), b2, vB[0]); PG8_STAGE(PG8_SB(0, 1), (b2) + (P::LINB ? hB : 0), vB[P::LINB ? 0 : 1]); PG8_STAGE(PG8_SA(0, 0), a2, vA[0]);
        PG8_WAIT_V(8); PG8_WAIT_L(0); PG8_BAR; PG8_MMA(1, 0, At, B0); PG8_MMA(1, 1, At, B1); PG8_BAR; PG8_SCHED;
        PG8_LDB(B0, 1, 0); PG8_LDB(B1, 1, 1); PG8_SCHED; PG8_LDA(At, 1, 0); PG8_STAGE(PG8_SA(0, 1), (a2) + (P::LINA ? hA : 0), vA[P::LINA ? 0 : 1]);
        PG8_WAIT_V(8); PG8_WAIT_L(0); PG8_BAR; PG8_MMA(0, 0, At, B0); PG8_MMA(0, 1, At, B1); PG8_BAR; PG8_SCHED;
        PG8_LDA(At, 1, 1); PG8_STAGE(PG8_SB(1, 0), b3, vB[0]); PG8_STAGE(PG8_SB(1, 1), (b3) + (P::LINB ? hB : 0), vB[P::LINB ? 0 : 1]); PG8_STAGE(PG8_SA(1, 0), a3, vA[0]);
        PG8_WAIT_V(8); PG8_WAIT_L(0); PG8_BAR; PG8_MMA(1, 0, At, B0); PG8_MMA(1, 1, At, B1); PG8_BAR; PG8_SCHED;
      } else {
        PG8_LDB(B0, 0, 0); PG8_SCHED; PG8_LDA(At, 0, 0); PG8_STAGE(PG8_SA(1, 1), (a1) + (P::LINA ? hA : 0), vA[P::LINA ? 0 : 1]);
        PG8_WAIT_L(8); PG8_BAR; PG8_WAIT_L(0); PG8_MMA(0, 0, At, B0); PG8_BAR; PG8_SCHED;
        if (last && has_next) { PG8_OFFS(nxt, vA, vB); }
        PG8_LDB(B1, 0, 1); PG8_STAGE(PG8_SB(0, 0), b2, vB[0]);
        PG8_BAR; PG8_WAIT_L(0); PG8_MMA(0, 1, At, B1); PG8_BAR;
        PG8_LDA(At, 0, 1); PG8_STAGE(PG8_SA(0, 0), a2, vA[0]);
        PG8_BAR; PG8_WAIT_L(0); PG8_MMA(1, 0, At, B0); PG8_BAR; PG8_SCHED;
        PG8_STAGE(PG8_SB(0, 1), (b2) + (P::LINB ? hB : 0), vB[P::LINB ? 0 : 1]);
        PG8_WAIT_V(6); PG8_BAR; PG8_MMA(1, 1, At, B1); PG8_BAR;
        PG8_LDB(B0, 1, 0); PG8_SCHED; PG8_LDA(At, 1, 0); PG8_STAGE(PG8_SA(0, 1), (a2) + (P::LINA ? hA : 0), vA[P::LINA ? 0 : 1]);
        PG8_WAIT_L(8); PG8_BAR; PG8_WAIT_L(0); PG8_MMA(0, 0, At, B0); PG8_BAR; PG8_SCHED;
        PG8_LDB(B1, 1, 1); PG8_STAGE(PG8_SB(1, 0), b3, vB[0]);
        PG8_BAR; PG8_WAIT_L(0); PG8_MMA(0, 1, At, B1); PG8_BAR;
        PG8_LDA(At, 1, 1); PG8_STAGE(PG8_SA(1, 0), a3, vA[0]);
        PG8_BAR; PG8_WAIT_L(0); PG8_MMA(1, 0, At, B0); PG8_BAR; PG8_SCHED;
        PG8_STAGE(PG8_SB(1, 1), (b3) + (P::LINB ? hB : 0), vB[P::LINB ? 0 : 1]);
        PG8_WAIT_V(6); PG8_BAR; PG8_MMA(1, 1, At, B1); PG8_BAR;
      }
    }
    if constexpr (P::ALIGN) { if (wr == 0) PG8_BAR; }
    { int fr_e = fr, fq_e = fq; asm volatile("" : "+v"(fr_e), "+v"(fq_e)); p.epi(acc, cur, wr, wc, fr_e, fq_e); }
    if (!has_next) break;
    zf_ = 0.f; asm volatile("" : "+v"(zf_));
#pragma unroll
    for (int a = 0; a < 2; ++a)
#pragma unroll
      for (int b = 0; b < 2; ++b)
#pragma unroll
        for (int m = 0; m < 4; ++m)
#pragma unroll
          for (int n = 0; n < 2; ++n) acc[a][b][m][n] = (f32x4){zf_, zf_, zf_, zf_};
    cur = nxt; cA = nA; cB = nB; ++ui;
    if constexpr (P::ALIGN) { if (wr == 1) PG8_BAR; }
  }
  PG8_WAIT_V(0);
  if constexpr (!P::ALIGN) { if (wr == 0) PG8_BAR; }
  PG8_BAR;
#undef PG8_SA
#undef PG8_SB
#undef PG8_STAGE
#undef PG8_RD32
#undef PG8_LDA
#undef PG8_LDB
#undef PG8_MMA
#undef PG8_WAIT_V
#undef PG8_WAIT_L
#undef PG8_BAR
#undef PG8_SCHED
#undef PG8_DECODE
#undef PG8_HAS
#undef PG8_OFFS
}
}
namespace mk {
constexpr size_t MiB = 1u << 20;
constexpr size_t WS_CTL = 0, CTL_ZERO_BYTES = 65536;
constexpr size_t WS_MOD = 65536;
constexpr size_t WS_LAML = 262144;
constexpr size_t WS_WIN_T = 1 * MiB, WS_WGLU_T = 5 * MiB, WS_WMIX_T = 6 * MiB, WS_WFOUR_T = 8 * MiB, WS_WROUT_T = 10 * MiB;
constexpr size_t WS_DMT = 10 * MiB + 512 * 1024, WS_W1 = 10 * MiB + 768 * 1024, WS_W2 = 10 * MiB + 896 * 1024;
constexpr size_t WS_WEXP = 12 * MiB, EXP_STRIDE = 3 * MiB / 2, EXP_DOFF = 1 * MiB;
constexpr size_t WS_R = 110 * MiB;
constexpr size_t WS_WS = WS_R, WS_TT = WS_R + 8 * MiB, WS_A0 = WS_R + 34 * MiB, WS_AS5 = WS_R + 67 * MiB, WS_Q = WS_R + 103 * MiB, WS_K = WS_R + 119 * MiB,
                 WS_VT = WS_R + 136 * MiB, WS_SST = WS_R + 153 * MiB, WS_GB = WS_R + 177 * MiB, WS_CONCAT = WS_R + 193 * MiB;
constexpr size_t WS_F = WS_R, WS_LTOK = WS_R + 32 * MiB, WS_ASG = WS_R + 36 * MiB, WS_HID = WS_R + 42 * MiB, WS_YAS = WS_R + 130 * MiB,
                 WS_A1 = WS_R + 306 * MiB;
constexpr size_t WS_X1 = WS_R, WS_X2 = WS_R + 64 * MiB, WS_FB = WS_R + 128 * MiB;
constexpr size_t WS_HOPT = WS_R + 338 * MiB;
constexpr size_t WS_WEXP1 = WS_R + 338 * MiB;
constexpr size_t EXP1_STRIDE = 1 * MiB, EXP1_DOFF = 512 * 1024;
constexpr size_t WS_NEED = WS_R + 403 * MiB;
constexpr int HALF_CAP_ROWS = 90112;
constexpr int CW_BAR = 4096, CW_CNT = 8192  , CW_DQ0 = 12288, CW_DQ1 = 12352, CW_DONE = 13312  ;

struct Args { const float* in[31]; float* h; unsigned char* ws; int ph_lo, ph_hi, flags, pad; };
enum { IN_X = 0, IN_C, IN_CTX, IN_CCTX, IN_WADA, IN_BADA, IN_WIN, IN_LRE, IN_LIM, IN_LDT, IN_BRE, IN_BIM, IN_CRE, IN_CIM, IN_S5D, IN_WGLU, IN_BGLU, IN_QG, IN_KG,
       IN_RPB, IN_WMIX, IN_WFOUR, IN_BFOUR, IN_WROUT, IN_RBIAS, IN_WEG, IN_WEU, IN_WED, IN_WSG, IN_WSU, IN_WSD };
constexpr int FLAG_SKIP_EXPERTS = 1;

struct Ctx {
  LAS unsigned char* lds; const Args* a; unsigned char* ws; int tid, lane, wave, G, c;
};

__device__ __forceinline__ u32x4 pack8(const f32x4& v0, const f32x4& v1) { u32x4 w; w.x = cvt_pk_bf16(v0[0], v0[1]); w.y = cvt_pk_bf16(v0[2], v0[3]); w.z = cvt_pk_bf16(v1[0], v1[1]); w.w = cvt_pk_bf16(v1[2], v1[3]); return w; }
__device__ __forceinline__ int rowmap(int code, int n) {
  if (code == 1) { if (n < 512 || n >= 1536) return n; const int blk = n & ~255, c = n & 255; return blk + 128 * ((c >> 5) & 1) + 32 * (c >> 6) + (c & 31); }
  if (code == 2) return 256 * (n >> 7) + (n & 127);
  if (code == 3) return 256 * (n >> 7) + 128 + (n & 127);
  return n;
}
__device__ __forceinline__ void transpose_item(const float* W, int K, int N, bf16_t* WT, int code, LAS unsigned char* scr, int item, int lane) {
  const int nblk = N / 64, kb = item / nblk, nb = item % nblk, k0 = 64 * kb, n0 = 64 * nb;
  const int q = lane >> 4, a = lane & 15;
  f32x4 v[16];
  const float* src = W + (size_t)(k0 + 2 * q) * N + n0 + 4 * a;
#pragma unroll
  for (int i = 0; i < 16; ++i) v[i] = *(const f32x4*)(src + (size_t)((i & 1) + 8 * (i >> 1)) * N);
#pragma unroll
  for (int ii = 0; ii < 8; ++ii) { const int dsw = q + 4 * (ii ^ (a & 7));
#pragma unroll
    for (int j = 0; j < 4; ++j) *(LAS unsigned*)(scr + (4 * a + j) * 128 + 4 * dsw) = cvt_pk_bf16(v[2 * ii][j], v[2 * ii + 1][j]); }
  asm volatile("s_waitcnt lgkmcnt(0)" ::: "memory");
  const int c = lane & 7;
#pragma unroll
  for (int jj = 0; jj < 8; ++jj) { const int n = (lane >> 3) + 8 * jj, cs = c ^ ((n >> 2) & 7);
    const u32x4 o = *(const LAS u32x4*)(scr + n * 128 + 16 * cs);
    *(u32x4*)(WT + (size_t)rowmap(code, n0 + n) * K + k0 + 8 * c) = o; }
  asm volatile("s_waitcnt lgkmcnt(0)" ::: "memory");
}
__device__ __forceinline__ void transpose_item8(const float* W, int K, int N, unsigned char* WT, int code, float scale, LAS unsigned char* scr, int item, int lane) {
  const int nblk = N / 64, kb = item / nblk, nb = item % nblk, k0 = 64 * kb, n0 = 64 * nb;
  const int q = lane >> 4, a = lane & 15;
  f32x4 v[16];
  const float* src = W + (size_t)(k0 + 4 * q) * N + n0 + 4 * a;
#pragma unroll
  for (int i = 0; i < 16; ++i) v[i] = *(const f32x4*)(src + (size_t)((i & 3) + 16 * (i >> 2)) * N);
#pragma unroll
  for (int ib = 0; ib < 4; ++ib) { const int dsw = q + 4 * (ib ^ (a & 3));
#pragma unroll
    for (int j = 0; j < 4; ++j) { int w = 0; w = __builtin_amdgcn_cvt_pk_fp8_f32(v[4 * ib][j] * scale, v[4 * ib + 1][j] * scale, w, false); w = __builtin_amdgcn_cvt_pk_fp8_f32(v[4 * ib + 2][j] * scale, v[4 * ib + 3][j] * scale, w, true);
      *(LAS int*)(scr + (4 * a + j) * 64 + 4 * dsw) = w; } }
  asm volatile("s_waitcnt lgkmcnt(0)" ::: "memory");
  const int c = lane & 3;
#pragma unroll
  for (int jj = 0; jj < 4; ++jj) { const int n = (lane >> 2) + 16 * jj, cs = c ^ ((n >> 2) & 3);
    const u32x4 o = *(const LAS u32x4*)(scr + n * 64 + 16 * cs);
    *(u32x4*)(WT + (size_t)rowmap(code, n0 + n) * K + k0 + 16 * c) = o; }
  asm volatile("s_waitcnt lgkmcnt(0)" ::: "memory");
}
constexpr int IT_WIN = 512, IT_GLU = 64, IT_MIX = 256, IT_FOUR = 256, IT_ROUT = 32, IT_SMALL = IT_WIN + IT_GLU + IT_MIX + IT_FOUR + IT_ROUT, IT_EXP = 192;
__device__ __forceinline__ void small_item(const Ctx& X, LAS unsigned char* scr, int it) {
  const Args& a = *X.a; unsigned char* ws = X.ws;
  if (it < IT_WIN) { transpose_item(a.in[IN_WIN], 1024, 2048, (bf16_t*)(ws + WS_WIN_T), 1, scr, it, X.lane); return; } it -= IT_WIN;
  if (it < IT_GLU) { transpose_item(a.in[IN_WGLU], 512, 512, (bf16_t*)(ws + WS_WGLU_T), 0, scr, it, X.lane); return; } it -= IT_GLU;
  if (it < IT_MIX) { transpose_item(a.in[IN_WMIX], 1024, 1024, (bf16_t*)(ws + WS_WMIX_T), 0, scr, it, X.lane); return; } it -= IT_MIX;
  if (it < IT_FOUR) { transpose_item(a.in[IN_WFOUR], 1024, 1024, (bf16_t*)(ws + WS_WFOUR_T), 0, scr, it, X.lane); return; } it -= IT_FOUR;
  { const int l = it >> 4; transpose_item(a.in[IN_WROUT] + (size_t)l * 1024 * 64, 1024, 64, (bf16_t*)(ws + WS_WROUT_T) + (size_t)l * 64 * 1024, 0, scr, it & 15, X.lane); }
}
__device__ __forceinline__ void expert_item(const Ctx& X, LAS unsigned char* scr, int layer, int it) {
  const Args& a = *X.a; const int e = it / IT_EXP, r = it % IT_EXP;
  bf16_t* gu = (bf16_t*)(X.ws + (layer == 0 ? WS_WEXP + (size_t)e * EXP_STRIDE : WS_WEXP1 + (size_t)e * EXP1_STRIDE));
  bf16_t* dt = (bf16_t*)(X.ws + (layer == 0 ? WS_WEXP + (size_t)e * EXP_STRIDE + EXP_DOFF : WS_WEXP1 + (size_t)e * EXP1_STRIDE + EXP1_DOFF));
  const float *wg, *wu, *wd;
  if (e < 64) { const size_t o = ((size_t)layer * 64 + e) * 262144; wg = a.in[IN_WEG] + o; wu = a.in[IN_WEU] + o; wd = a.in[IN_WED] + o; }
  else { const size_t o = (size_t)layer * 262144; wg = a.in[IN_WSG] + o; wu = a.in[IN_WSU] + o; wd = a.in[IN_WSD] + o; }
  if (r < 64) transpose_item8(wg, 1024, 256, (unsigned char*)gu, 2, 32.f, scr, r, X.lane);
  else if (r < 128) transpose_item8(wu, 1024, 256, (unsigned char*)gu, 3, 32.f, scr, r - 64, X.lane);
  else transpose_item(wd, 256, 1024, dt, 0, scr, r - 128, X.lane);
}
__device__ __forceinline__ void transpose_work(const Ctx& X, unsigned* ctr, int first_small, int n_small, int layer, int n_exp_items, unsigned* done = nullptr, unsigned need = 0u) {
  LAS unsigned char* scr = X.lds + X.wave * 8192;
  volatile LAS int* shb = (volatile LAS int*)(X.lds + LDS_MISC_OFF + 1024);
  const int total = n_small + n_exp_items;
  const int per = done ? 1 : 4;
  for (;;) {
    __syncthreads();
    if (X.tid == 0) { int b = total; if (!done || __hip_atomic_load(done, __ATOMIC_RELAXED, __HIP_MEMORY_SCOPE_AGENT) < need) b = (int)atomicAdd(ctr, (unsigned)(8 * per)); shb[0] = b; }
    __syncthreads();
    const int base = shb[0];
    if (base >= total) break;
    for (int k = 0; k < per; ++k) { const int it = base + X.wave * per + k; if (it >= total) break;
      if (it < n_small) small_item(X, scr, first_small + it); else expert_item(X, scr, layer, it - n_small); }
  }
}

__device__ __forceinline__ void p0_adaln(const Ctx& X, int it) {
  const Args& a = *X.a; const int layer = it / 48, ct = it % 48, col = ct * 128 + X.lane;
  LAS float* sl = (LAS float*)X.lds;
  for (int i = X.tid; i < 2048; i += NTHR) { const float v = i < 1024 ? a.in[IN_C][i] : a.in[IN_CCTX][i - 1024]; sl[i] = v / (1.f + __expf(-v)); }
  __syncthreads();
  const float* W = a.in[IN_WADA] + (size_t)layer * 1024 * 6144 + col;
  float a0 = 0.f, a1 = 0.f, b0 = 0.f, b1 = 0.f; const int k0 = X.wave * 128;
#pragma unroll 16
  for (int k = 0; k < 128; ++k) { const float w0 = W[(size_t)(k0 + k) * 6144], w1 = W[(size_t)(k0 + k) * 6144 + 64]; const float s0 = sl[k0 + k], s1 = sl[1024 + k0 + k];
    a0 += s0 * w0; a1 += s1 * w0; b0 += s0 * w1; b1 += s1 * w1; }
  LAS float* red = sl + 2048;
  red[(X.wave * 128 + X.lane) * 2] = a0; red[(X.wave * 128 + X.lane) * 2 + 1] = a1; red[(X.wave * 128 + 64 + X.lane) * 2] = b0; red[(X.wave * 128 + 64 + X.lane) * 2 + 1] = b1;
  __syncthreads();
  if (X.tid < 256) { const int l = X.tid & 127, v = X.tid >> 7; float s = 0.f;
#pragma unroll
    for (int w = 0; w < 8; ++w) s += red[(w * 128 + l) * 2 + v];
    s += a.in[IN_BADA][layer * 6144 + ct * 128 + l];
    float* mod = (float*)(X.ws + WS_MOD);
    if (layer == 0) mod[v * 6144 + ct * 128 + l] = s; else if (v == 0) mod[2 * 6144 + ct * 128 + l] = s; }
  __syncthreads();
}

__device__ __forceinline__ void p0_s5tables(const Ctx& X, int g, int part) {
  const Args& a = *X.a;
  LAS f32x2* POW = (LAS f32x2*)X.lds;
  LAS f32x2* BB = (LAS f32x2*)(X.lds + 33792);
  LAS f32x2* CC = (LAS f32x2*)(X.lds + 33792 + 16384);
  LAS float* KK = (LAS float*)(X.lds + 33792 + 32768);
  LAS float* DD = (LAS float*)(X.lds + 33792 + 32768 + 65536);
  const int tid = X.tid;
  if (tid < 128) {
    const int dir = tid >> 6, p = tid & 63, idx = (dir * 32 + g) * 64 + p;
    const float lr = fminf(a.in[IN_LRE][idx], -1e-4f), li = a.in[IN_LIM][idx], dt = expf(a.in[IN_LDT][dir * 32 + g]);
    for (int tau = 0; tau <= 32; ++tau) { const float mg = expf(lr * dt * (float)tau); float sn, cs; sincospif(li * dt * (float)tau * 0.318309886183790672f, &sn, &cs); POW[(dir * 33 + tau) * 64 + p] = (f32x2){mg * cs, mg * sn}; }
    const f32x2 l1 = POW[(dir * 33 + 1) * 64 + p], l32 = POW[(dir * 33 + 32) * 64 + p];
    if (part == 0) ((float2*)(X.ws + WS_LAML))[idx] = make_float2(l32.x, l32.y);
    const float nr = l1.x - 1.f, ni = l1.y, den = lr * lr + li * li, cr = (nr * lr + ni * li) / den, ci = (ni * lr - nr * li) / den;
    for (int c = 0; c < 16; ++c) { const float xr = a.in[IN_BRE][idx * 16 + c], xi = a.in[IN_BIM][idx * 16 + c]; BB[(dir * 64 + p) * 16 + c] = (f32x2){cr * xr - ci * xi, cr * xi + ci * xr}; }
  }
  for (int i = tid; i < 2048; i += NTHR) { const int dir = i >> 10, c = (i >> 6) & 15, p = i & 63; const int gi = ((dir * 32 + g) * 16 + c) * 64 + p; CC[i] = (f32x2){a.in[IN_CRE][gi], a.in[IN_CIM][gi]}; }
  if (tid < 16) DD[tid] = a.in[IN_S5D][g * 16 + tid];
  __syncthreads();
  for (int combo = tid; combo < 1024; combo += NTHR) {
    const int dir = combo >> 9, tau = (combo >> 4) & 31, c = combo & 15;
    float accv[16];
#pragma unroll
    for (int j = 0; j < 16; ++j) accv[j] = 0.f;
#pragma unroll 2
    for (int p = 0; p < 64; ++p) {
      const f32x2 cc = CC[(dir * 16 + c) * 64 + p], pw = POW[(dir * 33 + tau) * 64 + p];
      const float zr = cc.x * pw.x - cc.y * pw.y, zi = cc.x * pw.y + cc.y * pw.x;
      const LAS f32x4* bp = (const LAS f32x4*)(BB + (dir * 64 + p) * 16);
#pragma unroll
      for (int j = 0; j < 8; ++j) { const f32x4 b = bp[j]; accv[2 * j] += zr * b.x - zi * b.y; accv[2 * j + 1] += zr * b.z - zi * b.w; }
    }
#pragma unroll
    for (int j = 0; j < 4; ++j) *(LAS f32x4*)(KK + ((dir * 32 + tau) * 16 + c) * 16 + 4 * j) = (f32x4){accv[4 * j], accv[4 * j + 1], accv[4 * j + 2], accv[4 * j + 3]};
  }
  __syncthreads();
  bf16_t* TT = (bf16_t*)(X.ws + WS_TT) + (size_t)g * 512 * 768;
  for (int q = part * 12288 + tid; q < (part + 1) * 12288; q += NTHR) {
    const int row = q / 96, cc8 = q % 96, i = row >> 4, c = row & 15; f32x4 v0, v1;
    if (cc8 < 64) {
      const int s = cc8 >> 1, c0 = (cc8 & 1) * 8;
      const int dir = s < i ? 0 : 1, tau = s < i ? i - s : s - i;
      const LAS f32x4* kp = (const LAS f32x4*)(KK + ((dir * 32 + tau) * 16 + c) * 16 + c0);
      v0 = kp[0]; v1 = kp[1];
      if (s == i) { const LAS f32x4* k0p = (const LAS f32x4*)(KK + ((0 * 32 + 0) * 16 + c) * 16 + c0); v0 += k0p[0]; v1 += k0p[1];
        const float d = DD[c]; const int dj = c - c0;
        if (dj >= 0 && dj < 4) v0[dj] += d; else if (dj >= 4 && dj < 8) v1[dj - 4] += d; }
    } else {
      const int kk = (cc8 - 64) * 8, dir = kk >> 7, ri = (kk >> 6) & 1, p0 = kk & 63, tau = dir == 0 ? i + 1 : 32 - i;
      const LAS f32x4* cp = (const LAS f32x4*)(CC + (dir * 16 + c) * 64 + p0); const LAS f32x4* pp = (const LAS f32x4*)(POW + (dir * 33 + tau) * 64 + p0);
      float v[8];
#pragma unroll
      for (int j = 0; j < 4; ++j) { const f32x4 cc = cp[j], pw = pp[j];
        v[2 * j] = ri == 0 ? (cc.x * pw.x - cc.y * pw.y) : -(cc.x * pw.y + cc.y * pw.x); v[2 * j + 1] = ri == 0 ? (cc.z * pw.z - cc.w * pw.w) : -(cc.z * pw.w + cc.w * pw.z); }
      v0 = (f32x4){v[0], v[1], v[2], v[3]}; v1 = (f32x4){v[4], v[5], v[6], v[7]};
    }
    *(u32x4*)(TT + (size_t)row * 768 + cc8 * 8) = pack8(v0, v1);
  }
  bf16_t* WSm = (bf16_t*)(X.ws + WS_WS) + (size_t)g * 256 * 512;
  for (int q = part * 4096 + tid; q < (part + 1) * 4096; q += NTHR) {
    const int n = q >> 6, cc8 = q & 63, dir = n >> 7, ri = (n >> 6) & 1, p = n & 63, s = cc8 >> 1, c0 = (cc8 & 1) * 8, tau = dir == 0 ? 31 - s : s;
    const f32x2 pw = POW[(dir * 33 + tau) * 64 + p]; const LAS f32x4* bp = (const LAS f32x4*)(BB + (dir * 64 + p) * 16 + c0); float v[8];
#pragma unroll
    for (int j = 0; j < 4; ++j) { const f32x4 b = bp[j]; v[2 * j] = ri == 0 ? (pw.x * b.x - pw.y * b.y) : (pw.x * b.y + pw.y * b.x); v[2 * j + 1] = ri == 0 ? (pw.x * b.z - pw.y * b.w) : (pw.x * b.w + pw.y * b.z); }
    *(u32x4*)(WSm + (size_t)n * 512 + cc8 * 8) = pack8((f32x4){v[0], v[1], v[2], v[3]}, (f32x4){v[4], v[5], v[6], v[7]});
  }
  __syncthreads();
}

__device__ __forceinline__ void p0_dftconst(const Ctx& X, int idx) {
  for (int q = idx * NTHR + X.tid; q < 32768; q += 32 * NTHR) {
    float v[8]; bf16_t* dst;
    if (q < 16384) {
      const int R = q >> 5, c0 = (q & 31) * 8, ri = R >> 8, m = R & 255; dst = (bf16_t*)(X.ws + WS_DMT) + (size_t)R * 256 + c0;
#pragma unroll
      for (int j = 0; j < 8; ++j) { float s, c; sincospif((float)(((c0 + j) * m) & 255) * (1.f / 128.f), &s, &c); v[j] = ri == 0 ? c : -s; }
    } else if (q < 24576) {
      const int q2 = q - 16384, R = q2 >> 5, c0 = (q2 & 31) * 8, rip = R >> 7, ka = R & 127; dst = (bf16_t*)(X.ws + WS_W1) + (size_t)R * 256 + c0;
#pragma unroll
      for (int j = 0; j < 8; ++j) { const int C = c0 + j, ri = C >> 7, ta = C & 127; float s, c; sincospif((float)((ka * ta) & 127) * (1.f / 64.f), &s, &c);
        v[j] = (rip == ri) ? c : (rip == 0 ? s : -s); }
    } else {
      const int q2 = q - 24576, R = q2 >> 5, c0 = (q2 & 31) * 8; dst = (bf16_t*)(X.ws + WS_W2) + (size_t)R * 256 + c0;
#pragma unroll
      for (int j = 0; j < 8; ++j) { const int C = c0 + j, rip = C >> 7, tb = C & 127; float s, c; sincospif((float)((R * tb) & 127) * (1.f / 64.f), &s, &c);
        v[j] = R < 128 ? (rip == 0 ? c : s) * (1.f / 2048.f) : 0.f; }
    }
    u32x4 o; o.x = cvt_pk_bf16(v[0], v[1]); o.y = cvt_pk_bf16(v[2], v[3]); o.z = cvt_pk_bf16(v[4], v[5]); o.w = cvt_pk_bf16(v[6], v[7]);
    *(u32x4*)dst = o;
  }
}

__device__ __forceinline__ void phase_prep(const Ctx& X, int rep) {
  const int c = X.c;
  if (c < 96) p0_adaln(X, c);
  else if (c < 224) p0_s5tables(X, (c - 96) >> 2, (c - 96) & 3);
  else p0_dftconst(X, c - 224);
  __syncthreads();
  unsigned* ctl = (unsigned*)(X.ws + WS_CTL);
  transpose_work(X, ctl + CW_DQ0 + 128 * rep, 0, IT_SMALL, (X.a->flags & 2) ? 1 : 0, (X.a->flags & FLAG_SKIP_EXPERTS) ? 0 : 65 * IT_EXP);
}

__device__ __forceinline__ void modulate_row(const float* hrow, const float* shift, const float* scale, bf16_t* orow, int lane) {
  const f32x4* xr = (const f32x4*)hrow + lane; f32x4 v[4]; float ss = 0.f;
#pragma unroll
  for (int j = 0; j < 4; ++j) { v[j] = xr[64 * j]; ss += (v[j].x * v[j].x + v[j].y * v[j].y) + (v[j].z * v[j].z + v[j].w * v[j].w); }
  const float r = rsqrtf(wave_sum(ss) * (1.f / 1024.f) + 1e-6f);
  u32x2* o8 = (u32x2*)orow + lane;
#pragma unroll
  for (int j = 0; j < 4; ++j) { const f32x4 sh = ((const f32x4*)shift)[lane + 64 * j], sc = ((const f32x4*)scale)[lane + 64 * j];
    u32x2 w; w.x = cvt_pk_bf16(v[j].x * r * (1.f + sc.x) + sh.x, v[j].y * r * (1.f + sc.y) + sh.y); w.y = cvt_pk_bf16(v[j].z * r * (1.f + sc.z) + sh.z, v[j].w * r * (1.f + sc.w) + sh.w);
    o8[64 * j] = w; }
}
__device__ __forceinline__ void phase_mod0(const Ctx& X) {
  const Args& a = *X.a; const float* mod = (const float*)(X.ws + WS_MOD); bf16_t* A0 = (bf16_t*)(X.ws + WS_A0);
  const int gw = X.c * NWAVES + X.wave, NGW = X.G * NWAVES;
  for (int r = gw; r < NROW; r += NGW) {
    if (r < TOK) modulate_row(a.in[IN_X] + (size_t)r * 1024, mod, mod + 1024, A0 + (size_t)r * 1024, X.lane);
    else modulate_row(a.in[IN_CTX] + (size_t)(r - TOK) * 1024, mod + 6144, mod + 6144 + 1024, A0 + (size_t)r * 1024, X.lane);
  }
}


struct G1 {
  static constexpr bool PERM = true; static constexpr bool F8 = false; static constexpr int SCALE_B = 0x7A7A7A7A; static constexpr bool CONTIG = false; static constexpr bool ALIGN = true; static constexpr bool LINA = true, LINB = true; __device__ __forceinline__ size_t halfA() const { return 128u * 2048u; } __device__ __forceinline__ size_t halfB() const { return 128u * 2048u; } int K, nunits; unsigned char* ws; const float* qg; const float* kg;
  __device__ __forceinline__ void decode(int w, Unit& u) const { if (w < 390) { u.a = 0; u.pm = w / 6; u.pn = w % 6; } else { const int w2 = w - 390; u.a = 1; u.pm = w2 & 1; u.pn = w2 >> 1; } u.b = 0; }
  __device__ __forceinline__ const char* baseA(const Unit& u) const { return (const char*)ws + (u.a == 0 ? WS_A0 : WS_WIN_T + (size_t)1536 * 2048); }
  __device__ __forceinline__ const char* baseB(const Unit& u) const { return (const char*)ws + (u.a == 0 ? WS_WIN_T : WS_A0); }
  __device__ __forceinline__ unsigned rowA(const Unit& u, int r) const { return (unsigned)(u.pm * 256 + r) * 2048u; }
  __device__ __forceinline__ unsigned rowB(const Unit& u, int r) const { return (unsigned)(u.pn * 256 + r) * 2048u; }
  __device__ __forceinline__ void epi(const Acc& acc, const Unit& u, int wr, int wc, int fr, int fq) const {
    if (u.a == 1) {
      bf16_t* VT = (bf16_t*)(ws + WS_VT);
#pragma unroll
      for (int ai = 0; ai < 2; ++ai)
#pragma unroll
        for (int m = 0; m < 4; ++m) { const int dd = u.pm * 256 + ai * 128 + wr * 64 + m * 16 + fr, head = dd >> 6, d = dd & 63;
#pragma unroll
          for (int bj = 0; bj < 2; ++bj) { const int t0 = u.pn * 256 + bj * 128 + wc * 32 + 8 * fq, kr = t0 >> 6, cg = (t0 >> 3) & 7;
            *(u32x4*)(VT + ((((size_t)(head * 260 + kr) * 8 + cg) * 64 + d) * 8)) = pack8(acc[ai][bj][m][0], acc[ai][bj][m][1]); } }
      return;
    }
    if (u.pn < 2) {
      bf16_t* AS5 = (bf16_t*)(ws + WS_AS5);
#pragma unroll
      for (int ai = 0; ai < 2; ++ai)
#pragma unroll
        for (int m = 0; m < 4; ++m) { const int row = u.pm * 256 + ai * 128 + wr * 64 + m * 16 + fr; int crow, s;
          if (row < TOK) { crow = row >> 5; s = row & 31; } else { const int j = row - TOK; crow = 512 + (j >> 5); s = j & 31; }
#pragma unroll
          for (int bj = 0; bj < 2; ++bj) { const int g = 16 * u.pn + 8 * bj + 2 * wc + (fq >> 1), c0 = 8 * (fq & 1);
            *(u32x4*)(AS5 + ((size_t)(g * 768 + crow) * 768 + s * 16 + c0)) = pack8(acc[ai][bj][m][0], acc[ai][bj][m][1]); } }
      return;
    }
    const bool isq = u.pn < 4;
    if (isq && u.pm == 64) return;
    const int head = 4 * ((u.pn - 2) & 1) + wc; const float* gain = isq ? qg : kg;
    bf16_t* dst = isq ? (bf16_t*)(ws + WS_Q) : (bf16_t*)(ws + WS_K);
    f32x4 gv[2][2];
#pragma unroll
    for (int bj = 0; bj < 2; ++bj) { gv[bj][0] = *(const f32x4*)(gain + 32 * bj + 8 * fq); gv[bj][1] = *(const f32x4*)(gain + 32 * bj + 8 * fq + 4); }
#pragma unroll
    for (int ai = 0; ai < 2; ++ai)
#pragma unroll
      for (int m = 0; m < 4; ++m) { const int row = u.pm * 256 + ai * 128 + wr * 64 + m * 16 + fr; float ss = 0.f;
#pragma unroll
        for (int bj = 0; bj < 2; ++bj)
#pragma unroll
          for (int n = 0; n < 2; ++n) { const f32x4 x = acc[ai][bj][m][n]; ss += (x[0] * x[0] + x[1] * x[1]) + (x[2] * x[2] + x[3] * x[3]); }
        ss += sx(ss, 16); ss += sx(ss, 32);
        const float rinv = rsqrtf(ss * (1.f / 64.f) + 1e-6f);
#pragma unroll
        for (int bj = 0; bj < 2; ++bj) { const f32x4 v0 = acc[ai][bj][m][0] * rinv * gv[bj][0], v1 = acc[ai][bj][m][1] * rinv * gv[bj][1];
          if (isq) *(u32x4*)(dst + (size_t)row * 512 + head * 64 + 32 * bj + 8 * fq) = pack8(v0, v1);
          else { const int kr = row >> 6, cg = (row >> 3) & 7, k8 = row & 7, ks = 2 * bj + (fq >> 1), hh2 = fq & 1;
            *(u32x4*)(dst + (((((size_t)(head * 260 + kr) * 8 + cg) * 4 + ks) * 8 + k8) * 2 + hh2) * 8) = pack8(v0, v1); } } }
  }
};

struct G2 {
  static constexpr bool PERM = true; static constexpr bool F8 = false; static constexpr int SCALE_B = 0x7A7A7A7A; static constexpr bool CONTIG = false; static constexpr bool ALIGN = true; static constexpr bool LINA = true, LINB = true; __device__ __forceinline__ size_t halfA() const { return 128u * 1536u; } __device__ __forceinline__ size_t halfB() const { return 128u * 1024u; } int K, nunits; unsigned char* ws;
  __device__ __forceinline__ void decode(int w, Unit& u) const { u.a = w / 3; u.pm = w % 3; u.pn = 0; u.b = 0; }
  __device__ __forceinline__ const char* baseA(const Unit& u) const { return (const char*)ws + WS_AS5 + (size_t)u.a * 768 * 768 * 2; }
  __device__ __forceinline__ const char* baseB(const Unit& u) const { return (const char*)ws + WS_WS + (size_t)u.a * 256 * 512 * 2; }
  __device__ __forceinline__ unsigned rowA(const Unit& u, int r) const { return (unsigned)(u.pm * 256 + r) * 1536u; }
  __device__ __forceinline__ unsigned rowB(const Unit& u, int r) const { return (unsigned)r * 1024u; }
  __device__ __forceinline__ void epi(const Acc& acc, const Unit& u, int wr, int wc, int fr, int fq) const {
    float* SST = (float*)(ws + WS_SST) + (size_t)u.a * 768 * 256;
#pragma unroll
    for (int ai = 0; ai < 2; ++ai)
#pragma unroll
      for (int m = 0; m < 4; ++m) { const int crow = u.pm * 256 + ai * 128 + wr * 64 + m * 16 + fr; if (crow >= 520) continue;
#pragma unroll
        for (int bj = 0; bj < 2; ++bj) { float* p = SST + (size_t)crow * 256 + bj * 128 + wc * 32 + 8 * fq; *(f32x4*)p = acc[ai][bj][m][0]; *(f32x4*)(p + 4) = acc[ai][bj][m][1]; } }
  }
};

struct G3 {
  static constexpr bool PERM = true; static constexpr bool F8 = false; static constexpr int SCALE_B = 0x7A7A7A7A; static constexpr bool CONTIG = false; static constexpr bool ALIGN = true; static constexpr bool LINA = true, LINB = true; __device__ __forceinline__ size_t halfA() const { return 128u * 1536u; } __device__ __forceinline__ size_t halfB() const { return 128u * 1536u; } int K, nunits; unsigned char* ws;
  __device__ __forceinline__ void decode(int w, Unit& u) const { u.a = w >> 2; u.pm = (w >> 1) & 1; u.pn = w & 1; u.b = 0; }
  __device__ __forceinline__ const char* baseA(const Unit& u) const { return (const char*)ws + WS_AS5 + (size_t)u.a * 768 * 768 * 2; }
  __device__ __forceinline__ const char* baseB(const Unit& u) const { return (const char*)ws + WS_TT + (size_t)u.a * 512 * 768 * 2; }
  __device__ __forceinline__ unsigned rowA(const Unit& u, int r) const { return (unsigned)(u.pm * 256 + r) * 1536u; }
  __device__ __forceinline__ unsigned rowB(const Unit& u, int r) const { return (unsigned)(u.pn * 256 + r) * 1536u; }
  __device__ __forceinline__ void epi(const Acc& acc, const Unit& u, int wr, int wc, int fr, int fq) const {
    bf16_t* GB = (bf16_t*)(ws + WS_GB);
#pragma unroll
    for (int ai = 0; ai < 2; ++ai)
#pragma unroll
      for (int m = 0; m < 4; ++m) { const int crow = u.pm * 256 + ai * 128 + wr * 64 + m * 16 + fr;
#pragma unroll
        for (int bj = 0; bj < 2; ++bj) { const int pp = u.pn * 256 + bj * 128 + wc * 32 + 8 * fq, i = pp >> 4, c0 = pp & 15; f32x4 v0 = acc[ai][bj][m][0], v1 = acc[ai][bj][m][1];
#pragma unroll
          for (int j = 0; j < 4; ++j) { v0[j] = gelu_tanh(v0[j]); v1[j] = gelu_tanh(v1[j]); }
          *(u32x4*)(GB + (size_t)(crow * 32 + i) * 512 + u.a * 16 + c0) = pack8(v0, v1); } }
  }
};

struct G4 {
  static constexpr bool PERM = true; static constexpr bool F8 = false; static constexpr int SCALE_B = 0x7A7A7A7A; static constexpr bool CONTIG = false; static constexpr bool ALIGN = true; static constexpr bool LINA = true, LINB = true; __device__ __forceinline__ size_t halfA() const { return 128u * 1024u; } __device__ __forceinline__ size_t halfB() const { return 128u * 1024u; } int K, nunits; unsigned char* ws; const float* bglu;
  __device__ __forceinline__ void decode(int w, Unit& u) const { u.pm = w >> 1; u.pn = w & 1; u.a = 0; u.b = 0; }
  __device__ __forceinline__ const char* baseA(const Unit&) const { return (const char*)ws + WS_GB; }
  __device__ __forceinline__ const char* baseB(const Unit&) const { return (const char*)ws + WS_WGLU_T; }
  __device__ __forceinline__ unsigned rowA(const Unit& u, int r) const { return (unsigned)(u.pm * 256 + r) * 1024u; }
  __device__ __forceinline__ unsigned rowB(const Unit& u, int r) const { return (unsigned)(u.pn * 256 + r) * 1024u; }
  __device__ __forceinline__ void epi(const Acc& acc, const Unit& u, int wr, int wc, int fr, int fq) const {
    const bf16_t* GB = (const bf16_t*)(ws + WS_GB); bf16_t* CC = (bf16_t*)(ws + WS_CONCAT);
#pragma unroll
    for (int bj = 0; bj < 2; ++bj) { const int col0 = u.pn * 256 + bj * 128 + wc * 32 + 8 * fq; const f32x4 b0 = *(const f32x4*)(bglu + col0), b1 = *(const f32x4*)(bglu + col0 + 4);
#pragma unroll
      for (int ai = 0; ai < 2; ++ai)
#pragma unroll
        for (int m = 0; m < 4; ++m) { const int row = u.pm * 256 + ai * 128 + wr * 64 + m * 16 + fr; const u32x4 gw = *(const u32x4*)(GB + (size_t)row * 512 + col0);
          f32x4 v0 = acc[ai][bj][m][0] + b0, v1 = acc[ai][bj][m][1] + b1;
          v0[0] = bf_lo(gw.x) * fast_sigmoid(v0[0]); v0[1] = bf_hi(gw.x) * fast_sigmoid(v0[1]); v0[2] = bf_lo(gw.y) * fast_sigmoid(v0[2]); v0[3] = bf_hi(gw.y) * fast_sigmoid(v0[3]);
          v1[0] = bf_lo(gw.z) * fast_sigmoid(v1[0]); v1[1] = bf_hi(gw.z) * fast_sigmoid(v1[1]); v1[2] = bf_lo(gw.w) * fast_sigmoid(v1[2]); v1[3] = bf_hi(gw.w) * fast_sigmoid(v1[3]);
          *(u32x4*)(CC + (size_t)row * 1024 + col0) = pack8(v0, v1); } }
  }
};

struct GRes {
  static constexpr bool PERM = false; static constexpr bool F8 = false; static constexpr int SCALE_B = 0x7A7A7A7A; static constexpr bool CONTIG = false; static constexpr bool ALIGN = true; static constexpr bool LINA = true, LINB = true; __device__ __forceinline__ size_t halfA() const { return 128u * 2048u; } __device__ __forceinline__ size_t halfB() const { return 128u * 2048u; } int K, nunits; const char* A; const char* Bt; const float* hin; float* hout; const float* gate; const float* bias;
  __device__ __forceinline__ void decode(int w, Unit& u) const { u.pm = w >> 2; u.pn = w & 3; u.a = 0; u.b = 0; }
  __device__ __forceinline__ const char* baseA(const Unit&) const { return A; }
  __device__ __forceinline__ const char* baseB(const Unit&) const { return Bt; }
  __device__ __forceinline__ unsigned rowA(const Unit& u, int r) const { return (unsigned)(u.pm * 256 + r) * 2048u; }
  __device__ __forceinline__ unsigned rowB(const Unit& u, int r) const { return (unsigned)(u.pn * 256 + r) * 2048u; }
  __device__ __forceinline__ void epi(const Acc& acc, const Unit& u, int wr, int wc, int fr, int fq) const {
#pragma unroll
    for (int bj = 0; bj < 2; ++bj)
#pragma unroll
      for (int n = 0; n < 2; ++n) { const int col0 = u.pn * 256 + bj * 128 + wc * 32 + 16 * n + 4 * fq; const f32x4 gt = *(const f32x4*)(gate + col0);
        f32x4 bs = (f32x4){0.f, 0.f, 0.f, 0.f}; if (bias) bs = *(const f32x4*)(bias + col0);
#pragma unroll
        for (int ai = 0; ai < 2; ++ai)
#pragma unroll
          for (int m = 0; m < 4; ++m) { const size_t off = (size_t)(u.pm * 256 + ai * 128 + wr * 64 + m * 16 + fr) * 1024 + col0;
            const f32x4 hv = *(const f32x4*)(hin + off); *(f32x4*)(hout + off) = hv + gt * (acc[ai][bj][m][n] + bs); } }
  }
};

__device__ __forceinline__ void build_moetab(const Ctx& X, int layer, LAS int* toff) {
  const unsigned* cnt = (const unsigned*)(X.ws + WS_CTL) + CW_CNT + layer * 128;
  LAS int* texp = toff + 256;
  LAS int* ntile = toff + 132;
  __syncthreads();
  if (X.tid < 64) ntile[X.tid] = ((int)__hip_atomic_load(cnt + X.tid, __ATOMIC_RELAXED, __HIP_MEMORY_SCOPE_AGENT) + 255) >> 8;
  __syncthreads();
  if (X.tid == 0) { int s = 0; for (int e = 0; e < 64; ++e) { toff[e] = s; s += ntile[e]; } toff[64] = s; toff[65] = s + 64; }
  __syncthreads();
  if (X.tid < 65) { const int e = X.tid; const int lo = toff[e], hi = toff[e + 1]; for (int t = lo; t < hi && t < 704; ++t) texp[t] = e; }
  __syncthreads();
}
__device__ __forceinline__ int find_expert(const LAS int* toff, int ti) { return toff[256 + ti]; }

struct G6 {
  static constexpr bool PERM = true; static constexpr bool F8 = true; static constexpr int SCALE_B = 0x7A7A7A7A; static constexpr bool CONTIG = false; static constexpr bool ALIGN = true; static constexpr bool LINA = false, LINB = true;
  __device__ __forceinline__ size_t halfA() const { return 0; } __device__ __forceinline__ size_t halfB() const { return 128u * 1024u; }
  int K, nunits; unsigned char* ws; const LAS int* toff; const LAS unsigned* tokt; const char* wbase; size_t wstride; int dry;
  __device__ __forceinline__ void decode(int w, Unit& u) const { const int ti = w >> 1; u.pn = w & 1; u.a = find_expert(toff, ti); u.pm = ti - toff[u.a]; u.b = ti; }
  __device__ __forceinline__ const char* baseA(const Unit&) const { return (const char*)ws + WS_F; }
  __device__ __forceinline__ const char* baseB(const Unit& u) const { return wbase + (size_t)u.a * wstride; }
  __device__ __forceinline__ unsigned rowA(const Unit& u, int r) const { return tokt[u.ord * 256 + r]; }
  __device__ __forceinline__ void build_tokt(const Ctx& X, LAS unsigned* tk) const {
    for (int i = 0; i * X.G + X.c < nunits; ++i) { Unit u; decode(xcd_remap(i * X.G + X.c, nunits), u);
      if (X.tid < 256) { const int idx = u.pm * 256 + X.tid; int tok = idx;
        if (u.a < 64) tok = ((const int*)(ws + WS_LTOK))[u.a * 16384 + idx];
        if (dry == 2) tok = (u.b * 256 + X.tid) & 16383;
        tk[i * 256 + X.tid] = (unsigned)tok * 1024u; } }
    __syncthreads();
  }
  __device__ __forceinline__ unsigned rowB(const Unit& u, int r) const { return (unsigned)(u.pn * 256 + r) * 1024u; }
  __device__ __forceinline__ void epi(const Acc& acc, const Unit& u, int wr, int wc, int fr, int fq) const {
    bf16_t* HID = (bf16_t*)(ws + WS_HID);
#pragma unroll
    for (int ai = 0; ai < 2; ++ai)
#pragma unroll
      for (int m = 0; m < 4; ++m) { const size_t hrow = (size_t)u.b * 256 + ai * 128 + wr * 64 + m * 16 + fr; f32x4 v0, v1;
#pragma unroll
        for (int j = 0; j < 4; ++j) { const float g0 = acc[ai][0][m][0][j], g1 = acc[ai][0][m][1][j]; if (dry == 3) { v0[j] = g0 + acc[ai][1][m][0][j]; v1[j] = g1 + acc[ai][1][m][1][j]; } else { v0[j] = g0 * fast_sigmoid(g0) * acc[ai][1][m][0][j]; v1[j] = g1 * fast_sigmoid(g1) * acc[ai][1][m][1][j]; } }
        const u32x4 pk = pack8(v0, v1); if (!dry || pk.x == 0x12345678u) *(u32x4*)(HID + hrow * 256 + u.pn * 128 + wc * 32 + 8 * fq) = pk; }
  }
};
struct G7 {
  static constexpr bool PERM = true; static constexpr bool F8 = false; static constexpr int SCALE_B = 0x7A7A7A7A; static constexpr bool CONTIG = false; static constexpr bool ALIGN = true; static constexpr bool LINA = true, LINB = true;
  __device__ __forceinline__ size_t halfA() const { return 128u * 512u; } __device__ __forceinline__ size_t halfB() const { return 128u * 512u; }
  int K, nunits; unsigned char* ws; const LAS int* toff; int dry; const char* wbase; size_t wstride;
  __device__ __forceinline__ void decode(int w, Unit& u) const { const int ti = w >> 2; u.pn = w & 3; u.a = find_expert(toff, ti); u.pm = ti - toff[u.a]; u.b = ti; }
  __device__ __forceinline__ const char* baseA(const Unit&) const { return (const char*)ws + WS_HID; }
  __device__ __forceinline__ const char* baseB(const Unit& u) const { return wbase + (size_t)(dry == 2 ? 0 : u.a) * wstride; }
  __device__ __forceinline__ unsigned rowA(const Unit& u, int r) const { return (unsigned)((dry == 2 ? 0 : u.b) * 256 + r) * 512u; }
  __device__ __forceinline__ unsigned rowB(const Unit& u, int r) const { return (unsigned)((dry == 2 ? 0 : u.pn) * 256 + r) * 512u; }
  __device__ __forceinline__ void epi(const Acc& acc, const Unit& u, int wr, int wc, int fr, int fq) const {
    unsigned char* YAS = ws + WS_YAS;
#pragma unroll
    for (int ai = 0; ai < 2; ++ai)
#pragma unroll
      for (int m = 0; m < 4; ++m) { const size_t yrow = (size_t)u.b * 256 + ai * 128 + wr * 64 + m * 16 + fr;
#pragma unroll
        for (int bj = 0; bj < 2; ++bj) { const f32x4 v0 = acc[ai][bj][m][0], v1 = acc[ai][bj][m][1]; int w0 = 0, w1 = 0;
          w0 = __builtin_amdgcn_cvt_pk_fp8_f32(v0[0], v0[1], w0, false); w0 = __builtin_amdgcn_cvt_pk_fp8_f32(v0[2], v0[3], w0, true);
          w1 = __builtin_amdgcn_cvt_pk_fp8_f32(v1[0], v1[1], w1, false); w1 = __builtin_amdgcn_cvt_pk_fp8_f32(v1[2], v1[3], w1, true);
          if (!dry || w0 == 0x12345678) *(u32x2*)(YAS + yrow * 1024 + u.pn * 256 + bj * 128 + wc * 32 + 8 * fq) = (u32x2){(unsigned)w0, (unsigned)w1}; } }
  }
};

struct G8 {
  static constexpr bool PERM = true; static constexpr bool F8 = false; static constexpr int SCALE_B = 0x7A7A7A7A; static constexpr bool CONTIG = false; static constexpr bool ALIGN = true; static constexpr bool LINA = true, LINB = false; __device__ __forceinline__ size_t halfA() const { return 128u * 512u; } __device__ __forceinline__ size_t halfB() const { return 0; } int K, nunits; unsigned char* ws;
  __device__ __forceinline__ void decode(int w, Unit& u) const { u.pm = w >> 8; u.a = (w >> 6) & 3; u.pn = w & 63; u.b = 0; }
  __device__ __forceinline__ const char* baseA(const Unit&) const { return (const char*)ws + WS_DMT; }
  __device__ __forceinline__ const char* baseB(const Unit& u) const { return (const char*)ws + WS_A1 + (size_t)u.a * 512; }
  __device__ __forceinline__ unsigned rowA(const Unit& u, int r) const { return (unsigned)(u.pm * 256 + r) * 512u; }
  __device__ __forceinline__ unsigned rowB(const Unit& u, int r) const { const int n = u.pn * 256 + r; return (unsigned)(128 * (n & 127) + (n >> 7)) * 2048u; }
  __device__ __forceinline__ void epi(const Acc& acc, const Unit& u, int wr, int wc, int fr, int fq) const {
    bf16_t* X1 = (bf16_t*)(ws + WS_X1);
#pragma unroll
    for (int ai = 0; ai < 2; ++ai)
#pragma unroll
      for (int m = 0; m < 4; ++m) { const int mm = ai * 128 + wr * 64 + m * 16 + fr;
#pragma unroll
        for (int bj = 0; bj < 2; ++bj) { const int n0 = u.pn * 256 + bj * 128 + wc * 32 + 8 * fq, tb = n0 >> 7, ta0 = n0 & 127;
          *(u32x4*)(X1 + ((((size_t)(u.a * 256 + mm) * 128 + tb) * 2 + u.pm) * 128 + ta0)) = pack8(acc[ai][bj][m][0], acc[ai][bj][m][1]); } }
  }
};
struct G9 {
  static constexpr bool PERM = true; static constexpr bool F8 = false; static constexpr int SCALE_B = 0x7A7A7A7A; static constexpr bool CONTIG = false; static constexpr bool ALIGN = true; static constexpr bool LINA = true, LINB = true; __device__ __forceinline__ size_t halfA() const { return 128u * 512u; } __device__ __forceinline__ size_t halfB() const { return 128u * 512u; } int K, nunits; unsigned char* ws;
  __device__ __forceinline__ void decode(int w, Unit& u) const { u.pm = 0; u.pn = w; u.a = 0; u.b = 0; }
  __device__ __forceinline__ const char* baseA(const Unit&) const { return (const char*)ws + WS_W1; }
  __device__ __forceinline__ const char* baseB(const Unit&) const { return (const char*)ws + WS_X1; }
  __device__ __forceinline__ unsigned rowA(const Unit&, int r) const { return (unsigned)r * 512u; }
  __device__ __forceinline__ unsigned rowB(const Unit& u, int r) const { return (unsigned)(u.pn * 256 + r) * 512u; }
  __device__ __forceinline__ void epi(const Acc& acc, const Unit& u, int wr, int wc, int fr, int fq) const {
    bf16_t* X2 = (bf16_t*)(ws + WS_X2);
#pragma unroll
    for (int m = 0; m < 4; ++m) { const int ka = wr * 64 + m * 16 + fr;
#pragma unroll
      for (int bj = 0; bj < 2; ++bj) { const int n0 = u.pn * 256 + bj * 128 + wc * 32 + 8 * fq, gm = n0 >> 7, tb0 = n0 & 127; f32x4 r0, r1, i0, i1;
#pragma unroll
        for (int j = 0; j < 4; ++j) {
          { const float ang = (float)((ka * (tb0 + j)) & 16383) * (1.f / 16384.f), cs = __builtin_amdgcn_cosf(ang), sn = __builtin_amdgcn_sinf(ang); const float yr = acc[0][bj][m][0][j], yi = acc[1][bj][m][0][j]; r0[j] = yr * cs + yi * sn; i0[j] = yi * cs - yr * sn; }
          { const float ang = (float)((ka * (tb0 + 4 + j)) & 16383) * (1.f / 16384.f), cs = __builtin_amdgcn_cosf(ang), sn = __builtin_amdgcn_sinf(ang); const float yr = acc[0][bj][m][1][j], yi = acc[1][bj][m][1][j]; r1[j] = yr * cs + yi * sn; i1[j] = yi * cs - yr * sn; } }
        bf16_t* p = X2 + (((size_t)(gm * 128 + ka) * 2) * 128 + tb0); *(u32x4*)p = pack8(r0, r1); *(u32x4*)(p + 128) = pack8(i0, i1); } }
  }
};
struct G10 {
  static constexpr bool PERM = true; static constexpr bool F8 = false; static constexpr int SCALE_B = 0x7A7A7A7A; static constexpr bool CONTIG = false; static constexpr bool ALIGN = true; static constexpr bool LINA = true, LINB = false; __device__ __forceinline__ size_t halfA() const { return 128u * 512u; } __device__ __forceinline__ size_t halfB() const { return 0; } int K, nunits; unsigned char* ws;
  __device__ __forceinline__ void decode(int w, Unit& u) const { u.pm = 0; u.pn = w; u.a = 0; u.b = 0; }
  __device__ __forceinline__ const char* baseA(const Unit&) const { return (const char*)ws + WS_W2; }
  __device__ __forceinline__ const char* baseB(const Unit&) const { return (const char*)ws + WS_X2; }
  __device__ __forceinline__ unsigned rowA(const Unit&, int r) const { return (unsigned)r * 512u; }
  __device__ __forceinline__ unsigned rowB(const Unit& u, int r) const { const int n = u.pn * 256 + r, ka = n >> 10, gm = n & 1023; return (unsigned)(gm * 128 + ka) * 512u; }
  __device__ __forceinline__ void epi(const Acc& acc, const Unit& u, int wr, int wc, int fr, int fq) const {
    bf16_t* FB = (bf16_t*)(ws + WS_FB); const int ka = u.pn >> 2;
#pragma unroll
    for (int m = 0; m < 4; ++m) { const int kb = wr * 64 + m * 16 + fr; const size_t k = (size_t)ka + 128 * kb;
#pragma unroll
      for (int bj = 0; bj < 2; ++bj) { const int d0 = (u.pn & 3) * 256 + bj * 128 + wc * 32 + 8 * fq; *(u32x4*)(FB + k * 1024 + d0) = pack8(acc[0][bj][m][0], acc[0][bj][m][1]); } }
  }
};
}
namespace mk {
typedef float f32x16 __attribute__((ext_vector_type(16)));

__device__ __forceinline__ void phase_scan(const Ctx& X) {
  if (X.c >= 64) return;
  const int ch = X.c * 64 + (X.tid & 63), seg = X.tid >> 6;
  const int g = ch >> 7, dir = (ch >> 6) & 1, p = ch & 63;
  const float2 lam = ((const float2*)(X.ws + WS_LAML))[(dir * 32 + g) * 64 + p];
  const float* S = (const float*)(X.ws + WS_SST) + (size_t)g * 768 * 256 + dir * 128 + p;
  bf16_t* XP = (bf16_t*)(X.ws + WS_AS5) + (size_t)g * 768 * 768 + 512 + dir * 128 + p;
  LAS float* EX = (LAS float*)X.lds;
  const int j0 = seg * 65;
  float xr = 0.f, xi = 0.f;
  for (int b = 0; b < 65; b += 13) {
    float sr[13], si[13];
#pragma unroll
    for (int k = 0; k < 13; ++k) { const int j = j0 + b + k; const int row = dir == 0 ? (j < 8 ? 512 + j : j - 8) : 519 - j; sr[k] = S[(size_t)row * 256]; si[k] = S[(size_t)row * 256 + 64]; }
#pragma unroll
    for (int k = 0; k < 13; ++k) { const float nr = lam.x * xr - lam.y * xi + sr[k], ni = lam.x * xi + lam.y * xr + si[k]; xr = nr; xi = ni; }
  }
  EX[(seg * 64 + (X.tid & 63)) * 2] = xr; EX[(seg * 64 + (X.tid & 63)) * 2 + 1] = xi;
  float pr = 1.f, pi = 0.f;
  for (int k = 0; k < 65; ++k) { const float nr = pr * lam.x - pi * lam.y, ni = pr * lam.y + pi * lam.x; pr = nr; pi = ni; }
  __syncthreads();
  float cr = 0.f, ci = 0.f;
  for (int s2 = 0; s2 < seg; ++s2) { const float er = EX[(s2 * 64 + (X.tid & 63)) * 2], ei = EX[(s2 * 64 + (X.tid & 63)) * 2 + 1];
    const float nr = pr * cr - pi * ci + er, ni = pr * ci + pi * cr + ei; cr = nr; ci = ni; }
  xr = cr; xi = ci;
  for (int b = 0; b < 65; b += 13) {
    float sr[13], si[13];
#pragma unroll
    for (int k = 0; k < 13; ++k) { const int j = j0 + b + k; const int row = dir == 0 ? (j < 8 ? 512 + j : j - 8) : 519 - j; sr[k] = S[(size_t)row * 256]; si[k] = S[(size_t)row * 256 + 64]; }
#pragma unroll
    for (int k = 0; k < 13; ++k) { const int j = j0 + b + k; const int row = dir == 0 ? (j < 8 ? 512 + j : j - 8) : 519 - j;
      XP[(size_t)row * 768] = f2bf(xr); XP[(size_t)row * 768 + 64] = f2bf(xi);
      const float nr = lam.x * xr - lam.y * xi + sr[k], ni = lam.x * xi + lam.y * xr + si[k]; xr = nr; xi = ni; }
  }
  __syncthreads();
}

__device__ __forceinline__ void zero_lists(const Ctx& X) {
  u32x4* z = (u32x4*)(X.ws + WS_LTOK); unsigned zu_ = 0u; asm volatile("" : "+v"(zu_)); const u32x4 zero = (u32x4){zu_, zu_, zu_, zu_};
  for (int i = X.c * NTHR + X.tid; i < (int)(4 * MiB / 16); i += X.G * NTHR) z[i] = zero;
}
#define MFMA32(a, b, c) __builtin_amdgcn_mfma_f32_32x32x16_bf16((a), (b), (c), 0, 0, 0)
__device__ __forceinline__ void attn_unit(const Ctx& X, const LAS float* rpbl, int head, int tile) {
  const bf16_t* Q = (const bf16_t*)(X.ws + WS_Q); const bf16_t* Kb = (const bf16_t*)(X.ws + WS_K); const bf16_t* VT = (const bf16_t*)(X.ws + WS_VT);
  bf16_t* CCt = (bf16_t*)(X.ws + WS_CONCAT);
  const int lane = X.lane, ql = lane & 31, hh = lane >> 5;
  const int rp = tile >> 2, mt = tile & 3;
  const int r = 2 * rp + (ql >> 4), cq = 16 * mt + (ql & 15), tq = r * 64 + cq;
  const int r0q = min(max(r - 4, 0), 248), csq = min(max(cq - 8, 0), 48);
  const int rlo = min(max(2 * rp - 4, 0), 248), rhi = min(max(2 * rp - 3, 0), 248) + 7;
  const int csb = min(max(16 * mt - 8, 0), 32);
  const int nloc = rhi - rlo + 1;
  unsigned cmask = 0u;
#pragma unroll
  for (int k = 0; k < 32; ++k) cmask |= ((csb + k >= csq) && (csb + k <= csq + 15)) ? (1u << k) : 0u;
  bf16x8 qf[4];
#pragma unroll
  for (int ks = 0; ks < 4; ++ks) qf[ks] = *(const bf16x8*)(Q + (size_t)tq * 512 + head * 64 + 16 * ks + 8 * hh);
  const int kperm = (ql & ~12) | ((ql & 4) << 1) | ((ql & 8) >> 1);
  f32x16 o0, o1;
#pragma unroll
  for (int i = 0; i < 16; ++i) { o0[i] = 0.f; o1[i] = 0.f; }
  float lsum = 0.f;
  const float c1 = 0.125f * 1.44269504f, c2 = 8.f * 1.44269504f;
  const float* rp_h = nullptr; (void)rp_h;
  const size_t koff_lane = (size_t)(((kperm >> 3) * 4 * 8 + (kperm & 7)) * 2 + hh) * 8;
  const size_t voff_lane = (size_t)(hh * 64 + ql) * 8;
  bf16x8 kf[4], vf[2][2];
  { const int kr0 = rlo, cg0 = csb >> 3;
    const bf16_t* kp = Kb + ((size_t)(head * 260 + kr0) * 8 + cg0) * 512 + koff_lane; const bf16_t* vp = VT + ((size_t)(head * 260 + kr0) * 8 + cg0) * 512 + voff_lane;
#pragma unroll
    for (int ks = 0; ks < 4; ++ks) kf[ks] = *(const bf16x8*)(kp + ks * 128);
#pragma unroll
    for (int db = 0; db < 2; ++db)
#pragma unroll
      for (int s2 = 0; s2 < 2; ++s2) vf[db][s2] = *(const bf16x8*)(vp + db * 256 + s2 * 1024); }
  for (int b = 0; b < nloc + 8; ++b) {
    const bool loc = b < nloc;
    const int kr = rlo + b;
    bf16x8 kc[4], vc[2][2];
#pragma unroll
    for (int ks = 0; ks < 4; ++ks) kc[ks] = kf[ks];
#pragma unroll
    for (int db = 0; db < 2; ++db)
#pragma unroll
      for (int s2 = 0; s2 < 2; ++s2) vc[db][s2] = vf[db][s2];
    if (b + 1 < nloc + 8) { const int bn = b + 1; const int krn = bn < nloc ? rlo + bn : 256 + ((bn - nloc) >> 1), cgn = bn < nloc ? (csb >> 3) : 4 * ((bn - nloc) & 1);
      const bf16_t* kp = Kb + ((size_t)(head * 260 + krn) * 8 + cgn) * 512 + koff_lane; const bf16_t* vp = VT + ((size_t)(head * 260 + krn) * 8 + cgn) * 512 + voff_lane;
#pragma unroll
      for (int ks = 0; ks < 4; ++ks) kf[ks] = *(const bf16x8*)(kp + ks * 128);
#pragma unroll
      for (int db = 0; db < 2; ++db)
#pragma unroll
        for (int s2 = 0; s2 < 2; ++s2) vf[db][s2] = *(const bf16x8*)(vp + db * 256 + s2 * 1024); }
    f32x16 sacc;
#pragma unroll
    for (int i = 0; i < 16; ++i) sacc[i] = 0.f;
#pragma unroll
    for (int ks = 0; ks < 4; ++ks) sacc = MFMA32(kc[ks], qf[ks], sacc);
    float pv[16];
    if (loc) {
      const bool rowok = (kr >= r0q) && (kr <= r0q + 7);
      const int dr = min(max(kr - r + 7, 0), 14);
      const LAS float* bp = rpbl + (head * 15 + dr) * 31;
      const int dc0 = csb - cq + 15;
#pragma unroll
      for (int i = 0; i < 16; ++i) { const int kidx = 16 * (i >> 3) + 8 * hh + (i & 7);
        const bool ok = rowok && ((cmask >> kidx) & 1u);
        const float bias = bp[min(max(dc0 + kidx, 0), 30)];
        const float e = __builtin_amdgcn_exp2f(sacc[i] * c1 + bias * 1.44269504f - c2); pv[i] = ok ? e : 0.f; }
    } else {
#pragma unroll
      for (int i = 0; i < 16; ++i) pv[i] = __builtin_amdgcn_exp2f(sacc[i] * c1 - c2);
    }
    u32x4 p0, p1;
    p0.x = cvt_pk_bf16(pv[0], pv[1]); p0.y = cvt_pk_bf16(pv[2], pv[3]); p0.z = cvt_pk_bf16(pv[4], pv[5]); p0.w = cvt_pk_bf16(pv[6], pv[7]);
    p1.x = cvt_pk_bf16(pv[8], pv[9]); p1.y = cvt_pk_bf16(pv[10], pv[11]); p1.z = cvt_pk_bf16(pv[12], pv[13]); p1.w = cvt_pk_bf16(pv[14], pv[15]);
    lsum += (bf_lo(p0.x) + bf_hi(p0.x)) + (bf_lo(p0.y) + bf_hi(p0.y)) + (bf_lo(p0.z) + bf_hi(p0.z)) + (bf_lo(p0.w) + bf_hi(p0.w))
          + (bf_lo(p1.x) + bf_hi(p1.x)) + (bf_lo(p1.y) + bf_hi(p1.y)) + (bf_lo(p1.z) + bf_hi(p1.z)) + (bf_lo(p1.w) + bf_hi(p1.w));
    const bf16x8 pb0 = __builtin_bit_cast(bf16x8, p0), pb1 = __builtin_bit_cast(bf16x8, p1);
    o0 = MFMA32(vc[0][0], pb0, o0); o0 = MFMA32(vc[0][1], pb1, o0);
    o1 = MFMA32(vc[1][0], pb0, o1); o1 = MFMA32(vc[1][1], pb1, o1);
  }
  lsum += sx(lsum, 32);
  const float inv = 1.f / lsum;
  bf16_t* op = CCt + (size_t)tq * 1024 + 512 + head * 64 + 4 * hh;
#pragma unroll
  for (int gq = 0; gq < 4; ++gq) {
    u32x2 w0, w1;
    w0.x = cvt_pk_bf16(o0[4 * gq] * inv, o0[4 * gq + 1] * inv); w0.y = cvt_pk_bf16(o0[4 * gq + 2] * inv, o0[4 * gq + 3] * inv);
    w1.x = cvt_pk_bf16(o1[4 * gq] * inv, o1[4 * gq + 1] * inv); w1.y = cvt_pk_bf16(o1[4 * gq + 2] * inv, o1[4 * gq + 3] * inv);
    *(u32x2*)(op + 8 * gq) = w0; *(u32x2*)(op + 32 + 8 * gq) = w1;
  }
}
__device__ __forceinline__ void phase_attn(const Ctx& X) {
  LAS float* rpbl = (LAS float*)X.lds;
  zero_lists(X);
  for (int i = X.tid; i < 8 * 15 * 31; i += NTHR) rpbl[i] = X.a->in[IN_RPB][i];
  __syncthreads();
  const int gw = X.c * NWAVES + X.wave, NGW = X.G * NWAVES;
  for (int U = gw; U < 4096; U += NGW) attn_unit(X, rpbl, U >> 9, U & 511);
}

__device__ __forceinline__ void phase_router(const Ctx& X, int layer, int dry) {
  const float* mod = (const float*)(X.ws + WS_MOD) + (layer == 0 ? 0 : 2 * 6144);
  const float* shift = mod + 3072; const float* scale = mod + 4096;
  const float* h = X.a->h; bf16_t* F = (bf16_t*)(X.ws + WS_F);
  unsigned* cntg = (unsigned*)(X.ws + WS_CTL) + CW_CNT + layer * 128;
  int* ltok = (int*)(X.ws + WS_LTOK); int* asg = (int*)(X.ws + WS_ASG);
  const bf16_t* WR = (const bf16_t*)(X.ws + WS_WROUT_T) + (size_t)layer * 64 * 1024;
  const float* rbias = X.a->in[IN_RBIAS] + layer * 64;
  constexpr int FROW = 2064;
  const int lane = X.lane, wave = X.wave, tid = X.tid;
  for (int tile = X.c; tile < TOK / 64; tile += X.G) {
    const int t0 = tile * 64;
    for (int rb4 = 0; rb4 < 2; ++rb4) {
      f32x4 v[4][4];
#pragma unroll
      for (int rr = 0; rr < 4; ++rr) { const f32x4* xr = (const f32x4*)(h + (size_t)(t0 + wave * 8 + rb4 * 4 + rr) * 1024) + lane;
#pragma unroll
        for (int j = 0; j < 4; ++j) v[rr][j] = xr[64 * j]; }
#pragma unroll
      for (int rr = 0; rr < 4; ++rr) {
        const int lr = wave * 8 + rb4 * 4 + rr, t = t0 + lr; float ss = 0.f;
#pragma unroll
        for (int j = 0; j < 4; ++j) ss += (v[rr][j].x * v[rr][j].x + v[rr][j].y * v[rr][j].y) + (v[rr][j].z * v[rr][j].z + v[rr][j].w * v[rr][j].w);
        const float r = rsqrtf(wave_sum(ss) * (1.f / 1024.f) + 1e-6f);
#pragma unroll
        for (int j = 0; j < 4; ++j) { const f32x4 f = v[rr][j] * r * (((const f32x4*)scale)[lane + 64 * j] + 1.f) + ((const f32x4*)shift)[lane + 64 * j];
          u32x2 w; w.x = cvt_pk_bf16(f.x, f.y); w.y = cvt_pk_bf16(f.z, f.w);
          if (!dry) { int w8 = 0; w8 = __builtin_amdgcn_cvt_pk_fp8_f32(f.x, f.y, w8, false); w8 = __builtin_amdgcn_cvt_pk_fp8_f32(f.z, f.w, w8, true);
            ((int*)((unsigned char*)F + (size_t)t * 1024))[lane + 64 * j] = w8; }
          *(LAS u32x2*)(X.lds + lr * FROW + (lane + 64 * j) * 8) = w; }
      }
    }
    __syncthreads();
    if (dry == 2) continue;
    f32x4 pl[4][4];
    { const int fr = lane & 15, fq = lane >> 4;
#pragma unroll
      for (int a = 0; a < 4; ++a)
#pragma unroll
        for (int b = 0; b < 4; ++b) pl[a][b] = (f32x4){0.f, 0.f, 0.f, 0.f};
      bf16x8 bq[4][4];
#pragma unroll
      for (int ks = 0; ks < 4; ++ks)
#pragma unroll
        for (int eb = 0; eb < 4; ++eb) bq[ks][eb] = *(const bf16x8*)(WR + (size_t)(eb * 16 + fr) * 1024 + wave * 128 + ks * 32 + fq * 8);
#pragma unroll
      for (int ks = 0; ks < 4; ++ks) {
        bf16x8 af[4];
#pragma unroll
        for (int rb = 0; rb < 4; ++rb) af[rb] = *(const LAS bf16x8*)(X.lds + (rb * 16 + fr) * FROW + (wave * 128 + ks * 32 + fq * 8) * 2);
#pragma unroll
        for (int rb = 0; rb < 4; ++rb)
#pragma unroll
          for (int eb = 0; eb < 4; ++eb) pl[rb][eb] = __builtin_amdgcn_mfma_f32_16x16x32_bf16(af[rb], bq[ks][eb], pl[rb][eb], 0, 0, 0);
      }
    }
    __syncthreads();
    { LAS float* PART = (LAS float*)X.lds;
      const int fr = lane & 15, fq = lane >> 4;
#pragma unroll
      for (int rb = 0; rb < 4; ++rb)
#pragma unroll
        for (int eb = 0; eb < 4; ++eb)
#pragma unroll
          for (int j = 0; j < 4; ++j) PART[(wave * 64 + rb * 16 + 4 * fq + j) * 64 + eb * 16 + fr] = pl[rb][eb][j];
      __syncthreads();
      float sum[8];
#pragma unroll
      for (int i = 0; i < 8; ++i) { float a = 0.f;
#pragma unroll
        for (int w = 0; w < 8; ++w) a += PART[w * 4096 + i * 512 + tid];
        sum[i] = a; }
      __syncthreads();
      LAS float* LG0 = (LAS float*)X.lds;
#pragma unroll
      for (int i = 0; i < 8; ++i) { const int o = i * 512 + tid; LG0[(o >> 6) * 65 + (o & 63)] = sum[i]; }
    }
    LAS float* LG = (LAS float*)X.lds;
    LAS float* GS = LG + 64 * 65;
    LAS float* SELV = GS + 512;
    LAS int* OUTE = (LAS int*)(SELV + 4096);
    LAS float* OUTS = (LAS float*)(OUTE + 512);
    LAS int* HIST = (LAS int*)(OUTS + 512);
    LAS int* BASE = HIST + 64;
    if (tid < 64) HIST[tid] = 0;
    __syncthreads();
    if (dry == 3) continue;
    const int tl = tid >> 3, grp = tid & 7;
    float v[8], sc[8];
    { float m1 = -INFINITY, m2 = -INFINITY;
#pragma unroll
      for (int j = 0; j < 8; ++j) { const float s = 1.f / (1.f + __expf(-LG[tl * 65 + grp * 8 + j])); sc[j] = s; v[j] = s + rbias[grp * 8 + j];
        if (v[j] > m1) { m2 = m1; m1 = v[j]; } else if (v[j] > m2) m2 = v[j]; }
      GS[tl * 8 + grp] = m1 + m2; }
    __syncthreads();
    bool keep;
    { const float mine = GS[tl * 8 + grp]; int rank = 0;
#pragma unroll
      for (int g2 = 0; g2 < 8; ++g2) { const float o = GS[tl * 8 + g2]; rank += (o > mine || (o == mine && g2 < grp)) ? 1 : 0; }
      keep = rank < 4;
#pragma unroll
      for (int j = 0; j < 8; ++j) SELV[tl * 64 + grp * 8 + j] = keep ? v[j] : -INFINITY; }
    __syncthreads();
    if (keep) {
      int rk[8];
#pragma unroll
      for (int j = 0; j < 8; ++j) rk[j] = 0;
      for (int e2 = 0; e2 < 64; ++e2) { const float o = SELV[tl * 64 + e2];
#pragma unroll
        for (int j = 0; j < 8; ++j) rk[j] += (o > v[j] || (o == v[j] && e2 < grp * 8 + j)) ? 1 : 0; }
#pragma unroll
      for (int j = 0; j < 8; ++j) if (rk[j] < 8) { OUTE[tl * 8 + rk[j]] = grp * 8 + j; OUTS[tl * 8 + rk[j]] = sc[j]; }
    }
    __syncthreads();
    { const int jj = tid & 7, e = OUTE[tl * 8 + jj]; const float s = OUTS[tl * 8 + jj];
      float sum = s; sum += sx(sum, 1); sum += sx(sum, 2); sum += sx(sum, 4);
      const float w = 2.5f * s / sum;
      const int sl = atomicAdd((int*)&HIST[e], 1);
      __syncthreads();
      const int t = t0 + tl;
      if (tid < 64) { const int n = HIST[tid]; BASE[tid] = (n && !dry) ? (int)atomicAdd(cntg + tid, (unsigned)n) : 0; }
      __syncthreads();
      const int slot = BASE[e] + sl;
      if (!dry) { ltok[(size_t)e * 16384 + slot] = t; } if (!dry) ((int2*)asg)[t * 8 + jj] = make_int2((e << 16) | slot, __float_as_int(w)); }
    __syncthreads();
  }
}

__device__ __forceinline__ void phase_combine(const Ctx& X, int layer, const LAS int* toff, int dry) {
  const float* mod = (const float*)(X.ws + WS_MOD) + (layer == 0 ? 0 : 2 * 6144);
  const float* gffn = mod + 5120;
  const float* nmod = (const float*)(X.ws + WS_MOD) + 2 * 6144;
  float* h = X.a->h; const unsigned char* YAS = X.ws + WS_YAS; const int* asg = (const int*)(X.ws + WS_ASG); bf16_t* A1 = (bf16_t*)(X.ws + WS_A1);
  const int gw = X.c * NWAVES + X.wave, NGW = X.G * NWAVES, lane = X.lane;
  for (int t0 = gw; t0 < TOK; t0 += 2 * NGW) {
    int yw[2][9][4]; f32x4 hv[2][4]; float wgt[2][8];
#pragma unroll
    for (int u = 0; u < 2; ++u) { const int t = t0 + u * NGW;
      int pos[9];
#pragma unroll
      for (int k = 0; k < 8; ++k) { const int2 a = ((const int2*)asg)[t * 8 + k]; pos[k] = toff[a.x >> 16] * 256 + (a.x & 0xffff); wgt[u][k] = __int_as_float(a.y); }
      pos[8] = toff[64] * 256 + t;
#pragma unroll
      for (int k = 0; k < 9; ++k) { const int* yr = (const int*)(YAS + (size_t)pos[k] * 1024) + lane;
#pragma unroll
        for (int j = 0; j < 4; ++j) yw[u][k][j] = yr[64 * j]; }
      const f32x4* hr = (const f32x4*)(h + (size_t)t * 1024) + lane;
#pragma unroll
      for (int j = 0; j < 4; ++j) hv[u][j] = hr[64 * j]; }
#pragma unroll
    for (int u = 0; u < 2; ++u) { const int t = t0 + u * NGW;
      f32x4 acc[4];
#pragma unroll
      for (int j = 0; j < 4; ++j) acc[j] = (f32x4){0.f, 0.f, 0.f, 0.f};
#pragma unroll
      for (int k = 0; k < 9; ++k) { const float wk = k < 8 ? wgt[u][k] : 1.f;
#pragma unroll
        for (int j = 0; j < 4; ++j) { const int w = yw[u][k][j];
          acc[j].x += wk * __builtin_amdgcn_cvt_f32_fp8(w, 0); acc[j].y += wk * __builtin_amdgcn_cvt_f32_fp8(w, 1); acc[j].z += wk * __builtin_amdgcn_cvt_f32_fp8(w, 2); acc[j].w += wk * __builtin_amdgcn_cvt_f32_fp8(w, 3); } }
      f32x4* hr = (f32x4*)(h + (size_t)t * 1024) + lane; f32x4 v[4]; float ss = 0.f;
#pragma unroll
      for (int j = 0; j < 4; ++j) { const f32x4 gt = ((const f32x4*)gffn)[lane + 64 * j]; v[j] = hv[u][j] + gt * acc[j]; if (!dry) hr[64 * j] = v[j];
        ss += (v[j].x * v[j].x + v[j].y * v[j].y) + (v[j].z * v[j].z + v[j].w * v[j].w); }
      if (layer == 0) {
        const float r = rsqrtf(wave_sum(ss) * (1.f / 1024.f) + 1e-6f);
#pragma unroll
        for (int j = 0; j < 4; ++j) { const f32x4 sh = ((const f32x4*)nmod)[lane + 64 * j], sc = ((const f32x4*)(nmod + 1024))[lane + 64 * j];
          u32x2 w; w.x = cvt_pk_bf16(v[j].x * r * (1.f + sc.x) + sh.x, v[j].y * r * (1.f + sc.y) + sh.y); w.y = cvt_pk_bf16(v[j].z * r * (1.f + sc.z) + sh.z, v[j].w * r * (1.f + sc.w) + sh.w);
          if (!dry) ((u32x2*)(A1 + (size_t)t * 1024))[lane + 64 * j] = w; }
      }
    }
  }
}

constexpr int NPHASE = 21;
template <bool SP2>
__global__ void __launch_bounds__(NTHR, 2) mk_fwd(Args args) {
  extern __shared__ __attribute__((aligned(16))) unsigned char lds_raw[];
  Ctx X; X.lds = (LAS unsigned char*)lds_raw; X.a = &args; X.ws = args.ws; X.tid = threadIdx.x; X.lane = X.tid & 63; X.wave = __builtin_amdgcn_readfirstlane(X.tid >> 6);
  X.G = gridDim.x; X.c = blockIdx.x;
  const int wave_s = X.wave;
  volatile LAS unsigned* MISC = (volatile LAS unsigned*)(X.lds + LDS_MISC_OFF);
  LAS int* TOFF = (LAS int*)(X.lds + LDS_MISC_OFF + 64);
  if (X.tid < 16) MISC[X.tid] = 0u;
  __syncthreads();
  unsigned* ctl = (unsigned*)(X.ws + WS_CTL);
  const int lo = args.ph_lo, hi = args.ph_hi;
  const bool multi = (hi - lo) > 1;
  XcdBarrier bar; bar.bar = ctl + CW_BAR; bar.x = 0; bar.st = nullptr;
  if (multi) bar = xcd_barrier_post(ctl + CW_BAR, MISC, X.tid);
  LAS unsigned char* lds = X.lds;
  unsigned char* ws = X.ws;
  const float* mod = (const float*)(ws + WS_MOD); (void)mod;
#ifndef PH_MASK
#define PH_MASK 0x1fffffull
#endif
#define IN(k) ((((unsigned long long)PH_MASK >> (k)) & 1ull) && lo <= (k) && (k) < hi)
#define SEAM(k) do { if (IN(k) && IN((k) + 1)) xcd_barrier(bar, X.tid); } while (0)
#ifndef REP_MASK
#define REP_MASK 0ull
#endif
#define REPS(k) ((int)(((unsigned long long)REP_MASK >> (k)) & 1ull))
#define FILL(ph, nb) do { if (!(args.flags & FLAG_SKIP_EXPERTS) && multi) { if (X.c < (nb)) { __syncthreads(); if (X.tid == 0) atomicAdd(ctl + CW_DONE + 64 * (ph), 1u); } \
    else transpose_work(X, ctl + CW_DQ1, 0, 0, 1, 65 * IT_EXP, ctl + CW_DONE + 64 * (ph), (unsigned)(nb)); } } while (0)
#define LAUNDER() do { int w0_ = wave_s; asm volatile("" : "+s"(w0_)); int l_ = __builtin_amdgcn_mbcnt_hi(~0u, __builtin_amdgcn_mbcnt_lo(~0u, 0u)); asm volatile("" : "+v"(l_)); X.wave = w0_; X.lane = l_; X.tid = w0_ * 64 + l_; \
    size_t z0_ = 0; asm volatile("" : "+s"(z0_)); unsigned char* w_ = args.ws + z0_; X.ws = w_; ws = w_; mod = (const float*)(w_ + WS_MOD); } while (0)
  if (IN(0)) for (int rep_ = 0; rep_ <= REPS(0); ++rep_) { if (rep_) xcd_barrier(bar, X.tid); LAUNDER(); phase_prep(X, rep_); } SEAM(0);
#ifdef EXTRA_BARS
  if (multi) for (int eb_ = 0; eb_ < EXTRA_BARS; ++eb_) xcd_barrier(bar, X.tid);
#endif
  if (IN(1)) for (int rep_ = 0; rep_ <= REPS(1); ++rep_) { if (rep_) xcd_barrier(bar, X.tid); LAUNDER(); phase_mod0(X); } SEAM(1);
  if (IN(2)) for (int rep_ = 0; rep_ <= REPS(2); ++rep_) { if (rep_) xcd_barrier(bar, X.tid); LAUNDER(); G1 p; p.K = 1024; p.nunits = 520; p.ws = ws; p.qg = args.in[IN_QG]; p.kg = args.in[IN_KG]; gemm_phase<G1, SP2>(lds, p, X.G, X.c, X.tid); FILL(2, 8); } SEAM(2);
  if (IN(3)) for (int rep_ = 0; rep_ <= REPS(3); ++rep_) { if (rep_) xcd_barrier(bar, X.tid); LAUNDER(); G2 p; p.K = 512; p.nunits = 96; p.ws = ws; gemm_phase<G2, SP2>(lds, p, X.G, X.c, X.tid); FILL(3, 96); } SEAM(3);
  if (IN(4)) for (int rep_ = 0; rep_ <= REPS(4); ++rep_) { if (rep_) xcd_barrier(bar, X.tid); LAUNDER(); phase_scan(X); FILL(4, 64); } SEAM(4);
  if (IN(5)) for (int rep_ = 0; rep_ <= REPS(5); ++rep_) { if (rep_) xcd_barrier(bar, X.tid); LAUNDER(); G3 p; p.K = 768; p.nunits = 128; p.ws = ws; gemm_phase<G3, SP2>(lds, p, X.G, X.c, X.tid); FILL(5, 128); } SEAM(5);
  if (IN(6)) for (int rep_ = 0; rep_ <= REPS(6); ++rep_) { if (rep_) xcd_barrier(bar, X.tid); LAUNDER(); G4 p; p.K = 512; p.nunits = 128; p.ws = ws; p.bglu = args.in[IN_BGLU]; gemm_phase<G4, SP2>(lds, p, X.G, X.c, X.tid); FILL(6, 128); } SEAM(6);
  if (IN(7)) for (int rep_ = 0; rep_ <= REPS(7); ++rep_) { if (rep_) xcd_barrier(bar, X.tid); LAUNDER(); phase_attn(X); } SEAM(7);
  if (IN(8)) for (int rep_ = 0; rep_ <= REPS(8); ++rep_) { if (rep_) xcd_barrier(bar, X.tid); LAUNDER(); GRes p; p.K = 1024; p.nunits = 256; p.A = (const char*)ws + WS_CONCAT; p.Bt = (const char*)ws + WS_WMIX_T; p.hin = args.in[IN_X]; p.hout = args.h; p.gate = mod + 2048; p.bias = nullptr;
    gemm_phase<GRes, SP2>(lds, p, X.G, X.c, X.tid); } SEAM(8);
#pragma unroll 1
  for (int layer = 0; layer < 2; ++layer) {
    const int pb = layer == 0 ? 9 : 17;
    if (IN(pb)) for (int rep_ = 0; rep_ <= REPS(pb); ++rep_) { if (rep_) xcd_barrier(bar, X.tid); LAUNDER(); phase_router(X, layer, rep_ ? ROUTER_VARIANT : 0); } SEAM(pb);
#ifndef ROUTER_VARIANT
#define ROUTER_VARIANT 1
#endif
#ifndef G6_VARIANT
#define G6_VARIANT 1
#endif
    if (IN(pb + 1)) for (int rep_ = REPS(pb + 1); rep_ >= 0; --rep_) { if (rep_ == 0 && REPS(pb + 1)) xcd_barrier(bar, X.tid); LAUNDER(); build_moetab(X, layer, TOFF); G6 p; p.dry = rep_ ? G6_VARIANT : 0; p.K = 512; p.ws = ws; p.toff = TOFF; p.nunits = TOFF[65] * 2; p.wbase = (const char*)ws + (layer == 0 ? WS_WEXP : WS_WEXP1); p.wstride = layer == 0 ? EXP_STRIDE : EXP1_STRIDE;
      { LAS unsigned* tk = (LAS unsigned*)(X.lds + LDS_STAGE); p.tokt = tk; p.build_tokt(X, tk); } gemm_phase<G6, SP2>(lds, p, X.G, X.c, X.tid); } SEAM(pb + 1);
#ifndef G7_VARIANT
#define G7_VARIANT 1
#endif
    if (IN(pb + 2)) for (int rep_ = REPS(pb + 2); rep_ >= 0; --rep_) { if (rep_ == 0 && REPS(pb + 2)) xcd_barrier(bar, X.tid); LAUNDER(); build_moetab(X, layer, TOFF); G7 p; p.K = 256; p.ws = ws; p.toff = TOFF; p.dry = rep_ ? G7_VARIANT : 0; p.nunits = TOFF[65] * 4; p.wbase = (const char*)ws + (layer == 0 ? WS_WEXP + EXP_DOFF : WS_WEXP1 + EXP1_DOFF); p.wstride = layer == 0 ? EXP_STRIDE : EXP1_STRIDE; gemm_phase<G7, SP2>(lds, p, X.G, X.c, X.tid); } SEAM(pb + 2);
    if (IN(pb + 3)) for (int rep_ = REPS(pb + 3); rep_ >= 0; --rep_) { if (rep_ == 0 && REPS(pb + 3)) xcd_barrier(bar, X.tid); LAUNDER(); build_moetab(X, layer, TOFF); phase_combine(X, layer, TOFF, rep_);
      if (layer == 0 && rep_ == 0 && !(args.flags & FLAG_SKIP_EXPERTS)) { __syncthreads(); transpose_work(X, ctl + CW_DQ1, 0, 0, 1, 65 * IT_EXP); } }
    if (layer == 0) {
      SEAM(12);
      if (IN(13)) for (int rep_ = 0; rep_ <= REPS(13); ++rep_) { if (rep_) xcd_barrier(bar, X.tid); LAUNDER(); G8 p; p.K = 256; p.nunits = 512; p.ws = ws; gemm_phase<G8, SP2>(lds, p, X.G, X.c, X.tid); } SEAM(13);
      if (IN(14)) for (int rep_ = 0; rep_ <= REPS(14); ++rep_) { if (rep_) xcd_barrier(bar, X.tid); LAUNDER(); G9 p; p.K = 256; p.nunits = 512; p.ws = ws; gemm_phase<G9, SP2>(lds, p, X.G, X.c, X.tid); } SEAM(14);
      if (IN(15)) for (int rep_ = 0; rep_ <= REPS(15); ++rep_) { if (rep_) xcd_barrier(bar, X.tid); LAUNDER(); G10 p; p.K = 256; p.nunits = 512; p.ws = ws; gemm_phase<G10, SP2>(lds, p, X.G, X.c, X.tid); } SEAM(15);
      if (IN(16)) { LAUNDER(); zero_lists(X); GRes p; p.K = 1024; p.nunits = 256; p.A = (const char*)ws + WS_FB; p.Bt = (const char*)ws + WS_WFOUR_T; p.hin = args.h; p.hout = args.h; p.gate = mod + 2 * 6144 + 2048; p.bias = args.in[IN_BFOUR];
        gemm_phase<GRes, SP2>(lds, p, X.G, X.c, X.tid); } SEAM(16);
    }
  }
#undef IN
#undef SEAM
}
}
#ifndef MK_SP2
#define MK_SP2 true
#endif
#ifndef MK_N_LAUNCHES
#define MK_N_LAUNCHES 1
#endif
#ifndef CHECK
#define CHECK 0
#endif
static int g_grid = 0;
static bool mk_setup(int n_in, int out_size, size_t ws_size) {
  if (g_grid == 0) {
    g_grid = -1;
    if (n_in != 31 || out_size != 16384 * 1024 || ws_size < mk::WS_NEED) { fprintf(stderr, "kernel_launch: unexpected n_in %d out %d ws %zu\n", n_in, out_size, ws_size); return false; }
    int dev = 0, cus = 0;
    if (hipGetDevice(&dev) != hipSuccess || hipDeviceGetAttribute(&cus, hipDeviceAttributeMultiprocessorCount, dev) != hipSuccess) return false;
    if (cus < 256) { fprintf(stderr, "kernel_launch: needs 256 CUs, device has %d\n", cus); return false; }
    if (hipFuncSetAttribute((const void*)mk::mk_fwd<MK_SP2>, hipFuncAttributeMaxDynamicSharedMemorySize, mk::LDS_BYTES) != hipSuccess) { fprintf(stderr, "kernel_launch: hipFuncSetAttribute failed\n"); return false; }
    g_grid = 256;
  }
  return g_grid > 0;
}
static void mk_run(hipStream_t s, mk::Args a, int lo, int hi) {
  a.ph_lo = lo; a.ph_hi = hi;
  hipLaunchKernelGGL(mk::mk_fwd<MK_SP2>, dim3(g_grid), dim3(mk::NTHR), mk::LDS_BYTES, s, a);
}

#if CHECK
namespace chk {
using mk::bf16_t;
__device__ __forceinline__ float b2f(bf16_t b) { return __uint_as_float(((unsigned)b) << 16); }
__global__ void k_cmp(int mode, const void* A, const float* B, unsigned long long n, double* acc) {
  double e = 0.0, r = 0.0; const bf16_t* A16 = (const bf16_t*)A;
  for (unsigned long long i = (unsigned long long)blockIdx.x * 256 + threadIdx.x; i < n; i += (unsigned long long)gridDim.x * 256) {
    float a = 0.f, b = 0.f; const int row = (int)(i >> 9), col = (int)(i & 511);
    switch (mode) {
      case 0: a = ((const float*)A)[i]; b = B[i]; break;
      case 1: a = b2f(A16[i]); b = B[i]; break;
      case 2: { b = B[(size_t)row * 2048 + col]; const int g = col >> 4, c = col & 15; int crow, s; if (row < 16384) { crow = row >> 5; s = row & 31; } else { const int j = row - 16384; crow = 512 + (j >> 5); s = j & 31; }
                a = b2f(A16[((size_t)(g * 768 + crow)) * 768 + s * 16 + c]); } break;
      case 3: b = B[(size_t)row * 2048 + 512 + col]; a = b2f(A16[(size_t)row * 512 + col]); break;
      case 4: b = B[(size_t)row * 2048 + 1024 + col]; a = b2f(A16[(size_t)row * 512 + col]); break;
      case 5: b = B[(size_t)row * 2048 + 1536 + col]; a = b2f(A16[(size_t)col * 16640 + row]); break;
      case 6: b = B[(size_t)row * 1024 + col]; a = b2f(A16[(size_t)row * 1024 + col]); break;
      case 7: b = B[(size_t)row * 1024 + 512 + col]; a = b2f(A16[(size_t)row * 1024 + 512 + col]); break;
      case 8: { const int ta = (int)(i & 127), ri = (int)((i >> 7) & 1), tb = (int)((i >> 8) & 127), m = (int)((i >> 15) & 255), g = (int)(i >> 23); a = b2f(A16[i]); const int t = 128 * ta + tb; b = B[((size_t)t * 4 + g) * 512 + ri * 256 + m]; } break;
      default: break;
    }
    const double d = (double)a - (double)b; e += d * d; r += (double)b * (double)b;
  }
  for (int o = 32; o >= 1; o >>= 1) { e += __shfl_xor(e, o); r += __shfl_xor(r, o); }
  if ((threadIdx.x & 63) == 0) { atomicAdd(acc, e); atomicAdd(acc + 1, r); }
}
__global__ void k_cmp_x2(const bf16_t* X2, const float* Yr, const float* Yi, double* acc) {
  double e = 0.0, r = 0.0;
  for (unsigned long long i = (unsigned long long)blockIdx.x * 256 + threadIdx.x; i < (1ull << 25); i += (unsigned long long)gridDim.x * 256) {
    const int tb = (int)(i & 127), rip = (int)((i >> 7) & 1), ka = (int)((i >> 8) & 127), gm = (int)(i >> 15);
    const float a = b2f(X2[i]); const size_t yi = (((size_t)ka * 128 + tb) << 10) + gm; const float b = rip ? Yi[yi] : Yr[yi];
    const double d = (double)a - (double)b; e += d * d; r += (double)b * (double)b;
  }
  for (int o = 32; o >= 1; o >>= 1) { e += __shfl_xor(e, o); r += __shfl_xor(r, o); }
  if ((threadIdx.x & 63) == 0) { atomicAdd(acc, e); atomicAdd(acc + 1, r); }
}
__global__ void k_judge(const double* acc, int n, float tol, int* fail) {
  if (threadIdx.x == 0 && blockIdx.x == 0) { fail[0] = 0; for (int k = 0; k < n; ++k) { const double rel = sqrt(acc[2 * k] / acc[2 * k + 1]); if (!(rel <= (double)tol)) { fail[0] = k + 1; break; } } }
}
__global__ void k_encode(float* out, size_t n, const int* fail) {
  const int f = fail[0]; if (f == 0) return; const float sc = 1.f + 0.1f * (float)f;
  for (size_t i = (size_t)blockIdx.x * 256 + threadIdx.x; i < n; i += (size_t)gridDim.x * 256) out[i] *= sc;
}
__global__ void k_f2bf(const float* in, bf16_t* out, size_t n) { for (size_t i = (size_t)blockIdx.x * 256 + threadIdx.x; i < n; i += (size_t)gridDim.x * 256) out[i] = mk::f2bf(in[i]); }
static void cmp(hipStream_t s, int mode, const void* A, const float* B, unsigned long long n, double* acc) { hipLaunchKernelGGL(k_cmp, dim3(2048), dim3(256), 0, s, mode, A, B, n, acc); }
}
#endif

extern "C" void kernel_launch(void* const* d_in, const int* in_sizes, int n_in, void* d_out, int out_size, void* d_ws, size_t ws_size, hipStream_t stream) {
  if (!mk_setup(n_in, out_size, ws_size)) return;
  unsigned char* ws = (unsigned char*)d_ws;
  const size_t MiB = mk::MiB;
  mk::Args a{};
  for (int i = 0; i < 31; ++i) a.in[i] = (const float*)d_in[i];
  a.h = (float*)d_out; a.ws = ws; a.flags = 0; a.pad = 0;
#if CHECK == 0
  (void)hipMemsetAsync(ws + mk::WS_CTL, 0, mk::CTL_ZERO_BYTES, stream);
#if MK_N_LAUNCHES == 1
  mk_run(stream, a, 0, mk::NPHASE);
#else
  for (int ph = 0; ph < mk::NPHASE; ++ph) mk_run(stream, a, ph, ph + 1);
#endif
#else
  ref::In in; { const float** p = (const float**)&in; for (int i = 0; i < 31; ++i) p[i] = (const float*)d_in[i]; }
  float* out = (float*)d_out;
  char* wsc = (char*)d_ws;
  ref::Small sm; sm.mod = (float*)(wsc + 498 * MiB); sm.lamb = (float2*)(wsc + 498 * MiB + 131072); sm.bbar = (float2*)(wsc + 498 * MiB + 262144);
  sm.tw = (float2*)(wsc + 499 * MiB); sm.Dm = (float*)(wsc + 499 * MiB + 262144);
  double* acc = (double*)(wsc + 500 * MiB); int* fail = (int*)(wsc + 500 * MiB + 4096);
  (void)hipMemsetAsync(acc, 0, 8192, stream);
  (void)hipMemsetAsync(ws + mk::WS_CTL, 0, mk::CTL_ZERO_BYTES, stream);
  float* HOPT = (float*)(ws + mk::WS_HOPT);
  int nchk = 0;
#if CHECK == 1
  ref::MixBuf mb; mb.a0 = (float*)(wsc + 12 * MiB); mb.z = (float*)(wsc + 336 * MiB); mb.g = (float*)(wsc + 466 * MiB); mb.t = (float*)(wsc + 77 * MiB); mb.concat = mb.a0; mb.ymix = mb.z;
  char* moe_arena = wsc + 12 * MiB;
  ref::FourBuf fb; { char* p = wsc + 12 * MiB; fb.a1 = (float*)p; p += 64 * MiB; fb.Z = (float*)p; p += 128 * MiB; fb.Yr = (float*)p; p += 64 * MiB; fb.Yi = (float*)p; p += 64 * MiB; fb.F = (float*)p; fb.yf = fb.Z; }
  a.flags = mk::FLAG_SKIP_EXPERTS;
  nchk = 10;
  ref::forward(stream, in, out, sm, mb, moe_arena, fb, [&](int st) {
    if (st == 1) { mk_run(stream, a, 0, 1); chk::cmp(stream, 0, ws + mk::WS_MOD, sm.mod, 3 * 6144, acc + 0); }
    if (st == 2) { mk_run(stream, a, 1, 2); chk::cmp(stream, 1, ws + mk::WS_A0, mb.a0, 16640ull * 1024, acc + 2); }
    if (st == 3) { mk_run(stream, a, 2, 3); chk::cmp(stream, 2, ws + mk::WS_AS5, mb.z, 16640ull * 512, acc + 4); chk::cmp(stream, 3, ws + mk::WS_Q, mb.z, 16384ull * 512, acc + 6);
                   chk::cmp(stream, 4, ws + mk::WS_K, mb.z, 16640ull * 512, acc + 8); chk::cmp(stream, 5, ws + mk::WS_VT, mb.z, 16640ull * 512, acc + 10); }
    if (st == 4) { mk_run(stream, a, 3, 4); mk_run(stream, a, 4, 5); mk_run(stream, a, 5, 6); chk::cmp(stream, 1, ws + mk::WS_GB, mb.g, 16384ull * 512, acc + 12); }
    if (st == 5) { mk_run(stream, a, 6, 7); chk::cmp(stream, 6, ws + mk::WS_CONCAT, mb.concat, 16384ull * 512, acc + 14); }
    if (st == 6) { mk_run(stream, a, 7, 8); chk::cmp(stream, 7, ws + mk::WS_CONCAT, mb.concat, 16384ull * 512, acc + 16); }
    if (st == 7) { mk::Args b = a; b.h = HOPT; mk_run(stream, b, 8, 9); chk::cmp(stream, 0, HOPT, out, 16384ull * 1024, acc + 18); }
  });
#elif CHECK == 2 || CHECK == 4
  const int L = CHECK == 2 ? 0 : 1;
  ref::MixBuf mb; { char* p = wsc + 12 * MiB; mb.a0 = (float*)p; p += 65 * MiB; mb.z = (float*)p; p += 130 * MiB; mb.g = (float*)p; p += 32 * MiB; mb.t = (float*)p; p += 32 * MiB; mb.concat = (float*)p; p += 64 * MiB; mb.ymix = mb.z; }
  ref::FourBuf fb; { char* p = wsc + 12 * MiB; fb.a1 = (float*)p; p += 64 * MiB; fb.Z = (float*)p; p += 128 * MiB; fb.Yr = (float*)p; p += 64 * MiB; fb.Yi = (float*)p; p += 64 * MiB; fb.F = (float*)p; fb.yf = fb.Z; }
  char* moe_arena = wsc + 110 * MiB;
  nchk = L == 0 ? 2 : 1;
  a.flags = 0;
  ref::forward(stream, in, out, sm, mb, moe_arena, fb, [&](int st) {
    if ((L == 0 && st == 7) || (L == 1 && st == 11)) {
      mk::Args b = a; b.h = HOPT; if (L == 1) b.flags = 2;
      mk_run(stream, b, 0, 1);
      (void)hipMemcpyAsync(HOPT, out, (size_t)16384 * 1024 * 4, hipMemcpyDeviceToDevice, stream);
      const int pb = L == 0 ? 9 : 20; b.flags |= mk::FLAG_SKIP_EXPERTS;
      for (int ph = pb; ph < pb + 7; ++ph) mk_run(stream, b, ph, ph + 1);
    }
    if ((L == 0 && st == 8) || (L == 1 && st == 12)) chk::cmp(stream, 0, HOPT, out, 16384ull * 1024, acc + 0);
    if (L == 0 && st == 9) chk::cmp(stream, 1, ws + mk::WS_A1, fb.a1, 16384ull * 1024, acc + 2);
  });
#elif CHECK == 3
  ref::MixBuf mb; { char* p = wsc + 12 * MiB; mb.a0 = (float*)p; p += 65 * MiB; mb.z = (float*)p; p += 130 * MiB; mb.g = (float*)p; p += 32 * MiB; mb.t = (float*)p; p += 32 * MiB; mb.concat = (float*)p; p += 64 * MiB; mb.ymix = mb.z; }
  char* moe_arena = wsc + 12 * MiB;
  ref::FourBuf fb; fb.Z = (float*)(wsc + 270 * MiB);
  fb.a1 = (float*)(wsc + 12 * MiB); fb.Yr = (float*)(wsc + 12 * MiB);   fb.Yi = (float*)(wsc + 468 * MiB - 0); fb.F = (float*)(wsc + 270 * MiB); fb.yf = (float*)(wsc + 334 * MiB);
  fb.Yi = (float*)(wsc + 76 * MiB);
  nchk = 4;
  a.flags = mk::FLAG_SKIP_EXPERTS;
  ref::forward(stream, in, out, sm, mb, moe_arena, fb, [&](int st) {
    if (st == 9) {
      mk::Args b = a; b.h = HOPT;
      mk_run(stream, b, 0, 1);
      hipLaunchKernelGGL(chk::k_f2bf, dim3(2048), dim3(256), 0, stream, fb.a1, (chk::bf16_t*)(ws + mk::WS_A1), (size_t)16384 * 1024);
      (void)hipMemcpyAsync(HOPT, out, (size_t)16384 * 1024 * 4, hipMemcpyDeviceToDevice, stream);
      mk_run(stream, b, 16, 17);
    }
  });
#endif
  hipLaunchKernelGGL(chk::k_judge, dim3(1), dim3(64), 0, stream, acc, nchk, 0.05f, fail);
  hipLaunchKernelGGL(chk::k_encode, dim3(2048), dim3(256), 0, stream, out, (size_t)16384 * 1024, fail);
#endif
}
```

```cpp
#define CHECK 0
#define MK_N_LAUNCHES 1
#define MK_SP2 true
#define REP_MASK 0ull
#define ROUTER_VARIANT 1
#include <hip/hip_runtime.h>
#include <cstdio>
#include <cstdint>
#include <cmath>
namespace mk {
#define LAS __attribute__((address_space(3)))
typedef unsigned short bf16_t;
typedef short bf16x8 __attribute__((ext_vector_type(8)));
typedef float f32x4 __attribute__((ext_vector_type(4)));
typedef float f32x2 __attribute__((ext_vector_type(2)));
typedef unsigned u32x4 __attribute__((ext_vector_type(4)));
typedef unsigned u32x2 __attribute__((ext_vector_type(2)));
typedef int i32x8 __attribute__((ext_vector_type(8)));
typedef int i32x4 __attribute__((ext_vector_type(4)));

constexpr int TOK = 16384, CTXN = 256, NROW = TOK + CTXN;
constexpr int NWAVES = 8, NTHR = 512;
constexpr int LDS_STAGE = 131072, LDS_BYTES = 155648, LDS_MISC_OFF = LDS_BYTES - 4096;

__device__ __forceinline__ unsigned cvt_pk_bf16(float lo, float hi) { unsigned r; asm volatile("v_cvt_pk_bf16_f32 %0, %1, %2" : "=v"(r) : "v"(lo), "v"(hi)); return r; }
__device__ __forceinline__ float bf_lo(unsigned w) { return __uint_as_float(w << 16); }
__device__ __forceinline__ float bf_hi(unsigned w) { return __uint_as_float(w & 0xffff0000u); }
__device__ __forceinline__ float bf2f(bf16_t b) { return __uint_as_float(((unsigned)b) << 16); }
__device__ __forceinline__ bf16_t f2bf(float f) { unsigned u = __float_as_uint(f); return (bf16_t)((u + 0x7fffu + ((u >> 16) & 1u)) >> 16); }
__device__ __forceinline__ float sx(float v, int o) { unsigned z = 0u; asm volatile("" : "+v"(z)); int l = (int)__builtin_amdgcn_mbcnt_hi(~0u, __builtin_amdgcn_mbcnt_lo(~0u, z)); return __int_as_float(__builtin_amdgcn_ds_bpermute((l ^ o) << 2, __float_as_int(v))); }
__device__ __forceinline__ float wave_sum(float v) {
#pragma unroll
  for (int o = 1; o < 64; o <<= 1) v += sx(v, o);
  return v;
}
__device__ __forceinline__ float fast_sigmoid(float x) { return __builtin_amdgcn_rcpf(1.f + __expf(-x)); }
__device__ __forceinline__ float fast_tanh(float x) { float e = __expf(2.f * x); return 1.f - 2.f * __builtin_amdgcn_rcpf(e + 1.f); }
__device__ __forceinline__ float gelu_tanh(float x) { return 0.5f * x * (1.f + fast_tanh(0.7978845608028654f * (x + 0.044715f * x * x * x))); }

#define XB_TMO      128
#define XB_XCNT(j)  (256  + 64 * (j))
#define XB_XSUB(j)  (1280 + 64 * (j))
#define XB_XGEN(j)  (2304 + 64 * (j))
#define XB_TOP      3328
#define XB_TOPGEN   3392
#define XCD_BAR_WORDS 3456
#define XB_SPIN_CAP (1u << 20)
__device__ __forceinline__ unsigned xb_ld(unsigned* p) { return __hip_atomic_load(p, __ATOMIC_RELAXED, __HIP_MEMORY_SCOPE_AGENT); }
__device__ __forceinline__ unsigned xb_add(unsigned* p, unsigned v) { return __hip_atomic_fetch_add(p, v, __ATOMIC_RELAXED, __HIP_MEMORY_SCOPE_AGENT); }
__device__ __forceinline__ unsigned xb_xcc_id() { return (unsigned)__builtin_amdgcn_s_getreg((3 << 11) | 20) & 0xFu; }
#define XB_SPIN(cond, bar) do { unsigned _sp = 0; while (cond) { __builtin_amdgcn_s_sleep(1); \
    if ((++_sp & 255u) == 0u) { if (xb_ld(&(bar)[XB_TMO])) break; if (_sp > XB_SPIN_CAP) { atomicAdd(&(bar)[XB_TMO], 1u); break; } } } } while (0)
struct XcdBarrier { unsigned* bar; unsigned x; volatile LAS unsigned* st; };
__device__ __forceinline__ XcdBarrier xcd_barrier_post(unsigned* bar, volatile LAS unsigned* st, int tid) {
  XcdBarrier b; b.bar = bar; b.x = xb_xcc_id(); b.st = st;
  if (tid == 0) (void)xb_add(&bar[XB_XCNT(b.x)], 1u);
  return b;
}
__device__ __forceinline__ void xcd_barrier_complete(unsigned* bar, unsigned x, unsigned& nloc, unsigned& nx) {
  const unsigned G = gridDim.x * gridDim.y * gridDim.z;
  unsigned sum, cnt, mine, sp = 0u;
  for (;;) {
    sum = 0u; cnt = 0u; mine = 0u;
#pragma unroll
    for (unsigned j = 0; j < 16; ++j) { const unsigned c = xb_ld(&bar[XB_XCNT(j)]); sum += c; cnt += (c > 0u) ? 1u : 0u; }
    if (sum == G) { mine = xb_ld(&bar[256 + 64 * x]); break; }
    __builtin_amdgcn_s_sleep(1);
    if ((++sp & 255u) == 0u) { if (xb_ld(&bar[XB_TMO])) break; if (sp > XB_SPIN_CAP) { atomicAdd(&bar[XB_TMO], 1u); break; } }
  }
  nloc = mine > 0u ? mine : 1u; nx = cnt > 0u ? cnt : 1u;
}
__device__ __forceinline__ void xcd_barrier(const XcdBarrier& b, int tid) {
  asm volatile("s_waitcnt vmcnt(0)" ::: "memory");
  __syncthreads();
  if (tid == 0) {
    unsigned* bar = b.bar;
    __builtin_amdgcn_s_waitcnt(0);
    unsigned nloc = b.st[0], nx = b.st[1];
    if (nloc == 0u) { xcd_barrier_complete(bar, b.x, nloc, nx); b.st[0] = nloc; b.st[1] = nx; }
    const unsigned old = xb_add(&bar[XB_XSUB(b.x)], 1u);
    const unsigned gen = old / nloc;
    if (old + 1u == (gen + 1u) * nloc) {
      __builtin_amdgcn_fence(__ATOMIC_RELEASE, "agent");
      asm volatile("s_waitcnt vmcnt(0)" ::: "memory");
      const unsigned og = xb_add(&bar[XB_TOP], 1u);
      const unsigned tg = og / nx;
      if (og + 1u == (tg + 1u) * nx) xb_add(&bar[XB_TOPGEN], 1u);
      else XB_SPIN(xb_ld(&bar[XB_TOPGEN]) == tg, bar);
      __builtin_amdgcn_fence(__ATOMIC_ACQUIRE, "agent");
      xb_add(&bar[XB_XGEN(b.x)], 1u);
      asm volatile("s_waitcnt vmcnt(0)" ::: "memory");
    } else {
      XB_SPIN(xb_ld(&bar[XB_XGEN(b.x)]) == gen, bar);
      __builtin_amdgcn_fence(__ATOMIC_ACQUIRE, "agent");
      asm volatile("s_waitcnt vmcnt(0)" ::: "memory");
    }
  }
  __syncthreads();
}

constexpr int BM = 256, BK = 64, HALF = 128, HTB = HALF * BK * 2, NXCD = 8;
__device__ __forceinline__ int lds_byte(int r, int c) { const int st = (r >> 4) * 2 + (c >> 5), rr = r & 15, cc = c & 31, ob = rr * 64 + cc * 2; return st * 1024 + (ob ^ (((ob >> 9) & 1) << 5)); }
__device__ __forceinline__ void stage_rc(int b, int& R, int& C) { const int st = b / 1024, sb = b % 1024, swz = sb ^ (((sb >> 9) & 1) << 5); R = (st >> 1) * 16 + swz / 64; C = (st & 1) * 32 + (swz % 64) / 2; }
__device__ __forceinline__ int perm32(int rho) { const int n = rho >> 4, i = rho & 15; return 8 * (i >> 2) + 4 * n + (i & 3); }

struct Unit { int pm, pn, a, b, ord; };
__device__ __forceinline__ int xcd_remap(int L, int nunits) { const int q = nunits / NXCD, r = nunits % NXCD, xcd = L % NXCD, off = L / NXCD; return (xcd < r ? xcd * (q + 1) : r * (q + 1) + (xcd - r) * q) + off; }
typedef f32x4 Acc[2][2][4][2];
template <class P, bool SP2>
__device__ __forceinline__ void gemm_phase(LAS unsigned char* lds, const P& p, int G, int c, int tid_in) {
  const int tid = tid_in, wid = __builtin_amdgcn_readfirstlane(tid >> 6), lane = tid & 63, wr = wid >> 2, wc = wid & 3, fr = lane & 15, fq = lane >> 4;
  const int K = p.K, nt = K / BK;
  const int nunits = p.nunits;
  const size_t kstep = (size_t)(BK * 2);
  const unsigned ldsw = (unsigned)wid * 1024u;
  const int aoff = lds_byte(wr * 64 + fr, P::F8 ? fq * 16 : fq * 8), boff = lds_byte(wc * 32 + fr, P::F8 ? fq * 16 : fq * 8);
#define PG8_SA(b, h) (((b) * 2 + (h)) * HTB)
#define PG8_SB(b, h) ((4 + (b) * 2 + (h)) * HTB)
#define PG8_STAGE(bufoff, gbase, voff) do { _Pragma("unroll") for (int _i = 0; _i < 2; ++_i) \
        __builtin_amdgcn_global_load_lds((const unsigned*)((const char*)(gbase) + (voff)[_i]), (LAS unsigned*)(lds + (bufoff) + ldsw + _i * 8192), 16, 0, 0); } while (0)
#define PG8_RD32(p_) __builtin_shufflevector(*(const LAS i32x4*)(p_), *(const LAS i32x4*)((p_) + 16), 0, 1, 2, 3, 4, 5, 6, 7)
#define PG8_LDA(dst, b, h) do { if constexpr (P::F8) { _Pragma("unroll") for (int m = 0; m < 4; ++m) dst##8[m] = PG8_RD32(lds + PG8_SA(b, h) + aoff + m * 2048); } \
        else { _Pragma("unroll") for (int m = 0; m < 4; ++m) _Pragma("unroll") for (int k = 0; k < 2; ++k) dst[m][k] = *(const LAS bf16x8*)(lds + PG8_SA(b, h) + aoff + m * 2048 + k * 1024); } } while (0)
#define PG8_LDB(dst, b, h) do { if constexpr (P::F8) { _Pragma("unroll") for (int n = 0; n < 2; ++n) dst##8[n] = PG8_RD32(lds + PG8_SB(b, h) + boff + n * 2048); } \
        else { _Pragma("unroll") for (int n = 0; n < 2; ++n) _Pragma("unroll") for (int k = 0; k < 2; ++k) dst[n][k] = *(const LAS bf16x8*)(lds + PG8_SB(b, h) + boff + n * 2048 + k * 1024); } } while (0)
#define PG8_MMA(ai, bj, At, Bt) do { __builtin_amdgcn_s_setprio(1); if constexpr (P::F8) { _Pragma("unroll") for (int m = 0; m < 4; ++m) _Pragma("unroll") for (int n = 0; n < 2; ++n) \
        acc[ai][bj][m][n] = __builtin_amdgcn_mfma_scale_f32_16x16x128_f8f6f4(Bt##8[n], At##8[m], acc[ai][bj][m][n], 0, 0, 0, 0, 0, 0); }     \
        else { _Pragma("unroll") for (int m = 0; m < 4; ++m) _Pragma("unroll") for (int n = 0; n < 2; ++n) _Pragma("unroll") for (int k = 0; k < 2; ++k) \
        acc[ai][bj][m][n] = __builtin_amdgcn_mfma_f32_16x16x32_bf16(Bt[n][k], At[m][k], acc[ai][bj][m][n], 0, 0, 0); } __builtin_amdgcn_s_setprio(0); } while (0)
#define PG8_WAIT_V(n) asm volatile("s_waitcnt vmcnt(" #n ")" ::: "memory")
#define PG8_WAIT_L(n) asm volatile("s_waitcnt lgkmcnt(" #n ")" ::: "memory")
#define PG8_BAR __builtin_amdgcn_s_barrier()
#define PG8_SCHED __builtin_amdgcn_sched_barrier(0)
#define PG8_DECODE(i, u) do { p.decode(P::CONTIG ? (u_lo + (i)) : xcd_remap((i) * G + c, nunits), u); u.ord = (i); } while (0)
#define PG8_HAS(i) (P::CONTIG ? (u_lo + (i) < u_hi) : ((i) * G + c < nunits))
#define PG8_OFFS(u, vA, vB) do { int _t = tid; asm volatile("" : "+v"(_t)); _Pragma("unroll") for (int _i = 0; _i < 2; ++_i) { int _R, _C; stage_rc(_t * 16 + _i * 8192, _R, _C); \
        const int _Rb = P::PERM ? ((_R & ~31) + perm32(_R & 31)) : _R; _Pragma("unroll") for (int _h = 0; _h < 2; ++_h) { \
        if (_h == 0 || !P::LINA) vA[_h][_i] = p.rowA(u, _h * HALF + _R) + (unsigned)(_C * 2); if (_h == 0 || !P::LINB) vB[_h][_i] = p.rowB(u, _h * HALF + _Rb) + (unsigned)(_C * 2); } } } while (0)
  const int vc_ = (G % 8 == 0) ? (c % 8) * (G / 8) + c / 8 : c;
  const int u_lo = (int)(((long)vc_ * nunits) / G), u_hi = (int)(((long)(vc_ + 1) * nunits) / G);
  if (!PG8_HAS(0)) return;
  Unit cur, nxt; int ui = 0;
  PG8_DECODE(0, cur);
  Acc acc; float zf_ = 0.f; asm volatile("" : "+v"(zf_));
#pragma unroll
  for (int a = 0; a < 2; ++a)
#pragma unroll
    for (int b = 0; b < 2; ++b)
#pragma unroll
      for (int m = 0; m < 4; ++m)
#pragma unroll
        for (int n = 0; n < 2; ++n) acc[a][b][m][n] = (f32x4){zf_, zf_, zf_, zf_};
  bf16x8 At[4][2], B0[2][2], B1[2][2]; i32x8 At8[4], B08[2], B18[2];
  unsigned vA[2][2], vB[2][2];
  PG8_OFFS(cur, vA, vB);
  const char* cA = p.baseA(cur); const char* cB = p.baseB(cur);
  const size_t hA = P::LINA ? p.halfA() : 0, hB = P::LINB ? p.halfB() : 0;
  if constexpr (SP2) {
    PG8_STAGE(PG8_SB(0, 0), cB, vB[0]); PG8_STAGE(PG8_SB(0, 1), (cB) + (P::LINB ? hB : 0), vB[P::LINB ? 0 : 1]); PG8_STAGE(PG8_SA(0, 0), cA, vA[0]); PG8_STAGE(PG8_SA(0, 1), (cA) + (P::LINA ? hA : 0), vA[P::LINA ? 0 : 1]);
    if (wr == 1) PG8_BAR;
    PG8_WAIT_V(2); PG8_BAR;
    PG8_STAGE(PG8_SB(1, 0), cB + kstep, vB[0]); PG8_STAGE(PG8_SA(1, 0), cA + kstep, vA[0]); PG8_STAGE(PG8_SB(1, 1), (cB + kstep) + (P::LINB ? hB : 0), vB[P::LINB ? 0 : 1]);
    PG8_WAIT_V(6); PG8_BAR;
  } else {
    PG8_STAGE(PG8_SB(0, 0), cB, vB[0]); PG8_STAGE(PG8_SA(0, 0), cA, vA[0]); PG8_STAGE(PG8_SB(0, 1), (cB) + (P::LINB ? hB : 0), vB[P::LINB ? 0 : 1]); PG8_STAGE(PG8_SA(0, 1), (cA) + (P::LINA ? hA : 0), vA[P::LINA ? 0 : 1]);
    if (wr == 1) PG8_BAR;
    PG8_WAIT_V(4); PG8_BAR;
    PG8_STAGE(PG8_SB(1, 0), cB + kstep, vB[0]); PG8_STAGE(PG8_SA(1, 0), cA + kstep, vA[0]); PG8_STAGE(PG8_SB(1, 1), (cB + kstep) + (P::LINB ? hB : 0), vB[P::LINB ? 0 : 1]);
    PG8_WAIT_V(6); PG8_BAR;
  }
  for (;;) {
    const bool has_next = PG8_HAS(ui + 1);
    if (has_next) PG8_DECODE(ui + 1, nxt);
    const char* nA = has_next ? p.baseA(nxt) : cA; const char* nB = has_next ? p.baseB(nxt) : cB;
    for (int t = 0; t < nt; t += 2) {
      const bool last = (t == nt - 2);
      const char* a1 = cA + (size_t)(t + 1) * kstep;
      const char* a2 = last ? nA : cA + (size_t)(t + 2) * kstep; const char* b2 = last ? nB : cB + (size_t)(t + 2) * kstep;
      const char* a3 = a2 + kstep; const char* b3 = b2 + kstep;
      if constexpr (SP2) {
        PG8_LDB(B0, 0, 0); PG8_LDB(B1, 0, 1); PG8_SCHED; PG8_LDA(At, 0, 0); PG8_STAGE(PG8_SA(1, 1), (a1) + (P::LINA ? hA : 0), vA[P::LINA ? 0 : 1]);
        PG8_WAIT_V(8); PG8_WAIT_L(0); PG8_BAR; PG8_MMA(0, 0, At, B0); PG8_MMA(0, 1, At, B1); PG8_BAR; PG8_SCHED;
        if (last && has_next) { PG8_OFFS(nxt, vA, vB); }
        PG8_LDA(At, 0, 1); PG8_STAGE(PG8_SB(0, 0), b2, vB[0]); PG8_STAGE(PG8_SB(0, 1), (b2) + (P::LINB ? hB : 0), vB[P::LINB ? 0 : 1]); PG8_STAGE(PG8_SA(0, 0), a2, vA[0]);
        PG8_WAIT_V(8); PG8_WAIT_L(0); PG8_BAR; PG8_MMA(1, 0, At, B0); PG8_MMA(1, 1, At, B1); PG8_BAR; PG8_SCHED;
        PG8_LDB(B0, 1, 0); PG8_LDB(B1, 1, 1); PG8_SCHED; PG8_LDA(At, 1, 0); PG8_STAGE(PG8_SA(0, 1), (a2) + (P::LINA ? hA : 0), vA[P::LINA ? 0 : 1]);
        PG8_WAIT_V(8); PG8_WAIT_L(0); PG8_BAR; PG8_MMA(0, 0, At, B0); PG8_MMA(0, 1, At, B1); PG8_BAR; PG8_SCHED;
        PG8_LDA(At, 1, 1); PG8_STAGE(PG8_SB(1, 0), b3, vB[0]); PG8_STAGE(PG8_SB(1, 1), (b3) + (P::LINB ? hB : 0), vB[P::LINB ? 0 : 1]); PG8_STAGE(PG8_SA(1, 0), a3, vA[0]);
        PG8_WAIT_V(8); PG8_WAIT_L(0); PG8_BAR; PG8_MMA(1, 0, At, B0); PG8_MMA(1, 1, At, B1); PG8_BAR; PG8_SCHED;
      } else {
        PG8_LDB(B0, 0, 0); PG8_SCHED; PG8_LDA(At, 0, 0); PG8_STAGE(PG8_SA(1, 1), (a1) + (P::LINA ? hA : 0), vA[P::LINA ? 0 : 1]);
        PG8_WAIT_L(8); PG8_BAR; PG8_WAIT_L(0); PG8_MMA(0, 0, At, B0); PG8_BAR; PG8_SCHED;
        if (last && has_next) { PG8_OFFS(nxt, vA, vB); }
        PG8_LDB(B1, 0, 1); PG8_STAGE(PG8_SB(0, 0), b2, vB[0]);
        PG8_BAR; PG8_WAIT_L(0); PG8_MMA(0, 1, At, B1); PG8_BAR;
        PG8_LDA(At, 0, 1); PG8_STAGE(PG8_SA(0, 0), a2, vA[0]);
        PG8_BAR; PG8_WAIT_L(0); PG8_MMA(1, 0, At, B0); PG8_BAR; PG8_SCHED;
        PG8_STAGE(PG8_SB(0, 1), (b2) + (P::LINB ? hB : 0), vB[P::LINB ? 0 : 1]);
        PG8_WAIT_V(6); PG8_BAR; PG8_MMA(1, 1, At, B1); PG8_BAR;
        PG8_LDB(B0, 1, 0); PG8_SCHED; PG8_LDA(At, 1, 0); PG8_STAGE(PG8_SA(0, 1), (a2) + (P::LINA ? hA : 0), vA[P::LINA ? 0 : 1]);
        PG8_WAIT_L(8); PG8_BAR; PG8_WAIT_L(0); PG8_MMA(0, 0, At, B0); PG8_BAR; PG8_SCHED;
        PG8_LDB(B1, 1, 1); PG8_STAGE(PG8_SB(1, 0), b3, vB[0]);
        PG8_BAR; PG8_WAIT_L(0); PG8_MMA(0, 1, At, B1); PG8_BAR;
        PG8_LDA(At, 1, 1); PG8_STAGE(PG8_SA(1, 0), a3, vA[0]);
        PG8_BAR; PG8_WAIT_L(0); PG8_MMA(1, 0, At, B0); PG8_BAR; PG8_SCHED;
        PG8_STAGE(PG8_SB(1, 1), (b3) + (P::LINB ? hB : 0), vB[P::LINB ? 0 : 1]);
        PG8_WAIT_V(6); PG8_BAR; PG8_MMA(1, 1, At, B1); PG8_BAR;
      }
    }
    if constexpr (P::ALIGN) { if (wr == 0) PG8_BAR; }
    { int fr_e = fr, fq_e = fq; asm volatile("" : "+v"(fr_e), "+v"(fq_e)); p.epi(acc, cur, wr, wc, fr_e, fq_e); }
    if (!has_next) break;
    zf_ = 0.f; asm volatile("" : "+v"(zf_));
#pragma unroll
    for (int a = 0; a < 2; ++a)
#pragma unroll
      for (int b = 0; b < 2; ++b)
#pragma unroll
        for (int m = 0; m < 4; ++m)
#pragma unroll
          for (int n = 0; n < 2; ++n) acc[a][b][m][n] = (f32x4){zf_, zf_, zf_, zf_};
    cur = nxt; cA = nA; cB = nB; ++ui;
    if constexpr (P::ALIGN) { if (wr == 1) PG8_BAR; }
  }
  PG8_WAIT_V(0);
  if constexpr (!P::ALIGN) { if (wr == 0) PG8_BAR; }
  PG8_BAR;
#undef PG8_SA
#undef PG8_SB
#undef PG8_STAGE
#undef PG8_RD32
#undef PG8_LDA
#undef PG8_LDB
#undef PG8_MMA
#undef PG8_WAIT_V
#undef PG8_WAIT_L
#undef PG8_BAR
#undef PG8_SCHED
#undef PG8_DECODE
#undef PG8_HAS
#undef PG8_OFFS
}
}
namespace mk {
constexpr size_t MiB = 1u << 20;
constexpr size_t WS_CTL = 0, CTL_ZERO_BYTES = 65536;
constexpr size_t WS_MOD = 65536;
constexpr size_t WS_LAML = 262144;
constexpr size_t WS_WIN_T = 1 * MiB, WS_WGLU_T = 5 * MiB, WS_WMIX_T = 6 * MiB, WS_WFOUR_T = 8 * MiB, WS_WROUT_T = 10 * MiB;
constexpr size_t WS_DMT = 10 * MiB + 512 * 1024, WS_W1 = 10 * MiB + 768 * 1024, WS_W2 = 10 * MiB + 896 * 1024;
constexpr size_t WS_WEXP = 12 * MiB, EXP_STRIDE = 3 * MiB / 2, EXP_DOFF = 1 * MiB;
constexpr size_t WS_R = 110 * MiB;
constexpr size_t WS_WS = WS_R, WS_TT = WS_R + 8 * MiB, WS_A0 = WS_R + 34 * MiB, WS_AS5 = WS_R + 67 * MiB, WS_Q = WS_R + 103 * MiB, WS_K = WS_R + 119 * MiB,
                 WS_VT = WS_R + 136 * MiB, WS_SST = WS_R + 153 * MiB, WS_GB = WS_R + 177 * MiB, WS_CONCAT = WS_R + 193 * MiB;
constexpr size_t WS_F = WS_R, WS_LTOK = WS_R + 16 * MiB, WS_ASG = WS_R + 20 * MiB, WS_HID = WS_R + 22 * MiB, WS_YAS = WS_R + 102 * MiB,
                 WS_A1 = WS_R + 262 * MiB, WS_HB = WS_R + 294 * MiB;
constexpr size_t WS_X1 = WS_R, WS_X2 = WS_R + 64 * MiB, WS_FB = WS_R + 128 * MiB;
constexpr size_t WS_HOPT = WS_R + 338 * MiB;
constexpr size_t WS_WEXP1 = WS_R + 338 * MiB;
constexpr size_t EXP1_STRIDE = 1 * MiB, EXP1_DOFF = 512 * 1024;
constexpr size_t WS_NEED = WS_R + 403 * MiB;
constexpr int HALF_CAP_ROWS = 90112;
constexpr int CW_BAR = 4096, CW_CNT = 8192  , CW_DQ0 = 12288, CW_DQ1 = 12352, CW_DONE = 13312  ;

struct Args { const float* in[31]; float* h; unsigned char* ws; int ph_lo, ph_hi, flags, pad; };
enum { IN_X = 0, IN_C, IN_CTX, IN_CCTX, IN_WADA, IN_BADA, IN_WIN, IN_LRE, IN_LIM, IN_LDT, IN_BRE, IN_BIM, IN_CRE, IN_CIM, IN_S5D, IN_WGLU, IN_BGLU, IN_QG, IN_KG,
       IN_RPB, IN_WMIX, IN_WFOUR, IN_BFOUR, IN_WROUT, IN_RBIAS, IN_WEG, IN_WEU, IN_WED, IN_WSG, IN_WSU, IN_WSD };
constexpr int FLAG_SKIP_EXPERTS = 1;

struct Ctx {
  LAS unsigned char* lds; const Args* a; unsigned char* ws; int tid, lane, wave, G, c;
};

__device__ __forceinline__ u32x4 pack8(const f32x4& v0, const f32x4& v1) { u32x4 w; w.x = cvt_pk_bf16(v0[0], v0[1]); w.y = cvt_pk_bf16(v0[2], v0[3]); w.z = cvt_pk_bf16(v1[0], v1[1]); w.w = cvt_pk_bf16(v1[2], v1[3]); return w; }
__device__ __forceinline__ int rowmap(int code, int n) {
  if (code == 1) { if (n < 512 || n >= 1536) return n; const int blk = n & ~255, c = n & 255; return blk + 128 * ((c >> 5) & 1) + 32 * (c >> 6) + (c & 31); }
  if (code == 2) return 256 * (n >> 7) + (n & 127);
  if (code == 3) return 256 * (n >> 7) + 128 + (n & 127);
  return n;
}
__device__ __forceinline__ void transpose_item(const float* W, int K, int N, bf16_t* WT, int code, LAS unsigned char* scr, int item, int lane) {
  const int nblk = N / 64, kb = item / nblk, nb = item % nblk, k0 = 64 * kb, n0 = 64 * nb;
  const int q = lane >> 4, a = lane & 15;
  f32x4 v[16];
  const float* src = W + (size_t)(k0 + 2 * q) * N + n0 + 4 * a;
#pragma unroll
  for (int i = 0; i < 16; ++i) v[i] = *(const f32x4*)(src + (size_t)((i & 1) + 8 * (i >> 1)) * N);
#pragma unroll
  for (int ii = 0; ii < 8; ++ii) { const int dsw = q + 4 * (ii ^ (a & 7));
#pragma unroll
    for (int j = 0; j < 4; ++j) *(LAS unsigned*)(scr + (4 * a + j) * 128 + 4 * dsw) = cvt_pk_bf16(v[2 * ii][j], v[2 * ii + 1][j]); }
  asm volatile("s_waitcnt lgkmcnt(0)" ::: "memory");
  const int c = lane & 7;
#pragma unroll
  for (int jj = 0; jj < 8; ++jj) { const int n = (lane >> 3) + 8 * jj, cs = c ^ ((n >> 2) & 7);
    const u32x4 o = *(const LAS u32x4*)(scr + n * 128 + 16 * cs);
    *(u32x4*)(WT + (size_t)rowmap(code, n0 + n) * K + k0 + 8 * c) = o; }
  asm volatile("s_waitcnt lgkmcnt(0)" ::: "memory");
}
__device__ __forceinline__ void transpose_item8(const float* W, int K, int N, unsigned char* WT, int code, float scale, LAS unsigned char* scr, int item, int lane) {
  const int nblk = N / 64, kb = item / nblk, nb = item % nblk, k0 = 64 * kb, n0 = 64 * nb;
  const int q = lane >> 4, a = lane & 15;
  f32x4 v[16];
  const float* src = W + (size_t)(k0 + 4 * q) * N + n0 + 4 * a;
#pragma unroll
  for (int i = 0; i < 16; ++i) v[i] = *(const f32x4*)(src + (size_t)((i & 3) + 16 * (i >> 2)) * N);
#pragma unroll
  for (int ib = 0; ib < 4; ++ib) { const int dsw = q + 4 * (ib ^ (a & 3));
#pragma unroll
    for (int j = 0; j < 4; ++j) { int w = 0; w = __builtin_amdgcn_cvt_pk_fp8_f32(v[4 * ib][j] * scale, v[4 * ib + 1][j] * scale, w, false); w = __builtin_amdgcn_cvt_pk_fp8_f32(v[4 * ib + 2][j] * scale, v[4 * ib + 3][j] * scale, w, true);
      *(LAS int*)(scr + (4 * a + j) * 64 + 4 * dsw) = w; } }
  asm volatile("s_waitcnt lgkmcnt(0)" ::: "memory");
  const int c = lane & 3;
#pragma unroll
  for (int jj = 0; jj < 4; ++jj) { const int n = (lane >> 2) + 16 * jj, cs = c ^ ((n >> 2) & 3);
    const u32x4 o = *(const LAS u32x4*)(scr + n * 64 + 16 * cs);
    *(u32x4*)(WT + (size_t)rowmap(code, n0 + n) * K + k0 + 16 * c) = o; }
  asm volatile("s_waitcnt lgkmcnt(0)" ::: "memory");
}
constexpr int IT_WIN = 512, IT_GLU = 64, IT_MIX = 256, IT_FOUR = 256, IT_ROUT = 32, IT_SMALL = IT_WIN + IT_GLU + IT_MIX + IT_FOUR + IT_ROUT, IT_EXP = 192;
__device__ __forceinline__ void small_item(const Ctx& X, LAS unsigned char* scr, int it) {
  const Args& a = *X.a; unsigned char* ws = X.ws;
  if (it < IT_WIN) { transpose_item(a.in[IN_WIN], 1024, 2048, (bf16_t*)(ws + WS_WIN_T), 1, scr, it, X.lane); return; } it -= IT_WIN;
  if (it < IT_GLU) { transpose_item(a.in[IN_WGLU], 512, 512, (bf16_t*)(ws + WS_WGLU_T), 0, scr, it, X.lane); return; } it -= IT_GLU;
  if (it < IT_MIX) { transpose_item(a.in[IN_WMIX], 1024, 1024, (bf16_t*)(ws + WS_WMIX_T), 0, scr, it, X.lane); return; } it -= IT_MIX;
  if (it < IT_FOUR) { transpose_item(a.in[IN_WFOUR], 1024, 1024, (bf16_t*)(ws + WS_WFOUR_T), 0, scr, it, X.lane); return; } it -= IT_FOUR;
  { const int l = it >> 4; transpose_item(a.in[IN_WROUT] + (size_t)l * 1024 * 64, 1024, 64, (bf16_t*)(ws + WS_WROUT_T) + (size_t)l * 64 * 1024, 0, scr, it & 15, X.lane); }
}
__device__ __forceinline__ void expert_item(const Ctx& X, LAS unsigned char* scr, int layer, int it) {
  const Args& a = *X.a; const int e = it / IT_EXP, r = it % IT_EXP;
  bf16_t* gu = (bf16_t*)(X.ws + (layer == 0 ? WS_WEXP + (size_t)e * EXP_STRIDE : WS_WEXP1 + (size_t)e * EXP1_STRIDE));
  bf16_t* dt = (bf16_t*)(X.ws + (layer == 0 ? WS_WEXP + (size_t)e * EXP_STRIDE + EXP_DOFF : WS_WEXP1 + (size_t)e * EXP1_STRIDE + EXP1_DOFF));
  const float *wg, *wu, *wd;
  if (e < 64) { const size_t o = ((size_t)layer * 64 + e) * 262144; wg = a.in[IN_WEG] + o; wu = a.in[IN_WEU] + o; wd = a.in[IN_WED] + o; }
  else { const size_t o = (size_t)layer * 262144; wg = a.in[IN_WSG] + o; wu = a.in[IN_WSU] + o; wd = a.in[IN_WSD] + o; }
  if (r < 64) transpose_item8(wg, 1024, 256, (unsigned char*)gu, 2, 32.f, scr, r, X.lane);
  else if (r < 128) transpose_item8(wu, 1024, 256, (unsigned char*)gu, 3, 32.f, scr, r - 64, X.lane);
  else transpose_item(wd, 256, 1024, dt, 0, scr, r - 128, X.lane);
}
__device__ __forceinline__ void transpose_work(const Ctx& X, unsigned* ctr, int first_small, int n_small, int layer, int n_exp_items, unsigned* done = nullptr, unsigned need = 0u) {
  LAS unsigned char* scr = X.lds + X.wave * 8192;
  volatile LAS int* shb = (volatile LAS int*)(X.lds + LDS_MISC_OFF + 1024);
  const int total = n_small + n_exp_items;
  const int per = done ? 1 : 4;
  for (;;) {
    __syncthreads();
    if (X.tid == 0) { int b = total; if (!done || __hip_atomic_load(done, __ATOMIC_RELAXED, __HIP_MEMORY_SCOPE_AGENT) < need) b = (int)atomicAdd(ctr, (unsigned)(8 * per)); shb[0] = b; }
    __syncthreads();
    const int base = shb[0];
    if (base >= total) break;
    for (int k = 0; k < per; ++k) { const int it = base + X.wave * per + k; if (it >= total) break;
      if (it < n_small) small_item(X, scr, first_small + it); else expert_item(X, scr, layer, it - n_small); }
  }
}

__device__ __forceinline__ void p0_adaln(const Ctx& X, int it) {
  const Args& a = *X.a; const int layer = it / 48, ct = it % 48, col = ct * 128 + X.lane;
  LAS float* sl = (LAS float*)X.lds;
  for (int i = X.tid; i < 2048; i += NTHR) { const float v = i < 1024 ? a.in[IN_C][i] : a.in[IN_CCTX][i - 1024]; sl[i] = v / (1.f + __expf(-v)); }
  __syncthreads();
  const float* W = a.in[IN_WADA] + (size_t)layer * 1024 * 6144 + col;
  float a0 = 0.f, a1 = 0.f, b0 = 0.f, b1 = 0.f; const int k0 = X.wave * 128;
#pragma unroll 16
  for (int k = 0; k < 128; ++k) { const float w0 = W[(size_t)(k0 + k) * 6144], w1 = W[(size_t)(k0 + k) * 6144 + 64]; const float s0 = sl[k0 + k], s1 = sl[1024 + k0 + k];
    a0 += s0 * w0; a1 += s1 * w0; b0 += s0 * w1; b1 += s1 * w1; }
  LAS float* red = sl + 2048;
  red[(X.wave * 128 + X.lane) * 2] = a0; red[(X.wave * 128 + X.lane) * 2 + 1] = a1; red[(X.wave * 128 + 64 + X.lane) * 2] = b0; red[(X.wave * 128 + 64 + X.lane) * 2 + 1] = b1;
  __syncthreads();
  if (X.tid < 256) { const int l = X.tid & 127, v = X.tid >> 7; float s = 0.f;
#pragma unroll
    for (int w = 0; w < 8; ++w) s += red[(w * 128 + l) * 2 + v];
    s += a.in[IN_BADA][layer * 6144 + ct * 128 + l];
    float* mod = (float*)(X.ws + WS_MOD);
    if (layer == 0) mod[v * 6144 + ct * 128 + l] = s; else if (v == 0) mod[2 * 6144 + ct * 128 + l] = s; }
  __syncthreads();
}

__device__ __forceinline__ void p0_s5tables(const Ctx& X, int g, int part) {
  const Args& a = *X.a;
  LAS f32x2* POW = (LAS f32x2*)X.lds;
  LAS f32x2* BB = (LAS f32x2*)(X.lds + 33792);
  LAS f32x2* CC = (LAS f32x2*)(X.lds + 33792 + 16384);
  LAS float* KK = (LAS float*)(X.lds + 33792 + 32768);
  LAS float* DD = (LAS float*)(X.lds + 33792 + 32768 + 65536);
  const int tid = X.tid;
  if (tid < 128) {
    const int dir = tid >> 6, p = tid & 63, idx = (dir * 32 + g) * 64 + p;
    const float lr = fminf(a.in[IN_LRE][idx], -1e-4f), li = a.in[IN_LIM][idx], dt = expf(a.in[IN_LDT][dir * 32 + g]);
    for (int tau = 0; tau <= 32; ++tau) { const float mg = expf(lr * dt * (float)tau); float sn, cs; sincospif(li * dt * (float)tau * 0.318309886183790672f, &sn, &cs); POW[(dir * 33 + tau) * 64 + p] = (f32x2){mg * cs, mg * sn}; }
    const f32x2 l1 = POW[(dir * 33 + 1) * 64 + p], l32 = POW[(dir * 33 + 32) * 64 + p];
    if (part == 0) ((float2*)(X.ws + WS_LAML))[idx] = make_float2(l32.x, l32.y);
    const float nr = l1.x - 1.f, ni = l1.y, den = lr * lr + li * li, cr = (nr * lr + ni * li) / den, ci = (ni * lr - nr * li) / den;
    for (int c = 0; c < 16; ++c) { const float xr = a.in[IN_BRE][idx * 16 + c], xi = a.in[IN_BIM][idx * 16 + c]; BB[(dir * 64 + p) * 16 + c] = (f32x2){cr * xr - ci * xi, cr * xi + ci * xr}; }
  }
  for (int i = tid; i < 2048; i += NTHR) { const int dir = i >> 10, c = (i >> 6) & 15, p = i & 63; const int gi = ((dir * 32 + g) * 16 + c) * 64 + p; CC[i] = (f32x2){a.in[IN_CRE][gi], a.in[IN_CIM][gi]}; }
  if (tid < 16) DD[tid] = a.in[IN_S5D][g * 16 + tid];
  __syncthreads();
  for (int combo = tid; combo < 1024; combo += NTHR) {
    const int dir = combo >> 9, tau = (combo >> 4) & 31, c = combo & 15;
    float accv[16];
#pragma unroll
    for (int j = 0; j < 16; ++j) accv[j] = 0.f;
#pragma unroll 2
    for (int p = 0; p < 64; ++p) {
      const f32x2 cc = CC[(dir * 16 + c) * 64 + p], pw = POW[(dir * 33 + tau) * 64 + p];
      const float zr = cc.x * pw.x - cc.y * pw.y, zi = cc.x * pw.y + cc.y * pw.x;
      const LAS f32x4* bp = (const LAS f32x4*)(BB + (dir * 64 + p) * 16);
#pragma unroll
      for (int j = 0; j < 8; ++j) { const f32x4 b = bp[j]; accv[2 * j] += zr * b.x - zi * b.y; accv[2 * j + 1] += zr * b.z - zi * b.w; }
    }
#pragma unroll
    for (int j = 0; j < 4; ++j) *(LAS f32x4*)(KK + ((dir * 32 + tau) * 16 + c) * 16 + 4 * j) = (f32x4){accv[4 * j], accv[4 * j + 1], accv[4 * j + 2], accv[4 * j + 3]};
  }
  __syncthreads();
  bf16_t* TT = (bf16_t*)(X.ws + WS_TT) + (size_t)g * 512 * 768;
  for (int q = part * 12288 + tid; q < (part + 1) * 12288; q += NTHR) {
    const int row = q / 96, cc8 = q % 96, i = row >> 4, c = row & 15; f32x4 v0, v1;
    if (cc8 < 64) {
      const int s = cc8 >> 1, c0 = (cc8 & 1) * 8;
      const int dir = s < i ? 0 : 1, tau = s < i ? i - s : s - i;
      const LAS f32x4* kp = (const LAS f32x4*)(KK + ((dir * 32 + tau) * 16 + c) * 16 + c0);
      v0 = kp[0]; v1 = kp[1];
      if (s == i) { const LAS f32x4* k0p = (const LAS f32x4*)(KK + ((0 * 32 + 0) * 16 + c) * 16 + c0); v0 += k0p[0]; v1 += k0p[1];
        const float d = DD[c]; const int dj = c - c0;
        if (dj >= 0 && dj < 4) v0[dj] += d; else if (dj >= 4 && dj < 8) v1[dj - 4] += d; }
    } else {
      const int kk = (cc8 - 64) * 8, dir = kk >> 7, ri = (kk >> 6) & 1, p0 = kk & 63, tau = dir == 0 ? i + 1 : 32 - i;
      const LAS f32x4* cp = (const LAS f32x4*)(CC + (dir * 16 + c) * 64 + p0); const LAS f32x4* pp = (const LAS f32x4*)(POW + (dir * 33 + tau) * 64 + p0);
      float v[8];
#pragma unroll
      for (int j = 0; j < 4; ++j) { const f32x4 cc = cp[j], pw = pp[j];
        v[2 * j] = ri == 0 ? (cc.x * pw.x - cc.y * pw.y) : -(cc.x * pw.y + cc.y * pw.x); v[2 * j + 1] = ri == 0 ? (cc.z * pw.z - cc.w * pw.w) : -(cc.z * pw.w + cc.w * pw.z); }
      v0 = (f32x4){v[0], v[1], v[2], v[3]}; v1 = (f32x4){v[4], v[5], v[6], v[7]};
    }
    *(u32x4*)(TT + (size_t)row * 768 + cc8 * 8) = pack8(v0, v1);
  }
  bf16_t* WSm = (bf16_t*)(X.ws + WS_WS) + (size_t)g * 256 * 512;
  for (int q = part * 4096 + tid; q < (part + 1) * 4096; q += NTHR) {
    const int n = q >> 6, cc8 = q & 63, dir = n >> 7, ri = (n >> 6) & 1, p = n & 63, s = cc8 >> 1, c0 = (cc8 & 1) * 8, tau = dir == 0 ? 31 - s : s;
    const f32x2 pw = POW[(dir * 33 + tau) * 64 + p]; const LAS f32x4* bp = (const LAS f32x4*)(BB + (dir * 64 + p) * 16 + c0); float v[8];
#pragma unroll
    for (int j = 0; j < 4; ++j) { const f32x4 b = bp[j]; v[2 * j] = ri == 0 ? (pw.x * b.x - pw.y * b.y) : (pw.x * b.y + pw.y * b.x); v[2 * j + 1] = ri == 0 ? (pw.x * b.z - pw.y * b.w) : (pw.x * b.w + pw.y * b.z); }
    *(u32x4*)(WSm + (size_t)n * 512 + cc8 * 8) = pack8((f32x4){v[0], v[1], v[2], v[3]}, (f32x4){v[4], v[5], v[6], v[7]});
  }
  __syncthreads();
}

__device__ __forceinline__ void p0_dftconst(const Ctx& X, int idx) {
  for (int q = idx * NTHR + X.tid; q < 32768; q += 32 * NTHR) {
    float v[8]; bf16_t* dst;
    if (q < 16384) {
      const int R = q >> 5, c0 = (q & 31) * 8, ri = R >> 8, m = R & 255; dst = (bf16_t*)(X.ws + WS_DMT) + (size_t)R * 256 + c0;
#pragma unroll
      for (int j = 0; j < 8; ++j) { float s, c; sincospif((float)(((c0 + j) * m) & 255) * (1.f / 128.f), &s, &c); v[j] = ri == 0 ? c : -s; }
    } else if (q < 24576) {
      const int q2 = q - 16384, R = q2 >> 5, c0 = (q2 & 31) * 8, rip = R >> 7, ka = R & 127; dst = (bf16_t*)(X.ws + WS_W1) + (size_t)R * 256 + c0;
#pragma unroll
      for (int j = 0; j < 8; ++j) { const int C = c0 + j, ri = C >> 7, ta = C & 127; float s, c; sincospif((float)((ka * ta) & 127) * (1.f / 64.f), &s, &c);
        v[j] = (rip == ri) ? c : (rip == 0 ? s : -s); }
    } else {
      const int q2 = q - 24576, R = q2 >> 5, c0 = (q2 & 31) * 8; dst = (bf16_t*)(X.ws + WS_W2) + (size_t)R * 256 + c0;
#pragma unroll
      for (int j = 0; j < 8; ++j) { const int C = c0 + j, rip = C >> 7, tb = C & 127; float s, c; sincospif((float)((R * tb) & 127) * (1.f / 64.f), &s, &c);
        v[j] = R < 128 ? (rip == 0 ? c : s) * (1.f / 2048.f) : 0.f; }
    }
    u32x4 o; o.x = cvt_pk_bf16(v[0], v[1]); o.y = cvt_pk_bf16(v[2], v[3]); o.z = cvt_pk_bf16(v[4], v[5]); o.w = cvt_pk_bf16(v[6], v[7]);
    *(u32x4*)dst = o;
  }
}

__device__ __forceinline__ void phase_prep(const Ctx& X, int rep) {
  const int c = X.c;
  if (c < 96) p0_adaln(X, c);
  else if (c < 224) p0_s5tables(X, (c - 96) >> 2, (c - 96) & 3);
  else p0_dftconst(X, c - 224);
  __syncthreads();
  unsigned* ctl = (unsigned*)(X.ws + WS_CTL);
  transpose_work(X, ctl + CW_DQ0 + 128 * rep, 0, IT_SMALL, (X.a->flags & 2) ? 1 : 0, (X.a->flags & FLAG_SKIP_EXPERTS) ? 0 : 65 * IT_EXP);
}

__device__ __forceinline__ void modulate_row(const float* hrow, const float* shift, const float* scale, bf16_t* orow, int lane) {
  const f32x4* xr = (const f32x4*)hrow + lane; f32x4 v[4]; float ss = 0.f;
#pragma unroll
  for (int j = 0; j < 4; ++j) { v[j] = xr[64 * j]; ss += (v[j].x * v[j].x + v[j].y * v[j].y) + (v[j].z * v[j].z + v[j].w * v[j].w); }
  const float r = rsqrtf(wave_sum(ss) * (1.f / 1024.f) + 1e-6f);
  u32x2* o8 = (u32x2*)orow + lane;
#pragma unroll
  for (int j = 0; j < 4; ++j) { const f32x4 sh = ((const f32x4*)shift)[lane + 64 * j], sc = ((const f32x4*)scale)[lane + 64 * j];
    u32x2 w; w.x = cvt_pk_bf16(v[j].x * r * (1.f + sc.x) + sh.x, v[j].y * r * (1.f + sc.y) + sh.y); w.y = cvt_pk_bf16(v[j].z * r * (1.f + sc.z) + sh.z, v[j].w * r * (1.f + sc.w) + sh.w);
    o8[64 * j] = w; }
}
__device__ __forceinline__ void phase_mod0(const Ctx& X) {
  const Args& a = *X.a; const float* mod = (const float*)(X.ws + WS_MOD); bf16_t* A0 = (bf16_t*)(X.ws + WS_A0);
  const int gw = X.c * NWAVES + X.wave, NGW = X.G * NWAVES;
  for (int r = gw; r < NROW; r += NGW) {
    if (r < TOK) modulate_row(a.in[IN_X] + (size_t)r * 1024, mod, mod + 1024, A0 + (size_t)r * 1024, X.lane);
    else modulate_row(a.in[IN_CTX] + (size_t)(r - TOK) * 1024, mod + 6144, mod + 6144 + 1024, A0 + (size_t)r * 1024, X.lane);
  }
}


struct G1 {
  static constexpr bool PERM = true; static constexpr bool F8 = false; static constexpr int SCALE_B = 0x7A7A7A7A; static constexpr bool CONTIG = false; static constexpr bool ALIGN = true; static constexpr bool LINA = true, LINB = true; __device__ __forceinline__ size_t halfA() const { return 128u * 2048u; } __device__ __forceinline__ size_t halfB() const { return 128u * 2048u; } int K, nunits; unsigned char* ws; const float* qg; const float* kg;
  __device__ __forceinline__ void decode(int w, Unit& u) const { if (w < 390) { u.a = 0; u.pm = w / 6; u.pn = w % 6; } else { const int w2 = w - 390; u.a = 1; u.pm = w2 & 1; u.pn = w2 >> 1; } u.b = 0; }
  __device__ __forceinline__ const char* baseA(const Unit& u) const { return (const char*)ws + (u.a == 0 ? WS_A0 : WS_WIN_T + (size_t)1536 * 2048); }
  __device__ __forceinline__ const char* baseB(const Unit& u) const { return (const char*)ws + (u.a == 0 ? WS_WIN_T : WS_A0); }
  __device__ __forceinline__ unsigned rowA(const Unit& u, int r) const { return (unsigned)(u.pm * 256 + r) * 2048u; }
  __device__ __forceinline__ unsigned rowB(const Unit& u, int r) const { return (unsigned)(u.pn * 256 + r) * 2048u; }
  __device__ __forceinline__ void epi(const Acc& acc, const Unit& u, int wr, int wc, int fr, int fq) const {
    if (u.a == 1) {
      bf16_t* VT = (bf16_t*)(ws + WS_VT);
#pragma unroll
      for (int ai = 0; ai < 2; ++ai)
#pragma unroll
        for (int m = 0; m < 4; ++m) { const int dd = u.pm * 256 + ai * 128 + wr * 64 + m * 16 + fr, head = dd >> 6, d = dd & 63;
#pragma unroll
          for (int bj = 0; bj < 2; ++bj) { const int t0 = u.pn * 256 + bj * 128 + wc * 32 + 8 * fq, kr = t0 >> 6, cg = (t0 >> 3) & 7;
            *(u32x4*)(VT + ((((size_t)(head * 260 + kr) * 8 + cg) * 64 + d) * 8)) = pack8(acc[ai][bj][m][0], acc[ai][bj][m][1]); } }
      return;
    }
    if (u.pn < 2) {
      bf16_t* AS5 = (bf16_t*)(ws + WS_AS5);
#pragma unroll
      for (int ai = 0; ai < 2; ++ai)
#pragma unroll
        for (int m = 0; m < 4; ++m) { const int row = u.pm * 256 + ai * 128 + wr * 64 + m * 16 + fr; int crow, s;
          if (row < TOK) { crow = row >> 5; s = row & 31; } else { const int j = row - TOK; crow = 512 + (j >> 5); s = j & 31; }
#pragma unroll
          for (int bj = 0; bj < 2; ++bj) { const int g = 16 * u.pn + 8 * bj + 2 * wc + (fq >> 1), c0 = 8 * (fq & 1);
            *(u32x4*)(AS5 + ((size_t)(g * 768 + crow) * 768 + s * 16 + c0)) = pack8(acc[ai][bj][m][0], acc[ai][bj][m][1]); } }
      return;
    }
    const bool isq = u.pn < 4;
    if (isq && u.pm == 64) return;
    const int head = 4 * ((u.pn - 2) & 1) + wc; const float* gain = isq ? qg : kg;
    bf16_t* dst = isq ? (bf16_t*)(ws + WS_Q) : (bf16_t*)(ws + WS_K);
    f32x4 gv[2][2];
#pragma unroll
    for (int bj = 0; bj < 2; ++bj) { gv[bj][0] = *(const f32x4*)(gain + 32 * bj + 8 * fq); gv[bj][1] = *(const f32x4*)(gain + 32 * bj + 8 * fq + 4); }
#pragma unroll
    for (int ai = 0; ai < 2; ++ai)
#pragma unroll
      for (int m = 0; m < 4; ++m) { const int row = u.pm * 256 + ai * 128 + wr * 64 + m * 16 + fr; float ss = 0.f;
#pragma unroll
        for (int bj = 0; bj < 2; ++bj)
#pragma unroll
          for (int n = 0; n < 2; ++n) { const f32x4 x = acc[ai][bj][m][n]; ss += (x[0] * x[0] + x[1] * x[1]) + (x[2] * x[2] + x[3] * x[3]); }
        ss += sx(ss, 16); ss += sx(ss, 32);
        const float rinv = rsqrtf(ss * (1.f / 64.f) + 1e-6f);
#pragma unroll
        for (int bj = 0; bj < 2; ++bj) { const f32x4 v0 = acc[ai][bj][m][0] * rinv * gv[bj][0], v1 = acc[ai][bj][m][1] * rinv * gv[bj][1];
          if (isq) *(u32x4*)(dst + (size_t)row * 512 + head * 64 + 32 * bj + 8 * fq) = pack8(v0, v1);
          else { const int kr = row >> 6, cg = (row >> 3) & 7, k8 = row & 7, ks = 2 * bj + (fq >> 1), hh2 = fq & 1;
            *(u32x4*)(dst + (((((size_t)(head * 260 + kr) * 8 + cg) * 4 + ks) * 8 + k8) * 2 + hh2) * 8) = pack8(v0, v1); } } }
  }
};

struct G2 {
  static constexpr bool PERM = true; static constexpr bool F8 = false; static constexpr int SCALE_B = 0x7A7A7A7A; static constexpr bool CONTIG = false; static constexpr bool ALIGN = true; static constexpr bool LINA = true, LINB = true; __device__ __forceinline__ size_t halfA() const { return 128u * 1536u; } __device__ __forceinline__ size_t halfB() const { return 128u * 1024u; } int K, nunits; unsigned char* ws;
  __device__ __forceinline__ void decode(int w, Unit& u) const { u.a = w / 3; u.pm = w % 3; u.pn = 0; u.b = 0; }
  __device__ __forceinline__ const char* baseA(const Unit& u) const { return (const char*)ws + WS_AS5 + (size_t)u.a * 768 * 768 * 2; }
  __device__ __forceinline__ const char* baseB(const Unit& u) const { return (const char*)ws + WS_WS + (size_t)u.a * 256 * 512 * 2; }
  __device__ __forceinline__ unsigned rowA(const Unit& u, int r) const { return (unsigned)(u.pm * 256 + r) * 1536u; }
  __device__ __forceinline__ unsigned rowB(const Unit& u, int r) const { return (unsigned)r * 1024u; }
  __device__ __forceinline__ void epi(const Acc& acc, const Unit& u, int wr, int wc, int fr, int fq) const {
    float* SST = (float*)(ws + WS_SST) + (size_t)u.a * 768 * 256;
#pragma unroll
    for (int ai = 0; ai < 2; ++ai)
#pragma unroll
      for (int m = 0; m < 4; ++m) { const int crow = u.pm * 256 + ai * 128 + wr * 64 + m * 16 + fr; if (crow >= 520) continue;
#pragma unroll
        for (int bj = 0; bj < 2; ++bj) { float* p = SST + (size_t)crow * 256 + bj * 128 + wc * 32 + 8 * fq; *(f32x4*)p = acc[ai][bj][m][0]; *(f32x4*)(p + 4) = acc[ai][bj][m][1]; } }
  }
};

struct G3 {
  static constexpr bool PERM = true; static constexpr bool F8 = false; static constexpr int SCALE_B = 0x7A7A7A7A; static constexpr bool CONTIG = false; static constexpr bool ALIGN = true; static constexpr bool LINA = true, LINB = true; __device__ __forceinline__ size_t halfA() const { return 128u * 1536u; } __device__ __forceinline__ size_t halfB() const { return 128u * 1536u; } int K, nunits; unsigned char* ws;
  __device__ __forceinline__ void decode(int w, Unit& u) const { u.a = w >> 2; u.pm = (w >> 1) & 1; u.pn = w & 1; u.b = 0; }
  __device__ __forceinline__ const char* baseA(const Unit& u) const { return (const char*)ws + WS_AS5 + (size_t)u.a * 768 * 768 * 2; }
  __device__ __forceinline__ const char* baseB(const Unit& u) const { return (const char*)ws + WS_TT + (size_t)u.a * 512 * 768 * 2; }
  __device__ __forceinline__ unsigned rowA(const Unit& u, int r) const { return (unsigned)(u.pm * 256 + r) * 1536u; }
  __device__ __forceinline__ unsigned rowB(const Unit& u, int r) const { return (unsigned)(u.pn * 256 + r) * 1536u; }
  __device__ __forceinline__ void epi(const Acc& acc, const Unit& u, int wr, int wc, int fr, int fq) const {
    bf16_t* GB = (bf16_t*)(ws + WS_GB);
#pragma unroll
    for (int ai = 0; ai < 2; ++ai)
#pragma unroll
      for (int m = 0; m < 4; ++m) { const int crow = u.pm * 256 + ai * 128 + wr * 64 + m * 16 + fr;
#pragma unroll
        for (int bj = 0; bj < 2; ++bj) { const int pp = u.pn * 256 + bj * 128 + wc * 32 + 8 * fq, i = pp >> 4, c0 = pp & 15; f32x4 v0 = acc[ai][bj][m][0], v1 = acc[ai][bj][m][1];
#pragma unroll
          for (int j = 0; j < 4; ++j) { v0[j] = gelu_tanh(v0[j]); v1[j] = gelu_tanh(v1[j]); }
          *(u32x4*)(GB + (size_t)(crow * 32 + i) * 512 + u.a * 16 + c0) = pack8(v0, v1); } }
  }
};

struct G4 {
  static constexpr bool PERM = true; static constexpr bool F8 = false; static constexpr int SCALE_B = 0x7A7A7A7A; static constexpr bool CONTIG = false; static constexpr bool ALIGN = true; static constexpr bool LINA = true, LINB = true; __device__ __forceinline__ size_t halfA() const { return 128u * 1024u; } __device__ __forceinline__ size_t halfB() const { return 128u * 1024u; } int K, nunits; unsigned char* ws; const float* bglu;
  __device__ __forceinline__ void decode(int w, Unit& u) const { u.pm = w >> 1; u.pn = w & 1; u.a = 0; u.b = 0; }
  __device__ __forceinline__ const char* baseA(const Unit&) const { return (const char*)ws + WS_GB; }
  __device__ __forceinline__ const char* baseB(const Unit&) const { return (const char*)ws + WS_WGLU_T; }
  __device__ __forceinline__ unsigned rowA(const Unit& u, int r) const { return (unsigned)(u.pm * 256 + r) * 1024u; }
  __device__ __forceinline__ unsigned rowB(const Unit& u, int r) const { return (unsigned)(u.pn * 256 + r) * 1024u; }
  __device__ __forceinline__ void epi(const Acc& acc, const Unit& u, int wr, int wc, int fr, int fq) const {
    const bf16_t* GB = (const bf16_t*)(ws + WS_GB); bf16_t* CC = (bf16_t*)(ws + WS_CONCAT);
#pragma unroll
    for (int bj = 0; bj < 2; ++bj) { const int col0 = u.pn * 256 + bj * 128 + wc * 32 + 8 * fq; const f32x4 b0 = *(const f32x4*)(bglu + col0), b1 = *(const f32x4*)(bglu + col0 + 4);
#pragma unroll
      for (int ai = 0; ai < 2; ++ai)
#pragma unroll
        for (int m = 0; m < 4; ++m) { const int row = u.pm * 256 + ai * 128 + wr * 64 + m * 16 + fr; const u32x4 gw = *(const u32x4*)(GB + (size_t)row * 512 + col0);
          f32x4 v0 = acc[ai][bj][m][0] + b0, v1 = acc[ai][bj][m][1] + b1;
          v0[0] = bf_lo(gw.x) * fast_sigmoid(v0[0]); v0[1] = bf_hi(gw.x) * fast_sigmoid(v0[1]); v0[2] = bf_lo(gw.y) * fast_sigmoid(v0[2]); v0[3] = bf_hi(gw.y) * fast_sigmoid(v0[3]);
          v1[0] = bf_lo(gw.z) * fast_sigmoid(v1[0]); v1[1] = bf_hi(gw.z) * fast_sigmoid(v1[1]); v1[2] = bf_lo(gw.w) * fast_sigmoid(v1[2]); v1[3] = bf_hi(gw.w) * fast_sigmoid(v1[3]);
          *(u32x4*)(CC + (size_t)row * 1024 + col0) = pack8(v0, v1); } }
  }
};

struct GRes {
  static constexpr bool PERM = true; static constexpr bool F8 = false; static constexpr int SCALE_B = 0x7A7A7A7A; static constexpr bool CONTIG = false; static constexpr bool ALIGN = true; static constexpr bool LINA = true, LINB = true;
  __device__ __forceinline__ size_t halfA() const { return 128u * 2048u; } __device__ __forceinline__ size_t halfB() const { return 128u * 2048u; }
  int K, nunits; const char* A; const char* Bt; const float* hin32; const bf16_t* hin16; bf16_t* hout; const float* gate; const float* bias;
  __device__ __forceinline__ void decode(int w, Unit& u) const { u.pm = w >> 2; u.pn = w & 3; u.a = 0; u.b = 0; }
  __device__ __forceinline__ const char* baseA(const Unit&) const { return A; }
  __device__ __forceinline__ const char* baseB(const Unit&) const { return Bt; }
  __device__ __forceinline__ unsigned rowA(const Unit& u, int r) const { return (unsigned)(u.pm * 256 + r) * 2048u; }
  __device__ __forceinline__ unsigned rowB(const Unit& u, int r) const { return (unsigned)(u.pn * 256 + r) * 2048u; }
  __device__ __forceinline__ void epi(const Acc& acc, const Unit& u, int wr, int wc, int fr, int fq) const {
#pragma unroll
    for (int bj = 0; bj < 2; ++bj) { const int col0 = u.pn * 256 + bj * 128 + wc * 32 + 8 * fq;
      const f32x4 g0 = *(const f32x4*)(gate + col0), g1 = *(const f32x4*)(gate + col0 + 4);
      f32x4 b0 = (f32x4){0.f, 0.f, 0.f, 0.f}, b1 = b0; if (bias) { b0 = *(const f32x4*)(bias + col0); b1 = *(const f32x4*)(bias + col0 + 4); }
#pragma unroll
      for (int ai = 0; ai < 2; ++ai)
#pragma unroll
        for (int m = 0; m < 4; ++m) { const size_t off = (size_t)(u.pm * 256 + ai * 128 + wr * 64 + m * 16 + fr) * 1024 + col0;
          f32x4 h0, h1;
          if (hin32) { h0 = *(const f32x4*)(hin32 + off); h1 = *(const f32x4*)(hin32 + off + 4); }
          else { const u32x4 w = *(const u32x4*)(hin16 + off); h0 = (f32x4){bf_lo(w.x), bf_hi(w.x), bf_lo(w.y), bf_hi(w.y)}; h1 = (f32x4){bf_lo(w.z), bf_hi(w.z), bf_lo(w.w), bf_hi(w.w)}; }
          *(u32x4*)(hout + off) = pack8(h0 + g0 * (acc[ai][bj][m][0] + b0), h1 + g1 * (acc[ai][bj][m][1] + b1)); } }
  }
};

__device__ __forceinline__ void build_moetab(const Ctx& X, int layer, LAS int* toff) {
  const unsigned* cnt = (const unsigned*)(X.ws + WS_CTL) + CW_CNT + layer * 128;
  LAS int* texp = toff + 256;
  LAS int* ntile = toff + 132;
  __syncthreads();
  if (X.tid < 64) ntile[X.tid] = ((int)__hip_atomic_load(cnt + X.tid, __ATOMIC_RELAXED, __HIP_MEMORY_SCOPE_AGENT) + 255) >> 8;
  __syncthreads();
  if (X.tid == 0) { int s = 0; for (int e = 0; e < 64; ++e) { toff[e] = s; s += ntile[e]; } toff[64] = s; toff[65] = s + 64; }
  __syncthreads();
  if (X.tid < 65) { const int e = X.tid; const int lo = toff[e], hi = toff[e + 1]; for (int t = lo; t < hi && t < 704; ++t) texp[t] = e; }
  __syncthreads();
}
__device__ __forceinline__ int find_expert(const LAS int* toff, int ti) { return toff[256 + ti]; }

struct G6 {
  static constexpr bool PERM = true; static constexpr bool F8 = true; static constexpr int SCALE_B = 0x7A7A7A7A; static constexpr bool CONTIG = false; static constexpr bool ALIGN = true; static constexpr bool LINA = false, LINB = true;
  __device__ __forceinline__ size_t halfA() const { return 0; } __device__ __forceinline__ size_t halfB() const { return 128u * 1024u; }
  int K, nunits; unsigned char* ws; const LAS int* toff; const LAS unsigned* tokt; const char* wbase; size_t wstride; int dry;
  __device__ __forceinline__ void decode(int w, Unit& u) const { const int ti = w >> 1; u.pn = w & 1; u.a = find_expert(toff, ti); u.pm = ti - toff[u.a]; u.b = ti; }
  __device__ __forceinline__ const char* baseA(const Unit&) const { return (const char*)ws + WS_F; }
  __device__ __forceinline__ const char* baseB(const Unit& u) const { return wbase + (size_t)u.a * wstride; }
  __device__ __forceinline__ unsigned rowA(const Unit& u, int r) const { return tokt[u.ord * 256 + r]; }
  __device__ __forceinline__ void build_tokt(const Ctx& X, LAS unsigned* tk) const {
    for (int i = 0; i * X.G + X.c < nunits; ++i) { Unit u; decode(xcd_remap(i * X.G + X.c, nunits), u);
      if (X.tid < 256) { const int idx = u.pm * 256 + X.tid; int tok = idx;
        if (u.a < 64) tok = ((const int*)(ws + WS_LTOK))[u.a * 16384 + idx];
        if (dry == 2) tok = (u.b * 256 + X.tid) & 16383;
        tk[i * 256 + X.tid] = (unsigned)tok * 1024u; } }
    __syncthreads();
  }
  __device__ __forceinline__ unsigned rowB(const Unit& u, int r) const { return (unsigned)(u.pn * 256 + r) * 1024u; }
  __device__ __forceinline__ void epi(const Acc& acc, const Unit& u, int wr, int wc, int fr, int fq) const {
    bf16_t* HID = (bf16_t*)(ws + WS_HID);
#pragma unroll
    for (int ai = 0; ai < 2; ++ai)
#pragma unroll
      for (int m = 0; m < 4; ++m) { const size_t hrow = (size_t)u.b * 256 + ai * 128 + wr * 64 + m * 16 + fr; f32x4 v0, v1;
#pragma unroll
        for (int j = 0; j < 4; ++j) { const float g0 = acc[ai][0][m][0][j] * 0.03125f, g1 = acc[ai][0][m][1][j] * 0.03125f; if (dry == 3) { v0[j] = g0 + acc[ai][1][m][0][j]; v1[j] = g1 + acc[ai][1][m][1][j]; } else { v0[j] = g0 * fast_sigmoid(g0) * (acc[ai][1][m][0][j] * 0.03125f); v1[j] = g1 * fast_sigmoid(g1) * (acc[ai][1][m][1][j] * 0.03125f); } }
        const u32x4 pk = pack8(v0, v1); if (!dry || pk.x == 0x12345678u) *(u32x4*)(HID + hrow * 256 + u.pn * 128 + wc * 32 + 8 * fq) = pk; }
  }
};
struct G7 {
  static constexpr bool PERM = true; static constexpr bool F8 = false; static constexpr int SCALE_B = 0x7A7A7A7A; static constexpr bool CONTIG = false; static constexpr bool ALIGN = true; static constexpr bool LINA = true, LINB = true;
  __device__ __forceinline__ size_t halfA() const { return 128u * 512u; } __device__ __forceinline__ size_t halfB() const { return 128u * 512u; }
  int K, nunits; unsigned char* ws; const LAS int* toff; int dry; const char* wbase; size_t wstride;
  __device__ __forceinline__ void decode(int w, Unit& u) const { const int ti = w >> 2; u.pn = w & 3; u.a = find_expert(toff, ti); u.pm = ti - toff[u.a]; u.b = ti; }
  __device__ __forceinline__ const char* baseA(const Unit&) const { return (const char*)ws + WS_HID; }
  __device__ __forceinline__ const char* baseB(const Unit& u) const { return wbase + (size_t)(dry == 2 ? 0 : u.a) * wstride; }
  __device__ __forceinline__ unsigned rowA(const Unit& u, int r) const { return (unsigned)((dry == 2 ? 0 : u.b) * 256 + r) * 512u; }
  __device__ __forceinline__ unsigned rowB(const Unit& u, int r) const { return (unsigned)((dry == 2 ? 0 : u.pn) * 256 + r) * 512u; }
  __device__ __forceinline__ void epi(const Acc& acc, const Unit& u, int wr, int wc, int fr, int fq) const {
    unsigned char* YAS = ws + WS_YAS;
#pragma unroll
    for (int ai = 0; ai < 2; ++ai)
#pragma unroll
      for (int m = 0; m < 4; ++m) { const size_t yrow = (size_t)u.b * 256 + ai * 128 + wr * 64 + m * 16 + fr;
#pragma unroll
        for (int bj = 0; bj < 2; ++bj) { const f32x4 v0 = acc[ai][bj][m][0], v1 = acc[ai][bj][m][1]; int w0 = 0, w1 = 0;
          w0 = __builtin_amdgcn_cvt_pk_fp8_f32(v0[0], v0[1], w0, false); w0 = __builtin_amdgcn_cvt_pk_fp8_f32(v0[2], v0[3], w0, true);
          w1 = __builtin_amdgcn_cvt_pk_fp8_f32(v1[0], v1[1], w1, false); w1 = __builtin_amdgcn_cvt_pk_fp8_f32(v1[2], v1[3], w1, true);
          if (!dry || w0 == 0x12345678) *(u32x2*)(YAS + yrow * 1024 + u.pn * 256 + bj * 128 + wc * 32 + 8 * fq) = (u32x2){(unsigned)w0, (unsigned)w1}; } }
  }
};

struct G8 {
  static constexpr bool PERM = true; static constexpr bool F8 = false; static constexpr int SCALE_B = 0x7A7A7A7A; static constexpr bool CONTIG = false; static constexpr bool ALIGN = true; static constexpr bool LINA = true, LINB = false; __device__ __forceinline__ size_t halfA() const { return 128u * 512u; } __device__ __forceinline__ size_t halfB() const { return 0; } int K, nunits; unsigned char* ws;
  __device__ __forceinline__ void decode(int w, Unit& u) const { u.pm = w >> 8; u.a = (w >> 6) & 3; u.pn = w & 63; u.b = 0; }
  __device__ __forceinline__ const char* baseA(const Unit&) const { return (const char*)ws + WS_DMT; }
  __device__ __forceinline__ const char* baseB(const Unit& u) const { return (const char*)ws + WS_A1 + (size_t)u.a * 512; }
  __device__ __forceinline__ unsigned rowA(const Unit& u, int r) const { return (unsigned)(u.pm * 256 + r) * 512u; }
  __device__ __forceinline__ unsigned rowB(const Unit& u, int r) const { const int n = u.pn * 256 + r; return (unsigned)(128 * (n & 127) + (n >> 7)) * 2048u; }
  __device__ __forceinline__ void epi(const Acc& acc, const Unit& u, int wr, int wc, int fr, int fq) const {
    bf16_t* X1 = (bf16_t*)(ws + WS_X1);
#pragma unroll
    for (int ai = 0; ai < 2; ++ai)
#pragma unroll
      for (int m = 0; m < 4; ++m) { const int mm = ai * 128 + wr * 64 + m * 16 + fr;
#pragma unroll
        for (int bj = 0; bj < 2; ++bj) { const int n0 = u.pn * 256 + bj * 128 + wc * 32 + 8 * fq, tb = n0 >> 7, ta0 = n0 & 127;
          *(u32x4*)(X1 + ((((size_t)(u.a * 256 + mm) * 128 + tb) * 2 + u.pm) * 128 + ta0)) = pack8(acc[ai][bj][m][0], acc[ai][bj][m][1]); } }
  }
};
struct G9 {
  static constexpr bool PERM = true; static constexpr bool F8 = false; static constexpr int SCALE_B = 0x7A7A7A7A; static constexpr bool CONTIG = false; static constexpr bool ALIGN = true; static constexpr bool LINA = true, LINB = true; __device__ __forceinline__ size_t halfA() const { return 128u * 512u; } __device__ __forceinline__ size_t halfB() const { return 128u * 512u; } int K, nunits; unsigned char* ws;
  __device__ __forceinline__ void decode(int w, Unit& u) const { u.pm = 0; u.pn = w; u.a = 0; u.b = 0; }
  __device__ __forceinline__ const char* baseA(const Unit&) const { return (const char*)ws + WS_W1; }
  __device__ __forceinline__ const char* baseB(const Unit&) const { return (const char*)ws + WS_X1; }
  __device__ __forceinline__ unsigned rowA(const Unit&, int r) const { return (unsigned)r * 512u; }
  __device__ __forceinline__ unsigned rowB(const Unit& u, int r) const { return (unsigned)(u.pn * 256 + r) * 512u; }
  __device__ __forceinline__ void epi(const Acc& acc, const Unit& u, int wr, int wc, int fr, int fq) const {
    bf16_t* X2 = (bf16_t*)(ws + WS_X2);
#pragma unroll
    for (int m = 0; m < 4; ++m) { const int ka = wr * 64 + m * 16 + fr;
#pragma unroll
      for (int bj = 0; bj < 2; ++bj) { const int n0 = u.pn * 256 + bj * 128 + wc * 32 + 8 * fq, gm = n0 >> 7, tb0 = n0 & 127; f32x4 r0, r1, i0, i1;
#pragma unroll
        for (int j = 0; j < 4; ++j) {
          { const float ang = (float)((ka * (tb0 + j)) & 16383) * (1.f / 16384.f), cs = __builtin_amdgcn_cosf(ang), sn = __builtin_amdgcn_sinf(ang); const float yr = acc[0][bj][m][0][j], yi = acc[1][bj][m][0][j]; r0[j] = yr * cs + yi * sn; i0[j] = yi * cs - yr * sn; }
          { const float ang = (float)((ka * (tb0 + 4 + j)) & 16383) * (1.f / 16384.f), cs = __builtin_amdgcn_cosf(ang), sn = __builtin_amdgcn_sinf(ang); const float yr = acc[0][bj][m][1][j], yi = acc[1][bj][m][1][j]; r1[j] = yr * cs + yi * sn; i1[j] = yi * cs - yr * sn; } }
        bf16_t* p = X2 + (((size_t)(gm * 128 + ka) * 2) * 128 + tb0); *(u32x4*)p = pack8(r0, r1); *(u32x4*)(p + 128) = pack8(i0, i1); } }
  }
};
struct G10 {
  static constexpr bool PERM = true; static constexpr bool F8 = false; static constexpr int SCALE_B = 0x7A7A7A7A; static constexpr bool CONTIG = false; static constexpr bool ALIGN = true; static constexpr bool LINA = true, LINB = false; __device__ __forceinline__ size_t halfA() const { return 128u * 512u; } __device__ __forceinline__ size_t halfB() const { return 0; } int K, nunits; unsigned char* ws;
  __device__ __forceinline__ void decode(int w, Unit& u) const { u.pm = 0; u.pn = w; u.a = 0; u.b = 0; }
  __device__ __forceinline__ const char* baseA(const Unit&) const { return (const char*)ws + WS_W2; }
  __device__ __forceinline__ const char* baseB(const Unit&) const { return (const char*)ws + WS_X2; }
  __device__ __forceinline__ unsigned rowA(const Unit&, int r) const { return (unsigned)r * 512u; }
  __device__ __forceinline__ unsigned rowB(const Unit& u, int r) const { const int n = u.pn * 256 + r, ka = n >> 10, gm = n & 1023; return (unsigned)(gm * 128 + ka) * 512u; }
  __device__ __forceinline__ void epi(const Acc& acc, const Unit& u, int wr, int wc, int fr, int fq) const {
    bf16_t* FB = (bf16_t*)(ws + WS_FB); const int ka = u.pn >> 2;
#pragma unroll
    for (int m = 0; m < 4; ++m) { const int kb = wr * 64 + m * 16 + fr; const size_t k = (size_t)ka + 128 * kb;
#pragma unroll
      for (int bj = 0; bj < 2; ++bj) { const int d0 = (u.pn & 3) * 256 + bj * 128 + wc * 32 + 8 * fq; *(u32x4*)(FB + k * 1024 + d0) = pack8(acc[0][bj][m][0], acc[0][bj][m][1]); } }
  }
};
}
namespace mk {
typedef float f32x16 __attribute__((ext_vector_type(16)));

__device__ __forceinline__ void phase_scan(const Ctx& X) {
  if (X.c >= 64) return;
  const int ch = X.c * 64 + (X.tid & 63), seg = X.tid >> 6;
  const int g = ch >> 7, dir = (ch >> 6) & 1, p = ch & 63;
  const float2 lam = ((const float2*)(X.ws + WS_LAML))[(dir * 32 + g) * 64 + p];
  const float* S = (const float*)(X.ws + WS_SST) + (size_t)g * 768 * 256 + dir * 128 + p;
  bf16_t* XP = (bf16_t*)(X.ws + WS_AS5) + (size_t)g * 768 * 768 + 512 + dir * 128 + p;
  LAS float* EX = (LAS float*)X.lds;
  const int j0 = seg * 65;
  float xr = 0.f, xi = 0.f;
  for (int b = 0; b < 65; b += 13) {
    float sr[13], si[13];
#pragma unroll
    for (int k = 0; k < 13; ++k) { const int j = j0 + b + k; const int row = dir == 0 ? (j < 8 ? 512 + j : j - 8) : 519 - j; sr[k] = S[(size_t)row * 256]; si[k] = S[(size_t)row * 256 + 64]; }
#pragma unroll
    for (int k = 0; k < 13; ++k) { const float nr = lam.x * xr - lam.y * xi + sr[k], ni = lam.x * xi + lam.y * xr + si[k]; xr = nr; xi = ni; }
  }
  EX[(seg * 64 + (X.tid & 63)) * 2] = xr; EX[(seg * 64 + (X.tid & 63)) * 2 + 1] = xi;
  float pr = 1.f, pi = 0.f;
  for (int k = 0; k < 65; ++k) { const float nr = pr * lam.x - pi * lam.y, ni = pr * lam.y + pi * lam.x; pr = nr; pi = ni; }
  __syncthreads();
  float cr = 0.f, ci = 0.f;
  for (int s2 = 0; s2 < seg; ++s2) { const float er = EX[(s2 * 64 + (X.tid & 63)) * 2], ei = EX[(s2 * 64 + (X.tid & 63)) * 2 + 1];
    const float nr = pr * cr - pi * ci + er, ni = pr * ci + pi * cr + ei; cr = nr; ci = ni; }
  xr = cr; xi = ci;
  for (int b = 0; b < 65; b += 13) {
    float sr[13], si[13];
#pragma unroll
    for (int k = 0; k < 13; ++k) { const int j = j0 + b + k; const int row = dir == 0 ? (j < 8 ? 512 + j : j - 8) : 519 - j; sr[k] = S[(size_t)row * 256]; si[k] = S[(size_t)row * 256 + 64]; }
#pragma unroll
    for (int k = 0; k < 13; ++k) { const int j = j0 + b + k; const int row = dir == 0 ? (j < 8 ? 512 + j : j - 8) : 519 - j;
      XP[(size_t)row * 768] = f2bf(xr); XP[(size_t)row * 768 + 64] = f2bf(xi);
      const float nr = lam.x * xr - lam.y * xi + sr[k], ni = lam.x * xi + lam.y * xr + si[k]; xr = nr; xi = ni; }
  }
  __syncthreads();
}

__device__ __forceinline__ void zero_lists(const Ctx& X) {
  u32x4* z = (u32x4*)(X.ws + WS_LTOK); unsigned zu_ = 0u; asm volatile("" : "+v"(zu_)); const u32x4 zero = (u32x4){zu_, zu_, zu_, zu_};
  for (int i = X.c * NTHR + X.tid; i < (int)(4 * MiB / 16); i += X.G * NTHR) z[i] = zero;
}
#define MFMA32(a, b, c) __builtin_amdgcn_mfma_f32_32x32x16_bf16((a), (b), (c), 0, 0, 0)
__device__ __forceinline__ void attn_unit(const Ctx& X, const LAS float* rpbl, int head, int tile) {
  const bf16_t* Q = (const bf16_t*)(X.ws + WS_Q); const bf16_t* Kb = (const bf16_t*)(X.ws + WS_K); const bf16_t* VT = (const bf16_t*)(X.ws + WS_VT);
  bf16_t* CCt = (bf16_t*)(X.ws + WS_CONCAT);
  const int lane = X.lane, ql = lane & 31, hh = lane >> 5;
  const int rp = tile >> 2, mt = tile & 3;
  const int r = 2 * rp + (ql >> 4), cq = 16 * mt + (ql & 15), tq = r * 64 + cq;
  const int r0q = min(max(r - 4, 0), 248), csq = min(max(cq - 8, 0), 48);
  const int rlo = min(max(2 * rp - 4, 0), 248), rhi = min(max(2 * rp - 3, 0), 248) + 7;
  const int csb = min(max(16 * mt - 8, 0), 32);
  const int nloc = rhi - rlo + 1;
  unsigned cmask = 0u;
#pragma unroll
  for (int k = 0; k < 32; ++k) cmask |= ((csb + k >= csq) && (csb + k <= csq + 15)) ? (1u << k) : 0u;
  bf16x8 qf[4];
#pragma unroll
  for (int ks = 0; ks < 4; ++ks) qf[ks] = *(const bf16x8*)(Q + (size_t)tq * 512 + head * 64 + 16 * ks + 8 * hh);
  const int kperm = (ql & ~12) | ((ql & 4) << 1) | ((ql & 8) >> 1);
  f32x16 o0, o1;
#pragma unroll
  for (int i = 0; i < 16; ++i) { o0[i] = 0.f; o1[i] = 0.f; }
  float lsum = 0.f;
  const float c1 = 0.125f * 1.44269504f, c2 = 8.f * 1.44269504f;
  const float* rp_h = nullptr; (void)rp_h;
  const size_t koff_lane = (size_t)(((kperm >> 3) * 4 * 8 + (kperm & 7)) * 2 + hh) * 8;
  const size_t voff_lane = (size_t)(hh * 64 + ql) * 8;
  bf16x8 kf[4], vf[2][2];
  { const int kr0 = rlo, cg0 = csb >> 3;
    const bf16_t* kp = Kb + ((size_t)(head * 260 + kr0) * 8 + cg0) * 512 + koff_lane; const bf16_t* vp = VT + ((size_t)(head * 260 + kr0) * 8 + cg0) * 512 + voff_lane;
#pragma unroll
    for (int ks = 0; ks < 4; ++ks) kf[ks] = *(const bf16x8*)(kp + ks * 128);
#pragma unroll
    for (int db = 0; db < 2; ++db)
#pragma unroll
      for (int s2 = 0; s2 < 2; ++s2) vf[db][s2] = *(const bf16x8*)(vp + db * 256 + s2 * 1024); }
  for (int b = 0; b < nloc + 8; ++b) {
    const bool loc = b < nloc;
    const int kr = rlo + b;
    bf16x8 kc[4], vc[2][2];
#pragma unroll
    for (int ks = 0; ks < 4; ++ks) kc[ks] = kf[ks];
#pragma unroll
    for (int db = 0; db < 2; ++db)
#pragma unroll
      for (int s2 = 0; s2 < 2; ++s2) vc[db][s2] = vf[db][s2];
    if (b + 1 < nloc + 8) { const int bn = b + 1; const int krn = bn < nloc ? rlo + bn : 256 + ((bn - nloc) >> 1), cgn = bn < nloc ? (csb >> 3) : 4 * ((bn - nloc) & 1);
      const bf16_t* kp = Kb + ((size_t)(head * 260 + krn) * 8 + cgn) * 512 + koff_lane; const bf16_t* vp = VT + ((size_t)(head * 260 + krn) * 8 + cgn) * 512 + voff_lane;
#pragma unroll
      for (int ks = 0; ks < 4; ++ks) kf[ks] = *(const bf16x8*)(kp + ks * 128);
#pragma unroll
      for (int db = 0; db < 2; ++db)
#pragma unroll
        for (int s2 = 0; s2 < 2; ++s2) vf[db][s2] = *(const bf16x8*)(vp + db * 256 + s2 * 1024); }
    f32x16 sacc;
#pragma unroll
    for (int i = 0; i < 16; ++i) sacc[i] = 0.f;
#pragma unroll
    for (int ks = 0; ks < 4; ++ks) sacc = MFMA32(kc[ks], qf[ks], sacc);
    float pv[16];
    if (loc) {
      const bool rowok = (kr >= r0q) && (kr <= r0q + 7);
      const int dr = min(max(kr - r + 7, 0), 14);
      const LAS float* bp = rpbl + (head * 15 + dr) * 31;
      const int dc0 = csb - cq + 15;
#pragma unroll
      for (int i = 0; i < 16; ++i) { const int kidx = 16 * (i >> 3) + 8 * hh + (i & 7);
        const bool ok = rowok && ((cmask >> kidx) & 1u);
        const float bias = bp[min(max(dc0 + kidx, 0), 30)];
        const float e = __builtin_amdgcn_exp2f(sacc[i] * c1 + bias * 1.44269504f - c2); pv[i] = ok ? e : 0.f; }
    } else {
#pragma unroll
      for (int i = 0; i < 16; ++i) pv[i] = __builtin_amdgcn_exp2f(sacc[i] * c1 - c2);
    }
    u32x4 p0, p1;
    p0.x = cvt_pk_bf16(pv[0], pv[1]); p0.y = cvt_pk_bf16(pv[2], pv[3]); p0.z = cvt_pk_bf16(pv[4], pv[5]); p0.w = cvt_pk_bf16(pv[6], pv[7]);
    p1.x = cvt_pk_bf16(pv[8], pv[9]); p1.y = cvt_pk_bf16(pv[10], pv[11]); p1.z = cvt_pk_bf16(pv[12], pv[13]); p1.w = cvt_pk_bf16(pv[14], pv[15]);
    lsum += (bf_lo(p0.x) + bf_hi(p0.x)) + (bf_lo(p0.y) + bf_hi(p0.y)) + (bf_lo(p0.z) + bf_hi(p0.z)) + (bf_lo(p0.w) + bf_hi(p0.w))
          + (bf_lo(p1.x) + bf_hi(p1.x)) + (bf_lo(p1.y) + bf_hi(p1.y)) + (bf_lo(p1.z) + bf_hi(p1.z)) + (bf_lo(p1.w) + bf_hi(p1.w));
    const bf16x8 pb0 = __builtin_bit_cast(bf16x8, p0), pb1 = __builtin_bit_cast(bf16x8, p1);
    o0 = MFMA32(vc[0][0], pb0, o0); o0 = MFMA32(vc[0][1], pb1, o0);
    o1 = MFMA32(vc[1][0], pb0, o1); o1 = MFMA32(vc[1][1], pb1, o1);
  }
  lsum += sx(lsum, 32);
  const float inv = 1.f / lsum;
  bf16_t* op = CCt + (size_t)tq * 1024 + 512 + head * 64 + 4 * hh;
#pragma unroll
  for (int gq = 0; gq < 4; ++gq) {
    u32x2 w0, w1;
    w0.x = cvt_pk_bf16(o0[4 * gq] * inv, o0[4 * gq + 1] * inv); w0.y = cvt_pk_bf16(o0[4 * gq + 2] * inv, o0[4 * gq + 3] * inv);
    w1.x = cvt_pk_bf16(o1[4 * gq] * inv, o1[4 * gq + 1] * inv); w1.y = cvt_pk_bf16(o1[4 * gq + 2] * inv, o1[4 * gq + 3] * inv);
    *(u32x2*)(op + 8 * gq) = w0; *(u32x2*)(op + 32 + 8 * gq) = w1;
  }
}
__device__ __forceinline__ void phase_attn(const Ctx& X) {
  LAS float* rpbl = (LAS float*)X.lds;
  zero_lists(X);
  for (int i = X.tid; i < 8 * 15 * 31; i += NTHR) rpbl[i] = X.a->in[IN_RPB][i];
  __syncthreads();
  const int gw = X.c * NWAVES + X.wave, NGW = X.G * NWAVES;
  for (int U = gw; U < 4096; U += NGW) attn_unit(X, rpbl, U >> 9, U & 511);
}

__device__ __forceinline__ void phase_router(const Ctx& X, int layer, int dry) {
  const float* mod = (const float*)(X.ws + WS_MOD) + (layer == 0 ? 0 : 2 * 6144);
  const float* shift = mod + 3072; const float* scale = mod + 4096;
  const bf16_t* h = (const bf16_t*)(X.ws + WS_HB); bf16_t* F = (bf16_t*)(X.ws + WS_F);
  unsigned* cntg = (unsigned*)(X.ws + WS_CTL) + CW_CNT + layer * 128;
  int* ltok = (int*)(X.ws + WS_LTOK); int* asg = (int*)(X.ws + WS_ASG);
  const bf16_t* WR = (const bf16_t*)(X.ws + WS_WROUT_T) + (size_t)layer * 64 * 1024;
  const float* rbias = X.a->in[IN_RBIAS] + layer * 64;
  constexpr int FROW = 2064;
  const int lane = X.lane, wave = X.wave, tid = X.tid;
  for (int tile = X.c; tile < TOK / 64; tile += X.G) {
    const int t0 = tile * 64;
    for (int rb4 = 0; rb4 < 2; ++rb4) {
      f32x4 v[4][4];
#pragma unroll
      for (int rr = 0; rr < 4; ++rr) { const u32x2* xr = (const u32x2*)(h + (size_t)(t0 + wave * 8 + rb4 * 4 + rr) * 1024) + lane;
#pragma unroll
        for (int j = 0; j < 4; ++j) { const u32x2 w = xr[64 * j]; v[rr][j] = (f32x4){bf_lo(w.x), bf_hi(w.x), bf_lo(w.y), bf_hi(w.y)}; } }
#pragma unroll
      for (int rr = 0; rr < 4; ++rr) {
        const int lr = wave * 8 + rb4 * 4 + rr, t = t0 + lr; float ss = 0.f;
#pragma unroll
        for (int j = 0; j < 4; ++j) ss += (v[rr][j].x * v[rr][j].x + v[rr][j].y * v[rr][j].y) + (v[rr][j].z * v[rr][j].z + v[rr][j].w * v[rr][j].w);
        const float r = rsqrtf(wave_sum(ss) * (1.f / 1024.f) + 1e-6f);
#pragma unroll
        for (int j = 0; j < 4; ++j) { const f32x4 f = v[rr][j] * r * (((const f32x4*)scale)[lane + 64 * j] + 1.f) + ((const f32x4*)shift)[lane + 64 * j];
          u32x2 w; w.x = cvt_pk_bf16(f.x, f.y); w.y = cvt_pk_bf16(f.z, f.w);
          if (!dry) { int w8 = 0; w8 = __builtin_amdgcn_cvt_pk_fp8_f32(f.x, f.y, w8, false); w8 = __builtin_amdgcn_cvt_pk_fp8_f32(f.z, f.w, w8, true);
            ((int*)((unsigned char*)F + (size_t)t * 1024))[lane + 64 * j] = w8; }
          *(LAS u32x2*)(X.lds + lr * FROW + (lane + 64 * j) * 8) = w; }
      }
    }
    __syncthreads();
    if (dry == 2) continue;
    f32x4 pl[4][4];
    { const int fr = lane & 15, fq = lane >> 4;
#pragma unroll
      for (int a = 0; a < 4; ++a)
#pragma unroll
        for (int b = 0; b < 4; ++b) pl[a][b] = (f32x4){0.f, 0.f, 0.f, 0.f};
      bf16x8 bq[4][4];
#pragma unroll
      for (int ks = 0; ks < 4; ++ks)
#pragma unroll
        for (int eb = 0; eb < 4; ++eb) bq[ks][eb] = *(const bf16x8*)(WR + (size_t)(eb * 16 + fr) * 1024 + wave * 128 + ks * 32 + fq * 8);
#pragma unroll
      for (int ks = 0; ks < 4; ++ks) {
        bf16x8 af[4];
#pragma unroll
        for (int rb = 0; rb < 4; ++rb) af[rb] = *(const LAS bf16x8*)(X.lds + (rb * 16 + fr) * FROW + (wave * 128 + ks * 32 + fq * 8) * 2);
#pragma unroll
        for (int rb = 0; rb < 4; ++rb)
#pragma unroll
          for (int eb = 0; eb < 4; ++eb) pl[rb][eb] = __builtin_amdgcn_mfma_f32_16x16x32_bf16(af[rb], bq[ks][eb], pl[rb][eb], 0, 0, 0);
      }
    }
    __syncthreads();
    { LAS float* PART = (LAS float*)X.lds;
      const int fr = lane & 15, fq = lane >> 4;
#pragma unroll
      for (int rb = 0; rb < 4; ++rb)
#pragma unroll
        for (int eb = 0; eb < 4; ++eb)
#pragma unroll
          for (int j = 0; j < 4; ++j) PART[(wave * 64 + rb * 16 + 4 * fq + j) * 64 + eb * 16 + fr] = pl[rb][eb][j];
      __syncthreads();
      float sum[8];
#pragma unroll
      for (int i = 0; i < 8; ++i) { float a = 0.f;
#pragma unroll
        for (int w = 0; w < 8; ++w) a += PART[w * 4096 + i * 512 + tid];
        sum[i] = a; }
      __syncthreads();
      LAS float* LG0 = (LAS float*)X.lds;
#pragma unroll
      for (int i = 0; i < 8; ++i) { const int o = i * 512 + tid; LG0[(o >> 6) * 65 + (o & 63)] = sum[i]; }
    }
    LAS float* LG = (LAS float*)X.lds;
    LAS float* GS = LG + 64 * 65;
    LAS float* SELV = GS + 512;
    LAS int* OUTE = (LAS int*)(SELV + 4096);
    LAS float* OUTS = (LAS float*)(OUTE + 512);
    LAS int* HIST = (LAS int*)(OUTS + 512);
    LAS int* BASE = HIST + 64;
    if (tid < 64) HIST[tid] = 0;
    __syncthreads();
    if (dry == 3) continue;
    const int tl = tid >> 3, grp = tid & 7;
    float v[8], sc[8];
    { float m1 = -INFINITY, m2 = -INFINITY;
#pragma unroll
      for (int j = 0; j < 8; ++j) { const float s = 1.f / (1.f + __expf(-LG[tl * 65 + grp * 8 + j])); sc[j] = s; v[j] = s + rbias[grp * 8 + j];
        if (v[j] > m1) { m2 = m1; m1 = v[j]; } else if (v[j] > m2) m2 = v[j]; }
      GS[tl * 8 + grp] = m1 + m2; }
    __syncthreads();
    bool keep;
    { const float mine = GS[tl * 8 + grp]; int rank = 0;
#pragma unroll
      for (int g2 = 0; g2 < 8; ++g2) { const float o = GS[tl * 8 + g2]; rank += (o > mine || (o == mine && g2 < grp)) ? 1 : 0; }
      keep = rank < 4;
#pragma unroll
      for (int j = 0; j < 8; ++j) SELV[tl * 64 + grp * 8 + j] = keep ? v[j] : -INFINITY; }
    __syncthreads();
    if (keep) {
      int rk[8];
#pragma unroll
      for (int j = 0; j < 8; ++j) rk[j] = 0;
      for (int e2 = 0; e2 < 64; ++e2) { const float o = SELV[tl * 64 + e2];
#pragma unroll
        for (int j = 0; j < 8; ++j) rk[j] += (o > v[j] || (o == v[j] && e2 < grp * 8 + j)) ? 1 : 0; }
#pragma unroll
      for (int j = 0; j < 8; ++j) if (rk[j] < 8) { OUTE[tl * 8 + rk[j]] = grp * 8 + j; OUTS[tl * 8 + rk[j]] = sc[j]; }
    }
    __syncthreads();
    { const int jj = tid & 7, e = OUTE[tl * 8 + jj]; const float s = OUTS[tl * 8 + jj];
      float sum = s; sum += sx(sum, 1); sum += sx(sum, 2); sum += sx(sum, 4);
      const float w = 2.5f * s / sum;
      const int sl = atomicAdd((int*)&HIST[e], 1);
      __syncthreads();
      const int t = t0 + tl;
      if (tid < 64) { const int n = HIST[tid]; BASE[tid] = (n && !dry) ? (int)atomicAdd(cntg + tid, (unsigned)n) : 0; }
      __syncthreads();
      const int slot = BASE[e] + sl;
      if (!dry) { ltok[(size_t)e * 16384 + slot] = t; } if (!dry) ((int2*)asg)[t * 8 + jj] = make_int2((e << 16) | slot, __float_as_int(w)); }
    __syncthreads();
  }
}

__device__ __forceinline__ void phase_combine(const Ctx& X, int layer, const LAS int* toff, int dry) {
  const float* mod = (const float*)(X.ws + WS_MOD) + (layer == 0 ? 0 : 2 * 6144);
  const float* gffn = mod + 5120;
  const float* nmod = (const float*)(X.ws + WS_MOD) + 2 * 6144;
  float* hout32 = X.a->h; bf16_t* hb = (bf16_t*)(X.ws + WS_HB); const unsigned char* YAS = X.ws + WS_YAS; const int* asg = (const int*)(X.ws + WS_ASG); bf16_t* A1 = (bf16_t*)(X.ws + WS_A1);
  const int gw = X.c * NWAVES + X.wave, NGW = X.G * NWAVES, lane = X.lane;
  for (int t0 = gw; t0 < TOK; t0 += 2 * NGW) {
    int yw[2][9][4]; f32x4 hv[2][4]; float wgt[2][8];
#pragma unroll
    for (int u = 0; u < 2; ++u) { const int t = t0 + u * NGW;
      int pos[9];
#pragma unroll
      for (int k = 0; k < 8; ++k) { const int2 a = ((const int2*)asg)[t * 8 + k]; pos[k] = toff[a.x >> 16] * 256 + (a.x & 0xffff); wgt[u][k] = __int_as_float(a.y); }
      pos[8] = toff[64] * 256 + t;
#pragma unroll
      for (int k = 0; k < 9; ++k) { const int* yr = (const int*)(YAS + (size_t)pos[k] * 1024) + lane;
#pragma unroll
        for (int j = 0; j < 4; ++j) yw[u][k][j] = yr[64 * j]; }
      const u32x2* hr = (const u32x2*)(hb + (size_t)t * 1024) + lane;
#pragma unroll
      for (int j = 0; j < 4; ++j) { const u32x2 w = hr[64 * j]; hv[u][j] = (f32x4){bf_lo(w.x), bf_hi(w.x), bf_lo(w.y), bf_hi(w.y)}; } }
#pragma unroll
    for (int u = 0; u < 2; ++u) { const int t = t0 + u * NGW;
      f32x4 acc[4];
#pragma unroll
      for (int j = 0; j < 4; ++j) acc[j] = (f32x4){0.f, 0.f, 0.f, 0.f};
#pragma unroll
      for (int k = 0; k < 9; ++k) { const float wk = k < 8 ? wgt[u][k] : 1.f;
#pragma unroll
        for (int j = 0; j < 4; ++j) { const int w = yw[u][k][j];
          acc[j].x += wk * __builtin_amdgcn_cvt_f32_fp8(w, 0); acc[j].y += wk * __builtin_amdgcn_cvt_f32_fp8(w, 1); acc[j].z += wk * __builtin_amdgcn_cvt_f32_fp8(w, 2); acc[j].w += wk * __builtin_amdgcn_cvt_f32_fp8(w, 3); } }
      f32x4 v[4]; float ss = 0.f;
#pragma unroll
      for (int j = 0; j < 4; ++j) { const f32x4 gt = ((const f32x4*)gffn)[lane + 64 * j]; v[j] = hv[u][j] + gt * acc[j];
        if (!dry) { if (layer == 0) ((u32x2*)(hb + (size_t)t * 1024))[lane + 64 * j] = (u32x2){cvt_pk_bf16(v[j].x, v[j].y), cvt_pk_bf16(v[j].z, v[j].w)}; else ((f32x4*)(hout32 + (size_t)t * 1024))[lane + 64 * j] = v[j]; }
        ss += (v[j].x * v[j].x + v[j].y * v[j].y) + (v[j].z * v[j].z + v[j].w * v[j].w); }
      if (layer == 0) {
        const float r = rsqrtf(wave_sum(ss) * (1.f / 1024.f) + 1e-6f);
#pragma unroll
        for (int j = 0; j < 4; ++j) { const f32x4 sh = ((const f32x4*)nmod)[lane + 64 * j], sc = ((const f32x4*)(nmod + 1024))[lane + 64 * j];
          u32x2 w; w.x = cvt_pk_bf16(v[j].x * r * (1.f + sc.x) + sh.x, v[j].y * r * (1.f + sc.y) + sh.y); w.y = cvt_pk_bf16(v[j].z * r * (1.f + sc.z) + sh.z, v[j].w * r * (1.f + sc.w) + sh.w);
          if (!dry) ((u32x2*)(A1 + (size_t)t * 1024))[lane + 64 * j] = w; }
      }
    }
  }
}

constexpr int NPHASE = 21;
template <bool SP2>
__global__ void __launch_bounds__(NTHR, 2) mk_fwd(Args args) {
  extern __shared__ __attribute__((aligned(16))) unsigned char lds_raw[];
  Ctx X; X.lds = (LAS unsigned char*)lds_raw; X.a = &args; X.ws = args.ws; X.tid = threadIdx.x; X.lane = X.tid & 63; X.wave = __builtin_amdgcn_readfirstlane(X.tid >> 6);
  X.G = gridDim.x; X.c = blockIdx.x;
  const int wave_s = X.wave;
  volatile LAS unsigned* MISC = (volatile LAS unsigned*)(X.lds + LDS_MISC_OFF);
  LAS int* TOFF = (LAS int*)(X.lds + LDS_MISC_OFF + 64);
  if (X.tid < 16) MISC[X.tid] = 0u;
  __syncthreads();
  unsigned* ctl = (unsigned*)(X.ws + WS_CTL);
  const int lo = args.ph_lo, hi = args.ph_hi;
  const bool multi = (hi - lo) > 1;
  XcdBarrier bar; bar.bar = ctl + CW_BAR; bar.x = 0; bar.st = nullptr;
  if (multi) bar = xcd_barrier_post(ctl + CW_BAR, MISC, X.tid);
  LAS unsigned char* lds = X.lds;
  unsigned char* ws = X.ws;
  const float* mod = (const float*)(ws + WS_MOD); (void)mod;
#ifndef PH_MASK
#define PH_MASK 0x1fffffull
#endif
#define IN(k) ((((unsigned long long)PH_MASK >> (k)) & 1ull) && lo <= (k) && (k) < hi)
#define SEAM(k) do { if (IN(k) && IN((k) + 1)) xcd_barrier(bar, X.tid); } while (0)
#ifndef REP_MASK
#define REP_MASK 0ull
#endif
#define REPS(k) ((int)(((unsigned long long)REP_MASK >> (k)) & 1ull))
#define FILL(ph, nb) do { if (!(args.flags & FLAG_SKIP_EXPERTS) && multi) { if (X.c < (nb)) { __syncthreads(); if (X.tid == 0) atomicAdd(ctl + CW_DONE + 64 * (ph), 1u); } \
    else transpose_work(X, ctl + CW_DQ1, 0, 0, 1, 65 * IT_EXP, ctl + CW_DONE + 64 * (ph), (unsigned)(nb)); } } while (0)
#define LAUNDER() do { int w0_ = wave_s; asm volatile("" : "+s"(w0_)); unsigned zl_ = 0u; asm volatile("" : "+v"(zl_)); int l_ = (int)__builtin_amdgcn_mbcnt_hi(~0u, __builtin_amdgcn_mbcnt_lo(~0u, zl_)); X.wave = w0_; X.lane = l_; X.tid = w0_ * 64 + l_; \
    size_t z0_ = 0; asm volatile("" : "+s"(z0_)); unsigned char* w_ = args.ws + z0_; X.ws = w_; ws = w_; mod = (const float*)(w_ + WS_MOD); } while (0)
  if (IN(0)) for (int rep_ = 0; rep_ <= REPS(0); ++rep_) { if (rep_) xcd_barrier(bar, X.tid); LAUNDER(); phase_prep(X, rep_); } SEAM(0);
#ifdef EXTRA_BARS
  if (multi) for (int eb_ = 0; eb_ < EXTRA_BARS; ++eb_) xcd_barrier(bar, X.tid);
#endif
  if (IN(1)) for (int rep_ = 0; rep_ <= REPS(1); ++rep_) { if (rep_) xcd_barrier(bar, X.tid); LAUNDER(); phase_mod0(X); } SEAM(1);
  if (IN(2)) for (int rep_ = 0; rep_ <= REPS(2); ++rep_) { if (rep_) xcd_barrier(bar, X.tid); LAUNDER(); G1 p; p.K = 1024; p.nunits = 520; p.ws = ws; p.qg = args.in[IN_QG]; p.kg = args.in[IN_KG]; gemm_phase<G1, SP2>(lds, p, X.G, X.c, X.tid); FILL(2, 8); } SEAM(2);
  if (IN(3)) for (int rep_ = 0; rep_ <= REPS(3); ++rep_) { if (rep_) xcd_barrier(bar, X.tid); LAUNDER(); G2 p; p.K = 512; p.nunits = 96; p.ws = ws; gemm_phase<G2, SP2>(lds, p, X.G, X.c, X.tid); FILL(3, 96); } SEAM(3);
  if (IN(4)) for (int rep_ = 0; rep_ <= REPS(4); ++rep_) { if (rep_) xcd_barrier(bar, X.tid); LAUNDER(); phase_scan(X); FILL(4, 64); } SEAM(4);
  if (IN(5)) for (int rep_ = 0; rep_ <= REPS(5); ++rep_) { if (rep_) xcd_barrier(bar, X.tid); LAUNDER(); G3 p; p.K = 768; p.nunits = 128; p.ws = ws; gemm_phase<G3, SP2>(lds, p, X.G, X.c, X.tid); FILL(5, 128); } SEAM(5);
  if (IN(6)) for (int rep_ = 0; rep_ <= REPS(6); ++rep_) { if (rep_) xcd_barrier(bar, X.tid); LAUNDER(); G4 p; p.K = 512; p.nunits = 128; p.ws = ws; p.bglu = args.in[IN_BGLU]; gemm_phase<G4, SP2>(lds, p, X.G, X.c, X.tid); FILL(6, 128); } SEAM(6);
  if (IN(7)) for (int rep_ = 0; rep_ <= REPS(7); ++rep_) { if (rep_) xcd_barrier(bar, X.tid); LAUNDER(); phase_attn(X); } SEAM(7);
  if (IN(8)) for (int rep_ = 0; rep_ <= REPS(8); ++rep_) { if (rep_) xcd_barrier(bar, X.tid); LAUNDER(); GRes p; p.K = 1024; p.nunits = 256; p.A = (const char*)ws + WS_CONCAT; p.Bt = (const char*)ws + WS_WMIX_T; p.hin32 = args.in[IN_X]; p.hin16 = nullptr; p.hout = (bf16_t*)(ws + WS_HB); p.gate = mod + 2048; p.bias = nullptr;
    gemm_phase<GRes, SP2>(lds, p, X.G, X.c, X.tid); } SEAM(8);
#pragma unroll 1
  for (int layer = 0; layer < 2; ++layer) {
    const int pb = layer == 0 ? 9 : 17;
    if (IN(pb)) for (int rep_ = 0; rep_ <= REPS(pb); ++rep_) { if (rep_) xcd_barrier(bar, X.tid); LAUNDER(); phase_router(X, layer, rep_ ? ROUTER_VARIANT : 0); } SEAM(pb);
#ifndef ROUTER_VARIANT
#define ROUTER_VARIANT 1
#endif
#ifndef G6_VARIANT
#define G6_VARIANT 1
#endif
    if (IN(pb + 1)) for (int rep_ = REPS(pb + 1); rep_ >= 0; --rep_) { if (rep_ == 0 && REPS(pb + 1)) xcd_barrier(bar, X.tid); LAUNDER(); build_moetab(X, layer, TOFF); G6 p; p.dry = rep_ ? G6_VARIANT : 0; p.K = 512; p.ws = ws; p.toff = TOFF; p.nunits = TOFF[65] * 2; p.wbase = (const char*)ws + (layer == 0 ? WS_WEXP : WS_WEXP1); p.wstride = layer == 0 ? EXP_STRIDE : EXP1_STRIDE;
      { LAS unsigned* tk = (LAS unsigned*)(X.lds + LDS_STAGE); p.tokt = tk; p.build_tokt(X, tk); } gemm_phase<G6, SP2>(lds, p, X.G, X.c, X.tid); } SEAM(pb + 1);
#ifndef G7_VARIANT
#define G7_VARIANT 1
#endif
    if (IN(pb + 2)) for (int rep_ = REPS(pb + 2); rep_ >= 0; --rep_) { if (rep_ == 0 && REPS(pb + 2)) xcd_barrier(bar, X.tid); LAUNDER(); build_moetab(X, layer, TOFF); G7 p; p.K = 256; p.ws = ws; p.toff = TOFF; p.dry = rep_ ? G7_VARIANT : 0; p.nunits = TOFF[65] * 4; p.wbase = (const char*)ws + (layer == 0 ? WS_WEXP + EXP_DOFF : WS_WEXP1 + EXP1_DOFF); p.wstride = layer == 0 ? EXP_STRIDE : EXP1_STRIDE; gemm_phase<G7, SP2>(lds, p, X.G, X.c, X.tid); } SEAM(pb + 2);
    if (IN(pb + 3)) for (int rep_ = REPS(pb + 3); rep_ >= 0; --rep_) { if (rep_ == 0 && REPS(pb + 3)) xcd_barrier(bar, X.tid); LAUNDER(); build_moetab(X, layer, TOFF); phase_combine(X, layer, TOFF, rep_);
      if (layer == 0 && rep_ == 0 && !(args.flags & FLAG_SKIP_EXPERTS)) { __syncthreads(); transpose_work(X, ctl + CW_DQ1, 0, 0, 1, 65 * IT_EXP); } }
    if (layer == 0) {
      SEAM(12);
      if (IN(13)) for (int rep_ = 0; rep_ <= REPS(13); ++rep_) { if (rep_) xcd_barrier(bar, X.tid); LAUNDER(); G8 p; p.K = 256; p.nunits = 512; p.ws = ws; gemm_phase<G8, SP2>(lds, p, X.G, X.c, X.tid); } SEAM(13);
      if (IN(14)) for (int rep_ = 0; rep_ <= REPS(14); ++rep_) { if (rep_) xcd_barrier(bar, X.tid); LAUNDER(); G9 p; p.K = 256; p.nunits = 512; p.ws = ws; gemm_phase<G9, SP2>(lds, p, X.G, X.c, X.tid); } SEAM(14);
      if (IN(15)) for (int rep_ = 0; rep_ <= REPS(15); ++rep_) { if (rep_) xcd_barrier(bar, X.tid); LAUNDER(); G10 p; p.K = 256; p.nunits = 512; p.ws = ws; gemm_phase<G10, SP2>(lds, p, X.G, X.c, X.tid); } SEAM(15);
      if (IN(16)) { LAUNDER(); zero_lists(X); GRes p; p.K = 1024; p.nunits = 256; p.A = (const char*)ws + WS_FB; p.Bt = (const char*)ws + WS_WFOUR_T; p.hin32 = nullptr; p.hin16 = (const bf16_t*)(ws + WS_HB); p.hout = (bf16_t*)(ws + WS_HB); p.gate = mod + 2 * 6144 + 2048; p.bias = args.in[IN_BFOUR];
        gemm_phase<GRes, SP2>(lds, p, X.G, X.c, X.tid); } SEAM(16);
    }
  }
#undef IN
#undef SEAM
}
}
#ifndef MK_SP2
#define MK_SP2 true
#endif
#ifndef MK_N_LAUNCHES
#define MK_N_LAUNCHES 1
#endif
#ifndef CHECK
#define CHECK 0
#endif
static int g_grid = 0;
static bool mk_setup(int n_in, int out_size, size_t ws_size) {
  if (g_grid == 0) {
    g_grid = -1;
    if (n_in != 31 || out_size != 16384 * 1024 || ws_size < mk::WS_NEED) { fprintf(stderr, "kernel_launch: unexpected n_in %d out %d ws %zu\n", n_in, out_size, ws_size); return false; }
    int dev = 0, cus = 0;
    if (hipGetDevice(&dev) != hipSuccess || hipDeviceGetAttribute(&cus, hipDeviceAttributeMultiprocessorCount, dev) != hipSuccess) return false;
    if (cus < 256) { fprintf(stderr, "kernel_launch: needs 256 CUs, device has %d\n", cus); return false; }
    if (hipFuncSetAttribute((const void*)mk::mk_fwd<MK_SP2>, hipFuncAttributeMaxDynamicSharedMemorySize, mk::LDS_BYTES) != hipSuccess) { fprintf(stderr, "kernel_launch: hipFuncSetAttribute failed\n"); return false; }
    g_grid = 256;
  }
  return g_grid > 0;
}
static void mk_run(hipStream_t s, mk::Args a, int lo, int hi) {
  a.ph_lo = lo; a.ph_hi = hi;
  hipLaunchKernelGGL(mk::mk_fwd<MK_SP2>, dim3(g_grid), dim3(mk::NTHR), mk::LDS_BYTES, s, a);
}

#if CHECK
namespace chk {
using mk::bf16_t;
__device__ __forceinline__ float b2f(bf16_t b) { return __uint_as_float(((unsigned)b) << 16); }
__global__ void k_cmp(int mode, const void* A, const float* B, unsigned long long n, double* acc) {
  double e = 0.0, r = 0.0; const bf16_t* A16 = (const bf16_t*)A;
  for (unsigned long long i = (unsigned long long)blockIdx.x * 256 + threadIdx.x; i < n; i += (unsigned long long)gridDim.x * 256) {
    float a = 0.f, b = 0.f; const int row = (int)(i >> 9), col = (int)(i & 511);
    switch (mode) {
      case 0: a = ((const float*)A)[i]; b = B[i]; break;
      case 1: a = b2f(A16[i]); b = B[i]; break;
      case 2: { b = B[(size_t)row * 2048 + col]; const int g = col >> 4, c = col & 15; int crow, s; if (row < 16384) { crow = row >> 5; s = row & 31; } else { const int j = row - 16384; crow = 512 + (j >> 5); s = j & 31; }
                a = b2f(A16[((size_t)(g * 768 + crow)) * 768 + s * 16 + c]); } break;
      case 3: b = B[(size_t)row * 2048 + 512 + col]; a = b2f(A16[(size_t)row * 512 + col]); break;
      case 4: b = B[(size_t)row * 2048 + 1024 + col]; a = b2f(A16[(size_t)row * 512 + col]); break;
      case 5: b = B[(size_t)row * 2048 + 1536 + col]; a = b2f(A16[(size_t)col * 16640 + row]); break;
      case 6: b = B[(size_t)row * 1024 + col]; a = b2f(A16[(size_t)row * 1024 + col]); break;
      case 7: b = B[(size_t)row * 1024 + 512 + col]; a = b2f(A16[(size_t)row * 1024 + 512 + col]); break;
      case 8: { const int ta = (int)(i & 127), ri = (int)((i >> 7) & 1), tb = (int)((i >> 8) & 127), m = (int)((i >> 15) & 255), g = (int)(i >> 23); a = b2f(A16[i]); const int t = 128 * ta + tb; b = B[((size_t)t * 4 + g) * 512 + ri * 256 + m]; } break;
      default: break;
    }
    const double d = (double)a - (double)b; e += d * d; r += (double)b * (double)b;
  }
  for (int o = 32; o >= 1; o >>= 1) { e += __shfl_xor(e, o); r += __shfl_xor(r, o); }
  if ((threadIdx.x & 63) == 0) { atomicAdd(acc, e); atomicAdd(acc + 1, r); }
}
__global__ void k_cmp_x2(const bf16_t* X2, const float* Yr, const float* Yi, double* acc) {
  double e = 0.0, r = 0.0;
  for (unsigned long long i = (unsigned long long)blockIdx.x * 256 + threadIdx.x; i < (1ull << 25); i += (unsigned long long)gridDim.x * 256) {
    const int tb = (int)(i & 127), rip = (int)((i >> 7) & 1), ka = (int)((i >> 8) & 127), gm = (int)(i >> 15);
    const float a = b2f(X2[i]); const size_t yi = (((size_t)ka * 128 + tb) << 10) + gm; const float b = rip ? Yi[yi] : Yr[yi];
    const double d = (double)a - (double)b; e += d * d; r += (double)b * (double)b;
  }
  for (int o = 32; o >= 1; o >>= 1) { e += __shfl_xor(e, o); r += __shfl_xor(r, o); }
  if ((threadIdx.x & 63) == 0) { atomicAdd(acc, e); atomicAdd(acc + 1, r); }
}
__global__ void k_judge(const double* acc, int n, float tol, int* fail) {
  if (threadIdx.x == 0 && blockIdx.x == 0) { fail[0] = 0; for (int k = 0; k < n; ++k) { const double rel = sqrt(acc[2 * k] / acc[2 * k + 1]); if (!(rel <= (double)tol)) { fail[0] = k + 1; break; } } }
}
__global__ void k_encode(float* out, size_t n, const int* fail) {
  const int f = fail[0]; if (f == 0) return; const float sc = 1.f + 0.1f * (float)f;
  for (size_t i = (size_t)blockIdx.x * 256 + threadIdx.x; i < n; i += (size_t)gridDim.x * 256) out[i] *= sc;
}
__global__ void k_f2bf(const float* in, bf16_t* out, size_t n) { for (size_t i = (size_t)blockIdx.x * 256 + threadIdx.x; i < n; i += (size_t)gridDim.x * 256) out[i] = mk::f2bf(in[i]); }
static void cmp(hipStream_t s, int mode, const void* A, const float* B, unsigned long long n, double* acc) { hipLaunchKernelGGL(k_cmp, dim3(2048), dim3(256), 0, s, mode, A, B, n, acc); }
}
#endif

extern "C" void kernel_launch(void* const* d_in, const int* in_sizes, int n_in, void* d_out, int out_size, void* d_ws, size_t ws_size, hipStream_t stream) {
  if (!mk_setup(n_in, out_size, ws_size)) return;
  unsigned char* ws = (unsigned char*)d_ws;
  const size_t MiB = mk::MiB;
  mk::Args a{};
  for (int i = 0; i < 31; ++i) a.in[i] = (const float*)d_in[i];
  a.h = (float*)d_out; a.ws = ws; a.flags = 0; a.pad = 0;
#if CHECK == 0
  (void)hipMemsetAsync(ws + mk::WS_CTL, 0, mk::CTL_ZERO_BYTES, stream);
#if MK_N_LAUNCHES == 1
  mk_run(stream, a, 0, mk::NPHASE);
#else
  for (int ph = 0; ph < mk::NPHASE; ++ph) mk_run(stream, a, ph, ph + 1);
#endif
#else
  ref::In in; { const float** p = (const float**)&in; for (int i = 0; i < 31; ++i) p[i] = (const float*)d_in[i]; }
  float* out = (float*)d_out;
  char* wsc = (char*)d_ws;
  ref::Small sm; sm.mod = (float*)(wsc + 498 * MiB); sm.lamb = (float2*)(wsc + 498 * MiB + 131072); sm.bbar = (float2*)(wsc + 498 * MiB + 262144);
  sm.tw = (float2*)(wsc + 499 * MiB); sm.Dm = (float*)(wsc + 499 * MiB + 262144);
  double* acc = (double*)(wsc + 500 * MiB); int* fail = (int*)(wsc + 500 * MiB + 4096);
  (void)hipMemsetAsync(acc, 0, 8192, stream);
  (void)hipMemsetAsync(ws + mk::WS_CTL, 0, mk::CTL_ZERO_BYTES, stream);
  float* HOPT = (float*)(ws + mk::WS_HOPT);
  int nchk = 0;
#if CHECK == 1
  ref::MixBuf mb; mb.a0 = (float*)(wsc + 12 * MiB); mb.z = (float*)(wsc + 336 * MiB); mb.g = (float*)(wsc + 466 * MiB); mb.t = (float*)(wsc + 77 * MiB); mb.concat = mb.a0; mb.ymix = mb.z;
  char* moe_arena = wsc + 12 * MiB;
  ref::FourBuf fb; { char* p = wsc + 12 * MiB; fb.a1 = (float*)p; p += 64 * MiB; fb.Z = (float*)p; p += 128 * MiB; fb.Yr = (float*)p; p += 64 * MiB; fb.Yi = (float*)p; p += 64 * MiB; fb.F = (float*)p; fb.yf = fb.Z; }
  a.flags = mk::FLAG_SKIP_EXPERTS;
  nchk = 10;
  ref::forward(stream, in, out, sm, mb, moe_arena, fb, [&](int st) {
    if (st == 1) { mk_run(stream, a, 0, 1); chk::cmp(stream, 0, ws + mk::WS_MOD, sm.mod, 3 * 6144, acc + 0); }
    if (st == 2) { mk_run(stream, a, 1, 2); chk::cmp(stream, 1, ws + mk::WS_A0, mb.a0, 16640ull * 1024, acc + 2); }
    if (st == 3) { mk_run(stream, a, 2, 3); chk::cmp(stream, 2, ws + mk::WS_AS5, mb.z, 16640ull * 512, acc + 4); chk::cmp(stream, 3, ws + mk::WS_Q, mb.z, 16384ull * 512, acc + 6);
                   chk::cmp(stream, 4, ws + mk::WS_K, mb.z, 16640ull * 512, acc + 8); chk::cmp(stream, 5, ws + mk::WS_VT, mb.z, 16640ull * 512, acc + 10); }
    if (st == 4) { mk_run(stream, a, 3, 4); mk_run(stream, a, 4, 5); mk_run(stream, a, 5, 6); chk::cmp(stream, 1, ws + mk::WS_GB, mb.g, 16384ull * 512, acc + 12); }
    if (st == 5) { mk_run(stream, a, 6, 7); chk::cmp(stream, 6, ws + mk::WS_CONCAT, mb.concat, 16384ull * 512, acc + 14); }
    if (st == 6) { mk_run(stream, a, 7, 8); chk::cmp(stream, 7, ws + mk::WS_CONCAT, mb.concat, 16384ull * 512, acc + 16); }
    if (st == 7) { mk::Args b = a; b.h = HOPT; mk_run(stream, b, 8, 9); chk::cmp(stream, 0, HOPT, out, 16384ull * 1024, acc + 18); }
  });
#elif CHECK == 2 || CHECK == 4
  const int L = CHECK == 2 ? 0 : 1;
  ref::MixBuf mb; { char* p = wsc + 12 * MiB; mb.a0 = (float*)p; p += 65 * MiB; mb.z = (float*)p; p += 130 * MiB; mb.g = (float*)p; p += 32 * MiB; mb.t = (float*)p; p += 32 * MiB; mb.concat = (float*)p; p += 64 * MiB; mb.ymix = mb.z; }
  ref::FourBuf fb; { char* p = wsc + 12 * MiB; fb.a1 = (float*)p; p += 64 * MiB; fb.Z = (float*)p; p += 128 * MiB; fb.Yr = (float*)p; p += 64 * MiB; fb.Yi = (float*)p; p += 64 * MiB; fb.F = (float*)p; fb.yf = fb.Z; }
  char* moe_arena = wsc + 110 * MiB;
  nchk = L == 0 ? 2 : 1;
  a.flags = 0;
  ref::forward(stream, in, out, sm, mb, moe_arena, fb, [&](int st) {
    if ((L == 0 && st == 7) || (L == 1 && st == 11)) {
      mk::Args b = a; b.h = HOPT; if (L == 1) b.flags = 2;
      mk_run(stream, b, 0, 1);
      (void)hipMemcpyAsync(HOPT, out, (size_t)16384 * 1024 * 4, hipMemcpyDeviceToDevice, stream);
      const int pb = L == 0 ? 9 : 20; b.flags |= mk::FLAG_SKIP_EXPERTS;
      for (int ph = pb; ph < pb + 7; ++ph) mk_run(stream, b, ph, ph + 1);
    }
    if ((L == 0 && st == 8) || (L == 1 && st == 12)) chk::cmp(stream, 0, HOPT, out, 16384ull * 1024, acc + 0);
    if (L == 0 && st == 9) chk::cmp(stream, 1, ws + mk::WS_A1, fb.a1, 16384ull * 1024, acc + 2);
  });
#elif CHECK == 3
  ref::MixBuf mb; { char* p = wsc + 12 * MiB; mb.a0 = (float*)p; p += 65 * MiB; mb.z = (float*)p; p += 130 * MiB; mb.g = (float*)p; p += 32 * MiB; mb.t = (float*)p; p += 32 * MiB; mb.concat = (float*)p; p += 64 * MiB; mb.ymix = mb.z; }
  char* moe_arena = wsc + 12 * MiB;
  ref::FourBuf fb; fb.Z = (float*)(wsc + 270 * MiB);
  fb.a1 = (float*)(wsc + 12 * MiB); fb.Yr = (float*)(wsc + 12 * MiB);   fb.Yi = (float*)(wsc + 468 * MiB - 0); fb.F = (float*)(wsc + 270 * MiB); fb.yf = (float*)(wsc + 334 * MiB);
  fb.Yi = (float*)(wsc + 76 * MiB);
  nchk = 4;
  a.flags = mk::FLAG_SKIP_EXPERTS;
  ref::forward(stream, in, out, sm, mb, moe_arena, fb, [&](int st) {
    if (st == 9) {
      mk::Args b = a; b.h = HOPT;
      mk_run(stream, b, 0, 1);
      hipLaunchKernelGGL(chk::k_f2bf, dim3(2048), dim3(256), 0, stream, fb.a1, (chk::bf16_t*)(ws + mk::WS_A1), (size_t)16384 * 1024);
      (void)hipMemcpyAsync(HOPT, out, (size_t)16384 * 1024 * 4, hipMemcpyDeviceToDevice, stream);
      mk_run(stream, b, 16, 17);
    }
  });
#endif
  hipLaunchKernelGGL(chk::k_judge, dim3(1), dim3(64), 0, stream, acc, nchk, 0.05f, fail);
  hipLaunchKernelGGL(chk::k_encode, dim3(2048), dim3(256), 0, stream, out, (size_t)16384 * 1024, fail);
#endif
}
```

```cpp
#define CHECK 0
#define MK_N_LAUNCHES 1
#define MK_SP2 true
#define REP_MASK 0ull
#include <hip/hip_runtime.h>
#include <cstdio>
#include <cstdint>
#include <cmath>
namespace mk {
#define LAS __attribute__((address_space(3)))
typedef unsigned short bf16_t;
typedef short bf16x8 __attribute__((ext_vector_type(8)));
typedef float f32x4 __attribute__((ext_vector_type(4)));
typedef float f32x2 __attribute__((ext_vector_type(2)));
typedef unsigned u32x4 __attribute__((ext_vector_type(4)));
typedef unsigned u32x2 __attribute__((ext_vector_type(2)));
typedef int i32x8 __attribute__((ext_vector_type(8)));
typedef int i32x4 __attribute__((ext_vector_type(4)));

constexpr int TOK = 16384, CTXN = 256, NROW = TOK + CTXN;
constexpr int NWAVES = 8, NTHR = 512;
constexpr int LDS_STAGE = 131072, LDS_BYTES = 155648, LDS_MISC_OFF = LDS_BYTES - 4096;

__device__ __forceinline__ unsigned cvt_pk_bf16(float lo, float hi) { unsigned r; asm volatile("v_cvt_pk_bf16_f32 %0, %1, %2" : "=v"(r) : "v"(lo), "v"(hi)); return r; }
__device__ __forceinline__ float bf_lo(unsigned w) { return __uint_as_float(w << 16); }
__device__ __forceinline__ float bf_hi(unsigned w) { return __uint_as_float(w & 0xffff0000u); }
__device__ __forceinline__ float bf2f(bf16_t b) { return __uint_as_float(((unsigned)b) << 16); }
__device__ __forceinline__ bf16_t f2bf(float f) { unsigned u = __float_as_uint(f); return (bf16_t)((u + 0x7fffu + ((u >> 16) & 1u)) >> 16); }
__device__ __forceinline__ float sx(float v, int o) { unsigned z = 0u; asm volatile("" : "+v"(z)); int l = (int)__builtin_amdgcn_mbcnt_hi(~0u, __builtin_amdgcn_mbcnt_lo(~0u, z)); return __int_as_float(__builtin_amdgcn_ds_bpermute((l ^ o) << 2, __float_as_int(v))); }
__device__ __forceinline__ float wave_sum(float v) {
#pragma unroll
  for (int o = 1; o < 64; o <<= 1) v += sx(v, o);
  return v;
}
__device__ __forceinline__ float fast_sigmoid(float x) { return __builtin_amdgcn_rcpf(1.f + __expf(-x)); }
__device__ __forceinline__ float fast_tanh(float x) { float e = __expf(2.f * x); return 1.f - 2.f * __builtin_amdgcn_rcpf(e + 1.f); }
__device__ __forceinline__ float gelu_tanh(float x) { return 0.5f * x * (1.f + fast_tanh(0.7978845608028654f * (x + 0.044715f * x * x * x))); }

#define XB_TMO      128
#define XB_XCNT(j)  (256  + 64 * (j))
#define XB_XSUB(j)  (1280 + 64 * (j))
#define XB_XGEN(j)  (2304 + 64 * (j))
#define XB_TOP      3328
#define XB_TOPGEN   3392
#define XCD_BAR_WORDS 3456
#define XB_SPIN_CAP (1u << 20)
__device__ __forceinline__ unsigned xb_ld(unsigned* p) { return __hip_atomic_load(p, __ATOMIC_RELAXED, __HIP_MEMORY_SCOPE_AGENT); }
__device__ __forceinline__ unsigned xb_add(unsigned* p, unsigned v) { return __hip_atomic_fetch_add(p, v, __ATOMIC_RELAXED, __HIP_MEMORY_SCOPE_AGENT); }
__device__ __forceinline__ unsigned xb_xcc_id() { return (unsigned)__builtin_amdgcn_s_getreg((3 << 11) | 20) & 0xFu; }
#define XB_SPIN(cond, bar) do { unsigned _sp = 0; while (cond) { __builtin_amdgcn_s_sleep(1); \
    if ((++_sp & 255u) == 0u) { if (xb_ld(&(bar)[XB_TMO])) break; if (_sp > XB_SPIN_CAP) { atomicAdd(&(bar)[XB_TMO], 1u); break; } } } } while (0)
struct XcdBarrier { unsigned* bar; unsigned x; volatile LAS unsigned* st; };
__device__ __forceinline__ XcdBarrier xcd_barrier_post(unsigned* bar, volatile LAS unsigned* st, int tid) {
  XcdBarrier b; b.bar = bar; b.x = xb_xcc_id(); b.st = st;
  if (tid == 0) (void)xb_add(&bar[XB_XCNT(b.x)], 1u);
  return b;
}
__device__ __forceinline__ void xcd_barrier_complete(unsigned* bar, unsigned x, unsigned& nloc, unsigned& nx) {
  const unsigned G = gridDim.x * gridDim.y * gridDim.z;
  unsigned sum, cnt, mine, sp = 0u;
  for (;;) {
    sum = 0u; cnt = 0u; mine = 0u;
#pragma unroll
    for (unsigned j = 0; j < 16; ++j) { const unsigned c = xb_ld(&bar[XB_XCNT(j)]); sum += c; cnt += (c > 0u) ? 1u : 0u; }
    if (sum == G) { mine = xb_ld(&bar[256 + 64 * x]); break; }
    __builtin_amdgcn_s_sleep(1);
    if ((++sp & 255u) == 0u) { if (xb_ld(&bar[XB_TMO])) break; if (sp > XB_SPIN_CAP) { atomicAdd(&bar[XB_TMO], 1u); break; } }
  }
  nloc = mine > 0u ? mine : 1u; nx = cnt > 0u ? cnt : 1u;
}
__device__ __forceinline__ void xcd_barrier(const XcdBarrier& b, int tid) {
  asm volatile("s_waitcnt vmcnt(0)" ::: "memory");
  __syncthreads();
  if (tid == 0) {
    unsigned* bar = b.bar;
    __builtin_amdgcn_s_waitcnt(0);
    unsigned nloc = b.st[0], nx = b.st[1];
    if (nloc == 0u) { xcd_barrier_complete(bar, b.x, nloc, nx); b.st[0] = nloc; b.st[1] = nx; }
    const unsigned old = xb_add(&bar[XB_XSUB(b.x)], 1u);
    const unsigned gen = old / nloc;
    if (old + 1u == (gen + 1u) * nloc) {
      __builtin_amdgcn_fence(__ATOMIC_RELEASE, "agent");
      asm volatile("s_waitcnt vmcnt(0)" ::: "memory");
      const unsigned og = xb_add(&bar[XB_TOP], 1u);
      const unsigned tg = og / nx;
      if (og + 1u == (tg + 1u) * nx) xb_add(&bar[XB_TOPGEN], 1u);
      else XB_SPIN(xb_ld(&bar[XB_TOPGEN]) == tg, bar);
      __builtin_amdgcn_fence(__ATOMIC_ACQUIRE, "agent");
      xb_add(&bar[XB_XGEN(b.x)], 1u);
      asm volatile("s_waitcnt vmcnt(0)" ::: "memory");
    } else {
      XB_SPIN(xb_ld(&bar[XB_XGEN(b.x)]) == gen, bar);
      __builtin_amdgcn_fence(__ATOMIC_ACQUIRE, "agent");
      asm volatile("s_waitcnt vmcnt(0)" ::: "memory");
    }
  }
  __syncthreads();
}

constexpr int BM = 256, BK = 64, HALF = 128, HTB = HALF * BK * 2, NXCD = 8;
__device__ __forceinline__ int lds_byte(int r, int c) { const int st = (r >> 4) * 2 + (c >> 5), rr = r & 15, cc = c & 31, ob = rr * 64 + cc * 2; return st * 1024 + (ob ^ (((ob >> 9) & 1) << 5)); }
__device__ __forceinline__ void stage_rc(int b, int& R, int& C) { const int st = b / 1024, sb = b % 1024, swz = sb ^ (((sb >> 9) & 1) << 5); R = (st >> 1) * 16 + swz / 64; C = (st & 1) * 32 + (swz % 64) / 2; }
__device__ __forceinline__ int swz16(int fr) { return 2 * ((fr >> 1) & 1) + 4 * ((fr >> 3) & 1); }
__device__ __forceinline__ int swz8(int fr) { return ((fr >> 1) & 1) + 4 * ((fr >> 3) & 1); }
__device__ __forceinline__ int perm32(int rho) { const int n = rho >> 4, i = rho & 15; return 8 * (i >> 2) + 4 * n + (i & 3); }

struct Unit { int pm, pn, a, b, ord; };
__device__ __forceinline__ int xcd_remap(int L, int nunits) { const int q = nunits / NXCD, r = nunits % NXCD, xcd = L % NXCD, off = L / NXCD; return (xcd < r ? xcd * (q + 1) : r * (q + 1) + (xcd - r) * q) + off; }
typedef f32x4 Acc[2][2][4][2];
template <class P, bool SP2>
__device__ __forceinline__ void gemm_phase(LAS unsigned char* lds, const P& p, int G, int c, int tid_in) {
  const int tid = tid_in, wid = __builtin_amdgcn_readfirstlane(tid >> 6), lane = tid & 63, wr = wid >> 2, wc = wid & 3, fr = lane & 15, fq = lane >> 4;
  const int K = p.K, nt = K / BK;
  const int nunits = p.nunits;
  const size_t kstep = (size_t)(BK * 2);
  const unsigned ldsw = (unsigned)wid * 1024u;
  const int aoff0 = P::F8 ? (wr * 64 + fr) * 128 + ((2 * fq) ^ swz8(fr)) * 16 : lds_byte(wr * 64 + fr, fq * 8);
  const int boff0 = P::F8 ? (wc * 32 + fr) * 128 + ((2 * fq) ^ swz8(fr)) * 16 : lds_byte(wc * 32 + fr, fq * 8);
#define PG8_SA(b, h) (((b) * 2 + (h)) * HTB)
#define PG8_SB(b, h) ((4 + (b) * 2 + (h)) * HTB)
#define PG8_STAGE(bufoff, gbase, voff) do { _Pragma("unroll") for (int _i = 0; _i < 2; ++_i) \
        __builtin_amdgcn_global_load_lds((const unsigned*)((const char*)(gbase) + (voff)[_i]), (LAS unsigned*)(lds + (bufoff) + ldsw + _i * 8192), 16, 0, 0); } while (0)
#define PG8_RD32(p0_, p1_) __builtin_shufflevector(*(const LAS i32x4*)(p0_), *(const LAS i32x4*)(p1_), 0, 1, 2, 3, 4, 5, 6, 7)
#define PG8_LDA(dst, b, h) do { if constexpr (P::F8) { int _o1 = aoff0 ^ 16; asm volatile("" : "+v"(_o1)); _Pragma("unroll") for (int m = 0; m < 4; ++m) dst##8[m] = PG8_RD32(lds + PG8_SA(b, h) + aoff0 + m * 2048, lds + PG8_SA(b, h) + _o1 + m * 2048); } \
        else { _Pragma("unroll") for (int m = 0; m < 4; ++m) _Pragma("unroll") for (int k = 0; k < 2; ++k) dst[m][k] = *(const LAS bf16x8*)(lds + PG8_SA(b, h) + aoff0 + m * 2048 + k * 1024); } } while (0)
#define PG8_LDB(dst, b, h) do { if constexpr (P::F8) { int _o1 = boff0 ^ 16; asm volatile("" : "+v"(_o1)); _Pragma("unroll") for (int n = 0; n < 2; ++n) dst##8[n] = PG8_RD32(lds + PG8_SB(b, h) + boff0 + n * 2048, lds + PG8_SB(b, h) + _o1 + n * 2048); } \
        else { _Pragma("unroll") for (int n = 0; n < 2; ++n) _Pragma("unroll") for (int k = 0; k < 2; ++k) dst[n][k] = *(const LAS bf16x8*)(lds + PG8_SB(b, h) + boff0 + n * 2048 + k * 1024); } } while (0)
#define PG8_MMA(ai, bj, At, Bt) do { __builtin_amdgcn_s_setprio(1); if constexpr (P::F8) { _Pragma("unroll") for (int m = 0; m < 4; ++m) _Pragma("unroll") for (int n = 0; n < 2; ++n) \
        acc[ai][bj][m][n] = __builtin_amdgcn_mfma_scale_f32_16x16x128_f8f6f4(Bt##8[n], At##8[m], acc[ai][bj][m][n], 0, 0, 0, 0, 0, 0); }     \
        else { _Pragma("unroll") for (int m = 0; m < 4; ++m) _Pragma("unroll") for (int n = 0; n < 2; ++n) _Pragma("unroll") for (int k = 0; k < 2; ++k) \
        acc[ai][bj][m][n] = __builtin_amdgcn_mfma_f32_16x16x32_bf16(Bt[n][k], At[m][k], acc[ai][bj][m][n], 0, 0, 0); } __builtin_amdgcn_s_setprio(0); } while (0)
#define PG8_WAIT_V(n) asm volatile("s_waitcnt vmcnt(" #n ")" ::: "memory")
#define PG8_WAIT_L(n) asm volatile("s_waitcnt lgkmcnt(" #n ")" ::: "memory")
#define PG8_BAR __builtin_amdgcn_s_barrier()
#define PG8_SCHED __builtin_amdgcn_sched_barrier(0)
#define PG8_DECODE(i, u) do { p.decode(P::CONTIG ? (u_lo + (i)) : xcd_remap((i) * G + c, nunits), u); u.ord = (i); } while (0)
#define PG8_HAS(i) (P::CONTIG ? (u_lo + (i) < u_hi) : ((i) * G + c < nunits))
#define PG8_OFFS(u, vA, vB) do { int _t = tid; asm volatile("" : "+v"(_t)); _Pragma("unroll") for (int _i = 0; _i < 2; ++_i) { int _R, _C; if constexpr (P::F8) { const int _p = _t + 512 * _i; _R = _p >> 3; _C = ((_p & 7) ^ swz8(_R & 15)) * 8; } else stage_rc(_t * 16 + _i * 8192, _R, _C); \
        const int _Rb = P::PERM ? ((_R & ~31) + perm32(_R & 31)) : _R; _Pragma("unroll") for (int _h = 0; _h < 2; ++_h) { \
        if (_h == 0 || !P::LINA) vA[_h][_i] = p.rowA(u, _h * HALF + _R) + (unsigned)(_C * 2); if (_h == 0 || !P::LINB) vB[_h][_i] = p.rowB(u, _h * HALF + _Rb) + (unsigned)(_C * 2); } } } while (0)
  const int vc_ = (G % 8 == 0) ? (c % 8) * (G / 8) + c / 8 : c;
  const int u_lo = (int)(((long)vc_ * nunits) / G), u_hi = (int)(((long)(vc_ + 1) * nunits) / G);
  if (!PG8_HAS(0)) return;
  Unit cur, nxt; int ui = 0;
  PG8_DECODE(0, cur);
  Acc acc; float zf_ = 0.f; asm volatile("" : "+v"(zf_));
#pragma unroll
  for (int a = 0; a < 2; ++a)
#pragma unroll
    for (int b = 0; b < 2; ++b)
#pragma unroll
      for (int m = 0; m < 4; ++m)
#pragma unroll
        for (int n = 0; n < 2; ++n) acc[a][b][m][n] = (f32x4){zf_, zf_, zf_, zf_};
  bf16x8 At[4][2], B0[2][2], B1[2][2]; i32x8 At8[4], B08[2], B18[2];
  unsigned vA[2][2], vB[2][2];
  PG8_OFFS(cur, vA, vB);
  const char* cA = p.baseA(cur); const char* cB = p.baseB(cur);
  const size_t hA = P::LINA ? p.halfA() : 0, hB = P::LINB ? p.halfB() : 0;
  if constexpr (SP2) {
    PG8_STAGE(PG8_SB(0, 0), cB, vB[0]); PG8_STAGE(PG8_SB(0, 1), (cB) + (P::LINB ? hB : 0), vB[P::LINB ? 0 : 1]); PG8_STAGE(PG8_SA(0, 0), cA, vA[0]); PG8_STAGE(PG8_SA(0, 1), (cA) + (P::LINA ? hA : 0), vA[P::LINA ? 0 : 1]);
    if (wr == 1) PG8_BAR;
    PG8_WAIT_V(2); PG8_BAR;
    PG8_STAGE(PG8_SB(1, 0), cB + kstep, vB[0]); PG8_STAGE(PG8_SA(1, 0), cA + kstep, vA[0]); PG8_STAGE(PG8_SB(1, 1), (cB + kstep) + (P::LINB ? hB : 0), vB[P::LINB ? 0 : 1]);
    PG8_WAIT_V(6); PG8_BAR;
  } else {
    PG8_STAGE(PG8_SB(0, 0), cB, vB[0]); PG8_STAGE(PG8_SA(0, 0), cA, vA[0]); PG8_STAGE(PG8_SB(0, 1), (cB) + (P::LINB ? hB : 0), vB[P::LINB ? 0 : 1]); PG8_STAGE(PG8_SA(0, 1), (cA) + (P::LINA ? hA : 0), vA[P::LINA ? 0 : 1]);
    if (wr == 1) PG8_BAR;
    PG8_WAIT_V(4); PG8_BAR;
    PG8_STAGE(PG8_SB(1, 0), cB + kstep, vB[0]); PG8_STAGE(PG8_SA(1, 0), cA + kstep, vA[0]); PG8_STAGE(PG8_SB(1, 1), (cB + kstep) + (P::LINB ? hB : 0), vB[P::LINB ? 0 : 1]);
    PG8_WAIT_V(6); PG8_BAR;
  }
  for (;;) {
    const bool has_next = PG8_HAS(ui + 1);
    if (has_next) PG8_DECODE(ui + 1, nxt);
    const char* nA = has_next ? p.baseA(nxt) : cA; const char* nB = has_next ? p.baseB(nxt) : cB;
    for (int t = 0; t < nt; t += 2) {
      const bool last = (t == nt - 2);
      const char* a1 = cA + (size_t)(t + 1) * kstep;
      const char* a2 = last ? nA : cA + (size_t)(t + 2) * kstep; const char* b2 = last ? nB : cB + (size_t)(t + 2) * kstep;
      const char* a3 = a2 + kstep; const char* b3 = b2 + kstep;
      if constexpr (SP2) {
        PG8_LDB(B0, 0, 0); PG8_LDB(B1, 0, 1); PG8_SCHED; PG8_LDA(At, 0, 0); PG8_STAGE(PG8_SA(1, 1), (a1) + (P::LINA ? hA : 0), vA[P::LINA ? 0 : 1]);
        PG8_WAIT_V(8); PG8_WAIT_L(0); PG8_BAR; PG8_MMA(0, 0, At, B0); PG8_MMA(0, 1, At, B1); PG8_BAR; PG8_SCHED;
        if (last && has_next) { PG8_OFFS(nxt, vA, vB); }
        PG8_LDA(At, 0, 1); PG8_STAGE(PG8_SB(0, 0), b2, vB[0]); PG8_STAGE(PG8_SB(0, 1), (b2) + (P::LINB ? hB : 0), vB[P::LINB ? 0 : 1]); PG8_STAGE(PG8_SA(0, 0), a2, vA[0]);
        PG8_WAIT_V(8); PG8_WAIT_L(0); PG8_BAR; PG8_MMA(1, 0, At, B0); PG8_MMA(1, 1, At, B1); PG8_BAR; PG8_SCHED;
        PG8_LDB(B0, 1, 0); PG8_LDB(B1, 1, 1); PG8_SCHED; PG8_LDA(At, 1, 0); PG8_STAGE(PG8_SA(0, 1), (a2) + (P::LINA ? hA : 0), vA[P::LINA ? 0 : 1]);
        PG8_WAIT_V(8); PG8_WAIT_L(0); PG8_BAR; PG8_MMA(0, 0, At, B0); PG8_MMA(0, 1, At, B1); PG8_BAR; PG8_SCHED;
        PG8_LDA(At, 1, 1); PG8_STAGE(PG8_SB(1, 0), b3, vB[0]); PG8_STAGE(PG8_SB(1, 1), (b3) + (P::LINB ? hB : 0), vB[P::LINB ? 0 : 1]); PG8_STAGE(PG8_SA(1, 0), a3, vA[0]);
        PG8_WAIT_V(8); PG8_WAIT_L(0); PG8_BAR; PG8_MMA(1, 0, At, B0); PG8_MMA(1, 1, At, B1); PG8_BAR; PG8_SCHED;
      } else {
        PG8_LDB(B0, 0, 0); PG8_SCHED; PG8_LDA(At, 0, 0); PG8_STAGE(PG8_SA(1, 1), (a1) + (P::LINA ? hA : 0), vA[P::LINA ? 0 : 1]);
        PG8_WAIT_L(8); PG8_BAR; PG8_WAIT_L(0); PG8_MMA(0, 0, At, B0); PG8_BAR; PG8_SCHED;
        if (last && has_next) { PG8_OFFS(nxt, vA, vB); }
        PG8_LDB(B1, 0, 1); PG8_STAGE(PG8_SB(0, 0), b2, vB[0]);
        PG8_BAR; PG8_WAIT_L(0); PG8_MMA(0, 1, At, B1); PG8_BAR;
        PG8_LDA(At, 0, 1); PG8_STAGE(PG8_SA(0, 0), a2, vA[0]);
        PG8_BAR; PG8_WAIT_L(0); PG8_MMA(1, 0, At, B0); PG8_BAR; PG8_SCHED;
        PG8_STAGE(PG8_SB(0, 1), (b2) + (P::LINB ? hB : 0), vB[P::LINB ? 0 : 1]);
        PG8_WAIT_V(6); PG8_BAR; PG8_MMA(1, 1, At, B1); PG8_BAR;
        PG8_LDB(B0, 1, 0); PG8_SCHED; PG8_LDA(At, 1, 0); PG8_STAGE(PG8_SA(0, 1), (a2) + (P::LINA ? hA : 0), vA[P::LINA ? 0 : 1]);
        PG8_WAIT_L(8); PG8_BAR; PG8_WAIT_L(0); PG8_MMA(0, 0, At, B0); PG8_BAR; PG8_SCHED;
        PG8_LDB(B1, 1, 1); PG8_STAGE(PG8_SB(1, 0), b3, vB[0]);
        PG8_BAR; PG8_WAIT_L(0); PG8_MMA(0, 1, At, B1); PG8_BAR;
        PG8_LDA(At, 1, 1); PG8_STAGE(PG8_SA(1, 0), a3, vA[0]);
        PG8_BAR; PG8_WAIT_L(0); PG8_MMA(1, 0, At, B0); PG8_BAR; PG8_SCHED;
        PG8_STAGE(PG8_SB(1, 1), (b3) + (P::LINB ? hB : 0), vB[P::LINB ? 0 : 1]);
        PG8_WAIT_V(6); PG8_BAR; PG8_MMA(1, 1, At, B1); PG8_BAR;
      }
    }
    if constexpr (P::ALIGN) { if (wr == 0) PG8_BAR; }
    { int fr_e = fr, fq_e = fq; asm volatile("" : "+v"(fr_e), "+v"(fq_e)); p.epi(acc, cur, wr, wc, fr_e, fq_e); }
    if (!has_next) break;
    zf_ = 0.f; asm volatile("" : "+v"(zf_));
#pragma unroll
    for (int a = 0; a < 2; ++a)
#pragma unroll
      for (int b = 0; b < 2; ++b)
#pragma unroll
        for (int m = 0; m < 4; ++m)
#pragma unroll
          for (int n = 0; n < 2; ++n) acc[a][b][m][n] = (f32x4){zf_, zf_, zf_, zf_};
    cur = nxt; cA = nA; cB = nB; ++ui;
    if constexpr (P::ALIGN) { if (wr == 1) PG8_BAR; }
  }
  PG8_WAIT_V(0);
  if constexpr (!P::ALIGN) { if (wr == 0) PG8_BAR; }
  PG8_BAR;
#undef PG8_SA
#undef PG8_SB
#undef PG8_STAGE
#undef PG8_RD32
#undef PG8_LDA
#undef PG8_LDB
#undef PG8_MMA
#undef PG8_WAIT_V
#undef PG8_WAIT_L
#undef PG8_BAR
#undef PG8_SCHED
#undef PG8_DECODE
#undef PG8_HAS
#undef PG8_OFFS
}
}
namespace mk {
constexpr size_t MiB = 1u << 20;
constexpr size_t WS_CTL = 0, CTL_ZERO_BYTES = 65536;
constexpr size_t WS_MOD = 65536;
constexpr size_t WS_LAML = 262144;
constexpr size_t WS_WIN_T = 1 * MiB, WS_WGLU_T = 5 * MiB, WS_WMIX_T = 6 * MiB, WS_WFOUR_T = 8 * MiB, WS_WROUT_T = 10 * MiB;
constexpr size_t WS_DMT = 10 * MiB + 512 * 1024, WS_W1 = 10 * MiB + 768 * 1024, WS_W2 = 10 * MiB + 896 * 1024;
constexpr size_t WS_WEXP = 12 * MiB, EXP_STRIDE = 3 * MiB / 2, EXP_DOFF = 1 * MiB;
constexpr size_t WS_R = 110 * MiB;
constexpr size_t WS_WS = WS_R, WS_TT = WS_R + 8 * MiB, WS_A0 = WS_R + 34 * MiB, WS_AS5 = WS_R + 67 * MiB, WS_Q = WS_R + 103 * MiB, WS_K = WS_R + 119 * MiB,
                 WS_VT = WS_R + 136 * MiB, WS_SST = WS_R + 153 * MiB, WS_GB = WS_R + 177 * MiB, WS_CONCAT = WS_R + 193 * MiB;
constexpr size_t WS_F = WS_R, WS_LTOK = WS_R + 16 * MiB, WS_ASG = WS_R + 20 * MiB, WS_HID = WS_R + 22 * MiB, WS_YAS = WS_R + 102 * MiB,
                 WS_A1 = WS_R + 262 * MiB, WS_HB = WS_R + 294 * MiB;
constexpr size_t WS_X1 = WS_R, WS_X2 = WS_R + 64 * MiB, WS_FB = WS_R + 128 * MiB;
constexpr size_t WS_HOPT = WS_R + 338 * MiB;
constexpr size_t WS_WEXP1 = WS_R + 338 * MiB;
constexpr size_t EXP1_STRIDE = 1 * MiB, EXP1_DOFF = 512 * 1024;
constexpr size_t WS_NEED = WS_R + 403 * MiB;
constexpr int HALF_CAP_ROWS = 90112;
constexpr int CW_BAR = 4096, CW_CNT = 8192  , CW_DQ0 = 12288, CW_DQ1 = 12352, CW_DONE = 13312  ;

struct Args { const float* in[31]; float* h; unsigned char* ws; int ph_lo, ph_hi, flags, pad; };
enum { IN_X = 0, IN_C, IN_CTX, IN_CCTX, IN_WADA, IN_BADA, IN_WIN, IN_LRE, IN_LIM, IN_LDT, IN_BRE, IN_BIM, IN_CRE, IN_CIM, IN_S5D, IN_WGLU, IN_BGLU, IN_QG, IN_KG,
       IN_RPB, IN_WMIX, IN_WFOUR, IN_BFOUR, IN_WROUT, IN_RBIAS, IN_WEG, IN_WEU, IN_WED, IN_WSG, IN_WSU, IN_WSD };
constexpr int FLAG_SKIP_EXPERTS = 1;

struct Ctx {
  LAS unsigned char* lds; const Args* a; unsigned char* ws; int tid, lane, wave, G, c;
};

__device__ __forceinline__ u32x4 pack8(const f32x4& v0, const f32x4& v1) { u32x4 w; w.x = cvt_pk_bf16(v0[0], v0[1]); w.y = cvt_pk_bf16(v0[2], v0[3]); w.z = cvt_pk_bf16(v1[0], v1[1]); w.w = cvt_pk_bf16(v1[2], v1[3]); return w; }
__device__ __forceinline__ int rowmap(int code, int n) {
  if (code == 1) { if (n < 512 || n >= 1536) return n; const int blk = n & ~255, c = n & 255; return blk + 128 * ((c >> 5) & 1) + 32 * (c >> 6) + (c & 31); }
  if (code == 2) return 256 * (n >> 7) + (n & 127);
  if (code == 3) return 256 * (n >> 7) + 128 + (n & 127);
  return n;
}
__device__ __forceinline__ void transpose_item(const float* W, int K, int N, bf16_t* WT, int code, LAS unsigned char* scr, int item, int lane) {
  const int nblk = N / 64, kb = item / nblk, nb = item % nblk, k0 = 64 * kb, n0 = 64 * nb;
  const int q = lane >> 4, a = lane & 15;
  f32x4 v[16];
  const float* src = W + (size_t)(k0 + 2 * q) * N + n0 + 4 * a;
#pragma unroll
  for (int i = 0; i < 16; ++i) v[i] = *(const f32x4*)(src + (size_t)((i & 1) + 8 * (i >> 1)) * N);
#pragma unroll
  for (int ii = 0; ii < 8; ++ii) { const int dsw = q + 4 * (ii ^ (a & 7));
#pragma unroll
    for (int j = 0; j < 4; ++j) *(LAS unsigned*)(scr + (4 * a + j) * 128 + 4 * dsw) = cvt_pk_bf16(v[2 * ii][j], v[2 * ii + 1][j]); }
  asm volatile("s_waitcnt lgkmcnt(0)" ::: "memory");
  const int c = lane & 7;
#pragma unroll
  for (int jj = 0; jj < 8; ++jj) { const int n = (lane >> 3) + 8 * jj, cs = c ^ ((n >> 2) & 7);
    const u32x4 o = *(const LAS u32x4*)(scr + n * 128 + 16 * cs);
    *(u32x4*)(WT + (size_t)rowmap(code, n0 + n) * K + k0 + 8 * c) = o; }
  asm volatile("s_waitcnt lgkmcnt(0)" ::: "memory");
}
__device__ __forceinline__ void transpose_item8(const float* W, int K, int N, unsigned char* WT, int code, float scale, LAS unsigned char* scr, int item, int lane) {
  const int nblk = N / 64, kb = item / nblk, nb = item % nblk, k0 = 64 * kb, n0 = 64 * nb;
  const int q = lane >> 4, a = lane & 15;
  f32x4 v[16];
  const float* src = W + (size_t)(k0 + 4 * q) * N + n0 + 4 * a;
#pragma unroll
  for (int i = 0; i < 16; ++i) v[i] = *(const f32x4*)(src + (size_t)((i & 3) + 16 * (i >> 2)) * N);
#pragma unroll
  for (int ib = 0; ib < 4; ++ib) { const int dsw = q + 4 * (ib ^ (a & 3));
#pragma unroll
    for (int j = 0; j < 4; ++j) { int w = 0; w = __builtin_amdgcn_cvt_pk_fp8_f32(v[4 * ib][j] * scale, v[4 * ib + 1][j] * scale, w, false); w = __builtin_amdgcn_cvt_pk_fp8_f32(v[4 * ib + 2][j] * scale, v[4 * ib + 3][j] * scale, w, true);
      *(LAS int*)(scr + (4 * a + j) * 64 + 4 * dsw) = w; } }
  asm volatile("s_waitcnt lgkmcnt(0)" ::: "memory");
  const int c = lane & 3;
#pragma unroll
  for (int jj = 0; jj < 4; ++jj) { const int n = (lane >> 2) + 16 * jj, cs = c ^ ((n >> 2) & 3);
    const u32x4 o = *(const LAS u32x4*)(scr + n * 64 + 16 * cs);
    *(u32x4*)(WT + (size_t)rowmap(code, n0 + n) * K + k0 + 16 * c) = o; }
  asm volatile("s_waitcnt lgkmcnt(0)" ::: "memory");
}
constexpr int IT_WIN = 512, IT_GLU = 64, IT_MIX = 256, IT_FOUR = 256, IT_ROUT = 32, IT_SMALL = IT_WIN + IT_GLU + IT_MIX + IT_FOUR + IT_ROUT, IT_EXP = 192;
__device__ __forceinline__ void small_item(const Ctx& X, LAS unsigned char* scr, int it) {
  const Args& a = *X.a; unsigned char* ws = X.ws;
  if (it < IT_WIN) { transpose_item(a.in[IN_WIN], 1024, 2048, (bf16_t*)(ws + WS_WIN_T), 1, scr, it, X.lane); return; } it -= IT_WIN;
  if (it < IT_GLU) { transpose_item(a.in[IN_WGLU], 512, 512, (bf16_t*)(ws + WS_WGLU_T), 0, scr, it, X.lane); return; } it -= IT_GLU;
  if (it < IT_MIX) { transpose_item(a.in[IN_WMIX], 1024, 1024, (bf16_t*)(ws + WS_WMIX_T), 0, scr, it, X.lane); return; } it -= IT_MIX;
  if (it < IT_FOUR) { transpose_item(a.in[IN_WFOUR], 1024, 1024, (bf16_t*)(ws + WS_WFOUR_T), 0, scr, it, X.lane); return; } it -= IT_FOUR;
  { const int l = it >> 4; transpose_item(a.in[IN_WROUT] + (size_t)l * 1024 * 64, 1024, 64, (bf16_t*)(ws + WS_WROUT_T) + (size_t)l * 64 * 1024, 0, scr, it & 15, X.lane); }
}
__device__ __forceinline__ void expert_item(const Ctx& X, LAS unsigned char* scr, int layer, int it) {
  const Args& a = *X.a; const int e = it / IT_EXP, r = it % IT_EXP;
  bf16_t* gu = (bf16_t*)(X.ws + (layer == 0 ? WS_WEXP + (size_t)e * EXP_STRIDE : WS_WEXP1 + (size_t)e * EXP1_STRIDE));
  bf16_t* dt = (bf16_t*)(X.ws + (layer == 0 ? WS_WEXP + (size_t)e * EXP_STRIDE + EXP_DOFF : WS_WEXP1 + (size_t)e * EXP1_STRIDE + EXP1_DOFF));
  const float *wg, *wu, *wd;
  if (e < 64) { const size_t o = ((size_t)layer * 64 + e) * 262144; wg = a.in[IN_WEG] + o; wu = a.in[IN_WEU] + o; wd = a.in[IN_WED] + o; }
  else { const size_t o = (size_t)layer * 262144; wg = a.in[IN_WSG] + o; wu = a.in[IN_WSU] + o; wd = a.in[IN_WSD] + o; }
  if (r < 64) transpose_item8(wg, 1024, 256, (unsigned char*)gu, 2, 32.f, scr, r, X.lane);
  else if (r < 128) transpose_item8(wu, 1024, 256, (unsigned char*)gu, 3, 32.f, scr, r - 64, X.lane);
  else transpose_item(wd, 256, 1024, dt, 0, scr, r - 128, X.lane);
}
__device__ __forceinline__ void transpose_work(const Ctx& X, unsigned* ctr, int first_small, int n_small, int layer, int n_exp_items, unsigned* done = nullptr, unsigned need = 0u) {
  LAS unsigned char* scr = X.lds + X.wave * 8192;
  volatile LAS int* shb = (volatile LAS int*)(X.lds + LDS_MISC_OFF + 1024);
  const int total = n_small + n_exp_items;
  const int per = done ? 1 : 4;
  for (;;) {
    __syncthreads();
    if (X.tid == 0) { int b = total; if (!done || __hip_atomic_load(done, __ATOMIC_RELAXED, __HIP_MEMORY_SCOPE_AGENT) < need) b = (int)atomicAdd(ctr, (unsigned)(8 * per)); shb[0] = b; }
    __syncthreads();
    const int base = shb[0];
    if (base >= total) break;
    for (int k = 0; k < per; ++k) { const int it = base + X.wave * per + k; if (it >= total) break;
      if (it < n_small) small_item(X, scr, first_small + it); else expert_item(X, scr, layer, it - n_small); }
  }
}

__device__ __forceinline__ void p0_adaln(const Ctx& X, int it) {
  const Args& a = *X.a; const int layer = it / 48, ct = it % 48, col = ct * 128 + X.lane;
  LAS float* sl = (LAS float*)X.lds;
  for (int i = X.tid; i < 2048; i += NTHR) { const float v = i < 1024 ? a.in[IN_C][i] : a.in[IN_CCTX][i - 1024]; sl[i] = v / (1.f + __expf(-v)); }
  __syncthreads();
  const float* W = a.in[IN_WADA] + (size_t)layer * 1024 * 6144 + col;
  float a0 = 0.f, a1 = 0.f, b0 = 0.f, b1 = 0.f; const int k0 = X.wave * 128;
#pragma unroll 16
  for (int k = 0; k < 128; ++k) { const float w0 = W[(size_t)(k0 + k) * 6144], w1 = W[(size_t)(k0 + k) * 6144 + 64]; const float s0 = sl[k0 + k], s1 = sl[1024 + k0 + k];
    a0 += s0 * w0; a1 += s1 * w0; b0 += s0 * w1; b1 += s1 * w1; }
  LAS float* red = sl + 2048;
  red[(X.wave * 128 + X.lane) * 2] = a0; red[(X.wave * 128 + X.lane) * 2 + 1] = a1; red[(X.wave * 128 + 64 + X.lane) * 2] = b0; red[(X.wave * 128 + 64 + X.lane) * 2 + 1] = b1;
  __syncthreads();
  if (X.tid < 256) { const int l = X.tid & 127, v = X.tid >> 7; float s = 0.f;
#pragma unroll
    for (int w = 0; w < 8; ++w) s += red[(w * 128 + l) * 2 + v];
    s += a.in[IN_BADA][layer * 6144 + ct * 128 + l];
    float* mod = (float*)(X.ws + WS_MOD);
    if (layer == 0) mod[v * 6144 + ct * 128 + l] = s; else if (v == 0) mod[2 * 6144 + ct * 128 + l] = s; }
  __syncthreads();
}

__device__ __forceinline__ void p0_s5tables(const Ctx& X, int g, int part) {
  const Args& a = *X.a;
  LAS f32x2* POW = (LAS f32x2*)X.lds;
  LAS f32x2* BB = (LAS f32x2*)(X.lds + 33792);
  LAS f32x2* CC = (LAS f32x2*)(X.lds + 33792 + 16384);
  LAS float* KK = (LAS float*)(X.lds + 33792 + 32768);
  LAS float* DD = (LAS float*)(X.lds + 33792 + 32768 + 65536);
  const int tid = X.tid;
  if (tid < 128) {
    const int dir = tid >> 6, p = tid & 63, idx = (dir * 32 + g) * 64 + p;
    const float lr = fminf(a.in[IN_LRE][idx], -1e-4f), li = a.in[IN_LIM][idx], dt = expf(a.in[IN_LDT][dir * 32 + g]);
    for (int tau = 0; tau <= 32; ++tau) { const float mg = expf(lr * dt * (float)tau); float sn, cs; sincospif(li * dt * (float)tau * 0.318309886183790672f, &sn, &cs); POW[(dir * 33 + tau) * 64 + p] = (f32x2){mg * cs, mg * sn}; }
    const f32x2 l1 = POW[(dir * 33 + 1) * 64 + p], l32 = POW[(dir * 33 + 32) * 64 + p];
    if (part == 0) ((float2*)(X.ws + WS_LAML))[idx] = make_float2(l32.x, l32.y);
    const float nr = l1.x - 1.f, ni = l1.y, den = lr * lr + li * li, cr = (nr * lr + ni * li) / den, ci = (ni * lr - nr * li) / den;
    for (int c = 0; c < 16; ++c) { const float xr = a.in[IN_BRE][idx * 16 + c], xi = a.in[IN_BIM][idx * 16 + c]; BB[(dir * 64 + p) * 16 + c] = (f32x2){cr * xr - ci * xi, cr * xi + ci * xr}; }
  }
  for (int i = tid; i < 2048; i += NTHR) { const int dir = i >> 10, c = (i >> 6) & 15, p = i & 63; const int gi = ((dir * 32 + g) * 16 + c) * 64 + p; CC[i] = (f32x2){a.in[IN_CRE][gi], a.in[IN_CIM][gi]}; }
  if (tid < 16) DD[tid] = a.in[IN_S5D][g * 16 + tid];
  __syncthreads();
  for (int combo = tid; combo < 1024; combo += NTHR) {
    const int dir = combo >> 9, tau = (combo >> 4) & 31, c = combo & 15;
    float accv[16];
#pragma unroll
    for (int j = 0; j < 16; ++j) accv[j] = 0.f;
#pragma unroll 2
    for (int p = 0; p < 64; ++p) {
      const f32x2 cc = CC[(dir * 16 + c) * 64 + p], pw = POW[(dir * 33 + tau) * 64 + p];
      const float zr = cc.x * pw.x - cc.y * pw.y, zi = cc.x * pw.y + cc.y * pw.x;
      const LAS f32x4* bp = (const LAS f32x4*)(BB + (dir * 64 + p) * 16);
#pragma unroll
      for (int j = 0; j < 8; ++j) { const f32x4 b = bp[j]; accv[2 * j] += zr * b.x - zi * b.y; accv[2 * j + 1] += zr * b.z - zi * b.w; }
    }
#pragma unroll
    for (int j = 0; j < 4; ++j) *(LAS f32x4*)(KK + ((dir * 32 + tau) * 16 + c) * 16 + 4 * j) = (f32x4){accv[4 * j], accv[4 * j + 1], accv[4 * j + 2], accv[4 * j + 3]};
  }
  __syncthreads();
  bf16_t* TT = (bf16_t*)(X.ws + WS_TT) + (size_t)g * 512 * 768;
  for (int q = part * 12288 + tid; q < (part + 1) * 12288; q += NTHR) {
    const int row = q / 96, cc8 = q % 96, i = row >> 4, c = row & 15; f32x4 v0, v1;
    if (cc8 < 64) {
      const int s = cc8 >> 1, c0 = (cc8 & 1) * 8;
      const int dir = s < i ? 0 : 1, tau = s < i ? i - s : s - i;
      const LAS f32x4* kp = (const LAS f32x4*)(KK + ((dir * 32 + tau) * 16 + c) * 16 + c0);
      v0 = kp[0]; v1 = kp[1];
      if (s == i) { const LAS f32x4* k0p = (const LAS f32x4*)(KK + ((0 * 32 + 0) * 16 + c) * 16 + c0); v0 += k0p[0]; v1 += k0p[1];
        const float d = DD[c]; const int dj = c - c0;
        if (dj >= 0 && dj < 4) v0[dj] += d; else if (dj >= 4 && dj < 8) v1[dj - 4] += d; }
    } else {
      const int kk = (cc8 - 64) * 8, dir = kk >> 7, ri = (kk >> 6) & 1, p0 = kk & 63, tau = dir == 0 ? i + 1 : 32 - i;
      const LAS f32x4* cp = (const LAS f32x4*)(CC + (dir * 16 + c) * 64 + p0); const LAS f32x4* pp = (const LAS f32x4*)(POW + (dir * 33 + tau) * 64 + p0);
      float v[8];
#pragma unroll
      for (int j = 0; j < 4; ++j) { const f32x4 cc = cp[j], pw = pp[j];
        v[2 * j] = ri == 0 ? (cc.x * pw.x - cc.y * pw.y) : -(cc.x * pw.y + cc.y * pw.x); v[2 * j + 1] = ri == 0 ? (cc.z * pw.z - cc.w * pw.w) : -(cc.z * pw.w + cc.w * pw.z); }
      v0 = (f32x4){v[0], v[1], v[2], v[3]}; v1 = (f32x4){v[4], v[5], v[6], v[7]};
    }
    *(u32x4*)(TT + (size_t)row * 768 + cc8 * 8) = pack8(v0, v1);
  }
  bf16_t* WSm = (bf16_t*)(X.ws + WS_WS) + (size_t)g * 256 * 512;
  for (int q = part * 4096 + tid; q < (part + 1) * 4096; q += NTHR) {
    const int n = q >> 6, cc8 = q & 63, dir = n >> 7, ri = (n >> 6) & 1, p = n & 63, s = cc8 >> 1, c0 = (cc8 & 1) * 8, tau = dir == 0 ? 31 - s : s;
    const f32x2 pw = POW[(dir * 33 + tau) * 64 + p]; const LAS f32x4* bp = (const LAS f32x4*)(BB + (dir * 64 + p) * 16 + c0); float v[8];
#pragma unroll
    for (int j = 0; j < 4; ++j) { const f32x4 b = bp[j]; v[2 * j] = ri == 0 ? (pw.x * b.x - pw.y * b.y) : (pw.x * b.y + pw.y * b.x); v[2 * j + 1] = ri == 0 ? (pw.x * b.z - pw.y * b.w) : (pw.x * b.w + pw.y * b.z); }
    *(u32x4*)(WSm + (size_t)n * 512 + cc8 * 8) = pack8((f32x4){v[0], v[1], v[2], v[3]}, (f32x4){v[4], v[5], v[6], v[7]});
  }
  __syncthreads();
}

__device__ __forceinline__ void p0_dftconst(const Ctx& X, int idx) {
  for (int q = idx * NTHR + X.tid; q < 32768; q += 32 * NTHR) {
    float v[8]; bf16_t* dst;
    if (q < 16384) {
      const int R = q >> 5, c0 = (q & 31) * 8, ri = R >> 8, m = R & 255; dst = (bf16_t*)(X.ws + WS_DMT) + (size_t)R * 256 + c0;
#pragma unroll
      for (int j = 0; j < 8; ++j) { float s, c; sincospif((float)(((c0 + j) * m) & 255) * (1.f / 128.f), &s, &c); v[j] = ri == 0 ? c : -s; }
    } else if (q < 24576) {
      const int q2 = q - 16384, R = q2 >> 5, c0 = (q2 & 31) * 8, rip = R >> 7, ka = R & 127; dst = (bf16_t*)(X.ws + WS_W1) + (size_t)R * 256 + c0;
#pragma unroll
      for (int j = 0; j < 8; ++j) { const int C = c0 + j, ri = C >> 7, ta = C & 127; float s, c; sincospif((float)((ka * ta) & 127) * (1.f / 64.f), &s, &c);
        v[j] = (rip == ri) ? c : (rip == 0 ? s : -s); }
    } else {
      const int q2 = q - 24576, R = q2 >> 5, c0 = (q2 & 31) * 8; dst = (bf16_t*)(X.ws + WS_W2) + (size_t)R * 256 + c0;
#pragma unroll
      for (int j = 0; j < 8; ++j) { const int C = c0 + j, rip = C >> 7, tb = C & 127; float s, c; sincospif((float)((R * tb) & 127) * (1.f / 64.f), &s, &c);
        v[j] = R < 128 ? (rip == 0 ? c : s) * (1.f / 2048.f) : 0.f; }
    }
    u32x4 o; o.x = cvt_pk_bf16(v[0], v[1]); o.y = cvt_pk_bf16(v[2], v[3]); o.z = cvt_pk_bf16(v[4], v[5]); o.w = cvt_pk_bf16(v[6], v[7]);
    *(u32x4*)dst = o;
  }
}

__device__ __forceinline__ void phase_prep(const Ctx& X, int rep) {
  const int c = X.c;
  if (c < 96) p0_adaln(X, c);
  else if (c < 224) p0_s5tables(X, (c - 96) >> 2, (c - 96) & 3);
  else p0_dftconst(X, c - 224);
  __syncthreads();
  unsigned* ctl = (unsigned*)(X.ws + WS_CTL);
  transpose_work(X, ctl + CW_DQ0 + 128 * rep, 0, IT_SMALL, (X.a->flags & 2) ? 1 : 0, (X.a->flags & FLAG_SKIP_EXPERTS) ? 0 : 65 * IT_EXP);
}

__device__ __forceinline__ void modulate_row(const float* hrow, const float* shift, const float* scale, bf16_t* orow, int lane) {
  const f32x4* xr = (const f32x4*)hrow + lane; f32x4 v[4]; float ss = 0.f;
#pragma unroll
  for (int j = 0; j < 4; ++j) { v[j] = xr[64 * j]; ss += (v[j].x * v[j].x + v[j].y * v[j].y) + (v[j].z * v[j].z + v[j].w * v[j].w); }
  const float r = rsqrtf(wave_sum(ss) * (1.f / 1024.f) + 1e-6f);
  u32x2* o8 = (u32x2*)orow + lane;
#pragma unroll
  for (int j = 0; j < 4; ++j) { const f32x4 sh = ((const f32x4*)shift)[lane + 64 * j], sc = ((const f32x4*)scale)[lane + 64 * j];
    u32x2 w; w.x = cvt_pk_bf16(v[j].x * r * (1.f + sc.x) + sh.x, v[j].y * r * (1.f + sc.y) + sh.y); w.y = cvt_pk_bf16(v[j].z * r * (1.f + sc.z) + sh.z, v[j].w * r * (1.f + sc.w) + sh.w);
    o8[64 * j] = w; }
}
__device__ __forceinline__ void phase_mod0(const Ctx& X) {
  const Args& a = *X.a; const float* mod = (const float*)(X.ws + WS_MOD); bf16_t* A0 = (bf16_t*)(X.ws + WS_A0);
  const int gw = X.c * NWAVES + X.wave, NGW = X.G * NWAVES;
  for (int r = gw; r < NROW; r += NGW) {
    if (r < TOK) modulate_row(a.in[IN_X] + (size_t)r * 1024, mod, mod + 1024, A0 + (size_t)r * 1024, X.lane);
    else modulate_row(a.in[IN_CTX] + (size_t)(r - TOK) * 1024, mod + 6144, mod + 6144 + 1024, A0 + (size_t)r * 1024, X.lane);
  }
}


struct G1 {
  static constexpr bool PERM = true; static constexpr bool F8 = false; static constexpr int SCALE_B = 0x7A7A7A7A; static constexpr bool CONTIG = false; static constexpr bool ALIGN = true; static constexpr bool LINA = true, LINB = true; __device__ __forceinline__ size_t halfA() const { return 128u * 2048u; } __device__ __forceinline__ size_t halfB() const { return 128u * 2048u; } int K, nunits; unsigned char* ws; const float* qg; const float* kg;
  __device__ __forceinline__ void decode(int w, Unit& u) const { if (w < 390) { u.a = 0; u.pm = w / 6; u.pn = w % 6; } else { const int w2 = w - 390; u.a = 1; u.pm = w2 & 1; u.pn = w2 >> 1; } u.b = 0; }
  __device__ __forceinline__ const char* baseA(const Unit& u) const { return (const char*)ws + (u.a == 0 ? WS_A0 : WS_WIN_T + (size_t)1536 * 2048); }
  __device__ __forceinline__ const char* baseB(const Unit& u) const { return (const char*)ws + (u.a == 0 ? WS_WIN_T : WS_A0); }
  __device__ __forceinline__ unsigned rowA(const Unit& u, int r) const { return (unsigned)(u.pm * 256 + r) * 2048u; }
  __device__ __forceinline__ unsigned rowB(const Unit& u, int r) const { return (unsigned)(u.pn * 256 + r) * 2048u; }
  __device__ __forceinline__ void epi(const Acc& acc, const Unit& u, int wr, int wc, int fr, int fq) const {
    if (u.a == 1) {
      bf16_t* VT = (bf16_t*)(ws + WS_VT);
#pragma unroll
      for (int ai = 0; ai < 2; ++ai)
#pragma unroll
        for (int m = 0; m < 4; ++m) { const int dd = u.pm * 256 + ai * 128 + wr * 64 + m * 16 + fr, head = dd >> 6, d = dd & 63;
#pragma unroll
          for (int bj = 0; bj < 2; ++bj) { const int t0 = u.pn * 256 + bj * 128 + wc * 32 + 8 * fq, kr = t0 >> 6, cg = (t0 >> 3) & 7;
            *(u32x4*)(VT + ((((size_t)(head * 260 + kr) * 8 + cg) * 64 + d) * 8)) = pack8(acc[ai][bj][m][0], acc[ai][bj][m][1]); } }
      return;
    }
    if (u.pn < 2) {
      bf16_t* AS5 = (bf16_t*)(ws + WS_AS5);
#pragma unroll
      for (int ai = 0; ai < 2; ++ai)
#pragma unroll
        for (int m = 0; m < 4; ++m) { const int row = u.pm * 256 + ai * 128 + wr * 64 + m * 16 + fr; int crow, s;
          if (row < TOK) { crow = row >> 5; s = row & 31; } else { const int j = row - TOK; crow = 512 + (j >> 5); s = j & 31; }
#pragma unroll
          for (int bj = 0; bj < 2; ++bj) { const int g = 16 * u.pn + 8 * bj + 2 * wc + (fq >> 1), c0 = 8 * (fq & 1);
            *(u32x4*)(AS5 + ((size_t)(g * 768 + crow) * 768 + s * 16 + c0)) = pack8(acc[ai][bj][m][0], acc[ai][bj][m][1]); } }
      return;
    }
    const bool isq = u.pn < 4;
    if (isq && u.pm == 64) return;
    const int head = 4 * ((u.pn - 2) & 1) + wc; const float* gain = isq ? qg : kg;
    bf16_t* dst = isq ? (bf16_t*)(ws + WS_Q) : (bf16_t*)(ws + WS_K);
    f32x4 gv[2][2];
#pragma unroll
    for (int bj = 0; bj < 2; ++bj) { gv[bj][0] = *(const f32x4*)(gain + 32 * bj + 8 * fq); gv[bj][1] = *(const f32x4*)(gain + 32 * bj + 8 * fq + 4); }
#pragma unroll
    for (int ai = 0; ai < 2; ++ai)
#pragma unroll
      for (int m = 0; m < 4; ++m) { const int row = u.pm * 256 + ai * 128 + wr * 64 + m * 16 + fr; float ss = 0.f;
#pragma unroll
        for (int bj = 0; bj < 2; ++bj)
#pragma unroll
          for (int n = 0; n < 2; ++n) { const f32x4 x = acc[ai][bj][m][n]; ss += (x[0] * x[0] + x[1] * x[1]) + (x[2] * x[2] + x[3] * x[3]); }
        ss += sx(ss, 16); ss += sx(ss, 32);
        const float rinv = rsqrtf(ss * (1.f / 64.f) + 1e-6f);
#pragma unroll
        for (int bj = 0; bj < 2; ++bj) { const f32x4 v0 = acc[ai][bj][m][0] * rinv * gv[bj][0], v1 = acc[ai][bj][m][1] * rinv * gv[bj][1];
          if (isq) *(u32x4*)(dst + (size_t)row * 512 + head * 64 + 32 * bj + 8 * fq) = pack8(v0, v1);
          else { const int kr = row >> 6, cg = (row >> 3) & 7, k8 = row & 7, ks = 2 * bj + (fq >> 1), hh2 = fq & 1;
            *(u32x4*)(dst + (((((size_t)(head * 260 + kr) * 8 + cg) * 4 + ks) * 8 + k8) * 2 + hh2) * 8) = pack8(v0, v1); } } }
  }
};

struct G2 {
  static constexpr bool PERM = true; static constexpr bool F8 = false; static constexpr int SCALE_B = 0x7A7A7A7A; static constexpr bool CONTIG = false; static constexpr bool ALIGN = true; static constexpr bool LINA = true, LINB = true; __device__ __forceinline__ size_t halfA() const { return 128u * 1536u; } __device__ __forceinline__ size_t halfB() const { return 128u * 1024u; } int K, nunits; unsigned char* ws;
  __device__ __forceinline__ void decode(int w, Unit& u) const { u.a = w / 3; u.pm = w % 3; u.pn = 0; u.b = 0; }
  __device__ __forceinline__ const char* baseA(const Unit& u) const { return (const char*)ws + WS_AS5 + (size_t)u.a * 768 * 768 * 2; }
  __device__ __forceinline__ const char* baseB(const Unit& u) const { return (const char*)ws + WS_WS + (size_t)u.a * 256 * 512 * 2; }
  __device__ __forceinline__ unsigned rowA(const Unit& u, int r) const { return (unsigned)(u.pm * 256 + r) * 1536u; }
  __device__ __forceinline__ unsigned rowB(const Unit& u, int r) const { return (unsigned)r * 1024u; }
  __device__ __forceinline__ void epi(const Acc& acc, const Unit& u, int wr, int wc, int fr, int fq) const {
    float* SST = (float*)(ws + WS_SST) + (size_t)u.a * 768 * 256;
#pragma unroll
    for (int ai = 0; ai < 2; ++ai)
#pragma unroll
      for (int m = 0; m < 4; ++m) { const int crow = u.pm * 256 + ai * 128 + wr * 64 + m * 16 + fr; if (crow >= 520) continue;
#pragma unroll
        for (int bj = 0; bj < 2; ++bj) { float* p = SST + (size_t)crow * 256 + bj * 128 + wc * 32 + 8 * fq; *(f32x4*)p = acc[ai][bj][m][0]; *(f32x4*)(p + 4) = acc[ai][bj][m][1]; } }
  }
};

struct G3 {
  static constexpr bool PERM = true; static constexpr bool F8 = false; static constexpr int SCALE_B = 0x7A7A7A7A; static constexpr bool CONTIG = false; static constexpr bool ALIGN = true; static constexpr bool LINA = true, LINB = true; __device__ __forceinline__ size_t halfA() const { return 128u * 1536u; } __device__ __forceinline__ size_t halfB() const { return 128u * 1536u; } int K, nunits; unsigned char* ws;
  __device__ __forceinline__ void decode(int w, Unit& u) const { u.a = w >> 2; u.pm = (w >> 1) & 1; u.pn = w & 1; u.b = 0; }
  __device__ __forceinline__ const char* baseA(const Unit& u) const { return (const char*)ws + WS_AS5 + (size_t)u.a * 768 * 768 * 2; }
  __device__ __forceinline__ const char* baseB(const Unit& u) const { return (const char*)ws + WS_TT + (size_t)u.a * 512 * 768 * 2; }
  __device__ __forceinline__ unsigned rowA(const Unit& u, int r) const { return (unsigned)(u.pm * 256 + r) * 1536u; }
  __device__ __forceinline__ unsigned rowB(const Unit& u, int r) const { return (unsigned)(u.pn * 256 + r) * 1536u; }
  __device__ __forceinline__ void epi(const Acc& acc, const Unit& u, int wr, int wc, int fr, int fq) const {
    bf16_t* GB = (bf16_t*)(ws + WS_GB);
#pragma unroll
    for (int ai = 0; ai < 2; ++ai)
#pragma unroll
      for (int m = 0; m < 4; ++m) { const int crow = u.pm * 256 + ai * 128 + wr * 64 + m * 16 + fr;
#pragma unroll
        for (int bj = 0; bj < 2; ++bj) { const int pp = u.pn * 256 + bj * 128 + wc * 32 + 8 * fq, i = pp >> 4, c0 = pp & 15; f32x4 v0 = acc[ai][bj][m][0], v1 = acc[ai][bj][m][1];
#pragma unroll
          for (int j = 0; j < 4; ++j) { v0[j] = gelu_tanh(v0[j]); v1[j] = gelu_tanh(v1[j]); }
          *(u32x4*)(GB + (size_t)(crow * 32 + i) * 512 + u.a * 16 + c0) = pack8(v0, v1); } }
  }
};

struct G4 {
  static constexpr bool PERM = true; static constexpr bool F8 = false; static constexpr int SCALE_B = 0x7A7A7A7A; static constexpr bool CONTIG = false; static constexpr bool ALIGN = true; static constexpr bool LINA = true, LINB = true; __device__ __forceinline__ size_t halfA() const { return 128u * 1024u; } __device__ __forceinline__ size_t halfB() const { return 128u * 1024u; } int K, nunits; unsigned char* ws; const float* bglu;
  __device__ __forceinline__ void decode(int w, Unit& u) const { u.pm = w >> 1; u.pn = w & 1; u.a = 0; u.b = 0; }
  __device__ __forceinline__ const char* baseA(const Unit&) const { return (const char*)ws + WS_GB; }
  __device__ __forceinline__ const char* baseB(const Unit&) const { return (const char*)ws + WS_WGLU_T; }
  __device__ __forceinline__ unsigned rowA(const Unit& u, int r) const { return (unsigned)(u.pm * 256 + r) * 1024u; }
  __device__ __forceinline__ unsigned rowB(const Unit& u, int r) const { return (unsigned)(u.pn * 256 + r) * 1024u; }
  __device__ __forceinline__ void epi(const Acc& acc, const Unit& u, int wr, int wc, int fr, int fq) const {
    const bf16_t* GB = (const bf16_t*)(ws + WS_GB); bf16_t* CC = (bf16_t*)(ws + WS_CONCAT);
#pragma unroll
    for (int bj = 0; bj < 2; ++bj) { const int col0 = u.pn * 256 + bj * 128 + wc * 32 + 8 * fq; const f32x4 b0 = *(const f32x4*)(bglu + col0), b1 = *(const f32x4*)(bglu + col0 + 4);
#pragma unroll
      for (int ai = 0; ai < 2; ++ai)
#pragma unroll
        for (int m = 0; m < 4; ++m) { const int row = u.pm * 256 + ai * 128 + wr * 64 + m * 16 + fr; const u32x4 gw = *(const u32x4*)(GB + (size_t)row * 512 + col0);
          f32x4 v0 = acc[ai][bj][m][0] + b0, v1 = acc[ai][bj][m][1] + b1;
          v0[0] = bf_lo(gw.x) * fast_sigmoid(v0[0]); v0[1] = bf_hi(gw.x) * fast_sigmoid(v0[1]); v0[2] = bf_lo(gw.y) * fast_sigmoid(v0[2]); v0[3] = bf_hi(gw.y) * fast_sigmoid(v0[3]);
          v1[0] = bf_lo(gw.z) * fast_sigmoid(v1[0]); v1[1] = bf_hi(gw.z) * fast_sigmoid(v1[1]); v1[2] = bf_lo(gw.w) * fast_sigmoid(v1[2]); v1[3] = bf_hi(gw.w) * fast_sigmoid(v1[3]);
          *(u32x4*)(CC + (size_t)row * 1024 + col0) = pack8(v0, v1); } }
  }
};

struct GRes {
  static constexpr bool PERM = true; static constexpr bool F8 = false; static constexpr int SCALE_B = 0x7A7A7A7A; static constexpr bool CONTIG = false; static constexpr bool ALIGN = true; static constexpr bool LINA = true, LINB = true;
  __device__ __forceinline__ size_t halfA() const { return 128u * 2048u; } __device__ __forceinline__ size_t halfB() const { return 128u * 2048u; }
  int K, nunits; const char* A; const char* Bt; const float* hin32; const bf16_t* hin16; bf16_t* hout; const float* gate; const float* bias;
  __device__ __forceinline__ void decode(int w, Unit& u) const { u.pm = w >> 2; u.pn = w & 3; u.a = 0; u.b = 0; }
  __device__ __forceinline__ const char* baseA(const Unit&) const { return A; }
  __device__ __forceinline__ const char* baseB(const Unit&) const { return Bt; }
  __device__ __forceinline__ unsigned rowA(const Unit& u, int r) const { return (unsigned)(u.pm * 256 + r) * 2048u; }
  __device__ __forceinline__ unsigned rowB(const Unit& u, int r) const { return (unsigned)(u.pn * 256 + r) * 2048u; }
  __device__ __forceinline__ void epi(const Acc& acc, const Unit& u, int wr, int wc, int fr, int fq) const {
#pragma unroll
    for (int bj = 0; bj < 2; ++bj) { const int col0 = u.pn * 256 + bj * 128 + wc * 32 + 8 * fq;
      const f32x4 g0 = *(const f32x4*)(gate + col0), g1 = *(const f32x4*)(gate + col0 + 4);
      f32x4 b0 = (f32x4){0.f, 0.f, 0.f, 0.f}, b1 = b0; if (bias) { b0 = *(const f32x4*)(bias + col0); b1 = *(const f32x4*)(bias + col0 + 4); }
#pragma unroll
      for (int ai = 0; ai < 2; ++ai)
#pragma unroll
        for (int m = 0; m < 4; ++m) { const size_t off = (size_t)(u.pm * 256 + ai * 128 + wr * 64 + m * 16 + fr) * 1024 + col0;
          f32x4 h0, h1;
          if (hin32) { h0 = *(const f32x4*)(hin32 + off); h1 = *(const f32x4*)(hin32 + off + 4); }
          else { const u32x4 w = *(const u32x4*)(hin16 + off); h0 = (f32x4){bf_lo(w.x), bf_hi(w.x), bf_lo(w.y), bf_hi(w.y)}; h1 = (f32x4){bf_lo(w.z), bf_hi(w.z), bf_lo(w.w), bf_hi(w.w)}; }
          *(u32x4*)(hout + off) = pack8(h0 + g0 * (acc[ai][bj][m][0] + b0), h1 + g1 * (acc[ai][bj][m][1] + b1)); } }
  }
};

__device__ __forceinline__ void build_moetab(const Ctx& X, int layer, LAS int* toff) {
  const unsigned* cnt = (const unsigned*)(X.ws + WS_CTL) + CW_CNT + layer * 128;
  LAS int* texp = toff + 256;
  LAS int* ntile = toff + 132;
  __syncthreads();
  if (X.tid < 64) ntile[X.tid] = ((int)__hip_atomic_load(cnt + X.tid, __ATOMIC_RELAXED, __HIP_MEMORY_SCOPE_AGENT) + 255) >> 8;
  __syncthreads();
  if (X.tid == 0) { int s = 0; for (int e = 0; e < 64; ++e) { toff[e] = s; s += ntile[e]; } toff[64] = s; toff[65] = s + 64; }
  __syncthreads();
  if (X.tid < 65) { const int e = X.tid; const int lo = toff[e], hi = toff[e + 1]; for (int t = lo; t < hi && t < 704; ++t) texp[t] = e; }
  __syncthreads();
}
__device__ __forceinline__ int find_expert(const LAS int* toff, int ti) { return toff[256 + ti]; }

struct G6 {
  static constexpr bool PERM = true; static constexpr bool F8 = true; static constexpr int SCALE_B = 0x7A7A7A7A; static constexpr bool CONTIG = false; static constexpr bool ALIGN = true; static constexpr bool LINA = false, LINB = true;
  __device__ __forceinline__ size_t halfA() const { return 0; } __device__ __forceinline__ size_t halfB() const { return 128u * 1024u; }
  int K, nunits; unsigned char* ws; const LAS int* toff; const LAS unsigned* tokt; const char* wbase; size_t wstride;
  __device__ __forceinline__ void decode(int w, Unit& u) const { const int ti = w >> 1; u.pn = w & 1; u.a = find_expert(toff, ti); u.pm = ti - toff[u.a]; u.b = ti; }
  __device__ __forceinline__ const char* baseA(const Unit&) const { return (const char*)ws + WS_F; }
  __device__ __forceinline__ const char* baseB(const Unit& u) const { return wbase + (size_t)u.a * wstride; }
  __device__ __forceinline__ unsigned rowA(const Unit& u, int r) const { return tokt[u.ord * 256 + r]; }
  __device__ __forceinline__ void build_tokt(const Ctx& X, LAS unsigned* tk) const {
    for (int i = 0; i * X.G + X.c < nunits; ++i) { Unit u; decode(xcd_remap(i * X.G + X.c, nunits), u);
      if (X.tid < 256) { const int idx = u.pm * 256 + X.tid; int tok = idx;
        if (u.a < 64) tok = ((const int*)(ws + WS_LTOK))[u.a * 16384 + idx];
        tk[i * 256 + X.tid] = (unsigned)tok * 1024u; } }
    __syncthreads();
  }
  __device__ __forceinline__ unsigned rowB(const Unit& u, int r) const { return (unsigned)(u.pn * 256 + r) * 1024u; }
  __device__ __forceinline__ void epi(const Acc& acc, const Unit& u, int wr, int wc, int fr, int fq) const {
    bf16_t* HID = (bf16_t*)(ws + WS_HID);
#pragma unroll
    for (int ai = 0; ai < 2; ++ai)
#pragma unroll
      for (int m = 0; m < 4; ++m) { const size_t hrow = (size_t)u.b * 256 + ai * 128 + wr * 64 + m * 16 + fr; f32x4 v0, v1;
#pragma unroll
        for (int j = 0; j < 4; ++j) { const float g0 = acc[ai][0][m][0][j] * 0.03125f, g1 = acc[ai][0][m][1][j] * 0.03125f; v0[j] = g0 * fast_sigmoid(g0) * (acc[ai][1][m][0][j] * 0.03125f); v1[j] = g1 * fast_sigmoid(g1) * (acc[ai][1][m][1][j] * 0.03125f); }
        *(u32x4*)(HID + hrow * 256 + u.pn * 128 + wc * 32 + 8 * fq) = pack8(v0, v1); }
  }
};
struct G7 {
  static constexpr bool PERM = true; static constexpr bool F8 = false; static constexpr int SCALE_B = 0x7A7A7A7A; static constexpr bool CONTIG = false; static constexpr bool ALIGN = true; static constexpr bool LINA = true, LINB = true;
  __device__ __forceinline__ size_t halfA() const { return 128u * 512u; } __device__ __forceinline__ size_t halfB() const { return 128u * 512u; }
  int K, nunits; unsigned char* ws; const LAS int* toff; const char* wbase; size_t wstride;
  __device__ __forceinline__ void decode(int w, Unit& u) const { const int ti = w >> 2; u.pn = w & 3; u.a = find_expert(toff, ti); u.pm = ti - toff[u.a]; u.b = ti; }
  __device__ __forceinline__ const char* baseA(const Unit&) const { return (const char*)ws + WS_HID; }
  __device__ __forceinline__ const char* baseB(const Unit& u) const { return wbase + (size_t)u.a * wstride; }
  __device__ __forceinline__ unsigned rowA(const Unit& u, int r) const { return (unsigned)(u.b * 256 + r) * 512u; }
  __device__ __forceinline__ unsigned rowB(const Unit& u, int r) const { return (unsigned)(u.pn * 256 + r) * 512u; }
  __device__ __forceinline__ void epi(const Acc& acc, const Unit& u, int wr, int wc, int fr, int fq) const {
    unsigned char* YAS = ws + WS_YAS;
#pragma unroll
    for (int ai = 0; ai < 2; ++ai)
#pragma unroll
      for (int m = 0; m < 4; ++m) { const size_t yrow = (size_t)u.b * 256 + ai * 128 + wr * 64 + m * 16 + fr;
#pragma unroll
        for (int bj = 0; bj < 2; ++bj) { const f32x4 v0 = acc[ai][bj][m][0], v1 = acc[ai][bj][m][1]; int w0 = 0, w1 = 0;
          w0 = __builtin_amdgcn_cvt_pk_fp8_f32(v0[0], v0[1], w0, false); w0 = __builtin_amdgcn_cvt_pk_fp8_f32(v0[2], v0[3], w0, true);
          w1 = __builtin_amdgcn_cvt_pk_fp8_f32(v1[0], v1[1], w1, false); w1 = __builtin_amdgcn_cvt_pk_fp8_f32(v1[2], v1[3], w1, true);
          *(u32x2*)(YAS + yrow * 1024 + u.pn * 256 + bj * 128 + wc * 32 + 8 * fq) = (u32x2){(unsigned)w0, (unsigned)w1}; } }
  }
};

struct G8 {
  static constexpr bool PERM = true; static constexpr bool F8 = false; static constexpr int SCALE_B = 0x7A7A7A7A; static constexpr bool CONTIG = false; static constexpr bool ALIGN = true; static constexpr bool LINA = true, LINB = false; __device__ __forceinline__ size_t halfA() const { return 128u * 512u; } __device__ __forceinline__ size_t halfB() const { return 0; } int K, nunits; unsigned char* ws;
  __device__ __forceinline__ void decode(int w, Unit& u) const { u.pm = w >> 8; u.a = (w >> 6) & 3; u.pn = w & 63; u.b = 0; }
  __device__ __forceinline__ const char* baseA(const Unit&) const { return (const char*)ws + WS_DMT; }
  __device__ __forceinline__ const char* baseB(const Unit& u) const { return (const char*)ws + WS_A1 + (size_t)u.a * 512; }
  __device__ __forceinline__ unsigned rowA(const Unit& u, int r) const { return (unsigned)(u.pm * 256 + r) * 512u; }
  __device__ __forceinline__ unsigned rowB(const Unit& u, int r) const { const int n = u.pn * 256 + r; return (unsigned)(128 * (n & 127) + (n >> 7)) * 2048u; }
  __device__ __forceinline__ void epi(const Acc& acc, const Unit& u, int wr, int wc, int fr, int fq) const {
    bf16_t* X1 = (bf16_t*)(ws + WS_X1);
#pragma unroll
    for (int ai = 0; ai < 2; ++ai)
#pragma unroll
      for (int m = 0; m < 4; ++m) { const int mm = ai * 128 + wr * 64 + m * 16 + fr;
#pragma unroll
        for (int bj = 0; bj < 2; ++bj) { const int n0 = u.pn * 256 + bj * 128 + wc * 32 + 8 * fq, tb = n0 >> 7, ta0 = n0 & 127;
          *(u32x4*)(X1 + ((((size_t)(u.a * 256 + mm) * 128 + tb) * 2 + u.pm) * 128 + ta0)) = pack8(acc[ai][bj][m][0], acc[ai][bj][m][1]); } }
  }
};
struct G9 {
  static constexpr bool PERM = true; static constexpr bool F8 = false; static constexpr int SCALE_B = 0x7A7A7A7A; static constexpr bool CONTIG = false; static constexpr bool ALIGN = true; static constexpr bool LINA = true, LINB = true; __device__ __forceinline__ size_t halfA() const { return 128u * 512u; } __device__ __forceinline__ size_t halfB() const { return 128u * 512u; } int K, nunits; unsigned char* ws;
  __device__ __forceinline__ void decode(int w, Unit& u) const { u.pm = 0; u.pn = w; u.a = 0; u.b = 0; }
  __device__ __forceinline__ const char* baseA(const Unit&) const { return (const char*)ws + WS_W1; }
  __device__ __forceinline__ const char* baseB(const Unit&) const { return (const char*)ws + WS_X1; }
  __device__ __forceinline__ unsigned rowA(const Unit&, int r) const { return (unsigned)r * 512u; }
  __device__ __forceinline__ unsigned rowB(const Unit& u, int r) const { return (unsigned)(u.pn * 256 + r) * 512u; }
  __device__ __forceinline__ void epi(const Acc& acc, const Unit& u, int wr, int wc, int fr, int fq) const {
    bf16_t* X2 = (bf16_t*)(ws + WS_X2);
#pragma unroll
    for (int m = 0; m < 4; ++m) { const int ka = wr * 64 + m * 16 + fr;
#pragma unroll
      for (int bj = 0; bj < 2; ++bj) { const int n0 = u.pn * 256 + bj * 128 + wc * 32 + 8 * fq, gm = n0 >> 7, tb0 = n0 & 127; f32x4 r0, r1, i0, i1;
#pragma unroll
        for (int j = 0; j < 4; ++j) {
          { const float ang = (float)((ka * (tb0 + j)) & 16383) * (1.f / 16384.f), cs = __builtin_amdgcn_cosf(ang), sn = __builtin_amdgcn_sinf(ang); const float yr = acc[0][bj][m][0][j], yi = acc[1][bj][m][0][j]; r0[j] = yr * cs + yi * sn; i0[j] = yi * cs - yr * sn; }
          { const float ang = (float)((ka * (tb0 + 4 + j)) & 16383) * (1.f / 16384.f), cs = __builtin_amdgcn_cosf(ang), sn = __builtin_amdgcn_sinf(ang); const float yr = acc[0][bj][m][1][j], yi = acc[1][bj][m][1][j]; r1[j] = yr * cs + yi * sn; i1[j] = yi * cs - yr * sn; } }
        bf16_t* p = X2 + (((size_t)(gm * 128 + ka) * 2) * 128 + tb0); *(u32x4*)p = pack8(r0, r1); *(u32x4*)(p + 128) = pack8(i0, i1); } }
  }
};
struct G10 {
  static constexpr bool PERM = true; static constexpr bool F8 = false; static constexpr int SCALE_B = 0x7A7A7A7A; static constexpr bool CONTIG = false; static constexpr bool ALIGN = true; static constexpr bool LINA = true, LINB = false; __device__ __forceinline__ size_t halfA() const { return 128u * 512u; } __device__ __forceinline__ size_t halfB() const { return 0; } int K, nunits; unsigned char* ws;
  __device__ __forceinline__ void decode(int w, Unit& u) const { u.pm = 0; u.pn = w; u.a = 0; u.b = 0; }
  __device__ __forceinline__ const char* baseA(const Unit&) const { return (const char*)ws + WS_W2; }
  __device__ __forceinline__ const char* baseB(const Unit&) const { return (const char*)ws + WS_X2; }
  __device__ __forceinline__ unsigned rowA(const Unit&, int r) const { return (unsigned)r * 512u; }
  __device__ __forceinline__ unsigned rowB(const Unit& u, int r) const { const int n = u.pn * 256 + r, ka = n >> 10, gm = n & 1023; return (unsigned)(gm * 128 + ka) * 512u; }
  __device__ __forceinline__ void epi(const Acc& acc, const Unit& u, int wr, int wc, int fr, int fq) const {
    bf16_t* FB = (bf16_t*)(ws + WS_FB); const int ka = u.pn >> 2;
#pragma unroll
    for (int m = 0; m < 4; ++m) { const int kb = wr * 64 + m * 16 + fr; const size_t k = (size_t)ka + 128 * kb;
#pragma unroll
      for (int bj = 0; bj < 2; ++bj) { const int d0 = (u.pn & 3) * 256 + bj * 128 + wc * 32 + 8 * fq; *(u32x4*)(FB + k * 1024 + d0) = pack8(acc[0][bj][m][0], acc[0][bj][m][1]); } }
  }
};
}
namespace mk {
typedef float f32x16 __attribute__((ext_vector_type(16)));

__device__ __forceinline__ void phase_scan(const Ctx& X) {
  if (X.c >= 64) return;
  const int ch = X.c * 64 + (X.tid & 63), seg = X.tid >> 6;
  const int g = ch >> 7, dir = (ch >> 6) & 1, p = ch & 63;
  const float2 lam = ((const float2*)(X.ws + WS_LAML))[(dir * 32 + g) * 64 + p];
  const float* S = (const float*)(X.ws + WS_SST) + (size_t)g * 768 * 256 + dir * 128 + p;
  bf16_t* XP = (bf16_t*)(X.ws + WS_AS5) + (size_t)g * 768 * 768 + 512 + dir * 128 + p;
  LAS float* EX = (LAS float*)X.lds;
  const int j0 = seg * 65;
  float xr = 0.f, xi = 0.f;
  for (int b = 0; b < 65; b += 13) {
    float sr[13], si[13];
#pragma unroll
    for (int k = 0; k < 13; ++k) { const int j = j0 + b + k; const int row = dir == 0 ? (j < 8 ? 512 + j : j - 8) : 519 - j; sr[k] = S[(size_t)row * 256]; si[k] = S[(size_t)row * 256 + 64]; }
#pragma unroll
    for (int k = 0; k < 13; ++k) { const float nr = lam.x * xr - lam.y * xi + sr[k], ni = lam.x * xi + lam.y * xr + si[k]; xr = nr; xi = ni; }
  }
  EX[(seg * 64 + (X.tid & 63)) * 2] = xr; EX[(seg * 64 + (X.tid & 63)) * 2 + 1] = xi;
  float pr = 1.f, pi = 0.f;
  for (int k = 0; k < 65; ++k) { const float nr = pr * lam.x - pi * lam.y, ni = pr * lam.y + pi * lam.x; pr = nr; pi = ni; }
  __syncthreads();
  float cr = 0.f, ci = 0.f;
  for (int s2 = 0; s2 < seg; ++s2) { const float er = EX[(s2 * 64 + (X.tid & 63)) * 2], ei = EX[(s2 * 64 + (X.tid & 63)) * 2 + 1];
    const float nr = pr * cr - pi * ci + er, ni = pr * ci + pi * cr + ei; cr = nr; ci = ni; }
  xr = cr; xi = ci;
  for (int b = 0; b < 65; b += 13) {
    float sr[13], si[13];
#pragma unroll
    for (int k = 0; k < 13; ++k) { const int j = j0 + b + k; const int row = dir == 0 ? (j < 8 ? 512 + j : j - 8) : 519 - j; sr[k] = S[(size_t)row * 256]; si[k] = S[(size_t)row * 256 + 64]; }
#pragma unroll
    for (int k = 0; k < 13; ++k) { const int j = j0 + b + k; const int row = dir == 0 ? (j < 8 ? 512 + j : j - 8) : 519 - j;
      XP[(size_t)row * 768] = f2bf(xr); XP[(size_t)row * 768 + 64] = f2bf(xi);
      const float nr = lam.x * xr - lam.y * xi + sr[k], ni = lam.x * xi + lam.y * xr + si[k]; xr = nr; xi = ni; }
  }
  __syncthreads();
}

__device__ __forceinline__ void zero_lists(const Ctx& X) {
  u32x4* z = (u32x4*)(X.ws + WS_LTOK); unsigned zu_ = 0u; asm volatile("" : "+v"(zu_)); const u32x4 zero = (u32x4){zu_, zu_, zu_, zu_};
  for (int i = X.c * NTHR + X.tid; i < (int)(4 * MiB / 16); i += X.G * NTHR) z[i] = zero;
}
#define MFMA32(a, b, c) __builtin_amdgcn_mfma_f32_32x32x16_bf16((a), (b), (c), 0, 0, 0)
__device__ __forceinline__ void attn_unit(const Ctx& X, const LAS float* rpbl, int head, int tile) {
  const bf16_t* Q = (const bf16_t*)(X.ws + WS_Q); const bf16_t* Kb = (const bf16_t*)(X.ws + WS_K); const bf16_t* VT = (const bf16_t*)(X.ws + WS_VT);
  bf16_t* CCt = (bf16_t*)(X.ws + WS_CONCAT);
  const int lane = X.lane, ql = lane & 31, hh = lane >> 5;
  const int rp = tile >> 2, mt = tile & 3;
  const int r = 2 * rp + (ql >> 4), cq = 16 * mt + (ql & 15), tq = r * 64 + cq;
  const int r0q = min(max(r - 4, 0), 248), csq = min(max(cq - 8, 0), 48);
  const int rlo = min(max(2 * rp - 4, 0), 248), rhi = min(max(2 * rp - 3, 0), 248) + 7;
  const int csb = min(max(16 * mt - 8, 0), 32);
  const int nloc = rhi - rlo + 1;
  unsigned cmask = 0u;
#pragma unroll
  for (int k = 0; k < 32; ++k) cmask |= ((csb + k >= csq) && (csb + k <= csq + 15)) ? (1u << k) : 0u;
  bf16x8 qf[4];
#pragma unroll
  for (int ks = 0; ks < 4; ++ks) qf[ks] = *(const bf16x8*)(Q + (size_t)tq * 512 + head * 64 + 16 * ks + 8 * hh);
  const int kperm = (ql & ~12) | ((ql & 4) << 1) | ((ql & 8) >> 1);
  f32x16 o0, o1;
#pragma unroll
  for (int i = 0; i < 16; ++i) { o0[i] = 0.f; o1[i] = 0.f; }
  float lsum = 0.f;
  const float c1 = 0.125f * 1.44269504f, c2 = 8.f * 1.44269504f;
  const float* rp_h = nullptr; (void)rp_h;
  const size_t koff_lane = (size_t)(((kperm >> 3) * 4 * 8 + (kperm & 7)) * 2 + hh) * 8;
  const size_t voff_lane = (size_t)(hh * 64 + ql) * 8;
  bf16x8 kf[4], vf[2][2];
  { const int kr0 = rlo, cg0 = csb >> 3;
    const bf16_t* kp = Kb + ((size_t)(head * 260 + kr0) * 8 + cg0) * 512 + koff_lane; const bf16_t* vp = VT + ((size_t)(head * 260 + kr0) * 8 + cg0) * 512 + voff_lane;
#pragma unroll
    for (int ks = 0; ks < 4; ++ks) kf[ks] = *(const bf16x8*)(kp + ks * 128);
#pragma unroll
    for (int db = 0; db < 2; ++db)
#pragma unroll
      for (int s2 = 0; s2 < 2; ++s2) vf[db][s2] = *(const bf16x8*)(vp + db * 256 + s2 * 1024); }
  for (int b = 0; b < nloc + 8; ++b) {
    const bool loc = b < nloc;
    const int kr = rlo + b;
    bf16x8 kc[4], vc[2][2];
#pragma unroll
    for (int ks = 0; ks < 4; ++ks) kc[ks] = kf[ks];
#pragma unroll
    for (int db = 0; db < 2; ++db)
#pragma unroll
      for (int s2 = 0; s2 < 2; ++s2) vc[db][s2] = vf[db][s2];
    if (b + 1 < nloc + 8) { const int bn = b + 1; const int krn = bn < nloc ? rlo + bn : 256 + ((bn - nloc) >> 1), cgn = bn < nloc ? (csb >> 3) : 4 * ((bn - nloc) & 1);
      const bf16_t* kp = Kb + ((size_t)(head * 260 + krn) * 8 + cgn) * 512 + koff_lane; const bf16_t* vp = VT + ((size_t)(head * 260 + krn) * 8 + cgn) * 512 + voff_lane;
#pragma unroll
      for (int ks = 0; ks < 4; ++ks) kf[ks] = *(const bf16x8*)(kp + ks * 128);
#pragma unroll
      for (int db = 0; db < 2; ++db)
#pragma unroll
        for (int s2 = 0; s2 < 2; ++s2) vf[db][s2] = *(const bf16x8*)(vp + db * 256 + s2 * 1024); }
    f32x16 sacc;
#pragma unroll
    for (int i = 0; i < 16; ++i) sacc[i] = 0.f;
#pragma unroll
    for (int ks = 0; ks < 4; ++ks) sacc = MFMA32(kc[ks], qf[ks], sacc);
    float pv[16];
    if (loc) {
      const bool rowok = (kr >= r0q) && (kr <= r0q + 7);
      const int dr = min(max(kr - r + 7, 0), 14);
      const LAS float* bp = rpbl + (head * 15 + dr) * 31;
      const int dc0 = csb - cq + 15;
#pragma unroll
      for (int i = 0; i < 16; ++i) { const int kidx = 16 * (i >> 3) + 8 * hh + (i & 7);
        const bool ok = rowok && ((cmask >> kidx) & 1u);
        const float bias = bp[min(max(dc0 + kidx, 0), 30)];
        const float e = __builtin_amdgcn_exp2f(sacc[i] * c1 + bias * 1.44269504f - c2); pv[i] = ok ? e : 0.f; }
    } else {
#pragma unroll
      for (int i = 0; i < 16; ++i) pv[i] = __builtin_amdgcn_exp2f(sacc[i] * c1 - c2);
    }
    u32x4 p0, p1;
    p0.x = cvt_pk_bf16(pv[0], pv[1]); p0.y = cvt_pk_bf16(pv[2], pv[3]); p0.z = cvt_pk_bf16(pv[4], pv[5]); p0.w = cvt_pk_bf16(pv[6], pv[7]);
    p1.x = cvt_pk_bf16(pv[8], pv[9]); p1.y = cvt_pk_bf16(pv[10], pv[11]); p1.z = cvt_pk_bf16(pv[12], pv[13]); p1.w = cvt_pk_bf16(pv[14], pv[15]);
    lsum += (bf_lo(p0.x) + bf_hi(p0.x)) + (bf_lo(p0.y) + bf_hi(p0.y)) + (bf_lo(p0.z) + bf_hi(p0.z)) + (bf_lo(p0.w) + bf_hi(p0.w))
          + (bf_lo(p1.x) + bf_hi(p1.x)) + (bf_lo(p1.y) + bf_hi(p1.y)) + (bf_lo(p1.z) + bf_hi(p1.z)) + (bf_lo(p1.w) + bf_hi(p1.w));
    const bf16x8 pb0 = __builtin_bit_cast(bf16x8, p0), pb1 = __builtin_bit_cast(bf16x8, p1);
    o0 = MFMA32(vc[0][0], pb0, o0); o0 = MFMA32(vc[0][1], pb1, o0);
    o1 = MFMA32(vc[1][0], pb0, o1); o1 = MFMA32(vc[1][1], pb1, o1);
  }
  lsum += sx(lsum, 32);
  const float inv = 1.f / lsum;
  bf16_t* op = CCt + (size_t)tq * 1024 + 512 + head * 64 + 4 * hh;
#pragma unroll
  for (int gq = 0; gq < 4; ++gq) {
    u32x2 w0, w1;
    w0.x = cvt_pk_bf16(o0[4 * gq] * inv, o0[4 * gq + 1] * inv); w0.y = cvt_pk_bf16(o0[4 * gq + 2] * inv, o0[4 * gq + 3] * inv);
    w1.x = cvt_pk_bf16(o1[4 * gq] * inv, o1[4 * gq + 1] * inv); w1.y = cvt_pk_bf16(o1[4 * gq + 2] * inv, o1[4 * gq + 3] * inv);
    *(u32x2*)(op + 8 * gq) = w0; *(u32x2*)(op + 32 + 8 * gq) = w1;
  }
}
__device__ __forceinline__ void phase_attn(const Ctx& X) {
  LAS float* rpbl = (LAS float*)X.lds;
  zero_lists(X);
  for (int i = X.tid; i < 8 * 15 * 31; i += NTHR) rpbl[i] = X.a->in[IN_RPB][i];
  __syncthreads();
  const int gw = X.c * NWAVES + X.wave, NGW = X.G * NWAVES;
  for (int U = gw; U < 4096; U += NGW) attn_unit(X, rpbl, U >> 9, U & 511);
}

__device__ __forceinline__ void phase_router(const Ctx& X, int layer, int dry) {
  const float* mod = (const float*)(X.ws + WS_MOD) + (layer == 0 ? 0 : 2 * 6144);
  const float* shift = mod + 3072; const float* scale = mod + 4096;
  const bf16_t* h = (const bf16_t*)(X.ws + WS_HB); bf16_t* F = (bf16_t*)(X.ws + WS_F);
  unsigned* cntg = (unsigned*)(X.ws + WS_CTL) + CW_CNT + layer * 128;
  int* ltok = (int*)(X.ws + WS_LTOK); int* asg = (int*)(X.ws + WS_ASG);
  const bf16_t* WR = (const bf16_t*)(X.ws + WS_WROUT_T) + (size_t)layer * 64 * 1024;
  const float* rbias = X.a->in[IN_RBIAS] + layer * 64;
  constexpr int FROW = 2064;
  const int lane = X.lane, wave = X.wave, tid = X.tid;
  for (int tile = X.c; tile < TOK / 64; tile += X.G) {
    const int t0 = tile * 64;
    for (int rb4 = 0; rb4 < 2; ++rb4) {
      f32x4 v[4][4];
#pragma unroll
      for (int rr = 0; rr < 4; ++rr) { const u32x2* xr = (const u32x2*)(h + (size_t)(t0 + wave * 8 + rb4 * 4 + rr) * 1024) + lane;
#pragma unroll
        for (int j = 0; j < 4; ++j) { const u32x2 w = xr[64 * j]; v[rr][j] = (f32x4){bf_lo(w.x), bf_hi(w.x), bf_lo(w.y), bf_hi(w.y)}; } }
#pragma unroll
      for (int rr = 0; rr < 4; ++rr) {
        const int lr = wave * 8 + rb4 * 4 + rr, t = t0 + lr; float ss = 0.f;
#pragma unroll
        for (int j = 0; j < 4; ++j) ss += (v[rr][j].x * v[rr][j].x + v[rr][j].y * v[rr][j].y) + (v[rr][j].z * v[rr][j].z + v[rr][j].w * v[rr][j].w);
        const float r = rsqrtf(wave_sum(ss) * (1.f / 1024.f) + 1e-6f);
#pragma unroll
        for (int j = 0; j < 4; ++j) { const f32x4 f = v[rr][j] * r * (((const f32x4*)scale)[lane + 64 * j] + 1.f) + ((const f32x4*)shift)[lane + 64 * j];
          u32x2 w; w.x = cvt_pk_bf16(f.x, f.y); w.y = cvt_pk_bf16(f.z, f.w);
          if (!dry) { int w8 = 0; w8 = __builtin_amdgcn_cvt_pk_fp8_f32(f.x, f.y, w8, false); w8 = __builtin_amdgcn_cvt_pk_fp8_f32(f.z, f.w, w8, true);
            ((int*)((unsigned char*)F + (size_t)t * 1024))[lane + 64 * j] = w8; }
          *(LAS u32x2*)(X.lds + lr * FROW + (lane + 64 * j) * 8) = w; }
      }
    }
    __syncthreads();
    f32x4 pl[4][4];
    { const int fr = lane & 15, fq = lane >> 4;
#pragma unroll
      for (int a = 0; a < 4; ++a)
#pragma unroll
        for (int b = 0; b < 4; ++b) pl[a][b] = (f32x4){0.f, 0.f, 0.f, 0.f};
      bf16x8 bq[4][4];
#pragma unroll
      for (int ks = 0; ks < 4; ++ks)
#pragma unroll
        for (int eb = 0; eb < 4; ++eb) bq[ks][eb] = *(const bf16x8*)(WR + (size_t)(eb * 16 + fr) * 1024 + wave * 128 + ks * 32 + fq * 8);
#pragma unroll
      for (int ks = 0; ks < 4; ++ks) {
        bf16x8 af[4];
#pragma unroll
        for (int rb = 0; rb < 4; ++rb) af[rb] = *(const LAS bf16x8*)(X.lds + (rb * 16 + fr) * FROW + (wave * 128 + ks * 32 + fq * 8) * 2);
#pragma unroll
        for (int rb = 0; rb < 4; ++rb)
#pragma unroll
          for (int eb = 0; eb < 4; ++eb) pl[rb][eb] = __builtin_amdgcn_mfma_f32_16x16x32_bf16(af[rb], bq[ks][eb], pl[rb][eb], 0, 0, 0);
      }
    }
    __syncthreads();
    { LAS float* PART = (LAS float*)X.lds;
      const int fr = lane & 15, fq = lane >> 4;
#pragma unroll
      for (int rb = 0; rb < 4; ++rb)
#pragma unroll
        for (int eb = 0; eb < 4; ++eb)
#pragma unroll
          for (int j = 0; j < 4; ++j) PART[(wave * 64 + rb * 16 + 4 * fq + j) * 64 + eb * 16 + fr] = pl[rb][eb][j];
      __syncthreads();
      float sum[8];
#pragma unroll
      for (int i = 0; i < 8; ++i) { float a = 0.f;
#pragma unroll
        for (int w = 0; w < 8; ++w) a += PART[w * 4096 + i * 512 + tid];
        sum[i] = a; }
      __syncthreads();
      LAS float* LG0 = (LAS float*)X.lds;
#pragma unroll
      for (int i = 0; i < 8; ++i) { const int o = i * 512 + tid; LG0[(o >> 6) * 65 + (o & 63)] = sum[i]; }
    }
    LAS float* LG = (LAS float*)X.lds;
    LAS float* GS = LG + 64 * 65;
    LAS float* SELV = GS + 512;
    LAS int* OUTE = (LAS int*)(SELV + 4096);
    LAS float* OUTS = (LAS float*)(OUTE + 512);
    LAS int* HIST = (LAS int*)(OUTS + 512);
    LAS int* BASE = HIST + 64;
    if (tid < 64) HIST[tid] = 0;
    __syncthreads();
    const int tl = tid >> 3, grp = tid & 7;
    float v[8], sc[8];
    { float m1 = -INFINITY, m2 = -INFINITY;
#pragma unroll
      for (int j = 0; j < 8; ++j) { const float s = 1.f / (1.f + __expf(-LG[tl * 65 + grp * 8 + j])); sc[j] = s; v[j] = s + rbias[grp * 8 + j];
        if (v[j] > m1) { m2 = m1; m1 = v[j]; } else if (v[j] > m2) m2 = v[j]; }
      GS[tl * 8 + grp] = m1 + m2; }
    __syncthreads();
    bool keep;
    { const float mine = GS[tl * 8 + grp]; int rank = 0;
#pragma unroll
      for (int g2 = 0; g2 < 8; ++g2) { const float o = GS[tl * 8 + g2]; rank += (o > mine || (o == mine && g2 < grp)) ? 1 : 0; }
      keep = rank < 4;
#pragma unroll
      for (int j = 0; j < 8; ++j) SELV[tl * 64 + grp * 8 + j] = keep ? v[j] : -INFINITY; }
    __syncthreads();
    if (keep) {
      int rk[8];
#pragma unroll
      for (int j = 0; j < 8; ++j) rk[j] = 0;
      for (int e2 = 0; e2 < 64; ++e2) { const float o = SELV[tl * 64 + e2];
#pragma unroll
        for (int j = 0; j < 8; ++j) rk[j] += (o > v[j] || (o == v[j] && e2 < grp * 8 + j)) ? 1 : 0; }
#pragma unroll
      for (int j = 0; j < 8; ++j) if (rk[j] < 8) { OUTE[tl * 8 + rk[j]] = grp * 8 + j; OUTS[tl * 8 + rk[j]] = sc[j]; }
    }
    __syncthreads();
    { const int jj = tid & 7, e = OUTE[tl * 8 + jj]; const float s = OUTS[tl * 8 + jj];
      float sum = s; sum += sx(sum, 1); sum += sx(sum, 2); sum += sx(sum, 4);
      const float w = 2.5f * s / sum;
      const int sl = atomicAdd((int*)&HIST[e], 1);
      __syncthreads();
      const int t = t0 + tl;
      if (tid < 64) { const int n = HIST[tid]; BASE[tid] = (n && !dry) ? (int)atomicAdd(cntg + tid, (unsigned)n) : 0; }
      __syncthreads();
      const int slot = BASE[e] + sl;
      if (!dry) { ltok[(size_t)e * 16384 + slot] = t; } if (!dry) ((int2*)asg)[t * 8 + jj] = make_int2((e << 16) | slot, __float_as_int(w)); }
    __syncthreads();
  }
}

__device__ __forceinline__ void phase_combine(const Ctx& X, int layer, const LAS int* toff, int dry) {
  const float* mod = (const float*)(X.ws + WS_MOD) + (layer == 0 ? 0 : 2 * 6144);
  const float* gffn = mod + 5120;
  const float* nmod = (const float*)(X.ws + WS_MOD) + 2 * 6144;
  float* hout32 = X.a->h; bf16_t* hb = (bf16_t*)(X.ws + WS_HB); const unsigned char* YAS = X.ws + WS_YAS; const int* asg = (const int*)(X.ws + WS_ASG); bf16_t* A1 = (bf16_t*)(X.ws + WS_A1);
  const int gw = X.c * NWAVES + X.wave, NGW = X.G * NWAVES, lane = X.lane;
  for (int t0 = gw; t0 < TOK; t0 += 2 * NGW) {
    int yw[2][9][4]; f32x4 hv[2][4]; float wgt[2][8];
#pragma unroll
    for (int u = 0; u < 2; ++u) { const int t = t0 + u * NGW;
      int pos[9];
#pragma unroll
      for (int k = 0; k < 8; ++k) { const int2 a = ((const int2*)asg)[t * 8 + k]; pos[k] = toff[a.x >> 16] * 256 + (a.x & 0xffff); wgt[u][k] = __int_as_float(a.y); }
      pos[8] = toff[64] * 256 + t;
#pragma unroll
      for (int k = 0; k < 9; ++k) { const int* yr = (const int*)(YAS + (size_t)pos[k] * 1024) + lane;
#pragma unroll
        for (int j = 0; j < 4; ++j) yw[u][k][j] = yr[64 * j]; }
      const u32x2* hr = (const u32x2*)(hb + (size_t)t * 1024) + lane;
#pragma unroll
      for (int j = 0; j < 4; ++j) { const u32x2 w = hr[64 * j]; hv[u][j] = (f32x4){bf_lo(w.x), bf_hi(w.x), bf_lo(w.y), bf_hi(w.y)}; } }
#pragma unroll
    for (int u = 0; u < 2; ++u) { const int t = t0 + u * NGW;
      f32x4 acc[4];
#pragma unroll
      for (int j = 0; j < 4; ++j) acc[j] = (f32x4){0.f, 0.f, 0.f, 0.f};
#pragma unroll
      for (int k = 0; k < 9; ++k) { const float wk = k < 8 ? wgt[u][k] : 1.f;
#pragma unroll
        for (int j = 0; j < 4; ++j) { const int w = yw[u][k][j];
          acc[j].x += wk * __builtin_amdgcn_cvt_f32_fp8(w, 0); acc[j].y += wk * __builtin_amdgcn_cvt_f32_fp8(w, 1); acc[j].z += wk * __builtin_amdgcn_cvt_f32_fp8(w, 2); acc[j].w += wk * __builtin_amdgcn_cvt_f32_fp8(w, 3); } }
      f32x4 v[4]; float ss = 0.f;
#pragma unroll
      for (int j = 0; j < 4; ++j) { const f32x4 gt = ((const f32x4*)gffn)[lane + 64 * j]; v[j] = hv[u][j] + gt * acc[j];
        if (!dry) { if (layer == 0) ((u32x2*)(hb + (size_t)t * 1024))[lane + 64 * j] = (u32x2){cvt_pk_bf16(v[j].x, v[j].y), cvt_pk_bf16(v[j].z, v[j].w)}; else ((f32x4*)(hout32 + (size_t)t * 1024))[lane + 64 * j] = v[j]; }
        ss += (v[j].x * v[j].x + v[j].y * v[j].y) + (v[j].z * v[j].z + v[j].w * v[j].w); }
      if (layer == 0) {
        const float r = rsqrtf(wave_sum(ss) * (1.f / 1024.f) + 1e-6f);
#pragma unroll
        for (int j = 0; j < 4; ++j) { const f32x4 sh = ((const f32x4*)nmod)[lane + 64 * j], sc = ((const f32x4*)(nmod + 1024))[lane + 64 * j];
          u32x2 w; w.x = cvt_pk_bf16(v[j].x * r * (1.f + sc.x) + sh.x, v[j].y * r * (1.f + sc.y) + sh.y); w.y = cvt_pk_bf16(v[j].z * r * (1.f + sc.z) + sh.z, v[j].w * r * (1.f + sc.w) + sh.w);
          if (!dry) ((u32x2*)(A1 + (size_t)t * 1024))[lane + 64 * j] = w; }
      }
    }
  }
}

constexpr int NPHASE = 21;
template <bool SP2>
__global__ void __launch_bounds__(NTHR, 2) mk_fwd(Args args) {
  extern __shared__ __attribute__((aligned(16))) unsigned char lds_raw[];
  Ctx X; X.lds = (LAS unsigned char*)lds_raw; X.a = &args; X.ws = args.ws; X.tid = threadIdx.x; X.lane = X.tid & 63; X.wave = __builtin_amdgcn_readfirstlane(X.tid >> 6);
  X.G = gridDim.x; X.c = blockIdx.x;
  const int wave_s = X.wave;
  volatile LAS unsigned* MISC = (volatile LAS unsigned*)(X.lds + LDS_MISC_OFF);
  LAS int* TOFF = (LAS int*)(X.lds + LDS_MISC_OFF + 64);
  if (X.tid < 16) MISC[X.tid] = 0u;
  __syncthreads();
  unsigned* ctl = (unsigned*)(X.ws + WS_CTL);
  const int lo = args.ph_lo, hi = args.ph_hi;
  const bool multi = (hi - lo) > 1;
  XcdBarrier bar; bar.bar = ctl + CW_BAR; bar.x = 0; bar.st = nullptr;
  if (multi) bar = xcd_barrier_post(ctl + CW_BAR, MISC, X.tid);
  LAS unsigned char* lds = X.lds;
  unsigned char* ws = X.ws;
  const float* mod = (const float*)(ws + WS_MOD); (void)mod;
#ifndef PH_MASK
#define PH_MASK 0x1fffffull
#endif
#define IN(k) ((((unsigned long long)PH_MASK >> (k)) & 1ull) && lo <= (k) && (k) < hi)
#define SEAM(k) do { if (IN(k) && IN((k) + 1)) xcd_barrier(bar, X.tid); } while (0)
#ifndef REP_MASK
#define REP_MASK 0ull
#endif
#define REPS(k) ((int)(((unsigned long long)REP_MASK >> (k)) & 1ull))
#define FILL(ph, nb) do { if (!(args.flags & FLAG_SKIP_EXPERTS) && multi) { if (X.c < (nb)) { __syncthreads(); if (X.tid == 0) atomicAdd(ctl + CW_DONE + 64 * (ph), 1u); } \
    else transpose_work(X, ctl + CW_DQ1, 0, 0, 1, 65 * IT_EXP, ctl + CW_DONE + 64 * (ph), (unsigned)(nb)); } } while (0)
#define LAUNDER() do { int w0_ = wave_s; asm volatile("" : "+s"(w0_)); unsigned zl_ = 0u; asm volatile("" : "+v"(zl_)); int l_ = (int)__builtin_amdgcn_mbcnt_hi(~0u, __builtin_amdgcn_mbcnt_lo(~0u, zl_)); X.wave = w0_; X.lane = l_; X.tid = w0_ * 64 + l_; \
    size_t z0_ = 0; asm volatile("" : "+s"(z0_)); unsigned char* w_ = args.ws + z0_; X.ws = w_; ws = w_; mod = (const float*)(w_ + WS_MOD); } while (0)
  if (IN(0)) for (int rep_ = 0; rep_ <= REPS(0); ++rep_) { if (rep_) xcd_barrier(bar, X.tid); LAUNDER(); phase_prep(X, rep_); } SEAM(0);
#ifdef EXTRA_BARS
  if (multi) for (int eb_ = 0; eb_ < EXTRA_BARS; ++eb_) xcd_barrier(bar, X.tid);
#endif
  if (IN(1)) for (int rep_ = 0; rep_ <= REPS(1); ++rep_) { if (rep_) xcd_barrier(bar, X.tid); LAUNDER(); phase_mod0(X); } SEAM(1);
  if (IN(2)) for (int rep_ = 0; rep_ <= REPS(2); ++rep_) { if (rep_) xcd_barrier(bar, X.tid); LAUNDER(); G1 p; p.K = 1024; p.nunits = 520; p.ws = ws; p.qg = args.in[IN_QG]; p.kg = args.in[IN_KG]; gemm_phase<G1, SP2>(lds, p, X.G, X.c, X.tid); FILL(2, 8); } SEAM(2);
  if (IN(3)) for (int rep_ = 0; rep_ <= REPS(3); ++rep_) { if (rep_) xcd_barrier(bar, X.tid); LAUNDER(); G2 p; p.K = 512; p.nunits = 96; p.ws = ws; gemm_phase<G2, SP2>(lds, p, X.G, X.c, X.tid); FILL(3, 96); } SEAM(3);
  if (IN(4)) for (int rep_ = 0; rep_ <= REPS(4); ++rep_) { if (rep_) xcd_barrier(bar, X.tid); LAUNDER(); phase_scan(X); FILL(4, 64); } SEAM(4);
  if (IN(5)) for (int rep_ = 0; rep_ <= REPS(5); ++rep_) { if (rep_) xcd_barrier(bar, X.tid); LAUNDER(); G3 p; p.K = 768; p.nunits = 128; p.ws = ws; gemm_phase<G3, SP2>(lds, p, X.G, X.c, X.tid); FILL(5, 128); } SEAM(5);
  if (IN(6)) for (int rep_ = 0; rep_ <= REPS(6); ++rep_) { if (rep_) xcd_barrier(bar, X.tid); LAUNDER(); G4 p; p.K = 512; p.nunits = 128; p.ws = ws; p.bglu = args.in[IN_BGLU]; gemm_phase<G4, SP2>(lds, p, X.G, X.c, X.tid); FILL(6, 128); } SEAM(6);
  if (IN(7)) for (int rep_ = 0; rep_ <= REPS(7); ++rep_) { if (rep_) xcd_barrier(bar, X.tid); LAUNDER(); phase_attn(X); } SEAM(7);
  if (IN(8)) for (int rep_ = 0; rep_ <= REPS(8); ++rep_) { if (rep_) xcd_barrier(bar, X.tid); LAUNDER(); GRes p; p.K = 1024; p.nunits = 256; p.A = (const char*)ws + WS_CONCAT; p.Bt = (const char*)ws + WS_WMIX_T; p.hin32 = args.in[IN_X]; p.hin16 = nullptr; p.hout = (bf16_t*)(ws + WS_HB); p.gate = mod + 2048; p.bias = nullptr;
    gemm_phase<GRes, SP2>(lds, p, X.G, X.c, X.tid); } SEAM(8);
#pragma unroll 1
  for (int layer = 0; layer < 2; ++layer) {
    const int pb = layer == 0 ? 9 : 17;
    if (IN(pb)) for (int rep_ = 0; rep_ <= REPS(pb); ++rep_) { if (rep_) xcd_barrier(bar, X.tid); LAUNDER(); phase_router(X, layer, rep_); } SEAM(pb);
#ifndef ROUTER_VARIANT
#define ROUTER_VARIANT 1
#endif
#ifndef G6_VARIANT
#define G6_VARIANT 1
#endif
    if (IN(pb + 1)) for (int rep_ = REPS(pb + 1); rep_ >= 0; --rep_) { if (rep_ == 0 && REPS(pb + 1)) xcd_barrier(bar, X.tid); LAUNDER(); build_moetab(X, layer, TOFF); G6 p; p.K = 512; p.ws = ws; p.toff = TOFF; p.nunits = TOFF[65] * 2; p.wbase = (const char*)ws + (layer == 0 ? WS_WEXP : WS_WEXP1); p.wstride = layer == 0 ? EXP_STRIDE : EXP1_STRIDE;
      { LAS unsigned* tk = (LAS unsigned*)(X.lds + LDS_STAGE); p.tokt = tk; p.build_tokt(X, tk); } gemm_phase<G6, false>(lds, p, X.G, X.c, X.tid); } SEAM(pb + 1);
#ifndef G7_VARIANT
#define G7_VARIANT 1
#endif
    if (IN(pb + 2)) for (int rep_ = REPS(pb + 2); rep_ >= 0; --rep_) { if (rep_ == 0 && REPS(pb + 2)) xcd_barrier(bar, X.tid); LAUNDER(); build_moetab(X, layer, TOFF); G7 p; p.K = 256; p.ws = ws; p.toff = TOFF; p.nunits = TOFF[65] * 4; p.wbase = (const char*)ws + (layer == 0 ? WS_WEXP + EXP_DOFF : WS_WEXP1 + EXP1_DOFF); p.wstride = layer == 0 ? EXP_STRIDE : EXP1_STRIDE; gemm_phase<G7, SP2>(lds, p, X.G, X.c, X.tid); } SEAM(pb + 2);
    if (IN(pb + 3)) for (int rep_ = REPS(pb + 3); rep_ >= 0; --rep_) { if (rep_ == 0 && REPS(pb + 3)) xcd_barrier(bar, X.tid); LAUNDER(); build_moetab(X, layer, TOFF); phase_combine(X, layer, TOFF, rep_);
      if (layer == 0 && rep_ == 0 && !(args.flags & FLAG_SKIP_EXPERTS)) { __syncthreads(); transpose_work(X, ctl + CW_DQ1, 0, 0, 1, 65 * IT_EXP); } }
    if (layer == 0) {
      SEAM(12);
      if (IN(13)) for (int rep_ = 0; rep_ <= REPS(13); ++rep_) { if (rep_) xcd_barrier(bar, X.tid); LAUNDER(); G8 p; p.K = 256; p.nunits = 512; p.ws = ws; gemm_phase<G8, SP2>(lds, p, X.G, X.c, X.tid); } SEAM(13);
      if (IN(14)) for (int rep_ = 0; rep_ <= REPS(14); ++rep_) { if (rep_) xcd_barrier(bar, X.tid); LAUNDER(); G9 p; p.K = 256; p.nunits = 512; p.ws = ws; gemm_phase<G9, SP2>(lds, p, X.G, X.c, X.tid); } SEAM(14);
      if (IN(15)) for (int rep_ = 0; rep_ <= REPS(15); ++rep_) { if (rep_) xcd_barrier(bar, X.tid); LAUNDER(); G10 p; p.K = 256; p.nunits = 512; p.ws = ws; gemm_phase<G10, SP2>(lds, p, X.G, X.c, X.tid); } SEAM(15);
      if (IN(16)) { LAUNDER(); zero_lists(X); GRes p; p.K = 1024; p.nunits = 256; p.A = (const char*)ws + WS_FB; p.Bt = (const char*)ws + WS_WFOUR_T; p.hin32 = nullptr; p.hin16 = (const bf16_t*)(ws + WS_HB); p.hout = (bf16_t*)(ws + WS_HB); p.gate = mod + 2 * 6144 + 2048; p.bias = args.in[IN_BFOUR];
        gemm_phase<GRes, SP2>(lds, p, X.G, X.c, X.tid); } SEAM(16);
    }
  }
#undef IN
#undef SEAM
}
}
#ifndef MK_SP2
#define MK_SP2 true
#endif
#ifndef MK_N_LAUNCHES
#define MK_N_LAUNCHES 1
#endif
#ifndef CHECK
#define CHECK 0
#endif
static int g_grid = 0;
static bool mk_setup(int n_in, int out_size, size_t ws_size) {
  if (g_grid == 0) {
    g_grid = -1;
    if (n_in != 31 || out_size != 16384 * 1024 || ws_size < mk::WS_NEED) { fprintf(stderr, "kernel_launch: unexpected n_in %d out %d ws %zu\n", n_in, out_size, ws_size); return false; }
    int dev = 0, cus = 0;
    if (hipGetDevice(&dev) != hipSuccess || hipDeviceGetAttribute(&cus, hipDeviceAttributeMultiprocessorCount, dev) != hipSuccess) return false;
    if (cus < 256) { fprintf(stderr, "kernel_launch: needs 256 CUs, device has %d\n", cus); return false; }
    if (hipFuncSetAttribute((const void*)mk::mk_fwd<MK_SP2>, hipFuncAttributeMaxDynamicSharedMemorySize, mk::LDS_BYTES) != hipSuccess) { fprintf(stderr, "kernel_launch: hipFuncSetAttribute failed\n"); return false; }
    g_grid = 256;
  }
  return g_grid > 0;
}
static void mk_run(hipStream_t s, mk::Args a, int lo, int hi) {
  a.ph_lo = lo; a.ph_hi = hi;
  hipLaunchKernelGGL(mk::mk_fwd<MK_SP2>, dim3(g_grid), dim3(mk::NTHR), mk::LDS_BYTES, s, a);
}

#if CHECK
namespace chk {
using mk::bf16_t;
__device__ __forceinline__ float b2f(bf16_t b) { return __uint_as_float(((unsigned)b) << 16); }
__global__ void k_cmp(int mode, const void* A, const float* B, unsigned long long n, double* acc) {
  double e = 0.0, r = 0.0; const bf16_t* A16 = (const bf16_t*)A;
  for (unsigned long long i = (unsigned long long)blockIdx.x * 256 + threadIdx.x; i < n; i += (unsigned long long)gridDim.x * 256) {
    float a = 0.f, b = 0.f; const int row = (int)(i >> 9), col = (int)(i & 511);
    switch (mode) {
      case 0: a = ((const float*)A)[i]; b = B[i]; break;
      case 1: a = b2f(A16[i]); b = B[i]; break;
      case 2: { b = B[(size_t)row * 2048 + col]; const int g = col >> 4, c = col & 15; int crow, s; if (row < 16384) { crow = row >> 5; s = row & 31; } else { const int j = row - 16384; crow = 512 + (j >> 5); s = j & 31; }
                a = b2f(A16[((size_t)(g * 768 + crow)) * 768 + s * 16 + c]); } break;
      case 3: b = B[(size_t)row * 2048 + 512 + col]; a = b2f(A16[(size_t)row * 512 + col]); break;
      case 4: b = B[(size_t)row * 2048 + 1024 + col]; a = b2f(A16[(size_t)row * 512 + col]); break;
      case 5: b = B[(size_t)row * 2048 + 1536 + col]; a = b2f(A16[(size_t)col * 16640 + row]); break;
      case 6: b = B[(size_t)row * 1024 + col]; a = b2f(A16[(size_t)row * 1024 + col]); break;
      case 7: b = B[(size_t)row * 1024 + 512 + col]; a = b2f(A16[(size_t)row * 1024 + 512 + col]); break;
      case 8: { const int ta = (int)(i & 127), ri = (int)((i >> 7) & 1), tb = (int)((i >> 8) & 127), m = (int)((i >> 15) & 255), g = (int)(i >> 23); a = b2f(A16[i]); const int t = 128 * ta + tb; b = B[((size_t)t * 4 + g) * 512 + ri * 256 + m]; } break;
      default: break;
    }
    const double d = (double)a - (double)b; e += d * d; r += (double)b * (double)b;
  }
  for (int o = 32; o >= 1; o >>= 1) { e += __shfl_xor(e, o); r += __shfl_xor(r, o); }
  if ((threadIdx.x & 63) == 0) { atomicAdd(acc, e); atomicAdd(acc + 1, r); }
}
__global__ void k_cmp_x2(const bf16_t* X2, const float* Yr, const float* Yi, double* acc) {
  double e = 0.0, r = 0.0;
  for (unsigned long long i = (unsigned long long)blockIdx.x * 256 + threadIdx.x; i < (1ull << 25); i += (unsigned long long)gridDim.x * 256) {
    const int tb = (int)(i & 127), rip = (int)((i >> 7) & 1), ka = (int)((i >> 8) & 127), gm = (int)(i >> 15);
    const float a = b2f(X2[i]); const size_t yi = (((size_t)ka * 128 + tb) << 10) + gm; const float b = rip ? Yi[yi] : Yr[yi];
    const double d = (double)a - (double)b; e += d * d; r += (double)b * (double)b;
  }
  for (int o = 32; o >= 1; o >>= 1) { e += __shfl_xor(e, o); r += __shfl_xor(r, o); }
  if ((threadIdx.x & 63) == 0) { atomicAdd(acc, e); atomicAdd(acc + 1, r); }
}
__global__ void k_judge(const double* acc, int n, float tol, int* fail) {
  if (threadIdx.x == 0 && blockIdx.x == 0) { fail[0] = 0; for (int k = 0; k < n; ++k) { const double rel = sqrt(acc[2 * k] / acc[2 * k + 1]); if (!(rel <= (double)tol)) { fail[0] = k + 1; break; } } }
}
__global__ void k_encode(float* out, size_t n, const int* fail) {
  const int f = fail[0]; if (f == 0) return; const float sc = 1.f + 0.1f * (float)f;
  for (size_t i = (size_t)blockIdx.x * 256 + threadIdx.x; i < n; i += (size_t)gridDim.x * 256) out[i] *= sc;
}
__global__ void k_f2bf(const float* in, bf16_t* out, size_t n) { for (size_t i = (size_t)blockIdx.x * 256 + threadIdx.x; i < n; i += (size_t)gridDim.x * 256) out[i] = mk::f2bf(in[i]); }
static void cmp(hipStream_t s, int mode, const void* A, const float* B, unsigned long long n, double* acc) { hipLaunchKernelGGL(k_cmp, dim3(2048), dim3(256), 0, s, mode, A, B, n, acc); }
}
#endif

extern "C" void kernel_launch(void* const* d_in, const int* in_sizes, int n_in, void* d_out, int out_size, void* d_ws, size_t ws_size, hipStream_t stream) {
  if (!mk_setup(n_in, out_size, ws_size)) return;
  unsigned char* ws = (unsigned char*)d_ws;
  const size_t MiB = mk::MiB;
  mk::Args a{};
  for (int i = 0; i < 31; ++i) a.in[i] = (const float*)d_in[i];
  a.h = (float*)d_out; a.ws = ws; a.flags = 0; a.pad = 0;
#if CHECK == 0
  (void)hipMemsetAsync(ws + mk::WS_CTL, 0, mk::CTL_ZERO_BYTES, stream);
#if MK_N_LAUNCHES == 1
  mk_run(stream, a, 0, mk::NPHASE);
#else
  for (int ph = 0; ph < mk::NPHASE; ++ph) mk_run(stream, a, ph, ph + 1);
#endif
#else
  ref::In in; { const float** p = (const float**)&in; for (int i = 0; i < 31; ++i) p[i] = (const float*)d_in[i]; }
  float* out = (float*)d_out;
  char* wsc = (char*)d_ws;
  ref::Small sm; sm.mod = (float*)(wsc + 498 * MiB); sm.lamb = (float2*)(wsc + 498 * MiB + 131072); sm.bbar = (float2*)(wsc + 498 * MiB + 262144);
  sm.tw = (float2*)(wsc + 499 * MiB); sm.Dm = (float*)(wsc + 499 * MiB + 262144);
  double* acc = (double*)(wsc + 500 * MiB); int* fail = (int*)(wsc + 500 * MiB + 4096);
  (void)hipMemsetAsync(acc, 0, 8192, stream);
  (void)hipMemsetAsync(ws + mk::WS_CTL, 0, mk::CTL_ZERO_BYTES, stream);
  float* HOPT = (float*)(ws + mk::WS_HOPT);
  int nchk = 0;
#if CHECK == 1
  ref::MixBuf mb; mb.a0 = (float*)(wsc + 12 * MiB); mb.z = (float*)(wsc + 336 * MiB); mb.g = (float*)(wsc + 466 * MiB); mb.t = (float*)(wsc + 77 * MiB); mb.concat = mb.a0; mb.ymix = mb.z;
  char* moe_arena = wsc + 12 * MiB;
  ref::FourBuf fb; { char* p = wsc + 12 * MiB; fb.a1 = (float*)p; p += 64 * MiB; fb.Z = (float*)p; p += 128 * MiB; fb.Yr = (float*)p; p += 64 * MiB; fb.Yi = (float*)p; p += 64 * MiB; fb.F = (float*)p; fb.yf = fb.Z; }
  a.flags = mk::FLAG_SKIP_EXPERTS;
  nchk = 10;
  ref::forward(stream, in, out, sm, mb, moe_arena, fb, [&](int st) {
    if (st == 1) { mk_run(stream, a, 0, 1); chk::cmp(stream, 0, ws + mk::WS_MOD, sm.mod, 3 * 6144, acc + 0); }
    if (st == 2) { mk_run(stream, a, 1, 2); chk::cmp(stream, 1, ws + mk::WS_A0, mb.a0, 16640ull * 1024, acc + 2); }
    if (st == 3) { mk_run(stream, a, 2, 3); chk::cmp(stream, 2, ws + mk::WS_AS5, mb.z, 16640ull * 512, acc + 4); chk::cmp(stream, 3, ws + mk::WS_Q, mb.z, 16384ull * 512, acc + 6);
                   chk::cmp(stream, 4, ws + mk::WS_K, mb.z, 16640ull * 512, acc + 8); chk::cmp(stream, 5, ws + mk::WS_VT, mb.z, 16640ull * 512, acc + 10); }
    if (st == 4) { mk_run(stream, a, 3, 4); mk_run(stream, a, 4, 5); mk_run(stream, a, 5, 6); chk::cmp(stream, 1, ws + mk::WS_GB, mb.g, 16384ull * 512, acc + 12); }
    if (st == 5) { mk_run(stream, a, 6, 7); chk::cmp(stream, 6, ws + mk::WS_CONCAT, mb.concat, 16384ull * 512, acc + 14); }
    if (st == 6) { mk_run(stream, a, 7, 8); chk::cmp(stream, 7, ws + mk::WS_CONCAT, mb.concat, 16384ull * 512, acc + 16); }
    if (st == 7) { mk::Args b = a; b.h = HOPT; mk_run(stream, b, 8, 9); chk::cmp(stream, 0, HOPT, out, 16384ull * 1024, acc + 18); }
  });
#elif CHECK == 2 || CHECK == 4
  const int L = CHECK == 2 ? 0 : 1;
  ref::MixBuf mb; { char* p = wsc + 12 * MiB; mb.a0 = (float*)p; p += 65 * MiB; mb.z = (float*)p; p += 130 * MiB; mb.g = (float*)p; p += 32 * MiB; mb.t = (float*)p; p += 32 * MiB; mb.concat = (float*)p; p += 64 * MiB; mb.ymix = mb.z; }
  ref::FourBuf fb; { char* p = wsc + 12 * MiB; fb.a1 = (float*)p; p += 64 * MiB; fb.Z = (float*)p; p += 128 * MiB; fb.Yr = (float*)p; p += 64 * MiB; fb.Yi = (float*)p; p += 64 * MiB; fb.F = (float*)p; fb.yf = fb.Z; }
  char* moe_arena = wsc + 110 * MiB;
  nchk = L == 0 ? 2 : 1;
  a.flags = 0;
  ref::forward(stream, in, out, sm, mb, moe_arena, fb, [&](int st) {
    if ((L == 0 && st == 7) || (L == 1 && st == 11)) {
      mk::Args b = a; b.h = HOPT; if (L == 1) b.flags = 2;
      mk_run(stream, b, 0, 1);
      (void)hipMemcpyAsync(HOPT, out, (size_t)16384 * 1024 * 4, hipMemcpyDeviceToDevice, stream);
      const int pb = L == 0 ? 9 : 20; b.flags |= mk::FLAG_SKIP_EXPERTS;
      for (int ph = pb; ph < pb + 7; ++ph) mk_run(stream, b, ph, ph + 1);
    }
    if ((L == 0 && st == 8) || (L == 1 && st == 12)) chk::cmp(stream, 0, HOPT, out, 16384ull * 1024, acc + 0);
    if (L == 0 && st == 9) chk::cmp(stream, 1, ws + mk::WS_A1, fb.a1, 16384ull * 1024, acc + 2);
  });
#elif CHECK == 3
  ref::MixBuf mb; { char* p = wsc + 12 * MiB; mb.a0 = (float*)p; p += 65 * MiB; mb.z = (float*)p; p += 130 * MiB; mb.g = (float*)p; p += 32 * MiB; mb.t = (float*)p; p += 32 * MiB; mb.concat = (float*)p; p += 64 * MiB; mb.ymix = mb.z; }
  char* moe_arena = wsc + 12 * MiB;
  ref::FourBuf fb; fb.Z = (float*)(wsc + 270 * MiB);
  fb.a1 = (float*)(wsc + 12 * MiB); fb.Yr = (float*)(wsc + 12 * MiB);   fb.Yi = (float*)(wsc + 468 * MiB - 0); fb.F = (float*)(wsc + 270 * MiB); fb.yf = (float*)(wsc + 334 * MiB);
  fb.Yi = (float*)(wsc + 76 * MiB);
  nchk = 4;
  a.flags = mk::FLAG_SKIP_EXPERTS;
  ref::forward(stream, in, out, sm, mb, moe_arena, fb, [&](int st) {
    if (st == 9) {
      mk::Args b = a; b.h = HOPT;
      mk_run(stream, b, 0, 1);
      hipLaunchKernelGGL(chk::k_f2bf, dim3(2048), dim3(256), 0, stream, fb.a1, (chk::bf16_t*)(ws + mk::WS_A1), (size_t)16384 * 1024);
      (void)hipMemcpyAsync(HOPT, out, (size_t)16384 * 1024 * 4, hipMemcpyDeviceToDevice, stream);
      mk_run(stream, b, 16, 17);
    }
  });
#endif
  hipLaunchKernelGGL(chk::k_judge, dim3(1), dim3(64), 0, stream, acc, nchk, 0.05f, fail);
  hipLaunchKernelGGL(chk::k_encode, dim3(2048), dim3(256), 0, stream, out, (size_t)16384 * 1024, fail);
#endif
}
```

```cpp
#define CHECK 0
#define MK_N_LAUNCHES 1
#define MK_SP2 true
#define REP_MASK 0ull
#include <hip/hip_runtime.h>
#include <cstdio>
#include <cstdint>
#include <cmath>
namespace mk {
#define LAS __attribute__((address_space(3)))
typedef unsigned short bf16_t;
typedef short bf16x8 __attribute__((ext_vector_type(8)));
typedef float f32x4 __attribute__((ext_vector_type(4)));
typedef float f32x2 __attribute__((ext_vector_type(2)));
typedef unsigned u32x4 __attribute__((ext_vector_type(4)));
typedef unsigned u32x2 __attribute__((ext_vector_type(2)));
typedef int i32x8 __attribute__((ext_vector_type(8)));
typedef int i32x4 __attribute__((ext_vector_type(4)));

constexpr int TOK = 16384, CTXN = 256, NROW = TOK + CTXN;
constexpr int NWAVES = 8, NTHR = 512;
constexpr int LDS_STAGE = 131072, LDS_BYTES = 155648, LDS_MISC_OFF = LDS_BYTES - 4096;

__device__ __forceinline__ unsigned cvt_pk_bf16(float lo, float hi) { unsigned r; asm volatile("v_cvt_pk_bf16_f32 %0, %1, %2" : "=v"(r) : "v"(lo), "v"(hi)); return r; }
__device__ __forceinline__ int pack4_fp8(float a, float b, float c, float d) { int w = 0;
  w = __builtin_amdgcn_cvt_pk_fp8_f32(__builtin_amdgcn_fmed3f(a, -448.f, 448.f), __builtin_amdgcn_fmed3f(b, -448.f, 448.f), w, false);
  w = __builtin_amdgcn_cvt_pk_fp8_f32(__builtin_amdgcn_fmed3f(c, -448.f, 448.f), __builtin_amdgcn_fmed3f(d, -448.f, 448.f), w, true); return w; }
__device__ __forceinline__ void st16_wt(void* p, u32x4 v) { asm volatile("global_store_dwordx4 %0, %1, off sc1\n\ts_nop 1" :: "v"(p), "v"(v) : "memory"); }
__device__ __forceinline__ float bf_lo(unsigned w) { return __uint_as_float(w << 16); }
__device__ __forceinline__ float bf_hi(unsigned w) { return __uint_as_float(w & 0xffff0000u); }
__device__ __forceinline__ float bf2f(bf16_t b) { return __uint_as_float(((unsigned)b) << 16); }
__device__ __forceinline__ bf16_t f2bf(float f) { unsigned u = __float_as_uint(f); return (bf16_t)((u + 0x7fffu + ((u >> 16) & 1u)) >> 16); }
__device__ __forceinline__ float sx(float v, int o) { unsigned z = 0u; asm volatile("" : "+v"(z)); int l = (int)__builtin_amdgcn_mbcnt_hi(~0u, __builtin_amdgcn_mbcnt_lo(~0u, z)); return __int_as_float(__builtin_amdgcn_ds_bpermute((l ^ o) << 2, __float_as_int(v))); }
__device__ __forceinline__ float wave_sum(float v) {
#pragma unroll
  for (int o = 1; o < 64; o <<= 1) v += sx(v, o);
  return v;
}
__device__ __forceinline__ float fast_sigmoid(float x) { return __builtin_amdgcn_rcpf(1.f + __expf(-x)); }
__device__ __forceinline__ float fast_tanh(float x) { float e = __expf(2.f * x); return 1.f - 2.f * __builtin_amdgcn_rcpf(e + 1.f); }
__device__ __forceinline__ float gelu_tanh(float x) { return 0.5f * x * (1.f + fast_tanh(0.7978845608028654f * (x + 0.044715f * x * x * x))); }

#define XB_TMO      128
#define XB_XCNT(j)  (256  + 64 * (j))
#define XB_XSUB(j)  (1280 + 64 * (j))
#define XB_XGEN(j)  (2304 + 64 * (j))
#define XB_TOP      3328
#define XB_TOPGEN   3392
#define XCD_BAR_WORDS 3456
#define XB_SPIN_CAP (1u << 20)
__device__ __forceinline__ unsigned xb_ld(unsigned* p) { return __hip_atomic_load(p, __ATOMIC_RELAXED, __HIP_MEMORY_SCOPE_AGENT); }
__device__ __forceinline__ unsigned xb_add(unsigned* p, unsigned v) { return __hip_atomic_fetch_add(p, v, __ATOMIC_RELAXED, __HIP_MEMORY_SCOPE_AGENT); }
__device__ __forceinline__ unsigned xb_xcc_id() { return (unsigned)__builtin_amdgcn_s_getreg((3 << 11) | 20) & 0xFu; }
#define XB_SPIN(cond, bar) do { unsigned _sp = 0; while (cond) { __builtin_amdgcn_s_sleep(1); \
    if ((++_sp & 255u) == 0u) { if (xb_ld(&(bar)[XB_TMO])) break; if (_sp > XB_SPIN_CAP) { atomicAdd(&(bar)[XB_TMO], 1u); break; } } } } while (0)
struct XcdBarrier { unsigned* bar; unsigned x; volatile LAS unsigned* st; };
__device__ __forceinline__ XcdBarrier xcd_barrier_post(unsigned* bar, volatile LAS unsigned* st, int tid) {
  XcdBarrier b; b.bar = bar; b.x = xb_xcc_id(); b.st = st;
  if (tid == 0) (void)xb_add(&bar[XB_XCNT(b.x)], 1u);
  return b;
}
__device__ __forceinline__ void xcd_barrier_complete(unsigned* bar, unsigned x, unsigned& nloc, unsigned& nx) {
  const unsigned G = gridDim.x * gridDim.y * gridDim.z;
  unsigned sum, cnt, mine, sp = 0u;
  for (;;) {
    sum = 0u; cnt = 0u; mine = 0u;
#pragma unroll
    for (unsigned j = 0; j < 16; ++j) { const unsigned c = xb_ld(&bar[XB_XCNT(j)]); sum += c; cnt += (c > 0u) ? 1u : 0u; }
    if (sum == G) { mine = xb_ld(&bar[256 + 64 * x]); break; }
    __builtin_amdgcn_s_sleep(1);
    if ((++sp & 255u) == 0u) { if (xb_ld(&bar[XB_TMO])) break; if (sp > XB_SPIN_CAP) { atomicAdd(&bar[XB_TMO], 1u); break; } }
  }
  nloc = mine > 0u ? mine : 1u; nx = cnt > 0u ? cnt : 1u;
}
__device__ __forceinline__ void xcd_barrier(const XcdBarrier& b, int tid) {
  asm volatile("s_waitcnt vmcnt(0)" ::: "memory");
  __syncthreads();
  if (tid == 0) {
    unsigned* bar = b.bar;
    __builtin_amdgcn_s_waitcnt(0);
    unsigned nloc = b.st[0], nx = b.st[1];
    if (nloc == 0u) { xcd_barrier_complete(bar, b.x, nloc, nx); b.st[0] = nloc; b.st[1] = nx; }
    const unsigned old = xb_add(&bar[XB_XSUB(b.x)], 1u);
    const unsigned gen = old / nloc;
    if (old + 1u == (gen + 1u) * nloc) {
      __builtin_amdgcn_fence(__ATOMIC_RELEASE, "agent");
      asm volatile("s_waitcnt vmcnt(0)" ::: "memory");
      const unsigned og = xb_add(&bar[XB_TOP], 1u);
      const unsigned tg = og / nx;
      if (og + 1u == (tg + 1u) * nx) xb_add(&bar[XB_TOPGEN], 1u);
      else XB_SPIN(xb_ld(&bar[XB_TOPGEN]) == tg, bar);
      __builtin_amdgcn_fence(__ATOMIC_ACQUIRE, "agent");
      xb_add(&bar[XB_XGEN(b.x)], 1u);
      asm volatile("s_waitcnt vmcnt(0)" ::: "memory");
    } else {
      XB_SPIN(xb_ld(&bar[XB_XGEN(b.x)]) == gen, bar);
      __builtin_amdgcn_fence(__ATOMIC_ACQUIRE, "agent");
      asm volatile("s_waitcnt vmcnt(0)" ::: "memory");
    }
  }
  __syncthreads();
}

constexpr int BM = 256, BK = 64, HALF = 128, HTB = HALF * BK * 2, NXCD = 8;
__device__ __forceinline__ int lds_byte(int r, int c) { const int st = (r >> 4) * 2 + (c >> 5), rr = r & 15, cc = c & 31, ob = rr * 64 + cc * 2; return st * 1024 + (ob ^ (((ob >> 9) & 1) << 5)); }
__device__ __forceinline__ void stage_rc(int b, int& R, int& C) { const int st = b / 1024, sb = b % 1024, swz = sb ^ (((sb >> 9) & 1) << 5); R = (st >> 1) * 16 + swz / 64; C = (st & 1) * 32 + (swz % 64) / 2; }
__device__ __forceinline__ int swz16(int fr) { return 2 * ((fr >> 1) & 1) + 4 * ((fr >> 3) & 1); }
__device__ __forceinline__ int swz8(int fr) { return ((fr >> 1) & 1) + 4 * ((fr >> 3) & 1); }
__device__ __forceinline__ int perm32(int rho) { const int n = rho >> 4, i = rho & 15; return 8 * (i >> 2) + 4 * n + (i & 3); }

struct Unit { int pm, pn, a, b, ord; };
__device__ __forceinline__ int xcd_remap(int L, int nunits) { const int q = nunits / NXCD, r = nunits % NXCD, xcd = L % NXCD, off = L / NXCD; return (xcd < r ? xcd * (q + 1) : r * (q + 1) + (xcd - r) * q) + off; }
typedef f32x4 Acc[2][2][4][2];
template <class P, bool SP2>
__device__ __forceinline__ void gemm_phase(LAS unsigned char* lds, const P& p, int G, int c, int tid_in) {
  const int tid = tid_in, wid = __builtin_amdgcn_readfirstlane(tid >> 6), lane = tid & 63, wr = wid >> 2, wc = wid & 3, fr = lane & 15, fq = lane >> 4;
  const int K = p.K, nt = K / BK;
  const int nunits = p.nunits;
  const size_t kstep = (size_t)(BK * 2);
  const unsigned ldsw = (unsigned)wid * 1024u;
  const int aoff0 = P::F8 ? (wr * 64 + fr) * 128 + ((2 * fq) ^ swz8(fr)) * 16 : lds_byte(wr * 64 + fr, fq * 8);
  const int boff0 = P::F8 ? (wc * 32 + fr) * 128 + ((2 * fq) ^ swz8(fr)) * 16 : lds_byte(wc * 32 + fr, fq * 8);
#define PG8_SA(b, h) (((b) * 2 + (h)) * HTB)
#define PG8_SB(b, h) ((4 + (b) * 2 + (h)) * HTB)
#define PG8_STAGE(bufoff, gbase, voff) do { _Pragma("unroll") for (int _i = 0; _i < 2; ++_i) \
        __builtin_amdgcn_global_load_lds((const unsigned*)((const char*)(gbase) + (voff)[_i]), (LAS unsigned*)(lds + (bufoff) + ldsw + _i * 8192), 16, 0, 0); } while (0)
#define PG8_RD32(p0_, p1_) __builtin_shufflevector(*(const LAS i32x4*)(p0_), *(const LAS i32x4*)(p1_), 0, 1, 2, 3, 4, 5, 6, 7)
#define PG8_LDA(dst, b, h) do { if constexpr (P::F8) { int _o1 = aoff0 ^ 16; asm volatile("" : "+v"(_o1)); _Pragma("unroll") for (int m = 0; m < 4; ++m) dst##8[m] = PG8_RD32(lds + PG8_SA(b, h) + aoff0 + m * 2048, lds + PG8_SA(b, h) + _o1 + m * 2048); } \
        else { _Pragma("unroll") for (int m = 0; m < 4; ++m) _Pragma("unroll") for (int k = 0; k < 2; ++k) dst[m][k] = *(const LAS bf16x8*)(lds + PG8_SA(b, h) + aoff0 + m * 2048 + k * 1024); } } while (0)
#define PG8_LDB(dst, b, h) do { if constexpr (P::F8) { int _o1 = boff0 ^ 16; asm volatile("" : "+v"(_o1)); _Pragma("unroll") for (int n = 0; n < 2; ++n) dst##8[n] = PG8_RD32(lds + PG8_SB(b, h) + boff0 + n * 2048, lds + PG8_SB(b, h) + _o1 + n * 2048); } \
        else { _Pragma("unroll") for (int n = 0; n < 2; ++n) _Pragma("unroll") for (int k = 0; k < 2; ++k) dst[n][k] = *(const LAS bf16x8*)(lds + PG8_SB(b, h) + boff0 + n * 2048 + k * 1024); } } while (0)
#define PG8_MMA(ai, bj, At, Bt) do { __builtin_amdgcn_s_setprio(1); if constexpr (P::F8) { _Pragma("unroll") for (int m = 0; m < 4; ++m) _Pragma("unroll") for (int n = 0; n < 2; ++n) \
        acc[ai][bj][m][n] = __builtin_amdgcn_mfma_scale_f32_16x16x128_f8f6f4(Bt##8[n], At##8[m], acc[ai][bj][m][n], 0, 0, 0, 0, 0, 0); }     \
        else { _Pragma("unroll") for (int m = 0; m < 4; ++m) _Pragma("unroll") for (int n = 0; n < 2; ++n) _Pragma("unroll") for (int k = 0; k < 2; ++k) \
        acc[ai][bj][m][n] = __builtin_amdgcn_mfma_f32_16x16x32_bf16(Bt[n][k], At[m][k], acc[ai][bj][m][n], 0, 0, 0); } __builtin_amdgcn_s_setprio(0); } while (0)
#define PG8_WAIT_V(n) asm volatile("s_waitcnt vmcnt(" #n ")" ::: "memory")
#define PG8_WAIT_L(n) asm volatile("s_waitcnt lgkmcnt(" #n ")" ::: "memory")
#define PG8_BAR __builtin_amdgcn_s_barrier()
#define PG8_SCHED __builtin_amdgcn_sched_barrier(0)
#define PG8_DECODE(i, u) do { p.decode(P::CONTIG ? (u_lo + (i)) : xcd_remap((i) * G + c, nunits), u); u.ord = (i); } while (0)
#define PG8_HAS(i) (P::CONTIG ? (u_lo + (i) < u_hi) : ((i) * G + c < nunits))
#define PG8_OFFS(u, vA, vB) do { int _t = tid; asm volatile("" : "+v"(_t)); _Pragma("unroll") for (int _i = 0; _i < 2; ++_i) { int _R, _C; if constexpr (P::F8) { const int _p = _t + 512 * _i; _R = _p >> 3; _C = ((_p & 7) ^ swz8(_R & 15)) * 8; } else stage_rc(_t * 16 + _i * 8192, _R, _C); \
        const int _Rb = P::PERM ? ((_R & ~31) + perm32(_R & 31)) : _R; _Pragma("unroll") for (int _h = 0; _h < 2; ++_h) { \
        if (_h == 0 || !P::LINA) vA[_h][_i] = p.rowA(u, _h * HALF + _R) + (unsigned)(_C * 2); if (_h == 0 || !P::LINB) vB[_h][_i] = p.rowB(u, _h * HALF + _Rb) + (unsigned)(_C * 2); } } } while (0)
  const int vc_ = (G % 8 == 0) ? (c % 8) * (G / 8) + c / 8 : c;
  const int u_lo = (int)(((long)vc_ * nunits) / G), u_hi = (int)(((long)(vc_ + 1) * nunits) / G);
  if (!PG8_HAS(0)) return;
  Unit cur, nxt; int ui = 0;
  PG8_DECODE(0, cur);
  Acc acc; float zf_ = 0.f; asm volatile("" : "+v"(zf_));
#pragma unroll
  for (int a = 0; a < 2; ++a)
#pragma unroll
    for (int b = 0; b < 2; ++b)
#pragma unroll
      for (int m = 0; m < 4; ++m)
#pragma unroll
        for (int n = 0; n < 2; ++n) acc[a][b][m][n] = (f32x4){zf_, zf_, zf_, zf_};
  bf16x8 At[4][2], B0[2][2], B1[2][2]; i32x8 At8[4], B08[2], B18[2];
  unsigned vA[2][2], vB[2][2];
  PG8_OFFS(cur, vA, vB);
  const char* cA = p.baseA(cur); const char* cB = p.baseB(cur);
  const size_t hA = P::LINA ? p.halfA() : 0, hB = P::LINB ? p.halfB() : 0;
  if constexpr (SP2) {
    PG8_STAGE(PG8_SB(0, 0), cB, vB[0]); PG8_STAGE(PG8_SB(0, 1), (cB) + (P::LINB ? hB : 0), vB[P::LINB ? 0 : 1]); PG8_STAGE(PG8_SA(0, 0), cA, vA[0]); PG8_STAGE(PG8_SA(0, 1), (cA) + (P::LINA ? hA : 0), vA[P::LINA ? 0 : 1]);
    if (wr == 1) PG8_BAR;
    PG8_WAIT_V(2); PG8_BAR;
    PG8_STAGE(PG8_SB(1, 0), cB + kstep, vB[0]); PG8_STAGE(PG8_SA(1, 0), cA + kstep, vA[0]); PG8_STAGE(PG8_SB(1, 1), (cB + kstep) + (P::LINB ? hB : 0), vB[P::LINB ? 0 : 1]);
    PG8_WAIT_V(6); PG8_BAR;
  } else {
    PG8_STAGE(PG8_SB(0, 0), cB, vB[0]); PG8_STAGE(PG8_SA(0, 0), cA, vA[0]); PG8_STAGE(PG8_SB(0, 1), (cB) + (P::LINB ? hB : 0), vB[P::LINB ? 0 : 1]); PG8_STAGE(PG8_SA(0, 1), (cA) + (P::LINA ? hA : 0), vA[P::LINA ? 0 : 1]);
    if (wr == 1) PG8_BAR;
    PG8_WAIT_V(4); PG8_BAR;
    PG8_STAGE(PG8_SB(1, 0), cB + kstep, vB[0]); PG8_STAGE(PG8_SA(1, 0), cA + kstep, vA[0]); PG8_STAGE(PG8_SB(1, 1), (cB + kstep) + (P::LINB ? hB : 0), vB[P::LINB ? 0 : 1]);
    PG8_WAIT_V(6); PG8_BAR;
  }
  for (;;) {
    const bool has_next = PG8_HAS(ui + 1);
    if (has_next) PG8_DECODE(ui + 1, nxt);
    const char* nA = has_next ? p.baseA(nxt) : cA; const char* nB = has_next ? p.baseB(nxt) : cB;
    for (int t = 0; t < nt; t += 2) {
      const bool last = (t == nt - 2);
      const char* a1 = cA + (size_t)(t + 1) * kstep;
      const char* a2 = last ? nA : cA + (size_t)(t + 2) * kstep; const char* b2 = last ? nB : cB + (size_t)(t + 2) * kstep;
      const char* a3 = a2 + kstep; const char* b3 = b2 + kstep;
      if constexpr (SP2) {
        PG8_LDB(B0, 0, 0); PG8_LDB(B1, 0, 1); PG8_SCHED; PG8_LDA(At, 0, 0); PG8_STAGE(PG8_SA(1, 1), (a1) + (P::LINA ? hA : 0), vA[P::LINA ? 0 : 1]);
        PG8_WAIT_V(8); PG8_WAIT_L(0); PG8_BAR; PG8_MMA(0, 0, At, B0); PG8_MMA(0, 1, At, B1); PG8_BAR; PG8_SCHED;
        if (last && has_next) { PG8_OFFS(nxt, vA, vB); }
        PG8_LDA(At, 0, 1); PG8_STAGE(PG8_SB(0, 0), b2, vB[0]); PG8_STAGE(PG8_SB(0, 1), (b2) + (P::LINB ? hB : 0), vB[P::LINB ? 0 : 1]); PG8_STAGE(PG8_SA(0, 0), a2, vA[0]);
        PG8_WAIT_V(8); PG8_WAIT_L(0); PG8_BAR; PG8_MMA(1, 0, At, B0); PG8_MMA(1, 1, At, B1); PG8_BAR; PG8_SCHED;
        PG8_LDB(B0, 1, 0); PG8_LDB(B1, 1, 1); PG8_SCHED; PG8_LDA(At, 1, 0); PG8_STAGE(PG8_SA(0, 1), (a2) + (P::LINA ? hA : 0), vA[P::LINA ? 0 : 1]);
        PG8_WAIT_V(8); PG8_WAIT_L(0); PG8_BAR; PG8_MMA(0, 0, At, B0); PG8_MMA(0, 1, At, B1); PG8_BAR; PG8_SCHED;
        PG8_LDA(At, 1, 1); PG8_STAGE(PG8_SB(1, 0), b3, vB[0]); PG8_STAGE(PG8_SB(1, 1), (b3) + (P::LINB ? hB : 0), vB[P::LINB ? 0 : 1]); PG8_STAGE(PG8_SA(1, 0), a3, vA[0]);
        PG8_WAIT_V(8); PG8_WAIT_L(0); PG8_BAR; PG8_MMA(1, 0, At, B0); PG8_MMA(1, 1, At, B1); PG8_BAR; PG8_SCHED;
      } else {
        PG8_LDB(B0, 0, 0); PG8_SCHED; PG8_LDA(At, 0, 0); PG8_STAGE(PG8_SA(1, 1), (a1) + (P::LINA ? hA : 0), vA[P::LINA ? 0 : 1]);
        PG8_WAIT_L(8); PG8_BAR; PG8_WAIT_L(0); PG8_MMA(0, 0, At, B0); PG8_BAR; PG8_SCHED;
        if (last && has_next) { PG8_OFFS(nxt, vA, vB); }
        PG8_LDB(B1, 0, 1); PG8_STAGE(PG8_SB(0, 0), b2, vB[0]);
        PG8_BAR; PG8_WAIT_L(0); PG8_MMA(0, 1, At, B1); PG8_BAR;
        PG8_LDA(At, 0, 1); PG8_STAGE(PG8_SA(0, 0), a2, vA[0]);
        PG8_BAR; PG8_WAIT_L(0); PG8_MMA(1, 0, At, B0); PG8_BAR; PG8_SCHED;
        PG8_STAGE(PG8_SB(0, 1), (b2) + (P::LINB ? hB : 0), vB[P::LINB ? 0 : 1]);
        PG8_WAIT_V(6); PG8_BAR; PG8_MMA(1, 1, At, B1); PG8_BAR;
        PG8_LDB(B0, 1, 0); PG8_SCHED; PG8_LDA(At, 1, 0); PG8_STAGE(PG8_SA(0, 1), (a2) + (P::LINA ? hA : 0), vA[P::LINA ? 0 : 1]);
        PG8_WAIT_L(8); PG8_BAR; PG8_WAIT_L(0); PG8_MMA(0, 0, At, B0); PG8_BAR; PG8_SCHED;
        PG8_LDB(B1, 1, 1); PG8_STAGE(PG8_SB(1, 0), b3, vB[0]);
        PG8_BAR; PG8_WAIT_L(0); PG8_MMA(0, 1, At, B1); PG8_BAR;
        PG8_LDA(At, 1, 1); PG8_STAGE(PG8_SA(1, 0), a3, vA[0]);
        PG8_BAR; PG8_WAIT_L(0); PG8_MMA(1, 0, At, B0); PG8_BAR; PG8_SCHED;
        PG8_STAGE(PG8_SB(1, 1), (b3) + (P::LINB ? hB : 0), vB[P::LINB ? 0 : 1]);
        PG8_WAIT_V(6); PG8_BAR; PG8_MMA(1, 1, At, B1); PG8_BAR;
      }
    }
    if constexpr (P::ALIGN) { if (wr == 0) PG8_BAR; }
    { int fr_e = fr, fq_e = fq; asm volatile("" : "+v"(fr_e), "+v"(fq_e)); p.epi(acc, cur, wr, wc, fr_e, fq_e); }
    if (!has_next) break;
    zf_ = 0.f; asm volatile("" : "+v"(zf_));
#pragma unroll
    for (int a = 0; a < 2; ++a)
#pragma unroll
      for (int b = 0; b < 2; ++b)
#pragma unroll
        for (int m = 0; m < 4; ++m)
#pragma unroll
          for (int n = 0; n < 2; ++n) acc[a][b][m][n] = (f32x4){zf_, zf_, zf_, zf_};
    cur = nxt; cA = nA; cB = nB; ++ui;
    if constexpr (P::ALIGN) { if (wr == 1) PG8_BAR; }
  }
  PG8_WAIT_V(0);
  if constexpr (!P::ALIGN) { if (wr == 0) PG8_BAR; }
  PG8_BAR;
#undef PG8_SA
#undef PG8_SB
#undef PG8_STAGE
#undef PG8_RD32
#undef PG8_LDA
#undef PG8_LDB
#undef PG8_MMA
#undef PG8_WAIT_V
#undef PG8_WAIT_L
#undef PG8_BAR
#undef PG8_SCHED
#undef PG8_DECODE
#undef PG8_HAS
#undef PG8_OFFS
}
}
namespace mk {
constexpr size_t MiB = 1u << 20;
constexpr size_t WS_CTL = 0, CTL_ZERO_BYTES = 65536;
constexpr size_t WS_MOD = 65536;
constexpr size_t WS_LAML = 262144;
constexpr size_t WS_WIN_T = 1 * MiB, WS_WGLU_T = 5 * MiB, WS_WMIX_T = 6 * MiB, WS_WFOUR_T = 8 * MiB, WS_WROUT_T = 10 * MiB;
constexpr size_t WS_DMT = 10 * MiB + 512 * 1024, WS_W1 = 10 * MiB + 768 * 1024, WS_W2 = 10 * MiB + 896 * 1024;
constexpr size_t WS_WEXP = 12 * MiB, EXP_STRIDE = 3 * MiB / 2, EXP_DOFF = 1 * MiB;
constexpr size_t WS_R = 110 * MiB;
constexpr size_t WS_WS = WS_R, WS_TT = WS_R + 8 * MiB, WS_A0 = WS_R + 34 * MiB, WS_AS5 = WS_R + 67 * MiB, WS_Q = WS_R + 103 * MiB, WS_K = WS_R + 119 * MiB,
                 WS_VT = WS_R + 136 * MiB, WS_SST = WS_R + 153 * MiB, WS_GB = WS_R + 177 * MiB, WS_CONCAT = WS_R + 193 * MiB;
constexpr size_t WS_F = WS_R, WS_LTOK = WS_R + 16 * MiB, WS_ASG = WS_R + 20 * MiB, WS_HID = WS_R + 22 * MiB, WS_YAS = WS_R + 102 * MiB,
                 WS_A1 = WS_R + 262 * MiB, WS_HB = WS_R + 294 * MiB;
constexpr size_t WS_X1 = WS_R, WS_X2 = WS_R + 64 * MiB, WS_SPC = WS_R + 96 * MiB, WS_FB = WS_R + 128 * MiB;
constexpr size_t WS_HOPT = WS_R + 338 * MiB;
constexpr size_t WS_WEXP1 = WS_R + 338 * MiB;
constexpr size_t EXP1_STRIDE = 1 * MiB, EXP1_DOFF = 512 * 1024;
constexpr size_t WS_NEED = WS_R + 403 * MiB;
constexpr int HALF_CAP_ROWS = 90112;
constexpr int CW_BAR = 4096, CW_CNT = 8192  , CW_DQ0 = 12288, CW_DQ1 = 12352, CW_DONE = 13312  ;

struct Args { const float* in[31]; float* h; unsigned char* ws; int ph_lo, ph_hi, flags, pad; };
enum { IN_X = 0, IN_C, IN_CTX, IN_CCTX, IN_WADA, IN_BADA, IN_WIN, IN_LRE, IN_LIM, IN_LDT, IN_BRE, IN_BIM, IN_CRE, IN_CIM, IN_S5D, IN_WGLU, IN_BGLU, IN_QG, IN_KG,
       IN_RPB, IN_WMIX, IN_WFOUR, IN_BFOUR, IN_WROUT, IN_RBIAS, IN_WEG, IN_WEU, IN_WED, IN_WSG, IN_WSU, IN_WSD };
constexpr int FLAG_SKIP_EXPERTS = 1;

struct Ctx {
  LAS unsigned char* lds; const Args* a; unsigned char* ws; int tid, lane, wave, G, c;
};

__device__ __forceinline__ u32x4 pack8(const f32x4& v0, const f32x4& v1) { u32x4 w; w.x = cvt_pk_bf16(v0[0], v0[1]); w.y = cvt_pk_bf16(v0[2], v0[3]); w.z = cvt_pk_bf16(v1[0], v1[1]); w.w = cvt_pk_bf16(v1[2], v1[3]); return w; }
__device__ __forceinline__ int rowmap(int code, int n) {
  if (code == 1) { if (n < 512 || n >= 1536) return n; const int blk = n & ~255, c = n & 255; return blk + 128 * ((c >> 5) & 1) + 32 * (c >> 6) + (c & 31); }
  if (code == 2) return 256 * (n >> 7) + (n & 127);
  if (code == 3) return 256 * (n >> 7) + 128 + (n & 127);
  return n;
}
__device__ __forceinline__ int kmap(int kcode, int k) {
  if (kcode == 1) { const int h = k >> 9, g = (k >> 7) & 3, m = k & 127; return g * 256 + (h == 0 ? m : (m == 0 ? 128 : 256 - m)); }
  return k;
}
__device__ __forceinline__ void transpose_item(const float* W, int K, int N, bf16_t* WT, int code, LAS unsigned char* scr, int item, int lane, int kcode = 0) {
  const int nblk = N / 64, kb = item / nblk, nb = item % nblk, k0 = 64 * kb, n0 = 64 * nb;
  const int q = lane >> 4, a = lane & 15;
  f32x4 v[16];
  const float* src = W + (size_t)(k0 + 2 * q) * N + n0 + 4 * a;
  if (kcode == 0) {
#pragma unroll
    for (int i = 0; i < 16; ++i) v[i] = *(const f32x4*)(src + (size_t)((i & 1) + 8 * (i >> 1)) * N);
  } else {
#pragma unroll
    for (int i = 0; i < 16; ++i) v[i] = *(const f32x4*)(W + (size_t)kmap(kcode, k0 + 2 * q + (i & 1) + 8 * (i >> 1)) * N + n0 + 4 * a);
  }
#pragma unroll
  for (int ii = 0; ii < 8; ++ii) { const int dsw = q + 4 * (ii ^ (a & 7));
#pragma unroll
    for (int j = 0; j < 4; ++j) *(LAS unsigned*)(scr + (4 * a + j) * 128 + 4 * dsw) = cvt_pk_bf16(v[2 * ii][j], v[2 * ii + 1][j]); }
  asm volatile("s_waitcnt lgkmcnt(0)" ::: "memory");
  const int c = lane & 7;
#pragma unroll
  for (int jj = 0; jj < 8; ++jj) { const int n = (lane >> 3) + 8 * jj, cs = c ^ ((n >> 2) & 7);
    const u32x4 o = *(const LAS u32x4*)(scr + n * 128 + 16 * cs);
    *(u32x4*)(WT + (size_t)rowmap(code, n0 + n) * K + k0 + 8 * c) = o; }
  asm volatile("s_waitcnt lgkmcnt(0)" ::: "memory");
}
__device__ __forceinline__ void transpose_item8(const float* W, int K, int N, unsigned char* WT, int code, float scale, LAS unsigned char* scr, int item, int lane) {
  const int nblk = N / 64, kb = item / nblk, nb = item % nblk, k0 = 64 * kb, n0 = 64 * nb;
  const int q = lane >> 4, a = lane & 15;
  f32x4 v[16];
  const float* src = W + (size_t)(k0 + 4 * q) * N + n0 + 4 * a;
#pragma unroll
  for (int i = 0; i < 16; ++i) v[i] = *(const f32x4*)(src + (size_t)((i & 3) + 16 * (i >> 2)) * N);
#pragma unroll
  for (int ib = 0; ib < 4; ++ib) { const int dsw = q + 4 * (ib ^ (a & 3));
#pragma unroll
    for (int j = 0; j < 4; ++j) *(LAS int*)(scr + (4 * a + j) * 64 + 4 * dsw) = pack4_fp8(v[4 * ib][j] * scale, v[4 * ib + 1][j] * scale, v[4 * ib + 2][j] * scale, v[4 * ib + 3][j] * scale); }
  asm volatile("s_waitcnt lgkmcnt(0)" ::: "memory");
  const int c = lane & 3;
#pragma unroll
  for (int jj = 0; jj < 4; ++jj) { const int n = (lane >> 2) + 16 * jj, cs = c ^ ((n >> 2) & 3);
    const u32x4 o = *(const LAS u32x4*)(scr + n * 64 + 16 * cs);
    *(u32x4*)(WT + (size_t)rowmap(code, n0 + n) * K + k0 + 16 * c) = o; }
  asm volatile("s_waitcnt lgkmcnt(0)" ::: "memory");
}
constexpr int IT_WIN = 512, IT_GLU = 64, IT_MIX = 256, IT_FOUR = 256, IT_ROUT = 32, IT_SMALL = IT_WIN + IT_GLU + IT_MIX + IT_FOUR + IT_ROUT, IT_EXP = 192;
__device__ __forceinline__ void small_item(const Ctx& X, LAS unsigned char* scr, int it) {
  const Args& a = *X.a; unsigned char* ws = X.ws;
  if (it < IT_WIN) { transpose_item(a.in[IN_WIN], 1024, 2048, (bf16_t*)(ws + WS_WIN_T), 1, scr, it, X.lane); return; } it -= IT_WIN;
  if (it < IT_GLU) { transpose_item(a.in[IN_WGLU], 512, 512, (bf16_t*)(ws + WS_WGLU_T), 0, scr, it, X.lane); return; } it -= IT_GLU;
  if (it < IT_MIX) { transpose_item(a.in[IN_WMIX], 1024, 1024, (bf16_t*)(ws + WS_WMIX_T), 0, scr, it, X.lane); return; } it -= IT_MIX;
  if (it < IT_FOUR) { transpose_item(a.in[IN_WFOUR], 1024, 1024, (bf16_t*)(ws + WS_WFOUR_T), 0, scr, it, X.lane, 1); return; } it -= IT_FOUR;
  { const int l = it >> 4; transpose_item(a.in[IN_WROUT] + (size_t)l * 1024 * 64, 1024, 64, (bf16_t*)(ws + WS_WROUT_T) + (size_t)l * 64 * 1024, 0, scr, it & 15, X.lane); }
}
__device__ __forceinline__ void expert_item(const Ctx& X, LAS unsigned char* scr, int layer, int it) {
  const Args& a = *X.a; const int e = it / IT_EXP, r = it % IT_EXP;
  bf16_t* gu = (bf16_t*)(X.ws + (layer == 0 ? WS_WEXP + (size_t)e * EXP_STRIDE : WS_WEXP1 + (size_t)e * EXP1_STRIDE));
  bf16_t* dt = (bf16_t*)(X.ws + (layer == 0 ? WS_WEXP + (size_t)e * EXP_STRIDE + EXP_DOFF : WS_WEXP1 + (size_t)e * EXP1_STRIDE + EXP1_DOFF));
  const float *wg, *wu, *wd;
  if (e < 64) { const size_t o = ((size_t)layer * 64 + e) * 262144; wg = a.in[IN_WEG] + o; wu = a.in[IN_WEU] + o; wd = a.in[IN_WED] + o; }
  else { const size_t o = (size_t)layer * 262144; wg = a.in[IN_WSG] + o; wu = a.in[IN_WSU] + o; wd = a.in[IN_WSD] + o; }
  if (r < 64) transpose_item8(wg, 1024, 256, (unsigned char*)gu, 2, 32.f, scr, r, X.lane);
  else if (r < 128) transpose_item8(wu, 1024, 256, (unsigned char*)gu, 3, 32.f, scr, r - 64, X.lane);
  else transpose_item(wd, 256, 1024, dt, 0, scr, r - 128, X.lane);
}
__device__ __forceinline__ void transpose_work(const Ctx& X, unsigned* ctr, int first_small, int n_small, int layer, int n_exp_items, unsigned* done = nullptr, unsigned need = 0u) {
  LAS unsigned char* scr = X.lds + X.wave * 8192;
  volatile LAS int* shb = (volatile LAS int*)(X.lds + LDS_MISC_OFF + 1024);
  const int total = n_small + n_exp_items;
  const int per = done ? 1 : 4;
  for (;;) {
    __syncthreads();
    if (X.tid == 0) { int b = total; if (!done || __hip_atomic_load(done, __ATOMIC_RELAXED, __HIP_MEMORY_SCOPE_AGENT) < need) b = (int)atomicAdd(ctr, (unsigned)(8 * per)); shb[0] = b; }
    __syncthreads();
    const int base = shb[0];
    if (base >= total) break;
    for (int k = 0; k < per; ++k) { const int it = base + X.wave * per + k; if (it >= total) break;
      if (it < n_small) small_item(X, scr, first_small + it); else expert_item(X, scr, layer, it - n_small); }
  }
}

__device__ __forceinline__ void p0_adaln(const Ctx& X, int it) {
  const Args& a = *X.a; const int layer = it / 48, ct = it % 48, col = ct * 128 + X.lane;
  LAS float* sl = (LAS float*)X.lds;
  for (int i = X.tid; i < 2048; i += NTHR) { const float v = i < 1024 ? a.in[IN_C][i] : a.in[IN_CCTX][i - 1024]; sl[i] = v / (1.f + __expf(-v)); }
  __syncthreads();
  const float* W = a.in[IN_WADA] + (size_t)layer * 1024 * 6144 + col;
  float a0 = 0.f, a1 = 0.f, b0 = 0.f, b1 = 0.f; const int k0 = X.wave * 128;
#pragma unroll 16
  for (int k = 0; k < 128; ++k) { const float w0 = W[(size_t)(k0 + k) * 6144], w1 = W[(size_t)(k0 + k) * 6144 + 64]; const float s0 = sl[k0 + k], s1 = sl[1024 + k0 + k];
    a0 += s0 * w0; a1 += s1 * w0; b0 += s0 * w1; b1 += s1 * w1; }
  LAS float* red = sl + 2048;
  red[(X.wave * 128 + X.lane) * 2] = a0; red[(X.wave * 128 + X.lane) * 2 + 1] = a1; red[(X.wave * 128 + 64 + X.lane) * 2] = b0; red[(X.wave * 128 + 64 + X.lane) * 2 + 1] = b1;
  __syncthreads();
  if (X.tid < 256) { const int l = X.tid & 127, v = X.tid >> 7; float s = 0.f;
#pragma unroll
    for (int w = 0; w < 8; ++w) s += red[(w * 128 + l) * 2 + v];
    s += a.in[IN_BADA][layer * 6144 + ct * 128 + l];
    float* mod = (float*)(X.ws + WS_MOD);
    if (layer == 0) mod[v * 6144 + ct * 128 + l] = s; else if (v == 0) mod[2 * 6144 + ct * 128 + l] = s; }
  __syncthreads();
}

__device__ __forceinline__ void p0_s5tables(const Ctx& X, int g, int part) {
  const Args& a = *X.a;
  LAS f32x2* POW = (LAS f32x2*)X.lds;
  LAS f32x2* BB = (LAS f32x2*)(X.lds + 33792);
  LAS f32x2* CC = (LAS f32x2*)(X.lds + 33792 + 16384);
  LAS float* KK = (LAS float*)(X.lds + 33792 + 32768);
  LAS float* DD = (LAS float*)(X.lds + 33792 + 32768 + 65536);
  const int tid = X.tid;
  if (tid < 128) {
    const int dir = tid >> 6, p = tid & 63, idx = (dir * 32 + g) * 64 + p;
    const float lr = fminf(a.in[IN_LRE][idx], -1e-4f), li = a.in[IN_LIM][idx], dt = expf(a.in[IN_LDT][dir * 32 + g]);
    for (int tau = 0; tau <= 32; ++tau) { const float mg = expf(lr * dt * (float)tau); float sn, cs; sincospif(li * dt * (float)tau * 0.318309886183790672f, &sn, &cs); POW[(dir * 33 + tau) * 64 + p] = (f32x2){mg * cs, mg * sn}; }
    const f32x2 l1 = POW[(dir * 33 + 1) * 64 + p], l32 = POW[(dir * 33 + 32) * 64 + p];
    if (part == 0) ((float2*)(X.ws + WS_LAML))[idx] = make_float2(l32.x, l32.y);
    const float nr = l1.x - 1.f, ni = l1.y, den = lr * lr + li * li, cr = (nr * lr + ni * li) / den, ci = (ni * lr - nr * li) / den;
    for (int c = 0; c < 16; ++c) { const float xr = a.in[IN_BRE][idx * 16 + c], xi = a.in[IN_BIM][idx * 16 + c]; BB[(dir * 64 + p) * 16 + c] = (f32x2){cr * xr - ci * xi, cr * xi + ci * xr}; }
  }
  for (int i = tid; i < 2048; i += NTHR) { const int dir = i >> 10, c = (i >> 6) & 15, p = i & 63; const int gi = ((dir * 32 + g) * 16 + c) * 64 + p; CC[i] = (f32x2){a.in[IN_CRE][gi], a.in[IN_CIM][gi]}; }
  if (tid < 16) DD[tid] = a.in[IN_S5D][g * 16 + tid];
  __syncthreads();
  for (int combo = tid; combo < 1024; combo += NTHR) {
    const int dir = combo >> 9, tau = (combo >> 4) & 31, c = combo & 15;
    float accv[16];
#pragma unroll
    for (int j = 0; j < 16; ++j) accv[j] = 0.f;
#pragma unroll 2
    for (int p = 0; p < 64; ++p) {
      const f32x2 cc = CC[(dir * 16 + c) * 64 + p], pw = POW[(dir * 33 + tau) * 64 + p];
      const float zr = cc.x * pw.x - cc.y * pw.y, zi = cc.x * pw.y + cc.y * pw.x;
      const LAS f32x4* bp = (const LAS f32x4*)(BB + (dir * 64 + p) * 16);
#pragma unroll
      for (int j = 0; j < 8; ++j) { const f32x4 b = bp[j]; accv[2 * j] += zr * b.x - zi * b.y; accv[2 * j + 1] += zr * b.z - zi * b.w; }
    }
#pragma unroll
    for (int j = 0; j < 4; ++j) *(LAS f32x4*)(KK + ((dir * 32 + tau) * 16 + c) * 16 + 4 * j) = (f32x4){accv[4 * j], accv[4 * j + 1], accv[4 * j + 2], accv[4 * j + 3]};
  }
  __syncthreads();
  bf16_t* TT = (bf16_t*)(X.ws + WS_TT) + (size_t)g * 512 * 768;
  for (int q = part * 12288 + tid; q < (part + 1) * 12288; q += NTHR) {
    const int row = q / 96, cc8 = q % 96, i = row >> 4, c = row & 15; f32x4 v0, v1;
    if (cc8 < 64) {
      const int s = cc8 >> 1, c0 = (cc8 & 1) * 8;
      const int dir = s < i ? 0 : 1, tau = s < i ? i - s : s - i;
      const LAS f32x4* kp = (const LAS f32x4*)(KK + ((dir * 32 + tau) * 16 + c) * 16 + c0);
      v0 = kp[0]; v1 = kp[1];
      if (s == i) { const LAS f32x4* k0p = (const LAS f32x4*)(KK + ((0 * 32 + 0) * 16 + c) * 16 + c0); v0 += k0p[0]; v1 += k0p[1];
        const float d = DD[c]; const int dj = c - c0;
        if (dj >= 0 && dj < 4) v0[dj] += d; else if (dj >= 4 && dj < 8) v1[dj - 4] += d; }
    } else {
      const int kk = (cc8 - 64) * 8, dir = kk >> 7, ri = (kk >> 6) & 1, p0 = kk & 63, tau = dir == 0 ? i + 1 : 32 - i;
      const LAS f32x4* cp = (const LAS f32x4*)(CC + (dir * 16 + c) * 64 + p0); const LAS f32x4* pp = (const LAS f32x4*)(POW + (dir * 33 + tau) * 64 + p0);
      float v[8];
#pragma unroll
      for (int j = 0; j < 4; ++j) { const f32x4 cc = cp[j], pw = pp[j];
        v[2 * j] = ri == 0 ? (cc.x * pw.x - cc.y * pw.y) : -(cc.x * pw.y + cc.y * pw.x); v[2 * j + 1] = ri == 0 ? (cc.z * pw.z - cc.w * pw.w) : -(cc.z * pw.w + cc.w * pw.z); }
      v0 = (f32x4){v[0], v[1], v[2], v[3]}; v1 = (f32x4){v[4], v[5], v[6], v[7]};
    }
    *(u32x4*)(TT + (size_t)row * 768 + cc8 * 8) = pack8(v0, v1);
  }
  bf16_t* WSm = (bf16_t*)(X.ws + WS_WS) + (size_t)g * 256 * 512;
  for (int q = part * 4096 + tid; q < (part + 1) * 4096; q += NTHR) {
    const int n = q >> 6, cc8 = q & 63, dir = n >> 7, ri = (n >> 6) & 1, p = n & 63, s = cc8 >> 1, c0 = (cc8 & 1) * 8, tau = dir == 0 ? 31 - s : s;
    const f32x2 pw = POW[(dir * 33 + tau) * 64 + p]; const LAS f32x4* bp = (const LAS f32x4*)(BB + (dir * 64 + p) * 16 + c0); float v[8];
#pragma unroll
    for (int j = 0; j < 4; ++j) { const f32x4 b = bp[j]; v[2 * j] = ri == 0 ? (pw.x * b.x - pw.y * b.y) : (pw.x * b.y + pw.y * b.x); v[2 * j + 1] = ri == 0 ? (pw.x * b.z - pw.y * b.w) : (pw.x * b.w + pw.y * b.z); }
    *(u32x4*)(WSm + (size_t)n * 512 + cc8 * 8) = pack8((f32x4){v[0], v[1], v[2], v[3]}, (f32x4){v[4], v[5], v[6], v[7]});
  }
  __syncthreads();
}

__device__ __forceinline__ void p0_dftconst(const Ctx& X, int idx) {
  for (int q = idx * NTHR + X.tid; q < 24576; q += 32 * NTHR) {
    float v[8]; bf16_t* dst;
    if (q < 8192) {
      const int R = q >> 5, c0 = (q & 31) * 8, ri = R >> 7, m = R & 127; dst = (bf16_t*)(X.ws + WS_DMT) + (size_t)R * 256 + c0;
#pragma unroll
      for (int j = 0; j < 8; ++j) { float s, c; sincospif((float)(((c0 + j) * m) & 255) * (1.f / 128.f), &s, &c); v[j] = ri == 0 ? c : (m == 0 ? (((c0 + j) & 1) ? -1.f : 1.f) : -s); }
    } else if (q < 16384) {
      const int q2 = q - 8192, R = q2 >> 5, c0 = (q2 & 31) * 8, rip = R >> 7, ka = R & 127; dst = (bf16_t*)(X.ws + WS_W1) + (size_t)R * 256 + c0;
#pragma unroll
      for (int j = 0; j < 8; ++j) { const int C = c0 + j, ri = C >> 7, ta = C & 127; float s, c; sincospif((float)((ka * ta) & 127) * (1.f / 64.f), &s, &c);
        v[j] = (rip == ri) ? c : (rip == 0 ? s : -s); }
    } else {
      const int q2 = q - 16384, R = q2 >> 5, c0 = (q2 & 31) * 8, kb = R & 127; dst = (bf16_t*)(X.ws + WS_W2) + (size_t)R * 256 + c0;
#pragma unroll
      for (int j = 0; j < 8; ++j) { const int C = c0 + j, rip = C >> 7, tb = C & 127; float s, c; sincospif((float)((kb * tb) & 127) * (1.f / 64.f), &s, &c);
        v[j] = (R < 128 ? (rip == 0 ? c : s) : (rip == 0 ? -s : c)) * (1.f / 2048.f); }
    }
    u32x4 o; o.x = cvt_pk_bf16(v[0], v[1]); o.y = cvt_pk_bf16(v[2], v[3]); o.z = cvt_pk_bf16(v[4], v[5]); o.w = cvt_pk_bf16(v[6], v[7]);
    *(u32x4*)dst = o;
  }
}

__device__ __forceinline__ void phase_prep(const Ctx& X, int rep) {
  const int c = X.c;
  if (c < 96) p0_adaln(X, c);
  else if (c < 224) p0_s5tables(X, (c - 96) >> 2, (c - 96) & 3);
  else p0_dftconst(X, c - 224);
  __syncthreads();
  unsigned* ctl = (unsigned*)(X.ws + WS_CTL);
  transpose_work(X, ctl + CW_DQ0 + 128 * rep, 0, IT_SMALL, (X.a->flags & 2) ? 1 : 0, (X.a->flags & FLAG_SKIP_EXPERTS) ? 0 : 65 * IT_EXP);
}

__device__ __forceinline__ void modulate_row(const float* hrow, const float* shift, const float* scale, bf16_t* orow, int lane) {
  const f32x4* xr = (const f32x4*)hrow + lane; f32x4 v[4]; float ss = 0.f;
#pragma unroll
  for (int j = 0; j < 4; ++j) { v[j] = xr[64 * j]; ss += (v[j].x * v[j].x + v[j].y * v[j].y) + (v[j].z * v[j].z + v[j].w * v[j].w); }
  const float r = rsqrtf(wave_sum(ss) * (1.f / 1024.f) + 1e-6f);
  u32x2* o8 = (u32x2*)orow + lane;
#pragma unroll
  for (int j = 0; j < 4; ++j) { const f32x4 sh = ((const f32x4*)shift)[lane + 64 * j], sc = ((const f32x4*)scale)[lane + 64 * j];
    u32x2 w; w.x = cvt_pk_bf16(v[j].x * r * (1.f + sc.x) + sh.x, v[j].y * r * (1.f + sc.y) + sh.y); w.y = cvt_pk_bf16(v[j].z * r * (1.f + sc.z) + sh.z, v[j].w * r * (1.f + sc.w) + sh.w);
    o8[64 * j] = w; }
}
__device__ __forceinline__ void phase_mod0(const Ctx& X) {
  const Args& a = *X.a; const float* mod = (const float*)(X.ws + WS_MOD); bf16_t* A0 = (bf16_t*)(X.ws + WS_A0);
  const int gw = X.c * NWAVES + X.wave, NGW = X.G * NWAVES;
  for (int r = gw; r < NROW; r += NGW) {
    if (r < TOK) modulate_row(a.in[IN_X] + (size_t)r * 1024, mod, mod + 1024, A0 + (size_t)r * 1024, X.lane);
    else modulate_row(a.in[IN_CTX] + (size_t)(r - TOK) * 1024, mod + 6144, mod + 6144 + 1024, A0 + (size_t)r * 1024, X.lane);
  }
}


struct G1 {
  static constexpr bool PERM = true; static constexpr bool F8 = false; static constexpr int SCALE_B = 0x7A7A7A7A; static constexpr bool CONTIG = false; static constexpr bool ALIGN = true; static constexpr bool LINA = true, LINB = true; __device__ __forceinline__ size_t halfA() const { return 128u * 2048u; } __device__ __forceinline__ size_t halfB() const { return 128u * 2048u; } int K, nunits; unsigned char* ws; const float* qg; const float* kg;
  __device__ __forceinline__ void decode(int w, Unit& u) const { if (w < 390) { u.a = 0; u.pm = w / 6; u.pn = w % 6; } else { const int w2 = w - 390; u.a = 1; u.pm = w2 & 1; u.pn = w2 >> 1; } u.b = 0; }
  __device__ __forceinline__ const char* baseA(const Unit& u) const { return (const char*)ws + (u.a == 0 ? WS_A0 : WS_WIN_T + (size_t)1536 * 2048); }
  __device__ __forceinline__ const char* baseB(const Unit& u) const { return (const char*)ws + (u.a == 0 ? WS_WIN_T : WS_A0); }
  __device__ __forceinline__ unsigned rowA(const Unit& u, int r) const { return (unsigned)(u.pm * 256 + r) * 2048u; }
  __device__ __forceinline__ unsigned rowB(const Unit& u, int r) const { return (unsigned)(u.pn * 256 + r) * 2048u; }
  __device__ __forceinline__ void epi(const Acc& acc, const Unit& u, int wr, int wc, int fr, int fq) const {
    if (u.a == 1) {
      bf16_t* VT = (bf16_t*)(ws + WS_VT);
#pragma unroll
      for (int ai = 0; ai < 2; ++ai)
#pragma unroll
        for (int m = 0; m < 4; ++m) { const int dd = u.pm * 256 + ai * 128 + wr * 64 + m * 16 + fr, head = dd >> 6, d = dd & 63;
#pragma unroll
          for (int bj = 0; bj < 2; ++bj) { const int t0 = u.pn * 256 + bj * 128 + wc * 32 + 8 * fq, kr = t0 >> 6, cg = (t0 >> 3) & 7;
            *(u32x4*)((VT + ((((size_t)(head * 260 + kr) * 8 + cg) * 64 + d) * 8))) = pack8(acc[ai][bj][m][0], acc[ai][bj][m][1]); } }
      return;
    }
    if (u.pn < 2) {
      bf16_t* AS5 = (bf16_t*)(ws + WS_AS5);
#pragma unroll
      for (int ai = 0; ai < 2; ++ai)
#pragma unroll
        for (int m = 0; m < 4; ++m) { const int row = u.pm * 256 + ai * 128 + wr * 64 + m * 16 + fr; int crow, s;
          if (row < TOK) { crow = row >> 5; s = row & 31; } else { const int j = row - TOK; crow = 512 + (j >> 5); s = j & 31; }
#pragma unroll
          for (int bj = 0; bj < 2; ++bj) { const int g = 16 * u.pn + 8 * bj + 2 * wc + (fq >> 1), c0 = 8 * (fq & 1);
            *(u32x4*)((AS5 + ((size_t)(g * 768 + crow) * 768 + s * 16 + c0))) = pack8(acc[ai][bj][m][0], acc[ai][bj][m][1]); } }
      return;
    }
    const bool isq = u.pn < 4;
    if (isq && u.pm == 64) return;
    const int head = 4 * ((u.pn - 2) & 1) + wc; const float* gain = isq ? qg : kg;
    bf16_t* dst = isq ? (bf16_t*)(ws + WS_Q) : (bf16_t*)(ws + WS_K);
    f32x4 gv[2][2];
#pragma unroll
    for (int bj = 0; bj < 2; ++bj) { gv[bj][0] = *(const f32x4*)(gain + 32 * bj + 8 * fq); gv[bj][1] = *(const f32x4*)(gain + 32 * bj + 8 * fq + 4); }
#pragma unroll
    for (int ai = 0; ai < 2; ++ai)
#pragma unroll
      for (int m = 0; m < 4; ++m) { const int row = u.pm * 256 + ai * 128 + wr * 64 + m * 16 + fr; float ss = 0.f;
#pragma unroll
        for (int bj = 0; bj < 2; ++bj)
#pragma unroll
          for (int n = 0; n < 2; ++n) { const f32x4 x = acc[ai][bj][m][n]; ss += (x[0] * x[0] + x[1] * x[1]) + (x[2] * x[2] + x[3] * x[3]); }
        ss += sx(ss, 16); ss += sx(ss, 32);
        const float rinv = rsqrtf(ss * (1.f / 64.f) + 1e-6f);
#pragma unroll
        for (int bj = 0; bj < 2; ++bj) { const f32x4 v0 = acc[ai][bj][m][0] * rinv * gv[bj][0], v1 = acc[ai][bj][m][1] * rinv * gv[bj][1];
          if (isq) *(u32x4*)((dst + (size_t)row * 512 + head * 64 + 32 * bj + 8 * fq)) = pack8(v0, v1);
          else { const int kr = row >> 6, cg = (row >> 3) & 7, k8 = row & 7, ks = 2 * bj + (fq >> 1), hh2 = fq & 1;
            *(u32x4*)((dst + (((((size_t)(head * 260 + kr) * 8 + cg) * 4 + ks) * 8 + k8) * 2 + hh2) * 8)) = pack8(v0, v1); } } }
  }
};

struct G2 {
  static constexpr bool PERM = true; static constexpr bool F8 = false; static constexpr int SCALE_B = 0x7A7A7A7A; static constexpr bool CONTIG = false; static constexpr bool ALIGN = true; static constexpr bool LINA = true, LINB = true; __device__ __forceinline__ size_t halfA() const { return 128u * 1536u; } __device__ __forceinline__ size_t halfB() const { return 128u * 1024u; } int K, nunits; unsigned char* ws;
  __device__ __forceinline__ void decode(int w, Unit& u) const { u.a = w / 3; u.pm = w % 3; u.pn = 0; u.b = 0; }
  __device__ __forceinline__ const char* baseA(const Unit& u) const { return (const char*)ws + WS_AS5 + (size_t)u.a * 768 * 768 * 2; }
  __device__ __forceinline__ const char* baseB(const Unit& u) const { return (const char*)ws + WS_WS + (size_t)u.a * 256 * 512 * 2; }
  __device__ __forceinline__ unsigned rowA(const Unit& u, int r) const { return (unsigned)(u.pm * 256 + r) * 1536u; }
  __device__ __forceinline__ unsigned rowB(const Unit& u, int r) const { return (unsigned)r * 1024u; }
  __device__ __forceinline__ void epi(const Acc& acc, const Unit& u, int wr, int wc, int fr, int fq) const {
    float* SST = (float*)(ws + WS_SST) + (size_t)u.a * 768 * 256;
#pragma unroll
    for (int ai = 0; ai < 2; ++ai)
#pragma unroll
      for (int m = 0; m < 4; ++m) { const int crow = u.pm * 256 + ai * 128 + wr * 64 + m * 16 + fr; if (crow >= 520) continue;
#pragma unroll
        for (int bj = 0; bj < 2; ++bj) { float* p = SST + (size_t)crow * 256 + bj * 128 + wc * 32 + 8 * fq; *(f32x4*)p = acc[ai][bj][m][0]; *(f32x4*)(p + 4) = acc[ai][bj][m][1]; } }
  }
};

struct G3 {
  static constexpr bool PERM = true; static constexpr bool F8 = false; static constexpr int SCALE_B = 0x7A7A7A7A; static constexpr bool CONTIG = false; static constexpr bool ALIGN = true; static constexpr bool LINA = true, LINB = true; __device__ __forceinline__ size_t halfA() const { return 128u * 1536u; } __device__ __forceinline__ size_t halfB() const { return 128u * 1536u; } int K, nunits; unsigned char* ws;
  __device__ __forceinline__ void decode(int w, Unit& u) const { u.a = w >> 2; u.pm = (w >> 1) & 1; u.pn = w & 1; u.b = 0; }
  __device__ __forceinline__ const char* baseA(const Unit& u) const { return (const char*)ws + WS_AS5 + (size_t)u.a * 768 * 768 * 2; }
  __device__ __forceinline__ const char* baseB(const Unit& u) const { return (const char*)ws + WS_TT + (size_t)u.a * 512 * 768 * 2; }
  __device__ __forceinline__ unsigned rowA(const Unit& u, int r) const { return (unsigned)(u.pm * 256 + r) * 1536u; }
  __device__ __forceinline__ unsigned rowB(const Unit& u, int r) const { return (unsigned)(u.pn * 256 + r) * 1536u; }
  __device__ __forceinline__ void epi(const Acc& acc, const Unit& u, int wr, int wc, int fr, int fq) const {
    bf16_t* GB = (bf16_t*)(ws + WS_GB);
#pragma unroll
    for (int ai = 0; ai < 2; ++ai)
#pragma unroll
      for (int m = 0; m < 4; ++m) { const int crow = u.pm * 256 + ai * 128 + wr * 64 + m * 16 + fr;
#pragma unroll
        for (int bj = 0; bj < 2; ++bj) { const int pp = u.pn * 256 + bj * 128 + wc * 32 + 8 * fq, i = pp >> 4, c0 = pp & 15; f32x4 v0 = acc[ai][bj][m][0], v1 = acc[ai][bj][m][1];
#pragma unroll
          for (int j = 0; j < 4; ++j) { v0[j] = gelu_tanh(v0[j]); v1[j] = gelu_tanh(v1[j]); }
          *(u32x4*)((GB + (size_t)(crow * 32 + i) * 512 + u.a * 16 + c0)) = pack8(v0, v1); } }
  }
};

struct G4 {
  static constexpr bool PERM = true; static constexpr bool F8 = false; static constexpr int SCALE_B = 0x7A7A7A7A; static constexpr bool CONTIG = false; static constexpr bool ALIGN = true; static constexpr bool LINA = true, LINB = true; __device__ __forceinline__ size_t halfA() const { return 128u * 1024u; } __device__ __forceinline__ size_t halfB() const { return 128u * 1024u; } int K, nunits; unsigned char* ws; const float* bglu;
  __device__ __forceinline__ void decode(int w, Unit& u) const { u.pm = w >> 1; u.pn = w & 1; u.a = 0; u.b = 0; }
  __device__ __forceinline__ const char* baseA(const Unit&) const { return (const char*)ws + WS_GB; }
  __device__ __forceinline__ const char* baseB(const Unit&) const { return (const char*)ws + WS_WGLU_T; }
  __device__ __forceinline__ unsigned rowA(const Unit& u, int r) const { return (unsigned)(u.pm * 256 + r) * 1024u; }
  __device__ __forceinline__ unsigned rowB(const Unit& u, int r) const { return (unsigned)(u.pn * 256 + r) * 1024u; }
  __device__ __forceinline__ void epi(const Acc& acc, const Unit& u, int wr, int wc, int fr, int fq) const {
    const bf16_t* GB = (const bf16_t*)(ws + WS_GB); bf16_t* CC = (bf16_t*)(ws + WS_CONCAT);
#pragma unroll
    for (int bj = 0; bj < 2; ++bj) { const int col0 = u.pn * 256 + bj * 128 + wc * 32 + 8 * fq; const f32x4 b0 = *(const f32x4*)(bglu + col0), b1 = *(const f32x4*)(bglu + col0 + 4);
#pragma unroll
      for (int ai = 0; ai < 2; ++ai)
#pragma unroll
        for (int m = 0; m < 4; ++m) { const int row = u.pm * 256 + ai * 128 + wr * 64 + m * 16 + fr; const u32x4 gw = *(const u32x4*)(GB + (size_t)row * 512 + col0);
          f32x4 v0 = acc[ai][bj][m][0] + b0, v1 = acc[ai][bj][m][1] + b1;
          v0[0] = bf_lo(gw.x) * fast_sigmoid(v0[0]); v0[1] = bf_hi(gw.x) * fast_sigmoid(v0[1]); v0[2] = bf_lo(gw.y) * fast_sigmoid(v0[2]); v0[3] = bf_hi(gw.y) * fast_sigmoid(v0[3]);
          v1[0] = bf_lo(gw.z) * fast_sigmoid(v1[0]); v1[1] = bf_hi(gw.z) * fast_sigmoid(v1[1]); v1[2] = bf_lo(gw.w) * fast_sigmoid(v1[2]); v1[3] = bf_hi(gw.w) * fast_sigmoid(v1[3]);
          *(u32x4*)((CC + (size_t)row * 1024 + col0)) = pack8(v0, v1); } }
  }
};

struct GRes {
  static constexpr bool PERM = true; static constexpr bool F8 = false; static constexpr int SCALE_B = 0x7A7A7A7A; static constexpr bool CONTIG = false; static constexpr bool ALIGN = true; static constexpr bool LINA = true, LINB = true;
  __device__ __forceinline__ size_t halfA() const { return 128u * 2048u; } __device__ __forceinline__ size_t halfB() const { return 128u * 2048u; }
  int K, nunits; const char* A; const char* Bt; const float* hin32; const bf16_t* hin16; bf16_t* hout; const float* gate; const float* bias;
  __device__ __forceinline__ void decode(int w, Unit& u) const { u.pm = w >> 2; u.pn = w & 3; u.a = 0; u.b = 0; }
  __device__ __forceinline__ const char* baseA(const Unit&) const { return A; }
  __device__ __forceinline__ const char* baseB(const Unit&) const { return Bt; }
  __device__ __forceinline__ unsigned rowA(const Unit& u, int r) const { return (unsigned)(u.pm * 256 + r) * 2048u; }
  __device__ __forceinline__ unsigned rowB(const Unit& u, int r) const { return (unsigned)(u.pn * 256 + r) * 2048u; }
  __device__ __forceinline__ void epi(const Acc& acc, const Unit& u, int wr, int wc, int fr, int fq) const {
#pragma unroll
    for (int bj = 0; bj < 2; ++bj) { const int col0 = u.pn * 256 + bj * 128 + wc * 32 + 8 * fq;
      const f32x4 g0 = *(const f32x4*)(gate + col0), g1 = *(const f32x4*)(gate + col0 + 4);
      f32x4 b0 = (f32x4){0.f, 0.f, 0.f, 0.f}, b1 = b0; if (bias) { b0 = *(const f32x4*)(bias + col0); b1 = *(const f32x4*)(bias + col0 + 4); }
#pragma unroll
      for (int ai = 0; ai < 2; ++ai)
#pragma unroll
        for (int m = 0; m < 4; ++m) { const size_t off = (size_t)(u.pm * 256 + ai * 128 + wr * 64 + m * 16 + fr) * 1024 + col0;
          f32x4 h0, h1;
          if (hin32) { h0 = *(const f32x4*)(hin32 + off); h1 = *(const f32x4*)(hin32 + off + 4); }
          else { const u32x4 w = *(const u32x4*)(hin16 + off); h0 = (f32x4){bf_lo(w.x), bf_hi(w.x), bf_lo(w.y), bf_hi(w.y)}; h1 = (f32x4){bf_lo(w.z), bf_hi(w.z), bf_lo(w.w), bf_hi(w.w)}; }
          *(u32x4*)((hout + off)) = pack8(h0 + g0 * (acc[ai][bj][m][0] + b0), h1 + g1 * (acc[ai][bj][m][1] + b1)); } }
  }
};

__device__ __forceinline__ void build_moetab(const Ctx& X, int layer, LAS int* toff) {
  const unsigned* cnt = (const unsigned*)(X.ws + WS_CTL) + CW_CNT + layer * 2048;
  LAS int* texp = toff + 256;
  LAS int* ntile = toff + 132;
  __syncthreads();
  if (X.tid < 64) ntile[X.tid] = ((int)__hip_atomic_load(cnt + X.tid * 32, __ATOMIC_RELAXED, __HIP_MEMORY_SCOPE_AGENT) + 255) >> 8;
  __syncthreads();
  if (X.tid == 0) { int s = 0; for (int e = 0; e < 64; ++e) { toff[e] = s; s += ntile[e]; } toff[64] = s; toff[65] = s + 64; }
  __syncthreads();
  if (X.tid < 65) { const int e = X.tid; const int lo = toff[e], hi = toff[e + 1]; for (int t = lo; t < hi && t < 704; ++t) texp[t] = e; }
  __syncthreads();
}
__device__ __forceinline__ int find_expert(const LAS int* toff, int ti) { return toff[256 + ti]; }

struct G6 {
  static constexpr bool PERM = true; static constexpr bool F8 = true; static constexpr int SCALE_B = 0x7A7A7A7A; static constexpr bool CONTIG = false; static constexpr bool ALIGN = true; static constexpr bool LINA = false, LINB = true;
  __device__ __forceinline__ size_t halfA() const { return 0; } __device__ __forceinline__ size_t halfB() const { return 128u * 1024u; }
  int K, nunits; unsigned char* ws; const LAS int* toff; const LAS unsigned* tokt; const char* wbase; size_t wstride;
  __device__ __forceinline__ void decode(int w, Unit& u) const { const int ti = w >> 1; u.pn = w & 1; u.a = find_expert(toff, ti); u.pm = ti - toff[u.a]; u.b = ti; }
  __device__ __forceinline__ const char* baseA(const Unit&) const { return (const char*)ws + WS_F; }
  __device__ __forceinline__ const char* baseB(const Unit& u) const { return wbase + (size_t)u.a * wstride; }
  __device__ __forceinline__ unsigned rowA(const Unit& u, int r) const { return tokt[u.ord * 256 + r]; }
  __device__ __forceinline__ void build_tokt(const Ctx& X, LAS unsigned* tk) const {
    for (int i = 0; i * X.G + X.c < nunits; ++i) { Unit u; decode(xcd_remap(i * X.G + X.c, nunits), u);
      if (X.tid < 256) { const int idx = u.pm * 256 + X.tid; int tok = idx;
        if (u.a < 64) tok = ((const int*)(ws + WS_LTOK))[u.a * 16384 + idx];
        tk[i * 256 + X.tid] = (unsigned)tok * 1024u; } }
    __syncthreads();
  }
  __device__ __forceinline__ unsigned rowB(const Unit& u, int r) const { return (unsigned)(u.pn * 256 + r) * 1024u; }
  __device__ __forceinline__ void epi(const Acc& acc, const Unit& u, int wr, int wc, int fr, int fq) const {
    bf16_t* HID = (bf16_t*)(ws + WS_HID);
#pragma unroll
    for (int ai = 0; ai < 2; ++ai)
#pragma unroll
      for (int m = 0; m < 4; ++m) { const size_t hrow = (size_t)u.b * 256 + ai * 128 + wr * 64 + m * 16 + fr; f32x4 v0, v1;
#pragma unroll
        for (int j = 0; j < 4; ++j) { const float g0 = acc[ai][0][m][0][j] * 0.03125f, g1 = acc[ai][0][m][1][j] * 0.03125f; v0[j] = g0 * fast_sigmoid(g0) * (acc[ai][1][m][0][j] * 0.03125f); v1[j] = g1 * fast_sigmoid(g1) * (acc[ai][1][m][1][j] * 0.03125f); }
        *(u32x4*)((HID + hrow * 256 + u.pn * 128 + wc * 32 + 8 * fq)) = pack8(v0, v1); }
  }
};
struct G7 {
  static constexpr bool PERM = true; static constexpr bool F8 = false; static constexpr int SCALE_B = 0x7A7A7A7A; static constexpr bool CONTIG = false; static constexpr bool ALIGN = true; static constexpr bool LINA = true, LINB = true;
  __device__ __forceinline__ size_t halfA() const { return 128u * 512u; } __device__ __forceinline__ size_t halfB() const { return 128u * 512u; }
  int K, nunits; unsigned char* ws; const LAS int* toff; const char* wbase; size_t wstride;
  __device__ __forceinline__ void decode(int w, Unit& u) const { const int ti = w >> 2; u.pn = w & 3; u.a = find_expert(toff, ti); u.pm = ti - toff[u.a]; u.b = ti; }
  __device__ __forceinline__ const char* baseA(const Unit&) const { return (const char*)ws + WS_HID; }
  __device__ __forceinline__ const char* baseB(const Unit& u) const { return wbase + (size_t)u.a * wstride; }
  __device__ __forceinline__ unsigned rowA(const Unit& u, int r) const { return (unsigned)(u.b * 256 + r) * 512u; }
  __device__ __forceinline__ unsigned rowB(const Unit& u, int r) const { return (unsigned)(u.pn * 256 + r) * 512u; }
  __device__ __forceinline__ void epi(const Acc& acc, const Unit& u, int wr, int wc, int fr, int fq) const {
    unsigned char* YAS = ws + WS_YAS;
#pragma unroll
    for (int ai = 0; ai < 2; ++ai)
#pragma unroll
      for (int m = 0; m < 4; ++m) { const size_t yrow = (size_t)u.b * 256 + ai * 128 + wr * 64 + m * 16 + fr;
#pragma unroll
        for (int bj = 0; bj < 2; ++bj) { const f32x4 v0 = acc[ai][bj][m][0], v1 = acc[ai][bj][m][1];
          const int w0 = pack4_fp8(v0[0], v0[1], v0[2], v0[3]), w1 = pack4_fp8(v1[0], v1[1], v1[2], v1[3]);
          *(u32x2*)(YAS + yrow * 1024 + u.pn * 256 + bj * 128 + wc * 32 + 8 * fq) = (u32x2){(unsigned)w0, (unsigned)w1}; } }
  }
};

struct G8 {
  static constexpr bool PERM = true; static constexpr bool F8 = false; static constexpr int SCALE_B = 0x7A7A7A7A; static constexpr bool CONTIG = false; static constexpr bool ALIGN = true; static constexpr bool LINA = true, LINB = false; __device__ __forceinline__ size_t halfA() const { return 128u * 512u; } __device__ __forceinline__ size_t halfB() const { return 0; } int K, nunits; unsigned char* ws;
  __device__ __forceinline__ void decode(int w, Unit& u) const { u.pm = 0; u.a = (w >> 6) & 3; u.pn = w & 63; u.b = 0; }
  __device__ __forceinline__ const char* baseA(const Unit&) const { return (const char*)ws + WS_DMT; }
  __device__ __forceinline__ const char* baseB(const Unit& u) const { return (const char*)ws + WS_A1 + (size_t)u.a * 512; }
  __device__ __forceinline__ unsigned rowA(const Unit&, int r) const { return (unsigned)r * 512u; }
  __device__ __forceinline__ unsigned rowB(const Unit& u, int r) const { const int n = u.pn * 256 + r; return (unsigned)(128 * (n & 127) + (n >> 7)) * 2048u; }
  __device__ __forceinline__ void epi(const Acc& acc, const Unit& u, int wr, int wc, int fr, int fq) const {
    bf16_t* X1 = (bf16_t*)(ws + WS_X1);
#pragma unroll
    for (int ai = 0; ai < 2; ++ai)
#pragma unroll
      for (int m = 0; m < 4; ++m) { const int mm = wr * 64 + m * 16 + fr;
#pragma unroll
        for (int bj = 0; bj < 2; ++bj) { const int n0 = u.pn * 256 + bj * 128 + wc * 32 + 8 * fq, tb = n0 >> 7, ta0 = n0 & 127;
          *(u32x4*)((X1 + ((((size_t)(u.a * 128 + mm) * 128 + tb) * 2 + ai) * 128 + ta0))) = pack8(acc[ai][bj][m][0], acc[ai][bj][m][1]); } }
  }
};
struct G9 {
  static constexpr bool PERM = true; static constexpr bool F8 = false; static constexpr int SCALE_B = 0x7A7A7A7A; static constexpr bool CONTIG = false; static constexpr bool ALIGN = true; static constexpr bool LINA = true, LINB = true; __device__ __forceinline__ size_t halfA() const { return 128u * 512u; } __device__ __forceinline__ size_t halfB() const { return 128u * 512u; } int K, nunits; unsigned char* ws;
  __device__ __forceinline__ void decode(int w, Unit& u) const { u.pm = 0; u.pn = w; u.a = 0; u.b = 0; }
  __device__ __forceinline__ const char* baseA(const Unit&) const { return (const char*)ws + WS_W1; }
  __device__ __forceinline__ const char* baseB(const Unit&) const { return (const char*)ws + WS_X1; }
  __device__ __forceinline__ unsigned rowA(const Unit&, int r) const { return (unsigned)r * 512u; }
  __device__ __forceinline__ unsigned rowB(const Unit& u, int r) const { return (unsigned)(u.pn * 256 + r) * 512u; }
  __device__ __forceinline__ void epi(const Acc& acc, const Unit& u, int wr, int wc, int fr, int fq) const {
    bf16_t* X2 = (bf16_t*)(ws + WS_X2);
#pragma unroll
    for (int m = 0; m < 4; ++m) { const int ka = wr * 64 + m * 16 + fr;
#pragma unroll
      for (int bj = 0; bj < 2; ++bj) { const int n0 = u.pn * 256 + bj * 128 + wc * 32 + 8 * fq, gm = n0 >> 7, tb0 = n0 & 127; f32x4 r0, r1, i0, i1;
#pragma unroll
        for (int j = 0; j < 4; ++j) {
          { const float ang = (float)((ka * (tb0 + j)) & 16383) * (1.f / 16384.f), cs = __builtin_amdgcn_cosf(ang), sn = __builtin_amdgcn_sinf(ang); const float yr = acc[0][bj][m][0][j], yi = acc[1][bj][m][0][j]; r0[j] = yr * cs + yi * sn; i0[j] = yi * cs - yr * sn; }
          { const float ang = (float)((ka * (tb0 + 4 + j)) & 16383) * (1.f / 16384.f), cs = __builtin_amdgcn_cosf(ang), sn = __builtin_amdgcn_sinf(ang); const float yr = acc[0][bj][m][1][j], yi = acc[1][bj][m][1][j]; r1[j] = yr * cs + yi * sn; i1[j] = yi * cs - yr * sn; } }
        bf16_t* p = X2 + (((size_t)(gm * 128 + ka) * 2) * 128 + tb0); *(u32x4*)(p) = pack8(r0, r1); *(u32x4*)((p + 128)) = pack8(i0, i1); } }
  }
};
struct G10 {
  static constexpr bool PERM = true; static constexpr bool F8 = false; static constexpr int SCALE_B = 0x7A7A7A7A; static constexpr bool CONTIG = false; static constexpr bool ALIGN = true; static constexpr bool LINA = true, LINB = false; __device__ __forceinline__ size_t halfA() const { return 128u * 512u; } __device__ __forceinline__ size_t halfB() const { return 0; } int K, nunits; unsigned char* ws;
  __device__ __forceinline__ void decode(int w, Unit& u) const { u.pm = 0; u.pn = w; u.a = 0; u.b = 0; }
  __device__ __forceinline__ const char* baseA(const Unit&) const { return (const char*)ws + WS_W2; }
  __device__ __forceinline__ const char* baseB(const Unit&) const { return (const char*)ws + WS_X2; }
  __device__ __forceinline__ unsigned rowA(const Unit&, int r) const { return (unsigned)r * 512u; }
  __device__ __forceinline__ unsigned rowB(const Unit& u, int r) const { const int n = u.pn * 256 + r, ka = n >> 9, gm = n & 511; return (unsigned)(gm * 128 + ka) * 512u; }
  __device__ __forceinline__ void epi(const Acc& acc, const Unit& u, int wr, int wc, int fr, int fq) const {
    bf16_t* FB = (bf16_t*)(ws + WS_FB); float2* SPC = (float2*)(ws + WS_SPC); const int ka = u.pn >> 1;
#pragma unroll
    for (int m = 0; m < 4; ++m) { const int kb = wr * 64 + m * 16 + fr; const int k = ka + 128 * kb, kmir = (16384 - k) & 16383;
#pragma unroll
      for (int bj = 0; bj < 2; ++bj) { const int gm0 = (u.pn & 1) * 256 + bj * 128 + wc * 32 + 8 * fq, d0 = (gm0 >> 7) * 128 + (gm0 & 127); const u32x4 o = pack8(acc[0][bj][m][0], acc[0][bj][m][1]);
        *(u32x4*)(FB + (size_t)k * 1024 + d0) = o; *(u32x4*)(FB + (size_t)kmir * 1024 + 512 + d0) = o;
        if ((gm0 & 127) == 0) SPC[k * 4 + (gm0 >> 7)] = make_float2(acc[0][bj][m][0][0], acc[1][bj][m][0][0]); } }
  }
};
}
namespace mk {
typedef float f32x16 __attribute__((ext_vector_type(16)));

__device__ __forceinline__ void phase_scan(const Ctx& X) {
  if (X.c >= 64) return;
  const int ch = X.c * 64 + (X.tid & 63), seg = X.tid >> 6;
  const int g = ch >> 7, dir = (ch >> 6) & 1, p = ch & 63;
  const float2 lam = ((const float2*)(X.ws + WS_LAML))[(dir * 32 + g) * 64 + p];
  const float* S = (const float*)(X.ws + WS_SST) + (size_t)g * 768 * 256 + dir * 128 + p;
  bf16_t* XP = (bf16_t*)(X.ws + WS_AS5) + (size_t)g * 768 * 768 + 512 + dir * 128 + p;
  LAS float* EX = (LAS float*)X.lds;
  const int j0 = seg * 65;
  float xr = 0.f, xi = 0.f;
  for (int b = 0; b < 65; b += 13) {
    float sr[13], si[13];
#pragma unroll
    for (int k = 0; k < 13; ++k) { const int j = j0 + b + k; const int row = dir == 0 ? (j < 8 ? 512 + j : j - 8) : 519 - j; sr[k] = S[(size_t)row * 256]; si[k] = S[(size_t)row * 256 + 64]; }
#pragma unroll
    for (int k = 0; k < 13; ++k) { const float nr = lam.x * xr - lam.y * xi + sr[k], ni = lam.x * xi + lam.y * xr + si[k]; xr = nr; xi = ni; }
  }
  EX[(seg * 64 + (X.tid & 63)) * 2] = xr; EX[(seg * 64 + (X.tid & 63)) * 2 + 1] = xi;
  float pr = 1.f, pi = 0.f;
  for (int k = 0; k < 65; ++k) { const float nr = pr * lam.x - pi * lam.y, ni = pr * lam.y + pi * lam.x; pr = nr; pi = ni; }
  __syncthreads();
  float cr = 0.f, ci = 0.f;
  for (int s2 = 0; s2 < seg; ++s2) { const float er = EX[(s2 * 64 + (X.tid & 63)) * 2], ei = EX[(s2 * 64 + (X.tid & 63)) * 2 + 1];
    const float nr = pr * cr - pi * ci + er, ni = pr * ci + pi * cr + ei; cr = nr; ci = ni; }
  xr = cr; xi = ci;
  for (int b = 0; b < 65; b += 13) {
    float sr[13], si[13];
#pragma unroll
    for (int k = 0; k < 13; ++k) { const int j = j0 + b + k; const int row = dir == 0 ? (j < 8 ? 512 + j : j - 8) : 519 - j; sr[k] = S[(size_t)row * 256]; si[k] = S[(size_t)row * 256 + 64]; }
#pragma unroll
    for (int k = 0; k < 13; ++k) { const int j = j0 + b + k; const int row = dir == 0 ? (j < 8 ? 512 + j : j - 8) : 519 - j;
      XP[(size_t)row * 768] = f2bf(xr); XP[(size_t)row * 768 + 64] = f2bf(xi);
      const float nr = lam.x * xr - lam.y * xi + sr[k], ni = lam.x * xi + lam.y * xr + si[k]; xr = nr; xi = ni; }
  }
  __syncthreads();
}

__device__ __forceinline__ void zero_lists(const Ctx& X) {
  u32x4* z = (u32x4*)(X.ws + WS_LTOK); unsigned zu_ = 0u; asm volatile("" : "+v"(zu_)); const u32x4 zero = (u32x4){zu_, zu_, zu_, zu_};
  for (int i = X.c * NTHR + X.tid; i < (int)(4 * MiB / 16); i += X.G * NTHR) z[i] = zero;
}
#define MFMA32(a, b, c) __builtin_amdgcn_mfma_f32_32x32x16_bf16((a), (b), (c), 0, 0, 0)
__device__ __forceinline__ void attn_unit(const Ctx& X, const LAS float* rpbl, int head, int tile) {
  const bf16_t* Q = (const bf16_t*)(X.ws + WS_Q); const bf16_t* Kb = (const bf16_t*)(X.ws + WS_K); const bf16_t* VT = (const bf16_t*)(X.ws + WS_VT);
  bf16_t* CCt = (bf16_t*)(X.ws + WS_CONCAT);
  const int lane = X.lane, ql = lane & 31, hh = lane >> 5;
  const int rp = tile >> 2, mt = tile & 3;
  const int r = 2 * rp + (ql >> 4), cq = 16 * mt + (ql & 15), tq = r * 64 + cq;
  const int r0q = min(max(r - 4, 0), 248), csq = min(max(cq - 8, 0), 48);
  const int rlo = min(max(2 * rp - 4, 0), 248), rhi = min(max(2 * rp - 3, 0), 248) + 7;
  const int csb = min(max(16 * mt - 8, 0), 32);
  const int nloc = rhi - rlo + 1;
  unsigned cmask = 0u;
#pragma unroll
  for (int k = 0; k < 32; ++k) cmask |= ((csb + k >= csq) && (csb + k <= csq + 15)) ? (1u << k) : 0u;
  bf16x8 qf[4];
#pragma unroll
  for (int ks = 0; ks < 4; ++ks) qf[ks] = *(const bf16x8*)(Q + (size_t)tq * 512 + head * 64 + 16 * ks + 8 * hh);
  const int kperm = (ql & ~12) | ((ql & 4) << 1) | ((ql & 8) >> 1);
  f32x16 o0, o1;
#pragma unroll
  for (int i = 0; i < 16; ++i) { o0[i] = 0.f; o1[i] = 0.f; }
  float lsum = 0.f;
  const float c1 = 0.125f * 1.44269504f, c2 = 8.f * 1.44269504f;
  const float* rp_h = nullptr; (void)rp_h;
  const size_t koff_lane = (size_t)(((kperm >> 3) * 4 * 8 + (kperm & 7)) * 2 + hh) * 8;
  const size_t voff_lane = (size_t)(hh * 64 + ql) * 8;
  bf16x8 kf[4], vf[2][2];
  { const int kr0 = rlo, cg0 = csb >> 3;
    const bf16_t* kp = Kb + ((size_t)(head * 260 + kr0) * 8 + cg0) * 512 + koff_lane; const bf16_t* vp = VT + ((size_t)(head * 260 + kr0) * 8 + cg0) * 512 + voff_lane;
#pragma unroll
    for (int ks = 0; ks < 4; ++ks) kf[ks] = *(const bf16x8*)(kp + ks * 128);
#pragma unroll
    for (int db = 0; db < 2; ++db)
#pragma unroll
      for (int s2 = 0; s2 < 2; ++s2) vf[db][s2] = *(const bf16x8*)(vp + db * 256 + s2 * 1024); }
  for (int b = 0; b < nloc + 8; ++b) {
    const bool loc = b < nloc;
    const int kr = rlo + b;
    bf16x8 kc[4], vc[2][2];
#pragma unroll
    for (int ks = 0; ks < 4; ++ks) kc[ks] = kf[ks];
#pragma unroll
    for (int db = 0; db < 2; ++db)
#pragma unroll
      for (int s2 = 0; s2 < 2; ++s2) vc[db][s2] = vf[db][s2];
    if (b + 1 < nloc + 8) { const int bn = b + 1; const int krn = bn < nloc ? rlo + bn : 256 + ((bn - nloc) >> 1), cgn = bn < nloc ? (csb >> 3) : 4 * ((bn - nloc) & 1);
      const bf16_t* kp = Kb + ((size_t)(head * 260 + krn) * 8 + cgn) * 512 + koff_lane; const bf16_t* vp = VT + ((size_t)(head * 260 + krn) * 8 + cgn) * 512 + voff_lane;
#pragma unroll
      for (int ks = 0; ks < 4; ++ks) kf[ks] = *(const bf16x8*)(kp + ks * 128);
#pragma unroll
      for (int db = 0; db < 2; ++db)
#pragma unroll
        for (int s2 = 0; s2 < 2; ++s2) vf[db][s2] = *(const bf16x8*)(vp + db * 256 + s2 * 1024); }
    f32x16 sacc;
#pragma unroll
    for (int i = 0; i < 16; ++i) sacc[i] = 0.f;
#pragma unroll
    for (int ks = 0; ks < 4; ++ks) sacc = MFMA32(kc[ks], qf[ks], sacc);
    float pv[16];
    if (loc) {
      const bool rowok = (kr >= r0q) && (kr <= r0q + 7);
      const int dr = min(max(kr - r + 7, 0), 14);
      const LAS float* bp = rpbl + (head * 15 + dr) * 31;
      const int dc0 = csb - cq + 15;
#pragma unroll
      for (int i = 0; i < 16; ++i) { const int kidx = 16 * (i >> 3) + 8 * hh + (i & 7);
        const bool ok = rowok && ((cmask >> kidx) & 1u);
        const float bias = bp[min(max(dc0 + kidx, 0), 30)];
        const float e = __builtin_amdgcn_exp2f(sacc[i] * c1 + bias * 1.44269504f - c2); pv[i] = ok ? e : 0.f; }
    } else {
#pragma unroll
      for (int i = 0; i < 16; ++i) pv[i] = __builtin_amdgcn_exp2f(sacc[i] * c1 - c2);
    }
    u32x4 p0, p1;
    p0.x = cvt_pk_bf16(pv[0], pv[1]); p0.y = cvt_pk_bf16(pv[2], pv[3]); p0.z = cvt_pk_bf16(pv[4], pv[5]); p0.w = cvt_pk_bf16(pv[6], pv[7]);
    p1.x = cvt_pk_bf16(pv[8], pv[9]); p1.y = cvt_pk_bf16(pv[10], pv[11]); p1.z = cvt_pk_bf16(pv[12], pv[13]); p1.w = cvt_pk_bf16(pv[14], pv[15]);
    lsum += (bf_lo(p0.x) + bf_hi(p0.x)) + (bf_lo(p0.y) + bf_hi(p0.y)) + (bf_lo(p0.z) + bf_hi(p0.z)) + (bf_lo(p0.w) + bf_hi(p0.w))
          + (bf_lo(p1.x) + bf_hi(p1.x)) + (bf_lo(p1.y) + bf_hi(p1.y)) + (bf_lo(p1.z) + bf_hi(p1.z)) + (bf_lo(p1.w) + bf_hi(p1.w));
    const bf16x8 pb0 = __builtin_bit_cast(bf16x8, p0), pb1 = __builtin_bit_cast(bf16x8, p1);
    o0 = MFMA32(vc[0][0], pb0, o0); o0 = MFMA32(vc[0][1], pb1, o0);
    o1 = MFMA32(vc[1][0], pb0, o1); o1 = MFMA32(vc[1][1], pb1, o1);
  }
  lsum += sx(lsum, 32);
  const float inv = 1.f / lsum;
  bf16_t* op = CCt + (size_t)tq * 1024 + 512 + head * 64 + 4 * hh;
#pragma unroll
  for (int gq = 0; gq < 4; ++gq) {
    u32x2 w0, w1;
    w0.x = cvt_pk_bf16(o0[4 * gq] * inv, o0[4 * gq + 1] * inv); w0.y = cvt_pk_bf16(o0[4 * gq + 2] * inv, o0[4 * gq + 3] * inv);
    w1.x = cvt_pk_bf16(o1[4 * gq] * inv, o1[4 * gq + 1] * inv); w1.y = cvt_pk_bf16(o1[4 * gq + 2] * inv, o1[4 * gq + 3] * inv);
    *(u32x2*)(op + 8 * gq) = w0; *(u32x2*)(op + 32 + 8 * gq) = w1;
  }
}
__device__ __forceinline__ void phase_attn(const Ctx& X) {
  LAS float* rpbl = (LAS float*)X.lds;
  zero_lists(X);
  for (int i = X.tid; i < 8 * 15 * 31; i += NTHR) rpbl[i] = X.a->in[IN_RPB][i];
  __syncthreads();
  const int gw = X.c * NWAVES + X.wave, NGW = X.G * NWAVES;
  for (int U = gw; U < 4096; U += NGW) attn_unit(X, rpbl, U >> 9, U & 511);
}

__device__ __forceinline__ void fourier_fix(const Ctx& X, int nunits) {
  const float2* SPC = (const float2*)(X.ws + WS_SPC); bf16_t* FB = (bf16_t*)(X.ws + WS_FB);
  for (int i = 0; i * X.G + X.c < nunits; ++i) { const int pm = xcd_remap(i * X.G + X.c, nunits) >> 2;
    for (int q = X.tid; q < 1024; q += NTHR) { const int k = pm * 256 + (q >> 2), g = q & 3, kmir = (16384 - k) & 16383;
      const float2 a = SPC[k * 4 + g], b = SPC[kmir * 4 + g];
      FB[(size_t)k * 1024 + g * 128] = f2bf(0.5f * (a.x + b.x)); FB[(size_t)k * 1024 + 512 + g * 128] = f2bf(0.5f * (a.y + b.y)); } }
  __syncthreads();
}

__device__ __forceinline__ void phase_router(const Ctx& X, int layer, int dry) {
  const float* mod = (const float*)(X.ws + WS_MOD) + (layer == 0 ? 0 : 2 * 6144);
  const float* shift = mod + 3072; const float* scale = mod + 4096;
  const bf16_t* h = (const bf16_t*)(X.ws + WS_HB); bf16_t* F = (bf16_t*)(X.ws + WS_F);
  unsigned* cntg = (unsigned*)(X.ws + WS_CTL) + CW_CNT + layer * 2048;
  int* ltok = (int*)(X.ws + WS_LTOK); int* asg = (int*)(X.ws + WS_ASG);
  const bf16_t* WR = (const bf16_t*)(X.ws + WS_WROUT_T) + (size_t)layer * 64 * 1024;
  const float* rbias = X.a->in[IN_RBIAS] + layer * 64;
  constexpr int FROW = 2064;
  const int lane = X.lane, wave = X.wave, tid = X.tid;
  for (int tile = X.c; tile < TOK / 64; tile += X.G) {
    const int t0 = tile * 64;
    for (int rb4 = 0; rb4 < 2; ++rb4) {
      f32x4 v[4][4];
#pragma unroll
      for (int rr = 0; rr < 4; ++rr) { const u32x2* xr = (const u32x2*)(h + (size_t)(t0 + wave * 8 + rb4 * 4 + rr) * 1024) + lane;
#pragma unroll
        for (int j = 0; j < 4; ++j) { const u32x2 w = xr[64 * j]; v[rr][j] = (f32x4){bf_lo(w.x), bf_hi(w.x), bf_lo(w.y), bf_hi(w.y)}; } }
#pragma unroll
      for (int rr = 0; rr < 4; ++rr) {
        const int lr = wave * 8 + rb4 * 4 + rr, t = t0 + lr; float ss = 0.f;
#pragma unroll
        for (int j = 0; j < 4; ++j) ss += (v[rr][j].x * v[rr][j].x + v[rr][j].y * v[rr][j].y) + (v[rr][j].z * v[rr][j].z + v[rr][j].w * v[rr][j].w);
        const float r = rsqrtf(wave_sum(ss) * (1.f / 1024.f) + 1e-6f);
#pragma unroll
        for (int j = 0; j < 4; ++j) { const f32x4 f = v[rr][j] * r * (((const f32x4*)scale)[lane + 64 * j] + 1.f) + ((const f32x4*)shift)[lane + 64 * j];
          u32x2 w; w.x = cvt_pk_bf16(f.x, f.y); w.y = cvt_pk_bf16(f.z, f.w);
          if (!dry) ((int*)((unsigned char*)F + (size_t)t * 1024))[lane + 64 * j] = pack4_fp8(f.x, f.y, f.z, f.w);
          *(LAS u32x2*)(X.lds + lr * FROW + (lane + 64 * j) * 8) = w; }
      }
    }
    __syncthreads();
    f32x4 pl[4][4];
    { const int fr = lane & 15, fq = lane >> 4;
#pragma unroll
      for (int a = 0; a < 4; ++a)
#pragma unroll
        for (int b = 0; b < 4; ++b) pl[a][b] = (f32x4){0.f, 0.f, 0.f, 0.f};
      bf16x8 bq[4][4];
#pragma unroll
      for (int ks = 0; ks < 4; ++ks)
#pragma unroll
        for (int eb = 0; eb < 4; ++eb) bq[ks][eb] = *(const bf16x8*)(WR + (size_t)(eb * 16 + fr) * 1024 + wave * 128 + ks * 32 + fq * 8);
#pragma unroll
      for (int ks = 0; ks < 4; ++ks) {
        bf16x8 af[4];
#pragma unroll
        for (int rb = 0; rb < 4; ++rb) af[rb] = *(const LAS bf16x8*)(X.lds + (rb * 16 + fr) * FROW + (wave * 128 + ks * 32 + fq * 8) * 2);
#pragma unroll
        for (int rb = 0; rb < 4; ++rb)
#pragma unroll
          for (int eb = 0; eb < 4; ++eb) pl[rb][eb] = __builtin_amdgcn_mfma_f32_16x16x32_bf16(af[rb], bq[ks][eb], pl[rb][eb], 0, 0, 0);
      }
    }
    __syncthreads();
    { LAS float* PART = (LAS float*)X.lds;
      const int fr = lane & 15, fq = lane >> 4;
#pragma unroll
      for (int rb = 0; rb < 4; ++rb)
#pragma unroll
        for (int eb = 0; eb < 4; ++eb)
#pragma unroll
          for (int j = 0; j < 4; ++j) PART[(wave * 64 + rb * 16 + 4 * fq + j) * 64 + eb * 16 + fr] = pl[rb][eb][j];
      __syncthreads();
      float sum[8];
#pragma unroll
      for (int i = 0; i < 8; ++i) { float a = 0.f;
#pragma unroll
        for (int w = 0; w < 8; ++w) a += PART[w * 4096 + i * 512 + tid];
        sum[i] = a; }
      __syncthreads();
      LAS float* LG0 = (LAS float*)X.lds;
#pragma unroll
      for (int i = 0; i < 8; ++i) { const int o = i * 512 + tid; LG0[(o >> 6) * 65 + (o & 63)] = sum[i]; }
    }
    LAS float* LG = (LAS float*)X.lds;
    LAS float* GS = LG + 64 * 65;
    LAS float* SELV = GS + 512;
    LAS int* OUTE = (LAS int*)(SELV + 4096);
    LAS float* OUTS = (LAS float*)(OUTE + 512);
    LAS int* HIST = (LAS int*)(OUTS + 512);
    LAS int* BASE = HIST + 64;
    if (tid < 64) HIST[tid] = 0;
    __syncthreads();
    const int tl = tid >> 3, grp = tid & 7;
    float v[8], sc[8];
    { float m1 = -INFINITY, m2 = -INFINITY;
#pragma unroll
      for (int j = 0; j < 8; ++j) { const float s = 1.f / (1.f + __expf(-LG[tl * 65 + grp * 8 + j])); sc[j] = s; v[j] = s + rbias[grp * 8 + j];
        if (v[j] > m1) { m2 = m1; m1 = v[j]; } else if (v[j] > m2) m2 = v[j]; }
      GS[tl * 8 + grp] = m1 + m2; }
    __syncthreads();
    bool keep;
    { const float mine = GS[tl * 8 + grp]; int rank = 0;
#pragma unroll
      for (int g2 = 0; g2 < 8; ++g2) { const float o = GS[tl * 8 + g2]; rank += (o > mine || (o == mine && g2 < grp)) ? 1 : 0; }
      keep = rank < 4;
#pragma unroll
      for (int j = 0; j < 8; ++j) SELV[tl * 64 + grp * 8 + j] = keep ? v[j] : -INFINITY; }
    __syncthreads();
    if (keep) {
      int rk[8];
#pragma unroll
      for (int j = 0; j < 8; ++j) rk[j] = 0;
      for (int e2 = 0; e2 < 64; ++e2) { const float o = SELV[tl * 64 + e2];
#pragma unroll
        for (int j = 0; j < 8; ++j) rk[j] += (o > v[j] || (o == v[j] && e2 < grp * 8 + j)) ? 1 : 0; }
#pragma unroll
      for (int j = 0; j < 8; ++j) if (rk[j] < 8) { OUTE[tl * 8 + rk[j]] = grp * 8 + j; OUTS[tl * 8 + rk[j]] = sc[j]; }
    }
    __syncthreads();
    { const int jj = tid & 7, e = OUTE[tl * 8 + jj]; const float s = OUTS[tl * 8 + jj];
      float sum = s; sum += sx(sum, 1); sum += sx(sum, 2); sum += sx(sum, 4);
      const float w = 2.5f * s / sum;
      const int sl = atomicAdd((int*)&HIST[e], 1);
      __syncthreads();
      const int t = t0 + tl;
      if (tid < 64) { const int n = HIST[tid]; BASE[tid] = (n && !dry) ? (int)atomicAdd(cntg + tid * 32, (unsigned)n) : 0; }
      __syncthreads();
      const int slot = BASE[e] + sl;
      if (!dry) { ltok[(size_t)e * 16384 + slot] = t; } if (!dry) ((int2*)asg)[t * 8 + jj] = make_int2((e << 16) | slot, __float_as_int(w)); }
    __syncthreads();
  }
}

__device__ __forceinline__ void phase_combine(const Ctx& X, int layer, const LAS int* toff, int dry) {
  const float* mod = (const float*)(X.ws + WS_MOD) + (layer == 0 ? 0 : 2 * 6144);
  const float* gffn = mod + 5120;
  const float* nmod = (const float*)(X.ws + WS_MOD) + 2 * 6144;
  float* hout32 = X.a->h; bf16_t* hb = (bf16_t*)(X.ws + WS_HB); const unsigned char* YAS = X.ws + WS_YAS; const int* asg = (const int*)(X.ws + WS_ASG); bf16_t* A1 = (bf16_t*)(X.ws + WS_A1);
  const int gw = X.c * NWAVES + X.wave, NGW = X.G * NWAVES, lane = X.lane;
  for (int t0 = gw; t0 < TOK; t0 += 2 * NGW) {
    int yw[2][9][4]; f32x4 hv[2][4]; float wgt[2][8];
#pragma unroll
    for (int u = 0; u < 2; ++u) { const int t = t0 + u * NGW;
      int pos[9];
#pragma unroll
      for (int k = 0; k < 8; ++k) { const int2 a = ((const int2*)asg)[t * 8 + k]; pos[k] = toff[a.x >> 16] * 256 + (a.x & 0xffff); wgt[u][k] = __int_as_float(a.y); }
      pos[8] = toff[64] * 256 + t;
#pragma unroll
      for (int k = 0; k < 9; ++k) { const int* yr = (const int*)(YAS + (size_t)pos[k] * 1024) + lane;
#pragma unroll
        for (int j = 0; j < 4; ++j) yw[u][k][j] = yr[64 * j]; }
      const u32x2* hr = (const u32x2*)(hb + (size_t)t * 1024) + lane;
#pragma unroll
      for (int j = 0; j < 4; ++j) { const u32x2 w = hr[64 * j]; hv[u][j] = (f32x4){bf_lo(w.x), bf_hi(w.x), bf_lo(w.y), bf_hi(w.y)}; } }
#pragma unroll
    for (int u = 0; u < 2; ++u) { const int t = t0 + u * NGW;
      f32x4 acc[4];
#pragma unroll
      for (int j = 0; j < 4; ++j) acc[j] = (f32x4){0.f, 0.f, 0.f, 0.f};
#pragma unroll
      for (int k = 0; k < 9; ++k) { const float wk = k < 8 ? wgt[u][k] : 1.f;
#pragma unroll
        for (int j = 0; j < 4; ++j) { const int w = yw[u][k][j];
          acc[j].x += wk * __builtin_amdgcn_cvt_f32_fp8(w, 0); acc[j].y += wk * __builtin_amdgcn_cvt_f32_fp8(w, 1); acc[j].z += wk * __builtin_amdgcn_cvt_f32_fp8(w, 2); acc[j].w += wk * __builtin_amdgcn_cvt_f32_fp8(w, 3); } }
      f32x4 v[4]; float ss = 0.f;
#pragma unroll
      for (int j = 0; j < 4; ++j) { const f32x4 gt = ((const f32x4*)gffn)[lane + 64 * j]; v[j] = hv[u][j] + gt * acc[j];
        if (!dry) { if (layer == 0) ((u32x2*)(hb + (size_t)t * 1024))[lane + 64 * j] = (u32x2){cvt_pk_bf16(v[j].x, v[j].y), cvt_pk_bf16(v[j].z, v[j].w)}; else ((f32x4*)(hout32 + (size_t)t * 1024))[lane + 64 * j] = v[j]; }
        ss += (v[j].x * v[j].x + v[j].y * v[j].y) + (v[j].z * v[j].z + v[j].w * v[j].w); }
      if (layer == 0) {
        const float r = rsqrtf(wave_sum(ss) * (1.f / 1024.f) + 1e-6f);
#pragma unroll
        for (int j = 0; j < 4; ++j) { const f32x4 sh = ((const f32x4*)nmod)[lane + 64 * j], sc = ((const f32x4*)(nmod + 1024))[lane + 64 * j];
          u32x2 w; w.x = cvt_pk_bf16(v[j].x * r * (1.f + sc.x) + sh.x, v[j].y * r * (1.f + sc.y) + sh.y); w.y = cvt_pk_bf16(v[j].z * r * (1.f + sc.z) + sh.z, v[j].w * r * (1.f + sc.w) + sh.w);
          if (!dry) ((u32x2*)(A1 + (size_t)t * 1024))[lane + 64 * j] = w; }
      }
    }
  }
}

constexpr int NPHASE = 21;
template <bool SP2>
__global__ void __launch_bounds__(NTHR, 2) mk_fwd(Args args) {
  extern __shared__ __attribute__((aligned(16))) unsigned char lds_raw[];
  Ctx X; X.lds = (LAS unsigned char*)lds_raw; X.a = &args; X.ws = args.ws; X.tid = threadIdx.x; X.lane = X.tid & 63; X.wave = __builtin_amdgcn_readfirstlane(X.tid >> 6);
  X.G = gridDim.x; X.c = blockIdx.x;
  const int wave_s = X.wave;
  volatile LAS unsigned* MISC = (volatile LAS unsigned*)(X.lds + LDS_MISC_OFF);
  LAS int* TOFF = (LAS int*)(X.lds + LDS_MISC_OFF + 64);
  if (X.tid < 16) MISC[X.tid] = 0u;
  __syncthreads();
  unsigned* ctl = (unsigned*)(X.ws + WS_CTL);
  const int lo = args.ph_lo, hi = args.ph_hi;
  const bool multi = (hi - lo) > 1;
  XcdBarrier bar; bar.bar = ctl + CW_BAR; bar.x = 0; bar.st = nullptr;
  if (multi) bar = xcd_barrier_post(ctl + CW_BAR, MISC, X.tid);
  LAS unsigned char* lds = X.lds;
  unsigned char* ws = X.ws;
  const float* mod = (const float*)(ws + WS_MOD); (void)mod;
#ifndef PH_MASK
#define PH_MASK 0x1fffffull
#endif
#define IN(k) ((((unsigned long long)PH_MASK >> (k)) & 1ull) && lo <= (k) && (k) < hi)
#define SEAM(k) do { if (IN(k) && IN((k) + 1)) xcd_barrier(bar, X.tid); } while (0)
#ifndef REP_MASK
#define REP_MASK 0ull
#endif
#define REPS(k) ((int)(((unsigned long long)REP_MASK >> (k)) & 1ull))
#define FILL(ph, nb) do { if (!(args.flags & FLAG_SKIP_EXPERTS) && multi) { if (X.c < (nb)) { __syncthreads(); if (X.tid == 0) atomicAdd(ctl + CW_DONE + 64 * (ph), 1u); } \
    else transpose_work(X, ctl + CW_DQ1, 0, 0, 1, 65 * IT_EXP, ctl + CW_DONE + 64 * (ph), (unsigned)(nb)); } } while (0)
#define LAUNDER() do { int w0_ = wave_s; asm volatile("" : "+s"(w0_)); unsigned zl_ = 0u; asm volatile("" : "+v"(zl_)); int l_ = (int)__builtin_amdgcn_mbcnt_hi(~0u, __builtin_amdgcn_mbcnt_lo(~0u, zl_)); X.wave = w0_; X.lane = l_; X.tid = w0_ * 64 + l_; \
    size_t z0_ = 0; asm volatile("" : "+s"(z0_)); unsigned char* w_ = args.ws + z0_; X.ws = w_; ws = w_; mod = (const float*)(w_ + WS_MOD); } while (0)
  if (IN(0)) for (int rep_ = 0; rep_ <= REPS(0); ++rep_) { if (rep_) xcd_barrier(bar, X.tid); LAUNDER(); phase_prep(X, rep_); } SEAM(0);
#ifdef EXTRA_BARS
  if (multi) for (int eb_ = 0; eb_ < EXTRA_BARS; ++eb_) xcd_barrier(bar, X.tid);
#endif
  if (IN(1)) for (int rep_ = 0; rep_ <= REPS(1); ++rep_) { if (rep_) xcd_barrier(bar, X.tid); LAUNDER(); phase_mod0(X); } SEAM(1);
  if (IN(2)) for (int rep_ = 0; rep_ <= REPS(2); ++rep_) { if (rep_) xcd_barrier(bar, X.tid); LAUNDER(); G1 p; p.K = 1024; p.nunits = 520; p.ws = ws; p.qg = args.in[IN_QG]; p.kg = args.in[IN_KG]; gemm_phase<G1, SP2>(lds, p, X.G, X.c, X.tid); FILL(2, 8); } SEAM(2);
  if (IN(3)) for (int rep_ = 0; rep_ <= REPS(3); ++rep_) { if (rep_) xcd_barrier(bar, X.tid); LAUNDER(); G2 p; p.K = 512; p.nunits = 96; p.ws = ws; gemm_phase<G2, SP2>(lds, p, X.G, X.c, X.tid); FILL(3, 96); } SEAM(3);
  if (IN(4)) for (int rep_ = 0; rep_ <= REPS(4); ++rep_) { if (rep_) xcd_barrier(bar, X.tid); LAUNDER(); phase_scan(X); FILL(4, 64); } SEAM(4);
  if (IN(5)) for (int rep_ = 0; rep_ <= REPS(5); ++rep_) { if (rep_) xcd_barrier(bar, X.tid); LAUNDER(); G3 p; p.K = 768; p.nunits = 128; p.ws = ws; gemm_phase<G3, SP2>(lds, p, X.G, X.c, X.tid); FILL(5, 128); } SEAM(5);
  if (IN(6)) for (int rep_ = 0; rep_ <= REPS(6); ++rep_) { if (rep_) xcd_barrier(bar, X.tid); LAUNDER(); G4 p; p.K = 512; p.nunits = 128; p.ws = ws; p.bglu = args.in[IN_BGLU]; gemm_phase<G4, SP2>(lds, p, X.G, X.c, X.tid); FILL(6, 128); } SEAM(6);
  if (IN(7)) for (int rep_ = 0; rep_ <= REPS(7); ++rep_) { if (rep_) xcd_barrier(bar, X.tid); LAUNDER(); phase_attn(X); } SEAM(7);
  if (IN(8)) for (int rep_ = 0; rep_ <= REPS(8); ++rep_) { if (rep_) xcd_barrier(bar, X.tid); LAUNDER(); GRes p; p.K = 1024; p.nunits = 256; p.A = (const char*)ws + WS_CONCAT; p.Bt = (const char*)ws + WS_WMIX_T; p.hin32 = args.in[IN_X]; p.hin16 = nullptr; p.hout = (bf16_t*)(ws + WS_HB); p.gate = mod + 2048; p.bias = nullptr;
    gemm_phase<GRes, SP2>(lds, p, X.G, X.c, X.tid); } SEAM(8);
#pragma unroll 1
  for (int layer = 0; layer < 2; ++layer) {
    const int pb = layer == 0 ? 9 : 17;
    if (IN(pb)) for (int rep_ = 0; rep_ <= REPS(pb); ++rep_) { if (rep_) xcd_barrier(bar, X.tid); LAUNDER(); phase_router(X, layer, rep_); } SEAM(pb);
#ifndef ROUTER_VARIANT
#define ROUTER_VARIANT 1
#endif
#ifndef G6_VARIANT
#define G6_VARIANT 1
#endif
    if (IN(pb + 1)) for (int rep_ = REPS(pb + 1); rep_ >= 0; --rep_) { if (rep_ == 0 && REPS(pb + 1)) xcd_barrier(bar, X.tid); LAUNDER(); build_moetab(X, layer, TOFF); G6 p; p.K = 512; p.ws = ws; p.toff = TOFF; p.nunits = TOFF[65] * 2; p.wbase = (const char*)ws + (layer == 0 ? WS_WEXP : WS_WEXP1); p.wstride = layer == 0 ? EXP_STRIDE : EXP1_STRIDE;
      { LAS unsigned* tk = (LAS unsigned*)(X.lds + LDS_STAGE); p.tokt = tk; p.build_tokt(X, tk); } gemm_phase<G6, false>(lds, p, X.G, X.c, X.tid); } SEAM(pb + 1);
#ifndef G7_VARIANT
#define G7_VARIANT 1
#endif
    if (IN(pb + 2)) for (int rep_ = REPS(pb + 2); rep_ >= 0; --rep_) { if (rep_ == 0 && REPS(pb + 2)) xcd_barrier(bar, X.tid); LAUNDER(); build_moetab(X, layer, TOFF); G7 p; p.K = 256; p.ws = ws; p.toff = TOFF; p.nunits = TOFF[65] * 4; p.wbase = (const char*)ws + (layer == 0 ? WS_WEXP + EXP_DOFF : WS_WEXP1 + EXP1_DOFF); p.wstride = layer == 0 ? EXP_STRIDE : EXP1_STRIDE; gemm_phase<G7, SP2>(lds, p, X.G, X.c, X.tid); } SEAM(pb + 2);
    if (IN(pb + 3)) for (int rep_ = REPS(pb + 3); rep_ >= 0; --rep_) { if (rep_ == 0 && REPS(pb + 3)) xcd_barrier(bar, X.tid); LAUNDER(); build_moetab(X, layer, TOFF); phase_combine(X, layer, TOFF, rep_);
      if (layer == 0 && rep_ == 0 && !(args.flags & FLAG_SKIP_EXPERTS)) { __syncthreads(); transpose_work(X, ctl + CW_DQ1, 0, 0, 1, 65 * IT_EXP); } }
    if (layer == 0) {
      SEAM(12);
      if (IN(13)) for (int rep_ = 0; rep_ <= REPS(13); ++rep_) { if (rep_) xcd_barrier(bar, X.tid); LAUNDER(); G8 p; p.K = 256; p.nunits = 256; p.ws = ws; gemm_phase<G8, SP2>(lds, p, X.G, X.c, X.tid); } SEAM(13);
      if (IN(14)) for (int rep_ = 0; rep_ <= REPS(14); ++rep_) { if (rep_) xcd_barrier(bar, X.tid); LAUNDER(); G9 p; p.K = 256; p.nunits = 256; p.ws = ws; gemm_phase<G9, SP2>(lds, p, X.G, X.c, X.tid); } SEAM(14);
      if (IN(15)) for (int rep_ = 0; rep_ <= REPS(15); ++rep_) { if (rep_) xcd_barrier(bar, X.tid); LAUNDER(); G10 p; p.K = 256; p.nunits = 256; p.ws = ws; gemm_phase<G10, SP2>(lds, p, X.G, X.c, X.tid); } SEAM(15);
      if (IN(16)) { LAUNDER(); zero_lists(X); fourier_fix(X, 256); GRes p; p.K = 1024; p.nunits = 256; p.A = (const char*)ws + WS_FB; p.Bt = (const char*)ws + WS_WFOUR_T; p.hin32 = nullptr; p.hin16 = (const bf16_t*)(ws + WS_HB); p.hout = (bf16_t*)(ws + WS_HB); p.gate = mod + 2 * 6144 + 2048; p.bias = args.in[IN_BFOUR];
        gemm_phase<GRes, SP2>(lds, p, X.G, X.c, X.tid); } SEAM(16);
    }
  }
#undef IN
#undef SEAM
}
}
#ifndef MK_SP2
#define MK_SP2 true
#endif
#ifndef MK_N_LAUNCHES
#define MK_N_LAUNCHES 1
#endif
#ifndef CHECK
#define CHECK 0
#endif
static int g_grid = 0;
static bool mk_setup(int n_in, int out_size, size_t ws_size) {
  if (g_grid == 0) {
    g_grid = -1;
    if (n_in != 31 || out_size != 16384 * 1024 || ws_size < mk::WS_NEED) { fprintf(stderr, "kernel_launch: unexpected n_in %d out %d ws %zu\n", n_in, out_size, ws_size); return false; }
    int dev = 0, cus = 0;
    if (hipGetDevice(&dev) != hipSuccess || hipDeviceGetAttribute(&cus, hipDeviceAttributeMultiprocessorCount, dev) != hipSuccess) return false;
    if (cus < 256) { fprintf(stderr, "kernel_launch: needs 256 CUs, device has %d\n", cus); return false; }
    if (hipFuncSetAttribute((const void*)mk::mk_fwd<MK_SP2>, hipFuncAttributeMaxDynamicSharedMemorySize, mk::LDS_BYTES) != hipSuccess) { fprintf(stderr, "kernel_launch: hipFuncSetAttribute failed\n"); return false; }
    g_grid = 256;
  }
  return g_grid > 0;
}
static void mk_run(hipStream_t s, mk::Args a, int lo, int hi) {
  a.ph_lo = lo; a.ph_hi = hi;
  hipLaunchKernelGGL(mk::mk_fwd<MK_SP2>, dim3(g_grid), dim3(mk::NTHR), mk::LDS_BYTES, s, a);
}

#if CHECK
namespace chk {
using mk::bf16_t;
__device__ __forceinline__ float b2f(bf16_t b) { return __uint_as_float(((unsigned)b) << 16); }
__global__ void k_cmp(int mode, const void* A, const float* B, unsigned long long n, double* acc) {
  double e = 0.0, r = 0.0; const bf16_t* A16 = (const bf16_t*)A;
  for (unsigned long long i = (unsigned long long)blockIdx.x * 256 + threadIdx.x; i < n; i += (unsigned long long)gridDim.x * 256) {
    float a = 0.f, b = 0.f; const int row = (int)(i >> 9), col = (int)(i & 511);
    switch (mode) {
      case 0: a = ((const float*)A)[i]; b = B[i]; break;
      case 1: a = b2f(A16[i]); b = B[i]; break;
      case 2: { b = B[(size_t)row * 2048 + col]; const int g = col >> 4, c = col & 15; int crow, s; if (row < 16384) { crow = row >> 5; s = row & 31; } else { const int j = row - 16384; crow = 512 + (j >> 5); s = j & 31; }
                a = b2f(A16[((size_t)(g * 768 + crow)) * 768 + s * 16 + c]); } break;
      case 3: b = B[(size_t)row * 2048 + 512 + col]; a = b2f(A16[(size_t)row * 512 + col]); break;
      case 4: b = B[(size_t)row * 2048 + 1024 + col]; a = b2f(A16[(size_t)row * 512 + col]); break;
      case 5: b = B[(size_t)row * 2048 + 1536 + col]; a = b2f(A16[(size_t)col * 16640 + row]); break;
      case 6: b = B[(size_t)row * 1024 + col]; a = b2f(A16[(size_t)row * 1024 + col]); break;
      case 7: b = B[(size_t)row * 1024 + 512 + col]; a = b2f(A16[(size_t)row * 1024 + 512 + col]); break;
      case 8: { const int ta = (int)(i & 127), ri = (int)((i >> 7) & 1), tb = (int)((i >> 8) & 127), m = (int)((i >> 15) & 255), g = (int)(i >> 23); a = b2f(A16[i]); const int t = 128 * ta + tb; b = B[((size_t)t * 4 + g) * 512 + ri * 256 + m]; } break;
      default: break;
    }
    const double d = (double)a - (double)b; e += d * d; r += (double)b * (double)b;
  }
  for (int o = 32; o >= 1; o >>= 1) { e += __shfl_xor(e, o); r += __shfl_xor(r, o); }
  if ((threadIdx.x & 63) == 0) { atomicAdd(acc, e); atomicAdd(acc + 1, r); }
}
__global__ void k_cmp_x2(const bf16_t* X2, const float* Yr, const float* Yi, double* acc) {
  double e = 0.0, r = 0.0;
  for (unsigned long long i = (unsigned long long)blockIdx.x * 256 + threadIdx.x; i < (1ull << 25); i += (unsigned long long)gridDim.x * 256) {
    const int tb = (int)(i & 127), rip = (int)((i >> 7) & 1), ka = (int)((i >> 8) & 127), gm = (int)(i >> 15);
    const float a = b2f(X2[i]); const size_t yi = (((size_t)ka * 128 + tb) << 10) + gm; const float b = rip ? Yi[yi] : Yr[yi];
    const double d = (double)a - (double)b; e += d * d; r += (double)b * (double)b;
  }
  for (int o = 32; o >= 1; o >>= 1) { e += __shfl_xor(e, o); r += __shfl_xor(r, o); }
  if ((threadIdx.x & 63) == 0) { atomicAdd(acc, e); atomicAdd(acc + 1, r); }
}
__global__ void k_judge(const double* acc, int n, float tol, int* fail) {
  if (threadIdx.x == 0 && blockIdx.x == 0) { fail[0] = 0; for (int k = 0; k < n; ++k) { const double rel = sqrt(acc[2 * k] / acc[2 * k + 1]); if (!(rel <= (double)tol)) { fail[0] = k + 1; break; } } }
}
__global__ void k_encode(float* out, size_t n, const int* fail) {
  const int f = fail[0]; if (f == 0) return; const float sc = 1.f + 0.1f * (float)f;
  for (size_t i = (size_t)blockIdx.x * 256 + threadIdx.x; i < n; i += (size_t)gridDim.x * 256) out[i] *= sc;
}
__global__ void k_f2bf(const float* in, bf16_t* out, size_t n) { for (size_t i = (size_t)blockIdx.x * 256 + threadIdx.x; i < n; i += (size_t)gridDim.x * 256) out[i] = mk::f2bf(in[i]); }
static void cmp(hipStream_t s, int mode, const void* A, const float* B, unsigned long long n, double* acc) { hipLaunchKernelGGL(k_cmp, dim3(2048), dim3(256), 0, s, mode, A, B, n, acc); }
}
#endif

extern "C" void kernel_launch(void* const* d_in, const int* in_sizes, int n_in, void* d_out, int out_size, void* d_ws, size_t ws_size, hipStream_t stream) {
  if (!mk_setup(n_in, out_size, ws_size)) return;
  unsigned char* ws = (unsigned char*)d_ws;
  const size_t MiB = mk::MiB;
  mk::Args a{};
  for (int i = 0; i < 31; ++i) a.in[i] = (const float*)d_in[i];
  a.h = (float*)d_out; a.ws = ws; a.flags = 0; a.pad = 0;
#if CHECK == 0
  (void)hipMemsetAsync(ws + mk::WS_CTL, 0, mk::CTL_ZERO_BYTES, stream);
#if MK_N_LAUNCHES == 1
  mk_run(stream, a, 0, mk::NPHASE);
#else
  for (int ph = 0; ph < mk::NPHASE; ++ph) mk_run(stream, a, ph, ph + 1);
#endif
#else
  ref::In in; { const float** p = (const float**)&in; for (int i = 0; i < 31; ++i) p[i] = (const float*)d_in[i]; }
  float* out = (float*)d_out;
  char* wsc = (char*)d_ws;
  ref::Small sm; sm.mod = (float*)(wsc + 498 * MiB); sm.lamb = (float2*)(wsc + 498 * MiB + 131072); sm.bbar = (float2*)(wsc + 498 * MiB + 262144);
  sm.tw = (float2*)(wsc + 499 * MiB); sm.Dm = (float*)(wsc + 499 * MiB + 262144);
  double* acc = (double*)(wsc + 500 * MiB); int* fail = (int*)(wsc + 500 * MiB + 4096);
  (void)hipMemsetAsync(acc, 0, 8192, stream);
  (void)hipMemsetAsync(ws + mk::WS_CTL, 0, mk::CTL_ZERO_BYTES, stream);
  float* HOPT = (float*)(ws + mk::WS_HOPT);
  int nchk = 0;
#if CHECK == 1
  ref::MixBuf mb; mb.a0 = (float*)(wsc + 12 * MiB); mb.z = (float*)(wsc + 336 * MiB); mb.g = (float*)(wsc + 466 * MiB); mb.t = (float*)(wsc + 77 * MiB); mb.concat = mb.a0; mb.ymix = mb.z;
  char* moe_arena = wsc + 12 * MiB;
  ref::FourBuf fb; { char* p = wsc + 12 * MiB; fb.a1 = (float*)p; p += 64 * MiB; fb.Z = (float*)p; p += 128 * MiB; fb.Yr = (float*)p; p += 64 * MiB; fb.Yi = (float*)p; p += 64 * MiB; fb.F = (float*)p; fb.yf = fb.Z; }
  a.flags = mk::FLAG_SKIP_EXPERTS;
  nchk = 10;
  ref::forward(stream, in, out, sm, mb, moe_arena, fb, [&](int st) {
    if (st == 1) { mk_run(stream, a, 0, 1); chk::cmp(stream, 0, ws + mk::WS_MOD, sm.mod, 3 * 6144, acc + 0); }
    if (st == 2) { mk_run(stream, a, 1, 2); chk::cmp(stream, 1, ws + mk::WS_A0, mb.a0, 16640ull * 1024, acc + 2); }
    if (st == 3) { mk_run(stream, a, 2, 3); chk::cmp(stream, 2, ws + mk::WS_AS5, mb.z, 16640ull * 512, acc + 4); chk::cmp(stream, 3, ws + mk::WS_Q, mb.z, 16384ull * 512, acc + 6);
                   chk::cmp(stream, 4, ws + mk::WS_K, mb.z, 16640ull * 512, acc + 8); chk::cmp(stream, 5, ws + mk::WS_VT, mb.z, 16640ull * 512, acc + 10); }
    if (st == 4) { mk_run(stream, a, 3, 4); mk_run(stream, a, 4, 5); mk_run(stream, a, 5, 6); chk::cmp(stream, 1, ws + mk::WS_GB, mb.g, 16384ull * 512, acc + 12); }
    if (st == 5) { mk_run(stream, a, 6, 7); chk::cmp(stream, 6, ws + mk::WS_CONCAT, mb.concat, 16384ull * 512, acc + 14); }
    if (st == 6) { mk_run(stream, a, 7, 8); chk::cmp(stream, 7, ws + mk::WS_CONCAT, mb.concat, 16384ull * 512, acc + 16); }
    if (st == 7) { mk::Args b = a; b.h = HOPT; mk_run(stream, b, 8, 9); chk::cmp(stream, 0, HOPT, out, 16384ull * 1024, acc + 18); }
  });
#elif CHECK == 2 || CHECK == 4
  const int L = CHECK == 2 ? 0 : 1;
  ref::MixBuf mb; { char* p = wsc + 12 * MiB; mb.a0 = (float*)p; p += 65 * MiB; mb.z = (float*)p; p += 130 * MiB; mb.g = (float*)p; p += 32 * MiB; mb.t = (float*)p; p += 32 * MiB; mb.concat = (float*)p; p += 64 * MiB; mb.ymix = mb.z; }
  ref::FourBuf fb; { char* p = wsc + 12 * MiB; fb.a1 = (float*)p; p += 64 * MiB; fb.Z = (float*)p; p += 128 * MiB; fb.Yr = (float*)p; p += 64 * MiB; fb.Yi = (float*)p; p += 64 * MiB; fb.F = (float*)p; fb.yf = fb.Z; }
  char* moe_arena = wsc + 110 * MiB;
  nchk = L == 0 ? 2 : 1;
  a.flags = 0;
  ref::forward(stream, in, out, sm, mb, moe_arena, fb, [&](int st) {
    if ((L == 0 && st == 7) || (L == 1 && st == 11)) {
      mk::Args b = a; b.h = HOPT; if (L == 1) b.flags = 2;
      mk_run(stream, b, 0, 1);
      (void)hipMemcpyAsync(HOPT, out, (size_t)16384 * 1024 * 4, hipMemcpyDeviceToDevice, stream);
      const int pb = L == 0 ? 9 : 20; b.flags |= mk::FLAG_SKIP_EXPERTS;
      for (int ph = pb; ph < pb + 7; ++ph) mk_run(stream, b, ph, ph + 1);
    }
    if ((L == 0 && st == 8) || (L == 1 && st == 12)) chk::cmp(stream, 0, HOPT, out, 16384ull * 1024, acc + 0);
    if (L == 0 && st == 9) chk::cmp(stream, 1, ws + mk::WS_A1, fb.a1, 16384ull * 1024, acc + 2);
  });
#elif CHECK == 3
  ref::MixBuf mb; { char* p = wsc + 12 * MiB; mb.a0 = (float*)p; p += 65 * MiB; mb.z = (float*)p; p += 130 * MiB; mb.g = (float*)p; p += 32 * MiB; mb.t = (float*)p; p += 32 * MiB; mb.concat = (float*)p; p += 64 * MiB; mb.ymix = mb.z; }
  char* moe_arena = wsc + 12 * MiB;
  ref::FourBuf fb; fb.Z = (float*)(wsc + 270 * MiB);
  fb.a1 = (float*)(wsc + 12 * MiB); fb.Yr = (float*)(wsc + 12 * MiB);   fb.Yi = (float*)(wsc + 468 * MiB - 0); fb.F = (float*)(wsc + 270 * MiB); fb.yf = (float*)(wsc + 334 * MiB);
  fb.Yi = (float*)(wsc + 76 * MiB);
  nchk = 4;
  a.flags = mk::FLAG_SKIP_EXPERTS;
  ref::forward(stream, in, out, sm, mb, moe_arena, fb, [&](int st) {
    if (st == 9) {
      mk::Args b = a; b.h = HOPT;
      mk_run(stream, b, 0, 1);
      hipLaunchKernelGGL(chk::k_f2bf, dim3(2048), dim3(256), 0, stream, fb.a1, (chk::bf16_t*)(ws + mk::WS_A1), (size_t)16384 * 1024);
      (void)hipMemcpyAsync(HOPT, out, (size_t)16384 * 1024 * 4, hipMemcpyDeviceToDevice, stream);
      mk_run(stream, b, 16, 17);
    }
  });
#endif
  hipLaunchKernelGGL(chk::k_judge, dim3(1), dim3(64), 0, stream, acc, nchk, 0.05f, fail);
  hipLaunchKernelGGL(chk::k_encode, dim3(2048), dim3(256), 0, stream, out, (size_t)16384 * 1024, fail);
#endif
}
```

```cpp
#define CHECK 0
#define MK_N_LAUNCHES 1
#define MK_SP2 true
#define REP_MASK 0ull
#include <hip/hip_runtime.h>
#include <cstdio>
#include <cstdint>
#include <cmath>
namespace mk {
#define LAS __attribute__((address_space(3)))
typedef unsigned short bf16_t;
typedef short bf16x8 __attribute__((ext_vector_type(8)));
typedef float f32x4 __attribute__((ext_vector_type(4)));
typedef float f32x2 __attribute__((ext_vector_type(2)));
typedef unsigned u32x4 __attribute__((ext_vector_type(4)));
typedef unsigned u32x2 __attribute__((ext_vector_type(2)));
typedef int i32x8 __attribute__((ext_vector_type(8)));
typedef int i32x4 __attribute__((ext_vector_type(4)));

constexpr int TOK = 16384, CTXN = 256, NROW = TOK + CTXN;
constexpr int NWAVES = 8, NTHR = 512;
constexpr int LDS_STAGE = 131072, LDS_BYTES = 155648, LDS_MISC_OFF = LDS_BYTES - 4096;

__device__ __forceinline__ unsigned cvt_pk_bf16(float lo, float hi) { unsigned r; asm volatile("v_cvt_pk_bf16_f32 %0, %1, %2" : "=v"(r) : "v"(lo), "v"(hi)); return r; }
__device__ __forceinline__ int pack4_fp8(float a, float b, float c, float d) { int w = 0;
  w = __builtin_amdgcn_cvt_pk_fp8_f32(__builtin_amdgcn_fmed3f(a, -448.f, 448.f), __builtin_amdgcn_fmed3f(b, -448.f, 448.f), w, false);
  w = __builtin_amdgcn_cvt_pk_fp8_f32(__builtin_amdgcn_fmed3f(c, -448.f, 448.f), __builtin_amdgcn_fmed3f(d, -448.f, 448.f), w, true); return w; }
__device__ __forceinline__ void st16_wt(void* p, u32x4 v) { asm volatile("global_store_dwordx4 %0, %1, off sc1\n\ts_nop 1" :: "v"(p), "v"(v) : "memory"); }
__device__ __forceinline__ float bf_lo(unsigned w) { return __uint_as_float(w << 16); }
__device__ __forceinline__ float bf_hi(unsigned w) { return __uint_as_float(w & 0xffff0000u); }
__device__ __forceinline__ float bf2f(bf16_t b) { return __uint_as_float(((unsigned)b) << 16); }
__device__ __forceinline__ bf16_t f2bf(float f) { unsigned u = __float_as_uint(f); return (bf16_t)((u + 0x7fffu + ((u >> 16) & 1u)) >> 16); }
__device__ __forceinline__ float sx(float v, int o) { unsigned z = 0u; asm volatile("" : "+v"(z)); int l = (int)__builtin_amdgcn_mbcnt_hi(~0u, __builtin_amdgcn_mbcnt_lo(~0u, z)); return __int_as_float(__builtin_amdgcn_ds_bpermute((l ^ o) << 2, __float_as_int(v))); }
__device__ __forceinline__ float wave_sum(float v) {
#pragma unroll
  for (int o = 1; o < 64; o <<= 1) v += sx(v, o);
  return v;
}
__device__ __forceinline__ float fast_sigmoid(float x) { return __builtin_amdgcn_rcpf(1.f + __expf(-x)); }
__device__ __forceinline__ float fast_tanh(float x) { float e = __expf(2.f * x); return 1.f - 2.f * __builtin_amdgcn_rcpf(e + 1.f); }
__device__ __forceinline__ float gelu_tanh(float x) { return 0.5f * x * (1.f + fast_tanh(0.7978845608028654f * (x + 0.044715f * x * x * x))); }

#define XB_TMO      128
#define XB_XCNT(j)  (256  + 64 * (j))
#define XB_XSUB(j)  (1280 + 64 * (j))
#define XB_XGEN(j)  (2304 + 64 * (j))
#define XB_TOP      3328
#define XB_TOPGEN   3392
#define XCD_BAR_WORDS 3456
#define XB_SPIN_CAP (1u << 20)
__device__ __forceinline__ unsigned xb_ld(unsigned* p) { return __hip_atomic_load(p, __ATOMIC_RELAXED, __HIP_MEMORY_SCOPE_AGENT); }
__device__ __forceinline__ unsigned xb_add(unsigned* p, unsigned v) { return __hip_atomic_fetch_add(p, v, __ATOMIC_RELAXED, __HIP_MEMORY_SCOPE_AGENT); }
__device__ __forceinline__ unsigned xb_xcc_id() { return (unsigned)__builtin_amdgcn_s_getreg((3 << 11) | 20) & 0xFu; }
#define XB_SPIN(cond, bar) do { unsigned _sp = 0; while (cond) { __builtin_amdgcn_s_sleep(1); \
    if ((++_sp & 255u) == 0u) { if (xb_ld(&(bar)[XB_TMO])) break; if (_sp > XB_SPIN_CAP) { atomicAdd(&(bar)[XB_TMO], 1u); break; } } } } while (0)
struct XcdBarrier { unsigned* bar; unsigned x; volatile LAS unsigned* st; };
__device__ __forceinline__ XcdBarrier xcd_barrier_post(unsigned* bar, volatile LAS unsigned* st, int tid) {
  XcdBarrier b; b.bar = bar; b.x = xb_xcc_id(); b.st = st;
  if (tid == 0) (void)xb_add(&bar[XB_XCNT(b.x)], 1u);
  return b;
}
__device__ __forceinline__ void xcd_barrier_complete(unsigned* bar, unsigned x, unsigned& nloc, unsigned& nx) {
  const unsigned G = gridDim.x * gridDim.y * gridDim.z;
  unsigned sum, cnt, mine, sp = 0u;
  for (;;) {
    sum = 0u; cnt = 0u; mine = 0u;
#pragma unroll
    for (unsigned j = 0; j < 16; ++j) { const unsigned c = xb_ld(&bar[XB_XCNT(j)]); sum += c; cnt += (c > 0u) ? 1u : 0u; }
    if (sum == G) { mine = xb_ld(&bar[256 + 64 * x]); break; }
    __builtin_amdgcn_s_sleep(1);
    if ((++sp & 255u) == 0u) { if (xb_ld(&bar[XB_TMO])) break; if (sp > XB_SPIN_CAP) { atomicAdd(&bar[XB_TMO], 1u); break; } }
  }
  nloc = mine > 0u ? mine : 1u; nx = cnt > 0u ? cnt : 1u;
}
__device__ __forceinline__ void xcd_barrier(const XcdBarrier& b, int tid) {
  asm volatile("s_waitcnt vmcnt(0)" ::: "memory");
  __syncthreads();
  if (tid == 0) {
    unsigned* bar = b.bar;
    __builtin_amdgcn_s_waitcnt(0);
    unsigned nloc = b.st[0], nx = b.st[1];
    if (nloc == 0u) { xcd_barrier_complete(bar, b.x, nloc, nx); b.st[0] = nloc; b.st[1] = nx; }
    const unsigned old = xb_add(&bar[XB_XSUB(b.x)], 1u);
    const unsigned gen = old / nloc;
    if (old + 1u == (gen + 1u) * nloc) {
      __builtin_amdgcn_fence(__ATOMIC_RELEASE, "agent");
      asm volatile("s_waitcnt vmcnt(0)" ::: "memory");
      const unsigned og = xb_add(&bar[XB_TOP], 1u);
      const unsigned tg = og / nx;
      if (og + 1u == (tg + 1u) * nx) xb_add(&bar[XB_TOPGEN], 1u);
      else XB_SPIN(xb_ld(&bar[XB_TOPGEN]) == tg, bar);
      __builtin_amdgcn_fence(__ATOMIC_ACQUIRE, "agent");
      xb_add(&bar[XB_XGEN(b.x)], 1u);
      asm volatile("s_waitcnt vmcnt(0)" ::: "memory");
    } else {
      XB_SPIN(xb_ld(&bar[XB_XGEN(b.x)]) == gen, bar);
      __builtin_amdgcn_fence(__ATOMIC_ACQUIRE, "agent");
      asm volatile("s_waitcnt vmcnt(0)" ::: "memory");
    }
  }
  __syncthreads();
}

constexpr int BM = 256, BK = 64, HALF = 128, HTB = HALF * BK * 2, NXCD = 8;
__device__ __forceinline__ int lds_byte(int r, int c) { const int st = (r >> 4) * 2 + (c >> 5), rr = r & 15, cc = c & 31, ob = rr * 64 + cc * 2; return st * 1024 + (ob ^ (((ob >> 9) & 1) << 5)); }
__device__ __forceinline__ void stage_rc(int b, int& R, int& C) { const int st = b / 1024, sb = b % 1024, swz = sb ^ (((sb >> 9) & 1) << 5); R = (st >> 1) * 16 + swz / 64; C = (st & 1) * 32 + (swz % 64) / 2; }
__device__ __forceinline__ int swz16(int fr) { return 2 * ((fr >> 1) & 1) + 4 * ((fr >> 3) & 1); }
__device__ __forceinline__ int swz8(int fr) { return ((fr >> 1) & 1) + 4 * ((fr >> 3) & 1); }
__device__ __forceinline__ int perm32(int rho) { const int n = rho >> 4, i = rho & 15; return 8 * (i >> 2) + 4 * n + (i & 3); }

struct Unit { int pm, pn, a, b, ord; };
__device__ __forceinline__ int xcd_remap(int L, int nunits) { const int q = nunits / NXCD, r = nunits % NXCD, xcd = L % NXCD, off = L / NXCD; return (xcd < r ? xcd * (q + 1) : r * (q + 1) + (xcd - r) * q) + off; }
typedef f32x4 Acc[2][2][4][2];
template <class P, bool SP2>
__device__ __forceinline__ void gemm_phase(LAS unsigned char* lds, const P& p, int G, int c, int tid_in) {
  const int tid = tid_in, wid = __builtin_amdgcn_readfirstlane(tid >> 6), lane = tid & 63, wr = wid >> 2, wc = wid & 3, fr = lane & 15, fq = lane >> 4;
  const int K = p.K, nt = K / BK;
  const int nunits = p.nunits;
  const size_t kstep = (size_t)(BK * 2);
  const unsigned ldsw = (unsigned)wid * 1024u;
  const int aoff0 = P::F8 ? (wr * 64 + fr) * 128 + ((2 * fq) ^ swz8(fr)) * 16 : lds_byte(wr * 64 + fr, fq * 8);
  const int boff0 = P::F8 ? (wc * 32 + fr) * 128 + ((2 * fq) ^ swz8(fr)) * 16 : lds_byte(wc * 32 + fr, fq * 8);
#define PG8_SA(b, h) (((b) * 2 + (h)) * HTB)
#define PG8_SB(b, h) ((4 + (b) * 2 + (h)) * HTB)
#define PG8_STAGE(bufoff, gbase, voff) do { _Pragma("unroll") for (int _i = 0; _i < 2; ++_i) \
        __builtin_amdgcn_global_load_lds((const unsigned*)((const char*)(gbase) + (voff)[_i]), (LAS unsigned*)(lds + (bufoff) + ldsw + _i * 8192), 16, 0, 0); } while (0)
#define PG8_RD32(p0_, p1_) __builtin_shufflevector(*(const LAS i32x4*)(p0_), *(const LAS i32x4*)(p1_), 0, 1, 2, 3, 4, 5, 6, 7)
#define PG8_LDA(dst, b, h) do { if constexpr (P::F8) { int _o1 = aoff0 ^ 16; asm volatile("" : "+v"(_o1)); _Pragma("unroll") for (int m = 0; m < 4; ++m) dst##8[m] = PG8_RD32(lds + PG8_SA(b, h) + aoff0 + m * 2048, lds + PG8_SA(b, h) + _o1 + m * 2048); } \
        else { _Pragma("unroll") for (int m = 0; m < 4; ++m) _Pragma("unroll") for (int k = 0; k < 2; ++k) dst[m][k] = *(const LAS bf16x8*)(lds + PG8_SA(b, h) + aoff0 + m * 2048 + k * 1024); } } while (0)
#define PG8_LDB(dst, b, h) do { if constexpr (P::F8) { int _o1 = boff0 ^ 16; asm volatile("" : "+v"(_o1)); _Pragma("unroll") for (int n = 0; n < 2; ++n) dst##8[n] = PG8_RD32(lds + PG8_SB(b, h) + boff0 + n * 2048, lds + PG8_SB(b, h) + _o1 + n * 2048); } \
        else { _Pragma("unroll") for (int n = 0; n < 2; ++n) _Pragma("unroll") for (int k = 0; k < 2; ++k) dst[n][k] = *(const LAS bf16x8*)(lds + PG8_SB(b, h) + boff0 + n * 2048 + k * 1024); } } while (0)
#define PG8_MMA(ai, bj, At, Bt) do { __builtin_amdgcn_s_setprio(1); if constexpr (P::F8) { _Pragma("unroll") for (int m = 0; m < 4; ++m) _Pragma("unroll") for (int n = 0; n < 2; ++n) \
        acc[ai][bj][m][n] = __builtin_amdgcn_mfma_scale_f32_16x16x128_f8f6f4(Bt##8[n], At##8[m], acc[ai][bj][m][n], 0, 0, 0, 0, 0, 0); }     \
        else { _Pragma("unroll") for (int m = 0; m < 4; ++m) _Pragma("unroll") for (int n = 0; n < 2; ++n) _Pragma("unroll") for (int k = 0; k < 2; ++k) \
        acc[ai][bj][m][n] = __builtin_amdgcn_mfma_f32_16x16x32_bf16(Bt[n][k], At[m][k], acc[ai][bj][m][n], 0, 0, 0); } __builtin_amdgcn_s_setprio(0); } while (0)
#define PG8_WAIT_V(n) asm volatile("s_waitcnt vmcnt(" #n ")" ::: "memory")
#define PG8_WAIT_L(n) asm volatile("s_waitcnt lgkmcnt(" #n ")" ::: "memory")
#define PG8_BAR __builtin_amdgcn_s_barrier()
#define PG8_SCHED __builtin_amdgcn_sched_barrier(0)
#define PG8_DECODE(i, u) do { p.decode(P::CONTIG ? (u_lo + (i)) : xcd_remap((i) * G + c, nunits), u); u.ord = (i); } while (0)
#define PG8_HAS(i) (P::CONTIG ? (u_lo + (i) < u_hi) : ((i) * G + c < nunits))
#define PG8_OFFS(u, vA, vB) do { int _t = tid; asm volatile("" : "+v"(_t)); _Pragma("unroll") for (int _i = 0; _i < 2; ++_i) { int _R, _C; if constexpr (P::F8) { const int _p = _t + 512 * _i; _R = _p >> 3; _C = ((_p & 7) ^ swz8(_R & 15)) * 8; } else stage_rc(_t * 16 + _i * 8192, _R, _C); \
        const int _Rb = P::PERM ? ((_R & ~31) + perm32(_R & 31)) : _R; _Pragma("unroll") for (int _h = 0; _h < 2; ++_h) { \
        if (_h == 0 || !P::LINA) vA[_h][_i] = p.rowA(u, _h * HALF + _R) + (unsigned)(_C * 2); if (_h == 0 || !P::LINB) vB[_h][_i] = p.rowB(u, _h * HALF + _Rb) + (unsigned)(_C * 2); } } } while (0)
  const int vc_ = (G % 8 == 0) ? (c % 8) * (G / 8) + c / 8 : c;
  const int u_lo = (int)(((long)vc_ * nunits) / G), u_hi = (int)(((long)(vc_ + 1) * nunits) / G);
  if (!PG8_HAS(0)) return;
  Unit cur, nxt; int ui = 0;
  PG8_DECODE(0, cur);
  Acc acc; float zf_ = 0.f; asm volatile("" : "+v"(zf_));
#pragma unroll
  for (int a = 0; a < 2; ++a)
#pragma unroll
    for (int b = 0; b < 2; ++b)
#pragma unroll
      for (int m = 0; m < 4; ++m)
#pragma unroll
        for (int n = 0; n < 2; ++n) acc[a][b][m][n] = (f32x4){zf_, zf_, zf_, zf_};
  bf16x8 At[4][2], B0[2][2], B1[2][2]; i32x8 At8[4], B08[2], B18[2];
  unsigned vA[2][2], vB[2][2];
  PG8_OFFS(cur, vA, vB);
  const char* cA = p.baseA(cur); const char* cB = p.baseB(cur);
  const size_t hA = P::LINA ? p.halfA() : 0, hB = P::LINB ? p.halfB() : 0;
  if constexpr (SP2) {
    PG8_STAGE(PG8_SB(0, 0), cB, vB[0]); PG8_STAGE(PG8_SB(0, 1), (cB) + (P::LINB ? hB : 0), vB[P::LINB ? 0 : 1]); PG8_STAGE(PG8_SA(0, 0), cA, vA[0]); PG8_STAGE(PG8_SA(0, 1), (cA) + (P::LINA ? hA : 0), vA[P::LINA ? 0 : 1]);
    if (wr == 1) PG8_BAR;
    PG8_WAIT_V(2); PG8_BAR;
    PG8_STAGE(PG8_SB(1, 0), cB + kstep, vB[0]); PG8_STAGE(PG8_SA(1, 0), cA + kstep, vA[0]); PG8_STAGE(PG8_SB(1, 1), (cB + kstep) + (P::LINB ? hB : 0), vB[P::LINB ? 0 : 1]);
    PG8_WAIT_V(6); PG8_BAR;
  } else {
    PG8_STAGE(PG8_SB(0, 0), cB, vB[0]); PG8_STAGE(PG8_SA(0, 0), cA, vA[0]); PG8_STAGE(PG8_SB(0, 1), (cB) + (P::LINB ? hB : 0), vB[P::LINB ? 0 : 1]); PG8_STAGE(PG8_SA(0, 1), (cA) + (P::LINA ? hA : 0), vA[P::LINA ? 0 : 1]);
    if (wr == 1) PG8_BAR;
    PG8_WAIT_V(4); PG8_BAR;
    PG8_STAGE(PG8_SB(1, 0), cB + kstep, vB[0]); PG8_STAGE(PG8_SA(1, 0), cA + kstep, vA[0]); PG8_STAGE(PG8_SB(1, 1), (cB + kstep) + (P::LINB ? hB : 0), vB[P::LINB ? 0 : 1]);
    PG8_WAIT_V(6); PG8_BAR;
  }
  for (;;) {
    const bool has_next = PG8_HAS(ui + 1);
    if (has_next) PG8_DECODE(ui + 1, nxt);
    const char* nA = has_next ? p.baseA(nxt) : cA; const char* nB = has_next ? p.baseB(nxt) : cB;
    for (int t = 0; t < nt; t += 2) {
      const bool last = (t == nt - 2);
      const char* a1 = cA + (size_t)(t + 1) * kstep;
      const char* a2 = last ? nA : cA + (size_t)(t + 2) * kstep; const char* b2 = last ? nB : cB + (size_t)(t + 2) * kstep;
      const char* a3 = a2 + kstep; const char* b3 = b2 + kstep;
      if constexpr (SP2) {
        PG8_LDB(B0, 0, 0); PG8_LDB(B1, 0, 1); PG8_SCHED; PG8_LDA(At, 0, 0); PG8_STAGE(PG8_SA(1, 1), (a1) + (P::LINA ? hA : 0), vA[P::LINA ? 0 : 1]);
        PG8_WAIT_V(8); PG8_WAIT_L(0); PG8_BAR; PG8_MMA(0, 0, At, B0); PG8_MMA(0, 1, At, B1); PG8_BAR; PG8_SCHED;
        if (last && has_next) { PG8_OFFS(nxt, vA, vB); }
        PG8_LDA(At, 0, 1); PG8_STAGE(PG8_SB(0, 0), b2, vB[0]); PG8_STAGE(PG8_SB(0, 1), (b2) + (P::LINB ? hB : 0), vB[P::LINB ? 0 : 1]); PG8_STAGE(PG8_SA(0, 0), a2, vA[0]);
        PG8_WAIT_V(8); PG8_WAIT_L(0); PG8_BAR; PG8_MMA(1, 0, At, B0); PG8_MMA(1, 1, At, B1); PG8_BAR; PG8_SCHED;
        PG8_LDB(B0, 1, 0); PG8_LDB(B1, 1, 1); PG8_SCHED; PG8_LDA(At, 1, 0); PG8_STAGE(PG8_SA(0, 1), (a2) + (P::LINA ? hA : 0), vA[P::LINA ? 0 : 1]);
        PG8_WAIT_V(8); PG8_WAIT_L(0); PG8_BAR; PG8_MMA(0, 0, At, B0); PG8_MMA(0, 1, At, B1); PG8_BAR; PG8_SCHED;
        PG8_LDA(At, 1, 1); PG8_STAGE(PG8_SB(1, 0), b3, vB[0]); PG8_STAGE(PG8_SB(1, 1), (b3) + (P::LINB ? hB : 0), vB[P::LINB ? 0 : 1]); PG8_STAGE(PG8_SA(1, 0), a3, vA[0]);
        PG8_WAIT_V(8); PG8_WAIT_L(0); PG8_BAR; PG8_MMA(1, 0, At, B0); PG8_MMA(1, 1, At, B1); PG8_BAR; PG8_SCHED;
      } else {
        PG8_LDB(B0, 0, 0); PG8_SCHED; PG8_LDA(At, 0, 0); PG8_STAGE(PG8_SA(1, 1), (a1) + (P::LINA ? hA : 0), vA[P::LINA ? 0 : 1]);
        PG8_WAIT_L(8); PG8_BAR; PG8_WAIT_L(0); PG8_MMA(0, 0, At, B0); PG8_BAR; PG8_SCHED;
        if (last && has_next) { PG8_OFFS(nxt, vA, vB); }
        PG8_LDB(B1, 0, 1); PG8_STAGE(PG8_SB(0, 0), b2, vB[0]);
        PG8_BAR; PG8_WAIT_L(0); PG8_MMA(0, 1, At, B1); PG8_BAR;
        PG8_LDA(At, 0, 1); PG8_STAGE(PG8_SA(0, 0), a2, vA[0]);
        PG8_BAR; PG8_WAIT_L(0); PG8_MMA(1, 0, At, B0); PG8_BAR; PG8_SCHED;
        PG8_STAGE(PG8_SB(0, 1), (b2) + (P::LINB ? hB : 0), vB[P::LINB ? 0 : 1]);
        PG8_WAIT_V(6); PG8_BAR; PG8_MMA(1, 1, At, B1); PG8_BAR;
        PG8_LDB(B0, 1, 0); PG8_SCHED; PG8_LDA(At, 1, 0); PG8_STAGE(PG8_SA(0, 1), (a2) + (P::LINA ? hA : 0), vA[P::LINA ? 0 : 1]);
        PG8_WAIT_L(8); PG8_BAR; PG8_WAIT_L(0); PG8_MMA(0, 0, At, B0); PG8_BAR; PG8_SCHED;
        PG8_LDB(B1, 1, 1); PG8_STAGE(PG8_SB(1, 0), b3, vB[0]);
        PG8_BAR; PG8_WAIT_L(0); PG8_MMA(0, 1, At, B1); PG8_BAR;
        PG8_LDA(At, 1, 1); PG8_STAGE(PG8_SA(1, 0), a3, vA[0]);
        PG8_BAR; PG8_WAIT_L(0); PG8_MMA(1, 0, At, B0); PG8_BAR; PG8_SCHED;
        PG8_STAGE(PG8_SB(1, 1), (b3) + (P::LINB ? hB : 0), vB[P::LINB ? 0 : 1]);
        PG8_WAIT_V(6); PG8_BAR; PG8_MMA(1, 1, At, B1); PG8_BAR;
      }
    }
    if constexpr (P::ALIGN) { if (wr == 0) PG8_BAR; }
    { int fr_e = fr, fq_e = fq; asm volatile("" : "+v"(fr_e), "+v"(fq_e)); p.epi(acc, cur, wr, wc, fr_e, fq_e); }
    if (!has_next) break;
    zf_ = 0.f; asm volatile("" : "+v"(zf_));
#pragma unroll
    for (int a = 0; a < 2; ++a)
#pragma unroll
      for (int b = 0; b < 2; ++b)
#pragma unroll
        for (int m = 0; m < 4; ++m)
#pragma unroll
          for (int n = 0; n < 2; ++n) acc[a][b][m][n] = (f32x4){zf_, zf_, zf_, zf_};
    cur = nxt; cA = nA; cB = nB; ++ui;
    if constexpr (P::ALIGN) { if (wr == 1) PG8_BAR; }
  }
  PG8_WAIT_V(0);
  if constexpr (!P::ALIGN) { if (wr == 0) PG8_BAR; }
  PG8_BAR;
#undef PG8_SA
#undef PG8_SB
#undef PG8_STAGE
#undef PG8_RD32
#undef PG8_LDA
#undef PG8_LDB
#undef PG8_MMA
#undef PG8_WAIT_V
#undef PG8_WAIT_L
#undef PG8_BAR
#undef PG8_SCHED
#undef PG8_DECODE
#undef PG8_HAS
#undef PG8_OFFS
}
}
namespace mk {
constexpr size_t MiB = 1u << 20;
constexpr size_t WS_CTL = 0, CTL_ZERO_BYTES = 65536;
constexpr size_t WS_MOD = 65536;
constexpr size_t WS_LAML = 262144;
constexpr size_t WS_WIN_T = 1 * MiB, WS_WGLU_T = 5 * MiB, WS_WMIX_T = 6 * MiB, WS_WFOUR_T = 8 * MiB, WS_WROUT_T = 10 * MiB;
constexpr size_t WS_DMT = 10 * MiB + 512 * 1024, WS_W1 = 10 * MiB + 768 * 1024, WS_W2 = 10 * MiB + 896 * 1024;
constexpr size_t WS_WEXP = 12 * MiB, EXP_STRIDE = 3 * MiB / 2, EXP_DOFF = 1 * MiB;
constexpr size_t WS_R = 110 * MiB;
constexpr size_t WS_WS = WS_R, WS_TT = WS_R + 8 * MiB, WS_A0 = WS_R + 34 * MiB, WS_AS5 = WS_R + 67 * MiB, WS_Q = WS_R + 103 * MiB, WS_K = WS_R + 119 * MiB,
                 WS_VT = WS_R + 136 * MiB, WS_SST = WS_R + 153 * MiB, WS_GB = WS_R + 177 * MiB, WS_CONCAT = WS_R + 193 * MiB;
constexpr size_t WS_F = WS_R, WS_LTOK = WS_R + 16 * MiB, WS_ASG = WS_R + 20 * MiB, WS_HID = WS_R + 22 * MiB, WS_YAS = WS_R + 102 * MiB,
                 WS_A1 = WS_R + 262 * MiB, WS_HB = WS_R + 294 * MiB;
constexpr size_t WS_X1 = WS_R, WS_X2 = WS_R + 64 * MiB, WS_SPC = WS_R + 96 * MiB, WS_FB = WS_R + 128 * MiB;
constexpr size_t WS_HOPT = WS_R + 338 * MiB;
constexpr size_t WS_WEXP1 = WS_R + 338 * MiB;
constexpr size_t EXP1_STRIDE = 1 * MiB, EXP1_DOFF = 512 * 1024;
constexpr size_t WS_NEED = WS_R + 403 * MiB;
constexpr int HALF_CAP_ROWS = 90112;
constexpr int CW_BAR = 4096, CW_CNT = 8192  , CW_DQ0 = 12288, CW_DQ1 = 12352, CW_DONE = 13312  ;

struct Args { const float* in[31]; float* h; unsigned char* ws; int ph_lo, ph_hi, flags, pad; };
enum { IN_X = 0, IN_C, IN_CTX, IN_CCTX, IN_WADA, IN_BADA, IN_WIN, IN_LRE, IN_LIM, IN_LDT, IN_BRE, IN_BIM, IN_CRE, IN_CIM, IN_S5D, IN_WGLU, IN_BGLU, IN_QG, IN_KG,
       IN_RPB, IN_WMIX, IN_WFOUR, IN_BFOUR, IN_WROUT, IN_RBIAS, IN_WEG, IN_WEU, IN_WED, IN_WSG, IN_WSU, IN_WSD };
constexpr int FLAG_SKIP_EXPERTS = 1;

struct Ctx {
  LAS unsigned char* lds; const Args* a; unsigned char* ws; int tid, lane, wave, G, c;
};

__device__ __forceinline__ u32x4 pack8(const f32x4& v0, const f32x4& v1) { u32x4 w; w.x = cvt_pk_bf16(v0[0], v0[1]); w.y = cvt_pk_bf16(v0[2], v0[3]); w.z = cvt_pk_bf16(v1[0], v1[1]); w.w = cvt_pk_bf16(v1[2], v1[3]); return w; }
__device__ __forceinline__ int rowmap(int code, int n) {
  if (code == 1) { if (n < 512 || n >= 1536) return n; const int blk = n & ~255, c = n & 255; return blk + 128 * ((c >> 5) & 1) + 32 * (c >> 6) + (c & 31); }
  if (code == 2) return 256 * (n >> 7) + (n & 127);
  if (code == 3) return 256 * (n >> 7) + 128 + (n & 127);
  return n;
}
__device__ __forceinline__ int kmap(int kcode, int k) {
  if (kcode == 1) { const int h = k >> 9, g = (k >> 7) & 3, m = k & 127; return g * 256 + (h == 0 ? m : (m == 0 ? 128 : 256 - m)); }
  return k;
}
__device__ __forceinline__ void transpose_item(const float* W, int K, int N, bf16_t* WT, int code, LAS unsigned char* scr, int item, int lane, int kcode = 0) {
  const int nblk = N / 64, kb = item / nblk, nb = item % nblk, k0 = 64 * kb, n0 = 64 * nb;
  const int q = lane >> 4, a = lane & 15;
  f32x4 v[16];
  const float* src = W + (size_t)(k0 + 2 * q) * N + n0 + 4 * a;
  if (kcode == 0) {
#pragma unroll
    for (int i = 0; i < 16; ++i) v[i] = *(const f32x4*)(src + (size_t)((i & 1) + 8 * (i >> 1)) * N);
  } else {
#pragma unroll
    for (int i = 0; i < 16; ++i) v[i] = *(const f32x4*)(W + (size_t)kmap(kcode, k0 + 2 * q + (i & 1) + 8 * (i >> 1)) * N + n0 + 4 * a);
  }
#pragma unroll
  for (int ii = 0; ii < 8; ++ii) { const int dsw = q + 4 * (ii ^ (a & 7));
#pragma unroll
    for (int j = 0; j < 4; ++j) *(LAS unsigned*)(scr + (4 * a + j) * 128 + 4 * dsw) = cvt_pk_bf16(v[2 * ii][j], v[2 * ii + 1][j]); }
  asm volatile("s_waitcnt lgkmcnt(0)" ::: "memory");
  const int c = lane & 7;
#pragma unroll
  for (int jj = 0; jj < 8; ++jj) { const int n = (lane >> 3) + 8 * jj, cs = c ^ ((n >> 2) & 7);
    const u32x4 o = *(const LAS u32x4*)(scr + n * 128 + 16 * cs);
    *(u32x4*)(WT + (size_t)rowmap(code, n0 + n) * K + k0 + 8 * c) = o; }
  asm volatile("s_waitcnt lgkmcnt(0)" ::: "memory");
}
__device__ __forceinline__ void transpose_item8(const float* W, int K, int N, unsigned char* WT, int code, float scale, LAS unsigned char* scr, int item, int lane) {
  const int nblk = N / 64, kb = item / nblk, nb = item % nblk, k0 = 64 * kb, n0 = 64 * nb;
  const int q = lane >> 4, a = lane & 15;
  f32x4 v[16];
  const float* src = W + (size_t)(k0 + 4 * q) * N + n0 + 4 * a;
#pragma unroll
  for (int i = 0; i < 16; ++i) v[i] = *(const f32x4*)(src + (size_t)((i & 3) + 16 * (i >> 2)) * N);
#pragma unroll
  for (int ib = 0; ib < 4; ++ib) { const int dsw = q + 4 * (ib ^ (a & 3));
#pragma unroll
    for (int j = 0; j < 4; ++j) *(LAS int*)(scr + (4 * a + j) * 64 + 4 * dsw) = pack4_fp8(v[4 * ib][j] * scale, v[4 * ib + 1][j] * scale, v[4 * ib + 2][j] * scale, v[4 * ib + 3][j] * scale); }
  asm volatile("s_waitcnt lgkmcnt(0)" ::: "memory");
  const int c = lane & 3;
#pragma unroll
  for (int jj = 0; jj < 4; ++jj) { const int n = (lane >> 2) + 16 * jj, cs = c ^ ((n >> 2) & 3);
    const u32x4 o = *(const LAS u32x4*)(scr + n * 64 + 16 * cs);
    *(u32x4*)(WT + (size_t)rowmap(code, n0 + n) * K + k0 + 16 * c) = o; }
  asm volatile("s_waitcnt lgkmcnt(0)" ::: "memory");
}
constexpr int IT_WIN = 512, IT_GLU = 64, IT_MIX = 256, IT_FOUR = 256, IT_ROUT = 32, IT_SMALL = IT_WIN + IT_GLU + IT_MIX + IT_FOUR + IT_ROUT, IT_EXP = 192;
__device__ __forceinline__ void small_item(const Ctx& X, LAS unsigned char* scr, int it) {
  const Args& a = *X.a; unsigned char* ws = X.ws;
  if (it < IT_WIN) { transpose_item(a.in[IN_WIN], 1024, 2048, (bf16_t*)(ws + WS_WIN_T), 1, scr, it, X.lane); return; } it -= IT_WIN;
  if (it < IT_GLU) { transpose_item(a.in[IN_WGLU], 512, 512, (bf16_t*)(ws + WS_WGLU_T), 0, scr, it, X.lane); return; } it -= IT_GLU;
  if (it < IT_MIX) { transpose_item(a.in[IN_WMIX], 1024, 1024, (bf16_t*)(ws + WS_WMIX_T), 0, scr, it, X.lane); return; } it -= IT_MIX;
  if (it < IT_FOUR) { transpose_item(a.in[IN_WFOUR], 1024, 1024, (bf16_t*)(ws + WS_WFOUR_T), 0, scr, it, X.lane, 1); return; } it -= IT_FOUR;
  { const int l = it >> 4; transpose_item(a.in[IN_WROUT] + (size_t)l * 1024 * 64, 1024, 64, (bf16_t*)(ws + WS_WROUT_T) + (size_t)l * 64 * 1024, 0, scr, it & 15, X.lane); }
}
__device__ __forceinline__ void expert_item(const Ctx& X, LAS unsigned char* scr, int layer, int it) {
  const Args& a = *X.a; const int e = it / IT_EXP, r = it % IT_EXP;
  bf16_t* gu = (bf16_t*)(X.ws + (layer == 0 ? WS_WEXP + (size_t)e * EXP_STRIDE : WS_WEXP1 + (size_t)e * EXP1_STRIDE));
  bf16_t* dt = (bf16_t*)(X.ws + (layer == 0 ? WS_WEXP + (size_t)e * EXP_STRIDE + EXP_DOFF : WS_WEXP1 + (size_t)e * EXP1_STRIDE + EXP1_DOFF));
  const float *wg, *wu, *wd;
  if (e < 64) { const size_t o = ((size_t)layer * 64 + e) * 262144; wg = a.in[IN_WEG] + o; wu = a.in[IN_WEU] + o; wd = a.in[IN_WED] + o; }
  else { const size_t o = (size_t)layer * 262144; wg = a.in[IN_WSG] + o; wu = a.in[IN_WSU] + o; wd = a.in[IN_WSD] + o; }
  if (r < 64) transpose_item8(wg, 1024, 256, (unsigned char*)gu, 2, 32.f, scr, r, X.lane);
  else if (r < 128) transpose_item8(wu, 1024, 256, (unsigned char*)gu, 3, 32.f, scr, r - 64, X.lane);
  else transpose_item(wd, 256, 1024, dt, 0, scr, r - 128, X.lane);
}
__device__ __forceinline__ void transpose_work(const Ctx& X, unsigned* ctr, int first_small, int n_small, int layer, int n_exp_items, unsigned* done = nullptr, unsigned need = 0u) {
  LAS unsigned char* scr = X.lds + X.wave * 8192;
  volatile LAS int* shb = (volatile LAS int*)(X.lds + LDS_MISC_OFF + 1024);
  const int total = n_small + n_exp_items;
  const int per = done ? 1 : 4;
  for (;;) {
    __syncthreads();
    if (X.tid == 0) { int b = total; if (!done || __hip_atomic_load(done, __ATOMIC_RELAXED, __HIP_MEMORY_SCOPE_AGENT) < need) b = (int)atomicAdd(ctr, (unsigned)(8 * per)); shb[0] = b; }
    __syncthreads();
    const int base = shb[0];
    if (base >= total) break;
    for (int k = 0; k < per; ++k) { const int it = base + X.wave * per + k; if (it >= total) break;
      if (it < n_small) small_item(X, scr, first_small + it); else expert_item(X, scr, layer, it - n_small); }
  }
}

__device__ __forceinline__ void p0_adaln(const Ctx& X, int it) {
  const Args& a = *X.a; const int layer = it / 48, ct = it % 48, col = ct * 128 + X.lane;
  LAS float* sl = (LAS float*)X.lds;
  for (int i = X.tid; i < 2048; i += NTHR) { const float v = i < 1024 ? a.in[IN_C][i] : a.in[IN_CCTX][i - 1024]; sl[i] = v / (1.f + __expf(-v)); }
  __syncthreads();
  const float* W = a.in[IN_WADA] + (size_t)layer * 1024 * 6144 + col;
  float a0 = 0.f, a1 = 0.f, b0 = 0.f, b1 = 0.f; const int k0 = X.wave * 128;
#pragma unroll 16
  for (int k = 0; k < 128; ++k) { const float w0 = W[(size_t)(k0 + k) * 6144], w1 = W[(size_t)(k0 + k) * 6144 + 64]; const float s0 = sl[k0 + k], s1 = sl[1024 + k0 + k];
    a0 += s0 * w0; a1 += s1 * w0; b0 += s0 * w1; b1 += s1 * w1; }
  LAS float* red = sl + 2048;
  red[(X.wave * 128 + X.lane) * 2] = a0; red[(X.wave * 128 + X.lane) * 2 + 1] = a1; red[(X.wave * 128 + 64 + X.lane) * 2] = b0; red[(X.wave * 128 + 64 + X.lane) * 2 + 1] = b1;
  __syncthreads();
  if (X.tid < 256) { const int l = X.tid & 127, v = X.tid >> 7; float s = 0.f;
#pragma unroll
    for (int w = 0; w < 8; ++w) s += red[(w * 128 + l) * 2 + v];
    s += a.in[IN_BADA][layer * 6144 + ct * 128 + l];
    float* mod = (float*)(X.ws + WS_MOD);
    if (layer == 0) mod[v * 6144 + ct * 128 + l] = s; else if (v == 0) mod[2 * 6144 + ct * 128 + l] = s; }
  __syncthreads();
}

__device__ __forceinline__ void p0_s5tables(const Ctx& X, int g, int part) {
  const Args& a = *X.a;
  LAS f32x2* POW = (LAS f32x2*)X.lds;
  LAS f32x2* BB = (LAS f32x2*)(X.lds + 33792);
  LAS f32x2* CC = (LAS f32x2*)(X.lds + 33792 + 16384);
  LAS float* KK = (LAS float*)(X.lds + 33792 + 32768);
  LAS float* DD = (LAS float*)(X.lds + 33792 + 32768 + 65536);
  const int tid = X.tid;
  if (tid < 128) {
    const int dir = tid >> 6, p = tid & 63, idx = (dir * 32 + g) * 64 + p;
    const float lr = fminf(a.in[IN_LRE][idx], -1e-4f), li = a.in[IN_LIM][idx], dt = expf(a.in[IN_LDT][dir * 32 + g]);
    for (int tau = 0; tau <= 32; ++tau) { const float mg = expf(lr * dt * (float)tau); float sn, cs; sincospif(li * dt * (float)tau * 0.318309886183790672f, &sn, &cs); POW[(dir * 33 + tau) * 64 + p] = (f32x2){mg * cs, mg * sn}; }
    const f32x2 l1 = POW[(dir * 33 + 1) * 64 + p], l32 = POW[(dir * 33 + 32) * 64 + p];
    if (part == 0) ((float2*)(X.ws + WS_LAML))[idx] = make_float2(l32.x, l32.y);
    const float nr = l1.x - 1.f, ni = l1.y, den = lr * lr + li * li, cr = (nr * lr + ni * li) / den, ci = (ni * lr - nr * li) / den;
    for (int c = 0; c < 16; ++c) { const float xr = a.in[IN_BRE][idx * 16 + c], xi = a.in[IN_BIM][idx * 16 + c]; BB[(dir * 64 + p) * 16 + c] = (f32x2){cr * xr - ci * xi, cr * xi + ci * xr}; }
  }
  for (int i = tid; i < 2048; i += NTHR) { const int dir = i >> 10, c = (i >> 6) & 15, p = i & 63; const int gi = ((dir * 32 + g) * 16 + c) * 64 + p; CC[i] = (f32x2){a.in[IN_CRE][gi], a.in[IN_CIM][gi]}; }
  if (tid < 16) DD[tid] = a.in[IN_S5D][g * 16 + tid];
  __syncthreads();
  for (int combo = tid; combo < 1024; combo += NTHR) {
    const int dir = combo >> 9, tau = (combo >> 4) & 31, c = combo & 15;
    float accv[16];
#pragma unroll
    for (int j = 0; j < 16; ++j) accv[j] = 0.f;
#pragma unroll 2
    for (int p = 0; p < 64; ++p) {
      const f32x2 cc = CC[(dir * 16 + c) * 64 + p], pw = POW[(dir * 33 + tau) * 64 + p];
      const float zr = cc.x * pw.x - cc.y * pw.y, zi = cc.x * pw.y + cc.y * pw.x;
      const LAS f32x4* bp = (const LAS f32x4*)(BB + (dir * 64 + p) * 16);
#pragma unroll
      for (int j = 0; j < 8; ++j) { const f32x4 b = bp[j]; accv[2 * j] += zr * b.x - zi * b.y; accv[2 * j + 1] += zr * b.z - zi * b.w; }
    }
#pragma unroll
    for (int j = 0; j < 4; ++j) *(LAS f32x4*)(KK + ((dir * 32 + tau) * 16 + c) * 16 + 4 * j) = (f32x4){accv[4 * j], accv[4 * j + 1], accv[4 * j + 2], accv[4 * j + 3]};
  }
  __syncthreads();
  bf16_t* TT = (bf16_t*)(X.ws + WS_TT) + (size_t)g * 512 * 768;
  for (int q = part * 12288 + tid; q < (part + 1) * 12288; q += NTHR) {
    const int row = q / 96, cc8 = q % 96, i = row >> 4, c = row & 15; f32x4 v0, v1;
    if (cc8 < 64) {
      const int s = cc8 >> 1, c0 = (cc8 & 1) * 8;
      const int dir = s < i ? 0 : 1, tau = s < i ? i - s : s - i;
      const LAS f32x4* kp = (const LAS f32x4*)(KK + ((dir * 32 + tau) * 16 + c) * 16 + c0);
      v0 = kp[0]; v1 = kp[1];
      if (s == i) { const LAS f32x4* k0p = (const LAS f32x4*)(KK + ((0 * 32 + 0) * 16 + c) * 16 + c0); v0 += k0p[0]; v1 += k0p[1];
        const float d = DD[c]; const int dj = c - c0;
        if (dj >= 0 && dj < 4) v0[dj] += d; else if (dj >= 4 && dj < 8) v1[dj - 4] += d; }
    } else {
      const int kk = (cc8 - 64) * 8, dir = kk >> 7, ri = (kk >> 6) & 1, p0 = kk & 63, tau = dir == 0 ? i + 1 : 32 - i;
      const LAS f32x4* cp = (const LAS f32x4*)(CC + (dir * 16 + c) * 64 + p0); const LAS f32x4* pp = (const LAS f32x4*)(POW + (dir * 33 + tau) * 64 + p0);
      float v[8];
#pragma unroll
      for (int j = 0; j < 4; ++j) { const f32x4 cc = cp[j], pw = pp[j];
        v[2 * j] = ri == 0 ? (cc.x * pw.x - cc.y * pw.y) : -(cc.x * pw.y + cc.y * pw.x); v[2 * j + 1] = ri == 0 ? (cc.z * pw.z - cc.w * pw.w) : -(cc.z * pw.w + cc.w * pw.z); }
      v0 = (f32x4){v[0], v[1], v[2], v[3]}; v1 = (f32x4){v[4], v[5], v[6], v[7]};
    }
    *(u32x4*)(TT + (size_t)row * 768 + cc8 * 8) = pack8(v0, v1);
  }
  bf16_t* WSm = (bf16_t*)(X.ws + WS_WS) + (size_t)g * 256 * 512;
  for (int q = part * 4096 + tid; q < (part + 1) * 4096; q += NTHR) {
    const int n = q >> 6, cc8 = q & 63, dir = n >> 7, ri = (n >> 6) & 1, p = n & 63, s = cc8 >> 1, c0 = (cc8 & 1) * 8, tau = dir == 0 ? 31 - s : s;
    const f32x2 pw = POW[(dir * 33 + tau) * 64 + p]; const LAS f32x4* bp = (const LAS f32x4*)(BB + (dir * 64 + p) * 16 + c0); float v[8];
#pragma unroll
    for (int j = 0; j < 4; ++j) { const f32x4 b = bp[j]; v[2 * j] = ri == 0 ? (pw.x * b.x - pw.y * b.y) : (pw.x * b.y + pw.y * b.x); v[2 * j + 1] = ri == 0 ? (pw.x * b.z - pw.y * b.w) : (pw.x * b.w + pw.y * b.z); }
    *(u32x4*)(WSm + (size_t)n * 512 + cc8 * 8) = pack8((f32x4){v[0], v[1], v[2], v[3]}, (f32x4){v[4], v[5], v[6], v[7]});
  }
  __syncthreads();
}

__device__ __forceinline__ void p0_dftconst(const Ctx& X, int idx) {
  for (int q = idx * NTHR + X.tid; q < 24576; q += 32 * NTHR) {
    float v[8]; bf16_t* dst;
    if (q < 8192) {
      const int R = q >> 5, c0 = (q & 31) * 8, ri = R >> 7, m = R & 127; dst = (bf16_t*)(X.ws + WS_DMT) + (size_t)R * 256 + c0;
#pragma unroll
      for (int j = 0; j < 8; ++j) { float s, c; sincospif((float)(((c0 + j) * m) & 255) * (1.f / 128.f), &s, &c); v[j] = ri == 0 ? c : (m == 0 ? (((c0 + j) & 1) ? -1.f : 1.f) : -s); }
    } else if (q < 16384) {
      const int q2 = q - 8192, R = q2 >> 5, c0 = (q2 & 31) * 8, rip = R >> 7, ka = R & 127; dst = (bf16_t*)(X.ws + WS_W1) + (size_t)R * 256 + c0;
#pragma unroll
      for (int j = 0; j < 8; ++j) { const int C = c0 + j, ri = C >> 7, ta = C & 127; float s, c; sincospif((float)((ka * ta) & 127) * (1.f / 64.f), &s, &c);
        v[j] = (rip == ri) ? c : (rip == 0 ? s : -s); }
    } else {
      const int q2 = q - 16384, R = q2 >> 5, c0 = (q2 & 31) * 8, kb = R & 127; dst = (bf16_t*)(X.ws + WS_W2) + (size_t)R * 256 + c0;
#pragma unroll
      for (int j = 0; j < 8; ++j) { const int C = c0 + j, rip = C >> 7, tb = C & 127; float s, c; sincospif((float)((kb * tb) & 127) * (1.f / 64.f), &s, &c);
        v[j] = (R < 128 ? (rip == 0 ? c : s) : (rip == 0 ? -s : c)) * (1.f / 2048.f); }
    }
    u32x4 o; o.x = cvt_pk_bf16(v[0], v[1]); o.y = cvt_pk_bf16(v[2], v[3]); o.z = cvt_pk_bf16(v[4], v[5]); o.w = cvt_pk_bf16(v[6], v[7]);
    *(u32x4*)dst = o;
  }
}

__device__ __forceinline__ void phase_prep(const Ctx& X, int rep) {
  const int c = X.c;
  if (c < 96) p0_adaln(X, c);
  else if (c < 224) p0_s5tables(X, (c - 96) >> 2, (c - 96) & 3);
  else p0_dftconst(X, c - 224);
  __syncthreads();
  unsigned* ctl = (unsigned*)(X.ws + WS_CTL);
  transpose_work(X, ctl + CW_DQ0 + 128 * rep, 0, IT_SMALL, (X.a->flags & 2) ? 1 : 0, (X.a->flags & FLAG_SKIP_EXPERTS) ? 0 : 65 * IT_EXP);
}

__device__ __forceinline__ void phase_mod0(const Ctx& X) {
  const Args& a = *X.a; const float* mod = (const float*)(X.ws + WS_MOD); bf16_t* A0 = (bf16_t*)(X.ws + WS_A0);
  const int gw = X.c * NWAVES + X.wave, NGW = X.G * NWAVES, lane = X.lane;
  f32x4 sh[4], sc[4], cur[4], nxt[4];
#pragma unroll
  for (int j = 0; j < 4; ++j) { sh[j] = ((const f32x4*)mod)[lane + 64 * j]; sc[j] = ((const f32x4*)(mod + 1024))[lane + 64 * j] + 1.f; }
  { const f32x4* xr = (const f32x4*)(a.in[IN_X] + (size_t)gw * 1024) + lane;
#pragma unroll
    for (int j = 0; j < 4; ++j) cur[j] = xr[64 * j]; }
  bool ctxmod = false;
  for (int r = gw; r < NROW; r += NGW) {
    const int rn = r + NGW;
    if (rn < NROW) { const f32x4* xr = (const f32x4*)(rn < TOK ? a.in[IN_X] + (size_t)rn * 1024 : a.in[IN_CTX] + (size_t)(rn - TOK) * 1024) + lane;
#pragma unroll
      for (int j = 0; j < 4; ++j) nxt[j] = xr[64 * j]; }
    if (r >= TOK && !ctxmod) { ctxmod = true;
#pragma unroll
      for (int j = 0; j < 4; ++j) { sh[j] = ((const f32x4*)(mod + 6144))[lane + 64 * j]; sc[j] = ((const f32x4*)(mod + 6144 + 1024))[lane + 64 * j] + 1.f; } }
    float ss = 0.f;
#pragma unroll
    for (int j = 0; j < 4; ++j) ss += (cur[j].x * cur[j].x + cur[j].y * cur[j].y) + (cur[j].z * cur[j].z + cur[j].w * cur[j].w);
    const float rr = rsqrtf(wave_sum(ss) * (1.f / 1024.f) + 1e-6f);
    u32x2* o8 = (u32x2*)(A0 + (size_t)r * 1024) + lane;
#pragma unroll
    for (int j = 0; j < 4; ++j) { const f32x4 f = cur[j] * rr * sc[j] + sh[j]; u32x2 w; w.x = cvt_pk_bf16(f.x, f.y); w.y = cvt_pk_bf16(f.z, f.w); o8[64 * j] = w; }
#pragma unroll
    for (int j = 0; j < 4; ++j) cur[j] = nxt[j];
  }
}


struct G1 {
  static constexpr bool PERM = true; static constexpr bool F8 = false; static constexpr int SCALE_B = 0x7A7A7A7A; static constexpr bool CONTIG = false; static constexpr bool ALIGN = true; static constexpr bool LINA = true, LINB = true; __device__ __forceinline__ size_t halfA() const { return 128u * 2048u; } __device__ __forceinline__ size_t halfB() const { return 128u * 2048u; } int K, nunits; unsigned char* ws; const float* qg; const float* kg;
  __device__ __forceinline__ void decode(int w, Unit& u) const { if (w < 390) { u.a = 0; u.pm = w / 6; u.pn = w % 6; } else { const int w2 = w - 390; u.a = 1; u.pm = w2 & 1; u.pn = w2 >> 1; } u.b = 0; }
  __device__ __forceinline__ const char* baseA(const Unit& u) const { return (const char*)ws + (u.a == 0 ? WS_A0 : WS_WIN_T + (size_t)1536 * 2048); }
  __device__ __forceinline__ const char* baseB(const Unit& u) const { return (const char*)ws + (u.a == 0 ? WS_WIN_T : WS_A0); }
  __device__ __forceinline__ unsigned rowA(const Unit& u, int r) const { return (unsigned)(u.pm * 256 + r) * 2048u; }
  __device__ __forceinline__ unsigned rowB(const Unit& u, int r) const { return (unsigned)(u.pn * 256 + r) * 2048u; }
  __device__ __forceinline__ void epi(const Acc& acc, const Unit& u, int wr, int wc, int fr, int fq) const {
    if (u.a == 1) {
      bf16_t* VT = (bf16_t*)(ws + WS_VT);
#pragma unroll
      for (int ai = 0; ai < 2; ++ai)
#pragma unroll
        for (int m = 0; m < 4; ++m) { const int dd = u.pm * 256 + ai * 128 + wr * 64 + m * 16 + fr, head = dd >> 6, d = dd & 63;
#pragma unroll
          for (int bj = 0; bj < 2; ++bj) { const int t0 = u.pn * 256 + bj * 128 + wc * 32 + 8 * fq, kr = t0 >> 6, cg = (t0 >> 3) & 7;
            *(u32x4*)((VT + ((((size_t)(head * 260 + kr) * 8 + cg) * 64 + d) * 8))) = pack8(acc[ai][bj][m][0], acc[ai][bj][m][1]); } }
      return;
    }
    if (u.pn < 2) {
      bf16_t* AS5 = (bf16_t*)(ws + WS_AS5);
#pragma unroll
      for (int ai = 0; ai < 2; ++ai)
#pragma unroll
        for (int m = 0; m < 4; ++m) { const int row = u.pm * 256 + ai * 128 + wr * 64 + m * 16 + fr; int crow, s;
          if (row < TOK) { crow = row >> 5; s = row & 31; } else { const int j = row - TOK; crow = 512 + (j >> 5); s = j & 31; }
#pragma unroll
          for (int bj = 0; bj < 2; ++bj) { const int g = 16 * u.pn + 8 * bj + 2 * wc + (fq >> 1), c0 = 8 * (fq & 1);
            *(u32x4*)((AS5 + ((size_t)(g * 768 + crow) * 768 + s * 16 + c0))) = pack8(acc[ai][bj][m][0], acc[ai][bj][m][1]); } }
      return;
    }
    const bool isq = u.pn < 4;
    if (isq && u.pm == 64) return;
    const int head = 4 * ((u.pn - 2) & 1) + wc; const float* gain = isq ? qg : kg;
    bf16_t* dst = isq ? (bf16_t*)(ws + WS_Q) : (bf16_t*)(ws + WS_K);
    f32x4 gv[2][2];
#pragma unroll
    for (int bj = 0; bj < 2; ++bj) { gv[bj][0] = *(const f32x4*)(gain + 32 * bj + 8 * fq); gv[bj][1] = *(const f32x4*)(gain + 32 * bj + 8 * fq + 4); }
#pragma unroll
    for (int ai = 0; ai < 2; ++ai)
#pragma unroll
      for (int m = 0; m < 4; ++m) { const int row = u.pm * 256 + ai * 128 + wr * 64 + m * 16 + fr; float ss = 0.f;
#pragma unroll
        for (int bj = 0; bj < 2; ++bj)
#pragma unroll
          for (int n = 0; n < 2; ++n) { const f32x4 x = acc[ai][bj][m][n]; ss += (x[0] * x[0] + x[1] * x[1]) + (x[2] * x[2] + x[3] * x[3]); }
        ss += sx(ss, 16); ss += sx(ss, 32);
        const float rinv = rsqrtf(ss * (1.f / 64.f) + 1e-6f);
#pragma unroll
        for (int bj = 0; bj < 2; ++bj) { const f32x4 v0 = acc[ai][bj][m][0] * rinv * gv[bj][0], v1 = acc[ai][bj][m][1] * rinv * gv[bj][1];
          if (isq) *(u32x4*)((dst + (size_t)row * 512 + head * 64 + 32 * bj + 8 * fq)) = pack8(v0, v1);
          else { const int kr = row >> 6, cg = (row >> 3) & 7, k8 = row & 7, ks = 2 * bj + (fq >> 1), hh2 = fq & 1;
            *(u32x4*)((dst + (((((size_t)(head * 260 + kr) * 8 + cg) * 4 + ks) * 8 + k8) * 2 + hh2) * 8)) = pack8(v0, v1); } } }
  }
};

struct G2 {
  static constexpr bool PERM = true; static constexpr bool F8 = false; static constexpr int SCALE_B = 0x7A7A7A7A; static constexpr bool CONTIG = false; static constexpr bool ALIGN = true; static constexpr bool LINA = true, LINB = true; __device__ __forceinline__ size_t halfA() const { return 128u * 1536u; } __device__ __forceinline__ size_t halfB() const { return 128u * 1024u; } int K, nunits; unsigned char* ws;
  __device__ __forceinline__ void decode(int w, Unit& u) const { u.a = w / 3; u.pm = w % 3; u.pn = 0; u.b = 0; }
  __device__ __forceinline__ const char* baseA(const Unit& u) const { return (const char*)ws + WS_AS5 + (size_t)u.a * 768 * 768 * 2; }
  __device__ __forceinline__ const char* baseB(const Unit& u) const { return (const char*)ws + WS_WS + (size_t)u.a * 256 * 512 * 2; }
  __device__ __forceinline__ unsigned rowA(const Unit& u, int r) const { return (unsigned)(u.pm * 256 + r) * 1536u; }
  __device__ __forceinline__ unsigned rowB(const Unit& u, int r) const { return (unsigned)r * 1024u; }
  __device__ __forceinline__ void epi(const Acc& acc, const Unit& u, int wr, int wc, int fr, int fq) const {
    float* SST = (float*)(ws + WS_SST) + (size_t)u.a * 768 * 256;
#pragma unroll
    for (int ai = 0; ai < 2; ++ai)
#pragma unroll
      for (int m = 0; m < 4; ++m) { const int crow = u.pm * 256 + ai * 128 + wr * 64 + m * 16 + fr; if (crow >= 520) continue;
#pragma unroll
        for (int bj = 0; bj < 2; ++bj) { float* p = SST + (size_t)crow * 256 + bj * 128 + wc * 32 + 8 * fq; *(f32x4*)p = acc[ai][bj][m][0]; *(f32x4*)(p + 4) = acc[ai][bj][m][1]; } }
  }
};

struct G3 {
  static constexpr bool PERM = true; static constexpr bool F8 = false; static constexpr int SCALE_B = 0x7A7A7A7A; static constexpr bool CONTIG = false; static constexpr bool ALIGN = true; static constexpr bool LINA = true, LINB = true; __device__ __forceinline__ size_t halfA() const { return 128u * 1536u; } __device__ __forceinline__ size_t halfB() const { return 128u * 1536u; } int K, nunits; unsigned char* ws;
  __device__ __forceinline__ void decode(int w, Unit& u) const { u.a = w >> 2; u.pm = (w >> 1) & 1; u.pn = w & 1; u.b = 0; }
  __device__ __forceinline__ const char* baseA(const Unit& u) const { return (const char*)ws + WS_AS5 + (size_t)u.a * 768 * 768 * 2; }
  __device__ __forceinline__ const char* baseB(const Unit& u) const { return (const char*)ws + WS_TT + (size_t)u.a * 512 * 768 * 2; }
  __device__ __forceinline__ unsigned rowA(const Unit& u, int r) const { return (unsigned)(u.pm * 256 + r) * 1536u; }
  __device__ __forceinline__ unsigned rowB(const Unit& u, int r) const { return (unsigned)(u.pn * 256 + r) * 1536u; }
  __device__ __forceinline__ void epi(const Acc& acc, const Unit& u, int wr, int wc, int fr, int fq) const {
    bf16_t* GB = (bf16_t*)(ws + WS_GB);
#pragma unroll
    for (int ai = 0; ai < 2; ++ai)
#pragma unroll
      for (int m = 0; m < 4; ++m) { const int crow = u.pm * 256 + ai * 128 + wr * 64 + m * 16 + fr;
#pragma unroll
        for (int bj = 0; bj < 2; ++bj) { const int pp = u.pn * 256 + bj * 128 + wc * 32 + 8 * fq, i = pp >> 4, c0 = pp & 15; f32x4 v0 = acc[ai][bj][m][0], v1 = acc[ai][bj][m][1];
#pragma unroll
          for (int j = 0; j < 4; ++j) { v0[j] = gelu_tanh(v0[j]); v1[j] = gelu_tanh(v1[j]); }
          *(u32x4*)((GB + (size_t)(crow * 32 + i) * 512 + u.a * 16 + c0)) = pack8(v0, v1); } }
  }
};

struct G4 {
  static constexpr bool PERM = true; static constexpr bool F8 = false; static constexpr int SCALE_B = 0x7A7A7A7A; static constexpr bool CONTIG = false; static constexpr bool ALIGN = true; static constexpr bool LINA = true, LINB = true; __device__ __forceinline__ size_t halfA() const { return 128u * 1024u; } __device__ __forceinline__ size_t halfB() const { return 128u * 1024u; } int K, nunits; unsigned char* ws; const float* bglu;
  __device__ __forceinline__ void decode(int w, Unit& u) const { u.pm = w >> 1; u.pn = w & 1; u.a = 0; u.b = 0; }
  __device__ __forceinline__ const char* baseA(const Unit&) const { return (const char*)ws + WS_GB; }
  __device__ __forceinline__ const char* baseB(const Unit&) const { return (const char*)ws + WS_WGLU_T; }
  __device__ __forceinline__ unsigned rowA(const Unit& u, int r) const { return (unsigned)(u.pm * 256 + r) * 1024u; }
  __device__ __forceinline__ unsigned rowB(const Unit& u, int r) const { return (unsigned)(u.pn * 256 + r) * 1024u; }
  __device__ __forceinline__ void epi(const Acc& acc, const Unit& u, int wr, int wc, int fr, int fq) const {
    const bf16_t* GB = (const bf16_t*)(ws + WS_GB); bf16_t* CC = (bf16_t*)(ws + WS_CONCAT);
#pragma unroll
    for (int bj = 0; bj < 2; ++bj) { const int col0 = u.pn * 256 + bj * 128 + wc * 32 + 8 * fq; const f32x4 b0 = *(const f32x4*)(bglu + col0), b1 = *(const f32x4*)(bglu + col0 + 4);
      u32x4 gin[2][4];
#pragma unroll
      for (int ai = 0; ai < 2; ++ai)
#pragma unroll
        for (int m = 0; m < 4; ++m) gin[ai][m] = *(const u32x4*)(GB + (size_t)(u.pm * 256 + ai * 128 + wr * 64 + m * 16 + fr) * 512 + col0);
#pragma unroll
      for (int ai = 0; ai < 2; ++ai)
#pragma unroll
        for (int m = 0; m < 4; ++m) { const int row = u.pm * 256 + ai * 128 + wr * 64 + m * 16 + fr; const u32x4 gw = gin[ai][m];
          f32x4 v0 = acc[ai][bj][m][0] + b0, v1 = acc[ai][bj][m][1] + b1;
          v0[0] = bf_lo(gw.x) * fast_sigmoid(v0[0]); v0[1] = bf_hi(gw.x) * fast_sigmoid(v0[1]); v0[2] = bf_lo(gw.y) * fast_sigmoid(v0[2]); v0[3] = bf_hi(gw.y) * fast_sigmoid(v0[3]);
          v1[0] = bf_lo(gw.z) * fast_sigmoid(v1[0]); v1[1] = bf_hi(gw.z) * fast_sigmoid(v1[1]); v1[2] = bf_lo(gw.w) * fast_sigmoid(v1[2]); v1[3] = bf_hi(gw.w) * fast_sigmoid(v1[3]);
          *(u32x4*)((CC + (size_t)row * 1024 + col0)) = pack8(v0, v1); } }
  }
};

struct GRes {
  static constexpr bool PERM = true; static constexpr bool F8 = false; static constexpr int SCALE_B = 0x7A7A7A7A; static constexpr bool CONTIG = false; static constexpr bool ALIGN = true; static constexpr bool LINA = true, LINB = true;
  __device__ __forceinline__ size_t halfA() const { return 128u * 2048u; } __device__ __forceinline__ size_t halfB() const { return 128u * 2048u; }
  int K, nunits; const char* A; const char* Bt; const float* hin32; const bf16_t* hin16; bf16_t* hout; const float* gate; const float* bias;
  __device__ __forceinline__ void decode(int w, Unit& u) const { u.pm = w >> 2; u.pn = w & 3; u.a = 0; u.b = 0; }
  __device__ __forceinline__ const char* baseA(const Unit&) const { return A; }
  __device__ __forceinline__ const char* baseB(const Unit&) const { return Bt; }
  __device__ __forceinline__ unsigned rowA(const Unit& u, int r) const { return (unsigned)(u.pm * 256 + r) * 2048u; }
  __device__ __forceinline__ unsigned rowB(const Unit& u, int r) const { return (unsigned)(u.pn * 256 + r) * 2048u; }
  __device__ __forceinline__ void epi(const Acc& acc, const Unit& u, int wr, int wc, int fr, int fq) const {
#pragma unroll
    for (int bj = 0; bj < 2; ++bj) { const int col0 = u.pn * 256 + bj * 128 + wc * 32 + 8 * fq;
      const f32x4 g0 = *(const f32x4*)(gate + col0), g1 = *(const f32x4*)(gate + col0 + 4);
      f32x4 b0 = (f32x4){0.f, 0.f, 0.f, 0.f}, b1 = b0; if (bias) { b0 = *(const f32x4*)(bias + col0); b1 = *(const f32x4*)(bias + col0 + 4); }
      if (hin32) { f32x4 hi[2][4][2];
#pragma unroll
        for (int ai = 0; ai < 2; ++ai)
#pragma unroll
          for (int m = 0; m < 4; ++m) { const size_t off = (size_t)(u.pm * 256 + ai * 128 + wr * 64 + m * 16 + fr) * 1024 + col0; hi[ai][m][0] = *(const f32x4*)(hin32 + off); hi[ai][m][1] = *(const f32x4*)(hin32 + off + 4); }
#pragma unroll
        for (int ai = 0; ai < 2; ++ai)
#pragma unroll
          for (int m = 0; m < 4; ++m) { const size_t off = (size_t)(u.pm * 256 + ai * 128 + wr * 64 + m * 16 + fr) * 1024 + col0;
            *(u32x4*)(hout + off) = pack8(hi[ai][m][0] + g0 * (acc[ai][bj][m][0] + b0), hi[ai][m][1] + g1 * (acc[ai][bj][m][1] + b1)); }
      } else { u32x4 hi[2][4];
#pragma unroll
        for (int ai = 0; ai < 2; ++ai)
#pragma unroll
          for (int m = 0; m < 4; ++m) hi[ai][m] = *(const u32x4*)(hin16 + (size_t)(u.pm * 256 + ai * 128 + wr * 64 + m * 16 + fr) * 1024 + col0);
#pragma unroll
        for (int ai = 0; ai < 2; ++ai)
#pragma unroll
          for (int m = 0; m < 4; ++m) { const size_t off = (size_t)(u.pm * 256 + ai * 128 + wr * 64 + m * 16 + fr) * 1024 + col0; const u32x4 w = hi[ai][m];
            const f32x4 h0 = (f32x4){bf_lo(w.x), bf_hi(w.x), bf_lo(w.y), bf_hi(w.y)}, h1 = (f32x4){bf_lo(w.z), bf_hi(w.z), bf_lo(w.w), bf_hi(w.w)};
            *(u32x4*)(hout + off) = pack8(h0 + g0 * (acc[ai][bj][m][0] + b0), h1 + g1 * (acc[ai][bj][m][1] + b1)); }
      } }
  }
};

__device__ __forceinline__ void build_moetab(const Ctx& X, int layer, LAS int* toff) {
  const unsigned* cnt = (const unsigned*)(X.ws + WS_CTL) + CW_CNT + layer * 2048;
  LAS int* texp = toff + 256;
  LAS int* ntile = toff + 132;
  __syncthreads();
  if (X.tid < 64) ntile[X.tid] = ((int)__hip_atomic_load(cnt + X.tid * 32, __ATOMIC_RELAXED, __HIP_MEMORY_SCOPE_AGENT) + 255) >> 8;
  __syncthreads();
  if (X.tid == 0) { int s = 0; for (int e = 0; e < 64; ++e) { toff[e] = s; s += ntile[e]; } toff[64] = s; toff[65] = s + 64; }
  __syncthreads();
  if (X.tid < 65) { const int e = X.tid; const int lo = toff[e], hi = toff[e + 1]; for (int t = lo; t < hi && t < 704; ++t) texp[t] = e; }
  __syncthreads();
}
__device__ __forceinline__ int find_expert(const LAS int* toff, int ti) { return toff[256 + ti]; }

struct G6 {
  static constexpr bool PERM = true; static constexpr bool F8 = true; static constexpr int SCALE_B = 0x7A7A7A7A; static constexpr bool CONTIG = false; static constexpr bool ALIGN = true; static constexpr bool LINA = false, LINB = true;
  __device__ __forceinline__ size_t halfA() const { return 0; } __device__ __forceinline__ size_t halfB() const { return 128u * 1024u; }
  int K, nunits; unsigned char* ws; const LAS int* toff; const LAS unsigned* tokt; const char* wbase; size_t wstride;
  __device__ __forceinline__ void decode(int w, Unit& u) const { const int ti = w >> 1; u.pn = w & 1; u.a = find_expert(toff, ti); u.pm = ti - toff[u.a]; u.b = ti; }
  __device__ __forceinline__ const char* baseA(const Unit&) const { return (const char*)ws + WS_F; }
  __device__ __forceinline__ const char* baseB(const Unit& u) const { return wbase + (size_t)u.a * wstride; }
  __device__ __forceinline__ unsigned rowA(const Unit& u, int r) const { return tokt[u.ord * 256 + r]; }
  __device__ __forceinline__ void build_tokt(const Ctx& X, LAS unsigned* tk) const {
    for (int i = 0; i * X.G + X.c < nunits; ++i) { Unit u; decode(xcd_remap(i * X.G + X.c, nunits), u);
      if (X.tid < 256) { const int idx = u.pm * 256 + X.tid; int tok = idx;
        if (u.a < 64) tok = ((const int*)(ws + WS_LTOK))[u.a * 16384 + idx];
        tk[i * 256 + X.tid] = (unsigned)tok * 1024u; } }
    __syncthreads();
  }
  __device__ __forceinline__ unsigned rowB(const Unit& u, int r) const { return (unsigned)(u.pn * 256 + r) * 1024u; }
  __device__ __forceinline__ void epi(const Acc& acc, const Unit& u, int wr, int wc, int fr, int fq) const {
    bf16_t* HID = (bf16_t*)(ws + WS_HID);
#pragma unroll
    for (int ai = 0; ai < 2; ++ai)
#pragma unroll
      for (int m = 0; m < 4; ++m) { const size_t hrow = (size_t)u.b * 256 + ai * 128 + wr * 64 + m * 16 + fr; f32x4 v0, v1;
#pragma unroll
        for (int j = 0; j < 4; ++j) { const float g0 = acc[ai][0][m][0][j] * 0.03125f, g1 = acc[ai][0][m][1][j] * 0.03125f; v0[j] = g0 * fast_sigmoid(g0) * (acc[ai][1][m][0][j] * 0.03125f); v1[j] = g1 * fast_sigmoid(g1) * (acc[ai][1][m][1][j] * 0.03125f); }
        *(u32x4*)((HID + hrow * 256 + u.pn * 128 + wc * 32 + 8 * fq)) = pack8(v0, v1); }
  }
};
struct G7 {
  static constexpr bool PERM = true; static constexpr bool F8 = false; static constexpr int SCALE_B = 0x7A7A7A7A; static constexpr bool CONTIG = false; static constexpr bool ALIGN = true; static constexpr bool LINA = true, LINB = true;
  __device__ __forceinline__ size_t halfA() const { return 128u * 512u; } __device__ __forceinline__ size_t halfB() const { return 128u * 512u; }
  int K, nunits; unsigned char* ws; const LAS int* toff; const char* wbase; size_t wstride;
  __device__ __forceinline__ void decode(int w, Unit& u) const { const int ti = w >> 2; u.pn = w & 3; u.a = find_expert(toff, ti); u.pm = ti - toff[u.a]; u.b = ti; }
  __device__ __forceinline__ const char* baseA(const Unit&) const { return (const char*)ws + WS_HID; }
  __device__ __forceinline__ const char* baseB(const Unit& u) const { return wbase + (size_t)u.a * wstride; }
  __device__ __forceinline__ unsigned rowA(const Unit& u, int r) const { return (unsigned)(u.b * 256 + r) * 512u; }
  __device__ __forceinline__ unsigned rowB(const Unit& u, int r) const { return (unsigned)(u.pn * 256 + r) * 512u; }
  __device__ __forceinline__ void epi(const Acc& acc, const Unit& u, int wr, int wc, int fr, int fq) const {
    unsigned char* YAS = ws + WS_YAS;
#pragma unroll
    for (int ai = 0; ai < 2; ++ai)
#pragma unroll
      for (int m = 0; m < 4; ++m) { const size_t yrow = (size_t)u.b * 256 + ai * 128 + wr * 64 + m * 16 + fr;
#pragma unroll
        for (int bj = 0; bj < 2; ++bj) { const f32x4 v0 = acc[ai][bj][m][0], v1 = acc[ai][bj][m][1];
          const int w0 = pack4_fp8(v0[0], v0[1], v0[2], v0[3]), w1 = pack4_fp8(v1[0], v1[1], v1[2], v1[3]);
          *(u32x2*)(YAS + yrow * 1024 + u.pn * 256 + bj * 128 + wc * 32 + 8 * fq) = (u32x2){(unsigned)w0, (unsigned)w1}; } }
  }
};

struct G8 {
  static constexpr bool PERM = true; static constexpr bool F8 = false; static constexpr int SCALE_B = 0x7A7A7A7A; static constexpr bool CONTIG = false; static constexpr bool ALIGN = true; static constexpr bool LINA = true, LINB = false; __device__ __forceinline__ size_t halfA() const { return 128u * 512u; } __device__ __forceinline__ size_t halfB() const { return 0; } int K, nunits; unsigned char* ws;
  __device__ __forceinline__ void decode(int w, Unit& u) const { u.pm = 0; u.a = (w >> 6) & 3; u.pn = w & 63; u.b = 0; }
  __device__ __forceinline__ const char* baseA(const Unit&) const { return (const char*)ws + WS_DMT; }
  __device__ __forceinline__ const char* baseB(const Unit& u) const { return (const char*)ws + WS_A1 + (size_t)u.a * 512; }
  __device__ __forceinline__ unsigned rowA(const Unit&, int r) const { return (unsigned)r * 512u; }
  __device__ __forceinline__ unsigned rowB(const Unit& u, int r) const { const int n = u.pn * 256 + r; return (unsigned)(128 * (n & 127) + (n >> 7)) * 2048u; }
  __device__ __forceinline__ void epi(const Acc& acc, const Unit& u, int wr, int wc, int fr, int fq) const {
    bf16_t* X1 = (bf16_t*)(ws + WS_X1);
#pragma unroll
    for (int ai = 0; ai < 2; ++ai)
#pragma unroll
      for (int m = 0; m < 4; ++m) { const int mm = wr * 64 + m * 16 + fr;
#pragma unroll
        for (int bj = 0; bj < 2; ++bj) { const int n0 = u.pn * 256 + bj * 128 + wc * 32 + 8 * fq, tb = n0 >> 7, ta0 = n0 & 127;
          *(u32x4*)((X1 + ((((size_t)(u.a * 128 + mm) * 128 + tb) * 2 + ai) * 128 + ta0))) = pack8(acc[ai][bj][m][0], acc[ai][bj][m][1]); } }
  }
};
struct G9 {
  static constexpr bool PERM = true; static constexpr bool F8 = false; static constexpr int SCALE_B = 0x7A7A7A7A; static constexpr bool CONTIG = false; static constexpr bool ALIGN = true; static constexpr bool LINA = true, LINB = true; __device__ __forceinline__ size_t halfA() const { return 128u * 512u; } __device__ __forceinline__ size_t halfB() const { return 128u * 512u; } int K, nunits; unsigned char* ws;
  __device__ __forceinline__ void decode(int w, Unit& u) const { u.pm = 0; u.pn = w; u.a = 0; u.b = 0; }
  __device__ __forceinline__ const char* baseA(const Unit&) const { return (const char*)ws + WS_W1; }
  __device__ __forceinline__ const char* baseB(const Unit&) const { return (const char*)ws + WS_X1; }
  __device__ __forceinline__ unsigned rowA(const Unit&, int r) const { return (unsigned)r * 512u; }
  __device__ __forceinline__ unsigned rowB(const Unit& u, int r) const { return (unsigned)(u.pn * 256 + r) * 512u; }
  __device__ __forceinline__ void epi(const Acc& acc, const Unit& u, int wr, int wc, int fr, int fq) const {
    bf16_t* X2 = (bf16_t*)(ws + WS_X2);
#pragma unroll
    for (int m = 0; m < 4; ++m) { const int ka = wr * 64 + m * 16 + fr;
#pragma unroll
      for (int bj = 0; bj < 2; ++bj) { const int n0 = u.pn * 256 + bj * 128 + wc * 32 + 8 * fq, gm = n0 >> 7, tb0 = n0 & 127; f32x4 r0, r1, i0, i1;
#pragma unroll
        for (int j = 0; j < 4; ++j) {
          { const float ang = (float)((ka * (tb0 + j)) & 16383) * (1.f / 16384.f), cs = __builtin_amdgcn_cosf(ang), sn = __builtin_amdgcn_sinf(ang); const float yr = acc[0][bj][m][0][j], yi = acc[1][bj][m][0][j]; r0[j] = yr * cs + yi * sn; i0[j] = yi * cs - yr * sn; }
          { const float ang = (float)((ka * (tb0 + 4 + j)) & 16383) * (1.f / 16384.f), cs = __builtin_amdgcn_cosf(ang), sn = __builtin_amdgcn_sinf(ang); const float yr = acc[0][bj][m][1][j], yi = acc[1][bj][m][1][j]; r1[j] = yr * cs + yi * sn; i1[j] = yi * cs - yr * sn; } }
        bf16_t* p = X2 + (((size_t)(gm * 128 + ka) * 2) * 128 + tb0); *(u32x4*)(p) = pack8(r0, r1); *(u32x4*)((p + 128)) = pack8(i0, i1); } }
  }
};
struct G10 {
  static constexpr bool PERM = true; static constexpr bool F8 = false; static constexpr int SCALE_B = 0x7A7A7A7A; static constexpr bool CONTIG = false; static constexpr bool ALIGN = true; static constexpr bool LINA = true, LINB = false; __device__ __forceinline__ size_t halfA() const { return 128u * 512u; } __device__ __forceinline__ size_t halfB() const { return 0; } int K, nunits; unsigned char* ws;
  __device__ __forceinline__ void decode(int w, Unit& u) const { u.pm = 0; u.pn = w; u.a = 0; u.b = 0; }
  __device__ __forceinline__ const char* baseA(const Unit&) const { return (const char*)ws + WS_W2; }
  __device__ __forceinline__ const char* baseB(const Unit&) const { return (const char*)ws + WS_X2; }
  __device__ __forceinline__ unsigned rowA(const Unit&, int r) const { return (unsigned)r * 512u; }
  __device__ __forceinline__ unsigned rowB(const Unit& u, int r) const { const int n = u.pn * 256 + r, ka = n >> 9, gm = n & 511; return (unsigned)(gm * 128 + ka) * 512u; }
  __device__ __forceinline__ void epi(const Acc& acc, const Unit& u, int wr, int wc, int fr, int fq) const {
    bf16_t* FB = (bf16_t*)(ws + WS_FB); float2* SPC = (float2*)(ws + WS_SPC); const int ka = u.pn >> 1;
#pragma unroll
    for (int m = 0; m < 4; ++m) { const int kb = wr * 64 + m * 16 + fr; const int k = ka + 128 * kb, kmir = (16384 - k) & 16383;
#pragma unroll
      for (int bj = 0; bj < 2; ++bj) { const int gm0 = (u.pn & 1) * 256 + bj * 128 + wc * 32 + 8 * fq, d0 = (gm0 >> 7) * 128 + (gm0 & 127); const u32x4 o = pack8(acc[0][bj][m][0], acc[0][bj][m][1]);
        *(u32x4*)(FB + (size_t)k * 1024 + d0) = o; *(u32x4*)(FB + (size_t)kmir * 1024 + 512 + d0) = o;
        if ((gm0 & 127) == 0) SPC[k * 4 + (gm0 >> 7)] = make_float2(acc[0][bj][m][0][0], acc[1][bj][m][0][0]); } }
  }
};
}
namespace mk {
typedef float f32x16 __attribute__((ext_vector_type(16)));

__device__ __forceinline__ void phase_scan(const Ctx& X) {
  if (X.c >= 64) return;
  const int ch = X.c * 64 + (X.tid & 63), seg = X.tid >> 6;
  const int g = ch >> 7, dir = (ch >> 6) & 1, p = ch & 63;
  const float2 lam = ((const float2*)(X.ws + WS_LAML))[(dir * 32 + g) * 64 + p];
  const float* S = (const float*)(X.ws + WS_SST) + (size_t)g * 768 * 256 + dir * 128 + p;
  bf16_t* XP = (bf16_t*)(X.ws + WS_AS5) + (size_t)g * 768 * 768 + 512 + dir * 128 + p;
  LAS float* EX = (LAS float*)X.lds;
  const int j0 = seg * 65;
  float xr = 0.f, xi = 0.f;
  for (int b = 0; b < 65; b += 13) {
    float sr[13], si[13];
#pragma unroll
    for (int k = 0; k < 13; ++k) { const int j = j0 + b + k; const int row = dir == 0 ? (j < 8 ? 512 + j : j - 8) : 519 - j; sr[k] = S[(size_t)row * 256]; si[k] = S[(size_t)row * 256 + 64]; }
#pragma unroll
    for (int k = 0; k < 13; ++k) { const float nr = lam.x * xr - lam.y * xi + sr[k], ni = lam.x * xi + lam.y * xr + si[k]; xr = nr; xi = ni; }
  }
  EX[(seg * 64 + (X.tid & 63)) * 2] = xr; EX[(seg * 64 + (X.tid & 63)) * 2 + 1] = xi;
  float pr = 1.f, pi = 0.f;
  for (int k = 0; k < 65; ++k) { const float nr = pr * lam.x - pi * lam.y, ni = pr * lam.y + pi * lam.x; pr = nr; pi = ni; }
  __syncthreads();
  float cr = 0.f, ci = 0.f;
  for (int s2 = 0; s2 < seg; ++s2) { const float er = EX[(s2 * 64 + (X.tid & 63)) * 2], ei = EX[(s2 * 64 + (X.tid & 63)) * 2 + 1];
    const float nr = pr * cr - pi * ci + er, ni = pr * ci + pi * cr + ei; cr = nr; ci = ni; }
  xr = cr; xi = ci;
  for (int b = 0; b < 65; b += 13) {
    float sr[13], si[13];
#pragma unroll
    for (int k = 0; k < 13; ++k) { const int j = j0 + b + k; const int row = dir == 0 ? (j < 8 ? 512 + j : j - 8) : 519 - j; sr[k] = S[(size_t)row * 256]; si[k] = S[(size_t)row * 256 + 64]; }
#pragma unroll
    for (int k = 0; k < 13; ++k) { const int j = j0 + b + k; const int row = dir == 0 ? (j < 8 ? 512 + j : j - 8) : 519 - j;
      XP[(size_t)row * 768] = f2bf(xr); XP[(size_t)row * 768 + 64] = f2bf(xi);
      const float nr = lam.x * xr - lam.y * xi + sr[k], ni = lam.x * xi + lam.y * xr + si[k]; xr = nr; xi = ni; }
  }
  __syncthreads();
}

__device__ __forceinline__ void zero_lists(const Ctx& X) {
  u32x4* z = (u32x4*)(X.ws + WS_LTOK); unsigned zu_ = 0u; asm volatile("" : "+v"(zu_)); const u32x4 zero = (u32x4){zu_, zu_, zu_, zu_};
  for (int i = X.c * NTHR + X.tid; i < (int)(4 * MiB / 16); i += X.G * NTHR) z[i] = zero;
}
#define MFMA32(a, b, c) __builtin_amdgcn_mfma_f32_32x32x16_bf16((a), (b), (c), 0, 0, 0)
__device__ __forceinline__ void attn_unit(const Ctx& X, const LAS float* rpbl, int head, int tile) {
  const bf16_t* Q = (const bf16_t*)(X.ws + WS_Q); const bf16_t* Kb = (const bf16_t*)(X.ws + WS_K); const bf16_t* VT = (const bf16_t*)(X.ws + WS_VT);
  bf16_t* CCt = (bf16_t*)(X.ws + WS_CONCAT);
  const int lane = X.lane, ql = lane & 31, hh = lane >> 5;
  const int rp = tile >> 2, mt = tile & 3;
  const int r = 2 * rp + (ql >> 4), cq = 16 * mt + (ql & 15), tq = r * 64 + cq;
  const int r0q = min(max(r - 4, 0), 248), csq = min(max(cq - 8, 0), 48);
  const int rlo = min(max(2 * rp - 4, 0), 248), rhi = min(max(2 * rp - 3, 0), 248) + 7;
  const int csb = min(max(16 * mt - 8, 0), 32);
  const int nloc = rhi - rlo + 1;
  unsigned cmask = 0u;
#pragma unroll
  for (int k = 0; k < 32; ++k) cmask |= ((csb + k >= csq) && (csb + k <= csq + 15)) ? (1u << k) : 0u;
  bf16x8 qf[4];
#pragma unroll
  for (int ks = 0; ks < 4; ++ks) qf[ks] = *(const bf16x8*)(Q + (size_t)tq * 512 + head * 64 + 16 * ks + 8 * hh);
  const int kperm = (ql & ~12) | ((ql & 4) << 1) | ((ql & 8) >> 1);
  f32x16 o0, o1;
#pragma unroll
  for (int i = 0; i < 16; ++i) { o0[i] = 0.f; o1[i] = 0.f; }
  float lsum = 0.f;
  const float c1 = 0.125f * 1.44269504f, c2 = 8.f * 1.44269504f;
  const float* rp_h = nullptr; (void)rp_h;
  const size_t koff_lane = (size_t)(((kperm >> 3) * 4 * 8 + (kperm & 7)) * 2 + hh) * 8;
  const size_t voff_lane = (size_t)(hh * 64 + ql) * 8;
  bf16x8 kf[4], vf[2][2];
  { const int kr0 = rlo, cg0 = csb >> 3;
    const bf16_t* kp = Kb + ((size_t)(head * 260 + kr0) * 8 + cg0) * 512 + koff_lane; const bf16_t* vp = VT + ((size_t)(head * 260 + kr0) * 8 + cg0) * 512 + voff_lane;
#pragma unroll
    for (int ks = 0; ks < 4; ++ks) kf[ks] = *(const bf16x8*)(kp + ks * 128);
#pragma unroll
    for (int db = 0; db < 2; ++db)
#pragma unroll
      for (int s2 = 0; s2 < 2; ++s2) vf[db][s2] = *(const bf16x8*)(vp + db * 256 + s2 * 1024); }
  for (int b = 0; b < nloc + 8; ++b) {
    const bool loc = b < nloc;
    const int kr = rlo + b;
    bf16x8 kc[4], vc[2][2];
#pragma unroll
    for (int ks = 0; ks < 4; ++ks) kc[ks] = kf[ks];
#pragma unroll
    for (int db = 0; db < 2; ++db)
#pragma unroll
      for (int s2 = 0; s2 < 2; ++s2) vc[db][s2] = vf[db][s2];
    if (b + 1 < nloc + 8) { const int bn = b + 1; const int krn = bn < nloc ? rlo + bn : 256 + ((bn - nloc) >> 1), cgn = bn < nloc ? (csb >> 3) : 4 * ((bn - nloc) & 1);
      const bf16_t* kp = Kb + ((size_t)(head * 260 + krn) * 8 + cgn) * 512 + koff_lane; const bf16_t* vp = VT + ((size_t)(head * 260 + krn) * 8 + cgn) * 512 + voff_lane;
#pragma unroll
      for (int ks = 0; ks < 4; ++ks) kf[ks] = *(const bf16x8*)(kp + ks * 128);
#pragma unroll
      for (int db = 0; db < 2; ++db)
#pragma unroll
        for (int s2 = 0; s2 < 2; ++s2) vf[db][s2] = *(const bf16x8*)(vp + db * 256 + s2 * 1024); }
    f32x16 sacc;
#pragma unroll
    for (int i = 0; i < 16; ++i) sacc[i] = 0.f;
#pragma unroll
    for (int ks = 0; ks < 4; ++ks) sacc = MFMA32(kc[ks], qf[ks], sacc);
    float pv[16];
    if (loc) {
      const bool rowok = (kr >= r0q) && (kr <= r0q + 7);
      const int dr = min(max(kr - r + 7, 0), 14);
      const LAS float* bp = rpbl + (head * 15 + dr) * 31;
      const int dc0 = csb - cq + 15;
#pragma unroll
      for (int i = 0; i < 16; ++i) { const int kidx = 16 * (i >> 3) + 8 * hh + (i & 7);
        const bool ok = rowok && ((cmask >> kidx) & 1u);
        const float bias = bp[min(max(dc0 + kidx, 0), 30)];
        const float e = __builtin_amdgcn_exp2f(sacc[i] * c1 + bias * 1.44269504f - c2); pv[i] = ok ? e : 0.f; }
    } else {
#pragma unroll
      for (int i = 0; i < 16; ++i) pv[i] = __builtin_amdgcn_exp2f(sacc[i] * c1 - c2);
    }
    u32x4 p0, p1;
    p0.x = cvt_pk_bf16(pv[0], pv[1]); p0.y = cvt_pk_bf16(pv[2], pv[3]); p0.z = cvt_pk_bf16(pv[4], pv[5]); p0.w = cvt_pk_bf16(pv[6], pv[7]);
    p1.x = cvt_pk_bf16(pv[8], pv[9]); p1.y = cvt_pk_bf16(pv[10], pv[11]); p1.z = cvt_pk_bf16(pv[12], pv[13]); p1.w = cvt_pk_bf16(pv[14], pv[15]);
    lsum += (bf_lo(p0.x) + bf_hi(p0.x)) + (bf_lo(p0.y) + bf_hi(p0.y)) + (bf_lo(p0.z) + bf_hi(p0.z)) + (bf_lo(p0.w) + bf_hi(p0.w))
          + (bf_lo(p1.x) + bf_hi(p1.x)) + (bf_lo(p1.y) + bf_hi(p1.y)) + (bf_lo(p1.z) + bf_hi(p1.z)) + (bf_lo(p1.w) + bf_hi(p1.w));
    const bf16x8 pb0 = __builtin_bit_cast(bf16x8, p0), pb1 = __builtin_bit_cast(bf16x8, p1);
    o0 = MFMA32(vc[0][0], pb0, o0); o0 = MFMA32(vc[0][1], pb1, o0);
    o1 = MFMA32(vc[1][0], pb0, o1); o1 = MFMA32(vc[1][1], pb1, o1);
  }
  lsum += sx(lsum, 32);
  const float inv = 1.f / lsum;
  bf16_t* op = CCt + (size_t)tq * 1024 + 512 + head * 64 + 4 * hh;
#pragma unroll
  for (int gq = 0; gq < 4; ++gq) {
    u32x2 w0, w1;
    w0.x = cvt_pk_bf16(o0[4 * gq] * inv, o0[4 * gq + 1] * inv); w0.y = cvt_pk_bf16(o0[4 * gq + 2] * inv, o0[4 * gq + 3] * inv);
    w1.x = cvt_pk_bf16(o1[4 * gq] * inv, o1[4 * gq + 1] * inv); w1.y = cvt_pk_bf16(o1[4 * gq + 2] * inv, o1[4 * gq + 3] * inv);
    *(u32x2*)(op + 8 * gq) = w0; *(u32x2*)(op + 32 + 8 * gq) = w1;
  }
}
__device__ __forceinline__ void phase_attn(const Ctx& X) {
  LAS float* rpbl = (LAS float*)X.lds;
  zero_lists(X);
  for (int i = X.tid; i < 8 * 15 * 31; i += NTHR) rpbl[i] = X.a->in[IN_RPB][i];
  __syncthreads();
  const int gw = X.c * NWAVES + X.wave, NGW = X.G * NWAVES;
  for (int U = gw; U < 4096; U += NGW) attn_unit(X, rpbl, U >> 9, U & 511);
}

__device__ __forceinline__ void fourier_fix(const Ctx& X, int nunits) {
  const float2* SPC = (const float2*)(X.ws + WS_SPC); bf16_t* FB = (bf16_t*)(X.ws + WS_FB);
  for (int i = 0; i * X.G + X.c < nunits; ++i) { const int pm = xcd_remap(i * X.G + X.c, nunits) >> 2;
    for (int q = X.tid; q < 1024; q += NTHR) { const int k = pm * 256 + (q >> 2), g = q & 3, kmir = (16384 - k) & 16383;
      const float2 a = SPC[k * 4 + g], b = SPC[kmir * 4 + g];
      FB[(size_t)k * 1024 + g * 128] = f2bf(0.5f * (a.x + b.x)); FB[(size_t)k * 1024 + 512 + g * 128] = f2bf(0.5f * (a.y + b.y)); } }
  __syncthreads();
}

__device__ __forceinline__ void phase_router(const Ctx& X, int layer, int dry) {
  const float* mod = (const float*)(X.ws + WS_MOD) + (layer == 0 ? 0 : 2 * 6144);
  const float* shift = mod + 3072; const float* scale = mod + 4096;
  const bf16_t* h = (const bf16_t*)(X.ws + WS_HB); bf16_t* F = (bf16_t*)(X.ws + WS_F);
  unsigned* cntg = (unsigned*)(X.ws + WS_CTL) + CW_CNT + layer * 2048;
  int* ltok = (int*)(X.ws + WS_LTOK); int* asg = (int*)(X.ws + WS_ASG);
  const bf16_t* WR = (const bf16_t*)(X.ws + WS_WROUT_T) + (size_t)layer * 64 * 1024;
  const float* rbias = X.a->in[IN_RBIAS] + layer * 64;
  constexpr int FROW = 2064;
  const int lane = X.lane, wave = X.wave, tid = X.tid;
  f32x4 scv[4], shv[4]; float rb[8];
#pragma unroll
  for (int j = 0; j < 4; ++j) { scv[j] = ((const f32x4*)scale)[lane + 64 * j] + 1.f; shv[j] = ((const f32x4*)shift)[lane + 64 * j]; }
#pragma unroll
  for (int j = 0; j < 8; ++j) rb[j] = rbias[(tid & 7) * 8 + j];
  for (int tile = X.c; tile < TOK / 64; tile += X.G) {
    const int t0 = tile * 64;
    { u32x2 raw[8][4];
#pragma unroll
      for (int rr = 0; rr < 8; ++rr) { const u32x2* xr = (const u32x2*)(h + (size_t)(t0 + wave * 8 + rr) * 1024) + lane;
#pragma unroll
        for (int j = 0; j < 4; ++j) raw[rr][j] = xr[64 * j]; }
#pragma unroll
      for (int rr = 0; rr < 8; ++rr) {
        const int lr = wave * 8 + rr, t = t0 + lr; float ss = 0.f; f32x4 v[4];
#pragma unroll
        for (int j = 0; j < 4; ++j) { const u32x2 w = raw[rr][j]; v[j] = (f32x4){bf_lo(w.x), bf_hi(w.x), bf_lo(w.y), bf_hi(w.y)}; ss += (v[j].x * v[j].x + v[j].y * v[j].y) + (v[j].z * v[j].z + v[j].w * v[j].w); }
        const float r = rsqrtf(wave_sum(ss) * (1.f / 1024.f) + 1e-6f);
#pragma unroll
        for (int j = 0; j < 4; ++j) { const f32x4 f = v[j] * r * scv[j] + shv[j];
          u32x2 w; w.x = cvt_pk_bf16(f.x, f.y); w.y = cvt_pk_bf16(f.z, f.w);
          if (!dry) ((int*)((unsigned char*)F + (size_t)t * 1024))[lane + 64 * j] = pack4_fp8(f.x, f.y, f.z, f.w);
          *(LAS u32x2*)(X.lds + lr * FROW + (lane + 64 * j) * 8) = w; }
      }
    }
    __syncthreads();
    f32x4 pl[4][4];
    { const int fr = lane & 15, fq = lane >> 4;
#pragma unroll
      for (int a = 0; a < 4; ++a)
#pragma unroll
        for (int b = 0; b < 4; ++b) pl[a][b] = (f32x4){0.f, 0.f, 0.f, 0.f};
      bf16x8 bq[4][4];
#pragma unroll
      for (int ks = 0; ks < 4; ++ks)
#pragma unroll
        for (int eb = 0; eb < 4; ++eb) bq[ks][eb] = *(const bf16x8*)(WR + (size_t)(eb * 16 + fr) * 1024 + wave * 128 + ks * 32 + fq * 8);
#pragma unroll
      for (int ks = 0; ks < 4; ++ks) {
        bf16x8 af[4];
#pragma unroll
        for (int rb = 0; rb < 4; ++rb) af[rb] = *(const LAS bf16x8*)(X.lds + (rb * 16 + fr) * FROW + (wave * 128 + ks * 32 + fq * 8) * 2);
#pragma unroll
        for (int rb = 0; rb < 4; ++rb)
#pragma unroll
          for (int eb = 0; eb < 4; ++eb) pl[rb][eb] = __builtin_amdgcn_mfma_f32_16x16x32_bf16(af[rb], bq[ks][eb], pl[rb][eb], 0, 0, 0);
      }
    }
    __syncthreads();
    { LAS float* PART = (LAS float*)X.lds;
      const int fr = lane & 15, fq = lane >> 4;
#pragma unroll
      for (int rb = 0; rb < 4; ++rb)
#pragma unroll
        for (int eb = 0; eb < 4; ++eb)
#pragma unroll
          for (int j = 0; j < 4; ++j) PART[(wave * 64 + rb * 16 + 4 * fq + j) * 64 + eb * 16 + fr] = pl[rb][eb][j];
      __syncthreads();
      float sum[8];
#pragma unroll
      for (int i = 0; i < 8; ++i) { float a = 0.f;
#pragma unroll
        for (int w = 0; w < 8; ++w) a += PART[w * 4096 + i * 512 + tid];
        sum[i] = a; }
      __syncthreads();
      LAS float* LG0 = (LAS float*)X.lds;
#pragma unroll
      for (int i = 0; i < 8; ++i) { const int o = i * 512 + tid; LG0[(o >> 6) * 65 + (o & 63)] = sum[i]; }
    }
    LAS float* LG = (LAS float*)X.lds;
    LAS float* GS = LG + 64 * 65;
    LAS float* SELV = GS + 512;
    LAS int* OUTE = (LAS int*)(SELV + 4096);
    LAS float* OUTS = (LAS float*)(OUTE + 512);
    LAS int* HIST = (LAS int*)(OUTS + 512);
    LAS int* BASE = HIST + 64;
    if (tid < 64) HIST[tid] = 0;
    __syncthreads();
    const int tl = tid >> 3, grp = tid & 7;
    float v[8], sc[8];
    { float m1 = -INFINITY, m2 = -INFINITY;
#pragma unroll
      for (int j = 0; j < 8; ++j) { const float s = 1.f / (1.f + __expf(-LG[tl * 65 + grp * 8 + j])); sc[j] = s; v[j] = s + rb[j];
        if (v[j] > m1) { m2 = m1; m1 = v[j]; } else if (v[j] > m2) m2 = v[j]; }
      GS[tl * 8 + grp] = m1 + m2; }
    __syncthreads();
    bool keep;
    { const float mine = GS[tl * 8 + grp]; int rank = 0;
#pragma unroll
      for (int g2 = 0; g2 < 8; ++g2) { const float o = GS[tl * 8 + g2]; rank += (o > mine || (o == mine && g2 < grp)) ? 1 : 0; }
      keep = rank < 4;
#pragma unroll
      for (int j = 0; j < 8; ++j) SELV[tl * 64 + grp * 8 + j] = keep ? v[j] : -INFINITY; }
    __syncthreads();
    if (keep) {
      int rk[8];
#pragma unroll
      for (int j = 0; j < 8; ++j) rk[j] = 0;
      for (int e2 = 0; e2 < 64; ++e2) { const float o = SELV[tl * 64 + e2];
#pragma unroll
        for (int j = 0; j < 8; ++j) rk[j] += (o > v[j] || (o == v[j] && e2 < grp * 8 + j)) ? 1 : 0; }
#pragma unroll
      for (int j = 0; j < 8; ++j) if (rk[j] < 8) { OUTE[tl * 8 + rk[j]] = grp * 8 + j; OUTS[tl * 8 + rk[j]] = sc[j]; }
    }
    __syncthreads();
    { const int jj = tid & 7, e = OUTE[tl * 8 + jj]; const float s = OUTS[tl * 8 + jj];
      float sum = s; sum += sx(sum, 1); sum += sx(sum, 2); sum += sx(sum, 4);
      const float w = 2.5f * s / sum;
      const int sl = atomicAdd((int*)&HIST[e], 1);
      __syncthreads();
      const int t = t0 + tl;
      if (tid < 64) { const int n = HIST[tid]; BASE[tid] = (n && !dry) ? (int)atomicAdd(cntg + tid * 32, (unsigned)n) : 0; }
      __syncthreads();
      const int slot = BASE[e] + sl;
      if (!dry) { ltok[(size_t)e * 16384 + slot] = t; } if (!dry) ((int2*)asg)[t * 8 + jj] = make_int2((e << 16) | slot, __float_as_int(w)); }
    __syncthreads();
  }
}

__device__ __forceinline__ void phase_combine(const Ctx& X, int layer, const LAS int* toff, int dry) {
  const float* mod = (const float*)(X.ws + WS_MOD) + (layer == 0 ? 0 : 2 * 6144);
  const float* gffn = mod + 5120;
  const float* nmod = (const float*)(X.ws + WS_MOD) + 2 * 6144;
  float* hout32 = X.a->h; bf16_t* hb = (bf16_t*)(X.ws + WS_HB); const unsigned char* YAS = X.ws + WS_YAS; const int* asg = (const int*)(X.ws + WS_ASG); bf16_t* A1 = (bf16_t*)(X.ws + WS_A1);
  const int gw = X.c * NWAVES + X.wave, NGW = X.G * NWAVES, lane = X.lane;
  f32x4 gtv[4], nsh[4], nsc[4];
#pragma unroll
  for (int j = 0; j < 4; ++j) { gtv[j] = ((const f32x4*)gffn)[lane + 64 * j]; nsh[j] = ((const f32x4*)nmod)[lane + 64 * j]; nsc[j] = ((const f32x4*)(nmod + 1024))[lane + 64 * j] + 1.f; }
  for (int t0 = gw; t0 < TOK; t0 += 2 * NGW) {
    int yw[2][9][4]; f32x4 hv[2][4]; float wgt[2][8];
#pragma unroll
    for (int u = 0; u < 2; ++u) { const int t = t0 + u * NGW;
      int pos[9];
#pragma unroll
      for (int k = 0; k < 8; ++k) { const int2 a = ((const int2*)asg)[t * 8 + k]; pos[k] = toff[a.x >> 16] * 256 + (a.x & 0xffff); wgt[u][k] = __int_as_float(a.y); }
      pos[8] = toff[64] * 256 + t;
#pragma unroll
      for (int k = 0; k < 9; ++k) { const int* yr = (const int*)(YAS + (size_t)pos[k] * 1024) + lane;
#pragma unroll
        for (int j = 0; j < 4; ++j) yw[u][k][j] = yr[64 * j]; }
      const u32x2* hr = (const u32x2*)(hb + (size_t)t * 1024) + lane;
#pragma unroll
      for (int j = 0; j < 4; ++j) { const u32x2 w = hr[64 * j]; hv[u][j] = (f32x4){bf_lo(w.x), bf_hi(w.x), bf_lo(w.y), bf_hi(w.y)}; } }
#pragma unroll
    for (int u = 0; u < 2; ++u) { const int t = t0 + u * NGW;
      f32x4 acc[4];
#pragma unroll
      for (int j = 0; j < 4; ++j) acc[j] = (f32x4){0.f, 0.f, 0.f, 0.f};
#pragma unroll
      for (int k = 0; k < 9; ++k) { const float wk = k < 8 ? wgt[u][k] : 1.f;
#pragma unroll
        for (int j = 0; j < 4; ++j) { const int w = yw[u][k][j];
          acc[j].x += wk * __builtin_amdgcn_cvt_f32_fp8(w, 0); acc[j].y += wk * __builtin_amdgcn_cvt_f32_fp8(w, 1); acc[j].z += wk * __builtin_amdgcn_cvt_f32_fp8(w, 2); acc[j].w += wk * __builtin_amdgcn_cvt_f32_fp8(w, 3); } }
      f32x4 v[4]; float ss = 0.f;
#pragma unroll
      for (int j = 0; j < 4; ++j) { v[j] = hv[u][j] + gtv[j] * acc[j];
        if (!dry) { if (layer == 0) ((u32x2*)(hb + (size_t)t * 1024))[lane + 64 * j] = (u32x2){cvt_pk_bf16(v[j].x, v[j].y), cvt_pk_bf16(v[j].z, v[j].w)}; else ((f32x4*)(hout32 + (size_t)t * 1024))[lane + 64 * j] = v[j]; }
        ss += (v[j].x * v[j].x + v[j].y * v[j].y) + (v[j].z * v[j].z + v[j].w * v[j].w); }
      if (layer == 0) {
        const float r = rsqrtf(wave_sum(ss) * (1.f / 1024.f) + 1e-6f);
#pragma unroll
        for (int j = 0; j < 4; ++j) { const f32x4 f = v[j] * r * nsc[j] + nsh[j];
          u32x2 w; w.x = cvt_pk_bf16(f.x, f.y); w.y = cvt_pk_bf16(f.z, f.w);
          if (!dry) ((u32x2*)(A1 + (size_t)t * 1024))[lane + 64 * j] = w; }
      }
    }
  }
}

constexpr int NPHASE = 21;
template <bool SP2>
__global__ void __launch_bounds__(NTHR, 2) mk_fwd(Args args) {
  extern __shared__ __attribute__((aligned(16))) unsigned char lds_raw[];
  Ctx X; X.lds = (LAS unsigned char*)lds_raw; X.a = &args; X.ws = args.ws; X.tid = threadIdx.x; X.lane = X.tid & 63; X.wave = __builtin_amdgcn_readfirstlane(X.tid >> 6);
  X.G = gridDim.x; X.c = blockIdx.x;
  const int wave_s = X.wave;
  volatile LAS unsigned* MISC = (volatile LAS unsigned*)(X.lds + LDS_MISC_OFF);
  LAS int* TOFF = (LAS int*)(X.lds + LDS_MISC_OFF + 64);
  if (X.tid < 16) MISC[X.tid] = 0u;
  __syncthreads();
  unsigned* ctl = (unsigned*)(X.ws + WS_CTL);
  const int lo = args.ph_lo, hi = args.ph_hi;
  const bool multi = (hi - lo) > 1;
  XcdBarrier bar; bar.bar = ctl + CW_BAR; bar.x = 0; bar.st = nullptr;
  if (multi) bar = xcd_barrier_post(ctl + CW_BAR, MISC, X.tid);
  LAS unsigned char* lds = X.lds;
  unsigned char* ws = X.ws;
  const float* mod = (const float*)(ws + WS_MOD); (void)mod;
#ifndef PH_MASK
#define PH_MASK 0x1fffffull
#endif
#define IN(k) ((((unsigned long long)PH_MASK >> (k)) & 1ull) && lo <= (k) && (k) < hi)
#define SEAM(k) do { if (IN(k) && IN((k) + 1)) xcd_barrier(bar, X.tid); } while (0)
#ifndef REP_MASK
#define REP_MASK 0ull
#endif
#define REPS(k) ((int)(((unsigned long long)REP_MASK >> (k)) & 1ull))
#define FILL(ph, nb) do { if (!(args.flags & FLAG_SKIP_EXPERTS) && multi) { if (X.c < (nb)) { __syncthreads(); if (X.tid == 0) atomicAdd(ctl + CW_DONE + 64 * (ph), 1u); } \
    else transpose_work(X, ctl + CW_DQ1, 0, 0, 1, 65 * IT_EXP, ctl + CW_DONE + 64 * (ph), (unsigned)(nb)); } } while (0)
#define LAUNDER() do { int w0_ = wave_s; asm volatile("" : "+s"(w0_)); unsigned zl_ = 0u; asm volatile("" : "+v"(zl_)); int l_ = (int)__builtin_amdgcn_mbcnt_hi(~0u, __builtin_amdgcn_mbcnt_lo(~0u, zl_)); X.wave = w0_; X.lane = l_; X.tid = w0_ * 64 + l_; \
    size_t z0_ = 0; asm volatile("" : "+s"(z0_)); unsigned char* w_ = args.ws + z0_; X.ws = w_; ws = w_; mod = (const float*)(w_ + WS_MOD); } while (0)
  if (IN(0)) for (int rep_ = 0; rep_ <= REPS(0); ++rep_) { if (rep_) xcd_barrier(bar, X.tid); LAUNDER(); phase_prep(X, rep_); } SEAM(0);
#ifdef EXTRA_BARS
  if (multi) for (int eb_ = 0; eb_ < EXTRA_BARS; ++eb_) xcd_barrier(bar, X.tid);
#endif
  if (IN(1)) for (int rep_ = 0; rep_ <= REPS(1); ++rep_) { if (rep_) xcd_barrier(bar, X.tid); LAUNDER(); phase_mod0(X); } SEAM(1);
  if (IN(2)) for (int rep_ = 0; rep_ <= REPS(2); ++rep_) { if (rep_) xcd_barrier(bar, X.tid); LAUNDER(); G1 p; p.K = 1024; p.nunits = 520; p.ws = ws; p.qg = args.in[IN_QG]; p.kg = args.in[IN_KG]; gemm_phase<G1, SP2>(lds, p, X.G, X.c, X.tid); FILL(2, 8); } SEAM(2);
  if (IN(3)) for (int rep_ = 0; rep_ <= REPS(3); ++rep_) { if (rep_) xcd_barrier(bar, X.tid); LAUNDER(); G2 p; p.K = 512; p.nunits = 96; p.ws = ws; gemm_phase<G2, SP2>(lds, p, X.G, X.c, X.tid); FILL(3, 96); } SEAM(3);
  if (IN(4)) for (int rep_ = 0; rep_ <= REPS(4); ++rep_) { if (rep_) xcd_barrier(bar, X.tid); LAUNDER(); phase_scan(X); FILL(4, 64); } SEAM(4);
  if (IN(5)) for (int rep_ = 0; rep_ <= REPS(5); ++rep_) { if (rep_) xcd_barrier(bar, X.tid); LAUNDER(); G3 p; p.K = 768; p.nunits = 128; p.ws = ws; gemm_phase<G3, SP2>(lds, p, X.G, X.c, X.tid); FILL(5, 128); } SEAM(5);
  if (IN(6)) for (int rep_ = 0; rep_ <= REPS(6); ++rep_) { if (rep_) xcd_barrier(bar, X.tid); LAUNDER(); G4 p; p.K = 512; p.nunits = 128; p.ws = ws; p.bglu = args.in[IN_BGLU]; gemm_phase<G4, SP2>(lds, p, X.G, X.c, X.tid); FILL(6, 128); } SEAM(6);
  if (IN(7)) for (int rep_ = 0; rep_ <= REPS(7); ++rep_) { if (rep_) xcd_barrier(bar, X.tid); LAUNDER(); phase_attn(X); } SEAM(7);
  if (IN(8)) for (int rep_ = 0; rep_ <= REPS(8); ++rep_) { if (rep_) xcd_barrier(bar, X.tid); LAUNDER(); GRes p; p.K = 1024; p.nunits = 256; p.A = (const char*)ws + WS_CONCAT; p.Bt = (const char*)ws + WS_WMIX_T; p.hin32 = args.in[IN_X]; p.hin16 = nullptr; p.hout = (bf16_t*)(ws + WS_HB); p.gate = mod + 2048; p.bias = nullptr;
    gemm_phase<GRes, SP2>(lds, p, X.G, X.c, X.tid); } SEAM(8);
#pragma unroll 1
  for (int layer = 0; layer < 2; ++layer) {
    const int pb = layer == 0 ? 9 : 17;
    if (IN(pb)) for (int rep_ = 0; rep_ <= REPS(pb); ++rep_) { if (rep_) xcd_barrier(bar, X.tid); LAUNDER(); phase_router(X, layer, rep_); } SEAM(pb);
#ifndef ROUTER_VARIANT
#define ROUTER_VARIANT 1
#endif
#ifndef G6_VARIANT
#define G6_VARIANT 1
#endif
    if (IN(pb + 1)) for (int rep_ = REPS(pb + 1); rep_ >= 0; --rep_) { if (rep_ == 0 && REPS(pb + 1)) xcd_barrier(bar, X.tid); LAUNDER(); build_moetab(X, layer, TOFF); G6 p; p.K = 512; p.ws = ws; p.toff = TOFF; p.nunits = TOFF[65] * 2; p.wbase = (const char*)ws + (layer == 0 ? WS_WEXP : WS_WEXP1); p.wstride = layer == 0 ? EXP_STRIDE : EXP1_STRIDE;
      { LAS unsigned* tk = (LAS unsigned*)(X.lds + LDS_STAGE); p.tokt = tk; p.build_tokt(X, tk); } gemm_phase<G6, false>(lds, p, X.G, X.c, X.tid); } SEAM(pb + 1);
#ifndef G7_VARIANT
#define G7_VARIANT 1
#endif
    if (IN(pb + 2)) for (int rep_ = REPS(pb + 2); rep_ >= 0; --rep_) { if (rep_ == 0 && REPS(pb + 2)) xcd_barrier(bar, X.tid); LAUNDER(); build_moetab(X, layer, TOFF); G7 p; p.K = 256; p.ws = ws; p.toff = TOFF; p.nunits = TOFF[65] * 4; p.wbase = (const char*)ws + (layer == 0 ? WS_WEXP + EXP_DOFF : WS_WEXP1 + EXP1_DOFF); p.wstride = layer == 0 ? EXP_STRIDE : EXP1_STRIDE; gemm_phase<G7, SP2>(lds, p, X.G, X.c, X.tid); } SEAM(pb + 2);
    if (IN(pb + 3)) for (int rep_ = REPS(pb + 3); rep_ >= 0; --rep_) { if (rep_ == 0 && REPS(pb + 3)) xcd_barrier(bar, X.tid); LAUNDER(); build_moetab(X, layer, TOFF); phase_combine(X, layer, TOFF, rep_);
      if (layer == 0 && rep_ == 0 && !(args.flags & FLAG_SKIP_EXPERTS)) { __syncthreads(); transpose_work(X, ctl + CW_DQ1, 0, 0, 1, 65 * IT_EXP); } }
    if (layer == 0) {
      SEAM(12);
      if (IN(13)) for (int rep_ = 0; rep_ <= REPS(13); ++rep_) { if (rep_) xcd_barrier(bar, X.tid); LAUNDER(); G8 p; p.K = 256; p.nunits = 256; p.ws = ws; gemm_phase<G8, SP2>(lds, p, X.G, X.c, X.tid); } SEAM(13);
      if (IN(14)) for (int rep_ = 0; rep_ <= REPS(14); ++rep_) { if (rep_) xcd_barrier(bar, X.tid); LAUNDER(); G9 p; p.K = 256; p.nunits = 256; p.ws = ws; gemm_phase<G9, SP2>(lds, p, X.G, X.c, X.tid); } SEAM(14);
      if (IN(15)) for (int rep_ = 0; rep_ <= REPS(15); ++rep_) { if (rep_) xcd_barrier(bar, X.tid); LAUNDER(); G10 p; p.K = 256; p.nunits = 256; p.ws = ws; gemm_phase<G10, SP2>(lds, p, X.G, X.c, X.tid); } SEAM(15);
      if (IN(16)) { LAUNDER(); zero_lists(X); fourier_fix(X, 256); GRes p; p.K = 1024; p.nunits = 256; p.A = (const char*)ws + WS_FB; p.Bt = (const char*)ws + WS_WFOUR_T; p.hin32 = nullptr; p.hin16 = (const bf16_t*)(ws + WS_HB); p.hout = (bf16_t*)(ws + WS_HB); p.gate = mod + 2 * 6144 + 2048; p.bias = args.in[IN_BFOUR];
        gemm_phase<GRes, SP2>(lds, p, X.G, X.c, X.tid); } SEAM(16);
    }
  }
#undef IN
#undef SEAM
}
}
#ifndef MK_SP2
#define MK_SP2 true
#endif
#ifndef MK_N_LAUNCHES
#define MK_N_LAUNCHES 1
#endif
#ifndef CHECK
#define CHECK 0
#endif
static int g_grid = 0;
static bool mk_setup(int n_in, int out_size, size_t ws_size) {
  if (g_grid == 0) {
    g_grid = -1;
    if (n_in != 31 || out_size != 16384 * 1024 || ws_size < mk::WS_NEED) { fprintf(stderr, "kernel_launch: unexpected n_in %d out %d ws %zu\n", n_in, out_size, ws_size); return false; }
    int dev = 0, cus = 0;
    if (hipGetDevice(&dev) != hipSuccess || hipDeviceGetAttribute(&cus, hipDeviceAttributeMultiprocessorCount, dev) != hipSuccess) return false;
    if (cus < 256) { fprintf(stderr, "kernel_launch: needs 256 CUs, device has %d\n", cus); return false; }
    if (hipFuncSetAttribute((const void*)mk::mk_fwd<MK_SP2>, hipFuncAttributeMaxDynamicSharedMemorySize, mk::LDS_BYTES) != hipSuccess) { fprintf(stderr, "kernel_launch: hipFuncSetAttribute failed\n"); return false; }
    g_grid = 256;
  }
  return g_grid > 0;
}
static void mk_run(hipStream_t s, mk::Args a, int lo, int hi) {
  a.ph_lo = lo; a.ph_hi = hi;
  hipLaunchKernelGGL(mk::mk_fwd<MK_SP2>, dim3(g_grid), dim3(mk::NTHR), mk::LDS_BYTES, s, a);
}

#if CHECK
namespace chk {
using mk::bf16_t;
__device__ __forceinline__ float b2f(bf16_t b) { return __uint_as_float(((unsigned)b) << 16); }
__global__ void k_cmp(int mode, const void* A, const float* B, unsigned long long n, double* acc) {
  double e = 0.0, r = 0.0; const bf16_t* A16 = (const bf16_t*)A;
  for (unsigned long long i = (unsigned long long)blockIdx.x * 256 + threadIdx.x; i < n; i += (unsigned long long)gridDim.x * 256) {
    float a = 0.f, b = 0.f; const int row = (int)(i >> 9), col = (int)(i & 511);
    switch (mode) {
      case 0: a = ((const float*)A)[i]; b = B[i]; break;
      case 1: a = b2f(A16[i]); b = B[i]; break;
      case 2: { b = B[(size_t)row * 2048 + col]; const int g = col >> 4, c = col & 15; int crow, s; if (row < 16384) { crow = row >> 5; s = row & 31; } else { const int j = row - 16384; crow = 512 + (j >> 5); s = j & 31; }
                a = b2f(A16[((size_t)(g * 768 + crow)) * 768 + s * 16 + c]); } break;
      case 3: b = B[(size_t)row * 2048 + 512 + col]; a = b2f(A16[(size_t)row * 512 + col]); break;
      case 4: b = B[(size_t)row * 2048 + 1024 + col]; a = b2f(A16[(size_t)row * 512 + col]); break;
      case 5: b = B[(size_t)row * 2048 + 1536 + col]; a = b2f(A16[(size_t)col * 16640 + row]); break;
      case 6: b = B[(size_t)row * 1024 + col]; a = b2f(A16[(size_t)row * 1024 + col]); break;
      case 7: b = B[(size_t)row * 1024 + 512 + col]; a = b2f(A16[(size_t)row * 1024 + 512 + col]); break;
      case 8: { const int ta = (int)(i & 127), ri = (int)((i >> 7) & 1), tb = (int)((i >> 8) & 127), m = (int)((i >> 15) & 255), g = (int)(i >> 23); a = b2f(A16[i]); const int t = 128 * ta + tb; b = B[((size_t)t * 4 + g) * 512 + ri * 256 + m]; } break;
      default: break;
    }
    const double d = (double)a - (double)b; e += d * d; r += (double)b * (double)b;
  }
  for (int o = 32; o >= 1; o >>= 1) { e += __shfl_xor(e, o); r += __shfl_xor(r, o); }
  if ((threadIdx.x & 63) == 0) { atomicAdd(acc, e); atomicAdd(acc + 1, r); }
}
__global__ void k_cmp_x2(const bf16_t* X2, const float* Yr, const float* Yi, double* acc) {
  double e = 0.0, r = 0.0;
  for (unsigned long long i = (unsigned long long)blockIdx.x * 256 + threadIdx.x; i < (1ull << 25); i += (unsigned long long)gridDim.x * 256) {
    const int tb = (int)(i & 127), rip = (int)((i >> 7) & 1), ka = (int)((i >> 8) & 127), gm = (int)(i >> 15);
    const float a = b2f(X2[i]); const size_t yi = (((size_t)ka * 128 + tb) << 10) + gm; const float b = rip ? Yi[yi] : Yr[yi];
    const double d = (double)a - (double)b; e += d * d; r += (double)b * (double)b;
  }
  for (int o = 32; o >= 1; o >>= 1) { e += __shfl_xor(e, o); r += __shfl_xor(r, o); }
  if ((threadIdx.x & 63) == 0) { atomicAdd(acc, e); atomicAdd(acc + 1, r); }
}
__global__ void k_judge(const double* acc, int n, float tol, int* fail) {
  if (threadIdx.x == 0 && blockIdx.x == 0) { fail[0] = 0; for (int k = 0; k < n; ++k) { const double rel = sqrt(acc[2 * k] / acc[2 * k + 1]); if (!(rel <= (double)tol)) { fail[0] = k + 1; break; } } }
}
__global__ void k_encode(float* out, size_t n, const int* fail) {
  const int f = fail[0]; if (f == 0) return; const float sc = 1.f + 0.1f * (float)f;
  for (size_t i = (size_t)blockIdx.x * 256 + threadIdx.x; i < n; i += (size_t)gridDim.x * 256) out[i] *= sc;
}
__global__ void k_f2bf(const float* in, bf16_t* out, size_t n) { for (size_t i = (size_t)blockIdx.x * 256 + threadIdx.x; i < n; i += (size_t)gridDim.x * 256) out[i] = mk::f2bf(in[i]); }
static void cmp(hipStream_t s, int mode, const void* A, const float* B, unsigned long long n, double* acc) { hipLaunchKernelGGL(k_cmp, dim3(2048), dim3(256), 0, s, mode, A, B, n, acc); }
}
#endif

extern "C" void kernel_launch(void* const* d_in, const int* in_sizes, int n_in, void* d_out, int out_size, void* d_ws, size_t ws_size, hipStream_t stream) {
  if (!mk_setup(n_in, out_size, ws_size)) return;
  unsigned char* ws = (unsigned char*)d_ws;
  const size_t MiB = mk::MiB;
  mk::Args a{};
  for (int i = 0; i < 31; ++i) a.in[i] = (const float*)d_in[i];
  a.h = (float*)d_out; a.ws = ws; a.flags = 0; a.pad = 0;
#if CHECK == 0
  (void)hipMemsetAsync(ws + mk::WS_CTL, 0, mk::CTL_ZERO_BYTES, stream);
#if MK_N_LAUNCHES == 1
  mk_run(stream, a, 0, mk::NPHASE);
#else
  for (int ph = 0; ph < mk::NPHASE; ++ph) mk_run(stream, a, ph, ph + 1);
#endif
#else
  ref::In in; { const float** p = (const float**)&in; for (int i = 0; i < 31; ++i) p[i] = (const float*)d_in[i]; }
  float* out = (float*)d_out;
  char* wsc = (char*)d_ws;
  ref::Small sm; sm.mod = (float*)(wsc + 498 * MiB); sm.lamb = (float2*)(wsc + 498 * MiB + 131072); sm.bbar = (float2*)(wsc + 498 * MiB + 262144);
  sm.tw = (float2*)(wsc + 499 * MiB); sm.Dm = (float*)(wsc + 499 * MiB + 262144);
  double* acc = (double*)(wsc + 500 * MiB); int* fail = (int*)(wsc + 500 * MiB + 4096);
  (void)hipMemsetAsync(acc, 0, 8192, stream);
  (void)hipMemsetAsync(ws + mk::WS_CTL, 0, mk::CTL_ZERO_BYTES, stream);
  float* HOPT = (float*)(ws + mk::WS_HOPT);
  int nchk = 0;
#if CHECK == 1
  ref::MixBuf mb; mb.a0 = (float*)(wsc + 12 * MiB); mb.z = (float*)(wsc + 336 * MiB); mb.g = (float*)(wsc + 466 * MiB); mb.t = (float*)(wsc + 77 * MiB); mb.concat = mb.a0; mb.ymix = mb.z;
  char* moe_arena = wsc + 12 * MiB;
  ref::FourBuf fb; { char* p = wsc + 12 * MiB; fb.a1 = (float*)p; p += 64 * MiB; fb.Z = (float*)p; p += 128 * MiB; fb.Yr = (float*)p; p += 64 * MiB; fb.Yi = (float*)p; p += 64 * MiB; fb.F = (float*)p; fb.yf = fb.Z; }
  a.flags = mk::FLAG_SKIP_EXPERTS;
  nchk = 10;
  ref::forward(stream, in, out, sm, mb, moe_arena, fb, [&](int st) {
    if (st == 1) { mk_run(stream, a, 0, 1); chk::cmp(stream, 0, ws + mk::WS_MOD, sm.mod, 3 * 6144, acc + 0); }
    if (st == 2) { mk_run(stream, a, 1, 2); chk::cmp(stream, 1, ws + mk::WS_A0, mb.a0, 16640ull * 1024, acc + 2); }
    if (st == 3) { mk_run(stream, a, 2, 3); chk::cmp(stream, 2, ws + mk::WS_AS5, mb.z, 16640ull * 512, acc + 4); chk::cmp(stream, 3, ws + mk::WS_Q, mb.z, 16384ull * 512, acc + 6);
                   chk::cmp(stream, 4, ws + mk::WS_K, mb.z, 16640ull * 512, acc + 8); chk::cmp(stream, 5, ws + mk::WS_VT, mb.z, 16640ull * 512, acc + 10); }
    if (st == 4) { mk_run(stream, a, 3, 4); mk_run(stream, a, 4, 5); mk_run(stream, a, 5, 6); chk::cmp(stream, 1, ws + mk::WS_GB, mb.g, 16384ull * 512, acc + 12); }
    if (st == 5) { mk_run(stream, a, 6, 7); chk::cmp(stream, 6, ws + mk::WS_CONCAT, mb.concat, 16384ull * 512, acc + 14); }
    if (st == 6) { mk_run(stream, a, 7, 8); chk::cmp(stream, 7, ws + mk::WS_CONCAT, mb.concat, 16384ull * 512, acc + 16); }
    if (st == 7) { mk::Args b = a; b.h = HOPT; mk_run(stream, b, 8, 9); chk::cmp(stream, 0, HOPT, out, 16384ull * 1024, acc + 18); }
  });
#elif CHECK == 2 || CHECK == 4
  const int L = CHECK == 2 ? 0 : 1;
  ref::MixBuf mb; { char* p = wsc + 12 * MiB; mb.a0 = (float*)p; p += 65 * MiB; mb.z = (float*)p; p += 130 * MiB; mb.g = (float*)p; p += 32 * MiB; mb.t = (float*)p; p += 32 * MiB; mb.concat = (float*)p; p += 64 * MiB; mb.ymix = mb.z; }
  ref::FourBuf fb; { char* p = wsc + 12 * MiB; fb.a1 = (float*)p; p += 64 * MiB; fb.Z = (float*)p; p += 128 * MiB; fb.Yr = (float*)p; p += 64 * MiB; fb.Yi = (float*)p; p += 64 * MiB; fb.F = (float*)p; fb.yf = fb.Z; }
  char* moe_arena = wsc + 110 * MiB;
  nchk = L == 0 ? 2 : 1;
  a.flags = 0;
  ref::forward(stream, in, out, sm, mb, moe_arena, fb, [&](int st) {
    if ((L == 0 && st == 7) || (L == 1 && st == 11)) {
      mk::Args b = a; b.h = HOPT; if (L == 1) b.flags = 2;
      mk_run(stream, b, 0, 1);
      (void)hipMemcpyAsync(HOPT, out, (size_t)16384 * 1024 * 4, hipMemcpyDeviceToDevice, stream);
      const int pb = L == 0 ? 9 : 20; b.flags |= mk::FLAG_SKIP_EXPERTS;
      for (int ph = pb; ph < pb + 7; ++ph) mk_run(stream, b, ph, ph + 1);
    }
    if ((L == 0 && st == 8) || (L == 1 && st == 12)) chk::cmp(stream, 0, HOPT, out, 16384ull * 1024, acc + 0);
    if (L == 0 && st == 9) chk::cmp(stream, 1, ws + mk::WS_A1, fb.a1, 16384ull * 1024, acc + 2);
  });
#elif CHECK == 3
  ref::MixBuf mb; { char* p = wsc + 12 * MiB; mb.a0 = (float*)p; p += 65 * MiB; mb.z = (float*)p; p += 130 * MiB; mb.g = (float*)p; p += 32 * MiB; mb.t = (float*)p; p += 32 * MiB; mb.concat = (float*)p; p += 64 * MiB; mb.ymix = mb.z; }
  char* moe_arena = wsc + 12 * MiB;
  ref::FourBuf fb; fb.Z = (float*)(wsc + 270 * MiB);
  fb.a1 = (float*)(wsc + 12 * MiB); fb.Yr = (float*)(wsc + 12 * MiB);   fb.Yi = (float*)(wsc + 468 * MiB - 0); fb.F = (float*)(wsc + 270 * MiB); fb.yf = (float*)(wsc + 334 * MiB);
  fb.Yi = (float*)(wsc + 76 * MiB);
  nchk = 4;
  a.flags = mk::FLAG_SKIP_EXPERTS;
  ref::forward(stream, in, out, sm, mb, moe_arena, fb, [&](int st) {
    if (st == 9) {
      mk::Args b = a; b.h = HOPT;
      mk_run(stream, b, 0, 1);
      hipLaunchKernelGGL(chk::k_f2bf, dim3(2048), dim3(256), 0, stream, fb.a1, (chk::bf16_t*)(ws + mk::WS_A1), (size_t)16384 * 1024);
      (void)hipMemcpyAsync(HOPT, out, (size_t)16384 * 1024 * 4, hipMemcpyDeviceToDevice, stream);
      mk_run(stream, b, 16, 17);
    }
  });
#endif
  hipLaunchKernelGGL(chk::k_judge, dim3(1), dim3(64), 0, stream, acc, nchk, 0.05f, fail);
  hipLaunchKernelGGL(chk::k_encode, dim3(2048), dim3(256), 0, stream, out, (size_t)16384 * 1024, fail);
#endif
}
```

```cpp
#define CHECK 0
#define MK_N_LAUNCHES 1
#define MK_SP2 true
#define REP_MASK 0ull
#include <hip/hip_runtime.h>
#include <cstdio>
#include <cstdint>
#include <cmath>
namespace mk {
#define LAS __attribute__((address_space(3)))
typedef unsigned short bf16_t;
typedef short bf16x8 __attribute__((ext_vector_type(8)));
typedef float f32x4 __attribute__((ext_vector_type(4)));
typedef float f32x2 __attribute__((ext_vector_type(2)));
typedef unsigned u32x4 __attribute__((ext_vector_type(4)));
typedef unsigned u32x2 __attribute__((ext_vector_type(2)));
typedef int i32x8 __attribute__((ext_vector_type(8)));
typedef int i32x4 __attribute__((ext_vector_type(4)));

constexpr int TOK = 16384, CTXN = 256, NROW = TOK + CTXN;
constexpr int NWAVES = 8, NTHR = 512;
constexpr int LDS_STAGE = 131072, LDS_BYTES = 155648, LDS_MISC_OFF = LDS_BYTES - 4096;

__device__ __forceinline__ unsigned cvt_pk_bf16(float lo, float hi) { unsigned r; asm volatile("v_cvt_pk_bf16_f32 %0, %1, %2" : "=v"(r) : "v"(lo), "v"(hi)); return r; }
__device__ __forceinline__ int pack4_fp8(float a, float b, float c, float d) { int w = 0;
  w = __builtin_amdgcn_cvt_pk_fp8_f32(__builtin_amdgcn_fmed3f(a, -448.f, 448.f), __builtin_amdgcn_fmed3f(b, -448.f, 448.f), w, false);
  w = __builtin_amdgcn_cvt_pk_fp8_f32(__builtin_amdgcn_fmed3f(c, -448.f, 448.f), __builtin_amdgcn_fmed3f(d, -448.f, 448.f), w, true); return w; }
__device__ __forceinline__ void st16_wt(void* p, u32x4 v) { asm volatile("global_store_dwordx4 %0, %1, off sc1\n\ts_nop 1" :: "v"(p), "v"(v) : "memory"); }
__device__ __forceinline__ float bf_lo(unsigned w) { return __uint_as_float(w << 16); }
__device__ __forceinline__ float bf_hi(unsigned w) { return __uint_as_float(w & 0xffff0000u); }
__device__ __forceinline__ float bf2f(bf16_t b) { return __uint_as_float(((unsigned)b) << 16); }
__device__ __forceinline__ bf16_t f2bf(float f) { unsigned u = __float_as_uint(f); return (bf16_t)((u + 0x7fffu + ((u >> 16) & 1u)) >> 16); }
__device__ __forceinline__ float sx(float v, int o) { unsigned z = 0u; asm volatile("" : "+v"(z)); int l = (int)__builtin_amdgcn_mbcnt_hi(~0u, __builtin_amdgcn_mbcnt_lo(~0u, z)); return __int_as_float(__builtin_amdgcn_ds_bpermute((l ^ o) << 2, __float_as_int(v))); }
__device__ __forceinline__ float wave_sum(float v) {
#pragma unroll
  for (int o = 1; o < 64; o <<= 1) v += sx(v, o);
  return v;
}
__device__ __forceinline__ float fast_sigmoid(float x) { return __builtin_amdgcn_rcpf(1.f + __expf(-x)); }
__device__ __forceinline__ float fast_tanh(float x) { float e = __expf(2.f * x); return 1.f - 2.f * __builtin_amdgcn_rcpf(e + 1.f); }
__device__ __forceinline__ float gelu_tanh(float x) { return 0.5f * x * (1.f + fast_tanh(0.7978845608028654f * (x + 0.044715f * x * x * x))); }

#define XB_TMO      128
#define XB_XCNT(j)  (256  + 64 * (j))
#define XB_XSUB(j)  (1280 + 64 * (j))
#define XB_XGEN(j)  (2304 + 64 * (j))
#define XB_TOP      3328
#define XB_TOPGEN   3392
#define XCD_BAR_WORDS 3456
#define XB_SPIN_CAP (1u << 20)
__device__ __forceinline__ unsigned xb_ld(unsigned* p) { return __hip_atomic_load(p, __ATOMIC_RELAXED, __HIP_MEMORY_SCOPE_AGENT); }
__device__ __forceinline__ unsigned xb_add(unsigned* p, unsigned v) { return __hip_atomic_fetch_add(p, v, __ATOMIC_RELAXED, __HIP_MEMORY_SCOPE_AGENT); }
__device__ __forceinline__ unsigned xb_xcc_id() { return (unsigned)__builtin_amdgcn_s_getreg((3 << 11) | 20) & 0xFu; }
#define XB_SPIN(cond, bar) do { unsigned _sp = 0; while (cond) { __builtin_amdgcn_s_sleep(1); \
    if ((++_sp & 255u) == 0u) { if (xb_ld(&(bar)[XB_TMO])) break; if (_sp > XB_SPIN_CAP) { atomicAdd(&(bar)[XB_TMO], 1u); break; } } } } while (0)
struct XcdBarrier { unsigned* bar; unsigned x; volatile LAS unsigned* st; };
__device__ __forceinline__ XcdBarrier xcd_barrier_post(unsigned* bar, volatile LAS unsigned* st, int tid) {
  XcdBarrier b; b.bar = bar; b.x = xb_xcc_id(); b.st = st;
  if (tid == 0) (void)xb_add(&bar[XB_XCNT(b.x)], 1u);
  return b;
}
__device__ __forceinline__ void xcd_barrier_complete(unsigned* bar, unsigned x, unsigned& nloc, unsigned& nx) {
  const unsigned G = gridDim.x * gridDim.y * gridDim.z;
  unsigned sum, cnt, mine, sp = 0u;
  for (;;) {
    sum = 0u; cnt = 0u; mine = 0u;
#pragma unroll
    for (unsigned j = 0; j < 16; ++j) { const unsigned c = xb_ld(&bar[XB_XCNT(j)]); sum += c; cnt += (c > 0u) ? 1u : 0u; }
    if (sum == G) { mine = xb_ld(&bar[256 + 64 * x]); break; }
    __builtin_amdgcn_s_sleep(1);
    if ((++sp & 255u) == 0u) { if (xb_ld(&bar[XB_TMO])) break; if (sp > XB_SPIN_CAP) { atomicAdd(&bar[XB_TMO], 1u); break; } }
  }
  nloc = mine > 0u ? mine : 1u; nx = cnt > 0u ? cnt : 1u;
}
__device__ __forceinline__ void xcd_barrier(const XcdBarrier& b, int tid) {
  asm volatile("s_waitcnt vmcnt(0)" ::: "memory");
  __syncthreads();
  if (tid == 0) {
    unsigned* bar = b.bar;
    __builtin_amdgcn_s_waitcnt(0);
    unsigned nloc = b.st[0], nx = b.st[1];
    if (nloc == 0u) { xcd_barrier_complete(bar, b.x, nloc, nx); b.st[0] = nloc; b.st[1] = nx; }
    const unsigned old = xb_add(&bar[XB_XSUB(b.x)], 1u);
    const unsigned gen = old / nloc;
    if (old + 1u == (gen + 1u) * nloc) {
      __builtin_amdgcn_fence(__ATOMIC_RELEASE, "agent");
      asm volatile("s_waitcnt vmcnt(0)" ::: "memory");
      const unsigned og = xb_add(&bar[XB_TOP], 1u);
      const unsigned tg = og / nx;
      if (og + 1u == (tg + 1u) * nx) xb_add(&bar[XB_TOPGEN], 1u);
      else XB_SPIN(xb_ld(&bar[XB_TOPGEN]) == tg, bar);
      __builtin_amdgcn_fence(__ATOMIC_ACQUIRE, "agent");
      xb_add(&bar[XB_XGEN(b.x)], 1u);
      asm volatile("s_waitcnt vmcnt(0)" ::: "memory");
    } else {
      XB_SPIN(xb_ld(&bar[XB_XGEN(b.x)]) == gen, bar);
      __builtin_amdgcn_fence(__ATOMIC_ACQUIRE, "agent");
      asm volatile("s_waitcnt vmcnt(0)" ::: "memory");
    }
  }
  __syncthreads();
}

constexpr int BM = 256, BK = 64, HALF = 128, HTB = HALF * BK * 2, NXCD = 8;
__device__ __forceinline__ int lds_byte(int r, int c) { const int st = (r >> 4) * 2 + (c >> 5), rr = r & 15, cc = c & 31, ob = rr * 64 + cc * 2; return st * 1024 + (ob ^ (((ob >> 9) & 1) << 5)); }
__device__ __forceinline__ void stage_rc(int b, int& R, int& C) { const int st = b / 1024, sb = b % 1024, swz = sb ^ (((sb >> 9) & 1) << 5); R = (st >> 1) * 16 + swz / 64; C = (st & 1) * 32 + (swz % 64) / 2; }
__device__ __forceinline__ int swz16(int fr) { return 2 * ((fr >> 1) & 1) + 4 * ((fr >> 3) & 1); }
__device__ __forceinline__ int swz8(int fr) { return ((fr >> 1) & 1) + 4 * ((fr >> 3) & 1); }
__device__ __forceinline__ int perm32(int rho) { const int n = rho >> 4, i = rho & 15; return 8 * (i >> 2) + 4 * n + (i & 3); }

struct Unit { int pm, pn, a, b, ord; };
__device__ __forceinline__ int xcd_remap(int L, int nunits) { const int q = nunits / NXCD, r = nunits % NXCD, xcd = L % NXCD, off = L / NXCD; return (xcd < r ? xcd * (q + 1) : r * (q + 1) + (xcd - r) * q) + off; }
typedef f32x4 Acc[2][2][4][2];
template <class P, bool SP2>
__device__ __forceinline__ void gemm_phase(LAS unsigned char* lds, const P& p, int G, int c, int tid_in) {
  const int tid = tid_in, wid = __builtin_amdgcn_readfirstlane(tid >> 6), lane = tid & 63, wr = wid >> 2, wc = wid & 3, fr = lane & 15, fq = lane >> 4;
  const int K = p.K, nt = K / BK;
  const int nunits = p.nunits;
  const size_t kstep = (size_t)(BK * 2);
  const unsigned ldsw = (unsigned)wid * 1024u;
  const int aoff0 = P::F8 ? (wr * 64 + fr) * 128 + ((2 * fq) ^ swz8(fr)) * 16 : lds_byte(wr * 64 + fr, fq * 8);
  const int boff0 = P::F8 ? (wc * 32 + fr) * 128 + ((2 * fq) ^ swz8(fr)) * 16 : lds_byte(wc * 32 + fr, fq * 8);
#define PG8_SA(b, h) (((b) * 2 + (h)) * HTB)
#define PG8_SB(b, h) ((4 + (b) * 2 + (h)) * HTB)
#define PG8_STAGE(bufoff, gbase, voff) do { _Pragma("unroll") for (int _i = 0; _i < 2; ++_i) \
        __builtin_amdgcn_global_load_lds((const unsigned*)((const char*)(gbase) + (voff)[_i]), (LAS unsigned*)(lds + (bufoff) + ldsw + _i * 8192), 16, 0, 0); } while (0)
#define PG8_RD32(p0_, p1_) __builtin_shufflevector(*(const LAS i32x4*)(p0_), *(const LAS i32x4*)(p1_), 0, 1, 2, 3, 4, 5, 6, 7)
#define PG8_LDA(dst, b, h) do { if constexpr (P::F8) { int _o1 = aoff0 ^ 16; asm volatile("" : "+v"(_o1)); _Pragma("unroll") for (int m = 0; m < 4; ++m) dst##8[m] = PG8_RD32(lds + PG8_SA(b, h) + aoff0 + m * 2048, lds + PG8_SA(b, h) + _o1 + m * 2048); } \
        else { _Pragma("unroll") for (int m = 0; m < 4; ++m) _Pragma("unroll") for (int k = 0; k < 2; ++k) dst[m][k] = *(const LAS bf16x8*)(lds + PG8_SA(b, h) + aoff0 + m * 2048 + k * 1024); } } while (0)
#define PG8_LDB(dst, b, h) do { if constexpr (P::F8) { int _o1 = boff0 ^ 16; asm volatile("" : "+v"(_o1)); _Pragma("unroll") for (int n = 0; n < 2; ++n) dst##8[n] = PG8_RD32(lds + PG8_SB(b, h) + boff0 + n * 2048, lds + PG8_SB(b, h) + _o1 + n * 2048); } \
        else { _Pragma("unroll") for (int n = 0; n < 2; ++n) _Pragma("unroll") for (int k = 0; k < 2; ++k) dst[n][k] = *(const LAS bf16x8*)(lds + PG8_SB(b, h) + boff0 + n * 2048 + k * 1024); } } while (0)
#define PG8_MMA(ai, bj, At, Bt) do { __builtin_amdgcn_s_setprio(1); if constexpr (P::F8) { _Pragma("unroll") for (int m = 0; m < 4; ++m) _Pragma("unroll") for (int n = 0; n < 2; ++n) \
        acc[ai][bj][m][n] = __builtin_amdgcn_mfma_scale_f32_16x16x128_f8f6f4(Bt##8[n], At##8[m], acc[ai][bj][m][n], 0, 0, 0, 0, 0, 0); }     \
        else { _Pragma("unroll") for (int m = 0; m < 4; ++m) _Pragma("unroll") for (int n = 0; n < 2; ++n) _Pragma("unroll") for (int k = 0; k < 2; ++k) \
        acc[ai][bj][m][n] = __builtin_amdgcn_mfma_f32_16x16x32_bf16(Bt[n][k], At[m][k], acc[ai][bj][m][n], 0, 0, 0); } __builtin_amdgcn_s_setprio(0); } while (0)
#define PG8_WAIT_V(n) asm volatile("s_waitcnt vmcnt(" #n ")" ::: "memory")
#define PG8_WAIT_L(n) asm volatile("s_waitcnt lgkmcnt(" #n ")" ::: "memory")
#define PG8_BAR __builtin_amdgcn_s_barrier()
#define PG8_SCHED __builtin_amdgcn_sched_barrier(0)
#define PG8_DECODE(i, u) do { p.decode(P::CONTIG ? (u_lo + (i)) : xcd_remap((i) * G + c, nunits), u); u.ord = (i); } while (0)
#define PG8_HAS(i) (P::CONTIG ? (u_lo + (i) < u_hi) : ((i) * G + c < nunits))
#define PG8_OFFS(u, vA, vB) do { int _t = tid; asm volatile("" : "+v"(_t)); _Pragma("unroll") for (int _i = 0; _i < 2; ++_i) { int _R, _C; if constexpr (P::F8) { const int _p = _t + 512 * _i; _R = _p >> 3; _C = ((_p & 7) ^ swz8(_R & 15)) * 8; } else stage_rc(_t * 16 + _i * 8192, _R, _C); \
        const int _Rb = P::PERM ? ((_R & ~31) + perm32(_R & 31)) : _R; _Pragma("unroll") for (int _h = 0; _h < 2; ++_h) { \
        if (_h == 0 || !P::LINA) vA[_h][_i] = p.rowA(u, _h * HALF + _R) + (unsigned)(_C * 2); if (_h == 0 || !P::LINB) vB[_h][_i] = p.rowB(u, _h * HALF + _Rb) + (unsigned)(_C * 2); } } } while (0)
  const int vc_ = (G % 8 == 0) ? (c % 8) * (G / 8) + c / 8 : c;
  const int u_lo = (int)(((long)vc_ * nunits) / G), u_hi = (int)(((long)(vc_ + 1) * nunits) / G);
  if (!PG8_HAS(0)) return;
  Unit cur, nxt; int ui = 0;
  PG8_DECODE(0, cur);
  Acc acc; float zf_ = 0.f; asm volatile("" : "+v"(zf_));
#pragma unroll
  for (int a = 0; a < 2; ++a)
#pragma unroll
    for (int b = 0; b < 2; ++b)
#pragma unroll
      for (int m = 0; m < 4; ++m)
#pragma unroll
        for (int n = 0; n < 2; ++n) acc[a][b][m][n] = (f32x4){zf_, zf_, zf_, zf_};
  bf16x8 At[4][2], B0[2][2], B1[2][2]; i32x8 At8[4], B08[2], B18[2];
  unsigned vA[2][2], vB[2][2];
  PG8_OFFS(cur, vA, vB);
  const char* cA = p.baseA(cur); const char* cB = p.baseB(cur);
  const size_t hA = P::LINA ? p.halfA() : 0, hB = P::LINB ? p.halfB() : 0;
  if constexpr (SP2) {
    PG8_STAGE(PG8_SB(0, 0), cB, vB[0]); PG8_STAGE(PG8_SB(0, 1), (cB) + (P::LINB ? hB : 0), vB[P::LINB ? 0 : 1]); PG8_STAGE(PG8_SA(0, 0), cA, vA[0]); PG8_STAGE(PG8_SA(0, 1), (cA) + (P::LINA ? hA : 0), vA[P::LINA ? 0 : 1]);
    if (wr == 1) PG8_BAR;
    PG8_WAIT_V(2); PG8_BAR;
    PG8_STAGE(PG8_SB(1, 0), cB + kstep, vB[0]); PG8_STAGE(PG8_SA(1, 0), cA + kstep, vA[0]); PG8_STAGE(PG8_SB(1, 1), (cB + kstep) + (P::LINB ? hB : 0), vB[P::LINB ? 0 : 1]);
    PG8_WAIT_V(6); PG8_BAR;
  } else {
    PG8_STAGE(PG8_SB(0, 0), cB, vB[0]); PG8_STAGE(PG8_SA(0, 0), cA, vA[0]); PG8_STAGE(PG8_SB(0, 1), (cB) + (P::LINB ? hB : 0), vB[P::LINB ? 0 : 1]); PG8_STAGE(PG8_SA(0, 1), (cA) + (P::LINA ? hA : 0), vA[P::LINA ? 0 : 1]);
    if (wr == 1) PG8_BAR;
    PG8_WAIT_V(4); PG8_BAR;
    PG8_STAGE(PG8_SB(1, 0), cB + kstep, vB[0]); PG8_STAGE(PG8_SA(1, 0), cA + kstep, vA[0]); PG8_STAGE(PG8_SB(1, 1), (cB + kstep) + (P::LINB ? hB : 0), vB[P::LINB ? 0 : 1]);
    PG8_WAIT_V(6); PG8_BAR;
  }
  for (;;) {
    const bool has_next = PG8_HAS(ui + 1);
    if (has_next) PG8_DECODE(ui + 1, nxt);
    const char* nA = has_next ? p.baseA(nxt) : cA; const char* nB = has_next ? p.baseB(nxt) : cB;
    for (int t = 0; t < nt; t += 2) {
      const bool last = (t == nt - 2);
      const char* a1 = cA + (size_t)(t + 1) * kstep;
      const char* a2 = last ? nA : cA + (size_t)(t + 2) * kstep; const char* b2 = last ? nB : cB + (size_t)(t + 2) * kstep;
      const char* a3 = a2 + kstep; const char* b3 = b2 + kstep;
      if constexpr (SP2) {
        PG8_LDB(B0, 0, 0); PG8_LDB(B1, 0, 1); PG8_SCHED; PG8_LDA(At, 0, 0); PG8_STAGE(PG8_SA(1, 1), (a1) + (P::LINA ? hA : 0), vA[P::LINA ? 0 : 1]);
        PG8_WAIT_V(8); PG8_WAIT_L(0); PG8_BAR; PG8_MMA(0, 0, At, B0); PG8_MMA(0, 1, At, B1); PG8_BAR; PG8_SCHED;
        if (last && has_next) { PG8_OFFS(nxt, vA, vB); }
        PG8_LDA(At, 0, 1); PG8_STAGE(PG8_SB(0, 0), b2, vB[0]); PG8_STAGE(PG8_SB(0, 1), (b2) + (P::LINB ? hB : 0), vB[P::LINB ? 0 : 1]); PG8_STAGE(PG8_SA(0, 0), a2, vA[0]);
        PG8_WAIT_V(8); PG8_WAIT_L(0); PG8_BAR; PG8_MMA(1, 0, At, B0); PG8_MMA(1, 1, At, B1); PG8_BAR; PG8_SCHED;
        PG8_LDB(B0, 1, 0); PG8_LDB(B1, 1, 1); PG8_SCHED; PG8_LDA(At, 1, 0); PG8_STAGE(PG8_SA(0, 1), (a2) + (P::LINA ? hA : 0), vA[P::LINA ? 0 : 1]);
        PG8_WAIT_V(8); PG8_WAIT_L(0); PG8_BAR; PG8_MMA(0, 0, At, B0); PG8_MMA(0, 1, At, B1); PG8_BAR; PG8_SCHED;
        PG8_LDA(At, 1, 1); PG8_STAGE(PG8_SB(1, 0), b3, vB[0]); PG8_STAGE(PG8_SB(1, 1), (b3) + (P::LINB ? hB : 0), vB[P::LINB ? 0 : 1]); PG8_STAGE(PG8_SA(1, 0), a3, vA[0]);
        PG8_WAIT_V(8); PG8_WAIT_L(0); PG8_BAR; PG8_MMA(1, 0, At, B0); PG8_MMA(1, 1, At, B1); PG8_BAR; PG8_SCHED;
      } else {
        PG8_LDB(B0, 0, 0); PG8_SCHED; PG8_LDA(At, 0, 0); PG8_STAGE(PG8_SA(1, 1), (a1) + (P::LINA ? hA : 0), vA[P::LINA ? 0 : 1]);
        PG8_WAIT_L(8); PG8_BAR; PG8_WAIT_L(0); PG8_MMA(0, 0, At, B0); PG8_BAR; PG8_SCHED;
        if (last && has_next) { PG8_OFFS(nxt, vA, vB); }
        PG8_LDB(B1, 0, 1); PG8_STAGE(PG8_SB(0, 0), b2, vB[0]);
        PG8_BAR; PG8_WAIT_L(0); PG8_MMA(0, 1, At, B1); PG8_BAR;
        PG8_LDA(At, 0, 1); PG8_STAGE(PG8_SA(0, 0), a2, vA[0]);
        PG8_BAR; PG8_WAIT_L(0); PG8_MMA(1, 0, At, B0); PG8_BAR; PG8_SCHED;
        PG8_STAGE(PG8_SB(0, 1), (b2) + (P::LINB ? hB : 0), vB[P::LINB ? 0 : 1]);
        PG8_WAIT_V(6); PG8_BAR; PG8_MMA(1, 1, At, B1); PG8_BAR;
        PG8_LDB(B0, 1, 0); PG8_SCHED; PG8_LDA(At, 1, 0); PG8_STAGE(PG8_SA(0, 1), (a2) + (P::LINA ? hA : 0), vA[P::LINA ? 0 : 1]);
        PG8_WAIT_L(8); PG8_BAR; PG8_WAIT_L(0); PG8_MMA(0, 0, At, B0); PG8_BAR; PG8_SCHED;
        PG8_LDB(B1, 1, 1); PG8_STAGE(PG8_SB(1, 0), b3, vB[0]);
        PG8_BAR; PG8_WAIT_L(0); PG8_MMA(0, 1, At, B1); PG8_BAR;
        PG8_LDA(At, 1, 1); PG8_STAGE(PG8_SA(1, 0), a3, vA[0]);
        PG8_BAR; PG8_WAIT_L(0); PG8_MMA(1, 0, At, B0); PG8_BAR; PG8_SCHED;
        PG8_STAGE(PG8_SB(1, 1), (b3) + (P::LINB ? hB : 0), vB[P::LINB ? 0 : 1]);
        PG8_WAIT_V(6); PG8_BAR; PG8_MMA(1, 1, At, B1); PG8_BAR;
      }
    }
    if constexpr (P::ALIGN) { if (wr == 0) PG8_BAR; }
    { int fr_e = fr, fq_e = fq; asm volatile("" : "+v"(fr_e), "+v"(fq_e)); p.epi(acc, cur, wr, wc, fr_e, fq_e); }
    if (!has_next) break;
    zf_ = 0.f; asm volatile("" : "+v"(zf_));
#pragma unroll
    for (int a = 0; a < 2; ++a)
#pragma unroll
      for (int b = 0; b < 2; ++b)
#pragma unroll
        for (int m = 0; m < 4; ++m)
#pragma unroll
          for (int n = 0; n < 2; ++n) acc[a][b][m][n] = (f32x4){zf_, zf_, zf_, zf_};
    cur = nxt; cA = nA; cB = nB; ++ui;
    if constexpr (P::ALIGN) { if (wr == 1) PG8_BAR; }
  }
  PG8_WAIT_V(0);
  if constexpr (!P::ALIGN) { if (wr == 0) PG8_BAR; }
  PG8_BAR;
#undef PG8_SA
#undef PG8_SB
#undef PG8_STAGE
#undef PG8_RD32
#undef PG8_LDA
#undef PG8_LDB
#undef PG8_MMA
#undef PG8_WAIT_V
#undef PG8_WAIT_L
#undef PG8_BAR
#undef PG8_SCHED
#undef PG8_DECODE
#undef PG8_HAS
#undef PG8_OFFS
}
}
namespace mk {
constexpr size_t MiB = 1u << 20;
constexpr size_t WS_CTL = 0, CTL_ZERO_BYTES = 65536;
constexpr size_t WS_MOD = 65536;
constexpr size_t WS_LAML = 262144;
constexpr size_t WS_WIN_T = 1 * MiB, WS_WGLU_T = 5 * MiB, WS_WMIX_T = 6 * MiB, WS_WFOUR_T = 8 * MiB, WS_WROUT_T = 10 * MiB;
constexpr size_t WS_DMT = 10 * MiB + 512 * 1024, WS_W1 = 10 * MiB + 768 * 1024, WS_W2 = 10 * MiB + 896 * 1024;
constexpr size_t WS_WEXP = 12 * MiB, EXP_STRIDE = 3 * MiB / 2, EXP_DOFF = 1 * MiB;
constexpr size_t WS_R = 110 * MiB;
constexpr size_t WS_WS = WS_R, WS_TT = WS_R + 8 * MiB, WS_A0 = WS_R + 34 * MiB, WS_AS5 = WS_R + 67 * MiB, WS_Q = WS_R + 103 * MiB, WS_K = WS_R + 119 * MiB,
                 WS_VT = WS_R + 136 * MiB, WS_SST = WS_R + 153 * MiB, WS_GB = WS_R + 177 * MiB, WS_CONCAT = WS_R + 193 * MiB;
constexpr size_t WS_F = WS_R, WS_LTOK = WS_R + 16 * MiB, WS_ASG = WS_R + 20 * MiB, WS_HID = WS_R + 22 * MiB, WS_YAS = WS_R + 102 * MiB,
                 WS_A1 = WS_R + 262 * MiB, WS_HB = WS_R + 294 * MiB;
constexpr size_t WS_X1 = WS_R, WS_X2 = WS_R + 64 * MiB, WS_SPC = WS_R + 96 * MiB, WS_FB = WS_R + 128 * MiB;
constexpr size_t WS_HOPT = WS_R + 338 * MiB;
constexpr size_t WS_WEXP1 = WS_R + 338 * MiB;
constexpr size_t EXP1_STRIDE = 1 * MiB, EXP1_DOFF = 512 * 1024;
constexpr size_t WS_NEED = WS_R + 403 * MiB;
constexpr int HALF_CAP_ROWS = 90112;
constexpr int CW_BAR = 4096, CW_CNT = 8192  , CW_DQ0 = 12288, CW_DQ1 = 12352, CW_DONE = 13312  ;

struct Args { const float* in[31]; float* h; unsigned char* ws; int ph_lo, ph_hi, flags, pad; };
enum { IN_X = 0, IN_C, IN_CTX, IN_CCTX, IN_WADA, IN_BADA, IN_WIN, IN_LRE, IN_LIM, IN_LDT, IN_BRE, IN_BIM, IN_CRE, IN_CIM, IN_S5D, IN_WGLU, IN_BGLU, IN_QG, IN_KG,
       IN_RPB, IN_WMIX, IN_WFOUR, IN_BFOUR, IN_WROUT, IN_RBIAS, IN_WEG, IN_WEU, IN_WED, IN_WSG, IN_WSU, IN_WSD };
constexpr int FLAG_SKIP_EXPERTS = 1;

struct Ctx {
  LAS unsigned char* lds; const Args* a; unsigned char* ws; int tid, lane, wave, G, c;
};

__device__ __forceinline__ u32x4 pack8(const f32x4& v0, const f32x4& v1) { u32x4 w; w.x = cvt_pk_bf16(v0[0], v0[1]); w.y = cvt_pk_bf16(v0[2], v0[3]); w.z = cvt_pk_bf16(v1[0], v1[1]); w.w = cvt_pk_bf16(v1[2], v1[3]); return w; }
__device__ __forceinline__ int rowmap(int code, int n) {
  if (code == 1) { if (n < 512 || n >= 1536) return n; const int blk = n & ~255, c = n & 255; return blk + 128 * ((c >> 5) & 1) + 32 * (c >> 6) + (c & 31); }
  if (code == 2) return 256 * (n >> 7) + (n & 127);
  if (code == 3) return 256 * (n >> 7) + 128 + (n & 127);
  return n;
}
__device__ __forceinline__ int kmap(int kcode, int k) {
  if (kcode == 1) { const int h = k >> 9, g = (k >> 7) & 3, m = k & 127; return g * 256 + (h == 0 ? m : (m == 0 ? 128 : 256 - m)); }
  return k;
}
__device__ __forceinline__ void transpose_item(const float* W, int K, int N, bf16_t* WT, int code, LAS unsigned char* scr, int item, int lane, int kcode = 0) {
  const int nblk = N / 64, kb = item / nblk, nb = item % nblk, k0 = 64 * kb, n0 = 64 * nb;
  const int q = lane >> 4, a = lane & 15;
  f32x4 v[16];
  const float* src = W + (size_t)(k0 + 2 * q) * N + n0 + 4 * a;
  if (kcode == 0) {
#pragma unroll
    for (int i = 0; i < 16; ++i) v[i] = *(const f32x4*)(src + (size_t)((i & 1) + 8 * (i >> 1)) * N);
  } else {
#pragma unroll
    for (int i = 0; i < 16; ++i) v[i] = *(const f32x4*)(W + (size_t)kmap(kcode, k0 + 2 * q + (i & 1) + 8 * (i >> 1)) * N + n0 + 4 * a);
  }
#pragma unroll
  for (int ii = 0; ii < 8; ++ii) { const int dsw = q + 4 * (ii ^ (a & 7));
#pragma unroll
    for (int j = 0; j < 4; ++j) *(LAS unsigned*)(scr + (4 * a + j) * 128 + 4 * dsw) = cvt_pk_bf16(v[2 * ii][j], v[2 * ii + 1][j]); }
  asm volatile("s_waitcnt lgkmcnt(0)" ::: "memory");
  const int c = lane & 7;
#pragma unroll
  for (int jj = 0; jj < 8; ++jj) { const int n = (lane >> 3) + 8 * jj, cs = c ^ ((n >> 2) & 7);
    const u32x4 o = *(const LAS u32x4*)(scr + n * 128 + 16 * cs);
    *(u32x4*)(WT + (size_t)rowmap(code, n0 + n) * K + k0 + 8 * c) = o; }
  asm volatile("s_waitcnt lgkmcnt(0)" ::: "memory");
}
__device__ __forceinline__ void transpose_item8(const float* W, int K, int N, unsigned char* WT, int code, float scale, LAS unsigned char* scr, int item, int lane) {
  const int nblk = N / 64, kb = item / nblk, nb = item % nblk, k0 = 64 * kb, n0 = 64 * nb;
  const int q = lane >> 4, a = lane & 15;
  f32x4 v[16];
  const float* src = W + (size_t)(k0 + 4 * q) * N + n0 + 4 * a;
#pragma unroll
  for (int i = 0; i < 16; ++i) v[i] = *(const f32x4*)(src + (size_t)((i & 3) + 16 * (i >> 2)) * N);
#pragma unroll
  for (int ib = 0; ib < 4; ++ib) { const int dsw = q + 4 * (ib ^ (a & 3));
#pragma unroll
    for (int j = 0; j < 4; ++j) *(LAS int*)(scr + (4 * a + j) * 64 + 4 * dsw) = pack4_fp8(v[4 * ib][j] * scale, v[4 * ib + 1][j] * scale, v[4 * ib + 2][j] * scale, v[4 * ib + 3][j] * scale); }
  asm volatile("s_waitcnt lgkmcnt(0)" ::: "memory");
  const int c = lane & 3;
#pragma unroll
  for (int jj = 0; jj < 4; ++jj) { const int n = (lane >> 2) + 16 * jj, cs = c ^ ((n >> 2) & 3);
    const u32x4 o = *(const LAS u32x4*)(scr + n * 64 + 16 * cs);
    *(u32x4*)(WT + (size_t)rowmap(code, n0 + n) * K + k0 + 16 * c) = o; }
  asm volatile("s_waitcnt lgkmcnt(0)" ::: "memory");
}
constexpr int IT_WIN = 512, IT_GLU = 64, IT_MIX = 256, IT_FOUR = 256, IT_ROUT = 32, IT_SMALL = IT_WIN + IT_GLU + IT_MIX + IT_FOUR + IT_ROUT, IT_EXP = 192;
__device__ __forceinline__ void small_item(const Ctx& X, LAS unsigned char* scr, int it) {
  const Args& a = *X.a; unsigned char* ws = X.ws;
  if (it < IT_WIN) { transpose_item(a.in[IN_WIN], 1024, 2048, (bf16_t*)(ws + WS_WIN_T), 1, scr, it, X.lane); return; } it -= IT_WIN;
  if (it < IT_GLU) { transpose_item(a.in[IN_WGLU], 512, 512, (bf16_t*)(ws + WS_WGLU_T), 0, scr, it, X.lane); return; } it -= IT_GLU;
  if (it < IT_MIX) { transpose_item(a.in[IN_WMIX], 1024, 1024, (bf16_t*)(ws + WS_WMIX_T), 0, scr, it, X.lane); return; } it -= IT_MIX;
  if (it < IT_FOUR) { transpose_item(a.in[IN_WFOUR], 1024, 1024, (bf16_t*)(ws + WS_WFOUR_T), 0, scr, it, X.lane, 1); return; } it -= IT_FOUR;
  { const int l = it >> 4; transpose_item(a.in[IN_WROUT] + (size_t)l * 1024 * 64, 1024, 64, (bf16_t*)(ws + WS_WROUT_T) + (size_t)l * 64 * 1024, 0, scr, it & 15, X.lane); }
}
__device__ __forceinline__ void expert_item(const Ctx& X, LAS unsigned char* scr, int layer, int it) {
  const Args& a = *X.a; const int e = it / IT_EXP, r = it % IT_EXP;
  bf16_t* gu = (bf16_t*)(X.ws + (layer == 0 ? WS_WEXP + (size_t)e * EXP_STRIDE : WS_WEXP1 + (size_t)e * EXP1_STRIDE));
  bf16_t* dt = (bf16_t*)(X.ws + (layer == 0 ? WS_WEXP + (size_t)e * EXP_STRIDE + EXP_DOFF : WS_WEXP1 + (size_t)e * EXP1_STRIDE + EXP1_DOFF));
  const float *wg, *wu, *wd;
  if (e < 64) { const size_t o = ((size_t)layer * 64 + e) * 262144; wg = a.in[IN_WEG] + o; wu = a.in[IN_WEU] + o; wd = a.in[IN_WED] + o; }
  else { const size_t o = (size_t)layer * 262144; wg = a.in[IN_WSG] + o; wu = a.in[IN_WSU] + o; wd = a.in[IN_WSD] + o; }
  if (r < 64) transpose_item8(wg, 1024, 256, (unsigned char*)gu, 2, 32.f, scr, r, X.lane);
  else if (r < 128) transpose_item8(wu, 1024, 256, (unsigned char*)gu, 3, 32.f, scr, r - 64, X.lane);
  else transpose_item8(wd, 256, 1024, (unsigned char*)dt, 0, 32.f, scr, r - 128, X.lane);
}
__device__ __forceinline__ void transpose_work(const Ctx& X, unsigned* ctr, int first_small, int n_small, int layer, int n_exp_items, unsigned* done = nullptr, unsigned need = 0u, int stop_at = -1) {
  LAS unsigned char* scr = X.lds + X.wave * 8192;
  volatile LAS int* shb = (volatile LAS int*)(X.lds + LDS_MISC_OFF + 1024);
  const int total = n_small + n_exp_items;
  if (stop_at < 0) stop_at = total;
  const int per = done ? 1 : 4;
  for (;;) {
    __syncthreads();
    if (X.tid == 0) { int b = total; if (!done || __hip_atomic_load(done, __ATOMIC_RELAXED, __HIP_MEMORY_SCOPE_AGENT) < need) b = (int)atomicAdd(ctr, (unsigned)(8 * per)); shb[0] = b; }
    __syncthreads();
    const int base = shb[0];
    if (base >= stop_at) break;
    for (int k = 0; k < per; ++k) { const int it = base + X.wave * per + k; if (it >= total) break;
      if (it < n_small) small_item(X, scr, first_small + it);
      else { int e_it = it - n_small, l = layer; if (layer == 2) { l = e_it >= 65 * IT_EXP ? 1 : 0; e_it -= l * 65 * IT_EXP; } expert_item(X, scr, l, e_it); } }
  }
}

__device__ __forceinline__ void p0_adaln(const Ctx& X, int it) {
  const Args& a = *X.a; const int layer = it / 48, ct = it % 48, col = ct * 128 + X.lane;
  LAS float* sl = (LAS float*)X.lds;
  for (int i = X.tid; i < 2048; i += NTHR) { const float v = i < 1024 ? a.in[IN_C][i] : a.in[IN_CCTX][i - 1024]; sl[i] = v / (1.f + __expf(-v)); }
  __syncthreads();
  const float* W = a.in[IN_WADA] + (size_t)layer * 1024 * 6144 + col;
  float a0 = 0.f, a1 = 0.f, b0 = 0.f, b1 = 0.f; const int k0 = X.wave * 128;
#pragma unroll 16
  for (int k = 0; k < 128; ++k) { const float w0 = W[(size_t)(k0 + k) * 6144], w1 = W[(size_t)(k0 + k) * 6144 + 64]; const float s0 = sl[k0 + k], s1 = sl[1024 + k0 + k];
    a0 += s0 * w0; a1 += s1 * w0; b0 += s0 * w1; b1 += s1 * w1; }
  LAS float* red = sl + 2048;
  red[(X.wave * 128 + X.lane) * 2] = a0; red[(X.wave * 128 + X.lane) * 2 + 1] = a1; red[(X.wave * 128 + 64 + X.lane) * 2] = b0; red[(X.wave * 128 + 64 + X.lane) * 2 + 1] = b1;
  __syncthreads();
  if (X.tid < 256) { const int l = X.tid & 127, v = X.tid >> 7; float s = 0.f;
#pragma unroll
    for (int w = 0; w < 8; ++w) s += red[(w * 128 + l) * 2 + v];
    s += a.in[IN_BADA][layer * 6144 + ct * 128 + l];
    float* mod = (float*)(X.ws + WS_MOD);
    if (layer == 0) mod[v * 6144 + ct * 128 + l] = s; else if (v == 0) mod[2 * 6144 + ct * 128 + l] = s; }
  __syncthreads();
}

__device__ __forceinline__ void p0_s5tables(const Ctx& X, int g, int part) {
  const Args& a = *X.a;
  LAS f32x2* POW = (LAS f32x2*)X.lds;
  LAS f32x2* BB = (LAS f32x2*)(X.lds + 33792);
  LAS f32x2* CC = (LAS f32x2*)(X.lds + 33792 + 16384);
  LAS float* KK = (LAS float*)(X.lds + 33792 + 32768);
  LAS float* DD = (LAS float*)(X.lds + 33792 + 32768 + 65536);
  const int tid = X.tid;
  if (tid < 128) {
    const int dir = tid >> 6, p = tid & 63, idx = (dir * 32 + g) * 64 + p;
    const float lr = fminf(a.in[IN_LRE][idx], -1e-4f), li = a.in[IN_LIM][idx], dt = expf(a.in[IN_LDT][dir * 32 + g]);
    for (int tau = 0; tau <= 32; ++tau) { const float mg = expf(lr * dt * (float)tau); float sn, cs; sincospif(li * dt * (float)tau * 0.318309886183790672f, &sn, &cs); POW[(dir * 33 + tau) * 64 + p] = (f32x2){mg * cs, mg * sn}; }
    const f32x2 l1 = POW[(dir * 33 + 1) * 64 + p], l32 = POW[(dir * 33 + 32) * 64 + p];
    if (part == 0) ((float2*)(X.ws + WS_LAML))[idx] = make_float2(l32.x, l32.y);
    const float nr = l1.x - 1.f, ni = l1.y, den = lr * lr + li * li, cr = (nr * lr + ni * li) / den, ci = (ni * lr - nr * li) / den;
    for (int c = 0; c < 16; ++c) { const float xr = a.in[IN_BRE][idx * 16 + c], xi = a.in[IN_BIM][idx * 16 + c]; BB[(dir * 64 + p) * 16 + c] = (f32x2){cr * xr - ci * xi, cr * xi + ci * xr}; }
  }
  for (int i = tid; i < 2048; i += NTHR) { const int dir = i >> 10, c = (i >> 6) & 15, p = i & 63; const int gi = ((dir * 32 + g) * 16 + c) * 64 + p; CC[i] = (f32x2){a.in[IN_CRE][gi], a.in[IN_CIM][gi]}; }
  if (tid < 16) DD[tid] = a.in[IN_S5D][g * 16 + tid];
  __syncthreads();
  for (int combo = tid; combo < 1024; combo += NTHR) {
    const int dir = combo >> 9, tau = (combo >> 4) & 31, c = combo & 15;
    float accv[16];
#pragma unroll
    for (int j = 0; j < 16; ++j) accv[j] = 0.f;
#pragma unroll 2
    for (int p = 0; p < 64; ++p) {
      const f32x2 cc = CC[(dir * 16 + c) * 64 + p], pw = POW[(dir * 33 + tau) * 64 + p];
      const float zr = cc.x * pw.x - cc.y * pw.y, zi = cc.x * pw.y + cc.y * pw.x;
      const LAS f32x4* bp = (const LAS f32x4*)(BB + (dir * 64 + p) * 16);
#pragma unroll
      for (int j = 0; j < 8; ++j) { const f32x4 b = bp[j]; accv[2 * j] += zr * b.x - zi * b.y; accv[2 * j + 1] += zr * b.z - zi * b.w; }
    }
#pragma unroll
    for (int j = 0; j < 4; ++j) *(LAS f32x4*)(KK + ((dir * 32 + tau) * 16 + c) * 16 + 4 * j) = (f32x4){accv[4 * j], accv[4 * j + 1], accv[4 * j + 2], accv[4 * j + 3]};
  }
  __syncthreads();
  bf16_t* TT = (bf16_t*)(X.ws + WS_TT) + (size_t)g * 512 * 768;
  for (int q = part * 12288 + tid; q < (part + 1) * 12288; q += NTHR) {
    const int row = q / 96, cc8 = q % 96, i = row >> 4, c = row & 15; f32x4 v0, v1;
    if (cc8 < 64) {
      const int s = cc8 >> 1, c0 = (cc8 & 1) * 8;
      const int dir = s < i ? 0 : 1, tau = s < i ? i - s : s - i;
      const LAS f32x4* kp = (const LAS f32x4*)(KK + ((dir * 32 + tau) * 16 + c) * 16 + c0);
      v0 = kp[0]; v1 = kp[1];
      if (s == i) { const LAS f32x4* k0p = (const LAS f32x4*)(KK + ((0 * 32 + 0) * 16 + c) * 16 + c0); v0 += k0p[0]; v1 += k0p[1];
        const float d = DD[c]; const int dj = c - c0;
        if (dj >= 0 && dj < 4) v0[dj] += d; else if (dj >= 4 && dj < 8) v1[dj - 4] += d; }
    } else {
      const int kk = (cc8 - 64) * 8, dir = kk >> 7, ri = (kk >> 6) & 1, p0 = kk & 63, tau = dir == 0 ? i + 1 : 32 - i;
      const LAS f32x4* cp = (const LAS f32x4*)(CC + (dir * 16 + c) * 64 + p0); const LAS f32x4* pp = (const LAS f32x4*)(POW + (dir * 33 + tau) * 64 + p0);
      float v[8];
#pragma unroll
      for (int j = 0; j < 4; ++j) { const f32x4 cc = cp[j], pw = pp[j];
        v[2 * j] = ri == 0 ? (cc.x * pw.x - cc.y * pw.y) : -(cc.x * pw.y + cc.y * pw.x); v[2 * j + 1] = ri == 0 ? (cc.z * pw.z - cc.w * pw.w) : -(cc.z * pw.w + cc.w * pw.z); }
      v0 = (f32x4){v[0], v[1], v[2], v[3]}; v1 = (f32x4){v[4], v[5], v[6], v[7]};
    }
    *(u32x4*)(TT + (size_t)row * 768 + cc8 * 8) = pack8(v0, v1);
  }
  bf16_t* WSm = (bf16_t*)(X.ws + WS_WS) + (size_t)g * 256 * 512;
  for (int q = part * 4096 + tid; q < (part + 1) * 4096; q += NTHR) {
    const int n = q >> 6, cc8 = q & 63, dir = n >> 7, ri = (n >> 6) & 1, p = n & 63, s = cc8 >> 1, c0 = (cc8 & 1) * 8, tau = dir == 0 ? 31 - s : s;
    const f32x2 pw = POW[(dir * 33 + tau) * 64 + p]; const LAS f32x4* bp = (const LAS f32x4*)(BB + (dir * 64 + p) * 16 + c0); float v[8];
#pragma unroll
    for (int j = 0; j < 4; ++j) { const f32x4 b = bp[j]; v[2 * j] = ri == 0 ? (pw.x * b.x - pw.y * b.y) : (pw.x * b.y + pw.y * b.x); v[2 * j + 1] = ri == 0 ? (pw.x * b.z - pw.y * b.w) : (pw.x * b.w + pw.y * b.z); }
    *(u32x4*)(WSm + (size_t)n * 512 + cc8 * 8) = pack8((f32x4){v[0], v[1], v[2], v[3]}, (f32x4){v[4], v[5], v[6], v[7]});
  }
  __syncthreads();
}

__device__ __forceinline__ void p0_dftconst(const Ctx& X, int idx) {
  for (int q = idx * NTHR + X.tid; q < 24576; q += 32 * NTHR) {
    float v[8]; bf16_t* dst;
    if (q < 8192) {
      const int R = q >> 5, c0 = (q & 31) * 8, ri = R >> 7, m = R & 127; dst = (bf16_t*)(X.ws + WS_DMT) + (size_t)R * 256 + c0;
#pragma unroll
      for (int j = 0; j < 8; ++j) { float s, c; sincospif((float)(((c0 + j) * m) & 255) * (1.f / 128.f), &s, &c); v[j] = ri == 0 ? c : (m == 0 ? (((c0 + j) & 1) ? -1.f : 1.f) : -s); }
    } else if (q < 16384) {
      const int q2 = q - 8192, R = q2 >> 5, c0 = (q2 & 31) * 8, rip = R >> 7, ka = R & 127; dst = (bf16_t*)(X.ws + WS_W1) + (size_t)R * 256 + c0;
#pragma unroll
      for (int j = 0; j < 8; ++j) { const int C = c0 + j, ri = C >> 7, ta = C & 127; float s, c; sincospif((float)((ka * ta) & 127) * (1.f / 64.f), &s, &c);
        v[j] = (rip == ri) ? c : (rip == 0 ? s : -s); }
    } else {
      const int q2 = q - 16384, R = q2 >> 5, c0 = (q2 & 31) * 8, kb = R & 127; dst = (bf16_t*)(X.ws + WS_W2) + (size_t)R * 256 + c0;
#pragma unroll
      for (int j = 0; j < 8; ++j) { const int C = c0 + j, rip = C >> 7, tb = C & 127; float s, c; sincospif((float)((kb * tb) & 127) * (1.f / 64.f), &s, &c);
        v[j] = (R < 128 ? (rip == 0 ? c : s) : (rip == 0 ? -s : c)) * (1.f / 2048.f); }
    }
    u32x4 o; o.x = cvt_pk_bf16(v[0], v[1]); o.y = cvt_pk_bf16(v[2], v[3]); o.z = cvt_pk_bf16(v[4], v[5]); o.w = cvt_pk_bf16(v[6], v[7]);
    *(u32x4*)dst = o;
  }
}

__device__ __forceinline__ void phase_prep(const Ctx& X, int rep) {
  const int c = X.c;
  if (c < 96) p0_adaln(X, c);
  else if (c < 224) p0_s5tables(X, (c - 96) >> 2, (c - 96) & 3);
  else p0_dftconst(X, c - 224);
  __syncthreads();
  unsigned* ctl = (unsigned*)(X.ws + WS_CTL);
  transpose_work(X, ctl + CW_DQ0 + 128 * rep, 0, IT_SMALL, 0, 0);
}

__device__ __forceinline__ void phase_mod0(const Ctx& X) {
  const Args& a = *X.a; const float* mod = (const float*)(X.ws + WS_MOD); bf16_t* A0 = (bf16_t*)(X.ws + WS_A0);
  const int gw = X.c * NWAVES + X.wave, NGW = X.G * NWAVES, lane = X.lane;
  f32x4 sh[4], sc[4], cur[4], nxt[4];
#pragma unroll
  for (int j = 0; j < 4; ++j) { sh[j] = ((const f32x4*)mod)[lane + 64 * j]; sc[j] = ((const f32x4*)(mod + 1024))[lane + 64 * j] + 1.f; }
  { const f32x4* xr = (const f32x4*)(a.in[IN_X] + (size_t)gw * 1024) + lane;
#pragma unroll
    for (int j = 0; j < 4; ++j) cur[j] = xr[64 * j]; }
  bool ctxmod = false;
  for (int r = gw; r < NROW; r += NGW) {
    const int rn = r + NGW;
    if (rn < NROW) { const f32x4* xr = (const f32x4*)(rn < TOK ? a.in[IN_X] + (size_t)rn * 1024 : a.in[IN_CTX] + (size_t)(rn - TOK) * 1024) + lane;
#pragma unroll
      for (int j = 0; j < 4; ++j) nxt[j] = xr[64 * j]; }
    if (r >= TOK && !ctxmod) { ctxmod = true;
#pragma unroll
      for (int j = 0; j < 4; ++j) { sh[j] = ((const f32x4*)(mod + 6144))[lane + 64 * j]; sc[j] = ((const f32x4*)(mod + 6144 + 1024))[lane + 64 * j] + 1.f; } }
    float ss = 0.f;
#pragma unroll
    for (int j = 0; j < 4; ++j) ss += (cur[j].x * cur[j].x + cur[j].y * cur[j].y) + (cur[j].z * cur[j].z + cur[j].w * cur[j].w);
    const float rr = rsqrtf(wave_sum(ss) * (1.f / 1024.f) + 1e-6f);
    u32x2* o8 = (u32x2*)(A0 + (size_t)r * 1024) + lane;
#pragma unroll
    for (int j = 0; j < 4; ++j) { const f32x4 f = cur[j] * rr * sc[j] + sh[j]; u32x2 w; w.x = cvt_pk_bf16(f.x, f.y); w.y = cvt_pk_bf16(f.z, f.w); o8[64 * j] = w; }
#pragma unroll
    for (int j = 0; j < 4; ++j) cur[j] = nxt[j];
  }
}


struct G1 {
  static constexpr bool PERM = true; static constexpr bool F8 = false; static constexpr int SCALE_B = 0x7A7A7A7A; static constexpr bool CONTIG = false; static constexpr bool ALIGN = true; static constexpr bool LINA = true, LINB = true; __device__ __forceinline__ size_t halfA() const { return 128u * 2048u; } __device__ __forceinline__ size_t halfB() const { return 128u * 2048u; } int K, nunits; unsigned char* ws; const float* qg; const float* kg;
  __device__ __forceinline__ void decode(int w, Unit& u) const { if (w < 390) { u.a = 0; u.pm = w / 6; u.pn = w % 6; } else { const int w2 = w - 390; u.a = 1; u.pm = w2 & 1; u.pn = w2 >> 1; } u.b = 0; }
  __device__ __forceinline__ const char* baseA(const Unit& u) const { return (const char*)ws + (u.a == 0 ? WS_A0 : WS_WIN_T + (size_t)1536 * 2048); }
  __device__ __forceinline__ const char* baseB(const Unit& u) const { return (const char*)ws + (u.a == 0 ? WS_WIN_T : WS_A0); }
  __device__ __forceinline__ unsigned rowA(const Unit& u, int r) const { return (unsigned)(u.pm * 256 + r) * 2048u; }
  __device__ __forceinline__ unsigned rowB(const Unit& u, int r) const { return (unsigned)(u.pn * 256 + r) * 2048u; }
  __device__ __forceinline__ void epi(const Acc& acc, const Unit& u, int wr, int wc, int fr, int fq) const {
    if (u.a == 1) {
      bf16_t* VT = (bf16_t*)(ws + WS_VT);
#pragma unroll
      for (int ai = 0; ai < 2; ++ai)
#pragma unroll
        for (int m = 0; m < 4; ++m) { const int dd = u.pm * 256 + ai * 128 + wr * 64 + m * 16 + fr, head = dd >> 6, d = dd & 63;
#pragma unroll
          for (int bj = 0; bj < 2; ++bj) { const int t0 = u.pn * 256 + bj * 128 + wc * 32 + 8 * fq, kr = t0 >> 6, cg = (t0 >> 3) & 7;
            *(u32x4*)((VT + ((((size_t)(head * 260 + kr) * 8 + cg) * 64 + d) * 8))) = pack8(acc[ai][bj][m][0], acc[ai][bj][m][1]); } }
      return;
    }
    if (u.pn < 2) {
      bf16_t* AS5 = (bf16_t*)(ws + WS_AS5);
#pragma unroll
      for (int ai = 0; ai < 2; ++ai)
#pragma unroll
        for (int m = 0; m < 4; ++m) { const int row = u.pm * 256 + ai * 128 + wr * 64 + m * 16 + fr; int crow, s;
          if (row < TOK) { crow = row >> 5; s = row & 31; } else { const int j = row - TOK; crow = 512 + (j >> 5); s = j & 31; }
#pragma unroll
          for (int bj = 0; bj < 2; ++bj) { const int g = 16 * u.pn + 8 * bj + 2 * wc + (fq >> 1), c0 = 8 * (fq & 1);
            *(u32x4*)((AS5 + ((size_t)(g * 768 + crow) * 768 + s * 16 + c0))) = pack8(acc[ai][bj][m][0], acc[ai][bj][m][1]); } }
      return;
    }
    const bool isq = u.pn < 4;
    if (isq && u.pm == 64) return;
    const int head = 4 * ((u.pn - 2) & 1) + wc; const float* gain = isq ? qg : kg;
    bf16_t* dst = isq ? (bf16_t*)(ws + WS_Q) : (bf16_t*)(ws + WS_K);
    f32x4 gv[2][2];
#pragma unroll
    for (int bj = 0; bj < 2; ++bj) { gv[bj][0] = *(const f32x4*)(gain + 32 * bj + 8 * fq); gv[bj][1] = *(const f32x4*)(gain + 32 * bj + 8 * fq + 4); }
#pragma unroll
    for (int ai = 0; ai < 2; ++ai)
#pragma unroll
      for (int m = 0; m < 4; ++m) { const int row = u.pm * 256 + ai * 128 + wr * 64 + m * 16 + fr; float ss = 0.f;
#pragma unroll
        for (int bj = 0; bj < 2; ++bj)
#pragma unroll
          for (int n = 0; n < 2; ++n) { const f32x4 x = acc[ai][bj][m][n]; ss += (x[0] * x[0] + x[1] * x[1]) + (x[2] * x[2] + x[3] * x[3]); }
        ss += sx(ss, 16); ss += sx(ss, 32);
        const float rinv = rsqrtf(ss * (1.f / 64.f) + 1e-6f);
#pragma unroll
        for (int bj = 0; bj < 2; ++bj) { const f32x4 v0 = acc[ai][bj][m][0] * rinv * gv[bj][0], v1 = acc[ai][bj][m][1] * rinv * gv[bj][1];
          if (isq) *(u32x4*)((dst + (size_t)row * 512 + head * 64 + 32 * bj + 8 * fq)) = pack8(v0, v1);
          else { const int kr = row >> 6, cg = (row >> 3) & 7, k8 = row & 7, ks = 2 * bj + (fq >> 1), hh2 = fq & 1;
            *(u32x4*)((dst + (((((size_t)(head * 260 + kr) * 8 + cg) * 4 + ks) * 8 + k8) * 2 + hh2) * 8)) = pack8(v0, v1); } } }
  }
};

struct G2 {
  static constexpr bool PERM = true; static constexpr bool F8 = false; static constexpr int SCALE_B = 0x7A7A7A7A; static constexpr bool CONTIG = false; static constexpr bool ALIGN = true; static constexpr bool LINA = true, LINB = true; __device__ __forceinline__ size_t halfA() const { return 128u * 1536u; } __device__ __forceinline__ size_t halfB() const { return 128u * 1024u; } int K, nunits; unsigned char* ws;
  __device__ __forceinline__ void decode(int w, Unit& u) const { u.a = w / 3; u.pm = w % 3; u.pn = 0; u.b = 0; }
  __device__ __forceinline__ const char* baseA(const Unit& u) const { return (const char*)ws + WS_AS5 + (size_t)u.a * 768 * 768 * 2; }
  __device__ __forceinline__ const char* baseB(const Unit& u) const { return (const char*)ws + WS_WS + (size_t)u.a * 256 * 512 * 2; }
  __device__ __forceinline__ unsigned rowA(const Unit& u, int r) const { return (unsigned)(u.pm * 256 + r) * 1536u; }
  __device__ __forceinline__ unsigned rowB(const Unit& u, int r) const { return (unsigned)r * 1024u; }
  __device__ __forceinline__ void epi(const Acc& acc, const Unit& u, int wr, int wc, int fr, int fq) const {
    float* SST = (float*)(ws + WS_SST) + (size_t)u.a * 768 * 256;
#pragma unroll
    for (int ai = 0; ai < 2; ++ai)
#pragma unroll
      for (int m = 0; m < 4; ++m) { const int crow = u.pm * 256 + ai * 128 + wr * 64 + m * 16 + fr; if (crow >= 520) continue;
#pragma unroll
        for (int bj = 0; bj < 2; ++bj) { float* p = SST + (size_t)crow * 256 + bj * 128 + wc * 32 + 8 * fq; *(f32x4*)p = acc[ai][bj][m][0]; *(f32x4*)(p + 4) = acc[ai][bj][m][1]; } }
  }
};

struct G3 {
  static constexpr bool PERM = true; static constexpr bool F8 = false; static constexpr int SCALE_B = 0x7A7A7A7A; static constexpr bool CONTIG = false; static constexpr bool ALIGN = true; static constexpr bool LINA = true, LINB = true; __device__ __forceinline__ size_t halfA() const { return 128u * 1536u; } __device__ __forceinline__ size_t halfB() const { return 128u * 1536u; } int K, nunits; unsigned char* ws;
  __device__ __forceinline__ void decode(int w, Unit& u) const { u.a = w >> 2; u.pm = (w >> 1) & 1; u.pn = w & 1; u.b = 0; }
  __device__ __forceinline__ const char* baseA(const Unit& u) const { return (const char*)ws + WS_AS5 + (size_t)u.a * 768 * 768 * 2; }
  __device__ __forceinline__ const char* baseB(const Unit& u) const { return (const char*)ws + WS_TT + (size_t)u.a * 512 * 768 * 2; }
  __device__ __forceinline__ unsigned rowA(const Unit& u, int r) const { return (unsigned)(u.pm * 256 + r) * 1536u; }
  __device__ __forceinline__ unsigned rowB(const Unit& u, int r) const { return (unsigned)(u.pn * 256 + r) * 1536u; }
  __device__ __forceinline__ void epi(const Acc& acc, const Unit& u, int wr, int wc, int fr, int fq) const {
    bf16_t* GB = (bf16_t*)(ws + WS_GB);
#pragma unroll
    for (int ai = 0; ai < 2; ++ai)
#pragma unroll
      for (int m = 0; m < 4; ++m) { const int crow = u.pm * 256 + ai * 128 + wr * 64 + m * 16 + fr;
#pragma unroll
        for (int bj = 0; bj < 2; ++bj) { const int pp = u.pn * 256 + bj * 128 + wc * 32 + 8 * fq, i = pp >> 4, c0 = pp & 15; f32x4 v0 = acc[ai][bj][m][0], v1 = acc[ai][bj][m][1];
#pragma unroll
          for (int j = 0; j < 4; ++j) { v0[j] = gelu_tanh(v0[j]); v1[j] = gelu_tanh(v1[j]); }
          *(u32x4*)((GB + (size_t)(crow * 32 + i) * 512 + u.a * 16 + c0)) = pack8(v0, v1); } }
  }
};

struct G4 {
  static constexpr bool PERM = true; static constexpr bool F8 = false; static constexpr int SCALE_B = 0x7A7A7A7A; static constexpr bool CONTIG = false; static constexpr bool ALIGN = true; static constexpr bool LINA = true, LINB = true; __device__ __forceinline__ size_t halfA() const { return 128u * 1024u; } __device__ __forceinline__ size_t halfB() const { return 128u * 1024u; } int K, nunits; unsigned char* ws; const float* bglu;
  __device__ __forceinline__ void decode(int w, Unit& u) const { u.pm = w >> 1; u.pn = w & 1; u.a = 0; u.b = 0; }
  __device__ __forceinline__ const char* baseA(const Unit&) const { return (const char*)ws + WS_GB; }
  __device__ __forceinline__ const char* baseB(const Unit&) const { return (const char*)ws + WS_WGLU_T; }
  __device__ __forceinline__ unsigned rowA(const Unit& u, int r) const { return (unsigned)(u.pm * 256 + r) * 1024u; }
  __device__ __forceinline__ unsigned rowB(const Unit& u, int r) const { return (unsigned)(u.pn * 256 + r) * 1024u; }
  __device__ __forceinline__ void epi(const Acc& acc, const Unit& u, int wr, int wc, int fr, int fq) const {
    const bf16_t* GB = (const bf16_t*)(ws + WS_GB); bf16_t* CC = (bf16_t*)(ws + WS_CONCAT);
#pragma unroll
    for (int bj = 0; bj < 2; ++bj) { const int col0 = u.pn * 256 + bj * 128 + wc * 32 + 8 * fq; const f32x4 b0 = *(const f32x4*)(bglu + col0), b1 = *(const f32x4*)(bglu + col0 + 4);
      u32x4 gin[2][4];
#pragma unroll
      for (int ai = 0; ai < 2; ++ai)
#pragma unroll
        for (int m = 0; m < 4; ++m) gin[ai][m] = *(const u32x4*)(GB + (size_t)(u.pm * 256 + ai * 128 + wr * 64 + m * 16 + fr) * 512 + col0);
#pragma unroll
      for (int ai = 0; ai < 2; ++ai)
#pragma unroll
        for (int m = 0; m < 4; ++m) { const int row = u.pm * 256 + ai * 128 + wr * 64 + m * 16 + fr; const u32x4 gw = gin[ai][m];
          f32x4 v0 = acc[ai][bj][m][0] + b0, v1 = acc[ai][bj][m][1] + b1;
          v0[0] = bf_lo(gw.x) * fast_sigmoid(v0[0]); v0[1] = bf_hi(gw.x) * fast_sigmoid(v0[1]); v0[2] = bf_lo(gw.y) * fast_sigmoid(v0[2]); v0[3] = bf_hi(gw.y) * fast_sigmoid(v0[3]);
          v1[0] = bf_lo(gw.z) * fast_sigmoid(v1[0]); v1[1] = bf_hi(gw.z) * fast_sigmoid(v1[1]); v1[2] = bf_lo(gw.w) * fast_sigmoid(v1[2]); v1[3] = bf_hi(gw.w) * fast_sigmoid(v1[3]);
          *(u32x4*)((CC + (size_t)row * 1024 + col0)) = pack8(v0, v1); } }
  }
};

struct GRes {
  static constexpr bool PERM = true; static constexpr bool F8 = false; static constexpr int SCALE_B = 0x7A7A7A7A; static constexpr bool CONTIG = false; static constexpr bool ALIGN = true; static constexpr bool LINA = true, LINB = true;
  __device__ __forceinline__ size_t halfA() const { return 128u * 2048u; } __device__ __forceinline__ size_t halfB() const { return 128u * 2048u; }
  int K, nunits; const char* A; const char* Bt; const float* hin32; const bf16_t* hin16; bf16_t* hout; const float* gate; const float* bias;
  __device__ __forceinline__ void decode(int w, Unit& u) const { u.pm = w >> 2; u.pn = w & 3; u.a = 0; u.b = 0; }
  __device__ __forceinline__ const char* baseA(const Unit&) const { return A; }
  __device__ __forceinline__ const char* baseB(const Unit&) const { return Bt; }
  __device__ __forceinline__ unsigned rowA(const Unit& u, int r) const { return (unsigned)(u.pm * 256 + r) * 2048u; }
  __device__ __forceinline__ unsigned rowB(const Unit& u, int r) const { return (unsigned)(u.pn * 256 + r) * 2048u; }
  __device__ __forceinline__ void epi(const Acc& acc, const Unit& u, int wr, int wc, int fr, int fq) const {
#pragma unroll
    for (int bj = 0; bj < 2; ++bj) { const int col0 = u.pn * 256 + bj * 128 + wc * 32 + 8 * fq;
      const f32x4 g0 = *(const f32x4*)(gate + col0), g1 = *(const f32x4*)(gate + col0 + 4);
      f32x4 b0 = (f32x4){0.f, 0.f, 0.f, 0.f}, b1 = b0; if (bias) { b0 = *(const f32x4*)(bias + col0); b1 = *(const f32x4*)(bias + col0 + 4); }
      if (hin32) { f32x4 hi[2][4][2];
#pragma unroll
        for (int ai = 0; ai < 2; ++ai)
#pragma unroll
          for (int m = 0; m < 4; ++m) { const size_t off = (size_t)(u.pm * 256 + ai * 128 + wr * 64 + m * 16 + fr) * 1024 + col0; hi[ai][m][0] = *(const f32x4*)(hin32 + off); hi[ai][m][1] = *(const f32x4*)(hin32 + off + 4); }
#pragma unroll
        for (int ai = 0; ai < 2; ++ai)
#pragma unroll
          for (int m = 0; m < 4; ++m) { const size_t off = (size_t)(u.pm * 256 + ai * 128 + wr * 64 + m * 16 + fr) * 1024 + col0;
            *(u32x4*)(hout + off) = pack8(hi[ai][m][0] + g0 * (acc[ai][bj][m][0] + b0), hi[ai][m][1] + g1 * (acc[ai][bj][m][1] + b1)); }
      } else { u32x4 hi[2][4];
#pragma unroll
        for (int ai = 0; ai < 2; ++ai)
#pragma unroll
          for (int m = 0; m < 4; ++m) hi[ai][m] = *(const u32x4*)(hin16 + (size_t)(u.pm * 256 + ai * 128 + wr * 64 + m * 16 + fr) * 1024 + col0);
#pragma unroll
        for (int ai = 0; ai < 2; ++ai)
#pragma unroll
          for (int m = 0; m < 4; ++m) { const size_t off = (size_t)(u.pm * 256 + ai * 128 + wr * 64 + m * 16 + fr) * 1024 + col0; const u32x4 w = hi[ai][m];
            const f32x4 h0 = (f32x4){bf_lo(w.x), bf_hi(w.x), bf_lo(w.y), bf_hi(w.y)}, h1 = (f32x4){bf_lo(w.z), bf_hi(w.z), bf_lo(w.w), bf_hi(w.w)};
            *(u32x4*)(hout + off) = pack8(h0 + g0 * (acc[ai][bj][m][0] + b0), h1 + g1 * (acc[ai][bj][m][1] + b1)); }
      } }
  }
};

__device__ __forceinline__ void build_moetab(const Ctx& X, int layer, LAS int* toff) {
  const unsigned* cnt = (const unsigned*)(X.ws + WS_CTL) + CW_CNT + layer * 2048;
  LAS int* texp = toff + 256;
  LAS int* ntile = toff + 132;
  __syncthreads();
  if (X.tid < 64) ntile[X.tid] = ((int)__hip_atomic_load(cnt + X.tid * 32, __ATOMIC_RELAXED, __HIP_MEMORY_SCOPE_AGENT) + 255) >> 8;
  __syncthreads();
  if (X.tid == 0) { int s = 0; for (int e = 0; e < 64; ++e) { toff[e] = s; s += ntile[e]; } toff[64] = s; toff[65] = s + 64; }
  __syncthreads();
  if (X.tid < 65) { const int e = X.tid; const int lo = toff[e], hi = toff[e + 1]; for (int t = lo; t < hi && t < 704; ++t) texp[t] = e; }
  __syncthreads();
}
__device__ __forceinline__ int find_expert(const LAS int* toff, int ti) { return toff[256 + ti]; }

struct G6 {
  static constexpr bool PERM = true; static constexpr bool F8 = true; static constexpr int SCALE_B = 0x7A7A7A7A; static constexpr bool CONTIG = false; static constexpr bool ALIGN = true; static constexpr bool LINA = false, LINB = true;
  __device__ __forceinline__ size_t halfA() const { return 0; } __device__ __forceinline__ size_t halfB() const { return 128u * 1024u; }
  int K, nunits; unsigned char* ws; const LAS int* toff; const LAS unsigned* tokt; const char* wbase; size_t wstride;
  __device__ __forceinline__ void decode(int w, Unit& u) const { const int ti = w >> 1; u.pn = w & 1; u.a = find_expert(toff, ti); u.pm = ti - toff[u.a]; u.b = ti; }
  __device__ __forceinline__ const char* baseA(const Unit&) const { return (const char*)ws + WS_F; }
  __device__ __forceinline__ const char* baseB(const Unit& u) const { return wbase + (size_t)u.a * wstride; }
  __device__ __forceinline__ unsigned rowA(const Unit& u, int r) const { return tokt[u.ord * 256 + r]; }
  __device__ __forceinline__ void build_tokt(const Ctx& X, LAS unsigned* tk) const {
    for (int i = 0; i * X.G + X.c < nunits; ++i) { Unit u; decode(xcd_remap(i * X.G + X.c, nunits), u);
      if (X.tid < 256) { const int idx = u.pm * 256 + X.tid; int tok = idx;
        if (u.a < 64) tok = ((const int*)(ws + WS_LTOK))[u.a * 16384 + idx];
        tk[i * 256 + X.tid] = (unsigned)tok * 1024u; } }
    __syncthreads();
  }
  __device__ __forceinline__ unsigned rowB(const Unit& u, int r) const { return (unsigned)(u.pn * 256 + r) * 1024u; }
  __device__ __forceinline__ void epi(const Acc& acc, const Unit& u, int wr, int wc, int fr, int fq) const {
    unsigned char* HID = ws + WS_HID;
#pragma unroll
    for (int ai = 0; ai < 2; ++ai)
#pragma unroll
      for (int m = 0; m < 4; ++m) { const size_t hrow = (size_t)u.b * 256 + ai * 128 + wr * 64 + m * 16 + fr; f32x4 v0, v1;
#pragma unroll
        for (int j = 0; j < 4; ++j) { const float g0 = acc[ai][0][m][0][j] * 0.03125f, g1 = acc[ai][0][m][1][j] * 0.03125f; v0[j] = g0 * fast_sigmoid(g0) * (acc[ai][1][m][0][j] * 0.25f); v1[j] = g1 * fast_sigmoid(g1) * (acc[ai][1][m][1][j] * 0.25f); }
        *(u32x2*)(HID + hrow * 256 + u.pn * 128 + wc * 32 + 8 * fq) = (u32x2){(unsigned)pack4_fp8(v0[0], v0[1], v0[2], v0[3]), (unsigned)pack4_fp8(v1[0], v1[1], v1[2], v1[3])}; }
  }
};
struct G7 {
  static constexpr bool PERM = true; static constexpr bool F8 = true; static constexpr int SCALE_B = 0x7A7A7A7A; static constexpr bool CONTIG = false; static constexpr bool ALIGN = true; static constexpr bool LINA = true, LINB = true;
  __device__ __forceinline__ size_t halfA() const { return 128u * 256u; } __device__ __forceinline__ size_t halfB() const { return 128u * 256u; }
  int K, nunits; unsigned char* ws; const LAS int* toff; const char* wbase; size_t wstride;
  __device__ __forceinline__ void decode(int w, Unit& u) const { const int ti = w >> 2; u.pn = w & 3; u.a = find_expert(toff, ti); u.pm = ti - toff[u.a]; u.b = ti; }
  __device__ __forceinline__ const char* baseA(const Unit&) const { return (const char*)ws + WS_HID; }
  __device__ __forceinline__ const char* baseB(const Unit& u) const { return wbase + (size_t)u.a * wstride; }
  __device__ __forceinline__ unsigned rowA(const Unit& u, int r) const { return (unsigned)(u.b * 256 + r) * 256u; }
  __device__ __forceinline__ unsigned rowB(const Unit& u, int r) const { return (unsigned)(u.pn * 256 + r) * 256u; }
  __device__ __forceinline__ void epi(const Acc& acc, const Unit& u, int wr, int wc, int fr, int fq) const {
    unsigned char* YAS = ws + WS_YAS;
#pragma unroll
    for (int ai = 0; ai < 2; ++ai)
#pragma unroll
      for (int m = 0; m < 4; ++m) { const size_t yrow = (size_t)u.b * 256 + ai * 128 + wr * 64 + m * 16 + fr;
#pragma unroll
        for (int bj = 0; bj < 2; ++bj) { const f32x4 v0 = acc[ai][bj][m][0] * 0.00390625f, v1 = acc[ai][bj][m][1] * 0.00390625f;
          const int w0 = pack4_fp8(v0[0], v0[1], v0[2], v0[3]), w1 = pack4_fp8(v1[0], v1[1], v1[2], v1[3]);
          *(u32x2*)(YAS + yrow * 1024 + u.pn * 256 + bj * 128 + wc * 32 + 8 * fq) = (u32x2){(unsigned)w0, (unsigned)w1}; } }
  }
};

struct G8 {
  static constexpr bool PERM = true; static constexpr bool F8 = false; static constexpr int SCALE_B = 0x7A7A7A7A; static constexpr bool CONTIG = false; static constexpr bool ALIGN = true; static constexpr bool LINA = true, LINB = false; __device__ __forceinline__ size_t halfA() const { return 128u * 512u; } __device__ __forceinline__ size_t halfB() const { return 0; } int K, nunits; unsigned char* ws;
  __device__ __forceinline__ void decode(int w, Unit& u) const { u.pm = 0; u.a = (w >> 6) & 3; u.pn = w & 63; u.b = 0; }
  __device__ __forceinline__ const char* baseA(const Unit&) const { return (const char*)ws + WS_DMT; }
  __device__ __forceinline__ const char* baseB(const Unit& u) const { return (const char*)ws + WS_A1 + (size_t)u.a * 512; }
  __device__ __forceinline__ unsigned rowA(const Unit&, int r) const { return (unsigned)r * 512u; }
  __device__ __forceinline__ unsigned rowB(const Unit& u, int r) const { const int n = u.pn * 256 + r; return (unsigned)(128 * (n & 127) + (n >> 7)) * 2048u; }
  __device__ __forceinline__ void epi(const Acc& acc, const Unit& u, int wr, int wc, int fr, int fq) const {
    bf16_t* X1 = (bf16_t*)(ws + WS_X1);
#pragma unroll
    for (int ai = 0; ai < 2; ++ai)
#pragma unroll
      for (int m = 0; m < 4; ++m) { const int mm = wr * 64 + m * 16 + fr;
#pragma unroll
        for (int bj = 0; bj < 2; ++bj) { const int n0 = u.pn * 256 + bj * 128 + wc * 32 + 8 * fq, tb = n0 >> 7, ta0 = n0 & 127;
          *(u32x4*)((X1 + ((((size_t)(u.a * 128 + mm) * 128 + tb) * 2 + ai) * 128 + ta0))) = pack8(acc[ai][bj][m][0], acc[ai][bj][m][1]); } }
  }
};
struct G9 {
  static constexpr bool PERM = true; static constexpr bool F8 = false; static constexpr int SCALE_B = 0x7A7A7A7A; static constexpr bool CONTIG = false; static constexpr bool ALIGN = true; static constexpr bool LINA = true, LINB = true; __device__ __forceinline__ size_t halfA() const { return 128u * 512u; } __device__ __forceinline__ size_t halfB() const { return 128u * 512u; } int K, nunits; unsigned char* ws;
  __device__ __forceinline__ void decode(int w, Unit& u) const { u.pm = 0; u.pn = w; u.a = 0; u.b = 0; }
  __device__ __forceinline__ const char* baseA(const Unit&) const { return (const char*)ws + WS_W1; }
  __device__ __forceinline__ const char* baseB(const Unit&) const { return (const char*)ws + WS_X1; }
  __device__ __forceinline__ unsigned rowA(const Unit&, int r) const { return (unsigned)r * 512u; }
  __device__ __forceinline__ unsigned rowB(const Unit& u, int r) const { return (unsigned)(u.pn * 256 + r) * 512u; }
  __device__ __forceinline__ void epi(const Acc& acc, const Unit& u, int wr, int wc, int fr, int fq) const {
    bf16_t* X2 = (bf16_t*)(ws + WS_X2);
#pragma unroll
    for (int m = 0; m < 4; ++m) { const int ka = wr * 64 + m * 16 + fr;
#pragma unroll
      for (int bj = 0; bj < 2; ++bj) { const int n0 = u.pn * 256 + bj * 128 + wc * 32 + 8 * fq, gm = n0 >> 7, tb0 = n0 & 127; f32x4 r0, r1, i0, i1;
#pragma unroll
        for (int j = 0; j < 4; ++j) {
          { const float ang = (float)((ka * (tb0 + j)) & 16383) * (1.f / 16384.f), cs = __builtin_amdgcn_cosf(ang), sn = __builtin_amdgcn_sinf(ang); const float yr = acc[0][bj][m][0][j], yi = acc[1][bj][m][0][j]; r0[j] = yr * cs + yi * sn; i0[j] = yi * cs - yr * sn; }
          { const float ang = (float)((ka * (tb0 + 4 + j)) & 16383) * (1.f / 16384.f), cs = __builtin_amdgcn_cosf(ang), sn = __builtin_amdgcn_sinf(ang); const float yr = acc[0][bj][m][1][j], yi = acc[1][bj][m][1][j]; r1[j] = yr * cs + yi * sn; i1[j] = yi * cs - yr * sn; } }
        bf16_t* p = X2 + (((size_t)(gm * 128 + ka) * 2) * 128 + tb0); *(u32x4*)(p) = pack8(r0, r1); *(u32x4*)((p + 128)) = pack8(i0, i1); } }
  }
};
struct G10 {
  static constexpr bool PERM = true; static constexpr bool F8 = false; static constexpr int SCALE_B = 0x7A7A7A7A; static constexpr bool CONTIG = false; static constexpr bool ALIGN = true; static constexpr bool LINA = true, LINB = false; __device__ __forceinline__ size_t halfA() const { return 128u * 512u; } __device__ __forceinline__ size_t halfB() const { return 0; } int K, nunits; unsigned char* ws;
  __device__ __forceinline__ void decode(int w, Unit& u) const { u.pm = 0; u.pn = w; u.a = 0; u.b = 0; }
  __device__ __forceinline__ const char* baseA(const Unit&) const { return (const char*)ws + WS_W2; }
  __device__ __forceinline__ const char* baseB(const Unit&) const { return (const char*)ws + WS_X2; }
  __device__ __forceinline__ unsigned rowA(const Unit&, int r) const { return (unsigned)r * 512u; }
  __device__ __forceinline__ unsigned rowB(const Unit& u, int r) const { const int n = u.pn * 256 + r, ka = n >> 9, gm = n & 511; return (unsigned)(gm * 128 + ka) * 512u; }
  __device__ __forceinline__ void epi(const Acc& acc, const Unit& u, int wr, int wc, int fr, int fq) const {
    bf16_t* FB = (bf16_t*)(ws + WS_FB); float2* SPC = (float2*)(ws + WS_SPC); const int ka = u.pn >> 1;
#pragma unroll
    for (int m = 0; m < 4; ++m) { const int kb = wr * 64 + m * 16 + fr; const int k = ka + 128 * kb, kmir = (16384 - k) & 16383;
#pragma unroll
      for (int bj = 0; bj < 2; ++bj) { const int gm0 = (u.pn & 1) * 256 + bj * 128 + wc * 32 + 8 * fq, d0 = (gm0 >> 7) * 128 + (gm0 & 127); const u32x4 o = pack8(acc[0][bj][m][0], acc[0][bj][m][1]);
        *(u32x4*)(FB + (size_t)k * 1024 + d0) = o; *(u32x4*)(FB + (size_t)kmir * 1024 + 512 + d0) = o;
        if ((gm0 & 127) == 0) SPC[k * 4 + (gm0 >> 7)] = make_float2(acc[0][bj][m][0][0], acc[1][bj][m][0][0]); } }
  }
};
}
namespace mk {
typedef float f32x16 __attribute__((ext_vector_type(16)));

__device__ __forceinline__ void phase_scan(const Ctx& X) {
  if (X.c >= 64) return;
  const int seg = X.wave, g = X.c >> 1, dir = X.c & 1, p = X.lane;
  const float2 lam = ((const float2*)(X.ws + WS_LAML))[(dir * 32 + g) * 64 + p];
  const float* S = (const float*)(X.ws + WS_SST) + (size_t)g * 768 * 256 + dir * 128 + p;
  bf16_t* XP = (bf16_t*)(X.ws + WS_AS5) + (size_t)g * 768 * 768 + 512 + dir * 128 + p;
  LAS float* EX = (LAS float*)X.lds;
  const int j0 = seg * 65;
  float xr = 0.f, xi = 0.f;
#pragma unroll
  for (int b = 0; b < 2; ++b) {
    float sr[33], si[33];
#pragma unroll
    for (int k = 0; k < 33 - b; ++k) { const int j = j0 + 33 * b + k; const int row = dir == 0 ? (j < 8 ? 512 + j : j - 8) : 519 - j; sr[k] = S[(size_t)row * 256]; si[k] = S[(size_t)row * 256 + 64]; }
#pragma unroll
    for (int k = 0; k < 33 - b; ++k) { const float nr = lam.x * xr - lam.y * xi + sr[k], ni = lam.x * xi + lam.y * xr + si[k]; xr = nr; xi = ni; }
  }
  EX[(seg * 64 + p) * 2] = xr; EX[(seg * 64 + p) * 2 + 1] = xi;
  float pr = 1.f, pi = 0.f;
  for (int k = 0; k < 65; ++k) { const float nr = pr * lam.x - pi * lam.y, ni = pr * lam.y + pi * lam.x; pr = nr; pi = ni; }
  __syncthreads();
  float cr = 0.f, ci = 0.f;
  for (int s2 = 0; s2 < seg; ++s2) { const float er = EX[(s2 * 64 + p) * 2], ei = EX[(s2 * 64 + p) * 2 + 1];
    const float nr = pr * cr - pi * ci + er, ni = pr * ci + pi * cr + ei; cr = nr; ci = ni; }
  xr = cr; xi = ci;
#pragma unroll
  for (int b = 0; b < 2; ++b) {
    float sr[33], si[33];
#pragma unroll
    for (int k = 0; k < 33 - b; ++k) { const int j = j0 + 33 * b + k; const int row = dir == 0 ? (j < 8 ? 512 + j : j - 8) : 519 - j; sr[k] = S[(size_t)row * 256]; si[k] = S[(size_t)row * 256 + 64]; }
#pragma unroll
    for (int k = 0; k < 33 - b; ++k) { const int j = j0 + 33 * b + k; const int row = dir == 0 ? (j < 8 ? 512 + j : j - 8) : 519 - j;
      XP[(size_t)row * 768] = f2bf(xr); XP[(size_t)row * 768 + 64] = f2bf(xi);
      const float nr = lam.x * xr - lam.y * xi + sr[k], ni = lam.x * xi + lam.y * xr + si[k]; xr = nr; xi = ni; }
  }
  __syncthreads();
}

__device__ __forceinline__ void zero_lists(const Ctx& X) {
  u32x4* z = (u32x4*)(X.ws + WS_LTOK); unsigned zu_ = 0u; asm volatile("" : "+v"(zu_)); const u32x4 zero = (u32x4){zu_, zu_, zu_, zu_};
  for (int i = X.c * NTHR + X.tid; i < (int)(4 * MiB / 16); i += X.G * NTHR) z[i] = zero;
}
#define MFMA32(a, b, c) __builtin_amdgcn_mfma_f32_32x32x16_bf16((a), (b), (c), 0, 0, 0)
__device__ __forceinline__ void attn_unit(const Ctx& X, const LAS float* rpbl, int head, int tile) {
  const bf16_t* Q = (const bf16_t*)(X.ws + WS_Q); const bf16_t* Kb = (const bf16_t*)(X.ws + WS_K); const bf16_t* VT = (const bf16_t*)(X.ws + WS_VT);
  bf16_t* CCt = (bf16_t*)(X.ws + WS_CONCAT);
  const int lane = X.lane, ql = lane & 31, hh = lane >> 5;
  const int rp = tile >> 2, mt = tile & 3;
  const int r = 2 * rp + (ql >> 4), cq = 16 * mt + (ql & 15), tq = r * 64 + cq;
  const int r0q = min(max(r - 4, 0), 248), csq = min(max(cq - 8, 0), 48);
  const int rlo = min(max(2 * rp - 4, 0), 248), rhi = min(max(2 * rp - 3, 0), 248) + 7;
  const int csb = min(max(16 * mt - 8, 0), 32);
  const int nloc = rhi - rlo + 1;
  unsigned cmask = 0u;
#pragma unroll
  for (int k = 0; k < 32; ++k) cmask |= ((csb + k >= csq) && (csb + k <= csq + 15)) ? (1u << k) : 0u;
  bf16x8 qf[4];
#pragma unroll
  for (int ks = 0; ks < 4; ++ks) qf[ks] = *(const bf16x8*)(Q + (size_t)tq * 512 + head * 64 + 16 * ks + 8 * hh);
  const int kperm = (ql & ~12) | ((ql & 4) << 1) | ((ql & 8) >> 1);
  f32x16 o0, o1;
#pragma unroll
  for (int i = 0; i < 16; ++i) { o0[i] = 0.f; o1[i] = 0.f; }
  float lsum = 0.f;
  const float c1 = 0.125f * 1.44269504f, c2 = 8.f * 1.44269504f;
  const float* rp_h = nullptr; (void)rp_h;
  const size_t koff_lane = (size_t)(((kperm >> 3) * 4 * 8 + (kperm & 7)) * 2 + hh) * 8;
  const size_t voff_lane = (size_t)(hh * 64 + ql) * 8;
  bf16x8 kf[4], vf[2][2];
  { const int kr0 = rlo, cg0 = csb >> 3;
    const bf16_t* kp = Kb + ((size_t)(head * 260 + kr0) * 8 + cg0) * 512 + koff_lane; const bf16_t* vp = VT + ((size_t)(head * 260 + kr0) * 8 + cg0) * 512 + voff_lane;
#pragma unroll
    for (int ks = 0; ks < 4; ++ks) kf[ks] = *(const bf16x8*)(kp + ks * 128);
#pragma unroll
    for (int db = 0; db < 2; ++db)
#pragma unroll
      for (int s2 = 0; s2 < 2; ++s2) vf[db][s2] = *(const bf16x8*)(vp + db * 256 + s2 * 1024); }
  for (int b = 0; b < nloc + 8; ++b) {
    const bool loc = b < nloc;
    const int kr = rlo + b;
    bf16x8 kc[4], vc[2][2];
#pragma unroll
    for (int ks = 0; ks < 4; ++ks) kc[ks] = kf[ks];
#pragma unroll
    for (int db = 0; db < 2; ++db)
#pragma unroll
      for (int s2 = 0; s2 < 2; ++s2) vc[db][s2] = vf[db][s2];
    if (b + 1 < nloc + 8) { const int bn = b + 1; const int krn = bn < nloc ? rlo + bn : 256 + ((bn - nloc) >> 1), cgn = bn < nloc ? (csb >> 3) : 4 * ((bn - nloc) & 1);
      const bf16_t* kp = Kb + ((size_t)(head * 260 + krn) * 8 + cgn) * 512 + koff_lane; const bf16_t* vp = VT + ((size_t)(head * 260 + krn) * 8 + cgn) * 512 + voff_lane;
#pragma unroll
      for (int ks = 0; ks < 4; ++ks) kf[ks] = *(const bf16x8*)(kp + ks * 128);
#pragma unroll
      for (int db = 0; db < 2; ++db)
#pragma unroll
        for (int s2 = 0; s2 < 2; ++s2) vf[db][s2] = *(const bf16x8*)(vp + db * 256 + s2 * 1024); }
    f32x16 sacc;
#pragma unroll
    for (int i = 0; i < 16; ++i) sacc[i] = 0.f;
#pragma unroll
    for (int ks = 0; ks < 4; ++ks) sacc = MFMA32(kc[ks], qf[ks], sacc);
    float pv[16];
    if (loc) {
      const bool rowok = (kr >= r0q) && (kr <= r0q + 7);
      const int dr = min(max(kr - r + 7, 0), 14);
      const LAS float* bp = rpbl + (head * 15 + dr) * 31;
      const int dc0 = csb - cq + 15;
#pragma unroll
      for (int i = 0; i < 16; ++i) { const int kidx = 16 * (i >> 3) + 8 * hh + (i & 7);
        const bool ok = rowok && ((cmask >> kidx) & 1u);
        const float bias = bp[min(max(dc0 + kidx, 0), 30)];
        const float e = __builtin_amdgcn_exp2f(sacc[i] * c1 + bias * 1.44269504f - c2); pv[i] = ok ? e : 0.f; }
    } else {
#pragma unroll
      for (int i = 0; i < 16; ++i) pv[i] = __builtin_amdgcn_exp2f(sacc[i] * c1 - c2);
    }
    u32x4 p0, p1;
    p0.x = cvt_pk_bf16(pv[0], pv[1]); p0.y = cvt_pk_bf16(pv[2], pv[3]); p0.z = cvt_pk_bf16(pv[4], pv[5]); p0.w = cvt_pk_bf16(pv[6], pv[7]);
    p1.x = cvt_pk_bf16(pv[8], pv[9]); p1.y = cvt_pk_bf16(pv[10], pv[11]); p1.z = cvt_pk_bf16(pv[12], pv[13]); p1.w = cvt_pk_bf16(pv[14], pv[15]);
    lsum += (bf_lo(p0.x) + bf_hi(p0.x)) + (bf_lo(p0.y) + bf_hi(p0.y)) + (bf_lo(p0.z) + bf_hi(p0.z)) + (bf_lo(p0.w) + bf_hi(p0.w))
          + (bf_lo(p1.x) + bf_hi(p1.x)) + (bf_lo(p1.y) + bf_hi(p1.y)) + (bf_lo(p1.z) + bf_hi(p1.z)) + (bf_lo(p1.w) + bf_hi(p1.w));
    const bf16x8 pb0 = __builtin_bit_cast(bf16x8, p0), pb1 = __builtin_bit_cast(bf16x8, p1);
    o0 = MFMA32(vc[0][0], pb0, o0); o0 = MFMA32(vc[0][1], pb1, o0);
    o1 = MFMA32(vc[1][0], pb0, o1); o1 = MFMA32(vc[1][1], pb1, o1);
  }
  lsum += sx(lsum, 32);
  const float inv = 1.f / lsum;
  bf16_t* op = CCt + (size_t)tq * 1024 + 512 + head * 64 + 4 * hh;
#pragma unroll
  for (int gq = 0; gq < 4; ++gq) {
    u32x2 w0, w1;
    w0.x = cvt_pk_bf16(o0[4 * gq] * inv, o0[4 * gq + 1] * inv); w0.y = cvt_pk_bf16(o0[4 * gq + 2] * inv, o0[4 * gq + 3] * inv);
    w1.x = cvt_pk_bf16(o1[4 * gq] * inv, o1[4 * gq + 1] * inv); w1.y = cvt_pk_bf16(o1[4 * gq + 2] * inv, o1[4 * gq + 3] * inv);
    *(u32x2*)(op + 8 * gq) = w0; *(u32x2*)(op + 32 + 8 * gq) = w1;
  }
}
__device__ __forceinline__ void phase_attn(const Ctx& X) {
  LAS float* rpbl = (LAS float*)X.lds;
  zero_lists(X);
  for (int i = X.tid; i < 8 * 15 * 31; i += NTHR) rpbl[i] = X.a->in[IN_RPB][i];
  __syncthreads();
  const int gw = X.c * NWAVES + X.wave, NGW = X.G * NWAVES;
  for (int U = gw; U < 4096; U += NGW) attn_unit(X, rpbl, U >> 9, U & 511);
}

__device__ __forceinline__ void fourier_fix(const Ctx& X, int nunits) {
  const float2* SPC = (const float2*)(X.ws + WS_SPC); bf16_t* FB = (bf16_t*)(X.ws + WS_FB);
  for (int i = 0; i * X.G + X.c < nunits; ++i) { const int pm = xcd_remap(i * X.G + X.c, nunits) >> 2;
    for (int q = X.tid; q < 1024; q += NTHR) { const int k = pm * 256 + (q >> 2), g = q & 3, kmir = (16384 - k) & 16383;
      const float2 a = SPC[k * 4 + g], b = SPC[kmir * 4 + g];
      FB[(size_t)k * 1024 + g * 128] = f2bf(0.5f * (a.x + b.x)); FB[(size_t)k * 1024 + 512 + g * 128] = f2bf(0.5f * (a.y + b.y)); } }
  __syncthreads();
}

__device__ __forceinline__ void phase_router(const Ctx& X, int layer, int dry) {
  const float* mod = (const float*)(X.ws + WS_MOD) + (layer == 0 ? 0 : 2 * 6144);
  const float* shift = mod + 3072; const float* scale = mod + 4096;
  const bf16_t* h = (const bf16_t*)(X.ws + WS_HB); bf16_t* F = (bf16_t*)(X.ws + WS_F);
  unsigned* cntg = (unsigned*)(X.ws + WS_CTL) + CW_CNT + layer * 2048;
  int* ltok = (int*)(X.ws + WS_LTOK); int* asg = (int*)(X.ws + WS_ASG);
  const bf16_t* WR = (const bf16_t*)(X.ws + WS_WROUT_T) + (size_t)layer * 64 * 1024;
  const float* rbias = X.a->in[IN_RBIAS] + layer * 64;
  constexpr int FROW = 2064;
  const int lane = X.lane, wave = X.wave, tid = X.tid;
  f32x4 scv[4], shv[4]; float rb[8];
#pragma unroll
  for (int j = 0; j < 4; ++j) { scv[j] = ((const f32x4*)scale)[lane + 64 * j] + 1.f; shv[j] = ((const f32x4*)shift)[lane + 64 * j]; }
#pragma unroll
  for (int j = 0; j < 8; ++j) rb[j] = rbias[(tid & 7) * 8 + j];
  for (int tile = X.c; tile < TOK / 64; tile += X.G) {
    const int t0 = tile * 64;
    { u32x2 raw[8][4];
#pragma unroll
      for (int rr = 0; rr < 8; ++rr) { const u32x2* xr = (const u32x2*)(h + (size_t)(t0 + wave * 8 + rr) * 1024) + lane;
#pragma unroll
        for (int j = 0; j < 4; ++j) raw[rr][j] = xr[64 * j]; }
#pragma unroll
      for (int rr = 0; rr < 8; ++rr) {
        const int lr = wave * 8 + rr, t = t0 + lr; float ss = 0.f; f32x4 v[4];
#pragma unroll
        for (int j = 0; j < 4; ++j) { const u32x2 w = raw[rr][j]; v[j] = (f32x4){bf_lo(w.x), bf_hi(w.x), bf_lo(w.y), bf_hi(w.y)}; ss += (v[j].x * v[j].x + v[j].y * v[j].y) + (v[j].z * v[j].z + v[j].w * v[j].w); }
        const float r = rsqrtf(wave_sum(ss) * (1.f / 1024.f) + 1e-6f);
#pragma unroll
        for (int j = 0; j < 4; ++j) { const f32x4 f = v[j] * r * scv[j] + shv[j];
          u32x2 w; w.x = cvt_pk_bf16(f.x, f.y); w.y = cvt_pk_bf16(f.z, f.w);
          if (!dry) ((int*)((unsigned char*)F + (size_t)t * 1024))[lane + 64 * j] = pack4_fp8(f.x, f.y, f.z, f.w);
          *(LAS u32x2*)(X.lds + lr * FROW + (lane + 64 * j) * 8) = w; }
      }
    }
    __syncthreads();
    f32x4 pl[4][4];
    { const int fr = lane & 15, fq = lane >> 4;
#pragma unroll
      for (int a = 0; a < 4; ++a)
#pragma unroll
        for (int b = 0; b < 4; ++b) pl[a][b] = (f32x4){0.f, 0.f, 0.f, 0.f};
      bf16x8 bq[4][4];
#pragma unroll
      for (int ks = 0; ks < 4; ++ks)
#pragma unroll
        for (int eb = 0; eb < 4; ++eb) bq[ks][eb] = *(const bf16x8*)(WR + (size_t)(eb * 16 + fr) * 1024 + wave * 128 + ks * 32 + fq * 8);
#pragma unroll
      for (int ks = 0; ks < 4; ++ks) {
        bf16x8 af[4];
#pragma unroll
        for (int rb = 0; rb < 4; ++rb) af[rb] = *(const LAS bf16x8*)(X.lds + (rb * 16 + fr) * FROW + (wave * 128 + ks * 32 + fq * 8) * 2);
#pragma unroll
        for (int rb = 0; rb < 4; ++rb)
#pragma unroll
          for (int eb = 0; eb < 4; ++eb) pl[rb][eb] = __builtin_amdgcn_mfma_f32_16x16x32_bf16(af[rb], bq[ks][eb], pl[rb][eb], 0, 0, 0);
      }
    }
    __syncthreads();
    { LAS float* PART = (LAS float*)X.lds;
      const int fr = lane & 15, fq = lane >> 4;
#pragma unroll
      for (int rb = 0; rb < 4; ++rb)
#pragma unroll
        for (int eb = 0; eb < 4; ++eb)
#pragma unroll
          for (int j = 0; j < 4; ++j) PART[(wave * 64 + rb * 16 + 4 * fq + j) * 64 + eb * 16 + fr] = pl[rb][eb][j];
      __syncthreads();
      float sum[8];
#pragma unroll
      for (int i = 0; i < 8; ++i) { float a = 0.f;
#pragma unroll
        for (int w = 0; w < 8; ++w) a += PART[w * 4096 + i * 512 + tid];
        sum[i] = a; }
      __syncthreads();
      LAS float* LG0 = (LAS float*)X.lds;
#pragma unroll
      for (int i = 0; i < 8; ++i) { const int o = i * 512 + tid; LG0[(o >> 6) * 65 + (o & 63)] = sum[i]; }
    }
    LAS float* LG = (LAS float*)X.lds;
    LAS float* GS = LG + 64 * 65;
    LAS float* SELV = GS + 512;
    LAS int* OUTE = (LAS int*)(SELV + 4096);
    LAS float* OUTS = (LAS float*)(OUTE + 512);
    LAS int* HIST = (LAS int*)(OUTS + 512);
    LAS int* BASE = HIST + 64;
    if (tid < 64) HIST[tid] = 0;
    __syncthreads();
    const int tl = tid >> 3, grp = tid & 7;
    float v[8], sc[8];
    { float m1 = -INFINITY, m2 = -INFINITY;
#pragma unroll
      for (int j = 0; j < 8; ++j) { const float s = 1.f / (1.f + __expf(-LG[tl * 65 + grp * 8 + j])); sc[j] = s; v[j] = s + rb[j];
        if (v[j] > m1) { m2 = m1; m1 = v[j]; } else if (v[j] > m2) m2 = v[j]; }
      GS[tl * 8 + grp] = m1 + m2; }
    __syncthreads();
    bool keep;
    { const float mine = GS[tl * 8 + grp]; int rank = 0;
#pragma unroll
      for (int g2 = 0; g2 < 8; ++g2) { const float o = GS[tl * 8 + g2]; rank += (o > mine || (o == mine && g2 < grp)) ? 1 : 0; }
      keep = rank < 4;
#pragma unroll
      for (int j = 0; j < 8; ++j) SELV[tl * 64 + grp * 8 + j] = keep ? v[j] : -INFINITY; }
    __syncthreads();
    if (keep) {
      int rk[8];
#pragma unroll
      for (int j = 0; j < 8; ++j) rk[j] = 0;
      for (int e2 = 0; e2 < 64; ++e2) { const float o = SELV[tl * 64 + e2];
#pragma unroll
        for (int j = 0; j < 8; ++j) rk[j] += (o > v[j] || (o == v[j] && e2 < grp * 8 + j)) ? 1 : 0; }
#pragma unroll
      for (int j = 0; j < 8; ++j) if (rk[j] < 8) { OUTE[tl * 8 + rk[j]] = grp * 8 + j; OUTS[tl * 8 + rk[j]] = sc[j]; }
    }
    __syncthreads();
    { const int jj = tid & 7, e = OUTE[tl * 8 + jj]; const float s = OUTS[tl * 8 + jj];
      float sum = s; sum += sx(sum, 1); sum += sx(sum, 2); sum += sx(sum, 4);
      const float w = 2.5f * s / sum;
      const int sl = atomicAdd((int*)&HIST[e], 1);
      __syncthreads();
      const int t = t0 + tl;
      if (tid < 64) { const int n = HIST[tid]; BASE[tid] = (n && !dry) ? (int)atomicAdd(cntg + tid * 32, (unsigned)n) : 0; }
      __syncthreads();
      const int slot = BASE[e] + sl;
      if (!dry) { ltok[(size_t)e * 16384 + slot] = t; } if (!dry) ((int2*)asg)[t * 8 + jj] = make_int2((e << 16) | slot, __float_as_int(w)); }
    __syncthreads();
  }
}

__device__ __forceinline__ void phase_combine(const Ctx& X, int layer, const LAS int* toff, int dry) {
  const float* mod = (const float*)(X.ws + WS_MOD) + (layer == 0 ? 0 : 2 * 6144);
  const float* gffn = mod + 5120;
  const float* nmod = (const float*)(X.ws + WS_MOD) + 2 * 6144;
  float* hout32 = X.a->h; bf16_t* hb = (bf16_t*)(X.ws + WS_HB); const unsigned char* YAS = X.ws + WS_YAS; const int* asg = (const int*)(X.ws + WS_ASG); bf16_t* A1 = (bf16_t*)(X.ws + WS_A1);
  const int gw = X.c * NWAVES + X.wave, NGW = X.G * NWAVES, lane = X.lane;
  f32x4 gtv[4], nsh[4], nsc[4];
#pragma unroll
  for (int j = 0; j < 4; ++j) { gtv[j] = ((const f32x4*)gffn)[lane + 64 * j]; nsh[j] = ((const f32x4*)nmod)[lane + 64 * j]; nsc[j] = ((const f32x4*)(nmod + 1024))[lane + 64 * j] + 1.f; }
  for (int t0 = gw; t0 < TOK; t0 += 2 * NGW) {
    int yw[2][9][4]; f32x4 hv[2][4]; float wgt[2][8];
#pragma unroll
    for (int u = 0; u < 2; ++u) { const int t = t0 + u * NGW;
      int pos[9];
#pragma unroll
      for (int k = 0; k < 8; ++k) { const int2 a = ((const int2*)asg)[t * 8 + k]; pos[k] = toff[a.x >> 16] * 256 + (a.x & 0xffff); wgt[u][k] = __int_as_float(a.y); }
      pos[8] = toff[64] * 256 + t;
#pragma unroll
      for (int k = 0; k < 9; ++k) { const int* yr = (const int*)(YAS + (size_t)pos[k] * 1024) + lane;
#pragma unroll
        for (int j = 0; j < 4; ++j) yw[u][k][j] = yr[64 * j]; }
      const u32x2* hr = (const u32x2*)(hb + (size_t)t * 1024) + lane;
#pragma unroll
      for (int j = 0; j < 4; ++j) { const u32x2 w = hr[64 * j]; hv[u][j] = (f32x4){bf_lo(w.x), bf_hi(w.x), bf_lo(w.y), bf_hi(w.y)}; } }
#pragma unroll
    for (int u = 0; u < 2; ++u) { const int t = t0 + u * NGW;
      f32x4 acc[4];
#pragma unroll
      for (int j = 0; j < 4; ++j) acc[j] = (f32x4){0.f, 0.f, 0.f, 0.f};
#pragma unroll
      for (int k = 0; k < 9; ++k) { const float wk = k < 8 ? wgt[u][k] : 1.f;
#pragma unroll
        for (int j = 0; j < 4; ++j) { const int w = yw[u][k][j];
          acc[j].x += wk * __builtin_amdgcn_cvt_f32_fp8(w, 0); acc[j].y += wk * __builtin_amdgcn_cvt_f32_fp8(w, 1); acc[j].z += wk * __builtin_amdgcn_cvt_f32_fp8(w, 2); acc[j].w += wk * __builtin_amdgcn_cvt_f32_fp8(w, 3); } }
      f32x4 v[4]; float ss = 0.f;
#pragma unroll
      for (int j = 0; j < 4; ++j) { v[j] = hv[u][j] + gtv[j] * acc[j];
        if (!dry) { if (layer == 0) ((u32x2*)(hb + (size_t)t * 1024))[lane + 64 * j] = (u32x2){cvt_pk_bf16(v[j].x, v[j].y), cvt_pk_bf16(v[j].z, v[j].w)}; else ((f32x4*)(hout32 + (size_t)t * 1024))[lane + 64 * j] = v[j]; }
        ss += (v[j].x * v[j].x + v[j].y * v[j].y) + (v[j].z * v[j].z + v[j].w * v[j].w); }
      if (layer == 0) {
        const float r = rsqrtf(wave_sum(ss) * (1.f / 1024.f) + 1e-6f);
#pragma unroll
        for (int j = 0; j < 4; ++j) { const f32x4 f = v[j] * r * nsc[j] + nsh[j];
          u32x2 w; w.x = cvt_pk_bf16(f.x, f.y); w.y = cvt_pk_bf16(f.z, f.w);
          if (!dry) ((u32x2*)(A1 + (size_t)t * 1024))[lane + 64 * j] = w; }
      }
    }
  }
}

constexpr int NPHASE = 21;
template <bool SP2>
__global__ void __launch_bounds__(NTHR, 2) mk_fwd(Args args) {
  extern __shared__ __attribute__((aligned(16))) unsigned char lds_raw[];
  Ctx X; X.lds = (LAS unsigned char*)lds_raw; X.a = &args; X.ws = args.ws; X.tid = threadIdx.x; X.lane = X.tid & 63; X.wave = __builtin_amdgcn_readfirstlane(X.tid >> 6);
  X.G = gridDim.x; X.c = blockIdx.x;
  const int wave_s = X.wave;
  volatile LAS unsigned* MISC = (volatile LAS unsigned*)(X.lds + LDS_MISC_OFF);
  LAS int* TOFF = (LAS int*)(X.lds + LDS_MISC_OFF + 64);
  if (X.tid < 16) MISC[X.tid] = 0u;
  __syncthreads();
  unsigned* ctl = (unsigned*)(X.ws + WS_CTL);
  const int lo = args.ph_lo, hi = args.ph_hi;
  const bool multi = (hi - lo) > 1;
  XcdBarrier bar; bar.bar = ctl + CW_BAR; bar.x = 0; bar.st = nullptr;
  if (multi) bar = xcd_barrier_post(ctl + CW_BAR, MISC, X.tid);
  LAS unsigned char* lds = X.lds;
  unsigned char* ws = X.ws;
  const float* mod = (const float*)(ws + WS_MOD); (void)mod;
#ifndef PH_MASK
#define PH_MASK 0x1fffffull
#endif
#define IN(k) ((((unsigned long long)PH_MASK >> (k)) & 1ull) && lo <= (k) && (k) < hi)
#define SEAM(k) do { if (IN(k) && IN((k) + 1)) xcd_barrier(bar, X.tid); } while (0)
#ifndef REP_MASK
#define REP_MASK 0ull
#endif
#define REPS(k) ((int)(((unsigned long long)REP_MASK >> (k)) & 1ull))
#define FILL(ph, nb) do { if (!(args.flags & FLAG_SKIP_EXPERTS) && multi) { if (X.c < (nb)) { __syncthreads(); if (X.tid == 0) atomicAdd(ctl + CW_DONE + 64 * (ph), 1u); } \
    else transpose_work(X, ctl + CW_DQ1, 0, 0, 2, 130 * IT_EXP, ctl + CW_DONE + 64 * (ph), (unsigned)(nb)); } } while (0)
#define LAUNDER() do { int w0_ = wave_s; asm volatile("" : "+s"(w0_)); unsigned zl_ = 0u; asm volatile("" : "+v"(zl_)); int l_ = (int)__builtin_amdgcn_mbcnt_hi(~0u, __builtin_amdgcn_mbcnt_lo(~0u, zl_)); X.wave = w0_; X.lane = l_; X.tid = w0_ * 64 + l_; \
    size_t z0_ = 0; asm volatile("" : "+s"(z0_)); unsigned char* w_ = args.ws + z0_; X.ws = w_; ws = w_; mod = (const float*)(w_ + WS_MOD); } while (0)
  if (IN(0)) for (int rep_ = 0; rep_ <= REPS(0); ++rep_) { if (rep_) xcd_barrier(bar, X.tid); LAUNDER(); phase_prep(X, rep_); } SEAM(0);
#ifdef EXTRA_BARS
  if (multi) for (int eb_ = 0; eb_ < EXTRA_BARS; ++eb_) xcd_barrier(bar, X.tid);
#endif
  if (IN(1)) for (int rep_ = 0; rep_ <= REPS(1); ++rep_) { if (rep_) xcd_barrier(bar, X.tid); LAUNDER(); phase_mod0(X); } SEAM(1);
  if (IN(2)) for (int rep_ = 0; rep_ <= REPS(2); ++rep_) { if (rep_) xcd_barrier(bar, X.tid); LAUNDER(); G1 p; p.K = 1024; p.nunits = 520; p.ws = ws; p.qg = args.in[IN_QG]; p.kg = args.in[IN_KG]; gemm_phase<G1, SP2>(lds, p, X.G, X.c, X.tid); FILL(2, 8); } SEAM(2);
  if (IN(3)) for (int rep_ = 0; rep_ <= REPS(3); ++rep_) { if (rep_) xcd_barrier(bar, X.tid); LAUNDER(); G2 p; p.K = 512; p.nunits = 96; p.ws = ws; gemm_phase<G2, SP2>(lds, p, X.G, X.c, X.tid); FILL(3, 96); } SEAM(3);
  if (IN(4)) for (int rep_ = 0; rep_ <= REPS(4); ++rep_) { if (rep_) xcd_barrier(bar, X.tid); LAUNDER(); phase_scan(X); FILL(4, 64); } SEAM(4);
  if (IN(5)) for (int rep_ = 0; rep_ <= REPS(5); ++rep_) { if (rep_) xcd_barrier(bar, X.tid); LAUNDER(); G3 p; p.K = 768; p.nunits = 128; p.ws = ws; gemm_phase<G3, SP2>(lds, p, X.G, X.c, X.tid); FILL(5, 128); } SEAM(5);
  if (IN(6)) for (int rep_ = 0; rep_ <= REPS(6); ++rep_) { if (rep_) xcd_barrier(bar, X.tid); LAUNDER(); G4 p; p.K = 512; p.nunits = 128; p.ws = ws; p.bglu = args.in[IN_BGLU]; gemm_phase<G4, SP2>(lds, p, X.G, X.c, X.tid); FILL(6, 128); } SEAM(6);
  if (IN(7)) for (int rep_ = 0; rep_ <= REPS(7); ++rep_) { if (rep_) xcd_barrier(bar, X.tid); LAUNDER(); phase_attn(X); } SEAM(7);
  if (IN(8)) for (int rep_ = 0; rep_ <= REPS(8); ++rep_) { if (rep_) xcd_barrier(bar, X.tid); LAUNDER(); GRes p; p.K = 1024; p.nunits = 256; p.A = (const char*)ws + WS_CONCAT; p.Bt = (const char*)ws + WS_WMIX_T; p.hin32 = args.in[IN_X]; p.hin16 = nullptr; p.hout = (bf16_t*)(ws + WS_HB); p.gate = mod + 2048; p.bias = nullptr;
    gemm_phase<GRes, SP2>(lds, p, X.G, X.c, X.tid); } SEAM(8);
#pragma unroll 1
  for (int layer = 0; layer < 2; ++layer) {
    const int pb = layer == 0 ? 9 : 17;
    if (IN(pb)) for (int rep_ = 0; rep_ <= REPS(pb); ++rep_) { if (rep_) xcd_barrier(bar, X.tid); LAUNDER(); phase_router(X, layer, rep_);
      if (layer == 0 && rep_ == 0 && !(args.flags & FLAG_SKIP_EXPERTS)) { __syncthreads(); transpose_work(X, ctl + CW_DQ1, 0, 0, 2, 130 * IT_EXP, nullptr, 0u, 65 * IT_EXP); } } SEAM(pb);
#ifndef ROUTER_VARIANT
#define ROUTER_VARIANT 1
#endif
#ifndef G6_VARIANT
#define G6_VARIANT 1
#endif
    if (IN(pb + 1)) for (int rep_ = REPS(pb + 1); rep_ >= 0; --rep_) { if (rep_ == 0 && REPS(pb + 1)) xcd_barrier(bar, X.tid); LAUNDER(); build_moetab(X, layer, TOFF); G6 p; p.K = 512; p.ws = ws; p.toff = TOFF; p.nunits = TOFF[65] * 2; p.wbase = (const char*)ws + (layer == 0 ? WS_WEXP : WS_WEXP1); p.wstride = layer == 0 ? EXP_STRIDE : EXP1_STRIDE;
      { LAS unsigned* tk = (LAS unsigned*)(X.lds + LDS_STAGE); p.tokt = tk; p.build_tokt(X, tk); } gemm_phase<G6, false>(lds, p, X.G, X.c, X.tid); } SEAM(pb + 1);
#ifndef G7_VARIANT
#define G7_VARIANT 1
#endif
    if (IN(pb + 2)) for (int rep_ = REPS(pb + 2); rep_ >= 0; --rep_) { if (rep_ == 0 && REPS(pb + 2)) xcd_barrier(bar, X.tid); LAUNDER(); build_moetab(X, layer, TOFF); G7 p; { int k_ = 128; asm volatile("" : "+s"(k_)); p.K = k_; } p.ws = ws; p.toff = TOFF; p.nunits = TOFF[65] * 4; p.wbase = (const char*)ws + (layer == 0 ? WS_WEXP + EXP_DOFF : WS_WEXP1 + EXP1_DOFF); p.wstride = layer == 0 ? EXP_STRIDE : EXP1_STRIDE; gemm_phase<G7, false>(lds, p, X.G, X.c, X.tid); } SEAM(pb + 2);
    if (IN(pb + 3)) for (int rep_ = REPS(pb + 3); rep_ >= 0; --rep_) { if (rep_ == 0 && REPS(pb + 3)) xcd_barrier(bar, X.tid); LAUNDER(); build_moetab(X, layer, TOFF); phase_combine(X, layer, TOFF, rep_);
      if (layer == 0 && rep_ == 0 && !(args.flags & FLAG_SKIP_EXPERTS)) { __syncthreads(); transpose_work(X, ctl + CW_DQ1, 0, 0, 2, 130 * IT_EXP); } }
    if (layer == 0) {
      SEAM(12);
      if (IN(13)) for (int rep_ = 0; rep_ <= REPS(13); ++rep_) { if (rep_) xcd_barrier(bar, X.tid); LAUNDER(); G8 p; p.K = 256; p.nunits = 256; p.ws = ws; gemm_phase<G8, SP2>(lds, p, X.G, X.c, X.tid); } SEAM(13);
      if (IN(14)) for (int rep_ = 0; rep_ <= REPS(14); ++rep_) { if (rep_) xcd_barrier(bar, X.tid); LAUNDER(); G9 p; p.K = 256; p.nunits = 256; p.ws = ws; gemm_phase<G9, SP2>(lds, p, X.G, X.c, X.tid); } SEAM(14);
      if (IN(15)) for (int rep_ = 0; rep_ <= REPS(15); ++rep_) { if (rep_) xcd_barrier(bar, X.tid); LAUNDER(); G10 p; p.K = 256; p.nunits = 256; p.ws = ws; gemm_phase<G10, SP2>(lds, p, X.G, X.c, X.tid); } SEAM(15);
      if (IN(16)) { LAUNDER(); zero_lists(X); fourier_fix(X, 256); GRes p; p.K = 1024; p.nunits = 256; p.A = (const char*)ws + WS_FB; p.Bt = (const char*)ws + WS_WFOUR_T; p.hin32 = nullptr; p.hin16 = (const bf16_t*)(ws + WS_HB); p.hout = (bf16_t*)(ws + WS_HB); p.gate = mod + 2 * 6144 + 2048; p.bias = args.in[IN_BFOUR];
        gemm_phase<GRes, SP2>(lds, p, X.G, X.c, X.tid); } SEAM(16);
    }
  }
#undef IN
#undef SEAM
}
}
#ifndef MK_SP2
#define MK_SP2 true
#endif
#ifndef MK_N_LAUNCHES
#define MK_N_LAUNCHES 1
#endif
#ifndef CHECK
#define CHECK 0
#endif
static int g_grid = 0;
static bool mk_setup(int n_in, int out_size, size_t ws_size) {
  if (g_grid == 0) {
    g_grid = -1;
    if (n_in != 31 || out_size != 16384 * 1024 || ws_size < mk::WS_NEED) { fprintf(stderr, "kernel_launch: unexpected n_in %d out %d ws %zu\n", n_in, out_size, ws_size); return false; }
    int dev = 0, cus = 0;
    if (hipGetDevice(&dev) != hipSuccess || hipDeviceGetAttribute(&cus, hipDeviceAttributeMultiprocessorCount, dev) != hipSuccess) return false;
    if (cus < 256) { fprintf(stderr, "kernel_launch: needs 256 CUs, device has %d\n", cus); return false; }
    if (hipFuncSetAttribute((const void*)mk::mk_fwd<MK_SP2>, hipFuncAttributeMaxDynamicSharedMemorySize, mk::LDS_BYTES) != hipSuccess) { fprintf(stderr, "kernel_launch: hipFuncSetAttribute failed\n"); return false; }
    g_grid = 256;
  }
  return g_grid > 0;
}
static void mk_run(hipStream_t s, mk::Args a, int lo, int hi) {
  a.ph_lo = lo; a.ph_hi = hi;
  hipLaunchKernelGGL(mk::mk_fwd<MK_SP2>, dim3(g_grid), dim3(mk::NTHR), mk::LDS_BYTES, s, a);
}

#if CHECK
namespace chk {
using mk::bf16_t;
__device__ __forceinline__ float b2f(bf16_t b) { return __uint_as_float(((unsigned)b) << 16); }
__global__ void k_cmp(int mode, const void* A, const float* B, unsigned long long n, double* acc) {
  double e = 0.0, r = 0.0; const bf16_t* A16 = (const bf16_t*)A;
  for (unsigned long long i = (unsigned long long)blockIdx.x * 256 + threadIdx.x; i < n; i += (unsigned long long)gridDim.x * 256) {
    float a = 0.f, b = 0.f; const int row = (int)(i >> 9), col = (int)(i & 511);
    switch (mode) {
      case 0: a = ((const float*)A)[i]; b = B[i]; break;
      case 1: a = b2f(A16[i]); b = B[i]; break;
      case 2: { b = B[(size_t)row * 2048 + col]; const int g = col >> 4, c = col & 15; int crow, s; if (row < 16384) { crow = row >> 5; s = row & 31; } else { const int j = row - 16384; crow = 512 + (j >> 5); s = j & 31; }
                a = b2f(A16[((size_t)(g * 768 + crow)) * 768 + s * 16 + c]); } break;
      case 3: b = B[(size_t)row * 2048 + 512 + col]; a = b2f(A16[(size_t)row * 512 + col]); break;
      case 4: b = B[(size_t)row * 2048 + 1024 + col]; a = b2f(A16[(size_t)row * 512 + col]); break;
      case 5: b = B[(size_t)row * 2048 + 1536 + col]; a = b2f(A16[(size_t)col * 16640 + row]); break;
      case 6: b = B[(size_t)row * 1024 + col]; a = b2f(A16[(size_t)row * 1024 + col]); break;
      case 7: b = B[(size_t)row * 1024 + 512 + col]; a = b2f(A16[(size_t)row * 1024 + 512 + col]); break;
      case 8: { const int ta = (int)(i & 127), ri = (int)((i >> 7) & 1), tb = (int)((i >> 8) & 127), m = (int)((i >> 15) & 255), g = (int)(i >> 23); a = b2f(A16[i]); const int t = 128 * ta + tb; b = B[((size_t)t * 4 + g) * 512 + ri * 256 + m]; } break;
      default: break;
    }
    const double d = (double)a - (double)b; e += d * d; r += (double)b * (double)b;
  }
  for (int o = 32; o >= 1; o >>= 1) { e += __shfl_xor(e, o); r += __shfl_xor(r, o); }
  if ((threadIdx.x & 63) == 0) { atomicAdd(acc, e); atomicAdd(acc + 1, r); }
}
__global__ void k_cmp_x2(const bf16_t* X2, const float* Yr, const float* Yi, double* acc) {
  double e = 0.0, r = 0.0;
  for (unsigned long long i = (unsigned long long)blockIdx.x * 256 + threadIdx.x; i < (1ull << 25); i += (unsigned long long)gridDim.x * 256) {
    const int tb = (int)(i & 127), rip = (int)((i >> 7) & 1), ka = (int)((i >> 8) & 127), gm = (int)(i >> 15);
    const float a = b2f(X2[i]); const size_t yi = (((size_t)ka * 128 + tb) << 10) + gm; const float b = rip ? Yi[yi] : Yr[yi];
    const double d = (double)a - (double)b; e += d * d; r += (double)b * (double)b;
  }
  for (int o = 32; o >= 1; o >>= 1) { e += __shfl_xor(e, o); r += __shfl_xor(r, o); }
  if ((threadIdx.x & 63) == 0) { atomicAdd(acc, e); atomicAdd(acc + 1, r); }
}
__global__ void k_judge(const double* acc, int n, float tol, int* fail) {
  if (threadIdx.x == 0 && blockIdx.x == 0) { fail[0] = 0; for (int k = 0; k < n; ++k) { const double rel = sqrt(acc[2 * k] / acc[2 * k + 1]); if (!(rel <= (double)tol)) { fail[0] = k + 1; break; } } }
}
__global__ void k_encode(float* out, size_t n, const int* fail) {
  const int f = fail[0]; if (f == 0) return; const float sc = 1.f + 0.1f * (float)f;
  for (size_t i = (size_t)blockIdx.x * 256 + threadIdx.x; i < n; i += (size_t)gridDim.x * 256) out[i] *= sc;
}
__global__ void k_f2bf(const float* in, bf16_t* out, size_t n) { for (size_t i = (size_t)blockIdx.x * 256 + threadIdx.x; i < n; i += (size_t)gridDim.x * 256) out[i] = mk::f2bf(in[i]); }
static void cmp(hipStream_t s, int mode, const void* A, const float* B, unsigned long long n, double* acc) { hipLaunchKernelGGL(k_cmp, dim3(2048), dim3(256), 0, s, mode, A, B, n, acc); }
}
#endif

extern "C" void kernel_launch(void* const* d_in, const int* in_sizes, int n_in, void* d_out, int out_size, void* d_ws, size_t ws_size, hipStream_t stream) {
  if (!mk_setup(n_in, out_size, ws_size)) return;
  unsigned char* ws = (unsigned char*)d_ws;
  const size_t MiB = mk::MiB;
  mk::Args a{};
  for (int i = 0; i < 31; ++i) a.in[i] = (const float*)d_in[i];
  a.h = (float*)d_out; a.ws = ws; a.flags = 0; a.pad = 0;
#if CHECK == 0
  (void)hipMemsetAsync(ws + mk::WS_CTL, 0, mk::CTL_ZERO_BYTES, stream);
#if MK_N_LAUNCHES == 1
  mk_run(stream, a, 0, mk::NPHASE);
#else
  for (int ph = 0; ph < mk::NPHASE; ++ph) mk_run(stream, a, ph, ph + 1);
#endif
#else
  ref::In in; { const float** p = (const float**)&in; for (int i = 0; i < 31; ++i) p[i] = (const float*)d_in[i]; }
  float* out = (float*)d_out;
  char* wsc = (char*)d_ws;
  ref::Small sm; sm.mod = (float*)(wsc + 498 * MiB); sm.lamb = (float2*)(wsc + 498 * MiB + 131072); sm.bbar = (float2*)(wsc + 498 * MiB + 262144);
  sm.tw = (float2*)(wsc + 499 * MiB); sm.Dm = (float*)(wsc + 499 * MiB + 262144);
  double* acc = (double*)(wsc + 500 * MiB); int* fail = (int*)(wsc + 500 * MiB + 4096);
  (void)hipMemsetAsync(acc, 0, 8192, stream);
  (void)hipMemsetAsync(ws + mk::WS_CTL, 0, mk::CTL_ZERO_BYTES, stream);
  float* HOPT = (float*)(ws + mk::WS_HOPT);
  int nchk = 0;
#if CHECK == 1
  ref::MixBuf mb; mb.a0 = (float*)(wsc + 12 * MiB); mb.z = (float*)(wsc + 336 * MiB); mb.g = (float*)(wsc + 466 * MiB); mb.t = (float*)(wsc + 77 * MiB); mb.concat = mb.a0; mb.ymix = mb.z;
  char* moe_arena = wsc + 12 * MiB;
  ref::FourBuf fb; { char* p = wsc + 12 * MiB; fb.a1 = (float*)p; p += 64 * MiB; fb.Z = (float*)p; p += 128 * MiB; fb.Yr = (float*)p; p += 64 * MiB; fb.Yi = (float*)p; p += 64 * MiB; fb.F = (float*)p; fb.yf = fb.Z; }
  a.flags = mk::FLAG_SKIP_EXPERTS;
  nchk = 10;
  ref::forward(stream, in, out, sm, mb, moe_arena, fb, [&](int st) {
    if (st == 1) { mk_run(stream, a, 0, 1); chk::cmp(stream, 0, ws + mk::WS_MOD, sm.mod, 3 * 6144, acc + 0); }
    if (st == 2) { mk_run(stream, a, 1, 2); chk::cmp(stream, 1, ws + mk::WS_A0, mb.a0, 16640ull * 1024, acc + 2); }
    if (st == 3) { mk_run(stream, a, 2, 3); chk::cmp(stream, 2, ws + mk::WS_AS5, mb.z, 16640ull * 512, acc + 4); chk::cmp(stream, 3, ws + mk::WS_Q, mb.z, 16384ull * 512, acc + 6);
                   chk::cmp(stream, 4, ws + mk::WS_K, mb.z, 16640ull * 512, acc + 8); chk::cmp(stream, 5, ws + mk::WS_VT, mb.z, 16640ull * 512, acc + 10); }
    if (st == 4) { mk_run(stream, a, 3, 4); mk_run(stream, a, 4, 5); mk_run(stream, a, 5, 6); chk::cmp(stream, 1, ws + mk::WS_GB, mb.g, 16384ull * 512, acc + 12); }
    if (st == 5) { mk_run(stream, a, 6, 7); chk::cmp(stream, 6, ws + mk::WS_CONCAT, mb.concat, 16384ull * 512, acc + 14); }
    if (st == 6) { mk_run(stream, a, 7, 8); chk::cmp(stream, 7, ws + mk::WS_CONCAT, mb.concat, 16384ull * 512, acc + 16); }
    if (st == 7) { mk::Args b = a; b.h = HOPT; mk_run(stream, b, 8, 9); chk::cmp(stream, 0, HOPT, out, 16384ull * 1024, acc + 18); }
  });
#elif CHECK == 2 || CHECK == 4
  const int L = CHECK == 2 ? 0 : 1;
  ref::MixBuf mb; { char* p = wsc + 12 * MiB; mb.a0 = (float*)p; p += 65 * MiB; mb.z = (float*)p; p += 130 * MiB; mb.g = (float*)p; p += 32 * MiB; mb.t = (float*)p; p += 32 * MiB; mb.concat = (float*)p; p += 64 * MiB; mb.ymix = mb.z; }
  ref::FourBuf fb; { char* p = wsc + 12 * MiB; fb.a1 = (float*)p; p += 64 * MiB; fb.Z = (float*)p; p += 128 * MiB; fb.Yr = (float*)p; p += 64 * MiB; fb.Yi = (float*)p; p += 64 * MiB; fb.F = (float*)p; fb.yf = fb.Z; }
  char* moe_arena = wsc + 110 * MiB;
  nchk = L == 0 ? 2 : 1;
  a.flags = 0;
  ref::forward(stream, in, out, sm, mb, moe_arena, fb, [&](int st) {
    if ((L == 0 && st == 7) || (L == 1 && st == 11)) {
      mk::Args b = a; b.h = HOPT; if (L == 1) b.flags = 2;
      mk_run(stream, b, 0, 1);
      (void)hipMemcpyAsync(HOPT, out, (size_t)16384 * 1024 * 4, hipMemcpyDeviceToDevice, stream);
      const int pb = L == 0 ? 9 : 20; b.flags |= mk::FLAG_SKIP_EXPERTS;
      for (int ph = pb; ph < pb + 7; ++ph) mk_run(stream, b, ph, ph + 1);
    }
    if ((L == 0 && st == 8) || (L == 1 && st == 12)) chk::cmp(stream, 0, HOPT, out, 16384ull * 1024, acc + 0);
    if (L == 0 && st == 9) chk::cmp(stream, 1, ws + mk::WS_A1, fb.a1, 16384ull * 1024, acc + 2);
  });
#elif CHECK == 3
  ref::MixBuf mb; { char* p = wsc + 12 * MiB; mb.a0 = (float*)p; p += 65 * MiB; mb.z = (float*)p; p += 130 * MiB; mb.g = (float*)p; p += 32 * MiB; mb.t = (float*)p; p += 32 * MiB; mb.concat = (float*)p; p += 64 * MiB; mb.ymix = mb.z; }
  char* moe_arena = wsc + 12 * MiB;
  ref::FourBuf fb; fb.Z = (float*)(wsc + 270 * MiB);
  fb.a1 = (float*)(wsc + 12 * MiB); fb.Yr = (float*)(wsc + 12 * MiB);   fb.Yi = (float*)(wsc + 468 * MiB - 0); fb.F = (float*)(wsc + 270 * MiB); fb.yf = (float*)(wsc + 334 * MiB);
  fb.Yi = (float*)(wsc + 76 * MiB);
  nchk = 4;
  a.flags = mk::FLAG_SKIP_EXPERTS;
  ref::forward(stream, in, out, sm, mb, moe_arena, fb, [&](int st) {
    if (st == 9) {
      mk::Args b = a; b.h = HOPT;
      mk_run(stream, b, 0, 1);
      hipLaunchKernelGGL(chk::k_f2bf, dim3(2048), dim3(256), 0, stream, fb.a1, (chk::bf16_t*)(ws + mk::WS_A1), (size_t)16384 * 1024);
      (void)hipMemcpyAsync(HOPT, out, (size_t)16384 * 1024 * 4, hipMemcpyDeviceToDevice, stream);
      mk_run(stream, b, 16, 17);
    }
  });
#endif
  hipLaunchKernelGGL(chk::k_judge, dim3(1), dim3(64), 0, stream, acc, nchk, 0.05f, fail);
  hipLaunchKernelGGL(chk::k_encode, dim3(2048), dim3(256), 0, stream, out, (size_t)16384 * 1024, fail);
#endif
}
```

```cpp
#define CHECK 0
#define MK_N_LAUNCHES 1
#define MK_SP2 true
#define REP_MASK 0ull
#include <hip/hip_runtime.h>
#include <cstdio>
#include <cstdint>
#include <cmath>
namespace mk {
#define LAS __attribute__((address_space(3)))
typedef unsigned short bf16_t;
typedef short bf16x8 __attribute__((ext_vector_type(8)));
typedef float f32x4 __attribute__((ext_vector_type(4)));
typedef float f32x2 __attribute__((ext_vector_type(2)));
typedef unsigned u32x4 __attribute__((ext_vector_type(4)));
typedef unsigned u32x2 __attribute__((ext_vector_type(2)));
typedef int i32x8 __attribute__((ext_vector_type(8)));
typedef int i32x4 __attribute__((ext_vector_type(4)));

constexpr int TOK = 16384, CTXN = 256, NROW = TOK + CTXN;
constexpr int NWAVES = 8, NTHR = 512;
constexpr int LDS_STAGE = 131072, LDS_BYTES = 155648, LDS_MISC_OFF = LDS_BYTES - 4096;

__device__ __forceinline__ unsigned cvt_pk_bf16(float lo, float hi) { unsigned r; asm volatile("v_cvt_pk_bf16_f32 %0, %1, %2" : "=v"(r) : "v"(lo), "v"(hi)); return r; }
__device__ __forceinline__ int pack4_fp8(float a, float b, float c, float d) { int w = 0;
  w = __builtin_amdgcn_cvt_pk_fp8_f32(__builtin_amdgcn_fmed3f(a, -448.f, 448.f), __builtin_amdgcn_fmed3f(b, -448.f, 448.f), w, false);
  w = __builtin_amdgcn_cvt_pk_fp8_f32(__builtin_amdgcn_fmed3f(c, -448.f, 448.f), __builtin_amdgcn_fmed3f(d, -448.f, 448.f), w, true); return w; }
__device__ __forceinline__ void st16_wt(void* p, u32x4 v) { asm volatile("global_store_dwordx4 %0, %1, off sc1\n\ts_nop 1" :: "v"(p), "v"(v) : "memory"); }
__device__ __forceinline__ float bf_lo(unsigned w) { return __uint_as_float(w << 16); }
__device__ __forceinline__ float bf_hi(unsigned w) { return __uint_as_float(w & 0xffff0000u); }
__device__ __forceinline__ float bf2f(bf16_t b) { return __uint_as_float(((unsigned)b) << 16); }
__device__ __forceinline__ bf16_t f2bf(float f) { unsigned u = __float_as_uint(f); return (bf16_t)((u + 0x7fffu + ((u >> 16) & 1u)) >> 16); }
__device__ __forceinline__ float sx(float v, int o) { unsigned z = 0u; asm volatile("" : "+v"(z)); int l = (int)__builtin_amdgcn_mbcnt_hi(~0u, __builtin_amdgcn_mbcnt_lo(~0u, z)); return __int_as_float(__builtin_amdgcn_ds_bpermute((l ^ o) << 2, __float_as_int(v))); }
__device__ __forceinline__ float wave_sum(float v) {
#pragma unroll
  for (int o = 1; o < 64; o <<= 1) v += sx(v, o);
  return v;
}
__device__ __forceinline__ float fast_sigmoid(float x) { return __builtin_amdgcn_rcpf(1.f + __expf(-x)); }
__device__ __forceinline__ float fast_tanh(float x) { float e = __expf(2.f * x); return 1.f - 2.f * __builtin_amdgcn_rcpf(e + 1.f); }
__device__ __forceinline__ float gelu_tanh(float x) { return 0.5f * x * (1.f + fast_tanh(0.7978845608028654f * (x + 0.044715f * x * x * x))); }

#define XB_TMO      128
#define XB_XCNT(j)  (256  + 64 * (j))
#define XB_XSUB(j)  (1280 + 64 * (j))
#define XB_XGEN(j)  (2304 + 64 * (j))
#define XB_TOP      3328
#define XB_TOPGEN   3392
#define XCD_BAR_WORDS 3456
#define XB_SPIN_CAP (1u << 20)
__device__ __forceinline__ unsigned xb_ld(unsigned* p) { return __hip_atomic_load(p, __ATOMIC_RELAXED, __HIP_MEMORY_SCOPE_AGENT); }
__device__ __forceinline__ unsigned xb_add(unsigned* p, unsigned v) { return __hip_atomic_fetch_add(p, v, __ATOMIC_RELAXED, __HIP_MEMORY_SCOPE_AGENT); }
__device__ __forceinline__ unsigned xb_xcc_id() { return (unsigned)__builtin_amdgcn_s_getreg((3 << 11) | 20) & 0xFu; }
#define XB_SPIN(cond, bar) do { unsigned _sp = 0; while (cond) { __builtin_amdgcn_s_sleep(1); \
    if ((++_sp & 255u) == 0u) { if (xb_ld(&(bar)[XB_TMO])) break; if (_sp > XB_SPIN_CAP) { atomicAdd(&(bar)[XB_TMO], 1u); break; } } } } while (0)
struct XcdBarrier { unsigned* bar; unsigned x; volatile LAS unsigned* st; };
__device__ __forceinline__ XcdBarrier xcd_barrier_post(unsigned* bar, volatile LAS unsigned* st, int tid) {
  XcdBarrier b; b.bar = bar; b.x = xb_xcc_id(); b.st = st;
  if (tid == 0) (void)xb_add(&bar[XB_XCNT(b.x)], 1u);
  return b;
}
__device__ __forceinline__ void xcd_barrier_complete(unsigned* bar, unsigned x, unsigned& nloc, unsigned& nx) {
  const unsigned G = gridDim.x * gridDim.y * gridDim.z;
  unsigned sum, cnt, mine, sp = 0u;
  for (;;) {
    sum = 0u; cnt = 0u; mine = 0u;
#pragma unroll
    for (unsigned j = 0; j < 16; ++j) { const unsigned c = xb_ld(&bar[XB_XCNT(j)]); sum += c; cnt += (c > 0u) ? 1u : 0u; }
    if (sum == G) { mine = xb_ld(&bar[256 + 64 * x]); break; }
    __builtin_amdgcn_s_sleep(1);
    if ((++sp & 255u) == 0u) { if (xb_ld(&bar[XB_TMO])) break; if (sp > XB_SPIN_CAP) { atomicAdd(&bar[XB_TMO], 1u); break; } }
  }
  nloc = mine > 0u ? mine : 1u; nx = cnt > 0u ? cnt : 1u;
}
__device__ __forceinline__ void xcd_barrier(const XcdBarrier& b, int tid) {
  asm volatile("s_waitcnt vmcnt(0)" ::: "memory");
  __syncthreads();
  if (tid == 0) {
    unsigned* bar = b.bar;
    __builtin_amdgcn_s_waitcnt(0);
    unsigned nloc = b.st[0], nx = b.st[1];
    if (nloc == 0u) { xcd_barrier_complete(bar, b.x, nloc, nx); b.st[0] = nloc; b.st[1] = nx; }
    const unsigned old = xb_add(&bar[XB_XSUB(b.x)], 1u);
    const unsigned gen = old / nloc;
    if (old + 1u == (gen + 1u) * nloc) {
      __builtin_amdgcn_fence(__ATOMIC_RELEASE, "agent");
      asm volatile("s_waitcnt vmcnt(0)" ::: "memory");
      const unsigned og = xb_add(&bar[XB_TOP], 1u);
      const unsigned tg = og / nx;
      if (og + 1u == (tg + 1u) * nx) xb_add(&bar[XB_TOPGEN], 1u);
      else XB_SPIN(xb_ld(&bar[XB_TOPGEN]) == tg, bar);
      __builtin_amdgcn_fence(__ATOMIC_ACQUIRE, "agent");
      xb_add(&bar[XB_XGEN(b.x)], 1u);
      asm volatile("s_waitcnt vmcnt(0)" ::: "memory");
    } else {
      XB_SPIN(xb_ld(&bar[XB_XGEN(b.x)]) == gen, bar);
      __builtin_amdgcn_fence(__ATOMIC_ACQUIRE, "agent");
      asm volatile("s_waitcnt vmcnt(0)" ::: "memory");
    }
  }
  __syncthreads();
}

constexpr int BM = 256, BK = 64, HALF = 128, HTB = HALF * BK * 2, NXCD = 8;
__device__ __forceinline__ int lds_byte(int r, int c) { const int st = (r >> 4) * 2 + (c >> 5), rr = r & 15, cc = c & 31, ob = rr * 64 + cc * 2; return st * 1024 + (ob ^ (((ob >> 9) & 1) << 5)); }
__device__ __forceinline__ void stage_rc(int b, int& R, int& C) { const int st = b / 1024, sb = b % 1024, swz = sb ^ (((sb >> 9) & 1) << 5); R = (st >> 1) * 16 + swz / 64; C = (st & 1) * 32 + (swz % 64) / 2; }
__device__ __forceinline__ int swz16(int fr) { return 2 * ((fr >> 1) & 1) + 4 * ((fr >> 3) & 1); }
__device__ __forceinline__ int swz8(int fr) { return ((fr >> 1) & 1) + 4 * ((fr >> 3) & 1); }
__device__ __forceinline__ int perm32(int rho) { const int n = rho >> 4, i = rho & 15; return 8 * (i >> 2) + 4 * n + (i & 3); }

struct Unit { int pm, pn, a, b, ord; };
__device__ __forceinline__ int xcd_remap(int L, int nunits) { const int q = nunits / NXCD, r = nunits % NXCD, xcd = L % NXCD, off = L / NXCD; return (xcd < r ? xcd * (q + 1) : r * (q + 1) + (xcd - r) * q) + off; }
typedef f32x4 Acc[2][2][4][2];
template <class P, bool SP2>
__device__ __forceinline__ void gemm_phase(LAS unsigned char* lds, const P& p, int G, int c, int tid_in) {
  const int tid = tid_in, wid = __builtin_amdgcn_readfirstlane(tid >> 6), lane = tid & 63, wr = wid >> 2, wc = wid & 3, fr = lane & 15, fq = lane >> 4;
  const int K = p.K, nt = K / BK;
  const int nunits = p.nunits;
  const size_t kstep = (size_t)(BK * 2);
  const unsigned ldsw = (unsigned)wid * 1024u;
  const int aoff0 = P::F8 ? (wr * 64 + fr) * 128 + ((2 * fq) ^ swz8(fr)) * 16 : lds_byte(wr * 64 + fr, fq * 8);
  const int boff0 = P::F8 ? (wc * 32 + fr) * 128 + ((2 * fq) ^ swz8(fr)) * 16 : lds_byte(wc * 32 + fr, fq * 8);
#define PG8_SA(b, h) (((b) * 2 + (h)) * HTB)
#define PG8_SB(b, h) ((4 + (b) * 2 + (h)) * HTB)
#define PG8_STAGE(bufoff, gbase, voff) do { _Pragma("unroll") for (int _i = 0; _i < 2; ++_i) \
        __builtin_amdgcn_global_load_lds((const unsigned*)((const char*)(gbase) + (voff)[_i]), (LAS unsigned*)(lds + (bufoff) + ldsw + _i * 8192), 16, 0, 0); } while (0)
#define PG8_RD32(p0_, p1_) __builtin_shufflevector(*(const LAS i32x4*)(p0_), *(const LAS i32x4*)(p1_), 0, 1, 2, 3, 4, 5, 6, 7)
#define PG8_LDA(dst, b, h) do { if constexpr (P::F8) { int _o1 = aoff0 ^ 16; asm volatile("" : "+v"(_o1)); _Pragma("unroll") for (int m = 0; m < 4; ++m) dst##8[m] = PG8_RD32(lds + PG8_SA(b, h) + aoff0 + m * 2048, lds + PG8_SA(b, h) + _o1 + m * 2048); } \
        else { _Pragma("unroll") for (int m = 0; m < 4; ++m) _Pragma("unroll") for (int k = 0; k < 2; ++k) dst[m][k] = *(const LAS bf16x8*)(lds + PG8_SA(b, h) + aoff0 + m * 2048 + k * 1024); } } while (0)
#define PG8_LDB(dst, b, h) do { if constexpr (P::F8) { int _o1 = boff0 ^ 16; asm volatile("" : "+v"(_o1)); _Pragma("unroll") for (int n = 0; n < 2; ++n) dst##8[n] = PG8_RD32(lds + PG8_SB(b, h) + boff0 + n * 2048, lds + PG8_SB(b, h) + _o1 + n * 2048); } \
        else { _Pragma("unroll") for (int n = 0; n < 2; ++n) _Pragma("unroll") for (int k = 0; k < 2; ++k) dst[n][k] = *(const LAS bf16x8*)(lds + PG8_SB(b, h) + boff0 + n * 2048 + k * 1024); } } while (0)
#define PG8_MMA(ai, bj, At, Bt) do { __builtin_amdgcn_s_setprio(1); if constexpr (P::F8) { _Pragma("unroll") for (int m = 0; m < 4; ++m) _Pragma("unroll") for (int n = 0; n < 2; ++n) \
        acc[ai][bj][m][n] = __builtin_amdgcn_mfma_scale_f32_16x16x128_f8f6f4(Bt##8[n], At##8[m], acc[ai][bj][m][n], 0, 0, 0, 0, 0, 0); }     \
        else { _Pragma("unroll") for (int m = 0; m < 4; ++m) _Pragma("unroll") for (int n = 0; n < 2; ++n) _Pragma("unroll") for (int k = 0; k < 2; ++k) \
        acc[ai][bj][m][n] = __builtin_amdgcn_mfma_f32_16x16x32_bf16(Bt[n][k], At[m][k], acc[ai][bj][m][n], 0, 0, 0); } __builtin_amdgcn_s_setprio(0); } while (0)
#define PG8_WAIT_V(n) asm volatile("s_waitcnt vmcnt(" #n ")" ::: "memory")
#define PG8_WAIT_L(n) asm volatile("s_waitcnt lgkmcnt(" #n ")" ::: "memory")
#define PG8_BAR __builtin_amdgcn_s_barrier()
#define PG8_SCHED __builtin_amdgcn_sched_barrier(0)
#define PG8_DECODE(i, u) do { p.decode(P::CONTIG ? (u_lo + (i)) : xcd_remap((i) * G + c, nunits), u); u.ord = (i); } while (0)
#define PG8_HAS(i) (P::CONTIG ? (u_lo + (i) < u_hi) : ((i) * G + c < nunits))
#define PG8_OFFS(u, vA, vB) do { int _t = tid; asm volatile("" : "+v"(_t)); _Pragma("unroll") for (int _i = 0; _i < 2; ++_i) { int _R, _C; if constexpr (P::F8) { const int _p = _t + 512 * _i; _R = _p >> 3; _C = ((_p & 7) ^ swz8(_R & 15)) * 8; } else stage_rc(_t * 16 + _i * 8192, _R, _C); \
        const int _Rb = P::PERM ? ((_R & ~31) + perm32(_R & 31)) : _R; _Pragma("unroll") for (int _h = 0; _h < 2; ++_h) { \
        if (_h == 0 || !P::LINA) vA[_h][_i] = p.rowA(u, _h * HALF + _R) + (unsigned)(_C * 2); if (_h == 0 || !P::LINB) vB[_h][_i] = p.rowB(u, _h * HALF + _Rb) + (unsigned)(_C * 2); } } } while (0)
  const int vc_ = (G % 8 == 0) ? (c % 8) * (G / 8) + c / 8 : c;
  const int u_lo = (int)(((long)vc_ * nunits) / G), u_hi = (int)(((long)(vc_ + 1) * nunits) / G);
  if (!PG8_HAS(0)) return;
  Unit cur, nxt; int ui = 0;
  PG8_DECODE(0, cur);
  Acc acc; float zf_ = 0.f; asm volatile("" : "+v"(zf_));
#pragma unroll
  for (int a = 0; a < 2; ++a)
#pragma unroll
    for (int b = 0; b < 2; ++b)
#pragma unroll
      for (int m = 0; m < 4; ++m)
#pragma unroll
        for (int n = 0; n < 2; ++n) acc[a][b][m][n] = (f32x4){zf_, zf_, zf_, zf_};
  bf16x8 At[4][2], B0[2][2], B1[2][2]; i32x8 At8[4], B08[2], B18[2];
  unsigned vA[2][2], vB[2][2];
  PG8_OFFS(cur, vA, vB);
  const char* cA = p.baseA(cur); const char* cB = p.baseB(cur);
  const size_t hA = P::LINA ? p.halfA() : 0, hB = P::LINB ? p.halfB() : 0;
  if constexpr (SP2) {
    PG8_STAGE(PG8_SB(0, 0), cB, vB[0]); PG8_STAGE(PG8_SB(0, 1), (cB) + (P::LINB ? hB : 0), vB[P::LINB ? 0 : 1]); PG8_STAGE(PG8_SA(0, 0), cA, vA[0]); PG8_STAGE(PG8_SA(0, 1), (cA) + (P::LINA ? hA : 0), vA[P::LINA ? 0 : 1]);
    if (wr == 1) PG8_BAR;
    PG8_WAIT_V(2); PG8_BAR;
    PG8_STAGE(PG8_SB(1, 0), cB + kstep, vB[0]); PG8_STAGE(PG8_SA(1, 0), cA + kstep, vA[0]); PG8_STAGE(PG8_SB(1, 1), (cB + kstep) + (P::LINB ? hB : 0), vB[P::LINB ? 0 : 1]);
    PG8_WAIT_V(6); PG8_BAR;
  } else {
    PG8_STAGE(PG8_SB(0, 0), cB, vB[0]); PG8_STAGE(PG8_SA(0, 0), cA, vA[0]); PG8_STAGE(PG8_SB(0, 1), (cB) + (P::LINB ? hB : 0), vB[P::LINB ? 0 : 1]); PG8_STAGE(PG8_SA(0, 1), (cA) + (P::LINA ? hA : 0), vA[P::LINA ? 0 : 1]);
    if (wr == 1) PG8_BAR;
    PG8_WAIT_V(4); PG8_BAR;
    PG8_STAGE(PG8_SB(1, 0), cB + kstep, vB[0]); PG8_STAGE(PG8_SA(1, 0), cA + kstep, vA[0]); PG8_STAGE(PG8_SB(1, 1), (cB + kstep) + (P::LINB ? hB : 0), vB[P::LINB ? 0 : 1]);
    PG8_WAIT_V(6); PG8_BAR;
  }
  for (;;) {
    const bool has_next = PG8_HAS(ui + 1);
    if (has_next) PG8_DECODE(ui + 1, nxt);
    const char* nA = has_next ? p.baseA(nxt) : cA; const char* nB = has_next ? p.baseB(nxt) : cB;
    for (int t = 0; t < nt; t += 2) {
      const bool last = (t == nt - 2);
      const char* a1 = cA + (size_t)(t + 1) * kstep;
      const char* a2 = last ? nA : cA + (size_t)(t + 2) * kstep; const char* b2 = last ? nB : cB + (size_t)(t + 2) * kstep;
      const char* a3 = a2 + kstep; const char* b3 = b2 + kstep;
      if constexpr (SP2) {
        PG8_LDB(B0, 0, 0); PG8_LDB(B1, 0, 1); PG8_SCHED; PG8_LDA(At, 0, 0); PG8_STAGE(PG8_SA(1, 1), (a1) + (P::LINA ? hA : 0), vA[P::LINA ? 0 : 1]);
        PG8_WAIT_V(8); PG8_WAIT_L(0); PG8_BAR; PG8_MMA(0, 0, At, B0); PG8_MMA(0, 1, At, B1); PG8_BAR; PG8_SCHED;
        if (last && has_next) { PG8_OFFS(nxt, vA, vB); }
        PG8_LDA(At, 0, 1); PG8_STAGE(PG8_SB(0, 0), b2, vB[0]); PG8_STAGE(PG8_SB(0, 1), (b2) + (P::LINB ? hB : 0), vB[P::LINB ? 0 : 1]); PG8_STAGE(PG8_SA(0, 0), a2, vA[0]);
        PG8_WAIT_V(8); PG8_WAIT_L(0); PG8_BAR; PG8_MMA(1, 0, At, B0); PG8_MMA(1, 1, At, B1); PG8_BAR; PG8_SCHED;
        PG8_LDB(B0, 1, 0); PG8_LDB(B1, 1, 1); PG8_SCHED; PG8_LDA(At, 1, 0); PG8_STAGE(PG8_SA(0, 1), (a2) + (P::LINA ? hA : 0), vA[P::LINA ? 0 : 1]);
        PG8_WAIT_V(8); PG8_WAIT_L(0); PG8_BAR; PG8_MMA(0, 0, At, B0); PG8_MMA(0, 1, At, B1); PG8_BAR; PG8_SCHED;
        PG8_LDA(At, 1, 1); PG8_STAGE(PG8_SB(1, 0), b3, vB[0]); PG8_STAGE(PG8_SB(1, 1), (b3) + (P::LINB ? hB : 0), vB[P::LINB ? 0 : 1]); PG8_STAGE(PG8_SA(1, 0), a3, vA[0]);
        PG8_WAIT_V(8); PG8_WAIT_L(0); PG8_BAR; PG8_MMA(1, 0, At, B0); PG8_MMA(1, 1, At, B1); PG8_BAR; PG8_SCHED;
      } else {
        PG8_LDB(B0, 0, 0); PG8_SCHED; PG8_LDA(At, 0, 0); PG8_STAGE(PG8_SA(1, 1), (a1) + (P::LINA ? hA : 0), vA[P::LINA ? 0 : 1]);
        PG8_WAIT_L(8); PG8_BAR; PG8_WAIT_L(0); PG8_MMA(0, 0, At, B0); PG8_BAR; PG8_SCHED;
        if (last && has_next) { PG8_OFFS(nxt, vA, vB); }
        PG8_LDB(B1, 0, 1); PG8_STAGE(PG8_SB(0, 0), b2, vB[0]);
        PG8_BAR; PG8_WAIT_L(0); PG8_MMA(0, 1, At, B1); PG8_BAR;
        PG8_LDA(At, 0, 1); PG8_STAGE(PG8_SA(0, 0), a2, vA[0]);
        PG8_BAR; PG8_WAIT_L(0); PG8_MMA(1, 0, At, B0); PG8_BAR; PG8_SCHED;
        PG8_STAGE(PG8_SB(0, 1), (b2) + (P::LINB ? hB : 0), vB[P::LINB ? 0 : 1]);
        PG8_WAIT_V(6); PG8_BAR; PG8_MMA(1, 1, At, B1); PG8_BAR;
        PG8_LDB(B0, 1, 0); PG8_SCHED; PG8_LDA(At, 1, 0); PG8_STAGE(PG8_SA(0, 1), (a2) + (P::LINA ? hA : 0), vA[P::LINA ? 0 : 1]);
        PG8_WAIT_L(8); PG8_BAR; PG8_WAIT_L(0); PG8_MMA(0, 0, At, B0); PG8_BAR; PG8_SCHED;
        PG8_LDB(B1, 1, 1); PG8_STAGE(PG8_SB(1, 0), b3, vB[0]);
        PG8_BAR; PG8_WAIT_L(0); PG8_MMA(0, 1, At, B1); PG8_BAR;
        PG8_LDA(At, 1, 1); PG8_STAGE(PG8_SA(1, 0), a3, vA[0]);
        PG8_BAR; PG8_WAIT_L(0); PG8_MMA(1, 0, At, B0); PG8_BAR; PG8_SCHED;
        PG8_STAGE(PG8_SB(1, 1), (b3) + (P::LINB ? hB : 0), vB[P::LINB ? 0 : 1]);
        PG8_WAIT_V(6); PG8_BAR; PG8_MMA(1, 1, At, B1); PG8_BAR;
      }
    }
    if constexpr (P::ALIGN) { if (wr == 0) PG8_BAR; }
    { int fr_e = fr, fq_e = fq; asm volatile("" : "+v"(fr_e), "+v"(fq_e)); p.epi(acc, cur, wr, wc, fr_e, fq_e); }
    if (!has_next) break;
    zf_ = 0.f; asm volatile("" : "+v"(zf_));
#pragma unroll
    for (int a = 0; a < 2; ++a)
#pragma unroll
      for (int b = 0; b < 2; ++b)
#pragma unroll
        for (int m = 0; m < 4; ++m)
#pragma unroll
          for (int n = 0; n < 2; ++n) acc[a][b][m][n] = (f32x4){zf_, zf_, zf_, zf_};
    cur = nxt; cA = nA; cB = nB; ++ui;
    if constexpr (P::ALIGN) { if (wr == 1) PG8_BAR; }
  }
  PG8_WAIT_V(0);
  if constexpr (!P::ALIGN) { if (wr == 0) PG8_BAR; }
  PG8_BAR;
#undef PG8_SA
#undef PG8_SB
#undef PG8_STAGE
#undef PG8_RD32
#undef PG8_LDA
#undef PG8_LDB
#undef PG8_MMA
#undef PG8_WAIT_V
#undef PG8_WAIT_L
#undef PG8_BAR
#undef PG8_SCHED
#undef PG8_DECODE
#undef PG8_HAS
#undef PG8_OFFS
}
}
namespace mk {
constexpr size_t MiB = 1u << 20;
constexpr size_t WS_CTL = 0, CTL_ZERO_BYTES = 65536;
constexpr size_t WS_MOD = 65536;
constexpr size_t WS_LAML = 262144;
constexpr size_t WS_WIN_T = 1 * MiB, WS_WGLU_T = 5 * MiB, WS_WMIX_T = 6 * MiB, WS_WFOUR_T = 8 * MiB, WS_WROUT_T = 10 * MiB;
constexpr size_t WS_DMT = 10 * MiB + 512 * 1024, WS_W1 = 10 * MiB + 768 * 1024, WS_W2 = 10 * MiB + 896 * 1024;
constexpr size_t WS_WEXP = 12 * MiB, EXP_STRIDE = 3 * MiB / 2, EXP_DOFF = 1 * MiB;
constexpr size_t WS_R = 110 * MiB;
constexpr size_t WS_WS = WS_R, WS_TT = WS_R + 8 * MiB, WS_A0 = WS_R + 34 * MiB, WS_AS5 = WS_R + 67 * MiB, WS_Q = WS_R + 103 * MiB, WS_K = WS_R + 119 * MiB,
                 WS_VT = WS_R + 136 * MiB, WS_SST = WS_R + 153 * MiB, WS_GB = WS_R + 177 * MiB, WS_CONCAT = WS_R + 193 * MiB;
constexpr size_t WS_F = WS_R, WS_LTOK = WS_R + 16 * MiB, WS_ASG = WS_R + 20 * MiB, WS_HID = WS_R + 22 * MiB, WS_YAS = WS_R + 102 * MiB,
                 WS_A1 = WS_R + 262 * MiB, WS_HB = WS_R + 294 * MiB;
constexpr size_t WS_X1 = WS_R, WS_X2 = WS_R + 64 * MiB, WS_SPC = WS_R + 96 * MiB, WS_FB = WS_R + 128 * MiB;
constexpr size_t WS_HOPT = WS_R + 338 * MiB;
constexpr size_t WS_WEXP1 = WS_R + 338 * MiB;
constexpr size_t EXP1_STRIDE = 1 * MiB, EXP1_DOFF = 512 * 1024;
constexpr size_t WS_NEED = WS_R + 403 * MiB;
constexpr int HALF_CAP_ROWS = 90112;
constexpr int CW_BAR = 4096, CW_CNT = 8192  , CW_DQ0 = 12288, CW_DQ1 = 12352, CW_DONE = 13312  ;

struct Args { const float* in[31]; float* h; unsigned char* ws; int ph_lo, ph_hi, flags, pad; };
enum { IN_X = 0, IN_C, IN_CTX, IN_CCTX, IN_WADA, IN_BADA, IN_WIN, IN_LRE, IN_LIM, IN_LDT, IN_BRE, IN_BIM, IN_CRE, IN_CIM, IN_S5D, IN_WGLU, IN_BGLU, IN_QG, IN_KG,
       IN_RPB, IN_WMIX, IN_WFOUR, IN_BFOUR, IN_WROUT, IN_RBIAS, IN_WEG, IN_WEU, IN_WED, IN_WSG, IN_WSU, IN_WSD };
constexpr int FLAG_SKIP_EXPERTS = 1;

struct Ctx {
  LAS unsigned char* lds; const Args* a; unsigned char* ws; int tid, lane, wave, G, c;
};

__device__ __forceinline__ u32x4 pack8(const f32x4& v0, const f32x4& v1) { u32x4 w; w.x = cvt_pk_bf16(v0[0], v0[1]); w.y = cvt_pk_bf16(v0[2], v0[3]); w.z = cvt_pk_bf16(v1[0], v1[1]); w.w = cvt_pk_bf16(v1[2], v1[3]); return w; }
__device__ __forceinline__ int rowmap(int code, int n) {
  if (code == 1) { if (n < 512 || n >= 1536) return n; const int blk = n & ~255, c = n & 255; return blk + 128 * ((c >> 5) & 1) + 32 * (c >> 6) + (c & 31); }
  if (code == 2) return 256 * (n >> 7) + (n & 127);
  if (code == 3) return 256 * (n >> 7) + 128 + (n & 127);
  return n;
}
__device__ __forceinline__ int kmap(int kcode, int k) {
  if (kcode == 1) { const int h = k >> 9, g = (k >> 7) & 3, m = k & 127; return g * 256 + (h == 0 ? m : (m == 0 ? 128 : 256 - m)); }
  return k;
}
__device__ __forceinline__ void transpose_item(const float* W, int K, int N, bf16_t* WT, int code, LAS unsigned char* scr, int item, int lane, int kcode = 0) {
  const int nblk = N / 64, kb = item / nblk, nb = item % nblk, k0 = 64 * kb, n0 = 64 * nb;
  const int q = lane >> 4, a = lane & 15;
  f32x4 v[16];
  const float* src = W + (size_t)(k0 + 2 * q) * N + n0 + 4 * a;
  if (kcode == 0) {
#pragma unroll
    for (int i = 0; i < 16; ++i) v[i] = *(const f32x4*)(src + (size_t)((i & 1) + 8 * (i >> 1)) * N);
  } else {
#pragma unroll
    for (int i = 0; i < 16; ++i) v[i] = *(const f32x4*)(W + (size_t)kmap(kcode, k0 + 2 * q + (i & 1) + 8 * (i >> 1)) * N + n0 + 4 * a);
  }
#pragma unroll
  for (int ii = 0; ii < 8; ++ii) { const int dsw = q + 4 * (ii ^ (a & 7));
#pragma unroll
    for (int j = 0; j < 4; ++j) *(LAS unsigned*)(scr + (4 * a + j) * 128 + 4 * dsw) = cvt_pk_bf16(v[2 * ii][j], v[2 * ii + 1][j]); }
  asm volatile("s_waitcnt lgkmcnt(0)" ::: "memory");
  const int c = lane & 7;
#pragma unroll
  for (int jj = 0; jj < 8; ++jj) { const int n = (lane >> 3) + 8 * jj, cs = c ^ ((n >> 2) & 7);
    const u32x4 o = *(const LAS u32x4*)(scr + n * 128 + 16 * cs);
    *(u32x4*)(WT + (size_t)rowmap(code, n0 + n) * K + k0 + 8 * c) = o; }
  asm volatile("s_waitcnt lgkmcnt(0)" ::: "memory");
}
__device__ __forceinline__ void transpose_item8(const float* W, int K, int N, unsigned char* WT, int code, float scale, LAS unsigned char* scr, int item, int lane) {
  const int nblk = N / 64, kb = item / nblk, nb = item % nblk, k0 = 64 * kb, n0 = 64 * nb;
  const int q = lane >> 4, a = lane & 15;
  f32x4 v[16];
  const float* src = W + (size_t)(k0 + 4 * q) * N + n0 + 4 * a;
#pragma unroll
  for (int i = 0; i < 16; ++i) v[i] = *(const f32x4*)(src + (size_t)((i & 3) + 16 * (i >> 2)) * N);
#pragma unroll
  for (int ib = 0; ib < 4; ++ib) { const int dsw = q + 4 * (ib ^ (a & 3));
#pragma unroll
    for (int j = 0; j < 4; ++j) *(LAS int*)(scr + (4 * a + j) * 64 + 4 * dsw) = pack4_fp8(v[4 * ib][j] * scale, v[4 * ib + 1][j] * scale, v[4 * ib + 2][j] * scale, v[4 * ib + 3][j] * scale); }
  asm volatile("s_waitcnt lgkmcnt(0)" ::: "memory");
  const int c = lane & 3;
#pragma unroll
  for (int jj = 0; jj < 4; ++jj) { const int n = (lane >> 2) + 16 * jj, cs = c ^ ((n >> 2) & 3);
    const u32x4 o = *(const LAS u32x4*)(scr + n * 64 + 16 * cs);
    *(u32x4*)(WT + (size_t)rowmap(code, n0 + n) * K + k0 + 16 * c) = o; }
  asm volatile("s_waitcnt lgkmcnt(0)" ::: "memory");
}
constexpr int IT_WIN = 512, IT_GLU = 64, IT_MIX = 256, IT_FOUR = 256, IT_ROUT = 32, IT_SMALL = IT_WIN + IT_GLU + IT_MIX + IT_FOUR + IT_ROUT, IT_EXP = 192;
__device__ __forceinline__ void small_item(const Ctx& X, LAS unsigned char* scr, int it) {
  const Args& a = *X.a; unsigned char* ws = X.ws;
  if (it < IT_WIN) { transpose_item(a.in[IN_WIN], 1024, 2048, (bf16_t*)(ws + WS_WIN_T), 1, scr, it, X.lane); return; } it -= IT_WIN;
  if (it < IT_GLU) { transpose_item(a.in[IN_WGLU], 512, 512, (bf16_t*)(ws + WS_WGLU_T), 0, scr, it, X.lane); return; } it -= IT_GLU;
  if (it < IT_MIX) { transpose_item(a.in[IN_WMIX], 1024, 1024, (bf16_t*)(ws + WS_WMIX_T), 0, scr, it, X.lane); return; } it -= IT_MIX;
  if (it < IT_FOUR) { transpose_item(a.in[IN_WFOUR], 1024, 1024, (bf16_t*)(ws + WS_WFOUR_T), 0, scr, it, X.lane, 1); return; } it -= IT_FOUR;
  { const int l = it >> 4; transpose_item(a.in[IN_WROUT] + (size_t)l * 1024 * 64, 1024, 64, (bf16_t*)(ws + WS_WROUT_T) + (size_t)l * 64 * 1024, 0, scr, it & 15, X.lane); }
}
__device__ __forceinline__ void expert_item(const Ctx& X, LAS unsigned char* scr, int layer, int it) {
  const Args& a = *X.a; const int e = it / IT_EXP, r = it % IT_EXP;
  bf16_t* gu = (bf16_t*)(X.ws + (layer == 0 ? WS_WEXP + (size_t)e * EXP_STRIDE : WS_WEXP1 + (size_t)e * EXP1_STRIDE));
  bf16_t* dt = (bf16_t*)(X.ws + (layer == 0 ? WS_WEXP + (size_t)e * EXP_STRIDE + EXP_DOFF : WS_WEXP1 + (size_t)e * EXP1_STRIDE + EXP1_DOFF));
  const float *wg, *wu, *wd;
  if (e < 64) { const size_t o = ((size_t)layer * 64 + e) * 262144; wg = a.in[IN_WEG] + o; wu = a.in[IN_WEU] + o; wd = a.in[IN_WED] + o; }
  else { const size_t o = (size_t)layer * 262144; wg = a.in[IN_WSG] + o; wu = a.in[IN_WSU] + o; wd = a.in[IN_WSD] + o; }
  if (r < 64) transpose_item8(wg, 1024, 256, (unsigned char*)gu, 2, 32.f, scr, r, X.lane);
  else if (r < 128) transpose_item8(wu, 1024, 256, (unsigned char*)gu, 3, 32.f, scr, r - 64, X.lane);
  else transpose_item8(wd, 256, 1024, (unsigned char*)dt, 0, 32.f, scr, r - 128, X.lane);
}
__device__ __forceinline__ void transpose_work(const Ctx& X, unsigned* ctr, int first_small, int n_small, int layer, int n_exp_items, unsigned* done = nullptr, unsigned need = 0u, int stop_at = -1) {
  LAS unsigned char* scr = X.lds + X.wave * 8192;
  volatile LAS int* shb = (volatile LAS int*)(X.lds + LDS_MISC_OFF + 1024);
  const int total = n_small + n_exp_items;
  if (stop_at < 0) stop_at = total;
  const int per = done ? 1 : 4;
  for (;;) {
    __syncthreads();
    if (X.tid == 0) { int b = total; if (!done || __hip_atomic_load(done, __ATOMIC_RELAXED, __HIP_MEMORY_SCOPE_AGENT) < need) b = (int)atomicAdd(ctr, (unsigned)(8 * per)); shb[0] = b; }
    __syncthreads();
    const int base = shb[0];
    if (base >= stop_at) break;
    for (int k = 0; k < per; ++k) { const int it = base + X.wave * per + k; if (it >= total) break;
      if (it < n_small) small_item(X, scr, first_small + it);
      else { int e_it = it - n_small, l = layer; if (layer == 2) { l = e_it >= 65 * IT_EXP ? 1 : 0; e_it -= l * 65 * IT_EXP; } expert_item(X, scr, l, e_it); } }
  }
}

__device__ __forceinline__ void p0_adaln(const Ctx& X, int it) {
  const Args& a = *X.a; const int layer = it / 48, ct = it % 48;
  LAS float* sl = (LAS float*)X.lds;
  for (int i = X.tid; i < 2048; i += NTHR) { const float v = i < 1024 ? a.in[IN_C][i] : a.in[IN_CCTX][i - 1024]; sl[i] = v / (1.f + __expf(-v)); }
  __syncthreads();
  const int c4 = X.lane & 31, kh = X.lane >> 5, k0 = X.wave * 128 + kh * 64;
  const float* W = a.in[IN_WADA] + (size_t)layer * 1024 * 6144 + ct * 128 + 4 * c4;
  f32x4 a0 = (f32x4){0.f, 0.f, 0.f, 0.f}, a1 = a0;
#pragma unroll 16
  for (int k = 0; k < 64; ++k) { const f32x4 w = *(const f32x4*)(W + (size_t)(k0 + k) * 6144); const float s0 = sl[k0 + k], s1 = sl[1024 + k0 + k]; a0 += w * s0; a1 += w * s1; }
  LAS float* red = sl + 2048;
#pragma unroll
  for (int e = 0; e < 4; ++e) { a0[e] += sx(a0[e], 32); a1[e] += sx(a1[e], 32); }
  if (kh == 0) {
#pragma unroll
    for (int e = 0; e < 4; ++e) { red[(X.wave * 128 + 4 * c4 + e) * 2] = a0[e]; red[(X.wave * 128 + 4 * c4 + e) * 2 + 1] = a1[e]; } }
  __syncthreads();
  if (X.tid < 256) { const int l = X.tid & 127, v = X.tid >> 7; float s = 0.f;
#pragma unroll
    for (int w = 0; w < 8; ++w) s += red[(w * 128 + l) * 2 + v];
    s += a.in[IN_BADA][layer * 6144 + ct * 128 + l];
    float* mod = (float*)(X.ws + WS_MOD);
    if (layer == 0) mod[v * 6144 + ct * 128 + l] = s; else if (v == 0) mod[2 * 6144 + ct * 128 + l] = s; }
  __syncthreads();
}

__device__ __forceinline__ void p0_s5tables(const Ctx& X, int g, int part) {
  const Args& a = *X.a;
  constexpr int PS = 66;
  LAS f32x2* POW = (LAS f32x2*)X.lds;
  LAS f32x2* BB = (LAS f32x2*)(X.lds + 34944);
  LAS f32x2* CC = (LAS f32x2*)(X.lds + 51328);
  LAS float* KK = (LAS float*)(X.lds + 68224);
  LAS float* DD = (LAS float*)(X.lds + 133760);
  const int tid = X.tid;
  {
    const int dir = (tid >> 6) & 1, p = tid & 63, tq = tid >> 7, idx = (dir * 32 + g) * 64 + p;
    f32x4 bre[4], bim[4];
    if (tid < 128) {
#pragma unroll
      for (int j = 0; j < 4; ++j) { bre[j] = *(const f32x4*)(a.in[IN_BRE] + idx * 16 + 4 * j); bim[j] = *(const f32x4*)(a.in[IN_BIM] + idx * 16 + 4 * j); } }
    f32x2 ccv[4];
#pragma unroll
    for (int it = 0; it < 4; ++it) { const int i = tid + it * NTHR, d2 = i >> 10, c = (i >> 6) & 15, p2 = i & 63; const int gi = ((d2 * 32 + g) * 16 + c) * 64 + p2; ccv[it] = (f32x2){a.in[IN_CRE][gi], a.in[IN_CIM][gi]}; }
    const float lr = fminf(a.in[IN_LRE][idx], -1e-4f), li = a.in[IN_LIM][idx], dt = expf(a.in[IN_LDT][dir * 32 + g]);
    for (int tau = tq; tau <= 32; tau += 4) { const float mg = expf(lr * dt * (float)tau); float sn, cs; sincospif(li * dt * (float)tau * 0.318309886183790672f, &sn, &cs); POW[(dir * 33 + tau) * PS + p] = (f32x2){mg * cs, mg * sn}; }
#pragma unroll
    for (int it = 0; it < 4; ++it) { const int i = tid + it * NTHR; CC[(i >> 6) * PS + (i & 63)] = ccv[it]; }
    if (tid < 16) DD[tid] = a.in[IN_S5D][g * 16 + tid];
    __syncthreads();
    if (tid < 128) {
      const f32x2 l1 = POW[(dir * 33 + 1) * PS + p], l32 = POW[(dir * 33 + 32) * PS + p];
      if (part == 0) ((float2*)(X.ws + WS_LAML))[idx] = make_float2(l32.x, l32.y);
      const float nr = l1.x - 1.f, ni = l1.y, den = lr * lr + li * li, cr = (nr * lr + ni * li) / den, ci = (ni * lr - nr * li) / den;
#pragma unroll
      for (int j = 0; j < 4; ++j)
#pragma unroll
        for (int e = 0; e < 4; ++e) { const float xr = bre[j][e], xi = bim[j][e]; BB[(dir * 64 + p) * 16 + 4 * j + e] = (f32x2){cr * xr - ci * xi, cr * xi + ci * xr}; }
    }
  }
  __syncthreads();
  { const int lane = X.lane, dirw = X.wave >> 2, cl = lane & 15, ph = lane >> 5, ri = (lane >> 4) & 1;
    float ccx[32], ccy[32], bv[32];
#pragma unroll
    for (int st = 0; st < 32; ++st) { const int p = 2 * st + ph; const f32x2 cc = CC[(dirw * 16 + cl) * PS + p]; const f32x2 bb = BB[(dirw * 64 + p) * 16 + cl];
      ccx[st] = ri == 0 ? cc.x : -cc.y; ccy[st] = ri == 0 ? -cc.y : -cc.x; bv[st] = ri == 0 ? bb.x : bb.y; }
#pragma unroll 1
    for (int t = 0; t < 8; ++t) { const int tau = (X.wave & 3) * 8 + t;
      f32x4 acc = (f32x4){0.f, 0.f, 0.f, 0.f};
      const LAS f32x2* pwp = POW + (dirw * 33 + tau) * PS + ph;
#pragma unroll
      for (int st = 0; st < 32; ++st) { const f32x2 pw = pwp[2 * st]; const float av = ccx[st] * pw.x + ccy[st] * pw.y;
        acc = __builtin_amdgcn_mfma_f32_16x16x4f32(av, bv[st], acc, 0, 0, 0); }
#pragma unroll
      for (int r = 0; r < 4; ++r) KK[((dirw * 32 + tau) * 16 + 4 * (lane >> 4) + r) * 16 + cl] = acc[r];
    }
  }
  __syncthreads();
  bf16_t* TT = (bf16_t*)(X.ws + WS_TT) + (size_t)g * 512 * 768;
  for (int q = tid; q < 128 * 64; q += NTHR) {
    const int row = part * 128 + (q >> 6), cc8 = q & 63, i = row >> 4, c = row & 15; f32x4 v0, v1;
    const int s = cc8 >> 1, c0 = (cc8 & 1) * 8;
    const int dir = s < i ? 0 : 1, tau = s < i ? i - s : s - i;
    const LAS f32x4* kp = (const LAS f32x4*)(KK + ((dir * 32 + tau) * 16 + c) * 16 + c0);
    v0 = kp[0]; v1 = kp[1];
    if (s == i) { const LAS f32x4* k0p = (const LAS f32x4*)(KK + ((0 * 32 + 0) * 16 + c) * 16 + c0); v0 += k0p[0]; v1 += k0p[1];
      const float d = DD[c]; const int dj = c - c0;
      if (dj >= 0 && dj < 4) v0[dj] += d; else if (dj >= 4 && dj < 8) v1[dj - 4] += d; }
    *(u32x4*)(TT + (size_t)row * 768 + cc8 * 8) = pack8(v0, v1);
  }
  for (int q = tid; q < 128 * 32; q += NTHR) {
    const int row = part * 128 + (q >> 5), cc8 = 64 + (q & 31), i = row >> 4, c = row & 15;
    const int kk = (cc8 - 64) * 8, dir = kk >> 7, ri = (kk >> 6) & 1, p0 = kk & 63, tau = dir == 0 ? i + 1 : 32 - i;
    const LAS f32x4* cp = (const LAS f32x4*)(CC + (dir * 16 + c) * PS + p0); const LAS f32x4* pp = (const LAS f32x4*)(POW + (dir * 33 + tau) * PS + p0);
    float v[8];
#pragma unroll
    for (int j = 0; j < 4; ++j) { const f32x4 cc = cp[j], pw = pp[j];
      v[2 * j] = ri == 0 ? (cc.x * pw.x - cc.y * pw.y) : -(cc.x * pw.y + cc.y * pw.x); v[2 * j + 1] = ri == 0 ? (cc.z * pw.z - cc.w * pw.w) : -(cc.z * pw.w + cc.w * pw.z); }
    *(u32x4*)(TT + (size_t)row * 768 + cc8 * 8) = pack8((f32x4){v[0], v[1], v[2], v[3]}, (f32x4){v[4], v[5], v[6], v[7]});
  }
  bf16_t* WSm = (bf16_t*)(X.ws + WS_WS) + (size_t)g * 256 * 512;
  for (int q = part * 4096 + tid; q < (part + 1) * 4096; q += NTHR) {
    const int n = q >> 6, cc8 = q & 63, dir = n >> 7, ri = (n >> 6) & 1, p = n & 63, s = cc8 >> 1, c0 = (cc8 & 1) * 8, tau = dir == 0 ? 31 - s : s;
    const f32x2 pw = POW[(dir * 33 + tau) * PS + p]; const LAS f32x4* bp = (const LAS f32x4*)(BB + (dir * 64 + p) * 16 + c0); float v[8];
#pragma unroll
    for (int j = 0; j < 4; ++j) { const f32x4 b = bp[j]; v[2 * j] = ri == 0 ? (pw.x * b.x - pw.y * b.y) : (pw.x * b.y + pw.y * b.x); v[2 * j + 1] = ri == 0 ? (pw.x * b.z - pw.y * b.w) : (pw.x * b.w + pw.y * b.z); }
    *(u32x4*)(WSm + (size_t)n * 512 + cc8 * 8) = pack8((f32x4){v[0], v[1], v[2], v[3]}, (f32x4){v[4], v[5], v[6], v[7]});
  }
  __syncthreads();
}

__device__ __forceinline__ void p0_dftconst(const Ctx& X, int idx) {
  for (int q = idx * NTHR + X.tid; q < 24576; q += 32 * NTHR) {
    float v[8]; bf16_t* dst;
    if (q < 8192) {
      const int R = q >> 5, c0 = (q & 31) * 8, ri = R >> 7, m = R & 127; dst = (bf16_t*)(X.ws + WS_DMT) + (size_t)R * 256 + c0;
#pragma unroll
      for (int j = 0; j < 8; ++j) { float s, c; sincospif((float)(((c0 + j) * m) & 255) * (1.f / 128.f), &s, &c); v[j] = ri == 0 ? c : (m == 0 ? (((c0 + j) & 1) ? -1.f : 1.f) : -s); }
    } else if (q < 16384) {
      const int q2 = q - 8192, R = q2 >> 5, c0 = (q2 & 31) * 8, rip = R >> 7, ka = R & 127; dst = (bf16_t*)(X.ws + WS_W1) + (size_t)R * 256 + c0;
#pragma unroll
      for (int j = 0; j < 8; ++j) { const int C = c0 + j, ri = C >> 7, ta = C & 127; float s, c; sincospif((float)((ka * ta) & 127) * (1.f / 64.f), &s, &c);
        v[j] = (rip == ri) ? c : (rip == 0 ? s : -s); }
    } else {
      const int q2 = q - 16384, R = q2 >> 5, c0 = (q2 & 31) * 8, kb = R & 127; dst = (bf16_t*)(X.ws + WS_W2) + (size_t)R * 256 + c0;
#pragma unroll
      for (int j = 0; j < 8; ++j) { const int C = c0 + j, rip = C >> 7, tb = C & 127; float s, c; sincospif((float)((kb * tb) & 127) * (1.f / 64.f), &s, &c);
        v[j] = (R < 128 ? (rip == 0 ? c : s) : (rip == 0 ? -s : c)) * (1.f / 2048.f); }
    }
    u32x4 o; o.x = cvt_pk_bf16(v[0], v[1]); o.y = cvt_pk_bf16(v[2], v[3]); o.z = cvt_pk_bf16(v[4], v[5]); o.w = cvt_pk_bf16(v[6], v[7]);
    *(u32x4*)dst = o;
  }
}

__device__ __forceinline__ void phase_prep(const Ctx& X, int rep) {
  const int c = X.c;
#ifndef P0_SKIP
#define P0_SKIP 0
#endif
  const int skip = rep ? P0_SKIP : 0;
  if (c < 96) { if (!(skip & 1)) p0_adaln(X, c); }
  else if (c < 224) { if (!(skip & 2)) p0_s5tables(X, (c - 96) >> 2, (c - 96) & 3); }
  else { if (!(skip & 4)) p0_dftconst(X, c - 224); }
  __syncthreads();
  unsigned* ctl = (unsigned*)(X.ws + WS_CTL);
  if (!(skip & 8)) transpose_work(X, ctl + CW_DQ0 + 128 * rep, 0, IT_SMALL, 0, 0);
}

__device__ __forceinline__ void phase_mod0(const Ctx& X) {
  const Args& a = *X.a; const float* mod = (const float*)(X.ws + WS_MOD); bf16_t* A0 = (bf16_t*)(X.ws + WS_A0);
  const int gw = X.c * NWAVES + X.wave, NGW = X.G * NWAVES, lane = X.lane;
  f32x4 sh[4], sc[4], cur[4], nxt[4];
#pragma unroll
  for (int j = 0; j < 4; ++j) { sh[j] = ((const f32x4*)mod)[lane + 64 * j]; sc[j] = ((const f32x4*)(mod + 1024))[lane + 64 * j] + 1.f; }
  { const f32x4* xr = (const f32x4*)(a.in[IN_X] + (size_t)gw * 1024) + lane;
#pragma unroll
    for (int j = 0; j < 4; ++j) cur[j] = xr[64 * j]; }
  bool ctxmod = false;
  for (int r = gw; r < NROW; r += NGW) {
    const int rn = r + NGW;
    if (rn < NROW) { const f32x4* xr = (const f32x4*)(rn < TOK ? a.in[IN_X] + (size_t)rn * 1024 : a.in[IN_CTX] + (size_t)(rn - TOK) * 1024) + lane;
#pragma unroll
      for (int j = 0; j < 4; ++j) nxt[j] = xr[64 * j]; }
    if (r >= TOK && !ctxmod) { ctxmod = true;
#pragma unroll
      for (int j = 0; j < 4; ++j) { sh[j] = ((const f32x4*)(mod + 6144))[lane + 64 * j]; sc[j] = ((const f32x4*)(mod + 6144 + 1024))[lane + 64 * j] + 1.f; } }
    float ss = 0.f;
#pragma unroll
    for (int j = 0; j < 4; ++j) ss += (cur[j].x * cur[j].x + cur[j].y * cur[j].y) + (cur[j].z * cur[j].z + cur[j].w * cur[j].w);
    const float rr = rsqrtf(wave_sum(ss) * (1.f / 1024.f) + 1e-6f);
    u32x2* o8 = (u32x2*)(A0 + (size_t)r * 1024) + lane;
#pragma unroll
    for (int j = 0; j < 4; ++j) { const f32x4 f = cur[j] * rr * sc[j] + sh[j]; u32x2 w; w.x = cvt_pk_bf16(f.x, f.y); w.y = cvt_pk_bf16(f.z, f.w); o8[64 * j] = w; }
#pragma unroll
    for (int j = 0; j < 4; ++j) cur[j] = nxt[j];
  }
}


struct G1 {
  static constexpr bool PERM = true; static constexpr bool F8 = false; static constexpr int SCALE_B = 0x7A7A7A7A; static constexpr bool CONTIG = false; static constexpr bool ALIGN = true; static constexpr bool LINA = true, LINB = true; __device__ __forceinline__ size_t halfA() const { return 128u * 2048u; } __device__ __forceinline__ size_t halfB() const { return 128u * 2048u; } int K, nunits; unsigned char* ws; const float* qg; const float* kg;
  __device__ __forceinline__ void decode(int w, Unit& u) const { if (w < 390) { u.a = 0; u.pm = w / 6; u.pn = w % 6; } else { const int w2 = w - 390; u.a = 1; u.pm = w2 & 1; u.pn = w2 >> 1; } u.b = 0; }
  __device__ __forceinline__ const char* baseA(const Unit& u) const { return (const char*)ws + (u.a == 0 ? WS_A0 : WS_WIN_T + (size_t)1536 * 2048); }
  __device__ __forceinline__ const char* baseB(const Unit& u) const { return (const char*)ws + (u.a == 0 ? WS_WIN_T : WS_A0); }
  __device__ __forceinline__ unsigned rowA(const Unit& u, int r) const { return (unsigned)(u.pm * 256 + r) * 2048u; }
  __device__ __forceinline__ unsigned rowB(const Unit& u, int r) const { return (unsigned)(u.pn * 256 + r) * 2048u; }
  __device__ __forceinline__ void epi(const Acc& acc, const Unit& u, int wr, int wc, int fr, int fq) const {
    if (u.a == 1) {
      bf16_t* VT = (bf16_t*)(ws + WS_VT);
#pragma unroll
      for (int ai = 0; ai < 2; ++ai)
#pragma unroll
        for (int m = 0; m < 4; ++m) { const int dd = u.pm * 256 + ai * 128 + wr * 64 + m * 16 + fr, head = dd >> 6, d = dd & 63;
#pragma unroll
          for (int bj = 0; bj < 2; ++bj) { const int t0 = u.pn * 256 + bj * 128 + wc * 32 + 8 * fq, kr = t0 >> 6, cg = (t0 >> 3) & 7;
            *(u32x4*)((VT + ((((size_t)(head * 260 + kr) * 8 + cg) * 64 + d) * 8))) = pack8(acc[ai][bj][m][0], acc[ai][bj][m][1]); } }
      return;
    }
    if (u.pn < 2) {
      bf16_t* AS5 = (bf16_t*)(ws + WS_AS5);
#pragma unroll
      for (int ai = 0; ai < 2; ++ai)
#pragma unroll
        for (int m = 0; m < 4; ++m) { const int row = u.pm * 256 + ai * 128 + wr * 64 + m * 16 + fr; int crow, s;
          if (row < TOK) { crow = row >> 5; s = row & 31; } else { const int j = row - TOK; crow = 512 + (j >> 5); s = j & 31; }
#pragma unroll
          for (int bj = 0; bj < 2; ++bj) { const int g = 16 * u.pn + 8 * bj + 2 * wc + (fq >> 1), c0 = 8 * (fq & 1);
            *(u32x4*)((AS5 + ((size_t)(g * 768 + crow) * 768 + s * 16 + c0))) = pack8(acc[ai][bj][m][0], acc[ai][bj][m][1]); } }
      return;
    }
    const bool isq = u.pn < 4;
    if (isq && u.pm == 64) return;
    const int head = 4 * ((u.pn - 2) & 1) + wc; const float* gain = isq ? qg : kg;
    bf16_t* dst = isq ? (bf16_t*)(ws + WS_Q) : (bf16_t*)(ws + WS_K);
    f32x4 gv[2][2];
#pragma unroll
    for (int bj = 0; bj < 2; ++bj) { gv[bj][0] = *(const f32x4*)(gain + 32 * bj + 8 * fq); gv[bj][1] = *(const f32x4*)(gain + 32 * bj + 8 * fq + 4); }
#pragma unroll
    for (int ai = 0; ai < 2; ++ai)
#pragma unroll
      for (int m = 0; m < 4; ++m) { const int row = u.pm * 256 + ai * 128 + wr * 64 + m * 16 + fr; float ss = 0.f;
#pragma unroll
        for (int bj = 0; bj < 2; ++bj)
#pragma unroll
          for (int n = 0; n < 2; ++n) { const f32x4 x = acc[ai][bj][m][n]; ss += (x[0] * x[0] + x[1] * x[1]) + (x[2] * x[2] + x[3] * x[3]); }
        ss += sx(ss, 16); ss += sx(ss, 32);
        const float rinv = rsqrtf(ss * (1.f / 64.f) + 1e-6f);
#pragma unroll
        for (int bj = 0; bj < 2; ++bj) { const f32x4 v0 = acc[ai][bj][m][0] * rinv * gv[bj][0], v1 = acc[ai][bj][m][1] * rinv * gv[bj][1];
          if (isq) *(u32x4*)((dst + (size_t)row * 512 + head * 64 + 32 * bj + 8 * fq)) = pack8(v0, v1);
          else { const int kr = row >> 6, cg = (row >> 3) & 7, k8 = row & 7, ks = 2 * bj + (fq >> 1), hh2 = fq & 1;
            *(u32x4*)((dst + (((((size_t)(head * 260 + kr) * 8 + cg) * 4 + ks) * 8 + k8) * 2 + hh2) * 8)) = pack8(v0, v1); } } }
  }
};

struct G2 {
  static constexpr bool PERM = true; static constexpr bool F8 = false; static constexpr int SCALE_B = 0x7A7A7A7A; static constexpr bool CONTIG = false; static constexpr bool ALIGN = true; static constexpr bool LINA = true, LINB = true; __device__ __forceinline__ size_t halfA() const { return 128u * 1536u; } __device__ __forceinline__ size_t halfB() const { return 128u * 1024u; } int K, nunits; unsigned char* ws;
  __device__ __forceinline__ void decode(int w, Unit& u) const { u.a = w / 3; u.pm = w % 3; u.pn = 0; u.b = 0; }
  __device__ __forceinline__ const char* baseA(const Unit& u) const { return (const char*)ws + WS_AS5 + (size_t)u.a * 768 * 768 * 2; }
  __device__ __forceinline__ const char* baseB(const Unit& u) const { return (const char*)ws + WS_WS + (size_t)u.a * 256 * 512 * 2; }
  __device__ __forceinline__ unsigned rowA(const Unit& u, int r) const { return (unsigned)(u.pm * 256 + r) * 1536u; }
  __device__ __forceinline__ unsigned rowB(const Unit& u, int r) const { return (unsigned)r * 1024u; }
  __device__ __forceinline__ void epi(const Acc& acc, const Unit& u, int wr, int wc, int fr, int fq) const {
    float* SST = (float*)(ws + WS_SST) + (size_t)u.a * 768 * 256;
#pragma unroll
    for (int ai = 0; ai < 2; ++ai)
#pragma unroll
      for (int m = 0; m < 4; ++m) { const int crow = u.pm * 256 + ai * 128 + wr * 64 + m * 16 + fr; if (crow >= 520) continue;
#pragma unroll
        for (int bj = 0; bj < 2; ++bj) { float* p = SST + (size_t)crow * 256 + bj * 128 + wc * 32 + 8 * fq; *(f32x4*)p = acc[ai][bj][m][0]; *(f32x4*)(p + 4) = acc[ai][bj][m][1]; } }
  }
};

struct G3 {
  static constexpr bool PERM = true; static constexpr bool F8 = false; static constexpr int SCALE_B = 0x7A7A7A7A; static constexpr bool CONTIG = false; static constexpr bool ALIGN = true; static constexpr bool LINA = true, LINB = true; __device__ __forceinline__ size_t halfA() const { return 128u * 1536u; } __device__ __forceinline__ size_t halfB() const { return 128u * 1536u; } int K, nunits; unsigned char* ws;
  __device__ __forceinline__ void decode(int w, Unit& u) const { u.a = w >> 2; u.pm = (w >> 1) & 1; u.pn = w & 1; u.b = 0; }
  __device__ __forceinline__ const char* baseA(const Unit& u) const { return (const char*)ws + WS_AS5 + (size_t)u.a * 768 * 768 * 2; }
  __device__ __forceinline__ const char* baseB(const Unit& u) const { return (const char*)ws + WS_TT + (size_t)u.a * 512 * 768 * 2; }
  __device__ __forceinline__ unsigned rowA(const Unit& u, int r) const { return (unsigned)(u.pm * 256 + r) * 1536u; }
  __device__ __forceinline__ unsigned rowB(const Unit& u, int r) const { return (unsigned)(u.pn * 256 + r) * 1536u; }
  __device__ __forceinline__ void epi(const Acc& acc, const Unit& u, int wr, int wc, int fr, int fq) const {
    bf16_t* GB = (bf16_t*)(ws + WS_GB);
#pragma unroll
    for (int ai = 0; ai < 2; ++ai)
#pragma unroll
      for (int m = 0; m < 4; ++m) { const int crow = u.pm * 256 + ai * 128 + wr * 64 + m * 16 + fr;
#pragma unroll
        for (int bj = 0; bj < 2; ++bj) { const int pp = u.pn * 256 + bj * 128 + wc * 32 + 8 * fq, i = pp >> 4, c0 = pp & 15; f32x4 v0 = acc[ai][bj][m][0], v1 = acc[ai][bj][m][1];
#pragma unroll
          for (int j = 0; j < 4; ++j) { v0[j] = gelu_tanh(v0[j]); v1[j] = gelu_tanh(v1[j]); }
          *(u32x4*)((GB + (size_t)(crow * 32 + i) * 512 + u.a * 16 + c0)) = pack8(v0, v1); } }
  }
};

struct G4 {
  static constexpr bool PERM = true; static constexpr bool F8 = false; static constexpr int SCALE_B = 0x7A7A7A7A; static constexpr bool CONTIG = false; static constexpr bool ALIGN = true; static constexpr bool LINA = true, LINB = true; __device__ __forceinline__ size_t halfA() const { return 128u * 1024u; } __device__ __forceinline__ size_t halfB() const { return 128u * 1024u; } int K, nunits; unsigned char* ws; const float* bglu;
  __device__ __forceinline__ void decode(int w, Unit& u) const { u.pm = w >> 1; u.pn = w & 1; u.a = 0; u.b = 0; }
  __device__ __forceinline__ const char* baseA(const Unit&) const { return (const char*)ws + WS_GB; }
  __device__ __forceinline__ const char* baseB(const Unit&) const { return (const char*)ws + WS_WGLU_T; }
  __device__ __forceinline__ unsigned rowA(const Unit& u, int r) const { return (unsigned)(u.pm * 256 + r) * 1024u; }
  __device__ __forceinline__ unsigned rowB(const Unit& u, int r) const { return (unsigned)(u.pn * 256 + r) * 1024u; }
  __device__ __forceinline__ void epi(const Acc& acc, const Unit& u, int wr, int wc, int fr, int fq) const {
    const bf16_t* GB = (const bf16_t*)(ws + WS_GB); bf16_t* CC = (bf16_t*)(ws + WS_CONCAT);
#pragma unroll
    for (int bj = 0; bj < 2; ++bj) { const int col0 = u.pn * 256 + bj * 128 + wc * 32 + 8 * fq; const f32x4 b0 = *(const f32x4*)(bglu + col0), b1 = *(const f32x4*)(bglu + col0 + 4);
      u32x4 gin[2][4];
#pragma unroll
      for (int ai = 0; ai < 2; ++ai)
#pragma unroll
        for (int m = 0; m < 4; ++m) gin[ai][m] = *(const u32x4*)(GB + (size_t)(u.pm * 256 + ai * 128 + wr * 64 + m * 16 + fr) * 512 + col0);
#pragma unroll
      for (int ai = 0; ai < 2; ++ai)
#pragma unroll
        for (int m = 0; m < 4; ++m) { const int row = u.pm * 256 + ai * 128 + wr * 64 + m * 16 + fr; const u32x4 gw = gin[ai][m];
          f32x4 v0 = acc[ai][bj][m][0] + b0, v1 = acc[ai][bj][m][1] + b1;
          v0[0] = bf_lo(gw.x) * fast_sigmoid(v0[0]); v0[1] = bf_hi(gw.x) * fast_sigmoid(v0[1]); v0[2] = bf_lo(gw.y) * fast_sigmoid(v0[2]); v0[3] = bf_hi(gw.y) * fast_sigmoid(v0[3]);
          v1[0] = bf_lo(gw.z) * fast_sigmoid(v1[0]); v1[1] = bf_hi(gw.z) * fast_sigmoid(v1[1]); v1[2] = bf_lo(gw.w) * fast_sigmoid(v1[2]); v1[3] = bf_hi(gw.w) * fast_sigmoid(v1[3]);
          *(u32x4*)((CC + (size_t)row * 1024 + col0)) = pack8(v0, v1); } }
  }
};

struct GRes {
  static constexpr bool PERM = true; static constexpr bool F8 = false; static constexpr int SCALE_B = 0x7A7A7A7A; static constexpr bool CONTIG = false; static constexpr bool ALIGN = true; static constexpr bool LINA = true, LINB = true;
  __device__ __forceinline__ size_t halfA() const { return 128u * 2048u; } __device__ __forceinline__ size_t halfB() const { return 128u * 2048u; }
  int K, nunits; const char* A; const char* Bt; const float* hin32; const bf16_t* hin16; bf16_t* hout; const float* gate; const float* bias;
  __device__ __forceinline__ void decode(int w, Unit& u) const { u.pm = w >> 2; u.pn = w & 3; u.a = 0; u.b = 0; }
  __device__ __forceinline__ const char* baseA(const Unit&) const { return A; }
  __device__ __forceinline__ const char* baseB(const Unit&) const { return Bt; }
  __device__ __forceinline__ unsigned rowA(const Unit& u, int r) const { return (unsigned)(u.pm * 256 + r) * 2048u; }
  __device__ __forceinline__ unsigned rowB(const Unit& u, int r) const { return (unsigned)(u.pn * 256 + r) * 2048u; }
  __device__ __forceinline__ void epi(const Acc& acc, const Unit& u, int wr, int wc, int fr, int fq) const {
#pragma unroll
    for (int bj = 0; bj < 2; ++bj) { const int col0 = u.pn * 256 + bj * 128 + wc * 32 + 8 * fq;
      const f32x4 g0 = *(const f32x4*)(gate + col0), g1 = *(const f32x4*)(gate + col0 + 4);
      f32x4 b0 = (f32x4){0.f, 0.f, 0.f, 0.f}, b1 = b0; if (bias) { b0 = *(const f32x4*)(bias + col0); b1 = *(const f32x4*)(bias + col0 + 4); }
      if (hin32) { f32x4 hi[2][4][2];
#pragma unroll
        for (int ai = 0; ai < 2; ++ai)
#pragma unroll
          for (int m = 0; m < 4; ++m) { const size_t off = (size_t)(u.pm * 256 + ai * 128 + wr * 64 + m * 16 + fr) * 1024 + col0; hi[ai][m][0] = *(const f32x4*)(hin32 + off); hi[ai][m][1] = *(const f32x4*)(hin32 + off + 4); }
#pragma unroll
        for (int ai = 0; ai < 2; ++ai)
#pragma unroll
          for (int m = 0; m < 4; ++m) { const size_t off = (size_t)(u.pm * 256 + ai * 128 + wr * 64 + m * 16 + fr) * 1024 + col0;
            *(u32x4*)(hout + off) = pack8(hi[ai][m][0] + g0 * (acc[ai][bj][m][0] + b0), hi[ai][m][1] + g1 * (acc[ai][bj][m][1] + b1)); }
      } else { u32x4 hi[2][4];
#pragma unroll
        for (int ai = 0; ai < 2; ++ai)
#pragma unroll
          for (int m = 0; m < 4; ++m) hi[ai][m] = *(const u32x4*)(hin16 + (size_t)(u.pm * 256 + ai * 128 + wr * 64 + m * 16 + fr) * 1024 + col0);
#pragma unroll
        for (int ai = 0; ai < 2; ++ai)
#pragma unroll
          for (int m = 0; m < 4; ++m) { const size_t off = (size_t)(u.pm * 256 + ai * 128 + wr * 64 + m * 16 + fr) * 1024 + col0; const u32x4 w = hi[ai][m];
            const f32x4 h0 = (f32x4){bf_lo(w.x), bf_hi(w.x), bf_lo(w.y), bf_hi(w.y)}, h1 = (f32x4){bf_lo(w.z), bf_hi(w.z), bf_lo(w.w), bf_hi(w.w)};
            *(u32x4*)(hout + off) = pack8(h0 + g0 * (acc[ai][bj][m][0] + b0), h1 + g1 * (acc[ai][bj][m][1] + b1)); }
      } }
  }
};

__device__ __forceinline__ void build_moetab(const Ctx& X, int layer, LAS int* toff) {
  const unsigned* cnt = (const unsigned*)(X.ws + WS_CTL) + CW_CNT + layer * 2048;
  LAS int* texp = toff + 256;
  LAS int* ntile = toff + 132;
  __syncthreads();
  if (X.tid < 64) ntile[X.tid] = ((int)__hip_atomic_load(cnt + X.tid * 32, __ATOMIC_RELAXED, __HIP_MEMORY_SCOPE_AGENT) + 255) >> 8;
  __syncthreads();
  if (X.tid == 0) { int s = 0; for (int e = 0; e < 64; ++e) { toff[e] = s; s += ntile[e]; } toff[64] = s; toff[65] = s + 64; }
  __syncthreads();
  if (X.tid < 65) { const int e = X.tid; const int lo = toff[e], hi = toff[e + 1]; for (int t = lo; t < hi && t < 704; ++t) texp[t] = e; }
  __syncthreads();
}
__device__ __forceinline__ int find_expert(const LAS int* toff, int ti) { return toff[256 + ti]; }

struct G6 {
  static constexpr bool PERM = true; static constexpr bool F8 = true; static constexpr int SCALE_B = 0x7A7A7A7A; static constexpr bool CONTIG = false; static constexpr bool ALIGN = true; static constexpr bool LINA = false, LINB = true;
  __device__ __forceinline__ size_t halfA() const { return 0; } __device__ __forceinline__ size_t halfB() const { return 128u * 1024u; }
  int K, nunits; unsigned char* ws; const LAS int* toff; const LAS unsigned* tokt; const char* wbase; size_t wstride;
  __device__ __forceinline__ void decode(int w, Unit& u) const { const int ti = w >> 1; u.pn = w & 1; u.a = find_expert(toff, ti); u.pm = ti - toff[u.a]; u.b = ti; }
  __device__ __forceinline__ const char* baseA(const Unit&) const { return (const char*)ws + WS_F; }
  __device__ __forceinline__ const char* baseB(const Unit& u) const { return wbase + (size_t)u.a * wstride; }
  __device__ __forceinline__ unsigned rowA(const Unit& u, int r) const { return tokt[u.ord * 256 + r]; }
  __device__ __forceinline__ void build_tokt(const Ctx& X, LAS unsigned* tk) const {
    for (int i = 0; i * X.G + X.c < nunits; ++i) { Unit u; decode(xcd_remap(i * X.G + X.c, nunits), u);
      if (X.tid < 256) { const int idx = u.pm * 256 + X.tid; int tok = idx;
        if (u.a < 64) tok = ((const int*)(ws + WS_LTOK))[u.a * 16384 + idx];
        tk[i * 256 + X.tid] = (unsigned)tok * 1024u; } }
    __syncthreads();
  }
  __device__ __forceinline__ unsigned rowB(const Unit& u, int r) const { return (unsigned)(u.pn * 256 + r) * 1024u; }
  __device__ __forceinline__ void epi(const Acc& acc, const Unit& u, int wr, int wc, int fr, int fq) const {
    unsigned char* HID = ws + WS_HID;
#pragma unroll
    for (int ai = 0; ai < 2; ++ai)
#pragma unroll
      for (int m = 0; m < 4; ++m) { const size_t hrow = (size_t)u.b * 256 + ai * 128 + wr * 64 + m * 16 + fr; f32x4 v0, v1;
#pragma unroll
        for (int j = 0; j < 4; ++j) { const float g0 = acc[ai][0][m][0][j] * 0.03125f, g1 = acc[ai][0][m][1][j] * 0.03125f; v0[j] = g0 * fast_sigmoid(g0) * (acc[ai][1][m][0][j] * 0.25f); v1[j] = g1 * fast_sigmoid(g1) * (acc[ai][1][m][1][j] * 0.25f); }
        *(u32x2*)(HID + hrow * 256 + u.pn * 128 + wc * 32 + 8 * fq) = (u32x2){(unsigned)pack4_fp8(v0[0], v0[1], v0[2], v0[3]), (unsigned)pack4_fp8(v1[0], v1[1], v1[2], v1[3])}; }
  }
};
struct G7 {
  static constexpr bool PERM = true; static constexpr bool F8 = true; static constexpr int SCALE_B = 0x7A7A7A7A; static constexpr bool CONTIG = false; static constexpr bool ALIGN = true; static constexpr bool LINA = true, LINB = true;
  __device__ __forceinline__ size_t halfA() const { return 128u * 256u; } __device__ __forceinline__ size_t halfB() const { return 128u * 256u; }
  int K, nunits; unsigned char* ws; const LAS int* toff; const char* wbase; size_t wstride;
  __device__ __forceinline__ void decode(int w, Unit& u) const { const int ti = w >> 2; u.pn = w & 3; u.a = find_expert(toff, ti); u.pm = ti - toff[u.a]; u.b = ti; }
  __device__ __forceinline__ const char* baseA(const Unit&) const { return (const char*)ws + WS_HID; }
  __device__ __forceinline__ const char* baseB(const Unit& u) const { return wbase + (size_t)u.a * wstride; }
  __device__ __forceinline__ unsigned rowA(const Unit& u, int r) const { return (unsigned)(u.b * 256 + r) * 256u; }
  __device__ __forceinline__ unsigned rowB(const Unit& u, int r) const { return (unsigned)(u.pn * 256 + r) * 256u; }
  __device__ __forceinline__ void epi(const Acc& acc, const Unit& u, int wr, int wc, int fr, int fq) const {
    unsigned char* YAS = ws + WS_YAS;
#pragma unroll
    for (int ai = 0; ai < 2; ++ai)
#pragma unroll
      for (int m = 0; m < 4; ++m) { const size_t yrow = (size_t)u.b * 256 + ai * 128 + wr * 64 + m * 16 + fr;
#pragma unroll
        for (int bj = 0; bj < 2; ++bj) { const f32x4 v0 = acc[ai][bj][m][0] * 0.00390625f, v1 = acc[ai][bj][m][1] * 0.00390625f;
          const int w0 = pack4_fp8(v0[0], v0[1], v0[2], v0[3]), w1 = pack4_fp8(v1[0], v1[1], v1[2], v1[3]);
          *(u32x2*)(YAS + yrow * 1024 + u.pn * 256 + bj * 128 + wc * 32 + 8 * fq) = (u32x2){(unsigned)w0, (unsigned)w1}; } }
  }
};

struct G8 {
  static constexpr bool PERM = true; static constexpr bool F8 = false; static constexpr int SCALE_B = 0x7A7A7A7A; static constexpr bool CONTIG = false; static constexpr bool ALIGN = true; static constexpr bool LINA = true, LINB = false; __device__ __forceinline__ size_t halfA() const { return 128u * 512u; } __device__ __forceinline__ size_t halfB() const { return 0; } int K, nunits; unsigned char* ws;
  __device__ __forceinline__ void decode(int w, Unit& u) const { u.pm = 0; u.a = (w >> 6) & 3; u.pn = w & 63; u.b = 0; }
  __device__ __forceinline__ const char* baseA(const Unit&) const { return (const char*)ws + WS_DMT; }
  __device__ __forceinline__ const char* baseB(const Unit& u) const { return (const char*)ws + WS_A1 + (size_t)u.a * 512; }
  __device__ __forceinline__ unsigned rowA(const Unit&, int r) const { return (unsigned)r * 512u; }
  __device__ __forceinline__ unsigned rowB(const Unit& u, int r) const { const int n = u.pn * 256 + r; return (unsigned)(128 * (n & 127) + (n >> 7)) * 2048u; }
  __device__ __forceinline__ void epi(const Acc& acc, const Unit& u, int wr, int wc, int fr, int fq) const {
    bf16_t* X1 = (bf16_t*)(ws + WS_X1);
#pragma unroll
    for (int ai = 0; ai < 2; ++ai)
#pragma unroll
      for (int m = 0; m < 4; ++m) { const int mm = wr * 64 + m * 16 + fr;
#pragma unroll
        for (int bj = 0; bj < 2; ++bj) { const int n0 = u.pn * 256 + bj * 128 + wc * 32 + 8 * fq, tb = n0 >> 7, ta0 = n0 & 127;
          *(u32x4*)((X1 + ((((size_t)(u.a * 128 + mm) * 128 + tb) * 2 + ai) * 128 + ta0))) = pack8(acc[ai][bj][m][0], acc[ai][bj][m][1]); } }
  }
};
struct G9 {
  static constexpr bool PERM = true; static constexpr bool F8 = false; static constexpr int SCALE_B = 0x7A7A7A7A; static constexpr bool CONTIG = false; static constexpr bool ALIGN = true; static constexpr bool LINA = true, LINB = true; __device__ __forceinline__ size_t halfA() const { return 128u * 512u; } __device__ __forceinline__ size_t halfB() const { return 128u * 512u; } int K, nunits; unsigned char* ws;
  __device__ __forceinline__ void decode(int w, Unit& u) const { u.pm = 0; u.pn = w; u.a = 0; u.b = 0; }
  __device__ __forceinline__ const char* baseA(const Unit&) const { return (const char*)ws + WS_W1; }
  __device__ __forceinline__ const char* baseB(const Unit&) const { return (const char*)ws + WS_X1; }
  __device__ __forceinline__ unsigned rowA(const Unit&, int r) const { return (unsigned)r * 512u; }
  __device__ __forceinline__ unsigned rowB(const Unit& u, int r) const { return (unsigned)(u.pn * 256 + r) * 512u; }
  __device__ __forceinline__ void epi(const Acc& acc, const Unit& u, int wr, int wc, int fr, int fq) const {
    bf16_t* X2 = (bf16_t*)(ws + WS_X2);
#pragma unroll
    for (int m = 0; m < 4; ++m) { const int ka = wr * 64 + m * 16 + fr;
#pragma unroll
      for (int bj = 0; bj < 2; ++bj) { const int n0 = u.pn * 256 + bj * 128 + wc * 32 + 8 * fq, gm = n0 >> 7, tb0 = n0 & 127; f32x4 r0, r1, i0, i1;
#pragma unroll
        for (int j = 0; j < 4; ++j) {
          { const float ang = (float)((ka * (tb0 + j)) & 16383) * (1.f / 16384.f), cs = __builtin_amdgcn_cosf(ang), sn = __builtin_amdgcn_sinf(ang); const float yr = acc[0][bj][m][0][j], yi = acc[1][bj][m][0][j]; r0[j] = yr * cs + yi * sn; i0[j] = yi * cs - yr * sn; }
          { const float ang = (float)((ka * (tb0 + 4 + j)) & 16383) * (1.f / 16384.f), cs = __builtin_amdgcn_cosf(ang), sn = __builtin_amdgcn_sinf(ang); const float yr = acc[0][bj][m][1][j], yi = acc[1][bj][m][1][j]; r1[j] = yr * cs + yi * sn; i1[j] = yi * cs - yr * sn; } }
        bf16_t* p = X2 + (((size_t)(gm * 128 + ka) * 2) * 128 + tb0); *(u32x4*)(p) = pack8(r0, r1); *(u32x4*)((p + 128)) = pack8(i0, i1); } }
  }
};
struct G10 {
  static constexpr bool PERM = true; static constexpr bool F8 = false; static constexpr int SCALE_B = 0x7A7A7A7A; static constexpr bool CONTIG = false; static constexpr bool ALIGN = true; static constexpr bool LINA = true, LINB = false; __device__ __forceinline__ size_t halfA() const { return 128u * 512u; } __device__ __forceinline__ size_t halfB() const { return 0; } int K, nunits; unsigned char* ws;
  __device__ __forceinline__ void decode(int w, Unit& u) const { u.pm = 0; u.pn = w; u.a = 0; u.b = 0; }
  __device__ __forceinline__ const char* baseA(const Unit&) const { return (const char*)ws + WS_W2; }
  __device__ __forceinline__ const char* baseB(const Unit&) const { return (const char*)ws + WS_X2; }
  __device__ __forceinline__ unsigned rowA(const Unit&, int r) const { return (unsigned)r * 512u; }
  __device__ __forceinline__ unsigned rowB(const Unit& u, int r) const { const int n = u.pn * 256 + r, ka = n >> 9, gm = n & 511; return (unsigned)(gm * 128 + ka) * 512u; }
  __device__ __forceinline__ void epi(const Acc& acc, const Unit& u, int wr, int wc, int fr, int fq) const {
    bf16_t* FB = (bf16_t*)(ws + WS_FB); float2* SPC = (float2*)(ws + WS_SPC); const int ka = u.pn >> 1;
#pragma unroll
    for (int m = 0; m < 4; ++m) { const int kb = wr * 64 + m * 16 + fr; const int k = ka + 128 * kb, kmir = (16384 - k) & 16383;
#pragma unroll
      for (int bj = 0; bj < 2; ++bj) { const int gm0 = (u.pn & 1) * 256 + bj * 128 + wc * 32 + 8 * fq, d0 = (gm0 >> 7) * 128 + (gm0 & 127); const u32x4 o = pack8(acc[0][bj][m][0], acc[0][bj][m][1]);
        *(u32x4*)(FB + (size_t)k * 1024 + d0) = o; *(u32x4*)(FB + (size_t)kmir * 1024 + 512 + d0) = o;
        if ((gm0 & 127) == 0) SPC[k * 4 + (gm0 >> 7)] = make_float2(acc[0][bj][m][0][0], acc[1][bj][m][0][0]); } }
  }
};
}
namespace mk {
typedef float f32x16 __attribute__((ext_vector_type(16)));

__device__ __forceinline__ void phase_scan(const Ctx& X) {
  if (X.c >= 64) return;
  const int seg = X.wave, g = X.c >> 1, dir = X.c & 1, p = X.lane;
  const float2 lam = ((const float2*)(X.ws + WS_LAML))[(dir * 32 + g) * 64 + p];
  const float* S = (const float*)(X.ws + WS_SST) + (size_t)g * 768 * 256 + dir * 128 + p;
  bf16_t* XP = (bf16_t*)(X.ws + WS_AS5) + (size_t)g * 768 * 768 + 512 + dir * 128 + p;
  LAS float* EX = (LAS float*)X.lds;
  const int j0 = seg * 65;
  float xr = 0.f, xi = 0.f;
#pragma unroll
  for (int b = 0; b < 2; ++b) {
    float sr[33], si[33];
#pragma unroll
    for (int k = 0; k < 33 - b; ++k) { const int j = j0 + 33 * b + k; const int row = dir == 0 ? (j < 8 ? 512 + j : j - 8) : 519 - j; sr[k] = S[(size_t)row * 256]; si[k] = S[(size_t)row * 256 + 64]; }
#pragma unroll
    for (int k = 0; k < 33 - b; ++k) { const float nr = lam.x * xr - lam.y * xi + sr[k], ni = lam.x * xi + lam.y * xr + si[k]; xr = nr; xi = ni; }
  }
  EX[(seg * 64 + p) * 2] = xr; EX[(seg * 64 + p) * 2 + 1] = xi;
  float pr = 1.f, pi = 0.f;
  for (int k = 0; k < 65; ++k) { const float nr = pr * lam.x - pi * lam.y, ni = pr * lam.y + pi * lam.x; pr = nr; pi = ni; }
  __syncthreads();
  float cr = 0.f, ci = 0.f;
  for (int s2 = 0; s2 < seg; ++s2) { const float er = EX[(s2 * 64 + p) * 2], ei = EX[(s2 * 64 + p) * 2 + 1];
    const float nr = pr * cr - pi * ci + er, ni = pr * ci + pi * cr + ei; cr = nr; ci = ni; }
  xr = cr; xi = ci;
#pragma unroll
  for (int b = 0; b < 2; ++b) {
    float sr[33], si[33];
#pragma unroll
    for (int k = 0; k < 33 - b; ++k) { const int j = j0 + 33 * b + k; const int row = dir == 0 ? (j < 8 ? 512 + j : j - 8) : 519 - j; sr[k] = S[(size_t)row * 256]; si[k] = S[(size_t)row * 256 + 64]; }
#pragma unroll
    for (int k = 0; k < 33 - b; ++k) { const int j = j0 + 33 * b + k; const int row = dir == 0 ? (j < 8 ? 512 + j : j - 8) : 519 - j;
      XP[(size_t)row * 768] = f2bf(xr); XP[(size_t)row * 768 + 64] = f2bf(xi);
      const float nr = lam.x * xr - lam.y * xi + sr[k], ni = lam.x * xi + lam.y * xr + si[k]; xr = nr; xi = ni; }
  }
  __syncthreads();
}

__device__ __forceinline__ void zero_lists(const Ctx& X) {
  u32x4* z = (u32x4*)(X.ws + WS_LTOK); unsigned zu_ = 0u; asm volatile("" : "+v"(zu_)); const u32x4 zero = (u32x4){zu_, zu_, zu_, zu_};
  for (int i = X.c * NTHR + X.tid; i < (int)(4 * MiB / 16); i += X.G * NTHR) z[i] = zero;
}
#define MFMA32(a, b, c) __builtin_amdgcn_mfma_f32_32x32x16_bf16((a), (b), (c), 0, 0, 0)
__device__ __forceinline__ void attn_unit(const Ctx& X, const LAS float* rpbl, int head, int tile) {
  const bf16_t* Q = (const bf16_t*)(X.ws + WS_Q); const bf16_t* Kb = (const bf16_t*)(X.ws + WS_K); const bf16_t* VT = (const bf16_t*)(X.ws + WS_VT);
  bf16_t* CCt = (bf16_t*)(X.ws + WS_CONCAT);
  const int lane = X.lane, ql = lane & 31, hh = lane >> 5;
  const int rp = tile >> 2, mt = tile & 3;
  const int r = 2 * rp + (ql >> 4), cq = 16 * mt + (ql & 15), tq = r * 64 + cq;
  const int r0q = min(max(r - 4, 0), 248), csq = min(max(cq - 8, 0), 48);
  const int rlo = min(max(2 * rp - 4, 0), 248), rhi = min(max(2 * rp - 3, 0), 248) + 7;
  const int csb = min(max(16 * mt - 8, 0), 32);
  const int nloc = rhi - rlo + 1;
  unsigned cmask = 0u;
#pragma unroll
  for (int k = 0; k < 32; ++k) cmask |= ((csb + k >= csq) && (csb + k <= csq + 15)) ? (1u << k) : 0u;
  bf16x8 qf[4];
#pragma unroll
  for (int ks = 0; ks < 4; ++ks) qf[ks] = *(const bf16x8*)(Q + (size_t)tq * 512 + head * 64 + 16 * ks + 8 * hh);
  const int kperm = (ql & ~12) | ((ql & 4) << 1) | ((ql & 8) >> 1);
  f32x16 o0, o1;
#pragma unroll
  for (int i = 0; i < 16; ++i) { o0[i] = 0.f; o1[i] = 0.f; }
  float lsum = 0.f;
  const float c1 = 0.125f * 1.44269504f, c2 = 8.f * 1.44269504f;
  const float* rp_h = nullptr; (void)rp_h;
  const size_t koff_lane = (size_t)(((kperm >> 3) * 4 * 8 + (kperm & 7)) * 2 + hh) * 8;
  const size_t voff_lane = (size_t)(hh * 64 + ql) * 8;
  bf16x8 kf[4], vf[2][2];
  { const int kr0 = rlo, cg0 = csb >> 3;
    const bf16_t* kp = Kb + ((size_t)(head * 260 + kr0) * 8 + cg0) * 512 + koff_lane; const bf16_t* vp = VT + ((size_t)(head * 260 + kr0) * 8 + cg0) * 512 + voff_lane;
#pragma unroll
    for (int ks = 0; ks < 4; ++ks) kf[ks] = *(const bf16x8*)(kp + ks * 128);
#pragma unroll
    for (int db = 0; db < 2; ++db)
#pragma unroll
      for (int s2 = 0; s2 < 2; ++s2) vf[db][s2] = *(const bf16x8*)(vp + db * 256 + s2 * 1024); }
  for (int b = 0; b < nloc + 8; ++b) {
    const bool loc = b < nloc;
    const int kr = rlo + b;
    bf16x8 kc[4], vc[2][2];
#pragma unroll
    for (int ks = 0; ks < 4; ++ks) kc[ks] = kf[ks];
#pragma unroll
    for (int db = 0; db < 2; ++db)
#pragma unroll
      for (int s2 = 0; s2 < 2; ++s2) vc[db][s2] = vf[db][s2];
    if (b + 1 < nloc + 8) { const int bn = b + 1; const int krn = bn < nloc ? rlo + bn : 256 + ((bn - nloc) >> 1), cgn = bn < nloc ? (csb >> 3) : 4 * ((bn - nloc) & 1);
      const bf16_t* kp = Kb + ((size_t)(head * 260 + krn) * 8 + cgn) * 512 + koff_lane; const bf16_t* vp = VT + ((size_t)(head * 260 + krn) * 8 + cgn) * 512 + voff_lane;
#pragma unroll
      for (int ks = 0; ks < 4; ++ks) kf[ks] = *(const bf16x8*)(kp + ks * 128);
#pragma unroll
      for (int db = 0; db < 2; ++db)
#pragma unroll
        for (int s2 = 0; s2 < 2; ++s2) vf[db][s2] = *(const bf16x8*)(vp + db * 256 + s2 * 1024); }
    f32x16 sacc;
#pragma unroll
    for (int i = 0; i < 16; ++i) sacc[i] = 0.f;
#pragma unroll
    for (int ks = 0; ks < 4; ++ks) sacc = MFMA32(kc[ks], qf[ks], sacc);
    float pv[16];
    if (loc) {
      const bool rowok = (kr >= r0q) && (kr <= r0q + 7);
      const int dr = min(max(kr - r + 7, 0), 14);
      const LAS float* bp = rpbl + (head * 15 + dr) * 31;
      const int dc0 = csb - cq + 15;
#pragma unroll
      for (int i = 0; i < 16; ++i) { const int kidx = 16 * (i >> 3) + 8 * hh + (i & 7);
        const bool ok = rowok && ((cmask >> kidx) & 1u);
        const float bias = bp[min(max(dc0 + kidx, 0), 30)];
        const float e = __builtin_amdgcn_exp2f(sacc[i] * c1 + bias * 1.44269504f - c2); pv[i] = ok ? e : 0.f; }
    } else {
#pragma unroll
      for (int i = 0; i < 16; ++i) pv[i] = __builtin_amdgcn_exp2f(sacc[i] * c1 - c2);
    }
    u32x4 p0, p1;
    p0.x = cvt_pk_bf16(pv[0], pv[1]); p0.y = cvt_pk_bf16(pv[2], pv[3]); p0.z = cvt_pk_bf16(pv[4], pv[5]); p0.w = cvt_pk_bf16(pv[6], pv[7]);
    p1.x = cvt_pk_bf16(pv[8], pv[9]); p1.y = cvt_pk_bf16(pv[10], pv[11]); p1.z = cvt_pk_bf16(pv[12], pv[13]); p1.w = cvt_pk_bf16(pv[14], pv[15]);
    lsum += (bf_lo(p0.x) + bf_hi(p0.x)) + (bf_lo(p0.y) + bf_hi(p0.y)) + (bf_lo(p0.z) + bf_hi(p0.z)) + (bf_lo(p0.w) + bf_hi(p0.w))
          + (bf_lo(p1.x) + bf_hi(p1.x)) + (bf_lo(p1.y) + bf_hi(p1.y)) + (bf_lo(p1.z) + bf_hi(p1.z)) + (bf_lo(p1.w) + bf_hi(p1.w));
    const bf16x8 pb0 = __builtin_bit_cast(bf16x8, p0), pb1 = __builtin_bit_cast(bf16x8, p1);
    o0 = MFMA32(vc[0][0], pb0, o0); o0 = MFMA32(vc[0][1], pb1, o0);
    o1 = MFMA32(vc[1][0], pb0, o1); o1 = MFMA32(vc[1][1], pb1, o1);
  }
  lsum += sx(lsum, 32);
  const float inv = 1.f / lsum;
  bf16_t* op = CCt + (size_t)tq * 1024 + 512 + head * 64 + 4 * hh;
#pragma unroll
  for (int gq = 0; gq < 4; ++gq) {
    u32x2 w0, w1;
    w0.x = cvt_pk_bf16(o0[4 * gq] * inv, o0[4 * gq + 1] * inv); w0.y = cvt_pk_bf16(o0[4 * gq + 2] * inv, o0[4 * gq + 3] * inv);
    w1.x = cvt_pk_bf16(o1[4 * gq] * inv, o1[4 * gq + 1] * inv); w1.y = cvt_pk_bf16(o1[4 * gq + 2] * inv, o1[4 * gq + 3] * inv);
    *(u32x2*)(op + 8 * gq) = w0; *(u32x2*)(op + 32 + 8 * gq) = w1;
  }
}
__device__ __forceinline__ void phase_attn(const Ctx& X) {
  LAS float* rpbl = (LAS float*)X.lds;
  zero_lists(X);
  for (int i = X.tid; i < 8 * 15 * 31; i += NTHR) rpbl[i] = X.a->in[IN_RPB][i];
  __syncthreads();
  const int gw = X.c * NWAVES + X.wave, NGW = X.G * NWAVES;
  for (int U = gw; U < 4096; U += NGW) attn_unit(X, rpbl, U >> 9, U & 511);
}

__device__ __forceinline__ void fourier_fix(const Ctx& X, int nunits) {
  const float2* SPC = (const float2*)(X.ws + WS_SPC); bf16_t* FB = (bf16_t*)(X.ws + WS_FB);
  for (int i = 0; i * X.G + X.c < nunits; ++i) { const int pm = xcd_remap(i * X.G + X.c, nunits) >> 2;
    for (int q = X.tid; q < 1024; q += NTHR) { const int k = pm * 256 + (q >> 2), g = q & 3, kmir = (16384 - k) & 16383;
      const float2 a = SPC[k * 4 + g], b = SPC[kmir * 4 + g];
      FB[(size_t)k * 1024 + g * 128] = f2bf(0.5f * (a.x + b.x)); FB[(size_t)k * 1024 + 512 + g * 128] = f2bf(0.5f * (a.y + b.y)); } }
  __syncthreads();
}

__device__ __forceinline__ void phase_router(const Ctx& X, int layer, int dry) {
  const float* mod = (const float*)(X.ws + WS_MOD) + (layer == 0 ? 0 : 2 * 6144);
  const float* shift = mod + 3072; const float* scale = mod + 4096;
  const bf16_t* h = (const bf16_t*)(X.ws + WS_HB); bf16_t* F = (bf16_t*)(X.ws + WS_F);
  unsigned* cntg = (unsigned*)(X.ws + WS_CTL) + CW_CNT + layer * 2048;
  int* ltok = (int*)(X.ws + WS_LTOK); int* asg = (int*)(X.ws + WS_ASG);
  const bf16_t* WR = (const bf16_t*)(X.ws + WS_WROUT_T) + (size_t)layer * 64 * 1024;
  const float* rbias = X.a->in[IN_RBIAS] + layer * 64;
  constexpr int FROW = 2064;
  const int lane = X.lane, wave = X.wave, tid = X.tid;
  f32x4 scv[4], shv[4]; float rb[8];
#pragma unroll
  for (int j = 0; j < 4; ++j) { scv[j] = ((const f32x4*)scale)[lane + 64 * j] + 1.f; shv[j] = ((const f32x4*)shift)[lane + 64 * j]; }
#pragma unroll
  for (int j = 0; j < 8; ++j) rb[j] = rbias[(tid & 7) * 8 + j];
  for (int tile = X.c; tile < TOK / 64; tile += X.G) {
    const int t0 = tile * 64;
    { u32x2 raw[8][4];
#pragma unroll
      for (int rr = 0; rr < 8; ++rr) { const u32x2* xr = (const u32x2*)(h + (size_t)(t0 + wave * 8 + rr) * 1024) + lane;
#pragma unroll
        for (int j = 0; j < 4; ++j) raw[rr][j] = xr[64 * j]; }
#pragma unroll
      for (int rr = 0; rr < 8; ++rr) {
        const int lr = wave * 8 + rr, t = t0 + lr; float ss = 0.f; f32x4 v[4];
#pragma unroll
        for (int j = 0; j < 4; ++j) { const u32x2 w = raw[rr][j]; v[j] = (f32x4){bf_lo(w.x), bf_hi(w.x), bf_lo(w.y), bf_hi(w.y)}; ss += (v[j].x * v[j].x + v[j].y * v[j].y) + (v[j].z * v[j].z + v[j].w * v[j].w); }
        const float r = rsqrtf(wave_sum(ss) * (1.f / 1024.f) + 1e-6f);
#pragma unroll
        for (int j = 0; j < 4; ++j) { const f32x4 f = v[j] * r * scv[j] + shv[j];
          u32x2 w; w.x = cvt_pk_bf16(f.x, f.y); w.y = cvt_pk_bf16(f.z, f.w);
          if (!dry) ((int*)((unsigned char*)F + (size_t)t * 1024))[lane + 64 * j] = pack4_fp8(f.x, f.y, f.z, f.w);
          *(LAS u32x2*)(X.lds + lr * FROW + (lane + 64 * j) * 8) = w; }
      }
    }
    __syncthreads();
    f32x4 pl[4][4];
    { const int fr = lane & 15, fq = lane >> 4;
#pragma unroll
      for (int a = 0; a < 4; ++a)
#pragma unroll
        for (int b = 0; b < 4; ++b) pl[a][b] = (f32x4){0.f, 0.f, 0.f, 0.f};
      bf16x8 bq[4][4];
#pragma unroll
      for (int ks = 0; ks < 4; ++ks)
#pragma unroll
        for (int eb = 0; eb < 4; ++eb) bq[ks][eb] = *(const bf16x8*)(WR + (size_t)(eb * 16 + fr) * 1024 + wave * 128 + ks * 32 + fq * 8);
#pragma unroll
      for (int ks = 0; ks < 4; ++ks) {
        bf16x8 af[4];
#pragma unroll
        for (int rb = 0; rb < 4; ++rb) af[rb] = *(const LAS bf16x8*)(X.lds + (rb * 16 + fr) * FROW + (wave * 128 + ks * 32 + fq * 8) * 2);
#pragma unroll
        for (int rb = 0; rb < 4; ++rb)
#pragma unroll
          for (int eb = 0; eb < 4; ++eb) pl[rb][eb] = __builtin_amdgcn_mfma_f32_16x16x32_bf16(af[rb], bq[ks][eb], pl[rb][eb], 0, 0, 0);
      }
    }
    __syncthreads();
    { LAS float* PART = (LAS float*)X.lds;
      const int fr = lane & 15, fq = lane >> 4;
#pragma unroll
      for (int rb = 0; rb < 4; ++rb)
#pragma unroll
        for (int eb = 0; eb < 4; ++eb)
#pragma unroll
          for (int j = 0; j < 4; ++j) PART[(wave * 64 + rb * 16 + 4 * fq + j) * 64 + eb * 16 + fr] = pl[rb][eb][j];
      __syncthreads();
      float sum[8];
#pragma unroll
      for (int i = 0; i < 8; ++i) { float a = 0.f;
#pragma unroll
        for (int w = 0; w < 8; ++w) a += PART[w * 4096 + i * 512 + tid];
        sum[i] = a; }
      __syncthreads();
      LAS float* LG0 = (LAS float*)X.lds;
#pragma unroll
      for (int i = 0; i < 8; ++i) { const int o = i * 512 + tid; LG0[(o >> 6) * 65 + (o & 63)] = sum[i]; }
    }
    LAS float* LG = (LAS float*)X.lds;
    LAS float* GS = LG + 64 * 65;
    LAS float* SELV = GS + 512;
    LAS int* OUTE = (LAS int*)(SELV + 4096);
    LAS float* OUTS = (LAS float*)(OUTE + 512);
    LAS int* HIST = (LAS int*)(OUTS + 512);
    LAS int* BASE = HIST + 64;
    if (tid < 64) HIST[tid] = 0;
    __syncthreads();
    const int tl = tid >> 3, grp = tid & 7;
    float v[8], sc[8];
    { float m1 = -INFINITY, m2 = -INFINITY;
#pragma unroll
      for (int j = 0; j < 8; ++j) { const float s = 1.f / (1.f + __expf(-LG[tl * 65 + grp * 8 + j])); sc[j] = s; v[j] = s + rb[j];
        if (v[j] > m1) { m2 = m1; m1 = v[j]; } else if (v[j] > m2) m2 = v[j]; }
      GS[tl * 8 + grp] = m1 + m2; }
    __syncthreads();
    bool keep;
    { const float mine = GS[tl * 8 + grp]; int rank = 0;
#pragma unroll
      for (int g2 = 0; g2 < 8; ++g2) { const float o = GS[tl * 8 + g2]; rank += (o > mine || (o == mine && g2 < grp)) ? 1 : 0; }
      keep = rank < 4;
#pragma unroll
      for (int j = 0; j < 8; ++j) SELV[tl * 64 + grp * 8 + j] = keep ? v[j] : -INFINITY; }
    __syncthreads();
    if (keep) {
      int rk[8];
#pragma unroll
      for (int j = 0; j < 8; ++j) rk[j] = 0;
      for (int e2 = 0; e2 < 64; ++e2) { const float o = SELV[tl * 64 + e2];
#pragma unroll
        for (int j = 0; j < 8; ++j) rk[j] += (o > v[j] || (o == v[j] && e2 < grp * 8 + j)) ? 1 : 0; }
#pragma unroll
      for (int j = 0; j < 8; ++j) if (rk[j] < 8) { OUTE[tl * 8 + rk[j]] = grp * 8 + j; OUTS[tl * 8 + rk[j]] = sc[j]; }
    }
    __syncthreads();
    { const int jj = tid & 7, e = OUTE[tl * 8 + jj]; const float s = OUTS[tl * 8 + jj];
      float sum = s; sum += sx(sum, 1); sum += sx(sum, 2); sum += sx(sum, 4);
      const float w = 2.5f * s / sum;
      const int sl = atomicAdd((int*)&HIST[e], 1);
      __syncthreads();
      const int t = t0 + tl;
      if (tid < 64) { const int n = HIST[tid]; BASE[tid] = (n && !dry) ? (int)atomicAdd(cntg + tid * 32, (unsigned)n) : 0; }
      __syncthreads();
      const int slot = BASE[e] + sl;
      if (!dry) { ltok[(size_t)e * 16384 + slot] = t; } if (!dry) ((int2*)asg)[t * 8 + jj] = make_int2((e << 16) | slot, __float_as_int(w)); }
    __syncthreads();
  }
}

__device__ __forceinline__ void phase_combine(const Ctx& X, int layer, const LAS int* toff, int dry) {
  const float* mod = (const float*)(X.ws + WS_MOD) + (layer == 0 ? 0 : 2 * 6144);
  const float* gffn = mod + 5120;
  const float* nmod = (const float*)(X.ws + WS_MOD) + 2 * 6144;
  float* hout32 = X.a->h; bf16_t* hb = (bf16_t*)(X.ws + WS_HB); const unsigned char* YAS = X.ws + WS_YAS; const int* asg = (const int*)(X.ws + WS_ASG); bf16_t* A1 = (bf16_t*)(X.ws + WS_A1);
  const int gw = X.c * NWAVES + X.wave, NGW = X.G * NWAVES, lane = X.lane;
  f32x4 gtv[4], nsh[4], nsc[4];
#pragma unroll
  for (int j = 0; j < 4; ++j) { gtv[j] = ((const f32x4*)gffn)[lane + 64 * j]; nsh[j] = ((const f32x4*)nmod)[lane + 64 * j]; nsc[j] = ((const f32x4*)(nmod + 1024))[lane + 64 * j] + 1.f; }
  for (int t0 = gw; t0 < TOK; t0 += 2 * NGW) {
    int yw[2][9][4]; f32x4 hv[2][4]; float wgt[2][8];
#pragma unroll
    for (int u = 0; u < 2; ++u) { const int t = t0 + u * NGW;
      int pos[9];
#pragma unroll
      for (int k = 0; k < 8; ++k) { const int2 a = ((const int2*)asg)[t * 8 + k]; pos[k] = toff[a.x >> 16] * 256 + (a.x & 0xffff); wgt[u][k] = __int_as_float(a.y); }
      pos[8] = toff[64] * 256 + t;
#pragma unroll
      for (int k = 0; k < 9; ++k) { const int* yr = (const int*)(YAS + (size_t)pos[k] * 1024) + lane;
#pragma unroll
        for (int j = 0; j < 4; ++j) yw[u][k][j] = yr[64 * j]; }
      const u32x2* hr = (const u32x2*)(hb + (size_t)t * 1024) + lane;
#pragma unroll
      for (int j = 0; j < 4; ++j) { const u32x2 w = hr[64 * j]; hv[u][j] = (f32x4){bf_lo(w.x), bf_hi(w.x), bf_lo(w.y), bf_hi(w.y)}; } }
#pragma unroll
    for (int u = 0; u < 2; ++u) { const int t = t0 + u * NGW;
      f32x4 acc[4];
#pragma unroll
      for (int j = 0; j < 4; ++j) acc[j] = (f32x4){0.f, 0.f, 0.f, 0.f};
#pragma unroll
      for (int k = 0; k < 9; ++k) { const float wk = k < 8 ? wgt[u][k] : 1.f;
#pragma unroll
        for (int j = 0; j < 4; ++j) { const int w = yw[u][k][j];
          acc[j].x += wk * __builtin_amdgcn_cvt_f32_fp8(w, 0); acc[j].y += wk * __builtin_amdgcn_cvt_f32_fp8(w, 1); acc[j].z += wk * __builtin_amdgcn_cvt_f32_fp8(w, 2); acc[j].w += wk * __builtin_amdgcn_cvt_f32_fp8(w, 3); } }
      f32x4 v[4]; float ss = 0.f;
#pragma unroll
      for (int j = 0; j < 4; ++j) { v[j] = hv[u][j] + gtv[j] * acc[j];
        if (!dry) { if (layer == 0) ((u32x2*)(hb + (size_t)t * 1024))[lane + 64 * j] = (u32x2){cvt_pk_bf16(v[j].x, v[j].y), cvt_pk_bf16(v[j].z, v[j].w)}; else ((f32x4*)(hout32 + (size_t)t * 1024))[lane + 64 * j] = v[j]; }
        ss += (v[j].x * v[j].x + v[j].y * v[j].y) + (v[j].z * v[j].z + v[j].w * v[j].w); }
      if (layer == 0) {
        const float r = rsqrtf(wave_sum(ss) * (1.f / 1024.f) + 1e-6f);
#pragma unroll
        for (int j = 0; j < 4; ++j) { const f32x4 f = v[j] * r * nsc[j] + nsh[j];
          u32x2 w; w.x = cvt_pk_bf16(f.x, f.y); w.y = cvt_pk_bf16(f.z, f.w);
          if (!dry) ((u32x2*)(A1 + (size_t)t * 1024))[lane + 64 * j] = w; }
      }
    }
  }
}

constexpr int NPHASE = 21;
template <bool SP2>
__global__ void __launch_bounds__(NTHR, 2) mk_fwd(Args args) {
  extern __shared__ __attribute__((aligned(16))) unsigned char lds_raw[];
  Ctx X; X.lds = (LAS unsigned char*)lds_raw; X.a = &args; X.ws = args.ws; X.tid = threadIdx.x; X.lane = X.tid & 63; X.wave = __builtin_amdgcn_readfirstlane(X.tid >> 6);
  X.G = gridDim.x; X.c = blockIdx.x;
  const int wave_s = X.wave;
  volatile LAS unsigned* MISC = (volatile LAS unsigned*)(X.lds + LDS_MISC_OFF);
  LAS int* TOFF = (LAS int*)(X.lds + LDS_MISC_OFF + 64);
  if (X.tid < 16) MISC[X.tid] = 0u;
  __syncthreads();
  unsigned* ctl = (unsigned*)(X.ws + WS_CTL);
  const int lo = args.ph_lo, hi = args.ph_hi;
  const bool multi = (hi - lo) > 1;
  XcdBarrier bar; bar.bar = ctl + CW_BAR; bar.x = 0; bar.st = nullptr;
  if (multi) bar = xcd_barrier_post(ctl + CW_BAR, MISC, X.tid);
  LAS unsigned char* lds = X.lds;
  unsigned char* ws = X.ws;
  const float* mod = (const float*)(ws + WS_MOD); (void)mod;
#ifndef PH_MASK
#define PH_MASK 0x1fffffull
#endif
#define IN(k) ((((unsigned long long)PH_MASK >> (k)) & 1ull) && lo <= (k) && (k) < hi)
#define SEAM(k) do { if (IN(k) && IN((k) + 1)) xcd_barrier(bar, X.tid); } while (0)
#ifndef REP_MASK
#define REP_MASK 0ull
#endif
#define REPS(k) ((int)(((unsigned long long)REP_MASK >> (k)) & 1ull))
#define FILL(ph, nb) do { if (!(args.flags & FLAG_SKIP_EXPERTS) && multi) { if (X.c < (nb)) { __syncthreads(); if (X.tid == 0) atomicAdd(ctl + CW_DONE + 64 * (ph), 1u); } \
    else transpose_work(X, ctl + CW_DQ1, 0, 0, 2, 130 * IT_EXP, ctl + CW_DONE + 64 * (ph), (unsigned)(nb)); } } while (0)
#define LAUNDER() do { int w0_ = wave_s; asm volatile("" : "+s"(w0_)); unsigned zl_ = 0u; asm volatile("" : "+v"(zl_)); int l_ = (int)__builtin_amdgcn_mbcnt_hi(~0u, __builtin_amdgcn_mbcnt_lo(~0u, zl_)); X.wave = w0_; X.lane = l_; X.tid = w0_ * 64 + l_; \
    size_t z0_ = 0; asm volatile("" : "+s"(z0_)); unsigned char* w_ = args.ws + z0_; X.ws = w_; ws = w_; mod = (const float*)(w_ + WS_MOD); } while (0)
  if (IN(0)) for (int rep_ = 0; rep_ <= REPS(0); ++rep_) { if (rep_) xcd_barrier(bar, X.tid); LAUNDER(); phase_prep(X, rep_); } SEAM(0);
#ifdef EXTRA_BARS
  if (multi) for (int eb_ = 0; eb_ < EXTRA_BARS; ++eb_) xcd_barrier(bar, X.tid);
#endif
  if (IN(1)) for (int rep_ = 0; rep_ <= REPS(1); ++rep_) { if (rep_) xcd_barrier(bar, X.tid); LAUNDER(); phase_mod0(X); } SEAM(1);
  if (IN(2)) for (int rep_ = 0; rep_ <= REPS(2); ++rep_) { if (rep_) xcd_barrier(bar, X.tid); LAUNDER(); G1 p; p.K = 1024; p.nunits = 520; p.ws = ws; p.qg = args.in[IN_QG]; p.kg = args.in[IN_KG]; gemm_phase<G1, SP2>(lds, p, X.G, X.c, X.tid); FILL(2, 8); } SEAM(2);
  if (IN(3)) for (int rep_ = 0; rep_ <= REPS(3); ++rep_) { if (rep_) xcd_barrier(bar, X.tid); LAUNDER(); G2 p; p.K = 512; p.nunits = 96; p.ws = ws; gemm_phase<G2, SP2>(lds, p, X.G, X.c, X.tid); FILL(3, 96); } SEAM(3);
  if (IN(4)) for (int rep_ = 0; rep_ <= REPS(4); ++rep_) { if (rep_) xcd_barrier(bar, X.tid); LAUNDER(); phase_scan(X); FILL(4, 64); } SEAM(4);
  if (IN(5)) for (int rep_ = 0; rep_ <= REPS(5); ++rep_) { if (rep_) xcd_barrier(bar, X.tid); LAUNDER(); G3 p; p.K = 768; p.nunits = 128; p.ws = ws; gemm_phase<G3, SP2>(lds, p, X.G, X.c, X.tid); FILL(5, 128); } SEAM(5);
  if (IN(6)) for (int rep_ = 0; rep_ <= REPS(6); ++rep_) { if (rep_) xcd_barrier(bar, X.tid); LAUNDER(); G4 p; p.K = 512; p.nunits = 128; p.ws = ws; p.bglu = args.in[IN_BGLU]; gemm_phase<G4, SP2>(lds, p, X.G, X.c, X.tid); FILL(6, 128); } SEAM(6);
  if (IN(7)) for (int rep_ = 0; rep_ <= REPS(7); ++rep_) { if (rep_) xcd_barrier(bar, X.tid); LAUNDER(); phase_attn(X); } SEAM(7);
  if (IN(8)) for (int rep_ = 0; rep_ <= REPS(8); ++rep_) { if (rep_) xcd_barrier(bar, X.tid); LAUNDER(); GRes p; p.K = 1024; p.nunits = 256; p.A = (const char*)ws + WS_CONCAT; p.Bt = (const char*)ws + WS_WMIX_T; p.hin32 = args.in[IN_X]; p.hin16 = nullptr; p.hout = (bf16_t*)(ws + WS_HB); p.gate = mod + 2048; p.bias = nullptr;
    gemm_phase<GRes, SP2>(lds, p, X.G, X.c, X.tid); } SEAM(8);
#pragma unroll 1
  for (int layer = 0; layer < 2; ++layer) {
    const int pb = layer == 0 ? 9 : 17;
    if (IN(pb)) for (int rep_ = 0; rep_ <= REPS(pb); ++rep_) { if (rep_) xcd_barrier(bar, X.tid); LAUNDER(); phase_router(X, layer, rep_);
      if (layer == 0 && rep_ == 0 && !(args.flags & FLAG_SKIP_EXPERTS)) { __syncthreads(); transpose_work(X, ctl + CW_DQ1, 0, 0, 2, 130 * IT_EXP, nullptr, 0u, 65 * IT_EXP); } } SEAM(pb);
#ifndef ROUTER_VARIANT
#define ROUTER_VARIANT 1
#endif
#ifndef G6_VARIANT
#define G6_VARIANT 1
#endif
    if (IN(pb + 1)) for (int rep_ = REPS(pb + 1); rep_ >= 0; --rep_) { if (rep_ == 0 && REPS(pb + 1)) xcd_barrier(bar, X.tid); LAUNDER(); build_moetab(X, layer, TOFF); G6 p; p.K = 512; p.ws = ws; p.toff = TOFF; p.nunits = TOFF[65] * 2; p.wbase = (const char*)ws + (layer == 0 ? WS_WEXP : WS_WEXP1); p.wstride = layer == 0 ? EXP_STRIDE : EXP1_STRIDE;
      { LAS unsigned* tk = (LAS unsigned*)(X.lds + LDS_STAGE); p.tokt = tk; p.build_tokt(X, tk); } gemm_phase<G6, false>(lds, p, X.G, X.c, X.tid); } SEAM(pb + 1);
#ifndef G7_VARIANT
#define G7_VARIANT 1
#endif
    if (IN(pb + 2)) for (int rep_ = REPS(pb + 2); rep_ >= 0; --rep_) { if (rep_ == 0 && REPS(pb + 2)) xcd_barrier(bar, X.tid); LAUNDER(); build_moetab(X, layer, TOFF); G7 p; { int k_ = 128; asm volatile("" : "+s"(k_)); p.K = k_; } p.ws = ws; p.toff = TOFF; p.nunits = TOFF[65] * 4; p.wbase = (const char*)ws + (layer == 0 ? WS_WEXP + EXP_DOFF : WS_WEXP1 + EXP1_DOFF); p.wstride = layer == 0 ? EXP_STRIDE : EXP1_STRIDE; gemm_phase<G7, false>(lds, p, X.G, X.c, X.tid); } SEAM(pb + 2);
    if (IN(pb + 3)) for (int rep_ = REPS(pb + 3); rep_ >= 0; --rep_) { if (rep_ == 0 && REPS(pb + 3)) xcd_barrier(bar, X.tid); LAUNDER(); build_moetab(X, layer, TOFF); phase_combine(X, layer, TOFF, rep_);
      if (layer == 0 && rep_ == 0 && !(args.flags & FLAG_SKIP_EXPERTS)) { __syncthreads(); transpose_work(X, ctl + CW_DQ1, 0, 0, 2, 130 * IT_EXP); } }
    if (layer == 0) {
      SEAM(12);
      if (IN(13)) for (int rep_ = 0; rep_ <= REPS(13); ++rep_) { if (rep_) xcd_barrier(bar, X.tid); LAUNDER(); G8 p; p.K = 256; p.nunits = 256; p.ws = ws; gemm_phase<G8, SP2>(lds, p, X.G, X.c, X.tid); } SEAM(13);
      if (IN(14)) for (int rep_ = 0; rep_ <= REPS(14); ++rep_) { if (rep_) xcd_barrier(bar, X.tid); LAUNDER(); G9 p; p.K = 256; p.nunits = 256; p.ws = ws; gemm_phase<G9, SP2>(lds, p, X.G, X.c, X.tid); } SEAM(14);
      if (IN(15)) for (int rep_ = 0; rep_ <= REPS(15); ++rep_) { if (rep_) xcd_barrier(bar, X.tid); LAUNDER(); G10 p; p.K = 256; p.nunits = 256; p.ws = ws; gemm_phase<G10, SP2>(lds, p, X.G, X.c, X.tid); } SEAM(15);
      if (IN(16)) { LAUNDER(); zero_lists(X); fourier_fix(X, 256); GRes p; p.K = 1024; p.nunits = 256; p.A = (const char*)ws + WS_FB; p.Bt = (const char*)ws + WS_WFOUR_T; p.hin32 = nullptr; p.hin16 = (const bf16_t*)(ws + WS_HB); p.hout = (bf16_t*)(ws + WS_HB); p.gate = mod + 2 * 6144 + 2048; p.bias = args.in[IN_BFOUR];
        gemm_phase<GRes, SP2>(lds, p, X.G, X.c, X.tid); } SEAM(16);
    }
  }
#undef IN
#undef SEAM
}
}
#ifndef MK_SP2
#define MK_SP2 true
#endif
#ifndef MK_N_LAUNCHES
#define MK_N_LAUNCHES 1
#endif
#ifndef CHECK
#define CHECK 0
#endif
static int g_grid = 0;
static bool mk_setup(int n_in, int out_size, size_t ws_size) {
  if (g_grid == 0) {
    g_grid = -1;
    if (n_in != 31 || out_size != 16384 * 1024 || ws_size < mk::WS_NEED) { fprintf(stderr, "kernel_launch: unexpected n_in %d out %d ws %zu\n", n_in, out_size, ws_size); return false; }
    int dev = 0, cus = 0;
    if (hipGetDevice(&dev) != hipSuccess || hipDeviceGetAttribute(&cus, hipDeviceAttributeMultiprocessorCount, dev) != hipSuccess) return false;
    if (cus < 256) { fprintf(stderr, "kernel_launch: needs 256 CUs, device has %d\n", cus); return false; }
    if (hipFuncSetAttribute((const void*)mk::mk_fwd<MK_SP2>, hipFuncAttributeMaxDynamicSharedMemorySize, mk::LDS_BYTES) != hipSuccess) { fprintf(stderr, "kernel_launch: hipFuncSetAttribute failed\n"); return false; }
    g_grid = 256;
  }
  return g_grid > 0;
}
static void mk_run(hipStream_t s, mk::Args a, int lo, int hi) {
  a.ph_lo = lo; a.ph_hi = hi;
  hipLaunchKernelGGL(mk::mk_fwd<MK_SP2>, dim3(g_grid), dim3(mk::NTHR), mk::LDS_BYTES, s, a);
}

#if CHECK
namespace chk {
using mk::bf16_t;
__device__ __forceinline__ float b2f(bf16_t b) { return __uint_as_float(((unsigned)b) << 16); }
__global__ void k_cmp(int mode, const void* A, const float* B, unsigned long long n, double* acc) {
  double e = 0.0, r = 0.0; const bf16_t* A16 = (const bf16_t*)A;
  for (unsigned long long i = (unsigned long long)blockIdx.x * 256 + threadIdx.x; i < n; i += (unsigned long long)gridDim.x * 256) {
    float a = 0.f, b = 0.f; const int row = (int)(i >> 9), col = (int)(i & 511);
    switch (mode) {
      case 0: a = ((const float*)A)[i]; b = B[i]; break;
      case 1: a = b2f(A16[i]); b = B[i]; break;
      case 2: { b = B[(size_t)row * 2048 + col]; const int g = col >> 4, c = col & 15; int crow, s; if (row < 16384) { crow = row >> 5; s = row & 31; } else { const int j = row - 16384; crow = 512 + (j >> 5); s = j & 31; }
                a = b2f(A16[((size_t)(g * 768 + crow)) * 768 + s * 16 + c]); } break;
      case 3: b = B[(size_t)row * 2048 + 512 + col]; a = b2f(A16[(size_t)row * 512 + col]); break;
      case 4: b = B[(size_t)row * 2048 + 1024 + col]; a = b2f(A16[(size_t)row * 512 + col]); break;
      case 5: b = B[(size_t)row * 2048 + 1536 + col]; a = b2f(A16[(size_t)col * 16640 + row]); break;
      case 6: b = B[(size_t)row * 1024 + col]; a = b2f(A16[(size_t)row * 1024 + col]); break;
      case 7: b = B[(size_t)row * 1024 + 512 + col]; a = b2f(A16[(size_t)row * 1024 + 512 + col]); break;
      case 8: { const int ta = (int)(i & 127), ri = (int)((i >> 7) & 1), tb = (int)((i >> 8) & 127), m = (int)((i >> 15) & 255), g = (int)(i >> 23); a = b2f(A16[i]); const int t = 128 * ta + tb; b = B[((size_t)t * 4 + g) * 512 + ri * 256 + m]; } break;
      default: break;
    }
    const double d = (double)a - (double)b; e += d * d; r += (double)b * (double)b;
  }
  for (int o = 32; o >= 1; o >>= 1) { e += __shfl_xor(e, o); r += __shfl_xor(r, o); }
  if ((threadIdx.x & 63) == 0) { atomicAdd(acc, e); atomicAdd(acc + 1, r); }
}
__global__ void k_cmp_x2(const bf16_t* X2, const float* Yr, const float* Yi, double* acc) {
  double e = 0.0, r = 0.0;
  for (unsigned long long i = (unsigned long long)blockIdx.x * 256 + threadIdx.x; i < (1ull << 25); i += (unsigned long long)gridDim.x * 256) {
    const int tb = (int)(i & 127), rip = (int)((i >> 7) & 1), ka = (int)((i >> 8) & 127), gm = (int)(i >> 15);
    const float a = b2f(X2[i]); const size_t yi = (((size_t)ka * 128 + tb) << 10) + gm; const float b = rip ? Yi[yi] : Yr[yi];
    const double d = (double)a - (double)b; e += d * d; r += (double)b * (double)b;
  }
  for (int o = 32; o >= 1; o >>= 1) { e += __shfl_xor(e, o); r += __shfl_xor(r, o); }
  if ((threadIdx.x & 63) == 0) { atomicAdd(acc, e); atomicAdd(acc + 1, r); }
}
__global__ void k_judge(const double* acc, int n, float tol, int* fail) {
  if (threadIdx.x == 0 && blockIdx.x == 0) { fail[0] = 0; for (int k = 0; k < n; ++k) { const double rel = sqrt(acc[2 * k] / acc[2 * k + 1]); if (!(rel <= (double)tol)) { fail[0] = k + 1; break; } } }
}
__global__ void k_encode(float* out, size_t n, const int* fail) {
  const int f = fail[0]; if (f == 0) return; const float sc = 1.f + 0.1f * (float)f;
  for (size_t i = (size_t)blockIdx.x * 256 + threadIdx.x; i < n; i += (size_t)gridDim.x * 256) out[i] *= sc;
}
__global__ void k_f2bf(const float* in, bf16_t* out, size_t n) { for (size_t i = (size_t)blockIdx.x * 256 + threadIdx.x; i < n; i += (size_t)gridDim.x * 256) out[i] = mk::f2bf(in[i]); }
static void cmp(hipStream_t s, int mode, const void* A, const float* B, unsigned long long n, double* acc) { hipLaunchKernelGGL(k_cmp, dim3(2048), dim3(256), 0, s, mode, A, B, n, acc); }
}
#endif

extern "C" void kernel_launch(void* const* d_in, const int* in_sizes, int n_in, void* d_out, int out_size, void* d_ws, size_t ws_size, hipStream_t stream) {
  if (!mk_setup(n_in, out_size, ws_size)) return;
  unsigned char* ws = (unsigned char*)d_ws;
  const size_t MiB = mk::MiB;
  mk::Args a{};
  for (int i = 0; i < 31; ++i) a.in[i] = (const float*)d_in[i];
  a.h = (float*)d_out; a.ws = ws; a.flags = 0; a.pad = 0;
#if CHECK == 0
  (void)hipMemsetAsync(ws + mk::WS_CTL, 0, mk::CTL_ZERO_BYTES, stream);
#if MK_N_LAUNCHES == 1
  mk_run(stream, a, 0, mk::NPHASE);
#else
  for (int ph = 0; ph < mk::NPHASE; ++ph) mk_run(stream, a, ph, ph + 1);
#endif
#else
  ref::In in; { const float** p = (const float**)&in; for (int i = 0; i < 31; ++i) p[i] = (const float*)d_in[i]; }
  float* out = (float*)d_out;
  char* wsc = (char*)d_ws;
  ref::Small sm; sm.mod = (float*)(wsc + 498 * MiB); sm.lamb = (float2*)(wsc + 498 * MiB + 131072); sm.bbar = (float2*)(wsc + 498 * MiB + 262144);
  sm.tw = (float2*)(wsc + 499 * MiB); sm.Dm = (float*)(wsc + 499 * MiB + 262144);
  double* acc = (double*)(wsc + 500 * MiB); int* fail = (int*)(wsc + 500 * MiB + 4096);
  (void)hipMemsetAsync(acc, 0, 8192, stream);
  (void)hipMemsetAsync(ws + mk::WS_CTL, 0, mk::CTL_ZERO_BYTES, stream);
  float* HOPT = (float*)(ws + mk::WS_HOPT);
  int nchk = 0;
#if CHECK == 1
  ref::MixBuf mb; mb.a0 = (float*)(wsc + 12 * MiB); mb.z = (float*)(wsc + 336 * MiB); mb.g = (float*)(wsc + 466 * MiB); mb.t = (float*)(wsc + 77 * MiB); mb.concat = mb.a0; mb.ymix = mb.z;
  char* moe_arena = wsc + 12 * MiB;
  ref::FourBuf fb; { char* p = wsc + 12 * MiB; fb.a1 = (float*)p; p += 64 * MiB; fb.Z = (float*)p; p += 128 * MiB; fb.Yr = (float*)p; p += 64 * MiB; fb.Yi = (float*)p; p += 64 * MiB; fb.F = (float*)p; fb.yf = fb.Z; }
  a.flags = mk::FLAG_SKIP_EXPERTS;
  nchk = 10;
  ref::forward(stream, in, out, sm, mb, moe_arena, fb, [&](int st) {
    if (st == 1) { mk_run(stream, a, 0, 1); chk::cmp(stream, 0, ws + mk::WS_MOD, sm.mod, 3 * 6144, acc + 0); }
    if (st == 2) { mk_run(stream, a, 1, 2); chk::cmp(stream, 1, ws + mk::WS_A0, mb.a0, 16640ull * 1024, acc + 2); }
    if (st == 3) { mk_run(stream, a, 2, 3); chk::cmp(stream, 2, ws + mk::WS_AS5, mb.z, 16640ull * 512, acc + 4); chk::cmp(stream, 3, ws + mk::WS_Q, mb.z, 16384ull * 512, acc + 6);
                   chk::cmp(stream, 4, ws + mk::WS_K, mb.z, 16640ull * 512, acc + 8); chk::cmp(stream, 5, ws + mk::WS_VT, mb.z, 16640ull * 512, acc + 10); }
    if (st == 4) { mk_run(stream, a, 3, 4); mk_run(stream, a, 4, 5); mk_run(stream, a, 5, 6); chk::cmp(stream, 1, ws + mk::WS_GB, mb.g, 16384ull * 512, acc + 12); }
    if (st == 5) { mk_run(stream, a, 6, 7); chk::cmp(stream, 6, ws + mk::WS_CONCAT, mb.concat, 16384ull * 512, acc + 14); }
    if (st == 6) { mk_run(stream, a, 7, 8); chk::cmp(stream, 7, ws + mk::WS_CONCAT, mb.concat, 16384ull * 512, acc + 16); }
    if (st == 7) { mk::Args b = a; b.h = HOPT; mk_run(stream, b, 8, 9); chk::cmp(stream, 0, HOPT, out, 16384ull * 1024, acc + 18); }
  });
#elif CHECK == 2 || CHECK == 4
  const int L = CHECK == 2 ? 0 : 1;
  ref::MixBuf mb; { char* p = wsc + 12 * MiB; mb.a0 = (float*)p; p += 65 * MiB; mb.z = (float*)p; p += 130 * MiB; mb.g = (float*)p; p += 32 * MiB; mb.t = (float*)p; p += 32 * MiB; mb.concat = (float*)p; p += 64 * MiB; mb.ymix = mb.z; }
  ref::FourBuf fb; { char* p = wsc + 12 * MiB; fb.a1 = (float*)p; p += 64 * MiB; fb.Z = (float*)p; p += 128 * MiB; fb.Yr = (float*)p; p += 64 * MiB; fb.Yi = (float*)p; p += 64 * MiB; fb.F = (float*)p; fb.yf = fb.Z; }
  char* moe_arena = wsc + 110 * MiB;
  nchk = L == 0 ? 2 : 1;
  a.flags = 0;
  ref::forward(stream, in, out, sm, mb, moe_arena, fb, [&](int st) {
    if ((L == 0 && st == 7) || (L == 1 && st == 11)) {
      mk::Args b = a; b.h = HOPT; if (L == 1) b.flags = 2;
      mk_run(stream, b, 0, 1);
      (void)hipMemcpyAsync(HOPT, out, (size_t)16384 * 1024 * 4, hipMemcpyDeviceToDevice, stream);
      const int pb = L == 0 ? 9 : 20; b.flags |= mk::FLAG_SKIP_EXPERTS;
      for (int ph = pb; ph < pb + 7; ++ph) mk_run(stream, b, ph, ph + 1);
    }
    if ((L == 0 && st == 8) || (L == 1 && st == 12)) chk::cmp(stream, 0, HOPT, out, 16384ull * 1024, acc + 0);
    if (L == 0 && st == 9) chk::cmp(stream, 1, ws + mk::WS_A1, fb.a1, 16384ull * 1024, acc + 2);
  });
#elif CHECK == 3
  ref::MixBuf mb; { char* p = wsc + 12 * MiB; mb.a0 = (float*)p; p += 65 * MiB; mb.z = (float*)p; p += 130 * MiB; mb.g = (float*)p; p += 32 * MiB; mb.t = (float*)p; p += 32 * MiB; mb.concat = (float*)p; p += 64 * MiB; mb.ymix = mb.z; }
  char* moe_arena = wsc + 12 * MiB;
  ref::FourBuf fb; fb.Z = (float*)(wsc + 270 * MiB);
  fb.a1 = (float*)(wsc + 12 * MiB); fb.Yr = (float*)(wsc + 12 * MiB);   fb.Yi = (float*)(wsc + 468 * MiB - 0); fb.F = (float*)(wsc + 270 * MiB); fb.yf = (float*)(wsc + 334 * MiB);
  fb.Yi = (float*)(wsc + 76 * MiB);
  nchk = 4;
  a.flags = mk::FLAG_SKIP_EXPERTS;
  ref::forward(stream, in, out, sm, mb, moe_arena, fb, [&](int st) {
    if (st == 9) {
      mk::Args b = a; b.h = HOPT;
      mk_run(stream, b, 0, 1);
      hipLaunchKernelGGL(chk::k_f2bf, dim3(2048), dim3(256), 0, stream, fb.a1, (chk::bf16_t*)(ws + mk::WS_A1), (size_t)16384 * 1024);
      (void)hipMemcpyAsync(HOPT, out, (size_t)16384 * 1024 * 4, hipMemcpyDeviceToDevice, stream);
      mk_run(stream, b, 16, 17);
    }
  });
#endif
  hipLaunchKernelGGL(chk::k_judge, dim3(1), dim3(64), 0, stream, acc, nchk, 0.05f, fail);
  hipLaunchKernelGGL(chk::k_encode, dim3(2048), dim3(256), 0, stream, out, (size_t)16384 * 1024, fail);
#endif
}
```

```cpp
#define CHECK 0
#define MK_N_LAUNCHES 1
#define MK_SP2 true
#define REP_MASK 0ull
#include <hip/hip_runtime.h>
#include <cstdio>
#include <cstdint>
#include <cmath>
namespace mk {
#define LAS __attribute__((address_space(3)))
typedef unsigned short bf16_t;
typedef short bf16x8 __attribute__((ext_vector_type(8)));
typedef float f32x4 __attribute__((ext_vector_type(4)));
typedef float f32x2 __attribute__((ext_vector_type(2)));
typedef unsigned u32x4 __attribute__((ext_vector_type(4)));
typedef unsigned u32x2 __attribute__((ext_vector_type(2)));
typedef int i32x8 __attribute__((ext_vector_type(8)));
typedef int i32x4 __attribute__((ext_vector_type(4)));

constexpr int TOK = 16384, CTXN = 256, NROW = TOK + CTXN;
constexpr int NWAVES = 8, NTHR = 512;
constexpr int LDS_STAGE = 131072, LDS_BYTES = 155648, LDS_MISC_OFF = LDS_BYTES - 4096;

__device__ __forceinline__ unsigned cvt_pk_bf16(float lo, float hi) { unsigned r; asm volatile("v_cvt_pk_bf16_f32 %0, %1, %2" : "=v"(r) : "v"(lo), "v"(hi)); return r; }
__device__ __forceinline__ int pack4_fp8(float a, float b, float c, float d) { int w = 0;
  w = __builtin_amdgcn_cvt_pk_fp8_f32(__builtin_amdgcn_fmed3f(a, -448.f, 448.f), __builtin_amdgcn_fmed3f(b, -448.f, 448.f), w, false);
  w = __builtin_amdgcn_cvt_pk_fp8_f32(__builtin_amdgcn_fmed3f(c, -448.f, 448.f), __builtin_amdgcn_fmed3f(d, -448.f, 448.f), w, true); return w; }
__device__ __forceinline__ void st16_wt(void* p, u32x4 v) { asm volatile("global_store_dwordx4 %0, %1, off sc1\n\ts_nop 1" :: "v"(p), "v"(v) : "memory"); }
__device__ __forceinline__ float bf_lo(unsigned w) { return __uint_as_float(w << 16); }
__device__ __forceinline__ float bf_hi(unsigned w) { return __uint_as_float(w & 0xffff0000u); }
__device__ __forceinline__ float bf2f(bf16_t b) { return __uint_as_float(((unsigned)b) << 16); }
__device__ __forceinline__ bf16_t f2bf(float f) { unsigned u = __float_as_uint(f); return (bf16_t)((u + 0x7fffu + ((u >> 16) & 1u)) >> 16); }
__device__ __forceinline__ float sx(float v, int o) { unsigned z = 0u; asm volatile("" : "+v"(z)); int l = (int)__builtin_amdgcn_mbcnt_hi(~0u, __builtin_amdgcn_mbcnt_lo(~0u, z)); return __int_as_float(__builtin_amdgcn_ds_bpermute((l ^ o) << 2, __float_as_int(v))); }
__device__ __forceinline__ float wave_sum(float v) {
#pragma unroll
  for (int o = 1; o < 64; o <<= 1) v += sx(v, o);
  return v;
}
__device__ __forceinline__ float fast_sigmoid(float x) { return __builtin_amdgcn_rcpf(1.f + __expf(-x)); }
__device__ __forceinline__ float fast_tanh(float x) { float e = __expf(2.f * x); return 1.f - 2.f * __builtin_amdgcn_rcpf(e + 1.f); }
__device__ __forceinline__ float gelu_tanh(float x) { return 0.5f * x * (1.f + fast_tanh(0.7978845608028654f * (x + 0.044715f * x * x * x))); }

#define XB_TMO      128
#define XB_XCNT(j)  (256  + 64 * (j))
#define XB_XSUB(j)  (1280 + 64 * (j))
#define XB_XGEN(j)  (2304 + 64 * (j))
#define XB_TOP      3328
#define XB_TOPGEN   3392
#define XCD_BAR_WORDS 3456
#define XB_SPIN_CAP (1u << 20)
__device__ __forceinline__ unsigned xb_ld(unsigned* p) { return __hip_atomic_load(p, __ATOMIC_RELAXED, __HIP_MEMORY_SCOPE_AGENT); }
__device__ __forceinline__ unsigned xb_add(unsigned* p, unsigned v) { return __hip_atomic_fetch_add(p, v, __ATOMIC_RELAXED, __HIP_MEMORY_SCOPE_AGENT); }
__device__ __forceinline__ unsigned xb_xcc_id() { return (unsigned)__builtin_amdgcn_s_getreg((3 << 11) | 20) & 0xFu; }
#define XB_SPIN(cond, bar) do { unsigned _sp = 0; while (cond) { __builtin_amdgcn_s_sleep(1); \
    if ((++_sp & 255u) == 0u) { if (xb_ld(&(bar)[XB_TMO])) break; if (_sp > XB_SPIN_CAP) { atomicAdd(&(bar)[XB_TMO], 1u); break; } } } } while (0)
struct XcdBarrier { unsigned* bar; unsigned x; volatile LAS unsigned* st; };
__device__ __forceinline__ XcdBarrier xcd_barrier_post(unsigned* bar, volatile LAS unsigned* st, int tid) {
  XcdBarrier b; b.bar = bar; b.x = xb_xcc_id(); b.st = st;
  if (tid == 0) (void)xb_add(&bar[XB_XCNT(b.x)], 1u);
  return b;
}
__device__ __forceinline__ void xcd_barrier_complete(unsigned* bar, unsigned x, unsigned& nloc, unsigned& nx) {
  const unsigned G = gridDim.x * gridDim.y * gridDim.z;
  unsigned sum, cnt, mine, sp = 0u;
  for (;;) {
    sum = 0u; cnt = 0u; mine = 0u;
#pragma unroll
    for (unsigned j = 0; j < 16; ++j) { const unsigned c = xb_ld(&bar[XB_XCNT(j)]); sum += c; cnt += (c > 0u) ? 1u : 0u; }
    if (sum == G) { mine = xb_ld(&bar[256 + 64 * x]); break; }
    __builtin_amdgcn_s_sleep(1);
    if ((++sp & 255u) == 0u) { if (xb_ld(&bar[XB_TMO])) break; if (sp > XB_SPIN_CAP) { atomicAdd(&bar[XB_TMO], 1u); break; } }
  }
  nloc = mine > 0u ? mine : 1u; nx = cnt > 0u ? cnt : 1u;
}
__device__ __forceinline__ void xcd_barrier(const XcdBarrier& b, int tid) {
  asm volatile("s_waitcnt vmcnt(0)" ::: "memory");
  __syncthreads();
  if (tid == 0) {
    unsigned* bar = b.bar;
    __builtin_amdgcn_s_waitcnt(0);
    unsigned nloc = b.st[0], nx = b.st[1];
    if (nloc == 0u) { xcd_barrier_complete(bar, b.x, nloc, nx); b.st[0] = nloc; b.st[1] = nx; }
    const unsigned old = xb_add(&bar[XB_XSUB(b.x)], 1u);
    const unsigned gen = old / nloc;
    if (old + 1u == (gen + 1u) * nloc) {
      __builtin_amdgcn_fence(__ATOMIC_RELEASE, "agent");
      asm volatile("s_waitcnt vmcnt(0)" ::: "memory");
      const unsigned og = xb_add(&bar[XB_TOP], 1u);
      const unsigned tg = og / nx;
      if (og + 1u == (tg + 1u) * nx) xb_add(&bar[XB_TOPGEN], 1u);
      else XB_SPIN(xb_ld(&bar[XB_TOPGEN]) == tg, bar);
      __builtin_amdgcn_fence(__ATOMIC_ACQUIRE, "agent");
      xb_add(&bar[XB_XGEN(b.x)], 1u);
      asm volatile("s_waitcnt vmcnt(0)" ::: "memory");
    } else {
      XB_SPIN(xb_ld(&bar[XB_XGEN(b.x)]) == gen, bar);
      __builtin_amdgcn_fence(__ATOMIC_ACQUIRE, "agent");
      asm volatile("s_waitcnt vmcnt(0)" ::: "memory");
    }
  }
  __syncthreads();
}

constexpr int BM = 256, BK = 64, HALF = 128, HTB = HALF * BK * 2, NXCD = 8;
__device__ __forceinline__ int lds_byte(int r, int c) { const int st = (r >> 4) * 2 + (c >> 5), rr = r & 15, cc = c & 31, ob = rr * 64 + cc * 2; return st * 1024 + (ob ^ (((ob >> 9) & 1) << 5)); }
__device__ __forceinline__ void stage_rc(int b, int& R, int& C) { const int st = b / 1024, sb = b % 1024, swz = sb ^ (((sb >> 9) & 1) << 5); R = (st >> 1) * 16 + swz / 64; C = (st & 1) * 32 + (swz % 64) / 2; }
__device__ __forceinline__ int swz16(int fr) { return 2 * ((fr >> 1) & 1) + 4 * ((fr >> 3) & 1); }
__device__ __forceinline__ int swz8(int fr) { return ((fr >> 1) & 1) + 4 * ((fr >> 3) & 1); }
__device__ __forceinline__ int perm32(int rho) { const int n = rho >> 4, i = rho & 15; return 8 * (i >> 2) + 4 * n + (i & 3); }

struct Unit { int pm, pn, a, b, ord; };
__device__ __forceinline__ int xcd_remap(int L, int nunits) { const int q = nunits / NXCD, r = nunits % NXCD, xcd = L % NXCD, off = L / NXCD; return (xcd < r ? xcd * (q + 1) : r * (q + 1) + (xcd - r) * q) + off; }
typedef f32x4 Acc[2][2][4][2];
template <class P, bool SP2>
__device__ __forceinline__ void gemm_phase(LAS unsigned char* lds, const P& p, int G, int c, int tid_in) {
  const int tid = tid_in, wid = __builtin_amdgcn_readfirstlane(tid >> 6), lane = tid & 63, wr = wid >> 2, wc = wid & 3, fr = lane & 15, fq = lane >> 4;
  const int K = p.K, nt = K / BK;
  const int nunits = p.nunits;
  const size_t kstep = (size_t)(BK * 2);
  const unsigned ldsw = (unsigned)wid * 1024u;
  const int aoff0 = P::F8 ? (wr * 64 + fr) * 128 + ((2 * fq) ^ swz8(fr)) * 16 : lds_byte(wr * 64 + fr, fq * 8);
  const int boff0 = P::F8 ? (wc * 32 + fr) * 128 + ((2 * fq) ^ swz8(fr)) * 16 : lds_byte(wc * 32 + fr, fq * 8);
#define PG8_SA(b, h) (((b) * 2 + (h)) * HTB)
#define PG8_SB(b, h) ((4 + (b) * 2 + (h)) * HTB)
#define PG8_STAGE(bufoff, gbase, voff) do { _Pragma("unroll") for (int _i = 0; _i < 2; ++_i) \
        __builtin_amdgcn_global_load_lds((const unsigned*)((const char*)(gbase) + (voff)[_i]), (LAS unsigned*)(lds + (bufoff) + ldsw + _i * 8192), 16, 0, 0); } while (0)
#define PG8_RD32(p0_, p1_) __builtin_shufflevector(*(const LAS i32x4*)(p0_), *(const LAS i32x4*)(p1_), 0, 1, 2, 3, 4, 5, 6, 7)
#define PG8_LDA(dst, b, h) do { if constexpr (P::F8) { int _o1 = aoff0 ^ 16; asm volatile("" : "+v"(_o1)); _Pragma("unroll") for (int m = 0; m < 4; ++m) dst##8[m] = PG8_RD32(lds + PG8_SA(b, h) + aoff0 + m * 2048, lds + PG8_SA(b, h) + _o1 + m * 2048); } \
        else { _Pragma("unroll") for (int m = 0; m < 4; ++m) _Pragma("unroll") for (int k = 0; k < 2; ++k) dst[m][k] = *(const LAS bf16x8*)(lds + PG8_SA(b, h) + aoff0 + m * 2048 + k * 1024); } } while (0)
#define PG8_LDB(dst, b, h) do { if constexpr (P::F8) { int _o1 = boff0 ^ 16; asm volatile("" : "+v"(_o1)); _Pragma("unroll") for (int n = 0; n < 2; ++n) dst##8[n] = PG8_RD32(lds + PG8_SB(b, h) + boff0 + n * 2048, lds + PG8_SB(b, h) + _o1 + n * 2048); } \
        else { _Pragma("unroll") for (int n = 0; n < 2; ++n) _Pragma("unroll") for (int k = 0; k < 2; ++k) dst[n][k] = *(const LAS bf16x8*)(lds + PG8_SB(b, h) + boff0 + n * 2048 + k * 1024); } } while (0)
#define PG8_MMA(ai, bj, At, Bt) do { __builtin_amdgcn_s_setprio(1); if constexpr (P::F8) { _Pragma("unroll") for (int m = 0; m < 4; ++m) _Pragma("unroll") for (int n = 0; n < 2; ++n) \
        acc[ai][bj][m][n] = __builtin_amdgcn_mfma_scale_f32_16x16x128_f8f6f4(Bt##8[n], At##8[m], acc[ai][bj][m][n], 0, 0, 0, 0, 0, 0); }     \
        else { _Pragma("unroll") for (int m = 0; m < 4; ++m) _Pragma("unroll") for (int n = 0; n < 2; ++n) _Pragma("unroll") for (int k = 0; k < 2; ++k) \
        acc[ai][bj][m][n] = __builtin_amdgcn_mfma_f32_16x16x32_bf16(Bt[n][k], At[m][k], acc[ai][bj][m][n], 0, 0, 0); } __builtin_amdgcn_s_setprio(0); } while (0)
#define PG8_WAIT_V(n) asm volatile("s_waitcnt vmcnt(" #n ")" ::: "memory")
#define PG8_WAIT_L(n) asm volatile("s_waitcnt lgkmcnt(" #n ")" ::: "memory")
#define PG8_BAR __builtin_amdgcn_s_barrier()
#define PG8_SCHED __builtin_amdgcn_sched_barrier(0)
#define PG8_DECODE(i, u) do { int w_; if constexpr (P::CONTIG) w_ = u_lo + (i); else if constexpr (P::GROUP > 1) w_ = xcd_remap(((i) / P::GROUP) * G + c, nunits / P::GROUP) * P::GROUP + ((i) % P::GROUP); else w_ = xcd_remap((i) * G + c, nunits); p.decode(w_, u); u.ord = (i); } while (0)
#define PG8_HAS(i) (P::CONTIG ? (u_lo + (i) < u_hi) : (((i) / P::GROUP) * G + c < nunits / P::GROUP))
#define PG8_OFFS(u, vA, vB) do { int _t = tid; asm volatile("" : "+v"(_t)); _Pragma("unroll") for (int _i = 0; _i < 2; ++_i) { int _R, _C; if constexpr (P::F8) { const int _p = _t + 512 * _i; _R = _p >> 3; _C = ((_p & 7) ^ swz8(_R & 15)) * 8; } else stage_rc(_t * 16 + _i * 8192, _R, _C); \
        const int _Rb = P::PERM ? ((_R & ~31) + perm32(_R & 31)) : _R; _Pragma("unroll") for (int _h = 0; _h < 2; ++_h) { \
        if (_h == 0 || !P::LINA) vA[_h][_i] = p.rowA(u, _h * HALF + _R) + (unsigned)(_C * 2); if (_h == 0 || !P::LINB) vB[_h][_i] = p.rowB(u, _h * HALF + _Rb) + (unsigned)(_C * 2); } } } while (0)
  const int vc_ = (G % 8 == 0) ? (c % 8) * (G / 8) + c / 8 : c;
  const int u_lo = (int)(((long)vc_ * nunits) / G), u_hi = (int)(((long)(vc_ + 1) * nunits) / G);
  if (!PG8_HAS(0)) return;
  Unit cur, nxt; int ui = 0;
  PG8_DECODE(0, cur);
  Acc acc; float zf_ = 0.f; asm volatile("" : "+v"(zf_));
#pragma unroll
  for (int a = 0; a < 2; ++a)
#pragma unroll
    for (int b = 0; b < 2; ++b)
#pragma unroll
      for (int m = 0; m < 4; ++m)
#pragma unroll
        for (int n = 0; n < 2; ++n) acc[a][b][m][n] = (f32x4){zf_, zf_, zf_, zf_};
  bf16x8 At[4][2], B0[2][2], B1[2][2]; i32x8 At8[4], B08[2], B18[2];
  unsigned vA[2][2], vB[2][2];
  PG8_OFFS(cur, vA, vB);
  const char* cA = p.baseA(cur); const char* cB = p.baseB(cur);
  const size_t hA = P::LINA ? p.halfA() : 0, hB = P::LINB ? p.halfB() : 0;
  if constexpr (SP2) {
    PG8_STAGE(PG8_SB(0, 0), cB, vB[0]); PG8_STAGE(PG8_SB(0, 1), (cB) + (P::LINB ? hB : 0), vB[P::LINB ? 0 : 1]); PG8_STAGE(PG8_SA(0, 0), cA, vA[0]); PG8_STAGE(PG8_SA(0, 1), (cA) + (P::LINA ? hA : 0), vA[P::LINA ? 0 : 1]);
    if (wr == 1) PG8_BAR;
    PG8_WAIT_V(2); PG8_BAR;
    PG8_STAGE(PG8_SB(1, 0), cB + kstep, vB[0]); PG8_STAGE(PG8_SA(1, 0), cA + kstep, vA[0]); PG8_STAGE(PG8_SB(1, 1), (cB + kstep) + (P::LINB ? hB : 0), vB[P::LINB ? 0 : 1]);
    PG8_WAIT_V(6); PG8_BAR;
  } else {
    PG8_STAGE(PG8_SB(0, 0), cB, vB[0]); PG8_STAGE(PG8_SA(0, 0), cA, vA[0]); PG8_STAGE(PG8_SB(0, 1), (cB) + (P::LINB ? hB : 0), vB[P::LINB ? 0 : 1]); PG8_STAGE(PG8_SA(0, 1), (cA) + (P::LINA ? hA : 0), vA[P::LINA ? 0 : 1]);
    if (wr == 1) PG8_BAR;
    PG8_WAIT_V(4); PG8_BAR;
    PG8_STAGE(PG8_SB(1, 0), cB + kstep, vB[0]); PG8_STAGE(PG8_SA(1, 0), cA + kstep, vA[0]); PG8_STAGE(PG8_SB(1, 1), (cB + kstep) + (P::LINB ? hB : 0), vB[P::LINB ? 0 : 1]);
    PG8_WAIT_V(6); PG8_BAR;
  }
  for (;;) {
    const bool has_next = PG8_HAS(ui + 1);
    if (has_next) PG8_DECODE(ui + 1, nxt);
    const char* nA = has_next ? p.baseA(nxt) : cA; const char* nB = has_next ? p.baseB(nxt) : cB;
    for (int t = 0; t < nt; t += 2) {
      const bool last = (t == nt - 2);
      const char* a1 = cA + (size_t)(t + 1) * kstep;
      const char* a2 = last ? nA : cA + (size_t)(t + 2) * kstep; const char* b2 = last ? nB : cB + (size_t)(t + 2) * kstep;
      const char* a3 = a2 + kstep; const char* b3 = b2 + kstep;
      if constexpr (SP2) {
        PG8_LDB(B0, 0, 0); PG8_LDB(B1, 0, 1); PG8_SCHED; PG8_LDA(At, 0, 0); PG8_STAGE(PG8_SA(1, 1), (a1) + (P::LINA ? hA : 0), vA[P::LINA ? 0 : 1]);
        PG8_WAIT_V(8); PG8_WAIT_L(0); PG8_BAR; PG8_MMA(0, 0, At, B0); PG8_MMA(0, 1, At, B1); PG8_BAR; PG8_SCHED;
        if (last && has_next) { PG8_OFFS(nxt, vA, vB); }
        PG8_LDA(At, 0, 1); PG8_STAGE(PG8_SB(0, 0), b2, vB[0]); PG8_STAGE(PG8_SB(0, 1), (b2) + (P::LINB ? hB : 0), vB[P::LINB ? 0 : 1]); PG8_STAGE(PG8_SA(0, 0), a2, vA[0]);
        PG8_WAIT_V(8); PG8_WAIT_L(0); PG8_BAR; PG8_MMA(1, 0, At, B0); PG8_MMA(1, 1, At, B1); PG8_BAR; PG8_SCHED;
        PG8_LDB(B0, 1, 0); PG8_LDB(B1, 1, 1); PG8_SCHED; PG8_LDA(At, 1, 0); PG8_STAGE(PG8_SA(0, 1), (a2) + (P::LINA ? hA : 0), vA[P::LINA ? 0 : 1]);
        PG8_WAIT_V(8); PG8_WAIT_L(0); PG8_BAR; PG8_MMA(0, 0, At, B0); PG8_MMA(0, 1, At, B1); PG8_BAR; PG8_SCHED;
        PG8_LDA(At, 1, 1); PG8_STAGE(PG8_SB(1, 0), b3, vB[0]); PG8_STAGE(PG8_SB(1, 1), (b3) + (P::LINB ? hB : 0), vB[P::LINB ? 0 : 1]); PG8_STAGE(PG8_SA(1, 0), a3, vA[0]);
        PG8_WAIT_V(8); PG8_WAIT_L(0); PG8_BAR; PG8_MMA(1, 0, At, B0); PG8_MMA(1, 1, At, B1); PG8_BAR; PG8_SCHED;
      } else {
        PG8_LDB(B0, 0, 0); PG8_SCHED; PG8_LDA(At, 0, 0); PG8_STAGE(PG8_SA(1, 1), (a1) + (P::LINA ? hA : 0), vA[P::LINA ? 0 : 1]);
        PG8_WAIT_L(8); PG8_BAR; PG8_WAIT_L(0); PG8_MMA(0, 0, At, B0); PG8_BAR; PG8_SCHED;
        if (last && has_next) { PG8_OFFS(nxt, vA, vB); }
        PG8_LDB(B1, 0, 1); PG8_STAGE(PG8_SB(0, 0), b2, vB[0]);
        PG8_BAR; PG8_WAIT_L(0); PG8_MMA(0, 1, At, B1); PG8_BAR;
        PG8_LDA(At, 0, 1); PG8_STAGE(PG8_SA(0, 0), a2, vA[0]);
        PG8_BAR; PG8_WAIT_L(0); PG8_MMA(1, 0, At, B0); PG8_BAR; PG8_SCHED;
        PG8_STAGE(PG8_SB(0, 1), (b2) + (P::LINB ? hB : 0), vB[P::LINB ? 0 : 1]);
        PG8_WAIT_V(6); PG8_BAR; PG8_MMA(1, 1, At, B1); PG8_BAR;
        PG8_LDB(B0, 1, 0); PG8_SCHED; PG8_LDA(At, 1, 0); PG8_STAGE(PG8_SA(0, 1), (a2) + (P::LINA ? hA : 0), vA[P::LINA ? 0 : 1]);
        PG8_WAIT_L(8); PG8_BAR; PG8_WAIT_L(0); PG8_MMA(0, 0, At, B0); PG8_BAR; PG8_SCHED;
        PG8_LDB(B1, 1, 1); PG8_STAGE(PG8_SB(1, 0), b3, vB[0]);
        PG8_BAR; PG8_WAIT_L(0); PG8_MMA(0, 1, At, B1); PG8_BAR;
        PG8_LDA(At, 1, 1); PG8_STAGE(PG8_SA(1, 0), a3, vA[0]);
        PG8_BAR; PG8_WAIT_L(0); PG8_MMA(1, 0, At, B0); PG8_BAR; PG8_SCHED;
        PG8_STAGE(PG8_SB(1, 1), (b3) + (P::LINB ? hB : 0), vB[P::LINB ? 0 : 1]);
        PG8_WAIT_V(6); PG8_BAR; PG8_MMA(1, 1, At, B1); PG8_BAR;
      }
    }
    if constexpr (P::ALIGN) { if (wr == 0) PG8_BAR; }
    { int fr_e = fr, fq_e = fq; asm volatile("" : "+v"(fr_e), "+v"(fq_e)); p.epi(acc, cur, wr, wc, fr_e, fq_e); }
    if (!has_next) break;
    zf_ = 0.f; asm volatile("" : "+v"(zf_));
#pragma unroll
    for (int a = 0; a < 2; ++a)
#pragma unroll
      for (int b = 0; b < 2; ++b)
#pragma unroll
        for (int m = 0; m < 4; ++m)
#pragma unroll
          for (int n = 0; n < 2; ++n) acc[a][b][m][n] = (f32x4){zf_, zf_, zf_, zf_};
    cur = nxt; cA = nA; cB = nB; ++ui;
    if constexpr (P::ALIGN) { if (wr == 1) PG8_BAR; }
  }
  PG8_WAIT_V(0);
  if constexpr (!P::ALIGN) { if (wr == 0) PG8_BAR; }
  PG8_BAR;
#undef PG8_SA
#undef PG8_SB
#undef PG8_STAGE
#undef PG8_RD32
#undef PG8_LDA
#undef PG8_LDB
#undef PG8_MMA
#undef PG8_WAIT_V
#undef PG8_WAIT_L
#undef PG8_BAR
#undef PG8_SCHED
#undef PG8_DECODE
#undef PG8_HAS
#undef PG8_OFFS
}
}
namespace mk {
constexpr size_t MiB = 1u << 20;
constexpr size_t WS_CTL = 0, CTL_ZERO_BYTES = 65536;
constexpr size_t WS_MOD = 65536;
constexpr size_t WS_LAML = 262144;
constexpr size_t WS_WIN_T = 1 * MiB, WS_WGLU_T = 5 * MiB, WS_WMIX_T = 6 * MiB, WS_WFOUR_T = 8 * MiB, WS_WROUT_T = 10 * MiB;
constexpr size_t WS_DMT = 10 * MiB + 512 * 1024, WS_W1 = 10 * MiB + 768 * 1024, WS_W2 = 10 * MiB + 896 * 1024;
constexpr size_t WS_WEXP = 12 * MiB, EXP_STRIDE = 3 * MiB / 2, EXP_DOFF = 1 * MiB;
constexpr size_t WS_R = 110 * MiB;
constexpr size_t WS_WS = WS_R, WS_TT = WS_R + 8 * MiB, WS_A0 = WS_R + 34 * MiB, WS_AS5 = WS_R + 67 * MiB, WS_Q = WS_R + 103 * MiB, WS_K = WS_R + 119 * MiB,
                 WS_VT = WS_R + 136 * MiB, WS_SST = WS_R + 153 * MiB, WS_GB = WS_R + 177 * MiB, WS_CONCAT = WS_R + 193 * MiB;
constexpr size_t WS_F = WS_R, WS_LTOK = WS_R + 16 * MiB, WS_ASG = WS_R + 20 * MiB, WS_HID = WS_R + 22 * MiB, WS_YAS = WS_R + 102 * MiB,
                 WS_A1 = WS_R + 262 * MiB, WS_HB = WS_R + 294 * MiB;
constexpr size_t WS_X1 = WS_R, WS_X2 = WS_R + 64 * MiB, WS_SPC = WS_R + 96 * MiB, WS_FB = WS_R + 128 * MiB;
constexpr size_t WS_HOPT = WS_R + 338 * MiB;
constexpr size_t WS_WEXP1 = WS_R + 338 * MiB;
constexpr size_t EXP1_STRIDE = 1 * MiB, EXP1_DOFF = 512 * 1024;
constexpr size_t WS_NEED = WS_R + 403 * MiB;
constexpr int HALF_CAP_ROWS = 90112;
constexpr int CW_BAR = 4096, CW_CNT = 8192  , CW_DQ0 = 12288, CW_DQ1 = 12352, CW_DONE = 13312  ;

struct Args { const float* in[31]; float* h; unsigned char* ws; int ph_lo, ph_hi, flags, pad; };
enum { IN_X = 0, IN_C, IN_CTX, IN_CCTX, IN_WADA, IN_BADA, IN_WIN, IN_LRE, IN_LIM, IN_LDT, IN_BRE, IN_BIM, IN_CRE, IN_CIM, IN_S5D, IN_WGLU, IN_BGLU, IN_QG, IN_KG,
       IN_RPB, IN_WMIX, IN_WFOUR, IN_BFOUR, IN_WROUT, IN_RBIAS, IN_WEG, IN_WEU, IN_WED, IN_WSG, IN_WSU, IN_WSD };
constexpr int FLAG_SKIP_EXPERTS = 1;

struct Ctx {
  LAS unsigned char* lds; const Args* a; unsigned char* ws; int tid, lane, wave, G, c;
};

__device__ __forceinline__ u32x4 pack8(const f32x4& v0, const f32x4& v1) { u32x4 w; w.x = cvt_pk_bf16(v0[0], v0[1]); w.y = cvt_pk_bf16(v0[2], v0[3]); w.z = cvt_pk_bf16(v1[0], v1[1]); w.w = cvt_pk_bf16(v1[2], v1[3]); return w; }
__device__ __forceinline__ int rowmap(int code, int n) {
  if (code == 1) { if (n < 512 || n >= 1536) return n; const int blk = n & ~255, c = n & 255; return blk + 128 * ((c >> 5) & 1) + 32 * (c >> 6) + (c & 31); }
  if (code == 2) return 256 * (n >> 7) + (n & 127);
  if (code == 3) return 256 * (n >> 7) + 128 + (n & 127);
  return n;
}
__device__ __forceinline__ int kmap(int kcode, int k) {
  if (kcode == 1) { const int h = k >> 9, g = (k >> 7) & 3, m = k & 127; return g * 256 + (h == 0 ? m : (m == 0 ? 128 : 256 - m)); }
  return k;
}
__device__ __forceinline__ void transpose_item(const float* W, int K, int N, bf16_t* WT, int code, LAS unsigned char* scr, int item, int lane, int kcode = 0) {
  const int nblk = N / 64, kb = item / nblk, nb = item % nblk, k0 = 64 * kb, n0 = 64 * nb;
  const int q = lane >> 4, a = lane & 15;
  f32x4 v[16];
  const float* src = W + (size_t)(k0 + 2 * q) * N + n0 + 4 * a;
  if (kcode == 0) {
#pragma unroll
    for (int i = 0; i < 16; ++i) v[i] = *(const f32x4*)(src + (size_t)((i & 1) + 8 * (i >> 1)) * N);
  } else {
#pragma unroll
    for (int i = 0; i < 16; ++i) v[i] = *(const f32x4*)(W + (size_t)kmap(kcode, k0 + 2 * q + (i & 1) + 8 * (i >> 1)) * N + n0 + 4 * a);
  }
#pragma unroll
  for (int ii = 0; ii < 8; ++ii) { const int dsw = q + 4 * (ii ^ (a & 7));
#pragma unroll
    for (int j = 0; j < 4; ++j) *(LAS unsigned*)(scr + (4 * a + j) * 128 + 4 * dsw) = cvt_pk_bf16(v[2 * ii][j], v[2 * ii + 1][j]); }
  asm volatile("s_waitcnt lgkmcnt(0)" ::: "memory");
  const int c = lane & 7;
#pragma unroll
  for (int jj = 0; jj < 8; ++jj) { const int n = (lane >> 3) + 8 * jj, cs = c ^ ((n >> 2) & 7);
    const u32x4 o = *(const LAS u32x4*)(scr + n * 128 + 16 * cs);
    *(u32x4*)(WT + (size_t)rowmap(code, n0 + n) * K + k0 + 8 * c) = o; }
  asm volatile("s_waitcnt lgkmcnt(0)" ::: "memory");
}
__device__ __forceinline__ void transpose_item8(const float* W, int K, int N, unsigned char* WT, int code, float scale, LAS unsigned char* scr, int item, int lane) {
  const int nblk = N / 64, kb = item / nblk, nb = item % nblk, k0 = 64 * kb, n0 = 64 * nb;
  const int q = lane >> 4, a = lane & 15;
  f32x4 v[16];
  const float* src = W + (size_t)(k0 + 4 * q) * N + n0 + 4 * a;
#pragma unroll
  for (int i = 0; i < 16; ++i) v[i] = *(const f32x4*)(src + (size_t)((i & 3) + 16 * (i >> 2)) * N);
#pragma unroll
  for (int ib = 0; ib < 4; ++ib) { const int dsw = q + 4 * (ib ^ (a & 3));
#pragma unroll
    for (int j = 0; j < 4; ++j) *(LAS int*)(scr + (4 * a + j) * 64 + 4 * dsw) = pack4_fp8(v[4 * ib][j] * scale, v[4 * ib + 1][j] * scale, v[4 * ib + 2][j] * scale, v[4 * ib + 3][j] * scale); }
  asm volatile("s_waitcnt lgkmcnt(0)" ::: "memory");
  const int c = lane & 3;
#pragma unroll
  for (int jj = 0; jj < 4; ++jj) { const int n = (lane >> 2) + 16 * jj, cs = c ^ ((n >> 2) & 3);
    const u32x4 o = *(const LAS u32x4*)(scr + n * 64 + 16 * cs);
    *(u32x4*)(WT + (size_t)rowmap(code, n0 + n) * K + k0 + 16 * c) = o; }
  asm volatile("s_waitcnt lgkmcnt(0)" ::: "memory");
}
constexpr int IT_WIN = 512, IT_GLU = 64, IT_MIX = 256, IT_FOUR = 256, IT_ROUT = 32, IT_SMALL = IT_WIN + IT_GLU + IT_MIX + IT_FOUR + IT_ROUT, IT_EXP = 192;
__device__ __forceinline__ void small_item(const Ctx& X, LAS unsigned char* scr, int it) {
  const Args& a = *X.a; unsigned char* ws = X.ws;
  if (it < IT_WIN) { transpose_item(a.in[IN_WIN], 1024, 2048, (bf16_t*)(ws + WS_WIN_T), 1, scr, it, X.lane); return; } it -= IT_WIN;
  if (it < IT_GLU) { transpose_item(a.in[IN_WGLU], 512, 512, (bf16_t*)(ws + WS_WGLU_T), 0, scr, it, X.lane); return; } it -= IT_GLU;
  if (it < IT_MIX) { transpose_item(a.in[IN_WMIX], 1024, 1024, (bf16_t*)(ws + WS_WMIX_T), 0, scr, it, X.lane); return; } it -= IT_MIX;
  if (it < IT_FOUR) { transpose_item(a.in[IN_WFOUR], 1024, 1024, (bf16_t*)(ws + WS_WFOUR_T), 0, scr, it, X.lane, 1); return; } it -= IT_FOUR;
  { const int l = it >> 4; transpose_item(a.in[IN_WROUT] + (size_t)l * 1024 * 64, 1024, 64, (bf16_t*)(ws + WS_WROUT_T) + (size_t)l * 64 * 1024, 0, scr, it & 15, X.lane); }
}
__device__ __forceinline__ void expert_item(const Ctx& X, LAS unsigned char* scr, int layer, int it) {
  const Args& a = *X.a; const int e = it / IT_EXP, r = it % IT_EXP;
  bf16_t* gu = (bf16_t*)(X.ws + (layer == 0 ? WS_WEXP + (size_t)e * EXP_STRIDE : WS_WEXP1 + (size_t)e * EXP1_STRIDE));
  bf16_t* dt = (bf16_t*)(X.ws + (layer == 0 ? WS_WEXP + (size_t)e * EXP_STRIDE + EXP_DOFF : WS_WEXP1 + (size_t)e * EXP1_STRIDE + EXP1_DOFF));
  const float *wg, *wu, *wd;
  if (e < 64) { const size_t o = ((size_t)layer * 64 + e) * 262144; wg = a.in[IN_WEG] + o; wu = a.in[IN_WEU] + o; wd = a.in[IN_WED] + o; }
  else { const size_t o = (size_t)layer * 262144; wg = a.in[IN_WSG] + o; wu = a.in[IN_WSU] + o; wd = a.in[IN_WSD] + o; }
  if (r < 64) transpose_item8(wg, 1024, 256, (unsigned char*)gu, 2, 32.f, scr, r, X.lane);
  else if (r < 128) transpose_item8(wu, 1024, 256, (unsigned char*)gu, 3, 32.f, scr, r - 64, X.lane);
  else transpose_item8(wd, 256, 1024, (unsigned char*)dt, 0, 32.f, scr, r - 128, X.lane);
}
__device__ __forceinline__ void transpose_work(const Ctx& X, unsigned* ctr, int first_small, int n_small, int layer, int n_exp_items, unsigned* done = nullptr, unsigned need = 0u, int stop_at = -1) {
  LAS unsigned char* scr = X.lds + X.wave * 8192;
  volatile LAS int* shb = (volatile LAS int*)(X.lds + LDS_MISC_OFF + 1024);
  const int total = n_small + n_exp_items;
  if (stop_at < 0) stop_at = total;
  const int per = done ? 1 : 4;
  for (;;) {
    __syncthreads();
    if (X.tid == 0) { int b = total; if (!done || __hip_atomic_load(done, __ATOMIC_RELAXED, __HIP_MEMORY_SCOPE_AGENT) < need) b = (int)atomicAdd(ctr, (unsigned)(8 * per)); shb[0] = b; }
    __syncthreads();
    const int base = shb[0];
    if (base >= stop_at) break;
    for (int k = 0; k < per; ++k) { const int it = base + X.wave * per + k; if (it >= total) break;
      if (it < n_small) small_item(X, scr, first_small + it);
      else { int e_it = it - n_small, l = layer; if (layer == 2) { l = e_it >= 65 * IT_EXP ? 1 : 0; e_it -= l * 65 * IT_EXP; } expert_item(X, scr, l, e_it); } }
  }
}

__device__ __forceinline__ void p0_adaln(const Ctx& X, int it) {
  const Args& a = *X.a; const int layer = it / 48, ct = it % 48;
  LAS float* sl = (LAS float*)X.lds;
  for (int i = X.tid; i < 2048; i += NTHR) { const float v = i < 1024 ? a.in[IN_C][i] : a.in[IN_CCTX][i - 1024]; sl[i] = v / (1.f + __expf(-v)); }
  __syncthreads();
  const int c4 = X.lane & 31, kh = X.lane >> 5, k0 = X.wave * 128 + kh * 64;
  const float* W = a.in[IN_WADA] + (size_t)layer * 1024 * 6144 + ct * 128 + 4 * c4;
  f32x4 a0 = (f32x4){0.f, 0.f, 0.f, 0.f}, a1 = a0;
#pragma unroll 16
  for (int k = 0; k < 64; ++k) { const f32x4 w = *(const f32x4*)(W + (size_t)(k0 + k) * 6144); const float s0 = sl[k0 + k], s1 = sl[1024 + k0 + k]; a0 += w * s0; a1 += w * s1; }
  LAS float* red = sl + 2048;
#pragma unroll
  for (int e = 0; e < 4; ++e) { a0[e] += sx(a0[e], 32); a1[e] += sx(a1[e], 32); }
  if (kh == 0) {
#pragma unroll
    for (int e = 0; e < 4; ++e) { red[(X.wave * 128 + 4 * c4 + e) * 2] = a0[e]; red[(X.wave * 128 + 4 * c4 + e) * 2 + 1] = a1[e]; } }
  __syncthreads();
  if (X.tid < 256) { const int l = X.tid & 127, v = X.tid >> 7; float s = 0.f;
#pragma unroll
    for (int w = 0; w < 8; ++w) s += red[(w * 128 + l) * 2 + v];
    s += a.in[IN_BADA][layer * 6144 + ct * 128 + l];
    float* mod = (float*)(X.ws + WS_MOD);
    if (layer == 0) mod[v * 6144 + ct * 128 + l] = s; else if (v == 0) mod[2 * 6144 + ct * 128 + l] = s; }
  __syncthreads();
}

__device__ __forceinline__ void p0_s5tables(const Ctx& X, int g, int part) {
  const Args& a = *X.a;
  constexpr int PS = 66;
  LAS f32x2* POW = (LAS f32x2*)X.lds;
  LAS f32x2* BB = (LAS f32x2*)(X.lds + 34944);
  LAS f32x2* CC = (LAS f32x2*)(X.lds + 51328);
  LAS float* KK = (LAS float*)(X.lds + 68224);
  LAS float* DD = (LAS float*)(X.lds + 133760);
  const int tid = X.tid;
  {
    const int dir = (tid >> 6) & 1, p = tid & 63, tq = tid >> 7, idx = (dir * 32 + g) * 64 + p;
    f32x4 bre[4], bim[4];
    if (tid < 128) {
#pragma unroll
      for (int j = 0; j < 4; ++j) { bre[j] = *(const f32x4*)(a.in[IN_BRE] + idx * 16 + 4 * j); bim[j] = *(const f32x4*)(a.in[IN_BIM] + idx * 16 + 4 * j); } }
    f32x2 ccv[4];
#pragma unroll
    for (int it = 0; it < 4; ++it) { const int i = tid + it * NTHR, d2 = i >> 10, c = (i >> 6) & 15, p2 = i & 63; const int gi = ((d2 * 32 + g) * 16 + c) * 64 + p2; ccv[it] = (f32x2){a.in[IN_CRE][gi], a.in[IN_CIM][gi]}; }
    const float lr = fminf(a.in[IN_LRE][idx], -1e-4f), li = a.in[IN_LIM][idx], dt = expf(a.in[IN_LDT][dir * 32 + g]);
    for (int tau = tq; tau <= 32; tau += 4) { const float mg = expf(lr * dt * (float)tau); float sn, cs; sincospif(li * dt * (float)tau * 0.318309886183790672f, &sn, &cs); POW[(dir * 33 + tau) * PS + p] = (f32x2){mg * cs, mg * sn}; }
#pragma unroll
    for (int it = 0; it < 4; ++it) { const int i = tid + it * NTHR; CC[(i >> 6) * PS + (i & 63)] = ccv[it]; }
    if (tid < 16) DD[tid] = a.in[IN_S5D][g * 16 + tid];
    __syncthreads();
    if (tid < 128) {
      const f32x2 l1 = POW[(dir * 33 + 1) * PS + p], l32 = POW[(dir * 33 + 32) * PS + p];
      if (part == 0) ((float2*)(X.ws + WS_LAML))[idx] = make_float2(l32.x, l32.y);
      const float nr = l1.x - 1.f, ni = l1.y, den = lr * lr + li * li, cr = (nr * lr + ni * li) / den, ci = (ni * lr - nr * li) / den;
#pragma unroll
      for (int j = 0; j < 4; ++j)
#pragma unroll
        for (int e = 0; e < 4; ++e) { const float xr = bre[j][e], xi = bim[j][e]; BB[(dir * 64 + p) * 16 + 4 * j + e] = (f32x2){cr * xr - ci * xi, cr * xi + ci * xr}; }
    }
  }
  __syncthreads();
  { const int lane = X.lane, dirw = X.wave >> 2, cl = lane & 15, ph = lane >> 5, ri = (lane >> 4) & 1;
    float ccx[32], ccy[32], bv[32];
#pragma unroll
    for (int st = 0; st < 32; ++st) { const int p = 2 * st + ph; const f32x2 cc = CC[(dirw * 16 + cl) * PS + p]; const f32x2 bb = BB[(dirw * 64 + p) * 16 + cl];
      ccx[st] = ri == 0 ? cc.x : -cc.y; ccy[st] = ri == 0 ? -cc.y : -cc.x; bv[st] = ri == 0 ? bb.x : bb.y; }
#pragma unroll 1
    for (int t = 0; t < 8; ++t) { const int tau = (X.wave & 3) * 8 + t;
      f32x4 acc = (f32x4){0.f, 0.f, 0.f, 0.f};
      const LAS f32x2* pwp = POW + (dirw * 33 + tau) * PS + ph;
#pragma unroll
      for (int st = 0; st < 32; ++st) { const f32x2 pw = pwp[2 * st]; const float av = ccx[st] * pw.x + ccy[st] * pw.y;
        acc = __builtin_amdgcn_mfma_f32_16x16x4f32(av, bv[st], acc, 0, 0, 0); }
#pragma unroll
      for (int r = 0; r < 4; ++r) KK[((dirw * 32 + tau) * 16 + 4 * (lane >> 4) + r) * 16 + cl] = acc[r];
    }
  }
  __syncthreads();
  bf16_t* TT = (bf16_t*)(X.ws + WS_TT) + (size_t)g * 512 * 768;
  for (int q = tid; q < 128 * 64; q += NTHR) {
    const int row = part * 128 + (q >> 6), cc8 = q & 63, i = row >> 4, c = row & 15; f32x4 v0, v1;
    const int s = cc8 >> 1, c0 = (cc8 & 1) * 8;
    const int dir = s < i ? 0 : 1, tau = s < i ? i - s : s - i;
    const LAS f32x4* kp = (const LAS f32x4*)(KK + ((dir * 32 + tau) * 16 + c) * 16 + c0);
    v0 = kp[0]; v1 = kp[1];
    if (s == i) { const LAS f32x4* k0p = (const LAS f32x4*)(KK + ((0 * 32 + 0) * 16 + c) * 16 + c0); v0 += k0p[0]; v1 += k0p[1];
      const float d = DD[c]; const int dj = c - c0;
      if (dj >= 0 && dj < 4) v0[dj] += d; else if (dj >= 4 && dj < 8) v1[dj - 4] += d; }
    *(u32x4*)(TT + (size_t)row * 768 + cc8 * 8) = pack8(v0, v1);
  }
  for (int q = tid; q < 128 * 32; q += NTHR) {
    const int row = part * 128 + (q >> 5), cc8 = 64 + (q & 31), i = row >> 4, c = row & 15;
    const int kk = (cc8 - 64) * 8, dir = kk >> 7, ri = (kk >> 6) & 1, p0 = kk & 63, tau = dir == 0 ? i + 1 : 32 - i;
    const LAS f32x4* cp = (const LAS f32x4*)(CC + (dir * 16 + c) * PS + p0); const LAS f32x4* pp = (const LAS f32x4*)(POW + (dir * 33 + tau) * PS + p0);
    float v[8];
#pragma unroll
    for (int j = 0; j < 4; ++j) { const f32x4 cc = cp[j], pw = pp[j];
      v[2 * j] = ri == 0 ? (cc.x * pw.x - cc.y * pw.y) : -(cc.x * pw.y + cc.y * pw.x); v[2 * j + 1] = ri == 0 ? (cc.z * pw.z - cc.w * pw.w) : -(cc.z * pw.w + cc.w * pw.z); }
    *(u32x4*)(TT + (size_t)row * 768 + cc8 * 8) = pack8((f32x4){v[0], v[1], v[2], v[3]}, (f32x4){v[4], v[5], v[6], v[7]});
  }
  bf16_t* WSm = (bf16_t*)(X.ws + WS_WS) + (size_t)g * 256 * 512;
  for (int q = part * 4096 + tid; q < (part + 1) * 4096; q += NTHR) {
    const int n = q >> 6, cc8 = q & 63, dir = n >> 7, ri = (n >> 6) & 1, p = n & 63, s = cc8 >> 1, c0 = (cc8 & 1) * 8, tau = dir == 0 ? 31 - s : s;
    const f32x2 pw = POW[(dir * 33 + tau) * PS + p]; const LAS f32x4* bp = (const LAS f32x4*)(BB + (dir * 64 + p) * 16 + c0); float v[8];
#pragma unroll
    for (int j = 0; j < 4; ++j) { const f32x4 b = bp[j]; v[2 * j] = ri == 0 ? (pw.x * b.x - pw.y * b.y) : (pw.x * b.y + pw.y * b.x); v[2 * j + 1] = ri == 0 ? (pw.x * b.z - pw.y * b.w) : (pw.x * b.w + pw.y * b.z); }
    *(u32x4*)(WSm + (size_t)n * 512 + cc8 * 8) = pack8((f32x4){v[0], v[1], v[2], v[3]}, (f32x4){v[4], v[5], v[6], v[7]});
  }
  __syncthreads();
}

__device__ __forceinline__ void p0_dftconst(const Ctx& X, int idx) {
  for (int q = idx * NTHR + X.tid; q < 24576; q += 32 * NTHR) {
    float v[8]; bf16_t* dst;
    if (q < 8192) {
      const int R = q >> 5, c0 = (q & 31) * 8, ri = R >> 7, m = R & 127; dst = (bf16_t*)(X.ws + WS_DMT) + (size_t)R * 256 + c0;
#pragma unroll
      for (int j = 0; j < 8; ++j) { float s, c; sincospif((float)(((c0 + j) * m) & 255) * (1.f / 128.f), &s, &c); v[j] = ri == 0 ? c : (m == 0 ? (((c0 + j) & 1) ? -1.f : 1.f) : -s); }
    } else if (q < 16384) {
      const int q2 = q - 8192, R = q2 >> 5, c0 = (q2 & 31) * 8, rip = R >> 7, ka = R & 127; dst = (bf16_t*)(X.ws + WS_W1) + (size_t)R * 256 + c0;
#pragma unroll
      for (int j = 0; j < 8; ++j) { const int C = c0 + j, ri = C >> 7, ta = C & 127; float s, c; sincospif((float)((ka * ta) & 127) * (1.f / 64.f), &s, &c);
        v[j] = (rip == ri) ? c : (rip == 0 ? s : -s); }
    } else {
      const int q2 = q - 16384, R = q2 >> 5, c0 = (q2 & 31) * 8, kb = R & 127; dst = (bf16_t*)(X.ws + WS_W2) + (size_t)R * 256 + c0;
#pragma unroll
      for (int j = 0; j < 8; ++j) { const int C = c0 + j, rip = C >> 7, tb = C & 127; float s, c; sincospif((float)((kb * tb) & 127) * (1.f / 64.f), &s, &c);
        v[j] = (R < 128 ? (rip == 0 ? c : s) : (rip == 0 ? -s : c)) * (1.f / 2048.f); }
    }
    u32x4 o; o.x = cvt_pk_bf16(v[0], v[1]); o.y = cvt_pk_bf16(v[2], v[3]); o.z = cvt_pk_bf16(v[4], v[5]); o.w = cvt_pk_bf16(v[6], v[7]);
    *(u32x4*)dst = o;
  }
}

__device__ __forceinline__ void phase_prep(const Ctx& X, int rep) {
  const int c = X.c;
#ifndef P0_SKIP
#define P0_SKIP 0
#endif
  const int skip = rep ? P0_SKIP : 0;
  if (c < 96) { if (!(skip & 1)) p0_adaln(X, c); }
  else if (c < 224) { if (!(skip & 2)) p0_s5tables(X, (c - 96) >> 2, (c - 96) & 3); }
  else { if (!(skip & 4)) p0_dftconst(X, c - 224); }
  __syncthreads();
  unsigned* ctl = (unsigned*)(X.ws + WS_CTL);
  if (!(skip & 8)) transpose_work(X, ctl + CW_DQ0 + 128 * rep, 0, IT_SMALL, 0, 0);
}

__device__ __forceinline__ void phase_mod0(const Ctx& X) {
  const Args& a = *X.a; const float* mod = (const float*)(X.ws + WS_MOD); bf16_t* A0 = (bf16_t*)(X.ws + WS_A0);
  const int gw = X.c * NWAVES + X.wave, NGW = X.G * NWAVES, lane = X.lane;
  f32x4 sh[4], sc[4], cur[4], nxt[4];
#pragma unroll
  for (int j = 0; j < 4; ++j) { sh[j] = ((const f32x4*)mod)[lane + 64 * j]; sc[j] = ((const f32x4*)(mod + 1024))[lane + 64 * j] + 1.f; }
  { const f32x4* xr = (const f32x4*)(a.in[IN_X] + (size_t)gw * 1024) + lane;
#pragma unroll
    for (int j = 0; j < 4; ++j) cur[j] = xr[64 * j]; }
  bool ctxmod = false;
  for (int r = gw; r < NROW; r += NGW) {
    const int rn = r + NGW;
    if (rn < NROW) { const f32x4* xr = (const f32x4*)(rn < TOK ? a.in[IN_X] + (size_t)rn * 1024 : a.in[IN_CTX] + (size_t)(rn - TOK) * 1024) + lane;
#pragma unroll
      for (int j = 0; j < 4; ++j) nxt[j] = xr[64 * j]; }
    if (r >= TOK && !ctxmod) { ctxmod = true;
#pragma unroll
      for (int j = 0; j < 4; ++j) { sh[j] = ((const f32x4*)(mod + 6144))[lane + 64 * j]; sc[j] = ((const f32x4*)(mod + 6144 + 1024))[lane + 64 * j] + 1.f; } }
    float ss = 0.f;
#pragma unroll
    for (int j = 0; j < 4; ++j) ss += (cur[j].x * cur[j].x + cur[j].y * cur[j].y) + (cur[j].z * cur[j].z + cur[j].w * cur[j].w);
    const float rr = rsqrtf(wave_sum(ss) * (1.f / 1024.f) + 1e-6f);
    u32x2* o8 = (u32x2*)(A0 + (size_t)r * 1024) + lane;
#pragma unroll
    for (int j = 0; j < 4; ++j) { const f32x4 f = cur[j] * rr * sc[j] + sh[j]; u32x2 w; w.x = cvt_pk_bf16(f.x, f.y); w.y = cvt_pk_bf16(f.z, f.w); o8[64 * j] = w; }
#pragma unroll
    for (int j = 0; j < 4; ++j) cur[j] = nxt[j];
  }
}


struct G1 {
  static constexpr bool PERM = true; static constexpr bool F8 = false; static constexpr int SCALE_B = 0x7A7A7A7A; static constexpr bool CONTIG = false; static constexpr int GROUP = 1; static constexpr bool ALIGN = true; static constexpr bool LINA = true, LINB = true; __device__ __forceinline__ size_t halfA() const { return 128u * 2048u; } __device__ __forceinline__ size_t halfB() const { return 128u * 2048u; } int K, nunits; unsigned char* ws; const float* qg; const float* kg;
  __device__ __forceinline__ void decode(int w, Unit& u) const { if (w < 390) { u.a = 0; u.pm = w / 6; u.pn = w % 6; } else { const int w2 = w - 390; u.a = 1; u.pm = w2 & 1; u.pn = w2 >> 1; } u.b = 0; }
  __device__ __forceinline__ const char* baseA(const Unit& u) const { return (const char*)ws + (u.a == 0 ? WS_A0 : WS_WIN_T + (size_t)1536 * 2048); }
  __device__ __forceinline__ const char* baseB(const Unit& u) const { return (const char*)ws + (u.a == 0 ? WS_WIN_T : WS_A0); }
  __device__ __forceinline__ unsigned rowA(const Unit& u, int r) const { return (unsigned)(u.pm * 256 + r) * 2048u; }
  __device__ __forceinline__ unsigned rowB(const Unit& u, int r) const { return (unsigned)(u.pn * 256 + r) * 2048u; }
  __device__ __forceinline__ void epi(const Acc& acc, const Unit& u, int wr, int wc, int fr, int fq) const {
    if (u.a == 1) {
      bf16_t* VT = (bf16_t*)(ws + WS_VT);
#pragma unroll
      for (int ai = 0; ai < 2; ++ai)
#pragma unroll
        for (int m = 0; m < 4; ++m) { const int dd = u.pm * 256 + ai * 128 + wr * 64 + m * 16 + fr, head = dd >> 6, d = dd & 63;
#pragma unroll
          for (int bj = 0; bj < 2; ++bj) { const int t0 = u.pn * 256 + bj * 128 + wc * 32 + 8 * fq, kr = t0 >> 6, cg = (t0 >> 3) & 7;
            *(u32x4*)((VT + ((((size_t)(head * 260 + kr) * 8 + cg) * 64 + d) * 8))) = pack8(acc[ai][bj][m][0], acc[ai][bj][m][1]); } }
      return;
    }
    if (u.pn < 2) {
      bf16_t* AS5 = (bf16_t*)(ws + WS_AS5);
#pragma unroll
      for (int ai = 0; ai < 2; ++ai)
#pragma unroll
        for (int m = 0; m < 4; ++m) { const int row = u.pm * 256 + ai * 128 + wr * 64 + m * 16 + fr; int crow, s;
          if (row < TOK) { crow = row >> 5; s = row & 31; } else { const int j = row - TOK; crow = 512 + (j >> 5); s = j & 31; }
#pragma unroll
          for (int bj = 0; bj < 2; ++bj) { const int g = 16 * u.pn + 8 * bj + 2 * wc + (fq >> 1), c0 = 8 * (fq & 1);
            *(u32x4*)((AS5 + ((size_t)(g * 768 + crow) * 768 + s * 16 + c0))) = pack8(acc[ai][bj][m][0], acc[ai][bj][m][1]); } }
      return;
    }
    const bool isq = u.pn < 4;
    if (isq && u.pm == 64) return;
    const int head = 4 * ((u.pn - 2) & 1) + wc; const float* gain = isq ? qg : kg;
    bf16_t* dst = isq ? (bf16_t*)(ws + WS_Q) : (bf16_t*)(ws + WS_K);
    f32x4 gv[2][2];
#pragma unroll
    for (int bj = 0; bj < 2; ++bj) { gv[bj][0] = *(const f32x4*)(gain + 32 * bj + 8 * fq); gv[bj][1] = *(const f32x4*)(gain + 32 * bj + 8 * fq + 4); }
#pragma unroll
    for (int ai = 0; ai < 2; ++ai)
#pragma unroll
      for (int m = 0; m < 4; ++m) { const int row = u.pm * 256 + ai * 128 + wr * 64 + m * 16 + fr; float ss = 0.f;
#pragma unroll
        for (int bj = 0; bj < 2; ++bj)
#pragma unroll
          for (int n = 0; n < 2; ++n) { const f32x4 x = acc[ai][bj][m][n]; ss += (x[0] * x[0] + x[1] * x[1]) + (x[2] * x[2] + x[3] * x[3]); }
        ss += sx(ss, 16); ss += sx(ss, 32);
        const float rinv = rsqrtf(ss * (1.f / 64.f) + 1e-6f);
#pragma unroll
        for (int bj = 0; bj < 2; ++bj) { const f32x4 v0 = acc[ai][bj][m][0] * rinv * gv[bj][0], v1 = acc[ai][bj][m][1] * rinv * gv[bj][1];
          if (isq) *(u32x4*)((dst + (size_t)row * 512 + head * 64 + 32 * bj + 8 * fq)) = pack8(v0, v1);
          else { const int kr = row >> 6, cg = (row >> 3) & 7, k8 = row & 7, ks = 2 * bj + (fq >> 1), hh2 = fq & 1;
            *(u32x4*)((dst + (((((size_t)(head * 260 + kr) * 8 + cg) * 4 + ks) * 8 + k8) * 2 + hh2) * 8)) = pack8(v0, v1); } } }
  }
};

struct G2 {
  static constexpr bool PERM = true; static constexpr bool F8 = false; static constexpr int SCALE_B = 0x7A7A7A7A; static constexpr bool CONTIG = false; static constexpr int GROUP = 1; static constexpr bool ALIGN = true; static constexpr bool LINA = true, LINB = true; __device__ __forceinline__ size_t halfA() const { return 128u * 1536u; } __device__ __forceinline__ size_t halfB() const { return 128u * 1024u; } int K, nunits; unsigned char* ws;
  __device__ __forceinline__ void decode(int w, Unit& u) const { u.a = w / 3; u.pm = w % 3; u.pn = 0; u.b = 0; }
  __device__ __forceinline__ const char* baseA(const Unit& u) const { return (const char*)ws + WS_AS5 + (size_t)u.a * 768 * 768 * 2; }
  __device__ __forceinline__ const char* baseB(const Unit& u) const { return (const char*)ws + WS_WS + (size_t)u.a * 256 * 512 * 2; }
  __device__ __forceinline__ unsigned rowA(const Unit& u, int r) const { return (unsigned)(u.pm * 256 + r) * 1536u; }
  __device__ __forceinline__ unsigned rowB(const Unit& u, int r) const { return (unsigned)r * 1024u; }
  __device__ __forceinline__ void epi(const Acc& acc, const Unit& u, int wr, int wc, int fr, int fq) const {
    float* SST = (float*)(ws + WS_SST) + (size_t)u.a * 768 * 256;
#pragma unroll
    for (int ai = 0; ai < 2; ++ai)
#pragma unroll
      for (int m = 0; m < 4; ++m) { const int crow = u.pm * 256 + ai * 128 + wr * 64 + m * 16 + fr; if (crow >= 520) continue;
#pragma unroll
        for (int bj = 0; bj < 2; ++bj) { float* p = SST + (size_t)crow * 256 + bj * 128 + wc * 32 + 8 * fq; *(f32x4*)p = acc[ai][bj][m][0]; *(f32x4*)(p + 4) = acc[ai][bj][m][1]; } }
  }
};

struct G3 {
  static constexpr bool PERM = true; static constexpr bool F8 = false; static constexpr int SCALE_B = 0x7A7A7A7A; static constexpr bool CONTIG = false; static constexpr int GROUP = 1; static constexpr bool ALIGN = true; static constexpr bool LINA = true, LINB = true; __device__ __forceinline__ size_t halfA() const { return 128u * 1536u; } __device__ __forceinline__ size_t halfB() const { return 128u * 1536u; } int K, nunits; unsigned char* ws;
  __device__ __forceinline__ void decode(int w, Unit& u) const { u.a = w >> 2; u.pm = (w >> 1) & 1; u.pn = w & 1; u.b = 0; }
  __device__ __forceinline__ const char* baseA(const Unit& u) const { return (const char*)ws + WS_AS5 + (size_t)u.a * 768 * 768 * 2; }
  __device__ __forceinline__ const char* baseB(const Unit& u) const { return (const char*)ws + WS_TT + (size_t)u.a * 512 * 768 * 2; }
  __device__ __forceinline__ unsigned rowA(const Unit& u, int r) const { return (unsigned)(u.pm * 256 + r) * 1536u; }
  __device__ __forceinline__ unsigned rowB(const Unit& u, int r) const { return (unsigned)(u.pn * 256 + r) * 1536u; }
  __device__ __forceinline__ void epi(const Acc& acc, const Unit& u, int wr, int wc, int fr, int fq) const {
    bf16_t* GB = (bf16_t*)(ws + WS_GB);
#pragma unroll
    for (int ai = 0; ai < 2; ++ai)
#pragma unroll
      for (int m = 0; m < 4; ++m) { const int crow = u.pm * 256 + ai * 128 + wr * 64 + m * 16 + fr;
#pragma unroll
        for (int bj = 0; bj < 2; ++bj) { const int pp = u.pn * 256 + bj * 128 + wc * 32 + 8 * fq, i = pp >> 4, c0 = pp & 15; f32x4 v0 = acc[ai][bj][m][0], v1 = acc[ai][bj][m][1];
#pragma unroll
          for (int j = 0; j < 4; ++j) { v0[j] = gelu_tanh(v0[j]); v1[j] = gelu_tanh(v1[j]); }
          *(u32x4*)((GB + (size_t)(crow * 32 + i) * 512 + u.a * 16 + c0)) = pack8(v0, v1); } }
  }
};

struct G4 {
  static constexpr bool PERM = true; static constexpr bool F8 = false; static constexpr int SCALE_B = 0x7A7A7A7A; static constexpr bool CONTIG = false; static constexpr int GROUP = 1; static constexpr bool ALIGN = true; static constexpr bool LINA = true, LINB = true; __device__ __forceinline__ size_t halfA() const { return 128u * 1024u; } __device__ __forceinline__ size_t halfB() const { return 128u * 1024u; } int K, nunits; unsigned char* ws; const float* bglu;
  __device__ __forceinline__ void decode(int w, Unit& u) const { u.pm = w >> 1; u.pn = w & 1; u.a = 0; u.b = 0; }
  __device__ __forceinline__ const char* baseA(const Unit&) const { return (const char*)ws + WS_GB; }
  __device__ __forceinline__ const char* baseB(const Unit&) const { return (const char*)ws + WS_WGLU_T; }
  __device__ __forceinline__ unsigned rowA(const Unit& u, int r) const { return (unsigned)(u.pm * 256 + r) * 1024u; }
  __device__ __forceinline__ unsigned rowB(const Unit& u, int r) const { return (unsigned)(u.pn * 256 + r) * 1024u; }
  __device__ __forceinline__ void epi(const Acc& acc, const Unit& u, int wr, int wc, int fr, int fq) const {
    const bf16_t* GB = (const bf16_t*)(ws + WS_GB); bf16_t* CC = (bf16_t*)(ws + WS_CONCAT);
#pragma unroll
    for (int bj = 0; bj < 2; ++bj) { const int col0 = u.pn * 256 + bj * 128 + wc * 32 + 8 * fq; const f32x4 b0 = *(const f32x4*)(bglu + col0), b1 = *(const f32x4*)(bglu + col0 + 4);
      u32x4 gin[2][4];
#pragma unroll
      for (int ai = 0; ai < 2; ++ai)
#pragma unroll
        for (int m = 0; m < 4; ++m) gin[ai][m] = *(const u32x4*)(GB + (size_t)(u.pm * 256 + ai * 128 + wr * 64 + m * 16 + fr) * 512 + col0);
#pragma unroll
      for (int ai = 0; ai < 2; ++ai)
#pragma unroll
        for (int m = 0; m < 4; ++m) { const int row = u.pm * 256 + ai * 128 + wr * 64 + m * 16 + fr; const u32x4 gw = gin[ai][m];
          f32x4 v0 = acc[ai][bj][m][0] + b0, v1 = acc[ai][bj][m][1] + b1;
          v0[0] = bf_lo(gw.x) * fast_sigmoid(v0[0]); v0[1] = bf_hi(gw.x) * fast_sigmoid(v0[1]); v0[2] = bf_lo(gw.y) * fast_sigmoid(v0[2]); v0[3] = bf_hi(gw.y) * fast_sigmoid(v0[3]);
          v1[0] = bf_lo(gw.z) * fast_sigmoid(v1[0]); v1[1] = bf_hi(gw.z) * fast_sigmoid(v1[1]); v1[2] = bf_lo(gw.w) * fast_sigmoid(v1[2]); v1[3] = bf_hi(gw.w) * fast_sigmoid(v1[3]);
          *(u32x4*)((CC + (size_t)row * 1024 + col0)) = pack8(v0, v1); } }
  }
};

struct GRes {
  static constexpr bool PERM = true; static constexpr bool F8 = false; static constexpr int SCALE_B = 0x7A7A7A7A; static constexpr bool CONTIG = false; static constexpr int GROUP = 1; static constexpr bool ALIGN = true; static constexpr bool LINA = true, LINB = true;
  __device__ __forceinline__ size_t halfA() const { return 128u * 2048u; } __device__ __forceinline__ size_t halfB() const { return 128u * 2048u; }
  int K, nunits; const char* A; const char* Bt; const float* hin32; const bf16_t* hin16; bf16_t* hout; const float* gate; const float* bias;
  __device__ __forceinline__ void decode(int w, Unit& u) const { u.pm = w >> 2; u.pn = w & 3; u.a = 0; u.b = 0; }
  __device__ __forceinline__ const char* baseA(const Unit&) const { return A; }
  __device__ __forceinline__ const char* baseB(const Unit&) const { return Bt; }
  __device__ __forceinline__ unsigned rowA(const Unit& u, int r) const { return (unsigned)(u.pm * 256 + r) * 2048u; }
  __device__ __forceinline__ unsigned rowB(const Unit& u, int r) const { return (unsigned)(u.pn * 256 + r) * 2048u; }
  __device__ __forceinline__ void epi(const Acc& acc, const Unit& u, int wr, int wc, int fr, int fq) const {
#pragma unroll
    for (int bj = 0; bj < 2; ++bj) { const int col0 = u.pn * 256 + bj * 128 + wc * 32 + 8 * fq;
      const f32x4 g0 = *(const f32x4*)(gate + col0), g1 = *(const f32x4*)(gate + col0 + 4);
      f32x4 b0 = (f32x4){0.f, 0.f, 0.f, 0.f}, b1 = b0; if (bias) { b0 = *(const f32x4*)(bias + col0); b1 = *(const f32x4*)(bias + col0 + 4); }
      if (hin32) { f32x4 hi[2][4][2];
#pragma unroll
        for (int ai = 0; ai < 2; ++ai)
#pragma unroll
          for (int m = 0; m < 4; ++m) { const size_t off = (size_t)(u.pm * 256 + ai * 128 + wr * 64 + m * 16 + fr) * 1024 + col0; hi[ai][m][0] = *(const f32x4*)(hin32 + off); hi[ai][m][1] = *(const f32x4*)(hin32 + off + 4); }
#pragma unroll
        for (int ai = 0; ai < 2; ++ai)
#pragma unroll
          for (int m = 0; m < 4; ++m) { const size_t off = (size_t)(u.pm * 256 + ai * 128 + wr * 64 + m * 16 + fr) * 1024 + col0;
            *(u32x4*)(hout + off) = pack8(hi[ai][m][0] + g0 * (acc[ai][bj][m][0] + b0), hi[ai][m][1] + g1 * (acc[ai][bj][m][1] + b1)); }
      } else { u32x4 hi[2][4];
#pragma unroll
        for (int ai = 0; ai < 2; ++ai)
#pragma unroll
          for (int m = 0; m < 4; ++m) hi[ai][m] = *(const u32x4*)(hin16 + (size_t)(u.pm * 256 + ai * 128 + wr * 64 + m * 16 + fr) * 1024 + col0);
#pragma unroll
        for (int ai = 0; ai < 2; ++ai)
#pragma unroll
          for (int m = 0; m < 4; ++m) { const size_t off = (size_t)(u.pm * 256 + ai * 128 + wr * 64 + m * 16 + fr) * 1024 + col0; const u32x4 w = hi[ai][m];
            const f32x4 h0 = (f32x4){bf_lo(w.x), bf_hi(w.x), bf_lo(w.y), bf_hi(w.y)}, h1 = (f32x4){bf_lo(w.z), bf_hi(w.z), bf_lo(w.w), bf_hi(w.w)};
            *(u32x4*)(hout + off) = pack8(h0 + g0 * (acc[ai][bj][m][0] + b0), h1 + g1 * (acc[ai][bj][m][1] + b1)); }
      } }
  }
};

__device__ __forceinline__ void build_moetab(const Ctx& X, int layer, LAS int* toff) {
  const unsigned* cnt = (const unsigned*)(X.ws + WS_CTL) + CW_CNT + layer * 2048;
  LAS int* texp = toff + 256;
  LAS int* ntile = toff + 132;
  __syncthreads();
  if (X.tid < 64) ntile[X.tid] = ((int)__hip_atomic_load(cnt + X.tid * 32, __ATOMIC_RELAXED, __HIP_MEMORY_SCOPE_AGENT) + 255) >> 8;
  __syncthreads();
  if (X.tid == 0) { int s = 0; for (int e = 0; e < 64; ++e) { toff[e] = s; s += ntile[e]; } toff[64] = s; toff[65] = s + 64; }
  __syncthreads();
  if (X.tid < 65) { const int e = X.tid; const int lo = toff[e], hi = toff[e + 1]; for (int t = lo; t < hi && t < 704; ++t) texp[t] = e; }
  __syncthreads();
}
__device__ __forceinline__ int find_expert(const LAS int* toff, int ti) { return toff[256 + ti]; }

struct G6 {
  static constexpr bool PERM = true; static constexpr bool F8 = true; static constexpr int SCALE_B = 0x7A7A7A7A; static constexpr bool CONTIG = false; static constexpr int GROUP = 1; static constexpr bool ALIGN = true; static constexpr bool LINA = false, LINB = true;
  __device__ __forceinline__ size_t halfA() const { return 0; } __device__ __forceinline__ size_t halfB() const { return 128u * 1024u; }
  int K, nunits; unsigned char* ws; const LAS int* toff; const LAS unsigned* tokt; const char* wbase; size_t wstride;
  __device__ __forceinline__ void decode(int w, Unit& u) const { const int ti = w >> 1; u.pn = w & 1; u.a = find_expert(toff, ti); u.pm = ti - toff[u.a]; u.b = ti; }
  __device__ __forceinline__ const char* baseA(const Unit&) const { return (const char*)ws + WS_F; }
  __device__ __forceinline__ const char* baseB(const Unit& u) const { return wbase + (size_t)u.a * wstride; }
  __device__ __forceinline__ unsigned rowA(const Unit& u, int r) const { return tokt[u.ord * 256 + r]; }
  __device__ __forceinline__ void build_tokt(const Ctx& X, LAS unsigned* tk) const {
    for (int i = 0; i * X.G + X.c < nunits; ++i) { Unit u; decode(xcd_remap(i * X.G + X.c, nunits), u);
      if (X.tid < 256) { const int idx = u.pm * 256 + X.tid; int tok = idx;
        if (u.a < 64) tok = ((const int*)(ws + WS_LTOK))[u.a * 16384 + idx];
        tk[i * 256 + X.tid] = (unsigned)tok * 1024u; } }
    __syncthreads();
  }
  __device__ __forceinline__ unsigned rowB(const Unit& u, int r) const { return (unsigned)(u.pn * 256 + r) * 1024u; }
  __device__ __forceinline__ void epi(const Acc& acc, const Unit& u, int wr, int wc, int fr, int fq) const {
    unsigned char* HID = ws + WS_HID;
#pragma unroll
    for (int ai = 0; ai < 2; ++ai)
#pragma unroll
      for (int m = 0; m < 4; ++m) { const size_t hrow = (size_t)u.b * 256 + ai * 128 + wr * 64 + m * 16 + fr; f32x4 v0, v1;
#pragma unroll
        for (int j = 0; j < 4; ++j) { const float g0 = acc[ai][0][m][0][j] * 0.03125f, g1 = acc[ai][0][m][1][j] * 0.03125f; v0[j] = g0 * fast_sigmoid(g0) * (acc[ai][1][m][0][j] * 0.03125f); v1[j] = g1 * fast_sigmoid(g1) * (acc[ai][1][m][1][j] * 0.03125f); }
        *(u32x2*)(HID + hrow * 256 + u.pn * 128 + wc * 32 + 8 * fq) = (u32x2){(unsigned)pack4_fp8(v0[0], v0[1], v0[2], v0[3]), (unsigned)pack4_fp8(v1[0], v1[1], v1[2], v1[3])}; }
  }
};
struct G7 {
  static constexpr bool PERM = true; static constexpr bool F8 = true; static constexpr int SCALE_B = 0x7A7A7A7A; static constexpr bool CONTIG = false; static constexpr int GROUP = 1; static constexpr bool ALIGN = true; static constexpr bool LINA = true, LINB = true;
  __device__ __forceinline__ size_t halfA() const { return 128u * 256u; } __device__ __forceinline__ size_t halfB() const { return 128u * 256u; }
  int K, nunits; unsigned char* ws; const LAS int* toff; const char* wbase; size_t wstride; int dry;
  __device__ __forceinline__ void decode(int w, Unit& u) const { const int ti = w >> 2; u.pn = w & 3; u.a = find_expert(toff, ti); u.pm = ti - toff[u.a]; u.b = ti; }
  __device__ __forceinline__ const char* baseA(const Unit&) const { return (const char*)ws + WS_HID; }
  __device__ __forceinline__ const char* baseB(const Unit& u) const { return wbase + (size_t)u.a * wstride; }
  __device__ __forceinline__ unsigned rowA(const Unit& u, int r) const { return (unsigned)(u.b * 256 + r) * 256u; }
  __device__ __forceinline__ unsigned rowB(const Unit& u, int r) const { return (unsigned)(u.pn * 256 + r) * 256u; }
  __device__ __forceinline__ void epi(const Acc& acc, const Unit& u, int wr, int wc, int fr, int fq) const {
    unsigned char* YAS = ws + WS_YAS;
    if (dry == 2) { if (acc[0][0][0][0][0] == 123.456f) *(float*)YAS = 1.f; return; }
#pragma unroll
    for (int ai = 0; ai < 2; ++ai)
#pragma unroll
      for (int m = 0; m < 4; ++m) { const size_t yrow = (size_t)u.b * 256 + ai * 128 + wr * 64 + m * 16 + fr;
#pragma unroll
        for (int bj = 0; bj < 2; ++bj) { const f32x4 v0 = acc[ai][bj][m][0], v1 = acc[ai][bj][m][1];
          const int w0 = pack4_fp8(v0[0], v0[1], v0[2], v0[3]), w1 = pack4_fp8(v1[0], v1[1], v1[2], v1[3]);
          if (!dry) *(u32x2*)(YAS + yrow * 1024 + u.pn * 256 + bj * 128 + wc * 32 + 8 * fq) = (u32x2){(unsigned)w0, (unsigned)w1}; else if (w0 == 0x12345678 && w1 == 0x9abcdef0) *(u32x2*)(YAS + yrow * 1024) = (u32x2){1u, 2u}; } }
  }
};

struct G8 {
  static constexpr bool PERM = true; static constexpr bool F8 = false; static constexpr int SCALE_B = 0x7A7A7A7A; static constexpr bool CONTIG = false; static constexpr int GROUP = 1; static constexpr bool ALIGN = true; static constexpr bool LINA = true, LINB = false; __device__ __forceinline__ size_t halfA() const { return 128u * 512u; } __device__ __forceinline__ size_t halfB() const { return 0; } int K, nunits; unsigned char* ws;
  __device__ __forceinline__ void decode(int w, Unit& u) const { u.pm = 0; u.a = (w >> 6) & 3; u.pn = w & 63; u.b = 0; }
  __device__ __forceinline__ const char* baseA(const Unit&) const { return (const char*)ws + WS_DMT; }
  __device__ __forceinline__ const char* baseB(const Unit& u) const { return (const char*)ws + WS_A1 + (size_t)u.a * 512; }
  __device__ __forceinline__ unsigned rowA(const Unit&, int r) const { return (unsigned)r * 512u; }
  __device__ __forceinline__ unsigned rowB(const Unit& u, int r) const { const int n = u.pn * 256 + r; return (unsigned)(128 * (n & 127) + (n >> 7)) * 2048u; }
  __device__ __forceinline__ void epi(const Acc& acc, const Unit& u, int wr, int wc, int fr, int fq) const {
    bf16_t* X1 = (bf16_t*)(ws + WS_X1);
#pragma unroll
    for (int ai = 0; ai < 2; ++ai)
#pragma unroll
      for (int m = 0; m < 4; ++m) { const int mm = wr * 64 + m * 16 + fr;
#pragma unroll
        for (int bj = 0; bj < 2; ++bj) { const int n0 = u.pn * 256 + bj * 128 + wc * 32 + 8 * fq, tb = n0 >> 7, ta0 = n0 & 127;
          *(u32x4*)((X1 + ((((size_t)(u.a * 128 + mm) * 128 + tb) * 2 + ai) * 128 + ta0))) = pack8(acc[ai][bj][m][0], acc[ai][bj][m][1]); } }
  }
};
struct G9 {
  static constexpr bool PERM = true; static constexpr bool F8 = false; static constexpr int SCALE_B = 0x7A7A7A7A; static constexpr bool CONTIG = false; static constexpr int GROUP = 1; static constexpr bool ALIGN = true; static constexpr bool LINA = true, LINB = true; __device__ __forceinline__ size_t halfA() const { return 128u * 512u; } __device__ __forceinline__ size_t halfB() const { return 128u * 512u; } int K, nunits; unsigned char* ws;
  __device__ __forceinline__ void decode(int w, Unit& u) const { u.pm = 0; u.pn = w; u.a = 0; u.b = 0; }
  __device__ __forceinline__ const char* baseA(const Unit&) const { return (const char*)ws + WS_W1; }
  __device__ __forceinline__ const char* baseB(const Unit&) const { return (const char*)ws + WS_X1; }
  __device__ __forceinline__ unsigned rowA(const Unit&, int r) const { return (unsigned)r * 512u; }
  __device__ __forceinline__ unsigned rowB(const Unit& u, int r) const { return (unsigned)(u.pn * 256 + r) * 512u; }
  __device__ __forceinline__ void epi(const Acc& acc, const Unit& u, int wr, int wc, int fr, int fq) const {
    bf16_t* X2 = (bf16_t*)(ws + WS_X2);
#pragma unroll
    for (int m = 0; m < 4; ++m) { const int ka = wr * 64 + m * 16 + fr;
#pragma unroll
      for (int bj = 0; bj < 2; ++bj) { const int n0 = u.pn * 256 + bj * 128 + wc * 32 + 8 * fq, gm = n0 >> 7, tb0 = n0 & 127; f32x4 r0, r1, i0, i1;
#pragma unroll
        for (int j = 0; j < 4; ++j) {
          { const float ang = (float)((ka * (tb0 + j)) & 16383) * (1.f / 16384.f), cs = __builtin_amdgcn_cosf(ang), sn = __builtin_amdgcn_sinf(ang); const float yr = acc[0][bj][m][0][j], yi = acc[1][bj][m][0][j]; r0[j] = yr * cs + yi * sn; i0[j] = yi * cs - yr * sn; }
          { const float ang = (float)((ka * (tb0 + 4 + j)) & 16383) * (1.f / 16384.f), cs = __builtin_amdgcn_cosf(ang), sn = __builtin_amdgcn_sinf(ang); const float yr = acc[0][bj][m][1][j], yi = acc[1][bj][m][1][j]; r1[j] = yr * cs + yi * sn; i1[j] = yi * cs - yr * sn; } }
        bf16_t* p = X2 + (((size_t)(gm * 128 + ka) * 2) * 128 + tb0); *(u32x4*)(p) = pack8(r0, r1); *(u32x4*)((p + 128)) = pack8(i0, i1); } }
  }
};
struct G10 {
  static constexpr bool PERM = true; static constexpr bool F8 = false; static constexpr int SCALE_B = 0x7A7A7A7A; static constexpr bool CONTIG = false; static constexpr int GROUP = 1; static constexpr bool ALIGN = true; static constexpr bool LINA = true, LINB = false; __device__ __forceinline__ size_t halfA() const { return 128u * 512u; } __device__ __forceinline__ size_t halfB() const { return 0; } int K, nunits; unsigned char* ws;
  __device__ __forceinline__ void decode(int w, Unit& u) const { u.pm = 0; u.pn = w; u.a = 0; u.b = 0; }
  __device__ __forceinline__ const char* baseA(const Unit&) const { return (const char*)ws + WS_W2; }
  __device__ __forceinline__ const char* baseB(const Unit&) const { return (const char*)ws + WS_X2; }
  __device__ __forceinline__ unsigned rowA(const Unit&, int r) const { return (unsigned)r * 512u; }
  __device__ __forceinline__ unsigned rowB(const Unit& u, int r) const { const int n = u.pn * 256 + r, ka = n >> 9, gm = n & 511; return (unsigned)(gm * 128 + ka) * 512u; }
  __device__ __forceinline__ void epi(const Acc& acc, const Unit& u, int wr, int wc, int fr, int fq) const {
    bf16_t* FB = (bf16_t*)(ws + WS_FB); float2* SPC = (float2*)(ws + WS_SPC); const int ka = u.pn >> 1;
#pragma unroll
    for (int m = 0; m < 4; ++m) { const int kb = wr * 64 + m * 16 + fr; const int k = ka + 128 * kb, kmir = (16384 - k) & 16383;
#pragma unroll
      for (int bj = 0; bj < 2; ++bj) { const int gm0 = (u.pn & 1) * 256 + bj * 128 + wc * 32 + 8 * fq, d0 = (gm0 >> 7) * 128 + (gm0 & 127); const u32x4 o = pack8(acc[0][bj][m][0], acc[0][bj][m][1]);
        *(u32x4*)(FB + (size_t)k * 1024 + d0) = o; *(u32x4*)(FB + (size_t)kmir * 1024 + 512 + d0) = o;
        if ((gm0 & 127) == 0) SPC[k * 4 + (gm0 >> 7)] = make_float2(acc[0][bj][m][0][0], acc[1][bj][m][0][0]); } }
  }
};
}
namespace mk {
typedef float f32x16 __attribute__((ext_vector_type(16)));

__device__ __forceinline__ void phase_scan(const Ctx& X) {
  if (X.c >= 64) return;
  const int seg = X.wave, g = X.c >> 1, dir = X.c & 1, p = X.lane;
  const float2 lam = ((const float2*)(X.ws + WS_LAML))[(dir * 32 + g) * 64 + p];
  const float* S = (const float*)(X.ws + WS_SST) + (size_t)g * 768 * 256 + dir * 128 + p;
  bf16_t* XP = (bf16_t*)(X.ws + WS_AS5) + (size_t)g * 768 * 768 + 512 + dir * 128 + p;
  LAS float* EX = (LAS float*)X.lds;
  const int j0 = seg * 65;
  float xr = 0.f, xi = 0.f;
#pragma unroll
  for (int b = 0; b < 2; ++b) {
    float sr[33], si[33];
#pragma unroll
    for (int k = 0; k < 33 - b; ++k) { const int j = j0 + 33 * b + k; const int row = dir == 0 ? (j < 8 ? 512 + j : j - 8) : 519 - j; sr[k] = S[(size_t)row * 256]; si[k] = S[(size_t)row * 256 + 64]; }
#pragma unroll
    for (int k = 0; k < 33 - b; ++k) { const float nr = lam.x * xr - lam.y * xi + sr[k], ni = lam.x * xi + lam.y * xr + si[k]; xr = nr; xi = ni; }
  }
  EX[(seg * 64 + p) * 2] = xr; EX[(seg * 64 + p) * 2 + 1] = xi;
  float pr = 1.f, pi = 0.f;
  for (int k = 0; k < 65; ++k) { const float nr = pr * lam.x - pi * lam.y, ni = pr * lam.y + pi * lam.x; pr = nr; pi = ni; }
  __syncthreads();
  float cr = 0.f, ci = 0.f;
  for (int s2 = 0; s2 < seg; ++s2) { const float er = EX[(s2 * 64 + p) * 2], ei = EX[(s2 * 64 + p) * 2 + 1];
    const float nr = pr * cr - pi * ci + er, ni = pr * ci + pi * cr + ei; cr = nr; ci = ni; }
  xr = cr; xi = ci;
#pragma unroll
  for (int b = 0; b < 2; ++b) {
    float sr[33], si[33];
#pragma unroll
    for (int k = 0; k < 33 - b; ++k) { const int j = j0 + 33 * b + k; const int row = dir == 0 ? (j < 8 ? 512 + j : j - 8) : 519 - j; sr[k] = S[(size_t)row * 256]; si[k] = S[(size_t)row * 256 + 64]; }
#pragma unroll
    for (int k = 0; k < 33 - b; ++k) { const int j = j0 + 33 * b + k; const int row = dir == 0 ? (j < 8 ? 512 + j : j - 8) : 519 - j;
      XP[(size_t)row * 768] = f2bf(xr); XP[(size_t)row * 768 + 64] = f2bf(xi);
      const float nr = lam.x * xr - lam.y * xi + sr[k], ni = lam.x * xi + lam.y * xr + si[k]; xr = nr; xi = ni; }
  }
  __syncthreads();
}

__device__ __forceinline__ void zero_lists(const Ctx& X) {
  u32x4* z = (u32x4*)(X.ws + WS_LTOK); unsigned zu_ = 0u; asm volatile("" : "+v"(zu_)); const u32x4 zero = (u32x4){zu_, zu_, zu_, zu_};
  for (int i = X.c * NTHR + X.tid; i < (int)(4 * MiB / 16); i += X.G * NTHR) z[i] = zero;
}
#define MFMA32(a, b, c) __builtin_amdgcn_mfma_f32_32x32x16_bf16((a), (b), (c), 0, 0, 0)
__device__ __forceinline__ void attn_unit(const Ctx& X, const LAS float* rpbl, int head, int tile) {
  const bf16_t* Q = (const bf16_t*)(X.ws + WS_Q); const bf16_t* Kb = (const bf16_t*)(X.ws + WS_K); const bf16_t* VT = (const bf16_t*)(X.ws + WS_VT);
  bf16_t* CCt = (bf16_t*)(X.ws + WS_CONCAT);
  const int lane = X.lane, ql = lane & 31, hh = lane >> 5;
  const int rp = tile >> 2, mt = tile & 3;
  const int r = 2 * rp + (ql >> 4), cq = 16 * mt + (ql & 15), tq = r * 64 + cq;
  const int r0q = min(max(r - 4, 0), 248), csq = min(max(cq - 8, 0), 48);
  const int rlo = min(max(2 * rp - 4, 0), 248), rhi = min(max(2 * rp - 3, 0), 248) + 7;
  const int csb = min(max(16 * mt - 8, 0), 32);
  const int nloc = rhi - rlo + 1;
  unsigned cmask = 0u;
#pragma unroll
  for (int k = 0; k < 32; ++k) cmask |= ((csb + k >= csq) && (csb + k <= csq + 15)) ? (1u << k) : 0u;
  bf16x8 qf[4];
#pragma unroll
  for (int ks = 0; ks < 4; ++ks) qf[ks] = *(const bf16x8*)(Q + (size_t)tq * 512 + head * 64 + 16 * ks + 8 * hh);
  const int kperm = (ql & ~12) | ((ql & 4) << 1) | ((ql & 8) >> 1);
  f32x16 o0, o1;
#pragma unroll
  for (int i = 0; i < 16; ++i) { o0[i] = 0.f; o1[i] = 0.f; }
  float lsum = 0.f;
  const float c1 = 0.125f * 1.44269504f, c2 = 8.f * 1.44269504f;
  const float* rp_h = nullptr; (void)rp_h;
  const size_t koff_lane = (size_t)(((kperm >> 3) * 4 * 8 + (kperm & 7)) * 2 + hh) * 8;
  const size_t voff_lane = (size_t)(hh * 64 + ql) * 8;
  bf16x8 kf[4], vf[2][2];
  { const int kr0 = rlo, cg0 = csb >> 3;
    const bf16_t* kp = Kb + ((size_t)(head * 260 + kr0) * 8 + cg0) * 512 + koff_lane; const bf16_t* vp = VT + ((size_t)(head * 260 + kr0) * 8 + cg0) * 512 + voff_lane;
#pragma unroll
    for (int ks = 0; ks < 4; ++ks) kf[ks] = *(const bf16x8*)(kp + ks * 128);
#pragma unroll
    for (int db = 0; db < 2; ++db)
#pragma unroll
      for (int s2 = 0; s2 < 2; ++s2) vf[db][s2] = *(const bf16x8*)(vp + db * 256 + s2 * 1024); }
  for (int b = 0; b < nloc + 8; ++b) {
    const bool loc = b < nloc;
    const int kr = rlo + b;
    bf16x8 kc[4], vc[2][2];
#pragma unroll
    for (int ks = 0; ks < 4; ++ks) kc[ks] = kf[ks];
#pragma unroll
    for (int db = 0; db < 2; ++db)
#pragma unroll
      for (int s2 = 0; s2 < 2; ++s2) vc[db][s2] = vf[db][s2];
    if (b + 1 < nloc + 8) { const int bn = b + 1; const int krn = bn < nloc ? rlo + bn : 256 + ((bn - nloc) >> 1), cgn = bn < nloc ? (csb >> 3) : 4 * ((bn - nloc) & 1);
      const bf16_t* kp = Kb + ((size_t)(head * 260 + krn) * 8 + cgn) * 512 + koff_lane; const bf16_t* vp = VT + ((size_t)(head * 260 + krn) * 8 + cgn) * 512 + voff_lane;
#pragma unroll
      for (int ks = 0; ks < 4; ++ks) kf[ks] = *(const bf16x8*)(kp + ks * 128);
#pragma unroll
      for (int db = 0; db < 2; ++db)
#pragma unroll
        for (int s2 = 0; s2 < 2; ++s2) vf[db][s2] = *(const bf16x8*)(vp + db * 256 + s2 * 1024); }
    f32x16 sacc;
#pragma unroll
    for (int i = 0; i < 16; ++i) sacc[i] = 0.f;
#pragma unroll
    for (int ks = 0; ks < 4; ++ks) sacc = MFMA32(kc[ks], qf[ks], sacc);
    float pv[16];
    if (loc) {
      const bool rowok = (kr >= r0q) && (kr <= r0q + 7);
      const int dr = min(max(kr - r + 7, 0), 14);
      const LAS float* bp = rpbl + (head * 15 + dr) * 31;
      const int dc0 = csb - cq + 15;
#pragma unroll
      for (int i = 0; i < 16; ++i) { const int kidx = 16 * (i >> 3) + 8 * hh + (i & 7);
        const bool ok = rowok && ((cmask >> kidx) & 1u);
        const float bias = bp[min(max(dc0 + kidx, 0), 30)];
        const float e = __builtin_amdgcn_exp2f(sacc[i] * c1 + bias * 1.44269504f - c2); pv[i] = ok ? e : 0.f; }
    } else {
#pragma unroll
      for (int i = 0; i < 16; ++i) pv[i] = __builtin_amdgcn_exp2f(sacc[i] * c1 - c2);
    }
    u32x4 p0, p1;
    p0.x = cvt_pk_bf16(pv[0], pv[1]); p0.y = cvt_pk_bf16(pv[2], pv[3]); p0.z = cvt_pk_bf16(pv[4], pv[5]); p0.w = cvt_pk_bf16(pv[6], pv[7]);
    p1.x = cvt_pk_bf16(pv[8], pv[9]); p1.y = cvt_pk_bf16(pv[10], pv[11]); p1.z = cvt_pk_bf16(pv[12], pv[13]); p1.w = cvt_pk_bf16(pv[14], pv[15]);
    lsum += (bf_lo(p0.x) + bf_hi(p0.x)) + (bf_lo(p0.y) + bf_hi(p0.y)) + (bf_lo(p0.z) + bf_hi(p0.z)) + (bf_lo(p0.w) + bf_hi(p0.w))
          + (bf_lo(p1.x) + bf_hi(p1.x)) + (bf_lo(p1.y) + bf_hi(p1.y)) + (bf_lo(p1.z) + bf_hi(p1.z)) + (bf_lo(p1.w) + bf_hi(p1.w));
    const bf16x8 pb0 = __builtin_bit_cast(bf16x8, p0), pb1 = __builtin_bit_cast(bf16x8, p1);
    o0 = MFMA32(vc[0][0], pb0, o0); o0 = MFMA32(vc[0][1], pb1, o0);
    o1 = MFMA32(vc[1][0], pb0, o1); o1 = MFMA32(vc[1][1], pb1, o1);
  }
  lsum += sx(lsum, 32);
  const float inv = 1.f / lsum;
  bf16_t* op = CCt + (size_t)tq * 1024 + 512 + head * 64 + 4 * hh;
#pragma unroll
  for (int gq = 0; gq < 4; ++gq) {
    u32x2 w0, w1;
    w0.x = cvt_pk_bf16(o0[4 * gq] * inv, o0[4 * gq + 1] * inv); w0.y = cvt_pk_bf16(o0[4 * gq + 2] * inv, o0[4 * gq + 3] * inv);
    w1.x = cvt_pk_bf16(o1[4 * gq] * inv, o1[4 * gq + 1] * inv); w1.y = cvt_pk_bf16(o1[4 * gq + 2] * inv, o1[4 * gq + 3] * inv);
    *(u32x2*)(op + 8 * gq) = w0; *(u32x2*)(op + 32 + 8 * gq) = w1;
  }
}
__device__ __forceinline__ void phase_attn(const Ctx& X) {
  LAS float* rpbl = (LAS float*)X.lds;
  zero_lists(X);
  for (int i = X.tid; i < 8 * 15 * 31; i += NTHR) rpbl[i] = X.a->in[IN_RPB][i];
  __syncthreads();
  const int gw = X.c * NWAVES + X.wave, NGW = X.G * NWAVES;
  for (int U = gw; U < 4096; U += NGW) attn_unit(X, rpbl, U >> 9, U & 511);
}

__device__ __forceinline__ void fourier_fix(const Ctx& X, int nunits) {
  const float2* SPC = (const float2*)(X.ws + WS_SPC); bf16_t* FB = (bf16_t*)(X.ws + WS_FB);
  for (int i = 0; i * X.G + X.c < nunits; ++i) { const int pm = xcd_remap(i * X.G + X.c, nunits) >> 2;
    for (int q = X.tid; q < 1024; q += NTHR) { const int k = pm * 256 + (q >> 2), g = q & 3, kmir = (16384 - k) & 16383;
      const float2 a = SPC[k * 4 + g], b = SPC[kmir * 4 + g];
      FB[(size_t)k * 1024 + g * 128] = f2bf(0.5f * (a.x + b.x)); FB[(size_t)k * 1024 + 512 + g * 128] = f2bf(0.5f * (a.y + b.y)); } }
  __syncthreads();
}

__device__ __forceinline__ void phase_router(const Ctx& X, int layer, int dry) {
  const float* mod = (const float*)(X.ws + WS_MOD) + (layer == 0 ? 0 : 2 * 6144);
  const float* shift = mod + 3072; const float* scale = mod + 4096;
  const bf16_t* h = (const bf16_t*)(X.ws + WS_HB); bf16_t* F = (bf16_t*)(X.ws + WS_F);
  unsigned* cntg = (unsigned*)(X.ws + WS_CTL) + CW_CNT + layer * 2048;
  int* ltok = (int*)(X.ws + WS_LTOK); int* asg = (int*)(X.ws + WS_ASG);
  const bf16_t* WR = (const bf16_t*)(X.ws + WS_WROUT_T) + (size_t)layer * 64 * 1024;
  const float* rbias = X.a->in[IN_RBIAS] + layer * 64;
  constexpr int FROW = 2064;
  const int lane = X.lane, wave = X.wave, tid = X.tid;
  f32x4 scv[4], shv[4]; float rb[8];
#pragma unroll
  for (int j = 0; j < 4; ++j) { scv[j] = ((const f32x4*)scale)[lane + 64 * j] + 1.f; shv[j] = ((const f32x4*)shift)[lane + 64 * j]; }
#pragma unroll
  for (int j = 0; j < 8; ++j) rb[j] = rbias[(tid & 7) * 8 + j];
  for (int tile = X.c; tile < TOK / 64; tile += X.G) {
    const int t0 = tile * 64;
    { u32x2 raw[8][4];
#pragma unroll
      for (int rr = 0; rr < 8; ++rr) { const u32x2* xr = (const u32x2*)(h + (size_t)(t0 + wave * 8 + rr) * 1024) + lane;
#pragma unroll
        for (int j = 0; j < 4; ++j) raw[rr][j] = xr[64 * j]; }
#pragma unroll
      for (int rr = 0; rr < 8; ++rr) {
        const int lr = wave * 8 + rr, t = t0 + lr; float ss = 0.f; f32x4 v[4];
#pragma unroll
        for (int j = 0; j < 4; ++j) { const u32x2 w = raw[rr][j]; v[j] = (f32x4){bf_lo(w.x), bf_hi(w.x), bf_lo(w.y), bf_hi(w.y)}; ss += (v[j].x * v[j].x + v[j].y * v[j].y) + (v[j].z * v[j].z + v[j].w * v[j].w); }
        const float r = rsqrtf(wave_sum(ss) * (1.f / 1024.f) + 1e-6f);
#pragma unroll
        for (int j = 0; j < 4; ++j) { const f32x4 f = v[j] * r * scv[j] + shv[j];
          u32x2 w; w.x = cvt_pk_bf16(f.x, f.y); w.y = cvt_pk_bf16(f.z, f.w);
          if (!dry) ((int*)((unsigned char*)F + (size_t)t * 1024))[lane + 64 * j] = pack4_fp8(f.x, f.y, f.z, f.w);
          *(LAS u32x2*)(X.lds + lr * FROW + (lane + 64 * j) * 8) = w; }
      }
    }
    __syncthreads();
    f32x4 pl[4][4];
    { const int fr = lane & 15, fq = lane >> 4;
#pragma unroll
      for (int a = 0; a < 4; ++a)
#pragma unroll
        for (int b = 0; b < 4; ++b) pl[a][b] = (f32x4){0.f, 0.f, 0.f, 0.f};
      bf16x8 bq[4][4];
#pragma unroll
      for (int ks = 0; ks < 4; ++ks)
#pragma unroll
        for (int eb = 0; eb < 4; ++eb) bq[ks][eb] = *(const bf16x8*)(WR + (size_t)(eb * 16 + fr) * 1024 + wave * 128 + ks * 32 + fq * 8);
#pragma unroll
      for (int ks = 0; ks < 4; ++ks) {
        bf16x8 af[4];
#pragma unroll
        for (int rb = 0; rb < 4; ++rb) af[rb] = *(const LAS bf16x8*)(X.lds + (rb * 16 + fr) * FROW + (wave * 128 + ks * 32 + fq * 8) * 2);
#pragma unroll
        for (int rb = 0; rb < 4; ++rb)
#pragma unroll
          for (int eb = 0; eb < 4; ++eb) pl[rb][eb] = __builtin_amdgcn_mfma_f32_16x16x32_bf16(af[rb], bq[ks][eb], pl[rb][eb], 0, 0, 0);
      }
    }
    __syncthreads();
    { LAS float* PART = (LAS float*)X.lds;
      const int fr = lane & 15, fq = lane >> 4;
#pragma unroll
      for (int rb = 0; rb < 4; ++rb)
#pragma unroll
        for (int eb = 0; eb < 4; ++eb)
#pragma unroll
          for (int j = 0; j < 4; ++j) PART[(wave * 64 + rb * 16 + 4 * fq + j) * 64 + eb * 16 + fr] = pl[rb][eb][j];
      __syncthreads();
      float sum[8];
#pragma unroll
      for (int i = 0; i < 8; ++i) { float a = 0.f;
#pragma unroll
        for (int w = 0; w < 8; ++w) a += PART[w * 4096 + i * 512 + tid];
        sum[i] = a; }
      __syncthreads();
      LAS float* LG0 = (LAS float*)X.lds;
#pragma unroll
      for (int i = 0; i < 8; ++i) { const int o = i * 512 + tid; LG0[(o >> 6) * 65 + (o & 63)] = sum[i]; }
    }
    LAS float* LG = (LAS float*)X.lds;
    LAS float* GS = LG + 64 * 65;
    LAS float* SELV = GS + 512;
    LAS int* OUTE = (LAS int*)(SELV + 4096);
    LAS float* OUTS = (LAS float*)(OUTE + 512);
    LAS int* HIST = (LAS int*)(OUTS + 512);
    LAS int* BASE = HIST + 64;
    if (tid < 64) HIST[tid] = 0;
    __syncthreads();
    const int tl = tid >> 3, grp = tid & 7;
    float v[8], sc[8];
    { float m1 = -INFINITY, m2 = -INFINITY;
#pragma unroll
      for (int j = 0; j < 8; ++j) { const float s = 1.f / (1.f + __expf(-LG[tl * 65 + grp * 8 + j])); sc[j] = s; v[j] = s + rb[j];
        if (v[j] > m1) { m2 = m1; m1 = v[j]; } else if (v[j] > m2) m2 = v[j]; }
      GS[tl * 8 + grp] = m1 + m2; }
    __syncthreads();
    bool keep;
    { const float mine = GS[tl * 8 + grp]; int rank = 0;
#pragma unroll
      for (int g2 = 0; g2 < 8; ++g2) { const float o = GS[tl * 8 + g2]; rank += (o > mine || (o == mine && g2 < grp)) ? 1 : 0; }
      keep = rank < 4;
#pragma unroll
      for (int j = 0; j < 8; ++j) SELV[tl * 64 + grp * 8 + j] = keep ? v[j] : -INFINITY; }
    __syncthreads();
    if (keep) {
      int rk[8];
#pragma unroll
      for (int j = 0; j < 8; ++j) rk[j] = 0;
      for (int e2 = 0; e2 < 64; ++e2) { const float o = SELV[tl * 64 + e2];
#pragma unroll
        for (int j = 0; j < 8; ++j) rk[j] += (o > v[j] || (o == v[j] && e2 < grp * 8 + j)) ? 1 : 0; }
#pragma unroll
      for (int j = 0; j < 8; ++j) if (rk[j] < 8) { OUTE[tl * 8 + rk[j]] = grp * 8 + j; OUTS[tl * 8 + rk[j]] = sc[j]; }
    }
    __syncthreads();
    { const int jj = tid & 7, e = OUTE[tl * 8 + jj]; const float s = OUTS[tl * 8 + jj];
      float sum = s; sum += sx(sum, 1); sum += sx(sum, 2); sum += sx(sum, 4);
      const float w = 2.5f * s / sum;
      const int sl = atomicAdd((int*)&HIST[e], 1);
      __syncthreads();
      const int t = t0 + tl;
      if (tid < 64) { const int n = HIST[tid]; BASE[tid] = (n && !dry) ? (int)atomicAdd(cntg + tid * 32, (unsigned)n) : 0; }
      __syncthreads();
      const int slot = BASE[e] + sl;
      if (!dry) { ltok[(size_t)e * 16384 + slot] = t; } if (!dry) ((int2*)asg)[t * 8 + jj] = make_int2((e << 16) | slot, __float_as_int(w)); }
    __syncthreads();
  }
}

__device__ __forceinline__ void phase_combine(const Ctx& X, int layer, const LAS int* toff, int dry) {
  const float* mod = (const float*)(X.ws + WS_MOD) + (layer == 0 ? 0 : 2 * 6144);
  const float* gffn = mod + 5120;
  const float* nmod = (const float*)(X.ws + WS_MOD) + 2 * 6144;
  float* hout32 = X.a->h; bf16_t* hb = (bf16_t*)(X.ws + WS_HB); const unsigned char* YAS = X.ws + WS_YAS; const int* asg = (const int*)(X.ws + WS_ASG); bf16_t* A1 = (bf16_t*)(X.ws + WS_A1);
  const int gw = X.c * NWAVES + X.wave, NGW = X.G * NWAVES, lane = X.lane;
  f32x4 gtv[4], nsh[4], nsc[4];
#pragma unroll
  for (int j = 0; j < 4; ++j) { gtv[j] = ((const f32x4*)gffn)[lane + 64 * j]; nsh[j] = ((const f32x4*)nmod)[lane + 64 * j]; nsc[j] = ((const f32x4*)(nmod + 1024))[lane + 64 * j] + 1.f; }
  for (int t0 = gw; t0 < TOK; t0 += 2 * NGW) {
    int yw[2][9][4]; f32x4 hv[2][4]; float wgt[2][8];
#pragma unroll
    for (int u = 0; u < 2; ++u) { const int t = t0 + u * NGW;
      int pos[9];
#pragma unroll
      for (int k = 0; k < 8; ++k) { const int2 a = ((const int2*)asg)[t * 8 + k]; pos[k] = toff[a.x >> 16] * 256 + (a.x & 0xffff); wgt[u][k] = __int_as_float(a.y); }
      pos[8] = toff[64] * 256 + t;
#pragma unroll
      for (int k = 0; k < 9; ++k) { const int* yr = (const int*)(YAS + (size_t)pos[k] * 1024) + lane;
#pragma unroll
        for (int j = 0; j < 4; ++j) yw[u][k][j] = yr[64 * j]; }
      const u32x2* hr = (const u32x2*)(hb + (size_t)t * 1024) + lane;
#pragma unroll
      for (int j = 0; j < 4; ++j) { const u32x2 w = hr[64 * j]; hv[u][j] = (f32x4){bf_lo(w.x), bf_hi(w.x), bf_lo(w.y), bf_hi(w.y)}; } }
#pragma unroll
    for (int u = 0; u < 2; ++u) { const int t = t0 + u * NGW;
      f32x4 acc[4];
#pragma unroll
      for (int j = 0; j < 4; ++j) acc[j] = (f32x4){0.f, 0.f, 0.f, 0.f};
#pragma unroll
      for (int k = 0; k < 9; ++k) { const float wk = (k < 8 ? wgt[u][k] : 1.f) * 0.03125f;
#pragma unroll
        for (int j = 0; j < 4; ++j) { const int w = yw[u][k][j];
          acc[j].x += wk * __builtin_amdgcn_cvt_f32_fp8(w, 0); acc[j].y += wk * __builtin_amdgcn_cvt_f32_fp8(w, 1); acc[j].z += wk * __builtin_amdgcn_cvt_f32_fp8(w, 2); acc[j].w += wk * __builtin_amdgcn_cvt_f32_fp8(w, 3); } }
      f32x4 v[4]; float ss = 0.f;
#pragma unroll
      for (int j = 0; j < 4; ++j) { v[j] = hv[u][j] + gtv[j] * acc[j];
        if (!dry) { if (layer == 0) ((u32x2*)(hb + (size_t)t * 1024))[lane + 64 * j] = (u32x2){cvt_pk_bf16(v[j].x, v[j].y), cvt_pk_bf16(v[j].z, v[j].w)}; else ((f32x4*)(hout32 + (size_t)t * 1024))[lane + 64 * j] = v[j]; }
        ss += (v[j].x * v[j].x + v[j].y * v[j].y) + (v[j].z * v[j].z + v[j].w * v[j].w); }
      if (layer == 0) {
        const float r = rsqrtf(wave_sum(ss) * (1.f / 1024.f) + 1e-6f);
#pragma unroll
        for (int j = 0; j < 4; ++j) { const f32x4 f = v[j] * r * nsc[j] + nsh[j];
          u32x2 w; w.x = cvt_pk_bf16(f.x, f.y); w.y = cvt_pk_bf16(f.z, f.w);
          if (!dry) ((u32x2*)(A1 + (size_t)t * 1024))[lane + 64 * j] = w; }
      }
    }
  }
}

constexpr int NPHASE = 21;
template <bool SP2>
__global__ void __launch_bounds__(NTHR, 2) mk_fwd(Args args) {
  extern __shared__ __attribute__((aligned(16))) unsigned char lds_raw[];
  Ctx X; X.lds = (LAS unsigned char*)lds_raw; X.a = &args; X.ws = args.ws; X.tid = threadIdx.x; X.lane = X.tid & 63; X.wave = __builtin_amdgcn_readfirstlane(X.tid >> 6);
  X.G = gridDim.x; X.c = blockIdx.x;
  const int wave_s = X.wave;
  volatile LAS unsigned* MISC = (volatile LAS unsigned*)(X.lds + LDS_MISC_OFF);
  LAS int* TOFF = (LAS int*)(X.lds + LDS_MISC_OFF + 64);
  if (X.tid < 16) MISC[X.tid] = 0u;
  __syncthreads();
  unsigned* ctl = (unsigned*)(X.ws + WS_CTL);
  const int lo = args.ph_lo, hi = args.ph_hi;
  const bool multi = (hi - lo) > 1;
  XcdBarrier bar; bar.bar = ctl + CW_BAR; bar.x = 0; bar.st = nullptr;
  if (multi) bar = xcd_barrier_post(ctl + CW_BAR, MISC, X.tid);
  LAS unsigned char* lds = X.lds;
  unsigned char* ws = X.ws;
  const float* mod = (const float*)(ws + WS_MOD); (void)mod;
#ifndef PH_MASK
#define PH_MASK 0x1fffffull
#endif
#define IN(k) ((((unsigned long long)PH_MASK >> (k)) & 1ull) && lo <= (k) && (k) < hi)
#define SEAM(k) do { if (IN(k) && IN((k) + 1)) xcd_barrier(bar, X.tid); } while (0)
#ifndef REP_MASK
#define REP_MASK 0ull
#endif
#define REPS(k) ((int)(((unsigned long long)REP_MASK >> (k)) & 1ull))
#define FILL(ph, nb) do { if (!(args.flags & FLAG_SKIP_EXPERTS) && multi) { if (X.c < (nb)) { __syncthreads(); if (X.tid == 0) atomicAdd(ctl + CW_DONE + 64 * (ph), 1u); } \
    else transpose_work(X, ctl + CW_DQ1, 0, 0, 2, 130 * IT_EXP, ctl + CW_DONE + 64 * (ph), (unsigned)(nb)); } } while (0)
#define LAUNDER() do { int w0_ = wave_s; asm volatile("" : "+s"(w0_)); unsigned zl_ = 0u; asm volatile("" : "+v"(zl_)); int l_ = (int)__builtin_amdgcn_mbcnt_hi(~0u, __builtin_amdgcn_mbcnt_lo(~0u, zl_)); X.wave = w0_; X.lane = l_; X.tid = w0_ * 64 + l_; \
    size_t z0_ = 0; asm volatile("" : "+s"(z0_)); unsigned char* w_ = args.ws + z0_; X.ws = w_; ws = w_; mod = (const float*)(w_ + WS_MOD); } while (0)
  if (IN(0)) for (int rep_ = 0; rep_ <= REPS(0); ++rep_) { if (rep_) xcd_barrier(bar, X.tid); LAUNDER(); phase_prep(X, rep_); } SEAM(0);
#ifdef EXTRA_BARS
  if (multi) for (int eb_ = 0; eb_ < EXTRA_BARS; ++eb_) xcd_barrier(bar, X.tid);
#endif
  if (IN(1)) for (int rep_ = 0; rep_ <= REPS(1); ++rep_) { if (rep_) xcd_barrier(bar, X.tid); LAUNDER(); phase_mod0(X); } SEAM(1);
  if (IN(2)) for (int rep_ = 0; rep_ <= REPS(2); ++rep_) { if (rep_) xcd_barrier(bar, X.tid); LAUNDER(); G1 p; p.K = 1024; p.nunits = 520; p.ws = ws; p.qg = args.in[IN_QG]; p.kg = args.in[IN_KG]; gemm_phase<G1, SP2>(lds, p, X.G, X.c, X.tid); FILL(2, 8); } SEAM(2);
  if (IN(3)) for (int rep_ = 0; rep_ <= REPS(3); ++rep_) { if (rep_) xcd_barrier(bar, X.tid); LAUNDER(); G2 p; p.K = 512; p.nunits = 96; p.ws = ws; gemm_phase<G2, SP2>(lds, p, X.G, X.c, X.tid); FILL(3, 96); } SEAM(3);
  if (IN(4)) for (int rep_ = 0; rep_ <= REPS(4); ++rep_) { if (rep_) xcd_barrier(bar, X.tid); LAUNDER(); phase_scan(X); FILL(4, 64); } SEAM(4);
  if (IN(5)) for (int rep_ = 0; rep_ <= REPS(5); ++rep_) { if (rep_) xcd_barrier(bar, X.tid); LAUNDER(); G3 p; p.K = 768; p.nunits = 128; p.ws = ws; gemm_phase<G3, SP2>(lds, p, X.G, X.c, X.tid); FILL(5, 128); } SEAM(5);
  if (IN(6)) for (int rep_ = 0; rep_ <= REPS(6); ++rep_) { if (rep_) xcd_barrier(bar, X.tid); LAUNDER(); G4 p; p.K = 512; p.nunits = 128; p.ws = ws; p.bglu = args.in[IN_BGLU]; gemm_phase<G4, SP2>(lds, p, X.G, X.c, X.tid); FILL(6, 128); } SEAM(6);
  if (IN(7)) for (int rep_ = 0; rep_ <= REPS(7); ++rep_) { if (rep_) xcd_barrier(bar, X.tid); LAUNDER(); phase_attn(X); } SEAM(7);
  if (IN(8)) for (int rep_ = 0; rep_ <= REPS(8); ++rep_) { if (rep_) xcd_barrier(bar, X.tid); LAUNDER(); GRes p; p.K = 1024; p.nunits = 256; p.A = (const char*)ws + WS_CONCAT; p.Bt = (const char*)ws + WS_WMIX_T; p.hin32 = args.in[IN_X]; p.hin16 = nullptr; p.hout = (bf16_t*)(ws + WS_HB); p.gate = mod + 2048; p.bias = nullptr;
    gemm_phase<GRes, SP2>(lds, p, X.G, X.c, X.tid); } SEAM(8);
#pragma unroll 1
  for (int layer = 0; layer < 2; ++layer) {
    const int pb = layer == 0 ? 9 : 17;
    if (IN(pb)) for (int rep_ = 0; rep_ <= REPS(pb); ++rep_) { if (rep_) xcd_barrier(bar, X.tid); LAUNDER(); phase_router(X, layer, rep_);
      if (layer == 0 && rep_ == 0 && !(args.flags & FLAG_SKIP_EXPERTS)) { __syncthreads(); transpose_work(X, ctl + CW_DQ1, 0, 0, 2, 130 * IT_EXP, nullptr, 0u, 65 * IT_EXP); } } SEAM(pb);
#ifndef ROUTER_VARIANT
#define ROUTER_VARIANT 1
#endif
#ifndef G6_VARIANT
#define G6_VARIANT 1
#endif
    if (IN(pb + 1)) for (int rep_ = REPS(pb + 1); rep_ >= 0; --rep_) { if (rep_ == 0 && REPS(pb + 1)) xcd_barrier(bar, X.tid); LAUNDER(); build_moetab(X, layer, TOFF); G6 p; p.K = 512; p.ws = ws; p.toff = TOFF; p.nunits = TOFF[65] * 2; p.wbase = (const char*)ws + (layer == 0 ? WS_WEXP : WS_WEXP1); p.wstride = layer == 0 ? EXP_STRIDE : EXP1_STRIDE;
      { LAS unsigned* tk = (LAS unsigned*)(X.lds + LDS_STAGE); p.tokt = tk; p.build_tokt(X, tk); } gemm_phase<G6, false>(lds, p, X.G, X.c, X.tid); } SEAM(pb + 1);
#ifndef G7_VARIANT
#define G7_VARIANT 1
#endif
    if (IN(pb + 2)) for (int rep_ = REPS(pb + 2); rep_ >= 0; --rep_) { if (rep_ == 0 && REPS(pb + 2)) xcd_barrier(bar, X.tid); LAUNDER(); build_moetab(X, layer, TOFF); G7 p; p.dry = rep_; { int k_ = 128; asm volatile("" : "+s"(k_)); p.K = k_; } p.ws = ws; p.toff = TOFF; p.nunits = TOFF[65] * 4; p.wbase = (const char*)ws + (layer == 0 ? WS_WEXP + EXP_DOFF : WS_WEXP1 + EXP1_DOFF); p.wstride = layer == 0 ? EXP_STRIDE : EXP1_STRIDE; gemm_phase<G7, SP2>(lds, p, X.G, X.c, X.tid); } SEAM(pb + 2);
    if (IN(pb + 3)) for (int rep_ = REPS(pb + 3); rep_ >= 0; --rep_) { if (rep_ == 0 && REPS(pb + 3)) xcd_barrier(bar, X.tid); LAUNDER(); build_moetab(X, layer, TOFF); phase_combine(X, layer, TOFF, rep_);
      if (layer == 0 && rep_ == 0 && !(args.flags & FLAG_SKIP_EXPERTS)) { __syncthreads(); transpose_work(X, ctl + CW_DQ1, 0, 0, 2, 130 * IT_EXP); } }
    if (layer == 0) {
      SEAM(12);
      if (IN(13)) for (int rep_ = 0; rep_ <= REPS(13); ++rep_) { if (rep_) xcd_barrier(bar, X.tid); LAUNDER(); G8 p; p.K = 256; p.nunits = 256; p.ws = ws; gemm_phase<G8, SP2>(lds, p, X.G, X.c, X.tid); } SEAM(13);
      if (IN(14)) for (int rep_ = 0; rep_ <= REPS(14); ++rep_) { if (rep_) xcd_barrier(bar, X.tid); LAUNDER(); G9 p; p.K = 256; p.nunits = 256; p.ws = ws; gemm_phase<G9, SP2>(lds, p, X.G, X.c, X.tid); } SEAM(14);
      if (IN(15)) for (int rep_ = 0; rep_ <= REPS(15); ++rep_) { if (rep_) xcd_barrier(bar, X.tid); LAUNDER(); G10 p; p.K = 256; p.nunits = 256; p.ws = ws; gemm_phase<G10, SP2>(lds, p, X.G, X.c, X.tid); } SEAM(15);
      if (IN(16)) { LAUNDER(); zero_lists(X); fourier_fix(X, 256); GRes p; p.K = 1024; p.nunits = 256; p.A = (const char*)ws + WS_FB; p.Bt = (const char*)ws + WS_WFOUR_T; p.hin32 = nullptr; p.hin16 = (const bf16_t*)(ws + WS_HB); p.hout = (bf16_t*)(ws + WS_HB); p.gate = mod + 2 * 6144 + 2048; p.bias = args.in[IN_BFOUR];
        gemm_phase<GRes, SP2>(lds, p, X.G, X.c, X.tid); } SEAM(16);
    }
  }
#undef IN
#undef SEAM
}
}
#ifndef MK_SP2
#define MK_SP2 true
#endif
#ifndef MK_N_LAUNCHES
#define MK_N_LAUNCHES 1
#endif
#ifndef CHECK
#define CHECK 0
#endif
static int g_grid = 0;
static bool mk_setup(int n_in, int out_size, size_t ws_size) {
  if (g_grid == 0) {
    g_grid = -1;
    if (n_in != 31 || out_size != 16384 * 1024 || ws_size < mk::WS_NEED) { fprintf(stderr, "kernel_launch: unexpected n_in %d out %d ws %zu\n", n_in, out_size, ws_size); return false; }
    int dev = 0, cus = 0;
    if (hipGetDevice(&dev) != hipSuccess || hipDeviceGetAttribute(&cus, hipDeviceAttributeMultiprocessorCount, dev) != hipSuccess) return false;
    if (cus < 256) { fprintf(stderr, "kernel_launch: needs 256 CUs, device has %d\n", cus); return false; }
    if (hipFuncSetAttribute((const void*)mk::mk_fwd<MK_SP2>, hipFuncAttributeMaxDynamicSharedMemorySize, mk::LDS_BYTES) != hipSuccess) { fprintf(stderr, "kernel_launch: hipFuncSetAttribute failed\n"); return false; }
    g_grid = 256;
  }
  return g_grid > 0;
}
static void mk_run(hipStream_t s, mk::Args a, int lo, int hi) {
  a.ph_lo = lo; a.ph_hi = hi;
  hipLaunchKernelGGL(mk::mk_fwd<MK_SP2>, dim3(g_grid), dim3(mk::NTHR), mk::LDS_BYTES, s, a);
}

#if CHECK
namespace chk {
using mk::bf16_t;
__device__ __forceinline__ float b2f(bf16_t b) { return __uint_as_float(((unsigned)b) << 16); }
__global__ void k_cmp(int mode, const void* A, const float* B, unsigned long long n, double* acc) {
  double e = 0.0, r = 0.0; const bf16_t* A16 = (const bf16_t*)A;
  for (unsigned long long i = (unsigned long long)blockIdx.x * 256 + threadIdx.x; i < n; i += (unsigned long long)gridDim.x * 256) {
    float a = 0.f, b = 0.f; const int row = (int)(i >> 9), col = (int)(i & 511);
    switch (mode) {
      case 0: a = ((const float*)A)[i]; b = B[i]; break;
      case 1: a = b2f(A16[i]); b = B[i]; break;
      case 2: { b = B[(size_t)row * 2048 + col]; const int g = col >> 4, c = col & 15; int crow, s; if (row < 16384) { crow = row >> 5; s = row & 31; } else { const int j = row - 16384; crow = 512 + (j >> 5); s = j & 31; }
                a = b2f(A16[((size_t)(g * 768 + crow)) * 768 + s * 16 + c]); } break;
      case 3: b = B[(size_t)row * 2048 + 512 + col]; a = b2f(A16[(size_t)row * 512 + col]); break;
      case 4: b = B[(size_t)row * 2048 + 1024 + col]; a = b2f(A16[(size_t)row * 512 + col]); break;
      case 5: b = B[(size_t)row * 2048 + 1536 + col]; a = b2f(A16[(size_t)col * 16640 + row]); break;
      case 6: b = B[(size_t)row * 1024 + col]; a = b2f(A16[(size_t)row * 1024 + col]); break;
      case 7: b = B[(size_t)row * 1024 + 512 + col]; a = b2f(A16[(size_t)row * 1024 + 512 + col]); break;
      case 8: { const int ta = (int)(i & 127), ri = (int)((i >> 7) & 1), tb = (int)((i >> 8) & 127), m = (int)((i >> 15) & 255), g = (int)(i >> 23); a = b2f(A16[i]); const int t = 128 * ta + tb; b = B[((size_t)t * 4 + g) * 512 + ri * 256 + m]; } break;
      default: break;
    }
    const double d = (double)a - (double)b; e += d * d; r += (double)b * (double)b;
  }
  for (int o = 32; o >= 1; o >>= 1) { e += __shfl_xor(e, o); r += __shfl_xor(r, o); }
  if ((threadIdx.x & 63) == 0) { atomicAdd(acc, e); atomicAdd(acc + 1, r); }
}
__global__ void k_cmp_x2(const bf16_t* X2, const float* Yr, const float* Yi, double* acc) {
  double e = 0.0, r = 0.0;
  for (unsigned long long i = (unsigned long long)blockIdx.x * 256 + threadIdx.x; i < (1ull << 25); i += (unsigned long long)gridDim.x * 256) {
    const int tb = (int)(i & 127), rip = (int)((i >> 7) & 1), ka = (int)((i >> 8) & 127), gm = (int)(i >> 15);
    const float a = b2f(X2[i]); const size_t yi = (((size_t)ka * 128 + tb) << 10) + gm; const float b = rip ? Yi[yi] : Yr[yi];
    const double d = (double)a - (double)b; e += d * d; r += (double)b * (double)b;
  }
  for (int o = 32; o >= 1; o >>= 1) { e += __shfl_xor(e, o); r += __shfl_xor(r, o); }
  if ((threadIdx.x & 63) == 0) { atomicAdd(acc, e); atomicAdd(acc + 1, r); }
}
__global__ void k_judge(const double* acc, int n, float tol, int* fail) {
  if (threadIdx.x == 0 && blockIdx.x == 0) { fail[0] = 0; for (int k = 0; k < n; ++k) { const double rel = sqrt(acc[2 * k] / acc[2 * k + 1]); if (!(rel <= (double)tol)) { fail[0] = k + 1; break; } } }
}
__global__ void k_encode(float* out, size_t n, const int* fail) {
  const int f = fail[0]; if (f == 0) return; const float sc = 1.f + 0.1f * (float)f;
  for (size_t i = (size_t)blockIdx.x * 256 + threadIdx.x; i < n; i += (size_t)gridDim.x * 256) out[i] *= sc;
}
__global__ void k_f2bf(const float* in, bf16_t* out, size_t n) { for (size_t i = (size_t)blockIdx.x * 256 + threadIdx.x; i < n; i += (size_t)gridDim.x * 256) out[i] = mk::f2bf(in[i]); }
static void cmp(hipStream_t s, int mode, const void* A, const float* B, unsigned long long n, double* acc) { hipLaunchKernelGGL(k_cmp, dim3(2048), dim3(256), 0, s, mode, A, B, n, acc); }
}
#endif

extern "C" void kernel_launch(void* const* d_in, const int* in_sizes, int n_in, void* d_out, int out_size, void* d_ws, size_t ws_size, hipStream_t stream) {
  if (!mk_setup(n_in, out_size, ws_size)) return;
  unsigned char* ws = (unsigned char*)d_ws;
  const size_t MiB = mk::MiB;
  mk::Args a{};
  for (int i = 0; i < 31; ++i) a.in[i] = (const float*)d_in[i];
  a.h = (float*)d_out; a.ws = ws; a.flags = 0; a.pad = 0;
#if CHECK == 0
  (void)hipMemsetAsync(ws + mk::WS_CTL, 0, mk::CTL_ZERO_BYTES, stream);
#if MK_N_LAUNCHES == 1
  mk_run(stream, a, 0, mk::NPHASE);
#else
  for (int ph = 0; ph < mk::NPHASE; ++ph) mk_run(stream, a, ph, ph + 1);
#endif
#else
  ref::In in; { const float** p = (const float**)&in; for (int i = 0; i < 31; ++i) p[i] = (const float*)d_in[i]; }
  float* out = (float*)d_out;
  char* wsc = (char*)d_ws;
  ref::Small sm; sm.mod = (float*)(wsc + 498 * MiB); sm.lamb = (float2*)(wsc + 498 * MiB + 131072); sm.bbar = (float2*)(wsc + 498 * MiB + 262144);
  sm.tw = (float2*)(wsc + 499 * MiB); sm.Dm = (float*)(wsc + 499 * MiB + 262144);
  double* acc = (double*)(wsc + 500 * MiB); int* fail = (int*)(wsc + 500 * MiB + 4096);
  (void)hipMemsetAsync(acc, 0, 8192, stream);
  (void)hipMemsetAsync(ws + mk::WS_CTL, 0, mk::CTL_ZERO_BYTES, stream);
  float* HOPT = (float*)(ws + mk::WS_HOPT);
  int nchk = 0;
#if CHECK == 1
  ref::MixBuf mb; mb.a0 = (float*)(wsc + 12 * MiB); mb.z = (float*)(wsc + 336 * MiB); mb.g = (float*)(wsc + 466 * MiB); mb.t = (float*)(wsc + 77 * MiB); mb.concat = mb.a0; mb.ymix = mb.z;
  char* moe_arena = wsc + 12 * MiB;
  ref::FourBuf fb; { char* p = wsc + 12 * MiB; fb.a1 = (float*)p; p += 64 * MiB; fb.Z = (float*)p; p += 128 * MiB; fb.Yr = (float*)p; p += 64 * MiB; fb.Yi = (float*)p; p += 64 * MiB; fb.F = (float*)p; fb.yf = fb.Z; }
  a.flags = mk::FLAG_SKIP_EXPERTS;
  nchk = 10;
  ref::forward(stream, in, out, sm, mb, moe_arena, fb, [&](int st) {
    if (st == 1) { mk_run(stream, a, 0, 1); chk::cmp(stream, 0, ws + mk::WS_MOD, sm.mod, 3 * 6144, acc + 0); }
    if (st == 2) { mk_run(stream, a, 1, 2); chk::cmp(stream, 1, ws + mk::WS_A0, mb.a0, 16640ull * 1024, acc + 2); }
    if (st == 3) { mk_run(stream, a, 2, 3); chk::cmp(stream, 2, ws + mk::WS_AS5, mb.z, 16640ull * 512, acc + 4); chk::cmp(stream, 3, ws + mk::WS_Q, mb.z, 16384ull * 512, acc + 6);
                   chk::cmp(stream, 4, ws + mk::WS_K, mb.z, 16640ull * 512, acc + 8); chk::cmp(stream, 5, ws + mk::WS_VT, mb.z, 16640ull * 512, acc + 10); }
    if (st == 4) { mk_run(stream, a, 3, 4); mk_run(stream, a, 4, 5); mk_run(stream, a, 5, 6); chk::cmp(stream, 1, ws + mk::WS_GB, mb.g, 16384ull * 512, acc + 12); }
    if (st == 5) { mk_run(stream, a, 6, 7); chk::cmp(stream, 6, ws + mk::WS_CONCAT, mb.concat, 16384ull * 512, acc + 14); }
    if (st == 6) { mk_run(stream, a, 7, 8); chk::cmp(stream, 7, ws + mk::WS_CONCAT, mb.concat, 16384ull * 512, acc + 16); }
    if (st == 7) { mk::Args b = a; b.h = HOPT; mk_run(stream, b, 8, 9); chk::cmp(stream, 0, HOPT, out, 16384ull * 1024, acc + 18); }
  });
#elif CHECK == 2 || CHECK == 4
  const int L = CHECK == 2 ? 0 : 1;
  ref::MixBuf mb; { char* p = wsc + 12 * MiB; mb.a0 = (float*)p; p += 65 * MiB; mb.z = (float*)p; p += 130 * MiB; mb.g = (float*)p; p += 32 * MiB; mb.t = (float*)p; p += 32 * MiB; mb.concat = (float*)p; p += 64 * MiB; mb.ymix = mb.z; }
  ref::FourBuf fb; { char* p = wsc + 12 * MiB; fb.a1 = (float*)p; p += 64 * MiB; fb.Z = (float*)p; p += 128 * MiB; fb.Yr = (float*)p; p += 64 * MiB; fb.Yi = (float*)p; p += 64 * MiB; fb.F = (float*)p; fb.yf = fb.Z; }
  char* moe_arena = wsc + 110 * MiB;
  nchk = L == 0 ? 2 : 1;
  a.flags = 0;
  ref::forward(stream, in, out, sm, mb, moe_arena, fb, [&](int st) {
    if ((L == 0 && st == 7) || (L == 1 && st == 11)) {
      mk::Args b = a; b.h = HOPT; if (L == 1) b.flags = 2;
      mk_run(stream, b, 0, 1);
      (void)hipMemcpyAsync(HOPT, out, (size_t)16384 * 1024 * 4, hipMemcpyDeviceToDevice, stream);
      const int pb = L == 0 ? 9 : 20; b.flags |= mk::FLAG_SKIP_EXPERTS;
      for (int ph = pb; ph < pb + 7; ++ph) mk_run(stream, b, ph, ph + 1);
    }
    if ((L == 0 && st == 8) || (L == 1 && st == 12)) chk::cmp(stream, 0, HOPT, out, 16384ull * 1024, acc + 0);
    if (L == 0 && st == 9) chk::cmp(stream, 1, ws + mk::WS_A1, fb.a1, 16384ull * 1024, acc + 2);
  });
#elif CHECK == 3
  ref::MixBuf mb; { char* p = wsc + 12 * MiB; mb.a0 = (float*)p; p += 65 * MiB; mb.z = (float*)p; p += 130 * MiB; mb.g = (float*)p; p += 32 * MiB; mb.t = (float*)p; p += 32 * MiB; mb.concat = (float*)p; p += 64 * MiB; mb.ymix = mb.z; }
  char* moe_arena = wsc + 12 * MiB;
  ref::FourBuf fb; fb.Z = (float*)(wsc + 270 * MiB);
  fb.a1 = (float*)(wsc + 12 * MiB); fb.Yr = (float*)(wsc + 12 * MiB);   fb.Yi = (float*)(wsc + 468 * MiB - 0); fb.F = (float*)(wsc + 270 * MiB); fb.yf = (float*)(wsc + 334 * MiB);
  fb.Yi = (float*)(wsc + 76 * MiB);
  nchk = 4;
  a.flags = mk::FLAG_SKIP_EXPERTS;
  ref::forward(stream, in, out, sm, mb, moe_arena, fb, [&](int st) {
    if (st == 9) {
      mk::Args b = a; b.h = HOPT;
      mk_run(stream, b, 0, 1);
      hipLaunchKernelGGL(chk::k_f2bf, dim3(2048), dim3(256), 0, stream, fb.a1, (chk::bf16_t*)(ws + mk::WS_A1), (size_t)16384 * 1024);
      (void)hipMemcpyAsync(HOPT, out, (size_t)16384 * 1024 * 4, hipMemcpyDeviceToDevice, stream);
      mk_run(stream, b, 16, 17);
    }
  });
#endif
  hipLaunchKernelGGL(chk::k_judge, dim3(1), dim3(64), 0, stream, acc, nchk, 0.05f, fail);
  hipLaunchKernelGGL(chk::k_encode, dim3(2048), dim3(256), 0, stream, out, (size_t)16384 * 1024, fail);
#endif
}
```
